# Optimizing an MI355X kernel written in HIP

```python
import jax, jax.numpy as jnp
from jax import lax
import numpy as np

D_MODEL = 1024
BATCH = 8
SEQ = 4096
DEPTH = 2

CHUNK = 64
EXPAND = 2
D_INNER = EXPAND * D_MODEL
POOL_WINDOWS = (2, 4, 8, 16)
N_POOL_GROUPS = len(POOL_WINDOWS)
POOL_GROUP = D_INNER // N_POOL_GROUPS
HGRN_HEAD_DIM = 128
HGRN_HEADS = D_INNER // HGRN_HEAD_DIM
N_MIXERS = 2
N_POOL_LAYERS = (DEPTH + 1) // 2
N_HGRN_LAYERS = DEPTH // 2
EPS = 1e-6

kernel_name = "hybrid_pool_hgrn2_stream_encoder"


def rms_norm(x, g):
    xf = x.astype(jnp.float32)
    y = xf * lax.rsqrt(jnp.mean(xf * xf, axis=-1, keepdims=True) + EPS)
    return (y * g.astype(jnp.float32)).astype(x.dtype)


def multiscale_pool(v):
    T = v.shape[1]
    vf = v.astype(jnp.float32)
    cs = jnp.cumsum(vf, axis=1)
    pos = jnp.arange(T, dtype=jnp.float32)
    outs = []
    for g, w in enumerate(POOL_WINDOWS):
        lo, hi = g * POOL_GROUP, (g + 1) * POOL_GROUP
        c = cs[..., lo:hi]
        prev = jnp.pad(c[:, :-w], ((0, 0), (w, 0), (0, 0)))
        cnt = jnp.minimum(pos + 1.0, float(w))[None, :, None]
        outs.append((c - prev) / cnt - vf[..., lo:hi])
    return jnp.stack(outs, axis=2).astype(v.dtype)


def pool_mixer(h, w_in, w_grp, scale, w_out):
    B, T, _ = h.shape
    u = h @ w_in
    v, gate = jnp.split(u, 2, axis=-1)
    p = multiscale_pool(v)
    m = jnp.einsum('btgc,gcd->btgd', p, w_grp).reshape(B, T, D_INNER) * scale
    return (m * jax.nn.silu(gate)) @ w_out


def hgrn2_chunk_scan(q, k, v, b):
    _, Bn, H, C, dk = q.shape
    dv = v.shape[-1]
    causal = jnp.tril(jnp.ones((C, C), dtype=bool))

    def step(S, xs):
        qc, kc, vc, bc = xs
        diff = bc[:, :, :, None, :] - bc[:, :, None, :, :]
        diff = jnp.where(causal[None, None, :, :, None], diff, -jnp.inf)
        A = jnp.einsum('bhtd,bhsd,bhtsd->bhts', qc, kc, jnp.exp(diff))
        o = (jnp.einsum('bhts,bhsv->bhtv', A, vc)
             + jnp.einsum('bhtd,bhdv->bhtv', qc * jnp.exp(bc), S))
        b_last = bc[:, :, -1:, :]
        S = (jnp.exp(b_last[:, :, 0, :])[..., None] * S
             + jnp.einsum('bhsd,bhsv->bhdv', kc * jnp.exp(b_last - bc), vc))
        return S, o

    S0 = jnp.zeros((Bn, H, dk, dv), jnp.float32)
    _, o = lax.scan(step, S0, (q, k, v, b))
    return o


def hgrn2_mixer(h, w_in, lb, norm_g, w_out):
    B, T, _ = h.shape
    N = T // CHUNK
    u = h @ w_in
    q, fz, i, gate = jnp.split(u, 4, axis=-1)
    fz = fz.astype(jnp.float32)
    lbf = lb.astype(jnp.float32)
    log_f = jnp.logaddexp(jnp.log(lbf), jnp.log1p(-lbf) + jax.nn.log_sigmoid(fz))
    k = (1.0 - lbf) * jax.nn.sigmoid(-fz)

    def to_chunks(a):
        return a.astype(jnp.float32).reshape(B, N, CHUNK, HGRN_HEADS, HGRN_HEAD_DIM).transpose(1, 0, 3, 2, 4)

    qc, kc, vc, lfc = to_chunks(q), to_chunks(k), to_chunks(i), to_chunks(log_f)
    bc = jnp.cumsum(lfc, axis=3)
    o = hgrn2_chunk_scan(qc, kc, vc, bc)
    o = o.transpose(1, 0, 3, 2, 4).reshape(B, T, HGRN_HEADS, HGRN_HEAD_DIM)
    o = o * lax.rsqrt(jnp.mean(o * o, axis=-1, keepdims=True) + EPS)
    o = (o * norm_g.astype(jnp.float32).reshape(HGRN_HEADS, HGRN_HEAD_DIM)).reshape(B, T, D_INNER)
    o = o.astype(h.dtype)
    return (o * jax.nn.silu(gate)) @ w_out


def setup_inputs(seed: int = 0) -> dict:
    key = jax.random.key(seed)
    ks = jax.random.split(key, 12)
    f32 = jnp.float32
    x = jax.random.normal(ks[0], (BATCH, SEQ, D_MODEL), f32)
    norm_g = 1.0 + 0.05 * jax.random.normal(ks[1], (DEPTH, D_MODEL), f32)
    pool_w_in = jax.random.normal(ks[2], (N_POOL_LAYERS, D_MODEL, 2 * D_INNER), f32) * D_MODEL ** -0.5
    pool_w_grp = jax.random.normal(ks[3], (N_POOL_LAYERS, N_POOL_GROUPS, POOL_GROUP, POOL_GROUP), f32) * POOL_GROUP ** -0.5
    pool_scale = 1.0 + 0.1 * jax.random.normal(ks[4], (N_POOL_LAYERS, D_INNER), f32)
    pool_w_out = jax.random.normal(ks[5], (N_POOL_LAYERS, D_INNER, D_MODEL), f32) * D_INNER ** -0.5
    hgrn_w_in = jax.random.normal(ks[6], (N_HGRN_LAYERS, D_MODEL, 4 * D_INNER), f32) * D_MODEL ** -0.5
    hgrn_lower_bounds = 0.5 * jax.random.normal(ks[7], (DEPTH, D_INNER), f32)
    hgrn_norm_g = 1.0 + 0.05 * jax.random.normal(ks[8], (N_HGRN_LAYERS, D_INNER), f32)
    hgrn_w_out = jax.random.normal(ks[9], (N_HGRN_LAYERS, D_INNER, D_MODEL), f32) * D_INNER ** -0.5
    final_g = 1.0 + 0.05 * jax.random.normal(ks[10], (D_MODEL,), f32)
    return {"x": x, "norm_g": norm_g, "pool_w_in": pool_w_in, "pool_w_grp": pool_w_grp,
            "pool_scale": pool_scale, "pool_w_out": pool_w_out, "hgrn_w_in": hgrn_w_in,
            "hgrn_lower_bounds": hgrn_lower_bounds, "hgrn_norm_g": hgrn_norm_g,
            "hgrn_w_out": hgrn_w_out, "final_g": final_g}


def reference(x, norm_g, pool_w_in, pool_w_grp, pool_scale, pool_w_out, hgrn_w_in,
              hgrn_lower_bounds, hgrn_norm_g, hgrn_w_out, final_g):
    p = jax.nn.softmax(hgrn_lower_bounds.astype(jnp.float32), axis=0)
    lbs = jnp.cumsum(p, axis=0) - p[0:1]
    h = x
    for layer in range(DEPTH):
        hn = rms_norm(h, norm_g[layer])
        j = layer // N_MIXERS
        if layer % N_MIXERS == 0:
            y = pool_mixer(hn, pool_w_in[j], pool_w_grp[j], pool_scale[j], pool_w_out[j])
        else:
            y = hgrn2_mixer(hn, hgrn_w_in[j], lbs[layer], hgrn_norm_g[j], hgrn_w_out[j])
        h = h + y.astype(h.dtype)
    return rms_norm(h, final_g)
```

```cpp
#include <hip/hip_runtime.h>
#include <hip/hip_cooperative_groups.h>
#include <cstdio>
#include <cstdint>
namespace cg = cooperative_groups;

#define LAS __attribute__((address_space(3)))
typedef unsigned short bf16_t;
typedef short bf16x8 __attribute__((ext_vector_type(8)));
typedef float f32x4 __attribute__((ext_vector_type(4)));
typedef float f32x2 __attribute__((ext_vector_type(2)));
typedef unsigned u32x4 __attribute__((ext_vector_type(4)));
typedef unsigned u32x2 __attribute__((ext_vector_type(2)));

constexpr int DM = 1024, BATCH = 8, SEQ = 4096, DI = 2048, M = BATCH * SEQ;
constexpr int NHEAD = 16, HD = 128;
constexpr float EPS = 1e-6f;
constexpr size_t MiB = 1u << 20;
constexpr size_t WS_WIN0 = 2 * MiB;
constexpr size_t WS_WGRP = 10 * MiB;
constexpr size_t WS_WOUT0 = 12 * MiB;
constexpr size_t WS_WIN1 = 16 * MiB;
constexpr size_t WS_WOUT1 = 32 * MiB;
constexpr size_t WS_PART1 = 36 * MiB;
constexpr size_t WS_PART2 = 38 * MiB;
constexpr size_t WS_SS = 40 * MiB;
constexpr size_t WS_XB = 48 * MiB;
constexpr size_t WS_A = 128 * MiB;
constexpr size_t WS_B = 256 * MiB;
constexpr size_t WS_C = 384 * MiB;
constexpr size_t WS_END = 512 * MiB;
constexpr int LDS_BYTES = 147456;

__device__ __forceinline__ unsigned f2bf(float f) { unsigned u = __builtin_bit_cast(unsigned, f); return (u + 0x7fffu + ((u >> 16) & 1u)) >> 16; }
__device__ __forceinline__ unsigned pk2(float lo, float hi) { return f2bf(lo) | (f2bf(hi) << 16); }
__device__ __forceinline__ float bf_lo(unsigned w) { return __builtin_bit_cast(float, w << 16); }
__device__ __forceinline__ float bf_hi(unsigned w) { return __builtin_bit_cast(float, w & 0xffff0000u); }
__device__ __forceinline__ float silu_f(float x) { return x * __builtin_amdgcn_rcpf(1.0f + __builtin_amdgcn_exp2f(-1.44269504089f * x)); }
__device__ __forceinline__ float wave_sum(float v) {
#pragma unroll
    for (int o = 1; o < 64; o <<= 1) v += __shfl_xor(v, o);
    return v;
}

namespace pg8 {
constexpr int BM = 256, BK = 64, HALF = 128, HTB = HALF * BK * 2, STAGE_BYTES = 8 * HTB, NXCD = 8, WGM = 8;
__host__ __device__ __forceinline__ int lds_byte(int r, int c) { const int st = (r >> 4) * 2 + (c >> 5), rr = r & 15, cc = c & 31, ob = rr * 64 + cc * 2; return st * 1024 + (ob ^ (((ob >> 9) & 1) << 5)); }
__host__ __device__ __forceinline__ void stage_rc(int b, int& R, int& C) { const int st = b / 1024, sb = b % 1024, swz = sb ^ (((sb >> 9) & 1) << 5); R = (st >> 1) * 16 + swz / 64; C = (st & 1) * 32 + (swz % 64) / 2; }
__host__ __device__ __forceinline__ int perm32(int rho) { const int n = rho >> 4, i = rho & 15; return 8 * (i >> 2) + 4 * n + (i & 3); }

struct Unit { int pm, pn; };
struct Gemm { const bf16_t* A; const bf16_t* Bt; int lda, ldb, K, grp_tiles; };

struct StaticOrder {
    int nM, nN, nwg, G, c;
    __host__ __device__ void init(int M_, int N_, int G_, int c_) { nM = M_ / BM; nN = N_ / BM; nwg = nM * nN; G = G_; c = c_; }
    __host__ __device__ bool next(int i, Unit& u) const {
        const long L = (long)i * G + c; if (L >= nwg) return false;
        int wgid = (int)L; { const int q = nwg / NXCD, r = nwg % NXCD, xcd = wgid % NXCD, off = wgid / NXCD; wgid = (xcd < r ? xcd * (q + 1) : r * (q + 1) + (xcd - r) * q) + off; }
        const int nig = WGM * nN, gid = wgid / nig, fm = gid * WGM, gsz = (nM - fm) < WGM ? (nM - fm) : WGM;
        u.pm = fm + ((wgid % nig) % gsz); u.pn = (wgid % nig) / gsz; return true;
    }
};

__device__ __forceinline__ unsigned cvt_pk_bf16(float lo, float hi) { unsigned r; asm volatile("v_cvt_pk_bf16_f32 %0, %1, %2" : "=v"(r) : "v"(lo), "v"(hi)); return r; }

template <class Epi, bool ALIGN_EPI = true, bool SP2 = true>
__device__ __forceinline__ void gemm_phase(LAS unsigned char* lds, const Gemm g, const StaticOrder& S, const Epi& E) {
    const int tid = threadIdx.x, wid = __builtin_amdgcn_readfirstlane(tid >> 6), lane = tid & 63, wr = wid >> 2, wc = wid & 3, fr = lane & 15, fq = lane >> 4;
    const int K = g.K, nt = K / BK;
    unsigned voffA[2], voffB[2];
#pragma unroll
    for (int i = 0; i < 2; ++i) { int R, C; stage_rc(tid * 16 + i * 8192, R, C); const int Rb = Epi::PERM ? ((R & ~31) + perm32(R & 31)) : R;
        voffA[i] = (unsigned)(R * g.lda + C) * 2u; voffB[i] = (unsigned)(Rb * g.ldb + C) * 2u; }
    const size_t kstep = (size_t)(BK * 2);
    const size_t hstepA = (size_t)HALF * g.lda * 2, hstepB = (size_t)HALF * g.ldb * 2;
    const size_t tstepA = 2 * hstepA, tstepB = 2 * hstepB;
    const unsigned ldsw = (unsigned)wid * 1024u;
    const int aoff = lds_byte(wr * 64 + fr, fq * 8), boff = lds_byte(wc * 32 + fr, fq * 8);
#define PG8_SA(b, h) (((b) * 2 + (h)) * HTB)
#define PG8_SB(b, h) ((4 + (b) * 2 + (h)) * HTB)
#define PG8_STAGE(bufoff, gbase, voff) do { _Pragma("unroll") for (int _i = 0; _i < 2; ++_i) \
        __builtin_amdgcn_global_load_lds((const unsigned*)((const char*)(gbase) + (voff)[_i]), (LAS unsigned*)(lds + (bufoff) + ldsw + _i * 8192), 16, 0, 0); } while (0)
#define PG8_LDA(dst, b, h) do { _Pragma("unroll") for (int m = 0; m < 4; ++m) _Pragma("unroll") for (int k = 0; k < 2; ++k) dst[m][k] = *(const LAS bf16x8*)(lds + PG8_SA(b, h) + aoff + m * 2048 + k * 1024); } while (0)
#define PG8_LDB(dst, b, h) do { _Pragma("unroll") for (int n = 0; n < 2; ++n) _Pragma("unroll") for (int k = 0; k < 2; ++k) dst[n][k] = *(const LAS bf16x8*)(lds + PG8_SB(b, h) + boff + n * 2048 + k * 1024); } while (0)
#define PG8_MMA(ai, bj, At, Bt) do { __builtin_amdgcn_s_setprio(1); _Pragma("unroll") for (int m = 0; m < 4; ++m) _Pragma("unroll") for (int n = 0; n < 2; ++n) _Pragma("unroll") for (int k = 0; k < 2; ++k) \
        acc[ai][bj][m][n] = __builtin_amdgcn_mfma_f32_16x16x32_bf16(Bt[n][k], At[m][k], acc[ai][bj][m][n], 0, 0, 0); __builtin_amdgcn_s_setprio(0); } while (0)
#define PG8_WAIT_V(n) asm volatile("s_waitcnt vmcnt(" #n ")" ::: "memory")
#define PG8_WAIT_L(n) asm volatile("s_waitcnt lgkmcnt(" #n ")" ::: "memory")
#define PG8_BAR __builtin_amdgcn_s_barrier()
#define PG8_SCHED __builtin_amdgcn_sched_barrier(0)
#define PG8_ABASE(u) ((const char*)g.A + (size_t)(u).pm * tstepA + (g.grp_tiles ? (size_t)((u).pn / g.grp_tiles) * (size_t)K * 2 : (size_t)0))
#define PG8_BBASE(u) ((const char*)g.Bt + (size_t)(u).pn * tstepB)
    Unit cur, nxt; int ui = 0;
    if (!S.next(0, cur)) return;
    f32x4 acc[2][2][4][2];
#pragma unroll
    for (int a = 0; a < 2; ++a)
#pragma unroll
        for (int b = 0; b < 2; ++b)
#pragma unroll
            for (int m = 0; m < 4; ++m)
#pragma unroll
                for (int n = 0; n < 2; ++n) acc[a][b][m][n] = (f32x4){0.f, 0.f, 0.f, 0.f};
    bf16x8 At[4][2], B0[2][2], B1[2][2];
    const char* cA = PG8_ABASE(cur); const char* cB = PG8_BBASE(cur);
    if constexpr (SP2) {
        PG8_STAGE(PG8_SB(0, 0), cB, voffB); PG8_STAGE(PG8_SB(0, 1), cB + hstepB, voffB); PG8_STAGE(PG8_SA(0, 0), cA, voffA); PG8_STAGE(PG8_SA(0, 1), cA + hstepA, voffA);
        if (wr == 1) PG8_BAR;
        PG8_WAIT_V(2); PG8_BAR;
        PG8_STAGE(PG8_SB(1, 0), cB + kstep, voffB); PG8_STAGE(PG8_SA(1, 0), cA + kstep, voffA); PG8_STAGE(PG8_SB(1, 1), cB + hstepB + kstep, voffB);
        PG8_WAIT_V(6); PG8_BAR;
    } else {
        PG8_STAGE(PG8_SB(0, 0), cB, voffB); PG8_STAGE(PG8_SA(0, 0), cA, voffA); PG8_STAGE(PG8_SB(0, 1), cB + hstepB, voffB); PG8_STAGE(PG8_SA(0, 1), cA + hstepA, voffA);
        if (wr == 1) PG8_BAR;
        PG8_WAIT_V(4); PG8_BAR;
        PG8_STAGE(PG8_SB(1, 0), cB + kstep, voffB); PG8_STAGE(PG8_SA(1, 0), cA + kstep, voffA); PG8_STAGE(PG8_SB(1, 1), cB + hstepB + kstep, voffB);
        PG8_WAIT_V(6); PG8_BAR;
    }
    for (;;) {
        const bool has_next = S.next(ui + 1, nxt);
        const char* nA = has_next ? PG8_ABASE(nxt) : cA; const char* nB = has_next ? PG8_BBASE(nxt) : cB;
        for (int t = 0; t < nt; t += 2) {
            const bool last = (t == nt - 2);
            const char* a1 = cA + (size_t)(t + 1) * kstep;
            const char* a2 = last ? nA : cA + (size_t)(t + 2) * kstep; const char* b2 = last ? nB : cB + (size_t)(t + 2) * kstep;
            const char* a3 = a2 + kstep; const char* b3 = b2 + kstep;
            if constexpr (SP2) {
            PG8_LDB(B0, 0, 0); PG8_LDB(B1, 0, 1); PG8_SCHED; PG8_LDA(At, 0, 0); PG8_STAGE(PG8_SA(1, 1), a1 + hstepA, voffA);
            PG8_WAIT_V(8); PG8_WAIT_L(0); PG8_BAR; PG8_MMA(0, 0, At, B0); PG8_MMA(0, 1, At, B1); PG8_BAR; PG8_SCHED;
            PG8_LDA(At, 0, 1); PG8_STAGE(PG8_SB(0, 0), b2, voffB); PG8_STAGE(PG8_SB(0, 1), b2 + hstepB, voffB); PG8_STAGE(PG8_SA(0, 0), a2, voffA);
            PG8_WAIT_V(8); PG8_WAIT_L(0); PG8_BAR; PG8_MMA(1, 0, At, B0); PG8_MMA(1, 1, At, B1); PG8_BAR; PG8_SCHED;
            PG8_LDB(B0, 1, 0); PG8_LDB(B1, 1, 1); PG8_SCHED; PG8_LDA(At, 1, 0); PG8_STAGE(PG8_SA(0, 1), a2 + hstepA, voffA);
            PG8_WAIT_V(8); PG8_WAIT_L(0); PG8_BAR; PG8_MMA(0, 0, At, B0); PG8_MMA(0, 1, At, B1); PG8_BAR; PG8_SCHED;
            PG8_LDA(At, 1, 1); PG8_STAGE(PG8_SB(1, 0), b3, voffB); PG8_STAGE(PG8_SB(1, 1), b3 + hstepB, voffB); PG8_STAGE(PG8_SA(1, 0), a3, voffA);
            PG8_WAIT_V(8); PG8_WAIT_L(0); PG8_BAR; PG8_MMA(1, 0, At, B0); PG8_MMA(1, 1, At, B1); PG8_BAR; PG8_SCHED;
            } else {
            PG8_LDB(B0, 0, 0); PG8_SCHED; PG8_LDA(At, 0, 0); PG8_STAGE(PG8_SA(1, 1), a1 + hstepA, voffA);
            PG8_WAIT_L(8); PG8_BAR; PG8_WAIT_L(0); PG8_MMA(0, 0, At, B0); PG8_BAR; PG8_SCHED;
            PG8_LDB(B1, 0, 1); PG8_STAGE(PG8_SB(0, 0), b2, voffB);
            PG8_BAR; PG8_WAIT_L(0); PG8_MMA(0, 1, At, B1); PG8_BAR;
            PG8_LDA(At, 0, 1); PG8_STAGE(PG8_SA(0, 0), a2, voffA);
            PG8_BAR; PG8_WAIT_L(0); PG8_MMA(1, 0, At, B0); PG8_BAR; PG8_SCHED;
            PG8_STAGE(PG8_SB(0, 1), b2 + hstepB, voffB);
            PG8_WAIT_V(6); PG8_BAR; PG8_MMA(1, 1, At, B1); PG8_BAR;
            PG8_LDB(B0, 1, 0); PG8_SCHED; PG8_LDA(At, 1, 0); PG8_STAGE(PG8_SA(0, 1), a2 + hstepA, voffA);
            PG8_WAIT_L(8); PG8_BAR; PG8_WAIT_L(0); PG8_MMA(0, 0, At, B0); PG8_BAR; PG8_SCHED;
            PG8_LDB(B1, 1, 1); PG8_STAGE(PG8_SB(1, 0), b3, voffB);
            PG8_BAR; PG8_WAIT_L(0); PG8_MMA(0, 1, At, B1); PG8_BAR;
            PG8_LDA(At, 1, 1); PG8_STAGE(PG8_SA(1, 0), a3, voffA);
            PG8_BAR; PG8_WAIT_L(0); PG8_MMA(1, 0, At, B0); PG8_BAR; PG8_SCHED;
            PG8_STAGE(PG8_SB(1, 1), b3 + hstepB, voffB);
            PG8_WAIT_V(6); PG8_BAR; PG8_MMA(1, 1, At, B1); PG8_BAR;
            }
        }
        if constexpr (ALIGN_EPI) { if (wr == 0) PG8_BAR; }
        E(acc, cur, wr, wc, fr, fq);
        if (!has_next) break;
#pragma unroll
        for (int a = 0; a < 2; ++a)
#pragma unroll
            for (int b = 0; b < 2; ++b)
#pragma unroll
                for (int m = 0; m < 4; ++m)
#pragma unroll
                    for (int n = 0; n < 2; ++n) acc[a][b][m][n] = (f32x4){0.f, 0.f, 0.f, 0.f};
        cur = nxt; cA = nA; cB = nB; ++ui;
        if constexpr (ALIGN_EPI) { if (wr == 1) PG8_BAR; }
    }
    PG8_WAIT_V(0);
    if constexpr (!ALIGN_EPI) { if (wr == 0) PG8_BAR; }
    PG8_BAR;
#undef PG8_SA
#undef PG8_SB
#undef PG8_STAGE
#undef PG8_LDA
#undef PG8_LDB
#undef PG8_MMA
#undef PG8_WAIT_V
#undef PG8_WAIT_L
#undef PG8_BAR
#undef PG8_SCHED
#undef PG8_ABASE
#undef PG8_BBASE
}

struct EpiP1 {
    static constexpr bool PERM = true;
    bf16_t* V; bf16_t* SG;
    __device__ __forceinline__ void operator()(const f32x4 (&acc)[2][2][4][2], const Unit& u, int wr, int wc, int fr, int fq) const {
        const int row0 = u.pm * BM + wr * 64 + fr; const bool gate = u.pn >= 8;
        bf16_t* base = gate ? SG : V; const int col0 = (u.pn & 7) * BM + wc * 32 + 8 * fq;
#pragma unroll
        for (int ai = 0; ai < 2; ++ai)
#pragma unroll
            for (int m = 0; m < 4; ++m) { bf16_t* rowp = base + (size_t)(row0 + ai * HALF + m * 16) * DI + col0;
#pragma unroll
                for (int bj = 0; bj < 2; ++bj) { f32x4 v0 = acc[ai][bj][m][0], v1 = acc[ai][bj][m][1];
                    if (gate) {
#pragma unroll
                        for (int j = 0; j < 4; ++j) { v0[j] = silu_f(v0[j]); v1[j] = silu_f(v1[j]); } }
                    u32x4 w; w.x = cvt_pk_bf16(v0[0], v0[1]); w.y = cvt_pk_bf16(v0[2], v0[3]); w.z = cvt_pk_bf16(v1[0], v1[1]); w.w = cvt_pk_bf16(v1[2], v1[3]);
                    *(u32x4*)(rowp + bj * HALF) = w; } }
    }
};
struct EpiP2 {
    static constexpr bool PERM = true;
    bf16_t* Z;
    __device__ __forceinline__ void operator()(const f32x4 (&acc)[2][2][4][2], const Unit& u, int wr, int wc, int fr, int fq) const {
        const int row0 = u.pm * BM + wr * 64 + fr; const int col0 = u.pn * BM + wc * 32 + 8 * fq;
#pragma unroll
        for (int ai = 0; ai < 2; ++ai)
#pragma unroll
            for (int m = 0; m < 4; ++m) { bf16_t* rowp = Z + (size_t)(row0 + ai * HALF + m * 16) * DI + col0;
#pragma unroll
                for (int bj = 0; bj < 2; ++bj) { const f32x4 v0 = acc[ai][bj][m][0], v1 = acc[ai][bj][m][1];
                    const u32x4 s = *(const u32x4*)(rowp + bj * HALF);
                    u32x4 w; w.x = cvt_pk_bf16(v0[0] * bf_lo(s.x), v0[1] * bf_hi(s.x)); w.y = cvt_pk_bf16(v0[2] * bf_lo(s.y), v0[3] * bf_hi(s.y));
                    w.z = cvt_pk_bf16(v1[0] * bf_lo(s.z), v1[1] * bf_hi(s.z)); w.w = cvt_pk_bf16(v1[2] * bf_lo(s.w), v1[3] * bf_hi(s.w));
                    *(u32x4*)(rowp + bj * HALF) = w; } }
    }
};
template <bool WRITE_HB> struct EpiRes {
    static constexpr bool PERM = false;
    const float* R; float* H; bf16_t* HB; float* part;
    __device__ __forceinline__ void operator()(const f32x4 (&acc)[2][2][4][2], const Unit& u, int wr, int wc, int fr, int fq) const {
        const int row0 = u.pm * BM + wr * 64 + fr, col0 = u.pn * BM + wc * 32 + 4 * fq;
#pragma unroll
        for (int ai = 0; ai < 2; ++ai)
#pragma unroll
            for (int m = 0; m < 4; ++m) { const int r = row0 + ai * HALF + m * 16; const size_t off = (size_t)r * DM + col0; float ss = 0.f;
#pragma unroll
                for (int bj = 0; bj < 2; ++bj)
#pragma unroll
                    for (int n = 0; n < 2; ++n) { const f32x4 xv = *(const f32x4*)(R + off + bj * HALF + n * 16); const f32x4 h = xv + acc[ai][bj][m][n];
                        *(f32x4*)(H + off + bj * HALF + n * 16) = h; ss += (h[0] * h[0] + h[1] * h[1]) + (h[2] * h[2] + h[3] * h[3]);
                        if (WRITE_HB) { u32x2 w; w.x = cvt_pk_bf16(h[0], h[1]); w.y = cvt_pk_bf16(h[2], h[3]); *(u32x2*)(HB + off + bj * HALF + n * 16) = w; } }
                ss += __shfl_xor(ss, 16); ss += __shfl_xor(ss, 32);
                if (fq == 0) part[(size_t)r * 16 + u.pn * 4 + wc] = ss;
                asm volatile("" ::: "memory"); }
    }
};
__device__ __forceinline__ float row_rstd(const float* part, int r) {
    const f32x4* p = (const f32x4*)(part + (size_t)r * 16); const f32x4 a = p[0], b = p[1], c = p[2], d = p[3];
    const float s = ((a[0] + a[1]) + (a[2] + a[3])) + ((b[0] + b[1]) + (b[2] + b[3])) + ((c[0] + c[1]) + (c[2] + c[3])) + ((d[0] + d[1]) + (d[2] + d[3]));
    return __builtin_amdgcn_rsqf(s * (1.0f / DM) + EPS);
}
struct EpiP4 {
    static constexpr bool PERM = true;
    bf16_t* Q; _Float16* G; bf16_t* I; const float* part; const float* lbnd;
    __device__ __forceinline__ void operator()(const f32x4 (&acc)[2][2][4][2], const Unit& u, int wr, int wc, int fr, int fq) const {
        const int row0 = u.pm * BM + wr * 64 + fr; const int kind = u.pn >> 3; const int col0 = (u.pn & 7) * BM + wc * 32 + 8 * fq;
        float lb[2][8];
        if (kind == 1) {
#pragma unroll
            for (int bj = 0; bj < 2; ++bj)
#pragma unroll
                for (int j = 0; j < 8; ++j) { const float l0 = lbnd[col0 + bj * HALF + j], l1 = lbnd[DI + col0 + bj * HALF + j]; lb[bj][j] = 1.0f / (1.0f + __expf(l0 - l1)); }
        }
#pragma unroll
        for (int ai = 0; ai < 2; ++ai)
#pragma unroll
            for (int m = 0; m < 4; ++m) { const int r = row0 + ai * HALF + m * 16; const float rs = row_rstd(part, r); const size_t off = (size_t)r * DI + col0;
#pragma unroll
                for (int bj = 0; bj < 2; ++bj) { f32x4 v0 = acc[ai][bj][m][0] * rs, v1 = acc[ai][bj][m][1] * rs;
                    if (kind == 1) {
                        float gl[8];
#pragma unroll
                        for (int j = 0; j < 8; ++j) { const float z = j < 4 ? v0[j & 3] : v1[j & 3]; const float sg = __builtin_amdgcn_rcpf(1.0f + __builtin_amdgcn_exp2f(-1.44269504089f * z));
                            const float f = lb[bj][j] + (1.0f - lb[bj][j]) * sg; gl[j] = __logf(f); }
                        typedef _Float16 h8 __attribute__((ext_vector_type(8)));
                        h8 hv;
#pragma unroll
                        for (int j = 0; j < 8; ++j) hv[j] = (_Float16)gl[j];
                        *(h8*)(G + off + bj * HALF) = hv;
                    } else {
                        u32x4 w; w.x = cvt_pk_bf16(v0[0], v0[1]); w.y = cvt_pk_bf16(v0[2], v0[3]); w.z = cvt_pk_bf16(v1[0], v1[1]); w.w = cvt_pk_bf16(v1[2], v1[3]);
                        *(u32x4*)((kind == 0 ? Q : I) + off + bj * HALF) = w; } } }
    }
};
struct EpiP5b {
    static constexpr bool PERM = true;
    bf16_t* O; const float* part; const float* ss;
    __device__ __forceinline__ void operator()(const f32x4 (&acc)[2][2][4][2], const Unit& u, int wr, int wc, int fr, int fq) const {
        const int row0 = u.pm * BM + wr * 64 + fr; const int col0 = u.pn * BM + wc * 32 + 8 * fq;
#pragma unroll
        for (int ai = 0; ai < 2; ++ai)
#pragma unroll
            for (int m = 0; m < 4; ++m) { const int r = row0 + ai * HALF + m * 16; const float rs = row_rstd(part, r); const size_t off = (size_t)r * DI + col0;
#pragma unroll
                for (int bj = 0; bj < 2; ++bj) { const f32x4 v0 = acc[ai][bj][m][0] * rs, v1 = acc[ai][bj][m][1] * rs;
                    const f32x2 sp = *(const f32x2*)(ss + (size_t)r * 32 + (u.pn * 2 + bj) * 2);
                    const float rh = __builtin_amdgcn_rsqf((sp.x + sp.y) * (1.0f / HD) + EPS);
                    const u32x4 s = *(const u32x4*)(O + off + bj * HALF);
                    u32x4 w; w.x = cvt_pk_bf16(bf_lo(s.x) * rh * silu_f(v0[0]), bf_hi(s.x) * rh * silu_f(v0[1])); w.y = cvt_pk_bf16(bf_lo(s.y) * rh * silu_f(v0[2]), bf_hi(s.y) * rh * silu_f(v0[3]));
                    w.z = cvt_pk_bf16(bf_lo(s.z) * rh * silu_f(v1[0]), bf_hi(s.z) * rh * silu_f(v1[1])); w.w = cvt_pk_bf16(bf_lo(s.w) * rh * silu_f(v1[2]), bf_hi(s.w) * rh * silu_f(v1[3]));
                    *(u32x4*)(O + off + bj * HALF) = w; } }
    }
};
}

struct Args {
    const float* x; const float* norm_g; const float* pool_w_in; const float* pool_w_grp; const float* pool_scale; const float* pool_w_out;
    const float* hgrn_w_in; const float* hgrn_lb; const float* hgrn_norm_g; const float* hgrn_w_out; const float* final_g;
    float* out; unsigned char* ws;
};

__device__ __forceinline__ void transpose_item(const float* W, int K, int N, bf16_t* WT, int row_off, const float* ks, const float* ns, LAS float* scr, int item, int lane) {
    const int nblk = N / 32, kb = item / nblk, nb = item % nblk, k0 = 64 * kb, n0 = 32 * nb;
    const float nsv = ns ? ns[n0 + (lane & 31)] : 1.0f;
#pragma unroll 8
    for (int i = 0; i < 32; ++i) { const int kk = 2 * i + (lane >> 5); float w = W[(size_t)(k0 + kk) * N + n0 + (lane & 31)] * nsv; if (ks) w *= ks[k0 + kk]; scr[kk * 33 + (lane & 31)] = w; }
    asm volatile("s_waitcnt lgkmcnt(0)" ::: "memory");
    const int c = lane & 7;
#pragma unroll
    for (int j = 0; j < 4; ++j) { const int n = (lane >> 3) + 8 * j; const LAS float* s = scr + (8 * c) * 33 + n;
        u32x4 o; o.x = pk2(s[0 * 33], s[1 * 33]); o.y = pk2(s[2 * 33], s[3 * 33]); o.z = pk2(s[4 * 33], s[5 * 33]); o.w = pk2(s[6 * 33], s[7 * 33]);
        *(u32x4*)(WT + (size_t)(row_off + n0 + n) * K + k0 + 8 * c) = o; }
    asm volatile("s_waitcnt lgkmcnt(0)" ::: "memory");
}

__global__ void __launch_bounds__(512, 2) fwd_kernel(Args a) {
    extern __shared__ __attribute__((aligned(16))) unsigned char lds_raw[];
    LAS unsigned char* lds = (LAS unsigned char*)lds_raw;
    cg::grid_group grid = cg::this_grid();
    const int tid = threadIdx.x, lane = tid & 63, wave = __builtin_amdgcn_readfirstlane(tid >> 6);
    const int G = gridDim.x, bid = blockIdx.x;
    const int gw = bid * 8 + wave, NGW = G * 8;
    unsigned char* ws = a.ws;
    bf16_t* Wt_in0 = (bf16_t*)(ws + WS_WIN0); bf16_t* Wt_grp = (bf16_t*)(ws + WS_WGRP); bf16_t* Wt_out0 = (bf16_t*)(ws + WS_WOUT0);
    bf16_t* Wt_in1 = (bf16_t*)(ws + WS_WIN1); bf16_t* Wt_out1 = (bf16_t*)(ws + WS_WOUT1);
    float* part1 = (float*)(ws + WS_PART1); float* part2 = (float*)(ws + WS_PART2); float* ssb = (float*)(ws + WS_SS);
    bf16_t* XB = (bf16_t*)(ws + WS_XB); bf16_t* BA = (bf16_t*)(ws + WS_A); bf16_t* BB = (bf16_t*)(ws + WS_B); bf16_t* BC = (bf16_t*)(ws + WS_C);

    {
        LAS float* scr = (LAS float*)(lds + wave * 16384);
        constexpr int I_IN0 = (DM / 64) * (4096 / 32), I_GRP1 = (512 / 64) * (512 / 32), I_OUT = (DI / 64) * (DM / 32), I_IN1 = (DM / 64) * (8192 / 32);
        constexpr int NITEMS = I_IN0 + 4 * I_GRP1 + I_OUT + I_IN1 + I_OUT;
        for (int it = gw; it < NITEMS; it += NGW) {
            int r = it;
            if (r < I_IN0) { transpose_item(a.pool_w_in, DM, 4096, Wt_in0, 0, a.norm_g, nullptr, scr, r, lane); continue; } r -= I_IN0;
            if (r < 4 * I_GRP1) { const int g = r / I_GRP1; transpose_item(a.pool_w_grp + (size_t)g * 512 * 512, 512, 512, Wt_grp, g * 512, nullptr, a.pool_scale + g * 512, scr, r % I_GRP1, lane); continue; } r -= 4 * I_GRP1;
            if (r < I_OUT) { transpose_item(a.pool_w_out, DI, DM, Wt_out0, 0, nullptr, nullptr, scr, r, lane); continue; } r -= I_OUT;
            if (r < I_IN1) { transpose_item(a.hgrn_w_in, DM, 8192, Wt_in1, 0, a.norm_g + DM, nullptr, scr, r, lane); continue; } r -= I_IN1;
            transpose_item(a.hgrn_w_out, DI, DM, Wt_out1, 0, a.hgrn_norm_g, nullptr, scr, r, lane);
        }
        for (int m = gw; m < M; m += NGW) {
            const f32x4* xr = (const f32x4*)(a.x + (size_t)m * DM) + lane;
            f32x4 v[4]; float s = 0.f;
#pragma unroll
            for (int j = 0; j < 4; ++j) { v[j] = xr[64 * j]; s += (v[j][0] * v[j][0] + v[j][1] * v[j][1]) + (v[j][2] * v[j][2] + v[j][3] * v[j][3]); }
            const float rstd = 1.0f / sqrtf(wave_sum(s) * (1.0f / DM) + EPS);
            unsigned long long* o8 = (unsigned long long*)(XB + (size_t)m * DM) + lane;
#pragma unroll
            for (int j = 0; j < 4; ++j) o8[64 * j] = (unsigned long long)pk2(v[j][0] * rstd, v[j][1] * rstd) | ((unsigned long long)pk2(v[j][2] * rstd, v[j][3] * rstd) << 32);
        }
    }
    grid.sync();

    {
        pg8::Gemm g{XB, Wt_in0, DM, DM, DM, 0}; pg8::StaticOrder S; S.init(M, 4096, G, bid);
        pg8::EpiP1 E{BA, BB};
        pg8::gemm_phase<pg8::EpiP1>(lds, g, S, E);
    }
    grid.sync();

    {
        const size_t nvec = (size_t)M * (DI / 8);
        for (size_t idx = (size_t)bid * 512 + tid; idx < nvec; idx += (size_t)G * 512) {
            const int m = (int)(idx >> 8), cgp = (int)(idx & 255), grp = cgp >> 6, w = 2 << grp, t = m & (SEQ - 1);
            const int cnt = (t + 1) < w ? (t + 1) : w;
            const bf16_t* vp = BA + (size_t)m * DI + cgp * 8;
            float sum[8];
#pragma unroll
            for (int j = 0; j < 8; ++j) sum[j] = 0.f;
            u32x4 v0 = *(const u32x4*)vp;
            for (int k = 0; k < cnt; ++k) { const u32x4 vv = *(const u32x4*)(vp - (size_t)k * DI);
                sum[0] += bf_lo(vv.x); sum[1] += bf_hi(vv.x); sum[2] += bf_lo(vv.y); sum[3] += bf_hi(vv.y); sum[4] += bf_lo(vv.z); sum[5] += bf_hi(vv.z); sum[6] += bf_lo(vv.w); sum[7] += bf_hi(vv.w); }
            const float inv = 1.0f / (float)cnt;
            u32x4 o; o.x = pk2(sum[0] * inv - bf_lo(v0.x), sum[1] * inv - bf_hi(v0.x)); o.y = pk2(sum[2] * inv - bf_lo(v0.y), sum[3] * inv - bf_hi(v0.y));
            o.z = pk2(sum[4] * inv - bf_lo(v0.z), sum[5] * inv - bf_hi(v0.z)); o.w = pk2(sum[6] * inv - bf_lo(v0.w), sum[7] * inv - bf_hi(v0.w));
            *(u32x4*)(BC + (size_t)m * DI + cgp * 8) = o;
        }
    }
    grid.sync();

    {
        pg8::Gemm g{BC, Wt_grp, DI, 512, 512, 2}; pg8::StaticOrder S; S.init(M, DI, G, bid);
        pg8::EpiP2 E{BB};
        pg8::gemm_phase<pg8::EpiP2>(lds, g, S, E);
    }
    grid.sync();

    {
        pg8::Gemm g{BB, Wt_out0, DI, DI, DI, 0}; pg8::StaticOrder S; S.init(M, DM, G, bid);
        pg8::EpiRes<true> E{a.x, a.out, XB, part1};
        pg8::gemm_phase<pg8::EpiRes<true>>(lds, g, S, E);
    }
    grid.sync();

    {
        pg8::Gemm g{XB, Wt_in1, DM, DM, DM, 0}; pg8::StaticOrder S; S.init(M, 6144, G, bid);
        pg8::EpiP4 E{BA, (_Float16*)BB, BC, part1, a.hgrn_lb};
        pg8::gemm_phase<pg8::EpiP4>(lds, g, S, E);
    }
    grid.sync();

    {
        constexpr int CT = 32;
        LAS float* qs = (LAS float*)lds;
        LAS float* fs = (LAS float*)(lds + 16384);
        LAS float* is = (LAS float*)(lds + 32768);
        LAS float* po = (LAS float*)(lds + 40960);
        const _Float16* Gp = (const _Float16*)BB;
        for (int item = bid; item < BATCH * NHEAD * 2; item += G) {
            const int b = item >> 5, h = (item >> 1) & 15, half = item & 1;
            float s[16];
#pragma unroll
            for (int j = 0; j < 16; ++j) s[j] = 0.f;
            for (int t0 = 0; t0 < SEQ; t0 += CT) {
                const size_t tok0 = (size_t)b * SEQ + t0;
                { const int t = tid >> 4, c8 = tid & 15; const size_t off = (tok0 + t) * DI + h * HD + c8 * 8;
                  const u32x4 qv = *(const u32x4*)(BA + off);
                  LAS float* qd = qs + t * 128 + c8 * 8;
                  qd[0] = bf_lo(qv.x); qd[1] = bf_hi(qv.x); qd[2] = bf_lo(qv.y); qd[3] = bf_hi(qv.y); qd[4] = bf_lo(qv.z); qd[5] = bf_hi(qv.z); qd[6] = bf_lo(qv.w); qd[7] = bf_hi(qv.w);
                  typedef _Float16 h8 __attribute__((ext_vector_type(8)));
                  const h8 gv = *(const h8*)(Gp + off);
                  LAS float* fd = fs + t * 128 + c8 * 8;
#pragma unroll
                  for (int j = 0; j < 8; ++j) fd[j] = __expf((float)gv[j]);
                }
                if (tid < 256) { const int t = tid >> 3, c8 = tid & 7; const size_t off = (tok0 + t) * DI + h * HD + half * 64 + c8 * 8;
                  const u32x4 iv = *(const u32x4*)(BC + off);
                  LAS float* id = is + t * 64 + c8 * 8;
                  id[0] = bf_lo(iv.x); id[1] = bf_hi(iv.x); id[2] = bf_lo(iv.y); id[3] = bf_hi(iv.y); id[4] = bf_lo(iv.z); id[5] = bf_hi(iv.z); id[6] = bf_lo(iv.w); id[7] = bf_hi(iv.w);
                }
                __syncthreads();
                for (int t = 0; t < CT; ++t) {
                    const float iv = is[t * 64 + lane];
                    const LAS f32x4* f4 = (const LAS f32x4*)(fs + t * 128 + wave * 16);
                    const LAS f32x4* q4 = (const LAS f32x4*)(qs + t * 128 + wave * 16);
                    float acc = 0.f;
#pragma unroll
                    for (int jj = 0; jj < 4; ++jj) { const f32x4 f = f4[jj], q = q4[jj];
#pragma unroll
                        for (int j = 0; j < 4; ++j) { s[jj * 4 + j] = f[j] * s[jj * 4 + j] + (1.0f - f[j]) * iv; acc += s[jj * 4 + j] * q[j]; } }
                    po[(t * 8 + wave) * 64 + lane] = acc;
                }
                __syncthreads();
                { const int t = tid >> 4, vg = tid & 15;
                  f32x4 o = (f32x4){0.f, 0.f, 0.f, 0.f};
#pragma unroll
                  for (int w = 0; w < 8; ++w) o += *(const LAS f32x4*)(po + (t * 8 + w) * 64 + vg * 4);
                  float ss = (o[0] * o[0] + o[1] * o[1]) + (o[2] * o[2] + o[3] * o[3]);
                  ss += __shfl_xor(ss, 1); ss += __shfl_xor(ss, 2); ss += __shfl_xor(ss, 4); ss += __shfl_xor(ss, 8);
                  u32x2 w2; w2.x = pk2(o[0], o[1]); w2.y = pk2(o[2], o[3]);
                  *(u32x2*)(BC + (tok0 + t) * DI + h * HD + half * 64 + vg * 4) = w2;
                  if (vg == 0) ssb[(tok0 + t) * 32 + h * 2 + half] = ss;
                }
                __syncthreads();
            }
        }
    }
    grid.sync();

    {
        pg8::Gemm g{XB, Wt_in1 + (size_t)6144 * DM, DM, DM, DM, 0}; pg8::StaticOrder S; S.init(M, DI, G, bid);
        pg8::EpiP5b E{BC, part1, ssb};
        pg8::gemm_phase<pg8::EpiP5b>(lds, g, S, E);
    }
    grid.sync();

    {
        pg8::Gemm g{BC, Wt_out1, DI, DI, DI, 0}; pg8::StaticOrder S; S.init(M, DM, G, bid);
        pg8::EpiRes<false> E{a.out, a.out, nullptr, part2};
        pg8::gemm_phase<pg8::EpiRes<false>>(lds, g, S, E);
    }
    grid.sync();

    {
        for (int m = gw; m < M; m += NGW) {
            float p = part2[(size_t)m * 16 + (lane & 15)];
            p += __shfl_xor(p, 1); p += __shfl_xor(p, 2); p += __shfl_xor(p, 4); p += __shfl_xor(p, 8);
            const float rstd = 1.0f / sqrtf(p * (1.0f / DM) + EPS);
            f32x4* orow = (f32x4*)(a.out + (size_t)m * DM) + lane; const f32x4* gr = (const f32x4*)a.final_g + lane;
#pragma unroll
            for (int j = 0; j < 4; ++j) { f32x4 v = orow[64 * j]; const f32x4 gg = gr[64 * j]; v = v * rstd * gg; orow[64 * j] = v; }
        }
    }
}

extern "C" void kernel_launch(void* const* d_in, const int* in_sizes, int n_in, void* d_out, int out_size, void* d_ws, size_t ws_size, hipStream_t stream) {
    static int grid = 0;
    if (grid == 0) {
        if (n_in != 11 || in_sizes[0] != M * DM || out_size != M * DM || ws_size < WS_END) { fprintf(stderr, "kernel_launch: unexpected shapes (n_in %d in0 %d out %d ws %zu)\n", n_in, n_in > 0 ? in_sizes[0] : -1, out_size, ws_size); grid = -1; return; }
        int dev = 0, cus = 0, per = 0;
        if (hipGetDevice(&dev) != hipSuccess || hipDeviceGetAttribute(&cus, hipDeviceAttributeMultiprocessorCount, dev) != hipSuccess) { grid = -1; return; }
        if (hipFuncSetAttribute((const void*)fwd_kernel, hipFuncAttributeMaxDynamicSharedMemorySize, LDS_BYTES) != hipSuccess) { fprintf(stderr, "kernel_launch: hipFuncSetAttribute failed\n"); grid = -1; return; }
        if (hipOccupancyMaxActiveBlocksPerMultiprocessor(&per, (const void*)fwd_kernel, 512, LDS_BYTES) != hipSuccess || per < 1) { fprintf(stderr, "kernel_launch: occupancy query says %d\n", per); (void)hipGetLastError(); grid = -1; return; }
        grid = cus;
        fprintf(stderr, "kernel_launch: cus %d per_cu %d grid %d\n", cus, per, grid);
    }
    if (grid < 0) return;
    Args a{};
    a.x = (const float*)d_in[0]; a.norm_g = (const float*)d_in[1]; a.pool_w_in = (const float*)d_in[2]; a.pool_w_grp = (const float*)d_in[3];
    a.pool_scale = (const float*)d_in[4]; a.pool_w_out = (const float*)d_in[5]; a.hgrn_w_in = (const float*)d_in[6]; a.hgrn_lb = (const float*)d_in[7];
    a.hgrn_norm_g = (const float*)d_in[8]; a.hgrn_w_out = (const float*)d_in[9]; a.final_g = (const float*)d_in[10];
    a.out = (float*)d_out; a.ws = (unsigned char*)d_ws;
    void* args[] = {&a};
    hipError_t e = hipLaunchCooperativeKernel((void*)fwd_kernel, dim3(grid), dim3(512), args, LDS_BYTES, stream);
    if (e != hipSuccess) fprintf(stderr, "kernel_launch: cooperative launch failed: %s (grid %d)\n", hipGetErrorString(e), grid);
}
```

```cpp
#include <hip/hip_runtime.h>
#include <hip/hip_cooperative_groups.h>
#include <cstdio>
#include <cstdint>
namespace cg = cooperative_groups;

#define LAS __attribute__((address_space(3)))
typedef unsigned short bf16_t;
typedef short bf16x8 __attribute__((ext_vector_type(8)));
typedef float f32x4 __attribute__((ext_vector_type(4)));
typedef float f32x2 __attribute__((ext_vector_type(2)));
typedef unsigned u32x4 __attribute__((ext_vector_type(4)));
typedef unsigned u32x2 __attribute__((ext_vector_type(2)));

constexpr int DM = 1024, BATCH = 8, SEQ = 4096, DI = 2048, M = BATCH * SEQ;
constexpr int NHEAD = 16, HD = 128;
constexpr float EPS = 1e-6f;
constexpr size_t MiB = 1u << 20;
constexpr size_t WS_WIN0 = 2 * MiB;
constexpr size_t WS_WGRP = 10 * MiB;
constexpr size_t WS_WOUT0 = 12 * MiB;
constexpr size_t WS_WIN1 = 16 * MiB;
constexpr size_t WS_WOUT1 = 32 * MiB;
constexpr size_t WS_PART1 = 36 * MiB;
constexpr size_t WS_PART2 = 38 * MiB;
constexpr size_t WS_DEC = 44 * MiB;
constexpr size_t WS_SS = 112 * MiB;
constexpr size_t WS_XB = 48 * MiB;
constexpr size_t WS_A = 128 * MiB;
constexpr size_t WS_B = 256 * MiB;
constexpr size_t WS_C = 384 * MiB;
constexpr size_t WS_END = 512 * MiB;
constexpr int LDS_BYTES = 147456;

__device__ __forceinline__ unsigned f2bf(float f) { unsigned u = __builtin_bit_cast(unsigned, f); return (u + 0x7fffu + ((u >> 16) & 1u)) >> 16; }
__device__ __forceinline__ unsigned pk2(float lo, float hi) { return f2bf(lo) | (f2bf(hi) << 16); }
typedef __bf16 bf2_t __attribute__((ext_vector_type(2)));
__device__ __forceinline__ unsigned pkbf(float lo, float hi) { f32x2 v = {lo, hi}; return __builtin_bit_cast(unsigned, __builtin_convertvector(v, bf2_t)); }
__device__ __forceinline__ float bf_lo(unsigned w) { return __builtin_bit_cast(float, w << 16); }
__device__ __forceinline__ float bf_hi(unsigned w) { return __builtin_bit_cast(float, w & 0xffff0000u); }
__device__ __forceinline__ float silu_f(float x) { return x * __builtin_amdgcn_rcpf(1.0f + __builtin_amdgcn_exp2f(-1.44269504089f * x)); }
__device__ __forceinline__ float lane_get(float v, int src_lane) { return __builtin_bit_cast(float, __builtin_amdgcn_ds_bpermute(src_lane << 2, __builtin_bit_cast(int, v))); }
__device__ __forceinline__ float xor_get(float v, int lane, int m) { return lane_get(v, lane ^ m); }
__device__ __forceinline__ float wave_sum(float v, int lane) {
#pragma unroll
    for (int o = 1; o < 64; o <<= 1) v += xor_get(v, lane, o);
    return v;
}

namespace pg8 {
constexpr int BM = 256, BK = 64, HALF = 128, HTB = HALF * BK * 2, STAGE_BYTES = 8 * HTB, NXCD = 8, WGM = 8;
__host__ __device__ __forceinline__ int lds_byte(int r, int c) { const int st = (r >> 4) * 2 + (c >> 5), rr = r & 15, cc = c & 31, ob = rr * 64 + cc * 2; return st * 1024 + (ob ^ (((ob >> 9) & 1) << 5)); }
__host__ __device__ __forceinline__ void stage_rc(int b, int& R, int& C) { const int st = b / 1024, sb = b % 1024, swz = sb ^ (((sb >> 9) & 1) << 5); R = (st >> 1) * 16 + swz / 64; C = (st & 1) * 32 + (swz % 64) / 2; }
__host__ __device__ __forceinline__ int perm32(int rho) { const int n = rho >> 4, i = rho & 15; return 8 * (i >> 2) + 4 * n + (i & 3); }

struct Unit { int pm, pn; };
struct Gemm { const bf16_t* A; const bf16_t* Bt; int lda, ldb, K, grp_tiles; };

struct StaticOrder {
    int nM, nN, nwg, G, c;
    __host__ __device__ void init(int M_, int N_, int G_, int c_) { nM = M_ / BM; nN = N_ / BM; nwg = nM * nN; G = G_; c = c_; }
    __host__ __device__ bool next(int i, Unit& u) const {
        const long L = (long)i * G + c; if (L >= nwg) return false;
        int wgid = (int)L; { const int q = nwg / NXCD, r = nwg % NXCD, xcd = wgid % NXCD, off = wgid / NXCD; wgid = (xcd < r ? xcd * (q + 1) : r * (q + 1) + (xcd - r) * q) + off; }
        const int nig = WGM * nN, gid = wgid / nig, fm = gid * WGM, gsz = (nM - fm) < WGM ? (nM - fm) : WGM;
        u.pm = fm + ((wgid % nig) % gsz); u.pn = (wgid % nig) / gsz; return true;
    }
};

__device__ __forceinline__ unsigned cvt_pk_bf16(float lo, float hi) { unsigned r; asm volatile("v_cvt_pk_bf16_f32 %0, %1, %2" : "=v"(r) : "v"(lo), "v"(hi)); return r; }

template <class Epi, bool ALIGN_EPI = true, bool SP2 = true>
__device__ __forceinline__ void gemm_phase(LAS unsigned char* lds, const Gemm g, const StaticOrder& S, const Epi& E, const int wid) {
    int lane_ = (int)__builtin_amdgcn_mbcnt_hi(~0u, __builtin_amdgcn_mbcnt_lo(~0u, 0u)); asm volatile("" : "+v"(lane_));
    int lane = lane_, tid = wid * 64 + lane, fr = lane & 15, fq = lane >> 4; const int wr = wid >> 2, wc = wid & 3;
    const int K = g.K, nt = K / BK;
    unsigned voffA[2], voffB[2]; int aoff, boff;
#define PG8_LANE_STATE() do { _Pragma("unroll") for (int i = 0; i < 2; ++i) { int R, C; stage_rc(tid * 16 + i * 8192, R, C); const int Rb = Epi::PERM ? ((R & ~31) + perm32(R & 31)) : R; \
        voffA[i] = (unsigned)(R * g.lda + C) * 2u; voffB[i] = (unsigned)(Rb * g.ldb + C) * 2u; } \
        aoff = lds_byte(wr * 64 + fr, fq * 8); boff = lds_byte(wc * 32 + fr, fq * 8); } while (0)
    PG8_LANE_STATE();
    const size_t kstep = (size_t)(BK * 2);
    const size_t hstepA = (size_t)HALF * g.lda * 2, hstepB = (size_t)HALF * g.ldb * 2;
    const size_t tstepA = 2 * hstepA, tstepB = 2 * hstepB;
    const unsigned ldsw = (unsigned)wid * 1024u;
#define PG8_SA(b, h) (((b) * 2 + (h)) * HTB)
#define PG8_SB(b, h) ((4 + (b) * 2 + (h)) * HTB)
#define PG8_STAGE(bufoff, gbase, voff) do { _Pragma("unroll") for (int _i = 0; _i < 2; ++_i) \
        __builtin_amdgcn_global_load_lds((const unsigned*)((const char*)(gbase) + (voff)[_i]), (LAS unsigned*)(lds + (bufoff) + ldsw + _i * 8192), 16, 0, 0); } while (0)
#define PG8_LDA(dst, b, h) do { _Pragma("unroll") for (int m = 0; m < 4; ++m) _Pragma("unroll") for (int k = 0; k < 2; ++k) dst[m][k] = *(const LAS bf16x8*)(lds + PG8_SA(b, h) + aoff + m * 2048 + k * 1024); } while (0)
#define PG8_LDB(dst, b, h) do { _Pragma("unroll") for (int n = 0; n < 2; ++n) _Pragma("unroll") for (int k = 0; k < 2; ++k) dst[n][k] = *(const LAS bf16x8*)(lds + PG8_SB(b, h) + boff + n * 2048 + k * 1024); } while (0)
#define PG8_MMA(ai, bj, At, Bt) do { __builtin_amdgcn_s_setprio(1); _Pragma("unroll") for (int m = 0; m < 4; ++m) _Pragma("unroll") for (int n = 0; n < 2; ++n) _Pragma("unroll") for (int k = 0; k < 2; ++k) \
        acc[ai][bj][m][n] = __builtin_amdgcn_mfma_f32_16x16x32_bf16(Bt[n][k], At[m][k], acc[ai][bj][m][n], 0, 0, 0); __builtin_amdgcn_s_setprio(0); } while (0)
#define PG8_WAIT_V(n) asm volatile("s_waitcnt vmcnt(" #n ")" ::: "memory")
#define PG8_WAIT_L(n) asm volatile("s_waitcnt lgkmcnt(" #n ")" ::: "memory")
#define PG8_BAR __builtin_amdgcn_s_barrier()
#define PG8_SCHED __builtin_amdgcn_sched_barrier(0)
#define PG8_ABASE(u) ((const char*)g.A + (size_t)(u).pm * tstepA + (g.grp_tiles ? (size_t)((u).pn / g.grp_tiles) * (size_t)K * 2 : (size_t)0))
#define PG8_BBASE(u) ((const char*)g.Bt + (size_t)(u).pn * tstepB)
    Unit cur, nxt; int ui = 0;
    if (!S.next(0, cur)) return;
    f32x4 acc[2][2][4][2];
#pragma unroll
    for (int a = 0; a < 2; ++a)
#pragma unroll
        for (int b = 0; b < 2; ++b)
#pragma unroll
            for (int m = 0; m < 4; ++m)
#pragma unroll
                for (int n = 0; n < 2; ++n) acc[a][b][m][n] = (f32x4){0.f, 0.f, 0.f, 0.f};
    bf16x8 At[4][2], B0[2][2], B1[2][2];
    const char* cA = PG8_ABASE(cur); const char* cB = PG8_BBASE(cur);
    if constexpr (SP2) {
        PG8_STAGE(PG8_SB(0, 0), cB, voffB); PG8_STAGE(PG8_SB(0, 1), cB + hstepB, voffB); PG8_STAGE(PG8_SA(0, 0), cA, voffA); PG8_STAGE(PG8_SA(0, 1), cA + hstepA, voffA);
        if (wr == 1) PG8_BAR;
        PG8_WAIT_V(2); PG8_BAR;
        PG8_STAGE(PG8_SB(1, 0), cB + kstep, voffB); PG8_STAGE(PG8_SA(1, 0), cA + kstep, voffA); PG8_STAGE(PG8_SB(1, 1), cB + hstepB + kstep, voffB);
        PG8_WAIT_V(6); PG8_BAR;
    } else {
        PG8_STAGE(PG8_SB(0, 0), cB, voffB); PG8_STAGE(PG8_SA(0, 0), cA, voffA); PG8_STAGE(PG8_SB(0, 1), cB + hstepB, voffB); PG8_STAGE(PG8_SA(0, 1), cA + hstepA, voffA);
        if (wr == 1) PG8_BAR;
        PG8_WAIT_V(4); PG8_BAR;
        PG8_STAGE(PG8_SB(1, 0), cB + kstep, voffB); PG8_STAGE(PG8_SA(1, 0), cA + kstep, voffA); PG8_STAGE(PG8_SB(1, 1), cB + hstepB + kstep, voffB);
        PG8_WAIT_V(6); PG8_BAR;
    }
    for (;;) {
        const bool has_next = S.next(ui + 1, nxt);
        const char* nA = has_next ? PG8_ABASE(nxt) : cA; const char* nB = has_next ? PG8_BBASE(nxt) : cB;
        for (int t = 0; t < nt; t += 2) {
            const bool last = (t == nt - 2);
            const char* a1 = cA + (size_t)(t + 1) * kstep;
            const char* a2 = last ? nA : cA + (size_t)(t + 2) * kstep; const char* b2 = last ? nB : cB + (size_t)(t + 2) * kstep;
            const char* a3 = a2 + kstep; const char* b3 = b2 + kstep;
            if constexpr (SP2) {
            PG8_LDB(B0, 0, 0); PG8_LDB(B1, 0, 1); PG8_SCHED; PG8_LDA(At, 0, 0); PG8_STAGE(PG8_SA(1, 1), a1 + hstepA, voffA);
            PG8_WAIT_V(8); PG8_WAIT_L(0); PG8_BAR; PG8_MMA(0, 0, At, B0); PG8_MMA(0, 1, At, B1); PG8_BAR; PG8_SCHED;
            PG8_LDA(At, 0, 1); PG8_STAGE(PG8_SB(0, 0), b2, voffB); PG8_STAGE(PG8_SB(0, 1), b2 + hstepB, voffB); PG8_STAGE(PG8_SA(0, 0), a2, voffA);
            PG8_WAIT_V(8); PG8_WAIT_L(0); PG8_BAR; PG8_MMA(1, 0, At, B0); PG8_MMA(1, 1, At, B1); PG8_BAR; PG8_SCHED;
            PG8_LDB(B0, 1, 0); PG8_LDB(B1, 1, 1); PG8_SCHED; PG8_LDA(At, 1, 0); PG8_STAGE(PG8_SA(0, 1), a2 + hstepA, voffA);
            PG8_WAIT_V(8); PG8_WAIT_L(0); PG8_BAR; PG8_MMA(0, 0, At, B0); PG8_MMA(0, 1, At, B1); PG8_BAR; PG8_SCHED;
            PG8_LDA(At, 1, 1); PG8_STAGE(PG8_SB(1, 0), b3, voffB); PG8_STAGE(PG8_SB(1, 1), b3 + hstepB, voffB); PG8_STAGE(PG8_SA(1, 0), a3, voffA);
            PG8_WAIT_V(8); PG8_WAIT_L(0); PG8_BAR; PG8_MMA(1, 0, At, B0); PG8_MMA(1, 1, At, B1); PG8_BAR; PG8_SCHED;
            } else {
            PG8_LDB(B0, 0, 0); PG8_SCHED; PG8_LDA(At, 0, 0); PG8_STAGE(PG8_SA(1, 1), a1 + hstepA, voffA);
            PG8_WAIT_L(8); PG8_BAR; PG8_WAIT_L(0); PG8_MMA(0, 0, At, B0); PG8_BAR; PG8_SCHED;
            PG8_LDB(B1, 0, 1); PG8_STAGE(PG8_SB(0, 0), b2, voffB);
            PG8_BAR; PG8_WAIT_L(0); PG8_MMA(0, 1, At, B1); PG8_BAR;
            PG8_LDA(At, 0, 1); PG8_STAGE(PG8_SA(0, 0), a2, voffA);
            PG8_BAR; PG8_WAIT_L(0); PG8_MMA(1, 0, At, B0); PG8_BAR; PG8_SCHED;
            PG8_STAGE(PG8_SB(0, 1), b2 + hstepB, voffB);
            PG8_WAIT_V(6); PG8_BAR; PG8_MMA(1, 1, At, B1); PG8_BAR;
            PG8_LDB(B0, 1, 0); PG8_SCHED; PG8_LDA(At, 1, 0); PG8_STAGE(PG8_SA(0, 1), a2 + hstepA, voffA);
            PG8_WAIT_L(8); PG8_BAR; PG8_WAIT_L(0); PG8_MMA(0, 0, At, B0); PG8_BAR; PG8_SCHED;
            PG8_LDB(B1, 1, 1); PG8_STAGE(PG8_SB(1, 0), b3, voffB);
            PG8_BAR; PG8_WAIT_L(0); PG8_MMA(0, 1, At, B1); PG8_BAR;
            PG8_LDA(At, 1, 1); PG8_STAGE(PG8_SA(1, 0), a3, voffA);
            PG8_BAR; PG8_WAIT_L(0); PG8_MMA(1, 0, At, B0); PG8_BAR; PG8_SCHED;
            PG8_STAGE(PG8_SB(1, 1), b3 + hstepB, voffB);
            PG8_WAIT_V(6); PG8_BAR; PG8_MMA(1, 1, At, B1); PG8_BAR;
            }
        }
        if constexpr (ALIGN_EPI) { if (wr == 0) PG8_BAR; }
        if constexpr (!Epi::AFTER_DRAIN) E(acc, cur, wr, wc, fr, fq);
        if (!has_next) break;
#pragma unroll
        for (int a = 0; a < 2; ++a)
#pragma unroll
            for (int b = 0; b < 2; ++b)
#pragma unroll
                for (int m = 0; m < 4; ++m)
#pragma unroll
                    for (int n = 0; n < 2; ++n) acc[a][b][m][n] = (f32x4){0.f, 0.f, 0.f, 0.f};
        cur = nxt; cA = nA; cB = nB; ++ui;
        asm volatile("" : "+v"(lane)); tid = wid * 64 + lane; fr = lane & 15; fq = lane >> 4; PG8_LANE_STATE();
        if constexpr (ALIGN_EPI) { if (wr == 1) PG8_BAR; }
    }
    PG8_WAIT_V(0);
    if constexpr (!ALIGN_EPI) { if (wr == 0) PG8_BAR; }
    PG8_BAR;
    if constexpr (Epi::AFTER_DRAIN) E.fused(acc, cur, wr, wc, fr, fq, lds, tid);
#undef PG8_SA
#undef PG8_SB
#undef PG8_STAGE
#undef PG8_LDA
#undef PG8_LDB
#undef PG8_MMA
#undef PG8_WAIT_V
#undef PG8_WAIT_L
#undef PG8_BAR
#undef PG8_SCHED
#undef PG8_ABASE
#undef PG8_LANE_STATE
#undef PG8_BBASE
}

struct EpiP1 {
    static constexpr bool PERM = true, AFTER_DRAIN = false;
    bf16_t* V; bf16_t* SG;
    __device__ __forceinline__ void operator()(f32x4 (&acc)[2][2][4][2], const Unit& u, int wr, int wc, int fr, int fq) const {
        const int row0 = u.pm * BM + wr * 64 + fr; const bool gate = u.pn >= 8;
        bf16_t* base = gate ? SG : V; const int col0 = (u.pn & 7) * BM + wc * 32 + 8 * fq;
#pragma unroll
        for (int ai = 0; ai < 2; ++ai)
#pragma unroll
            for (int m = 0; m < 4; ++m) { bf16_t* rowp = base + (size_t)(row0 + ai * HALF + m * 16) * DI + col0;
#pragma unroll
                for (int bj = 0; bj < 2; ++bj) { f32x4 v0 = acc[ai][bj][m][0], v1 = acc[ai][bj][m][1];
                    if (gate) {
#pragma unroll
                        for (int j = 0; j < 4; ++j) { v0[j] = silu_f(v0[j]); v1[j] = silu_f(v1[j]); } }
                    u32x4 w; w.x = cvt_pk_bf16(v0[0], v0[1]); w.y = cvt_pk_bf16(v0[2], v0[3]); w.z = cvt_pk_bf16(v1[0], v1[1]); w.w = cvt_pk_bf16(v1[2], v1[3]);
                    *(u32x4*)(rowp + bj * HALF) = w; } }
    }
};
struct EpiP2 {
    static constexpr bool PERM = true, AFTER_DRAIN = false;
    bf16_t* Z;
    __device__ __forceinline__ void operator()(f32x4 (&acc)[2][2][4][2], const Unit& u, int wr, int wc, int fr, int fq) const {
        const int row0 = u.pm * BM + wr * 64 + fr; const int col0 = u.pn * BM + wc * 32 + 8 * fq;
#pragma unroll
        for (int ai = 0; ai < 2; ++ai)
#pragma unroll
            for (int m = 0; m < 4; ++m) { bf16_t* rowp = Z + (size_t)(row0 + ai * HALF + m * 16) * DI + col0;
#pragma unroll
                for (int bj = 0; bj < 2; ++bj) { const f32x4 v0 = acc[ai][bj][m][0], v1 = acc[ai][bj][m][1];
                    const u32x4 s = *(const u32x4*)(rowp + bj * HALF);
                    u32x4 w; w.x = cvt_pk_bf16(v0[0] * bf_lo(s.x), v0[1] * bf_hi(s.x)); w.y = cvt_pk_bf16(v0[2] * bf_lo(s.y), v0[3] * bf_hi(s.y));
                    w.z = cvt_pk_bf16(v1[0] * bf_lo(s.z), v1[1] * bf_hi(s.z)); w.w = cvt_pk_bf16(v1[2] * bf_lo(s.w), v1[3] * bf_hi(s.w));
                    *(u32x4*)(rowp + bj * HALF) = w; } }
    }
};
template <bool WRITE_HB> struct EpiRes {
    static constexpr bool PERM = false, AFTER_DRAIN = false;
    const float* R; float* H; bf16_t* HB; float* part;
    __device__ __forceinline__ void operator()(f32x4 (&acc)[2][2][4][2], const Unit& u, int wr, int wc, int fr, int fq) const {
        const unsigned row0 = (unsigned)(u.pm * BM + wr * 64 + fr), col0 = (unsigned)(u.pn * BM + wc * 32 + 4 * fq);
        const unsigned ofs = (row0 * DM + col0) * 4u, pofs = (row0 * 16u + (unsigned)(u.pn * 4 + wc)) * 4u;
#pragma unroll
        for (int ai = 0; ai < 2; ++ai)
#pragma unroll
            for (int m = 0; m < 4; ++m) { const unsigned o = ofs + (unsigned)((ai * HALF + m * 16) * DM) * 4u; float ss = 0.f;
#pragma unroll
                for (int bj = 0; bj < 2; ++bj)
#pragma unroll
                    for (int n = 0; n < 2; ++n) { const unsigned oo = o + (unsigned)(bj * HALF + n * 16) * 4u;
                        const f32x4 xv = *(const f32x4*)((const char*)R + oo); const f32x4 h = xv + acc[ai][bj][m][n];
                        *(f32x4*)((char*)H + oo) = h; ss += (h[0] * h[0] + h[1] * h[1]) + (h[2] * h[2] + h[3] * h[3]);
                        if (WRITE_HB) { u32x2 w; w.x = pkbf(h[0], h[1]); w.y = pkbf(h[2], h[3]); *(u32x2*)((char*)HB + (oo >> 1)) = w; } }
                ss += xor_get(ss, fq * 16 + fr, 16); ss += xor_get(ss, fq * 16 + fr, 32);
                if (fq == 0) *(float*)((char*)part + (pofs + (unsigned)(ai * HALF + m * 16) * 64u)) = ss;
                asm volatile("" ::: "memory"); }
    }
};
__device__ __forceinline__ float row_rstd_b(const float* part, unsigned bofs) {
    const f32x4* p = (const f32x4*)((const char*)part + bofs); const f32x4 a = p[0], b = p[1], c = p[2], d = p[3];
    return __builtin_amdgcn_rsqf((((a[0] + a[1]) + (a[2] + a[3])) + ((b[0] + b[1]) + (b[2] + b[3])) + ((c[0] + c[1]) + (c[2] + c[3])) + ((d[0] + d[1]) + (d[2] + d[3]))) * (1.0f / DM) + EPS);
}
__device__ __forceinline__ float dpp_shr_mul(float v, const int n) {
    const int iv = __builtin_bit_cast(int, v), one = 0x3f800000; int r;
    if (n == 1) r = __builtin_amdgcn_update_dpp(one, iv, 0x111, 0xf, 0xf, false); else if (n == 2) r = __builtin_amdgcn_update_dpp(one, iv, 0x112, 0xf, 0xf, false);
    else if (n == 4) r = __builtin_amdgcn_update_dpp(one, iv, 0x114, 0xf, 0xf, false); else r = __builtin_amdgcn_update_dpp(one, iv, 0x118, 0xf, 0xf, false);
    return v * __builtin_bit_cast(float, r);
}
struct EpiP4 {
    static constexpr bool PERM = true, AFTER_DRAIN = false;
    bf16_t* Qt; bf16_t* Kt; bf16_t* V; float* DEC; const float* part; const float* lbnd;
    __device__ __forceinline__ void operator()(f32x4 (&acc)[2][2][4][2], const Unit& u, int wr, int wc, int fr, int fq) const {
        const unsigned row0 = (unsigned)(u.pm * BM + wr * 64 + fr);
        const unsigned pofs = row0 * 64u;
        if (u.pn >= 16) {
            const unsigned vofs = (row0 * DI + (unsigned)((u.pn - 16) * BM + wc * 32 + 8 * fq)) * 2u;
#pragma unroll
            for (int ai = 0; ai < 2; ++ai)
#pragma unroll
                for (int m = 0; m < 4; ++m) { const float rs = row_rstd_b(part, pofs + (unsigned)(ai * HALF + m * 16) * 64u);
#pragma unroll
                    for (int bj = 0; bj < 2; ++bj) { const f32x4 v0 = acc[ai][bj][m][0] * rs, v1 = acc[ai][bj][m][1] * rs;
                        u32x4 w; w.x = pkbf(v0[0], v0[1]); w.y = pkbf(v0[2], v0[3]); w.z = pkbf(v1[0], v1[1]); w.w = pkbf(v1[2], v1[3]);
                        *(u32x4*)((char*)V + (vofs + (unsigned)((ai * HALF + m * 16) * DI + bj * HALF) * 2u)) = w; }
                    asm volatile("" ::: "memory"); }
            return;
        }
        const unsigned c0 = (unsigned)(u.pn * HD + wc * 32 + 8 * fq);
        const unsigned qofs = (row0 * DI + c0) * 2u;
#pragma unroll
        for (int ai = 0; ai < 2; ++ai) {
            float rs[4];
#pragma unroll
            for (int m = 0; m < 4; ++m) { rs[m] = row_rstd_b(part, pofs + (unsigned)(ai * HALF + m * 16) * 64u); asm volatile("" : "+v"(rs[m]) :: "memory"); }
            unsigned cc = c0; asm volatile("" : "+v"(cc));
#pragma unroll
            for (int n = 0; n < 2; ++n) {
                const f32x4 l0 = *(const f32x4*)((const char*)lbnd + (cc + 4 * n) * 4u), l1 = *(const f32x4*)((const char*)lbnd + (cc + 4 * n + DI) * 4u);
                f32x4 decv;
#pragma unroll
                for (int j = 0; j < 4; ++j) { const float ex = __expf(l0[j] - l1[j]); const float lb = __builtin_amdgcn_rcpf(1.0f + ex), omlb = ex * lb; float bprod = 1.0f;
#pragma unroll
                    for (int m = 0; m < 4; ++m) {
                        const float qv = acc[ai][0][m][n][j] * rs[m], z = acc[ai][1][m][n][j] * rs[m];
                        const float sg = __builtin_amdgcn_rcpf(1.0f + __builtin_amdgcn_exp2f(-1.44269504089f * z));
                        const float f = lb + omlb * sg, k = omlb * (1.0f - sg);
                        float s = f; s = dpp_shr_mul(s, 1); s = dpp_shr_mul(s, 2); s = dpp_shr_mul(s, 4); s = dpp_shr_mul(s, 8);
                        const float E = bprod * s;
                        if (m < 3) bprod *= lane_get(s, fq * 16 + 15);
                        const float Ei = __builtin_amdgcn_rcpf(fmaxf(E, 7.9e-31f));
                        acc[ai][0][m][n][j] = qv * E; acc[ai][1][m][n][j] = k * Ei;
                        if (m == 3) decv[j] = E;
                    } }
                if (fr == 15) *(f32x4*)((char*)DEC + ((unsigned)(u.pm * 4 + ai * 2 + wr) * DI + cc + 4 * n) * 4u) = decv;
            }
#pragma unroll
            for (int m = 0; m < 4; ++m) { const unsigned ob = qofs + (unsigned)((ai * HALF + m * 16) * DI) * 2u;
                u32x4 w; w.x = pkbf(acc[ai][0][m][0][0], acc[ai][0][m][0][1]); w.y = pkbf(acc[ai][0][m][0][2], acc[ai][0][m][0][3]); w.z = pkbf(acc[ai][0][m][1][0], acc[ai][0][m][1][1]); w.w = pkbf(acc[ai][0][m][1][2], acc[ai][0][m][1][3]);
                *(u32x4*)((char*)Qt + ob) = w;
                u32x4 x; x.x = pkbf(acc[ai][1][m][0][0], acc[ai][1][m][0][1]); x.y = pkbf(acc[ai][1][m][0][2], acc[ai][1][m][0][3]); x.z = pkbf(acc[ai][1][m][1][0], acc[ai][1][m][1][1]); x.w = pkbf(acc[ai][1][m][1][2], acc[ai][1][m][1][3]);
                *(u32x4*)((char*)Kt + ob) = x; }
            asm volatile("" ::: "memory");
        }
    }
};
struct EpiP5b {
    static constexpr bool PERM = true, AFTER_DRAIN = false;
    bf16_t* O; const float* part; const float* ss;
    __device__ __forceinline__ void operator()(f32x4 (&acc)[2][2][4][2], const Unit& u, int wr, int wc, int fr, int fq) const {
        const int row0 = u.pm * BM + wr * 64 + fr; const int col0 = u.pn * BM + wc * 32 + 8 * fq;
        const unsigned pofs = (unsigned)row0 * 64u; const float* srow = ss + (size_t)row0 * 128 + u.pn * 16;
        char* op = (char*)(O + (size_t)row0 * DI + col0);
#pragma unroll
        for (int ai = 0; ai < 2; ++ai)
#pragma unroll
            for (int m = 0; m < 4; ++m) { const float rs = row_rstd_b(part, pofs + (unsigned)(ai * HALF + m * 16) * 64u);
#pragma unroll
                for (int bj = 0; bj < 2; ++bj) { const f32x4 v0 = acc[ai][bj][m][0] * rs, v1 = acc[ai][bj][m][1] * rs;
                    const f32x4* sp = (const f32x4*)(srow + (size_t)(ai * HALF + m * 16) * 128 + bj * 8); const f32x4 s0 = sp[0], s1 = sp[1];
                    const float rh = __builtin_amdgcn_rsqf((((s0[0] + s0[1]) + (s0[2] + s0[3])) + ((s1[0] + s1[1]) + (s1[2] + s1[3]))) * (1.0f / HD) + EPS);
                    u32x4* optr = (u32x4*)(op + (size_t)((ai * HALF + m * 16) * DI + bj * HALF) * 2);
                    const u32x4 s = *optr;
                    u32x4 w; w.x = pkbf(bf_lo(s.x) * rh * silu_f(v0[0]), bf_hi(s.x) * rh * silu_f(v0[1])); w.y = pkbf(bf_lo(s.y) * rh * silu_f(v0[2]), bf_hi(s.y) * rh * silu_f(v0[3]));
                    w.z = pkbf(bf_lo(s.z) * rh * silu_f(v1[0]), bf_hi(s.z) * rh * silu_f(v1[1])); w.w = pkbf(bf_lo(s.w) * rh * silu_f(v1[2]), bf_hi(s.w) * rh * silu_f(v1[3]));
                    *optr = w; }
                asm volatile("" ::: "memory"); }
    }
};
}

struct Args {
    const float* x; const float* norm_g; const float* pool_w_in; const float* pool_w_grp; const float* pool_scale; const float* pool_w_out;
    const float* hgrn_w_in; const float* hgrn_lb; const float* hgrn_norm_g; const float* hgrn_w_out; const float* final_g;
    float* out; unsigned char* ws;
};

__device__ __forceinline__ void transpose_item(const float* W, int K, int N, bf16_t* WT, int row_off, const float* ks, const float* ns, LAS float* scr, int item, int lane) {
    const int nblk = N / 32, kb = item / nblk, nb = item % nblk, k0 = 64 * kb, n0 = 32 * nb;
    const float nsv = ns ? ns[n0 + (lane & 31)] : 1.0f;
#pragma unroll 8
    for (int i = 0; i < 32; ++i) { const int kk = 2 * i + (lane >> 5); float w = W[(size_t)(k0 + kk) * N + n0 + (lane & 31)] * nsv; if (ks) w *= ks[k0 + kk]; scr[kk * 33 + (lane & 31)] = w; }
    asm volatile("s_waitcnt lgkmcnt(0)" ::: "memory");
    const int c = lane & 7;
#pragma unroll
    for (int j = 0; j < 4; ++j) { const int n = (lane >> 3) + 8 * j; const LAS float* s = scr + (8 * c) * 33 + n;
        u32x4 o; o.x = pk2(s[0 * 33], s[1 * 33]); o.y = pk2(s[2 * 33], s[3 * 33]); o.z = pk2(s[4 * 33], s[5 * 33]); o.w = pk2(s[6 * 33], s[7 * 33]);
        *(u32x4*)(WT + (size_t)(row_off + n0 + n) * K + k0 + 8 * c) = o; }
    asm volatile("s_waitcnt lgkmcnt(0)" ::: "memory");
}

__global__ void __launch_bounds__(512, 2) fwd_kernel(Args a) {
    extern __shared__ __attribute__((aligned(16))) unsigned char lds_raw[];
    LAS unsigned char* lds = (LAS unsigned char*)lds_raw;
    cg::grid_group grid = cg::this_grid();
    const int G = gridDim.x, bid = blockIdx.x;
    const int NGW = G * 8;
    const int wave = __builtin_amdgcn_readfirstlane((int)threadIdx.x >> 6);
#define PHASE_IDS int lane_ = (int)__builtin_amdgcn_mbcnt_hi(~0u, __builtin_amdgcn_mbcnt_lo(~0u, 0u)); asm volatile("" : "+v"(lane_)); const int lane = lane_, tid = wave * 64 + lane, gw = bid * 8 + wave; (void)gw; (void)tid;
    unsigned char* ws = a.ws;
    bf16_t* Wt_in0 = (bf16_t*)(ws + WS_WIN0); bf16_t* Wt_grp = (bf16_t*)(ws + WS_WGRP); bf16_t* Wt_out0 = (bf16_t*)(ws + WS_WOUT0);
    bf16_t* Wt_in1 = (bf16_t*)(ws + WS_WIN1); bf16_t* Wt_out1 = (bf16_t*)(ws + WS_WOUT1);
    float* part1 = (float*)(ws + WS_PART1); float* part2 = (float*)(ws + WS_PART2); float* ssb = (float*)(ws + WS_SS); float* decb = (float*)(ws + WS_DEC);
    bf16_t* XB = (bf16_t*)(ws + WS_XB); bf16_t* BA = (bf16_t*)(ws + WS_A); bf16_t* BB = (bf16_t*)(ws + WS_B); bf16_t* BC = (bf16_t*)(ws + WS_C);

    {
        PHASE_IDS
        LAS float* scr = (LAS float*)(lds + wave * 16384);
        constexpr int I_IN0 = (DM / 64) * (4096 / 32), I_GRP1 = (512 / 64) * (512 / 32), I_OUT = (DI / 64) * (DM / 32), I_IN1 = (DM / 64) * (8192 / 32);
        constexpr int NITEMS = I_IN0 + 4 * I_GRP1 + I_OUT + I_IN1 + I_OUT;
        for (int it = gw; it < NITEMS; it += NGW) {
            int r = it;
            if (r < I_IN0) { transpose_item(a.pool_w_in, DM, 4096, Wt_in0, 0, a.norm_g, nullptr, scr, r, lane); continue; } r -= I_IN0;
            if (r < 4 * I_GRP1) { const int g = r / I_GRP1; transpose_item(a.pool_w_grp + (size_t)g * 512 * 512, 512, 512, Wt_grp, g * 512, nullptr, a.pool_scale + g * 512, scr, r % I_GRP1, lane); continue; } r -= 4 * I_GRP1;
            if (r < I_OUT) { transpose_item(a.pool_w_out, DI, DM, Wt_out0, 0, nullptr, nullptr, scr, r, lane); continue; } r -= I_OUT;
            if (r < I_IN1) {
                const int n0 = 32 * (r % (8192 / 32)); int d0 = n0;
                if (n0 < 2048) d0 = 256 * (n0 >> 7) + (n0 & 127); else if (n0 < 4096) d0 = 256 * ((n0 - 2048) >> 7) + 128 + (n0 & 127);
                transpose_item(a.hgrn_w_in, DM, 8192, Wt_in1, d0 - n0, a.norm_g + DM, nullptr, scr, r, lane); continue; } r -= I_IN1;
            transpose_item(a.hgrn_w_out, DI, DM, Wt_out1, 0, a.hgrn_norm_g, nullptr, scr, r, lane);
        }
        for (int m = gw; m < M; m += NGW) {
            const f32x4* xr = (const f32x4*)(a.x + (size_t)m * DM) + lane;
            f32x4 v[4]; float s = 0.f;
#pragma unroll
            for (int j = 0; j < 4; ++j) { v[j] = xr[64 * j]; s += (v[j][0] * v[j][0] + v[j][1] * v[j][1]) + (v[j][2] * v[j][2] + v[j][3] * v[j][3]); }
            const float rstd = 1.0f / sqrtf(wave_sum(s, lane) * (1.0f / DM) + EPS);
            unsigned long long* o8 = (unsigned long long*)(XB + (size_t)m * DM) + lane;
#pragma unroll
            for (int j = 0; j < 4; ++j) o8[64 * j] = (unsigned long long)pk2(v[j][0] * rstd, v[j][1] * rstd) | ((unsigned long long)pk2(v[j][2] * rstd, v[j][3] * rstd) << 32);
        }
    }
    grid.sync();

    {
        pg8::Gemm g{XB, Wt_in0, DM, DM, DM, 0}; pg8::StaticOrder S; S.init(M, 4096, G, bid);
        pg8::EpiP1 E{BA, BB};
        pg8::gemm_phase<pg8::EpiP1>(lds, g, S, E, wave);
    }
    grid.sync();

    {
        PHASE_IDS
        const size_t nvec = (size_t)M * (DI / 8);
        for (size_t idx = (size_t)bid * 512 + tid; idx < nvec; idx += (size_t)G * 512) {
            const int m = (int)(idx >> 8), cgp = (int)(idx & 255), grp = cgp >> 6, w = 2 << grp, t = m & (SEQ - 1);
            const int cnt = (t + 1) < w ? (t + 1) : w;
            const bf16_t* vp = BA + (size_t)m * DI + cgp * 8;
            float sum[8];
#pragma unroll
            for (int j = 0; j < 8; ++j) sum[j] = 0.f;
            u32x4 v0 = *(const u32x4*)vp;
            for (int k = 0; k < cnt; ++k) { const u32x4 vv = *(const u32x4*)(vp - (size_t)k * DI);
                sum[0] += bf_lo(vv.x); sum[1] += bf_hi(vv.x); sum[2] += bf_lo(vv.y); sum[3] += bf_hi(vv.y); sum[4] += bf_lo(vv.z); sum[5] += bf_hi(vv.z); sum[6] += bf_lo(vv.w); sum[7] += bf_hi(vv.w); }
            const float inv = 1.0f / (float)cnt;
            u32x4 o; o.x = pk2(sum[0] * inv - bf_lo(v0.x), sum[1] * inv - bf_hi(v0.x)); o.y = pk2(sum[2] * inv - bf_lo(v0.y), sum[3] * inv - bf_hi(v0.y));
            o.z = pk2(sum[4] * inv - bf_lo(v0.z), sum[5] * inv - bf_hi(v0.z)); o.w = pk2(sum[6] * inv - bf_lo(v0.w), sum[7] * inv - bf_hi(v0.w));
            *(u32x4*)(BC + (size_t)m * DI + cgp * 8) = o;
        }
    }
    grid.sync();

    {
        pg8::Gemm g{BC, Wt_grp, DI, 512, 512, 2}; pg8::StaticOrder S; S.init(M, DI, G, bid);
        pg8::EpiP2 E{BB};
        pg8::gemm_phase<pg8::EpiP2>(lds, g, S, E, wave);
    }
    grid.sync();

    {
        pg8::Gemm g{BB, Wt_out0, DI, DI, DI, 0}; pg8::StaticOrder S; S.init(M, DM, G, bid);
        pg8::EpiRes<true> E{a.x, a.out, XB, part1};
        pg8::gemm_phase<pg8::EpiRes<true>>(lds, g, S, E, wave);
    }
    grid.sync();

    {
        pg8::Gemm g{XB, Wt_in1, DM, DM, DM, 0}; pg8::StaticOrder S; S.init(M, 6144, G, bid);
        pg8::EpiP4 E{BA, BB, BC, decb, part1, a.hgrn_lb};
        pg8::gemm_phase<pg8::EpiP4>(lds, g, S, E, wave);
    }
    grid.sync();

    {
        PHASE_IDS
        constexpr int CT = 32;
        LAS float* qs = (LAS float*)lds;
        LAS float* fs = (LAS float*)(lds + 16384);
        LAS float* is = (LAS float*)(lds + 32768);
        LAS float* po = (LAS float*)(lds + 40960);
        for (int item = bid; item < BATCH * NHEAD * 2; item += G) {
            const int b = item >> 5, h = (item >> 1) & 15, half = item & 1;
            float s[16];
#pragma unroll
            for (int j = 0; j < 16; ++j) s[j] = 0.f;
            for (int t0 = 0; t0 < SEQ; t0 += CT) {
                const size_t tok0 = (size_t)b * SEQ + t0;
                { const int t = tid >> 4, c8 = tid & 15; const size_t off = (tok0 + t) * DI + h * HD + c8 * 8;
                  const u32x4 qv = *(const u32x4*)(BA + off);
                  LAS float* qd = qs + t * 128 + c8 * 8;
                  qd[0] = bf_lo(qv.x); qd[1] = bf_hi(qv.x); qd[2] = bf_lo(qv.y); qd[3] = bf_hi(qv.y); qd[4] = bf_lo(qv.z); qd[5] = bf_hi(qv.z); qd[6] = bf_lo(qv.w); qd[7] = bf_hi(qv.w);
                  const u32x4 kv = *(const u32x4*)(BB + off);
                  LAS float* fd = fs + t * 128 + c8 * 8;
                  fd[0] = bf_lo(kv.x); fd[1] = bf_hi(kv.x); fd[2] = bf_lo(kv.y); fd[3] = bf_hi(kv.y); fd[4] = bf_lo(kv.z); fd[5] = bf_hi(kv.z); fd[6] = bf_lo(kv.w); fd[7] = bf_hi(kv.w);
                }
                if (tid < 256) { const int t = tid >> 3, c8 = tid & 7; const size_t off = (tok0 + t) * DI + h * HD + half * 64 + c8 * 8;
                  const u32x4 iv = *(const u32x4*)(BC + off);
                  LAS float* id = is + t * 64 + c8 * 8;
                  id[0] = bf_lo(iv.x); id[1] = bf_hi(iv.x); id[2] = bf_lo(iv.y); id[3] = bf_hi(iv.y); id[4] = bf_lo(iv.z); id[5] = bf_hi(iv.z); id[6] = bf_lo(iv.w); id[7] = bf_hi(iv.w);
                }
                __syncthreads();
                for (int t = 0; t < CT; ++t) {
                    const float iv = is[t * 64 + lane];
                    const LAS f32x4* f4 = (const LAS f32x4*)(fs + t * 128 + wave * 16);
                    const LAS f32x4* q4 = (const LAS f32x4*)(qs + t * 128 + wave * 16);
                    float acc = 0.f;
#pragma unroll
                    for (int jj = 0; jj < 4; ++jj) { const f32x4 f = f4[jj], q = q4[jj];
#pragma unroll
                        for (int j = 0; j < 4; ++j) { s[jj * 4 + j] += f[j] * iv; acc += s[jj * 4 + j] * q[j]; } }
                    po[(t * 8 + wave) * 64 + lane] = acc;
                }
                if (((t0 + CT) & 63) == 0) {
                    const f32x4* dp = (const f32x4*)(decb + (size_t)((tok0 + CT - 64) >> 6) * DI + h * HD + wave * 16);
#pragma unroll
                    for (int jj = 0; jj < 4; ++jj) { const f32x4 d = dp[jj];
#pragma unroll
                        for (int j = 0; j < 4; ++j) s[jj * 4 + j] *= d[j]; }
                }
                __syncthreads();
                { const int t = tid >> 4, vg = tid & 15;
                  f32x4 o = (f32x4){0.f, 0.f, 0.f, 0.f};
#pragma unroll
                  for (int w = 0; w < 8; ++w) o += *(const LAS f32x4*)(po + (t * 8 + w) * 64 + vg * 4);
                  float ss = (o[0] * o[0] + o[1] * o[1]) + (o[2] * o[2] + o[3] * o[3]);
                  ss += xor_get(ss, lane, 1); ss += xor_get(ss, lane, 2); ss += xor_get(ss, lane, 4); ss += xor_get(ss, lane, 8);
                  u32x2 w2; w2.x = pk2(o[0], o[1]); w2.y = pk2(o[2], o[3]);
                  *(u32x2*)(BC + (tok0 + t) * DI + h * HD + half * 64 + vg * 4) = w2;
                  if (vg < 4) ssb[(tok0 + t) * 128 + h * 8 + half * 4 + vg] = vg == 0 ? ss : 0.f;
                }
                __syncthreads();
            }
        }
    }
    grid.sync();

    {
        pg8::Gemm g{XB, Wt_in1 + (size_t)6144 * DM, DM, DM, DM, 0}; pg8::StaticOrder S; S.init(M, DI, G, bid);
        pg8::EpiP5b E{BC, part1, ssb};
        pg8::gemm_phase<pg8::EpiP5b>(lds, g, S, E, wave);
    }
    grid.sync();

    {
        pg8::Gemm g{BC, Wt_out1, DI, DI, DI, 0}; pg8::StaticOrder S; S.init(M, DM, G, bid);
        pg8::EpiRes<false> E{a.out, a.out, nullptr, part2};
        pg8::gemm_phase<pg8::EpiRes<false>>(lds, g, S, E, wave);
    }
    grid.sync();

    {
        PHASE_IDS
        for (int m = gw; m < M; m += NGW) {
            const f32x4* p4 = (const f32x4*)(part2 + (size_t)m * 16); const f32x4 pa = p4[0], pb = p4[1], pc = p4[2], pd = p4[3]; const float p = (((pa[0] + pa[1]) + (pa[2] + pa[3])) + ((pb[0] + pb[1]) + (pb[2] + pb[3]))) + (((pc[0] + pc[1]) + (pc[2] + pc[3])) + ((pd[0] + pd[1]) + (pd[2] + pd[3])));
            const float rstd = 1.0f / sqrtf(p * (1.0f / DM) + EPS);
            f32x4* orow = (f32x4*)(a.out + (size_t)m * DM) + lane; const f32x4* gr = (const f32x4*)a.final_g + lane;
#pragma unroll
            for (int j = 0; j < 4; ++j) { f32x4 v = orow[64 * j]; const f32x4 gg = gr[64 * j]; v = v * rstd * gg; orow[64 * j] = v; }
        }
    }
}

extern "C" void kernel_launch(void* const* d_in, const int* in_sizes, int n_in, void* d_out, int out_size, void* d_ws, size_t ws_size, hipStream_t stream) {
    static int grid = 0;
    if (grid == 0) {
        if (n_in != 11 || in_sizes[0] != M * DM || out_size != M * DM || ws_size < WS_END) { fprintf(stderr, "kernel_launch: unexpected shapes (n_in %d in0 %d out %d ws %zu)\n", n_in, n_in > 0 ? in_sizes[0] : -1, out_size, ws_size); grid = -1; return; }
        int dev = 0, cus = 0, per = 0;
        if (hipGetDevice(&dev) != hipSuccess || hipDeviceGetAttribute(&cus, hipDeviceAttributeMultiprocessorCount, dev) != hipSuccess) { grid = -1; return; }
        if (hipFuncSetAttribute((const void*)fwd_kernel, hipFuncAttributeMaxDynamicSharedMemorySize, LDS_BYTES) != hipSuccess) { fprintf(stderr, "kernel_launch: hipFuncSetAttribute failed\n"); grid = -1; return; }
        if (hipOccupancyMaxActiveBlocksPerMultiprocessor(&per, (const void*)fwd_kernel, 512, LDS_BYTES) != hipSuccess || per < 1) { fprintf(stderr, "kernel_launch: occupancy query says %d\n", per); (void)hipGetLastError(); grid = -1; return; }
        grid = cus;
        fprintf(stderr, "kernel_launch: cus %d per_cu %d grid %d\n", cus, per, grid);
    }
    if (grid < 0) return;
    Args a{};
    a.x = (const float*)d_in[0]; a.norm_g = (const float*)d_in[1]; a.pool_w_in = (const float*)d_in[2]; a.pool_w_grp = (const float*)d_in[3];
    a.pool_scale = (const float*)d_in[4]; a.pool_w_out = (const float*)d_in[5]; a.hgrn_w_in = (const float*)d_in[6]; a.hgrn_lb = (const float*)d_in[7];
    a.hgrn_norm_g = (const float*)d_in[8]; a.hgrn_w_out = (const float*)d_in[9]; a.final_g = (const float*)d_in[10];
    a.out = (float*)d_out; a.ws = (unsigned char*)d_ws;
    void* args[] = {&a};
    hipError_t e = hipLaunchCooperativeKernel((void*)fwd_kernel, dim3(grid), dim3(512), args, LDS_BYTES, stream);
    if (e != hipSuccess) fprintf(stderr, "kernel_launch: cooperative launch failed: %s (grid %d)\n", hipGetErrorString(e), grid);
}
```

```cpp
#include <hip/hip_runtime.h>
#include <hip/hip_cooperative_groups.h>
#include <cstdio>
#include <cstdint>
namespace cg = cooperative_groups;

#define LAS __attribute__((address_space(3)))
typedef unsigned short bf16_t;
typedef short bf16x8 __attribute__((ext_vector_type(8)));
typedef float f32x4 __attribute__((ext_vector_type(4)));
typedef float f32x2 __attribute__((ext_vector_type(2)));
typedef unsigned u32x4 __attribute__((ext_vector_type(4)));
typedef unsigned u32x2 __attribute__((ext_vector_type(2)));

constexpr int DM = 1024, BATCH = 8, SEQ = 4096, DI = 2048, M = BATCH * SEQ;
constexpr int NHEAD = 16, HD = 128;
constexpr float EPS = 1e-6f;
constexpr size_t MiB = 1u << 20;
constexpr size_t WS_WIN0 = 2 * MiB;
constexpr size_t WS_WGRP = 10 * MiB;
constexpr size_t WS_WOUT0 = 12 * MiB;
constexpr size_t WS_WIN1 = 16 * MiB;
constexpr size_t WS_WOUT1 = 32 * MiB;
constexpr size_t WS_PART1 = 36 * MiB;
constexpr size_t WS_PART2 = 38 * MiB;
constexpr size_t WS_DEC = 44 * MiB;
constexpr size_t WS_SS = 112 * MiB;
constexpr size_t WS_XB = 48 * MiB;
constexpr size_t WS_A = 128 * MiB;
constexpr size_t WS_B = 256 * MiB;
constexpr size_t WS_C = 384 * MiB;
constexpr size_t WS_END = 512 * MiB;
constexpr int LDS_BYTES = 147456;

__device__ __forceinline__ unsigned f2bf(float f) { unsigned u = __builtin_bit_cast(unsigned, f); return (u + 0x7fffu + ((u >> 16) & 1u)) >> 16; }
__device__ __forceinline__ unsigned pk2(float lo, float hi) { return f2bf(lo) | (f2bf(hi) << 16); }
typedef __bf16 bf2_t __attribute__((ext_vector_type(2)));
__device__ __forceinline__ unsigned pkbf(float lo, float hi) { f32x2 v = {lo, hi}; return __builtin_bit_cast(unsigned, __builtin_convertvector(v, bf2_t)); }
__device__ __forceinline__ float bf_lo(unsigned w) { return __builtin_bit_cast(float, w << 16); }
__device__ __forceinline__ float bf_hi(unsigned w) { return __builtin_bit_cast(float, w & 0xffff0000u); }
__device__ __forceinline__ float silu_f(float x) { return x * __builtin_amdgcn_rcpf(1.0f + __builtin_amdgcn_exp2f(-1.44269504089f * x)); }
__device__ __forceinline__ float lane_get(float v, int src_lane) { return __builtin_bit_cast(float, __builtin_amdgcn_ds_bpermute(src_lane << 2, __builtin_bit_cast(int, v))); }
__device__ __forceinline__ float xor_get(float v, int lane, int m) { return lane_get(v, lane ^ m); }
__device__ __forceinline__ float wave_sum(float v, int lane) {
#pragma unroll
    for (int o = 1; o < 64; o <<= 1) v += xor_get(v, lane, o);
    return v;
}

namespace pg8 {
constexpr int BM = 256, BK = 64, HALF = 128, HTB = HALF * BK * 2, STAGE_BYTES = 8 * HTB, NXCD = 8, WGM = 8;
__host__ __device__ __forceinline__ int lds_byte(int r, int c) { const int st = (r >> 4) * 2 + (c >> 5), rr = r & 15, cc = c & 31, ob = rr * 64 + cc * 2; return st * 1024 + (ob ^ (((ob >> 9) & 1) << 5)); }
__host__ __device__ __forceinline__ void stage_rc(int b, int& R, int& C) { const int st = b / 1024, sb = b % 1024, swz = sb ^ (((sb >> 9) & 1) << 5); R = (st >> 1) * 16 + swz / 64; C = (st & 1) * 32 + (swz % 64) / 2; }
__host__ __device__ __forceinline__ int perm32(int rho) { const int n = rho >> 4, i = rho & 15; return 8 * (i >> 2) + 4 * n + (i & 3); }

struct Unit { int pm, pn; };
struct Gemm { const bf16_t* A; const bf16_t* Bt; int lda, ldb, K, grp_tiles; };

struct StaticOrder {
    int nM, nN, nwg, G, c;
    __host__ __device__ void init(int M_, int N_, int G_, int c_) { nM = M_ / BM; nN = N_ / BM; nwg = nM * nN; G = G_; c = c_; }
    __host__ __device__ bool next(int i, Unit& u) const {
        const long L = (long)i * G + c; if (L >= nwg) return false;
        int wgid = (int)L; { const int q = nwg / NXCD, r = nwg % NXCD, xcd = wgid % NXCD, off = wgid / NXCD; wgid = (xcd < r ? xcd * (q + 1) : r * (q + 1) + (xcd - r) * q) + off; }
        const int nig = WGM * nN, gid = wgid / nig, fm = gid * WGM, gsz = (nM - fm) < WGM ? (nM - fm) : WGM;
        u.pm = fm + ((wgid % nig) % gsz); u.pn = (wgid % nig) / gsz; return true;
    }
};

__device__ __forceinline__ unsigned cvt_pk_bf16(float lo, float hi) { unsigned r; asm volatile("v_cvt_pk_bf16_f32 %0, %1, %2" : "=v"(r) : "v"(lo), "v"(hi)); return r; }

template <class Epi, bool ALIGN_EPI = true, bool SP2 = true>
__device__ __forceinline__ void gemm_phase(LAS unsigned char* lds, const Gemm g, const StaticOrder& S, const Epi& E, const int wid) {
    int lane_ = (int)__builtin_amdgcn_mbcnt_hi(~0u, __builtin_amdgcn_mbcnt_lo(~0u, 0u)); asm volatile("" : "+v"(lane_));
    int lane = lane_, tid = wid * 64 + lane, fr = lane & 15, fq = lane >> 4; const int wr = wid >> 2, wc = wid & 3;
    const int K = g.K, nt = K / BK;
    unsigned voffA[2], voffB[2]; int aoff, boff;
#define PG8_LANE_STATE() do { _Pragma("unroll") for (int i = 0; i < 2; ++i) { int R, C; stage_rc(tid * 16 + i * 8192, R, C); const int Rb = Epi::PERM ? ((R & ~31) + perm32(R & 31)) : R; \
        voffA[i] = (unsigned)(R * g.lda + C) * 2u; voffB[i] = (unsigned)(Rb * g.ldb + C) * 2u; } \
        aoff = lds_byte(wr * 64 + fr, fq * 8); boff = lds_byte(wc * 32 + fr, fq * 8); } while (0)
    PG8_LANE_STATE();
    const size_t kstep = (size_t)(BK * 2);
    const size_t hstepA = (size_t)HALF * g.lda * 2, hstepB = (size_t)HALF * g.ldb * 2;
    const size_t tstepA = 2 * hstepA, tstepB = 2 * hstepB;
    const unsigned ldsw = (unsigned)wid * 1024u;
#define PG8_SA(b, h) (((b) * 2 + (h)) * HTB)
#define PG8_SB(b, h) ((4 + (b) * 2 + (h)) * HTB)
#define PG8_STAGE(bufoff, gbase, voff) do { _Pragma("unroll") for (int _i = 0; _i < 2; ++_i) \
        __builtin_amdgcn_global_load_lds((const unsigned*)((const char*)(gbase) + (voff)[_i]), (LAS unsigned*)(lds + (bufoff) + ldsw + _i * 8192), 16, 0, 0); } while (0)
#define PG8_LDA(dst, b, h) do { _Pragma("unroll") for (int m = 0; m < 4; ++m) _Pragma("unroll") for (int k = 0; k < 2; ++k) dst[m][k] = *(const LAS bf16x8*)(lds + PG8_SA(b, h) + aoff + m * 2048 + k * 1024); } while (0)
#define PG8_LDB(dst, b, h) do { _Pragma("unroll") for (int n = 0; n < 2; ++n) _Pragma("unroll") for (int k = 0; k < 2; ++k) dst[n][k] = *(const LAS bf16x8*)(lds + PG8_SB(b, h) + boff + n * 2048 + k * 1024); } while (0)
#define PG8_MMA(ai, bj, At, Bt) do { __builtin_amdgcn_s_setprio(1); _Pragma("unroll") for (int m = 0; m < 4; ++m) _Pragma("unroll") for (int n = 0; n < 2; ++n) _Pragma("unroll") for (int k = 0; k < 2; ++k) \
        acc[ai][bj][m][n] = __builtin_amdgcn_mfma_f32_16x16x32_bf16(Bt[n][k], At[m][k], acc[ai][bj][m][n], 0, 0, 0); __builtin_amdgcn_s_setprio(0); } while (0)
#define PG8_WAIT_V(n) asm volatile("s_waitcnt vmcnt(" #n ")" ::: "memory")
#define PG8_WAIT_L(n) asm volatile("s_waitcnt lgkmcnt(" #n ")" ::: "memory")
#define PG8_BAR __builtin_amdgcn_s_barrier()
#define PG8_SCHED __builtin_amdgcn_sched_barrier(0)
#define PG8_ABASE(u) ((const char*)g.A + (size_t)(u).pm * tstepA + (g.grp_tiles ? (size_t)((u).pn / g.grp_tiles) * (size_t)K * 2 : (size_t)0))
#define PG8_BBASE(u) ((const char*)g.Bt + (size_t)(u).pn * tstepB)
    Unit cur, nxt; int ui = 0;
    if (!S.next(0, cur)) return;
    f32x4 acc[2][2][4][2];
#pragma unroll
    for (int a = 0; a < 2; ++a)
#pragma unroll
        for (int b = 0; b < 2; ++b)
#pragma unroll
            for (int m = 0; m < 4; ++m)
#pragma unroll
                for (int n = 0; n < 2; ++n) acc[a][b][m][n] = (f32x4){0.f, 0.f, 0.f, 0.f};
    bf16x8 At[4][2], B0[2][2], B1[2][2];
    const char* cA = PG8_ABASE(cur); const char* cB = PG8_BBASE(cur);
    if constexpr (SP2) {
        PG8_STAGE(PG8_SB(0, 0), cB, voffB); PG8_STAGE(PG8_SB(0, 1), cB + hstepB, voffB); PG8_STAGE(PG8_SA(0, 0), cA, voffA); PG8_STAGE(PG8_SA(0, 1), cA + hstepA, voffA);
        if (wr == 1) PG8_BAR;
        PG8_WAIT_V(2); PG8_BAR;
        PG8_STAGE(PG8_SB(1, 0), cB + kstep, voffB); PG8_STAGE(PG8_SA(1, 0), cA + kstep, voffA); PG8_STAGE(PG8_SB(1, 1), cB + hstepB + kstep, voffB);
        PG8_WAIT_V(6); PG8_BAR;
    } else {
        PG8_STAGE(PG8_SB(0, 0), cB, voffB); PG8_STAGE(PG8_SA(0, 0), cA, voffA); PG8_STAGE(PG8_SB(0, 1), cB + hstepB, voffB); PG8_STAGE(PG8_SA(0, 1), cA + hstepA, voffA);
        if (wr == 1) PG8_BAR;
        PG8_WAIT_V(4); PG8_BAR;
        PG8_STAGE(PG8_SB(1, 0), cB + kstep, voffB); PG8_STAGE(PG8_SA(1, 0), cA + kstep, voffA); PG8_STAGE(PG8_SB(1, 1), cB + hstepB + kstep, voffB);
        PG8_WAIT_V(6); PG8_BAR;
    }
    for (;;) {
        const bool has_next = S.next(ui + 1, nxt);
        const char* nA = has_next ? PG8_ABASE(nxt) : cA; const char* nB = has_next ? PG8_BBASE(nxt) : cB;
        for (int t = 0; t < nt; t += 2) {
            const bool last = (t == nt - 2);
            const char* a1 = cA + (size_t)(t + 1) * kstep;
            const char* a2 = last ? nA : cA + (size_t)(t + 2) * kstep; const char* b2 = last ? nB : cB + (size_t)(t + 2) * kstep;
            const char* a3 = a2 + kstep; const char* b3 = b2 + kstep;
            if constexpr (SP2) {
            PG8_LDB(B0, 0, 0); PG8_LDB(B1, 0, 1); PG8_SCHED; PG8_LDA(At, 0, 0); PG8_STAGE(PG8_SA(1, 1), a1 + hstepA, voffA);
            PG8_WAIT_V(8); PG8_WAIT_L(0); PG8_BAR; PG8_MMA(0, 0, At, B0); PG8_MMA(0, 1, At, B1); PG8_BAR; PG8_SCHED;
            PG8_LDA(At, 0, 1); PG8_STAGE(PG8_SB(0, 0), b2, voffB); PG8_STAGE(PG8_SB(0, 1), b2 + hstepB, voffB); PG8_STAGE(PG8_SA(0, 0), a2, voffA);
            PG8_WAIT_V(8); PG8_WAIT_L(0); PG8_BAR; PG8_MMA(1, 0, At, B0); PG8_MMA(1, 1, At, B1); PG8_BAR; PG8_SCHED;
            PG8_LDB(B0, 1, 0); PG8_LDB(B1, 1, 1); PG8_SCHED; PG8_LDA(At, 1, 0); PG8_STAGE(PG8_SA(0, 1), a2 + hstepA, voffA);
            PG8_WAIT_V(8); PG8_WAIT_L(0); PG8_BAR; PG8_MMA(0, 0, At, B0); PG8_MMA(0, 1, At, B1); PG8_BAR; PG8_SCHED;
            PG8_LDA(At, 1, 1); PG8_STAGE(PG8_SB(1, 0), b3, voffB); PG8_STAGE(PG8_SB(1, 1), b3 + hstepB, voffB); PG8_STAGE(PG8_SA(1, 0), a3, voffA);
            PG8_WAIT_V(8); PG8_WAIT_L(0); PG8_BAR; PG8_MMA(1, 0, At, B0); PG8_MMA(1, 1, At, B1); PG8_BAR; PG8_SCHED;
            } else {
            PG8_LDB(B0, 0, 0); PG8_SCHED; PG8_LDA(At, 0, 0); PG8_STAGE(PG8_SA(1, 1), a1 + hstepA, voffA);
            PG8_WAIT_L(8); PG8_BAR; PG8_WAIT_L(0); PG8_MMA(0, 0, At, B0); PG8_BAR; PG8_SCHED;
            PG8_LDB(B1, 0, 1); PG8_STAGE(PG8_SB(0, 0), b2, voffB);
            PG8_BAR; PG8_WAIT_L(0); PG8_MMA(0, 1, At, B1); PG8_BAR;
            PG8_LDA(At, 0, 1); PG8_STAGE(PG8_SA(0, 0), a2, voffA);
            PG8_BAR; PG8_WAIT_L(0); PG8_MMA(1, 0, At, B0); PG8_BAR; PG8_SCHED;
            PG8_STAGE(PG8_SB(0, 1), b2 + hstepB, voffB);
            PG8_WAIT_V(6); PG8_BAR; PG8_MMA(1, 1, At, B1); PG8_BAR;
            PG8_LDB(B0, 1, 0); PG8_SCHED; PG8_LDA(At, 1, 0); PG8_STAGE(PG8_SA(0, 1), a2 + hstepA, voffA);
            PG8_WAIT_L(8); PG8_BAR; PG8_WAIT_L(0); PG8_MMA(0, 0, At, B0); PG8_BAR; PG8_SCHED;
            PG8_LDB(B1, 1, 1); PG8_STAGE(PG8_SB(1, 0), b3, voffB);
            PG8_BAR; PG8_WAIT_L(0); PG8_MMA(0, 1, At, B1); PG8_BAR;
            PG8_LDA(At, 1, 1); PG8_STAGE(PG8_SA(1, 0), a3, voffA);
            PG8_BAR; PG8_WAIT_L(0); PG8_MMA(1, 0, At, B0); PG8_BAR; PG8_SCHED;
            PG8_STAGE(PG8_SB(1, 1), b3 + hstepB, voffB);
            PG8_WAIT_V(6); PG8_BAR; PG8_MMA(1, 1, At, B1); PG8_BAR;
            }
        }
        if constexpr (ALIGN_EPI) { if (wr == 0) PG8_BAR; }
        if constexpr (!Epi::AFTER_DRAIN) E(acc, cur, wr, wc, fr, fq);
        if (!has_next) break;
#pragma unroll
        for (int a = 0; a < 2; ++a)
#pragma unroll
            for (int b = 0; b < 2; ++b)
#pragma unroll
                for (int m = 0; m < 4; ++m)
#pragma unroll
                    for (int n = 0; n < 2; ++n) acc[a][b][m][n] = (f32x4){0.f, 0.f, 0.f, 0.f};
        cur = nxt; cA = nA; cB = nB; ++ui;
        asm volatile("" : "+v"(lane)); tid = wid * 64 + lane; fr = lane & 15; fq = lane >> 4; PG8_LANE_STATE();
        if constexpr (ALIGN_EPI) { if (wr == 1) PG8_BAR; }
    }
    PG8_WAIT_V(0);
    if constexpr (!ALIGN_EPI) { if (wr == 0) PG8_BAR; }
    PG8_BAR;
    if constexpr (Epi::AFTER_DRAIN) E.fused(acc, cur, wr, wc, fr, fq, lds, tid);
#undef PG8_SA
#undef PG8_SB
#undef PG8_STAGE
#undef PG8_LDA
#undef PG8_LDB
#undef PG8_MMA
#undef PG8_WAIT_V
#undef PG8_WAIT_L
#undef PG8_BAR
#undef PG8_SCHED
#undef PG8_ABASE
#undef PG8_LANE_STATE
#undef PG8_BBASE
}

struct EpiP1 {
    static constexpr bool PERM = true, AFTER_DRAIN = false;
    bf16_t* V; bf16_t* SG;
    __device__ __forceinline__ void operator()(f32x4 (&acc)[2][2][4][2], const Unit& u, int wr, int wc, int fr, int fq) const {
        const int row0 = u.pm * BM + wr * 64 + fr; const bool gate = u.pn >= 8;
        bf16_t* base = gate ? SG : V; const int col0 = (u.pn & 7) * BM + wc * 32 + 8 * fq;
#pragma unroll
        for (int ai = 0; ai < 2; ++ai)
#pragma unroll
            for (int m = 0; m < 4; ++m) { bf16_t* rowp = base + (size_t)(row0 + ai * HALF + m * 16) * DI + col0;
#pragma unroll
                for (int bj = 0; bj < 2; ++bj) { f32x4 v0 = acc[ai][bj][m][0], v1 = acc[ai][bj][m][1];
                    if (gate) {
#pragma unroll
                        for (int j = 0; j < 4; ++j) { v0[j] = silu_f(v0[j]); v1[j] = silu_f(v1[j]); } }
                    u32x4 w; w.x = cvt_pk_bf16(v0[0], v0[1]); w.y = cvt_pk_bf16(v0[2], v0[3]); w.z = cvt_pk_bf16(v1[0], v1[1]); w.w = cvt_pk_bf16(v1[2], v1[3]);
                    *(u32x4*)(rowp + bj * HALF) = w; } }
    }
};
struct EpiP2 {
    static constexpr bool PERM = true, AFTER_DRAIN = false;
    bf16_t* Z;
    __device__ __forceinline__ void operator()(f32x4 (&acc)[2][2][4][2], const Unit& u, int wr, int wc, int fr, int fq) const {
        const int row0 = u.pm * BM + wr * 64 + fr; const int col0 = u.pn * BM + wc * 32 + 8 * fq;
#pragma unroll
        for (int ai = 0; ai < 2; ++ai)
#pragma unroll
            for (int m = 0; m < 4; ++m) { bf16_t* rowp = Z + (size_t)(row0 + ai * HALF + m * 16) * DI + col0;
#pragma unroll
                for (int bj = 0; bj < 2; ++bj) { const f32x4 v0 = acc[ai][bj][m][0], v1 = acc[ai][bj][m][1];
                    const u32x4 s = *(const u32x4*)(rowp + bj * HALF);
                    u32x4 w; w.x = cvt_pk_bf16(v0[0] * bf_lo(s.x), v0[1] * bf_hi(s.x)); w.y = cvt_pk_bf16(v0[2] * bf_lo(s.y), v0[3] * bf_hi(s.y));
                    w.z = cvt_pk_bf16(v1[0] * bf_lo(s.z), v1[1] * bf_hi(s.z)); w.w = cvt_pk_bf16(v1[2] * bf_lo(s.w), v1[3] * bf_hi(s.w));
                    *(u32x4*)(rowp + bj * HALF) = w; } }
    }
};
template <bool WRITE_HB> struct EpiRes {
    static constexpr bool PERM = false, AFTER_DRAIN = false;
    const float* R; float* H; bf16_t* HB; float* part;
    __device__ __forceinline__ void operator()(f32x4 (&acc)[2][2][4][2], const Unit& u, int wr, int wc, int fr, int fq) const {
        const unsigned row0 = (unsigned)(u.pm * BM + wr * 64 + fr), col0 = (unsigned)(u.pn * BM + wc * 32 + 4 * fq);
        const unsigned ofs = (row0 * DM + col0) * 4u, pofs = (row0 * 16u + (unsigned)(u.pn * 4 + wc)) * 4u;
#pragma unroll
        for (int ai = 0; ai < 2; ++ai)
#pragma unroll
            for (int m = 0; m < 4; ++m) { const unsigned o = ofs + (unsigned)((ai * HALF + m * 16) * DM) * 4u; float ss = 0.f;
#pragma unroll
                for (int bj = 0; bj < 2; ++bj)
#pragma unroll
                    for (int n = 0; n < 2; ++n) { const unsigned oo = o + (unsigned)(bj * HALF + n * 16) * 4u;
                        const f32x4 xv = *(const f32x4*)((const char*)R + oo); const f32x4 h = xv + acc[ai][bj][m][n];
                        *(f32x4*)((char*)H + oo) = h; ss += (h[0] * h[0] + h[1] * h[1]) + (h[2] * h[2] + h[3] * h[3]);
                        if (WRITE_HB) { u32x2 w; w.x = pkbf(h[0], h[1]); w.y = pkbf(h[2], h[3]); *(u32x2*)((char*)HB + (oo >> 1)) = w; } }
                ss += xor_get(ss, fq * 16 + fr, 16); ss += xor_get(ss, fq * 16 + fr, 32);
                if (fq == 0) *(float*)((char*)part + (pofs + (unsigned)(ai * HALF + m * 16) * 64u)) = ss;
                asm volatile("" ::: "memory"); }
    }
};
__device__ __forceinline__ float row_rstd_b(const float* part, unsigned bofs) {
    const f32x4* p = (const f32x4*)((const char*)part + bofs); const f32x4 a = p[0], b = p[1], c = p[2], d = p[3];
    return __builtin_amdgcn_rsqf((((a[0] + a[1]) + (a[2] + a[3])) + ((b[0] + b[1]) + (b[2] + b[3])) + ((c[0] + c[1]) + (c[2] + c[3])) + ((d[0] + d[1]) + (d[2] + d[3]))) * (1.0f / DM) + EPS);
}
__device__ __forceinline__ float dpp_shr_mul(float v, const int n) {
    const int iv = __builtin_bit_cast(int, v), one = 0x3f800000; int r;
    if (n == 1) r = __builtin_amdgcn_update_dpp(one, iv, 0x111, 0xf, 0xf, false); else if (n == 2) r = __builtin_amdgcn_update_dpp(one, iv, 0x112, 0xf, 0xf, false);
    else if (n == 4) r = __builtin_amdgcn_update_dpp(one, iv, 0x114, 0xf, 0xf, false); else r = __builtin_amdgcn_update_dpp(one, iv, 0x118, 0xf, 0xf, false);
    return v * __builtin_bit_cast(float, r);
}
struct EpiP4 {
    static constexpr bool PERM = true, AFTER_DRAIN = false;
    bf16_t* Qt; bf16_t* Kt; bf16_t* V; float* DEC; const float* part; const float* lbnd;
    __device__ __forceinline__ void operator()(f32x4 (&acc)[2][2][4][2], const Unit& u, int wr, int wc, int fr, int fq) const {
        const unsigned row0 = (unsigned)(u.pm * BM + wr * 64 + fr);
        const unsigned pofs = row0 * 64u;
        if (u.pn >= 16) {
            const unsigned vofs = (row0 * DI + (unsigned)((u.pn - 16) * BM + wc * 32 + 8 * fq)) * 2u;
#pragma unroll
            for (int ai = 0; ai < 2; ++ai)
#pragma unroll
                for (int m = 0; m < 4; ++m) { const float rs = row_rstd_b(part, pofs + (unsigned)(ai * HALF + m * 16) * 64u);
#pragma unroll
                    for (int bj = 0; bj < 2; ++bj) { const f32x4 v0 = acc[ai][bj][m][0] * rs, v1 = acc[ai][bj][m][1] * rs;
                        u32x4 w; w.x = pkbf(v0[0], v0[1]); w.y = pkbf(v0[2], v0[3]); w.z = pkbf(v1[0], v1[1]); w.w = pkbf(v1[2], v1[3]);
                        *(u32x4*)((char*)V + (vofs + (unsigned)((ai * HALF + m * 16) * DI + bj * HALF) * 2u)) = w; }
                    asm volatile("" ::: "memory"); }
            return;
        }
        const unsigned c0 = (unsigned)(u.pn * HD + wc * 32 + 8 * fq);
        const unsigned qofs = (row0 * DI + c0) * 2u;
#pragma unroll
        for (int ai = 0; ai < 2; ++ai) {
            float rs[4];
#pragma unroll
            for (int m = 0; m < 4; ++m) { rs[m] = row_rstd_b(part, pofs + (unsigned)(ai * HALF + m * 16) * 64u); asm volatile("" : "+v"(rs[m]) :: "memory"); }
            unsigned cc = c0; asm volatile("" : "+v"(cc));
#pragma unroll
            for (int n = 0; n < 2; ++n) {
                const f32x4 l0 = *(const f32x4*)((const char*)lbnd + (cc + 4 * n) * 4u), l1 = *(const f32x4*)((const char*)lbnd + (cc + 4 * n + DI) * 4u);
                f32x4 decv;
#pragma unroll
                for (int j = 0; j < 4; ++j) { const float ex = __expf(l0[j] - l1[j]); const float lb = __builtin_amdgcn_rcpf(1.0f + ex), omlb = ex * lb; float bprod = 1.0f;
#pragma unroll
                    for (int m = 0; m < 4; ++m) {
                        const float qv = acc[ai][0][m][n][j] * rs[m], z = acc[ai][1][m][n][j] * rs[m];
                        const float sg = __builtin_amdgcn_rcpf(1.0f + __builtin_amdgcn_exp2f(-1.44269504089f * z));
                        const float f = lb + omlb * sg, k = omlb * (1.0f - sg);
                        float s = f; s = dpp_shr_mul(s, 1); s = dpp_shr_mul(s, 2); s = dpp_shr_mul(s, 4); s = dpp_shr_mul(s, 8);
                        const float E = bprod * s;
                        if (m < 3) bprod *= lane_get(s, fq * 16 + 15);
                        const float Ei = __builtin_amdgcn_rcpf(fmaxf(E, 7.9e-31f));
                        acc[ai][0][m][n][j] = qv * E; acc[ai][1][m][n][j] = k * Ei;
                        if (m == 3) decv[j] = E;
                    } }
                if (fr == 15) *(f32x4*)((char*)DEC + ((unsigned)(u.pm * 4 + ai * 2 + wr) * DI + cc + 4 * n) * 4u) = decv;
            }
#pragma unroll
            for (int m = 0; m < 4; ++m) { const unsigned ob = qofs + (unsigned)((ai * HALF + m * 16) * DI) * 2u;
                u32x4 w; w.x = pkbf(acc[ai][0][m][0][0], acc[ai][0][m][0][1]); w.y = pkbf(acc[ai][0][m][0][2], acc[ai][0][m][0][3]); w.z = pkbf(acc[ai][0][m][1][0], acc[ai][0][m][1][1]); w.w = pkbf(acc[ai][0][m][1][2], acc[ai][0][m][1][3]);
                *(u32x4*)((char*)Qt + ob) = w;
                u32x4 x; x.x = pkbf(acc[ai][1][m][0][0], acc[ai][1][m][0][1]); x.y = pkbf(acc[ai][1][m][0][2], acc[ai][1][m][0][3]); x.z = pkbf(acc[ai][1][m][1][0], acc[ai][1][m][1][1]); x.w = pkbf(acc[ai][1][m][1][2], acc[ai][1][m][1][3]);
                *(u32x4*)((char*)Kt + ob) = x; }
            asm volatile("" ::: "memory");
        }
    }
};
struct EpiP5b {
    static constexpr bool PERM = true, AFTER_DRAIN = false;
    bf16_t* O; const float* part; const float* ss;
    __device__ __forceinline__ void operator()(f32x4 (&acc)[2][2][4][2], const Unit& u, int wr, int wc, int fr, int fq) const {
        const int row0 = u.pm * BM + wr * 64 + fr; const int col0 = u.pn * BM + wc * 32 + 8 * fq;
        const unsigned pofs = (unsigned)row0 * 64u; const float* srow = ss + (size_t)row0 * 128 + u.pn * 16;
        char* op = (char*)(O + (size_t)row0 * DI + col0);
#pragma unroll
        for (int ai = 0; ai < 2; ++ai)
#pragma unroll
            for (int m = 0; m < 4; ++m) { const float rs = row_rstd_b(part, pofs + (unsigned)(ai * HALF + m * 16) * 64u);
#pragma unroll
                for (int bj = 0; bj < 2; ++bj) { const f32x4 v0 = acc[ai][bj][m][0] * rs, v1 = acc[ai][bj][m][1] * rs;
                    const f32x4* sp = (const f32x4*)(srow + (size_t)(ai * HALF + m * 16) * 128 + bj * 8); const f32x4 s0 = sp[0], s1 = sp[1];
                    const float rh = __builtin_amdgcn_rsqf((((s0[0] + s0[1]) + (s0[2] + s0[3])) + ((s1[0] + s1[1]) + (s1[2] + s1[3]))) * (1.0f / HD) + EPS);
                    u32x4* optr = (u32x4*)(op + (size_t)((ai * HALF + m * 16) * DI + bj * HALF) * 2);
                    const u32x4 s = *optr;
                    u32x4 w; w.x = pkbf(bf_lo(s.x) * rh * silu_f(v0[0]), bf_hi(s.x) * rh * silu_f(v0[1])); w.y = pkbf(bf_lo(s.y) * rh * silu_f(v0[2]), bf_hi(s.y) * rh * silu_f(v0[3]));
                    w.z = pkbf(bf_lo(s.z) * rh * silu_f(v1[0]), bf_hi(s.z) * rh * silu_f(v1[1])); w.w = pkbf(bf_lo(s.w) * rh * silu_f(v1[2]), bf_hi(s.w) * rh * silu_f(v1[3]));
                    *optr = w; }
                asm volatile("" ::: "memory"); }
    }
};
}

namespace scan {
#define MFMA16(a, b, c) __builtin_amdgcn_mfma_f32_16x16x32_bf16((a), (b), (c), 0, 0, 0)
__device__ __forceinline__ unsigned offb(unsigned row, unsigned ch) { return 256u * row + 16u * (ch ^ (((row & 3u) << 2) | ((row >> 2) & 3u))); }
__device__ __forceinline__ unsigned voffv(unsigned r, unsigned cp) { return 128u * r + 32u * (cp ^ (((r >> 1) & 3u) ^ (((r >> 3) & 1u) << 1))); }
__device__ __forceinline__ bf16x8 tr2(unsigned a0, unsigned a1) {
    u32x2 lo, hi;
    asm volatile("ds_read_b64_tr_b16 %0, %2\n\tds_read_b64_tr_b16 %1, %3\n\ts_waitcnt lgkmcnt(0)" : "=&v"(lo), "=&v"(hi) : "v"(a0), "v"(a1) : "memory");
    const u32x4 r = {lo.x, lo.y, hi.x, hi.y}; return __builtin_bit_cast(bf16x8, r);
}
__device__ __forceinline__ bf16x8 pack8(const f32x4 a, const f32x4 b) { const u32x4 r = {pkbf(a[0], a[1]), pkbf(a[2], a[3]), pkbf(b[0], b[1]), pkbf(b[2], b[3])}; return __builtin_bit_cast(bf16x8, r); }
template <int NJ>
__device__ __forceinline__ f32x4 ttile(LAS unsigned char* lds, unsigned ldsb, unsigned QI, unsigned KI, unsigned VI, int it, const bf16x8 (&sfrag)[4],
                                       unsigned vs, unsigned l15, unsigned g, unsigned ql, unsigned p) {
    const unsigned trow = 16u * (unsigned)it + l15;
    bf16x8 qb[4];
#pragma unroll
    for (int kd = 0; kd < 4; ++kd) qb[kd] = *(const LAS bf16x8*)(lds + QI + offb(trow, 4u * kd + g));
    f32x4 c[NJ];
#pragma unroll
    for (int j = 0; j < NJ; ++j) { c[j] = (f32x4){0.f, 0.f, 0.f, 0.f};
        if (j <= it) {
#pragma unroll
            for (int kd = 0; kd < 4; ++kd) { const bf16x8 a = *(const LAS bf16x8*)(lds + KI + offb(16u * j + l15, 4u * kd + g)); c[j] = MFMA16(a, qb[kd], c[j]); }
            if (j == it) {
#pragma unroll
                for (int r = 0; r < 4; ++r) c[j][r] = (4u * g + r <= l15) ? c[j][r] : 0.f; } } }
    f32x4 o = (f32x4){0.f, 0.f, 0.f, 0.f};
#pragma unroll
    for (int ks = 0; ks < NJ / 2; ++ks) if (2 * ks <= it) {
        const bf16x8 at = pack8(c[2 * ks], c[2 * ks + 1]);
        const bf16x8 vf = tr2(ldsb + VI + voffv(32u * ks + 4u * g + ql, vs) + 8u * p, ldsb + VI + voffv(32u * ks + 16u + 4u * g + ql, vs) + 8u * p);
        o = MFMA16(vf, at, o); }
#pragma unroll
    for (int kd = 0; kd < 4; ++kd) {
        const u32x2 q0 = *(const LAS u32x2*)(lds + QI + offb(trow, 4u * kd + (g >> 1)) + 8u * (g & 1)), q1 = *(const LAS u32x2*)(lds + QI + offb(trow, 4u * kd + 2u + (g >> 1)) + 8u * (g & 1));
        const u32x4 qq = {q0.x, q0.y, q1.x, q1.y};
        o = MFMA16(sfrag[kd], __builtin_bit_cast(bf16x8, qq), o); }
    return o;
}
__device__ __forceinline__ void phase(LAS unsigned char* lds, const bf16_t* Qt, const bf16_t* Kt, bf16_t* VO, const float* DEC, float* ss8, int bid, int G, int wave) {
    int lane_ = (int)__builtin_amdgcn_mbcnt_hi(~0u, __builtin_amdgcn_mbcnt_lo(~0u, 0u)); asm volatile("" : "+v"(lane_));
    const unsigned lane = (unsigned)lane_, tid = (unsigned)wave * 64u + lane, l15 = lane & 15u, g = lane >> 4, ql = l15 >> 2, p = lane & 3u;
    const unsigned vs = (unsigned)wave & 3u; const int th = wave >> 2, tA = th ? 1 : 0, tB = th ? 2 : 3;
    const unsigned ldsb = (unsigned)(uintptr_t)lds;
    const unsigned srow = tid >> 4, sch = tid & 15u, vrow = tid >> 3, vch = tid & 7u;
    for (int item = bid; item < BATCH * NHEAD * 2; item += G) {
        const int b = item >> 5, h = (item >> 1) & 15, half = item & 1;
        const size_t tokb = (size_t)b * SEQ;
        const bf16_t* qg = Qt + (tokb + srow) * DI + h * HD + sch * 8;
        const bf16_t* kg = Kt + (tokb + srow) * DI + h * HD + sch * 8;
        bf16_t* vg = VO + tokb * DI + h * HD + half * 64;
        f32x4 S[8]; bf16x8 sfrag[4];
#pragma unroll
        for (int i = 0; i < 8; ++i) S[i] = (f32x4){0.f, 0.f, 0.f, 0.f};
#pragma unroll
        for (int i = 0; i < 4; ++i) sfrag[i] = (bf16x8){0, 0, 0, 0, 0, 0, 0, 0};
        u32x4 rq0, rq1, rk0, rk1, rv;
#define SC_LOAD(n_) do { const size_t t0_ = (size_t)(n_) * 64; \
            rq0 = *(const u32x4*)(qg + t0_ * DI); rq1 = *(const u32x4*)(qg + (t0_ + 32) * DI); rk0 = *(const u32x4*)(kg + t0_ * DI); rk1 = *(const u32x4*)(kg + (t0_ + 32) * DI); \
            rv = *(const u32x4*)(vg + (t0_ + vrow) * DI + vch * 8); } while (0)
#define SC_STORE(base_) do { *(LAS u32x4*)(lds + (base_) + offb(srow, sch)) = rq0; *(LAS u32x4*)(lds + (base_) + offb(srow + 32u, sch)) = rq1; \
            *(LAS u32x4*)(lds + (base_) + 16384u + offb(srow, sch)) = rk0; *(LAS u32x4*)(lds + (base_) + 16384u + offb(srow + 32u, sch)) = rk1; \
            *(LAS u32x4*)(lds + (base_) + 32768u + voffv(vrow, vch >> 1) + 16u * (vch & 1u)) = rv; } while (0)
        SC_LOAD(0); SC_STORE(0u); __syncthreads();
        for (int n = 0; n < SEQ / 64; ++n) {
            const unsigned QI = (unsigned)(n & 1) * 40960u, KI = QI + 16384u, VI = QI + 32768u;
            if (n + 1 < SEQ / 64) SC_LOAD(n + 1);
            {
                const f32x4 o = ttile<4>(lds, ldsb, QI, KI, VI, tB, sfrag, vs, l15, g, ql, p);
                const size_t tl = (size_t)n * 64 + 16u * (unsigned)tB + l15, trow = tokb + tl;
                const u32x2 w = {pkbf(o[0], o[1]), pkbf(o[2], o[3])};
                *(u32x2*)(vg + tl * DI + 16u * vs + 4u * g) = w;
                float ss = (o[0] * o[0] + o[1] * o[1]) + (o[2] * o[2] + o[3] * o[3]);
                ss += xor_get(ss, (int)lane, 16); ss += xor_get(ss, (int)lane, 32);
                if (g == 0) ss8[trow * 128 + h * 8 + half * 4 + vs] = ss;
            }
            {
                const f32x4 o = ttile<2>(lds, ldsb, QI, KI, VI, tA, sfrag, vs, l15, g, ql, p);
                const size_t tl = (size_t)n * 64 + 16u * (unsigned)tA + l15, trow = tokb + tl;
                const u32x2 w = {pkbf(o[0], o[1]), pkbf(o[2], o[3])};
                *(u32x2*)(vg + tl * DI + 16u * vs + 4u * g) = w;
                float ss = (o[0] * o[0] + o[1] * o[1]) + (o[2] * o[2] + o[3] * o[3]);
                ss += xor_get(ss, (int)lane, 16); ss += xor_get(ss, (int)lane, 32);
                if (g == 0) ss8[trow * 128 + h * 8 + half * 4 + vs] = ss;
            }
            {
                const bf16x8 vn0 = tr2(ldsb + VI + voffv(8u * g + ql, vs) + 8u * p, ldsb + VI + voffv(8u * g + 4u + ql, vs) + 8u * p);
                const bf16x8 vn1 = tr2(ldsb + VI + voffv(32u + 8u * g + ql, vs) + 8u * p, ldsb + VI + voffv(36u + 8u * g + ql, vs) + 8u * p);
                const float* dcp = DEC + ((size_t)(b * (SEQ / 64) + n)) * DI + h * HD + 4u * g;
#pragma unroll
                for (int i = 0; i < 8; ++i) {
                    const bf16x8 kf0 = tr2(ldsb + KI + offb(8u * g + ql, 2u * i + (p >> 1)) + 8u * (p & 1u), ldsb + KI + offb(8u * g + 4u + ql, 2u * i + (p >> 1)) + 8u * (p & 1u));
                    const bf16x8 kf1 = tr2(ldsb + KI + offb(32u + 8u * g + ql, 2u * i + (p >> 1)) + 8u * (p & 1u), ldsb + KI + offb(36u + 8u * g + ql, 2u * i + (p >> 1)) + 8u * (p & 1u));
                    S[i] = MFMA16(kf0, vn0, S[i]); S[i] = MFMA16(kf1, vn1, S[i]);
                    const f32x4 dc = *(const f32x4*)(dcp + 16 * i);
                    S[i] = S[i] * dc; }
#pragma unroll
                for (int kd = 0; kd < 4; ++kd) sfrag[kd] = pack8(S[2 * kd], S[2 * kd + 1]);
            }
            if (n + 1 < SEQ / 64) SC_STORE((unsigned)((n + 1) & 1) * 40960u);
            __syncthreads();
        }
#undef SC_LOAD
#undef SC_STORE
    }
}
#undef MFMA16
}

struct Args {
    const float* x; const float* norm_g; const float* pool_w_in; const float* pool_w_grp; const float* pool_scale; const float* pool_w_out;
    const float* hgrn_w_in; const float* hgrn_lb; const float* hgrn_norm_g; const float* hgrn_w_out; const float* final_g;
    float* out; unsigned char* ws;
};

__device__ __forceinline__ void transpose_item(const float* W, int K, int N, bf16_t* WT, int row_off, const float* ks, const float* ns, LAS float* scr, int item, int lane) {
    const int nblk = N / 32, kb = item / nblk, nb = item % nblk, k0 = 64 * kb, n0 = 32 * nb;
    const float nsv = ns ? ns[n0 + (lane & 31)] : 1.0f;
#pragma unroll 8
    for (int i = 0; i < 32; ++i) { const int kk = 2 * i + (lane >> 5); float w = W[(size_t)(k0 + kk) * N + n0 + (lane & 31)] * nsv; if (ks) w *= ks[k0 + kk]; scr[kk * 33 + (lane & 31)] = w; }
    asm volatile("s_waitcnt lgkmcnt(0)" ::: "memory");
    const int c = lane & 7;
#pragma unroll
    for (int j = 0; j < 4; ++j) { const int n = (lane >> 3) + 8 * j; const LAS float* s = scr + (8 * c) * 33 + n;
        u32x4 o; o.x = pk2(s[0 * 33], s[1 * 33]); o.y = pk2(s[2 * 33], s[3 * 33]); o.z = pk2(s[4 * 33], s[5 * 33]); o.w = pk2(s[6 * 33], s[7 * 33]);
        *(u32x4*)(WT + (size_t)(row_off + n0 + n) * K + k0 + 8 * c) = o; }
    asm volatile("s_waitcnt lgkmcnt(0)" ::: "memory");
}

__global__ void __launch_bounds__(512, 2) fwd_kernel(Args a) {
    extern __shared__ __attribute__((aligned(16))) unsigned char lds_raw[];
    LAS unsigned char* lds = (LAS unsigned char*)lds_raw;
    cg::grid_group grid = cg::this_grid();
    const int G = gridDim.x, bid = blockIdx.x;
    const int NGW = G * 8;
    const int wave = __builtin_amdgcn_readfirstlane((int)threadIdx.x >> 6);
#define PHASE_IDS int lane_ = (int)__builtin_amdgcn_mbcnt_hi(~0u, __builtin_amdgcn_mbcnt_lo(~0u, 0u)); asm volatile("" : "+v"(lane_)); const int lane = lane_, tid = wave * 64 + lane, gw = bid * 8 + wave; (void)gw; (void)tid;
    unsigned char* ws = a.ws;
    bf16_t* Wt_in0 = (bf16_t*)(ws + WS_WIN0); bf16_t* Wt_grp = (bf16_t*)(ws + WS_WGRP); bf16_t* Wt_out0 = (bf16_t*)(ws + WS_WOUT0);
    bf16_t* Wt_in1 = (bf16_t*)(ws + WS_WIN1); bf16_t* Wt_out1 = (bf16_t*)(ws + WS_WOUT1);
    float* part1 = (float*)(ws + WS_PART1); float* part2 = (float*)(ws + WS_PART2); float* ssb = (float*)(ws + WS_SS); float* decb = (float*)(ws + WS_DEC);
    bf16_t* XB = (bf16_t*)(ws + WS_XB); bf16_t* BA = (bf16_t*)(ws + WS_A); bf16_t* BB = (bf16_t*)(ws + WS_B); bf16_t* BC = (bf16_t*)(ws + WS_C);

    {
        PHASE_IDS
        LAS float* scr = (LAS float*)(lds + wave * 16384);
        constexpr int I_IN0 = (DM / 64) * (4096 / 32), I_GRP1 = (512 / 64) * (512 / 32), I_OUT = (DI / 64) * (DM / 32), I_IN1 = (DM / 64) * (8192 / 32);
        constexpr int NITEMS = I_IN0 + 4 * I_GRP1 + I_OUT + I_IN1 + I_OUT;
        for (int it = gw; it < NITEMS; it += NGW) {
            int r = it;
            if (r < I_IN0) { transpose_item(a.pool_w_in, DM, 4096, Wt_in0, 0, a.norm_g, nullptr, scr, r, lane); continue; } r -= I_IN0;
            if (r < 4 * I_GRP1) { const int g = r / I_GRP1; transpose_item(a.pool_w_grp + (size_t)g * 512 * 512, 512, 512, Wt_grp, g * 512, nullptr, a.pool_scale + g * 512, scr, r % I_GRP1, lane); continue; } r -= 4 * I_GRP1;
            if (r < I_OUT) { transpose_item(a.pool_w_out, DI, DM, Wt_out0, 0, nullptr, nullptr, scr, r, lane); continue; } r -= I_OUT;
            if (r < I_IN1) {
                const int n0 = 32 * (r % (8192 / 32)); int d0 = n0;
                if (n0 < 2048) d0 = 256 * (n0 >> 7) + (n0 & 127); else if (n0 < 4096) d0 = 256 * ((n0 - 2048) >> 7) + 128 + (n0 & 127);
                transpose_item(a.hgrn_w_in, DM, 8192, Wt_in1, d0 - n0, a.norm_g + DM, nullptr, scr, r, lane); continue; } r -= I_IN1;
            transpose_item(a.hgrn_w_out, DI, DM, Wt_out1, 0, a.hgrn_norm_g, nullptr, scr, r, lane);
        }
        for (int m = gw; m < M; m += NGW) {
            const f32x4* xr = (const f32x4*)(a.x + (size_t)m * DM) + lane;
            f32x4 v[4]; float s = 0.f;
#pragma unroll
            for (int j = 0; j < 4; ++j) { v[j] = xr[64 * j]; s += (v[j][0] * v[j][0] + v[j][1] * v[j][1]) + (v[j][2] * v[j][2] + v[j][3] * v[j][3]); }
            const float rstd = 1.0f / sqrtf(wave_sum(s, lane) * (1.0f / DM) + EPS);
            unsigned long long* o8 = (unsigned long long*)(XB + (size_t)m * DM) + lane;
#pragma unroll
            for (int j = 0; j < 4; ++j) o8[64 * j] = (unsigned long long)pk2(v[j][0] * rstd, v[j][1] * rstd) | ((unsigned long long)pk2(v[j][2] * rstd, v[j][3] * rstd) << 32);
        }
    }
    grid.sync();

    {
        pg8::Gemm g{XB, Wt_in0, DM, DM, DM, 0}; pg8::StaticOrder S; S.init(M, 4096, G, bid);
        pg8::EpiP1 E{BA, BB};
        pg8::gemm_phase<pg8::EpiP1>(lds, g, S, E, wave);
    }
    grid.sync();

    {
        PHASE_IDS
        const size_t nvec = (size_t)M * (DI / 8);
        for (size_t idx = (size_t)bid * 512 + tid; idx < nvec; idx += (size_t)G * 512) {
            const int m = (int)(idx >> 8), cgp = (int)(idx & 255), grp = cgp >> 6, w = 2 << grp, t = m & (SEQ - 1);
            const int cnt = (t + 1) < w ? (t + 1) : w;
            const bf16_t* vp = BA + (size_t)m * DI + cgp * 8;
            float sum[8];
#pragma unroll
            for (int j = 0; j < 8; ++j) sum[j] = 0.f;
            u32x4 v0 = *(const u32x4*)vp;
            for (int k = 0; k < cnt; ++k) { const u32x4 vv = *(const u32x4*)(vp - (size_t)k * DI);
                sum[0] += bf_lo(vv.x); sum[1] += bf_hi(vv.x); sum[2] += bf_lo(vv.y); sum[3] += bf_hi(vv.y); sum[4] += bf_lo(vv.z); sum[5] += bf_hi(vv.z); sum[6] += bf_lo(vv.w); sum[7] += bf_hi(vv.w); }
            const float inv = 1.0f / (float)cnt;
            u32x4 o; o.x = pk2(sum[0] * inv - bf_lo(v0.x), sum[1] * inv - bf_hi(v0.x)); o.y = pk2(sum[2] * inv - bf_lo(v0.y), sum[3] * inv - bf_hi(v0.y));
            o.z = pk2(sum[4] * inv - bf_lo(v0.z), sum[5] * inv - bf_hi(v0.z)); o.w = pk2(sum[6] * inv - bf_lo(v0.w), sum[7] * inv - bf_hi(v0.w));
            *(u32x4*)(BC + (size_t)m * DI + cgp * 8) = o;
        }
    }
    grid.sync();

    {
        pg8::Gemm g{BC, Wt_grp, DI, 512, 512, 2}; pg8::StaticOrder S; S.init(M, DI, G, bid);
        pg8::EpiP2 E{BB};
        pg8::gemm_phase<pg8::EpiP2>(lds, g, S, E, wave);
    }
    grid.sync();

    {
        pg8::Gemm g{BB, Wt_out0, DI, DI, DI, 0}; pg8::StaticOrder S; S.init(M, DM, G, bid);
        pg8::EpiRes<true> E{a.x, a.out, XB, part1};
        pg8::gemm_phase<pg8::EpiRes<true>>(lds, g, S, E, wave);
    }
    grid.sync();

    {
        pg8::Gemm g{XB, Wt_in1, DM, DM, DM, 0}; pg8::StaticOrder S; S.init(M, 6144, G, bid);
        pg8::EpiP4 E{BA, BB, BC, decb, part1, a.hgrn_lb};
        pg8::gemm_phase<pg8::EpiP4>(lds, g, S, E, wave);
    }
    grid.sync();

    scan::phase(lds, BA, BB, BC, decb, ssb, bid, G, wave);
    grid.sync();

    {
        pg8::Gemm g{XB, Wt_in1 + (size_t)6144 * DM, DM, DM, DM, 0}; pg8::StaticOrder S; S.init(M, DI, G, bid);
        pg8::EpiP5b E{BC, part1, ssb};
        pg8::gemm_phase<pg8::EpiP5b>(lds, g, S, E, wave);
    }
    grid.sync();

    {
        pg8::Gemm g{BC, Wt_out1, DI, DI, DI, 0}; pg8::StaticOrder S; S.init(M, DM, G, bid);
        pg8::EpiRes<false> E{a.out, a.out, nullptr, part2};
        pg8::gemm_phase<pg8::EpiRes<false>>(lds, g, S, E, wave);
    }
    grid.sync();

    {
        PHASE_IDS
        for (int m = gw; m < M; m += NGW) {
            const f32x4* p4 = (const f32x4*)(part2 + (size_t)m * 16); const f32x4 pa = p4[0], pb = p4[1], pc = p4[2], pd = p4[3]; const float p = (((pa[0] + pa[1]) + (pa[2] + pa[3])) + ((pb[0] + pb[1]) + (pb[2] + pb[3]))) + (((pc[0] + pc[1]) + (pc[2] + pc[3])) + ((pd[0] + pd[1]) + (pd[2] + pd[3])));
            const float rstd = 1.0f / sqrtf(p * (1.0f / DM) + EPS);
            f32x4* orow = (f32x4*)(a.out + (size_t)m * DM) + lane; const f32x4* gr = (const f32x4*)a.final_g + lane;
#pragma unroll
            for (int j = 0; j < 4; ++j) { f32x4 v = orow[64 * j]; const f32x4 gg = gr[64 * j]; v = v * rstd * gg; orow[64 * j] = v; }
        }
    }
}

extern "C" void kernel_launch(void* const* d_in, const int* in_sizes, int n_in, void* d_out, int out_size, void* d_ws, size_t ws_size, hipStream_t stream) {
    static int grid = 0;
    if (grid == 0) {
        if (n_in != 11 || in_sizes[0] != M * DM || out_size != M * DM || ws_size < WS_END) { fprintf(stderr, "kernel_launch: unexpected shapes (n_in %d in0 %d out %d ws %zu)\n", n_in, n_in > 0 ? in_sizes[0] : -1, out_size, ws_size); grid = -1; return; }
        int dev = 0, cus = 0, per = 0;
        if (hipGetDevice(&dev) != hipSuccess || hipDeviceGetAttribute(&cus, hipDeviceAttributeMultiprocessorCount, dev) != hipSuccess) { grid = -1; return; }
        if (hipFuncSetAttribute((const void*)fwd_kernel, hipFuncAttributeMaxDynamicSharedMemorySize, LDS_BYTES) != hipSuccess) { fprintf(stderr, "kernel_launch: hipFuncSetAttribute failed\n"); grid = -1; return; }
        if (hipOccupancyMaxActiveBlocksPerMultiprocessor(&per, (const void*)fwd_kernel, 512, LDS_BYTES) != hipSuccess || per < 1) { fprintf(stderr, "kernel_launch: occupancy query says %d\n", per); (void)hipGetLastError(); grid = -1; return; }
        grid = cus;
        fprintf(stderr, "kernel_launch: cus %d per_cu %d grid %d\n", cus, per, grid);
    }
    if (grid < 0) return;
    Args a{};
    a.x = (const float*)d_in[0]; a.norm_g = (const float*)d_in[1]; a.pool_w_in = (const float*)d_in[2]; a.pool_w_grp = (const float*)d_in[3];
    a.pool_scale = (const float*)d_in[4]; a.pool_w_out = (const float*)d_in[5]; a.hgrn_w_in = (const float*)d_in[6]; a.hgrn_lb = (const float*)d_in[7];
    a.hgrn_norm_g = (const float*)d_in[8]; a.hgrn_w_out = (const float*)d_in[9]; a.final_g = (const float*)d_in[10];
    a.out = (float*)d_out; a.ws = (unsigned char*)d_ws;
    void* args[] = {&a};
    hipError_t e = hipLaunchCooperativeKernel((void*)fwd_kernel, dim3(grid), dim3(512), args, LDS_BYTES, stream);
    if (e != hipSuccess) fprintf(stderr, "kernel_launch: cooperative launch failed: %s (grid %d)\n", hipGetErrorString(e), grid);
}
```

```cpp
#include <hip/hip_runtime.h>
#include <hip/hip_cooperative_groups.h>
#include <cstdio>
#include <cstdint>
namespace cg = cooperative_groups;

#define LAS __attribute__((address_space(3)))
typedef unsigned short bf16_t;
typedef short bf16x8 __attribute__((ext_vector_type(8)));
typedef float f32x4 __attribute__((ext_vector_type(4)));
typedef float f32x2 __attribute__((ext_vector_type(2)));
typedef unsigned u32x4 __attribute__((ext_vector_type(4)));
typedef unsigned u32x2 __attribute__((ext_vector_type(2)));

constexpr int DM = 1024, BATCH = 8, SEQ = 4096, DI = 2048, M = BATCH * SEQ;
constexpr int NHEAD = 16, HD = 128;
constexpr float EPS = 1e-6f;
constexpr size_t MiB = 1u << 20;
constexpr size_t WS_WIN0 = 2 * MiB;
constexpr size_t WS_WGRP = 10 * MiB;
constexpr size_t WS_WOUT0 = 12 * MiB;
constexpr size_t WS_WIN1 = 16 * MiB;
constexpr size_t WS_WOUT1 = 32 * MiB;
constexpr size_t WS_PART1 = 36 * MiB;
constexpr size_t WS_PART2 = 38 * MiB;
constexpr size_t WS_DEC = 44 * MiB;
constexpr size_t WS_SS = 112 * MiB;
constexpr size_t WS_XB = 48 * MiB;
constexpr size_t WS_A = 128 * MiB;
constexpr size_t WS_B = 256 * MiB;
constexpr size_t WS_C = 384 * MiB;
constexpr size_t WS_END = 512 * MiB;
constexpr int LDS_BYTES = 147456;

__device__ __forceinline__ unsigned f2bf(float f) { unsigned u = __builtin_bit_cast(unsigned, f); return (u + 0x7fffu + ((u >> 16) & 1u)) >> 16; }
__device__ __forceinline__ unsigned pk2(float lo, float hi) { return f2bf(lo) | (f2bf(hi) << 16); }
typedef __bf16 bf2_t __attribute__((ext_vector_type(2)));
__device__ __forceinline__ unsigned pkbf(float lo, float hi) { f32x2 v = {lo, hi}; return __builtin_bit_cast(unsigned, __builtin_convertvector(v, bf2_t)); }
__device__ __forceinline__ float bf_lo(unsigned w) { return __builtin_bit_cast(float, w << 16); }
__device__ __forceinline__ float bf_hi(unsigned w) { return __builtin_bit_cast(float, w & 0xffff0000u); }
__device__ __forceinline__ float silu_f(float x) { return x * __builtin_amdgcn_rcpf(1.0f + __builtin_amdgcn_exp2f(-1.44269504089f * x)); }
__device__ __forceinline__ float lane_get(float v, int src_lane) { return __builtin_bit_cast(float, __builtin_amdgcn_ds_bpermute(src_lane << 2, __builtin_bit_cast(int, v))); }
__device__ __forceinline__ float xor_get(float v, int lane, int m) { return lane_get(v, lane ^ m); }
__device__ __forceinline__ float wave_sum(float v, int lane) {
#pragma unroll
    for (int o = 1; o < 64; o <<= 1) v += xor_get(v, lane, o);
    return v;
}

namespace pg8 {
constexpr int BM = 256, BK = 64, HALF = 128, HTB = HALF * BK * 2, STAGE_BYTES = 8 * HTB, NXCD = 8, WGM = 8;
__host__ __device__ __forceinline__ int lds_byte(int r, int c) { const int st = (r >> 4) * 2 + (c >> 5), rr = r & 15, cc = c & 31, ob = rr * 64 + cc * 2; return st * 1024 + (ob ^ (((ob >> 9) & 1) << 5)); }
__host__ __device__ __forceinline__ void stage_rc(int b, int& R, int& C) { const int st = b / 1024, sb = b % 1024, swz = sb ^ (((sb >> 9) & 1) << 5); R = (st >> 1) * 16 + swz / 64; C = (st & 1) * 32 + (swz % 64) / 2; }
__host__ __device__ __forceinline__ int perm32(int rho) { const int n = rho >> 4, i = rho & 15; return 8 * (i >> 2) + 4 * n + (i & 3); }

struct Unit { int pm, pn; };
struct Gemm { const bf16_t* A; const bf16_t* Bt; int lda, ldb, K, grp_tiles; };

struct StaticOrder {
    int nM, nN, nwg, G, c;
    __host__ __device__ void init(int M_, int N_, int G_, int c_) { nM = M_ / BM; nN = N_ / BM; nwg = nM * nN; G = G_; c = c_; }
    __host__ __device__ bool next(int i, Unit& u) const {
        const long L = (long)i * G + c; if (L >= nwg) return false;
        int wgid = (int)L; { const int q = nwg / NXCD, r = nwg % NXCD, xcd = wgid % NXCD, off = wgid / NXCD; wgid = (xcd < r ? xcd * (q + 1) : r * (q + 1) + (xcd - r) * q) + off; }
        const int nig = WGM * nN, gid = wgid / nig, fm = gid * WGM, gsz = (nM - fm) < WGM ? (nM - fm) : WGM;
        u.pm = fm + ((wgid % nig) % gsz); u.pn = (wgid % nig) / gsz; return true;
    }
};

__device__ __forceinline__ unsigned cvt_pk_bf16(float lo, float hi) { unsigned r; asm volatile("v_cvt_pk_bf16_f32 %0, %1, %2" : "=v"(r) : "v"(lo), "v"(hi)); return r; }

template <class Epi, bool ALIGN_EPI = true, bool SP2 = true>
__device__ __forceinline__ void gemm_phase(LAS unsigned char* lds, const Gemm g, const StaticOrder& S, const Epi& E, const int wid) {
    int lane_ = (int)__builtin_amdgcn_mbcnt_hi(~0u, __builtin_amdgcn_mbcnt_lo(~0u, 0u)); asm volatile("" : "+v"(lane_));
    int lane = lane_, tid = wid * 64 + lane, fr = lane & 15, fq = lane >> 4; const int wr = wid >> 2, wc = wid & 3;
    const int K = g.K, nt = K / BK;
    unsigned voffA[2], voffB[2]; int aoff, boff;
#define PG8_LANE_STATE() do { _Pragma("unroll") for (int i = 0; i < 2; ++i) { int R, C; stage_rc(tid * 16 + i * 8192, R, C); const int Rb = Epi::PERM ? ((R & ~31) + perm32(R & 31)) : R; \
        voffA[i] = (unsigned)(R * g.lda + C) * 2u; voffB[i] = (unsigned)(Rb * g.ldb + C) * 2u; } \
        aoff = lds_byte(wr * 64 + fr, fq * 8); boff = lds_byte(wc * 32 + fr, fq * 8); } while (0)
    PG8_LANE_STATE();
    const size_t kstep = (size_t)(BK * 2);
    const size_t hstepA = (size_t)HALF * g.lda * 2, hstepB = (size_t)HALF * g.ldb * 2;
    const size_t tstepA = 2 * hstepA, tstepB = 2 * hstepB;
    const unsigned ldsw = (unsigned)wid * 1024u;
#define PG8_SA(b, h) (((b) * 2 + (h)) * HTB)
#define PG8_SB(b, h) ((4 + (b) * 2 + (h)) * HTB)
#define PG8_STAGE(bufoff, gbase, voff) do { _Pragma("unroll") for (int _i = 0; _i < 2; ++_i) \
        __builtin_amdgcn_global_load_lds((const unsigned*)((const char*)(gbase) + (voff)[_i]), (LAS unsigned*)(lds + (bufoff) + ldsw + _i * 8192), 16, 0, 0); } while (0)
#define PG8_LDA(dst, b, h) do { _Pragma("unroll") for (int m = 0; m < 4; ++m) _Pragma("unroll") for (int k = 0; k < 2; ++k) dst[m][k] = *(const LAS bf16x8*)(lds + PG8_SA(b, h) + aoff + m * 2048 + k * 1024); } while (0)
#define PG8_LDB(dst, b, h) do { _Pragma("unroll") for (int n = 0; n < 2; ++n) _Pragma("unroll") for (int k = 0; k < 2; ++k) dst[n][k] = *(const LAS bf16x8*)(lds + PG8_SB(b, h) + boff + n * 2048 + k * 1024); } while (0)
#define PG8_MMA(ai, bj, At, Bt) do { __builtin_amdgcn_s_setprio(1); _Pragma("unroll") for (int m = 0; m < 4; ++m) _Pragma("unroll") for (int n = 0; n < 2; ++n) _Pragma("unroll") for (int k = 0; k < 2; ++k) \
        acc[ai][bj][m][n] = __builtin_amdgcn_mfma_f32_16x16x32_bf16(Bt[n][k], At[m][k], acc[ai][bj][m][n], 0, 0, 0); __builtin_amdgcn_s_setprio(0); } while (0)
#define PG8_WAIT_V(n) asm volatile("s_waitcnt vmcnt(" #n ")" ::: "memory")
#define PG8_WAIT_L(n) asm volatile("s_waitcnt lgkmcnt(" #n ")" ::: "memory")
#define PG8_BAR __builtin_amdgcn_s_barrier()
#define PG8_SCHED __builtin_amdgcn_sched_barrier(0)
#define PG8_ABASE(u) ((const char*)g.A + (size_t)(u).pm * tstepA + (g.grp_tiles ? (size_t)((u).pn / g.grp_tiles) * (size_t)K * 2 : (size_t)0))
#define PG8_BBASE(u) ((const char*)g.Bt + (size_t)(u).pn * tstepB)
    Unit cur, nxt; int ui = 0;
    if (!S.next(0, cur)) return;
    f32x4 acc[2][2][4][2];
#pragma unroll
    for (int a = 0; a < 2; ++a)
#pragma unroll
        for (int b = 0; b < 2; ++b)
#pragma unroll
            for (int m = 0; m < 4; ++m)
#pragma unroll
                for (int n = 0; n < 2; ++n) acc[a][b][m][n] = (f32x4){0.f, 0.f, 0.f, 0.f};
    bf16x8 At[4][2], B0[2][2], B1[2][2];
    const char* cA = PG8_ABASE(cur); const char* cB = PG8_BBASE(cur);
    if constexpr (SP2) {
        PG8_STAGE(PG8_SB(0, 0), cB, voffB); PG8_STAGE(PG8_SB(0, 1), cB + hstepB, voffB); PG8_STAGE(PG8_SA(0, 0), cA, voffA); PG8_STAGE(PG8_SA(0, 1), cA + hstepA, voffA);
        if (wr == 1) PG8_BAR;
        PG8_WAIT_V(2); PG8_BAR;
        PG8_STAGE(PG8_SB(1, 0), cB + kstep, voffB); PG8_STAGE(PG8_SA(1, 0), cA + kstep, voffA); PG8_STAGE(PG8_SB(1, 1), cB + hstepB + kstep, voffB);
        PG8_WAIT_V(6); PG8_BAR;
    } else {
        PG8_STAGE(PG8_SB(0, 0), cB, voffB); PG8_STAGE(PG8_SA(0, 0), cA, voffA); PG8_STAGE(PG8_SB(0, 1), cB + hstepB, voffB); PG8_STAGE(PG8_SA(0, 1), cA + hstepA, voffA);
        if (wr == 1) PG8_BAR;
        PG8_WAIT_V(4); PG8_BAR;
        PG8_STAGE(PG8_SB(1, 0), cB + kstep, voffB); PG8_STAGE(PG8_SA(1, 0), cA + kstep, voffA); PG8_STAGE(PG8_SB(1, 1), cB + hstepB + kstep, voffB);
        PG8_WAIT_V(6); PG8_BAR;
    }
    for (;;) {
        const bool has_next = S.next(ui + 1, nxt);
        const char* nA = has_next ? PG8_ABASE(nxt) : cA; const char* nB = has_next ? PG8_BBASE(nxt) : cB;
        for (int t = 0; t < nt; t += 2) {
            const bool last = (t == nt - 2);
            const char* a1 = cA + (size_t)(t + 1) * kstep;
            const char* a2 = last ? nA : cA + (size_t)(t + 2) * kstep; const char* b2 = last ? nB : cB + (size_t)(t + 2) * kstep;
            const char* a3 = a2 + kstep; const char* b3 = b2 + kstep;
            if constexpr (SP2) {
            PG8_LDB(B0, 0, 0); PG8_LDB(B1, 0, 1); PG8_SCHED; PG8_LDA(At, 0, 0); PG8_STAGE(PG8_SA(1, 1), a1 + hstepA, voffA);
            PG8_WAIT_V(8); PG8_WAIT_L(0); PG8_BAR; PG8_MMA(0, 0, At, B0); PG8_MMA(0, 1, At, B1); PG8_BAR; PG8_SCHED;
            PG8_LDA(At, 0, 1); PG8_STAGE(PG8_SB(0, 0), b2, voffB); PG8_STAGE(PG8_SB(0, 1), b2 + hstepB, voffB); PG8_STAGE(PG8_SA(0, 0), a2, voffA);
            PG8_WAIT_V(8); PG8_WAIT_L(0); PG8_BAR; PG8_MMA(1, 0, At, B0); PG8_MMA(1, 1, At, B1); PG8_BAR; PG8_SCHED;
            PG8_LDB(B0, 1, 0); PG8_LDB(B1, 1, 1); PG8_SCHED; PG8_LDA(At, 1, 0); PG8_STAGE(PG8_SA(0, 1), a2 + hstepA, voffA);
            PG8_WAIT_V(8); PG8_WAIT_L(0); PG8_BAR; PG8_MMA(0, 0, At, B0); PG8_MMA(0, 1, At, B1); PG8_BAR; PG8_SCHED;
            PG8_LDA(At, 1, 1); PG8_STAGE(PG8_SB(1, 0), b3, voffB); PG8_STAGE(PG8_SB(1, 1), b3 + hstepB, voffB); PG8_STAGE(PG8_SA(1, 0), a3, voffA);
            PG8_WAIT_V(8); PG8_WAIT_L(0); PG8_BAR; PG8_MMA(1, 0, At, B0); PG8_MMA(1, 1, At, B1); PG8_BAR; PG8_SCHED;
            } else {
            PG8_LDB(B0, 0, 0); PG8_SCHED; PG8_LDA(At, 0, 0); PG8_STAGE(PG8_SA(1, 1), a1 + hstepA, voffA);
            PG8_WAIT_L(8); PG8_BAR; PG8_WAIT_L(0); PG8_MMA(0, 0, At, B0); PG8_BAR; PG8_SCHED;
            PG8_LDB(B1, 0, 1); PG8_STAGE(PG8_SB(0, 0), b2, voffB);
            PG8_BAR; PG8_WAIT_L(0); PG8_MMA(0, 1, At, B1); PG8_BAR;
            PG8_LDA(At, 0, 1); PG8_STAGE(PG8_SA(0, 0), a2, voffA);
            PG8_BAR; PG8_WAIT_L(0); PG8_MMA(1, 0, At, B0); PG8_BAR; PG8_SCHED;
            PG8_STAGE(PG8_SB(0, 1), b2 + hstepB, voffB);
            PG8_WAIT_V(6); PG8_BAR; PG8_MMA(1, 1, At, B1); PG8_BAR;
            PG8_LDB(B0, 1, 0); PG8_SCHED; PG8_LDA(At, 1, 0); PG8_STAGE(PG8_SA(0, 1), a2 + hstepA, voffA);
            PG8_WAIT_L(8); PG8_BAR; PG8_WAIT_L(0); PG8_MMA(0, 0, At, B0); PG8_BAR; PG8_SCHED;
            PG8_LDB(B1, 1, 1); PG8_STAGE(PG8_SB(1, 0), b3, voffB);
            PG8_BAR; PG8_WAIT_L(0); PG8_MMA(0, 1, At, B1); PG8_BAR;
            PG8_LDA(At, 1, 1); PG8_STAGE(PG8_SA(1, 0), a3, voffA);
            PG8_BAR; PG8_WAIT_L(0); PG8_MMA(1, 0, At, B0); PG8_BAR; PG8_SCHED;
            PG8_STAGE(PG8_SB(1, 1), b3 + hstepB, voffB);
            PG8_WAIT_V(6); PG8_BAR; PG8_MMA(1, 1, At, B1); PG8_BAR;
            }
        }
        if constexpr (ALIGN_EPI) { if (wr == 0) PG8_BAR; }
        if constexpr (!Epi::AFTER_DRAIN) E(acc, cur, wr, wc, fr, fq);
        if (!has_next) break;
#pragma unroll
        for (int a = 0; a < 2; ++a)
#pragma unroll
            for (int b = 0; b < 2; ++b)
#pragma unroll
                for (int m = 0; m < 4; ++m)
#pragma unroll
                    for (int n = 0; n < 2; ++n) acc[a][b][m][n] = (f32x4){0.f, 0.f, 0.f, 0.f};
        cur = nxt; cA = nA; cB = nB; ++ui;
        asm volatile("" : "+v"(lane)); tid = wid * 64 + lane; fr = lane & 15; fq = lane >> 4; PG8_LANE_STATE();
        if constexpr (ALIGN_EPI) { if (wr == 1) PG8_BAR; }
    }
    PG8_WAIT_V(0);
    if constexpr (!ALIGN_EPI) { if (wr == 0) PG8_BAR; }
    PG8_BAR;
    if constexpr (Epi::AFTER_DRAIN) E.fused(acc, cur, wr, wc, fr, fq, lds, tid);
#undef PG8_SA
#undef PG8_SB
#undef PG8_STAGE
#undef PG8_LDA
#undef PG8_LDB
#undef PG8_MMA
#undef PG8_WAIT_V
#undef PG8_WAIT_L
#undef PG8_BAR
#undef PG8_SCHED
#undef PG8_ABASE
#undef PG8_LANE_STATE
#undef PG8_BBASE
}

struct EpiP1 {
    static constexpr bool PERM = true, AFTER_DRAIN = false;
    bf16_t* V; bf16_t* SG;
    __device__ __forceinline__ void operator()(f32x4 (&acc)[2][2][4][2], const Unit& u, int wr, int wc, int fr, int fq) const {
        const int row0 = u.pm * BM + wr * 64 + fr; const bool gate = u.pn >= 8;
        bf16_t* base = gate ? SG : V; const int col0 = (u.pn & 7) * BM + wc * 32 + 8 * fq;
#pragma unroll
        for (int ai = 0; ai < 2; ++ai)
#pragma unroll
            for (int m = 0; m < 4; ++m) { bf16_t* rowp = base + (size_t)(row0 + ai * HALF + m * 16) * DI + col0;
#pragma unroll
                for (int bj = 0; bj < 2; ++bj) { f32x4 v0 = acc[ai][bj][m][0], v1 = acc[ai][bj][m][1];
                    if (gate) {
#pragma unroll
                        for (int j = 0; j < 4; ++j) { v0[j] = silu_f(v0[j]); v1[j] = silu_f(v1[j]); } }
                    u32x4 w; w.x = cvt_pk_bf16(v0[0], v0[1]); w.y = cvt_pk_bf16(v0[2], v0[3]); w.z = cvt_pk_bf16(v1[0], v1[1]); w.w = cvt_pk_bf16(v1[2], v1[3]);
                    *(u32x4*)(rowp + bj * HALF) = w; } }
    }
};
struct EpiP2 {
    static constexpr bool PERM = true, AFTER_DRAIN = false;
    bf16_t* Z;
    __device__ __forceinline__ void operator()(f32x4 (&acc)[2][2][4][2], const Unit& u, int wr, int wc, int fr, int fq) const {
        const int row0 = u.pm * BM + wr * 64 + fr; const int col0 = u.pn * BM + wc * 32 + 8 * fq;
#pragma unroll
        for (int ai = 0; ai < 2; ++ai)
#pragma unroll
            for (int m = 0; m < 4; ++m) { bf16_t* rowp = Z + (size_t)(row0 + ai * HALF + m * 16) * DI + col0;
#pragma unroll
                for (int bj = 0; bj < 2; ++bj) { const f32x4 v0 = acc[ai][bj][m][0], v1 = acc[ai][bj][m][1];
                    const u32x4 s = *(const u32x4*)(rowp + bj * HALF);
                    u32x4 w; w.x = cvt_pk_bf16(v0[0] * bf_lo(s.x), v0[1] * bf_hi(s.x)); w.y = cvt_pk_bf16(v0[2] * bf_lo(s.y), v0[3] * bf_hi(s.y));
                    w.z = cvt_pk_bf16(v1[0] * bf_lo(s.z), v1[1] * bf_hi(s.z)); w.w = cvt_pk_bf16(v1[2] * bf_lo(s.w), v1[3] * bf_hi(s.w));
                    *(u32x4*)(rowp + bj * HALF) = w; } }
    }
};
template <bool WRITE_HB> struct EpiRes {
    static constexpr bool PERM = false, AFTER_DRAIN = false;
    const float* R; float* H; bf16_t* HB; float* part;
    __device__ __forceinline__ void operator()(f32x4 (&acc)[2][2][4][2], const Unit& u, int wr, int wc, int fr, int fq) const {
        const unsigned row0 = (unsigned)(u.pm * BM + wr * 64 + fr), col0 = (unsigned)(u.pn * BM + wc * 32 + 4 * fq);
        const unsigned ofs = (row0 * DM + col0) * 4u, pofs = (row0 * 16u + (unsigned)(u.pn * 4 + wc)) * 4u;
#pragma unroll
        for (int ai = 0; ai < 2; ++ai)
#pragma unroll
            for (int m = 0; m < 4; ++m) { const unsigned o = ofs + (unsigned)((ai * HALF + m * 16) * DM) * 4u; float ss = 0.f;
#pragma unroll
                for (int bj = 0; bj < 2; ++bj)
#pragma unroll
                    for (int n = 0; n < 2; ++n) { const unsigned oo = o + (unsigned)(bj * HALF + n * 16) * 4u;
                        const f32x4 xv = *(const f32x4*)((const char*)R + oo); const f32x4 h = xv + acc[ai][bj][m][n];
                        *(f32x4*)((char*)H + oo) = h; ss += (h[0] * h[0] + h[1] * h[1]) + (h[2] * h[2] + h[3] * h[3]);
                        if (WRITE_HB) { u32x2 w; w.x = pkbf(h[0], h[1]); w.y = pkbf(h[2], h[3]); *(u32x2*)((char*)HB + (oo >> 1)) = w; } }
                ss += xor_get(ss, fq * 16 + fr, 16); ss += xor_get(ss, fq * 16 + fr, 32);
                if (fq == 0) *(float*)((char*)part + (pofs + (unsigned)(ai * HALF + m * 16) * 64u)) = ss;
                asm volatile("" ::: "memory"); }
    }
};
__device__ __forceinline__ float row_rstd_b(const float* part, unsigned bofs) {
    const f32x4* p = (const f32x4*)((const char*)part + bofs); const f32x4 a = p[0], b = p[1], c = p[2], d = p[3];
    return __builtin_amdgcn_rsqf((((a[0] + a[1]) + (a[2] + a[3])) + ((b[0] + b[1]) + (b[2] + b[3])) + ((c[0] + c[1]) + (c[2] + c[3])) + ((d[0] + d[1]) + (d[2] + d[3]))) * (1.0f / DM) + EPS);
}
__device__ __forceinline__ float dpp_shr_mul(float v, const int n) {
    const int iv = __builtin_bit_cast(int, v), one = 0x3f800000; int r;
    if (n == 1) r = __builtin_amdgcn_update_dpp(one, iv, 0x111, 0xf, 0xf, false); else if (n == 2) r = __builtin_amdgcn_update_dpp(one, iv, 0x112, 0xf, 0xf, false);
    else if (n == 4) r = __builtin_amdgcn_update_dpp(one, iv, 0x114, 0xf, 0xf, false); else r = __builtin_amdgcn_update_dpp(one, iv, 0x118, 0xf, 0xf, false);
    return v * __builtin_bit_cast(float, r);
}
struct EpiP4 {
    static constexpr bool PERM = true, AFTER_DRAIN = false;
    bf16_t* Qt; bf16_t* Kt; bf16_t* V; float* DEC; const float* part; const float* lbnd;
    __device__ __forceinline__ void operator()(f32x4 (&acc)[2][2][4][2], const Unit& u, int wr, int wc, int fr, int fq) const {
        const unsigned row0 = (unsigned)(u.pm * BM + wr * 64 + fr);
        const unsigned pofs = row0 * 64u;
        if (u.pn >= 16) {
            const unsigned vofs = (row0 * DI + (unsigned)((u.pn - 16) * BM + wc * 32 + 8 * fq)) * 2u;
#pragma unroll
            for (int ai = 0; ai < 2; ++ai)
#pragma unroll
                for (int m = 0; m < 4; ++m) { const float rs = row_rstd_b(part, pofs + (unsigned)(ai * HALF + m * 16) * 64u);
#pragma unroll
                    for (int bj = 0; bj < 2; ++bj) { const f32x4 v0 = acc[ai][bj][m][0] * rs, v1 = acc[ai][bj][m][1] * rs;
                        u32x4 w; w.x = pkbf(v0[0], v0[1]); w.y = pkbf(v0[2], v0[3]); w.z = pkbf(v1[0], v1[1]); w.w = pkbf(v1[2], v1[3]);
                        *(u32x4*)((char*)V + (vofs + (unsigned)((ai * HALF + m * 16) * DI + bj * HALF) * 2u)) = w; }
                    asm volatile("" ::: "memory"); }
            return;
        }
        const unsigned c0 = (unsigned)(u.pn * HD + wc * 32 + 8 * fq);
        const unsigned qofs = (row0 * DI + c0) * 2u;
#pragma unroll
        for (int ai = 0; ai < 2; ++ai) {
            float rs[4];
#pragma unroll
            for (int m = 0; m < 4; ++m) { rs[m] = row_rstd_b(part, pofs + (unsigned)(ai * HALF + m * 16) * 64u); asm volatile("" : "+v"(rs[m]) :: "memory"); }
            unsigned cc = c0; asm volatile("" : "+v"(cc));
#pragma unroll
            for (int n = 0; n < 2; ++n) {
                const f32x4 l0 = *(const f32x4*)((const char*)lbnd + (cc + 4 * n) * 4u), l1 = *(const f32x4*)((const char*)lbnd + (cc + 4 * n + DI) * 4u);
                f32x4 decv;
#pragma unroll
                for (int j = 0; j < 4; ++j) { const float ex = __expf(l0[j] - l1[j]); const float lb = __builtin_amdgcn_rcpf(1.0f + ex), omlb = ex * lb; float bprod = 1.0f;
#pragma unroll
                    for (int m = 0; m < 4; ++m) {
                        const float qv = acc[ai][0][m][n][j] * rs[m], z = acc[ai][1][m][n][j] * rs[m];
                        const float sg = __builtin_amdgcn_rcpf(1.0f + __builtin_amdgcn_exp2f(-1.44269504089f * z));
                        const float f = lb + omlb * sg, k = omlb * (1.0f - sg);
                        float s = f; s = dpp_shr_mul(s, 1); s = dpp_shr_mul(s, 2); s = dpp_shr_mul(s, 4); s = dpp_shr_mul(s, 8);
                        const float E = bprod * s;
                        if (m < 3) bprod *= lane_get(s, fq * 16 + 15);
                        const float Ei = __builtin_amdgcn_rcpf(fmaxf(E, 7.9e-31f));
                        acc[ai][0][m][n][j] = qv * E; acc[ai][1][m][n][j] = k * Ei;
                        if (m == 3) decv[j] = E;
                    } }
                if (fr == 15) *(f32x4*)((char*)DEC + ((unsigned)(u.pm * 4 + ai * 2 + wr) * DI + cc + 4 * n) * 4u) = decv;
            }
#pragma unroll
            for (int m = 0; m < 4; ++m) { const unsigned ob = qofs + (unsigned)((ai * HALF + m * 16) * DI) * 2u;
                u32x4 w; w.x = pkbf(acc[ai][0][m][0][0], acc[ai][0][m][0][1]); w.y = pkbf(acc[ai][0][m][0][2], acc[ai][0][m][0][3]); w.z = pkbf(acc[ai][0][m][1][0], acc[ai][0][m][1][1]); w.w = pkbf(acc[ai][0][m][1][2], acc[ai][0][m][1][3]);
                *(u32x4*)((char*)Qt + ob) = w;
                u32x4 x; x.x = pkbf(acc[ai][1][m][0][0], acc[ai][1][m][0][1]); x.y = pkbf(acc[ai][1][m][0][2], acc[ai][1][m][0][3]); x.z = pkbf(acc[ai][1][m][1][0], acc[ai][1][m][1][1]); x.w = pkbf(acc[ai][1][m][1][2], acc[ai][1][m][1][3]);
                *(u32x4*)((char*)Kt + ob) = x; }
            asm volatile("" ::: "memory");
        }
    }
};
struct EpiP5b {
    static constexpr bool PERM = true, AFTER_DRAIN = false;
    bf16_t* O; const float* part; const float* ss;
    __device__ __forceinline__ void operator()(f32x4 (&acc)[2][2][4][2], const Unit& u, int wr, int wc, int fr, int fq) const {
        const int row0 = u.pm * BM + wr * 64 + fr; const int col0 = u.pn * BM + wc * 32 + 8 * fq;
        const unsigned pofs = (unsigned)row0 * 64u; const float* srow = ss + (size_t)row0 * 128 + u.pn * 16;
        char* op = (char*)(O + (size_t)row0 * DI + col0);
#pragma unroll
        for (int ai = 0; ai < 2; ++ai)
#pragma unroll
            for (int m = 0; m < 4; ++m) { const float rs = row_rstd_b(part, pofs + (unsigned)(ai * HALF + m * 16) * 64u);
#pragma unroll
                for (int bj = 0; bj < 2; ++bj) { const f32x4 v0 = acc[ai][bj][m][0] * rs, v1 = acc[ai][bj][m][1] * rs;
                    const f32x4* sp = (const f32x4*)(srow + (size_t)(ai * HALF + m * 16) * 128 + bj * 8); const f32x4 s0 = sp[0], s1 = sp[1];
                    const float rh = __builtin_amdgcn_rsqf((((s0[0] + s0[1]) + (s0[2] + s0[3])) + ((s1[0] + s1[1]) + (s1[2] + s1[3]))) * (1.0f / HD) + EPS);
                    u32x4* optr = (u32x4*)(op + (size_t)((ai * HALF + m * 16) * DI + bj * HALF) * 2);
                    const u32x4 s = *optr;
                    u32x4 w; w.x = pkbf(bf_lo(s.x) * rh * silu_f(v0[0]), bf_hi(s.x) * rh * silu_f(v0[1])); w.y = pkbf(bf_lo(s.y) * rh * silu_f(v0[2]), bf_hi(s.y) * rh * silu_f(v0[3]));
                    w.z = pkbf(bf_lo(s.z) * rh * silu_f(v1[0]), bf_hi(s.z) * rh * silu_f(v1[1])); w.w = pkbf(bf_lo(s.w) * rh * silu_f(v1[2]), bf_hi(s.w) * rh * silu_f(v1[3]));
                    *optr = w; }
                asm volatile("" ::: "memory"); }
    }
};
}

namespace scan {
#define MFMA16(a, b, c) __builtin_amdgcn_mfma_f32_16x16x32_bf16((a), (b), (c), 0, 0, 0)
__device__ __forceinline__ unsigned offb(unsigned row, unsigned ch) { return 256u * row + 16u * (ch ^ (((row & 3u) << 2) | ((row >> 2) & 3u))); }
__device__ __forceinline__ unsigned voffv(unsigned r, unsigned cp) { return 128u * r + 32u * (cp ^ (((r >> 1) & 3u) ^ (((r >> 3) & 1u) << 1))); }
__device__ __forceinline__ bf16x8 tr2(unsigned a0, unsigned a1) {
    u32x2 lo, hi;
    asm volatile("ds_read_b64_tr_b16 %0, %2\n\tds_read_b64_tr_b16 %1, %3\n\ts_waitcnt lgkmcnt(0)" : "=&v"(lo), "=&v"(hi) : "v"(a0), "v"(a1) : "memory");
    const u32x4 r = {lo.x, lo.y, hi.x, hi.y}; return __builtin_bit_cast(bf16x8, r);
}
__device__ __forceinline__ bf16x8 pack8(const f32x4 a, const f32x4 b) { const u32x4 r = {pkbf(a[0], a[1]), pkbf(a[2], a[3]), pkbf(b[0], b[1]), pkbf(b[2], b[3])}; return __builtin_bit_cast(bf16x8, r); }
template <int NJ>
__device__ __forceinline__ f32x4 ttile(LAS unsigned char* lds, unsigned ldsb, unsigned QI, unsigned KI, unsigned VI, int it, const bf16x8 (&sfrag)[4],
                                       unsigned vs, unsigned l15, unsigned g, unsigned ql, unsigned p) {
    const unsigned trow = 16u * (unsigned)it + l15;
    bf16x8 qb[4];
#pragma unroll
    for (int kd = 0; kd < 4; ++kd) qb[kd] = *(const LAS bf16x8*)(lds + QI + offb(trow, 4u * kd + g));
    f32x4 c[NJ];
#pragma unroll
    for (int j = 0; j < NJ; ++j) { c[j] = (f32x4){0.f, 0.f, 0.f, 0.f};
        if (j <= it) {
#pragma unroll
            for (int kd = 0; kd < 4; ++kd) { const bf16x8 a = *(const LAS bf16x8*)(lds + KI + offb(16u * j + l15, 4u * kd + g)); c[j] = MFMA16(a, qb[kd], c[j]); }
            if (j == it) {
#pragma unroll
                for (int r = 0; r < 4; ++r) c[j][r] = (4u * g + r <= l15) ? c[j][r] : 0.f; } } }
    f32x4 o = (f32x4){0.f, 0.f, 0.f, 0.f};
#pragma unroll
    for (int ks = 0; ks < NJ / 2; ++ks) if (2 * ks <= it) {
        const bf16x8 at = pack8(c[2 * ks], c[2 * ks + 1]);
        const bf16x8 vf = tr2(ldsb + VI + voffv(32u * ks + 4u * g + ql, vs) + 8u * p, ldsb + VI + voffv(32u * ks + 16u + 4u * g + ql, vs) + 8u * p);
        o = MFMA16(vf, at, o); }
#pragma unroll
    for (int kd = 0; kd < 4; ++kd) {
        const u32x2 q0 = *(const LAS u32x2*)(lds + QI + offb(trow, 4u * kd + (g >> 1)) + 8u * (g & 1)), q1 = *(const LAS u32x2*)(lds + QI + offb(trow, 4u * kd + 2u + (g >> 1)) + 8u * (g & 1));
        const u32x4 qq = {q0.x, q0.y, q1.x, q1.y};
        o = MFMA16(sfrag[kd], __builtin_bit_cast(bf16x8, qq), o); }
    return o;
}
__device__ __forceinline__ void phase(LAS unsigned char* lds, const bf16_t* Qt, const bf16_t* Kt, bf16_t* VO, const float* DEC, float* ss8, int bid, int G, int wave) {
    int lane_ = (int)__builtin_amdgcn_mbcnt_hi(~0u, __builtin_amdgcn_mbcnt_lo(~0u, 0u)); asm volatile("" : "+v"(lane_));
    const unsigned lane = (unsigned)lane_, tid = (unsigned)wave * 64u + lane, l15 = lane & 15u, g = lane >> 4, ql = l15 >> 2, p = lane & 3u;
    const unsigned vs = (unsigned)wave & 3u; const int th = wave >> 2, tA = th ? 1 : 0, tB = th ? 2 : 3;
    const unsigned ldsb = (unsigned)(uintptr_t)lds;
    const unsigned srow = tid >> 4, sch = tid & 15u, vrow = tid >> 3, vch = tid & 7u;
    for (int item = bid; item < BATCH * NHEAD * 2; item += G) {
        const int b = item >> 5, h = (item >> 1) & 15, half = item & 1;
        const size_t tokb = (size_t)b * SEQ;
        const bf16_t* qg = Qt + (tokb + srow) * DI + h * HD + sch * 8;
        const bf16_t* kg = Kt + (tokb + srow) * DI + h * HD + sch * 8;
        bf16_t* vg = VO + tokb * DI + h * HD + half * 64;
        f32x4 S[8]; bf16x8 sfrag[4];
#pragma unroll
        for (int i = 0; i < 8; ++i) S[i] = (f32x4){0.f, 0.f, 0.f, 0.f};
#pragma unroll
        for (int i = 0; i < 4; ++i) sfrag[i] = (bf16x8){0, 0, 0, 0, 0, 0, 0, 0};
        u32x4 rq0, rq1, rk0, rk1, rv;
#define SC_LOAD(n_) do { const size_t t0_ = (size_t)(n_) * 64; \
            rq0 = *(const u32x4*)(qg + t0_ * DI); rq1 = *(const u32x4*)(qg + (t0_ + 32) * DI); rk0 = *(const u32x4*)(kg + t0_ * DI); rk1 = *(const u32x4*)(kg + (t0_ + 32) * DI); \
            rv = *(const u32x4*)(vg + (t0_ + vrow) * DI + vch * 8); } while (0)
#define SC_STORE(base_) do { *(LAS u32x4*)(lds + (base_) + offb(srow, sch)) = rq0; *(LAS u32x4*)(lds + (base_) + offb(srow + 32u, sch)) = rq1; \
            *(LAS u32x4*)(lds + (base_) + 16384u + offb(srow, sch)) = rk0; *(LAS u32x4*)(lds + (base_) + 16384u + offb(srow + 32u, sch)) = rk1; \
            *(LAS u32x4*)(lds + (base_) + 32768u + voffv(vrow, vch >> 1) + 16u * (vch & 1u)) = rv; } while (0)
        SC_LOAD(0); SC_STORE(0u); __syncthreads();
        for (int n = 0; n < SEQ / 64; ++n) {
            const unsigned QI = (unsigned)(n & 1) * 40960u, KI = QI + 16384u, VI = QI + 32768u;
            if (n + 1 < SEQ / 64) SC_LOAD(n + 1);
            {
                const f32x4 o = ttile<4>(lds, ldsb, QI, KI, VI, tB, sfrag, vs, l15, g, ql, p);
                const size_t tl = (size_t)n * 64 + 16u * (unsigned)tB + l15, trow = tokb + tl;
                const u32x2 w = {pkbf(o[0], o[1]), pkbf(o[2], o[3])};
                *(u32x2*)(vg + tl * DI + 16u * vs + 4u * g) = w;
                float ss = (o[0] * o[0] + o[1] * o[1]) + (o[2] * o[2] + o[3] * o[3]);
                ss += xor_get(ss, (int)lane, 16); ss += xor_get(ss, (int)lane, 32);
                if (g == 0) ss8[trow * 128 + h * 8 + half * 4 + vs] = ss;
            }
            {
                const f32x4 o = ttile<2>(lds, ldsb, QI, KI, VI, tA, sfrag, vs, l15, g, ql, p);
                const size_t tl = (size_t)n * 64 + 16u * (unsigned)tA + l15, trow = tokb + tl;
                const u32x2 w = {pkbf(o[0], o[1]), pkbf(o[2], o[3])};
                *(u32x2*)(vg + tl * DI + 16u * vs + 4u * g) = w;
                float ss = (o[0] * o[0] + o[1] * o[1]) + (o[2] * o[2] + o[3] * o[3]);
                ss += xor_get(ss, (int)lane, 16); ss += xor_get(ss, (int)lane, 32);
                if (g == 0) ss8[trow * 128 + h * 8 + half * 4 + vs] = ss;
            }
            {
                const bf16x8 vn0 = tr2(ldsb + VI + voffv(8u * g + ql, vs) + 8u * p, ldsb + VI + voffv(8u * g + 4u + ql, vs) + 8u * p);
                const bf16x8 vn1 = tr2(ldsb + VI + voffv(32u + 8u * g + ql, vs) + 8u * p, ldsb + VI + voffv(36u + 8u * g + ql, vs) + 8u * p);
                const float* dcp = DEC + ((size_t)(b * (SEQ / 64) + n)) * DI + h * HD + 4u * g;
#pragma unroll
                for (int i = 0; i < 8; ++i) {
                    const bf16x8 kf0 = tr2(ldsb + KI + offb(8u * g + ql, 2u * i + (p >> 1)) + 8u * (p & 1u), ldsb + KI + offb(8u * g + 4u + ql, 2u * i + (p >> 1)) + 8u * (p & 1u));
                    const bf16x8 kf1 = tr2(ldsb + KI + offb(32u + 8u * g + ql, 2u * i + (p >> 1)) + 8u * (p & 1u), ldsb + KI + offb(36u + 8u * g + ql, 2u * i + (p >> 1)) + 8u * (p & 1u));
                    S[i] = MFMA16(kf0, vn0, S[i]); S[i] = MFMA16(kf1, vn1, S[i]);
                    const f32x4 dc = *(const f32x4*)(dcp + 16 * i);
                    S[i] = S[i] * dc; }
#pragma unroll
                for (int kd = 0; kd < 4; ++kd) sfrag[kd] = pack8(S[2 * kd], S[2 * kd + 1]);
            }
            if (n + 1 < SEQ / 64) SC_STORE((unsigned)((n + 1) & 1) * 40960u);
            __syncthreads();
        }
#undef SC_LOAD
#undef SC_STORE
    }
}
#undef MFMA16
}

#define XB_TMO      128
#define XB_XCNT(j)  (256  + 64 * (j))
#define XB_XSUB(j)  (1280 + 64 * (j))
#define XB_XGEN(j)  (2304 + 64 * (j))
#define XB_TOP      3328
#define XB_TOPGEN   3392
#define XCD_BAR_WORDS 3456
#define XB_SPIN_CAP (1u << 18)
__device__ __forceinline__ unsigned xb_ld(unsigned* p)              { return __hip_atomic_load(p, __ATOMIC_RELAXED, __HIP_MEMORY_SCOPE_AGENT); }
__device__ __forceinline__ unsigned xb_add(unsigned* p, unsigned v) { return __hip_atomic_fetch_add(p, v, __ATOMIC_RELAXED, __HIP_MEMORY_SCOPE_AGENT); }
__device__ __forceinline__ unsigned xb_xcc_id() { return (unsigned)__builtin_amdgcn_s_getreg((3 << 11) | 20) & 0xFu; }
#define XB_SPIN(cond, bar) do { unsigned _sp = 0; while (cond) { __builtin_amdgcn_s_sleep(1); \
    if ((++_sp & 255u) == 0u) { if (xb_ld(&(bar)[XB_TMO])) break; if (_sp > XB_SPIN_CAP) { atomicAdd(&(bar)[XB_TMO], 1u); break; } } } } while (0)
struct XcdBarrier { unsigned* bar; unsigned x; volatile LAS unsigned* st; };
__device__ __forceinline__ XcdBarrier xcd_barrier_post(unsigned* bar, volatile LAS unsigned* st) {
    XcdBarrier b; b.bar = bar; b.x = xb_xcc_id(); b.st = st;
    if (threadIdx.x == 0) (void)xb_add(&bar[XB_XCNT(b.x)], 1u);
    return b;
}
__device__ __forceinline__ void xcd_barrier_complete(unsigned* bar, unsigned x, unsigned& nloc, unsigned& nx) {
    const unsigned G = gridDim.x * gridDim.y * gridDim.z;
    unsigned sum, cnt, mine, sp = 0u;
    for (;;) {
        sum = 0u; cnt = 0u; mine = 0u;
#pragma unroll
        for (unsigned j = 0; j < 16; ++j) { const unsigned c = xb_ld(&bar[XB_XCNT(j)]); sum += c; cnt += (c > 0u) ? 1u : 0u; mine = (j == x) ? c : mine; }
        if (sum == G) break;
        __builtin_amdgcn_s_sleep(1);
        if ((++sp & 255u) == 0u) { if (xb_ld(&bar[XB_TMO])) break; if (sp > XB_SPIN_CAP) { atomicAdd(&bar[XB_TMO], 1u); break; } }
    }
    nloc = mine > 0u ? mine : 1u; nx = cnt > 0u ? cnt : 1u;
}
__device__ __forceinline__ void xcd_barrier(const XcdBarrier& b) {
    asm volatile("s_waitcnt vmcnt(0)" ::: "memory");
    __syncthreads();
    if (threadIdx.x == 0) {
        unsigned* bar = b.bar;
        __builtin_amdgcn_s_waitcnt(0);
        unsigned nloc = b.st[0], nx = b.st[1];
        if (nloc == 0u) { xcd_barrier_complete(bar, b.x, nloc, nx); b.st[0] = nloc; b.st[1] = nx; }
        const unsigned old = xb_add(&bar[XB_XSUB(b.x)], 1u);
        const unsigned gen = old / nloc;
        if (old + 1u == (gen + 1u) * nloc) {
            __builtin_amdgcn_fence(__ATOMIC_RELEASE, "agent");
            asm volatile("s_waitcnt vmcnt(0)" ::: "memory");
            const unsigned og = xb_add(&bar[XB_TOP], 1u);
            const unsigned tg = og / nx;
            if (og + 1u == (tg + 1u) * nx) xb_add(&bar[XB_TOPGEN], 1u);
            else XB_SPIN(xb_ld(&bar[XB_TOPGEN]) == tg, bar);
            __builtin_amdgcn_fence(__ATOMIC_ACQUIRE, "agent");
            xb_add(&bar[XB_XGEN(b.x)], 1u);
            asm volatile("s_waitcnt vmcnt(0)" ::: "memory");
        } else {
            XB_SPIN(xb_ld(&bar[XB_XGEN(b.x)]) == gen, bar);
            __builtin_amdgcn_fence(__ATOMIC_ACQUIRE, "agent");
            asm volatile("s_waitcnt vmcnt(0)" ::: "memory");
        }
    }
    __syncthreads();
}

struct Args {
    const float* x; const float* norm_g; const float* pool_w_in; const float* pool_w_grp; const float* pool_scale; const float* pool_w_out;
    const float* hgrn_w_in; const float* hgrn_lb; const float* hgrn_norm_g; const float* hgrn_w_out; const float* final_g;
    float* out; unsigned char* ws;
};

__device__ __forceinline__ void transpose_item(const float* W, int K, int N, bf16_t* WT, int row_off, const float* ks, const float* ns, LAS float* scr, int item, int lane) {
    const int nblk = N / 32, kb = item / nblk, nb = item % nblk, k0 = 64 * kb, n0 = 32 * nb;
    const float nsv = ns ? ns[n0 + (lane & 31)] : 1.0f;
#pragma unroll 8
    for (int i = 0; i < 32; ++i) { const int kk = 2 * i + (lane >> 5); float w = W[(size_t)(k0 + kk) * N + n0 + (lane & 31)] * nsv; if (ks) w *= ks[k0 + kk]; scr[kk * 33 + (lane & 31)] = w; }
    asm volatile("s_waitcnt lgkmcnt(0)" ::: "memory");
    const int c = lane & 7;
#pragma unroll
    for (int j = 0; j < 4; ++j) { const int n = (lane >> 3) + 8 * j; const LAS float* s = scr + (8 * c) * 33 + n;
        u32x4 o; o.x = pk2(s[0 * 33], s[1 * 33]); o.y = pk2(s[2 * 33], s[3 * 33]); o.z = pk2(s[4 * 33], s[5 * 33]); o.w = pk2(s[6 * 33], s[7 * 33]);
        *(u32x4*)(WT + (size_t)(row_off + n0 + n) * K + k0 + 8 * c) = o; }
    asm volatile("s_waitcnt lgkmcnt(0)" ::: "memory");
}

__global__ void __launch_bounds__(512, 2) fwd_kernel(Args a) {
    extern __shared__ __attribute__((aligned(16))) unsigned char lds_raw[];
    LAS unsigned char* lds = (LAS unsigned char*)lds_raw;
    cg::grid_group grid = cg::this_grid();
    volatile LAS unsigned* xst = (volatile LAS unsigned*)(lds + 131072 + 64);
    if (threadIdx.x < 2) xst[threadIdx.x] = 0u;
    __syncthreads();
    const XcdBarrier xbar = xcd_barrier_post((unsigned*)a.ws, xst);
#define GRID_BAR() xcd_barrier(xbar)
    const int G = gridDim.x, bid = blockIdx.x;
    const int NGW = G * 8;
    const int wave = __builtin_amdgcn_readfirstlane((int)threadIdx.x >> 6);
#define PHASE_IDS int lane_ = (int)__builtin_amdgcn_mbcnt_hi(~0u, __builtin_amdgcn_mbcnt_lo(~0u, 0u)); asm volatile("" : "+v"(lane_)); const int lane = lane_, tid = wave * 64 + lane, gw = bid * 8 + wave; (void)gw; (void)tid;
    unsigned char* ws = a.ws;
    bf16_t* Wt_in0 = (bf16_t*)(ws + WS_WIN0); bf16_t* Wt_grp = (bf16_t*)(ws + WS_WGRP); bf16_t* Wt_out0 = (bf16_t*)(ws + WS_WOUT0);
    bf16_t* Wt_in1 = (bf16_t*)(ws + WS_WIN1); bf16_t* Wt_out1 = (bf16_t*)(ws + WS_WOUT1);
    float* part1 = (float*)(ws + WS_PART1); float* part2 = (float*)(ws + WS_PART2); float* ssb = (float*)(ws + WS_SS); float* decb = (float*)(ws + WS_DEC);
    bf16_t* XB = (bf16_t*)(ws + WS_XB); bf16_t* BA = (bf16_t*)(ws + WS_A); bf16_t* BB = (bf16_t*)(ws + WS_B); bf16_t* BC = (bf16_t*)(ws + WS_C);

    {
        PHASE_IDS
        LAS float* scr = (LAS float*)(lds + wave * 16384);
        constexpr int I_IN0 = (DM / 64) * (4096 / 32), I_GRP1 = (512 / 64) * (512 / 32), I_OUT = (DI / 64) * (DM / 32), I_IN1 = (DM / 64) * (8192 / 32);
        constexpr int NITEMS = I_IN0 + 4 * I_GRP1 + I_OUT + I_IN1 + I_OUT;
        for (int it = gw; it < NITEMS; it += NGW) {
            int r = it;
            if (r < I_IN0) { transpose_item(a.pool_w_in, DM, 4096, Wt_in0, 0, a.norm_g, nullptr, scr, r, lane); continue; } r -= I_IN0;
            if (r < 4 * I_GRP1) { const int g = r / I_GRP1; transpose_item(a.pool_w_grp + (size_t)g * 512 * 512, 512, 512, Wt_grp, g * 512, nullptr, a.pool_scale + g * 512, scr, r % I_GRP1, lane); continue; } r -= 4 * I_GRP1;
            if (r < I_OUT) { transpose_item(a.pool_w_out, DI, DM, Wt_out0, 0, nullptr, nullptr, scr, r, lane); continue; } r -= I_OUT;
            if (r < I_IN1) {
                const int n0 = 32 * (r % (8192 / 32)); int d0 = n0;
                if (n0 < 2048) d0 = 256 * (n0 >> 7) + (n0 & 127); else if (n0 < 4096) d0 = 256 * ((n0 - 2048) >> 7) + 128 + (n0 & 127);
                transpose_item(a.hgrn_w_in, DM, 8192, Wt_in1, d0 - n0, a.norm_g + DM, nullptr, scr, r, lane); continue; } r -= I_IN1;
            transpose_item(a.hgrn_w_out, DI, DM, Wt_out1, 0, a.hgrn_norm_g, nullptr, scr, r, lane);
        }
        for (int m = gw; m < M; m += NGW) {
            const f32x4* xr = (const f32x4*)(a.x + (size_t)m * DM) + lane;
            f32x4 v[4]; float s = 0.f;
#pragma unroll
            for (int j = 0; j < 4; ++j) { v[j] = xr[64 * j]; s += (v[j][0] * v[j][0] + v[j][1] * v[j][1]) + (v[j][2] * v[j][2] + v[j][3] * v[j][3]); }
            const float rstd = 1.0f / sqrtf(wave_sum(s, lane) * (1.0f / DM) + EPS);
            unsigned long long* o8 = (unsigned long long*)(XB + (size_t)m * DM) + lane;
#pragma unroll
            for (int j = 0; j < 4; ++j) o8[64 * j] = (unsigned long long)pk2(v[j][0] * rstd, v[j][1] * rstd) | ((unsigned long long)pk2(v[j][2] * rstd, v[j][3] * rstd) << 32);
        }
    }
    grid.sync();

    {
        pg8::Gemm g{XB, Wt_in0, DM, DM, DM, 0}; pg8::StaticOrder S; S.init(M, 4096, G, bid);
        pg8::EpiP1 E{BA, BB};
        pg8::gemm_phase<pg8::EpiP1>(lds, g, S, E, wave);
    }
    GRID_BAR();

    {
        PHASE_IDS
        const size_t nvec = (size_t)M * (DI / 8);
        for (size_t idx = (size_t)bid * 512 + tid; idx < nvec; idx += (size_t)G * 512) {
            const int m = (int)(idx >> 8), cgp = (int)(idx & 255), grp = cgp >> 6, w = 2 << grp, t = m & (SEQ - 1);
            const int cnt = (t + 1) < w ? (t + 1) : w;
            const bf16_t* vp = BA + (size_t)m * DI + cgp * 8;
            float sum[8];
#pragma unroll
            for (int j = 0; j < 8; ++j) sum[j] = 0.f;
            u32x4 v0 = *(const u32x4*)vp;
            for (int k = 0; k < cnt; ++k) { const u32x4 vv = *(const u32x4*)(vp - (size_t)k * DI);
                sum[0] += bf_lo(vv.x); sum[1] += bf_hi(vv.x); sum[2] += bf_lo(vv.y); sum[3] += bf_hi(vv.y); sum[4] += bf_lo(vv.z); sum[5] += bf_hi(vv.z); sum[6] += bf_lo(vv.w); sum[7] += bf_hi(vv.w); }
            const float inv = 1.0f / (float)cnt;
            u32x4 o; o.x = pk2(sum[0] * inv - bf_lo(v0.x), sum[1] * inv - bf_hi(v0.x)); o.y = pk2(sum[2] * inv - bf_lo(v0.y), sum[3] * inv - bf_hi(v0.y));
            o.z = pk2(sum[4] * inv - bf_lo(v0.z), sum[5] * inv - bf_hi(v0.z)); o.w = pk2(sum[6] * inv - bf_lo(v0.w), sum[7] * inv - bf_hi(v0.w));
            *(u32x4*)(BC + (size_t)m * DI + cgp * 8) = o;
        }
    }
    GRID_BAR();

    {
        pg8::Gemm g{BC, Wt_grp, DI, 512, 512, 2}; pg8::StaticOrder S; S.init(M, DI, G, bid);
        pg8::EpiP2 E{BB};
        pg8::gemm_phase<pg8::EpiP2>(lds, g, S, E, wave);
    }
    GRID_BAR();

    {
        pg8::Gemm g{BB, Wt_out0, DI, DI, DI, 0}; pg8::StaticOrder S; S.init(M, DM, G, bid);
        pg8::EpiRes<true> E{a.x, a.out, XB, part1};
        pg8::gemm_phase<pg8::EpiRes<true>>(lds, g, S, E, wave);
    }
    GRID_BAR();

    {
        pg8::Gemm g{XB, Wt_in1, DM, DM, DM, 0}; pg8::StaticOrder S; S.init(M, 6144, G, bid);
        pg8::EpiP4 E{BA, BB, BC, decb, part1, a.hgrn_lb};
        pg8::gemm_phase<pg8::EpiP4>(lds, g, S, E, wave);
    }
    GRID_BAR();

    scan::phase(lds, BA, BB, BC, decb, ssb, bid, G, wave);
    GRID_BAR();

    {
        pg8::Gemm g{XB, Wt_in1 + (size_t)6144 * DM, DM, DM, DM, 0}; pg8::StaticOrder S; S.init(M, DI, G, bid);
        pg8::EpiP5b E{BC, part1, ssb};
        pg8::gemm_phase<pg8::EpiP5b>(lds, g, S, E, wave);
    }
    GRID_BAR();

    {
        pg8::Gemm g{BC, Wt_out1, DI, DI, DI, 0}; pg8::StaticOrder S; S.init(M, DM, G, bid);
        pg8::EpiRes<false> E{a.out, a.out, nullptr, part2};
        pg8::gemm_phase<pg8::EpiRes<false>>(lds, g, S, E, wave);
    }
    GRID_BAR();

    {
        PHASE_IDS
        for (int m = gw; m < M; m += NGW) {
            const f32x4* p4 = (const f32x4*)(part2 + (size_t)m * 16); const f32x4 pa = p4[0], pb = p4[1], pc = p4[2], pd = p4[3]; const float p = (((pa[0] + pa[1]) + (pa[2] + pa[3])) + ((pb[0] + pb[1]) + (pb[2] + pb[3]))) + (((pc[0] + pc[1]) + (pc[2] + pc[3])) + ((pd[0] + pd[1]) + (pd[2] + pd[3])));
            const float rstd = 1.0f / sqrtf(p * (1.0f / DM) + EPS);
            f32x4* orow = (f32x4*)(a.out + (size_t)m * DM) + lane; const f32x4* gr = (const f32x4*)a.final_g + lane;
#pragma unroll
            for (int j = 0; j < 4; ++j) { f32x4 v = orow[64 * j]; const f32x4 gg = gr[64 * j]; v = v * rstd * gg; orow[64 * j] = v; }
        }
    }
}

extern "C" void kernel_launch(void* const* d_in, const int* in_sizes, int n_in, void* d_out, int out_size, void* d_ws, size_t ws_size, hipStream_t stream) {
    static int grid = 0;
    if (grid == 0) {
        if (n_in != 11 || in_sizes[0] != M * DM || out_size != M * DM || ws_size < WS_END) { fprintf(stderr, "kernel_launch: unexpected shapes (n_in %d in0 %d out %d ws %zu)\n", n_in, n_in > 0 ? in_sizes[0] : -1, out_size, ws_size); grid = -1; return; }
        int dev = 0, cus = 0, per = 0;
        if (hipGetDevice(&dev) != hipSuccess || hipDeviceGetAttribute(&cus, hipDeviceAttributeMultiprocessorCount, dev) != hipSuccess) { grid = -1; return; }
        if (hipFuncSetAttribute((const void*)fwd_kernel, hipFuncAttributeMaxDynamicSharedMemorySize, LDS_BYTES) != hipSuccess) { fprintf(stderr, "kernel_launch: hipFuncSetAttribute failed\n"); grid = -1; return; }
        if (hipOccupancyMaxActiveBlocksPerMultiprocessor(&per, (const void*)fwd_kernel, 512, LDS_BYTES) != hipSuccess || per < 1) { fprintf(stderr, "kernel_launch: occupancy query says %d\n", per); (void)hipGetLastError(); grid = -1; return; }
        grid = cus;
        fprintf(stderr, "kernel_launch: cus %d per_cu %d grid %d\n", cus, per, grid);
    }
    if (grid < 0) return;
    if (hipMemsetAsync(d_ws, 0, 16384, stream) != hipSuccess) { fprintf(stderr, "kernel_launch: hipMemsetAsync failed\n"); return; }
    Args a{};
    a.x = (const float*)d_in[0]; a.norm_g = (const float*)d_in[1]; a.pool_w_in = (const float*)d_in[2]; a.pool_w_grp = (const float*)d_in[3];
    a.pool_scale = (const float*)d_in[4]; a.pool_w_out = (const float*)d_in[5]; a.hgrn_w_in = (const float*)d_in[6]; a.hgrn_lb = (const float*)d_in[7];
    a.hgrn_norm_g = (const float*)d_in[8]; a.hgrn_w_out = (const float*)d_in[9]; a.final_g = (const float*)d_in[10];
    a.out = (float*)d_out; a.ws = (unsigned char*)d_ws;
    void* args[] = {&a};
    hipError_t e = hipLaunchCooperativeKernel((void*)fwd_kernel, dim3(grid), dim3(512), args, LDS_BYTES, stream);
    if (e != hipSuccess) fprintf(stderr, "kernel_launch: cooperative launch failed: %s (grid %d)\n", hipGetErrorString(e), grid);
}
```

```cpp
#include <hip/hip_runtime.h>
#include <hip/hip_cooperative_groups.h>
#include <cstdio>
#include <cstdint>
namespace cg = cooperative_groups;

#define LAS __attribute__((address_space(3)))
typedef unsigned short bf16_t;
typedef short bf16x8 __attribute__((ext_vector_type(8)));
typedef float f32x4 __attribute__((ext_vector_type(4)));
typedef float f32x2 __attribute__((ext_vector_type(2)));
typedef unsigned u32x4 __attribute__((ext_vector_type(4)));
typedef unsigned u32x2 __attribute__((ext_vector_type(2)));

constexpr int DM = 1024, BATCH = 8, SEQ = 4096, DI = 2048, M = BATCH * SEQ;
constexpr int NHEAD = 16, HD = 128;
constexpr float EPS = 1e-6f;
constexpr size_t MiB = 1u << 20;
constexpr size_t WS_WIN0 = 2 * MiB;
constexpr size_t WS_WGRP = 10 * MiB;
constexpr size_t WS_WOUT0 = 12 * MiB;
constexpr size_t WS_WIN1 = 16 * MiB;
constexpr size_t WS_WOUT1 = 32 * MiB;
constexpr size_t WS_PART1 = 36 * MiB;
constexpr size_t WS_PART2 = 38 * MiB;
constexpr size_t WS_DEC = 44 * MiB;
constexpr size_t WS_SS = 112 * MiB;
constexpr size_t WS_XB = 48 * MiB;
constexpr size_t WS_A = 128 * MiB;
constexpr size_t WS_B = 256 * MiB;
constexpr size_t WS_C = 384 * MiB;
constexpr size_t WS_END = 512 * MiB;
constexpr int LDS_BYTES = 147456;

__device__ __forceinline__ unsigned f2bf(float f) { unsigned u = __builtin_bit_cast(unsigned, f); return (u + 0x7fffu + ((u >> 16) & 1u)) >> 16; }
__device__ __forceinline__ unsigned pk2(float lo, float hi) { return f2bf(lo) | (f2bf(hi) << 16); }
typedef __bf16 bf2_t __attribute__((ext_vector_type(2)));
__device__ __forceinline__ unsigned pkbf(float lo, float hi) { f32x2 v = {lo, hi}; return __builtin_bit_cast(unsigned, __builtin_convertvector(v, bf2_t)); }
__device__ __forceinline__ float bf_lo(unsigned w) { return __builtin_bit_cast(float, w << 16); }
__device__ __forceinline__ float bf_hi(unsigned w) { return __builtin_bit_cast(float, w & 0xffff0000u); }
__device__ __forceinline__ float silu_f(float x) { return x * __builtin_amdgcn_rcpf(1.0f + __builtin_amdgcn_exp2f(-1.44269504089f * x)); }
__device__ __forceinline__ float lane_get(float v, int src_lane) { return __builtin_bit_cast(float, __builtin_amdgcn_ds_bpermute(src_lane << 2, __builtin_bit_cast(int, v))); }
__device__ __forceinline__ float xor_get(float v, int lane, int m) { return lane_get(v, lane ^ m); }
__device__ __forceinline__ float wave_sum(float v, int lane) {
#pragma unroll
    for (int o = 1; o < 64; o <<= 1) v += xor_get(v, lane, o);
    return v;
}

namespace pg8 {
constexpr int BM = 256, BK = 64, HALF = 128, HTB = HALF * BK * 2, STAGE_BYTES = 8 * HTB, NXCD = 8, WGM = 8;
__host__ __device__ __forceinline__ int lds_byte(int r, int c) { const int st = (r >> 4) * 2 + (c >> 5), rr = r & 15, cc = c & 31, ob = rr * 64 + cc * 2; return st * 1024 + (ob ^ (((ob >> 9) & 1) << 5)); }
__host__ __device__ __forceinline__ void stage_rc(int b, int& R, int& C) { const int st = b / 1024, sb = b % 1024, swz = sb ^ (((sb >> 9) & 1) << 5); R = (st >> 1) * 16 + swz / 64; C = (st & 1) * 32 + (swz % 64) / 2; }
__host__ __device__ __forceinline__ int perm32(int rho) { const int n = rho >> 4, i = rho & 15; return 8 * (i >> 2) + 4 * n + (i & 3); }

struct Unit { int pm, pn; };
struct Gemm { const bf16_t* A; const bf16_t* Bt; int lda, ldb, K, grp_tiles; };

struct StaticOrder {
    int nM, nN, nwg, G, c;
    __host__ __device__ void init(int M_, int N_, int G_, int c_) { nM = M_ / BM; nN = N_ / BM; nwg = nM * nN; G = G_; c = c_; }
    __host__ __device__ bool next(int i, Unit& u) const {
        const long L = (long)i * G + c; if (L >= nwg) return false;
        int wgid = (int)L; { const int q = nwg / NXCD, r = nwg % NXCD, xcd = wgid % NXCD, off = wgid / NXCD; wgid = (xcd < r ? xcd * (q + 1) : r * (q + 1) + (xcd - r) * q) + off; }
        const int nig = WGM * nN, gid = wgid / nig, fm = gid * WGM, gsz = (nM - fm) < WGM ? (nM - fm) : WGM;
        u.pm = fm + ((wgid % nig) % gsz); u.pn = (wgid % nig) / gsz; return true;
    }
};

__device__ __forceinline__ unsigned cvt_pk_bf16(float lo, float hi) { unsigned r; asm volatile("v_cvt_pk_bf16_f32 %0, %1, %2" : "=v"(r) : "v"(lo), "v"(hi)); return r; }

template <class Epi, bool ALIGN_EPI = true, bool SP2 = true>
__device__ __forceinline__ void gemm_phase(LAS unsigned char* lds, const Gemm g, const StaticOrder& S, const Epi& E, const int wid) {
    int lane_ = (int)__builtin_amdgcn_mbcnt_hi(~0u, __builtin_amdgcn_mbcnt_lo(~0u, 0u)); asm volatile("" : "+v"(lane_));
    int lane = lane_, tid = wid * 64 + lane, fr = lane & 15, fq = lane >> 4; const int wr = wid >> 2, wc = wid & 3;
    const int K = g.K, nt = K / BK;
    unsigned voffA[2], voffB[2]; int aoff, boff;
#define PG8_LANE_STATE() do { _Pragma("unroll") for (int i = 0; i < 2; ++i) { int R, C; stage_rc(tid * 16 + i * 8192, R, C); const int Rb = Epi::PERM ? ((R & ~31) + perm32(R & 31)) : R; \
        voffA[i] = (unsigned)(R * g.lda + C) * 2u; voffB[i] = (unsigned)(Rb * g.ldb + C) * 2u; } \
        aoff = lds_byte(wr * 64 + fr, fq * 8); boff = lds_byte(wc * 32 + fr, fq * 8); } while (0)
    PG8_LANE_STATE();
    const size_t kstep = (size_t)(BK * 2);
    const size_t hstepA = (size_t)HALF * g.lda * 2, hstepB = (size_t)HALF * g.ldb * 2;
    const size_t tstepA = 2 * hstepA, tstepB = 2 * hstepB;
    const unsigned ldsw = (unsigned)wid * 1024u;
#define PG8_SA(b, h) (((b) * 2 + (h)) * HTB)
#define PG8_SB(b, h) ((4 + (b) * 2 + (h)) * HTB)
#define PG8_STAGE(bufoff, gbase, voff) do { _Pragma("unroll") for (int _i = 0; _i < 2; ++_i) \
        __builtin_amdgcn_global_load_lds((const unsigned*)((const char*)(gbase) + (voff)[_i]), (LAS unsigned*)(lds + (bufoff) + ldsw + _i * 8192), 16, 0, 0); } while (0)
#define PG8_LDA(dst, b, h) do { _Pragma("unroll") for (int m = 0; m < 4; ++m) _Pragma("unroll") for (int k = 0; k < 2; ++k) dst[m][k] = *(const LAS bf16x8*)(lds + PG8_SA(b, h) + aoff + m * 2048 + k * 1024); } while (0)
#define PG8_LDB(dst, b, h) do { _Pragma("unroll") for (int n = 0; n < 2; ++n) _Pragma("unroll") for (int k = 0; k < 2; ++k) dst[n][k] = *(const LAS bf16x8*)(lds + PG8_SB(b, h) + boff + n * 2048 + k * 1024); } while (0)
#define PG8_MMA(ai, bj, At, Bt) do { __builtin_amdgcn_s_setprio(1); _Pragma("unroll") for (int m = 0; m < 4; ++m) _Pragma("unroll") for (int n = 0; n < 2; ++n) _Pragma("unroll") for (int k = 0; k < 2; ++k) \
        acc[ai][bj][m][n] = __builtin_amdgcn_mfma_f32_16x16x32_bf16(Bt[n][k], At[m][k], acc[ai][bj][m][n], 0, 0, 0); __builtin_amdgcn_s_setprio(0); } while (0)
#define PG8_WAIT_V(n) asm volatile("s_waitcnt vmcnt(" #n ")" ::: "memory")
#define PG8_WAIT_L(n) asm volatile("s_waitcnt lgkmcnt(" #n ")" ::: "memory")
#define PG8_BAR __builtin_amdgcn_s_barrier()
#define PG8_SCHED __builtin_amdgcn_sched_barrier(0)
#define PG8_ABASE(u) ((const char*)g.A + (size_t)(u).pm * tstepA + (g.grp_tiles ? (size_t)((u).pn / g.grp_tiles) * (size_t)K * 2 : (size_t)0))
#define PG8_BBASE(u) ((const char*)g.Bt + (size_t)(u).pn * tstepB)
    Unit cur, nxt; int ui = 0;
    if (!S.next(0, cur)) return;
    f32x4 acc[2][2][4][2];
#pragma unroll
    for (int a = 0; a < 2; ++a)
#pragma unroll
        for (int b = 0; b < 2; ++b)
#pragma unroll
            for (int m = 0; m < 4; ++m)
#pragma unroll
                for (int n = 0; n < 2; ++n) acc[a][b][m][n] = (f32x4){0.f, 0.f, 0.f, 0.f};
    bf16x8 At[4][2], B0[2][2], B1[2][2];
    const char* cA = PG8_ABASE(cur); const char* cB = PG8_BBASE(cur);
    if constexpr (SP2) {
        PG8_STAGE(PG8_SB(0, 0), cB, voffB); PG8_STAGE(PG8_SB(0, 1), cB + hstepB, voffB); PG8_STAGE(PG8_SA(0, 0), cA, voffA); PG8_STAGE(PG8_SA(0, 1), cA + hstepA, voffA);
        if (wr == 1) PG8_BAR;
        PG8_WAIT_V(2); PG8_BAR;
        PG8_STAGE(PG8_SB(1, 0), cB + kstep, voffB); PG8_STAGE(PG8_SA(1, 0), cA + kstep, voffA); PG8_STAGE(PG8_SB(1, 1), cB + hstepB + kstep, voffB);
        PG8_WAIT_V(6); PG8_BAR;
    } else {
        PG8_STAGE(PG8_SB(0, 0), cB, voffB); PG8_STAGE(PG8_SA(0, 0), cA, voffA); PG8_STAGE(PG8_SB(0, 1), cB + hstepB, voffB); PG8_STAGE(PG8_SA(0, 1), cA + hstepA, voffA);
        if (wr == 1) PG8_BAR;
        PG8_WAIT_V(4); PG8_BAR;
        PG8_STAGE(PG8_SB(1, 0), cB + kstep, voffB); PG8_STAGE(PG8_SA(1, 0), cA + kstep, voffA); PG8_STAGE(PG8_SB(1, 1), cB + hstepB + kstep, voffB);
        PG8_WAIT_V(6); PG8_BAR;
    }
    for (;;) {
        const bool has_next = S.next(ui + 1, nxt);
        const char* nA = has_next ? PG8_ABASE(nxt) : cA; const char* nB = has_next ? PG8_BBASE(nxt) : cB;
        for (int t = 0; t < nt; t += 2) {
            const bool last = (t == nt - 2);
            const char* a1 = cA + (size_t)(t + 1) * kstep;
            const char* a2 = last ? nA : cA + (size_t)(t + 2) * kstep; const char* b2 = last ? nB : cB + (size_t)(t + 2) * kstep;
            const char* a3 = a2 + kstep; const char* b3 = b2 + kstep;
            if constexpr (SP2) {
            PG8_LDB(B0, 0, 0); PG8_LDB(B1, 0, 1); PG8_SCHED; PG8_LDA(At, 0, 0); PG8_STAGE(PG8_SA(1, 1), a1 + hstepA, voffA);
            PG8_WAIT_V(8); PG8_WAIT_L(0); PG8_BAR; PG8_MMA(0, 0, At, B0); PG8_MMA(0, 1, At, B1); PG8_BAR; PG8_SCHED;
            PG8_LDA(At, 0, 1); PG8_STAGE(PG8_SB(0, 0), b2, voffB); PG8_STAGE(PG8_SB(0, 1), b2 + hstepB, voffB); PG8_STAGE(PG8_SA(0, 0), a2, voffA);
            PG8_WAIT_V(8); PG8_WAIT_L(0); PG8_BAR; PG8_MMA(1, 0, At, B0); PG8_MMA(1, 1, At, B1); PG8_BAR; PG8_SCHED;
            PG8_LDB(B0, 1, 0); PG8_LDB(B1, 1, 1); PG8_SCHED; PG8_LDA(At, 1, 0); PG8_STAGE(PG8_SA(0, 1), a2 + hstepA, voffA);
            PG8_WAIT_V(8); PG8_WAIT_L(0); PG8_BAR; PG8_MMA(0, 0, At, B0); PG8_MMA(0, 1, At, B1); PG8_BAR; PG8_SCHED;
            PG8_LDA(At, 1, 1); PG8_STAGE(PG8_SB(1, 0), b3, voffB); PG8_STAGE(PG8_SB(1, 1), b3 + hstepB, voffB); PG8_STAGE(PG8_SA(1, 0), a3, voffA);
            PG8_WAIT_V(8); PG8_WAIT_L(0); PG8_BAR; PG8_MMA(1, 0, At, B0); PG8_MMA(1, 1, At, B1); PG8_BAR; PG8_SCHED;
            } else {
            PG8_LDB(B0, 0, 0); PG8_SCHED; PG8_LDA(At, 0, 0); PG8_STAGE(PG8_SA(1, 1), a1 + hstepA, voffA);
            PG8_WAIT_L(8); PG8_BAR; PG8_WAIT_L(0); PG8_MMA(0, 0, At, B0); PG8_BAR; PG8_SCHED;
            PG8_LDB(B1, 0, 1); PG8_STAGE(PG8_SB(0, 0), b2, voffB);
            PG8_BAR; PG8_WAIT_L(0); PG8_MMA(0, 1, At, B1); PG8_BAR;
            PG8_LDA(At, 0, 1); PG8_STAGE(PG8_SA(0, 0), a2, voffA);
            PG8_BAR; PG8_WAIT_L(0); PG8_MMA(1, 0, At, B0); PG8_BAR; PG8_SCHED;
            PG8_STAGE(PG8_SB(0, 1), b2 + hstepB, voffB);
            PG8_WAIT_V(6); PG8_BAR; PG8_MMA(1, 1, At, B1); PG8_BAR;
            PG8_LDB(B0, 1, 0); PG8_SCHED; PG8_LDA(At, 1, 0); PG8_STAGE(PG8_SA(0, 1), a2 + hstepA, voffA);
            PG8_WAIT_L(8); PG8_BAR; PG8_WAIT_L(0); PG8_MMA(0, 0, At, B0); PG8_BAR; PG8_SCHED;
            PG8_LDB(B1, 1, 1); PG8_STAGE(PG8_SB(1, 0), b3, voffB);
            PG8_BAR; PG8_WAIT_L(0); PG8_MMA(0, 1, At, B1); PG8_BAR;
            PG8_LDA(At, 1, 1); PG8_STAGE(PG8_SA(1, 0), a3, voffA);
            PG8_BAR; PG8_WAIT_L(0); PG8_MMA(1, 0, At, B0); PG8_BAR; PG8_SCHED;
            PG8_STAGE(PG8_SB(1, 1), b3 + hstepB, voffB);
            PG8_WAIT_V(6); PG8_BAR; PG8_MMA(1, 1, At, B1); PG8_BAR;
            }
        }
        if constexpr (ALIGN_EPI) { if (wr == 0) PG8_BAR; }
        if constexpr (!Epi::AFTER_DRAIN) E(acc, cur, wr, wc, fr, fq);
        if (!has_next) break;
#pragma unroll
        for (int a = 0; a < 2; ++a)
#pragma unroll
            for (int b = 0; b < 2; ++b)
#pragma unroll
                for (int m = 0; m < 4; ++m)
#pragma unroll
                    for (int n = 0; n < 2; ++n) acc[a][b][m][n] = (f32x4){0.f, 0.f, 0.f, 0.f};
        cur = nxt; cA = nA; cB = nB; ++ui;
        asm volatile("" : "+v"(lane)); tid = wid * 64 + lane; fr = lane & 15; fq = lane >> 4; PG8_LANE_STATE();
        if constexpr (ALIGN_EPI) { if (wr == 1) PG8_BAR; }
    }
    PG8_WAIT_V(0);
    if constexpr (!ALIGN_EPI) { if (wr == 0) PG8_BAR; }
    PG8_BAR;
    if constexpr (Epi::AFTER_DRAIN) E.fused(acc, cur, wr, wc, fr, fq, lds, tid);
#undef PG8_SA
#undef PG8_SB
#undef PG8_STAGE
#undef PG8_LDA
#undef PG8_LDB
#undef PG8_MMA
#undef PG8_WAIT_V
#undef PG8_WAIT_L
#undef PG8_BAR
#undef PG8_SCHED
#undef PG8_ABASE
#undef PG8_LANE_STATE
#undef PG8_BBASE
}

struct EpiP1 {
    static constexpr bool PERM = true, AFTER_DRAIN = false;
    bf16_t* V; bf16_t* SG;
    __device__ __forceinline__ void operator()(f32x4 (&acc)[2][2][4][2], const Unit& u, int wr, int wc, int fr, int fq) const {
        const int row0 = u.pm * BM + wr * 64 + fr; const bool gate = u.pn >= 8;
        bf16_t* base = gate ? SG : V; const int col0 = (u.pn & 7) * BM + wc * 32 + 8 * fq;
#pragma unroll
        for (int ai = 0; ai < 2; ++ai)
#pragma unroll
            for (int m = 0; m < 4; ++m) { bf16_t* rowp = base + (size_t)(row0 + ai * HALF + m * 16) * DI + col0;
#pragma unroll
                for (int bj = 0; bj < 2; ++bj) { f32x4 v0 = acc[ai][bj][m][0], v1 = acc[ai][bj][m][1];
                    if (gate) {
#pragma unroll
                        for (int j = 0; j < 4; ++j) { v0[j] = silu_f(v0[j]); v1[j] = silu_f(v1[j]); } }
                    u32x4 w; w.x = cvt_pk_bf16(v0[0], v0[1]); w.y = cvt_pk_bf16(v0[2], v0[3]); w.z = cvt_pk_bf16(v1[0], v1[1]); w.w = cvt_pk_bf16(v1[2], v1[3]);
                    *(u32x4*)(rowp + bj * HALF) = w; } }
    }
};
struct EpiP2 {
    static constexpr bool PERM = true, AFTER_DRAIN = false;
    bf16_t* Z;
    __device__ __forceinline__ void operator()(f32x4 (&acc)[2][2][4][2], const Unit& u, int wr, int wc, int fr, int fq) const {
        const int row0 = u.pm * BM + wr * 64 + fr; const int col0 = u.pn * BM + wc * 32 + 8 * fq;
#pragma unroll
        for (int ai = 0; ai < 2; ++ai)
#pragma unroll
            for (int m = 0; m < 4; ++m) { bf16_t* rowp = Z + (size_t)(row0 + ai * HALF + m * 16) * DI + col0;
#pragma unroll
                for (int bj = 0; bj < 2; ++bj) { const f32x4 v0 = acc[ai][bj][m][0], v1 = acc[ai][bj][m][1];
                    const u32x4 s = *(const u32x4*)(rowp + bj * HALF);
                    u32x4 w; w.x = cvt_pk_bf16(v0[0] * bf_lo(s.x), v0[1] * bf_hi(s.x)); w.y = cvt_pk_bf16(v0[2] * bf_lo(s.y), v0[3] * bf_hi(s.y));
                    w.z = cvt_pk_bf16(v1[0] * bf_lo(s.z), v1[1] * bf_hi(s.z)); w.w = cvt_pk_bf16(v1[2] * bf_lo(s.w), v1[3] * bf_hi(s.w));
                    *(u32x4*)(rowp + bj * HALF) = w; } }
    }
};
template <bool WRITE_HB> struct EpiRes {
    static constexpr bool PERM = false, AFTER_DRAIN = false;
    const float* R; float* H; bf16_t* HB; float* part;
    __device__ __forceinline__ void operator()(f32x4 (&acc)[2][2][4][2], const Unit& u, int wr, int wc, int fr, int fq) const {
        const unsigned row0 = (unsigned)(u.pm * BM + wr * 64 + fr), col0 = (unsigned)(u.pn * BM + wc * 32 + 4 * fq);
        const unsigned ofs = (row0 * DM + col0) * 4u, pofs = (row0 * 16u + (unsigned)(u.pn * 4 + wc)) * 4u;
#pragma unroll
        for (int ai = 0; ai < 2; ++ai)
#pragma unroll
            for (int m = 0; m < 4; ++m) { const unsigned o = ofs + (unsigned)((ai * HALF + m * 16) * DM) * 4u; float ss = 0.f;
#pragma unroll
                for (int bj = 0; bj < 2; ++bj)
#pragma unroll
                    for (int n = 0; n < 2; ++n) { const unsigned oo = o + (unsigned)(bj * HALF + n * 16) * 4u;
                        const f32x4 xv = *(const f32x4*)((const char*)R + oo); const f32x4 h = xv + acc[ai][bj][m][n];
                        *(f32x4*)((char*)H + oo) = h; ss += (h[0] * h[0] + h[1] * h[1]) + (h[2] * h[2] + h[3] * h[3]);
                        if (WRITE_HB) { u32x2 w; w.x = pkbf(h[0], h[1]); w.y = pkbf(h[2], h[3]); *(u32x2*)((char*)HB + (oo >> 1)) = w; } }
                ss += xor_get(ss, fq * 16 + fr, 16); ss += xor_get(ss, fq * 16 + fr, 32);
                if (fq == 0) *(float*)((char*)part + (pofs + (unsigned)(ai * HALF + m * 16) * 64u)) = ss;
                asm volatile("" ::: "memory"); }
    }
};
__device__ __forceinline__ float row_rstd_b(const float* part, unsigned bofs) {
    const f32x4* p = (const f32x4*)((const char*)part + bofs); const f32x4 a = p[0], b = p[1], c = p[2], d = p[3];
    return __builtin_amdgcn_rsqf((((a[0] + a[1]) + (a[2] + a[3])) + ((b[0] + b[1]) + (b[2] + b[3])) + ((c[0] + c[1]) + (c[2] + c[3])) + ((d[0] + d[1]) + (d[2] + d[3]))) * (1.0f / DM) + EPS);
}
__device__ __forceinline__ float dpp_shr_mul(float v, const int n) {
    const int iv = __builtin_bit_cast(int, v), one = 0x3f800000; int r;
    if (n == 1) r = __builtin_amdgcn_update_dpp(one, iv, 0x111, 0xf, 0xf, false); else if (n == 2) r = __builtin_amdgcn_update_dpp(one, iv, 0x112, 0xf, 0xf, false);
    else if (n == 4) r = __builtin_amdgcn_update_dpp(one, iv, 0x114, 0xf, 0xf, false); else r = __builtin_amdgcn_update_dpp(one, iv, 0x118, 0xf, 0xf, false);
    return v * __builtin_bit_cast(float, r);
}
struct EpiP4 {
    static constexpr bool PERM = true, AFTER_DRAIN = false;
    bf16_t* Qt; bf16_t* Kt; bf16_t* V; float* DEC; const float* part; const float* lbnd;
    __device__ __forceinline__ void operator()(f32x4 (&acc)[2][2][4][2], const Unit& u, int wr, int wc, int fr, int fq) const {
        const unsigned row0 = (unsigned)(u.pm * BM + wr * 64 + fr);
        const unsigned pofs = row0 * 64u;
        if (u.pn >= 16) {
            const unsigned vofs = (row0 * DI + (unsigned)((u.pn - 16) * BM + wc * 32 + 8 * fq)) * 2u;
#pragma unroll
            for (int ai = 0; ai < 2; ++ai)
#pragma unroll
                for (int m = 0; m < 4; ++m) { const float rs = row_rstd_b(part, pofs + (unsigned)(ai * HALF + m * 16) * 64u);
#pragma unroll
                    for (int bj = 0; bj < 2; ++bj) { const f32x4 v0 = acc[ai][bj][m][0] * rs, v1 = acc[ai][bj][m][1] * rs;
                        u32x4 w; w.x = pkbf(v0[0], v0[1]); w.y = pkbf(v0[2], v0[3]); w.z = pkbf(v1[0], v1[1]); w.w = pkbf(v1[2], v1[3]);
                        *(u32x4*)((char*)V + (vofs + (unsigned)((ai * HALF + m * 16) * DI + bj * HALF) * 2u)) = w; }
                    asm volatile("" ::: "memory"); }
            return;
        }
        const unsigned c0 = (unsigned)(u.pn * HD + wc * 32 + 8 * fq);
        const unsigned qofs = (row0 * DI + c0) * 2u;
#pragma unroll
        for (int ai = 0; ai < 2; ++ai) {
            float rs[4];
#pragma unroll
            for (int m = 0; m < 4; ++m) { rs[m] = row_rstd_b(part, pofs + (unsigned)(ai * HALF + m * 16) * 64u); asm volatile("" : "+v"(rs[m]) :: "memory"); }
            unsigned cc = c0; asm volatile("" : "+v"(cc));
#pragma unroll
            for (int n = 0; n < 2; ++n) {
                const f32x4 l0 = *(const f32x4*)((const char*)lbnd + (cc + 4 * n) * 4u), l1 = *(const f32x4*)((const char*)lbnd + (cc + 4 * n + DI) * 4u);
                f32x4 decv;
#pragma unroll
                for (int j = 0; j < 4; ++j) { const float ex = __expf(l0[j] - l1[j]); const float lb = __builtin_amdgcn_rcpf(1.0f + ex), omlb = ex * lb; float bprod = 1.0f;
#pragma unroll
                    for (int m = 0; m < 4; ++m) {
                        const float qv = acc[ai][0][m][n][j] * rs[m], z = acc[ai][1][m][n][j] * rs[m];
                        const float sg = __builtin_amdgcn_rcpf(1.0f + __builtin_amdgcn_exp2f(-1.44269504089f * z));
                        const float f = lb + omlb * sg, k = omlb * (1.0f - sg);
                        float s = f; s = dpp_shr_mul(s, 1); s = dpp_shr_mul(s, 2); s = dpp_shr_mul(s, 4); s = dpp_shr_mul(s, 8);
                        const float E = bprod * s;
                        if (m < 3) bprod *= lane_get(s, fq * 16 + 15);
                        const float Ei = __builtin_amdgcn_rcpf(fmaxf(E, 7.9e-31f));
                        acc[ai][0][m][n][j] = qv * E; acc[ai][1][m][n][j] = k * Ei;
                        if (m == 3) decv[j] = E;
                    } }
                if (fr == 15) *(f32x4*)((char*)DEC + ((unsigned)(u.pm * 4 + ai * 2 + wr) * DI + cc + 4 * n) * 4u) = decv;
            }
#pragma unroll
            for (int m = 0; m < 4; ++m) { const unsigned ob = qofs + (unsigned)((ai * HALF + m * 16) * DI) * 2u;
                u32x4 w; w.x = pkbf(acc[ai][0][m][0][0], acc[ai][0][m][0][1]); w.y = pkbf(acc[ai][0][m][0][2], acc[ai][0][m][0][3]); w.z = pkbf(acc[ai][0][m][1][0], acc[ai][0][m][1][1]); w.w = pkbf(acc[ai][0][m][1][2], acc[ai][0][m][1][3]);
                *(u32x4*)((char*)Qt + ob) = w;
                u32x4 x; x.x = pkbf(acc[ai][1][m][0][0], acc[ai][1][m][0][1]); x.y = pkbf(acc[ai][1][m][0][2], acc[ai][1][m][0][3]); x.z = pkbf(acc[ai][1][m][1][0], acc[ai][1][m][1][1]); x.w = pkbf(acc[ai][1][m][1][2], acc[ai][1][m][1][3]);
                *(u32x4*)((char*)Kt + ob) = x; }
            asm volatile("" ::: "memory");
        }
    }
};
struct EpiP5b {
    static constexpr bool PERM = true, AFTER_DRAIN = false;
    bf16_t* O; const float* part; const float* ss;
    __device__ __forceinline__ void operator()(f32x4 (&acc)[2][2][4][2], const Unit& u, int wr, int wc, int fr, int fq) const {
        const int row0 = u.pm * BM + wr * 64 + fr; const int col0 = u.pn * BM + wc * 32 + 8 * fq;
        const unsigned pofs = (unsigned)row0 * 64u; const float* srow = ss + (size_t)row0 * 128 + u.pn * 16;
        char* op = (char*)(O + (size_t)row0 * DI + col0);
#pragma unroll
        for (int ai = 0; ai < 2; ++ai)
#pragma unroll
            for (int m = 0; m < 4; ++m) { const float rs = row_rstd_b(part, pofs + (unsigned)(ai * HALF + m * 16) * 64u);
#pragma unroll
                for (int bj = 0; bj < 2; ++bj) { const f32x4 v0 = acc[ai][bj][m][0] * rs, v1 = acc[ai][bj][m][1] * rs;
                    const f32x4* sp = (const f32x4*)(srow + (size_t)(ai * HALF + m * 16) * 128 + bj * 8); const f32x4 s0 = sp[0], s1 = sp[1];
                    const float rh = __builtin_amdgcn_rsqf((((s0[0] + s0[1]) + (s0[2] + s0[3])) + ((s1[0] + s1[1]) + (s1[2] + s1[3]))) * (1.0f / HD) + EPS);
                    u32x4* optr = (u32x4*)(op + (size_t)((ai * HALF + m * 16) * DI + bj * HALF) * 2);
                    const u32x4 s = *optr;
                    u32x4 w; w.x = pkbf(bf_lo(s.x) * rh * silu_f(v0[0]), bf_hi(s.x) * rh * silu_f(v0[1])); w.y = pkbf(bf_lo(s.y) * rh * silu_f(v0[2]), bf_hi(s.y) * rh * silu_f(v0[3]));
                    w.z = pkbf(bf_lo(s.z) * rh * silu_f(v1[0]), bf_hi(s.z) * rh * silu_f(v1[1])); w.w = pkbf(bf_lo(s.w) * rh * silu_f(v1[2]), bf_hi(s.w) * rh * silu_f(v1[3]));
                    *optr = w; }
                asm volatile("" ::: "memory"); }
    }
};
}

namespace scan {
#define MFMA16(a, b, c) __builtin_amdgcn_mfma_f32_16x16x32_bf16((a), (b), (c), 0, 0, 0)
__device__ __forceinline__ unsigned offb(unsigned row, unsigned ch) { return 256u * row + 16u * (ch ^ (((row & 3u) << 2) | ((row >> 2) & 3u))); }
__device__ __forceinline__ unsigned voffv(unsigned r, unsigned cp) { return 128u * r + 32u * (cp ^ (((r >> 1) & 3u) ^ (((r >> 3) & 1u) << 1))); }
__device__ __forceinline__ bf16x8 tr2(unsigned a0, unsigned a1) {
    u32x2 lo, hi;
    asm volatile("ds_read_b64_tr_b16 %0, %2\n\tds_read_b64_tr_b16 %1, %3\n\ts_waitcnt lgkmcnt(0)" : "=&v"(lo), "=&v"(hi) : "v"(a0), "v"(a1) : "memory");
    const u32x4 r = {lo.x, lo.y, hi.x, hi.y}; return __builtin_bit_cast(bf16x8, r);
}
__device__ __forceinline__ bf16x8 pack8(const f32x4 a, const f32x4 b) { const u32x4 r = {pkbf(a[0], a[1]), pkbf(a[2], a[3]), pkbf(b[0], b[1]), pkbf(b[2], b[3])}; return __builtin_bit_cast(bf16x8, r); }
template <int NJ>
__device__ __forceinline__ f32x4 ttile(LAS unsigned char* lds, unsigned ldsb, unsigned QI, unsigned KI, unsigned VI, int it, const bf16x8 (&sfrag)[4],
                                       unsigned vs, unsigned l15, unsigned g, unsigned ql, unsigned p) {
    const unsigned trow = 16u * (unsigned)it + l15;
    bf16x8 qb[4];
#pragma unroll
    for (int kd = 0; kd < 4; ++kd) qb[kd] = *(const LAS bf16x8*)(lds + QI + offb(trow, 4u * kd + g));
    f32x4 c[NJ];
#pragma unroll
    for (int j = 0; j < NJ; ++j) { c[j] = (f32x4){0.f, 0.f, 0.f, 0.f};
        if (j <= it) {
#pragma unroll
            for (int kd = 0; kd < 4; ++kd) { const bf16x8 a = *(const LAS bf16x8*)(lds + KI + offb(16u * j + l15, 4u * kd + g)); c[j] = MFMA16(a, qb[kd], c[j]); }
            if (j == it) {
#pragma unroll
                for (int r = 0; r < 4; ++r) c[j][r] = (4u * g + r <= l15) ? c[j][r] : 0.f; } } }
    f32x4 o = (f32x4){0.f, 0.f, 0.f, 0.f};
#pragma unroll
    for (int ks = 0; ks < NJ / 2; ++ks) if (2 * ks <= it) {
        const bf16x8 at = pack8(c[2 * ks], c[2 * ks + 1]);
        const bf16x8 vf = tr2(ldsb + VI + voffv(32u * ks + 4u * g + ql, vs) + 8u * p, ldsb + VI + voffv(32u * ks + 16u + 4u * g + ql, vs) + 8u * p);
        o = MFMA16(vf, at, o); }
#pragma unroll
    for (int kd = 0; kd < 4; ++kd) {
        const u32x2 q0 = *(const LAS u32x2*)(lds + QI + offb(trow, 4u * kd + (g >> 1)) + 8u * (g & 1)), q1 = *(const LAS u32x2*)(lds + QI + offb(trow, 4u * kd + 2u + (g >> 1)) + 8u * (g & 1));
        const u32x4 qq = {q0.x, q0.y, q1.x, q1.y};
        o = MFMA16(sfrag[kd], __builtin_bit_cast(bf16x8, qq), o); }
    return o;
}
__device__ __forceinline__ void phase(LAS unsigned char* lds, const bf16_t* Qt, const bf16_t* Kt, bf16_t* VO, const float* DEC, float* ss8, int bid, int G, int wave) {
    int lane_ = (int)__builtin_amdgcn_mbcnt_hi(~0u, __builtin_amdgcn_mbcnt_lo(~0u, 0u)); asm volatile("" : "+v"(lane_));
    const unsigned lane = (unsigned)lane_, tid = (unsigned)wave * 64u + lane, l15 = lane & 15u, g = lane >> 4, ql = l15 >> 2, p = lane & 3u;
    const unsigned vs = (unsigned)wave & 3u; const int th = wave >> 2, tA = th ? 1 : 0, tB = th ? 2 : 3;
    const unsigned ldsb = (unsigned)(uintptr_t)lds;
    const unsigned srow = tid >> 4, sch = tid & 15u, vrow = tid >> 3, vch = tid & 7u;
    for (int item = bid; item < BATCH * NHEAD * 2; item += G) {
        const int b = item >> 5, h = (item >> 1) & 15, half = item & 1;
        const size_t tokb = (size_t)b * SEQ;
        const bf16_t* qg = Qt + (tokb + srow) * DI + h * HD + sch * 8;
        const bf16_t* kg = Kt + (tokb + srow) * DI + h * HD + sch * 8;
        bf16_t* vg = VO + tokb * DI + h * HD + half * 64;
        f32x4 S[8]; bf16x8 sfrag[4];
#pragma unroll
        for (int i = 0; i < 8; ++i) S[i] = (f32x4){0.f, 0.f, 0.f, 0.f};
#pragma unroll
        for (int i = 0; i < 4; ++i) sfrag[i] = (bf16x8){0, 0, 0, 0, 0, 0, 0, 0};
        u32x4 rq0, rq1, rk0, rk1, rv;
#define SC_LOAD(n_) do { const size_t t0_ = (size_t)(n_) * 64; \
            rq0 = *(const u32x4*)(qg + t0_ * DI); rq1 = *(const u32x4*)(qg + (t0_ + 32) * DI); rk0 = *(const u32x4*)(kg + t0_ * DI); rk1 = *(const u32x4*)(kg + (t0_ + 32) * DI); \
            rv = *(const u32x4*)(vg + (t0_ + vrow) * DI + vch * 8); } while (0)
#define SC_STORE(base_) do { *(LAS u32x4*)(lds + (base_) + offb(srow, sch)) = rq0; *(LAS u32x4*)(lds + (base_) + offb(srow + 32u, sch)) = rq1; \
            *(LAS u32x4*)(lds + (base_) + 16384u + offb(srow, sch)) = rk0; *(LAS u32x4*)(lds + (base_) + 16384u + offb(srow + 32u, sch)) = rk1; \
            *(LAS u32x4*)(lds + (base_) + 32768u + voffv(vrow, vch >> 1) + 16u * (vch & 1u)) = rv; } while (0)
        SC_LOAD(0); SC_STORE(0u); __syncthreads();
        for (int n = 0; n < SEQ / 64; ++n) {
            const unsigned QI = (unsigned)(n & 1) * 40960u, KI = QI + 16384u, VI = QI + 32768u;
            if (n + 1 < SEQ / 64) SC_LOAD(n + 1);
            {
                const f32x4 o = ttile<4>(lds, ldsb, QI, KI, VI, tB, sfrag, vs, l15, g, ql, p);
                const size_t tl = (size_t)n * 64 + 16u * (unsigned)tB + l15, trow = tokb + tl;
                const u32x2 w = {pkbf(o[0], o[1]), pkbf(o[2], o[3])};
                *(u32x2*)(vg + tl * DI + 16u * vs + 4u * g) = w;
                float ss = (o[0] * o[0] + o[1] * o[1]) + (o[2] * o[2] + o[3] * o[3]);
                ss += xor_get(ss, (int)lane, 16); ss += xor_get(ss, (int)lane, 32);
                if (g == 0) ss8[trow * 128 + h * 8 + half * 4 + vs] = ss;
            }
            {
                const f32x4 o = ttile<2>(lds, ldsb, QI, KI, VI, tA, sfrag, vs, l15, g, ql, p);
                const size_t tl = (size_t)n * 64 + 16u * (unsigned)tA + l15, trow = tokb + tl;
                const u32x2 w = {pkbf(o[0], o[1]), pkbf(o[2], o[3])};
                *(u32x2*)(vg + tl * DI + 16u * vs + 4u * g) = w;
                float ss = (o[0] * o[0] + o[1] * o[1]) + (o[2] * o[2] + o[3] * o[3]);
                ss += xor_get(ss, (int)lane, 16); ss += xor_get(ss, (int)lane, 32);
                if (g == 0) ss8[trow * 128 + h * 8 + half * 4 + vs] = ss;
            }
            {
                const bf16x8 vn0 = tr2(ldsb + VI + voffv(8u * g + ql, vs) + 8u * p, ldsb + VI + voffv(8u * g + 4u + ql, vs) + 8u * p);
                const bf16x8 vn1 = tr2(ldsb + VI + voffv(32u + 8u * g + ql, vs) + 8u * p, ldsb + VI + voffv(36u + 8u * g + ql, vs) + 8u * p);
                const float* dcp = DEC + ((size_t)(b * (SEQ / 64) + n)) * DI + h * HD + 4u * g;
#pragma unroll
                for (int i = 0; i < 8; ++i) {
                    const bf16x8 kf0 = tr2(ldsb + KI + offb(8u * g + ql, 2u * i + (p >> 1)) + 8u * (p & 1u), ldsb + KI + offb(8u * g + 4u + ql, 2u * i + (p >> 1)) + 8u * (p & 1u));
                    const bf16x8 kf1 = tr2(ldsb + KI + offb(32u + 8u * g + ql, 2u * i + (p >> 1)) + 8u * (p & 1u), ldsb + KI + offb(36u + 8u * g + ql, 2u * i + (p >> 1)) + 8u * (p & 1u));
                    S[i] = MFMA16(kf0, vn0, S[i]); S[i] = MFMA16(kf1, vn1, S[i]);
                    const f32x4 dc = *(const f32x4*)(dcp + 16 * i);
                    S[i] = S[i] * dc; }
#pragma unroll
                for (int kd = 0; kd < 4; ++kd) sfrag[kd] = pack8(S[2 * kd], S[2 * kd + 1]);
            }
            if (n + 1 < SEQ / 64) SC_STORE((unsigned)((n + 1) & 1) * 40960u);
            __syncthreads();
        }
#undef SC_LOAD
#undef SC_STORE
    }
}
#undef MFMA16
}

#define XB_TMO      128
#define XB_XCNT(j)  (256  + 64 * (j))
#define XB_XSUB(j)  (1280 + 64 * (j))
#define XB_XGEN(j)  (2304 + 64 * (j))
#define XB_TOP      3328
#define XB_TOPGEN   3392
#define XCD_BAR_WORDS 3456
#define XB_SPIN_CAP (1u << 18)
__device__ __forceinline__ unsigned xb_ld(unsigned* p)              { return __hip_atomic_load(p, __ATOMIC_RELAXED, __HIP_MEMORY_SCOPE_AGENT); }
__device__ __forceinline__ unsigned xb_add(unsigned* p, unsigned v) { return __hip_atomic_fetch_add(p, v, __ATOMIC_RELAXED, __HIP_MEMORY_SCOPE_AGENT); }
__device__ __forceinline__ unsigned xb_xcc_id() { return (unsigned)__builtin_amdgcn_s_getreg((3 << 11) | 20) & 0xFu; }
#define XB_SPIN(cond, bar) do { unsigned _sp = 0; while (cond) { __builtin_amdgcn_s_sleep(1); \
    if ((++_sp & 255u) == 0u) { if (xb_ld(&(bar)[XB_TMO])) break; if (_sp > XB_SPIN_CAP) { atomicAdd(&(bar)[XB_TMO], 1u); break; } } } } while (0)
struct XcdBarrier { unsigned* bar; unsigned x; volatile LAS unsigned* st; };
__device__ __forceinline__ XcdBarrier xcd_barrier_post(unsigned* bar, volatile LAS unsigned* st) {
    XcdBarrier b; b.bar = bar; b.x = xb_xcc_id(); b.st = st;
    if (threadIdx.x == 0) (void)xb_add(&bar[XB_XCNT(b.x)], 1u);
    return b;
}
__device__ __forceinline__ void xcd_barrier_complete(unsigned* bar, unsigned x, unsigned& nloc, unsigned& nx) {
    const unsigned G = gridDim.x * gridDim.y * gridDim.z;
    unsigned sum, cnt, mine, sp = 0u;
    for (;;) {
        sum = 0u; cnt = 0u; mine = 0u;
#pragma unroll
        for (unsigned j = 0; j < 16; ++j) { const unsigned c = xb_ld(&bar[XB_XCNT(j)]); sum += c; cnt += (c > 0u) ? 1u : 0u; mine = (j == x) ? c : mine; }
        if (sum == G) break;
        __builtin_amdgcn_s_sleep(1);
        if ((++sp & 255u) == 0u) { if (xb_ld(&bar[XB_TMO])) break; if (sp > XB_SPIN_CAP) { atomicAdd(&bar[XB_TMO], 1u); break; } }
    }
    nloc = mine > 0u ? mine : 1u; nx = cnt > 0u ? cnt : 1u;
}
__device__ __forceinline__ void xcd_barrier(const XcdBarrier& b) {
    asm volatile("s_waitcnt vmcnt(0)" ::: "memory");
    __syncthreads();
    if (threadIdx.x == 0) {
        unsigned* bar = b.bar;
        __builtin_amdgcn_s_waitcnt(0);
        unsigned nloc = b.st[0], nx = b.st[1];
        if (nloc == 0u) { xcd_barrier_complete(bar, b.x, nloc, nx); b.st[0] = nloc; b.st[1] = nx; }
        const unsigned old = xb_add(&bar[XB_XSUB(b.x)], 1u);
        const unsigned gen = old / nloc;
        if (old + 1u == (gen + 1u) * nloc) {
            __builtin_amdgcn_fence(__ATOMIC_RELEASE, "agent");
            asm volatile("s_waitcnt vmcnt(0)" ::: "memory");
            const unsigned og = xb_add(&bar[XB_TOP], 1u);
            const unsigned tg = og / nx;
            if (og + 1u == (tg + 1u) * nx) xb_add(&bar[XB_TOPGEN], 1u);
            else XB_SPIN(xb_ld(&bar[XB_TOPGEN]) == tg, bar);
            __builtin_amdgcn_fence(__ATOMIC_ACQUIRE, "agent");
            xb_add(&bar[XB_XGEN(b.x)], 1u);
            asm volatile("s_waitcnt vmcnt(0)" ::: "memory");
        } else {
            XB_SPIN(xb_ld(&bar[XB_XGEN(b.x)]) == gen, bar);
            __builtin_amdgcn_fence(__ATOMIC_ACQUIRE, "agent");
            asm volatile("s_waitcnt vmcnt(0)" ::: "memory");
        }
    }
    __syncthreads();
}

struct Args {
    const float* x; const float* norm_g; const float* pool_w_in; const float* pool_w_grp; const float* pool_scale; const float* pool_w_out;
    const float* hgrn_w_in; const float* hgrn_lb; const float* hgrn_norm_g; const float* hgrn_w_out; const float* final_g;
    float* out; unsigned char* ws;
};

__device__ __forceinline__ void transpose_item(const float* W, int K, int N, bf16_t* WT, int row_off, const float* ks, const float* ns, LAS float* scr, int item, int lane) {
    const int nblk = N / 32, kb = item / nblk, nb = item % nblk, k0 = 64 * kb, n0 = 32 * nb;
    const float nsv = ns ? ns[n0 + (lane & 31)] : 1.0f;
#pragma unroll 8
    for (int i = 0; i < 32; ++i) { const int kk = 2 * i + (lane >> 5); float w = W[(size_t)(k0 + kk) * N + n0 + (lane & 31)] * nsv; if (ks) w *= ks[k0 + kk]; scr[kk * 33 + (lane & 31)] = w; }
    asm volatile("s_waitcnt lgkmcnt(0)" ::: "memory");
    const int c = lane & 7;
#pragma unroll
    for (int j = 0; j < 4; ++j) { const int n = (lane >> 3) + 8 * j; const LAS float* s = scr + (8 * c) * 33 + n;
        u32x4 o; o.x = pk2(s[0 * 33], s[1 * 33]); o.y = pk2(s[2 * 33], s[3 * 33]); o.z = pk2(s[4 * 33], s[5 * 33]); o.w = pk2(s[6 * 33], s[7 * 33]);
        *(u32x4*)(WT + (size_t)(row_off + n0 + n) * K + k0 + 8 * c) = o; }
    asm volatile("s_waitcnt lgkmcnt(0)" ::: "memory");
}

__global__ void __launch_bounds__(512, 2) fwd_kernel(Args a) {
    extern __shared__ __attribute__((aligned(16))) unsigned char lds_raw[];
    LAS unsigned char* lds = (LAS unsigned char*)lds_raw;
    cg::grid_group grid = cg::this_grid();
    volatile LAS unsigned* xst = (volatile LAS unsigned*)(lds + 131072 + 64);
    if (threadIdx.x < 2) xst[threadIdx.x] = 0u;
    __syncthreads();
    const XcdBarrier xbar = xcd_barrier_post((unsigned*)a.ws, xst);
#define GRID_BAR() xcd_barrier(xbar)
    const int G = gridDim.x, bid = blockIdx.x;
    const int NGW = G * 8;
    const int wave = __builtin_amdgcn_readfirstlane((int)threadIdx.x >> 6);
#define PHASE_IDS int lane_ = (int)__builtin_amdgcn_mbcnt_hi(~0u, __builtin_amdgcn_mbcnt_lo(~0u, 0u)); asm volatile("" : "+v"(lane_)); const int lane = lane_, tid = wave * 64 + lane, gw = bid * 8 + wave; (void)gw; (void)tid;
    unsigned char* ws = a.ws;
    bf16_t* Wt_in0 = (bf16_t*)(ws + WS_WIN0); bf16_t* Wt_grp = (bf16_t*)(ws + WS_WGRP); bf16_t* Wt_out0 = (bf16_t*)(ws + WS_WOUT0);
    bf16_t* Wt_in1 = (bf16_t*)(ws + WS_WIN1); bf16_t* Wt_out1 = (bf16_t*)(ws + WS_WOUT1);
    float* part1 = (float*)(ws + WS_PART1); float* part2 = (float*)(ws + WS_PART2); float* ssb = (float*)(ws + WS_SS); float* decb = (float*)(ws + WS_DEC);
    bf16_t* XB = (bf16_t*)(ws + WS_XB); bf16_t* BA = (bf16_t*)(ws + WS_A); bf16_t* BB = (bf16_t*)(ws + WS_B); bf16_t* BC = (bf16_t*)(ws + WS_C);

    {
        PHASE_IDS
        LAS float* scr = (LAS float*)(lds + wave * 16384);
        constexpr int I_IN0 = (DM / 64) * (4096 / 32), I_GRP1 = (512 / 64) * (512 / 32), I_OUT = (DI / 64) * (DM / 32), I_IN1 = (DM / 64) * (8192 / 32);
        constexpr int NITEMS = I_IN0 + 4 * I_GRP1 + I_OUT + I_IN1 + I_OUT;
        for (int it = gw; it < NITEMS; it += NGW) {
            int r = it;
            if (r < I_IN0) { transpose_item(a.pool_w_in, DM, 4096, Wt_in0, 0, a.norm_g, nullptr, scr, r, lane); continue; } r -= I_IN0;
            if (r < 4 * I_GRP1) { const int g = r / I_GRP1; transpose_item(a.pool_w_grp + (size_t)g * 512 * 512, 512, 512, Wt_grp, g * 512, nullptr, a.pool_scale + g * 512, scr, r % I_GRP1, lane); continue; } r -= 4 * I_GRP1;
            if (r < I_OUT) { transpose_item(a.pool_w_out, DI, DM, Wt_out0, 0, nullptr, nullptr, scr, r, lane); continue; } r -= I_OUT;
            if (r < I_IN1) {
                const int n0 = 32 * (r % (8192 / 32)); int d0 = n0;
                if (n0 < 2048) d0 = 256 * (n0 >> 7) + (n0 & 127); else if (n0 < 4096) d0 = 256 * ((n0 - 2048) >> 7) + 128 + (n0 & 127);
                transpose_item(a.hgrn_w_in, DM, 8192, Wt_in1, d0 - n0, a.norm_g + DM, nullptr, scr, r, lane); continue; } r -= I_IN1;
            transpose_item(a.hgrn_w_out, DI, DM, Wt_out1, 0, a.hgrn_norm_g, nullptr, scr, r, lane);
        }
        for (int m = gw; m < M; m += NGW) {
            const f32x4* xr = (const f32x4*)(a.x + (size_t)m * DM) + lane;
            f32x4 v[4]; float s = 0.f;
#pragma unroll
            for (int j = 0; j < 4; ++j) { v[j] = xr[64 * j]; s += (v[j][0] * v[j][0] + v[j][1] * v[j][1]) + (v[j][2] * v[j][2] + v[j][3] * v[j][3]); }
            const float rstd = 1.0f / sqrtf(wave_sum(s, lane) * (1.0f / DM) + EPS);
            unsigned long long* o8 = (unsigned long long*)(XB + (size_t)m * DM) + lane;
#pragma unroll
            for (int j = 0; j < 4; ++j) o8[64 * j] = (unsigned long long)pk2(v[j][0] * rstd, v[j][1] * rstd) | ((unsigned long long)pk2(v[j][2] * rstd, v[j][3] * rstd) << 32);
        }
    }
    grid.sync();

    {
        pg8::Gemm g{XB, Wt_in0, DM, DM, DM, 0}; pg8::StaticOrder S; S.init(M, 4096, G, bid);
        pg8::EpiP1 E{BA, BB};
        pg8::gemm_phase<pg8::EpiP1>(lds, g, S, E, wave);
    }
    GRID_BAR();

    {
        PHASE_IDS
        constexpr int RUN = 64;
        const int nruns = (M / RUN) * (DI / 8);
        for (int idx = bid * 512 + tid; idx < nruns; idx += G * 512) {
            const int cgp = idx & 255, run = idx >> 8, grp = cgp >> 6, w = 2 << grp;
            const int m0 = run * RUN, t0 = m0 & (SEQ - 1);
            const bf16_t* vp = BA + (size_t)m0 * DI + cgp * 8; bf16_t* pp = BC + (size_t)m0 * DI + cgp * 8;
            float sum[8];
#pragma unroll
            for (int j = 0; j < 8; ++j) sum[j] = 0.f;
            if (t0 > 0) for (int k = 1; k < w; ++k) { const u32x4 vv = *(const u32x4*)(vp - (size_t)k * DI);
                sum[0] += bf_lo(vv.x); sum[1] += bf_hi(vv.x); sum[2] += bf_lo(vv.y); sum[3] += bf_hi(vv.y); sum[4] += bf_lo(vv.z); sum[5] += bf_hi(vv.z); sum[6] += bf_lo(vv.w); sum[7] += bf_hi(vv.w); }
#pragma unroll 4
            for (int i = 0; i < RUN; ++i) {
                const int t = t0 + i;
                const u32x4 vv = *(const u32x4*)(vp + (size_t)i * DI);
                float x[8] = {bf_lo(vv.x), bf_hi(vv.x), bf_lo(vv.y), bf_hi(vv.y), bf_lo(vv.z), bf_hi(vv.z), bf_lo(vv.w), bf_hi(vv.w)};
#pragma unroll
                for (int j = 0; j < 8; ++j) sum[j] += x[j];
                const int cnt = (t + 1) < w ? (t + 1) : w; const float inv = 1.0f / (float)cnt;
                u32x4 o; o.x = pkbf(sum[0] * inv - x[0], sum[1] * inv - x[1]); o.y = pkbf(sum[2] * inv - x[2], sum[3] * inv - x[3]);
                o.z = pkbf(sum[4] * inv - x[4], sum[5] * inv - x[5]); o.w = pkbf(sum[6] * inv - x[6], sum[7] * inv - x[7]);
                *(u32x4*)(pp + (size_t)i * DI) = o;
                if (t + 1 >= w) { const u32x4 uu = *(const u32x4*)(vp + (size_t)(i + 1 - w) * DI);
                    sum[0] -= bf_lo(uu.x); sum[1] -= bf_hi(uu.x); sum[2] -= bf_lo(uu.y); sum[3] -= bf_hi(uu.y); sum[4] -= bf_lo(uu.z); sum[5] -= bf_hi(uu.z); sum[6] -= bf_lo(uu.w); sum[7] -= bf_hi(uu.w); }
            }
        }
    }
    GRID_BAR();

    {
        pg8::Gemm g{BC, Wt_grp, DI, 512, 512, 2}; pg8::StaticOrder S; S.init(M, DI, G, bid);
        pg8::EpiP2 E{BB};
        pg8::gemm_phase<pg8::EpiP2>(lds, g, S, E, wave);
    }
    GRID_BAR();

    {
        pg8::Gemm g{BB, Wt_out0, DI, DI, DI, 0}; pg8::StaticOrder S; S.init(M, DM, G, bid);
        pg8::EpiRes<true> E{a.x, a.out, XB, part1};
        pg8::gemm_phase<pg8::EpiRes<true>>(lds, g, S, E, wave);
    }
    GRID_BAR();

    {
        pg8::Gemm g{XB, Wt_in1, DM, DM, DM, 0}; pg8::StaticOrder S; S.init(M, 6144, G, bid);
        pg8::EpiP4 E{BA, BB, BC, decb, part1, a.hgrn_lb};
        pg8::gemm_phase<pg8::EpiP4>(lds, g, S, E, wave);
    }
    GRID_BAR();

    scan::phase(lds, BA, BB, BC, decb, ssb, bid, G, wave);
    GRID_BAR();

    {
        pg8::Gemm g{XB, Wt_in1 + (size_t)6144 * DM, DM, DM, DM, 0}; pg8::StaticOrder S; S.init(M, DI, G, bid);
        pg8::EpiP5b E{BC, part1, ssb};
        pg8::gemm_phase<pg8::EpiP5b>(lds, g, S, E, wave);
    }
    GRID_BAR();

    {
        pg8::Gemm g{BC, Wt_out1, DI, DI, DI, 0}; pg8::StaticOrder S; S.init(M, DM, G, bid);
        pg8::EpiRes<false> E{a.out, a.out, nullptr, part2};
        pg8::gemm_phase<pg8::EpiRes<false>>(lds, g, S, E, wave);
    }
    GRID_BAR();

    {
        PHASE_IDS
        for (int m = gw; m < M; m += NGW) {
            const f32x4* p4 = (const f32x4*)(part2 + (size_t)m * 16); const f32x4 pa = p4[0], pb = p4[1], pc = p4[2], pd = p4[3]; const float p = (((pa[0] + pa[1]) + (pa[2] + pa[3])) + ((pb[0] + pb[1]) + (pb[2] + pb[3]))) + (((pc[0] + pc[1]) + (pc[2] + pc[3])) + ((pd[0] + pd[1]) + (pd[2] + pd[3])));
            const float rstd = 1.0f / sqrtf(p * (1.0f / DM) + EPS);
            f32x4* orow = (f32x4*)(a.out + (size_t)m * DM) + lane; const f32x4* gr = (const f32x4*)a.final_g + lane;
#pragma unroll
            for (int j = 0; j < 4; ++j) { f32x4 v = orow[64 * j]; const f32x4 gg = gr[64 * j]; v = v * rstd * gg; orow[64 * j] = v; }
        }
    }
}

extern "C" void kernel_launch(void* const* d_in, const int* in_sizes, int n_in, void* d_out, int out_size, void* d_ws, size_t ws_size, hipStream_t stream) {
    static int grid = 0;
    if (grid == 0) {
        if (n_in != 11 || in_sizes[0] != M * DM || out_size != M * DM || ws_size < WS_END) { fprintf(stderr, "kernel_launch: unexpected shapes (n_in %d in0 %d out %d ws %zu)\n", n_in, n_in > 0 ? in_sizes[0] : -1, out_size, ws_size); grid = -1; return; }
        int dev = 0, cus = 0, per = 0;
        if (hipGetDevice(&dev) != hipSuccess || hipDeviceGetAttribute(&cus, hipDeviceAttributeMultiprocessorCount, dev) != hipSuccess) { grid = -1; return; }
        if (hipFuncSetAttribute((const void*)fwd_kernel, hipFuncAttributeMaxDynamicSharedMemorySize, LDS_BYTES) != hipSuccess) { fprintf(stderr, "kernel_launch: hipFuncSetAttribute failed\n"); grid = -1; return; }
        if (hipOccupancyMaxActiveBlocksPerMultiprocessor(&per, (const void*)fwd_kernel, 512, LDS_BYTES) != hipSuccess || per < 1) { fprintf(stderr, "kernel_launch: occupancy query says %d\n", per); (void)hipGetLastError(); grid = -1; return; }
        grid = cus;
        fprintf(stderr, "kernel_launch: cus %d per_cu %d grid %d\n", cus, per, grid);
    }
    if (grid < 0) return;
    if (hipMemsetAsync(d_ws, 0, 16384, stream) != hipSuccess) { fprintf(stderr, "kernel_launch: hipMemsetAsync failed\n"); return; }
    Args a{};
    a.x = (const float*)d_in[0]; a.norm_g = (const float*)d_in[1]; a.pool_w_in = (const float*)d_in[2]; a.pool_w_grp = (const float*)d_in[3];
    a.pool_scale = (const float*)d_in[4]; a.pool_w_out = (const float*)d_in[5]; a.hgrn_w_in = (const float*)d_in[6]; a.hgrn_lb = (const float*)d_in[7];
    a.hgrn_norm_g = (const float*)d_in[8]; a.hgrn_w_out = (const float*)d_in[9]; a.final_g = (const float*)d_in[10];
    a.out = (float*)d_out; a.ws = (unsigned char*)d_ws;
    void* args[] = {&a};
    hipError_t e = hipLaunchCooperativeKernel((void*)fwd_kernel, dim3(grid), dim3(512), args, LDS_BYTES, stream);
    if (e != hipSuccess) fprintf(stderr, "kernel_launch: cooperative launch failed: %s (grid %d)\n", hipGetErrorString(e), grid);
}
```

```cpp
#include <hip/hip_runtime.h>
#include <hip/hip_cooperative_groups.h>
#include <cstdio>
#include <cstdint>
namespace cg = cooperative_groups;

#define LAS __attribute__((address_space(3)))
typedef unsigned short bf16_t;
typedef short bf16x8 __attribute__((ext_vector_type(8)));
typedef float f32x4 __attribute__((ext_vector_type(4)));
typedef float f32x2 __attribute__((ext_vector_type(2)));
typedef unsigned u32x4 __attribute__((ext_vector_type(4)));
typedef unsigned u32x2 __attribute__((ext_vector_type(2)));

constexpr int DM = 1024, BATCH = 8, SEQ = 4096, DI = 2048, M = BATCH * SEQ;
constexpr int NHEAD = 16, HD = 128;
constexpr float EPS = 1e-6f;
constexpr size_t MiB = 1u << 20;
constexpr size_t WS_WIN0 = 2 * MiB;
constexpr size_t WS_WGRP = 10 * MiB;
constexpr size_t WS_WOUT0 = 12 * MiB;
constexpr size_t WS_WIN1 = 16 * MiB;
constexpr size_t WS_WOUT1 = 32 * MiB;
constexpr size_t WS_PART1 = 36 * MiB;
constexpr size_t WS_PART2 = 38 * MiB;
constexpr size_t WS_DEC = 44 * MiB;
constexpr size_t WS_SS = 112 * MiB;
constexpr size_t WS_XB = 48 * MiB;
constexpr size_t WS_A = 128 * MiB;
constexpr size_t WS_B = 256 * MiB;
constexpr size_t WS_C = 384 * MiB;
constexpr size_t WS_END = 512 * MiB;
constexpr int LDS_BYTES = 147456;

__device__ __forceinline__ unsigned f2bf(float f) { unsigned u = __builtin_bit_cast(unsigned, f); return (u + 0x7fffu + ((u >> 16) & 1u)) >> 16; }
__device__ __forceinline__ unsigned pk2(float lo, float hi) { return f2bf(lo) | (f2bf(hi) << 16); }
typedef __bf16 bf2_t __attribute__((ext_vector_type(2)));
__device__ __forceinline__ unsigned pkbf(float lo, float hi) { f32x2 v = {lo, hi}; return __builtin_bit_cast(unsigned, __builtin_convertvector(v, bf2_t)); }
__device__ __forceinline__ float bf_lo(unsigned w) { return __builtin_bit_cast(float, w << 16); }
__device__ __forceinline__ float bf_hi(unsigned w) { return __builtin_bit_cast(float, w & 0xffff0000u); }
__device__ __forceinline__ float silu_f(float x) { return x * __builtin_amdgcn_rcpf(1.0f + __builtin_amdgcn_exp2f(-1.44269504089f * x)); }
__device__ __forceinline__ float lane_get(float v, int src_lane) { return __builtin_bit_cast(float, __builtin_amdgcn_ds_bpermute(src_lane << 2, __builtin_bit_cast(int, v))); }
__device__ __forceinline__ float xor_get(float v, int lane, int m) { return lane_get(v, lane ^ m); }
__device__ __forceinline__ float wave_sum(float v, int lane) {
#pragma unroll
    for (int o = 1; o < 64; o <<= 1) v += xor_get(v, lane, o);
    return v;
}

namespace pg8 {
constexpr int BM = 256, BK = 64, HALF = 128, HTB = HALF * BK * 2, STAGE_BYTES = 8 * HTB, NXCD = 8, WGM = 8;
__host__ __device__ __forceinline__ int lds_byte(int r, int c) { const int st = (r >> 4) * 2 + (c >> 5), rr = r & 15, cc = c & 31, ob = rr * 64 + cc * 2; return st * 1024 + (ob ^ (((ob >> 9) & 1) << 5)); }
__host__ __device__ __forceinline__ void stage_rc(int b, int& R, int& C) { const int st = b / 1024, sb = b % 1024, swz = sb ^ (((sb >> 9) & 1) << 5); R = (st >> 1) * 16 + swz / 64; C = (st & 1) * 32 + (swz % 64) / 2; }
__host__ __device__ __forceinline__ int perm32(int rho) { const int n = rho >> 4, i = rho & 15; return 8 * (i >> 2) + 4 * n + (i & 3); }

struct Unit { int pm, pn; };
struct Gemm { const bf16_t* A; const bf16_t* Bt; int lda, ldb, K, grp_tiles; };

struct StaticOrder {
    int nM, nN, nwg, G, c;
    __host__ __device__ void init(int M_, int N_, int G_, int c_) { nM = M_ / BM; nN = N_ / BM; nwg = nM * nN; G = G_; c = c_; }
    __host__ __device__ bool next(int i, Unit& u) const {
        const long L = (long)i * G + c; if (L >= nwg) return false;
        int wgid = (int)L; { const int q = nwg / NXCD, r = nwg % NXCD, xcd = wgid % NXCD, off = wgid / NXCD; wgid = (xcd < r ? xcd * (q + 1) : r * (q + 1) + (xcd - r) * q) + off; }
        const int nig = WGM * nN, gid = wgid / nig, fm = gid * WGM, gsz = (nM - fm) < WGM ? (nM - fm) : WGM;
        u.pm = fm + ((wgid % nig) % gsz); u.pn = (wgid % nig) / gsz; return true;
    }
};

__device__ __forceinline__ unsigned cvt_pk_bf16(float lo, float hi) { unsigned r; asm volatile("v_cvt_pk_bf16_f32 %0, %1, %2" : "=v"(r) : "v"(lo), "v"(hi)); return r; }

template <class Epi, bool ALIGN_EPI = true, bool SP2 = true>
__device__ __forceinline__ void gemm_phase(LAS unsigned char* lds, const Gemm g, const StaticOrder& S, const Epi& E, const int wid) {
    int lane_ = (int)__builtin_amdgcn_mbcnt_hi(~0u, __builtin_amdgcn_mbcnt_lo(~0u, 0u)); asm volatile("" : "+v"(lane_));
    int lane = lane_, tid = wid * 64 + lane, fr = lane & 15, fq = lane >> 4; const int wr = wid >> 2, wc = wid & 3;
    const int K = g.K, nt = K / BK;
    unsigned voffA[2], voffB[2]; int aoff, boff;
#define PG8_LANE_STATE() do { _Pragma("unroll") for (int i = 0; i < 2; ++i) { int R, C; stage_rc(tid * 16 + i * 8192, R, C); const int Rb = Epi::PERM ? ((R & ~31) + perm32(R & 31)) : R; \
        voffA[i] = (unsigned)(R * g.lda + C) * 2u; voffB[i] = (unsigned)(Rb * g.ldb + C) * 2u; } \
        aoff = lds_byte(wr * 64 + fr, fq * 8); boff = lds_byte(wc * 32 + fr, fq * 8); } while (0)
    PG8_LANE_STATE();
    const size_t kstep = (size_t)(BK * 2);
    const size_t hstepA = (size_t)HALF * g.lda * 2, hstepB = (size_t)HALF * g.ldb * 2;
    const size_t tstepA = 2 * hstepA, tstepB = 2 * hstepB;
    const unsigned ldsw = (unsigned)wid * 1024u;
#define PG8_SA(b, h) (((b) * 2 + (h)) * HTB)
#define PG8_SB(b, h) ((4 + (b) * 2 + (h)) * HTB)
#define PG8_STAGE(bufoff, gbase, voff) do { _Pragma("unroll") for (int _i = 0; _i < 2; ++_i) \
        __builtin_amdgcn_global_load_lds((const unsigned*)((const char*)(gbase) + (voff)[_i]), (LAS unsigned*)(lds + (bufoff) + ldsw + _i * 8192), 16, 0, 0); } while (0)
#define PG8_LDA(dst, b, h) do { _Pragma("unroll") for (int m = 0; m < 4; ++m) _Pragma("unroll") for (int k = 0; k < 2; ++k) dst[m][k] = *(const LAS bf16x8*)(lds + PG8_SA(b, h) + aoff + m * 2048 + k * 1024); } while (0)
#define PG8_LDB(dst, b, h) do { _Pragma("unroll") for (int n = 0; n < 2; ++n) _Pragma("unroll") for (int k = 0; k < 2; ++k) dst[n][k] = *(const LAS bf16x8*)(lds + PG8_SB(b, h) + boff + n * 2048 + k * 1024); } while (0)
#define PG8_MMA(ai, bj, At, Bt) do { __builtin_amdgcn_s_setprio(1); _Pragma("unroll") for (int m = 0; m < 4; ++m) _Pragma("unroll") for (int n = 0; n < 2; ++n) _Pragma("unroll") for (int k = 0; k < 2; ++k) \
        acc[ai][bj][m][n] = __builtin_amdgcn_mfma_f32_16x16x32_bf16(Bt[n][k], At[m][k], acc[ai][bj][m][n], 0, 0, 0); __builtin_amdgcn_s_setprio(0); } while (0)
#define PG8_WAIT_V(n) asm volatile("s_waitcnt vmcnt(" #n ")" ::: "memory")
#define PG8_WAIT_L(n) asm volatile("s_waitcnt lgkmcnt(" #n ")" ::: "memory")
#define PG8_BAR __builtin_amdgcn_s_barrier()
#define PG8_SCHED __builtin_amdgcn_sched_barrier(0)
#define PG8_ABASE(u) ((const char*)g.A + (size_t)(u).pm * tstepA + (g.grp_tiles ? (size_t)((u).pn / g.grp_tiles) * (size_t)K * 2 : (size_t)0))
#define PG8_BBASE(u) ((const char*)g.Bt + (size_t)(u).pn * tstepB)
    Unit cur, nxt; int ui = 0;
    if (!S.next(0, cur)) return;
    f32x4 acc[2][2][4][2];
#pragma unroll
    for (int a = 0; a < 2; ++a)
#pragma unroll
        for (int b = 0; b < 2; ++b)
#pragma unroll
            for (int m = 0; m < 4; ++m)
#pragma unroll
                for (int n = 0; n < 2; ++n) acc[a][b][m][n] = (f32x4){0.f, 0.f, 0.f, 0.f};
    bf16x8 At[4][2], B0[2][2], B1[2][2];
    const char* cA = PG8_ABASE(cur); const char* cB = PG8_BBASE(cur);
    if constexpr (SP2) {
        PG8_STAGE(PG8_SB(0, 0), cB, voffB); PG8_STAGE(PG8_SB(0, 1), cB + hstepB, voffB); PG8_STAGE(PG8_SA(0, 0), cA, voffA); PG8_STAGE(PG8_SA(0, 1), cA + hstepA, voffA);
        if (wr == 1) PG8_BAR;
        PG8_WAIT_V(2); PG8_BAR;
        PG8_STAGE(PG8_SB(1, 0), cB + kstep, voffB); PG8_STAGE(PG8_SA(1, 0), cA + kstep, voffA); PG8_STAGE(PG8_SB(1, 1), cB + hstepB + kstep, voffB);
        PG8_WAIT_V(6); PG8_BAR;
    } else {
        PG8_STAGE(PG8_SB(0, 0), cB, voffB); PG8_STAGE(PG8_SA(0, 0), cA, voffA); PG8_STAGE(PG8_SB(0, 1), cB + hstepB, voffB); PG8_STAGE(PG8_SA(0, 1), cA + hstepA, voffA);
        if (wr == 1) PG8_BAR;
        PG8_WAIT_V(4); PG8_BAR;
        PG8_STAGE(PG8_SB(1, 0), cB + kstep, voffB); PG8_STAGE(PG8_SA(1, 0), cA + kstep, voffA); PG8_STAGE(PG8_SB(1, 1), cB + hstepB + kstep, voffB);
        PG8_WAIT_V(6); PG8_BAR;
    }
    for (;;) {
        const bool has_next = S.next(ui + 1, nxt);
        const char* nA = has_next ? PG8_ABASE(nxt) : cA; const char* nB = has_next ? PG8_BBASE(nxt) : cB;
        for (int t = 0; t < nt; t += 2) {
            const bool last = (t == nt - 2);
            const char* a1 = cA + (size_t)(t + 1) * kstep;
            const char* a2 = last ? nA : cA + (size_t)(t + 2) * kstep; const char* b2 = last ? nB : cB + (size_t)(t + 2) * kstep;
            const char* a3 = a2 + kstep; const char* b3 = b2 + kstep;
            if constexpr (SP2) {
            PG8_LDB(B0, 0, 0); PG8_LDB(B1, 0, 1); PG8_SCHED; PG8_LDA(At, 0, 0); PG8_STAGE(PG8_SA(1, 1), a1 + hstepA, voffA);
            PG8_WAIT_V(8); PG8_WAIT_L(0); PG8_BAR; PG8_MMA(0, 0, At, B0); PG8_MMA(0, 1, At, B1); PG8_BAR; PG8_SCHED;
            PG8_LDA(At, 0, 1); PG8_STAGE(PG8_SB(0, 0), b2, voffB); PG8_STAGE(PG8_SB(0, 1), b2 + hstepB, voffB); PG8_STAGE(PG8_SA(0, 0), a2, voffA);
            PG8_WAIT_V(8); PG8_WAIT_L(0); PG8_BAR; PG8_MMA(1, 0, At, B0); PG8_MMA(1, 1, At, B1); PG8_BAR; PG8_SCHED;
            PG8_LDB(B0, 1, 0); PG8_LDB(B1, 1, 1); PG8_SCHED; PG8_LDA(At, 1, 0); PG8_STAGE(PG8_SA(0, 1), a2 + hstepA, voffA);
            PG8_WAIT_V(8); PG8_WAIT_L(0); PG8_BAR; PG8_MMA(0, 0, At, B0); PG8_MMA(0, 1, At, B1); PG8_BAR; PG8_SCHED;
            PG8_LDA(At, 1, 1); PG8_STAGE(PG8_SB(1, 0), b3, voffB); PG8_STAGE(PG8_SB(1, 1), b3 + hstepB, voffB); PG8_STAGE(PG8_SA(1, 0), a3, voffA);
            PG8_WAIT_V(8); PG8_WAIT_L(0); PG8_BAR; PG8_MMA(1, 0, At, B0); PG8_MMA(1, 1, At, B1); PG8_BAR; PG8_SCHED;
            } else {
            PG8_LDB(B0, 0, 0); PG8_SCHED; PG8_LDA(At, 0, 0); PG8_STAGE(PG8_SA(1, 1), a1 + hstepA, voffA);
            PG8_WAIT_L(8); PG8_BAR; PG8_WAIT_L(0); PG8_MMA(0, 0, At, B0); PG8_BAR; PG8_SCHED;
            PG8_LDB(B1, 0, 1); PG8_STAGE(PG8_SB(0, 0), b2, voffB);
            PG8_BAR; PG8_WAIT_L(0); PG8_MMA(0, 1, At, B1); PG8_BAR;
            PG8_LDA(At, 0, 1); PG8_STAGE(PG8_SA(0, 0), a2, voffA);
            PG8_BAR; PG8_WAIT_L(0); PG8_MMA(1, 0, At, B0); PG8_BAR; PG8_SCHED;
            PG8_STAGE(PG8_SB(0, 1), b2 + hstepB, voffB);
            PG8_WAIT_V(6); PG8_BAR; PG8_MMA(1, 1, At, B1); PG8_BAR;
            PG8_LDB(B0, 1, 0); PG8_SCHED; PG8_LDA(At, 1, 0); PG8_STAGE(PG8_SA(0, 1), a2 + hstepA, voffA);
            PG8_WAIT_L(8); PG8_BAR; PG8_WAIT_L(0); PG8_MMA(0, 0, At, B0); PG8_BAR; PG8_SCHED;
            PG8_LDB(B1, 1, 1); PG8_STAGE(PG8_SB(1, 0), b3, voffB);
            PG8_BAR; PG8_WAIT_L(0); PG8_MMA(0, 1, At, B1); PG8_BAR;
            PG8_LDA(At, 1, 1); PG8_STAGE(PG8_SA(1, 0), a3, voffA);
            PG8_BAR; PG8_WAIT_L(0); PG8_MMA(1, 0, At, B0); PG8_BAR; PG8_SCHED;
            PG8_STAGE(PG8_SB(1, 1), b3 + hstepB, voffB);
            PG8_WAIT_V(6); PG8_BAR; PG8_MMA(1, 1, At, B1); PG8_BAR;
            }
        }
        if constexpr (ALIGN_EPI) { if (wr == 0) PG8_BAR; }
        if constexpr (!Epi::AFTER_DRAIN) E(acc, cur, wr, wc, fr, fq);
        if (!has_next) break;
#pragma unroll
        for (int a = 0; a < 2; ++a)
#pragma unroll
            for (int b = 0; b < 2; ++b)
#pragma unroll
                for (int m = 0; m < 4; ++m)
#pragma unroll
                    for (int n = 0; n < 2; ++n) acc[a][b][m][n] = (f32x4){0.f, 0.f, 0.f, 0.f};
        cur = nxt; cA = nA; cB = nB; ++ui;
        asm volatile("" : "+v"(lane)); tid = wid * 64 + lane; fr = lane & 15; fq = lane >> 4; PG8_LANE_STATE();
        if constexpr (ALIGN_EPI) { if (wr == 1) PG8_BAR; }
    }
    PG8_WAIT_V(0);
    if constexpr (!ALIGN_EPI) { if (wr == 0) PG8_BAR; }
    PG8_BAR;
    if constexpr (Epi::AFTER_DRAIN) E.fused(acc, cur, wr, wc, fr, fq, lds, tid);
#undef PG8_SA
#undef PG8_SB
#undef PG8_STAGE
#undef PG8_LDA
#undef PG8_LDB
#undef PG8_MMA
#undef PG8_WAIT_V
#undef PG8_WAIT_L
#undef PG8_BAR
#undef PG8_SCHED
#undef PG8_ABASE
#undef PG8_LANE_STATE
#undef PG8_BBASE
}

struct EpiP1 {
    static constexpr bool PERM = true, AFTER_DRAIN = false;
    bf16_t* V; bf16_t* SG;
    __device__ __forceinline__ void operator()(f32x4 (&acc)[2][2][4][2], const Unit& u, int wr, int wc, int fr, int fq) const {
        const int row0 = u.pm * BM + wr * 64 + fr; const bool gate = u.pn >= 8;
        bf16_t* base = gate ? SG : V; const int col0 = (u.pn & 7) * BM + wc * 32 + 8 * fq;
#pragma unroll
        for (int ai = 0; ai < 2; ++ai)
#pragma unroll
            for (int m = 0; m < 4; ++m) { bf16_t* rowp = base + (size_t)(row0 + ai * HALF + m * 16) * DI + col0;
#pragma unroll
                for (int bj = 0; bj < 2; ++bj) { f32x4 v0 = acc[ai][bj][m][0], v1 = acc[ai][bj][m][1];
                    if (gate) {
#pragma unroll
                        for (int j = 0; j < 4; ++j) { v0[j] = silu_f(v0[j]); v1[j] = silu_f(v1[j]); } }
                    u32x4 w; w.x = cvt_pk_bf16(v0[0], v0[1]); w.y = cvt_pk_bf16(v0[2], v0[3]); w.z = cvt_pk_bf16(v1[0], v1[1]); w.w = cvt_pk_bf16(v1[2], v1[3]);
                    *(u32x4*)(rowp + bj * HALF) = w; } }
    }
};
struct EpiP2 {
    static constexpr bool PERM = true, AFTER_DRAIN = false;
    bf16_t* Z;
    __device__ __forceinline__ void operator()(f32x4 (&acc)[2][2][4][2], const Unit& u, int wr, int wc, int fr, int fq) const {
        const int row0 = u.pm * BM + wr * 64 + fr; const int col0 = u.pn * BM + wc * 32 + 8 * fq;
#pragma unroll
        for (int ai = 0; ai < 2; ++ai)
#pragma unroll
            for (int m = 0; m < 4; ++m) { bf16_t* rowp = Z + (size_t)(row0 + ai * HALF + m * 16) * DI + col0;
#pragma unroll
                for (int bj = 0; bj < 2; ++bj) { const f32x4 v0 = acc[ai][bj][m][0], v1 = acc[ai][bj][m][1];
                    const u32x4 s = *(const u32x4*)(rowp + bj * HALF);
                    u32x4 w; w.x = cvt_pk_bf16(v0[0] * bf_lo(s.x), v0[1] * bf_hi(s.x)); w.y = cvt_pk_bf16(v0[2] * bf_lo(s.y), v0[3] * bf_hi(s.y));
                    w.z = cvt_pk_bf16(v1[0] * bf_lo(s.z), v1[1] * bf_hi(s.z)); w.w = cvt_pk_bf16(v1[2] * bf_lo(s.w), v1[3] * bf_hi(s.w));
                    *(u32x4*)(rowp + bj * HALF) = w; } }
    }
};
template <bool WRITE_HB> struct EpiRes {
    static constexpr bool PERM = false, AFTER_DRAIN = false;
    const float* R; float* H; bf16_t* HB; float* part;
    __device__ __forceinline__ void operator()(f32x4 (&acc)[2][2][4][2], const Unit& u, int wr, int wc, int fr, int fq) const {
        const unsigned row0 = (unsigned)(u.pm * BM + wr * 64 + fr), col0 = (unsigned)(u.pn * BM + wc * 32 + 4 * fq);
        const unsigned ofs = (row0 * DM + col0) * 4u, pofs = (row0 * 16u + (unsigned)(u.pn * 4 + wc)) * 4u;
#pragma unroll
        for (int ai = 0; ai < 2; ++ai)
#pragma unroll
            for (int m = 0; m < 4; ++m) { const unsigned o = ofs + (unsigned)((ai * HALF + m * 16) * DM) * 4u; float ss = 0.f;
#pragma unroll
                for (int bj = 0; bj < 2; ++bj)
#pragma unroll
                    for (int n = 0; n < 2; ++n) { const unsigned oo = o + (unsigned)(bj * HALF + n * 16) * 4u;
                        const f32x4 xv = *(const f32x4*)((const char*)R + oo); const f32x4 h = xv + acc[ai][bj][m][n];
                        *(f32x4*)((char*)H + oo) = h; ss += (h[0] * h[0] + h[1] * h[1]) + (h[2] * h[2] + h[3] * h[3]);
                        if (WRITE_HB) { u32x2 w; w.x = pkbf(h[0], h[1]); w.y = pkbf(h[2], h[3]); *(u32x2*)((char*)HB + (oo >> 1)) = w; } }
                ss += xor_get(ss, fq * 16 + fr, 16); ss += xor_get(ss, fq * 16 + fr, 32);
                if (fq == 0) *(float*)((char*)part + (pofs + (unsigned)(ai * HALF + m * 16) * 64u)) = ss;
                asm volatile("" ::: "memory"); }
    }
};
__device__ __forceinline__ float row_rstd_b(const float* part, unsigned bofs) {
    const f32x4* p = (const f32x4*)((const char*)part + bofs); const f32x4 a = p[0], b = p[1], c = p[2], d = p[3];
    return __builtin_amdgcn_rsqf((((a[0] + a[1]) + (a[2] + a[3])) + ((b[0] + b[1]) + (b[2] + b[3])) + ((c[0] + c[1]) + (c[2] + c[3])) + ((d[0] + d[1]) + (d[2] + d[3]))) * (1.0f / DM) + EPS);
}
__device__ __forceinline__ float dpp_shr_mul(float v, const int n) {
    const int iv = __builtin_bit_cast(int, v), one = 0x3f800000; int r;
    if (n == 1) r = __builtin_amdgcn_update_dpp(one, iv, 0x111, 0xf, 0xf, false); else if (n == 2) r = __builtin_amdgcn_update_dpp(one, iv, 0x112, 0xf, 0xf, false);
    else if (n == 4) r = __builtin_amdgcn_update_dpp(one, iv, 0x114, 0xf, 0xf, false); else r = __builtin_amdgcn_update_dpp(one, iv, 0x118, 0xf, 0xf, false);
    return v * __builtin_bit_cast(float, r);
}
struct EpiP4 {
    static constexpr bool PERM = true, AFTER_DRAIN = false;
    bf16_t* Qt; bf16_t* Kt; bf16_t* V; float* DEC; const float* part; const float* lbnd;
    __device__ __forceinline__ void operator()(f32x4 (&acc)[2][2][4][2], const Unit& u, int wr, int wc, int fr, int fq) const {
        const unsigned row0 = (unsigned)(u.pm * BM + wr * 64 + fr);
        const unsigned pofs = row0 * 64u;
        if (u.pn >= 16) {
            const unsigned vofs = (row0 * DI + (unsigned)((u.pn - 16) * BM + wc * 32 + 8 * fq)) * 2u;
#pragma unroll
            for (int ai = 0; ai < 2; ++ai)
#pragma unroll
                for (int m = 0; m < 4; ++m) { const float rs = row_rstd_b(part, pofs + (unsigned)(ai * HALF + m * 16) * 64u);
#pragma unroll
                    for (int bj = 0; bj < 2; ++bj) { const f32x4 v0 = acc[ai][bj][m][0] * rs, v1 = acc[ai][bj][m][1] * rs;
                        u32x4 w; w.x = pkbf(v0[0], v0[1]); w.y = pkbf(v0[2], v0[3]); w.z = pkbf(v1[0], v1[1]); w.w = pkbf(v1[2], v1[3]);
                        *(u32x4*)((char*)V + (vofs + (unsigned)((ai * HALF + m * 16) * DI + bj * HALF) * 2u)) = w; }
                    asm volatile("" ::: "memory"); }
            return;
        }
        const unsigned c0 = (unsigned)(u.pn * HD + wc * 32 + 8 * fq);
        const unsigned qofs = (row0 * DI + c0) * 2u;
#pragma unroll
        for (int ai = 0; ai < 2; ++ai) {
            float rs[4];
#pragma unroll
            for (int m = 0; m < 4; ++m) { rs[m] = row_rstd_b(part, pofs + (unsigned)(ai * HALF + m * 16) * 64u); asm volatile("" : "+v"(rs[m]) :: "memory"); }
            unsigned cc = c0; asm volatile("" : "+v"(cc));
#pragma unroll
            for (int n = 0; n < 2; ++n) {
                const f32x4 l0 = *(const f32x4*)((const char*)lbnd + (cc + 4 * n) * 4u), l1 = *(const f32x4*)((const char*)lbnd + (cc + 4 * n + DI) * 4u);
                f32x4 decv;
#pragma unroll
                for (int j = 0; j < 4; ++j) { const float ex = __expf(l0[j] - l1[j]); const float lb = __builtin_amdgcn_rcpf(1.0f + ex), omlb = ex * lb; float bprod = 1.0f;
#pragma unroll
                    for (int m = 0; m < 4; ++m) {
                        const float qv = acc[ai][0][m][n][j] * rs[m], z = acc[ai][1][m][n][j] * rs[m];
                        const float sg = __builtin_amdgcn_rcpf(1.0f + __builtin_amdgcn_exp2f(-1.44269504089f * z));
                        const float f = lb + omlb * sg, k = omlb * (1.0f - sg);
                        float s = f; s = dpp_shr_mul(s, 1); s = dpp_shr_mul(s, 2); s = dpp_shr_mul(s, 4); s = dpp_shr_mul(s, 8);
                        const float E = bprod * s;
                        if (m < 3) bprod *= lane_get(s, fq * 16 + 15);
                        const float Ei = __builtin_amdgcn_rcpf(fmaxf(E, 7.9e-31f));
                        acc[ai][0][m][n][j] = qv * E; acc[ai][1][m][n][j] = k * Ei;
                        if (m == 3) decv[j] = E;
                    } }
                if (fr == 15) *(f32x4*)((char*)DEC + ((unsigned)(u.pm * 4 + ai * 2 + wr) * DI + cc + 4 * n) * 4u) = decv;
            }
#pragma unroll
            for (int m = 0; m < 4; ++m) { const unsigned ob = qofs + (unsigned)((ai * HALF + m * 16) * DI) * 2u;
                u32x4 w; w.x = pkbf(acc[ai][0][m][0][0], acc[ai][0][m][0][1]); w.y = pkbf(acc[ai][0][m][0][2], acc[ai][0][m][0][3]); w.z = pkbf(acc[ai][0][m][1][0], acc[ai][0][m][1][1]); w.w = pkbf(acc[ai][0][m][1][2], acc[ai][0][m][1][3]);
                *(u32x4*)((char*)Qt + ob) = w;
                u32x4 x; x.x = pkbf(acc[ai][1][m][0][0], acc[ai][1][m][0][1]); x.y = pkbf(acc[ai][1][m][0][2], acc[ai][1][m][0][3]); x.z = pkbf(acc[ai][1][m][1][0], acc[ai][1][m][1][1]); x.w = pkbf(acc[ai][1][m][1][2], acc[ai][1][m][1][3]);
                *(u32x4*)((char*)Kt + ob) = x; }
            asm volatile("" ::: "memory");
        }
    }
};
struct EpiP5b {
    static constexpr bool PERM = true, AFTER_DRAIN = false;
    bf16_t* O; const float* part; const float* ss;
    __device__ __forceinline__ void operator()(f32x4 (&acc)[2][2][4][2], const Unit& u, int wr, int wc, int fr, int fq) const {
        const int row0 = u.pm * BM + wr * 64 + fr; const int col0 = u.pn * BM + wc * 32 + 8 * fq;
        const unsigned pofs = (unsigned)row0 * 64u; const float* srow = ss + (size_t)row0 * 128 + u.pn * 16;
        char* op = (char*)(O + (size_t)row0 * DI + col0);
#pragma unroll
        for (int ai = 0; ai < 2; ++ai)
#pragma unroll
            for (int m = 0; m < 4; ++m) { const float rs = row_rstd_b(part, pofs + (unsigned)(ai * HALF + m * 16) * 64u);
#pragma unroll
                for (int bj = 0; bj < 2; ++bj) { const f32x4 v0 = acc[ai][bj][m][0] * rs, v1 = acc[ai][bj][m][1] * rs;
                    const f32x4* sp = (const f32x4*)(srow + (size_t)(ai * HALF + m * 16) * 128 + bj * 8); const f32x4 s0 = sp[0], s1 = sp[1];
                    const float rh = __builtin_amdgcn_rsqf((((s0[0] + s0[1]) + (s0[2] + s0[3])) + ((s1[0] + s1[1]) + (s1[2] + s1[3]))) * (1.0f / HD) + EPS);
                    u32x4* optr = (u32x4*)(op + (size_t)((ai * HALF + m * 16) * DI + bj * HALF) * 2);
                    const u32x4 s = *optr;
                    u32x4 w; w.x = pkbf(bf_lo(s.x) * rh * silu_f(v0[0]), bf_hi(s.x) * rh * silu_f(v0[1])); w.y = pkbf(bf_lo(s.y) * rh * silu_f(v0[2]), bf_hi(s.y) * rh * silu_f(v0[3]));
                    w.z = pkbf(bf_lo(s.z) * rh * silu_f(v1[0]), bf_hi(s.z) * rh * silu_f(v1[1])); w.w = pkbf(bf_lo(s.w) * rh * silu_f(v1[2]), bf_hi(s.w) * rh * silu_f(v1[3]));
                    *optr = w; }
                asm volatile("" ::: "memory"); }
    }
};
}

namespace scan {
#define MFMA16(a, b, c) __builtin_amdgcn_mfma_f32_16x16x32_bf16((a), (b), (c), 0, 0, 0)
__device__ __forceinline__ unsigned offb(unsigned row, unsigned ch) { return 256u * row + 16u * (ch ^ (((row & 3u) << 2) | ((row >> 2) & 3u))); }
__device__ __forceinline__ unsigned voffv(unsigned r, unsigned cp) { return 128u * r + 32u * (cp ^ (((r >> 1) & 3u) ^ (((r >> 3) & 1u) << 1))); }
__device__ __forceinline__ bf16x8 tr2(unsigned a0, unsigned a1) {
    u32x2 lo, hi;
    asm volatile("ds_read_b64_tr_b16 %0, %2\n\tds_read_b64_tr_b16 %1, %3\n\ts_waitcnt lgkmcnt(0)" : "=&v"(lo), "=&v"(hi) : "v"(a0), "v"(a1) : "memory");
    const u32x4 r = {lo.x, lo.y, hi.x, hi.y}; return __builtin_bit_cast(bf16x8, r);
}
__device__ __forceinline__ void tr8(unsigned a0, unsigned a1, unsigned c0, unsigned c1, bf16x8& f00, bf16x8& f01, bf16x8& f10, bf16x8& f11) {
    u32x2 r0, r1, r2, r3, r4, r5, r6, r7;
    asm volatile("ds_read_b64_tr_b16 %0, %8\n\tds_read_b64_tr_b16 %1, %9\n\tds_read_b64_tr_b16 %2, %8 offset:8192\n\tds_read_b64_tr_b16 %3, %9 offset:8192\n\t"
                 "ds_read_b64_tr_b16 %4, %10\n\tds_read_b64_tr_b16 %5, %11\n\tds_read_b64_tr_b16 %6, %10 offset:8192\n\tds_read_b64_tr_b16 %7, %11 offset:8192\n\ts_waitcnt lgkmcnt(0)"
                 : "=&v"(r0), "=&v"(r1), "=&v"(r2), "=&v"(r3), "=&v"(r4), "=&v"(r5), "=&v"(r6), "=&v"(r7) : "v"(a0), "v"(a1), "v"(c0), "v"(c1) : "memory");
    const u32x4 x00 = {r0.x, r0.y, r1.x, r1.y}, x01 = {r2.x, r2.y, r3.x, r3.y}, x10 = {r4.x, r4.y, r5.x, r5.y}, x11 = {r6.x, r6.y, r7.x, r7.y};
    f00 = __builtin_bit_cast(bf16x8, x00); f01 = __builtin_bit_cast(bf16x8, x01); f10 = __builtin_bit_cast(bf16x8, x10); f11 = __builtin_bit_cast(bf16x8, x11);
}
__device__ __forceinline__ bf16x8 pack8(const f32x4 a, const f32x4 b) { const u32x4 r = {pkbf(a[0], a[1]), pkbf(a[2], a[3]), pkbf(b[0], b[1]), pkbf(b[2], b[3])}; return __builtin_bit_cast(bf16x8, r); }
template <int NJ>
__device__ __forceinline__ f32x4 ttile(LAS unsigned char* lds, unsigned ldsb, unsigned QI, unsigned KI, unsigned VI, int it, const bf16x8 (&sfrag)[4],
                                       unsigned vs, unsigned l15, unsigned g, unsigned ql, unsigned p) {
    const unsigned trow = 16u * (unsigned)it + l15;
    bf16x8 qb[4];
#pragma unroll
    for (int kd = 0; kd < 4; ++kd) qb[kd] = *(const LAS bf16x8*)(lds + QI + offb(trow, 4u * kd + g));
    f32x4 c[NJ];
#pragma unroll
    for (int j = 0; j < NJ; ++j) { c[j] = (f32x4){0.f, 0.f, 0.f, 0.f};
        if (j <= it) {
#pragma unroll
            for (int kd = 0; kd < 4; ++kd) { const bf16x8 a = *(const LAS bf16x8*)(lds + KI + offb(16u * j + l15, 4u * kd + g)); c[j] = MFMA16(a, qb[kd], c[j]); }
            if (j == it) {
#pragma unroll
                for (int r = 0; r < 4; ++r) c[j][r] = (4u * g + r <= l15) ? c[j][r] : 0.f; } } }
    f32x4 o = (f32x4){0.f, 0.f, 0.f, 0.f};
#pragma unroll
    for (int ks = 0; ks < NJ / 2; ++ks) if (2 * ks <= it) {
        const bf16x8 at = pack8(c[2 * ks], c[2 * ks + 1]);
        const bf16x8 vf = tr2(ldsb + VI + voffv(32u * ks + 4u * g + ql, vs) + 8u * p, ldsb + VI + voffv(32u * ks + 16u + 4u * g + ql, vs) + 8u * p);
        o = MFMA16(vf, at, o); }
#pragma unroll
    for (int kd = 0; kd < 4; ++kd) {
        const u32x2 q0 = *(const LAS u32x2*)(lds + QI + offb(trow, 4u * kd + (g >> 1)) + 8u * (g & 1)), q1 = *(const LAS u32x2*)(lds + QI + offb(trow, 4u * kd + 2u + (g >> 1)) + 8u * (g & 1));
        const u32x4 qq = {q0.x, q0.y, q1.x, q1.y};
        o = MFMA16(sfrag[kd], __builtin_bit_cast(bf16x8, qq), o); }
    return o;
}
__device__ __forceinline__ void phase(LAS unsigned char* lds, const bf16_t* Qt, const bf16_t* Kt, bf16_t* VO, const float* DEC, float* ss8, int bid, int G, int wave) {
    int lane_ = (int)__builtin_amdgcn_mbcnt_hi(~0u, __builtin_amdgcn_mbcnt_lo(~0u, 0u)); asm volatile("" : "+v"(lane_));
    const unsigned lane = (unsigned)lane_, tid = (unsigned)wave * 64u + lane, l15 = lane & 15u, g = lane >> 4, ql = l15 >> 2, p = lane & 3u;
    const unsigned vs = (unsigned)wave & 3u; const int th = wave >> 2, tA = th ? 1 : 0, tB = th ? 2 : 3;
    const unsigned ldsb = (unsigned)(uintptr_t)lds;
    const unsigned srow = tid >> 4, sch = tid & 15u, vrow = tid >> 3, vch = tid & 7u;
    for (int item = bid; item < BATCH * NHEAD * 2; item += G) {
        const int b = item >> 5, h = (item >> 1) & 15, half = item & 1;
        const size_t tokb = (size_t)b * SEQ;
        const bf16_t* qg = Qt + (tokb + srow) * DI + h * HD + sch * 8;
        const bf16_t* kg = Kt + (tokb + srow) * DI + h * HD + sch * 8;
        bf16_t* vg = VO + tokb * DI + h * HD + half * 64;
        f32x4 S[8]; bf16x8 sfrag[4];
#pragma unroll
        for (int i = 0; i < 8; ++i) S[i] = (f32x4){0.f, 0.f, 0.f, 0.f};
#pragma unroll
        for (int i = 0; i < 4; ++i) sfrag[i] = (bf16x8){0, 0, 0, 0, 0, 0, 0, 0};
        u32x4 rq0, rq1, rk0, rk1, rv; f32x4 rdec = (f32x4){0.f, 0.f, 0.f, 0.f};
        const float* dg = DEC + (size_t)(b * (SEQ / 64)) * DI + h * HD + (tid & 31u) * 4u;
#define SC_LOAD(n_) do { const size_t t0_ = (size_t)(n_) * 64; \
            rq0 = *(const u32x4*)(qg + t0_ * DI); rq1 = *(const u32x4*)(qg + (t0_ + 32) * DI); rk0 = *(const u32x4*)(kg + t0_ * DI); rk1 = *(const u32x4*)(kg + (t0_ + 32) * DI); \
            rv = *(const u32x4*)(vg + (t0_ + vrow) * DI + vch * 8); if (tid < 32u) rdec = *(const f32x4*)(dg + (size_t)(n_) * DI); } while (0)
#define SC_STORE(base_) do { *(LAS u32x4*)(lds + (base_) + offb(srow, sch)) = rq0; *(LAS u32x4*)(lds + (base_) + offb(srow + 32u, sch)) = rq1; \
            *(LAS u32x4*)(lds + (base_) + 16384u + offb(srow, sch)) = rk0; *(LAS u32x4*)(lds + (base_) + 16384u + offb(srow + 32u, sch)) = rk1; \
            *(LAS u32x4*)(lds + (base_) + 32768u + voffv(vrow, vch >> 1) + 16u * (vch & 1u)) = rv; \
            if (tid < 32u) *(LAS f32x4*)(lds + 81920u + ((base_) ? 512u : 0u) + tid * 16u) = rdec; } while (0)
        SC_LOAD(0); SC_STORE(0u); __syncthreads();
        for (int n = 0; n < SEQ / 64; ++n) {
            const unsigned QI = (unsigned)(n & 1) * 40960u, KI = QI + 16384u, VI = QI + 32768u;
            if (n + 1 < SEQ / 64) SC_LOAD(n + 1);
            const f32x4 oB = ttile<4>(lds, ldsb, QI, KI, VI, tB, sfrag, vs, l15, g, ql, p);
            const f32x4 oA = ttile<2>(lds, ldsb, QI, KI, VI, tA, sfrag, vs, l15, g, ql, p);
            {
                const bf16x8 vn0 = tr2(ldsb + VI + voffv(8u * g + ql, vs) + 8u * p, ldsb + VI + voffv(8u * g + 4u + ql, vs) + 8u * p);
                const bf16x8 vn1 = tr2(ldsb + VI + voffv(32u + 8u * g + ql, vs) + 8u * p, ldsb + VI + voffv(36u + 8u * g + ql, vs) + 8u * p);
                const LAS float* dcp = (const LAS float*)(lds + 81920u + (unsigned)(n & 1) * 512u) + 4u * g;
                const unsigned ka = ldsb + KI + offb(8u * g + ql, (p >> 1)) + 8u * (p & 1u), kb = ldsb + KI + offb(8u * g + 4u + ql, (p >> 1)) + 8u * (p & 1u);
#pragma unroll
                for (int i = 0; i < 8; i += 2) {
                    bf16x8 k00, k01, k10, k11;
                    tr8(ka ^ ((unsigned)i << 5), kb ^ ((unsigned)i << 5), ka ^ ((unsigned)(i + 1) << 5), kb ^ ((unsigned)(i + 1) << 5), k00, k01, k10, k11);
                    S[i] = MFMA16(k00, vn0, S[i]); S[i + 1] = MFMA16(k10, vn0, S[i + 1]); S[i] = MFMA16(k01, vn1, S[i]); S[i + 1] = MFMA16(k11, vn1, S[i + 1]); }
#pragma unroll
                for (int i = 0; i < 8; ++i) { const f32x4 dc = *(const LAS f32x4*)(dcp + 16 * i); S[i] = S[i] * dc; }
#pragma unroll
                for (int kd = 0; kd < 4; ++kd) sfrag[kd] = pack8(S[2 * kd], S[2 * kd + 1]);
            }
            if (n + 1 < SEQ / 64) SC_STORE((unsigned)((n + 1) & 1) * 40960u);
            {
                const size_t tlB = (size_t)n * 64 + 16u * (unsigned)tB + l15, tlA = (size_t)n * 64 + 16u * (unsigned)tA + l15;
                const u32x2 wB = {pkbf(oB[0], oB[1]), pkbf(oB[2], oB[3])}, wA = {pkbf(oA[0], oA[1]), pkbf(oA[2], oA[3])};
                *(u32x2*)(vg + tlB * DI + 16u * vs + 4u * g) = wB; *(u32x2*)(vg + tlA * DI + 16u * vs + 4u * g) = wA;
                float sB = (oB[0] * oB[0] + oB[1] * oB[1]) + (oB[2] * oB[2] + oB[3] * oB[3]), sA = (oA[0] * oA[0] + oA[1] * oA[1]) + (oA[2] * oA[2] + oA[3] * oA[3]);
                sB += xor_get(sB, (int)lane, 16); sA += xor_get(sA, (int)lane, 16); sB += xor_get(sB, (int)lane, 32); sA += xor_get(sA, (int)lane, 32);
                if (g == 0) { ss8[(tokb + tlB) * 128 + h * 8 + half * 4 + vs] = sB; ss8[(tokb + tlA) * 128 + h * 8 + half * 4 + vs] = sA; }
            }
            __syncthreads();
        }
#undef SC_LOAD
#undef SC_STORE
    }
}
#undef MFMA16
}

#define XB_TMO      128
#define XB_XCNT(j)  (256  + 64 * (j))
#define XB_XSUB(j)  (1280 + 64 * (j))
#define XB_XGEN(j)  (2304 + 64 * (j))
#define XB_TOP      3328
#define XB_TOPGEN   3392
#define XCD_BAR_WORDS 3456
#define XB_SPIN_CAP (1u << 18)
__device__ __forceinline__ unsigned xb_ld(unsigned* p)              { return __hip_atomic_load(p, __ATOMIC_RELAXED, __HIP_MEMORY_SCOPE_AGENT); }
__device__ __forceinline__ unsigned xb_add(unsigned* p, unsigned v) { return __hip_atomic_fetch_add(p, v, __ATOMIC_RELAXED, __HIP_MEMORY_SCOPE_AGENT); }
__device__ __forceinline__ unsigned xb_xcc_id() { return (unsigned)__builtin_amdgcn_s_getreg((3 << 11) | 20) & 0xFu; }
#define XB_SPIN(cond, bar) do { unsigned _sp = 0; while (cond) { __builtin_amdgcn_s_sleep(1); \
    if ((++_sp & 255u) == 0u) { if (xb_ld(&(bar)[XB_TMO])) break; if (_sp > XB_SPIN_CAP) { atomicAdd(&(bar)[XB_TMO], 1u); break; } } } } while (0)
struct XcdBarrier { unsigned* bar; unsigned x; volatile LAS unsigned* st; };
__device__ __forceinline__ XcdBarrier xcd_barrier_post(unsigned* bar, volatile LAS unsigned* st) {
    XcdBarrier b; b.bar = bar; b.x = xb_xcc_id(); b.st = st;
    if (threadIdx.x == 0) (void)xb_add(&bar[XB_XCNT(b.x)], 1u);
    return b;
}
__device__ __forceinline__ void xcd_barrier_complete(unsigned* bar, unsigned x, unsigned& nloc, unsigned& nx) {
    const unsigned G = gridDim.x * gridDim.y * gridDim.z;
    unsigned sum, cnt, mine, sp = 0u;
    for (;;) {
        sum = 0u; cnt = 0u; mine = 0u;
#pragma unroll
        for (unsigned j = 0; j < 16; ++j) { const unsigned c = xb_ld(&bar[XB_XCNT(j)]); sum += c; cnt += (c > 0u) ? 1u : 0u; mine = (j == x) ? c : mine; }
        if (sum == G) break;
        __builtin_amdgcn_s_sleep(1);
        if ((++sp & 255u) == 0u) { if (xb_ld(&bar[XB_TMO])) break; if (sp > XB_SPIN_CAP) { atomicAdd(&bar[XB_TMO], 1u); break; } }
    }
    nloc = mine > 0u ? mine : 1u; nx = cnt > 0u ? cnt : 1u;
}
__device__ __forceinline__ void xcd_barrier(const XcdBarrier& b) {
    asm volatile("s_waitcnt vmcnt(0)" ::: "memory");
    __syncthreads();
    if (threadIdx.x == 0) {
        unsigned* bar = b.bar;
        __builtin_amdgcn_s_waitcnt(0);
        unsigned nloc = b.st[0], nx = b.st[1];
        if (nloc == 0u) { xcd_barrier_complete(bar, b.x, nloc, nx); b.st[0] = nloc; b.st[1] = nx; }
        const unsigned old = xb_add(&bar[XB_XSUB(b.x)], 1u);
        const unsigned gen = old / nloc;
        if (old + 1u == (gen + 1u) * nloc) {
            __builtin_amdgcn_fence(__ATOMIC_RELEASE, "agent");
            asm volatile("s_waitcnt vmcnt(0)" ::: "memory");
            const unsigned og = xb_add(&bar[XB_TOP], 1u);
            const unsigned tg = og / nx;
            if (og + 1u == (tg + 1u) * nx) xb_add(&bar[XB_TOPGEN], 1u);
            else XB_SPIN(xb_ld(&bar[XB_TOPGEN]) == tg, bar);
            __builtin_amdgcn_fence(__ATOMIC_ACQUIRE, "agent");
            xb_add(&bar[XB_XGEN(b.x)], 1u);
            asm volatile("s_waitcnt vmcnt(0)" ::: "memory");
        } else {
            XB_SPIN(xb_ld(&bar[XB_XGEN(b.x)]) == gen, bar);
            __builtin_amdgcn_fence(__ATOMIC_ACQUIRE, "agent");
            asm volatile("s_waitcnt vmcnt(0)" ::: "memory");
        }
    }
    __syncthreads();
}

struct Args {
    const float* x; const float* norm_g; const float* pool_w_in; const float* pool_w_grp; const float* pool_scale; const float* pool_w_out;
    const float* hgrn_w_in; const float* hgrn_lb; const float* hgrn_norm_g; const float* hgrn_w_out; const float* final_g;
    float* out; unsigned char* ws;
};

__device__ __forceinline__ void transpose_item(const float* W, int K, int N, bf16_t* WT, int row_off, const float* ks, const float* ns, LAS float* scr, int item, int lane) {
    const int nblk = N / 32, kb = item / nblk, nb = item % nblk, k0 = 64 * kb, n0 = 32 * nb;
    const float nsv = ns ? ns[n0 + (lane & 31)] : 1.0f;
#pragma unroll 8
    for (int i = 0; i < 32; ++i) { const int kk = 2 * i + (lane >> 5); float w = W[(size_t)(k0 + kk) * N + n0 + (lane & 31)] * nsv; if (ks) w *= ks[k0 + kk]; scr[kk * 33 + (lane & 31)] = w; }
    asm volatile("s_waitcnt lgkmcnt(0)" ::: "memory");
    const int c = lane & 7;
#pragma unroll
    for (int j = 0; j < 4; ++j) { const int n = (lane >> 3) + 8 * j; const LAS float* s = scr + (8 * c) * 33 + n;
        u32x4 o; o.x = pk2(s[0 * 33], s[1 * 33]); o.y = pk2(s[2 * 33], s[3 * 33]); o.z = pk2(s[4 * 33], s[5 * 33]); o.w = pk2(s[6 * 33], s[7 * 33]);
        *(u32x4*)(WT + (size_t)(row_off + n0 + n) * K + k0 + 8 * c) = o; }
    asm volatile("s_waitcnt lgkmcnt(0)" ::: "memory");
}

__global__ void __launch_bounds__(512, 2) fwd_kernel(Args a) {
    extern __shared__ __attribute__((aligned(16))) unsigned char lds_raw[];
    LAS unsigned char* lds = (LAS unsigned char*)lds_raw;
    volatile LAS unsigned* xst = (volatile LAS unsigned*)(lds + 131072 + 64);
    if (threadIdx.x < 2) xst[threadIdx.x] = 0u;
    __syncthreads();
    const XcdBarrier xbar = xcd_barrier_post((unsigned*)a.ws, xst);
#define GRID_BAR() xcd_barrier(xbar)
    const int G = gridDim.x, bid = blockIdx.x;
    const int NGW = G * 8;
    const int wave = __builtin_amdgcn_readfirstlane((int)threadIdx.x >> 6);
#define PHASE_IDS int lane_ = (int)__builtin_amdgcn_mbcnt_hi(~0u, __builtin_amdgcn_mbcnt_lo(~0u, 0u)); asm volatile("" : "+v"(lane_)); const int lane = lane_, tid = wave * 64 + lane, gw = bid * 8 + wave; (void)gw; (void)tid;
    unsigned char* ws = a.ws;
    bf16_t* Wt_in0 = (bf16_t*)(ws + WS_WIN0); bf16_t* Wt_grp = (bf16_t*)(ws + WS_WGRP); bf16_t* Wt_out0 = (bf16_t*)(ws + WS_WOUT0);
    bf16_t* Wt_in1 = (bf16_t*)(ws + WS_WIN1); bf16_t* Wt_out1 = (bf16_t*)(ws + WS_WOUT1);
    float* part1 = (float*)(ws + WS_PART1); float* part2 = (float*)(ws + WS_PART2); float* ssb = (float*)(ws + WS_SS); float* decb = (float*)(ws + WS_DEC);
    bf16_t* XB = (bf16_t*)(ws + WS_XB); bf16_t* BA = (bf16_t*)(ws + WS_A); bf16_t* BB = (bf16_t*)(ws + WS_B); bf16_t* BC = (bf16_t*)(ws + WS_C);

    {
        PHASE_IDS
        LAS float* scr = (LAS float*)(lds + wave * 16384);
        constexpr int I_IN0 = (DM / 64) * (4096 / 32), I_GRP1 = (512 / 64) * (512 / 32), I_OUT = (DI / 64) * (DM / 32), I_IN1 = (DM / 64) * (8192 / 32);
        constexpr int NITEMS = I_IN0 + 4 * I_GRP1 + I_OUT + I_IN1 + I_OUT;
        for (int it = gw; it < NITEMS; it += NGW) {
            int r = it;
            if (r < I_IN0) { transpose_item(a.pool_w_in, DM, 4096, Wt_in0, 0, a.norm_g, nullptr, scr, r, lane); continue; } r -= I_IN0;
            if (r < 4 * I_GRP1) { const int g = r / I_GRP1; transpose_item(a.pool_w_grp + (size_t)g * 512 * 512, 512, 512, Wt_grp, g * 512, nullptr, a.pool_scale + g * 512, scr, r % I_GRP1, lane); continue; } r -= 4 * I_GRP1;
            if (r < I_OUT) { transpose_item(a.pool_w_out, DI, DM, Wt_out0, 0, nullptr, nullptr, scr, r, lane); continue; } r -= I_OUT;
            if (r < I_IN1) {
                const int n0 = 32 * (r % (8192 / 32)); int d0 = n0;
                if (n0 < 2048) d0 = 256 * (n0 >> 7) + (n0 & 127); else if (n0 < 4096) d0 = 256 * ((n0 - 2048) >> 7) + 128 + (n0 & 127);
                transpose_item(a.hgrn_w_in, DM, 8192, Wt_in1, d0 - n0, a.norm_g + DM, nullptr, scr, r, lane); continue; } r -= I_IN1;
            transpose_item(a.hgrn_w_out, DI, DM, Wt_out1, 0, a.hgrn_norm_g, nullptr, scr, r, lane);
        }
        for (int m = gw; m < M; m += NGW) {
            const f32x4* xr = (const f32x4*)(a.x + (size_t)m * DM) + lane;
            f32x4 v[4]; float s = 0.f;
#pragma unroll
            for (int j = 0; j < 4; ++j) { v[j] = xr[64 * j]; s += (v[j][0] * v[j][0] + v[j][1] * v[j][1]) + (v[j][2] * v[j][2] + v[j][3] * v[j][3]); }
            const float rstd = 1.0f / sqrtf(wave_sum(s, lane) * (1.0f / DM) + EPS);
            unsigned long long* o8 = (unsigned long long*)(XB + (size_t)m * DM) + lane;
#pragma unroll
            for (int j = 0; j < 4; ++j) o8[64 * j] = (unsigned long long)pk2(v[j][0] * rstd, v[j][1] * rstd) | ((unsigned long long)pk2(v[j][2] * rstd, v[j][3] * rstd) << 32);
        }
    }
    GRID_BAR();

    {
        pg8::Gemm g{XB, Wt_in0, DM, DM, DM, 0}; pg8::StaticOrder S; S.init(M, 4096, G, bid);
        pg8::EpiP1 E{BA, BB};
        pg8::gemm_phase<pg8::EpiP1>(lds, g, S, E, wave);
    }
    GRID_BAR();

    {
        PHASE_IDS
        constexpr int RUN = 64;
        const int nruns = (M / RUN) * (DI / 8);
        for (int idx = bid * 512 + tid; idx < nruns; idx += G * 512) {
            const int cgp = idx & 255, run = idx >> 8, grp = cgp >> 6, w = 2 << grp;
            const int m0 = run * RUN, t0 = m0 & (SEQ - 1);
            const bf16_t* vp = BA + (size_t)m0 * DI + cgp * 8; bf16_t* pp = BC + (size_t)m0 * DI + cgp * 8;
            float sum[8];
#pragma unroll
            for (int j = 0; j < 8; ++j) sum[j] = 0.f;
            if (t0 > 0) for (int k = 1; k < w; ++k) { const u32x4 vv = *(const u32x4*)(vp - (size_t)k * DI);
                sum[0] += bf_lo(vv.x); sum[1] += bf_hi(vv.x); sum[2] += bf_lo(vv.y); sum[3] += bf_hi(vv.y); sum[4] += bf_lo(vv.z); sum[5] += bf_hi(vv.z); sum[6] += bf_lo(vv.w); sum[7] += bf_hi(vv.w); }
#pragma unroll 4
            for (int i = 0; i < RUN; ++i) {
                const int t = t0 + i;
                const u32x4 vv = *(const u32x4*)(vp + (size_t)i * DI);
                float x[8] = {bf_lo(vv.x), bf_hi(vv.x), bf_lo(vv.y), bf_hi(vv.y), bf_lo(vv.z), bf_hi(vv.z), bf_lo(vv.w), bf_hi(vv.w)};
#pragma unroll
                for (int j = 0; j < 8; ++j) sum[j] += x[j];
                const int cnt = (t + 1) < w ? (t + 1) : w; const float inv = 1.0f / (float)cnt;
                u32x4 o; o.x = pkbf(sum[0] * inv - x[0], sum[1] * inv - x[1]); o.y = pkbf(sum[2] * inv - x[2], sum[3] * inv - x[3]);
                o.z = pkbf(sum[4] * inv - x[4], sum[5] * inv - x[5]); o.w = pkbf(sum[6] * inv - x[6], sum[7] * inv - x[7]);
                *(u32x4*)(pp + (size_t)i * DI) = o;
                if (t + 1 >= w) { const u32x4 uu = *(const u32x4*)(vp + (size_t)(i + 1 - w) * DI);
                    sum[0] -= bf_lo(uu.x); sum[1] -= bf_hi(uu.x); sum[2] -= bf_lo(uu.y); sum[3] -= bf_hi(uu.y); sum[4] -= bf_lo(uu.z); sum[5] -= bf_hi(uu.z); sum[6] -= bf_lo(uu.w); sum[7] -= bf_hi(uu.w); }
            }
        }
    }
    GRID_BAR();

    {
        pg8::Gemm g{BC, Wt_grp, DI, 512, 512, 2}; pg8::StaticOrder S; S.init(M, DI, G, bid);
        pg8::EpiP2 E{BB};
        pg8::gemm_phase<pg8::EpiP2>(lds, g, S, E, wave);
    }
    GRID_BAR();

    {
        pg8::Gemm g{BB, Wt_out0, DI, DI, DI, 0}; pg8::StaticOrder S; S.init(M, DM, G, bid);
        pg8::EpiRes<true> E{a.x, a.out, XB, part1};
        pg8::gemm_phase<pg8::EpiRes<true>>(lds, g, S, E, wave);
    }
    GRID_BAR();

    {
        pg8::Gemm g{XB, Wt_in1, DM, DM, DM, 0}; pg8::StaticOrder S; S.init(M, 6144, G, bid);
        pg8::EpiP4 E{BA, BB, BC, decb, part1, a.hgrn_lb};
        pg8::gemm_phase<pg8::EpiP4>(lds, g, S, E, wave);
    }
    GRID_BAR();

    scan::phase(lds, BA, BB, BC, decb, ssb, bid, G, wave);
    GRID_BAR();

    {
        pg8::Gemm g{XB, Wt_in1 + (size_t)6144 * DM, DM, DM, DM, 0}; pg8::StaticOrder S; S.init(M, DI, G, bid);
        pg8::EpiP5b E{BC, part1, ssb};
        pg8::gemm_phase<pg8::EpiP5b>(lds, g, S, E, wave);
    }
    GRID_BAR();

    {
        pg8::Gemm g{BC, Wt_out1, DI, DI, DI, 0}; pg8::StaticOrder S; S.init(M, DM, G, bid);
        pg8::EpiRes<false> E{a.out, a.out, nullptr, part2};
        pg8::gemm_phase<pg8::EpiRes<false>>(lds, g, S, E, wave);
    }
    GRID_BAR();

    {
        PHASE_IDS
        for (int m = gw; m < M; m += NGW) {
            const f32x4* p4 = (const f32x4*)(part2 + (size_t)m * 16); const f32x4 pa = p4[0], pb = p4[1], pc = p4[2], pd = p4[3]; const float p = (((pa[0] + pa[1]) + (pa[2] + pa[3])) + ((pb[0] + pb[1]) + (pb[2] + pb[3]))) + (((pc[0] + pc[1]) + (pc[2] + pc[3])) + ((pd[0] + pd[1]) + (pd[2] + pd[3])));
            const float rstd = 1.0f / sqrtf(p * (1.0f / DM) + EPS);
            f32x4* orow = (f32x4*)(a.out + (size_t)m * DM) + lane; const f32x4* gr = (const f32x4*)a.final_g + lane;
#pragma unroll
            for (int j = 0; j < 4; ++j) { f32x4 v = orow[64 * j]; const f32x4 gg = gr[64 * j]; v = v * rstd * gg; orow[64 * j] = v; }
        }
    }
}

extern "C" void kernel_launch(void* const* d_in, const int* in_sizes, int n_in, void* d_out, int out_size, void* d_ws, size_t ws_size, hipStream_t stream) {
    static int grid = 0;
    if (grid == 0) {
        if (n_in != 11 || in_sizes[0] != M * DM || out_size != M * DM || ws_size < WS_END) { fprintf(stderr, "kernel_launch: unexpected shapes (n_in %d in0 %d out %d ws %zu)\n", n_in, n_in > 0 ? in_sizes[0] : -1, out_size, ws_size); grid = -1; return; }
        int dev = 0, cus = 0, per = 0;
        if (hipGetDevice(&dev) != hipSuccess || hipDeviceGetAttribute(&cus, hipDeviceAttributeMultiprocessorCount, dev) != hipSuccess) { grid = -1; return; }
        if (hipFuncSetAttribute((const void*)fwd_kernel, hipFuncAttributeMaxDynamicSharedMemorySize, LDS_BYTES) != hipSuccess) { fprintf(stderr, "kernel_launch: hipFuncSetAttribute failed\n"); grid = -1; return; }
        if (hipOccupancyMaxActiveBlocksPerMultiprocessor(&per, (const void*)fwd_kernel, 512, LDS_BYTES) != hipSuccess || per < 1) { fprintf(stderr, "kernel_launch: occupancy query says %d\n", per); (void)hipGetLastError(); grid = -1; return; }
        grid = cus;
        fprintf(stderr, "kernel_launch: cus %d per_cu %d grid %d\n", cus, per, grid);
    }
    if (grid < 0) return;
    if (hipMemsetAsync(d_ws, 0, 16384, stream) != hipSuccess) { fprintf(stderr, "kernel_launch: hipMemsetAsync failed\n"); return; }
    Args a{};
    a.x = (const float*)d_in[0]; a.norm_g = (const float*)d_in[1]; a.pool_w_in = (const float*)d_in[2]; a.pool_w_grp = (const float*)d_in[3];
    a.pool_scale = (const float*)d_in[4]; a.pool_w_out = (const float*)d_in[5]; a.hgrn_w_in = (const float*)d_in[6]; a.hgrn_lb = (const float*)d_in[7];
    a.hgrn_norm_g = (const float*)d_in[8]; a.hgrn_w_out = (const float*)d_in[9]; a.final_g = (const float*)d_in[10];
    a.out = (float*)d_out; a.ws = (unsigned char*)d_ws;
    void* args[] = {&a};
    hipError_t e = hipLaunchCooperativeKernel((void*)fwd_kernel, dim3(grid), dim3(512), args, LDS_BYTES, stream);
    if (e != hipSuccess) fprintf(stderr, "kernel_launch: cooperative launch failed: %s (grid %d)\n", hipGetErrorString(e), grid);
}
```

```cpp
#include <hip/hip_runtime.h>
#include <hip/hip_cooperative_groups.h>
#include <cstdio>
#include <cstdint>
namespace cg = cooperative_groups;

#define LAS __attribute__((address_space(3)))
typedef unsigned short bf16_t;
typedef short bf16x8 __attribute__((ext_vector_type(8)));
typedef float f32x4 __attribute__((ext_vector_type(4)));
typedef float f32x2 __attribute__((ext_vector_type(2)));
typedef unsigned u32x4 __attribute__((ext_vector_type(4)));
typedef unsigned u32x2 __attribute__((ext_vector_type(2)));

constexpr int DM = 1024, BATCH = 8, SEQ = 4096, DI = 2048, M = BATCH * SEQ;
constexpr int NHEAD = 16, HD = 128;
constexpr float EPS = 1e-6f;
constexpr size_t MiB = 1u << 20;
constexpr size_t WS_WIN0 = 2 * MiB;
constexpr size_t WS_WGRP = 10 * MiB;
constexpr size_t WS_WOUT0 = 12 * MiB;
constexpr size_t WS_WIN1 = 16 * MiB;
constexpr size_t WS_WOUT1 = 32 * MiB;
constexpr size_t WS_PART1 = 36 * MiB;
constexpr size_t WS_PART2 = 38 * MiB;
constexpr size_t WS_DEC = 44 * MiB;
constexpr size_t WS_SS = 112 * MiB;
constexpr size_t WS_XB = 48 * MiB;
constexpr size_t WS_A = 128 * MiB;
constexpr size_t WS_B = 256 * MiB;
constexpr size_t WS_C = 384 * MiB;
constexpr size_t WS_END = 512 * MiB;
constexpr int LDS_BYTES = 147456;

__device__ __forceinline__ unsigned f2bf(float f) { unsigned u = __builtin_bit_cast(unsigned, f); return (u + 0x7fffu + ((u >> 16) & 1u)) >> 16; }
__device__ __forceinline__ unsigned pk2(float lo, float hi) { return f2bf(lo) | (f2bf(hi) << 16); }
typedef __bf16 bf2_t __attribute__((ext_vector_type(2)));
__device__ __forceinline__ unsigned pkbf(float lo, float hi) { f32x2 v = {lo, hi}; return __builtin_bit_cast(unsigned, __builtin_convertvector(v, bf2_t)); }
__device__ __forceinline__ float bf_lo(unsigned w) { return __builtin_bit_cast(float, w << 16); }
__device__ __forceinline__ float bf_hi(unsigned w) { return __builtin_bit_cast(float, w & 0xffff0000u); }
__device__ __forceinline__ float silu_f(float x) { return x * __builtin_amdgcn_rcpf(1.0f + __builtin_amdgcn_exp2f(-1.44269504089f * x)); }
__device__ __forceinline__ float lane_get(float v, int src_lane) { return __builtin_bit_cast(float, __builtin_amdgcn_ds_bpermute(src_lane << 2, __builtin_bit_cast(int, v))); }
__device__ __forceinline__ float xor_get(float v, int lane, int m) { return lane_get(v, lane ^ m); }
__device__ __forceinline__ float wave_sum(float v, int lane) {
#pragma unroll
    for (int o = 1; o < 64; o <<= 1) v += xor_get(v, lane, o);
    return v;
}

namespace pg8 {
constexpr int BM = 256, BK = 64, HALF = 128, HTB = HALF * BK * 2, STAGE_BYTES = 8 * HTB, NXCD = 8, WGM = 8;
__host__ __device__ __forceinline__ int lds_byte(int r, int c) { const int st = (r >> 4) * 2 + (c >> 5), rr = r & 15, cc = c & 31, ob = rr * 64 + cc * 2; return st * 1024 + (ob ^ (((ob >> 9) & 1) << 5)); }
__host__ __device__ __forceinline__ void stage_rc(int b, int& R, int& C) { const int st = b / 1024, sb = b % 1024, swz = sb ^ (((sb >> 9) & 1) << 5); R = (st >> 1) * 16 + swz / 64; C = (st & 1) * 32 + (swz % 64) / 2; }
__host__ __device__ __forceinline__ int perm32(int rho) { const int n = rho >> 4, i = rho & 15; return 8 * (i >> 2) + 4 * n + (i & 3); }

struct Unit { int pm, pn; };
struct Gemm { const bf16_t* A; const bf16_t* Bt; int lda, ldb, K, grp_tiles; };

struct StaticOrder {
    int nM, nN, nwg, G, c;
    __host__ __device__ void init(int M_, int N_, int G_, int c_) { nM = M_ / BM; nN = N_ / BM; nwg = nM * nN; G = G_; c = c_; }
    __host__ __device__ bool next(int i, Unit& u) const {
        const long L = (long)i * G + c; if (L >= nwg) return false;
        int wgid = (int)L; { const int q = nwg / NXCD, r = nwg % NXCD, xcd = wgid % NXCD, off = wgid / NXCD; wgid = (xcd < r ? xcd * (q + 1) : r * (q + 1) + (xcd - r) * q) + off; }
        const int nig = WGM * nN, gid = wgid / nig, fm = gid * WGM, gsz = (nM - fm) < WGM ? (nM - fm) : WGM;
        u.pm = fm + ((wgid % nig) % gsz); u.pn = (wgid % nig) / gsz; return true;
    }
};

__device__ __forceinline__ unsigned cvt_pk_bf16(float lo, float hi) { unsigned r; asm volatile("v_cvt_pk_bf16_f32 %0, %1, %2" : "=v"(r) : "v"(lo), "v"(hi)); return r; }

template <class Epi, bool ALIGN_EPI = true, bool SP2 = true>
__device__ __forceinline__ void gemm_phase(LAS unsigned char* lds, const Gemm g, const StaticOrder& S, const Epi& E, const int wid) {
    int lane_ = (int)__builtin_amdgcn_mbcnt_hi(~0u, __builtin_amdgcn_mbcnt_lo(~0u, 0u)); asm volatile("" : "+v"(lane_));
    int lane = lane_, tid = wid * 64 + lane, fr = lane & 15, fq = lane >> 4; const int wr = wid >> 2, wc = wid & 3;
    const int K = g.K, nt = K / BK;
    unsigned voffA[2], voffB[2]; int aoff, boff;
#define PG8_LANE_STATE() do { _Pragma("unroll") for (int i = 0; i < 2; ++i) { int R, C; stage_rc(tid * 16 + i * 8192, R, C); const int Rb = Epi::PERM ? ((R & ~31) + perm32(R & 31)) : R; \
        voffA[i] = (unsigned)(R * g.lda + C) * 2u; voffB[i] = (unsigned)(Rb * g.ldb + C) * 2u; } \
        aoff = lds_byte(wr * 64 + fr, fq * 8); boff = lds_byte(wc * 32 + fr, fq * 8); } while (0)
    PG8_LANE_STATE();
    const size_t kstep = (size_t)(BK * 2);
    const size_t hstepA = (size_t)HALF * g.lda * 2, hstepB = (size_t)HALF * g.ldb * 2;
    const size_t tstepA = 2 * hstepA, tstepB = 2 * hstepB;
    const unsigned ldsw = (unsigned)wid * 1024u;
#define PG8_SA(b, h) (((b) * 2 + (h)) * HTB)
#define PG8_SB(b, h) ((4 + (b) * 2 + (h)) * HTB)
#define PG8_STAGE(bufoff, gbase, voff) do { _Pragma("unroll") for (int _i = 0; _i < 2; ++_i) \
        __builtin_amdgcn_global_load_lds((const unsigned*)((const char*)(gbase) + (voff)[_i]), (LAS unsigned*)(lds + (bufoff) + ldsw + _i * 8192), 16, 0, 0); } while (0)
#define PG8_LDA(dst, b, h) do { _Pragma("unroll") for (int m = 0; m < 4; ++m) _Pragma("unroll") for (int k = 0; k < 2; ++k) dst[m][k] = *(const LAS bf16x8*)(lds + PG8_SA(b, h) + aoff + m * 2048 + k * 1024); } while (0)
#define PG8_LDB(dst, b, h) do { _Pragma("unroll") for (int n = 0; n < 2; ++n) _Pragma("unroll") for (int k = 0; k < 2; ++k) dst[n][k] = *(const LAS bf16x8*)(lds + PG8_SB(b, h) + boff + n * 2048 + k * 1024); } while (0)
#define PG8_MMA(ai, bj, At, Bt) do { __builtin_amdgcn_s_setprio(1); _Pragma("unroll") for (int m = 0; m < 4; ++m) _Pragma("unroll") for (int n = 0; n < 2; ++n) _Pragma("unroll") for (int k = 0; k < 2; ++k) \
        acc[ai][bj][m][n] = __builtin_amdgcn_mfma_f32_16x16x32_bf16(Bt[n][k], At[m][k], acc[ai][bj][m][n], 0, 0, 0); __builtin_amdgcn_s_setprio(0); } while (0)
#define PG8_WAIT_V(n) asm volatile("s_waitcnt vmcnt(" #n ")" ::: "memory")
#define PG8_WAIT_L(n) asm volatile("s_waitcnt lgkmcnt(" #n ")" ::: "memory")
#define PG8_BAR __builtin_amdgcn_s_barrier()
#define PG8_SCHED __builtin_amdgcn_sched_barrier(0)
#define PG8_ABASE(u) ((const char*)g.A + (size_t)(u).pm * tstepA + (g.grp_tiles ? (size_t)((u).pn / g.grp_tiles) * (size_t)K * 2 : (size_t)0))
#define PG8_BBASE(u) ((const char*)g.Bt + (size_t)(u).pn * tstepB)
    Unit cur, nxt; int ui = 0;
    E.prologue(S, lds, tid);
    if (!S.next(0, cur)) return;
    f32x4 acc[2][2][4][2];
#pragma unroll
    for (int a = 0; a < 2; ++a)
#pragma unroll
        for (int b = 0; b < 2; ++b)
#pragma unroll
            for (int m = 0; m < 4; ++m)
#pragma unroll
                for (int n = 0; n < 2; ++n) acc[a][b][m][n] = (f32x4){0.f, 0.f, 0.f, 0.f};
    bf16x8 At[4][2], B0[2][2], B1[2][2];
    const char* cA = PG8_ABASE(cur); const char* cB = PG8_BBASE(cur);
    if constexpr (SP2) {
        PG8_STAGE(PG8_SB(0, 0), cB, voffB); PG8_STAGE(PG8_SB(0, 1), cB + hstepB, voffB); PG8_STAGE(PG8_SA(0, 0), cA, voffA); PG8_STAGE(PG8_SA(0, 1), cA + hstepA, voffA);
        if (wr == 1) PG8_BAR;
        PG8_WAIT_V(2); PG8_BAR;
        PG8_STAGE(PG8_SB(1, 0), cB + kstep, voffB); PG8_STAGE(PG8_SA(1, 0), cA + kstep, voffA); PG8_STAGE(PG8_SB(1, 1), cB + hstepB + kstep, voffB);
        PG8_WAIT_V(6); PG8_BAR;
    } else {
        PG8_STAGE(PG8_SB(0, 0), cB, voffB); PG8_STAGE(PG8_SA(0, 0), cA, voffA); PG8_STAGE(PG8_SB(0, 1), cB + hstepB, voffB); PG8_STAGE(PG8_SA(0, 1), cA + hstepA, voffA);
        if (wr == 1) PG8_BAR;
        PG8_WAIT_V(4); PG8_BAR;
        PG8_STAGE(PG8_SB(1, 0), cB + kstep, voffB); PG8_STAGE(PG8_SA(1, 0), cA + kstep, voffA); PG8_STAGE(PG8_SB(1, 1), cB + hstepB + kstep, voffB);
        PG8_WAIT_V(6); PG8_BAR;
    }
    for (;;) {
        const bool has_next = S.next(ui + 1, nxt);
        const char* nA = has_next ? PG8_ABASE(nxt) : cA; const char* nB = has_next ? PG8_BBASE(nxt) : cB;
        for (int t = 0; t < nt; t += 2) {
            const bool last = (t == nt - 2);
            const char* a1 = cA + (size_t)(t + 1) * kstep;
            const char* a2 = last ? nA : cA + (size_t)(t + 2) * kstep; const char* b2 = last ? nB : cB + (size_t)(t + 2) * kstep;
            const char* a3 = a2 + kstep; const char* b3 = b2 + kstep;
            if constexpr (SP2) {
            PG8_LDB(B0, 0, 0); PG8_LDB(B1, 0, 1); PG8_SCHED; PG8_LDA(At, 0, 0); PG8_STAGE(PG8_SA(1, 1), a1 + hstepA, voffA);
            PG8_WAIT_V(8); PG8_WAIT_L(0); PG8_BAR; PG8_MMA(0, 0, At, B0); PG8_MMA(0, 1, At, B1); PG8_BAR; PG8_SCHED;
            PG8_LDA(At, 0, 1); PG8_STAGE(PG8_SB(0, 0), b2, voffB); PG8_STAGE(PG8_SB(0, 1), b2 + hstepB, voffB); PG8_STAGE(PG8_SA(0, 0), a2, voffA);
            PG8_WAIT_V(8); PG8_WAIT_L(0); PG8_BAR; PG8_MMA(1, 0, At, B0); PG8_MMA(1, 1, At, B1); PG8_BAR; PG8_SCHED;
            PG8_LDB(B0, 1, 0); PG8_LDB(B1, 1, 1); PG8_SCHED; PG8_LDA(At, 1, 0); PG8_STAGE(PG8_SA(0, 1), a2 + hstepA, voffA);
            PG8_WAIT_V(8); PG8_WAIT_L(0); PG8_BAR; PG8_MMA(0, 0, At, B0); PG8_MMA(0, 1, At, B1); PG8_BAR; PG8_SCHED;
            PG8_LDA(At, 1, 1); PG8_STAGE(PG8_SB(1, 0), b3, voffB); PG8_STAGE(PG8_SB(1, 1), b3 + hstepB, voffB); PG8_STAGE(PG8_SA(1, 0), a3, voffA);
            PG8_WAIT_V(8); PG8_WAIT_L(0); PG8_BAR; PG8_MMA(1, 0, At, B0); PG8_MMA(1, 1, At, B1); PG8_BAR; PG8_SCHED;
            } else {
            PG8_LDB(B0, 0, 0); PG8_SCHED; PG8_LDA(At, 0, 0); PG8_STAGE(PG8_SA(1, 1), a1 + hstepA, voffA);
            PG8_WAIT_L(8); PG8_BAR; PG8_WAIT_L(0); PG8_MMA(0, 0, At, B0); PG8_BAR; PG8_SCHED;
            PG8_LDB(B1, 0, 1); PG8_STAGE(PG8_SB(0, 0), b2, voffB);
            PG8_BAR; PG8_WAIT_L(0); PG8_MMA(0, 1, At, B1); PG8_BAR;
            PG8_LDA(At, 0, 1); PG8_STAGE(PG8_SA(0, 0), a2, voffA);
            PG8_BAR; PG8_WAIT_L(0); PG8_MMA(1, 0, At, B0); PG8_BAR; PG8_SCHED;
            PG8_STAGE(PG8_SB(0, 1), b2 + hstepB, voffB);
            PG8_WAIT_V(6); PG8_BAR; PG8_MMA(1, 1, At, B1); PG8_BAR;
            PG8_LDB(B0, 1, 0); PG8_SCHED; PG8_LDA(At, 1, 0); PG8_STAGE(PG8_SA(0, 1), a2 + hstepA, voffA);
            PG8_WAIT_L(8); PG8_BAR; PG8_WAIT_L(0); PG8_MMA(0, 0, At, B0); PG8_BAR; PG8_SCHED;
            PG8_LDB(B1, 1, 1); PG8_STAGE(PG8_SB(1, 0), b3, voffB);
            PG8_BAR; PG8_WAIT_L(0); PG8_MMA(0, 1, At, B1); PG8_BAR;
            PG8_LDA(At, 1, 1); PG8_STAGE(PG8_SA(1, 0), a3, voffA);
            PG8_BAR; PG8_WAIT_L(0); PG8_MMA(1, 0, At, B0); PG8_BAR; PG8_SCHED;
            PG8_STAGE(PG8_SB(1, 1), b3 + hstepB, voffB);
            PG8_WAIT_V(6); PG8_BAR; PG8_MMA(1, 1, At, B1); PG8_BAR;
            }
        }
        if constexpr (ALIGN_EPI) { if (wr == 0) PG8_BAR; }
        if constexpr (!Epi::AFTER_DRAIN) E(acc, cur, wr, wc, fr, fq, lds, ui);
        if (!has_next) break;
#pragma unroll
        for (int a = 0; a < 2; ++a)
#pragma unroll
            for (int b = 0; b < 2; ++b)
#pragma unroll
                for (int m = 0; m < 4; ++m)
#pragma unroll
                    for (int n = 0; n < 2; ++n) acc[a][b][m][n] = (f32x4){0.f, 0.f, 0.f, 0.f};
        cur = nxt; cA = nA; cB = nB; ++ui;
        asm volatile("" : "+v"(lane)); tid = wid * 64 + lane; fr = lane & 15; fq = lane >> 4; PG8_LANE_STATE();
        if constexpr (ALIGN_EPI) { if (wr == 1) PG8_BAR; }
    }
    PG8_WAIT_V(0);
    if constexpr (!ALIGN_EPI) { if (wr == 0) PG8_BAR; }
    PG8_BAR;
    if constexpr (Epi::AFTER_DRAIN) E.fused(acc, cur, wr, wc, fr, fq, lds, tid);
#undef PG8_SA
#undef PG8_SB
#undef PG8_STAGE
#undef PG8_LDA
#undef PG8_LDB
#undef PG8_MMA
#undef PG8_WAIT_V
#undef PG8_WAIT_L
#undef PG8_BAR
#undef PG8_SCHED
#undef PG8_ABASE
#undef PG8_LANE_STATE
#undef PG8_BBASE
}

struct EpiP1 {
    static constexpr bool PERM = true, AFTER_DRAIN = false;
    __device__ __forceinline__ void prologue(const StaticOrder&, LAS unsigned char*, int) const {}
    bf16_t* V; bf16_t* SG;
    __device__ __forceinline__ void operator()(f32x4 (&acc)[2][2][4][2], const Unit& u, int wr, int wc, int fr, int fq, LAS unsigned char* lds, int ui) const {
        const int row0 = u.pm * BM + wr * 64 + fr; const bool gate = u.pn >= 8;
        bf16_t* base = gate ? SG : V; const int col0 = (u.pn & 7) * BM + wc * 32 + 8 * fq;
#pragma unroll
        for (int ai = 0; ai < 2; ++ai)
#pragma unroll
            for (int m = 0; m < 4; ++m) { bf16_t* rowp = base + (size_t)(row0 + ai * HALF + m * 16) * DI + col0;
#pragma unroll
                for (int bj = 0; bj < 2; ++bj) { f32x4 v0 = acc[ai][bj][m][0], v1 = acc[ai][bj][m][1];
                    if (gate) {
#pragma unroll
                        for (int j = 0; j < 4; ++j) { v0[j] = silu_f(v0[j]); v1[j] = silu_f(v1[j]); } }
                    u32x4 w; w.x = cvt_pk_bf16(v0[0], v0[1]); w.y = cvt_pk_bf16(v0[2], v0[3]); w.z = cvt_pk_bf16(v1[0], v1[1]); w.w = cvt_pk_bf16(v1[2], v1[3]);
                    *(u32x4*)(rowp + bj * HALF) = w; } }
    }
};
struct EpiP2 {
    static constexpr bool PERM = true, AFTER_DRAIN = false;
    __device__ __forceinline__ void prologue(const StaticOrder&, LAS unsigned char*, int) const {}
    bf16_t* Z;
    __device__ __forceinline__ void operator()(f32x4 (&acc)[2][2][4][2], const Unit& u, int wr, int wc, int fr, int fq, LAS unsigned char* lds, int ui) const {
        const int row0 = u.pm * BM + wr * 64 + fr; const int col0 = u.pn * BM + wc * 32 + 8 * fq;
#pragma unroll
        for (int ai = 0; ai < 2; ++ai)
#pragma unroll
            for (int m = 0; m < 4; ++m) { bf16_t* rowp = Z + (size_t)(row0 + ai * HALF + m * 16) * DI + col0;
#pragma unroll
                for (int bj = 0; bj < 2; ++bj) { const f32x4 v0 = acc[ai][bj][m][0], v1 = acc[ai][bj][m][1];
                    const u32x4 s = *(const u32x4*)(rowp + bj * HALF);
                    u32x4 w; w.x = cvt_pk_bf16(v0[0] * bf_lo(s.x), v0[1] * bf_hi(s.x)); w.y = cvt_pk_bf16(v0[2] * bf_lo(s.y), v0[3] * bf_hi(s.y));
                    w.z = cvt_pk_bf16(v1[0] * bf_lo(s.z), v1[1] * bf_hi(s.z)); w.w = cvt_pk_bf16(v1[2] * bf_lo(s.w), v1[3] * bf_hi(s.w));
                    *(u32x4*)(rowp + bj * HALF) = w; } }
    }
};
template <bool WRITE_HB> struct EpiRes {
    static constexpr bool PERM = false, AFTER_DRAIN = false;
    __device__ __forceinline__ void prologue(const StaticOrder&, LAS unsigned char*, int) const {}
    const float* R; float* H; bf16_t* HB; float* part;
    __device__ __forceinline__ void operator()(f32x4 (&acc)[2][2][4][2], const Unit& u, int wr, int wc, int fr, int fq, LAS unsigned char* lds, int ui) const {
        const unsigned row0 = (unsigned)(u.pm * BM + wr * 64 + fr), col0 = (unsigned)(u.pn * BM + wc * 32 + 4 * fq);
        const unsigned ofs = (row0 * DM + col0) * 4u, pofs = (row0 * 16u + (unsigned)(u.pn * 4 + wc)) * 4u;
#pragma unroll
        for (int ai = 0; ai < 2; ++ai)
#pragma unroll
            for (int m = 0; m < 4; ++m) { const unsigned o = ofs + (unsigned)((ai * HALF + m * 16) * DM) * 4u; float ss = 0.f;
#pragma unroll
                for (int bj = 0; bj < 2; ++bj)
#pragma unroll
                    for (int n = 0; n < 2; ++n) { const unsigned oo = o + (unsigned)(bj * HALF + n * 16) * 4u;
                        const f32x4 xv = *(const f32x4*)((const char*)R + oo); const f32x4 h = xv + acc[ai][bj][m][n];
                        *(f32x4*)((char*)H + oo) = h; ss += (h[0] * h[0] + h[1] * h[1]) + (h[2] * h[2] + h[3] * h[3]);
                        if (WRITE_HB) { u32x2 w; w.x = pkbf(h[0], h[1]); w.y = pkbf(h[2], h[3]); *(u32x2*)((char*)HB + (oo >> 1)) = w; } }
                ss += xor_get(ss, fq * 16 + fr, 16); ss += xor_get(ss, fq * 16 + fr, 32);
                if (fq == 0) *(float*)((char*)part + (pofs + (unsigned)(ai * HALF + m * 16) * 64u)) = ss;
                asm volatile("" ::: "memory"); }
    }
};
__device__ __forceinline__ float row_rstd_b(const float* part, unsigned bofs) {
    const f32x4* p = (const f32x4*)((const char*)part + bofs); const f32x4 a = p[0], b = p[1], c = p[2], d = p[3];
    return __builtin_amdgcn_rsqf((((a[0] + a[1]) + (a[2] + a[3])) + ((b[0] + b[1]) + (b[2] + b[3])) + ((c[0] + c[1]) + (c[2] + c[3])) + ((d[0] + d[1]) + (d[2] + d[3]))) * (1.0f / DM) + EPS);
}
__device__ __forceinline__ float dpp_shr_mul(float v, const int n) {
    const int iv = __builtin_bit_cast(int, v), one = 0x3f800000; int r;
    if (n == 1) r = __builtin_amdgcn_update_dpp(one, iv, 0x111, 0xf, 0xf, false); else if (n == 2) r = __builtin_amdgcn_update_dpp(one, iv, 0x112, 0xf, 0xf, false);
    else if (n == 4) r = __builtin_amdgcn_update_dpp(one, iv, 0x114, 0xf, 0xf, false); else r = __builtin_amdgcn_update_dpp(one, iv, 0x118, 0xf, 0xf, false);
    return v * __builtin_bit_cast(float, r);
}
constexpr unsigned TAB_OFF = 131072u + 256u;
struct EpiP4 {
    static constexpr bool PERM = true, AFTER_DRAIN = false;
    bf16_t* Qt; bf16_t* Kt; bf16_t* V; float* DEC; const float* part; const float* lbnd;
    __device__ __forceinline__ void prologue(const StaticOrder& S, LAS unsigned char* lds, int tid) const {
        LAS float* T = (LAS float*)(lds + TAB_OFF); Unit u;
        for (int i = 0; i < 12 && S.next(i, u); ++i)
            if (tid < 256) T[i * 256 + tid] = row_rstd_b(part, (unsigned)(u.pm * BM + tid) * 64u);
        __syncthreads();
    }
    __device__ __forceinline__ void operator()(f32x4 (&acc)[2][2][4][2], const Unit& u, int wr, int wc, int fr, int fq, LAS unsigned char* lds, int ui) const {
        const unsigned row0 = (unsigned)(u.pm * BM + wr * 64 + fr);
        const LAS float* T = (const LAS float*)(lds + TAB_OFF) + ui * 256 + wr * 64 + fr;
        if (u.pn >= 16) {
            const unsigned vofs = (row0 * DI + (unsigned)((u.pn - 16) * BM + wc * 32 + 8 * fq)) * 2u;
#pragma unroll
            for (int ai = 0; ai < 2; ++ai)
#pragma unroll
                for (int m = 0; m < 4; ++m) { const float rs = T[ai * HALF + m * 16];
#pragma unroll
                    for (int bj = 0; bj < 2; ++bj) { const f32x4 v0 = acc[ai][bj][m][0] * rs, v1 = acc[ai][bj][m][1] * rs;
                        u32x4 w; w.x = pkbf(v0[0], v0[1]); w.y = pkbf(v0[2], v0[3]); w.z = pkbf(v1[0], v1[1]); w.w = pkbf(v1[2], v1[3]);
                        *(u32x4*)((char*)V + (vofs + (unsigned)((ai * HALF + m * 16) * DI + bj * HALF) * 2u)) = w; } }
            return;
        }
        const unsigned c0 = (unsigned)(u.pn * HD + wc * 32 + 8 * fq);
        const unsigned qofs = (row0 * DI + c0) * 2u;
#pragma unroll
        for (int ai = 0; ai < 2; ++ai) {
            float rs[4];
#pragma unroll
            for (int m = 0; m < 4; ++m) rs[m] = T[ai * HALF + m * 16];
            unsigned cc = c0; asm volatile("" : "+v"(cc));
#pragma unroll
            for (int n = 0; n < 2; ++n) {
                const f32x4 l0 = *(const f32x4*)((const char*)lbnd + (cc + 4 * n) * 4u), l1 = *(const f32x4*)((const char*)lbnd + (cc + 4 * n + DI) * 4u);
                f32x4 decv;
#pragma unroll
                for (int j = 0; j < 4; ++j) { const float ex = __expf(l0[j] - l1[j]); const float lb = __builtin_amdgcn_rcpf(1.0f + ex), omlb = ex * lb; float bprod = 1.0f;
#pragma unroll
                    for (int m = 0; m < 4; ++m) {
                        const float qv = acc[ai][0][m][n][j] * rs[m], z = acc[ai][1][m][n][j] * rs[m];
                        const float sg = __builtin_amdgcn_rcpf(1.0f + __builtin_amdgcn_exp2f(-1.44269504089f * z));
                        const float f = lb + omlb * sg, k = omlb * (1.0f - sg);
                        float s = f; s = dpp_shr_mul(s, 1); s = dpp_shr_mul(s, 2); s = dpp_shr_mul(s, 4); s = dpp_shr_mul(s, 8);
                        const float E = bprod * s;
                        if (m < 3) bprod *= lane_get(s, fq * 16 + 15);
                        const float Ei = __builtin_amdgcn_rcpf(fmaxf(E, 7.9e-31f));
                        acc[ai][0][m][n][j] = qv * E; acc[ai][1][m][n][j] = k * Ei;
                        if (m == 3) decv[j] = E;
                    } }
                if (fr == 15) *(f32x4*)((char*)DEC + ((unsigned)(u.pm * 4 + ai * 2 + wr) * DI + cc + 4 * n) * 4u) = decv;
            }
#pragma unroll
            for (int m = 0; m < 4; ++m) { const unsigned ob = qofs + (unsigned)((ai * HALF + m * 16) * DI) * 2u;
                u32x4 w; w.x = pkbf(acc[ai][0][m][0][0], acc[ai][0][m][0][1]); w.y = pkbf(acc[ai][0][m][0][2], acc[ai][0][m][0][3]); w.z = pkbf(acc[ai][0][m][1][0], acc[ai][0][m][1][1]); w.w = pkbf(acc[ai][0][m][1][2], acc[ai][0][m][1][3]);
                *(u32x4*)((char*)Qt + ob) = w;
                u32x4 x; x.x = pkbf(acc[ai][1][m][0][0], acc[ai][1][m][0][1]); x.y = pkbf(acc[ai][1][m][0][2], acc[ai][1][m][0][3]); x.z = pkbf(acc[ai][1][m][1][0], acc[ai][1][m][1][1]); x.w = pkbf(acc[ai][1][m][1][2], acc[ai][1][m][1][3]);
                *(u32x4*)((char*)Kt + ob) = x; }
            asm volatile("" ::: "memory");
        }
    }
};
struct EpiP5b {
    static constexpr bool PERM = true, AFTER_DRAIN = false;
    bf16_t* O; const float* part; const float* ss;
    __device__ __forceinline__ void prologue(const StaticOrder& S, LAS unsigned char* lds, int tid) const {
        LAS float* T = (LAS float*)(lds + TAB_OFF); Unit u;
        for (int i = 0; i < 4 && S.next(i, u); ++i) {
            if (tid < 256) T[i * 768 + tid] = row_rstd_b(part, (unsigned)(u.pm * BM + tid) * 64u);
            { const int r = tid >> 1, hh = tid & 1; const f32x4* sp = (const f32x4*)(ss + (size_t)(u.pm * BM + r) * 128 + (u.pn * 2 + hh) * 8); const f32x4 s0 = sp[0], s1 = sp[1];
              T[i * 768 + 256 + tid] = __builtin_amdgcn_rsqf((((s0[0] + s0[1]) + (s0[2] + s0[3])) + ((s1[0] + s1[1]) + (s1[2] + s1[3]))) * (1.0f / HD) + EPS); }
        }
        __syncthreads();
    }
    __device__ __forceinline__ void operator()(f32x4 (&acc)[2][2][4][2], const Unit& u, int wr, int wc, int fr, int fq, LAS unsigned char* lds, int ui) const {
        const unsigned row0 = (unsigned)(u.pm * BM + wr * 64 + fr), col0 = (unsigned)(u.pn * BM + wc * 32 + 8 * fq);
        const LAS float* T = (const LAS float*)(lds + TAB_OFF) + ui * 768 + wr * 64 + fr;
        const unsigned oofs = (row0 * DI + col0) * 2u;
#pragma unroll
        for (int ai = 0; ai < 2; ++ai) {
            u32x4 ov[4][2];
#pragma unroll
            for (int m = 0; m < 4; ++m)
#pragma unroll
                for (int bj = 0; bj < 2; ++bj) ov[m][bj] = *(const u32x4*)((const char*)O + (oofs + (unsigned)((ai * HALF + m * 16) * DI + bj * HALF) * 2u));
#pragma unroll
            for (int m = 0; m < 4; ++m) { const int rl = ai * HALF + m * 16; const float rs = T[rl];
#pragma unroll
                for (int bj = 0; bj < 2; ++bj) { const f32x4 v0 = acc[ai][bj][m][0] * rs, v1 = acc[ai][bj][m][1] * rs;
                    const float rh = T[256 + 2 * rl + bj + (wr * 64 + fr)];
                    const u32x4 s = ov[m][bj];
                    u32x4 w; w.x = pkbf(bf_lo(s.x) * rh * silu_f(v0[0]), bf_hi(s.x) * rh * silu_f(v0[1])); w.y = pkbf(bf_lo(s.y) * rh * silu_f(v0[2]), bf_hi(s.y) * rh * silu_f(v0[3]));
                    w.z = pkbf(bf_lo(s.z) * rh * silu_f(v1[0]), bf_hi(s.z) * rh * silu_f(v1[1])); w.w = pkbf(bf_lo(s.w) * rh * silu_f(v1[2]), bf_hi(s.w) * rh * silu_f(v1[3]));
                    *(u32x4*)((char*)O + (oofs + (unsigned)((ai * HALF + m * 16) * DI + bj * HALF) * 2u)) = w; } }
            asm volatile("" ::: "memory"); }
    }
};
}

namespace scan {
#define MFMA16(a, b, c) __builtin_amdgcn_mfma_f32_16x16x32_bf16((a), (b), (c), 0, 0, 0)
__device__ __forceinline__ unsigned offb(unsigned row, unsigned ch) { return 256u * row + 16u * (ch ^ (((row & 3u) << 2) | ((row >> 2) & 3u))); }
__device__ __forceinline__ unsigned voffv(unsigned r, unsigned cp) { return 128u * r + 32u * (cp ^ (((r >> 1) & 3u) ^ (((r >> 3) & 1u) << 1))); }
__device__ __forceinline__ bf16x8 tr2(unsigned a0, unsigned a1) {
    u32x2 lo, hi;
    asm volatile("ds_read_b64_tr_b16 %0, %2\n\tds_read_b64_tr_b16 %1, %3\n\ts_waitcnt lgkmcnt(0)" : "=&v"(lo), "=&v"(hi) : "v"(a0), "v"(a1) : "memory");
    const u32x4 r = {lo.x, lo.y, hi.x, hi.y}; return __builtin_bit_cast(bf16x8, r);
}
__device__ __forceinline__ void tr8(unsigned a0, unsigned a1, unsigned c0, unsigned c1, bf16x8& f00, bf16x8& f01, bf16x8& f10, bf16x8& f11) {
    u32x2 r0, r1, r2, r3, r4, r5, r6, r7;
    asm volatile("ds_read_b64_tr_b16 %0, %8\n\tds_read_b64_tr_b16 %1, %9\n\tds_read_b64_tr_b16 %2, %8 offset:8192\n\tds_read_b64_tr_b16 %3, %9 offset:8192\n\t"
                 "ds_read_b64_tr_b16 %4, %10\n\tds_read_b64_tr_b16 %5, %11\n\tds_read_b64_tr_b16 %6, %10 offset:8192\n\tds_read_b64_tr_b16 %7, %11 offset:8192\n\ts_waitcnt lgkmcnt(0)"
                 : "=&v"(r0), "=&v"(r1), "=&v"(r2), "=&v"(r3), "=&v"(r4), "=&v"(r5), "=&v"(r6), "=&v"(r7) : "v"(a0), "v"(a1), "v"(c0), "v"(c1) : "memory");
    const u32x4 x00 = {r0.x, r0.y, r1.x, r1.y}, x01 = {r2.x, r2.y, r3.x, r3.y}, x10 = {r4.x, r4.y, r5.x, r5.y}, x11 = {r6.x, r6.y, r7.x, r7.y};
    f00 = __builtin_bit_cast(bf16x8, x00); f01 = __builtin_bit_cast(bf16x8, x01); f10 = __builtin_bit_cast(bf16x8, x10); f11 = __builtin_bit_cast(bf16x8, x11);
}
__device__ __forceinline__ bf16x8 pack8(const f32x4 a, const f32x4 b) { const u32x4 r = {pkbf(a[0], a[1]), pkbf(a[2], a[3]), pkbf(b[0], b[1]), pkbf(b[2], b[3])}; return __builtin_bit_cast(bf16x8, r); }
template <int NJ>
__device__ __forceinline__ f32x4 ttile(LAS unsigned char* lds, unsigned ldsb, unsigned QI, unsigned KI, unsigned VI, int it, const bf16x8 (&sfrag)[4],
                                       unsigned vs, unsigned l15, unsigned g, unsigned ql, unsigned p) {
    const unsigned trow = 16u * (unsigned)it + l15;
    bf16x8 qb[4];
#pragma unroll
    for (int kd = 0; kd < 4; ++kd) qb[kd] = *(const LAS bf16x8*)(lds + QI + offb(trow, 4u * kd + g));
    f32x4 c[NJ];
#pragma unroll
    for (int j = 0; j < NJ; ++j) { c[j] = (f32x4){0.f, 0.f, 0.f, 0.f};
        if (j <= it) {
#pragma unroll
            for (int kd = 0; kd < 4; ++kd) { const bf16x8 a = *(const LAS bf16x8*)(lds + KI + offb(16u * j + l15, 4u * kd + g)); c[j] = MFMA16(a, qb[kd], c[j]); }
            if (j == it) {
#pragma unroll
                for (int r = 0; r < 4; ++r) c[j][r] = (4u * g + r <= l15) ? c[j][r] : 0.f; } } }
    f32x4 o = (f32x4){0.f, 0.f, 0.f, 0.f};
#pragma unroll
    for (int ks = 0; ks < NJ / 2; ++ks) if (2 * ks <= it) {
        const bf16x8 at = pack8(c[2 * ks], c[2 * ks + 1]);
        const bf16x8 vf = tr2(ldsb + VI + voffv(32u * ks + 4u * g + ql, vs) + 8u * p, ldsb + VI + voffv(32u * ks + 16u + 4u * g + ql, vs) + 8u * p);
        o = MFMA16(vf, at, o); }
#pragma unroll
    for (int kd = 0; kd < 4; ++kd) {
        const u32x2 q0 = *(const LAS u32x2*)(lds + QI + offb(trow, 4u * kd + (g >> 1)) + 8u * (g & 1)), q1 = *(const LAS u32x2*)(lds + QI + offb(trow, 4u * kd + 2u + (g >> 1)) + 8u * (g & 1));
        const u32x4 qq = {q0.x, q0.y, q1.x, q1.y};
        o = MFMA16(sfrag[kd], __builtin_bit_cast(bf16x8, qq), o); }
    return o;
}
__device__ __forceinline__ void phase(LAS unsigned char* lds, const bf16_t* Qt, const bf16_t* Kt, bf16_t* VO, const float* DEC, float* ss8, int bid, int G, int wave) {
    int lane_ = (int)__builtin_amdgcn_mbcnt_hi(~0u, __builtin_amdgcn_mbcnt_lo(~0u, 0u)); asm volatile("" : "+v"(lane_));
    const unsigned lane = (unsigned)lane_, tid = (unsigned)wave * 64u + lane, l15 = lane & 15u, g = lane >> 4, ql = l15 >> 2, p = lane & 3u;
    const unsigned vs = (unsigned)wave & 3u; const int th = wave >> 2, tA = th ? 1 : 0, tB = th ? 2 : 3;
    const unsigned ldsb = (unsigned)(uintptr_t)lds;
    const unsigned srow = tid >> 4, sch = tid & 15u, vrow = tid >> 3, vch = tid & 7u;
    for (int item = bid; item < BATCH * NHEAD * 2; item += G) {
        const int b = item >> 5, h = (item >> 1) & 15, half = item & 1;
        const size_t tokb = (size_t)b * SEQ;
        const bf16_t* qg = Qt + (tokb + srow) * DI + h * HD + sch * 8;
        const bf16_t* kg = Kt + (tokb + srow) * DI + h * HD + sch * 8;
        bf16_t* vg = VO + tokb * DI + h * HD + half * 64;
        f32x4 S[8]; bf16x8 sfrag[4];
#pragma unroll
        for (int i = 0; i < 8; ++i) S[i] = (f32x4){0.f, 0.f, 0.f, 0.f};
#pragma unroll
        for (int i = 0; i < 4; ++i) sfrag[i] = (bf16x8){0, 0, 0, 0, 0, 0, 0, 0};
        u32x4 rq0, rq1, rk0, rk1, rv; f32x4 rdec = (f32x4){0.f, 0.f, 0.f, 0.f};
        const float* dg = DEC + (size_t)(b * (SEQ / 64)) * DI + h * HD + (tid & 31u) * 4u;
#define SC_LOAD(n_) do { const size_t t0_ = (size_t)(n_) * 64; \
            rq0 = *(const u32x4*)(qg + t0_ * DI); rq1 = *(const u32x4*)(qg + (t0_ + 32) * DI); rk0 = *(const u32x4*)(kg + t0_ * DI); rk1 = *(const u32x4*)(kg + (t0_ + 32) * DI); \
            rv = *(const u32x4*)(vg + (t0_ + vrow) * DI + vch * 8); if (tid < 32u) rdec = *(const f32x4*)(dg + (size_t)(n_) * DI); } while (0)
#define SC_STORE(base_) do { *(LAS u32x4*)(lds + (base_) + offb(srow, sch)) = rq0; *(LAS u32x4*)(lds + (base_) + offb(srow + 32u, sch)) = rq1; \
            *(LAS u32x4*)(lds + (base_) + 16384u + offb(srow, sch)) = rk0; *(LAS u32x4*)(lds + (base_) + 16384u + offb(srow + 32u, sch)) = rk1; \
            *(LAS u32x4*)(lds + (base_) + 32768u + voffv(vrow, vch >> 1) + 16u * (vch & 1u)) = rv; \
            if (tid < 32u) *(LAS f32x4*)(lds + 81920u + ((base_) ? 512u : 0u) + tid * 16u) = rdec; } while (0)
        SC_LOAD(0); SC_STORE(0u); __syncthreads();
        for (int n = 0; n < SEQ / 64; ++n) {
            const unsigned QI = (unsigned)(n & 1) * 40960u, KI = QI + 16384u, VI = QI + 32768u;
            if (n + 1 < SEQ / 64) SC_LOAD(n + 1);
            const f32x4 oB = ttile<4>(lds, ldsb, QI, KI, VI, tB, sfrag, vs, l15, g, ql, p);
            const f32x4 oA = ttile<2>(lds, ldsb, QI, KI, VI, tA, sfrag, vs, l15, g, ql, p);
            {
                const bf16x8 vn0 = tr2(ldsb + VI + voffv(8u * g + ql, vs) + 8u * p, ldsb + VI + voffv(8u * g + 4u + ql, vs) + 8u * p);
                const bf16x8 vn1 = tr2(ldsb + VI + voffv(32u + 8u * g + ql, vs) + 8u * p, ldsb + VI + voffv(36u + 8u * g + ql, vs) + 8u * p);
                const LAS float* dcp = (const LAS float*)(lds + 81920u + (unsigned)(n & 1) * 512u) + 4u * g;
                const unsigned ka = ldsb + KI + offb(8u * g + ql, (p >> 1)) + 8u * (p & 1u), kb = ldsb + KI + offb(8u * g + 4u + ql, (p >> 1)) + 8u * (p & 1u);
#pragma unroll
                for (int i = 0; i < 8; i += 2) {
                    bf16x8 k00, k01, k10, k11;
                    tr8(ka ^ ((unsigned)i << 5), kb ^ ((unsigned)i << 5), ka ^ ((unsigned)(i + 1) << 5), kb ^ ((unsigned)(i + 1) << 5), k00, k01, k10, k11);
                    S[i] = MFMA16(k00, vn0, S[i]); S[i + 1] = MFMA16(k10, vn0, S[i + 1]); S[i] = MFMA16(k01, vn1, S[i]); S[i + 1] = MFMA16(k11, vn1, S[i + 1]); }
#pragma unroll
                for (int i = 0; i < 8; ++i) { const f32x4 dc = *(const LAS f32x4*)(dcp + 16 * i); S[i] = S[i] * dc; }
#pragma unroll
                for (int kd = 0; kd < 4; ++kd) sfrag[kd] = pack8(S[2 * kd], S[2 * kd + 1]);
            }
            if (n + 1 < SEQ / 64) SC_STORE((unsigned)((n + 1) & 1) * 40960u);
            {
                const size_t tlB = (size_t)n * 64 + 16u * (unsigned)tB + l15, tlA = (size_t)n * 64 + 16u * (unsigned)tA + l15;
                const u32x2 wB = {pkbf(oB[0], oB[1]), pkbf(oB[2], oB[3])}, wA = {pkbf(oA[0], oA[1]), pkbf(oA[2], oA[3])};
                *(u32x2*)(vg + tlB * DI + 16u * vs + 4u * g) = wB; *(u32x2*)(vg + tlA * DI + 16u * vs + 4u * g) = wA;
                float sB = (oB[0] * oB[0] + oB[1] * oB[1]) + (oB[2] * oB[2] + oB[3] * oB[3]), sA = (oA[0] * oA[0] + oA[1] * oA[1]) + (oA[2] * oA[2] + oA[3] * oA[3]);
                sB += xor_get(sB, (int)lane, 16); sA += xor_get(sA, (int)lane, 16); sB += xor_get(sB, (int)lane, 32); sA += xor_get(sA, (int)lane, 32);
                if (g == 0) { ss8[(tokb + tlB) * 128 + h * 8 + half * 4 + vs] = sB; ss8[(tokb + tlA) * 128 + h * 8 + half * 4 + vs] = sA; }
            }
            __syncthreads();
        }
#undef SC_LOAD
#undef SC_STORE
    }
}
#undef MFMA16
}

#define XB_TMO      128
#define XB_XCNT(j)  (256  + 64 * (j))
#define XB_XSUB(j)  (1280 + 64 * (j))
#define XB_XGEN(j)  (2304 + 64 * (j))
#define XB_TOP      3328
#define XB_TOPGEN   3392
#define XCD_BAR_WORDS 3456
#define XB_SPIN_CAP (1u << 18)
__device__ __forceinline__ unsigned xb_ld(unsigned* p)              { return __hip_atomic_load(p, __ATOMIC_RELAXED, __HIP_MEMORY_SCOPE_AGENT); }
__device__ __forceinline__ unsigned xb_add(unsigned* p, unsigned v) { return __hip_atomic_fetch_add(p, v, __ATOMIC_RELAXED, __HIP_MEMORY_SCOPE_AGENT); }
__device__ __forceinline__ unsigned xb_xcc_id() { return (unsigned)__builtin_amdgcn_s_getreg((3 << 11) | 20) & 0xFu; }
#define XB_SPIN(cond, bar) do { unsigned _sp = 0; while (cond) { __builtin_amdgcn_s_sleep(1); \
    if ((++_sp & 255u) == 0u) { if (xb_ld(&(bar)[XB_TMO])) break; if (_sp > XB_SPIN_CAP) { atomicAdd(&(bar)[XB_TMO], 1u); break; } } } } while (0)
struct XcdBarrier { unsigned* bar; unsigned x; volatile LAS unsigned* st; };
__device__ __forceinline__ XcdBarrier xcd_barrier_post(unsigned* bar, volatile LAS unsigned* st) {
    XcdBarrier b; b.bar = bar; b.x = xb_xcc_id(); b.st = st;
    if (threadIdx.x == 0) (void)xb_add(&bar[XB_XCNT(b.x)], 1u);
    return b;
}
__device__ __forceinline__ void xcd_barrier_complete(unsigned* bar, unsigned x, unsigned& nloc, unsigned& nx) {
    const unsigned G = gridDim.x * gridDim.y * gridDim.z;
    unsigned sum, cnt, mine, sp = 0u;
    for (;;) {
        sum = 0u; cnt = 0u; mine = 0u;
#pragma unroll
        for (unsigned j = 0; j < 16; ++j) { const unsigned c = xb_ld(&bar[XB_XCNT(j)]); sum += c; cnt += (c > 0u) ? 1u : 0u; mine = (j == x) ? c : mine; }
        if (sum == G) break;
        __builtin_amdgcn_s_sleep(1);
        if ((++sp & 255u) == 0u) { if (xb_ld(&bar[XB_TMO])) break; if (sp > XB_SPIN_CAP) { atomicAdd(&bar[XB_TMO], 1u); break; } }
    }
    nloc = mine > 0u ? mine : 1u; nx = cnt > 0u ? cnt : 1u;
}
__device__ __forceinline__ void xcd_barrier(const XcdBarrier& b) {
    asm volatile("s_waitcnt vmcnt(0)" ::: "memory");
    __syncthreads();
    if (threadIdx.x == 0) {
        unsigned* bar = b.bar;
        __builtin_amdgcn_s_waitcnt(0);
        unsigned nloc = b.st[0], nx = b.st[1];
        if (nloc == 0u) { xcd_barrier_complete(bar, b.x, nloc, nx); b.st[0] = nloc; b.st[1] = nx; }
        const unsigned old = xb_add(&bar[XB_XSUB(b.x)], 1u);
        const unsigned gen = old / nloc;
        if (old + 1u == (gen + 1u) * nloc) {
            __builtin_amdgcn_fence(__ATOMIC_RELEASE, "agent");
            asm volatile("s_waitcnt vmcnt(0)" ::: "memory");
            const unsigned og = xb_add(&bar[XB_TOP], 1u);
            const unsigned tg = og / nx;
            if (og + 1u == (tg + 1u) * nx) xb_add(&bar[XB_TOPGEN], 1u);
            else XB_SPIN(xb_ld(&bar[XB_TOPGEN]) == tg, bar);
            __builtin_amdgcn_fence(__ATOMIC_ACQUIRE, "agent");
            xb_add(&bar[XB_XGEN(b.x)], 1u);
            asm volatile("s_waitcnt vmcnt(0)" ::: "memory");
        } else {
            XB_SPIN(xb_ld(&bar[XB_XGEN(b.x)]) == gen, bar);
            __builtin_amdgcn_fence(__ATOMIC_ACQUIRE, "agent");
            asm volatile("s_waitcnt vmcnt(0)" ::: "memory");
        }
    }
    __syncthreads();
}

struct Args {
    const float* x; const float* norm_g; const float* pool_w_in; const float* pool_w_grp; const float* pool_scale; const float* pool_w_out;
    const float* hgrn_w_in; const float* hgrn_lb; const float* hgrn_norm_g; const float* hgrn_w_out; const float* final_g;
    float* out; unsigned char* ws;
};

__device__ __forceinline__ void transpose_item(const float* W, int K, int N, bf16_t* WT, int row_off, const float* ks, const float* ns, LAS float* scr, int item, int lane) {
    const int nblk = N / 32, kb = item / nblk, nb = item % nblk, k0 = 64 * kb, n0 = 32 * nb;
    const float nsv = ns ? ns[n0 + (lane & 31)] : 1.0f;
#pragma unroll 8
    for (int i = 0; i < 32; ++i) { const int kk = 2 * i + (lane >> 5); float w = W[(size_t)(k0 + kk) * N + n0 + (lane & 31)] * nsv; if (ks) w *= ks[k0 + kk]; scr[kk * 33 + (lane & 31)] = w; }
    asm volatile("s_waitcnt lgkmcnt(0)" ::: "memory");
    const int c = lane & 7;
#pragma unroll
    for (int j = 0; j < 4; ++j) { const int n = (lane >> 3) + 8 * j; const LAS float* s = scr + (8 * c) * 33 + n;
        u32x4 o; o.x = pk2(s[0 * 33], s[1 * 33]); o.y = pk2(s[2 * 33], s[3 * 33]); o.z = pk2(s[4 * 33], s[5 * 33]); o.w = pk2(s[6 * 33], s[7 * 33]);
        *(u32x4*)(WT + (size_t)(row_off + n0 + n) * K + k0 + 8 * c) = o; }
    asm volatile("s_waitcnt lgkmcnt(0)" ::: "memory");
}

__global__ void __launch_bounds__(512, 2) fwd_kernel(Args a) {
    extern __shared__ __attribute__((aligned(16))) unsigned char lds_raw[];
    LAS unsigned char* lds = (LAS unsigned char*)lds_raw;
    volatile LAS unsigned* xst = (volatile LAS unsigned*)(lds + 131072 + 64);
    if (threadIdx.x < 2) xst[threadIdx.x] = 0u;
    __syncthreads();
    const XcdBarrier xbar = xcd_barrier_post((unsigned*)a.ws, xst);
#define GRID_BAR() xcd_barrier(xbar)
    const int G = gridDim.x, bid = blockIdx.x;
    const int NGW = G * 8;
    const int wave = __builtin_amdgcn_readfirstlane((int)threadIdx.x >> 6);
#define PHASE_IDS int lane_ = (int)__builtin_amdgcn_mbcnt_hi(~0u, __builtin_amdgcn_mbcnt_lo(~0u, 0u)); asm volatile("" : "+v"(lane_)); const int lane = lane_, tid = wave * 64 + lane, gw = bid * 8 + wave; (void)gw; (void)tid;
    unsigned char* ws = a.ws;
    bf16_t* Wt_in0 = (bf16_t*)(ws + WS_WIN0); bf16_t* Wt_grp = (bf16_t*)(ws + WS_WGRP); bf16_t* Wt_out0 = (bf16_t*)(ws + WS_WOUT0);
    bf16_t* Wt_in1 = (bf16_t*)(ws + WS_WIN1); bf16_t* Wt_out1 = (bf16_t*)(ws + WS_WOUT1);
    float* part1 = (float*)(ws + WS_PART1); float* part2 = (float*)(ws + WS_PART2); float* ssb = (float*)(ws + WS_SS); float* decb = (float*)(ws + WS_DEC);
    bf16_t* XB = (bf16_t*)(ws + WS_XB); bf16_t* BA = (bf16_t*)(ws + WS_A); bf16_t* BB = (bf16_t*)(ws + WS_B); bf16_t* BC = (bf16_t*)(ws + WS_C);

    {
        PHASE_IDS
        LAS float* scr = (LAS float*)(lds + wave * 16384);
        constexpr int I_IN0 = (DM / 64) * (4096 / 32), I_GRP1 = (512 / 64) * (512 / 32), I_OUT = (DI / 64) * (DM / 32), I_IN1 = (DM / 64) * (8192 / 32);
        constexpr int NITEMS = I_IN0 + 4 * I_GRP1 + I_OUT + I_IN1 + I_OUT;
        for (int it = gw; it < NITEMS; it += NGW) {
            int r = it;
            if (r < I_IN0) { transpose_item(a.pool_w_in, DM, 4096, Wt_in0, 0, a.norm_g, nullptr, scr, r, lane); continue; } r -= I_IN0;
            if (r < 4 * I_GRP1) { const int g = r / I_GRP1; transpose_item(a.pool_w_grp + (size_t)g * 512 * 512, 512, 512, Wt_grp, g * 512, nullptr, a.pool_scale + g * 512, scr, r % I_GRP1, lane); continue; } r -= 4 * I_GRP1;
            if (r < I_OUT) { transpose_item(a.pool_w_out, DI, DM, Wt_out0, 0, nullptr, nullptr, scr, r, lane); continue; } r -= I_OUT;
            if (r < I_IN1) {
                const int n0 = 32 * (r % (8192 / 32)); int d0 = n0;
                if (n0 < 2048) d0 = 256 * (n0 >> 7) + (n0 & 127); else if (n0 < 4096) d0 = 256 * ((n0 - 2048) >> 7) + 128 + (n0 & 127);
                transpose_item(a.hgrn_w_in, DM, 8192, Wt_in1, d0 - n0, a.norm_g + DM, nullptr, scr, r, lane); continue; } r -= I_IN1;
            transpose_item(a.hgrn_w_out, DI, DM, Wt_out1, 0, a.hgrn_norm_g, nullptr, scr, r, lane);
        }
        for (int m = gw; m < M; m += NGW) {
            const f32x4* xr = (const f32x4*)(a.x + (size_t)m * DM) + lane;
            f32x4 v[4]; float s = 0.f;
#pragma unroll
            for (int j = 0; j < 4; ++j) { v[j] = xr[64 * j]; s += (v[j][0] * v[j][0] + v[j][1] * v[j][1]) + (v[j][2] * v[j][2] + v[j][3] * v[j][3]); }
            const float rstd = 1.0f / sqrtf(wave_sum(s, lane) * (1.0f / DM) + EPS);
            unsigned long long* o8 = (unsigned long long*)(XB + (size_t)m * DM) + lane;
#pragma unroll
            for (int j = 0; j < 4; ++j) o8[64 * j] = (unsigned long long)pk2(v[j][0] * rstd, v[j][1] * rstd) | ((unsigned long long)pk2(v[j][2] * rstd, v[j][3] * rstd) << 32);
        }
    }
    GRID_BAR();

    {
        pg8::Gemm g{XB, Wt_in0, DM, DM, DM, 0}; pg8::StaticOrder S; S.init(M, 4096, G, bid);
        pg8::EpiP1 E{BA, BB};
        pg8::gemm_phase<pg8::EpiP1>(lds, g, S, E, wave);
    }
    GRID_BAR();

    {
        PHASE_IDS
        constexpr int RUN = 64;
        const int nruns = (M / RUN) * (DI / 8);
        for (int idx = bid * 512 + tid; idx < nruns; idx += G * 512) {
            const int cgp = idx & 255, run = idx >> 8, grp = cgp >> 6, w = 2 << grp;
            const int m0 = run * RUN, t0 = m0 & (SEQ - 1);
            const bf16_t* vp = BA + (size_t)m0 * DI + cgp * 8; bf16_t* pp = BC + (size_t)m0 * DI + cgp * 8;
            float sum[8];
#pragma unroll
            for (int j = 0; j < 8; ++j) sum[j] = 0.f;
            if (t0 > 0) for (int k = 1; k < w; ++k) { const u32x4 vv = *(const u32x4*)(vp - (size_t)k * DI);
                sum[0] += bf_lo(vv.x); sum[1] += bf_hi(vv.x); sum[2] += bf_lo(vv.y); sum[3] += bf_hi(vv.y); sum[4] += bf_lo(vv.z); sum[5] += bf_hi(vv.z); sum[6] += bf_lo(vv.w); sum[7] += bf_hi(vv.w); }
#pragma unroll 4
            for (int i = 0; i < RUN; ++i) {
                const int t = t0 + i;
                const u32x4 vv = *(const u32x4*)(vp + (size_t)i * DI);
                float x[8] = {bf_lo(vv.x), bf_hi(vv.x), bf_lo(vv.y), bf_hi(vv.y), bf_lo(vv.z), bf_hi(vv.z), bf_lo(vv.w), bf_hi(vv.w)};
#pragma unroll
                for (int j = 0; j < 8; ++j) sum[j] += x[j];
                const int cnt = (t + 1) < w ? (t + 1) : w; const float inv = 1.0f / (float)cnt;
                u32x4 o; o.x = pkbf(sum[0] * inv - x[0], sum[1] * inv - x[1]); o.y = pkbf(sum[2] * inv - x[2], sum[3] * inv - x[3]);
                o.z = pkbf(sum[4] * inv - x[4], sum[5] * inv - x[5]); o.w = pkbf(sum[6] * inv - x[6], sum[7] * inv - x[7]);
                *(u32x4*)(pp + (size_t)i * DI) = o;
                if (t + 1 >= w) { const u32x4 uu = *(const u32x4*)(vp + (size_t)(i + 1 - w) * DI);
                    sum[0] -= bf_lo(uu.x); sum[1] -= bf_hi(uu.x); sum[2] -= bf_lo(uu.y); sum[3] -= bf_hi(uu.y); sum[4] -= bf_lo(uu.z); sum[5] -= bf_hi(uu.z); sum[6] -= bf_lo(uu.w); sum[7] -= bf_hi(uu.w); }
            }
        }
    }
    GRID_BAR();

    {
        pg8::Gemm g{BC, Wt_grp, DI, 512, 512, 2}; pg8::StaticOrder S; S.init(M, DI, G, bid);
        pg8::EpiP2 E{BB};
        pg8::gemm_phase<pg8::EpiP2>(lds, g, S, E, wave);
    }
    GRID_BAR();

    {
        pg8::Gemm g{BB, Wt_out0, DI, DI, DI, 0}; pg8::StaticOrder S; S.init(M, DM, G, bid);
        pg8::EpiRes<true> E{a.x, a.out, XB, part1};
        pg8::gemm_phase<pg8::EpiRes<true>>(lds, g, S, E, wave);
    }
    GRID_BAR();

    {
        pg8::Gemm g{XB, Wt_in1, DM, DM, DM, 0}; pg8::StaticOrder S; S.init(M, 6144, G, bid);
        pg8::EpiP4 E{BA, BB, BC, decb, part1, a.hgrn_lb};
        pg8::gemm_phase<pg8::EpiP4>(lds, g, S, E, wave);
    }
    GRID_BAR();

    scan::phase(lds, BA, BB, BC, decb, ssb, bid, G, wave);
    GRID_BAR();

    {
        pg8::Gemm g{XB, Wt_in1 + (size_t)6144 * DM, DM, DM, DM, 0}; pg8::StaticOrder S; S.init(M, DI, G, bid);
        pg8::EpiP5b E{BC, part1, ssb};
        pg8::gemm_phase<pg8::EpiP5b>(lds, g, S, E, wave);
    }
    GRID_BAR();

    {
        pg8::Gemm g{BC, Wt_out1, DI, DI, DI, 0}; pg8::StaticOrder S; S.init(M, DM, G, bid);
        pg8::EpiRes<false> E{a.out, a.out, nullptr, part2};
        pg8::gemm_phase<pg8::EpiRes<false>>(lds, g, S, E, wave);
    }
    GRID_BAR();

    {
        PHASE_IDS
        for (int m = gw; m < M; m += NGW) {
            const f32x4* p4 = (const f32x4*)(part2 + (size_t)m * 16); const f32x4 pa = p4[0], pb = p4[1], pc = p4[2], pd = p4[3]; const float p = (((pa[0] + pa[1]) + (pa[2] + pa[3])) + ((pb[0] + pb[1]) + (pb[2] + pb[3]))) + (((pc[0] + pc[1]) + (pc[2] + pc[3])) + ((pd[0] + pd[1]) + (pd[2] + pd[3])));
            const float rstd = 1.0f / sqrtf(p * (1.0f / DM) + EPS);
            f32x4* orow = (f32x4*)(a.out + (size_t)m * DM) + lane; const f32x4* gr = (const f32x4*)a.final_g + lane;
#pragma unroll
            for (int j = 0; j < 4; ++j) { f32x4 v = orow[64 * j]; const f32x4 gg = gr[64 * j]; v = v * rstd * gg; orow[64 * j] = v; }
        }
    }
}

extern "C" void kernel_launch(void* const* d_in, const int* in_sizes, int n_in, void* d_out, int out_size, void* d_ws, size_t ws_size, hipStream_t stream) {
    static int grid = 0;
    if (grid == 0) {
        if (n_in != 11 || in_sizes[0] != M * DM || out_size != M * DM || ws_size < WS_END) { fprintf(stderr, "kernel_launch: unexpected shapes (n_in %d in0 %d out %d ws %zu)\n", n_in, n_in > 0 ? in_sizes[0] : -1, out_size, ws_size); grid = -1; return; }
        int dev = 0, cus = 0, per = 0;
        if (hipGetDevice(&dev) != hipSuccess || hipDeviceGetAttribute(&cus, hipDeviceAttributeMultiprocessorCount, dev) != hipSuccess) { grid = -1; return; }
        if (hipFuncSetAttribute((const void*)fwd_kernel, hipFuncAttributeMaxDynamicSharedMemorySize, LDS_BYTES) != hipSuccess) { fprintf(stderr, "kernel_launch: hipFuncSetAttribute failed\n"); grid = -1; return; }
        if (hipOccupancyMaxActiveBlocksPerMultiprocessor(&per, (const void*)fwd_kernel, 512, LDS_BYTES) != hipSuccess || per < 1) { fprintf(stderr, "kernel_launch: occupancy query says %d\n", per); (void)hipGetLastError(); grid = -1; return; }
        grid = cus;
        fprintf(stderr, "kernel_launch: cus %d per_cu %d grid %d\n", cus, per, grid);
    }
    if (grid < 0) return;
    if (hipMemsetAsync(d_ws, 0, 16384, stream) != hipSuccess) { fprintf(stderr, "kernel_launch: hipMemsetAsync failed\n"); return; }
    Args a{};
    a.x = (const float*)d_in[0]; a.norm_g = (const float*)d_in[1]; a.pool_w_in = (const float*)d_in[2]; a.pool_w_grp = (const float*)d_in[3];
    a.pool_scale = (const float*)d_in[4]; a.pool_w_out = (const float*)d_in[5]; a.hgrn_w_in = (const float*)d_in[6]; a.hgrn_lb = (const float*)d_in[7];
    a.hgrn_norm_g = (const float*)d_in[8]; a.hgrn_w_out = (const float*)d_in[9]; a.final_g = (const float*)d_in[10];
    a.out = (float*)d_out; a.ws = (unsigned char*)d_ws;
    void* args[] = {&a};
    hipError_t e = hipLaunchCooperativeKernel((void*)fwd_kernel, dim3(grid), dim3(512), args, LDS_BYTES, stream);
    if (e != hipSuccess) fprintf(stderr, "kernel_launch: cooperative launch failed: %s (grid %d)\n", hipGetErrorString(e), grid);
}
```

```cpp
#include <hip/hip_runtime.h>
#include <hip/hip_cooperative_groups.h>
#include <cstdio>
#include <cstdint>
namespace cg = cooperative_groups;

#define LAS __attribute__((address_space(3)))
typedef unsigned short bf16_t;
typedef short bf16x8 __attribute__((ext_vector_type(8)));
typedef float f32x4 __attribute__((ext_vector_type(4)));
typedef float f32x2 __attribute__((ext_vector_type(2)));
typedef unsigned u32x4 __attribute__((ext_vector_type(4)));
typedef unsigned u32x2 __attribute__((ext_vector_type(2)));

constexpr int DM = 1024, BATCH = 8, SEQ = 4096, DI = 2048, M = BATCH * SEQ;
constexpr int NHEAD = 16, HD = 128;
constexpr float EPS = 1e-6f;
constexpr size_t MiB = 1u << 20;
constexpr size_t WS_WIN0 = 2 * MiB;
constexpr size_t WS_WGRP = 10 * MiB;
constexpr size_t WS_WOUT0 = 12 * MiB;
constexpr size_t WS_WIN1 = 16 * MiB;
constexpr size_t WS_WOUT1 = 32 * MiB;
constexpr size_t WS_PART1 = 36 * MiB;
constexpr size_t WS_PART2 = 38 * MiB;
constexpr size_t WS_CNT = 16384;
constexpr size_t WS_X = 40 * MiB;
constexpr size_t WS_DEC = 44 * MiB;
constexpr size_t WS_SS = 112 * MiB;
constexpr size_t WS_XB = 48 * MiB;
constexpr size_t WS_A = 128 * MiB;
constexpr size_t WS_B = 256 * MiB;
constexpr size_t WS_C = 384 * MiB;
constexpr size_t WS_END = 512 * MiB;
constexpr int LDS_BYTES = 147456;

__device__ __forceinline__ unsigned f2bf(float f) { unsigned u = __builtin_bit_cast(unsigned, f); return (u + 0x7fffu + ((u >> 16) & 1u)) >> 16; }
__device__ __forceinline__ unsigned pk2(float lo, float hi) { return f2bf(lo) | (f2bf(hi) << 16); }
typedef __bf16 bf2_t __attribute__((ext_vector_type(2)));
__device__ __forceinline__ unsigned pkbf(float lo, float hi) { f32x2 v = {lo, hi}; return __builtin_bit_cast(unsigned, __builtin_convertvector(v, bf2_t)); }
__device__ __forceinline__ float bf_lo(unsigned w) { return __builtin_bit_cast(float, w << 16); }
__device__ __forceinline__ float bf_hi(unsigned w) { return __builtin_bit_cast(float, w & 0xffff0000u); }
__device__ __forceinline__ float silu_f(float x) { return x * __builtin_amdgcn_rcpf(1.0f + __builtin_amdgcn_exp2f(-1.44269504089f * x)); }
__device__ __forceinline__ float lane_get(float v, int src_lane) { return __builtin_bit_cast(float, __builtin_amdgcn_ds_bpermute(src_lane << 2, __builtin_bit_cast(int, v))); }
__device__ __forceinline__ float xor_get(float v, int lane, int m) { return lane_get(v, lane ^ m); }
__device__ __forceinline__ float wave_sum(float v, int lane) {
#pragma unroll
    for (int o = 1; o < 64; o <<= 1) v += xor_get(v, lane, o);
    return v;
}

namespace pg8 {
constexpr int BM = 256, BK = 64, HALF = 128, HTB = HALF * BK * 2, STAGE_BYTES = 8 * HTB, NXCD = 8, WGM = 8;
__host__ __device__ __forceinline__ int lds_byte(int r, int c) { const int st = (r >> 4) * 2 + (c >> 5), rr = r & 15, cc = c & 31, ob = rr * 64 + cc * 2; return st * 1024 + (ob ^ (((ob >> 9) & 1) << 5)); }
__host__ __device__ __forceinline__ void stage_rc(int b, int& R, int& C) { const int st = b / 1024, sb = b % 1024, swz = sb ^ (((sb >> 9) & 1) << 5); R = (st >> 1) * 16 + swz / 64; C = (st & 1) * 32 + (swz % 64) / 2; }
__host__ __device__ __forceinline__ int perm32(int rho) { const int n = rho >> 4, i = rho & 15; return 8 * (i >> 2) + 4 * n + (i & 3); }

struct Unit { int pm, pn; };
struct Gemm { const bf16_t* A; const bf16_t* Bt; int lda, ldb, K, grp_tiles; };

struct StaticOrder {
    int nM, nN, nwg, G, c;
    __host__ __device__ void init(int M_, int N_, int G_, int c_) { nM = M_ / BM; nN = N_ / BM; nwg = nM * nN; G = G_; c = c_; }
    __host__ __device__ bool next(int i, Unit& u) const {
        const long L = (long)i * G + c; if (L >= nwg) return false;
        int wgid = (int)L; { const int q = nwg / NXCD, r = nwg % NXCD, xcd = wgid % NXCD, off = wgid / NXCD; wgid = (xcd < r ? xcd * (q + 1) : r * (q + 1) + (xcd - r) * q) + off; }
        const int nig = WGM * nN, gid = wgid / nig, fm = gid * WGM, gsz = (nM - fm) < WGM ? (nM - fm) : WGM;
        u.pm = fm + ((wgid % nig) % gsz); u.pn = (wgid % nig) / gsz; return true;
    }
};

__device__ __forceinline__ unsigned cvt_pk_bf16(float lo, float hi) { unsigned r; asm volatile("v_cvt_pk_bf16_f32 %0, %1, %2" : "=v"(r) : "v"(lo), "v"(hi)); return r; }

template <class Epi, bool ALIGN_EPI = true, bool SP2 = true>
__device__ __forceinline__ void gemm_phase(LAS unsigned char* lds, const Gemm g, const StaticOrder& S, const Epi& E, const int wid) {
    int lane_ = (int)__builtin_amdgcn_mbcnt_hi(~0u, __builtin_amdgcn_mbcnt_lo(~0u, 0u)); asm volatile("" : "+v"(lane_));
    int lane = lane_, tid = wid * 64 + lane, fr = lane & 15, fq = lane >> 4; const int wr = wid >> 2, wc = wid & 3;
    const int K = g.K, nt = K / BK;
    unsigned voffA[2], voffB[2]; int aoff, boff;
#define PG8_LANE_STATE() do { _Pragma("unroll") for (int i = 0; i < 2; ++i) { int R, C; stage_rc(tid * 16 + i * 8192, R, C); const int Rb = Epi::PERM ? ((R & ~31) + perm32(R & 31)) : R; \
        voffA[i] = (unsigned)(R * g.lda + C) * 2u; voffB[i] = (unsigned)(Rb * g.ldb + C) * 2u; } \
        aoff = lds_byte(wr * 64 + fr, fq * 8); boff = lds_byte(wc * 32 + fr, fq * 8); } while (0)
    PG8_LANE_STATE();
    const size_t kstep = (size_t)(BK * 2);
    const size_t hstepA = (size_t)HALF * g.lda * 2, hstepB = (size_t)HALF * g.ldb * 2;
    const size_t tstepA = 2 * hstepA, tstepB = 2 * hstepB;
    const unsigned ldsw = (unsigned)wid * 1024u;
#define PG8_SA(b, h) (((b) * 2 + (h)) * HTB)
#define PG8_SB(b, h) ((4 + (b) * 2 + (h)) * HTB)
#define PG8_STAGE(bufoff, gbase, voff) do { _Pragma("unroll") for (int _i = 0; _i < 2; ++_i) \
        __builtin_amdgcn_global_load_lds((const unsigned*)((const char*)(gbase) + (voff)[_i]), (LAS unsigned*)(lds + (bufoff) + ldsw + _i * 8192), 16, 0, 0); } while (0)
#define PG8_LDA(dst, b, h) do { _Pragma("unroll") for (int m = 0; m < 4; ++m) _Pragma("unroll") for (int k = 0; k < 2; ++k) dst[m][k] = *(const LAS bf16x8*)(lds + PG8_SA(b, h) + aoff + m * 2048 + k * 1024); } while (0)
#define PG8_LDB(dst, b, h) do { _Pragma("unroll") for (int n = 0; n < 2; ++n) _Pragma("unroll") for (int k = 0; k < 2; ++k) dst[n][k] = *(const LAS bf16x8*)(lds + PG8_SB(b, h) + boff + n * 2048 + k * 1024); } while (0)
#define PG8_MMA(ai, bj, At, Bt) do { __builtin_amdgcn_s_setprio(1); _Pragma("unroll") for (int m = 0; m < 4; ++m) _Pragma("unroll") for (int n = 0; n < 2; ++n) _Pragma("unroll") for (int k = 0; k < 2; ++k) \
        acc[ai][bj][m][n] = __builtin_amdgcn_mfma_f32_16x16x32_bf16(Bt[n][k], At[m][k], acc[ai][bj][m][n], 0, 0, 0); __builtin_amdgcn_s_setprio(0); } while (0)
#define PG8_WAIT_V(n) asm volatile("s_waitcnt vmcnt(" #n ")" ::: "memory")
#define PG8_WAIT_L(n) asm volatile("s_waitcnt lgkmcnt(" #n ")" ::: "memory")
#define PG8_BAR __builtin_amdgcn_s_barrier()
#define PG8_SCHED __builtin_amdgcn_sched_barrier(0)
#define PG8_ABASE(u) ((const char*)g.A + (size_t)(u).pm * tstepA + (g.grp_tiles ? (size_t)((u).pn / g.grp_tiles) * (size_t)K * 2 : (size_t)0))
#define PG8_BBASE(u) ((const char*)g.Bt + (size_t)(u).pn * tstepB)
    Unit cur, nxt; int ui = 0;
    E.prologue(S, lds, tid);
    if (!S.next(0, cur)) return;
    f32x4 acc[2][2][4][2];
#pragma unroll
    for (int a = 0; a < 2; ++a)
#pragma unroll
        for (int b = 0; b < 2; ++b)
#pragma unroll
            for (int m = 0; m < 4; ++m)
#pragma unroll
                for (int n = 0; n < 2; ++n) acc[a][b][m][n] = (f32x4){0.f, 0.f, 0.f, 0.f};
    bf16x8 At[4][2], B0[2][2], B1[2][2];
    const char* cA = PG8_ABASE(cur); const char* cB = PG8_BBASE(cur);
    if constexpr (SP2) {
        PG8_STAGE(PG8_SB(0, 0), cB, voffB); PG8_STAGE(PG8_SB(0, 1), cB + hstepB, voffB); PG8_STAGE(PG8_SA(0, 0), cA, voffA); PG8_STAGE(PG8_SA(0, 1), cA + hstepA, voffA);
        if (wr == 1) PG8_BAR;
        PG8_WAIT_V(2); PG8_BAR;
        PG8_STAGE(PG8_SB(1, 0), cB + kstep, voffB); PG8_STAGE(PG8_SA(1, 0), cA + kstep, voffA); PG8_STAGE(PG8_SB(1, 1), cB + hstepB + kstep, voffB);
        PG8_WAIT_V(6); PG8_BAR;
    } else {
        PG8_STAGE(PG8_SB(0, 0), cB, voffB); PG8_STAGE(PG8_SA(0, 0), cA, voffA); PG8_STAGE(PG8_SB(0, 1), cB + hstepB, voffB); PG8_STAGE(PG8_SA(0, 1), cA + hstepA, voffA);
        if (wr == 1) PG8_BAR;
        PG8_WAIT_V(4); PG8_BAR;
        PG8_STAGE(PG8_SB(1, 0), cB + kstep, voffB); PG8_STAGE(PG8_SA(1, 0), cA + kstep, voffA); PG8_STAGE(PG8_SB(1, 1), cB + hstepB + kstep, voffB);
        PG8_WAIT_V(6); PG8_BAR;
    }
    for (;;) {
        const bool has_next = S.next(ui + 1, nxt);
        const char* nA = has_next ? PG8_ABASE(nxt) : cA; const char* nB = has_next ? PG8_BBASE(nxt) : cB;
        for (int t = 0; t < nt; t += 2) {
            const bool last = (t == nt - 2);
            const char* a1 = cA + (size_t)(t + 1) * kstep;
            const char* a2 = last ? nA : cA + (size_t)(t + 2) * kstep; const char* b2 = last ? nB : cB + (size_t)(t + 2) * kstep;
            const char* a3 = a2 + kstep; const char* b3 = b2 + kstep;
            if constexpr (SP2) {
            PG8_LDB(B0, 0, 0); PG8_LDB(B1, 0, 1); PG8_SCHED; PG8_LDA(At, 0, 0); PG8_STAGE(PG8_SA(1, 1), a1 + hstepA, voffA);
            PG8_WAIT_V(8); PG8_WAIT_L(0); PG8_BAR; PG8_MMA(0, 0, At, B0); PG8_MMA(0, 1, At, B1); PG8_BAR; PG8_SCHED;
            PG8_LDA(At, 0, 1); PG8_STAGE(PG8_SB(0, 0), b2, voffB); PG8_STAGE(PG8_SB(0, 1), b2 + hstepB, voffB); PG8_STAGE(PG8_SA(0, 0), a2, voffA);
            PG8_WAIT_V(8); PG8_WAIT_L(0); PG8_BAR; PG8_MMA(1, 0, At, B0); PG8_MMA(1, 1, At, B1); PG8_BAR; PG8_SCHED;
            PG8_LDB(B0, 1, 0); PG8_LDB(B1, 1, 1); PG8_SCHED; PG8_LDA(At, 1, 0); PG8_STAGE(PG8_SA(0, 1), a2 + hstepA, voffA);
            PG8_WAIT_V(8); PG8_WAIT_L(0); PG8_BAR; PG8_MMA(0, 0, At, B0); PG8_MMA(0, 1, At, B1); PG8_BAR; PG8_SCHED;
            PG8_LDA(At, 1, 1); PG8_STAGE(PG8_SB(1, 0), b3, voffB); PG8_STAGE(PG8_SB(1, 1), b3 + hstepB, voffB); PG8_STAGE(PG8_SA(1, 0), a3, voffA);
            PG8_WAIT_V(8); PG8_WAIT_L(0); PG8_BAR; PG8_MMA(1, 0, At, B0); PG8_MMA(1, 1, At, B1); PG8_BAR; PG8_SCHED;
            } else {
            PG8_LDB(B0, 0, 0); PG8_SCHED; PG8_LDA(At, 0, 0); PG8_STAGE(PG8_SA(1, 1), a1 + hstepA, voffA);
            PG8_WAIT_L(8); PG8_BAR; PG8_WAIT_L(0); PG8_MMA(0, 0, At, B0); PG8_BAR; PG8_SCHED;
            PG8_LDB(B1, 0, 1); PG8_STAGE(PG8_SB(0, 0), b2, voffB);
            PG8_BAR; PG8_WAIT_L(0); PG8_MMA(0, 1, At, B1); PG8_BAR;
            PG8_LDA(At, 0, 1); PG8_STAGE(PG8_SA(0, 0), a2, voffA);
            PG8_BAR; PG8_WAIT_L(0); PG8_MMA(1, 0, At, B0); PG8_BAR; PG8_SCHED;
            PG8_STAGE(PG8_SB(0, 1), b2 + hstepB, voffB);
            PG8_WAIT_V(6); PG8_BAR; PG8_MMA(1, 1, At, B1); PG8_BAR;
            PG8_LDB(B0, 1, 0); PG8_SCHED; PG8_LDA(At, 1, 0); PG8_STAGE(PG8_SA(0, 1), a2 + hstepA, voffA);
            PG8_WAIT_L(8); PG8_BAR; PG8_WAIT_L(0); PG8_MMA(0, 0, At, B0); PG8_BAR; PG8_SCHED;
            PG8_LDB(B1, 1, 1); PG8_STAGE(PG8_SB(1, 0), b3, voffB);
            PG8_BAR; PG8_WAIT_L(0); PG8_MMA(0, 1, At, B1); PG8_BAR;
            PG8_LDA(At, 1, 1); PG8_STAGE(PG8_SA(1, 0), a3, voffA);
            PG8_BAR; PG8_WAIT_L(0); PG8_MMA(1, 0, At, B0); PG8_BAR; PG8_SCHED;
            PG8_STAGE(PG8_SB(1, 1), b3 + hstepB, voffB);
            PG8_WAIT_V(6); PG8_BAR; PG8_MMA(1, 1, At, B1); PG8_BAR;
            }
        }
        if constexpr (ALIGN_EPI) { if (wr == 0) PG8_BAR; }
        if constexpr (!Epi::AFTER_DRAIN) E(acc, cur, wr, wc, fr, fq, lds, ui);
        if (!has_next) break;
#pragma unroll
        for (int a = 0; a < 2; ++a)
#pragma unroll
            for (int b = 0; b < 2; ++b)
#pragma unroll
                for (int m = 0; m < 4; ++m)
#pragma unroll
                    for (int n = 0; n < 2; ++n) acc[a][b][m][n] = (f32x4){0.f, 0.f, 0.f, 0.f};
        cur = nxt; cA = nA; cB = nB; ++ui;
        asm volatile("" : "+v"(lane)); tid = wid * 64 + lane; fr = lane & 15; fq = lane >> 4; PG8_LANE_STATE();
        if constexpr (ALIGN_EPI) { if (wr == 1) PG8_BAR; }
    }
    PG8_WAIT_V(0);
    if constexpr (!ALIGN_EPI) { if (wr == 0) PG8_BAR; }
    PG8_BAR;
    if constexpr (Epi::AFTER_DRAIN) E.fused(acc, cur, wr, wc, fr, fq, lds, tid);
#undef PG8_SA
#undef PG8_SB
#undef PG8_STAGE
#undef PG8_LDA
#undef PG8_LDB
#undef PG8_MMA
#undef PG8_WAIT_V
#undef PG8_WAIT_L
#undef PG8_BAR
#undef PG8_SCHED
#undef PG8_ABASE
#undef PG8_LANE_STATE
#undef PG8_BBASE
}

struct EpiP1 {
    static constexpr bool PERM = true, AFTER_DRAIN = false;
    __device__ __forceinline__ void prologue(const StaticOrder&, LAS unsigned char*, int) const {}
    bf16_t* V; bf16_t* SG;
    __device__ __forceinline__ void operator()(f32x4 (&acc)[2][2][4][2], const Unit& u, int wr, int wc, int fr, int fq, LAS unsigned char* lds, int ui) const {
        const int row0 = u.pm * BM + wr * 64 + fr; const bool gate = u.pn >= 8;
        bf16_t* base = gate ? SG : V; const int col0 = (u.pn & 7) * BM + wc * 32 + 8 * fq;
#pragma unroll
        for (int ai = 0; ai < 2; ++ai)
#pragma unroll
            for (int m = 0; m < 4; ++m) { bf16_t* rowp = base + (size_t)(row0 + ai * HALF + m * 16) * DI + col0;
#pragma unroll
                for (int bj = 0; bj < 2; ++bj) { f32x4 v0 = acc[ai][bj][m][0], v1 = acc[ai][bj][m][1];
                    if (gate) {
#pragma unroll
                        for (int j = 0; j < 4; ++j) { v0[j] = silu_f(v0[j]); v1[j] = silu_f(v1[j]); } }
                    u32x4 w; w.x = cvt_pk_bf16(v0[0], v0[1]); w.y = cvt_pk_bf16(v0[2], v0[3]); w.z = cvt_pk_bf16(v1[0], v1[1]); w.w = cvt_pk_bf16(v1[2], v1[3]);
                    *(u32x4*)(rowp + bj * HALF) = w; } }
    }
};
struct EpiP2 {
    static constexpr bool PERM = true, AFTER_DRAIN = false;
    __device__ __forceinline__ void prologue(const StaticOrder&, LAS unsigned char*, int) const {}
    bf16_t* Z;
    __device__ __forceinline__ void operator()(f32x4 (&acc)[2][2][4][2], const Unit& u, int wr, int wc, int fr, int fq, LAS unsigned char* lds, int ui) const {
        const int row0 = u.pm * BM + wr * 64 + fr; const int col0 = u.pn * BM + wc * 32 + 8 * fq;
#pragma unroll
        for (int ai = 0; ai < 2; ++ai)
#pragma unroll
            for (int m = 0; m < 4; ++m) { bf16_t* rowp = Z + (size_t)(row0 + ai * HALF + m * 16) * DI + col0;
#pragma unroll
                for (int bj = 0; bj < 2; ++bj) { const f32x4 v0 = acc[ai][bj][m][0], v1 = acc[ai][bj][m][1];
                    const u32x4 s = *(const u32x4*)(rowp + bj * HALF);
                    u32x4 w; w.x = cvt_pk_bf16(v0[0] * bf_lo(s.x), v0[1] * bf_hi(s.x)); w.y = cvt_pk_bf16(v0[2] * bf_lo(s.y), v0[3] * bf_hi(s.y));
                    w.z = cvt_pk_bf16(v1[0] * bf_lo(s.z), v1[1] * bf_hi(s.z)); w.w = cvt_pk_bf16(v1[2] * bf_lo(s.w), v1[3] * bf_hi(s.w));
                    *(u32x4*)(rowp + bj * HALF) = w; } }
    }
};
template <bool WRITE_HB> struct EpiRes {
    static constexpr bool PERM = false, AFTER_DRAIN = false;
    __device__ __forceinline__ void prologue(const StaticOrder&, LAS unsigned char*, int) const {}
    const float* R; float* H; bf16_t* HB; float* part;
    __device__ __forceinline__ void operator()(f32x4 (&acc)[2][2][4][2], const Unit& u, int wr, int wc, int fr, int fq, LAS unsigned char* lds, int ui) const {
        const unsigned row0 = (unsigned)(u.pm * BM + wr * 64 + fr), col0 = (unsigned)(u.pn * BM + wc * 32 + 4 * fq);
        const unsigned ofs = (row0 * DM + col0) * 4u, pofs = (row0 * 16u + (unsigned)(u.pn * 4 + wc)) * 4u;
#pragma unroll
        for (int ai = 0; ai < 2; ++ai)
#pragma unroll
            for (int m = 0; m < 4; ++m) { const unsigned o = ofs + (unsigned)((ai * HALF + m * 16) * DM) * 4u; float ss = 0.f;
#pragma unroll
                for (int bj = 0; bj < 2; ++bj)
#pragma unroll
                    for (int n = 0; n < 2; ++n) { const unsigned oo = o + (unsigned)(bj * HALF + n * 16) * 4u;
                        const f32x4 xv = *(const f32x4*)((const char*)R + oo); const f32x4 h = xv + acc[ai][bj][m][n];
                        *(f32x4*)((char*)H + oo) = h; ss += (h[0] * h[0] + h[1] * h[1]) + (h[2] * h[2] + h[3] * h[3]);
                        if (WRITE_HB) { u32x2 w; w.x = pkbf(h[0], h[1]); w.y = pkbf(h[2], h[3]); *(u32x2*)((char*)HB + (oo >> 1)) = w; } }
                ss += xor_get(ss, fq * 16 + fr, 16); ss += xor_get(ss, fq * 16 + fr, 32);
                if (fq == 0) *(float*)((char*)part + (pofs + (unsigned)(ai * HALF + m * 16) * 64u)) = ss;
                asm volatile("" ::: "memory"); }
    }
};
__device__ __forceinline__ float row_rstd_b(const float* part, unsigned bofs) {
    const f32x4* p = (const f32x4*)((const char*)part + bofs); const f32x4 a = p[0], b = p[1], c = p[2], d = p[3];
    return __builtin_amdgcn_rsqf((((a[0] + a[1]) + (a[2] + a[3])) + ((b[0] + b[1]) + (b[2] + b[3])) + ((c[0] + c[1]) + (c[2] + c[3])) + ((d[0] + d[1]) + (d[2] + d[3]))) * (1.0f / DM) + EPS);
}
__device__ __forceinline__ float dpp_shr_mul(float v, const int n) {
    const int iv = __builtin_bit_cast(int, v), one = 0x3f800000; int r;
    if (n == 1) r = __builtin_amdgcn_update_dpp(one, iv, 0x111, 0xf, 0xf, false); else if (n == 2) r = __builtin_amdgcn_update_dpp(one, iv, 0x112, 0xf, 0xf, false);
    else if (n == 4) r = __builtin_amdgcn_update_dpp(one, iv, 0x114, 0xf, 0xf, false); else r = __builtin_amdgcn_update_dpp(one, iv, 0x118, 0xf, 0xf, false);
    return v * __builtin_bit_cast(float, r);
}
constexpr unsigned TAB_OFF = 131072u + 256u;
struct EpiP4 {
    static constexpr bool PERM = true, AFTER_DRAIN = false;
    bf16_t* Qt; bf16_t* Kt; bf16_t* V; float* DEC; const float* part; const float* lbnd;
    __device__ __forceinline__ void prologue(const StaticOrder& S, LAS unsigned char* lds, int tid) const {
        LAS float* T = (LAS float*)(lds + TAB_OFF); Unit u;
        for (int i = 0; i < 12 && S.next(i, u); ++i)
            if (tid < 256) T[i * 256 + tid] = row_rstd_b(part, (unsigned)(u.pm * BM + tid) * 64u);
        __syncthreads();
    }
    __device__ __forceinline__ void operator()(f32x4 (&acc)[2][2][4][2], const Unit& u, int wr, int wc, int fr, int fq, LAS unsigned char* lds, int ui) const {
        const unsigned row0 = (unsigned)(u.pm * BM + wr * 64 + fr);
        const LAS float* T = (const LAS float*)(lds + TAB_OFF) + ui * 256 + wr * 64 + fr;
        if (u.pn >= 16) {
            const unsigned vofs = (row0 * DI + (unsigned)((u.pn - 16) * BM + wc * 32 + 8 * fq)) * 2u;
#pragma unroll
            for (int ai = 0; ai < 2; ++ai)
#pragma unroll
                for (int m = 0; m < 4; ++m) { const float rs = T[ai * HALF + m * 16];
#pragma unroll
                    for (int bj = 0; bj < 2; ++bj) { const f32x4 v0 = acc[ai][bj][m][0] * rs, v1 = acc[ai][bj][m][1] * rs;
                        u32x4 w; w.x = pkbf(v0[0], v0[1]); w.y = pkbf(v0[2], v0[3]); w.z = pkbf(v1[0], v1[1]); w.w = pkbf(v1[2], v1[3]);
                        *(u32x4*)((char*)V + (vofs + (unsigned)((ai * HALF + m * 16) * DI + bj * HALF) * 2u)) = w; } }
            return;
        }
        const unsigned c0 = (unsigned)(u.pn * HD + wc * 32 + 8 * fq);
        const unsigned qofs = (row0 * DI + c0) * 2u;
#pragma unroll
        for (int ai = 0; ai < 2; ++ai) {
            float rs[4];
#pragma unroll
            for (int m = 0; m < 4; ++m) rs[m] = T[ai * HALF + m * 16];
            unsigned cc = c0; asm volatile("" : "+v"(cc));
#pragma unroll
            for (int n = 0; n < 2; ++n) {
                const f32x4 l0 = *(const f32x4*)((const char*)lbnd + (cc + 4 * n) * 4u), l1 = *(const f32x4*)((const char*)lbnd + (cc + 4 * n + DI) * 4u);
                f32x4 decv;
#pragma unroll
                for (int j = 0; j < 4; ++j) { const float ex = __expf(l0[j] - l1[j]); const float lb = __builtin_amdgcn_rcpf(1.0f + ex), omlb = ex * lb; float bprod = 1.0f;
#pragma unroll
                    for (int m = 0; m < 4; ++m) {
                        const float qv = acc[ai][0][m][n][j] * rs[m], z = acc[ai][1][m][n][j] * rs[m];
                        const float sg = __builtin_amdgcn_rcpf(1.0f + __builtin_amdgcn_exp2f(-1.44269504089f * z));
                        const float f = lb + omlb * sg, k = omlb * (1.0f - sg);
                        float s = f; s = dpp_shr_mul(s, 1); s = dpp_shr_mul(s, 2); s = dpp_shr_mul(s, 4); s = dpp_shr_mul(s, 8);
                        const float E = bprod * s;
                        if (m < 3) bprod *= lane_get(s, fq * 16 + 15);
                        const float Ei = __builtin_amdgcn_rcpf(fmaxf(E, 7.9e-31f));
                        acc[ai][0][m][n][j] = qv * E; acc[ai][1][m][n][j] = k * Ei;
                        if (m == 3) decv[j] = E;
                    } }
                if (fr == 15) *(f32x4*)((char*)DEC + ((unsigned)(u.pm * 4 + ai * 2 + wr) * DI + cc + 4 * n) * 4u) = decv;
            }
#pragma unroll
            for (int m = 0; m < 4; ++m) { const unsigned ob = qofs + (unsigned)((ai * HALF + m * 16) * DI) * 2u;
                u32x4 w; w.x = pkbf(acc[ai][0][m][0][0], acc[ai][0][m][0][1]); w.y = pkbf(acc[ai][0][m][0][2], acc[ai][0][m][0][3]); w.z = pkbf(acc[ai][0][m][1][0], acc[ai][0][m][1][1]); w.w = pkbf(acc[ai][0][m][1][2], acc[ai][0][m][1][3]);
                *(u32x4*)((char*)Qt + ob) = w;
                u32x4 x; x.x = pkbf(acc[ai][1][m][0][0], acc[ai][1][m][0][1]); x.y = pkbf(acc[ai][1][m][0][2], acc[ai][1][m][0][3]); x.z = pkbf(acc[ai][1][m][1][0], acc[ai][1][m][1][1]); x.w = pkbf(acc[ai][1][m][1][2], acc[ai][1][m][1][3]);
                *(u32x4*)((char*)Kt + ob) = x; }
            asm volatile("" ::: "memory");
        }
    }
};
struct EpiP5b {
    static constexpr bool PERM = true, AFTER_DRAIN = false;
    bf16_t* O; const float* part; const float* ss;
    __device__ __forceinline__ void prologue(const StaticOrder& S, LAS unsigned char* lds, int tid) const {
        LAS float* T = (LAS float*)(lds + TAB_OFF); Unit u;
        for (int i = 0; i < 4 && S.next(i, u); ++i) {
            if (tid < 256) T[i * 768 + tid] = row_rstd_b(part, (unsigned)(u.pm * BM + tid) * 64u);
            { const int r = tid >> 1, hh = tid & 1; const f32x4* sp = (const f32x4*)(ss + (size_t)(u.pm * BM + r) * 128 + (u.pn * 2 + hh) * 8); const f32x4 s0 = sp[0], s1 = sp[1];
              T[i * 768 + 256 + tid] = __builtin_amdgcn_rsqf((((s0[0] + s0[1]) + (s0[2] + s0[3])) + ((s1[0] + s1[1]) + (s1[2] + s1[3]))) * (1.0f / HD) + EPS); }
        }
        __syncthreads();
    }
    __device__ __forceinline__ void operator()(f32x4 (&acc)[2][2][4][2], const Unit& u, int wr, int wc, int fr, int fq, LAS unsigned char* lds, int ui) const {
        const unsigned row0 = (unsigned)(u.pm * BM + wr * 64 + fr), col0 = (unsigned)(u.pn * BM + wc * 32 + 8 * fq);
        const LAS float* T = (const LAS float*)(lds + TAB_OFF) + ui * 768 + wr * 64 + fr;
        const unsigned oofs = (row0 * DI + col0) * 2u;
#pragma unroll
        for (int ai = 0; ai < 2; ++ai) {
            u32x4 ov[4][2];
#pragma unroll
            for (int m = 0; m < 4; ++m)
#pragma unroll
                for (int bj = 0; bj < 2; ++bj) ov[m][bj] = *(const u32x4*)((const char*)O + (oofs + (unsigned)((ai * HALF + m * 16) * DI + bj * HALF) * 2u));
#pragma unroll
            for (int m = 0; m < 4; ++m) { const int rl = ai * HALF + m * 16; const float rs = T[rl];
#pragma unroll
                for (int bj = 0; bj < 2; ++bj) { const f32x4 v0 = acc[ai][bj][m][0] * rs, v1 = acc[ai][bj][m][1] * rs;
                    const float rh = T[256 + 2 * rl + bj + (wr * 64 + fr)];
                    const u32x4 s = ov[m][bj];
                    u32x4 w; w.x = pkbf(bf_lo(s.x) * rh * silu_f(v0[0]), bf_hi(s.x) * rh * silu_f(v0[1])); w.y = pkbf(bf_lo(s.y) * rh * silu_f(v0[2]), bf_hi(s.y) * rh * silu_f(v0[3]));
                    w.z = pkbf(bf_lo(s.z) * rh * silu_f(v1[0]), bf_hi(s.z) * rh * silu_f(v1[1])); w.w = pkbf(bf_lo(s.w) * rh * silu_f(v1[2]), bf_hi(s.w) * rh * silu_f(v1[3]));
                    *(u32x4*)((char*)O + (oofs + (unsigned)((ai * HALF + m * 16) * DI + bj * HALF) * 2u)) = w; } }
            asm volatile("" ::: "memory"); }
    }
};
struct EpiFinal {
    static constexpr bool PERM = false, AFTER_DRAIN = false;
    float* H; const float* fg; float* X; unsigned* cnt;
    __device__ __forceinline__ void prologue(const StaticOrder&, LAS unsigned char*, int) const {}
    __device__ __forceinline__ void operator()(f32x4 (&acc)[2][2][4][2], const Unit& u, int wr, int wc, int fr, int fq, LAS unsigned char* lds, int ui) const {
        LAS float* Pt = (LAS float*)(lds + TAB_OFF);
        LAS float* St = Pt + 1024;
        const int tid = (wr * 4 + wc) * 64 + fq * 16 + fr;
        const unsigned row0 = (unsigned)(u.pm * BM + wr * 64 + fr), col0 = (unsigned)(u.pn * BM + wc * 32 + 4 * fq);
        const unsigned ofs = (row0 * DM + col0) * 4u;
#pragma unroll
        for (int ai = 0; ai < 2; ++ai)
#pragma unroll
            for (int m = 0; m < 4; ++m) { float ss = 0.f;
#pragma unroll
                for (int bj = 0; bj < 2; ++bj)
#pragma unroll
                    for (int n = 0; n < 2; ++n) { const unsigned oo = ofs + (unsigned)((ai * HALF + m * 16) * DM + bj * HALF + n * 16) * 4u;
                        const f32x4 h = acc[ai][bj][m][n] + *(const f32x4*)((const char*)H + oo); acc[ai][bj][m][n] = h;
                        ss += (h[0] * h[0] + h[1] * h[1]) + (h[2] * h[2] + h[3] * h[3]); }
                ss += xor_get(ss, fq * 16 + fr, 16); ss += xor_get(ss, fq * 16 + fr, 32);
                if (fq == 0) Pt[(ai * HALF + wr * 64 + m * 16 + fr) * 4 + wc] = ss;
                asm volatile("" ::: "memory"); }
        __syncthreads();
        float* xs = X + (size_t)u.pm * 1024;
        if (tid < 256) { const f32x4 p = *(const LAS f32x4*)(Pt + tid * 4);
            __hip_atomic_store(xs + u.pn * 256 + tid, (p[0] + p[1]) + (p[2] + p[3]), __ATOMIC_RELAXED, __HIP_MEMORY_SCOPE_AGENT); }
        asm volatile("s_waitcnt vmcnt(0)" ::: "memory");
        __syncthreads();
        if (tid == 0) {
            unsigned* c = cnt + 16 * u.pm;
            __hip_atomic_fetch_add(c, 1u, __ATOMIC_RELAXED, __HIP_MEMORY_SCOPE_AGENT);
            unsigned spins = 0;
            while (__hip_atomic_load(c, __ATOMIC_RELAXED, __HIP_MEMORY_SCOPE_AGENT) < 4u) { __builtin_amdgcn_s_sleep(2); if (++spins > (1u << 22)) break; }
            __builtin_amdgcn_fence(__ATOMIC_ACQUIRE, "agent");
            asm volatile("s_waitcnt vmcnt(0)" ::: "memory");
        }
        __syncthreads();
        if (tid < 256) { float s = 0.f;
#pragma unroll
            for (int t = 0; t < 4; ++t) s += __hip_atomic_load(xs + t * 256 + tid, __ATOMIC_RELAXED, __HIP_MEMORY_SCOPE_AGENT);
            St[tid] = __builtin_amdgcn_rsqf(s * (1.0f / DM) + EPS); }
        __syncthreads();
        f32x4 gv[2][2];
#pragma unroll
        for (int bj = 0; bj < 2; ++bj)
#pragma unroll
            for (int n = 0; n < 2; ++n) gv[bj][n] = *(const f32x4*)(fg + col0 + bj * HALF + n * 16);
#pragma unroll
        for (int ai = 0; ai < 2; ++ai)
#pragma unroll
            for (int m = 0; m < 4; ++m) { const float rs = St[ai * HALF + wr * 64 + m * 16 + fr];
#pragma unroll
                for (int bj = 0; bj < 2; ++bj)
#pragma unroll
                    for (int n = 0; n < 2; ++n) { const unsigned oo = ofs + (unsigned)((ai * HALF + m * 16) * DM + bj * HALF + n * 16) * 4u;
                        *(f32x4*)((char*)H + oo) = acc[ai][bj][m][n] * rs * gv[bj][n]; } }
        __syncthreads();
    }
};
}

namespace scan {
#define MFMA16(a, b, c) __builtin_amdgcn_mfma_f32_16x16x32_bf16((a), (b), (c), 0, 0, 0)
__device__ __forceinline__ unsigned offb(unsigned row, unsigned ch) { return 256u * row + 16u * (ch ^ (((row & 3u) << 2) | ((row >> 2) & 3u))); }
__device__ __forceinline__ unsigned voffv(unsigned r, unsigned cp) { return 128u * r + 32u * (cp ^ (((r >> 1) & 3u) ^ (((r >> 3) & 1u) << 1))); }
__device__ __forceinline__ bf16x8 tr2(unsigned a0, unsigned a1) {
    u32x2 lo, hi;
    asm volatile("ds_read_b64_tr_b16 %0, %2\n\tds_read_b64_tr_b16 %1, %3\n\ts_waitcnt lgkmcnt(0)" : "=&v"(lo), "=&v"(hi) : "v"(a0), "v"(a1) : "memory");
    const u32x4 r = {lo.x, lo.y, hi.x, hi.y}; return __builtin_bit_cast(bf16x8, r);
}
__device__ __forceinline__ void tr8(unsigned a0, unsigned a1, unsigned c0, unsigned c1, bf16x8& f00, bf16x8& f01, bf16x8& f10, bf16x8& f11) {
    u32x2 r0, r1, r2, r3, r4, r5, r6, r7;
    asm volatile("ds_read_b64_tr_b16 %0, %8\n\tds_read_b64_tr_b16 %1, %9\n\tds_read_b64_tr_b16 %2, %8 offset:8192\n\tds_read_b64_tr_b16 %3, %9 offset:8192\n\t"
                 "ds_read_b64_tr_b16 %4, %10\n\tds_read_b64_tr_b16 %5, %11\n\tds_read_b64_tr_b16 %6, %10 offset:8192\n\tds_read_b64_tr_b16 %7, %11 offset:8192\n\ts_waitcnt lgkmcnt(0)"
                 : "=&v"(r0), "=&v"(r1), "=&v"(r2), "=&v"(r3), "=&v"(r4), "=&v"(r5), "=&v"(r6), "=&v"(r7) : "v"(a0), "v"(a1), "v"(c0), "v"(c1) : "memory");
    const u32x4 x00 = {r0.x, r0.y, r1.x, r1.y}, x01 = {r2.x, r2.y, r3.x, r3.y}, x10 = {r4.x, r4.y, r5.x, r5.y}, x11 = {r6.x, r6.y, r7.x, r7.y};
    f00 = __builtin_bit_cast(bf16x8, x00); f01 = __builtin_bit_cast(bf16x8, x01); f10 = __builtin_bit_cast(bf16x8, x10); f11 = __builtin_bit_cast(bf16x8, x11);
}
__device__ __forceinline__ bf16x8 pack8(const f32x4 a, const f32x4 b) { const u32x4 r = {pkbf(a[0], a[1]), pkbf(a[2], a[3]), pkbf(b[0], b[1]), pkbf(b[2], b[3])}; return __builtin_bit_cast(bf16x8, r); }
template <int NJ>
__device__ __forceinline__ f32x4 ttile(LAS unsigned char* lds, unsigned ldsb, unsigned QI, unsigned KI, unsigned VI, int it, const bf16x8 (&sfrag)[4],
                                       unsigned vs, unsigned l15, unsigned g, unsigned ql, unsigned p) {
    const unsigned trow = 16u * (unsigned)it + l15;
    bf16x8 qb[4];
#pragma unroll
    for (int kd = 0; kd < 4; ++kd) qb[kd] = *(const LAS bf16x8*)(lds + QI + offb(trow, 4u * kd + g));
    f32x4 c[NJ];
#pragma unroll
    for (int j = 0; j < NJ; ++j) { c[j] = (f32x4){0.f, 0.f, 0.f, 0.f};
        if (j <= it) {
#pragma unroll
            for (int kd = 0; kd < 4; ++kd) { const bf16x8 a = *(const LAS bf16x8*)(lds + KI + offb(16u * j + l15, 4u * kd + g)); c[j] = MFMA16(a, qb[kd], c[j]); }
            if (j == it) {
#pragma unroll
                for (int r = 0; r < 4; ++r) c[j][r] = (4u * g + r <= l15) ? c[j][r] : 0.f; } } }
    f32x4 o = (f32x4){0.f, 0.f, 0.f, 0.f};
#pragma unroll
    for (int ks = 0; ks < NJ / 2; ++ks) if (2 * ks <= it) {
        const bf16x8 at = pack8(c[2 * ks], c[2 * ks + 1]);
        const bf16x8 vf = tr2(ldsb + VI + voffv(32u * ks + 4u * g + ql, vs) + 8u * p, ldsb + VI + voffv(32u * ks + 16u + 4u * g + ql, vs) + 8u * p);
        o = MFMA16(vf, at, o); }
#pragma unroll
    for (int kd = 0; kd < 4; ++kd) {
        const u32x2 q0 = *(const LAS u32x2*)(lds + QI + offb(trow, 4u * kd + (g >> 1)) + 8u * (g & 1)), q1 = *(const LAS u32x2*)(lds + QI + offb(trow, 4u * kd + 2u + (g >> 1)) + 8u * (g & 1));
        const u32x4 qq = {q0.x, q0.y, q1.x, q1.y};
        o = MFMA16(sfrag[kd], __builtin_bit_cast(bf16x8, qq), o); }
    return o;
}
__device__ __forceinline__ void phase(LAS unsigned char* lds, const bf16_t* Qt, const bf16_t* Kt, bf16_t* VO, const float* DEC, float* ss8, int bid, int G, int wave) {
    int lane_ = (int)__builtin_amdgcn_mbcnt_hi(~0u, __builtin_amdgcn_mbcnt_lo(~0u, 0u)); asm volatile("" : "+v"(lane_));
    const unsigned lane = (unsigned)lane_, tid = (unsigned)wave * 64u + lane, l15 = lane & 15u, g = lane >> 4, ql = l15 >> 2, p = lane & 3u;
    const unsigned vs = (unsigned)wave & 3u; const int th = wave >> 2, tA = th ? 1 : 0, tB = th ? 2 : 3;
    const unsigned ldsb = (unsigned)(uintptr_t)lds;
    const unsigned srow = tid >> 4, sch = tid & 15u, vrow = tid >> 3, vch = tid & 7u;
    for (int item = bid; item < BATCH * NHEAD * 2; item += G) {
        const int b = item >> 5, h = (item >> 1) & 15, half = item & 1;
        const size_t tokb = (size_t)b * SEQ;
        const bf16_t* qg = Qt + (tokb + srow) * DI + h * HD + sch * 8;
        const bf16_t* kg = Kt + (tokb + srow) * DI + h * HD + sch * 8;
        bf16_t* vg = VO + tokb * DI + h * HD + half * 64;
        f32x4 S[8]; bf16x8 sfrag[4];
#pragma unroll
        for (int i = 0; i < 8; ++i) S[i] = (f32x4){0.f, 0.f, 0.f, 0.f};
#pragma unroll
        for (int i = 0; i < 4; ++i) sfrag[i] = (bf16x8){0, 0, 0, 0, 0, 0, 0, 0};
        u32x4 rq0, rq1, rk0, rk1, rv; f32x4 rdec = (f32x4){0.f, 0.f, 0.f, 0.f};
        const float* dg = DEC + (size_t)(b * (SEQ / 64)) * DI + h * HD + (tid & 31u) * 4u;
#define SC_LOAD(n_) do { const size_t t0_ = (size_t)(n_) * 64; \
            rq0 = *(const u32x4*)(qg + t0_ * DI); rq1 = *(const u32x4*)(qg + (t0_ + 32) * DI); rk0 = *(const u32x4*)(kg + t0_ * DI); rk1 = *(const u32x4*)(kg + (t0_ + 32) * DI); \
            rv = *(const u32x4*)(vg + (t0_ + vrow) * DI + vch * 8); if (tid < 32u) rdec = *(const f32x4*)(dg + (size_t)(n_) * DI); } while (0)
#define SC_STORE(base_) do { *(LAS u32x4*)(lds + (base_) + offb(srow, sch)) = rq0; *(LAS u32x4*)(lds + (base_) + offb(srow + 32u, sch)) = rq1; \
            *(LAS u32x4*)(lds + (base_) + 16384u + offb(srow, sch)) = rk0; *(LAS u32x4*)(lds + (base_) + 16384u + offb(srow + 32u, sch)) = rk1; \
            *(LAS u32x4*)(lds + (base_) + 32768u + voffv(vrow, vch >> 1) + 16u * (vch & 1u)) = rv; \
            if (tid < 32u) *(LAS f32x4*)(lds + 81920u + ((base_) ? 512u : 0u) + tid * 16u) = rdec; } while (0)
        SC_LOAD(0); SC_STORE(0u); __syncthreads();
        for (int n = 0; n < SEQ / 64; ++n) {
            const unsigned QI = (unsigned)(n & 1) * 40960u, KI = QI + 16384u, VI = QI + 32768u;
            if (n + 1 < SEQ / 64) SC_LOAD(n + 1);
            const f32x4 oB = ttile<4>(lds, ldsb, QI, KI, VI, tB, sfrag, vs, l15, g, ql, p);
            const f32x4 oA = ttile<2>(lds, ldsb, QI, KI, VI, tA, sfrag, vs, l15, g, ql, p);
            {
                const bf16x8 vn0 = tr2(ldsb + VI + voffv(8u * g + ql, vs) + 8u * p, ldsb + VI + voffv(8u * g + 4u + ql, vs) + 8u * p);
                const bf16x8 vn1 = tr2(ldsb + VI + voffv(32u + 8u * g + ql, vs) + 8u * p, ldsb + VI + voffv(36u + 8u * g + ql, vs) + 8u * p);
                const LAS float* dcp = (const LAS float*)(lds + 81920u + (unsigned)(n & 1) * 512u) + 4u * g;
                const unsigned ka = ldsb + KI + offb(8u * g + ql, (p >> 1)) + 8u * (p & 1u), kb = ldsb + KI + offb(8u * g + 4u + ql, (p >> 1)) + 8u * (p & 1u);
#pragma unroll
                for (int i = 0; i < 8; i += 2) {
                    bf16x8 k00, k01, k10, k11;
                    tr8(ka ^ ((unsigned)i << 5), kb ^ ((unsigned)i << 5), ka ^ ((unsigned)(i + 1) << 5), kb ^ ((unsigned)(i + 1) << 5), k00, k01, k10, k11);
                    S[i] = MFMA16(k00, vn0, S[i]); S[i + 1] = MFMA16(k10, vn0, S[i + 1]); S[i] = MFMA16(k01, vn1, S[i]); S[i + 1] = MFMA16(k11, vn1, S[i + 1]); }
#pragma unroll
                for (int i = 0; i < 8; ++i) { const f32x4 dc = *(const LAS f32x4*)(dcp + 16 * i); S[i] = S[i] * dc; }
#pragma unroll
                for (int kd = 0; kd < 4; ++kd) sfrag[kd] = pack8(S[2 * kd], S[2 * kd + 1]);
            }
            if (n + 1 < SEQ / 64) SC_STORE((unsigned)((n + 1) & 1) * 40960u);
            {
                const size_t tlB = (size_t)n * 64 + 16u * (unsigned)tB + l15, tlA = (size_t)n * 64 + 16u * (unsigned)tA + l15;
                const u32x2 wB = {pkbf(oB[0], oB[1]), pkbf(oB[2], oB[3])}, wA = {pkbf(oA[0], oA[1]), pkbf(oA[2], oA[3])};
                *(u32x2*)(vg + tlB * DI + 16u * vs + 4u * g) = wB; *(u32x2*)(vg + tlA * DI + 16u * vs + 4u * g) = wA;
                float sB = (oB[0] * oB[0] + oB[1] * oB[1]) + (oB[2] * oB[2] + oB[3] * oB[3]), sA = (oA[0] * oA[0] + oA[1] * oA[1]) + (oA[2] * oA[2] + oA[3] * oA[3]);
                sB += xor_get(sB, (int)lane, 16); sA += xor_get(sA, (int)lane, 16); sB += xor_get(sB, (int)lane, 32); sA += xor_get(sA, (int)lane, 32);
                if (g == 0) { ss8[(tokb + tlB) * 128 + h * 8 + half * 4 + vs] = sB; ss8[(tokb + tlA) * 128 + h * 8 + half * 4 + vs] = sA; }
            }
            __syncthreads();
        }
#undef SC_LOAD
#undef SC_STORE
    }
}
#undef MFMA16
}

#define XB_TMO      128
#define XB_XCNT(j)  (256  + 64 * (j))
#define XB_XSUB(j)  (1280 + 64 * (j))
#define XB_XGEN(j)  (2304 + 64 * (j))
#define XB_TOP      3328
#define XB_TOPGEN   3392
#define XCD_BAR_WORDS 3456
#define XB_SPIN_CAP (1u << 18)
__device__ __forceinline__ unsigned xb_ld(unsigned* p)              { return __hip_atomic_load(p, __ATOMIC_RELAXED, __HIP_MEMORY_SCOPE_AGENT); }
__device__ __forceinline__ unsigned xb_add(unsigned* p, unsigned v) { return __hip_atomic_fetch_add(p, v, __ATOMIC_RELAXED, __HIP_MEMORY_SCOPE_AGENT); }
__device__ __forceinline__ unsigned xb_xcc_id() { return (unsigned)__builtin_amdgcn_s_getreg((3 << 11) | 20) & 0xFu; }
#define XB_SPIN(cond, bar) do { unsigned _sp = 0; while (cond) { __builtin_amdgcn_s_sleep(1); \
    if ((++_sp & 255u) == 0u) { if (xb_ld(&(bar)[XB_TMO])) break; if (_sp > XB_SPIN_CAP) { atomicAdd(&(bar)[XB_TMO], 1u); break; } } } } while (0)
struct XcdBarrier { unsigned* bar; unsigned x; volatile LAS unsigned* st; };
__device__ __forceinline__ XcdBarrier xcd_barrier_post(unsigned* bar, volatile LAS unsigned* st) {
    XcdBarrier b; b.bar = bar; b.x = xb_xcc_id(); b.st = st;
    if (threadIdx.x == 0) (void)xb_add(&bar[XB_XCNT(b.x)], 1u);
    return b;
}
__device__ __forceinline__ void xcd_barrier_complete(unsigned* bar, unsigned x, unsigned& nloc, unsigned& nx) {
    const unsigned G = gridDim.x * gridDim.y * gridDim.z;
    unsigned sum, cnt, mine, sp = 0u;
    for (;;) {
        sum = 0u; cnt = 0u; mine = 0u;
#pragma unroll
        for (unsigned j = 0; j < 16; ++j) { const unsigned c = xb_ld(&bar[XB_XCNT(j)]); sum += c; cnt += (c > 0u) ? 1u : 0u; mine = (j == x) ? c : mine; }
        if (sum == G) break;
        __builtin_amdgcn_s_sleep(1);
        if ((++sp & 255u) == 0u) { if (xb_ld(&bar[XB_TMO])) break; if (sp > XB_SPIN_CAP) { atomicAdd(&bar[XB_TMO], 1u); break; } }
    }
    nloc = mine > 0u ? mine : 1u; nx = cnt > 0u ? cnt : 1u;
}
__device__ __forceinline__ void xcd_barrier(const XcdBarrier& b) {
    asm volatile("s_waitcnt vmcnt(0)" ::: "memory");
    __syncthreads();
    if (threadIdx.x == 0) {
        unsigned* bar = b.bar;
        __builtin_amdgcn_s_waitcnt(0);
        unsigned nloc = b.st[0], nx = b.st[1];
        if (nloc == 0u) { xcd_barrier_complete(bar, b.x, nloc, nx); b.st[0] = nloc; b.st[1] = nx; }
        const unsigned old = xb_add(&bar[XB_XSUB(b.x)], 1u);
        const unsigned gen = old / nloc;
        if (old + 1u == (gen + 1u) * nloc) {
            __builtin_amdgcn_fence(__ATOMIC_RELEASE, "agent");
            asm volatile("s_waitcnt vmcnt(0)" ::: "memory");
            const unsigned og = xb_add(&bar[XB_TOP], 1u);
            const unsigned tg = og / nx;
            if (og + 1u == (tg + 1u) * nx) xb_add(&bar[XB_TOPGEN], 1u);
            else XB_SPIN(xb_ld(&bar[XB_TOPGEN]) == tg, bar);
            __builtin_amdgcn_fence(__ATOMIC_ACQUIRE, "agent");
            xb_add(&bar[XB_XGEN(b.x)], 1u);
            asm volatile("s_waitcnt vmcnt(0)" ::: "memory");
        } else {
            XB_SPIN(xb_ld(&bar[XB_XGEN(b.x)]) == gen, bar);
            __builtin_amdgcn_fence(__ATOMIC_ACQUIRE, "agent");
            asm volatile("s_waitcnt vmcnt(0)" ::: "memory");
        }
    }
    __syncthreads();
}

struct Args {
    const float* x; const float* norm_g; const float* pool_w_in; const float* pool_w_grp; const float* pool_scale; const float* pool_w_out;
    const float* hgrn_w_in; const float* hgrn_lb; const float* hgrn_norm_g; const float* hgrn_w_out; const float* final_g;
    float* out; unsigned char* ws;
};

__device__ __forceinline__ void transpose_item(const float* W, int K, int N, bf16_t* WT, int row_off, const float* ks, const float* ns, LAS float* scr, int item, int lane) {
    const int nblk = N / 32, kb = item / nblk, nb = item % nblk, k0 = 64 * kb, n0 = 32 * nb;
    const float nsv = ns ? ns[n0 + (lane & 31)] : 1.0f;
#pragma unroll 8
    for (int i = 0; i < 32; ++i) { const int kk = 2 * i + (lane >> 5); float w = W[(size_t)(k0 + kk) * N + n0 + (lane & 31)] * nsv; if (ks) w *= ks[k0 + kk]; scr[kk * 33 + (lane & 31)] = w; }
    asm volatile("s_waitcnt lgkmcnt(0)" ::: "memory");
    const int c = lane & 7;
#pragma unroll
    for (int j = 0; j < 4; ++j) { const int n = (lane >> 3) + 8 * j; const LAS float* s = scr + (8 * c) * 33 + n;
        u32x4 o; o.x = pk2(s[0 * 33], s[1 * 33]); o.y = pk2(s[2 * 33], s[3 * 33]); o.z = pk2(s[4 * 33], s[5 * 33]); o.w = pk2(s[6 * 33], s[7 * 33]);
        *(u32x4*)(WT + (size_t)(row_off + n0 + n) * K + k0 + 8 * c) = o; }
    asm volatile("s_waitcnt lgkmcnt(0)" ::: "memory");
}

__global__ void __launch_bounds__(512, 2) fwd_kernel(Args a) {
    extern __shared__ __attribute__((aligned(16))) unsigned char lds_raw[];
    LAS unsigned char* lds = (LAS unsigned char*)lds_raw;
    volatile LAS unsigned* xst = (volatile LAS unsigned*)(lds + 131072 + 64);
    if (threadIdx.x < 2) xst[threadIdx.x] = 0u;
    __syncthreads();
    const XcdBarrier xbar = xcd_barrier_post((unsigned*)a.ws, xst);
#define GRID_BAR() xcd_barrier(xbar)
    const int G = gridDim.x, bid = blockIdx.x;
    const int NGW = G * 8;
    const int wave = __builtin_amdgcn_readfirstlane((int)threadIdx.x >> 6);
#define PHASE_IDS int lane_ = (int)__builtin_amdgcn_mbcnt_hi(~0u, __builtin_amdgcn_mbcnt_lo(~0u, 0u)); asm volatile("" : "+v"(lane_)); const int lane = lane_, tid = wave * 64 + lane, gw = bid * 8 + wave; (void)gw; (void)tid;
    unsigned char* ws = a.ws;
    bf16_t* Wt_in0 = (bf16_t*)(ws + WS_WIN0); bf16_t* Wt_grp = (bf16_t*)(ws + WS_WGRP); bf16_t* Wt_out0 = (bf16_t*)(ws + WS_WOUT0);
    bf16_t* Wt_in1 = (bf16_t*)(ws + WS_WIN1); bf16_t* Wt_out1 = (bf16_t*)(ws + WS_WOUT1);
    float* part1 = (float*)(ws + WS_PART1); float* part2 = (float*)(ws + WS_PART2); float* ssb = (float*)(ws + WS_SS); float* decb = (float*)(ws + WS_DEC);
    bf16_t* XB = (bf16_t*)(ws + WS_XB); bf16_t* BA = (bf16_t*)(ws + WS_A); bf16_t* BB = (bf16_t*)(ws + WS_B); bf16_t* BC = (bf16_t*)(ws + WS_C);

    {
        PHASE_IDS
        LAS float* scr = (LAS float*)(lds + wave * 16384);
        constexpr int I_IN0 = (DM / 64) * (4096 / 32), I_GRP1 = (512 / 64) * (512 / 32), I_OUT = (DI / 64) * (DM / 32), I_IN1 = (DM / 64) * (8192 / 32);
        constexpr int NITEMS = I_IN0 + 4 * I_GRP1 + I_OUT + I_IN1 + I_OUT;
        for (int it = gw; it < NITEMS; it += NGW) {
            int r = it;
            if (r < I_IN0) { transpose_item(a.pool_w_in, DM, 4096, Wt_in0, 0, a.norm_g, nullptr, scr, r, lane); continue; } r -= I_IN0;
            if (r < 4 * I_GRP1) { const int g = r / I_GRP1; transpose_item(a.pool_w_grp + (size_t)g * 512 * 512, 512, 512, Wt_grp, g * 512, nullptr, a.pool_scale + g * 512, scr, r % I_GRP1, lane); continue; } r -= 4 * I_GRP1;
            if (r < I_OUT) { transpose_item(a.pool_w_out, DI, DM, Wt_out0, 0, nullptr, nullptr, scr, r, lane); continue; } r -= I_OUT;
            if (r < I_IN1) {
                const int n0 = 32 * (r % (8192 / 32)); int d0 = n0;
                if (n0 < 2048) d0 = 256 * (n0 >> 7) + (n0 & 127); else if (n0 < 4096) d0 = 256 * ((n0 - 2048) >> 7) + 128 + (n0 & 127);
                transpose_item(a.hgrn_w_in, DM, 8192, Wt_in1, d0 - n0, a.norm_g + DM, nullptr, scr, r, lane); continue; } r -= I_IN1;
            transpose_item(a.hgrn_w_out, DI, DM, Wt_out1, 0, a.hgrn_norm_g, nullptr, scr, r, lane);
        }
        for (int m = gw; m < M; m += NGW) {
            const f32x4* xr = (const f32x4*)(a.x + (size_t)m * DM) + lane;
            f32x4 v[4]; float s = 0.f;
#pragma unroll
            for (int j = 0; j < 4; ++j) { v[j] = xr[64 * j]; s += (v[j][0] * v[j][0] + v[j][1] * v[j][1]) + (v[j][2] * v[j][2] + v[j][3] * v[j][3]); }
            const float rstd = 1.0f / sqrtf(wave_sum(s, lane) * (1.0f / DM) + EPS);
            unsigned long long* o8 = (unsigned long long*)(XB + (size_t)m * DM) + lane;
#pragma unroll
            for (int j = 0; j < 4; ++j) o8[64 * j] = (unsigned long long)pk2(v[j][0] * rstd, v[j][1] * rstd) | ((unsigned long long)pk2(v[j][2] * rstd, v[j][3] * rstd) << 32);
        }
    }
    GRID_BAR();

    {
        pg8::Gemm g{XB, Wt_in0, DM, DM, DM, 0}; pg8::StaticOrder S; S.init(M, 4096, G, bid);
        pg8::EpiP1 E{BA, BB};
        pg8::gemm_phase<pg8::EpiP1>(lds, g, S, E, wave);
    }
    GRID_BAR();

    {
        PHASE_IDS
        constexpr int RUN = 64;
        const int nruns = (M / RUN) * (DI / 8);
        for (int idx = bid * 512 + tid; idx < nruns; idx += G * 512) {
            const int cgp = idx & 255, run = idx >> 8, grp = cgp >> 6, w = 2 << grp;
            const int m0 = run * RUN, t0 = m0 & (SEQ - 1);
            const bf16_t* vp = BA + (size_t)m0 * DI + cgp * 8; bf16_t* pp = BC + (size_t)m0 * DI + cgp * 8;
            float sum[8];
#pragma unroll
            for (int j = 0; j < 8; ++j) sum[j] = 0.f;
            if (t0 > 0) for (int k = 1; k < w; ++k) { const u32x4 vv = *(const u32x4*)(vp - (size_t)k * DI);
                sum[0] += bf_lo(vv.x); sum[1] += bf_hi(vv.x); sum[2] += bf_lo(vv.y); sum[3] += bf_hi(vv.y); sum[4] += bf_lo(vv.z); sum[5] += bf_hi(vv.z); sum[6] += bf_lo(vv.w); sum[7] += bf_hi(vv.w); }
#pragma unroll 4
            for (int i = 0; i < RUN; ++i) {
                const int t = t0 + i;
                const u32x4 vv = *(const u32x4*)(vp + (size_t)i * DI);
                float x[8] = {bf_lo(vv.x), bf_hi(vv.x), bf_lo(vv.y), bf_hi(vv.y), bf_lo(vv.z), bf_hi(vv.z), bf_lo(vv.w), bf_hi(vv.w)};
#pragma unroll
                for (int j = 0; j < 8; ++j) sum[j] += x[j];
                const int cnt = (t + 1) < w ? (t + 1) : w; const float inv = 1.0f / (float)cnt;
                u32x4 o; o.x = pkbf(sum[0] * inv - x[0], sum[1] * inv - x[1]); o.y = pkbf(sum[2] * inv - x[2], sum[3] * inv - x[3]);
                o.z = pkbf(sum[4] * inv - x[4], sum[5] * inv - x[5]); o.w = pkbf(sum[6] * inv - x[6], sum[7] * inv - x[7]);
                *(u32x4*)(pp + (size_t)i * DI) = o;
                if (t + 1 >= w) { const u32x4 uu = *(const u32x4*)(vp + (size_t)(i + 1 - w) * DI);
                    sum[0] -= bf_lo(uu.x); sum[1] -= bf_hi(uu.x); sum[2] -= bf_lo(uu.y); sum[3] -= bf_hi(uu.y); sum[4] -= bf_lo(uu.z); sum[5] -= bf_hi(uu.z); sum[6] -= bf_lo(uu.w); sum[7] -= bf_hi(uu.w); }
            }
        }
    }
    GRID_BAR();

    {
        pg8::Gemm g{BC, Wt_grp, DI, 512, 512, 2}; pg8::StaticOrder S; S.init(M, DI, G, bid);
        pg8::EpiP2 E{BB};
        pg8::gemm_phase<pg8::EpiP2>(lds, g, S, E, wave);
    }
    GRID_BAR();

    {
        pg8::Gemm g{BB, Wt_out0, DI, DI, DI, 0}; pg8::StaticOrder S; S.init(M, DM, G, bid);
        pg8::EpiRes<true> E{a.x, a.out, XB, part1};
        pg8::gemm_phase<pg8::EpiRes<true>>(lds, g, S, E, wave);
    }
    GRID_BAR();

    {
        pg8::Gemm g{XB, Wt_in1, DM, DM, DM, 0}; pg8::StaticOrder S; S.init(M, 6144, G, bid);
        pg8::EpiP4 E{BA, BB, BC, decb, part1, a.hgrn_lb};
        pg8::gemm_phase<pg8::EpiP4>(lds, g, S, E, wave);
    }
    GRID_BAR();

    scan::phase(lds, BA, BB, BC, decb, ssb, bid, G, wave);
    GRID_BAR();

    {
        pg8::Gemm g{XB, Wt_in1 + (size_t)6144 * DM, DM, DM, DM, 0}; pg8::StaticOrder S; S.init(M, DI, G, bid);
        pg8::EpiP5b E{BC, part1, ssb};
        pg8::gemm_phase<pg8::EpiP5b>(lds, g, S, E, wave);
    }
    GRID_BAR();

    {
        pg8::Gemm g{BC, Wt_out1, DI, DI, DI, 0}; pg8::StaticOrder S; S.init(M, DM, G, bid);
        pg8::EpiFinal E{a.out, a.final_g, (float*)(ws + WS_X), (unsigned*)(ws + WS_CNT)};
        pg8::gemm_phase<pg8::EpiFinal>(lds, g, S, E, wave);
    }
}

extern "C" void kernel_launch(void* const* d_in, const int* in_sizes, int n_in, void* d_out, int out_size, void* d_ws, size_t ws_size, hipStream_t stream) {
    static int grid = 0;
    if (grid == 0) {
        if (n_in != 11 || in_sizes[0] != M * DM || out_size != M * DM || ws_size < WS_END) { fprintf(stderr, "kernel_launch: unexpected shapes (n_in %d in0 %d out %d ws %zu)\n", n_in, n_in > 0 ? in_sizes[0] : -1, out_size, ws_size); grid = -1; return; }
        int dev = 0, cus = 0, per = 0;
        if (hipGetDevice(&dev) != hipSuccess || hipDeviceGetAttribute(&cus, hipDeviceAttributeMultiprocessorCount, dev) != hipSuccess) { grid = -1; return; }
        if (hipFuncSetAttribute((const void*)fwd_kernel, hipFuncAttributeMaxDynamicSharedMemorySize, LDS_BYTES) != hipSuccess) { fprintf(stderr, "kernel_launch: hipFuncSetAttribute failed\n"); grid = -1; return; }
        if (hipOccupancyMaxActiveBlocksPerMultiprocessor(&per, (const void*)fwd_kernel, 512, LDS_BYTES) != hipSuccess || per < 1) { fprintf(stderr, "kernel_launch: occupancy query says %d\n", per); (void)hipGetLastError(); grid = -1; return; }
        grid = cus;
        fprintf(stderr, "kernel_launch: cus %d per_cu %d grid %d\n", cus, per, grid);
    }
    if (grid < 0) return;
    if (hipMemsetAsync(d_ws, 0, 32768, stream) != hipSuccess) { fprintf(stderr, "kernel_launch: hipMemsetAsync failed\n"); return; }
    Args a{};
    a.x = (const float*)d_in[0]; a.norm_g = (const float*)d_in[1]; a.pool_w_in = (const float*)d_in[2]; a.pool_w_grp = (const float*)d_in[3];
    a.pool_scale = (const float*)d_in[4]; a.pool_w_out = (const float*)d_in[5]; a.hgrn_w_in = (const float*)d_in[6]; a.hgrn_lb = (const float*)d_in[7];
    a.hgrn_norm_g = (const float*)d_in[8]; a.hgrn_w_out = (const float*)d_in[9]; a.final_g = (const float*)d_in[10];
    a.out = (float*)d_out; a.ws = (unsigned char*)d_ws;
    void* args[] = {&a};
    hipError_t e = hipLaunchCooperativeKernel((void*)fwd_kernel, dim3(grid), dim3(512), args, LDS_BYTES, stream);
    if (e != hipSuccess) fprintf(stderr, "kernel_launch: cooperative launch failed: %s (grid %d)\n", hipGetErrorString(e), grid);
}
```

```cpp
#include <hip/hip_runtime.h>
#include <hip/hip_cooperative_groups.h>
#include <cstdio>
#include <cstdint>
namespace cg = cooperative_groups;

#define LAS __attribute__((address_space(3)))
typedef unsigned short bf16_t;
typedef short bf16x8 __attribute__((ext_vector_type(8)));
typedef float f32x4 __attribute__((ext_vector_type(4)));
typedef float f32x2 __attribute__((ext_vector_type(2)));
typedef unsigned u32x4 __attribute__((ext_vector_type(4)));
typedef unsigned u32x2 __attribute__((ext_vector_type(2)));

constexpr int DM = 1024, BATCH = 8, SEQ = 4096, DI = 2048, M = BATCH * SEQ;
constexpr int NHEAD = 16, HD = 128;
constexpr float EPS = 1e-6f;
constexpr size_t MiB = 1u << 20;
constexpr size_t WS_WIN0 = 2 * MiB;
constexpr size_t WS_WGRP = 10 * MiB;
constexpr size_t WS_WOUT0 = 12 * MiB;
constexpr size_t WS_WIN1 = 16 * MiB;
constexpr size_t WS_WOUT1 = 32 * MiB;
constexpr size_t WS_PART1 = 36 * MiB;
constexpr size_t WS_PART2 = 38 * MiB;
constexpr size_t WS_CNT = 16384;
constexpr size_t WS_X = 40 * MiB;
constexpr size_t WS_DEC = 44 * MiB;
constexpr size_t WS_SS = 112 * MiB;
constexpr size_t WS_XB = 48 * MiB;
constexpr size_t WS_A = 128 * MiB;
constexpr size_t WS_B = 256 * MiB;
constexpr size_t WS_C = 384 * MiB;
constexpr size_t WS_END = 512 * MiB;
constexpr int LDS_BYTES = 147456;

__device__ __forceinline__ unsigned f2bf(float f) { unsigned u = __builtin_bit_cast(unsigned, f); return (u + 0x7fffu + ((u >> 16) & 1u)) >> 16; }
__device__ __forceinline__ unsigned pk2(float lo, float hi) { return f2bf(lo) | (f2bf(hi) << 16); }
typedef __bf16 bf2_t __attribute__((ext_vector_type(2)));
__device__ __forceinline__ unsigned pkbf(float lo, float hi) { f32x2 v = {lo, hi}; return __builtin_bit_cast(unsigned, __builtin_convertvector(v, bf2_t)); }
__device__ __forceinline__ float bf_lo(unsigned w) { return __builtin_bit_cast(float, w << 16); }
__device__ __forceinline__ float bf_hi(unsigned w) { return __builtin_bit_cast(float, w & 0xffff0000u); }
__device__ __forceinline__ float silu_f(float x) { return x * __builtin_amdgcn_rcpf(1.0f + __builtin_amdgcn_exp2f(-1.44269504089f * x)); }
__device__ __forceinline__ float lane_get(float v, int src_lane) { return __builtin_bit_cast(float, __builtin_amdgcn_ds_bpermute(src_lane << 2, __builtin_bit_cast(int, v))); }
__device__ __forceinline__ float xor_get(float v, int lane, int m) { return lane_get(v, lane ^ m); }
__device__ __forceinline__ float wave_sum(float v, int lane) {
#pragma unroll
    for (int o = 1; o < 64; o <<= 1) v += xor_get(v, lane, o);
    return v;
}

namespace pg8 {
constexpr int BM = 256, BK = 64, HALF = 128, HTB = HALF * BK * 2, STAGE_BYTES = 8 * HTB, NXCD = 8, WGM = 8;
__host__ __device__ __forceinline__ int lds_byte(int r, int c) { const int st = (r >> 4) * 2 + (c >> 5), rr = r & 15, cc = c & 31, ob = rr * 64 + cc * 2; return st * 1024 + (ob ^ (((ob >> 9) & 1) << 5)); }
__host__ __device__ __forceinline__ void stage_rc(int b, int& R, int& C) { const int st = b / 1024, sb = b % 1024, swz = sb ^ (((sb >> 9) & 1) << 5); R = (st >> 1) * 16 + swz / 64; C = (st & 1) * 32 + (swz % 64) / 2; }
__host__ __device__ __forceinline__ int perm32(int rho) { const int n = rho >> 4, i = rho & 15; return 8 * (i >> 2) + 4 * n + (i & 3); }

struct Unit { int pm, pn; };
struct Gemm { const bf16_t* A; const bf16_t* Bt; int lda, ldb, K, grp_tiles; };

struct StaticOrder {
    int nM, nN, nwg, G, c;
    __host__ __device__ void init(int M_, int N_, int G_, int c_) { nM = M_ / BM; nN = N_ / BM; nwg = nM * nN; G = G_; c = c_; }
    __host__ __device__ bool next(int i, Unit& u) const {
        const long L = (long)i * G + c; if (L >= nwg) return false;
        int wgid = (int)L; { const int q = nwg / NXCD, r = nwg % NXCD, xcd = wgid % NXCD, off = wgid / NXCD; wgid = (xcd < r ? xcd * (q + 1) : r * (q + 1) + (xcd - r) * q) + off; }
        const int nig = WGM * nN, gid = wgid / nig, fm = gid * WGM, gsz = (nM - fm) < WGM ? (nM - fm) : WGM;
        u.pm = fm + ((wgid % nig) % gsz); u.pn = (wgid % nig) / gsz; return true;
    }
};

__device__ __forceinline__ unsigned cvt_pk_bf16(float lo, float hi) { unsigned r; asm volatile("v_cvt_pk_bf16_f32 %0, %1, %2" : "=v"(r) : "v"(lo), "v"(hi)); return r; }

template <class Epi, bool ALIGN_EPI = true, bool SP2 = true>
__device__ __forceinline__ void gemm_phase(LAS unsigned char* lds, const Gemm g, const StaticOrder& S, const Epi& E, const int wid) {
    int lane_ = (int)__builtin_amdgcn_mbcnt_hi(~0u, __builtin_amdgcn_mbcnt_lo(~0u, 0u)); asm volatile("" : "+v"(lane_));
    int lane = lane_, tid = wid * 64 + lane, fr = lane & 15, fq = lane >> 4; const int wr = wid >> 2, wc = wid & 3;
    const int K = g.K, nt = K / BK;
    unsigned voffA[2], voffB[2]; int aoff, boff;
#define PG8_LANE_STATE() do { _Pragma("unroll") for (int i = 0; i < 2; ++i) { int R, C; stage_rc(tid * 16 + i * 8192, R, C); const int Rb = Epi::PERM ? ((R & ~31) + perm32(R & 31)) : R; \
        voffA[i] = (unsigned)(R * g.lda + C) * 2u; voffB[i] = (unsigned)(Rb * g.ldb + C) * 2u; } \
        aoff = lds_byte(wr * 64 + fr, fq * 8); boff = lds_byte(wc * 32 + fr, fq * 8); } while (0)
    PG8_LANE_STATE();
    const size_t kstep = (size_t)(BK * 2);
    const size_t hstepA = (size_t)HALF * g.lda * 2, hstepB = (size_t)HALF * g.ldb * 2;
    const size_t tstepA = 2 * hstepA, tstepB = 2 * hstepB;
    const unsigned ldsw = (unsigned)wid * 1024u;
#define PG8_SA(b, h) (((b) * 2 + (h)) * HTB)
#define PG8_SB(b, h) ((4 + (b) * 2 + (h)) * HTB)
#define PG8_STAGE(bufoff, gbase, voff) do { _Pragma("unroll") for (int _i = 0; _i < 2; ++_i) \
        __builtin_amdgcn_global_load_lds((const unsigned*)((const char*)(gbase) + (voff)[_i]), (LAS unsigned*)(lds + (bufoff) + ldsw + _i * 8192), 16, 0, 0); } while (0)
#define PG8_LDA(dst, b, h) do { _Pragma("unroll") for (int m = 0; m < 4; ++m) _Pragma("unroll") for (int k = 0; k < 2; ++k) dst[m][k] = *(const LAS bf16x8*)(lds + PG8_SA(b, h) + aoff + m * 2048 + k * 1024); } while (0)
#define PG8_LDB(dst, b, h) do { _Pragma("unroll") for (int n = 0; n < 2; ++n) _Pragma("unroll") for (int k = 0; k < 2; ++k) dst[n][k] = *(const LAS bf16x8*)(lds + PG8_SB(b, h) + boff + n * 2048 + k * 1024); } while (0)
#define PG8_MMA(ai, bj, At, Bt) do { __builtin_amdgcn_s_setprio(1); _Pragma("unroll") for (int m = 0; m < 4; ++m) _Pragma("unroll") for (int n = 0; n < 2; ++n) _Pragma("unroll") for (int k = 0; k < 2; ++k) \
        acc[ai][bj][m][n] = __builtin_amdgcn_mfma_f32_16x16x32_bf16(Bt[n][k], At[m][k], acc[ai][bj][m][n], 0, 0, 0); __builtin_amdgcn_s_setprio(0); } while (0)
#define PG8_WAIT_V(n) asm volatile("s_waitcnt vmcnt(" #n ")" ::: "memory")
#define PG8_WAIT_L(n) asm volatile("s_waitcnt lgkmcnt(" #n ")" ::: "memory")
#define PG8_BAR __builtin_amdgcn_s_barrier()
#define PG8_SCHED __builtin_amdgcn_sched_barrier(0)
#define PG8_ABASE(u) ((const char*)g.A + (size_t)(u).pm * tstepA + (g.grp_tiles ? (size_t)((u).pn / g.grp_tiles) * (size_t)K * 2 : (size_t)0))
#define PG8_BBASE(u) ((const char*)g.Bt + (size_t)(u).pn * tstepB)
    Unit cur, nxt; int ui = 0;
    E.prologue(S, lds, tid);
    if (!S.next(0, cur)) return;
    f32x4 acc[2][2][4][2];
#pragma unroll
    for (int a = 0; a < 2; ++a)
#pragma unroll
        for (int b = 0; b < 2; ++b)
#pragma unroll
            for (int m = 0; m < 4; ++m)
#pragma unroll
                for (int n = 0; n < 2; ++n) acc[a][b][m][n] = (f32x4){0.f, 0.f, 0.f, 0.f};
    bf16x8 At[4][2], B0[2][2], B1[2][2];
    const char* cA = PG8_ABASE(cur); const char* cB = PG8_BBASE(cur);
    if constexpr (SP2) {
        PG8_STAGE(PG8_SB(0, 0), cB, voffB); PG8_STAGE(PG8_SB(0, 1), cB + hstepB, voffB); PG8_STAGE(PG8_SA(0, 0), cA, voffA); PG8_STAGE(PG8_SA(0, 1), cA + hstepA, voffA);
        if (wr == 1) PG8_BAR;
        PG8_WAIT_V(2); PG8_BAR;
        PG8_STAGE(PG8_SB(1, 0), cB + kstep, voffB); PG8_STAGE(PG8_SA(1, 0), cA + kstep, voffA); PG8_STAGE(PG8_SB(1, 1), cB + hstepB + kstep, voffB);
        PG8_WAIT_V(6); PG8_BAR;
    } else {
        PG8_STAGE(PG8_SB(0, 0), cB, voffB); PG8_STAGE(PG8_SA(0, 0), cA, voffA); PG8_STAGE(PG8_SB(0, 1), cB + hstepB, voffB); PG8_STAGE(PG8_SA(0, 1), cA + hstepA, voffA);
        if (wr == 1) PG8_BAR;
        PG8_WAIT_V(4); PG8_BAR;
        PG8_STAGE(PG8_SB(1, 0), cB + kstep, voffB); PG8_STAGE(PG8_SA(1, 0), cA + kstep, voffA); PG8_STAGE(PG8_SB(1, 1), cB + hstepB + kstep, voffB);
        PG8_WAIT_V(6); PG8_BAR;
    }
    for (;;) {
        const bool has_next = S.next(ui + 1, nxt);
        const char* nA = has_next ? PG8_ABASE(nxt) : cA; const char* nB = has_next ? PG8_BBASE(nxt) : cB;
        for (int t = 0; t < nt; t += 2) {
            const bool last = (t == nt - 2);
            const char* a1 = cA + (size_t)(t + 1) * kstep;
            const char* a2 = last ? nA : cA + (size_t)(t + 2) * kstep; const char* b2 = last ? nB : cB + (size_t)(t + 2) * kstep;
            const char* a3 = a2 + kstep; const char* b3 = b2 + kstep;
            if constexpr (SP2) {
            PG8_LDB(B0, 0, 0); PG8_LDB(B1, 0, 1); PG8_SCHED; PG8_LDA(At, 0, 0); PG8_STAGE(PG8_SA(1, 1), a1 + hstepA, voffA);
            PG8_WAIT_V(8); PG8_WAIT_L(0); PG8_BAR; PG8_MMA(0, 0, At, B0); PG8_MMA(0, 1, At, B1); PG8_BAR; PG8_SCHED;
            PG8_LDA(At, 0, 1); PG8_STAGE(PG8_SB(0, 0), b2, voffB); PG8_STAGE(PG8_SB(0, 1), b2 + hstepB, voffB); PG8_STAGE(PG8_SA(0, 0), a2, voffA);
            PG8_WAIT_V(8); PG8_WAIT_L(0); PG8_BAR; PG8_MMA(1, 0, At, B0); PG8_MMA(1, 1, At, B1); PG8_BAR; PG8_SCHED;
            PG8_LDB(B0, 1, 0); PG8_LDB(B1, 1, 1); PG8_SCHED; PG8_LDA(At, 1, 0); PG8_STAGE(PG8_SA(0, 1), a2 + hstepA, voffA);
            PG8_WAIT_V(8); PG8_WAIT_L(0); PG8_BAR; PG8_MMA(0, 0, At, B0); PG8_MMA(0, 1, At, B1); PG8_BAR; PG8_SCHED;
            PG8_LDA(At, 1, 1); PG8_STAGE(PG8_SB(1, 0), b3, voffB); PG8_STAGE(PG8_SB(1, 1), b3 + hstepB, voffB); PG8_STAGE(PG8_SA(1, 0), a3, voffA);
            PG8_WAIT_V(8); PG8_WAIT_L(0); PG8_BAR; PG8_MMA(1, 0, At, B0); PG8_MMA(1, 1, At, B1); PG8_BAR; PG8_SCHED;
            } else {
            PG8_LDB(B0, 0, 0); PG8_SCHED; PG8_LDA(At, 0, 0); PG8_STAGE(PG8_SA(1, 1), a1 + hstepA, voffA);
            PG8_WAIT_L(8); PG8_BAR; PG8_WAIT_L(0); PG8_MMA(0, 0, At, B0); PG8_BAR; PG8_SCHED;
            PG8_LDB(B1, 0, 1); PG8_STAGE(PG8_SB(0, 0), b2, voffB);
            PG8_BAR; PG8_WAIT_L(0); PG8_MMA(0, 1, At, B1); PG8_BAR;
            PG8_LDA(At, 0, 1); PG8_STAGE(PG8_SA(0, 0), a2, voffA);
            PG8_BAR; PG8_WAIT_L(0); PG8_MMA(1, 0, At, B0); PG8_BAR; PG8_SCHED;
            PG8_STAGE(PG8_SB(0, 1), b2 + hstepB, voffB);
            PG8_WAIT_V(6); PG8_BAR; PG8_MMA(1, 1, At, B1); PG8_BAR;
            PG8_LDB(B0, 1, 0); PG8_SCHED; PG8_LDA(At, 1, 0); PG8_STAGE(PG8_SA(0, 1), a2 + hstepA, voffA);
            PG8_WAIT_L(8); PG8_BAR; PG8_WAIT_L(0); PG8_MMA(0, 0, At, B0); PG8_BAR; PG8_SCHED;
            PG8_LDB(B1, 1, 1); PG8_STAGE(PG8_SB(1, 0), b3, voffB);
            PG8_BAR; PG8_WAIT_L(0); PG8_MMA(0, 1, At, B1); PG8_BAR;
            PG8_LDA(At, 1, 1); PG8_STAGE(PG8_SA(1, 0), a3, voffA);
            PG8_BAR; PG8_WAIT_L(0); PG8_MMA(1, 0, At, B0); PG8_BAR; PG8_SCHED;
            PG8_STAGE(PG8_SB(1, 1), b3 + hstepB, voffB);
            PG8_WAIT_V(6); PG8_BAR; PG8_MMA(1, 1, At, B1); PG8_BAR;
            }
        }
        if constexpr (ALIGN_EPI) { if (wr == 0) PG8_BAR; }
        if constexpr (!Epi::AFTER_DRAIN) E(acc, cur, wr, wc, fr, fq, lds, ui);
        if (!has_next) break;
#pragma unroll
        for (int a = 0; a < 2; ++a)
#pragma unroll
            for (int b = 0; b < 2; ++b)
#pragma unroll
                for (int m = 0; m < 4; ++m)
#pragma unroll
                    for (int n = 0; n < 2; ++n) acc[a][b][m][n] = (f32x4){0.f, 0.f, 0.f, 0.f};
        cur = nxt; cA = nA; cB = nB; ++ui;
        asm volatile("" : "+v"(lane)); tid = wid * 64 + lane; fr = lane & 15; fq = lane >> 4; PG8_LANE_STATE();
        if constexpr (ALIGN_EPI) { if (wr == 1) PG8_BAR; }
    }
    PG8_WAIT_V(0);
    if constexpr (!ALIGN_EPI) { if (wr == 0) PG8_BAR; }
    PG8_BAR;
    if constexpr (Epi::AFTER_DRAIN) E.fused(acc, cur, wr, wc, fr, fq, lds, tid);
#undef PG8_SA
#undef PG8_SB
#undef PG8_STAGE
#undef PG8_LDA
#undef PG8_LDB
#undef PG8_MMA
#undef PG8_WAIT_V
#undef PG8_WAIT_L
#undef PG8_BAR
#undef PG8_SCHED
#undef PG8_ABASE
#undef PG8_LANE_STATE
#undef PG8_BBASE
}

struct EpiP1 {
    static constexpr bool PERM = true, AFTER_DRAIN = false;
    __device__ __forceinline__ void prologue(const StaticOrder&, LAS unsigned char*, int) const {}
    bf16_t* V; bf16_t* SG;
    __device__ __forceinline__ void operator()(f32x4 (&acc)[2][2][4][2], const Unit& u, int wr, int wc, int fr, int fq, LAS unsigned char* lds, int ui) const {
        const int row0 = u.pm * BM + wr * 64 + fr; const bool gate = u.pn >= 8;
        bf16_t* base = gate ? SG : V; const int col0 = (u.pn & 7) * BM + wc * 32 + 8 * fq;
#pragma unroll
        for (int ai = 0; ai < 2; ++ai)
#pragma unroll
            for (int m = 0; m < 4; ++m) { bf16_t* rowp = base + (size_t)(row0 + ai * HALF + m * 16) * DI + col0;
#pragma unroll
                for (int bj = 0; bj < 2; ++bj) { f32x4 v0 = acc[ai][bj][m][0], v1 = acc[ai][bj][m][1];
                    if (gate) {
#pragma unroll
                        for (int j = 0; j < 4; ++j) { v0[j] = silu_f(v0[j]); v1[j] = silu_f(v1[j]); } }
                    u32x4 w; w.x = cvt_pk_bf16(v0[0], v0[1]); w.y = cvt_pk_bf16(v0[2], v0[3]); w.z = cvt_pk_bf16(v1[0], v1[1]); w.w = cvt_pk_bf16(v1[2], v1[3]);
                    *(u32x4*)(rowp + bj * HALF) = w; } }
    }
};
struct EpiP2 {
    static constexpr bool PERM = true, AFTER_DRAIN = false;
    __device__ __forceinline__ void prologue(const StaticOrder&, LAS unsigned char*, int) const {}
    bf16_t* Z;
    __device__ __forceinline__ void operator()(f32x4 (&acc)[2][2][4][2], const Unit& u, int wr, int wc, int fr, int fq, LAS unsigned char* lds, int ui) const {
        const int row0 = u.pm * BM + wr * 64 + fr; const int col0 = u.pn * BM + wc * 32 + 8 * fq;
#pragma unroll
        for (int ai = 0; ai < 2; ++ai)
#pragma unroll
            for (int m = 0; m < 4; ++m) { bf16_t* rowp = Z + (size_t)(row0 + ai * HALF + m * 16) * DI + col0;
#pragma unroll
                for (int bj = 0; bj < 2; ++bj) { const f32x4 v0 = acc[ai][bj][m][0], v1 = acc[ai][bj][m][1];
                    const u32x4 s = *(const u32x4*)(rowp + bj * HALF);
                    u32x4 w; w.x = cvt_pk_bf16(v0[0] * bf_lo(s.x), v0[1] * bf_hi(s.x)); w.y = cvt_pk_bf16(v0[2] * bf_lo(s.y), v0[3] * bf_hi(s.y));
                    w.z = cvt_pk_bf16(v1[0] * bf_lo(s.z), v1[1] * bf_hi(s.z)); w.w = cvt_pk_bf16(v1[2] * bf_lo(s.w), v1[3] * bf_hi(s.w));
                    *(u32x4*)(rowp + bj * HALF) = w; } }
    }
};
template <bool WRITE_HB, bool WRITE_H = true> struct EpiRes {
    static constexpr bool PERM = false, AFTER_DRAIN = false;
    __device__ __forceinline__ void prologue(const StaticOrder&, LAS unsigned char*, int) const {}
    const float* R; float* H; bf16_t* HB; float* part;
    __device__ __forceinline__ void operator()(f32x4 (&acc)[2][2][4][2], const Unit& u, int wr, int wc, int fr, int fq, LAS unsigned char* lds, int ui) const {
        const unsigned row0 = (unsigned)(u.pm * BM + wr * 64 + fr), col0 = (unsigned)(u.pn * BM + wc * 32 + 4 * fq);
        const unsigned ofs = (row0 * DM + col0) * 4u, pofs = (row0 * 16u + (unsigned)(u.pn * 4 + wc)) * 4u;
#pragma unroll
        for (int ai = 0; ai < 2; ++ai)
#pragma unroll
            for (int m = 0; m < 4; ++m) { const unsigned o = ofs + (unsigned)((ai * HALF + m * 16) * DM) * 4u; float ss = 0.f;
#pragma unroll
                for (int bj = 0; bj < 2; ++bj)
#pragma unroll
                    for (int n = 0; n < 2; ++n) { const unsigned oo = o + (unsigned)(bj * HALF + n * 16) * 4u;
                        const f32x4 xv = *(const f32x4*)((const char*)R + oo); const f32x4 h = xv + acc[ai][bj][m][n];
                        if (WRITE_H) *(f32x4*)((char*)H + oo) = h; ss += (h[0] * h[0] + h[1] * h[1]) + (h[2] * h[2] + h[3] * h[3]);
                        if (WRITE_HB) { u32x2 w; w.x = pkbf(h[0], h[1]); w.y = pkbf(h[2], h[3]); *(u32x2*)((char*)HB + (oo >> 1)) = w; } }
                ss += xor_get(ss, fq * 16 + fr, 16); ss += xor_get(ss, fq * 16 + fr, 32);
                if (fq == 0) *(float*)((char*)part + (pofs + (unsigned)(ai * HALF + m * 16) * 64u)) = ss;
                asm volatile("" ::: "memory"); }
    }
};
__device__ __forceinline__ float row_rstd_b(const float* part, unsigned bofs) {
    const f32x4* p = (const f32x4*)((const char*)part + bofs); const f32x4 a = p[0], b = p[1], c = p[2], d = p[3];
    return __builtin_amdgcn_rsqf((((a[0] + a[1]) + (a[2] + a[3])) + ((b[0] + b[1]) + (b[2] + b[3])) + ((c[0] + c[1]) + (c[2] + c[3])) + ((d[0] + d[1]) + (d[2] + d[3]))) * (1.0f / DM) + EPS);
}
__device__ __forceinline__ float dpp_shr_mul(float v, const int n) {
    const int iv = __builtin_bit_cast(int, v), one = 0x3f800000; int r;
    if (n == 1) r = __builtin_amdgcn_update_dpp(one, iv, 0x111, 0xf, 0xf, false); else if (n == 2) r = __builtin_amdgcn_update_dpp(one, iv, 0x112, 0xf, 0xf, false);
    else if (n == 4) r = __builtin_amdgcn_update_dpp(one, iv, 0x114, 0xf, 0xf, false); else r = __builtin_amdgcn_update_dpp(one, iv, 0x118, 0xf, 0xf, false);
    return v * __builtin_bit_cast(float, r);
}
constexpr unsigned TAB_OFF = 131072u + 256u;
struct EpiP4 {
    static constexpr bool PERM = true, AFTER_DRAIN = false;
    bf16_t* Qt; bf16_t* Kt; bf16_t* V; float* DEC; const float* part; const float* lbnd;
    __device__ __forceinline__ void prologue(const StaticOrder& S, LAS unsigned char* lds, int tid) const {
        LAS float* T = (LAS float*)(lds + TAB_OFF); Unit u;
        for (int i = 0; i < 12 && S.next(i, u); ++i)
            if (tid < 256) T[i * 256 + tid] = row_rstd_b(part, (unsigned)(u.pm * BM + tid) * 64u);
        __syncthreads();
    }
    __device__ __forceinline__ void operator()(f32x4 (&acc)[2][2][4][2], const Unit& u, int wr, int wc, int fr, int fq, LAS unsigned char* lds, int ui) const {
        const unsigned row0 = (unsigned)(u.pm * BM + wr * 64 + fr);
        const LAS float* T = (const LAS float*)(lds + TAB_OFF) + ui * 256 + wr * 64 + fr;
        if (u.pn >= 16) {
            const unsigned vofs = (row0 * DI + (unsigned)((u.pn - 16) * BM + wc * 32 + 8 * fq)) * 2u;
#pragma unroll
            for (int ai = 0; ai < 2; ++ai)
#pragma unroll
                for (int m = 0; m < 4; ++m) { const float rs = T[ai * HALF + m * 16];
#pragma unroll
                    for (int bj = 0; bj < 2; ++bj) { const f32x4 v0 = acc[ai][bj][m][0] * rs, v1 = acc[ai][bj][m][1] * rs;
                        u32x4 w; w.x = pkbf(v0[0], v0[1]); w.y = pkbf(v0[2], v0[3]); w.z = pkbf(v1[0], v1[1]); w.w = pkbf(v1[2], v1[3]);
                        *(u32x4*)((char*)V + (vofs + (unsigned)((ai * HALF + m * 16) * DI + bj * HALF) * 2u)) = w; } }
            return;
        }
        const unsigned c0 = (unsigned)(u.pn * HD + wc * 32 + 8 * fq);
        const unsigned qofs = (row0 * DI + c0) * 2u;
#pragma unroll
        for (int ai = 0; ai < 2; ++ai) {
            float rs[4];
#pragma unroll
            for (int m = 0; m < 4; ++m) rs[m] = T[ai * HALF + m * 16];
            unsigned cc = c0; asm volatile("" : "+v"(cc));
#pragma unroll
            for (int n = 0; n < 2; ++n) {
                const f32x4 l0 = *(const f32x4*)((const char*)lbnd + (cc + 4 * n) * 4u), l1 = *(const f32x4*)((const char*)lbnd + (cc + 4 * n + DI) * 4u);
                f32x4 decv;
#pragma unroll
                for (int j = 0; j < 4; ++j) { const float ex = __expf(l0[j] - l1[j]); const float lb = __builtin_amdgcn_rcpf(1.0f + ex), omlb = ex * lb; float bprod = 1.0f;
#pragma unroll
                    for (int m = 0; m < 4; ++m) {
                        const float qv = acc[ai][0][m][n][j] * rs[m], z = acc[ai][1][m][n][j] * rs[m];
                        const float sg = __builtin_amdgcn_rcpf(1.0f + __builtin_amdgcn_exp2f(-1.44269504089f * z));
                        const float f = lb + omlb * sg, k = omlb * (1.0f - sg);
                        float s = f; s = dpp_shr_mul(s, 1); s = dpp_shr_mul(s, 2); s = dpp_shr_mul(s, 4); s = dpp_shr_mul(s, 8);
                        const float E = bprod * s;
                        if (m < 3) bprod *= lane_get(s, fq * 16 + 15);
                        const float Ei = __builtin_amdgcn_rcpf(fmaxf(E, 7.9e-31f));
                        acc[ai][0][m][n][j] = qv * E; acc[ai][1][m][n][j] = k * Ei;
                        if (m == 3) decv[j] = E;
                    } }
                if (fr == 15) *(f32x4*)((char*)DEC + ((unsigned)(u.pm * 4 + ai * 2 + wr) * DI + cc + 4 * n) * 4u) = decv;
            }
#pragma unroll
            for (int m = 0; m < 4; ++m) { const unsigned ob = qofs + (unsigned)((ai * HALF + m * 16) * DI) * 2u;
                u32x4 w; w.x = pkbf(acc[ai][0][m][0][0], acc[ai][0][m][0][1]); w.y = pkbf(acc[ai][0][m][0][2], acc[ai][0][m][0][3]); w.z = pkbf(acc[ai][0][m][1][0], acc[ai][0][m][1][1]); w.w = pkbf(acc[ai][0][m][1][2], acc[ai][0][m][1][3]);
                *(u32x4*)((char*)Qt + ob) = w;
                u32x4 x; x.x = pkbf(acc[ai][1][m][0][0], acc[ai][1][m][0][1]); x.y = pkbf(acc[ai][1][m][0][2], acc[ai][1][m][0][3]); x.z = pkbf(acc[ai][1][m][1][0], acc[ai][1][m][1][1]); x.w = pkbf(acc[ai][1][m][1][2], acc[ai][1][m][1][3]);
                *(u32x4*)((char*)Kt + ob) = x; }
            asm volatile("" ::: "memory");
        }
    }
};
struct EpiP5b {
    static constexpr bool PERM = true, AFTER_DRAIN = false;
    bf16_t* O; const float* part; const float* ss;
    __device__ __forceinline__ void prologue(const StaticOrder& S, LAS unsigned char* lds, int tid) const {
        LAS float* T = (LAS float*)(lds + TAB_OFF); Unit u;
        for (int i = 0; i < 4 && S.next(i, u); ++i) {
            if (tid < 256) T[i * 768 + tid] = row_rstd_b(part, (unsigned)(u.pm * BM + tid) * 64u);
            { const int r = tid >> 1, hh = tid & 1; const f32x4* sp = (const f32x4*)(ss + (size_t)(u.pm * BM + r) * 128 + (u.pn * 2 + hh) * 8); const f32x4 s0 = sp[0], s1 = sp[1];
              T[i * 768 + 256 + tid] = __builtin_amdgcn_rsqf((((s0[0] + s0[1]) + (s0[2] + s0[3])) + ((s1[0] + s1[1]) + (s1[2] + s1[3]))) * (1.0f / HD) + EPS); }
        }
        __syncthreads();
    }
    __device__ __forceinline__ void operator()(f32x4 (&acc)[2][2][4][2], const Unit& u, int wr, int wc, int fr, int fq, LAS unsigned char* lds, int ui) const {
        const unsigned row0 = (unsigned)(u.pm * BM + wr * 64 + fr), col0 = (unsigned)(u.pn * BM + wc * 32 + 8 * fq);
        const LAS float* T = (const LAS float*)(lds + TAB_OFF) + ui * 768 + wr * 64 + fr;
        const unsigned oofs = (row0 * DI + col0) * 2u;
#pragma unroll
        for (int ai = 0; ai < 2; ++ai) {
            u32x4 ov[4][2];
#pragma unroll
            for (int m = 0; m < 4; ++m)
#pragma unroll
                for (int bj = 0; bj < 2; ++bj) ov[m][bj] = *(const u32x4*)((const char*)O + (oofs + (unsigned)((ai * HALF + m * 16) * DI + bj * HALF) * 2u));
#pragma unroll
            for (int m = 0; m < 4; ++m) { const int rl = ai * HALF + m * 16; const float rs = T[rl];
#pragma unroll
                for (int bj = 0; bj < 2; ++bj) { const f32x4 v0 = acc[ai][bj][m][0] * rs, v1 = acc[ai][bj][m][1] * rs;
                    const float rh = T[256 + 2 * rl + bj + (wr * 64 + fr)];
                    const u32x4 s = ov[m][bj];
                    u32x4 w; w.x = pkbf(bf_lo(s.x) * rh * silu_f(v0[0]), bf_hi(s.x) * rh * silu_f(v0[1])); w.y = pkbf(bf_lo(s.y) * rh * silu_f(v0[2]), bf_hi(s.y) * rh * silu_f(v0[3]));
                    w.z = pkbf(bf_lo(s.z) * rh * silu_f(v1[0]), bf_hi(s.z) * rh * silu_f(v1[1])); w.w = pkbf(bf_lo(s.w) * rh * silu_f(v1[2]), bf_hi(s.w) * rh * silu_f(v1[3]));
                    *(u32x4*)((char*)O + (oofs + (unsigned)((ai * HALF + m * 16) * DI + bj * HALF) * 2u)) = w; } }
            asm volatile("" ::: "memory"); }
    }
};
struct EpiFinal {
    static constexpr bool PERM = false, AFTER_DRAIN = false;
    const bf16_t* HB; float* H; const float* fg; float* X; unsigned* cnt;
    __device__ __forceinline__ void prologue(const StaticOrder&, LAS unsigned char*, int) const {}
    __device__ __forceinline__ void operator()(f32x4 (&acc)[2][2][4][2], const Unit& u, int wr, int wc, int fr, int fq, LAS unsigned char* lds, int ui) const {
        LAS float* Pt = (LAS float*)(lds + TAB_OFF);
        LAS float* St = Pt + 1024;
        const int tid = (wr * 4 + wc) * 64 + fq * 16 + fr;
        const unsigned row0 = (unsigned)(u.pm * BM + wr * 64 + fr), col0 = (unsigned)(u.pn * BM + wc * 32 + 4 * fq);
        const unsigned ofs = (row0 * DM + col0) * 4u;
#pragma unroll
        for (int ai = 0; ai < 2; ++ai)
#pragma unroll
            for (int m = 0; m < 4; ++m) { float ss = 0.f;
#pragma unroll
                for (int bj = 0; bj < 2; ++bj)
#pragma unroll
                    for (int n = 0; n < 2; ++n) { const unsigned oo = ofs + (unsigned)((ai * HALF + m * 16) * DM + bj * HALF + n * 16) * 4u;
                        const u32x2 hb = *(const u32x2*)((const char*)HB + (oo >> 1));
                        const f32x4 h = acc[ai][bj][m][n] + (f32x4){bf_lo(hb.x), bf_hi(hb.x), bf_lo(hb.y), bf_hi(hb.y)}; acc[ai][bj][m][n] = h;
                        ss += (h[0] * h[0] + h[1] * h[1]) + (h[2] * h[2] + h[3] * h[3]); }
                ss += xor_get(ss, fq * 16 + fr, 16); ss += xor_get(ss, fq * 16 + fr, 32);
                if (fq == 0) Pt[(ai * HALF + wr * 64 + m * 16 + fr) * 4 + wc] = ss;
                asm volatile("" ::: "memory"); }
        __syncthreads();
        float* xs = X + (size_t)u.pm * 1024;
        if (tid < 256) { const f32x4 p = *(const LAS f32x4*)(Pt + tid * 4);
            __hip_atomic_store(xs + u.pn * 256 + tid, (p[0] + p[1]) + (p[2] + p[3]), __ATOMIC_RELAXED, __HIP_MEMORY_SCOPE_AGENT); }
        asm volatile("s_waitcnt vmcnt(0)" ::: "memory");
        __syncthreads();
        if (tid == 0) {
            unsigned* c = cnt + 16 * u.pm;
            __hip_atomic_fetch_add(c, 1u, __ATOMIC_RELAXED, __HIP_MEMORY_SCOPE_AGENT);
            unsigned spins = 0;
            while (__hip_atomic_load(c, __ATOMIC_RELAXED, __HIP_MEMORY_SCOPE_AGENT) < 4u) { __builtin_amdgcn_s_sleep(2); if (++spins > (1u << 22)) break; }
            __builtin_amdgcn_fence(__ATOMIC_ACQUIRE, "agent");
            asm volatile("s_waitcnt vmcnt(0)" ::: "memory");
        }
        __syncthreads();
        if (tid < 256) { float s = 0.f;
#pragma unroll
            for (int t = 0; t < 4; ++t) s += __hip_atomic_load(xs + t * 256 + tid, __ATOMIC_RELAXED, __HIP_MEMORY_SCOPE_AGENT);
            St[tid] = __builtin_amdgcn_rsqf(s * (1.0f / DM) + EPS); }
        __syncthreads();
        f32x4 gv[2][2];
#pragma unroll
        for (int bj = 0; bj < 2; ++bj)
#pragma unroll
            for (int n = 0; n < 2; ++n) gv[bj][n] = *(const f32x4*)(fg + col0 + bj * HALF + n * 16);
#pragma unroll
        for (int ai = 0; ai < 2; ++ai)
#pragma unroll
            for (int m = 0; m < 4; ++m) { const float rs = St[ai * HALF + wr * 64 + m * 16 + fr];
#pragma unroll
                for (int bj = 0; bj < 2; ++bj)
#pragma unroll
                    for (int n = 0; n < 2; ++n) { const unsigned oo = ofs + (unsigned)((ai * HALF + m * 16) * DM + bj * HALF + n * 16) * 4u;
                        *(f32x4*)((char*)H + oo) = acc[ai][bj][m][n] * rs * gv[bj][n]; } }
        __syncthreads();
    }
};
}

namespace scan {
#define MFMA16(a, b, c) __builtin_amdgcn_mfma_f32_16x16x32_bf16((a), (b), (c), 0, 0, 0)
__device__ __forceinline__ unsigned offb(unsigned row, unsigned ch) { return 256u * row + 16u * (ch ^ (((row & 3u) << 2) | ((row >> 2) & 3u))); }
__device__ __forceinline__ unsigned voffv(unsigned r, unsigned cp) { return 128u * r + 32u * (cp ^ (((r >> 1) & 3u) ^ (((r >> 3) & 1u) << 1))); }
__device__ __forceinline__ bf16x8 tr2(unsigned a0, unsigned a1) {
    u32x2 lo, hi;
    asm volatile("ds_read_b64_tr_b16 %0, %2\n\tds_read_b64_tr_b16 %1, %3\n\ts_waitcnt lgkmcnt(0)" : "=&v"(lo), "=&v"(hi) : "v"(a0), "v"(a1) : "memory");
    const u32x4 r = {lo.x, lo.y, hi.x, hi.y}; return __builtin_bit_cast(bf16x8, r);
}
__device__ __forceinline__ void tr8(unsigned a0, unsigned a1, unsigned c0, unsigned c1, bf16x8& f00, bf16x8& f01, bf16x8& f10, bf16x8& f11) {
    u32x2 r0, r1, r2, r3, r4, r5, r6, r7;
    asm volatile("ds_read_b64_tr_b16 %0, %8\n\tds_read_b64_tr_b16 %1, %9\n\tds_read_b64_tr_b16 %2, %8 offset:8192\n\tds_read_b64_tr_b16 %3, %9 offset:8192\n\t"
                 "ds_read_b64_tr_b16 %4, %10\n\tds_read_b64_tr_b16 %5, %11\n\tds_read_b64_tr_b16 %6, %10 offset:8192\n\tds_read_b64_tr_b16 %7, %11 offset:8192\n\ts_waitcnt lgkmcnt(0)"
                 : "=&v"(r0), "=&v"(r1), "=&v"(r2), "=&v"(r3), "=&v"(r4), "=&v"(r5), "=&v"(r6), "=&v"(r7) : "v"(a0), "v"(a1), "v"(c0), "v"(c1) : "memory");
    const u32x4 x00 = {r0.x, r0.y, r1.x, r1.y}, x01 = {r2.x, r2.y, r3.x, r3.y}, x10 = {r4.x, r4.y, r5.x, r5.y}, x11 = {r6.x, r6.y, r7.x, r7.y};
    f00 = __builtin_bit_cast(bf16x8, x00); f01 = __builtin_bit_cast(bf16x8, x01); f10 = __builtin_bit_cast(bf16x8, x10); f11 = __builtin_bit_cast(bf16x8, x11);
}
__device__ __forceinline__ bf16x8 pack8(const f32x4 a, const f32x4 b) { const u32x4 r = {pkbf(a[0], a[1]), pkbf(a[2], a[3]), pkbf(b[0], b[1]), pkbf(b[2], b[3])}; return __builtin_bit_cast(bf16x8, r); }
__device__ __forceinline__ u32x2 tr_issue(unsigned a) { u32x2 r; asm volatile("ds_read_b64_tr_b16 %0, %1" : "=v"(r) : "v"(a) : "memory"); return r; }
__device__ __forceinline__ u32x2 tr_issue_hi(unsigned a) { u32x2 r; asm volatile("ds_read_b64_tr_b16 %0, %1 offset:8192" : "=v"(r) : "v"(a) : "memory"); return r; }
#define TRW(x) "+v"(x)
__device__ __forceinline__ void tr_wait20(u32x2 (&a)[20], bool do_wait) {
    if (do_wait) asm volatile("s_waitcnt lgkmcnt(0)" : TRW(a[0]), TRW(a[1]), TRW(a[2]), TRW(a[3]), TRW(a[4]), TRW(a[5]), TRW(a[6]), TRW(a[7]), TRW(a[8]), TRW(a[9]), TRW(a[10]), TRW(a[11]), TRW(a[12]), TRW(a[13]), TRW(a[14]), TRW(a[15]), TRW(a[16]), TRW(a[17]), TRW(a[18]), TRW(a[19]) :: "memory");
    else asm volatile("" : TRW(a[0]), TRW(a[1]), TRW(a[2]), TRW(a[3]), TRW(a[4]), TRW(a[5]), TRW(a[6]), TRW(a[7]), TRW(a[8]), TRW(a[9]), TRW(a[10]), TRW(a[11]), TRW(a[12]), TRW(a[13]), TRW(a[14]), TRW(a[15]), TRW(a[16]), TRW(a[17]), TRW(a[18]), TRW(a[19]) :: "memory");
}
#undef TRW
__device__ __forceinline__ bf16x8 frag2(const u32x2 lo, const u32x2 hi) { const u32x4 r = {lo.x, lo.y, hi.x, hi.y}; return __builtin_bit_cast(bf16x8, r); }
template <int NJ>
__device__ __forceinline__ void at_part(LAS unsigned char* lds, unsigned QI, unsigned KI, int it, unsigned l15, unsigned g, bf16x8 (&at)[NJ / 2]) {
    const unsigned trow = 16u * (unsigned)it + l15;
    bf16x8 qb[4];
#pragma unroll
    for (int kd = 0; kd < 4; ++kd) qb[kd] = *(const LAS bf16x8*)(lds + QI + offb(trow, 4u * kd + g));
    f32x4 c[NJ];
#pragma unroll
    for (int j = 0; j < NJ; ++j) { c[j] = (f32x4){0.f, 0.f, 0.f, 0.f};
        if (j <= it) {
#pragma unroll
            for (int kd = 0; kd < 4; ++kd) { const bf16x8 a = *(const LAS bf16x8*)(lds + KI + offb(16u * j + l15, 4u * kd + g)); c[j] = MFMA16(a, qb[kd], c[j]); }
            if (j == it) {
#pragma unroll
                for (int r = 0; r < 4; ++r) c[j][r] = (4u * g + r <= l15) ? c[j][r] : 0.f; } } }
#pragma unroll
    for (int ks = 0; ks < NJ / 2; ++ks) at[ks] = pack8(c[2 * ks], c[2 * ks + 1]);
}
template <int NK>
__device__ __forceinline__ f32x4 o_part(LAS unsigned char* lds, unsigned QI, int it, const bf16x8 (&at)[NK], const bf16x8 (&vf)[2], const bf16x8 (&sfrag)[4], unsigned l15, unsigned g) {
    const unsigned trow = 16u * (unsigned)it + l15;
    f32x4 o = (f32x4){0.f, 0.f, 0.f, 0.f};
#pragma unroll
    for (int ks = 0; ks < NK; ++ks) if (2 * ks <= it) o = MFMA16(vf[ks], at[ks], o);
#pragma unroll
    for (int kd = 0; kd < 4; ++kd) {
        const u32x2 q0 = *(const LAS u32x2*)(lds + QI + offb(trow, 4u * kd + (g >> 1)) + 8u * (g & 1)), q1 = *(const LAS u32x2*)(lds + QI + offb(trow, 4u * kd + 2u + (g >> 1)) + 8u * (g & 1));
        o = MFMA16(sfrag[kd], frag2(q0, q1), o); }
    return o;
}
__device__ __forceinline__ void phase(LAS unsigned char* lds, const bf16_t* Qt, const bf16_t* Kt, bf16_t* VO, const float* DEC, float* ss8, int bid, int G, int wave) {
    int lane_ = (int)__builtin_amdgcn_mbcnt_hi(~0u, __builtin_amdgcn_mbcnt_lo(~0u, 0u)); asm volatile("" : "+v"(lane_));
    const unsigned lane = (unsigned)lane_, tid = (unsigned)wave * 64u + lane, l15 = lane & 15u, g = lane >> 4, ql = l15 >> 2, p = lane & 3u;
    const unsigned vs = (unsigned)wave & 3u; const int th = wave >> 2, tA = th ? 1 : 0, tB = th ? 2 : 3;
    const unsigned ldsb = (unsigned)(uintptr_t)lds;
    const unsigned srow = tid >> 4, sch = tid & 15u, vrow = tid >> 3, vch = tid & 7u;
    for (int item = bid; item < BATCH * NHEAD * 2; item += G) {
        const int half = (item >> 3) & 1, pair = (item & 7) | ((item >> 4) << 3), b = pair >> 4, h = pair & 15;
        const size_t tokb = (size_t)b * SEQ;
        const bf16_t* qg = Qt + (tokb + srow) * DI + h * HD + sch * 8;
        const bf16_t* kg = Kt + (tokb + srow) * DI + h * HD + sch * 8;
        bf16_t* vg = VO + tokb * DI + h * HD + half * 64;
        f32x4 S[8]; bf16x8 sfrag[4];
#pragma unroll
        for (int i = 0; i < 8; ++i) S[i] = (f32x4){0.f, 0.f, 0.f, 0.f};
#pragma unroll
        for (int i = 0; i < 4; ++i) sfrag[i] = (bf16x8){0, 0, 0, 0, 0, 0, 0, 0};
        u32x4 rq0, rq1, rk0, rk1, rv; f32x4 rdec = (f32x4){0.f, 0.f, 0.f, 0.f};
        const float* dg = DEC + (size_t)(b * (SEQ / 64)) * DI + h * HD + (tid & 31u) * 4u;
#define SC_LOAD(n_) do { const size_t t0_ = (size_t)(n_) * 64; \
            rq0 = *(const u32x4*)(qg + t0_ * DI); rq1 = *(const u32x4*)(qg + (t0_ + 32) * DI); rk0 = *(const u32x4*)(kg + t0_ * DI); rk1 = *(const u32x4*)(kg + (t0_ + 32) * DI); \
            rv = *(const u32x4*)(vg + (t0_ + vrow) * DI + vch * 8); if (tid < 32u) rdec = *(const f32x4*)(dg + (size_t)(n_) * DI); } while (0)
#define SC_STORE(base_) do { *(LAS u32x4*)(lds + (base_) + offb(srow, sch)) = rq0; *(LAS u32x4*)(lds + (base_) + offb(srow + 32u, sch)) = rq1; \
            *(LAS u32x4*)(lds + (base_) + 16384u + offb(srow, sch)) = rk0; *(LAS u32x4*)(lds + (base_) + 16384u + offb(srow + 32u, sch)) = rk1; \
            *(LAS u32x4*)(lds + (base_) + 32768u + voffv(vrow, vch >> 1) + 16u * (vch & 1u)) = rv; \
            if (tid < 32u) *(LAS f32x4*)(lds + 81920u + ((base_) ? 512u : 0u) + tid * 16u) = rdec; } while (0)
        SC_LOAD(0); SC_STORE(0u); __syncthreads();
        for (int n = 0; n < SEQ / 64; ++n) {
            const unsigned QI = (unsigned)(n & 1) * 40960u, KI = QI + 16384u, VI = QI + 32768u;
            if (n + 1 < SEQ / 64) SC_LOAD(n + 1);
            u32x2 tv0, tv1, tv2, tv3, tv4, tv5, tv6, tv7;
            {
                const unsigned va = ldsb + VI + 8u * p;
                tv0 = tr_issue(va + voffv(4u * g + ql, vs)); tv1 = tr_issue(va + voffv(16u + 4u * g + ql, vs)); tv2 = tr_issue(va + voffv(32u + 4u * g + ql, vs)); tv3 = tr_issue(va + voffv(48u + 4u * g + ql, vs));
                tv4 = tr_issue(va + voffv(8u * g + ql, vs)); tv5 = tr_issue(va + voffv(8u * g + 4u + ql, vs)); tv6 = tr_issue(va + voffv(32u + 8u * g + ql, vs)); tv7 = tr_issue(va + voffv(36u + 8u * g + ql, vs));
            }
            bf16x8 atB[2], atA[1];
            at_part<4>(lds, QI, KI, tB, l15, g, atB);
            at_part<2>(lds, QI, KI, tA, l15, g, atA);
            asm volatile("s_waitcnt lgkmcnt(0)" : "+v"(tv0), "+v"(tv1), "+v"(tv2), "+v"(tv3), "+v"(tv4), "+v"(tv5), "+v"(tv6), "+v"(tv7) :: "memory");
            __builtin_amdgcn_sched_barrier(0);
            const bf16x8 vf[2] = {frag2(tv0, tv1), frag2(tv2, tv3)};
            const f32x4 oB = o_part<2>(lds, QI, tB, atB, vf, sfrag, l15, g);
            const f32x4 oA = o_part<1>(lds, QI, tA, atA, vf, sfrag, l15, g);
            {
                const bf16x8 vn0 = frag2(tv4, tv5), vn1 = frag2(tv6, tv7);
                const LAS float* dcp = (const LAS float*)(lds + 81920u + (unsigned)(n & 1) * 512u) + 4u * g;
                const unsigned ka = ldsb + KI + offb(8u * g + ql, (p >> 1)) + 8u * (p & 1u), kb = ldsb + KI + offb(8u * g + 4u + ql, (p >> 1)) + 8u * (p & 1u);
#pragma unroll
                for (int i = 0; i < 8; i += 2) {
                    bf16x8 k00, k01, k10, k11;
                    tr8(ka ^ ((unsigned)i << 5), kb ^ ((unsigned)i << 5), ka ^ ((unsigned)(i + 1) << 5), kb ^ ((unsigned)(i + 1) << 5), k00, k01, k10, k11);
                    S[i] = MFMA16(k00, vn0, S[i]); S[i + 1] = MFMA16(k10, vn0, S[i + 1]); S[i] = MFMA16(k01, vn1, S[i]); S[i + 1] = MFMA16(k11, vn1, S[i + 1]); }
#pragma unroll
                for (int i = 0; i < 8; ++i) { const f32x4 dc = *(const LAS f32x4*)(dcp + 16 * i); S[i] = S[i] * dc; }
#pragma unroll
                for (int kd = 0; kd < 4; ++kd) sfrag[kd] = pack8(S[2 * kd], S[2 * kd + 1]);
            }
            if (n + 1 < SEQ / 64) SC_STORE((unsigned)((n + 1) & 1) * 40960u);
            {
                const size_t tlB = (size_t)n * 64 + 16u * (unsigned)tB + l15, tlA = (size_t)n * 64 + 16u * (unsigned)tA + l15;
                const u32x2 wB = {pkbf(oB[0], oB[1]), pkbf(oB[2], oB[3])}, wA = {pkbf(oA[0], oA[1]), pkbf(oA[2], oA[3])};
                *(u32x2*)(vg + tlB * DI + 16u * vs + 4u * g) = wB; *(u32x2*)(vg + tlA * DI + 16u * vs + 4u * g) = wA;
                float sB = (oB[0] * oB[0] + oB[1] * oB[1]) + (oB[2] * oB[2] + oB[3] * oB[3]), sA = (oA[0] * oA[0] + oA[1] * oA[1]) + (oA[2] * oA[2] + oA[3] * oA[3]);
                sB += xor_get(sB, (int)lane, 16); sA += xor_get(sA, (int)lane, 16); sB += xor_get(sB, (int)lane, 32); sA += xor_get(sA, (int)lane, 32);
                if (g == 0) { ss8[(tokb + tlB) * 128 + h * 8 + half * 4 + vs] = sB; ss8[(tokb + tlA) * 128 + h * 8 + half * 4 + vs] = sA; }
            }
            __syncthreads();
        }
#undef SC_LOAD
#undef SC_STORE
    }
}
#undef MFMA16
}

#define XB_TMO      128
#define XB_XCNT(j)  (256  + 64 * (j))
#define XB_XSUB(j)  (1280 + 64 * (j))
#define XB_XGEN(j)  (2304 + 64 * (j))
#define XB_TOP      3328
#define XB_TOPGEN   3392
#define XCD_BAR_WORDS 3456
#define XB_SPIN_CAP (1u << 18)
__device__ __forceinline__ unsigned xb_ld(unsigned* p)              { return __hip_atomic_load(p, __ATOMIC_RELAXED, __HIP_MEMORY_SCOPE_AGENT); }
__device__ __forceinline__ unsigned xb_add(unsigned* p, unsigned v) { return __hip_atomic_fetch_add(p, v, __ATOMIC_RELAXED, __HIP_MEMORY_SCOPE_AGENT); }
__device__ __forceinline__ unsigned xb_xcc_id() { return (unsigned)__builtin_amdgcn_s_getreg((3 << 11) | 20) & 0xFu; }
#define XB_SPIN(cond, bar) do { unsigned _sp = 0; while (cond) { __builtin_amdgcn_s_sleep(1); \
    if ((++_sp & 255u) == 0u) { if (xb_ld(&(bar)[XB_TMO])) break; if (_sp > XB_SPIN_CAP) { atomicAdd(&(bar)[XB_TMO], 1u); break; } } } } while (0)
struct XcdBarrier { unsigned* bar; unsigned x; volatile LAS unsigned* st; };
__device__ __forceinline__ XcdBarrier xcd_barrier_post(unsigned* bar, volatile LAS unsigned* st) {
    XcdBarrier b; b.bar = bar; b.x = xb_xcc_id(); b.st = st;
    if (threadIdx.x == 0) (void)xb_add(&bar[XB_XCNT(b.x)], 1u);
    return b;
}
__device__ __forceinline__ void xcd_barrier_complete(unsigned* bar, unsigned x, unsigned& nloc, unsigned& nx) {
    const unsigned G = gridDim.x * gridDim.y * gridDim.z;
    unsigned sum, cnt, mine, sp = 0u;
    for (;;) {
        sum = 0u; cnt = 0u; mine = 0u;
#pragma unroll
        for (unsigned j = 0; j < 16; ++j) { const unsigned c = xb_ld(&bar[XB_XCNT(j)]); sum += c; cnt += (c > 0u) ? 1u : 0u; mine = (j == x) ? c : mine; }
        if (sum == G) break;
        __builtin_amdgcn_s_sleep(1);
        if ((++sp & 255u) == 0u) { if (xb_ld(&bar[XB_TMO])) break; if (sp > XB_SPIN_CAP) { atomicAdd(&bar[XB_TMO], 1u); break; } }
    }
    nloc = mine > 0u ? mine : 1u; nx = cnt > 0u ? cnt : 1u;
}
__device__ __forceinline__ void xcd_barrier(const XcdBarrier& b) {
    asm volatile("s_waitcnt vmcnt(0)" ::: "memory");
    __syncthreads();
    if (threadIdx.x == 0) {
        unsigned* bar = b.bar;
        __builtin_amdgcn_s_waitcnt(0);
        unsigned nloc = b.st[0], nx = b.st[1];
        if (nloc == 0u) { xcd_barrier_complete(bar, b.x, nloc, nx); b.st[0] = nloc; b.st[1] = nx; }
        const unsigned old = xb_add(&bar[XB_XSUB(b.x)], 1u);
        const unsigned gen = old / nloc;
        if (old + 1u == (gen + 1u) * nloc) {
            __builtin_amdgcn_fence(__ATOMIC_RELEASE, "agent");
            asm volatile("s_waitcnt vmcnt(0)" ::: "memory");
            const unsigned og = xb_add(&bar[XB_TOP], 1u);
            const unsigned tg = og / nx;
            if (og + 1u == (tg + 1u) * nx) xb_add(&bar[XB_TOPGEN], 1u);
            else XB_SPIN(xb_ld(&bar[XB_TOPGEN]) == tg, bar);
            __builtin_amdgcn_fence(__ATOMIC_ACQUIRE, "agent");
            xb_add(&bar[XB_XGEN(b.x)], 1u);
            asm volatile("s_waitcnt vmcnt(0)" ::: "memory");
        } else {
            XB_SPIN(xb_ld(&bar[XB_XGEN(b.x)]) == gen, bar);
            __builtin_amdgcn_fence(__ATOMIC_ACQUIRE, "agent");
            asm volatile("s_waitcnt vmcnt(0)" ::: "memory");
        }
    }
    __syncthreads();
}

struct Args {
    const float* x; const float* norm_g; const float* pool_w_in; const float* pool_w_grp; const float* pool_scale; const float* pool_w_out;
    const float* hgrn_w_in; const float* hgrn_lb; const float* hgrn_norm_g; const float* hgrn_w_out; const float* final_g;
    float* out; unsigned char* ws;
};

__device__ __forceinline__ void transpose_item(const float* W, int K, int N, bf16_t* WT, int row_off, const float* ks, const float* ns, LAS float* scr, int item, int lane) {
    const int nblk = N / 32, kb = item / nblk, nb = item % nblk, k0 = 64 * kb, n0 = 32 * nb;
    const float nsv = ns ? ns[n0 + (lane & 31)] : 1.0f;
#pragma unroll 8
    for (int i = 0; i < 32; ++i) { const int kk = 2 * i + (lane >> 5); float w = W[(size_t)(k0 + kk) * N + n0 + (lane & 31)] * nsv; if (ks) w *= ks[k0 + kk]; scr[kk * 33 + (lane & 31)] = w; }
    asm volatile("s_waitcnt lgkmcnt(0)" ::: "memory");
    const int c = lane & 7;
#pragma unroll
    for (int j = 0; j < 4; ++j) { const int n = (lane >> 3) + 8 * j; const LAS float* s = scr + (8 * c) * 33 + n;
        u32x4 o; o.x = pk2(s[0 * 33], s[1 * 33]); o.y = pk2(s[2 * 33], s[3 * 33]); o.z = pk2(s[4 * 33], s[5 * 33]); o.w = pk2(s[6 * 33], s[7 * 33]);
        *(u32x4*)(WT + (size_t)(row_off + n0 + n) * K + k0 + 8 * c) = o; }
    asm volatile("s_waitcnt lgkmcnt(0)" ::: "memory");
}

__global__ void __launch_bounds__(512, 2) fwd_kernel(Args a) {
    extern __shared__ __attribute__((aligned(16))) unsigned char lds_raw[];
    LAS unsigned char* lds = (LAS unsigned char*)lds_raw;
    volatile LAS unsigned* xst = (volatile LAS unsigned*)(lds + 131072 + 64);
    if (threadIdx.x < 2) xst[threadIdx.x] = 0u;
    __syncthreads();
    const XcdBarrier xbar = xcd_barrier_post((unsigned*)a.ws, xst);
#define GRID_BAR() xcd_barrier(xbar)
    const int G = gridDim.x, bid = blockIdx.x;
    const int NGW = G * 8;
    const int wave = __builtin_amdgcn_readfirstlane((int)threadIdx.x >> 6);
#define PHASE_IDS int lane_ = (int)__builtin_amdgcn_mbcnt_hi(~0u, __builtin_amdgcn_mbcnt_lo(~0u, 0u)); asm volatile("" : "+v"(lane_)); const int lane = lane_, tid = wave * 64 + lane, gw = bid * 8 + wave; (void)gw; (void)tid;
    unsigned char* ws = a.ws;
    bf16_t* Wt_in0 = (bf16_t*)(ws + WS_WIN0); bf16_t* Wt_grp = (bf16_t*)(ws + WS_WGRP); bf16_t* Wt_out0 = (bf16_t*)(ws + WS_WOUT0);
    bf16_t* Wt_in1 = (bf16_t*)(ws + WS_WIN1); bf16_t* Wt_out1 = (bf16_t*)(ws + WS_WOUT1);
    float* part1 = (float*)(ws + WS_PART1); float* part2 = (float*)(ws + WS_PART2); float* ssb = (float*)(ws + WS_SS); float* decb = (float*)(ws + WS_DEC);
    bf16_t* XB = (bf16_t*)(ws + WS_XB); bf16_t* BA = (bf16_t*)(ws + WS_A); bf16_t* BB = (bf16_t*)(ws + WS_B); bf16_t* BC = (bf16_t*)(ws + WS_C);

    {
        PHASE_IDS
        LAS float* scr = (LAS float*)(lds + wave * 16384);
        constexpr int I_IN0 = (DM / 64) * (4096 / 32), I_GRP1 = (512 / 64) * (512 / 32), I_OUT = (DI / 64) * (DM / 32), I_IN1 = (DM / 64) * (8192 / 32);
        constexpr int NITEMS = I_IN0 + 4 * I_GRP1 + I_OUT + I_IN1 + I_OUT;
        for (int it = gw; it < NITEMS; it += NGW) {
            int r = it;
            if (r < I_IN0) { transpose_item(a.pool_w_in, DM, 4096, Wt_in0, 0, a.norm_g, nullptr, scr, r, lane); continue; } r -= I_IN0;
            if (r < 4 * I_GRP1) { const int g = r / I_GRP1; transpose_item(a.pool_w_grp + (size_t)g * 512 * 512, 512, 512, Wt_grp, g * 512, nullptr, a.pool_scale + g * 512, scr, r % I_GRP1, lane); continue; } r -= 4 * I_GRP1;
            if (r < I_OUT) { transpose_item(a.pool_w_out, DI, DM, Wt_out0, 0, nullptr, nullptr, scr, r, lane); continue; } r -= I_OUT;
            if (r < I_IN1) {
                const int n0 = 32 * (r % (8192 / 32)); int d0 = n0;
                if (n0 < 2048) d0 = 256 * (n0 >> 7) + (n0 & 127); else if (n0 < 4096) d0 = 256 * ((n0 - 2048) >> 7) + 128 + (n0 & 127);
                transpose_item(a.hgrn_w_in, DM, 8192, Wt_in1, d0 - n0, a.norm_g + DM, nullptr, scr, r, lane); continue; } r -= I_IN1;
            transpose_item(a.hgrn_w_out, DI, DM, Wt_out1, 0, a.hgrn_norm_g, nullptr, scr, r, lane);
        }
        for (int m = gw; m < M; m += NGW) {
            const f32x4* xr = (const f32x4*)(a.x + (size_t)m * DM) + lane;
            f32x4 v[4]; float s = 0.f;
#pragma unroll
            for (int j = 0; j < 4; ++j) { v[j] = xr[64 * j]; s += (v[j][0] * v[j][0] + v[j][1] * v[j][1]) + (v[j][2] * v[j][2] + v[j][3] * v[j][3]); }
            const float rstd = 1.0f / sqrtf(wave_sum(s, lane) * (1.0f / DM) + EPS);
            unsigned long long* o8 = (unsigned long long*)(XB + (size_t)m * DM) + lane;
#pragma unroll
            for (int j = 0; j < 4; ++j) o8[64 * j] = (unsigned long long)pk2(v[j][0] * rstd, v[j][1] * rstd) | ((unsigned long long)pk2(v[j][2] * rstd, v[j][3] * rstd) << 32);
        }
    }
    GRID_BAR();

    {
        pg8::Gemm g{XB, Wt_in0, DM, DM, DM, 0}; pg8::StaticOrder S; S.init(M, 4096, G, bid);
        pg8::EpiP1 E{BA, BB};
        pg8::gemm_phase<pg8::EpiP1>(lds, g, S, E, wave);
    }
    GRID_BAR();

    {
        PHASE_IDS
        constexpr int RUN = 64;
        const int nruns = (M / RUN) * (DI / 8);
        for (int idx = bid * 512 + tid; idx < nruns; idx += G * 512) {
            const int cgp = idx & 255, run = idx >> 8, grp = cgp >> 6, w = 2 << grp;
            const int m0 = run * RUN, t0 = m0 & (SEQ - 1);
            const bf16_t* vp = BA + (size_t)m0 * DI + cgp * 8; bf16_t* pp = BC + (size_t)m0 * DI + cgp * 8;
            float sum[8];
#pragma unroll
            for (int j = 0; j < 8; ++j) sum[j] = 0.f;
            if (t0 > 0) for (int k = 1; k < w; ++k) { const u32x4 vv = *(const u32x4*)(vp - (size_t)k * DI);
                sum[0] += bf_lo(vv.x); sum[1] += bf_hi(vv.x); sum[2] += bf_lo(vv.y); sum[3] += bf_hi(vv.y); sum[4] += bf_lo(vv.z); sum[5] += bf_hi(vv.z); sum[6] += bf_lo(vv.w); sum[7] += bf_hi(vv.w); }
#pragma unroll 4
            for (int i = 0; i < RUN; ++i) {
                const int t = t0 + i;
                const u32x4 vv = *(const u32x4*)(vp + (size_t)i * DI);
                float x[8] = {bf_lo(vv.x), bf_hi(vv.x), bf_lo(vv.y), bf_hi(vv.y), bf_lo(vv.z), bf_hi(vv.z), bf_lo(vv.w), bf_hi(vv.w)};
#pragma unroll
                for (int j = 0; j < 8; ++j) sum[j] += x[j];
                const int cnt = (t + 1) < w ? (t + 1) : w; const float inv = 1.0f / (float)cnt;
                u32x4 o; o.x = pkbf(sum[0] * inv - x[0], sum[1] * inv - x[1]); o.y = pkbf(sum[2] * inv - x[2], sum[3] * inv - x[3]);
                o.z = pkbf(sum[4] * inv - x[4], sum[5] * inv - x[5]); o.w = pkbf(sum[6] * inv - x[6], sum[7] * inv - x[7]);
                *(u32x4*)(pp + (size_t)i * DI) = o;
                if (t + 1 >= w) { const u32x4 uu = *(const u32x4*)(vp + (size_t)(i + 1 - w) * DI);
                    sum[0] -= bf_lo(uu.x); sum[1] -= bf_hi(uu.x); sum[2] -= bf_lo(uu.y); sum[3] -= bf_hi(uu.y); sum[4] -= bf_lo(uu.z); sum[5] -= bf_hi(uu.z); sum[6] -= bf_lo(uu.w); sum[7] -= bf_hi(uu.w); }
            }
        }
    }
    GRID_BAR();

    {
        pg8::Gemm g{BC, Wt_grp, DI, 512, 512, 2}; pg8::StaticOrder S; S.init(M, DI, G, bid);
        pg8::EpiP2 E{BB};
        pg8::gemm_phase<pg8::EpiP2>(lds, g, S, E, wave);
    }
    GRID_BAR();

    {
        pg8::Gemm g{BB, Wt_out0, DI, DI, DI, 0}; pg8::StaticOrder S; S.init(M, DM, G, bid);
        pg8::EpiRes<true, false> E{a.x, nullptr, XB, part1};
        pg8::gemm_phase<pg8::EpiRes<true, false>>(lds, g, S, E, wave);
    }
    GRID_BAR();

    {
        pg8::Gemm g{XB, Wt_in1, DM, DM, DM, 0}; pg8::StaticOrder S; S.init(M, 6144, G, bid);
        pg8::EpiP4 E{BA, BB, BC, decb, part1, a.hgrn_lb};
        pg8::gemm_phase<pg8::EpiP4>(lds, g, S, E, wave);
    }
    GRID_BAR();

    scan::phase(lds, BA, BB, BC, decb, ssb, bid, G, wave);
    GRID_BAR();

    {
        pg8::Gemm g{XB, Wt_in1 + (size_t)6144 * DM, DM, DM, DM, 0}; pg8::StaticOrder S; S.init(M, DI, G, bid);
        pg8::EpiP5b E{BC, part1, ssb};
        pg8::gemm_phase<pg8::EpiP5b>(lds, g, S, E, wave);
    }
    GRID_BAR();

    {
        pg8::Gemm g{BC, Wt_out1, DI, DI, DI, 0}; pg8::StaticOrder S; S.init(M, DM, G, bid);
        pg8::EpiFinal E{XB, a.out, a.final_g, (float*)(ws + WS_X), (unsigned*)(ws + WS_CNT)};
        pg8::gemm_phase<pg8::EpiFinal>(lds, g, S, E, wave);
    }
}

extern "C" void kernel_launch(void* const* d_in, const int* in_sizes, int n_in, void* d_out, int out_size, void* d_ws, size_t ws_size, hipStream_t stream) {
    static int grid = 0;
    if (grid == 0) {
        if (n_in != 11 || in_sizes[0] != M * DM || out_size != M * DM || ws_size < WS_END) { fprintf(stderr, "kernel_launch: unexpected shapes (n_in %d in0 %d out %d ws %zu)\n", n_in, n_in > 0 ? in_sizes[0] : -1, out_size, ws_size); grid = -1; return; }
        int dev = 0, cus = 0, per = 0;
        if (hipGetDevice(&dev) != hipSuccess || hipDeviceGetAttribute(&cus, hipDeviceAttributeMultiprocessorCount, dev) != hipSuccess) { grid = -1; return; }
        if (hipFuncSetAttribute((const void*)fwd_kernel, hipFuncAttributeMaxDynamicSharedMemorySize, LDS_BYTES) != hipSuccess) { fprintf(stderr, "kernel_launch: hipFuncSetAttribute failed\n"); grid = -1; return; }
        if (hipOccupancyMaxActiveBlocksPerMultiprocessor(&per, (const void*)fwd_kernel, 512, LDS_BYTES) != hipSuccess || per < 1) { fprintf(stderr, "kernel_launch: occupancy query says %d\n", per); (void)hipGetLastError(); grid = -1; return; }
        grid = cus;
        fprintf(stderr, "kernel_launch: cus %d per_cu %d grid %d\n", cus, per, grid);
    }
    if (grid < 0) return;
    if (hipMemsetAsync(d_ws, 0, 32768, stream) != hipSuccess) { fprintf(stderr, "kernel_launch: hipMemsetAsync failed\n"); return; }
    Args a{};
    a.x = (const float*)d_in[0]; a.norm_g = (const float*)d_in[1]; a.pool_w_in = (const float*)d_in[2]; a.pool_w_grp = (const float*)d_in[3];
    a.pool_scale = (const float*)d_in[4]; a.pool_w_out = (const float*)d_in[5]; a.hgrn_w_in = (const float*)d_in[6]; a.hgrn_lb = (const float*)d_in[7];
    a.hgrn_norm_g = (const float*)d_in[8]; a.hgrn_w_out = (const float*)d_in[9]; a.final_g = (const float*)d_in[10];
    a.out = (float*)d_out; a.ws = (unsigned char*)d_ws;
    void* args[] = {&a};
    hipError_t e = hipLaunchCooperativeKernel((void*)fwd_kernel, dim3(grid), dim3(512), args, LDS_BYTES, stream);
    if (e != hipSuccess) fprintf(stderr, "kernel_launch: cooperative launch failed: %s (grid %d)\n", hipGetErrorString(e), grid);
}
```

```cpp
#include <hip/hip_runtime.h>
#include <hip/hip_cooperative_groups.h>
#include <cstdio>
#include <cstdint>
namespace cg = cooperative_groups;

#define LAS __attribute__((address_space(3)))
typedef unsigned short bf16_t;
typedef short bf16x8 __attribute__((ext_vector_type(8)));
typedef float f32x4 __attribute__((ext_vector_type(4)));
typedef float f32x2 __attribute__((ext_vector_type(2)));
typedef unsigned u32x4 __attribute__((ext_vector_type(4)));
typedef unsigned u32x2 __attribute__((ext_vector_type(2)));

constexpr int DM = 1024, BATCH = 8, SEQ = 4096, DI = 2048, M = BATCH * SEQ;
constexpr int NHEAD = 16, HD = 128;
constexpr float EPS = 1e-6f;
constexpr size_t MiB = 1u << 20;
constexpr size_t WS_WIN0 = 2 * MiB;
constexpr size_t WS_WGRP = 10 * MiB;
constexpr size_t WS_WOUT0 = 12 * MiB;
constexpr size_t WS_WIN1 = 16 * MiB;
constexpr size_t WS_WOUT1 = 32 * MiB;
constexpr size_t WS_PART1 = 36 * MiB;
constexpr size_t WS_PART2 = 38 * MiB;
constexpr size_t WS_CNT = 16384;
constexpr size_t WS_X = 40 * MiB;
constexpr size_t WS_DEC = 44 * MiB;
constexpr size_t WS_SS = 112 * MiB;
constexpr size_t WS_XB = 48 * MiB;
constexpr size_t WS_A = 128 * MiB;
constexpr size_t WS_B = 256 * MiB;
constexpr size_t WS_C = 384 * MiB;
constexpr size_t WS_END = 512 * MiB;
constexpr int LDS_BYTES = 147456;

__device__ __forceinline__ unsigned f2bf(float f) { unsigned u = __builtin_bit_cast(unsigned, f); return (u + 0x7fffu + ((u >> 16) & 1u)) >> 16; }
__device__ __forceinline__ unsigned pk2(float lo, float hi) { return f2bf(lo) | (f2bf(hi) << 16); }
typedef __bf16 bf2_t __attribute__((ext_vector_type(2)));
__device__ __forceinline__ unsigned pkbf(float lo, float hi) { f32x2 v = {lo, hi}; return __builtin_bit_cast(unsigned, __builtin_convertvector(v, bf2_t)); }
__device__ __forceinline__ float bf_lo(unsigned w) { return __builtin_bit_cast(float, w << 16); }
__device__ __forceinline__ float bf_hi(unsigned w) { return __builtin_bit_cast(float, w & 0xffff0000u); }
__device__ __forceinline__ float silu_f(float x) { return x * __builtin_amdgcn_rcpf(1.0f + __builtin_amdgcn_exp2f(-1.44269504089f * x)); }
__device__ __forceinline__ float lane_get(float v, int src_lane) { return __builtin_bit_cast(float, __builtin_amdgcn_ds_bpermute(src_lane << 2, __builtin_bit_cast(int, v))); }
__device__ __forceinline__ float xor_get(float v, int lane, int m) { return lane_get(v, lane ^ m); }
__device__ __forceinline__ float wave_sum(float v, int lane) {
#pragma unroll
    for (int o = 1; o < 64; o <<= 1) v += xor_get(v, lane, o);
    return v;
}

namespace pg8 {
constexpr int BM = 256, BK = 64, HALF = 128, HTB = HALF * BK * 2, STAGE_BYTES = 8 * HTB, NXCD = 8, WGM = 8;
__host__ __device__ __forceinline__ int lds_byte(int r, int c) { const int st = (r >> 4) * 2 + (c >> 5), rr = r & 15, cc = c & 31, ob = rr * 64 + cc * 2; return st * 1024 + (ob ^ (((ob >> 9) & 1) << 5)); }
__host__ __device__ __forceinline__ void stage_rc(int b, int& R, int& C) { const int st = b / 1024, sb = b % 1024, swz = sb ^ (((sb >> 9) & 1) << 5); R = (st >> 1) * 16 + swz / 64; C = (st & 1) * 32 + (swz % 64) / 2; }
__host__ __device__ __forceinline__ int perm32(int rho) { const int n = rho >> 4, i = rho & 15; return 8 * (i >> 2) + 4 * n + (i & 3); }

struct Unit { int pm, pn; };
struct Gemm { const bf16_t* A; const bf16_t* Bt; int lda, ldb, K, grp_tiles; };

struct StaticOrder {
    int nM, nN, nwg, G, c;
    __host__ __device__ void init(int M_, int N_, int G_, int c_) { nM = M_ / BM; nN = N_ / BM; nwg = nM * nN; G = G_; c = c_; }
    __host__ __device__ bool next(int i, Unit& u) const {
        const long L = (long)i * G + c; if (L >= nwg) return false;
        int wgid = (int)L; { const int q = nwg / NXCD, r = nwg % NXCD, xcd = wgid % NXCD, off = wgid / NXCD; wgid = (xcd < r ? xcd * (q + 1) : r * (q + 1) + (xcd - r) * q) + off; }
        const int nig = WGM * nN, gid = wgid / nig, fm = gid * WGM, gsz = (nM - fm) < WGM ? (nM - fm) : WGM;
        u.pm = fm + ((wgid % nig) % gsz); u.pn = (wgid % nig) / gsz; return true;
    }
};

__device__ __forceinline__ unsigned cvt_pk_bf16(float lo, float hi) { unsigned r; asm volatile("v_cvt_pk_bf16_f32 %0, %1, %2" : "=v"(r) : "v"(lo), "v"(hi)); return r; }

template <class Epi, bool ALIGN_EPI = true, bool SP2 = true>
__device__ __forceinline__ void gemm_phase(LAS unsigned char* lds, const Gemm g, const StaticOrder& S, const Epi& E, const int wid) {
    int lane_ = (int)__builtin_amdgcn_mbcnt_hi(~0u, __builtin_amdgcn_mbcnt_lo(~0u, 0u)); asm volatile("" : "+v"(lane_));
    int lane = lane_, tid = wid * 64 + lane, fr = lane & 15, fq = lane >> 4; const int wr = wid >> 2, wc = wid & 3;
    const int K = g.K, nt = K / BK;
    unsigned voffA[2], voffB[2]; int aoff, boff;
#define PG8_LANE_STATE() do { _Pragma("unroll") for (int i = 0; i < 2; ++i) { int R, C; stage_rc(tid * 16 + i * 8192, R, C); const int Rb = Epi::PERM ? ((R & ~31) + perm32(R & 31)) : R; \
        voffA[i] = (unsigned)(R * g.lda + C) * 2u; voffB[i] = (unsigned)(Rb * g.ldb + C) * 2u; } \
        aoff = lds_byte(wr * 64 + fr, fq * 8); boff = lds_byte(wc * 32 + fr, fq * 8); } while (0)
    PG8_LANE_STATE();
    const size_t kstep = (size_t)(BK * 2);
    const size_t hstepA = (size_t)HALF * g.lda * 2, hstepB = (size_t)HALF * g.ldb * 2;
    const size_t tstepA = 2 * hstepA, tstepB = 2 * hstepB;
    const unsigned ldsw = (unsigned)wid * 1024u;
#define PG8_SA(b, h) (((b) * 2 + (h)) * HTB)
#define PG8_SB(b, h) ((4 + (b) * 2 + (h)) * HTB)
#define PG8_STAGE(bufoff, gbase, voff) do { _Pragma("unroll") for (int _i = 0; _i < 2; ++_i) \
        __builtin_amdgcn_global_load_lds((const unsigned*)((const char*)(gbase) + (voff)[_i]), (LAS unsigned*)(lds + (bufoff) + ldsw + _i * 8192), 16, 0, 0); } while (0)
#define PG8_LDA(dst, b, h) do { _Pragma("unroll") for (int m = 0; m < 4; ++m) _Pragma("unroll") for (int k = 0; k < 2; ++k) dst[m][k] = *(const LAS bf16x8*)(lds + PG8_SA(b, h) + aoff + m * 2048 + k * 1024); } while (0)
#define PG8_LDB(dst, b, h) do { _Pragma("unroll") for (int n = 0; n < 2; ++n) _Pragma("unroll") for (int k = 0; k < 2; ++k) dst[n][k] = *(const LAS bf16x8*)(lds + PG8_SB(b, h) + boff + n * 2048 + k * 1024); } while (0)
#define PG8_MMA(ai, bj, At, Bt) do { __builtin_amdgcn_s_setprio(1); _Pragma("unroll") for (int m = 0; m < 4; ++m) _Pragma("unroll") for (int n = 0; n < 2; ++n) _Pragma("unroll") for (int k = 0; k < 2; ++k) \
        acc[ai][bj][m][n] = __builtin_amdgcn_mfma_f32_16x16x32_bf16(Bt[n][k], At[m][k], acc[ai][bj][m][n], 0, 0, 0); __builtin_amdgcn_s_setprio(0); } while (0)
#define PG8_WAIT_V(n) asm volatile("s_waitcnt vmcnt(" #n ")" ::: "memory")
#define PG8_WAIT_L(n) asm volatile("s_waitcnt lgkmcnt(" #n ")" ::: "memory")
#define PG8_BAR __builtin_amdgcn_s_barrier()
#define PG8_SCHED __builtin_amdgcn_sched_barrier(0)
#define PG8_ABASE(u) ((const char*)g.A + (size_t)(u).pm * tstepA + (g.grp_tiles ? (size_t)((u).pn / g.grp_tiles) * (size_t)K * 2 : (size_t)0))
#define PG8_BBASE(u) ((const char*)g.Bt + (size_t)(u).pn * tstepB)
    Unit cur, nxt; int ui = 0;
    E.prologue(S, lds, tid);
    if (!S.next(0, cur)) return;
    f32x4 acc[2][2][4][2];
#pragma unroll
    for (int a = 0; a < 2; ++a)
#pragma unroll
        for (int b = 0; b < 2; ++b)
#pragma unroll
            for (int m = 0; m < 4; ++m)
#pragma unroll
                for (int n = 0; n < 2; ++n) acc[a][b][m][n] = (f32x4){0.f, 0.f, 0.f, 0.f};
    bf16x8 At[4][2], B0[2][2], B1[2][2];
    const char* cA = PG8_ABASE(cur); const char* cB = PG8_BBASE(cur);
    if constexpr (SP2) {
        PG8_STAGE(PG8_SB(0, 0), cB, voffB); PG8_STAGE(PG8_SB(0, 1), cB + hstepB, voffB); PG8_STAGE(PG8_SA(0, 0), cA, voffA); PG8_STAGE(PG8_SA(0, 1), cA + hstepA, voffA);
        if (wr == 1) PG8_BAR;
        PG8_WAIT_V(2); PG8_BAR;
        PG8_STAGE(PG8_SB(1, 0), cB + kstep, voffB); PG8_STAGE(PG8_SA(1, 0), cA + kstep, voffA); PG8_STAGE(PG8_SB(1, 1), cB + hstepB + kstep, voffB);
        PG8_WAIT_V(6); PG8_BAR;
    } else {
        PG8_STAGE(PG8_SB(0, 0), cB, voffB); PG8_STAGE(PG8_SA(0, 0), cA, voffA); PG8_STAGE(PG8_SB(0, 1), cB + hstepB, voffB); PG8_STAGE(PG8_SA(0, 1), cA + hstepA, voffA);
        if (wr == 1) PG8_BAR;
        PG8_WAIT_V(4); PG8_BAR;
        PG8_STAGE(PG8_SB(1, 0), cB + kstep, voffB); PG8_STAGE(PG8_SA(1, 0), cA + kstep, voffA); PG8_STAGE(PG8_SB(1, 1), cB + hstepB + kstep, voffB);
        PG8_WAIT_V(6); PG8_BAR;
    }
    for (;;) {
        const bool has_next = S.next(ui + 1, nxt);
        const char* nA = has_next ? PG8_ABASE(nxt) : cA; const char* nB = has_next ? PG8_BBASE(nxt) : cB;
        for (int t = 0; t < nt; t += 2) {
            const bool last = (t == nt - 2);
            const char* a1 = cA + (size_t)(t + 1) * kstep;
            const char* a2 = last ? nA : cA + (size_t)(t + 2) * kstep; const char* b2 = last ? nB : cB + (size_t)(t + 2) * kstep;
            const char* a3 = a2 + kstep; const char* b3 = b2 + kstep;
            if constexpr (SP2) {
            PG8_LDB(B0, 0, 0); PG8_LDB(B1, 0, 1); PG8_SCHED; PG8_LDA(At, 0, 0); PG8_STAGE(PG8_SA(1, 1), a1 + hstepA, voffA);
            PG8_WAIT_V(8); PG8_WAIT_L(0); PG8_BAR; PG8_MMA(0, 0, At, B0); PG8_MMA(0, 1, At, B1); PG8_BAR; PG8_SCHED;
            PG8_LDA(At, 0, 1); PG8_STAGE(PG8_SB(0, 0), b2, voffB); PG8_STAGE(PG8_SB(0, 1), b2 + hstepB, voffB); PG8_STAGE(PG8_SA(0, 0), a2, voffA);
            PG8_WAIT_V(8); PG8_WAIT_L(0); PG8_BAR; PG8_MMA(1, 0, At, B0); PG8_MMA(1, 1, At, B1); PG8_BAR; PG8_SCHED;
            PG8_LDB(B0, 1, 0); PG8_LDB(B1, 1, 1); PG8_SCHED; PG8_LDA(At, 1, 0); PG8_STAGE(PG8_SA(0, 1), a2 + hstepA, voffA);
            PG8_WAIT_V(8); PG8_WAIT_L(0); PG8_BAR; PG8_MMA(0, 0, At, B0); PG8_MMA(0, 1, At, B1); PG8_BAR; PG8_SCHED;
            PG8_LDA(At, 1, 1); PG8_STAGE(PG8_SB(1, 0), b3, voffB); PG8_STAGE(PG8_SB(1, 1), b3 + hstepB, voffB); PG8_STAGE(PG8_SA(1, 0), a3, voffA);
            PG8_WAIT_V(8); PG8_WAIT_L(0); PG8_BAR; PG8_MMA(1, 0, At, B0); PG8_MMA(1, 1, At, B1); PG8_BAR; PG8_SCHED;
            } else {
            PG8_LDB(B0, 0, 0); PG8_SCHED; PG8_LDA(At, 0, 0); PG8_STAGE(PG8_SA(1, 1), a1 + hstepA, voffA);
            PG8_WAIT_L(8); PG8_BAR; PG8_WAIT_L(0); PG8_MMA(0, 0, At, B0); PG8_BAR; PG8_SCHED;
            PG8_LDB(B1, 0, 1); PG8_STAGE(PG8_SB(0, 0), b2, voffB);
            PG8_BAR; PG8_WAIT_L(0); PG8_MMA(0, 1, At, B1); PG8_BAR;
            PG8_LDA(At, 0, 1); PG8_STAGE(PG8_SA(0, 0), a2, voffA);
            PG8_BAR; PG8_WAIT_L(0); PG8_MMA(1, 0, At, B0); PG8_BAR; PG8_SCHED;
            PG8_STAGE(PG8_SB(0, 1), b2 + hstepB, voffB);
            PG8_WAIT_V(6); PG8_BAR; PG8_MMA(1, 1, At, B1); PG8_BAR;
            PG8_LDB(B0, 1, 0); PG8_SCHED; PG8_LDA(At, 1, 0); PG8_STAGE(PG8_SA(0, 1), a2 + hstepA, voffA);
            PG8_WAIT_L(8); PG8_BAR; PG8_WAIT_L(0); PG8_MMA(0, 0, At, B0); PG8_BAR; PG8_SCHED;
            PG8_LDB(B1, 1, 1); PG8_STAGE(PG8_SB(1, 0), b3, voffB);
            PG8_BAR; PG8_WAIT_L(0); PG8_MMA(0, 1, At, B1); PG8_BAR;
            PG8_LDA(At, 1, 1); PG8_STAGE(PG8_SA(1, 0), a3, voffA);
            PG8_BAR; PG8_WAIT_L(0); PG8_MMA(1, 0, At, B0); PG8_BAR; PG8_SCHED;
            PG8_STAGE(PG8_SB(1, 1), b3 + hstepB, voffB);
            PG8_WAIT_V(6); PG8_BAR; PG8_MMA(1, 1, At, B1); PG8_BAR;
            }
        }
        if constexpr (ALIGN_EPI) { if (wr == 0) PG8_BAR; }
        if constexpr (!Epi::AFTER_DRAIN) E(acc, cur, wr, wc, fr, fq, lds, ui);
        if (!has_next) break;
#pragma unroll
        for (int a = 0; a < 2; ++a)
#pragma unroll
            for (int b = 0; b < 2; ++b)
#pragma unroll
                for (int m = 0; m < 4; ++m)
#pragma unroll
                    for (int n = 0; n < 2; ++n) acc[a][b][m][n] = (f32x4){0.f, 0.f, 0.f, 0.f};
        cur = nxt; cA = nA; cB = nB; ++ui;
        asm volatile("" : "+v"(lane)); tid = wid * 64 + lane; fr = lane & 15; fq = lane >> 4; PG8_LANE_STATE();
        if constexpr (ALIGN_EPI) { if (wr == 1) PG8_BAR; }
    }
    PG8_WAIT_V(0);
    if constexpr (!ALIGN_EPI) { if (wr == 0) PG8_BAR; }
    PG8_BAR;
    if constexpr (Epi::AFTER_DRAIN) E.fused(acc, cur, wr, wc, fr, fq, lds, tid);
#undef PG8_SA
#undef PG8_SB
#undef PG8_STAGE
#undef PG8_LDA
#undef PG8_LDB
#undef PG8_MMA
#undef PG8_WAIT_V
#undef PG8_WAIT_L
#undef PG8_BAR
#undef PG8_SCHED
#undef PG8_ABASE
#undef PG8_LANE_STATE
#undef PG8_BBASE
}

struct EpiP1 {
    static constexpr bool PERM = true, AFTER_DRAIN = false;
    __device__ __forceinline__ void prologue(const StaticOrder&, LAS unsigned char*, int) const {}
    bf16_t* V; bf16_t* SG;
    __device__ __forceinline__ void operator()(f32x4 (&acc)[2][2][4][2], const Unit& u, int wr, int wc, int fr, int fq, LAS unsigned char* lds, int ui) const {
        const int row0 = u.pm * BM + wr * 64 + fr; const bool gate = u.pn >= 8;
        bf16_t* base = gate ? SG : V; const int col0 = (u.pn & 7) * BM + wc * 32 + 8 * fq;
#pragma unroll
        for (int ai = 0; ai < 2; ++ai)
#pragma unroll
            for (int m = 0; m < 4; ++m) { bf16_t* rowp = base + (size_t)(row0 + ai * HALF + m * 16) * DI + col0;
#pragma unroll
                for (int bj = 0; bj < 2; ++bj) { f32x4 v0 = acc[ai][bj][m][0], v1 = acc[ai][bj][m][1];
                    if (gate) {
#pragma unroll
                        for (int j = 0; j < 4; ++j) { v0[j] = silu_f(v0[j]); v1[j] = silu_f(v1[j]); } }
                    u32x4 w; w.x = cvt_pk_bf16(v0[0], v0[1]); w.y = cvt_pk_bf16(v0[2], v0[3]); w.z = cvt_pk_bf16(v1[0], v1[1]); w.w = cvt_pk_bf16(v1[2], v1[3]);
                    *(u32x4*)(rowp + bj * HALF) = w; } }
    }
};
struct EpiP2 {
    static constexpr bool PERM = true, AFTER_DRAIN = false;
    __device__ __forceinline__ void prologue(const StaticOrder&, LAS unsigned char*, int) const {}
    bf16_t* Z;
    __device__ __forceinline__ void operator()(f32x4 (&acc)[2][2][4][2], const Unit& u, int wr, int wc, int fr, int fq, LAS unsigned char* lds, int ui) const {
        const int row0 = u.pm * BM + wr * 64 + fr; const int col0 = u.pn * BM + wc * 32 + 8 * fq;
#pragma unroll
        for (int ai = 0; ai < 2; ++ai)
#pragma unroll
            for (int m = 0; m < 4; ++m) { bf16_t* rowp = Z + (size_t)(row0 + ai * HALF + m * 16) * DI + col0;
#pragma unroll
                for (int bj = 0; bj < 2; ++bj) { const f32x4 v0 = acc[ai][bj][m][0], v1 = acc[ai][bj][m][1];
                    const u32x4 s = *(const u32x4*)(rowp + bj * HALF);
                    u32x4 w; w.x = cvt_pk_bf16(v0[0] * bf_lo(s.x), v0[1] * bf_hi(s.x)); w.y = cvt_pk_bf16(v0[2] * bf_lo(s.y), v0[3] * bf_hi(s.y));
                    w.z = cvt_pk_bf16(v1[0] * bf_lo(s.z), v1[1] * bf_hi(s.z)); w.w = cvt_pk_bf16(v1[2] * bf_lo(s.w), v1[3] * bf_hi(s.w));
                    *(u32x4*)(rowp + bj * HALF) = w; } }
    }
};
template <bool WRITE_HB, bool WRITE_H = true> struct EpiRes {
    static constexpr bool PERM = false, AFTER_DRAIN = false;
    __device__ __forceinline__ void prologue(const StaticOrder&, LAS unsigned char*, int) const {}
    const float* R; float* H; bf16_t* HB; float* part;
    __device__ __forceinline__ void operator()(f32x4 (&acc)[2][2][4][2], const Unit& u, int wr, int wc, int fr, int fq, LAS unsigned char* lds, int ui) const {
        const unsigned row0 = (unsigned)(u.pm * BM + wr * 64 + fr), col0 = (unsigned)(u.pn * BM + wc * 32 + 4 * fq);
        const unsigned ofs = (row0 * DM + col0) * 4u, pofs = (row0 * 16u + (unsigned)(u.pn * 4 + wc)) * 4u;
#pragma unroll
        for (int ai = 0; ai < 2; ++ai)
#pragma unroll
            for (int m = 0; m < 4; ++m) { const unsigned o = ofs + (unsigned)((ai * HALF + m * 16) * DM) * 4u; float ss = 0.f;
#pragma unroll
                for (int bj = 0; bj < 2; ++bj)
#pragma unroll
                    for (int n = 0; n < 2; ++n) { const unsigned oo = o + (unsigned)(bj * HALF + n * 16) * 4u;
                        const f32x4 xv = *(const f32x4*)((const char*)R + oo); const f32x4 h = xv + acc[ai][bj][m][n];
                        if (WRITE_H) *(f32x4*)((char*)H + oo) = h; ss += (h[0] * h[0] + h[1] * h[1]) + (h[2] * h[2] + h[3] * h[3]);
                        if (WRITE_HB) { u32x2 w; w.x = pkbf(h[0], h[1]); w.y = pkbf(h[2], h[3]); *(u32x2*)((char*)HB + (oo >> 1)) = w; } }
                ss += xor_get(ss, fq * 16 + fr, 16); ss += xor_get(ss, fq * 16 + fr, 32);
                if (fq == 0) *(float*)((char*)part + (pofs + (unsigned)(ai * HALF + m * 16) * 64u)) = ss;
                asm volatile("" ::: "memory"); }
    }
};
__device__ __forceinline__ float row_rstd_b(const float* part, unsigned bofs) {
    const f32x4* p = (const f32x4*)((const char*)part + bofs); const f32x4 a = p[0], b = p[1], c = p[2], d = p[3];
    return __builtin_amdgcn_rsqf((((a[0] + a[1]) + (a[2] + a[3])) + ((b[0] + b[1]) + (b[2] + b[3])) + ((c[0] + c[1]) + (c[2] + c[3])) + ((d[0] + d[1]) + (d[2] + d[3]))) * (1.0f / DM) + EPS);
}
__device__ __forceinline__ float dpp_shr_mul(float v, const int n) {
    const int iv = __builtin_bit_cast(int, v), one = 0x3f800000; int r;
    if (n == 1) r = __builtin_amdgcn_update_dpp(one, iv, 0x111, 0xf, 0xf, false); else if (n == 2) r = __builtin_amdgcn_update_dpp(one, iv, 0x112, 0xf, 0xf, false);
    else if (n == 4) r = __builtin_amdgcn_update_dpp(one, iv, 0x114, 0xf, 0xf, false); else r = __builtin_amdgcn_update_dpp(one, iv, 0x118, 0xf, 0xf, false);
    return v * __builtin_bit_cast(float, r);
}
constexpr unsigned TAB_OFF = 131072u + 256u;
struct EpiP4 {
    static constexpr bool PERM = true, AFTER_DRAIN = false;
    bf16_t* Qt; bf16_t* Kt; bf16_t* V; float* DEC; const float* part; const float* lbnd;
    __device__ __forceinline__ void prologue(const StaticOrder& S, LAS unsigned char* lds, int tid) const {
        LAS float* T = (LAS float*)(lds + TAB_OFF); Unit u;
        for (int i = 0; i < 12 && S.next(i, u); ++i)
            if (tid < 256) T[i * 256 + tid] = row_rstd_b(part, (unsigned)(u.pm * BM + tid) * 64u);
        __syncthreads();
    }
    __device__ __forceinline__ void operator()(f32x4 (&acc)[2][2][4][2], const Unit& u, int wr, int wc, int fr, int fq, LAS unsigned char* lds, int ui) const {
        const unsigned row0 = (unsigned)(u.pm * BM + wr * 64 + fr);
        const LAS float* T = (const LAS float*)(lds + TAB_OFF) + ui * 256 + wr * 64 + fr;
        if (u.pn >= 16) {
            const unsigned vofs = (row0 * DI + (unsigned)((u.pn - 16) * BM + wc * 32 + 8 * fq)) * 2u;
#pragma unroll
            for (int ai = 0; ai < 2; ++ai)
#pragma unroll
                for (int m = 0; m < 4; ++m) { const float rs = T[ai * HALF + m * 16];
#pragma unroll
                    for (int bj = 0; bj < 2; ++bj) { const f32x4 v0 = acc[ai][bj][m][0] * rs, v1 = acc[ai][bj][m][1] * rs;
                        u32x4 w; w.x = pkbf(v0[0], v0[1]); w.y = pkbf(v0[2], v0[3]); w.z = pkbf(v1[0], v1[1]); w.w = pkbf(v1[2], v1[3]);
                        *(u32x4*)((char*)V + (vofs + (unsigned)((ai * HALF + m * 16) * DI + bj * HALF) * 2u)) = w; } }
            return;
        }
        const unsigned c0 = (unsigned)(u.pn * HD + wc * 32 + 8 * fq);
        const unsigned qofs = (row0 * DI + c0) * 2u;
#pragma unroll
        for (int ai = 0; ai < 2; ++ai) {
            float rs[4];
#pragma unroll
            for (int m = 0; m < 4; ++m) rs[m] = T[ai * HALF + m * 16];
            unsigned cc = c0; asm volatile("" : "+v"(cc));
#pragma unroll
            for (int n = 0; n < 2; ++n) {
                const f32x4 l0 = *(const f32x4*)((const char*)lbnd + (cc + 4 * n) * 4u), l1 = *(const f32x4*)((const char*)lbnd + (cc + 4 * n + DI) * 4u);
                f32x4 decv;
#pragma unroll
                for (int j = 0; j < 4; ++j) { const float ex = __expf(l0[j] - l1[j]); const float lb = __builtin_amdgcn_rcpf(1.0f + ex), omlb = ex * lb; float bprod = 1.0f;
#pragma unroll
                    for (int m = 0; m < 4; ++m) {
                        const float qv = acc[ai][0][m][n][j] * rs[m], z = acc[ai][1][m][n][j] * rs[m];
                        const float sg = __builtin_amdgcn_rcpf(1.0f + __builtin_amdgcn_exp2f(-1.44269504089f * z));
                        const float f = lb + omlb * sg, k = omlb * (1.0f - sg);
                        float s = f; s = dpp_shr_mul(s, 1); s = dpp_shr_mul(s, 2); s = dpp_shr_mul(s, 4); s = dpp_shr_mul(s, 8);
                        const float E = bprod * s;
                        if (m < 3) bprod *= lane_get(s, fq * 16 + 15);
                        const float Ei = __builtin_amdgcn_rcpf(fmaxf(E, 7.9e-31f));
                        acc[ai][0][m][n][j] = qv * E; acc[ai][1][m][n][j] = k * Ei;
                        if (m == 3) decv[j] = E;
                    } }
                if (fr == 15) *(f32x4*)((char*)DEC + ((unsigned)(u.pm * 4 + ai * 2 + wr) * DI + cc + 4 * n) * 4u) = decv;
            }
#pragma unroll
            for (int m = 0; m < 4; ++m) { const unsigned ob = qofs + (unsigned)((ai * HALF + m * 16) * DI) * 2u;
                u32x4 w; w.x = pkbf(acc[ai][0][m][0][0], acc[ai][0][m][0][1]); w.y = pkbf(acc[ai][0][m][0][2], acc[ai][0][m][0][3]); w.z = pkbf(acc[ai][0][m][1][0], acc[ai][0][m][1][1]); w.w = pkbf(acc[ai][0][m][1][2], acc[ai][0][m][1][3]);
                *(u32x4*)((char*)Qt + ob) = w;
                u32x4 x; x.x = pkbf(acc[ai][1][m][0][0], acc[ai][1][m][0][1]); x.y = pkbf(acc[ai][1][m][0][2], acc[ai][1][m][0][3]); x.z = pkbf(acc[ai][1][m][1][0], acc[ai][1][m][1][1]); x.w = pkbf(acc[ai][1][m][1][2], acc[ai][1][m][1][3]);
                *(u32x4*)((char*)Kt + ob) = x; }
            asm volatile("" ::: "memory");
        }
    }
};
struct EpiP5b {
    static constexpr bool PERM = true, AFTER_DRAIN = false;
    bf16_t* O; const float* part; const float* ss;
    __device__ __forceinline__ void prologue(const StaticOrder& S, LAS unsigned char* lds, int tid) const {
        LAS float* T = (LAS float*)(lds + TAB_OFF); Unit u;
        for (int i = 0; i < 4 && S.next(i, u); ++i) {
            if (tid < 256) T[i * 768 + tid] = row_rstd_b(part, (unsigned)(u.pm * BM + tid) * 64u);
            { const int r = tid >> 1, hh = tid & 1; const f32x4* sp = (const f32x4*)(ss + (size_t)(u.pm * BM + r) * 128 + (u.pn * 2 + hh) * 8); const f32x4 s0 = sp[0], s1 = sp[1];
              T[i * 768 + 256 + tid] = __builtin_amdgcn_rsqf((((s0[0] + s0[1]) + (s0[2] + s0[3])) + ((s1[0] + s1[1]) + (s1[2] + s1[3]))) * (1.0f / HD) + EPS); }
        }
        __syncthreads();
    }
    __device__ __forceinline__ void operator()(f32x4 (&acc)[2][2][4][2], const Unit& u, int wr, int wc, int fr, int fq, LAS unsigned char* lds, int ui) const {
        const unsigned row0 = (unsigned)(u.pm * BM + wr * 64 + fr), col0 = (unsigned)(u.pn * BM + wc * 32 + 8 * fq);
        const LAS float* T = (const LAS float*)(lds + TAB_OFF) + ui * 768 + wr * 64 + fr;
        const unsigned oofs = (row0 * DI + col0) * 2u;
#pragma unroll
        for (int ai = 0; ai < 2; ++ai) {
            u32x4 ov[4][2];
#pragma unroll
            for (int m = 0; m < 4; ++m)
#pragma unroll
                for (int bj = 0; bj < 2; ++bj) ov[m][bj] = *(const u32x4*)((const char*)O + (oofs + (unsigned)((ai * HALF + m * 16) * DI + bj * HALF) * 2u));
#pragma unroll
            for (int m = 0; m < 4; ++m) { const int rl = ai * HALF + m * 16; const float rs = T[rl];
#pragma unroll
                for (int bj = 0; bj < 2; ++bj) { const f32x4 v0 = acc[ai][bj][m][0] * rs, v1 = acc[ai][bj][m][1] * rs;
                    const float rh = T[256 + 2 * rl + bj + (wr * 64 + fr)];
                    const u32x4 s = ov[m][bj];
                    u32x4 w; w.x = pkbf(bf_lo(s.x) * rh * silu_f(v0[0]), bf_hi(s.x) * rh * silu_f(v0[1])); w.y = pkbf(bf_lo(s.y) * rh * silu_f(v0[2]), bf_hi(s.y) * rh * silu_f(v0[3]));
                    w.z = pkbf(bf_lo(s.z) * rh * silu_f(v1[0]), bf_hi(s.z) * rh * silu_f(v1[1])); w.w = pkbf(bf_lo(s.w) * rh * silu_f(v1[2]), bf_hi(s.w) * rh * silu_f(v1[3]));
                    *(u32x4*)((char*)O + (oofs + (unsigned)((ai * HALF + m * 16) * DI + bj * HALF) * 2u)) = w; } }
            asm volatile("" ::: "memory"); }
    }
};
struct EpiFinal {
    static constexpr bool PERM = false, AFTER_DRAIN = false;
    const bf16_t* HB; float* H; const float* fg; float* X; unsigned* cnt;
    __device__ __forceinline__ void prologue(const StaticOrder&, LAS unsigned char*, int) const {}
    __device__ __forceinline__ void operator()(f32x4 (&acc)[2][2][4][2], const Unit& u, int wr, int wc, int fr, int fq, LAS unsigned char* lds, int ui) const {
        LAS float* Pt = (LAS float*)(lds + TAB_OFF);
        LAS float* St = Pt + 1024;
        const int tid = (wr * 4 + wc) * 64 + fq * 16 + fr;
        const unsigned row0 = (unsigned)(u.pm * BM + wr * 64 + fr), col0 = (unsigned)(u.pn * BM + wc * 32 + 4 * fq);
        const unsigned ofs = (row0 * DM + col0) * 4u;
#pragma unroll
        for (int ai = 0; ai < 2; ++ai)
#pragma unroll
            for (int m = 0; m < 4; ++m) { float ss = 0.f;
#pragma unroll
                for (int bj = 0; bj < 2; ++bj)
#pragma unroll
                    for (int n = 0; n < 2; ++n) { const unsigned oo = ofs + (unsigned)((ai * HALF + m * 16) * DM + bj * HALF + n * 16) * 4u;
                        const u32x2 hb = *(const u32x2*)((const char*)HB + (oo >> 1));
                        const f32x4 h = acc[ai][bj][m][n] + (f32x4){bf_lo(hb.x), bf_hi(hb.x), bf_lo(hb.y), bf_hi(hb.y)}; acc[ai][bj][m][n] = h;
                        ss += (h[0] * h[0] + h[1] * h[1]) + (h[2] * h[2] + h[3] * h[3]); }
                ss += xor_get(ss, fq * 16 + fr, 16); ss += xor_get(ss, fq * 16 + fr, 32);
                if (fq == 0) Pt[(ai * HALF + wr * 64 + m * 16 + fr) * 4 + wc] = ss;
                asm volatile("" ::: "memory"); }
        __syncthreads();
        float* xs = X + (size_t)u.pm * 1024;
        if (tid < 256) { const f32x4 p = *(const LAS f32x4*)(Pt + tid * 4);
            __hip_atomic_store(xs + u.pn * 256 + tid, (p[0] + p[1]) + (p[2] + p[3]), __ATOMIC_RELAXED, __HIP_MEMORY_SCOPE_AGENT); }
        asm volatile("s_waitcnt vmcnt(0)" ::: "memory");
        __syncthreads();
        if (tid == 0) {
            unsigned* c = cnt + 16 * u.pm;
            __hip_atomic_fetch_add(c, 1u, __ATOMIC_RELAXED, __HIP_MEMORY_SCOPE_AGENT);
            unsigned spins = 0;
            while (__hip_atomic_load(c, __ATOMIC_RELAXED, __HIP_MEMORY_SCOPE_AGENT) < 4u) { __builtin_amdgcn_s_sleep(2); if (++spins > (1u << 22)) break; }
            __builtin_amdgcn_fence(__ATOMIC_ACQUIRE, "agent");
            asm volatile("s_waitcnt vmcnt(0)" ::: "memory");
        }
        __syncthreads();
        if (tid < 256) { float s = 0.f;
#pragma unroll
            for (int t = 0; t < 4; ++t) s += __hip_atomic_load(xs + t * 256 + tid, __ATOMIC_RELAXED, __HIP_MEMORY_SCOPE_AGENT);
            St[tid] = __builtin_amdgcn_rsqf(s * (1.0f / DM) + EPS); }
        __syncthreads();
        f32x4 gv[2][2];
#pragma unroll
        for (int bj = 0; bj < 2; ++bj)
#pragma unroll
            for (int n = 0; n < 2; ++n) gv[bj][n] = *(const f32x4*)(fg + col0 + bj * HALF + n * 16);
#pragma unroll
        for (int ai = 0; ai < 2; ++ai)
#pragma unroll
            for (int m = 0; m < 4; ++m) { const float rs = St[ai * HALF + wr * 64 + m * 16 + fr];
#pragma unroll
                for (int bj = 0; bj < 2; ++bj)
#pragma unroll
                    for (int n = 0; n < 2; ++n) { const unsigned oo = ofs + (unsigned)((ai * HALF + m * 16) * DM + bj * HALF + n * 16) * 4u;
                        *(f32x4*)((char*)H + oo) = acc[ai][bj][m][n] * rs * gv[bj][n]; } }
        __syncthreads();
    }
};
}

namespace scan {
#define MFMA16(a, b, c) __builtin_amdgcn_mfma_f32_16x16x32_bf16((a), (b), (c), 0, 0, 0)
__device__ __forceinline__ unsigned offb(unsigned row, unsigned ch) { return 256u * row + 16u * (ch ^ (((row & 3u) << 2) | ((row >> 2) & 3u))); }
__device__ __forceinline__ unsigned voffv(unsigned r, unsigned cp) { return 128u * r + 32u * (cp ^ (((r >> 1) & 3u) ^ (((r >> 3) & 1u) << 1))); }
__device__ __forceinline__ bf16x8 tr2(unsigned a0, unsigned a1) {
    u32x2 lo, hi;
    asm volatile("ds_read_b64_tr_b16 %0, %2\n\tds_read_b64_tr_b16 %1, %3\n\ts_waitcnt lgkmcnt(0)" : "=&v"(lo), "=&v"(hi) : "v"(a0), "v"(a1) : "memory");
    const u32x4 r = {lo.x, lo.y, hi.x, hi.y}; return __builtin_bit_cast(bf16x8, r);
}
__device__ __forceinline__ void tr8(unsigned a0, unsigned a1, unsigned c0, unsigned c1, bf16x8& f00, bf16x8& f01, bf16x8& f10, bf16x8& f11) {
    u32x2 r0, r1, r2, r3, r4, r5, r6, r7;
    asm volatile("ds_read_b64_tr_b16 %0, %8\n\tds_read_b64_tr_b16 %1, %9\n\tds_read_b64_tr_b16 %2, %8 offset:8192\n\tds_read_b64_tr_b16 %3, %9 offset:8192\n\t"
                 "ds_read_b64_tr_b16 %4, %10\n\tds_read_b64_tr_b16 %5, %11\n\tds_read_b64_tr_b16 %6, %10 offset:8192\n\tds_read_b64_tr_b16 %7, %11 offset:8192\n\ts_waitcnt lgkmcnt(0)"
                 : "=&v"(r0), "=&v"(r1), "=&v"(r2), "=&v"(r3), "=&v"(r4), "=&v"(r5), "=&v"(r6), "=&v"(r7) : "v"(a0), "v"(a1), "v"(c0), "v"(c1) : "memory");
    const u32x4 x00 = {r0.x, r0.y, r1.x, r1.y}, x01 = {r2.x, r2.y, r3.x, r3.y}, x10 = {r4.x, r4.y, r5.x, r5.y}, x11 = {r6.x, r6.y, r7.x, r7.y};
    f00 = __builtin_bit_cast(bf16x8, x00); f01 = __builtin_bit_cast(bf16x8, x01); f10 = __builtin_bit_cast(bf16x8, x10); f11 = __builtin_bit_cast(bf16x8, x11);
}
__device__ __forceinline__ bf16x8 pack8(const f32x4 a, const f32x4 b) { const u32x4 r = {pkbf(a[0], a[1]), pkbf(a[2], a[3]), pkbf(b[0], b[1]), pkbf(b[2], b[3])}; return __builtin_bit_cast(bf16x8, r); }
__device__ __forceinline__ u32x2 tr_issue(unsigned a) { u32x2 r; asm volatile("ds_read_b64_tr_b16 %0, %1" : "=v"(r) : "v"(a) : "memory"); return r; }
__device__ __forceinline__ u32x2 tr_issue_hi(unsigned a) { u32x2 r; asm volatile("ds_read_b64_tr_b16 %0, %1 offset:8192" : "=v"(r) : "v"(a) : "memory"); return r; }
#define TRW(x) "+v"(x)
__device__ __forceinline__ void tr_wait20(u32x2 (&a)[20], bool do_wait) {
    if (do_wait) asm volatile("s_waitcnt lgkmcnt(0)" : TRW(a[0]), TRW(a[1]), TRW(a[2]), TRW(a[3]), TRW(a[4]), TRW(a[5]), TRW(a[6]), TRW(a[7]), TRW(a[8]), TRW(a[9]), TRW(a[10]), TRW(a[11]), TRW(a[12]), TRW(a[13]), TRW(a[14]), TRW(a[15]), TRW(a[16]), TRW(a[17]), TRW(a[18]), TRW(a[19]) :: "memory");
    else asm volatile("" : TRW(a[0]), TRW(a[1]), TRW(a[2]), TRW(a[3]), TRW(a[4]), TRW(a[5]), TRW(a[6]), TRW(a[7]), TRW(a[8]), TRW(a[9]), TRW(a[10]), TRW(a[11]), TRW(a[12]), TRW(a[13]), TRW(a[14]), TRW(a[15]), TRW(a[16]), TRW(a[17]), TRW(a[18]), TRW(a[19]) :: "memory");
}
#undef TRW
__device__ __forceinline__ bf16x8 frag2(const u32x2 lo, const u32x2 hi) { const u32x4 r = {lo.x, lo.y, hi.x, hi.y}; return __builtin_bit_cast(bf16x8, r); }
template <int NJ>
__device__ __forceinline__ void at_part(LAS unsigned char* lds, unsigned QI, unsigned KI, int it, unsigned l15, unsigned g, bf16x8 (&at)[NJ / 2]) {
    const unsigned trow = 16u * (unsigned)it + l15;
    bf16x8 qb[4];
#pragma unroll
    for (int kd = 0; kd < 4; ++kd) qb[kd] = *(const LAS bf16x8*)(lds + QI + offb(trow, 4u * kd + g));
    f32x4 c[NJ];
#pragma unroll
    for (int j = 0; j < NJ; ++j) { c[j] = (f32x4){0.f, 0.f, 0.f, 0.f};
        if (j <= it) {
#pragma unroll
            for (int kd = 0; kd < 4; ++kd) { const bf16x8 a = *(const LAS bf16x8*)(lds + KI + offb(16u * j + l15, 4u * kd + g)); c[j] = MFMA16(a, qb[kd], c[j]); }
            if (j == it) {
#pragma unroll
                for (int r = 0; r < 4; ++r) c[j][r] = (4u * g + r <= l15) ? c[j][r] : 0.f; } } }
#pragma unroll
    for (int ks = 0; ks < NJ / 2; ++ks) at[ks] = pack8(c[2 * ks], c[2 * ks + 1]);
}
template <int NK>
__device__ __forceinline__ f32x4 o_part(LAS unsigned char* lds, unsigned QI, int it, const bf16x8 (&at)[NK], const bf16x8 (&vf)[2], const bf16x8 (&sfrag)[4], unsigned l15, unsigned g) {
    const unsigned trow = 16u * (unsigned)it + l15;
    f32x4 o = (f32x4){0.f, 0.f, 0.f, 0.f};
#pragma unroll
    for (int ks = 0; ks < NK; ++ks) if (2 * ks <= it) o = MFMA16(vf[ks], at[ks], o);
#pragma unroll
    for (int kd = 0; kd < 4; ++kd) {
        const u32x2 q0 = *(const LAS u32x2*)(lds + QI + offb(trow, 4u * kd + (g >> 1)) + 8u * (g & 1)), q1 = *(const LAS u32x2*)(lds + QI + offb(trow, 4u * kd + 2u + (g >> 1)) + 8u * (g & 1));
        o = MFMA16(sfrag[kd], frag2(q0, q1), o); }
    return o;
}
__device__ __forceinline__ void phase(LAS unsigned char* lds, const bf16_t* Qt, const bf16_t* Kt, bf16_t* VO, const float* DEC, float* ss8, int bid, int G, int wave) {
    int lane_ = (int)__builtin_amdgcn_mbcnt_hi(~0u, __builtin_amdgcn_mbcnt_lo(~0u, 0u)); asm volatile("" : "+v"(lane_));
    const unsigned lane = (unsigned)lane_, tid = (unsigned)wave * 64u + lane, l15 = lane & 15u, g = lane >> 4, ql = l15 >> 2, p = lane & 3u;
    const unsigned vs = (unsigned)wave & 3u; const int th = wave >> 2, tA = th ? 1 : 0, tB = th ? 2 : 3;
    const unsigned ldsb = (unsigned)(uintptr_t)lds;
    const unsigned srow = tid >> 4, sch = tid & 15u, vrow = tid >> 3, vch = tid & 7u;
    for (int item = bid; item < BATCH * NHEAD * 2; item += G) {
        const int half = (item >> 3) & 1, pair = (item & 7) | ((item >> 4) << 3), b = pair >> 4, h = pair & 15;
        const size_t tokb = (size_t)b * SEQ;
        const bf16_t* qg = Qt + (tokb + srow) * DI + h * HD + sch * 8;
        const bf16_t* kg = Kt + (tokb + srow) * DI + h * HD + sch * 8;
        bf16_t* vg = VO + tokb * DI + h * HD + half * 64;
        f32x4 S[8]; bf16x8 sfrag[4];
#pragma unroll
        for (int i = 0; i < 8; ++i) S[i] = (f32x4){0.f, 0.f, 0.f, 0.f};
#pragma unroll
        for (int i = 0; i < 4; ++i) sfrag[i] = (bf16x8){0, 0, 0, 0, 0, 0, 0, 0};
        u32x4 rq0, rq1, rk0, rk1, rv; f32x4 rdec = (f32x4){0.f, 0.f, 0.f, 0.f};
        const float* dg = DEC + (size_t)(b * (SEQ / 64)) * DI + h * HD + (tid & 31u) * 4u;
#define SC_LOAD(n_) do { const size_t t0_ = (size_t)(n_) * 64; \
            rq0 = *(const u32x4*)(qg + t0_ * DI); rq1 = *(const u32x4*)(qg + (t0_ + 32) * DI); rk0 = *(const u32x4*)(kg + t0_ * DI); rk1 = *(const u32x4*)(kg + (t0_ + 32) * DI); \
            rv = *(const u32x4*)(vg + (t0_ + vrow) * DI + vch * 8); if (tid < 32u) rdec = *(const f32x4*)(dg + (size_t)(n_) * DI); } while (0)
#define SC_STORE(base_) do { *(LAS u32x4*)(lds + (base_) + offb(srow, sch)) = rq0; *(LAS u32x4*)(lds + (base_) + offb(srow + 32u, sch)) = rq1; \
            *(LAS u32x4*)(lds + (base_) + 16384u + offb(srow, sch)) = rk0; *(LAS u32x4*)(lds + (base_) + 16384u + offb(srow + 32u, sch)) = rk1; \
            *(LAS u32x4*)(lds + (base_) + 32768u + voffv(vrow, vch >> 1) + 16u * (vch & 1u)) = rv; \
            if (tid < 32u) *(LAS f32x4*)(lds + 81920u + ((base_) ? 512u : 0u) + tid * 16u) = rdec; } while (0)
        SC_LOAD(0); SC_STORE(0u); __syncthreads();
        for (int n = 0; n < SEQ / 64; ++n) {
            const unsigned QI = (unsigned)(n & 1) * 40960u, KI = QI + 16384u, VI = QI + 32768u;
            if (n + 1 < SEQ / 64) SC_LOAD(n + 1);
            u32x2 tv0, tv1, tv2, tv3, tv4, tv5, tv6, tv7;
            {
                const unsigned va = ldsb + VI + 8u * p;
                tv0 = tr_issue(va + voffv(4u * g + ql, vs)); tv1 = tr_issue(va + voffv(16u + 4u * g + ql, vs)); tv2 = tr_issue(va + voffv(32u + 4u * g + ql, vs)); tv3 = tr_issue(va + voffv(48u + 4u * g + ql, vs));
                tv4 = tr_issue(va + voffv(8u * g + ql, vs)); tv5 = tr_issue(va + voffv(8u * g + 4u + ql, vs)); tv6 = tr_issue(va + voffv(32u + 8u * g + ql, vs)); tv7 = tr_issue(va + voffv(36u + 8u * g + ql, vs));
            }
            bf16x8 atB[2], atA[1];
            at_part<4>(lds, QI, KI, tB, l15, g, atB);
            at_part<2>(lds, QI, KI, tA, l15, g, atA);
            asm volatile("s_waitcnt lgkmcnt(0)" : "+v"(tv0), "+v"(tv1), "+v"(tv2), "+v"(tv3), "+v"(tv4), "+v"(tv5), "+v"(tv6), "+v"(tv7) :: "memory");
            __builtin_amdgcn_sched_barrier(0);
            const bf16x8 vf[2] = {frag2(tv0, tv1), frag2(tv2, tv3)};
            const f32x4 oB = o_part<2>(lds, QI, tB, atB, vf, sfrag, l15, g);
            const f32x4 oA = o_part<1>(lds, QI, tA, atA, vf, sfrag, l15, g);
            {
                const bf16x8 vn0 = frag2(tv4, tv5), vn1 = frag2(tv6, tv7);
                const LAS float* dcp = (const LAS float*)(lds + 81920u + (unsigned)(n & 1) * 512u) + 4u * g;
                const unsigned ka = ldsb + KI + offb(8u * g + ql, (p >> 1)) + 8u * (p & 1u), kb = ldsb + KI + offb(8u * g + 4u + ql, (p >> 1)) + 8u * (p & 1u);
#pragma unroll
                for (int i = 0; i < 8; i += 2) {
                    bf16x8 k00, k01, k10, k11;
                    tr8(ka ^ ((unsigned)i << 5), kb ^ ((unsigned)i << 5), ka ^ ((unsigned)(i + 1) << 5), kb ^ ((unsigned)(i + 1) << 5), k00, k01, k10, k11);
                    S[i] = MFMA16(k00, vn0, S[i]); S[i + 1] = MFMA16(k10, vn0, S[i + 1]); S[i] = MFMA16(k01, vn1, S[i]); S[i + 1] = MFMA16(k11, vn1, S[i + 1]); }
#pragma unroll
                for (int i = 0; i < 8; ++i) { const f32x4 dc = *(const LAS f32x4*)(dcp + 16 * i); S[i] = S[i] * dc; }
#pragma unroll
                for (int kd = 0; kd < 4; ++kd) sfrag[kd] = pack8(S[2 * kd], S[2 * kd + 1]);
            }
            if (n + 1 < SEQ / 64) SC_STORE((unsigned)((n + 1) & 1) * 40960u);
            {
                const size_t tlB = (size_t)n * 64 + 16u * (unsigned)tB + l15, tlA = (size_t)n * 64 + 16u * (unsigned)tA + l15;
                const u32x2 wB = {pkbf(oB[0], oB[1]), pkbf(oB[2], oB[3])}, wA = {pkbf(oA[0], oA[1]), pkbf(oA[2], oA[3])};
                *(u32x2*)(vg + tlB * DI + 16u * vs + 4u * g) = wB; *(u32x2*)(vg + tlA * DI + 16u * vs + 4u * g) = wA;
                float sB = (oB[0] * oB[0] + oB[1] * oB[1]) + (oB[2] * oB[2] + oB[3] * oB[3]), sA = (oA[0] * oA[0] + oA[1] * oA[1]) + (oA[2] * oA[2] + oA[3] * oA[3]);
                sB += xor_get(sB, (int)lane, 16); sA += xor_get(sA, (int)lane, 16); sB += xor_get(sB, (int)lane, 32); sA += xor_get(sA, (int)lane, 32);
                if (g == 0) { ss8[(tokb + tlB) * 128 + h * 8 + half * 4 + vs] = sB; ss8[(tokb + tlA) * 128 + h * 8 + half * 4 + vs] = sA; }
            }
            __syncthreads();
        }
#undef SC_LOAD
#undef SC_STORE
    }
}
#undef MFMA16
}

#define XB_TMO      128
#define XB_XCNT(j)  (256  + 64 * (j))
#define XB_XSUB(j)  (1280 + 64 * (j))
#define XB_XGEN(j)  (2304 + 64 * (j))
#define XB_TOP      3328
#define XB_TOPGEN   3392
#define XCD_BAR_WORDS 3456
#define XB_SPIN_CAP (1u << 18)
__device__ __forceinline__ unsigned xb_ld(unsigned* p)              { return __hip_atomic_load(p, __ATOMIC_RELAXED, __HIP_MEMORY_SCOPE_AGENT); }
__device__ __forceinline__ unsigned xb_add(unsigned* p, unsigned v) { return __hip_atomic_fetch_add(p, v, __ATOMIC_RELAXED, __HIP_MEMORY_SCOPE_AGENT); }
__device__ __forceinline__ unsigned xb_xcc_id() { return (unsigned)__builtin_amdgcn_s_getreg((3 << 11) | 20) & 0xFu; }
#define XB_SPIN(cond, bar) do { unsigned _sp = 0; while (cond) { __builtin_amdgcn_s_sleep(1); \
    if ((++_sp & 255u) == 0u) { if (xb_ld(&(bar)[XB_TMO])) break; if (_sp > XB_SPIN_CAP) { atomicAdd(&(bar)[XB_TMO], 1u); break; } } } } while (0)
struct XcdBarrier { unsigned* bar; unsigned x; volatile LAS unsigned* st; };
__device__ __forceinline__ XcdBarrier xcd_barrier_post(unsigned* bar, volatile LAS unsigned* st) {
    XcdBarrier b; b.bar = bar; b.x = xb_xcc_id(); b.st = st;
    if (threadIdx.x == 0) (void)xb_add(&bar[XB_XCNT(b.x)], 1u);
    return b;
}
__device__ __forceinline__ void xcd_barrier_complete(unsigned* bar, unsigned x, unsigned& nloc, unsigned& nx) {
    const unsigned G = gridDim.x * gridDim.y * gridDim.z;
    unsigned sum, cnt, mine, sp = 0u;
    for (;;) {
        sum = 0u; cnt = 0u; mine = 0u;
#pragma unroll
        for (unsigned j = 0; j < 16; ++j) { const unsigned c = xb_ld(&bar[XB_XCNT(j)]); sum += c; cnt += (c > 0u) ? 1u : 0u; mine = (j == x) ? c : mine; }
        if (sum == G) break;
        __builtin_amdgcn_s_sleep(1);
        if ((++sp & 255u) == 0u) { if (xb_ld(&bar[XB_TMO])) break; if (sp > XB_SPIN_CAP) { atomicAdd(&bar[XB_TMO], 1u); break; } }
    }
    nloc = mine > 0u ? mine : 1u; nx = cnt > 0u ? cnt : 1u;
}
__device__ __forceinline__ void xcd_barrier(const XcdBarrier& b) {
    asm volatile("s_waitcnt vmcnt(0)" ::: "memory");
    __syncthreads();
    if (threadIdx.x == 0) {
        unsigned* bar = b.bar;
        __builtin_amdgcn_s_waitcnt(0);
        unsigned nloc = b.st[0], nx = b.st[1];
        if (nloc == 0u) { xcd_barrier_complete(bar, b.x, nloc, nx); b.st[0] = nloc; b.st[1] = nx; }
        const unsigned old = xb_add(&bar[XB_XSUB(b.x)], 1u);
        const unsigned gen = old / nloc;
        if (old + 1u == (gen + 1u) * nloc) {
            __builtin_amdgcn_fence(__ATOMIC_RELEASE, "agent");
            asm volatile("s_waitcnt vmcnt(0)" ::: "memory");
            const unsigned og = xb_add(&bar[XB_TOP], 1u);
            const unsigned tg = og / nx;
            if (og + 1u == (tg + 1u) * nx) xb_add(&bar[XB_TOPGEN], 1u);
            else XB_SPIN(xb_ld(&bar[XB_TOPGEN]) == tg, bar);
            __builtin_amdgcn_fence(__ATOMIC_ACQUIRE, "agent");
            xb_add(&bar[XB_XGEN(b.x)], 1u);
            asm volatile("s_waitcnt vmcnt(0)" ::: "memory");
        } else {
            XB_SPIN(xb_ld(&bar[XB_XGEN(b.x)]) == gen, bar);
            __builtin_amdgcn_fence(__ATOMIC_ACQUIRE, "agent");
            asm volatile("s_waitcnt vmcnt(0)" ::: "memory");
        }
    }
    __syncthreads();
}

struct Args {
    const float* x; const float* norm_g; const float* pool_w_in; const float* pool_w_grp; const float* pool_scale; const float* pool_w_out;
    const float* hgrn_w_in; const float* hgrn_lb; const float* hgrn_norm_g; const float* hgrn_w_out; const float* final_g;
    float* out; unsigned char* ws;
};

__device__ __forceinline__ void transpose_item(const float* W, int K, int N, bf16_t* WT, int row_off, const float* ks, const float* ns, LAS float* scr, int item, int lane) {
    const int nblk = N / 32, kb = item / nblk, nb = item % nblk, k0 = 64 * kb, n0 = 32 * nb;
    const float nsv = ns ? ns[n0 + (lane & 31)] : 1.0f;
    float wv[32];
    const float* wp = W + (size_t)(k0 + (lane >> 5)) * N + n0 + (lane & 31);
#pragma unroll
    for (int i = 0; i < 32; ++i) wv[i] = wp[(size_t)(2 * i) * N];
    const float ksv = ks ? ks[k0 + lane] : 1.0f;
#pragma unroll
    for (int i = 0; i < 32; ++i) { const int kk = 2 * i + (lane >> 5); scr[kk * 33 + (lane & 31)] = wv[i] * nsv * lane_get(ksv, kk); }
    asm volatile("s_waitcnt lgkmcnt(0)" ::: "memory");
    const int c = lane & 7;
#pragma unroll
    for (int j = 0; j < 4; ++j) { const int n = (lane >> 3) + 8 * j; const LAS float* s = scr + (8 * c) * 33 + n;
        u32x4 o; o.x = pk2(s[0 * 33], s[1 * 33]); o.y = pk2(s[2 * 33], s[3 * 33]); o.z = pk2(s[4 * 33], s[5 * 33]); o.w = pk2(s[6 * 33], s[7 * 33]);
        *(u32x4*)(WT + (size_t)(row_off + n0 + n) * K + k0 + 8 * c) = o; }
    asm volatile("s_waitcnt lgkmcnt(0)" ::: "memory");
}

__global__ void __launch_bounds__(512, 2) fwd_kernel(Args a) {
    extern __shared__ __attribute__((aligned(16))) unsigned char lds_raw[];
    LAS unsigned char* lds = (LAS unsigned char*)lds_raw;
    volatile LAS unsigned* xst = (volatile LAS unsigned*)(lds + 131072 + 64);
    if (threadIdx.x < 2) xst[threadIdx.x] = 0u;
    __syncthreads();
    const XcdBarrier xbar = xcd_barrier_post((unsigned*)a.ws, xst);
#define GRID_BAR() xcd_barrier(xbar)
    const int G = gridDim.x, bid = blockIdx.x;
    const int NGW = G * 8;
    const int wave = __builtin_amdgcn_readfirstlane((int)threadIdx.x >> 6);
#define PHASE_IDS int lane_ = (int)__builtin_amdgcn_mbcnt_hi(~0u, __builtin_amdgcn_mbcnt_lo(~0u, 0u)); asm volatile("" : "+v"(lane_)); const int lane = lane_, tid = wave * 64 + lane, gw = bid * 8 + wave; (void)gw; (void)tid;
    unsigned char* ws = a.ws;
    bf16_t* Wt_in0 = (bf16_t*)(ws + WS_WIN0); bf16_t* Wt_grp = (bf16_t*)(ws + WS_WGRP); bf16_t* Wt_out0 = (bf16_t*)(ws + WS_WOUT0);
    bf16_t* Wt_in1 = (bf16_t*)(ws + WS_WIN1); bf16_t* Wt_out1 = (bf16_t*)(ws + WS_WOUT1);
    float* part1 = (float*)(ws + WS_PART1); float* part2 = (float*)(ws + WS_PART2); float* ssb = (float*)(ws + WS_SS); float* decb = (float*)(ws + WS_DEC);
    bf16_t* XB = (bf16_t*)(ws + WS_XB); bf16_t* BA = (bf16_t*)(ws + WS_A); bf16_t* BB = (bf16_t*)(ws + WS_B); bf16_t* BC = (bf16_t*)(ws + WS_C);

    {
        PHASE_IDS
        LAS float* scr = (LAS float*)(lds + wave * 16384);
        constexpr int I_IN0 = (DM / 64) * (4096 / 32), I_GRP1 = (512 / 64) * (512 / 32), I_OUT = (DI / 64) * (DM / 32), I_IN1 = (DM / 64) * (8192 / 32);
        constexpr int NITEMS = I_IN0 + 4 * I_GRP1 + I_OUT + I_IN1 + I_OUT;
        for (int it = gw; it < NITEMS; it += NGW) {
            int r = it;
            if (r < I_IN0) { transpose_item(a.pool_w_in, DM, 4096, Wt_in0, 0, a.norm_g, nullptr, scr, r, lane); continue; } r -= I_IN0;
            if (r < 4 * I_GRP1) { const int g = r / I_GRP1; transpose_item(a.pool_w_grp + (size_t)g * 512 * 512, 512, 512, Wt_grp, g * 512, nullptr, a.pool_scale + g * 512, scr, r % I_GRP1, lane); continue; } r -= 4 * I_GRP1;
            if (r < I_OUT) { transpose_item(a.pool_w_out, DI, DM, Wt_out0, 0, nullptr, nullptr, scr, r, lane); continue; } r -= I_OUT;
            if (r < I_IN1) {
                const int n0 = 32 * (r % (8192 / 32)); int d0 = n0;
                if (n0 < 2048) d0 = 256 * (n0 >> 7) + (n0 & 127); else if (n0 < 4096) d0 = 256 * ((n0 - 2048) >> 7) + 128 + (n0 & 127);
                transpose_item(a.hgrn_w_in, DM, 8192, Wt_in1, d0 - n0, a.norm_g + DM, nullptr, scr, r, lane); continue; } r -= I_IN1;
            transpose_item(a.hgrn_w_out, DI, DM, Wt_out1, 0, a.hgrn_norm_g, nullptr, scr, r, lane);
        }
        for (int m = gw; m < M; m += NGW) {
            const f32x4* xr = (const f32x4*)(a.x + (size_t)m * DM) + lane;
            f32x4 v[4]; float s = 0.f;
#pragma unroll
            for (int j = 0; j < 4; ++j) { v[j] = xr[64 * j]; s += (v[j][0] * v[j][0] + v[j][1] * v[j][1]) + (v[j][2] * v[j][2] + v[j][3] * v[j][3]); }
            const float rstd = 1.0f / sqrtf(wave_sum(s, lane) * (1.0f / DM) + EPS);
            unsigned long long* o8 = (unsigned long long*)(XB + (size_t)m * DM) + lane;
#pragma unroll
            for (int j = 0; j < 4; ++j) o8[64 * j] = (unsigned long long)pk2(v[j][0] * rstd, v[j][1] * rstd) | ((unsigned long long)pk2(v[j][2] * rstd, v[j][3] * rstd) << 32);
        }
    }
    GRID_BAR();

    {
        pg8::Gemm g{XB, Wt_in0, DM, DM, DM, 0}; pg8::StaticOrder S; S.init(M, 4096, G, bid);
        pg8::EpiP1 E{BA, BB};
        pg8::gemm_phase<pg8::EpiP1>(lds, g, S, E, wave);
    }
    GRID_BAR();

    {
        PHASE_IDS
        constexpr int RUN = 64;
        const int nruns = (M / RUN) * (DI / 8);
        for (int idx = bid * 512 + tid; idx < nruns; idx += G * 512) {
            const int cgp = idx & 255, run = idx >> 8, grp = cgp >> 6, w = 2 << grp;
            const int m0 = run * RUN, t0 = m0 & (SEQ - 1);
            const bf16_t* vp = BA + (size_t)m0 * DI + cgp * 8; bf16_t* pp = BC + (size_t)m0 * DI + cgp * 8;
            float sum[8];
#pragma unroll
            for (int j = 0; j < 8; ++j) sum[j] = 0.f;
            if (t0 > 0) for (int k = 1; k < w; ++k) { const u32x4 vv = *(const u32x4*)(vp - (size_t)k * DI);
                sum[0] += bf_lo(vv.x); sum[1] += bf_hi(vv.x); sum[2] += bf_lo(vv.y); sum[3] += bf_hi(vv.y); sum[4] += bf_lo(vv.z); sum[5] += bf_hi(vv.z); sum[6] += bf_lo(vv.w); sum[7] += bf_hi(vv.w); }
#pragma unroll 4
            for (int i = 0; i < RUN; ++i) {
                const int t = t0 + i;
                const u32x4 vv = *(const u32x4*)(vp + (size_t)i * DI);
                float x[8] = {bf_lo(vv.x), bf_hi(vv.x), bf_lo(vv.y), bf_hi(vv.y), bf_lo(vv.z), bf_hi(vv.z), bf_lo(vv.w), bf_hi(vv.w)};
#pragma unroll
                for (int j = 0; j < 8; ++j) sum[j] += x[j];
                const int cnt = (t + 1) < w ? (t + 1) : w; const float inv = 1.0f / (float)cnt;
                u32x4 o; o.x = pkbf(sum[0] * inv - x[0], sum[1] * inv - x[1]); o.y = pkbf(sum[2] * inv - x[2], sum[3] * inv - x[3]);
                o.z = pkbf(sum[4] * inv - x[4], sum[5] * inv - x[5]); o.w = pkbf(sum[6] * inv - x[6], sum[7] * inv - x[7]);
                *(u32x4*)(pp + (size_t)i * DI) = o;
                if (t + 1 >= w) { const u32x4 uu = *(const u32x4*)(vp + (size_t)(i + 1 - w) * DI);
                    sum[0] -= bf_lo(uu.x); sum[1] -= bf_hi(uu.x); sum[2] -= bf_lo(uu.y); sum[3] -= bf_hi(uu.y); sum[4] -= bf_lo(uu.z); sum[5] -= bf_hi(uu.z); sum[6] -= bf_lo(uu.w); sum[7] -= bf_hi(uu.w); }
            }
        }
    }
    GRID_BAR();

    {
        pg8::Gemm g{BC, Wt_grp, DI, 512, 512, 2}; pg8::StaticOrder S; S.init(M, DI, G, bid);
        pg8::EpiP2 E{BB};
        pg8::gemm_phase<pg8::EpiP2>(lds, g, S, E, wave);
    }
    GRID_BAR();

    {
        pg8::Gemm g{BB, Wt_out0, DI, DI, DI, 0}; pg8::StaticOrder S; S.init(M, DM, G, bid);
        pg8::EpiRes<true, false> E{a.x, nullptr, XB, part1};
        pg8::gemm_phase<pg8::EpiRes<true, false>>(lds, g, S, E, wave);
    }
    GRID_BAR();

    {
        pg8::Gemm g{XB, Wt_in1, DM, DM, DM, 0}; pg8::StaticOrder S; S.init(M, 6144, G, bid);
        pg8::EpiP4 E{BA, BB, BC, decb, part1, a.hgrn_lb};
        pg8::gemm_phase<pg8::EpiP4>(lds, g, S, E, wave);
    }
    GRID_BAR();

    scan::phase(lds, BA, BB, BC, decb, ssb, bid, G, wave);
    GRID_BAR();

    {
        pg8::Gemm g{XB, Wt_in1 + (size_t)6144 * DM, DM, DM, DM, 0}; pg8::StaticOrder S; S.init(M, DI, G, bid);
        pg8::EpiP5b E{BC, part1, ssb};
        pg8::gemm_phase<pg8::EpiP5b>(lds, g, S, E, wave);
    }
    GRID_BAR();

    {
        pg8::Gemm g{BC, Wt_out1, DI, DI, DI, 0}; pg8::StaticOrder S; S.init(M, DM, G, bid);
        pg8::EpiFinal E{XB, a.out, a.final_g, (float*)(ws + WS_X), (unsigned*)(ws + WS_CNT)};
        pg8::gemm_phase<pg8::EpiFinal>(lds, g, S, E, wave);
    }
}

extern "C" void kernel_launch(void* const* d_in, const int* in_sizes, int n_in, void* d_out, int out_size, void* d_ws, size_t ws_size, hipStream_t stream) {
    static int grid = 0;
    if (grid == 0) {
        if (n_in != 11 || in_sizes[0] != M * DM || out_size != M * DM || ws_size < WS_END) { fprintf(stderr, "kernel_launch: unexpected shapes (n_in %d in0 %d out %d ws %zu)\n", n_in, n_in > 0 ? in_sizes[0] : -1, out_size, ws_size); grid = -1; return; }
        int dev = 0, cus = 0, per = 0;
        if (hipGetDevice(&dev) != hipSuccess || hipDeviceGetAttribute(&cus, hipDeviceAttributeMultiprocessorCount, dev) != hipSuccess) { grid = -1; return; }
        if (hipFuncSetAttribute((const void*)fwd_kernel, hipFuncAttributeMaxDynamicSharedMemorySize, LDS_BYTES) != hipSuccess) { fprintf(stderr, "kernel_launch: hipFuncSetAttribute failed\n"); grid = -1; return; }
        if (hipOccupancyMaxActiveBlocksPerMultiprocessor(&per, (const void*)fwd_kernel, 512, LDS_BYTES) != hipSuccess || per < 1) { fprintf(stderr, "kernel_launch: occupancy query says %d\n", per); (void)hipGetLastError(); grid = -1; return; }
        grid = cus;
        fprintf(stderr, "kernel_launch: cus %d per_cu %d grid %d\n", cus, per, grid);
    }
    if (grid < 0) return;
    if (hipMemsetAsync(d_ws, 0, 32768, stream) != hipSuccess) { fprintf(stderr, "kernel_launch: hipMemsetAsync failed\n"); return; }
    Args a{};
    a.x = (const float*)d_in[0]; a.norm_g = (const float*)d_in[1]; a.pool_w_in = (const float*)d_in[2]; a.pool_w_grp = (const float*)d_in[3];
    a.pool_scale = (const float*)d_in[4]; a.pool_w_out = (const float*)d_in[5]; a.hgrn_w_in = (const float*)d_in[6]; a.hgrn_lb = (const float*)d_in[7];
    a.hgrn_norm_g = (const float*)d_in[8]; a.hgrn_w_out = (const float*)d_in[9]; a.final_g = (const float*)d_in[10];
    a.out = (float*)d_out; a.ws = (unsigned char*)d_ws;
    void* args[] = {&a};
    hipError_t e = hipLaunchCooperativeKernel((void*)fwd_kernel, dim3(grid), dim3(512), args, LDS_BYTES, stream);
    if (e != hipSuccess) fprintf(stderr, "kernel_launch: cooperative launch failed: %s (grid %d)\n", hipGetErrorString(e), grid);
}
```

```cpp
#include <hip/hip_runtime.h>
#include <hip/hip_cooperative_groups.h>
#include <cstdio>
#include <cstdint>
namespace cg = cooperative_groups;

#define LAS __attribute__((address_space(3)))
typedef unsigned short bf16_t;
typedef short bf16x8 __attribute__((ext_vector_type(8)));
typedef float f32x4 __attribute__((ext_vector_type(4)));
typedef float f32x2 __attribute__((ext_vector_type(2)));
typedef unsigned u32x4 __attribute__((ext_vector_type(4)));
typedef unsigned u32x2 __attribute__((ext_vector_type(2)));

constexpr int DM = 1024, BATCH = 8, SEQ = 4096, DI = 2048, M = BATCH * SEQ;
constexpr int NHEAD = 16, HD = 128;
constexpr float EPS = 1e-6f;
constexpr size_t MiB = 1u << 20;
constexpr size_t WS_WIN0 = 2 * MiB;
constexpr size_t WS_WGRP = 10 * MiB;
constexpr size_t WS_WOUT0 = 12 * MiB;
constexpr size_t WS_WIN1 = 16 * MiB;
constexpr size_t WS_WOUT1 = 32 * MiB;
constexpr size_t WS_PART1 = 36 * MiB;
constexpr size_t WS_PART2 = 38 * MiB;
constexpr size_t WS_CNT = 16384;
constexpr size_t WS_X = 40 * MiB;
constexpr size_t WS_DEC = 44 * MiB;
constexpr size_t WS_SS = 112 * MiB;
constexpr size_t WS_XB = 48 * MiB;
constexpr size_t WS_A = 128 * MiB;
constexpr size_t WS_B = 256 * MiB;
constexpr size_t WS_C = 384 * MiB;
constexpr size_t WS_END = 512 * MiB;
constexpr int LDS_BYTES = 147456;

__device__ __forceinline__ unsigned f2bf(float f) { unsigned u = __builtin_bit_cast(unsigned, f); return (u + 0x7fffu + ((u >> 16) & 1u)) >> 16; }
__device__ __forceinline__ unsigned pk2(float lo, float hi) { return f2bf(lo) | (f2bf(hi) << 16); }
typedef __bf16 bf2_t __attribute__((ext_vector_type(2)));
__device__ __forceinline__ unsigned pkbf(float lo, float hi) { f32x2 v = {lo, hi}; return __builtin_bit_cast(unsigned, __builtin_convertvector(v, bf2_t)); }
__device__ __forceinline__ float bf_lo(unsigned w) { return __builtin_bit_cast(float, w << 16); }
__device__ __forceinline__ float bf_hi(unsigned w) { return __builtin_bit_cast(float, w & 0xffff0000u); }
__device__ __forceinline__ float silu_f(float x) { return x * __builtin_amdgcn_rcpf(1.0f + __builtin_amdgcn_exp2f(-1.44269504089f * x)); }
__device__ __forceinline__ float lane_get(float v, int src_lane) { return __builtin_bit_cast(float, __builtin_amdgcn_ds_bpermute(src_lane << 2, __builtin_bit_cast(int, v))); }
__device__ __forceinline__ float xor_get(float v, int lane, int m) { return lane_get(v, lane ^ m); }
__device__ __forceinline__ float wave_sum(float v, int lane) {
#pragma unroll
    for (int o = 1; o < 64; o <<= 1) v += xor_get(v, lane, o);
    return v;
}

namespace pg8 {
constexpr int BM = 256, BK = 64, HALF = 128, HTB = HALF * BK * 2, STAGE_BYTES = 8 * HTB, NXCD = 8, WGM = 8;
__host__ __device__ __forceinline__ int lds_byte(int r, int c) { const int st = (r >> 4) * 2 + (c >> 5), rr = r & 15, cc = c & 31, ob = rr * 64 + cc * 2; return st * 1024 + (ob ^ (((ob >> 9) & 1) << 5)); }
__host__ __device__ __forceinline__ void stage_rc(int b, int& R, int& C) { const int st = b / 1024, sb = b % 1024, swz = sb ^ (((sb >> 9) & 1) << 5); R = (st >> 1) * 16 + swz / 64; C = (st & 1) * 32 + (swz % 64) / 2; }
__host__ __device__ __forceinline__ int perm32(int rho) { const int n = rho >> 4, i = rho & 15; return 8 * (i >> 2) + 4 * n + (i & 3); }

struct Unit { int pm, pn; };
struct Gemm { const bf16_t* A; const bf16_t* Bt; int lda, ldb, K, grp_tiles; };

struct StaticOrder {
    int nM, nN, nwg, G, c;
    __host__ __device__ void init(int M_, int N_, int G_, int c_) { nM = M_ / BM; nN = N_ / BM; nwg = nM * nN; G = G_; c = c_; }
    __host__ __device__ bool next(int i, Unit& u) const {
        const long L = (long)i * G + c; if (L >= nwg) return false;
        int wgid = (int)L; { const int q = nwg / NXCD, r = nwg % NXCD, xcd = wgid % NXCD, off = wgid / NXCD; wgid = (xcd < r ? xcd * (q + 1) : r * (q + 1) + (xcd - r) * q) + off; }
        const int nig = WGM * nN, gid = wgid / nig, fm = gid * WGM, gsz = (nM - fm) < WGM ? (nM - fm) : WGM;
        u.pm = fm + ((wgid % nig) % gsz); u.pn = (wgid % nig) / gsz; return true;
    }
};

__device__ __forceinline__ unsigned cvt_pk_bf16(float lo, float hi) { unsigned r; asm volatile("v_cvt_pk_bf16_f32 %0, %1, %2" : "=v"(r) : "v"(lo), "v"(hi)); return r; }

template <class Epi, bool ALIGN_EPI = true, bool SP2 = true>
__device__ __forceinline__ void gemm_phase(LAS unsigned char* lds, const Gemm g, const StaticOrder& S, const Epi& E, const int wid) {
    int lane_ = (int)__builtin_amdgcn_mbcnt_hi(~0u, __builtin_amdgcn_mbcnt_lo(~0u, 0u)); asm volatile("" : "+v"(lane_));
    int lane = lane_, tid = wid * 64 + lane, fr = lane & 15, fq = lane >> 4; const int wr = wid >> 2, wc = wid & 3;
    const int K = g.K, nt = K / BK;
    unsigned voffA[2], voffB[2]; int aoff, boff;
#define PG8_LANE_STATE() do { _Pragma("unroll") for (int i = 0; i < 2; ++i) { int R, C; stage_rc(tid * 16 + i * 8192, R, C); const int Rb = Epi::PERM ? ((R & ~31) + perm32(R & 31)) : R; \
        voffA[i] = (unsigned)(R * g.lda + C) * 2u; voffB[i] = (unsigned)(Rb * g.ldb + C) * 2u; } \
        aoff = lds_byte(wr * 64 + fr, fq * 8); boff = lds_byte(wc * 32 + fr, fq * 8); } while (0)
    PG8_LANE_STATE();
    const size_t kstep = (size_t)(BK * 2);
    const size_t hstepA = (size_t)HALF * g.lda * 2, hstepB = (size_t)HALF * g.ldb * 2;
    const size_t tstepA = 2 * hstepA, tstepB = 2 * hstepB;
    const unsigned ldsw = (unsigned)wid * 1024u;
#define PG8_SA(b, h) (((b) * 2 + (h)) * HTB)
#define PG8_SB(b, h) ((4 + (b) * 2 + (h)) * HTB)
#define PG8_STAGE(bufoff, gbase, voff) do { _Pragma("unroll") for (int _i = 0; _i < 2; ++_i) \
        __builtin_amdgcn_global_load_lds((const unsigned*)((const char*)(gbase) + (voff)[_i]), (LAS unsigned*)(lds + (bufoff) + ldsw + _i * 8192), 16, 0, 0); } while (0)
#define PG8_LDA(dst, b, h) do { _Pragma("unroll") for (int m = 0; m < 4; ++m) _Pragma("unroll") for (int k = 0; k < 2; ++k) dst[m][k] = *(const LAS bf16x8*)(lds + PG8_SA(b, h) + aoff + m * 2048 + k * 1024); } while (0)
#define PG8_LDB(dst, b, h) do { _Pragma("unroll") for (int n = 0; n < 2; ++n) _Pragma("unroll") for (int k = 0; k < 2; ++k) dst[n][k] = *(const LAS bf16x8*)(lds + PG8_SB(b, h) + boff + n * 2048 + k * 1024); } while (0)
#define PG8_MMA(ai, bj, At, Bt) do { __builtin_amdgcn_s_setprio(1); _Pragma("unroll") for (int m = 0; m < 4; ++m) _Pragma("unroll") for (int n = 0; n < 2; ++n) _Pragma("unroll") for (int k = 0; k < 2; ++k) \
        acc[ai][bj][m][n] = __builtin_amdgcn_mfma_f32_16x16x32_bf16(Bt[n][k], At[m][k], acc[ai][bj][m][n], 0, 0, 0); __builtin_amdgcn_s_setprio(0); } while (0)
#define PG8_WAIT_V(n) asm volatile("s_waitcnt vmcnt(" #n ")" ::: "memory")
#define PG8_WAIT_L(n) asm volatile("s_waitcnt lgkmcnt(" #n ")" ::: "memory")
#define PG8_BAR __builtin_amdgcn_s_barrier()
#define PG8_SCHED __builtin_amdgcn_sched_barrier(0)
#define PG8_ABASE(u) ((const char*)g.A + (size_t)(u).pm * tstepA + (g.grp_tiles ? (size_t)((u).pn / g.grp_tiles) * (size_t)K * 2 : (size_t)0))
#define PG8_BBASE(u) ((const char*)g.Bt + (size_t)(u).pn * tstepB)
    Unit cur, nxt; int ui = 0;
    E.prologue(S, lds, tid);
    if (!S.next(0, cur)) return;
    f32x4 acc[2][2][4][2];
#pragma unroll
    for (int a = 0; a < 2; ++a)
#pragma unroll
        for (int b = 0; b < 2; ++b)
#pragma unroll
            for (int m = 0; m < 4; ++m)
#pragma unroll
                for (int n = 0; n < 2; ++n) acc[a][b][m][n] = (f32x4){0.f, 0.f, 0.f, 0.f};
    bf16x8 At[4][2], B0[2][2], B1[2][2];
    const char* cA = PG8_ABASE(cur); const char* cB = PG8_BBASE(cur);
    if constexpr (SP2) {
        PG8_STAGE(PG8_SB(0, 0), cB, voffB); PG8_STAGE(PG8_SB(0, 1), cB + hstepB, voffB); PG8_STAGE(PG8_SA(0, 0), cA, voffA); PG8_STAGE(PG8_SA(0, 1), cA + hstepA, voffA);
        if (wr == 1) PG8_BAR;
        PG8_WAIT_V(2); PG8_BAR;
        PG8_STAGE(PG8_SB(1, 0), cB + kstep, voffB); PG8_STAGE(PG8_SA(1, 0), cA + kstep, voffA); PG8_STAGE(PG8_SB(1, 1), cB + hstepB + kstep, voffB);
        PG8_WAIT_V(6); PG8_BAR;
    } else {
        PG8_STAGE(PG8_SB(0, 0), cB, voffB); PG8_STAGE(PG8_SA(0, 0), cA, voffA); PG8_STAGE(PG8_SB(0, 1), cB + hstepB, voffB); PG8_STAGE(PG8_SA(0, 1), cA + hstepA, voffA);
        if (wr == 1) PG8_BAR;
        PG8_WAIT_V(4); PG8_BAR;
        PG8_STAGE(PG8_SB(1, 0), cB + kstep, voffB); PG8_STAGE(PG8_SA(1, 0), cA + kstep, voffA); PG8_STAGE(PG8_SB(1, 1), cB + hstepB + kstep, voffB);
        PG8_WAIT_V(6); PG8_BAR;
    }
    for (;;) {
        const bool has_next = S.next(ui + 1, nxt);
        const char* nA = has_next ? PG8_ABASE(nxt) : cA; const char* nB = has_next ? PG8_BBASE(nxt) : cB;
        for (int t = 0; t < nt; t += 2) {
            const bool last = (t == nt - 2);
            const char* a1 = cA + (size_t)(t + 1) * kstep;
            const char* a2 = last ? nA : cA + (size_t)(t + 2) * kstep; const char* b2 = last ? nB : cB + (size_t)(t + 2) * kstep;
            const char* a3 = a2 + kstep; const char* b3 = b2 + kstep;
            if constexpr (SP2) {
            PG8_LDB(B0, 0, 0); PG8_LDB(B1, 0, 1); PG8_SCHED; PG8_LDA(At, 0, 0); PG8_STAGE(PG8_SA(1, 1), a1 + hstepA, voffA);
            PG8_WAIT_V(8); PG8_WAIT_L(0); PG8_BAR; PG8_MMA(0, 0, At, B0); PG8_MMA(0, 1, At, B1); PG8_BAR; PG8_SCHED;
            PG8_LDA(At, 0, 1); PG8_STAGE(PG8_SB(0, 0), b2, voffB); PG8_STAGE(PG8_SB(0, 1), b2 + hstepB, voffB); PG8_STAGE(PG8_SA(0, 0), a2, voffA);
            PG8_WAIT_V(8); PG8_WAIT_L(0); PG8_BAR; PG8_MMA(1, 0, At, B0); PG8_MMA(1, 1, At, B1); PG8_BAR; PG8_SCHED;
            PG8_LDB(B0, 1, 0); PG8_LDB(B1, 1, 1); PG8_SCHED; PG8_LDA(At, 1, 0); PG8_STAGE(PG8_SA(0, 1), a2 + hstepA, voffA);
            PG8_WAIT_V(8); PG8_WAIT_L(0); PG8_BAR; PG8_MMA(0, 0, At, B0); PG8_MMA(0, 1, At, B1); PG8_BAR; PG8_SCHED;
            PG8_LDA(At, 1, 1); PG8_STAGE(PG8_SB(1, 0), b3, voffB); PG8_STAGE(PG8_SB(1, 1), b3 + hstepB, voffB); PG8_STAGE(PG8_SA(1, 0), a3, voffA);
            PG8_WAIT_V(8); PG8_WAIT_L(0); PG8_BAR; PG8_MMA(1, 0, At, B0); PG8_MMA(1, 1, At, B1); PG8_BAR; PG8_SCHED;
            } else {
            PG8_LDB(B0, 0, 0); PG8_SCHED; PG8_LDA(At, 0, 0); PG8_STAGE(PG8_SA(1, 1), a1 + hstepA, voffA);
            PG8_WAIT_L(8); PG8_BAR; PG8_WAIT_L(0); PG8_MMA(0, 0, At, B0); PG8_BAR; PG8_SCHED;
            PG8_LDB(B1, 0, 1); PG8_STAGE(PG8_SB(0, 0), b2, voffB);
            PG8_BAR; PG8_WAIT_L(0); PG8_MMA(0, 1, At, B1); PG8_BAR;
            PG8_LDA(At, 0, 1); PG8_STAGE(PG8_SA(0, 0), a2, voffA);
            PG8_BAR; PG8_WAIT_L(0); PG8_MMA(1, 0, At, B0); PG8_BAR; PG8_SCHED;
            PG8_STAGE(PG8_SB(0, 1), b2 + hstepB, voffB);
            PG8_WAIT_V(6); PG8_BAR; PG8_MMA(1, 1, At, B1); PG8_BAR;
            PG8_LDB(B0, 1, 0); PG8_SCHED; PG8_LDA(At, 1, 0); PG8_STAGE(PG8_SA(0, 1), a2 + hstepA, voffA);
            PG8_WAIT_L(8); PG8_BAR; PG8_WAIT_L(0); PG8_MMA(0, 0, At, B0); PG8_BAR; PG8_SCHED;
            PG8_LDB(B1, 1, 1); PG8_STAGE(PG8_SB(1, 0), b3, voffB);
            PG8_BAR; PG8_WAIT_L(0); PG8_MMA(0, 1, At, B1); PG8_BAR;
            PG8_LDA(At, 1, 1); PG8_STAGE(PG8_SA(1, 0), a3, voffA);
            PG8_BAR; PG8_WAIT_L(0); PG8_MMA(1, 0, At, B0); PG8_BAR; PG8_SCHED;
            PG8_STAGE(PG8_SB(1, 1), b3 + hstepB, voffB);
            PG8_WAIT_V(6); PG8_BAR; PG8_MMA(1, 1, At, B1); PG8_BAR;
            }
        }
        if constexpr (ALIGN_EPI) { if (wr == 0) PG8_BAR; }
        if constexpr (!Epi::AFTER_DRAIN) E(acc, cur, wr, wc, fr, fq, lds, ui);
        if (!has_next) break;
#pragma unroll
        for (int a = 0; a < 2; ++a)
#pragma unroll
            for (int b = 0; b < 2; ++b)
#pragma unroll
                for (int m = 0; m < 4; ++m)
#pragma unroll
                    for (int n = 0; n < 2; ++n) acc[a][b][m][n] = (f32x4){0.f, 0.f, 0.f, 0.f};
        cur = nxt; cA = nA; cB = nB; ++ui;
        asm volatile("" : "+v"(lane)); tid = wid * 64 + lane; fr = lane & 15; fq = lane >> 4; PG8_LANE_STATE();
        if constexpr (ALIGN_EPI) { if (wr == 1) PG8_BAR; }
    }
    PG8_WAIT_V(0);
    if constexpr (!ALIGN_EPI) { if (wr == 0) PG8_BAR; }
    PG8_BAR;
    if constexpr (Epi::AFTER_DRAIN) E.fused(acc, cur, wr, wc, fr, fq, lds, tid);
#undef PG8_SA
#undef PG8_SB
#undef PG8_STAGE
#undef PG8_LDA
#undef PG8_LDB
#undef PG8_MMA
#undef PG8_WAIT_V
#undef PG8_WAIT_L
#undef PG8_BAR
#undef PG8_SCHED
#undef PG8_ABASE
#undef PG8_LANE_STATE
#undef PG8_BBASE
}

struct EpiP1 {
    static constexpr bool PERM = true, AFTER_DRAIN = false;
    __device__ __forceinline__ void prologue(const StaticOrder&, LAS unsigned char*, int) const {}
    bf16_t* V; bf16_t* SG;
    __device__ __forceinline__ void operator()(f32x4 (&acc)[2][2][4][2], const Unit& u, int wr, int wc, int fr, int fq, LAS unsigned char* lds, int ui) const {
        const int row0 = u.pm * BM + wr * 64 + fr; const bool gate = u.pn >= 8;
        bf16_t* base = gate ? SG : V; const int col0 = (u.pn & 7) * BM + wc * 32 + 8 * fq;
#pragma unroll
        for (int ai = 0; ai < 2; ++ai)
#pragma unroll
            for (int m = 0; m < 4; ++m) { bf16_t* rowp = base + (size_t)(row0 + ai * HALF + m * 16) * DI + col0;
#pragma unroll
                for (int bj = 0; bj < 2; ++bj) { f32x4 v0 = acc[ai][bj][m][0], v1 = acc[ai][bj][m][1];
                    if (gate) {
#pragma unroll
                        for (int j = 0; j < 4; ++j) { v0[j] = silu_f(v0[j]); v1[j] = silu_f(v1[j]); } }
                    u32x4 w; w.x = cvt_pk_bf16(v0[0], v0[1]); w.y = cvt_pk_bf16(v0[2], v0[3]); w.z = cvt_pk_bf16(v1[0], v1[1]); w.w = cvt_pk_bf16(v1[2], v1[3]);
                    *(u32x4*)(rowp + bj * HALF) = w; } }
    }
};
struct EpiP2 {
    static constexpr bool PERM = true, AFTER_DRAIN = false;
    __device__ __forceinline__ void prologue(const StaticOrder&, LAS unsigned char*, int) const {}
    bf16_t* Z;
    __device__ __forceinline__ void operator()(f32x4 (&acc)[2][2][4][2], const Unit& u, int wr, int wc, int fr, int fq, LAS unsigned char* lds, int ui) const {
        const int row0 = u.pm * BM + wr * 64 + fr; const int col0 = u.pn * BM + wc * 32 + 8 * fq;
#pragma unroll
        for (int ai = 0; ai < 2; ++ai)
#pragma unroll
            for (int m = 0; m < 4; ++m) { bf16_t* rowp = Z + (size_t)(row0 + ai * HALF + m * 16) * DI + col0;
#pragma unroll
                for (int bj = 0; bj < 2; ++bj) { const f32x4 v0 = acc[ai][bj][m][0], v1 = acc[ai][bj][m][1];
                    const u32x4 s = *(const u32x4*)(rowp + bj * HALF);
                    u32x4 w; w.x = cvt_pk_bf16(v0[0] * bf_lo(s.x), v0[1] * bf_hi(s.x)); w.y = cvt_pk_bf16(v0[2] * bf_lo(s.y), v0[3] * bf_hi(s.y));
                    w.z = cvt_pk_bf16(v1[0] * bf_lo(s.z), v1[1] * bf_hi(s.z)); w.w = cvt_pk_bf16(v1[2] * bf_lo(s.w), v1[3] * bf_hi(s.w));
                    *(u32x4*)(rowp + bj * HALF) = w; } }
    }
};
template <bool WRITE_HB, bool WRITE_H = true> struct EpiRes {
    static constexpr bool PERM = false, AFTER_DRAIN = false;
    __device__ __forceinline__ void prologue(const StaticOrder&, LAS unsigned char*, int) const {}
    const float* R; float* H; bf16_t* HB; float* part;
    __device__ __forceinline__ void operator()(f32x4 (&acc)[2][2][4][2], const Unit& u, int wr, int wc, int fr, int fq, LAS unsigned char* lds, int ui) const {
        const unsigned row0 = (unsigned)(u.pm * BM + wr * 64 + fr), col0 = (unsigned)(u.pn * BM + wc * 32 + 4 * fq);
        const unsigned ofs = (row0 * DM + col0) * 4u, pofs = (row0 * 16u + (unsigned)(u.pn * 4 + wc)) * 4u;
#pragma unroll
        for (int ai = 0; ai < 2; ++ai)
#pragma unroll
            for (int m = 0; m < 4; ++m) { const unsigned o = ofs + (unsigned)((ai * HALF + m * 16) * DM) * 4u; float ss = 0.f;
#pragma unroll
                for (int bj = 0; bj < 2; ++bj)
#pragma unroll
                    for (int n = 0; n < 2; ++n) { const unsigned oo = o + (unsigned)(bj * HALF + n * 16) * 4u;
                        const f32x4 xv = *(const f32x4*)((const char*)R + oo); const f32x4 h = xv + acc[ai][bj][m][n];
                        if (WRITE_H) *(f32x4*)((char*)H + oo) = h; ss += (h[0] * h[0] + h[1] * h[1]) + (h[2] * h[2] + h[3] * h[3]);
                        if (WRITE_HB) { u32x2 w; w.x = pkbf(h[0], h[1]); w.y = pkbf(h[2], h[3]); *(u32x2*)((char*)HB + (oo >> 1)) = w; } }
                ss += xor_get(ss, fq * 16 + fr, 16); ss += xor_get(ss, fq * 16 + fr, 32);
                if (fq == 0) *(float*)((char*)part + (pofs + (unsigned)(ai * HALF + m * 16) * 64u)) = ss;
                asm volatile("" ::: "memory"); }
    }
};
__device__ __forceinline__ float row_rstd_b(const float* part, unsigned bofs) {
    const f32x4* p = (const f32x4*)((const char*)part + bofs); const f32x4 a = p[0], b = p[1], c = p[2], d = p[3];
    return __builtin_amdgcn_rsqf((((a[0] + a[1]) + (a[2] + a[3])) + ((b[0] + b[1]) + (b[2] + b[3])) + ((c[0] + c[1]) + (c[2] + c[3])) + ((d[0] + d[1]) + (d[2] + d[3]))) * (1.0f / DM) + EPS);
}
__device__ __forceinline__ float dpp_shr_mul(float v, const int n) {
    const int iv = __builtin_bit_cast(int, v), one = 0x3f800000; int r;
    if (n == 1) r = __builtin_amdgcn_update_dpp(one, iv, 0x111, 0xf, 0xf, false); else if (n == 2) r = __builtin_amdgcn_update_dpp(one, iv, 0x112, 0xf, 0xf, false);
    else if (n == 4) r = __builtin_amdgcn_update_dpp(one, iv, 0x114, 0xf, 0xf, false); else r = __builtin_amdgcn_update_dpp(one, iv, 0x118, 0xf, 0xf, false);
    return v * __builtin_bit_cast(float, r);
}
constexpr unsigned TAB_OFF = 131072u + 256u;
struct EpiP4 {
    static constexpr bool PERM = true, AFTER_DRAIN = false;
    bf16_t* Qt; bf16_t* Kt; bf16_t* V; float* DEC; const float* part; const float* lbnd;
    __device__ __forceinline__ void prologue(const StaticOrder& S, LAS unsigned char* lds, int tid) const {
        LAS float* T = (LAS float*)(lds + TAB_OFF); Unit u;
        for (int i = 0; i < 12 && S.next(i, u); ++i)
            if (tid < 256) T[i * 256 + tid] = row_rstd_b(part, (unsigned)(u.pm * BM + tid) * 64u);
        __syncthreads();
    }
    __device__ __forceinline__ void operator()(f32x4 (&acc)[2][2][4][2], const Unit& u, int wr, int wc, int fr, int fq, LAS unsigned char* lds, int ui) const {
        const unsigned row0 = (unsigned)(u.pm * BM + wr * 64 + fr);
        const LAS float* T = (const LAS float*)(lds + TAB_OFF) + ui * 256 + wr * 64 + fr;
        if (u.pn >= 16) {
            const unsigned vofs = (row0 * DI + (unsigned)((u.pn - 16) * BM + wc * 32 + 8 * fq)) * 2u;
#pragma unroll
            for (int ai = 0; ai < 2; ++ai)
#pragma unroll
                for (int m = 0; m < 4; ++m) { const float rs = T[ai * HALF + m * 16];
#pragma unroll
                    for (int bj = 0; bj < 2; ++bj) { const f32x4 v0 = acc[ai][bj][m][0] * rs, v1 = acc[ai][bj][m][1] * rs;
                        u32x4 w; w.x = pkbf(v0[0], v0[1]); w.y = pkbf(v0[2], v0[3]); w.z = pkbf(v1[0], v1[1]); w.w = pkbf(v1[2], v1[3]);
                        *(u32x4*)((char*)V + (vofs + (unsigned)((ai * HALF + m * 16) * DI + bj * HALF) * 2u)) = w; } }
            return;
        }
        const unsigned c0 = (unsigned)(u.pn * HD + wc * 32 + 8 * fq);
        const unsigned qofs = (row0 * DI + c0) * 2u;
#pragma unroll
        for (int ai = 0; ai < 2; ++ai) {
            float rs[4];
#pragma unroll
            for (int m = 0; m < 4; ++m) rs[m] = T[ai * HALF + m * 16];
            unsigned cc = c0; asm volatile("" : "+v"(cc));
#pragma unroll
            for (int n = 0; n < 2; ++n) {
                const f32x4 l0 = *(const f32x4*)((const char*)lbnd + (cc + 4 * n) * 4u), l1 = *(const f32x4*)((const char*)lbnd + (cc + 4 * n + DI) * 4u);
                f32x4 decv;
#pragma unroll
                for (int j = 0; j < 4; ++j) { const float ex = __expf(l0[j] - l1[j]); const float lb = __builtin_amdgcn_rcpf(1.0f + ex), omlb = ex * lb; float bprod = 1.0f;
#pragma unroll
                    for (int m = 0; m < 4; ++m) {
                        const float qv = acc[ai][0][m][n][j] * rs[m], z = acc[ai][1][m][n][j] * rs[m];
                        const float sg = __builtin_amdgcn_rcpf(1.0f + __builtin_amdgcn_exp2f(-1.44269504089f * z));
                        const float f = lb + omlb * sg, k = omlb * (1.0f - sg);
                        float s = f; s = dpp_shr_mul(s, 1); s = dpp_shr_mul(s, 2); s = dpp_shr_mul(s, 4); s = dpp_shr_mul(s, 8);
                        const float E = bprod * s;
                        if (m < 3) bprod *= lane_get(s, fq * 16 + 15);
                        const float Ei = __builtin_amdgcn_rcpf(fmaxf(E, 7.9e-31f));
                        acc[ai][0][m][n][j] = qv * E; acc[ai][1][m][n][j] = k * Ei;
                        if (m == 3) decv[j] = E;
                    } }
                if (fr == 15) *(f32x4*)((char*)DEC + ((unsigned)(u.pm * 4 + ai * 2 + wr) * DI + cc + 4 * n) * 4u) = decv;
            }
#pragma unroll
            for (int m = 0; m < 4; ++m) { const unsigned ob = qofs + (unsigned)((ai * HALF + m * 16) * DI) * 2u;
                u32x4 w; w.x = pkbf(acc[ai][0][m][0][0], acc[ai][0][m][0][1]); w.y = pkbf(acc[ai][0][m][0][2], acc[ai][0][m][0][3]); w.z = pkbf(acc[ai][0][m][1][0], acc[ai][0][m][1][1]); w.w = pkbf(acc[ai][0][m][1][2], acc[ai][0][m][1][3]);
                *(u32x4*)((char*)Qt + ob) = w;
                u32x4 x; x.x = pkbf(acc[ai][1][m][0][0], acc[ai][1][m][0][1]); x.y = pkbf(acc[ai][1][m][0][2], acc[ai][1][m][0][3]); x.z = pkbf(acc[ai][1][m][1][0], acc[ai][1][m][1][1]); x.w = pkbf(acc[ai][1][m][1][2], acc[ai][1][m][1][3]);
                *(u32x4*)((char*)Kt + ob) = x; }
            asm volatile("" ::: "memory");
        }
    }
};
struct EpiP5b {
    static constexpr bool PERM = true, AFTER_DRAIN = false;
    bf16_t* O; const float* part; const float* ss;
    __device__ __forceinline__ void prologue(const StaticOrder& S, LAS unsigned char* lds, int tid) const {
        LAS float* T = (LAS float*)(lds + TAB_OFF); Unit u;
        for (int i = 0; i < 4 && S.next(i, u); ++i) {
            if (tid < 256) T[i * 768 + tid] = row_rstd_b(part, (unsigned)(u.pm * BM + tid) * 64u);
            { const int r = tid >> 1, hh = tid & 1; const f32x4* sp = (const f32x4*)(ss + (size_t)(u.pm * BM + r) * 128 + (u.pn * 2 + hh) * 8); const f32x4 s0 = sp[0], s1 = sp[1];
              T[i * 768 + 256 + tid] = __builtin_amdgcn_rsqf((((s0[0] + s0[1]) + (s0[2] + s0[3])) + ((s1[0] + s1[1]) + (s1[2] + s1[3]))) * (1.0f / HD) + EPS); }
        }
        __syncthreads();
    }
    __device__ __forceinline__ void operator()(f32x4 (&acc)[2][2][4][2], const Unit& u, int wr, int wc, int fr, int fq, LAS unsigned char* lds, int ui) const {
        const unsigned row0 = (unsigned)(u.pm * BM + wr * 64 + fr), col0 = (unsigned)(u.pn * BM + wc * 32 + 8 * fq);
        const LAS float* T = (const LAS float*)(lds + TAB_OFF) + ui * 768 + wr * 64 + fr;
        const unsigned oofs = (row0 * DI + col0) * 2u;
#pragma unroll
        for (int ai = 0; ai < 2; ++ai) {
            u32x4 ov[4][2];
#pragma unroll
            for (int m = 0; m < 4; ++m)
#pragma unroll
                for (int bj = 0; bj < 2; ++bj) ov[m][bj] = *(const u32x4*)((const char*)O + (oofs + (unsigned)((ai * HALF + m * 16) * DI + bj * HALF) * 2u));
#pragma unroll
            for (int m = 0; m < 4; ++m) { const int rl = ai * HALF + m * 16; const float rs = T[rl];
#pragma unroll
                for (int bj = 0; bj < 2; ++bj) { const f32x4 v0 = acc[ai][bj][m][0] * rs, v1 = acc[ai][bj][m][1] * rs;
                    const float rh = T[256 + 2 * rl + bj + (wr * 64 + fr)];
                    const u32x4 s = ov[m][bj];
                    u32x4 w; w.x = pkbf(bf_lo(s.x) * rh * silu_f(v0[0]), bf_hi(s.x) * rh * silu_f(v0[1])); w.y = pkbf(bf_lo(s.y) * rh * silu_f(v0[2]), bf_hi(s.y) * rh * silu_f(v0[3]));
                    w.z = pkbf(bf_lo(s.z) * rh * silu_f(v1[0]), bf_hi(s.z) * rh * silu_f(v1[1])); w.w = pkbf(bf_lo(s.w) * rh * silu_f(v1[2]), bf_hi(s.w) * rh * silu_f(v1[3]));
                    *(u32x4*)((char*)O + (oofs + (unsigned)((ai * HALF + m * 16) * DI + bj * HALF) * 2u)) = w; } }
            asm volatile("" ::: "memory"); }
    }
};
struct EpiFinal {
    static constexpr bool PERM = false, AFTER_DRAIN = false;
    const bf16_t* HB; float* H; const float* fg; float* X; unsigned* cnt;
    __device__ __forceinline__ void prologue(const StaticOrder&, LAS unsigned char*, int) const {}
    __device__ __forceinline__ void operator()(f32x4 (&acc)[2][2][4][2], const Unit& u, int wr, int wc, int fr, int fq, LAS unsigned char* lds, int ui) const {
        LAS float* Pt = (LAS float*)(lds + TAB_OFF);
        LAS float* St = Pt + 1024;
        const int tid = (wr * 4 + wc) * 64 + fq * 16 + fr;
        const unsigned row0 = (unsigned)(u.pm * BM + wr * 64 + fr), col0 = (unsigned)(u.pn * BM + wc * 32 + 4 * fq);
        const unsigned ofs = (row0 * DM + col0) * 4u;
#pragma unroll
        for (int ai = 0; ai < 2; ++ai)
#pragma unroll
            for (int m = 0; m < 4; ++m) { float ss = 0.f;
#pragma unroll
                for (int bj = 0; bj < 2; ++bj)
#pragma unroll
                    for (int n = 0; n < 2; ++n) { const unsigned oo = ofs + (unsigned)((ai * HALF + m * 16) * DM + bj * HALF + n * 16) * 4u;
                        const u32x2 hb = *(const u32x2*)((const char*)HB + (oo >> 1));
                        const f32x4 h = acc[ai][bj][m][n] + (f32x4){bf_lo(hb.x), bf_hi(hb.x), bf_lo(hb.y), bf_hi(hb.y)}; acc[ai][bj][m][n] = h;
                        ss += (h[0] * h[0] + h[1] * h[1]) + (h[2] * h[2] + h[3] * h[3]); }
                ss += xor_get(ss, fq * 16 + fr, 16); ss += xor_get(ss, fq * 16 + fr, 32);
                if (fq == 0) Pt[(ai * HALF + wr * 64 + m * 16 + fr) * 4 + wc] = ss;
                asm volatile("" ::: "memory"); }
        __syncthreads();
        float* xs = X + (size_t)u.pm * 1024;
        if (tid < 256) { const f32x4 p = *(const LAS f32x4*)(Pt + tid * 4);
            __hip_atomic_store(xs + u.pn * 256 + tid, (p[0] + p[1]) + (p[2] + p[3]), __ATOMIC_RELAXED, __HIP_MEMORY_SCOPE_AGENT); }
        asm volatile("s_waitcnt vmcnt(0)" ::: "memory");
        __syncthreads();
        if (tid == 0) {
            unsigned* c = cnt + 16 * u.pm;
            __hip_atomic_fetch_add(c, 1u, __ATOMIC_RELAXED, __HIP_MEMORY_SCOPE_AGENT);
            unsigned spins = 0;
            while (__hip_atomic_load(c, __ATOMIC_RELAXED, __HIP_MEMORY_SCOPE_AGENT) < 4u) { __builtin_amdgcn_s_sleep(2); if (++spins > (1u << 22)) break; }
            __builtin_amdgcn_fence(__ATOMIC_ACQUIRE, "agent");
            asm volatile("s_waitcnt vmcnt(0)" ::: "memory");
        }
        __syncthreads();
        if (tid < 256) { float s = 0.f;
#pragma unroll
            for (int t = 0; t < 4; ++t) s += __hip_atomic_load(xs + t * 256 + tid, __ATOMIC_RELAXED, __HIP_MEMORY_SCOPE_AGENT);
            St[tid] = __builtin_amdgcn_rsqf(s * (1.0f / DM) + EPS); }
        __syncthreads();
        f32x4 gv[2][2];
#pragma unroll
        for (int bj = 0; bj < 2; ++bj)
#pragma unroll
            for (int n = 0; n < 2; ++n) gv[bj][n] = *(const f32x4*)(fg + col0 + bj * HALF + n * 16);
#pragma unroll
        for (int ai = 0; ai < 2; ++ai)
#pragma unroll
            for (int m = 0; m < 4; ++m) { const float rs = St[ai * HALF + wr * 64 + m * 16 + fr];
#pragma unroll
                for (int bj = 0; bj < 2; ++bj)
#pragma unroll
                    for (int n = 0; n < 2; ++n) { const unsigned oo = ofs + (unsigned)((ai * HALF + m * 16) * DM + bj * HALF + n * 16) * 4u;
                        *(f32x4*)((char*)H + oo) = acc[ai][bj][m][n] * rs * gv[bj][n]; } }
        __syncthreads();
    }
};
}

namespace scan {
#define MFMA16(a, b, c) __builtin_amdgcn_mfma_f32_16x16x32_bf16((a), (b), (c), 0, 0, 0)
__device__ __forceinline__ unsigned offb(unsigned row, unsigned ch) { return 256u * row + 16u * (ch ^ (((row & 3u) << 2) | ((row >> 2) & 3u))); }
__device__ __forceinline__ unsigned voffv(unsigned r, unsigned cp) { return 128u * r + 32u * (cp ^ (((r >> 1) & 3u) ^ (((r >> 3) & 1u) << 1))); }
__device__ __forceinline__ bf16x8 tr2(unsigned a0, unsigned a1) {
    u32x2 lo, hi;
    asm volatile("ds_read_b64_tr_b16 %0, %2\n\tds_read_b64_tr_b16 %1, %3\n\ts_waitcnt lgkmcnt(0)" : "=&v"(lo), "=&v"(hi) : "v"(a0), "v"(a1) : "memory");
    const u32x4 r = {lo.x, lo.y, hi.x, hi.y}; return __builtin_bit_cast(bf16x8, r);
}
__device__ __forceinline__ void tr8(unsigned a0, unsigned a1, unsigned c0, unsigned c1, bf16x8& f00, bf16x8& f01, bf16x8& f10, bf16x8& f11) {
    u32x2 r0, r1, r2, r3, r4, r5, r6, r7;
    asm volatile("ds_read_b64_tr_b16 %0, %8\n\tds_read_b64_tr_b16 %1, %9\n\tds_read_b64_tr_b16 %2, %8 offset:8192\n\tds_read_b64_tr_b16 %3, %9 offset:8192\n\t"
                 "ds_read_b64_tr_b16 %4, %10\n\tds_read_b64_tr_b16 %5, %11\n\tds_read_b64_tr_b16 %6, %10 offset:8192\n\tds_read_b64_tr_b16 %7, %11 offset:8192\n\ts_waitcnt lgkmcnt(0)"
                 : "=&v"(r0), "=&v"(r1), "=&v"(r2), "=&v"(r3), "=&v"(r4), "=&v"(r5), "=&v"(r6), "=&v"(r7) : "v"(a0), "v"(a1), "v"(c0), "v"(c1) : "memory");
    const u32x4 x00 = {r0.x, r0.y, r1.x, r1.y}, x01 = {r2.x, r2.y, r3.x, r3.y}, x10 = {r4.x, r4.y, r5.x, r5.y}, x11 = {r6.x, r6.y, r7.x, r7.y};
    f00 = __builtin_bit_cast(bf16x8, x00); f01 = __builtin_bit_cast(bf16x8, x01); f10 = __builtin_bit_cast(bf16x8, x10); f11 = __builtin_bit_cast(bf16x8, x11);
}
__device__ __forceinline__ bf16x8 pack8(const f32x4 a, const f32x4 b) { const u32x4 r = {pkbf(a[0], a[1]), pkbf(a[2], a[3]), pkbf(b[0], b[1]), pkbf(b[2], b[3])}; return __builtin_bit_cast(bf16x8, r); }
__device__ __forceinline__ u32x2 tr_issue(unsigned a) { u32x2 r; asm volatile("ds_read_b64_tr_b16 %0, %1" : "=v"(r) : "v"(a) : "memory"); return r; }
__device__ __forceinline__ u32x2 tr_issue_hi(unsigned a) { u32x2 r; asm volatile("ds_read_b64_tr_b16 %0, %1 offset:8192" : "=v"(r) : "v"(a) : "memory"); return r; }
#define TRW(x) "+v"(x)
__device__ __forceinline__ void tr_wait20(u32x2 (&a)[20], bool do_wait) {
    if (do_wait) asm volatile("s_waitcnt lgkmcnt(0)" : TRW(a[0]), TRW(a[1]), TRW(a[2]), TRW(a[3]), TRW(a[4]), TRW(a[5]), TRW(a[6]), TRW(a[7]), TRW(a[8]), TRW(a[9]), TRW(a[10]), TRW(a[11]), TRW(a[12]), TRW(a[13]), TRW(a[14]), TRW(a[15]), TRW(a[16]), TRW(a[17]), TRW(a[18]), TRW(a[19]) :: "memory");
    else asm volatile("" : TRW(a[0]), TRW(a[1]), TRW(a[2]), TRW(a[3]), TRW(a[4]), TRW(a[5]), TRW(a[6]), TRW(a[7]), TRW(a[8]), TRW(a[9]), TRW(a[10]), TRW(a[11]), TRW(a[12]), TRW(a[13]), TRW(a[14]), TRW(a[15]), TRW(a[16]), TRW(a[17]), TRW(a[18]), TRW(a[19]) :: "memory");
}
#undef TRW
__device__ __forceinline__ bf16x8 frag2(const u32x2 lo, const u32x2 hi) { const u32x4 r = {lo.x, lo.y, hi.x, hi.y}; return __builtin_bit_cast(bf16x8, r); }
template <int NJ>
__device__ __forceinline__ void at_part(LAS unsigned char* lds, unsigned QI, unsigned KI, int it, unsigned l15, unsigned g, bf16x8 (&at)[NJ / 2]) {
    const unsigned trow = 16u * (unsigned)it + l15;
    bf16x8 qb[4];
#pragma unroll
    for (int kd = 0; kd < 4; ++kd) qb[kd] = *(const LAS bf16x8*)(lds + QI + offb(trow, 4u * kd + g));
    f32x4 c[NJ];
#pragma unroll
    for (int j = 0; j < NJ; ++j) { c[j] = (f32x4){0.f, 0.f, 0.f, 0.f};
        if (j <= it) {
#pragma unroll
            for (int kd = 0; kd < 4; ++kd) { const bf16x8 a = *(const LAS bf16x8*)(lds + KI + offb(16u * j + l15, 4u * kd + g)); c[j] = MFMA16(a, qb[kd], c[j]); }
            if (j == it) {
#pragma unroll
                for (int r = 0; r < 4; ++r) c[j][r] = (4u * g + r <= l15) ? c[j][r] : 0.f; } } }
#pragma unroll
    for (int ks = 0; ks < NJ / 2; ++ks) at[ks] = pack8(c[2 * ks], c[2 * ks + 1]);
}
template <int NK>
__device__ __forceinline__ f32x4 o_part(LAS unsigned char* lds, unsigned QI, int it, const bf16x8 (&at)[NK], const bf16x8 (&vf)[2], const bf16x8 (&sfrag)[4], unsigned l15, unsigned g) {
    const unsigned trow = 16u * (unsigned)it + l15;
    f32x4 o = (f32x4){0.f, 0.f, 0.f, 0.f};
#pragma unroll
    for (int ks = 0; ks < NK; ++ks) if (2 * ks <= it) o = MFMA16(vf[ks], at[ks], o);
#pragma unroll
    for (int kd = 0; kd < 4; ++kd) {
        const u32x2 q0 = *(const LAS u32x2*)(lds + QI + offb(trow, 4u * kd + (g >> 1)) + 8u * (g & 1)), q1 = *(const LAS u32x2*)(lds + QI + offb(trow, 4u * kd + 2u + (g >> 1)) + 8u * (g & 1));
        o = MFMA16(sfrag[kd], frag2(q0, q1), o); }
    return o;
}
__device__ __forceinline__ void phase(LAS unsigned char* lds, const bf16_t* Qt, const bf16_t* Kt, bf16_t* VO, const float* DEC, float* ss8, int bid, int G, int wave) {
    int lane_ = (int)__builtin_amdgcn_mbcnt_hi(~0u, __builtin_amdgcn_mbcnt_lo(~0u, 0u)); asm volatile("" : "+v"(lane_));
    const unsigned lane = (unsigned)lane_, tid = (unsigned)wave * 64u + lane, l15 = lane & 15u, g = lane >> 4, ql = l15 >> 2, p = lane & 3u;
    const unsigned vs = (unsigned)wave & 3u; const int th = wave >> 2, tA = th ? 1 : 0, tB = th ? 2 : 3;
    const unsigned ldsb = (unsigned)(uintptr_t)lds;
    const unsigned srow = tid >> 4, sch = tid & 15u, vrow = tid >> 3, vch = tid & 7u;
    for (int item = bid; item < BATCH * NHEAD * 2; item += G) {
        const int half = (item >> 3) & 1, pair = (item & 7) | ((item >> 4) << 3), b = pair >> 4, h = pair & 15;
        const size_t tokb = (size_t)b * SEQ;
        const bf16_t* qg = Qt + (tokb + srow) * DI + h * HD + sch * 8;
        const bf16_t* kg = Kt + (tokb + srow) * DI + h * HD + sch * 8;
        bf16_t* vg = VO + tokb * DI + h * HD + half * 64;
        f32x4 S[8]; bf16x8 sfrag[4];
#pragma unroll
        for (int i = 0; i < 8; ++i) S[i] = (f32x4){0.f, 0.f, 0.f, 0.f};
#pragma unroll
        for (int i = 0; i < 4; ++i) sfrag[i] = (bf16x8){0, 0, 0, 0, 0, 0, 0, 0};
        u32x4 rq0, rq1, rk0, rk1, rv; f32x4 rdec = (f32x4){0.f, 0.f, 0.f, 0.f};
        const float* dg = DEC + (size_t)(b * (SEQ / 64)) * DI + h * HD + (tid & 31u) * 4u;
#define SC_LOAD(n_) do { const size_t t0_ = (size_t)(n_) * 64; \
            rq0 = *(const u32x4*)(qg + t0_ * DI); rq1 = *(const u32x4*)(qg + (t0_ + 32) * DI); rk0 = *(const u32x4*)(kg + t0_ * DI); rk1 = *(const u32x4*)(kg + (t0_ + 32) * DI); \
            rv = *(const u32x4*)(vg + (t0_ + vrow) * DI + vch * 8); if (tid < 32u) rdec = *(const f32x4*)(dg + (size_t)(n_) * DI); } while (0)
#define SC_STORE(base_) do { *(LAS u32x4*)(lds + (base_) + offb(srow, sch)) = rq0; *(LAS u32x4*)(lds + (base_) + offb(srow + 32u, sch)) = rq1; \
            *(LAS u32x4*)(lds + (base_) + 16384u + offb(srow, sch)) = rk0; *(LAS u32x4*)(lds + (base_) + 16384u + offb(srow + 32u, sch)) = rk1; \
            *(LAS u32x4*)(lds + (base_) + 32768u + voffv(vrow, vch >> 1) + 16u * (vch & 1u)) = rv; \
            if (tid < 32u) *(LAS f32x4*)(lds + 81920u + ((base_) ? 512u : 0u) + tid * 16u) = rdec; } while (0)
        SC_LOAD(0); SC_STORE(0u); __syncthreads();
        for (int n = 0; n < SEQ / 64; ++n) {
            const unsigned QI = (unsigned)(n & 1) * 40960u, KI = QI + 16384u, VI = QI + 32768u;
            if (n + 1 < SEQ / 64) SC_LOAD(n + 1);
            u32x2 tv0, tv1, tv2, tv3, tv4, tv5, tv6, tv7;
            {
                const unsigned va = ldsb + VI + 8u * p;
                tv0 = tr_issue(va + voffv(4u * g + ql, vs)); tv1 = tr_issue(va + voffv(16u + 4u * g + ql, vs)); tv2 = tr_issue(va + voffv(32u + 4u * g + ql, vs)); tv3 = tr_issue(va + voffv(48u + 4u * g + ql, vs));
                tv4 = tr_issue(va + voffv(8u * g + ql, vs)); tv5 = tr_issue(va + voffv(8u * g + 4u + ql, vs)); tv6 = tr_issue(va + voffv(32u + 8u * g + ql, vs)); tv7 = tr_issue(va + voffv(36u + 8u * g + ql, vs));
            }
            bf16x8 atB[2], atA[1];
            at_part<4>(lds, QI, KI, tB, l15, g, atB);
            at_part<2>(lds, QI, KI, tA, l15, g, atA);
            asm volatile("s_waitcnt lgkmcnt(0)" : "+v"(tv0), "+v"(tv1), "+v"(tv2), "+v"(tv3), "+v"(tv4), "+v"(tv5), "+v"(tv6), "+v"(tv7) :: "memory");
            __builtin_amdgcn_sched_barrier(0);
            const bf16x8 vf[2] = {frag2(tv0, tv1), frag2(tv2, tv3)};
            const f32x4 oB = o_part<2>(lds, QI, tB, atB, vf, sfrag, l15, g);
            const f32x4 oA = o_part<1>(lds, QI, tA, atA, vf, sfrag, l15, g);
            {
                const bf16x8 vn0 = frag2(tv4, tv5), vn1 = frag2(tv6, tv7);
                const LAS float* dcp = (const LAS float*)(lds + 81920u + (unsigned)(n & 1) * 512u) + 4u * g;
                const unsigned ka = ldsb + KI + offb(8u * g + ql, (p >> 1)) + 8u * (p & 1u), kb = ldsb + KI + offb(8u * g + 4u + ql, (p >> 1)) + 8u * (p & 1u);
#pragma unroll
                for (int i = 0; i < 8; i += 2) {
                    bf16x8 k00, k01, k10, k11;
                    tr8(ka ^ ((unsigned)i << 5), kb ^ ((unsigned)i << 5), ka ^ ((unsigned)(i + 1) << 5), kb ^ ((unsigned)(i + 1) << 5), k00, k01, k10, k11);
                    S[i] = MFMA16(k00, vn0, S[i]); S[i + 1] = MFMA16(k10, vn0, S[i + 1]); S[i] = MFMA16(k01, vn1, S[i]); S[i + 1] = MFMA16(k11, vn1, S[i + 1]); }
#pragma unroll
                for (int i = 0; i < 8; ++i) { const f32x4 dc = *(const LAS f32x4*)(dcp + 16 * i); S[i] = S[i] * dc; }
#pragma unroll
                for (int kd = 0; kd < 4; ++kd) sfrag[kd] = pack8(S[2 * kd], S[2 * kd + 1]);
            }
            if (n + 1 < SEQ / 64) SC_STORE((unsigned)((n + 1) & 1) * 40960u);
            {
                const size_t tlB = (size_t)n * 64 + 16u * (unsigned)tB + l15, tlA = (size_t)n * 64 + 16u * (unsigned)tA + l15;
                const u32x2 wB = {pkbf(oB[0], oB[1]), pkbf(oB[2], oB[3])}, wA = {pkbf(oA[0], oA[1]), pkbf(oA[2], oA[3])};
                *(u32x2*)(vg + tlB * DI + 16u * vs + 4u * g) = wB; *(u32x2*)(vg + tlA * DI + 16u * vs + 4u * g) = wA;
                float sB = (oB[0] * oB[0] + oB[1] * oB[1]) + (oB[2] * oB[2] + oB[3] * oB[3]), sA = (oA[0] * oA[0] + oA[1] * oA[1]) + (oA[2] * oA[2] + oA[3] * oA[3]);
                sB += xor_get(sB, (int)lane, 16); sA += xor_get(sA, (int)lane, 16); sB += xor_get(sB, (int)lane, 32); sA += xor_get(sA, (int)lane, 32);
                if (g == 0) { ss8[(tokb + tlB) * 128 + h * 8 + half * 4 + vs] = sB; ss8[(tokb + tlA) * 128 + h * 8 + half * 4 + vs] = sA; }
            }
            __syncthreads();
        }
#undef SC_LOAD
#undef SC_STORE
    }
}
#undef MFMA16
}

#define XB_TMO      128
#define XB_XCNT(j)  (256  + 64 * (j))
#define XB_XSUB(j)  (1280 + 64 * (j))
#define XB_XGEN(j)  (2304 + 64 * (j))
#define XB_TOP      3328
#define XB_TOPGEN   3392
#define XCD_BAR_WORDS 3456
#define XB_SPIN_CAP (1u << 18)
__device__ __forceinline__ unsigned xb_ld(unsigned* p)              { return __hip_atomic_load(p, __ATOMIC_RELAXED, __HIP_MEMORY_SCOPE_AGENT); }
__device__ __forceinline__ unsigned xb_add(unsigned* p, unsigned v) { return __hip_atomic_fetch_add(p, v, __ATOMIC_RELAXED, __HIP_MEMORY_SCOPE_AGENT); }
__device__ __forceinline__ unsigned xb_xcc_id() { return (unsigned)__builtin_amdgcn_s_getreg((3 << 11) | 20) & 0xFu; }
#define XB_SPIN(cond, bar) do { unsigned _sp = 0; while (cond) { __builtin_amdgcn_s_sleep(1); \
    if ((++_sp & 255u) == 0u) { if (xb_ld(&(bar)[XB_TMO])) break; if (_sp > XB_SPIN_CAP) { atomicAdd(&(bar)[XB_TMO], 1u); break; } } } } while (0)
struct XcdBarrier { unsigned* bar; unsigned x; volatile LAS unsigned* st; };
__device__ __forceinline__ XcdBarrier xcd_barrier_post(unsigned* bar, volatile LAS unsigned* st) {
    XcdBarrier b; b.bar = bar; b.x = xb_xcc_id(); b.st = st;
    if (threadIdx.x == 0) (void)xb_add(&bar[XB_XCNT(b.x)], 1u);
    return b;
}
__device__ __forceinline__ void xcd_barrier_complete(unsigned* bar, unsigned x, unsigned& nloc, unsigned& nx) {
    const unsigned G = gridDim.x * gridDim.y * gridDim.z;
    unsigned sum, cnt, mine, sp = 0u;
    for (;;) {
        sum = 0u; cnt = 0u; mine = 0u;
#pragma unroll
        for (unsigned j = 0; j < 16; ++j) { const unsigned c = xb_ld(&bar[XB_XCNT(j)]); sum += c; cnt += (c > 0u) ? 1u : 0u; mine = (j == x) ? c : mine; }
        if (sum == G) break;
        __builtin_amdgcn_s_sleep(1);
        if ((++sp & 255u) == 0u) { if (xb_ld(&bar[XB_TMO])) break; if (sp > XB_SPIN_CAP) { atomicAdd(&bar[XB_TMO], 1u); break; } }
    }
    nloc = mine > 0u ? mine : 1u; nx = cnt > 0u ? cnt : 1u;
}
__device__ __forceinline__ void xcd_barrier(const XcdBarrier& b) {
    asm volatile("s_waitcnt vmcnt(0)" ::: "memory");
    __syncthreads();
    if (threadIdx.x == 0) {
        unsigned* bar = b.bar;
        __builtin_amdgcn_s_waitcnt(0);
        unsigned nloc = b.st[0], nx = b.st[1];
        if (nloc == 0u) { xcd_barrier_complete(bar, b.x, nloc, nx); b.st[0] = nloc; b.st[1] = nx; }
        const unsigned old = xb_add(&bar[XB_XSUB(b.x)], 1u);
        const unsigned gen = old / nloc;
        if (old + 1u == (gen + 1u) * nloc) {
            __builtin_amdgcn_fence(__ATOMIC_RELEASE, "agent");
            asm volatile("s_waitcnt vmcnt(0)" ::: "memory");
            const unsigned og = xb_add(&bar[XB_TOP], 1u);
            const unsigned tg = og / nx;
            if (og + 1u == (tg + 1u) * nx) xb_add(&bar[XB_TOPGEN], 1u);
            else XB_SPIN(xb_ld(&bar[XB_TOPGEN]) == tg, bar);
            __builtin_amdgcn_fence(__ATOMIC_ACQUIRE, "agent");
            xb_add(&bar[XB_XGEN(b.x)], 1u);
            asm volatile("s_waitcnt vmcnt(0)" ::: "memory");
        } else {
            XB_SPIN(xb_ld(&bar[XB_XGEN(b.x)]) == gen, bar);
            __builtin_amdgcn_fence(__ATOMIC_ACQUIRE, "agent");
            asm volatile("s_waitcnt vmcnt(0)" ::: "memory");
        }
    }
    __syncthreads();
}

struct Args {
    const float* x; const float* norm_g; const float* pool_w_in; const float* pool_w_grp; const float* pool_scale; const float* pool_w_out;
    const float* hgrn_w_in; const float* hgrn_lb; const float* hgrn_norm_g; const float* hgrn_w_out; const float* final_g;
    float* out; unsigned char* ws;
};

__device__ __forceinline__ void transpose_item(const float* W, int K, int N, bf16_t* WT, int row_off, const float* ks, const float* ns, LAS float* scr, int item, int lane) {
    const int nblk = N / 32, kb = item / nblk, nb = item % nblk, k0 = 64 * kb, n0 = 32 * nb;
    const float nsv = ns ? ns[n0 + (lane & 31)] : 1.0f;
    float wv[32];
    const float* wp = W + (size_t)(k0 + (lane >> 5)) * N + n0 + (lane & 31);
#pragma unroll
    for (int i = 0; i < 32; ++i) wv[i] = wp[(size_t)(2 * i) * N];
    const float ksv = ks ? ks[k0 + lane] : 1.0f;
#pragma unroll
    for (int i = 0; i < 32; ++i) { const int kk = 2 * i + (lane >> 5); scr[kk * 33 + (lane & 31)] = wv[i] * nsv * lane_get(ksv, kk); }
    asm volatile("s_waitcnt lgkmcnt(0)" ::: "memory");
    const int c = lane & 7;
#pragma unroll
    for (int j = 0; j < 4; ++j) { const int n = (lane >> 3) + 8 * j; const LAS float* s = scr + (8 * c) * 33 + n;
        u32x4 o; o.x = pk2(s[0 * 33], s[1 * 33]); o.y = pk2(s[2 * 33], s[3 * 33]); o.z = pk2(s[4 * 33], s[5 * 33]); o.w = pk2(s[6 * 33], s[7 * 33]);
        *(u32x4*)(WT + (size_t)(row_off + n0 + n) * K + k0 + 8 * c) = o; }
    asm volatile("s_waitcnt lgkmcnt(0)" ::: "memory");
}

__global__ void __launch_bounds__(512, 2) fwd_kernel(Args a) {
    extern __shared__ __attribute__((aligned(16))) unsigned char lds_raw[];
    LAS unsigned char* lds = (LAS unsigned char*)lds_raw;
    volatile LAS unsigned* xst = (volatile LAS unsigned*)(lds + 131072 + 64);
    if (threadIdx.x < 2) xst[threadIdx.x] = 0u;
    __syncthreads();
    const XcdBarrier xbar = xcd_barrier_post((unsigned*)a.ws, xst);
#define GRID_BAR() xcd_barrier(xbar)
    const int G = gridDim.x, bid = blockIdx.x;
    const int NGW = G * 8;
    const int wave = __builtin_amdgcn_readfirstlane((int)threadIdx.x >> 6);
#define PHASE_IDS int lane_ = (int)__builtin_amdgcn_mbcnt_hi(~0u, __builtin_amdgcn_mbcnt_lo(~0u, 0u)); asm volatile("" : "+v"(lane_)); const int lane = lane_, tid = wave * 64 + lane, gw = bid * 8 + wave; (void)gw; (void)tid;
    unsigned char* ws = a.ws;
    bf16_t* Wt_in0 = (bf16_t*)(ws + WS_WIN0); bf16_t* Wt_grp = (bf16_t*)(ws + WS_WGRP); bf16_t* Wt_out0 = (bf16_t*)(ws + WS_WOUT0);
    bf16_t* Wt_in1 = (bf16_t*)(ws + WS_WIN1); bf16_t* Wt_out1 = (bf16_t*)(ws + WS_WOUT1);
    float* part1 = (float*)(ws + WS_PART1); float* part2 = (float*)(ws + WS_PART2); float* ssb = (float*)(ws + WS_SS); float* decb = (float*)(ws + WS_DEC);
    bf16_t* XB = (bf16_t*)(ws + WS_XB); bf16_t* BA = (bf16_t*)(ws + WS_A); bf16_t* BB = (bf16_t*)(ws + WS_B); bf16_t* BC = (bf16_t*)(ws + WS_C);

    {
        PHASE_IDS
        LAS float* scr = (LAS float*)(lds + wave * 16384);
        constexpr int I_IN0 = (DM / 64) * (4096 / 32), I_GRP1 = (512 / 64) * (512 / 32), I_OUT = (DI / 64) * (DM / 32), I_IN1 = (DM / 64) * (8192 / 32);
        constexpr int NITEMS = I_IN0 + 4 * I_GRP1 + I_OUT + I_IN1 + I_OUT;
        for (int it = gw; it < NITEMS; it += NGW) {
            int r = it;
            if (r < I_IN0) { transpose_item(a.pool_w_in, DM, 4096, Wt_in0, 0, a.norm_g, nullptr, scr, r, lane); continue; } r -= I_IN0;
            if (r < 4 * I_GRP1) { const int g = r / I_GRP1; transpose_item(a.pool_w_grp + (size_t)g * 512 * 512, 512, 512, Wt_grp, g * 512, nullptr, a.pool_scale + g * 512, scr, r % I_GRP1, lane); continue; } r -= 4 * I_GRP1;
            if (r < I_OUT) { transpose_item(a.pool_w_out, DI, DM, Wt_out0, 0, nullptr, nullptr, scr, r, lane); continue; } r -= I_OUT;
            if (r < I_IN1) {
                const int n0 = 32 * (r % (8192 / 32)); int d0 = n0;
                if (n0 < 2048) d0 = 256 * (n0 >> 7) + (n0 & 127); else if (n0 < 4096) d0 = 256 * ((n0 - 2048) >> 7) + 128 + (n0 & 127);
                transpose_item(a.hgrn_w_in, DM, 8192, Wt_in1, d0 - n0, a.norm_g + DM, nullptr, scr, r, lane); continue; } r -= I_IN1;
            transpose_item(a.hgrn_w_out, DI, DM, Wt_out1, 0, a.hgrn_norm_g, nullptr, scr, r, lane);
        }
        for (int m = gw; m < M; m += NGW) {
            const f32x4* xr = (const f32x4*)(a.x + (size_t)m * DM) + lane;
            f32x4 v[4]; float s = 0.f;
#pragma unroll
            for (int j = 0; j < 4; ++j) { v[j] = xr[64 * j]; s += (v[j][0] * v[j][0] + v[j][1] * v[j][1]) + (v[j][2] * v[j][2] + v[j][3] * v[j][3]); }
            const float rstd = 1.0f / sqrtf(wave_sum(s, lane) * (1.0f / DM) + EPS);
            unsigned long long* o8 = (unsigned long long*)(XB + (size_t)m * DM) + lane;
#pragma unroll
            for (int j = 0; j < 4; ++j) o8[64 * j] = (unsigned long long)pk2(v[j][0] * rstd, v[j][1] * rstd) | ((unsigned long long)pk2(v[j][2] * rstd, v[j][3] * rstd) << 32);
        }
    }
    GRID_BAR();

    {
        pg8::Gemm g{XB, Wt_in0, DM, DM, DM, 0}; pg8::StaticOrder S; S.init(M, 4096, G, bid);
        pg8::EpiP1 E{BA, BB};
        pg8::gemm_phase<pg8::EpiP1>(lds, g, S, E, wave);
    }
    GRID_BAR();

    {
        PHASE_IDS
        constexpr int RUN = 64;
        const int nruns = (M / RUN) * (DI / 8);
        for (int idx = bid * 512 + tid; idx < nruns; idx += G * 512) {
            const int cgp = idx & 255, run = idx >> 8, grp = cgp >> 6, w = 2 << grp;
            const int m0 = run * RUN, t0 = m0 & (SEQ - 1);
            const bf16_t* vp = BA + (size_t)m0 * DI + cgp * 8; bf16_t* pp = BC + (size_t)m0 * DI + cgp * 8;
            float sum[8];
#pragma unroll
            for (int j = 0; j < 8; ++j) sum[j] = 0.f;
            if (t0 > 0) for (int k = 1; k < w; ++k) { const u32x4 vv = *(const u32x4*)(vp - (size_t)k * DI);
                sum[0] += bf_lo(vv.x); sum[1] += bf_hi(vv.x); sum[2] += bf_lo(vv.y); sum[3] += bf_hi(vv.y); sum[4] += bf_lo(vv.z); sum[5] += bf_hi(vv.z); sum[6] += bf_lo(vv.w); sum[7] += bf_hi(vv.w); }
            for (int i0 = 0; i0 < RUN; i0 += 8) {
                u32x4 vin[8], vout[8];
#pragma unroll
                for (int j = 0; j < 8; ++j) vin[j] = *(const u32x4*)(vp + (size_t)(i0 + j) * DI);
#pragma unroll
                for (int j = 0; j < 8; ++j) { const int i = i0 + j; vout[j] = (t0 + i + 1 >= w) ? *(const u32x4*)(vp + (size_t)(i + 1 - w) * DI) : (u32x4){0u, 0u, 0u, 0u}; }
#pragma unroll
                for (int j = 0; j < 8; ++j) {
                    const int i = i0 + j, t = t0 + i;
                    const u32x4 vv = vin[j];
                    float x[8] = {bf_lo(vv.x), bf_hi(vv.x), bf_lo(vv.y), bf_hi(vv.y), bf_lo(vv.z), bf_hi(vv.z), bf_lo(vv.w), bf_hi(vv.w)};
#pragma unroll
                    for (int c = 0; c < 8; ++c) sum[c] += x[c];
                    const int cnt = (t + 1) < w ? (t + 1) : w; const float inv = 1.0f / (float)cnt;
                    u32x4 o; o.x = pkbf(sum[0] * inv - x[0], sum[1] * inv - x[1]); o.y = pkbf(sum[2] * inv - x[2], sum[3] * inv - x[3]);
                    o.z = pkbf(sum[4] * inv - x[4], sum[5] * inv - x[5]); o.w = pkbf(sum[6] * inv - x[6], sum[7] * inv - x[7]);
                    *(u32x4*)(pp + (size_t)i * DI) = o;
                    const u32x4 uu = vout[j];
                    sum[0] -= bf_lo(uu.x); sum[1] -= bf_hi(uu.x); sum[2] -= bf_lo(uu.y); sum[3] -= bf_hi(uu.y); sum[4] -= bf_lo(uu.z); sum[5] -= bf_hi(uu.z); sum[6] -= bf_lo(uu.w); sum[7] -= bf_hi(uu.w);
                }
            }
        }
    }
    GRID_BAR();

    {
        pg8::Gemm g{BC, Wt_grp, DI, 512, 512, 2}; pg8::StaticOrder S; S.init(M, DI, G, bid);
        pg8::EpiP2 E{BB};
        pg8::gemm_phase<pg8::EpiP2>(lds, g, S, E, wave);
    }
    GRID_BAR();

    {
        pg8::Gemm g{BB, Wt_out0, DI, DI, DI, 0}; pg8::StaticOrder S; S.init(M, DM, G, bid);
        pg8::EpiRes<true, false> E{a.x, nullptr, XB, part1};
        pg8::gemm_phase<pg8::EpiRes<true, false>>(lds, g, S, E, wave);
    }
    GRID_BAR();

    {
        pg8::Gemm g{XB, Wt_in1, DM, DM, DM, 0}; pg8::StaticOrder S; S.init(M, 6144, G, bid);
        pg8::EpiP4 E{BA, BB, BC, decb, part1, a.hgrn_lb};
        pg8::gemm_phase<pg8::EpiP4>(lds, g, S, E, wave);
    }
    GRID_BAR();

    scan::phase(lds, BA, BB, BC, decb, ssb, bid, G, wave);
    GRID_BAR();

    {
        pg8::Gemm g{XB, Wt_in1 + (size_t)6144 * DM, DM, DM, DM, 0}; pg8::StaticOrder S; S.init(M, DI, G, bid);
        pg8::EpiP5b E{BC, part1, ssb};
        pg8::gemm_phase<pg8::EpiP5b>(lds, g, S, E, wave);
    }
    GRID_BAR();

    {
        pg8::Gemm g{BC, Wt_out1, DI, DI, DI, 0}; pg8::StaticOrder S; S.init(M, DM, G, bid);
        pg8::EpiFinal E{XB, a.out, a.final_g, (float*)(ws + WS_X), (unsigned*)(ws + WS_CNT)};
        pg8::gemm_phase<pg8::EpiFinal>(lds, g, S, E, wave);
    }
}

extern "C" void kernel_launch(void* const* d_in, const int* in_sizes, int n_in, void* d_out, int out_size, void* d_ws, size_t ws_size, hipStream_t stream) {
    static int grid = 0;
    if (grid == 0) {
        if (n_in != 11 || in_sizes[0] != M * DM || out_size != M * DM || ws_size < WS_END) { fprintf(stderr, "kernel_launch: unexpected shapes (n_in %d in0 %d out %d ws %zu)\n", n_in, n_in > 0 ? in_sizes[0] : -1, out_size, ws_size); grid = -1; return; }
        int dev = 0, cus = 0, per = 0;
        if (hipGetDevice(&dev) != hipSuccess || hipDeviceGetAttribute(&cus, hipDeviceAttributeMultiprocessorCount, dev) != hipSuccess) { grid = -1; return; }
        if (hipFuncSetAttribute((const void*)fwd_kernel, hipFuncAttributeMaxDynamicSharedMemorySize, LDS_BYTES) != hipSuccess) { fprintf(stderr, "kernel_launch: hipFuncSetAttribute failed\n"); grid = -1; return; }
        if (hipOccupancyMaxActiveBlocksPerMultiprocessor(&per, (const void*)fwd_kernel, 512, LDS_BYTES) != hipSuccess || per < 1) { fprintf(stderr, "kernel_launch: occupancy query says %d\n", per); (void)hipGetLastError(); grid = -1; return; }
        grid = cus;
        fprintf(stderr, "kernel_launch: cus %d per_cu %d grid %d\n", cus, per, grid);
    }
    if (grid < 0) return;
    if (hipMemsetAsync(d_ws, 0, 32768, stream) != hipSuccess) { fprintf(stderr, "kernel_launch: hipMemsetAsync failed\n"); return; }
    Args a{};
    a.x = (const float*)d_in[0]; a.norm_g = (const float*)d_in[1]; a.pool_w_in = (const float*)d_in[2]; a.pool_w_grp = (const float*)d_in[3];
    a.pool_scale = (const float*)d_in[4]; a.pool_w_out = (const float*)d_in[5]; a.hgrn_w_in = (const float*)d_in[6]; a.hgrn_lb = (const float*)d_in[7];
    a.hgrn_norm_g = (const float*)d_in[8]; a.hgrn_w_out = (const float*)d_in[9]; a.final_g = (const float*)d_in[10];
    a.out = (float*)d_out; a.ws = (unsigned char*)d_ws;
    void* args[] = {&a};
    hipError_t e = hipLaunchCooperativeKernel((void*)fwd_kernel, dim3(grid), dim3(512), args, LDS_BYTES, stream);
    if (e != hipSuccess) fprintf(stderr, "kernel_launch: cooperative launch failed: %s (grid %d)\n", hipGetErrorString(e), grid);
}
```

```cpp
#include <hip/hip_runtime.h>
#include <cstdio>
#include <cstdint>

#define LAS __attribute__((address_space(3)))
typedef unsigned short bf16_t;
typedef short bf16x8 __attribute__((ext_vector_type(8)));
typedef float f32x4 __attribute__((ext_vector_type(4)));
typedef float f32x2 __attribute__((ext_vector_type(2)));
typedef unsigned u32x4 __attribute__((ext_vector_type(4)));
typedef unsigned u32x2 __attribute__((ext_vector_type(2)));

constexpr int DM = 1024, BATCH = 8, SEQ = 4096, DI = 2048, M = BATCH * SEQ;
constexpr int NHEAD = 16, HD = 128;
constexpr float EPS = 1e-6f;
constexpr size_t MiB = 1u << 20;
constexpr size_t WS_WIN0 = 2 * MiB;
constexpr size_t WS_WGRP = 10 * MiB;
constexpr size_t WS_WOUT0 = 12 * MiB;
constexpr size_t WS_WIN1 = 16 * MiB;
constexpr size_t WS_WOUT1 = 32 * MiB;
constexpr size_t WS_PART1 = 36 * MiB;
constexpr size_t WS_CNT = 16384;
constexpr size_t WS_X = 40 * MiB;
constexpr size_t WS_DEC = 44 * MiB;
constexpr size_t WS_SS = 112 * MiB;
constexpr size_t WS_XB = 48 * MiB;
constexpr size_t WS_A = 128 * MiB;
constexpr size_t WS_B = 256 * MiB;
constexpr size_t WS_C = 384 * MiB;
constexpr size_t WS_END = 512 * MiB;
constexpr int LDS_BYTES = 147456;

typedef __bf16 bf2_t __attribute__((ext_vector_type(2)));
__device__ __forceinline__ unsigned pkbf(float lo, float hi) { f32x2 v = {lo, hi}; return __builtin_bit_cast(unsigned, __builtin_convertvector(v, bf2_t)); }
__device__ __forceinline__ float bf_lo(unsigned w) { return __builtin_bit_cast(float, w << 16); }
__device__ __forceinline__ float bf_hi(unsigned w) { return __builtin_bit_cast(float, w & 0xffff0000u); }
__device__ __forceinline__ float silu_f(float x) { return x * __builtin_amdgcn_rcpf(1.0f + __builtin_amdgcn_exp2f(-1.44269504089f * x)); }
__device__ __forceinline__ float lane_get(float v, int src_lane) { return __builtin_bit_cast(float, __builtin_amdgcn_ds_bpermute(src_lane << 2, __builtin_bit_cast(int, v))); }
__device__ __forceinline__ float xor_get(float v, int lane, int m) { return lane_get(v, lane ^ m); }
__device__ __forceinline__ float wave_sum(float v, int lane) {
#pragma unroll
    for (int o = 1; o < 64; o <<= 1) v += xor_get(v, lane, o);
    return v;
}

namespace pg8 {
constexpr int BM = 256, BK = 64, HALF = 128, HTB = HALF * BK * 2, NXCD = 8, WGM = 8;
__host__ __device__ __forceinline__ int lds_byte(int r, int c) { const int st = (r >> 4) * 2 + (c >> 5), rr = r & 15, cc = c & 31, ob = rr * 64 + cc * 2; return st * 1024 + (ob ^ (((ob >> 9) & 1) << 5)); }
__host__ __device__ __forceinline__ void stage_rc(int b, int& R, int& C) { const int st = b / 1024, sb = b % 1024, swz = sb ^ (((sb >> 9) & 1) << 5); R = (st >> 1) * 16 + swz / 64; C = (st & 1) * 32 + (swz % 64) / 2; }
__host__ __device__ __forceinline__ int perm32(int rho) { const int n = rho >> 4, i = rho & 15; return 8 * (i >> 2) + 4 * n + (i & 3); }

struct Unit { int pm, pn; };
struct Gemm { const bf16_t* A; const bf16_t* Bt; int lda, ldb, K, grp_tiles; };

struct StaticOrder {
    int nM, nN, nwg, G, c;
    __host__ __device__ void init(int M_, int N_, int G_, int c_) { nM = M_ / BM; nN = N_ / BM; nwg = nM * nN; G = G_; c = c_; }
    __host__ __device__ bool next(int i, Unit& u) const {
        const long L = (long)i * G + c; if (L >= nwg) return false;
        int wgid = (int)L; { const int q = nwg / NXCD, r = nwg % NXCD, xcd = wgid % NXCD, off = wgid / NXCD; wgid = (xcd < r ? xcd * (q + 1) : r * (q + 1) + (xcd - r) * q) + off; }
        const int nig = WGM * nN, gid = wgid / nig, fm = gid * WGM, gsz = (nM - fm) < WGM ? (nM - fm) : WGM;
        u.pm = fm + ((wgid % nig) % gsz); u.pn = (wgid % nig) / gsz; return true;
    }
};


__device__ __forceinline__ void zero_acc(f32x4 (&acc)[2][2][4][2]) {
#pragma unroll
    for (int a = 0; a < 2; ++a)
#pragma unroll
        for (int b = 0; b < 2; ++b)
#pragma unroll
            for (int m = 0; m < 4; ++m)
#pragma unroll
                for (int n = 0; n < 2; ++n) acc[a][b][m][n] = (f32x4){0.f, 0.f, 0.f, 0.f};
}
template <class Epi, bool ALIGN_EPI = true, bool SP2 = true>
__device__ __forceinline__ void gemm_phase(LAS unsigned char* lds, const Gemm g, const StaticOrder& S, const Epi& E, const int wid) {
    int lane_ = (int)__builtin_amdgcn_mbcnt_hi(~0u, __builtin_amdgcn_mbcnt_lo(~0u, 0u)); asm volatile("" : "+v"(lane_));
    int lane = lane_, tid = wid * 64 + lane, fr = lane & 15, fq = lane >> 4; const int wr = wid >> 2, wc = wid & 3;
    const int K = g.K, nt = K / BK;
    unsigned voffA[2], voffB[2]; int aoff, boff;
#define PG8_LANE_STATE() do { _Pragma("unroll") for (int i = 0; i < 2; ++i) { int R, C; stage_rc(tid * 16 + i * 8192, R, C); const int Rb = Epi::PERM ? ((R & ~31) + perm32(R & 31)) : R; \
        voffA[i] = (unsigned)(R * g.lda + C) * 2u; voffB[i] = (unsigned)(Rb * g.ldb + C) * 2u; } \
        aoff = lds_byte(wr * 64 + fr, fq * 8); boff = lds_byte(wc * 32 + fr, fq * 8); } while (0)
    PG8_LANE_STATE();
    const size_t kstep = (size_t)(BK * 2);
    const size_t hstepA = (size_t)HALF * g.lda * 2, hstepB = (size_t)HALF * g.ldb * 2;
    const size_t tstepA = 2 * hstepA, tstepB = 2 * hstepB;
    const unsigned ldsw = (unsigned)wid * 1024u;
#define PG8_SA(b, h) (((b) * 2 + (h)) * HTB)
#define PG8_SB(b, h) ((4 + (b) * 2 + (h)) * HTB)
#define PG8_STAGE(bufoff, gbase, voff) do { _Pragma("unroll") for (int _i = 0; _i < 2; ++_i) \
        __builtin_amdgcn_global_load_lds((const unsigned*)((const char*)(gbase) + (voff)[_i]), (LAS unsigned*)(lds + (bufoff) + ldsw + _i * 8192), 16, 0, 0); } while (0)
#define PG8_LDA(dst, b, h) do { _Pragma("unroll") for (int m = 0; m < 4; ++m) _Pragma("unroll") for (int k = 0; k < 2; ++k) dst[m][k] = *(const LAS bf16x8*)(lds + PG8_SA(b, h) + aoff + m * 2048 + k * 1024); } while (0)
#define PG8_LDB(dst, b, h) do { _Pragma("unroll") for (int n = 0; n < 2; ++n) _Pragma("unroll") for (int k = 0; k < 2; ++k) dst[n][k] = *(const LAS bf16x8*)(lds + PG8_SB(b, h) + boff + n * 2048 + k * 1024); } while (0)
#define PG8_MMA(ai, bj, At, Bt) do { __builtin_amdgcn_s_setprio(1); _Pragma("unroll") for (int m = 0; m < 4; ++m) _Pragma("unroll") for (int n = 0; n < 2; ++n) _Pragma("unroll") for (int k = 0; k < 2; ++k) \
        acc[ai][bj][m][n] = __builtin_amdgcn_mfma_f32_16x16x32_bf16(Bt[n][k], At[m][k], acc[ai][bj][m][n], 0, 0, 0); __builtin_amdgcn_s_setprio(0); } while (0)
#define PG8_WAIT_V(n) asm volatile("s_waitcnt vmcnt(" #n ")" ::: "memory")
#define PG8_WAIT_L(n) asm volatile("s_waitcnt lgkmcnt(" #n ")" ::: "memory")
#define PG8_BAR __builtin_amdgcn_s_barrier()
#define PG8_SCHED __builtin_amdgcn_sched_barrier(0)
#define PG8_ABASE(u) ((const char*)g.A + (size_t)(u).pm * tstepA + (g.grp_tiles ? (size_t)((u).pn / g.grp_tiles) * (size_t)K * 2 : (size_t)0))
#define PG8_BBASE(u) ((const char*)g.Bt + (size_t)(u).pn * tstepB)
    Unit cur, nxt; int ui = 0;
    E.prologue(S, lds, tid);
    if (!S.next(0, cur)) return;
    f32x4 acc[2][2][4][2];
    E.init_acc(acc, cur, wr, wc, fr, fq);
    bf16x8 At[4][2], B0[2][2], B1[2][2];
    const char* cA = PG8_ABASE(cur); const char* cB = PG8_BBASE(cur);
    if constexpr (SP2) {
        PG8_STAGE(PG8_SB(0, 0), cB, voffB); PG8_STAGE(PG8_SB(0, 1), cB + hstepB, voffB); PG8_STAGE(PG8_SA(0, 0), cA, voffA); PG8_STAGE(PG8_SA(0, 1), cA + hstepA, voffA);
        if (wr == 1) PG8_BAR;
        PG8_WAIT_V(2); PG8_BAR;
        PG8_STAGE(PG8_SB(1, 0), cB + kstep, voffB); PG8_STAGE(PG8_SA(1, 0), cA + kstep, voffA); PG8_STAGE(PG8_SB(1, 1), cB + hstepB + kstep, voffB);
        PG8_WAIT_V(6); PG8_BAR;
    } else {
        PG8_STAGE(PG8_SB(0, 0), cB, voffB); PG8_STAGE(PG8_SA(0, 0), cA, voffA); PG8_STAGE(PG8_SB(0, 1), cB + hstepB, voffB); PG8_STAGE(PG8_SA(0, 1), cA + hstepA, voffA);
        if (wr == 1) PG8_BAR;
        PG8_WAIT_V(4); PG8_BAR;
        PG8_STAGE(PG8_SB(1, 0), cB + kstep, voffB); PG8_STAGE(PG8_SA(1, 0), cA + kstep, voffA); PG8_STAGE(PG8_SB(1, 1), cB + hstepB + kstep, voffB);
        PG8_WAIT_V(6); PG8_BAR;
    }
    for (;;) {
        const bool has_next = S.next(ui + 1, nxt);
        const char* nA = has_next ? PG8_ABASE(nxt) : cA; const char* nB = has_next ? PG8_BBASE(nxt) : cB;
        for (int t = 0; t < nt; t += 2) {
            const bool last = (t == nt - 2);
            const char* a1 = cA + (size_t)(t + 1) * kstep;
            const char* a2 = last ? nA : cA + (size_t)(t + 2) * kstep; const char* b2 = last ? nB : cB + (size_t)(t + 2) * kstep;
            const char* a3 = a2 + kstep; const char* b3 = b2 + kstep;
            if constexpr (SP2) {
            PG8_LDB(B0, 0, 0); PG8_LDB(B1, 0, 1); PG8_SCHED; PG8_LDA(At, 0, 0); PG8_STAGE(PG8_SA(1, 1), a1 + hstepA, voffA);
            PG8_WAIT_V(8); PG8_WAIT_L(0); PG8_BAR; PG8_MMA(0, 0, At, B0); PG8_MMA(0, 1, At, B1); PG8_BAR; PG8_SCHED;
            PG8_LDA(At, 0, 1); PG8_STAGE(PG8_SB(0, 0), b2, voffB); PG8_STAGE(PG8_SB(0, 1), b2 + hstepB, voffB); PG8_STAGE(PG8_SA(0, 0), a2, voffA);
            PG8_WAIT_V(8); PG8_WAIT_L(0); PG8_BAR; PG8_MMA(1, 0, At, B0); PG8_MMA(1, 1, At, B1); PG8_BAR; PG8_SCHED;
            PG8_LDB(B0, 1, 0); PG8_LDB(B1, 1, 1); PG8_SCHED; PG8_LDA(At, 1, 0); PG8_STAGE(PG8_SA(0, 1), a2 + hstepA, voffA);
            PG8_WAIT_V(8); PG8_WAIT_L(0); PG8_BAR; PG8_MMA(0, 0, At, B0); PG8_MMA(0, 1, At, B1); PG8_BAR; PG8_SCHED;
            PG8_LDA(At, 1, 1); PG8_STAGE(PG8_SB(1, 0), b3, voffB); PG8_STAGE(PG8_SB(1, 1), b3 + hstepB, voffB); PG8_STAGE(PG8_SA(1, 0), a3, voffA);
            PG8_WAIT_V(8); PG8_WAIT_L(0); PG8_BAR; PG8_MMA(1, 0, At, B0); PG8_MMA(1, 1, At, B1); PG8_BAR; PG8_SCHED;
            } else {
            PG8_LDB(B0, 0, 0); PG8_SCHED; PG8_LDA(At, 0, 0); PG8_STAGE(PG8_SA(1, 1), a1 + hstepA, voffA);
            PG8_WAIT_L(8); PG8_BAR; PG8_WAIT_L(0); PG8_MMA(0, 0, At, B0); PG8_BAR; PG8_SCHED;
            PG8_LDB(B1, 0, 1); PG8_STAGE(PG8_SB(0, 0), b2, voffB);
            PG8_BAR; PG8_WAIT_L(0); PG8_MMA(0, 1, At, B1); PG8_BAR;
            PG8_LDA(At, 0, 1); PG8_STAGE(PG8_SA(0, 0), a2, voffA);
            PG8_BAR; PG8_WAIT_L(0); PG8_MMA(1, 0, At, B0); PG8_BAR; PG8_SCHED;
            PG8_STAGE(PG8_SB(0, 1), b2 + hstepB, voffB);
            PG8_WAIT_V(6); PG8_BAR; PG8_MMA(1, 1, At, B1); PG8_BAR;
            PG8_LDB(B0, 1, 0); PG8_SCHED; PG8_LDA(At, 1, 0); PG8_STAGE(PG8_SA(0, 1), a2 + hstepA, voffA);
            PG8_WAIT_L(8); PG8_BAR; PG8_WAIT_L(0); PG8_MMA(0, 0, At, B0); PG8_BAR; PG8_SCHED;
            PG8_LDB(B1, 1, 1); PG8_STAGE(PG8_SB(1, 0), b3, voffB);
            PG8_BAR; PG8_WAIT_L(0); PG8_MMA(0, 1, At, B1); PG8_BAR;
            PG8_LDA(At, 1, 1); PG8_STAGE(PG8_SA(1, 0), a3, voffA);
            PG8_BAR; PG8_WAIT_L(0); PG8_MMA(1, 0, At, B0); PG8_BAR; PG8_SCHED;
            PG8_STAGE(PG8_SB(1, 1), b3 + hstepB, voffB);
            PG8_WAIT_V(6); PG8_BAR; PG8_MMA(1, 1, At, B1); PG8_BAR;
            }
        }
        if constexpr (ALIGN_EPI) { if (wr == 0) PG8_BAR; }
        if constexpr (!Epi::AFTER_DRAIN) E(acc, cur, wr, wc, fr, fq, lds, ui);
        if (!has_next) break;
        cur = nxt; cA = nA; cB = nB; ++ui;
        asm volatile("" : "+v"(lane)); tid = wid * 64 + lane; fr = lane & 15; fq = lane >> 4; PG8_LANE_STATE();
        E.init_acc(acc, cur, wr, wc, fr, fq);
        if constexpr (ALIGN_EPI) { if (wr == 1) PG8_BAR; }
    }
    PG8_WAIT_V(0);
    if constexpr (!ALIGN_EPI) { if (wr == 0) PG8_BAR; }
    PG8_BAR;
    if constexpr (Epi::AFTER_DRAIN) E.fused(acc, cur, wr, wc, fr, fq, lds, tid);
#undef PG8_SA
#undef PG8_SB
#undef PG8_STAGE
#undef PG8_LDA
#undef PG8_LDB
#undef PG8_MMA
#undef PG8_WAIT_V
#undef PG8_WAIT_L
#undef PG8_BAR
#undef PG8_SCHED
#undef PG8_ABASE
#undef PG8_LANE_STATE
#undef PG8_BBASE
}

struct EpiP1 {
    static constexpr bool PERM = true, AFTER_DRAIN = false;
    __device__ __forceinline__ void init_acc(f32x4 (&acc)[2][2][4][2], const Unit&, int, int, int, int) const { zero_acc(acc); }
    __device__ __forceinline__ void prologue(const StaticOrder&, LAS unsigned char*, int) const {}
    bf16_t* V; bf16_t* SG;
    __device__ __forceinline__ void operator()(f32x4 (&acc)[2][2][4][2], const Unit& u, int wr, int wc, int fr, int fq, LAS unsigned char* lds, int ui) const {
        const int row0 = u.pm * BM + wr * 64 + fr; const bool gate = u.pn >= 8;
        bf16_t* base = gate ? SG : V; const int col0 = (u.pn & 7) * BM + wc * 32 + 8 * fq;
#pragma unroll
        for (int ai = 0; ai < 2; ++ai)
#pragma unroll
            for (int m = 0; m < 4; ++m) { bf16_t* rowp = base + (size_t)(row0 + ai * HALF + m * 16) * DI + col0;
#pragma unroll
                for (int bj = 0; bj < 2; ++bj) { f32x4 v0 = acc[ai][bj][m][0], v1 = acc[ai][bj][m][1];
                    if (gate) {
#pragma unroll
                        for (int j = 0; j < 4; ++j) { v0[j] = silu_f(v0[j]); v1[j] = silu_f(v1[j]); } }
                    u32x4 w; w.x = pkbf(v0[0], v0[1]); w.y = pkbf(v0[2], v0[3]); w.z = pkbf(v1[0], v1[1]); w.w = pkbf(v1[2], v1[3]);
                    *(u32x4*)(rowp + bj * HALF) = w; } }
    }
};
struct EpiP2 {
    static constexpr bool PERM = true, AFTER_DRAIN = false;
    __device__ __forceinline__ void init_acc(f32x4 (&acc)[2][2][4][2], const Unit&, int, int, int, int) const { zero_acc(acc); }
    __device__ __forceinline__ void prologue(const StaticOrder&, LAS unsigned char*, int) const {}
    bf16_t* Z;
    __device__ __forceinline__ void operator()(f32x4 (&acc)[2][2][4][2], const Unit& u, int wr, int wc, int fr, int fq, LAS unsigned char* lds, int ui) const {
        const unsigned row0 = (unsigned)(u.pm * BM + wr * 64 + fr), col0 = (unsigned)(u.pn * BM + wc * 32 + 8 * fq);
        const unsigned zofs = (row0 * DI + col0) * 2u;
#pragma unroll
        for (int ai = 0; ai < 2; ++ai) {
            u32x4 sv[4][2];
#pragma unroll
            for (int m = 0; m < 4; ++m)
#pragma unroll
                for (int bj = 0; bj < 2; ++bj) sv[m][bj] = *(const u32x4*)((const char*)Z + (zofs + (unsigned)((ai * HALF + m * 16) * DI + bj * HALF) * 2u));
#pragma unroll
            for (int m = 0; m < 4; ++m)
#pragma unroll
                for (int bj = 0; bj < 2; ++bj) { const f32x4 v0 = acc[ai][bj][m][0], v1 = acc[ai][bj][m][1]; const u32x4 s = sv[m][bj];
                    u32x4 w; w.x = pkbf(v0[0] * bf_lo(s.x), v0[1] * bf_hi(s.x)); w.y = pkbf(v0[2] * bf_lo(s.y), v0[3] * bf_hi(s.y));
                    w.z = pkbf(v1[0] * bf_lo(s.z), v1[1] * bf_hi(s.z)); w.w = pkbf(v1[2] * bf_lo(s.w), v1[3] * bf_hi(s.w));
                    *(u32x4*)((char*)Z + (zofs + (unsigned)((ai * HALF + m * 16) * DI + bj * HALF) * 2u)) = w; }
            asm volatile("" ::: "memory"); }
    }
};
template <bool WRITE_HB, bool WRITE_H = true> struct EpiRes {
    static constexpr bool PERM = true, AFTER_DRAIN = false;
    __device__ __forceinline__ void prologue(const StaticOrder&, LAS unsigned char*, int) const {}
    const float* R; float* H; bf16_t* HB; float* part;
    __device__ __forceinline__ void init_acc(f32x4 (&acc)[2][2][4][2], const Unit& u, int wr, int wc, int fr, int fq) const {
        const unsigned row0 = (unsigned)(u.pm * BM + wr * 64 + fr), col0 = (unsigned)(u.pn * BM + wc * 32 + 8 * fq);
        const unsigned ofs = (row0 * DM + col0) * 4u;
#pragma unroll
        for (int ai = 0; ai < 2; ++ai)
#pragma unroll
            for (int bj = 0; bj < 2; ++bj)
#pragma unroll
                for (int m = 0; m < 4; ++m)
#pragma unroll
                    for (int n = 0; n < 2; ++n) acc[ai][bj][m][n] = *(const f32x4*)((const char*)R + (ofs + (unsigned)((ai * HALF + m * 16) * DM + bj * HALF + n * 4) * 4u));
    }
    __device__ __forceinline__ void operator()(f32x4 (&acc)[2][2][4][2], const Unit& u, int wr, int wc, int fr, int fq, LAS unsigned char* lds, int ui) const {
        const unsigned row0 = (unsigned)(u.pm * BM + wr * 64 + fr), col0 = (unsigned)(u.pn * BM + wc * 32 + 8 * fq);
        const unsigned ofs = (row0 * DM + col0) * 4u, pofs = (row0 * 16u + (unsigned)(u.pn * 4 + wc)) * 4u;
#pragma unroll
        for (int ai = 0; ai < 2; ++ai)
#pragma unroll
            for (int m = 0; m < 4; ++m) { const unsigned o = ofs + (unsigned)((ai * HALF + m * 16) * DM) * 4u; float ss = 0.f;
#pragma unroll
                for (int bj = 0; bj < 2; ++bj) { const unsigned oo = o + (unsigned)(bj * HALF) * 4u; const f32x4 h0 = acc[ai][bj][m][0], h1 = acc[ai][bj][m][1];
                    if (WRITE_H) { *(f32x4*)((char*)H + oo) = h0; *(f32x4*)((char*)H + oo + 16u) = h1; }
                    ss += ((h0[0] * h0[0] + h0[1] * h0[1]) + (h0[2] * h0[2] + h0[3] * h0[3])) + ((h1[0] * h1[0] + h1[1] * h1[1]) + (h1[2] * h1[2] + h1[3] * h1[3]));
                    if (WRITE_HB) { u32x4 w; w.x = pkbf(h0[0], h0[1]); w.y = pkbf(h0[2], h0[3]); w.z = pkbf(h1[0], h1[1]); w.w = pkbf(h1[2], h1[3]); *(u32x4*)((char*)HB + (oo >> 1)) = w; } }
                ss += xor_get(ss, fq * 16 + fr, 16); ss += xor_get(ss, fq * 16 + fr, 32);
                if (fq == 0) *(float*)((char*)part + (pofs + (unsigned)(ai * HALF + m * 16) * 64u)) = ss; }
    }
};
__device__ __forceinline__ float row_rstd_b(const float* part, unsigned bofs) {
    const f32x4* p = (const f32x4*)((const char*)part + bofs); const f32x4 a = p[0], b = p[1], c = p[2], d = p[3];
    return __builtin_amdgcn_rsqf((((a[0] + a[1]) + (a[2] + a[3])) + ((b[0] + b[1]) + (b[2] + b[3])) + ((c[0] + c[1]) + (c[2] + c[3])) + ((d[0] + d[1]) + (d[2] + d[3]))) * (1.0f / DM) + EPS);
}
__device__ __forceinline__ float dpp_shr_mul(float v, const int n) {
    const int iv = __builtin_bit_cast(int, v), one = 0x3f800000; int r;
    if (n == 1) r = __builtin_amdgcn_update_dpp(one, iv, 0x111, 0xf, 0xf, false); else if (n == 2) r = __builtin_amdgcn_update_dpp(one, iv, 0x112, 0xf, 0xf, false);
    else if (n == 4) r = __builtin_amdgcn_update_dpp(one, iv, 0x114, 0xf, 0xf, false); else r = __builtin_amdgcn_update_dpp(one, iv, 0x118, 0xf, 0xf, false);
    return v * __builtin_bit_cast(float, r);
}
constexpr unsigned TAB_OFF = 131072u + 256u;
struct EpiP4 {
    static constexpr bool PERM = true, AFTER_DRAIN = false;
    __device__ __forceinline__ void init_acc(f32x4 (&acc)[2][2][4][2], const Unit&, int, int, int, int) const { zero_acc(acc); }
    bf16_t* Qt; bf16_t* Kt; bf16_t* V; float* DEC; const float* part; const float* lbnd;
    __device__ __forceinline__ void prologue(const StaticOrder& S, LAS unsigned char* lds, int tid) const {
        LAS float* T = (LAS float*)(lds + TAB_OFF); Unit u;
        for (int i = 0; i < 12 && S.next(i, u); ++i)
            if (tid < 256) T[i * 256 + tid] = row_rstd_b(part, (unsigned)(u.pm * BM + tid) * 64u);
        __syncthreads();
    }
    __device__ __forceinline__ void operator()(f32x4 (&acc)[2][2][4][2], const Unit& u, int wr, int wc, int fr, int fq, LAS unsigned char* lds, int ui) const {
        const unsigned row0 = (unsigned)(u.pm * BM + wr * 64 + fr);
        const LAS float* T = (const LAS float*)(lds + TAB_OFF) + ui * 256 + wr * 64 + fr;
        if (u.pn >= 16) {
            const unsigned vofs = (row0 * DI + (unsigned)((u.pn - 16) * BM + wc * 32 + 8 * fq)) * 2u;
#pragma unroll
            for (int ai = 0; ai < 2; ++ai)
#pragma unroll
                for (int m = 0; m < 4; ++m) { const float rs = T[ai * HALF + m * 16];
#pragma unroll
                    for (int bj = 0; bj < 2; ++bj) { const f32x4 v0 = acc[ai][bj][m][0] * rs, v1 = acc[ai][bj][m][1] * rs;
                        u32x4 w; w.x = pkbf(v0[0], v0[1]); w.y = pkbf(v0[2], v0[3]); w.z = pkbf(v1[0], v1[1]); w.w = pkbf(v1[2], v1[3]);
                        *(u32x4*)((char*)V + (vofs + (unsigned)((ai * HALF + m * 16) * DI + bj * HALF) * 2u)) = w; } }
            return;
        }
        const unsigned c0 = (unsigned)(u.pn * HD + wc * 32 + 8 * fq);
        const unsigned qofs = (row0 * DI + c0) * 2u;
#pragma unroll
        for (int ai = 0; ai < 2; ++ai) {
            float rs[4];
#pragma unroll
            for (int m = 0; m < 4; ++m) rs[m] = T[ai * HALF + m * 16];
            unsigned cc = c0; asm volatile("" : "+v"(cc));
#pragma unroll
            for (int n = 0; n < 2; ++n) {
                const f32x4 l0 = *(const f32x4*)((const char*)lbnd + (cc + 4 * n) * 4u), l1 = *(const f32x4*)((const char*)lbnd + (cc + 4 * n + DI) * 4u);
                f32x4 decv;
#pragma unroll
                for (int j = 0; j < 4; ++j) { const float ex = __expf(l0[j] - l1[j]); const float lb = __builtin_amdgcn_rcpf(1.0f + ex), omlb = ex * lb; float bprod = 1.0f;
#pragma unroll
                    for (int m = 0; m < 4; ++m) {
                        const float qv = acc[ai][0][m][n][j] * rs[m], z = acc[ai][1][m][n][j] * rs[m];
                        const float sg = __builtin_amdgcn_rcpf(1.0f + __builtin_amdgcn_exp2f(-1.44269504089f * z));
                        const float f = lb + omlb * sg, k = omlb * (1.0f - sg);
                        float s = f; s = dpp_shr_mul(s, 1); s = dpp_shr_mul(s, 2); s = dpp_shr_mul(s, 4); s = dpp_shr_mul(s, 8);
                        const float E = bprod * s;
                        if (m < 3) bprod *= lane_get(s, fq * 16 + 15);
                        const float Ei = __builtin_amdgcn_rcpf(fmaxf(E, 7.9e-31f));
                        acc[ai][0][m][n][j] = qv * E; acc[ai][1][m][n][j] = k * Ei;
                        if (m == 3) decv[j] = E;
                    } }
                if (fr == 15) *(f32x4*)((char*)DEC + ((unsigned)(u.pm * 4 + ai * 2 + wr) * DI + cc + 4 * n) * 4u) = decv;
            }
#pragma unroll
            for (int m = 0; m < 4; ++m) { const unsigned ob = qofs + (unsigned)((ai * HALF + m * 16) * DI) * 2u;
                u32x4 w; w.x = pkbf(acc[ai][0][m][0][0], acc[ai][0][m][0][1]); w.y = pkbf(acc[ai][0][m][0][2], acc[ai][0][m][0][3]); w.z = pkbf(acc[ai][0][m][1][0], acc[ai][0][m][1][1]); w.w = pkbf(acc[ai][0][m][1][2], acc[ai][0][m][1][3]);
                *(u32x4*)((char*)Qt + ob) = w;
                u32x4 x; x.x = pkbf(acc[ai][1][m][0][0], acc[ai][1][m][0][1]); x.y = pkbf(acc[ai][1][m][0][2], acc[ai][1][m][0][3]); x.z = pkbf(acc[ai][1][m][1][0], acc[ai][1][m][1][1]); x.w = pkbf(acc[ai][1][m][1][2], acc[ai][1][m][1][3]);
                *(u32x4*)((char*)Kt + ob) = x; }
            asm volatile("" ::: "memory");
        }
    }
};
struct EpiP5b {
    static constexpr bool PERM = true, AFTER_DRAIN = false;
    __device__ __forceinline__ void init_acc(f32x4 (&acc)[2][2][4][2], const Unit&, int, int, int, int) const { zero_acc(acc); }
    bf16_t* O; const float* part; const float* ss;
    __device__ __forceinline__ void prologue(const StaticOrder& S, LAS unsigned char* lds, int tid) const {
        LAS float* T = (LAS float*)(lds + TAB_OFF); Unit u;
        for (int i = 0; i < 4 && S.next(i, u); ++i) {
            if (tid < 256) T[i * 768 + tid] = row_rstd_b(part, (unsigned)(u.pm * BM + tid) * 64u);
            { const int r = tid >> 1, hh = tid & 1; const f32x4* sp = (const f32x4*)(ss + (size_t)(u.pm * BM + r) * 128 + (u.pn * 2 + hh) * 8); const f32x4 s0 = sp[0], s1 = sp[1];
              T[i * 768 + 256 + tid] = __builtin_amdgcn_rsqf((((s0[0] + s0[1]) + (s0[2] + s0[3])) + ((s1[0] + s1[1]) + (s1[2] + s1[3]))) * (1.0f / HD) + EPS); }
        }
        __syncthreads();
    }
    __device__ __forceinline__ void operator()(f32x4 (&acc)[2][2][4][2], const Unit& u, int wr, int wc, int fr, int fq, LAS unsigned char* lds, int ui) const {
        const unsigned row0 = (unsigned)(u.pm * BM + wr * 64 + fr), col0 = (unsigned)(u.pn * BM + wc * 32 + 8 * fq);
        const LAS float* T = (const LAS float*)(lds + TAB_OFF) + ui * 768 + wr * 64 + fr;
        const unsigned oofs = (row0 * DI + col0) * 2u;
#pragma unroll
        for (int ai = 0; ai < 2; ++ai) {
            u32x4 ov[4][2];
#pragma unroll
            for (int m = 0; m < 4; ++m)
#pragma unroll
                for (int bj = 0; bj < 2; ++bj) ov[m][bj] = *(const u32x4*)((const char*)O + (oofs + (unsigned)((ai * HALF + m * 16) * DI + bj * HALF) * 2u));
#pragma unroll
            for (int m = 0; m < 4; ++m) { const int rl = ai * HALF + m * 16; const float rs = T[rl];
#pragma unroll
                for (int bj = 0; bj < 2; ++bj) { const f32x4 v0 = acc[ai][bj][m][0] * rs, v1 = acc[ai][bj][m][1] * rs;
                    const float rh = T[256 + 2 * rl + bj + (wr * 64 + fr)];
                    const u32x4 s = ov[m][bj];
                    u32x4 w; w.x = pkbf(bf_lo(s.x) * rh * silu_f(v0[0]), bf_hi(s.x) * rh * silu_f(v0[1])); w.y = pkbf(bf_lo(s.y) * rh * silu_f(v0[2]), bf_hi(s.y) * rh * silu_f(v0[3]));
                    w.z = pkbf(bf_lo(s.z) * rh * silu_f(v1[0]), bf_hi(s.z) * rh * silu_f(v1[1])); w.w = pkbf(bf_lo(s.w) * rh * silu_f(v1[2]), bf_hi(s.w) * rh * silu_f(v1[3]));
                    *(u32x4*)((char*)O + (oofs + (unsigned)((ai * HALF + m * 16) * DI + bj * HALF) * 2u)) = w; } }
            asm volatile("" ::: "memory"); }
    }
};
struct EpiFinal {
    static constexpr bool PERM = true, AFTER_DRAIN = false;
    __device__ __forceinline__ void init_acc(f32x4 (&acc)[2][2][4][2], const Unit&, int, int, int, int) const { zero_acc(acc); }
    const bf16_t* HB; float* H; const float* fg; float* X; unsigned* cnt;
    __device__ __forceinline__ void prologue(const StaticOrder&, LAS unsigned char*, int) const {}
    __device__ __forceinline__ void operator()(f32x4 (&acc)[2][2][4][2], const Unit& u, int wr, int wc, int fr, int fq, LAS unsigned char* lds, int ui) const {
        LAS float* Pt = (LAS float*)(lds + TAB_OFF);
        LAS float* St = Pt + 1024;
        const int tid = (wr * 4 + wc) * 64 + fq * 16 + fr;
        const unsigned row0 = (unsigned)(u.pm * BM + wr * 64 + fr), col0 = (unsigned)(u.pn * BM + wc * 32 + 8 * fq);
        const unsigned ofs = (row0 * DM + col0) * 4u;
#pragma unroll
        for (int ai = 0; ai < 2; ++ai) {
            u32x4 hv[4][2];
#pragma unroll
            for (int m = 0; m < 4; ++m)
#pragma unroll
                for (int bj = 0; bj < 2; ++bj) hv[m][bj] = *(const u32x4*)((const char*)HB + ((ofs + (unsigned)((ai * HALF + m * 16) * DM + bj * HALF) * 4u) >> 1));
#pragma unroll
            for (int m = 0; m < 4; ++m) { float ss = 0.f;
#pragma unroll
                for (int bj = 0; bj < 2; ++bj) { const u32x4 hb = hv[m][bj];
                    const f32x4 h0 = acc[ai][bj][m][0] + (f32x4){bf_lo(hb.x), bf_hi(hb.x), bf_lo(hb.y), bf_hi(hb.y)}, h1 = acc[ai][bj][m][1] + (f32x4){bf_lo(hb.z), bf_hi(hb.z), bf_lo(hb.w), bf_hi(hb.w)};
                    acc[ai][bj][m][0] = h0; acc[ai][bj][m][1] = h1;
                    ss += ((h0[0] * h0[0] + h0[1] * h0[1]) + (h0[2] * h0[2] + h0[3] * h0[3])) + ((h1[0] * h1[0] + h1[1] * h1[1]) + (h1[2] * h1[2] + h1[3] * h1[3])); }
                ss += xor_get(ss, fq * 16 + fr, 16); ss += xor_get(ss, fq * 16 + fr, 32);
                if (fq == 0) Pt[(ai * HALF + wr * 64 + m * 16 + fr) * 4 + wc] = ss; }
            asm volatile("" ::: "memory"); }
        __syncthreads();
        float* xs = X + (size_t)u.pm * 1024;
        if (tid < 256) { const f32x4 p = *(const LAS f32x4*)(Pt + tid * 4);
            __hip_atomic_store(xs + u.pn * 256 + tid, (p[0] + p[1]) + (p[2] + p[3]), __ATOMIC_RELAXED, __HIP_MEMORY_SCOPE_AGENT); }
        asm volatile("s_waitcnt vmcnt(0)" ::: "memory");
        __syncthreads();
        if (tid == 0) {
            unsigned* c = cnt + 16 * u.pm;
            __hip_atomic_fetch_add(c, 1u, __ATOMIC_RELAXED, __HIP_MEMORY_SCOPE_AGENT);
            unsigned spins = 0;
            while (__hip_atomic_load(c, __ATOMIC_RELAXED, __HIP_MEMORY_SCOPE_AGENT) < 4u) { __builtin_amdgcn_s_sleep(2); if (++spins > (1u << 22)) break; }
            __builtin_amdgcn_fence(__ATOMIC_ACQUIRE, "agent");
            asm volatile("s_waitcnt vmcnt(0)" ::: "memory");
        }
        __syncthreads();
        if (tid < 256) { float s = 0.f;
#pragma unroll
            for (int t = 0; t < 4; ++t) s += __hip_atomic_load(xs + t * 256 + tid, __ATOMIC_RELAXED, __HIP_MEMORY_SCOPE_AGENT);
            St[tid] = __builtin_amdgcn_rsqf(s * (1.0f / DM) + EPS); }
        __syncthreads();
        f32x4 gv[2][2];
#pragma unroll
        for (int bj = 0; bj < 2; ++bj)
#pragma unroll
            for (int n = 0; n < 2; ++n) gv[bj][n] = *(const f32x4*)(fg + col0 + bj * HALF + n * 4);
#pragma unroll
        for (int ai = 0; ai < 2; ++ai)
#pragma unroll
            for (int m = 0; m < 4; ++m) { const float rs = St[ai * HALF + wr * 64 + m * 16 + fr];
#pragma unroll
                for (int bj = 0; bj < 2; ++bj) { const unsigned oo = ofs + (unsigned)((ai * HALF + m * 16) * DM + bj * HALF) * 4u;
                    *(f32x4*)((char*)H + oo) = acc[ai][bj][m][0] * rs * gv[bj][0]; *(f32x4*)((char*)H + oo + 16u) = acc[ai][bj][m][1] * rs * gv[bj][1]; } }
        __syncthreads();
    }
};
}

namespace scan {
#define MFMA16(a, b, c) __builtin_amdgcn_mfma_f32_16x16x32_bf16((a), (b), (c), 0, 0, 0)
__device__ __forceinline__ unsigned offb(unsigned row, unsigned ch) { return 256u * row + 16u * (ch ^ (((row & 3u) << 2) | ((row >> 2) & 3u))); }
__device__ __forceinline__ unsigned voffv(unsigned r, unsigned cp) { return 128u * r + 32u * (cp ^ (((r >> 1) & 3u) ^ (((r >> 3) & 1u) << 1))); }
__device__ __forceinline__ void tr8(unsigned a0, unsigned a1, unsigned c0, unsigned c1, bf16x8& f00, bf16x8& f01, bf16x8& f10, bf16x8& f11) {
    u32x2 r0, r1, r2, r3, r4, r5, r6, r7;
    asm volatile("ds_read_b64_tr_b16 %0, %8\n\tds_read_b64_tr_b16 %1, %9\n\tds_read_b64_tr_b16 %2, %8 offset:8192\n\tds_read_b64_tr_b16 %3, %9 offset:8192\n\t"
                 "ds_read_b64_tr_b16 %4, %10\n\tds_read_b64_tr_b16 %5, %11\n\tds_read_b64_tr_b16 %6, %10 offset:8192\n\tds_read_b64_tr_b16 %7, %11 offset:8192\n\ts_waitcnt lgkmcnt(0)"
                 : "=&v"(r0), "=&v"(r1), "=&v"(r2), "=&v"(r3), "=&v"(r4), "=&v"(r5), "=&v"(r6), "=&v"(r7) : "v"(a0), "v"(a1), "v"(c0), "v"(c1) : "memory");
    const u32x4 x00 = {r0.x, r0.y, r1.x, r1.y}, x01 = {r2.x, r2.y, r3.x, r3.y}, x10 = {r4.x, r4.y, r5.x, r5.y}, x11 = {r6.x, r6.y, r7.x, r7.y};
    f00 = __builtin_bit_cast(bf16x8, x00); f01 = __builtin_bit_cast(bf16x8, x01); f10 = __builtin_bit_cast(bf16x8, x10); f11 = __builtin_bit_cast(bf16x8, x11);
}
__device__ __forceinline__ bf16x8 pack8(const f32x4 a, const f32x4 b) { const u32x4 r = {pkbf(a[0], a[1]), pkbf(a[2], a[3]), pkbf(b[0], b[1]), pkbf(b[2], b[3])}; return __builtin_bit_cast(bf16x8, r); }
__device__ __forceinline__ u32x2 tr_issue(unsigned a) { u32x2 r; asm volatile("ds_read_b64_tr_b16 %0, %1" : "=v"(r) : "v"(a) : "memory"); return r; }
__device__ __forceinline__ bf16x8 frag2(const u32x2 lo, const u32x2 hi) { const u32x4 r = {lo.x, lo.y, hi.x, hi.y}; return __builtin_bit_cast(bf16x8, r); }
template <int NJ>
__device__ __forceinline__ void at_part(LAS unsigned char* lds, unsigned QI, unsigned KI, int it, unsigned l15, unsigned g, bf16x8 (&at)[NJ / 2]) {
    const unsigned trow = 16u * (unsigned)it + l15;
    bf16x8 qb[4];
#pragma unroll
    for (int kd = 0; kd < 4; ++kd) qb[kd] = *(const LAS bf16x8*)(lds + QI + offb(trow, 4u * kd + g));
    f32x4 c[NJ];
#pragma unroll
    for (int j = 0; j < NJ; ++j) { c[j] = (f32x4){0.f, 0.f, 0.f, 0.f};
        if (j <= it) {
#pragma unroll
            for (int kd = 0; kd < 4; ++kd) { const bf16x8 a = *(const LAS bf16x8*)(lds + KI + offb(16u * j + l15, 4u * kd + g)); c[j] = MFMA16(a, qb[kd], c[j]); }
            if (j == it) {
#pragma unroll
                for (int r = 0; r < 4; ++r) c[j][r] = (4u * g + r <= l15) ? c[j][r] : 0.f; } } }
#pragma unroll
    for (int ks = 0; ks < NJ / 2; ++ks) at[ks] = pack8(c[2 * ks], c[2 * ks + 1]);
}
template <int NK>
__device__ __forceinline__ f32x4 o_part(LAS unsigned char* lds, unsigned QI, int it, const bf16x8 (&at)[NK], const bf16x8 (&vf)[2], const bf16x8 (&sfrag)[4], unsigned l15, unsigned g) {
    const unsigned trow = 16u * (unsigned)it + l15;
    f32x4 o = (f32x4){0.f, 0.f, 0.f, 0.f};
#pragma unroll
    for (int ks = 0; ks < NK; ++ks) if (2 * ks <= it) o = MFMA16(vf[ks], at[ks], o);
#pragma unroll
    for (int kd = 0; kd < 4; ++kd) {
        const u32x2 q0 = *(const LAS u32x2*)(lds + QI + offb(trow, 4u * kd + (g >> 1)) + 8u * (g & 1)), q1 = *(const LAS u32x2*)(lds + QI + offb(trow, 4u * kd + 2u + (g >> 1)) + 8u * (g & 1));
        o = MFMA16(sfrag[kd], frag2(q0, q1), o); }
    return o;
}
__device__ __forceinline__ void phase(LAS unsigned char* lds, const bf16_t* Qt, const bf16_t* Kt, bf16_t* VO, const float* DEC, float* ss8, int bid, int G, int wave) {
    int lane_ = (int)__builtin_amdgcn_mbcnt_hi(~0u, __builtin_amdgcn_mbcnt_lo(~0u, 0u)); asm volatile("" : "+v"(lane_));
    const unsigned lane = (unsigned)lane_, tid = (unsigned)wave * 64u + lane, l15 = lane & 15u, g = lane >> 4, ql = l15 >> 2, p = lane & 3u;
    const unsigned vs = (unsigned)wave & 3u; const int th = wave >> 2, tA = th ? 1 : 0, tB = th ? 2 : 3;
    const unsigned ldsb = (unsigned)(uintptr_t)lds;
    const unsigned srow = tid >> 4, sch = tid & 15u, vrow = tid >> 3, vch = tid & 7u;
    for (int item = bid; item < BATCH * NHEAD * 2; item += G) {
        const int half = (item >> 3) & 1, pair = (item & 7) | ((item >> 4) << 3), b = pair >> 4, h = pair & 15;
        const size_t tokb = (size_t)b * SEQ;
        const bf16_t* qg = Qt + (tokb + srow) * DI + h * HD + sch * 8;
        const bf16_t* kg = Kt + (tokb + srow) * DI + h * HD + sch * 8;
        bf16_t* vg = VO + tokb * DI + h * HD + half * 64;
        f32x4 S[8]; bf16x8 sfrag[4];
#pragma unroll
        for (int i = 0; i < 8; ++i) S[i] = (f32x4){0.f, 0.f, 0.f, 0.f};
#pragma unroll
        for (int i = 0; i < 4; ++i) sfrag[i] = (bf16x8){0, 0, 0, 0, 0, 0, 0, 0};
        u32x4 rq0, rq1, rk0, rk1, rv; f32x4 rdec = (f32x4){0.f, 0.f, 0.f, 0.f};
        const float* dg = DEC + (size_t)(b * (SEQ / 64)) * DI + h * HD + (tid & 31u) * 4u;
#define SC_LOAD(n_) do { const size_t t0_ = (size_t)(n_) * 64; \
            rq0 = *(const u32x4*)(qg + t0_ * DI); rq1 = *(const u32x4*)(qg + (t0_ + 32) * DI); rk0 = *(const u32x4*)(kg + t0_ * DI); rk1 = *(const u32x4*)(kg + (t0_ + 32) * DI); \
            rv = *(const u32x4*)(vg + (t0_ + vrow) * DI + vch * 8); if (tid < 32u) rdec = *(const f32x4*)(dg + (size_t)(n_) * DI); } while (0)
#define SC_STORE(base_) do { *(LAS u32x4*)(lds + (base_) + offb(srow, sch)) = rq0; *(LAS u32x4*)(lds + (base_) + offb(srow + 32u, sch)) = rq1; \
            *(LAS u32x4*)(lds + (base_) + 16384u + offb(srow, sch)) = rk0; *(LAS u32x4*)(lds + (base_) + 16384u + offb(srow + 32u, sch)) = rk1; \
            *(LAS u32x4*)(lds + (base_) + 32768u + voffv(vrow, vch >> 1) + 16u * (vch & 1u)) = rv; \
            if (tid < 32u) *(LAS f32x4*)(lds + 81920u + ((base_) ? 512u : 0u) + tid * 16u) = rdec; } while (0)
        SC_LOAD(0); SC_STORE(0u); __syncthreads();
        for (int n = 0; n < SEQ / 64; ++n) {
            const unsigned QI = (unsigned)(n & 1) * 40960u, KI = QI + 16384u, VI = QI + 32768u;
            if (n + 1 < SEQ / 64) SC_LOAD(n + 1);
            u32x2 tv0, tv1, tv2, tv3, tv4, tv5, tv6, tv7;
            {
                const unsigned va = ldsb + VI + 8u * p;
                tv0 = tr_issue(va + voffv(4u * g + ql, vs)); tv1 = tr_issue(va + voffv(16u + 4u * g + ql, vs)); tv2 = tr_issue(va + voffv(32u + 4u * g + ql, vs)); tv3 = tr_issue(va + voffv(48u + 4u * g + ql, vs));
                tv4 = tr_issue(va + voffv(8u * g + ql, vs)); tv5 = tr_issue(va + voffv(8u * g + 4u + ql, vs)); tv6 = tr_issue(va + voffv(32u + 8u * g + ql, vs)); tv7 = tr_issue(va + voffv(36u + 8u * g + ql, vs));
            }
            bf16x8 atB[2], atA[1];
            at_part<4>(lds, QI, KI, tB, l15, g, atB);
            at_part<2>(lds, QI, KI, tA, l15, g, atA);
            asm volatile("s_waitcnt lgkmcnt(0)" : "+v"(tv0), "+v"(tv1), "+v"(tv2), "+v"(tv3), "+v"(tv4), "+v"(tv5), "+v"(tv6), "+v"(tv7) :: "memory");
            __builtin_amdgcn_sched_barrier(0);
            const bf16x8 vf[2] = {frag2(tv0, tv1), frag2(tv2, tv3)};
            const f32x4 oB = o_part<2>(lds, QI, tB, atB, vf, sfrag, l15, g);
            const f32x4 oA = o_part<1>(lds, QI, tA, atA, vf, sfrag, l15, g);
            {
                const bf16x8 vn0 = frag2(tv4, tv5), vn1 = frag2(tv6, tv7);
                const LAS float* dcp = (const LAS float*)(lds + 81920u + (unsigned)(n & 1) * 512u) + 4u * g;
                const unsigned ka = ldsb + KI + offb(8u * g + ql, (p >> 1)) + 8u * (p & 1u), kb = ldsb + KI + offb(8u * g + 4u + ql, (p >> 1)) + 8u * (p & 1u);
#pragma unroll
                for (int i = 0; i < 8; i += 2) {
                    bf16x8 k00, k01, k10, k11;
                    tr8(ka ^ ((unsigned)i << 5), kb ^ ((unsigned)i << 5), ka ^ ((unsigned)(i + 1) << 5), kb ^ ((unsigned)(i + 1) << 5), k00, k01, k10, k11);
                    S[i] = MFMA16(k00, vn0, S[i]); S[i + 1] = MFMA16(k10, vn0, S[i + 1]); S[i] = MFMA16(k01, vn1, S[i]); S[i + 1] = MFMA16(k11, vn1, S[i + 1]); }
#pragma unroll
                for (int i = 0; i < 8; ++i) { const f32x4 dc = *(const LAS f32x4*)(dcp + 16 * i); S[i] = S[i] * dc; }
#pragma unroll
                for (int kd = 0; kd < 4; ++kd) sfrag[kd] = pack8(S[2 * kd], S[2 * kd + 1]);
            }
            if (n + 1 < SEQ / 64) SC_STORE((unsigned)((n + 1) & 1) * 40960u);
            {
                const size_t tlB = (size_t)n * 64 + 16u * (unsigned)tB + l15, tlA = (size_t)n * 64 + 16u * (unsigned)tA + l15;
                const u32x2 wB = {pkbf(oB[0], oB[1]), pkbf(oB[2], oB[3])}, wA = {pkbf(oA[0], oA[1]), pkbf(oA[2], oA[3])};
                *(u32x2*)(vg + tlB * DI + 16u * vs + 4u * g) = wB; *(u32x2*)(vg + tlA * DI + 16u * vs + 4u * g) = wA;
                float sB = (oB[0] * oB[0] + oB[1] * oB[1]) + (oB[2] * oB[2] + oB[3] * oB[3]), sA = (oA[0] * oA[0] + oA[1] * oA[1]) + (oA[2] * oA[2] + oA[3] * oA[3]);
                sB += xor_get(sB, (int)lane, 16); sA += xor_get(sA, (int)lane, 16); sB += xor_get(sB, (int)lane, 32); sA += xor_get(sA, (int)lane, 32);
                if (g == 0) { ss8[(tokb + tlB) * 128 + h * 8 + half * 4 + vs] = sB; ss8[(tokb + tlA) * 128 + h * 8 + half * 4 + vs] = sA; }
            }
            __syncthreads();
        }
#undef SC_LOAD
#undef SC_STORE
    }
}
#undef MFMA16
}

#define XB_TMO      128
#define XB_XCNT(j)  (256  + 64 * (j))
#define XB_XSUB(j)  (1280 + 64 * (j))
#define XB_XGEN(j)  (2304 + 64 * (j))
#define XB_TOP      3328
#define XB_TOPGEN   3392
#define XCD_BAR_WORDS 3456
#define XB_SPIN_CAP (1u << 18)
__device__ __forceinline__ unsigned xb_ld(unsigned* p)              { return __hip_atomic_load(p, __ATOMIC_RELAXED, __HIP_MEMORY_SCOPE_AGENT); }
__device__ __forceinline__ unsigned xb_add(unsigned* p, unsigned v) { return __hip_atomic_fetch_add(p, v, __ATOMIC_RELAXED, __HIP_MEMORY_SCOPE_AGENT); }
__device__ __forceinline__ unsigned xb_xcc_id() { return (unsigned)__builtin_amdgcn_s_getreg((3 << 11) | 20) & 0xFu; }
#define XB_SPIN(cond, bar) do { unsigned _sp = 0; while (cond) { __builtin_amdgcn_s_sleep(1); \
    if ((++_sp & 255u) == 0u) { if (xb_ld(&(bar)[XB_TMO])) break; if (_sp > XB_SPIN_CAP) { atomicAdd(&(bar)[XB_TMO], 1u); break; } } } } while (0)
struct XcdBarrier { unsigned* bar; unsigned x; volatile LAS unsigned* st; };
__device__ __forceinline__ XcdBarrier xcd_barrier_post(unsigned* bar, volatile LAS unsigned* st) {
    XcdBarrier b; b.bar = bar; b.x = xb_xcc_id(); b.st = st;
    if (threadIdx.x == 0) (void)xb_add(&bar[XB_XCNT(b.x)], 1u);
    return b;
}
__device__ __forceinline__ void xcd_barrier_complete(unsigned* bar, unsigned x, unsigned& nloc, unsigned& nx) {
    const unsigned G = gridDim.x * gridDim.y * gridDim.z;
    unsigned sum, cnt, mine, sp = 0u;
    for (;;) {
        sum = 0u; cnt = 0u; mine = 0u;
#pragma unroll
        for (unsigned j = 0; j < 16; ++j) { const unsigned c = xb_ld(&bar[XB_XCNT(j)]); sum += c; cnt += (c > 0u) ? 1u : 0u; mine = (j == x) ? c : mine; }
        if (sum == G) break;
        __builtin_amdgcn_s_sleep(1);
        if ((++sp & 255u) == 0u) { if (xb_ld(&bar[XB_TMO])) break; if (sp > XB_SPIN_CAP) { atomicAdd(&bar[XB_TMO], 1u); break; } }
    }
    nloc = mine > 0u ? mine : 1u; nx = cnt > 0u ? cnt : 1u;
}
__device__ __forceinline__ void xcd_barrier(const XcdBarrier& b) {
    asm volatile("s_waitcnt vmcnt(0)" ::: "memory");
    __syncthreads();
    if (threadIdx.x == 0) {
        unsigned* bar = b.bar;
        __builtin_amdgcn_s_waitcnt(0);
        unsigned nloc = b.st[0], nx = b.st[1];
        if (nloc == 0u) { xcd_barrier_complete(bar, b.x, nloc, nx); b.st[0] = nloc; b.st[1] = nx; }
        const unsigned old = xb_add(&bar[XB_XSUB(b.x)], 1u);
        const unsigned gen = old / nloc;
        if (old + 1u == (gen + 1u) * nloc) {
            __builtin_amdgcn_fence(__ATOMIC_RELEASE, "agent");
            asm volatile("s_waitcnt vmcnt(0)" ::: "memory");
            const unsigned og = xb_add(&bar[XB_TOP], 1u);
            const unsigned tg = og / nx;
            if (og + 1u == (tg + 1u) * nx) xb_add(&bar[XB_TOPGEN], 1u);
            else XB_SPIN(xb_ld(&bar[XB_TOPGEN]) == tg, bar);
            __builtin_amdgcn_fence(__ATOMIC_ACQUIRE, "agent");
            xb_add(&bar[XB_XGEN(b.x)], 1u);
            asm volatile("s_waitcnt vmcnt(0)" ::: "memory");
        } else {
            XB_SPIN(xb_ld(&bar[XB_XGEN(b.x)]) == gen, bar);
            __builtin_amdgcn_fence(__ATOMIC_ACQUIRE, "agent");
            asm volatile("s_waitcnt vmcnt(0)" ::: "memory");
        }
    }
    __syncthreads();
}

struct Args {
    const float* x; const float* norm_g; const float* pool_w_in; const float* pool_w_grp; const float* pool_scale; const float* pool_w_out;
    const float* hgrn_w_in; const float* hgrn_lb; const float* hgrn_norm_g; const float* hgrn_w_out; const float* final_g;
    float* out; unsigned char* ws;
};

struct TItem { const float* W; bf16_t* WT; const float* ks; const float* ns; int K, N, row_off, item; };
__device__ __forceinline__ void titem_issue(const TItem& t, int lane, float (&wv)[32]) {
    const int nblk = t.N / 32, kb = t.item / nblk, nb = t.item % nblk, k0 = 64 * kb, n0 = 32 * nb;
    const float* wp = t.W + (size_t)(k0 + (lane >> 5)) * t.N + n0 + (lane & 31);
#pragma unroll
    for (int i = 0; i < 32; ++i) wv[i] = wp[(size_t)(2 * i) * t.N];
}
__device__ __forceinline__ void titem_finish(const TItem& t, int lane, const float (&wv)[32], LAS float* scr) {
    const int nblk = t.N / 32, kb = t.item / nblk, nb = t.item % nblk, k0 = 64 * kb, n0 = 32 * nb;
    const float nsv = t.ns ? t.ns[n0 + (lane & 31)] : 1.0f;
    const float ksv = t.ks ? t.ks[k0 + lane] : 1.0f;
#pragma unroll
    for (int i = 0; i < 32; ++i) { const int kk = 2 * i + (lane >> 5); scr[kk * 33 + (lane & 31)] = wv[i] * nsv * lane_get(ksv, kk); }
    asm volatile("s_waitcnt lgkmcnt(0)" ::: "memory");
    const int c = lane & 7;
#pragma unroll
    for (int j = 0; j < 4; ++j) { const int n = (lane >> 3) + 8 * j; const LAS float* s = scr + (8 * c) * 33 + n;
        u32x4 o; o.x = pkbf(s[0 * 33], s[1 * 33]); o.y = pkbf(s[2 * 33], s[3 * 33]); o.z = pkbf(s[4 * 33], s[5 * 33]); o.w = pkbf(s[6 * 33], s[7 * 33]);
        *(u32x4*)(t.WT + (size_t)(t.row_off + n0 + n) * t.K + k0 + 8 * c) = o; }
    asm volatile("s_waitcnt lgkmcnt(0)" ::: "memory");
}

__global__ void __launch_bounds__(512, 2) fwd_kernel(Args a) {
    extern __shared__ __attribute__((aligned(16))) unsigned char lds_raw[];
    LAS unsigned char* lds = (LAS unsigned char*)lds_raw;
    volatile LAS unsigned* xst = (volatile LAS unsigned*)(lds + 131072 + 64);
    if (threadIdx.x < 2) xst[threadIdx.x] = 0u;
    __syncthreads();
    const XcdBarrier xbar = xcd_barrier_post((unsigned*)a.ws, xst);
#define GRID_BAR() xcd_barrier(xbar)
    const int G = gridDim.x, bid = blockIdx.x;
    const int NGW = G * 8;
    const int wave = __builtin_amdgcn_readfirstlane((int)threadIdx.x >> 6);
#define PHASE_IDS int lane_ = (int)__builtin_amdgcn_mbcnt_hi(~0u, __builtin_amdgcn_mbcnt_lo(~0u, 0u)); asm volatile("" : "+v"(lane_)); const int lane = lane_, tid = wave * 64 + lane, gw = bid * 8 + wave; (void)gw; (void)tid;
    unsigned char* ws = a.ws;
    bf16_t* Wt_in0 = (bf16_t*)(ws + WS_WIN0); bf16_t* Wt_grp = (bf16_t*)(ws + WS_WGRP); bf16_t* Wt_out0 = (bf16_t*)(ws + WS_WOUT0);
    bf16_t* Wt_in1 = (bf16_t*)(ws + WS_WIN1); bf16_t* Wt_out1 = (bf16_t*)(ws + WS_WOUT1);
    float* part1 = (float*)(ws + WS_PART1); float* ssb = (float*)(ws + WS_SS); float* decb = (float*)(ws + WS_DEC);
    bf16_t* XB = (bf16_t*)(ws + WS_XB); bf16_t* BA = (bf16_t*)(ws + WS_A); bf16_t* BB = (bf16_t*)(ws + WS_B); bf16_t* BC = (bf16_t*)(ws + WS_C);

    {
        PHASE_IDS
        LAS float* scr = (LAS float*)(lds + wave * 16384);
        constexpr int I_IN0 = (DM / 64) * (4096 / 32), I_GRP1 = (512 / 64) * (512 / 32), I_OUT = (DI / 64) * (DM / 32), I_IN1 = (DM / 64) * (8192 / 32);
        constexpr int NITEMS = I_IN0 + 4 * I_GRP1 + I_OUT + I_IN1 + I_OUT;
        auto decode = [&](int it) -> TItem {
            int r = it;
            if (r < I_IN0) return TItem{a.pool_w_in, Wt_in0, a.norm_g, nullptr, DM, 4096, 0, r}; r -= I_IN0;
            if (r < 4 * I_GRP1) { const int g = r / I_GRP1; return TItem{a.pool_w_grp + (size_t)g * 512 * 512, Wt_grp, nullptr, a.pool_scale + g * 512, 512, 512, g * 512, r % I_GRP1}; } r -= 4 * I_GRP1;
            if (r < I_OUT) return TItem{a.pool_w_out, Wt_out0, nullptr, nullptr, DI, DM, 0, r}; r -= I_OUT;
            if (r < I_IN1) {
                const int n0 = 32 * (r % (8192 / 32)); int d0 = n0;
                if (n0 < 2048) d0 = 256 * (n0 >> 7) + (n0 & 127); else if (n0 < 4096) d0 = 256 * ((n0 - 2048) >> 7) + 128 + (n0 & 127);
                return TItem{a.hgrn_w_in, Wt_in1, a.norm_g + DM, nullptr, DM, 8192, d0 - n0, r}; } r -= I_IN1;
            return TItem{a.hgrn_w_out, Wt_out1, a.hgrn_norm_g, nullptr, DI, DM, 0, r};
        };
        {
            float wa[32], wb[32]; TItem ia{}, ib{};
            int it = gw; bool ha = it < NITEMS;
            if (ha) { ia = decode(it); titem_issue(ia, lane, wa); }
            while (ha) {
                const int itb = it + NGW; const bool hb = itb < NITEMS;
                if (hb) { ib = decode(itb); titem_issue(ib, lane, wb); }
                titem_finish(ia, lane, wa, scr);
                it = itb + NGW; ha = it < NITEMS;
                if (ha) { ia = decode(it); titem_issue(ia, lane, wa); }
                if (!hb) break;
                titem_finish(ib, lane, wb, scr);
            }
        }
        for (int m0 = gw * 8; m0 < M; m0 += NGW * 8) {
            f32x4 v[8][4]; float s[8];
#pragma unroll
            for (int r = 0; r < 8; ++r) { const f32x4* xr = (const f32x4*)(a.x + (size_t)(m0 + r) * DM) + lane;
#pragma unroll
                for (int j = 0; j < 4; ++j) v[r][j] = xr[64 * j]; }
#pragma unroll
            for (int r = 0; r < 8; ++r) { s[r] = 0.f;
#pragma unroll
                for (int j = 0; j < 4; ++j) s[r] += (v[r][j][0] * v[r][j][0] + v[r][j][1] * v[r][j][1]) + (v[r][j][2] * v[r][j][2] + v[r][j][3] * v[r][j][3]); }
#pragma unroll
            for (int o = 1; o < 64; o <<= 1) {
#pragma unroll
                for (int r = 0; r < 8; ++r) s[r] += xor_get(s[r], lane, o); }
#pragma unroll
            for (int r = 0; r < 8; ++r) { const float rstd = 1.0f / sqrtf(s[r] * (1.0f / DM) + EPS);
                unsigned long long* o8 = (unsigned long long*)(XB + (size_t)(m0 + r) * DM) + lane;
#pragma unroll
                for (int j = 0; j < 4; ++j) o8[64 * j] = (unsigned long long)pkbf(v[r][j][0] * rstd, v[r][j][1] * rstd) | ((unsigned long long)pkbf(v[r][j][2] * rstd, v[r][j][3] * rstd) << 32); }
        }
    }
    GRID_BAR();

    {
        pg8::Gemm g{XB, Wt_in0, DM, DM, DM, 0}; pg8::StaticOrder S; S.init(M, 4096, G, bid);
        pg8::EpiP1 E{BA, BB};
        pg8::gemm_phase<pg8::EpiP1>(lds, g, S, E, wave);
    }
    GRID_BAR();

    {
        PHASE_IDS
        constexpr int RUN = 64;
        const int nruns = (M / RUN) * (DI / 8);
        for (int idx = bid * 512 + tid; idx < nruns; idx += G * 512) {
            const int cgp = idx & 255, run = idx >> 8, grp = cgp >> 6, w = 2 << grp;
            const int m0 = run * RUN, t0 = m0 & (SEQ - 1);
            const bf16_t* vp = BA + (size_t)m0 * DI + cgp * 8; bf16_t* pp = BC + (size_t)m0 * DI + cgp * 8;
            float sum[8];
#pragma unroll
            for (int j = 0; j < 8; ++j) sum[j] = 0.f;
            if (t0 > 0) for (int k = 1; k < w; ++k) { const u32x4 vv = *(const u32x4*)(vp - (size_t)k * DI);
                sum[0] += bf_lo(vv.x); sum[1] += bf_hi(vv.x); sum[2] += bf_lo(vv.y); sum[3] += bf_hi(vv.y); sum[4] += bf_lo(vv.z); sum[5] += bf_hi(vv.z); sum[6] += bf_lo(vv.w); sum[7] += bf_hi(vv.w); }
            for (int i0 = 0; i0 < RUN; i0 += 8) {
                u32x4 vin[8], vout[8];
#pragma unroll
                for (int j = 0; j < 8; ++j) vin[j] = *(const u32x4*)(vp + (size_t)(i0 + j) * DI);
#pragma unroll
                for (int j = 0; j < 8; ++j) { const int i = i0 + j; vout[j] = (t0 + i + 1 >= w) ? *(const u32x4*)(vp + (size_t)(i + 1 - w) * DI) : (u32x4){0u, 0u, 0u, 0u}; }
#pragma unroll
                for (int j = 0; j < 8; ++j) {
                    const int i = i0 + j, t = t0 + i;
                    const u32x4 vv = vin[j];
                    float x[8] = {bf_lo(vv.x), bf_hi(vv.x), bf_lo(vv.y), bf_hi(vv.y), bf_lo(vv.z), bf_hi(vv.z), bf_lo(vv.w), bf_hi(vv.w)};
#pragma unroll
                    for (int c = 0; c < 8; ++c) sum[c] += x[c];
                    const int cnt = (t + 1) < w ? (t + 1) : w; const float inv = 1.0f / (float)cnt;
                    u32x4 o; o.x = pkbf(sum[0] * inv - x[0], sum[1] * inv - x[1]); o.y = pkbf(sum[2] * inv - x[2], sum[3] * inv - x[3]);
                    o.z = pkbf(sum[4] * inv - x[4], sum[5] * inv - x[5]); o.w = pkbf(sum[6] * inv - x[6], sum[7] * inv - x[7]);
                    *(u32x4*)(pp + (size_t)i * DI) = o;
                    const u32x4 uu = vout[j];
                    sum[0] -= bf_lo(uu.x); sum[1] -= bf_hi(uu.x); sum[2] -= bf_lo(uu.y); sum[3] -= bf_hi(uu.y); sum[4] -= bf_lo(uu.z); sum[5] -= bf_hi(uu.z); sum[6] -= bf_lo(uu.w); sum[7] -= bf_hi(uu.w);
                }
            }
        }
    }
    GRID_BAR();

    {
        pg8::Gemm g{BC, Wt_grp, DI, 512, 512, 2}; pg8::StaticOrder S; S.init(M, DI, G, bid);
        pg8::EpiP2 E{BB};
        pg8::gemm_phase<pg8::EpiP2>(lds, g, S, E, wave);
    }
    GRID_BAR();

    {
        pg8::Gemm g{BB, Wt_out0, DI, DI, DI, 0}; pg8::StaticOrder S; S.init(M, DM, G, bid);
        pg8::EpiRes<true, false> E{a.x, nullptr, XB, part1};
        pg8::gemm_phase<pg8::EpiRes<true, false>>(lds, g, S, E, wave);
    }
    GRID_BAR();

    {
        pg8::Gemm g{XB, Wt_in1, DM, DM, DM, 0}; pg8::StaticOrder S; S.init(M, 6144, G, bid);
        pg8::EpiP4 E{BA, BB, BC, decb, part1, a.hgrn_lb};
        pg8::gemm_phase<pg8::EpiP4>(lds, g, S, E, wave);
    }
    GRID_BAR();

    scan::phase(lds, BA, BB, BC, decb, ssb, bid, G, wave);
    GRID_BAR();

    {
        pg8::Gemm g{XB, Wt_in1 + (size_t)6144 * DM, DM, DM, DM, 0}; pg8::StaticOrder S; S.init(M, DI, G, bid);
        pg8::EpiP5b E{BC, part1, ssb};
        pg8::gemm_phase<pg8::EpiP5b>(lds, g, S, E, wave);
    }
    GRID_BAR();

    {
        pg8::Gemm g{BC, Wt_out1, DI, DI, DI, 0}; pg8::StaticOrder S; S.init(M, DM, G, bid);
        pg8::EpiFinal E{XB, a.out, a.final_g, (float*)(ws + WS_X), (unsigned*)(ws + WS_CNT)};
        pg8::gemm_phase<pg8::EpiFinal>(lds, g, S, E, wave);
    }
}

extern "C" void kernel_launch(void* const* d_in, const int* in_sizes, int n_in, void* d_out, int out_size, void* d_ws, size_t ws_size, hipStream_t stream) {
    static int grid = 0;
    if (grid == 0) {
        if (n_in != 11 || in_sizes[0] != M * DM || out_size != M * DM || ws_size < WS_END) { fprintf(stderr, "kernel_launch: unexpected shapes (n_in %d in0 %d out %d ws %zu)\n", n_in, n_in > 0 ? in_sizes[0] : -1, out_size, ws_size); grid = -1; return; }
        int dev = 0, cus = 0, per = 0;
        if (hipGetDevice(&dev) != hipSuccess || hipDeviceGetAttribute(&cus, hipDeviceAttributeMultiprocessorCount, dev) != hipSuccess) { grid = -1; return; }
        if (hipFuncSetAttribute((const void*)fwd_kernel, hipFuncAttributeMaxDynamicSharedMemorySize, LDS_BYTES) != hipSuccess) { fprintf(stderr, "kernel_launch: hipFuncSetAttribute failed\n"); grid = -1; return; }
        if (hipOccupancyMaxActiveBlocksPerMultiprocessor(&per, (const void*)fwd_kernel, 512, LDS_BYTES) != hipSuccess || per < 1) { fprintf(stderr, "kernel_launch: occupancy query says %d\n", per); (void)hipGetLastError(); grid = -1; return; }
        grid = cus;
        fprintf(stderr, "kernel_launch: cus %d per_cu %d grid %d\n", cus, per, grid);
    }
    if (grid < 0) return;
    if (hipMemsetAsync(d_ws, 0, 32768, stream) != hipSuccess) { fprintf(stderr, "kernel_launch: hipMemsetAsync failed\n"); return; }
    Args a{};
    a.x = (const float*)d_in[0]; a.norm_g = (const float*)d_in[1]; a.pool_w_in = (const float*)d_in[2]; a.pool_w_grp = (const float*)d_in[3];
    a.pool_scale = (const float*)d_in[4]; a.pool_w_out = (const float*)d_in[5]; a.hgrn_w_in = (const float*)d_in[6]; a.hgrn_lb = (const float*)d_in[7];
    a.hgrn_norm_g = (const float*)d_in[8]; a.hgrn_w_out = (const float*)d_in[9]; a.final_g = (const float*)d_in[10];
    a.out = (float*)d_out; a.ws = (unsigned char*)d_ws;
    void* args[] = {&a};
    hipError_t e = hipLaunchCooperativeKernel((void*)fwd_kernel, dim3(grid), dim3(512), args, LDS_BYTES, stream);
    if (e != hipSuccess) fprintf(stderr, "kernel_launch: cooperative launch failed: %s (grid %d)\n", hipGetErrorString(e), grid);
}
```

```cpp
#include <hip/hip_runtime.h>
#include <cstdio>
#include <cstdint>

#define LAS __attribute__((address_space(3)))
typedef unsigned short bf16_t;
typedef short bf16x8 __attribute__((ext_vector_type(8)));
typedef float f32x4 __attribute__((ext_vector_type(4)));
typedef float f32x2 __attribute__((ext_vector_type(2)));
typedef unsigned u32x4 __attribute__((ext_vector_type(4)));
typedef unsigned u32x2 __attribute__((ext_vector_type(2)));

constexpr int DM = 1024, BATCH = 8, SEQ = 4096, DI = 2048, M = BATCH * SEQ;
constexpr int NHEAD = 16, HD = 128;
constexpr float EPS = 1e-6f;
constexpr size_t MiB = 1u << 20;
constexpr size_t WS_WIN0 = 2 * MiB;
constexpr size_t WS_WGRP = 10 * MiB;
constexpr size_t WS_WOUT0 = 12 * MiB;
constexpr size_t WS_WIN1 = 16 * MiB;
constexpr size_t WS_WOUT1 = 32 * MiB;
constexpr size_t WS_PART1 = 36 * MiB;
constexpr size_t WS_CNT = 16384;
constexpr size_t WS_X = 40 * MiB;
constexpr size_t WS_DEC = 44 * MiB;
constexpr size_t WS_SS = 112 * MiB;
constexpr size_t WS_XB = 48 * MiB;
constexpr size_t WS_A = 128 * MiB;
constexpr size_t WS_B = 256 * MiB;
constexpr size_t WS_C = 384 * MiB;
constexpr size_t WS_END = 512 * MiB;
constexpr int LDS_BYTES = 147456;

typedef __bf16 bf2_t __attribute__((ext_vector_type(2)));
__device__ __forceinline__ unsigned pkbf(float lo, float hi) { f32x2 v = {lo, hi}; return __builtin_bit_cast(unsigned, __builtin_convertvector(v, bf2_t)); }
__device__ __forceinline__ float bf_lo(unsigned w) { return __builtin_bit_cast(float, w << 16); }
__device__ __forceinline__ float bf_hi(unsigned w) { return __builtin_bit_cast(float, w & 0xffff0000u); }
__device__ __forceinline__ float silu_f(float x) { return x * __builtin_amdgcn_rcpf(1.0f + __builtin_amdgcn_exp2f(-1.44269504089f * x)); }
__device__ __forceinline__ float lane_get(float v, int src_lane) { return __builtin_bit_cast(float, __builtin_amdgcn_ds_bpermute(src_lane << 2, __builtin_bit_cast(int, v))); }
__device__ __forceinline__ float xor_get(float v, int lane, int m) { return lane_get(v, lane ^ m); }
__device__ __forceinline__ float wave_sum(float v, int lane) {
#pragma unroll
    for (int o = 1; o < 64; o <<= 1) v += xor_get(v, lane, o);
    return v;
}

namespace pg8 {
constexpr int BM = 256, BK = 64, HALF = 128, HTB = HALF * BK * 2, NXCD = 8, WGM = 4;
__host__ __device__ __forceinline__ int lds_byte(int r, int c) { const int st = (r >> 4) * 2 + (c >> 5), rr = r & 15, cc = c & 31, ob = rr * 64 + cc * 2; return st * 1024 + (ob ^ (((ob >> 9) & 1) << 5)); }
__host__ __device__ __forceinline__ void stage_rc(int b, int& R, int& C) { const int st = b / 1024, sb = b % 1024, swz = sb ^ (((sb >> 9) & 1) << 5); R = (st >> 1) * 16 + swz / 64; C = (st & 1) * 32 + (swz % 64) / 2; }
__host__ __device__ __forceinline__ int perm32(int rho) { const int n = rho >> 4, i = rho & 15; return 8 * (i >> 2) + 4 * n + (i & 3); }

struct Unit { int pm, pn; };
struct Gemm { const bf16_t* A; const bf16_t* Bt; int lda, ldb, K, grp_tiles; };

struct StaticOrder {
    int nM, nN, nwg, G, c;
    __host__ __device__ void init(int M_, int N_, int G_, int c_) { nM = M_ / BM; nN = N_ / BM; nwg = nM * nN; G = G_; c = c_; }
    __host__ __device__ bool next(int i, Unit& u) const {
        const long L = (long)i * G + c; if (L >= nwg) return false;
        int wgid = (int)L; { const int q = nwg / NXCD, r = nwg % NXCD, xcd = wgid % NXCD, off = wgid / NXCD; wgid = (xcd < r ? xcd * (q + 1) : r * (q + 1) + (xcd - r) * q) + off; }
        const int nig = WGM * nN, gid = wgid / nig, fm = gid * WGM, gsz = (nM - fm) < WGM ? (nM - fm) : WGM;
        u.pm = fm + ((wgid % nig) % gsz); u.pn = (wgid % nig) / gsz; return true;
    }
};


__device__ __forceinline__ void zero_acc(f32x4 (&acc)[2][2][4][2]) {
#pragma unroll
    for (int a = 0; a < 2; ++a)
#pragma unroll
        for (int b = 0; b < 2; ++b)
#pragma unroll
            for (int m = 0; m < 4; ++m)
#pragma unroll
                for (int n = 0; n < 2; ++n) acc[a][b][m][n] = (f32x4){0.f, 0.f, 0.f, 0.f};
}
template <class Epi, bool ALIGN_EPI = true, bool SP2 = true>
__device__ __forceinline__ void gemm_phase(LAS unsigned char* lds, const Gemm g, const StaticOrder& S, const Epi& E, const int wid) {
    int lane_ = (int)__builtin_amdgcn_mbcnt_hi(~0u, __builtin_amdgcn_mbcnt_lo(~0u, 0u)); asm volatile("" : "+v"(lane_));
    int lane = lane_, tid = wid * 64 + lane, fr = lane & 15, fq = lane >> 4; const int wr = wid >> 2, wc = wid & 3;
    const int K = g.K, nt = K / BK;
    unsigned voffA[2], voffB[2]; int aoff, boff;
#define PG8_LANE_STATE() do { _Pragma("unroll") for (int i = 0; i < 2; ++i) { int R, C; stage_rc(tid * 16 + i * 8192, R, C); const int Rb = Epi::PERM ? ((R & ~31) + perm32(R & 31)) : R; \
        voffA[i] = (unsigned)(R * g.lda + C) * 2u; voffB[i] = (unsigned)(Rb * g.ldb + C) * 2u; } \
        aoff = lds_byte(wr * 64 + fr, fq * 8); boff = lds_byte(wc * 32 + fr, fq * 8); } while (0)
    PG8_LANE_STATE();
    const size_t kstep = (size_t)(BK * 2);
    const size_t hstepA = (size_t)HALF * g.lda * 2, hstepB = (size_t)HALF * g.ldb * 2;
    const size_t tstepA = 2 * hstepA, tstepB = 2 * hstepB;
    const unsigned ldsw = (unsigned)wid * 1024u;
#define PG8_SA(b, h) (((b) * 2 + (h)) * HTB)
#define PG8_SB(b, h) ((4 + (b) * 2 + (h)) * HTB)
#define PG8_STAGE(bufoff, gbase, voff) do { _Pragma("unroll") for (int _i = 0; _i < 2; ++_i) \
        __builtin_amdgcn_global_load_lds((const unsigned*)((const char*)(gbase) + (voff)[_i]), (LAS unsigned*)(lds + (bufoff) + ldsw + _i * 8192), 16, 0, 0); } while (0)
#define PG8_LDA(dst, b, h) do { _Pragma("unroll") for (int m = 0; m < 4; ++m) _Pragma("unroll") for (int k = 0; k < 2; ++k) dst[m][k] = *(const LAS bf16x8*)(lds + PG8_SA(b, h) + aoff + m * 2048 + k * 1024); } while (0)
#define PG8_LDB(dst, b, h) do { _Pragma("unroll") for (int n = 0; n < 2; ++n) _Pragma("unroll") for (int k = 0; k < 2; ++k) dst[n][k] = *(const LAS bf16x8*)(lds + PG8_SB(b, h) + boff + n * 2048 + k * 1024); } while (0)
#define PG8_MMA(ai, bj, At, Bt) do { __builtin_amdgcn_s_setprio(1); _Pragma("unroll") for (int m = 0; m < 4; ++m) _Pragma("unroll") for (int n = 0; n < 2; ++n) _Pragma("unroll") for (int k = 0; k < 2; ++k) \
        acc[ai][bj][m][n] = __builtin_amdgcn_mfma_f32_16x16x32_bf16(Bt[n][k], At[m][k], acc[ai][bj][m][n], 0, 0, 0); __builtin_amdgcn_s_setprio(0); } while (0)
#define PG8_WAIT_V(n) asm volatile("s_waitcnt vmcnt(" #n ")" ::: "memory")
#define PG8_WAIT_L(n) asm volatile("s_waitcnt lgkmcnt(" #n ")" ::: "memory")
#define PG8_BAR __builtin_amdgcn_s_barrier()
#define PG8_SCHED __builtin_amdgcn_sched_barrier(0)
#define PG8_ABASE(u) ((const char*)g.A + (size_t)(u).pm * tstepA + (g.grp_tiles ? (size_t)((u).pn / g.grp_tiles) * (size_t)K * 2 : (size_t)0))
#define PG8_BBASE(u) ((const char*)g.Bt + (size_t)(u).pn * tstepB)
    Unit cur, nxt; int ui = 0;
    E.prologue(S, lds, tid);
    if (!S.next(0, cur)) return;
    f32x4 acc[2][2][4][2];
    E.init_acc(acc, cur, wr, wc, fr, fq);
    bf16x8 At[4][2], B0[2][2], B1[2][2];
    const char* cA = PG8_ABASE(cur); const char* cB = PG8_BBASE(cur);
    if constexpr (SP2) {
        PG8_STAGE(PG8_SB(0, 0), cB, voffB); PG8_STAGE(PG8_SB(0, 1), cB + hstepB, voffB); PG8_STAGE(PG8_SA(0, 0), cA, voffA); PG8_STAGE(PG8_SA(0, 1), cA + hstepA, voffA);
        if (wr == 1) PG8_BAR;
        PG8_WAIT_V(2); PG8_BAR;
        PG8_STAGE(PG8_SB(1, 0), cB + kstep, voffB); PG8_STAGE(PG8_SA(1, 0), cA + kstep, voffA); PG8_STAGE(PG8_SB(1, 1), cB + hstepB + kstep, voffB);
        PG8_WAIT_V(6); PG8_BAR;
    } else {
        PG8_STAGE(PG8_SB(0, 0), cB, voffB); PG8_STAGE(PG8_SA(0, 0), cA, voffA); PG8_STAGE(PG8_SB(0, 1), cB + hstepB, voffB); PG8_STAGE(PG8_SA(0, 1), cA + hstepA, voffA);
        if (wr == 1) PG8_BAR;
        PG8_WAIT_V(4); PG8_BAR;
        PG8_STAGE(PG8_SB(1, 0), cB + kstep, voffB); PG8_STAGE(PG8_SA(1, 0), cA + kstep, voffA); PG8_STAGE(PG8_SB(1, 1), cB + hstepB + kstep, voffB);
        PG8_WAIT_V(6); PG8_BAR;
    }
    for (;;) {
        const bool has_next = S.next(ui + 1, nxt);
        const char* nA = has_next ? PG8_ABASE(nxt) : cA; const char* nB = has_next ? PG8_BBASE(nxt) : cB;
        for (int t = 0; t < nt; t += 2) {
            const bool last = (t == nt - 2);
            const char* a1 = cA + (size_t)(t + 1) * kstep;
            const char* a2 = last ? nA : cA + (size_t)(t + 2) * kstep; const char* b2 = last ? nB : cB + (size_t)(t + 2) * kstep;
            const char* a3 = a2 + kstep; const char* b3 = b2 + kstep;
            if constexpr (SP2) {
            PG8_LDB(B0, 0, 0); PG8_LDB(B1, 0, 1); PG8_SCHED; PG8_LDA(At, 0, 0); PG8_STAGE(PG8_SA(1, 1), a1 + hstepA, voffA);
            PG8_WAIT_V(8); PG8_WAIT_L(0); PG8_BAR; PG8_MMA(0, 0, At, B0); PG8_MMA(0, 1, At, B1); PG8_BAR; PG8_SCHED;
            PG8_LDA(At, 0, 1); PG8_STAGE(PG8_SB(0, 0), b2, voffB); PG8_STAGE(PG8_SB(0, 1), b2 + hstepB, voffB); PG8_STAGE(PG8_SA(0, 0), a2, voffA);
            PG8_WAIT_V(8); PG8_WAIT_L(0); PG8_BAR; PG8_MMA(1, 0, At, B0); PG8_MMA(1, 1, At, B1); PG8_BAR; PG8_SCHED;
            PG8_LDB(B0, 1, 0); PG8_LDB(B1, 1, 1); PG8_SCHED; PG8_LDA(At, 1, 0); PG8_STAGE(PG8_SA(0, 1), a2 + hstepA, voffA);
            PG8_WAIT_V(8); PG8_WAIT_L(0); PG8_BAR; PG8_MMA(0, 0, At, B0); PG8_MMA(0, 1, At, B1); PG8_BAR; PG8_SCHED;
            PG8_LDA(At, 1, 1); PG8_STAGE(PG8_SB(1, 0), b3, voffB); PG8_STAGE(PG8_SB(1, 1), b3 + hstepB, voffB); PG8_STAGE(PG8_SA(1, 0), a3, voffA);
            PG8_WAIT_V(8); PG8_WAIT_L(0); PG8_BAR; PG8_MMA(1, 0, At, B0); PG8_MMA(1, 1, At, B1); PG8_BAR; PG8_SCHED;
            } else {
            PG8_LDB(B0, 0, 0); PG8_SCHED; PG8_LDA(At, 0, 0); PG8_STAGE(PG8_SA(1, 1), a1 + hstepA, voffA);
            PG8_WAIT_L(8); PG8_BAR; PG8_WAIT_L(0); PG8_MMA(0, 0, At, B0); PG8_BAR; PG8_SCHED;
            PG8_LDB(B1, 0, 1); PG8_STAGE(PG8_SB(0, 0), b2, voffB);
            PG8_BAR; PG8_WAIT_L(0); PG8_MMA(0, 1, At, B1); PG8_BAR;
            PG8_LDA(At, 0, 1); PG8_STAGE(PG8_SA(0, 0), a2, voffA);
            PG8_BAR; PG8_WAIT_L(0); PG8_MMA(1, 0, At, B0); PG8_BAR; PG8_SCHED;
            PG8_STAGE(PG8_SB(0, 1), b2 + hstepB, voffB);
            PG8_WAIT_V(6); PG8_BAR; PG8_MMA(1, 1, At, B1); PG8_BAR;
            PG8_LDB(B0, 1, 0); PG8_SCHED; PG8_LDA(At, 1, 0); PG8_STAGE(PG8_SA(0, 1), a2 + hstepA, voffA);
            PG8_WAIT_L(8); PG8_BAR; PG8_WAIT_L(0); PG8_MMA(0, 0, At, B0); PG8_BAR; PG8_SCHED;
            PG8_LDB(B1, 1, 1); PG8_STAGE(PG8_SB(1, 0), b3, voffB);
            PG8_BAR; PG8_WAIT_L(0); PG8_MMA(0, 1, At, B1); PG8_BAR;
            PG8_LDA(At, 1, 1); PG8_STAGE(PG8_SA(1, 0), a3, voffA);
            PG8_BAR; PG8_WAIT_L(0); PG8_MMA(1, 0, At, B0); PG8_BAR; PG8_SCHED;
            PG8_STAGE(PG8_SB(1, 1), b3 + hstepB, voffB);
            PG8_WAIT_V(6); PG8_BAR; PG8_MMA(1, 1, At, B1); PG8_BAR;
            }
        }
        if constexpr (ALIGN_EPI) { if (wr == 0) PG8_BAR; }
        if constexpr (!Epi::AFTER_DRAIN) E(acc, cur, wr, wc, fr, fq, lds, ui);
        if (!has_next) break;
        cur = nxt; cA = nA; cB = nB; ++ui;
        asm volatile("" : "+v"(lane)); tid = wid * 64 + lane; fr = lane & 15; fq = lane >> 4; PG8_LANE_STATE();
        E.init_acc(acc, cur, wr, wc, fr, fq);
        if constexpr (ALIGN_EPI) { if (wr == 1) PG8_BAR; }
    }
    PG8_WAIT_V(0);
    if constexpr (!ALIGN_EPI) { if (wr == 0) PG8_BAR; }
    PG8_BAR;
    if constexpr (Epi::AFTER_DRAIN) E.fused(acc, cur, wr, wc, fr, fq, lds, tid);
#undef PG8_SA
#undef PG8_SB
#undef PG8_STAGE
#undef PG8_LDA
#undef PG8_LDB
#undef PG8_MMA
#undef PG8_WAIT_V
#undef PG8_WAIT_L
#undef PG8_BAR
#undef PG8_SCHED
#undef PG8_ABASE
#undef PG8_LANE_STATE
#undef PG8_BBASE
}

struct EpiP1 {
    static constexpr bool PERM = true, AFTER_DRAIN = false;
    __device__ __forceinline__ void init_acc(f32x4 (&acc)[2][2][4][2], const Unit&, int, int, int, int) const { zero_acc(acc); }
    __device__ __forceinline__ void prologue(const StaticOrder&, LAS unsigned char*, int) const {}
    bf16_t* V; bf16_t* SG;
    __device__ __forceinline__ void operator()(f32x4 (&acc)[2][2][4][2], const Unit& u, int wr, int wc, int fr, int fq, LAS unsigned char* lds, int ui) const {
        const int row0 = u.pm * BM + wr * 64 + fr; const bool gate = u.pn >= 8;
        bf16_t* base = gate ? SG : V; const int col0 = (u.pn & 7) * BM + wc * 32 + 8 * fq;
#pragma unroll
        for (int ai = 0; ai < 2; ++ai)
#pragma unroll
            for (int m = 0; m < 4; ++m) { bf16_t* rowp = base + (size_t)(row0 + ai * HALF + m * 16) * DI + col0;
#pragma unroll
                for (int bj = 0; bj < 2; ++bj) { f32x4 v0 = acc[ai][bj][m][0], v1 = acc[ai][bj][m][1];
                    if (gate) {
#pragma unroll
                        for (int j = 0; j < 4; ++j) { v0[j] = silu_f(v0[j]); v1[j] = silu_f(v1[j]); } }
                    u32x4 w; w.x = pkbf(v0[0], v0[1]); w.y = pkbf(v0[2], v0[3]); w.z = pkbf(v1[0], v1[1]); w.w = pkbf(v1[2], v1[3]);
                    *(u32x4*)(rowp + bj * HALF) = w; } }
    }
};
struct EpiP2 {
    static constexpr bool PERM = true, AFTER_DRAIN = false;
    __device__ __forceinline__ void init_acc(f32x4 (&acc)[2][2][4][2], const Unit&, int, int, int, int) const { zero_acc(acc); }
    __device__ __forceinline__ void prologue(const StaticOrder&, LAS unsigned char*, int) const {}
    bf16_t* Z;
    __device__ __forceinline__ void operator()(f32x4 (&acc)[2][2][4][2], const Unit& u, int wr, int wc, int fr, int fq, LAS unsigned char* lds, int ui) const {
        const unsigned row0 = (unsigned)(u.pm * BM + wr * 64 + fr), col0 = (unsigned)(u.pn * BM + wc * 32 + 8 * fq);
        const unsigned zofs = (row0 * DI + col0) * 2u;
#pragma unroll
        for (int ai = 0; ai < 2; ++ai) {
            u32x4 sv[4][2];
#pragma unroll
            for (int m = 0; m < 4; ++m)
#pragma unroll
                for (int bj = 0; bj < 2; ++bj) sv[m][bj] = *(const u32x4*)((const char*)Z + (zofs + (unsigned)((ai * HALF + m * 16) * DI + bj * HALF) * 2u));
#pragma unroll
            for (int m = 0; m < 4; ++m)
#pragma unroll
                for (int bj = 0; bj < 2; ++bj) { const f32x4 v0 = acc[ai][bj][m][0], v1 = acc[ai][bj][m][1]; const u32x4 s = sv[m][bj];
                    u32x4 w; w.x = pkbf(v0[0] * bf_lo(s.x), v0[1] * bf_hi(s.x)); w.y = pkbf(v0[2] * bf_lo(s.y), v0[3] * bf_hi(s.y));
                    w.z = pkbf(v1[0] * bf_lo(s.z), v1[1] * bf_hi(s.z)); w.w = pkbf(v1[2] * bf_lo(s.w), v1[3] * bf_hi(s.w));
                    *(u32x4*)((char*)Z + (zofs + (unsigned)((ai * HALF + m * 16) * DI + bj * HALF) * 2u)) = w; }
            asm volatile("" ::: "memory"); }
    }
};
template <bool WRITE_HB, bool WRITE_H = true> struct EpiRes {
    static constexpr bool PERM = true, AFTER_DRAIN = false;
    __device__ __forceinline__ void prologue(const StaticOrder&, LAS unsigned char*, int) const {}
    const float* R; float* H; bf16_t* HB; float* part;
    __device__ __forceinline__ void init_acc(f32x4 (&acc)[2][2][4][2], const Unit& u, int wr, int wc, int fr, int fq) const {
        const unsigned row0 = (unsigned)(u.pm * BM + wr * 64 + fr), col0 = (unsigned)(u.pn * BM + wc * 32 + 8 * fq);
        const unsigned ofs = (row0 * DM + col0) * 4u;
#pragma unroll
        for (int ai = 0; ai < 2; ++ai)
#pragma unroll
            for (int bj = 0; bj < 2; ++bj)
#pragma unroll
                for (int m = 0; m < 4; ++m)
#pragma unroll
                    for (int n = 0; n < 2; ++n) acc[ai][bj][m][n] = *(const f32x4*)((const char*)R + (ofs + (unsigned)((ai * HALF + m * 16) * DM + bj * HALF + n * 4) * 4u));
    }
    __device__ __forceinline__ void operator()(f32x4 (&acc)[2][2][4][2], const Unit& u, int wr, int wc, int fr, int fq, LAS unsigned char* lds, int ui) const {
        const unsigned row0 = (unsigned)(u.pm * BM + wr * 64 + fr), col0 = (unsigned)(u.pn * BM + wc * 32 + 8 * fq);
        const unsigned ofs = (row0 * DM + col0) * 4u, pofs = (row0 * 16u + (unsigned)(u.pn * 4 + wc)) * 4u;
#pragma unroll
        for (int ai = 0; ai < 2; ++ai)
#pragma unroll
            for (int m = 0; m < 4; ++m) { const unsigned o = ofs + (unsigned)((ai * HALF + m * 16) * DM) * 4u; float ss = 0.f;
#pragma unroll
                for (int bj = 0; bj < 2; ++bj) { const unsigned oo = o + (unsigned)(bj * HALF) * 4u; const f32x4 h0 = acc[ai][bj][m][0], h1 = acc[ai][bj][m][1];
                    if (WRITE_H) { *(f32x4*)((char*)H + oo) = h0; *(f32x4*)((char*)H + oo + 16u) = h1; }
                    ss += ((h0[0] * h0[0] + h0[1] * h0[1]) + (h0[2] * h0[2] + h0[3] * h0[3])) + ((h1[0] * h1[0] + h1[1] * h1[1]) + (h1[2] * h1[2] + h1[3] * h1[3]));
                    if (WRITE_HB) { u32x4 w; w.x = pkbf(h0[0], h0[1]); w.y = pkbf(h0[2], h0[3]); w.z = pkbf(h1[0], h1[1]); w.w = pkbf(h1[2], h1[3]); *(u32x4*)((char*)HB + (oo >> 1)) = w; } }
                ss += xor_get(ss, fq * 16 + fr, 16); ss += xor_get(ss, fq * 16 + fr, 32);
                if (fq == 0) *(float*)((char*)part + (pofs + (unsigned)(ai * HALF + m * 16) * 64u)) = ss; }
    }
};
__device__ __forceinline__ float row_rstd_b(const float* part, unsigned bofs) {
    const f32x4* p = (const f32x4*)((const char*)part + bofs); const f32x4 a = p[0], b = p[1], c = p[2], d = p[3];
    return __builtin_amdgcn_rsqf((((a[0] + a[1]) + (a[2] + a[3])) + ((b[0] + b[1]) + (b[2] + b[3])) + ((c[0] + c[1]) + (c[2] + c[3])) + ((d[0] + d[1]) + (d[2] + d[3]))) * (1.0f / DM) + EPS);
}
__device__ __forceinline__ float dpp_shr_mul(float v, const int n) {
    const int iv = __builtin_bit_cast(int, v), one = 0x3f800000; int r;
    if (n == 1) r = __builtin_amdgcn_update_dpp(one, iv, 0x111, 0xf, 0xf, false); else if (n == 2) r = __builtin_amdgcn_update_dpp(one, iv, 0x112, 0xf, 0xf, false);
    else if (n == 4) r = __builtin_amdgcn_update_dpp(one, iv, 0x114, 0xf, 0xf, false); else r = __builtin_amdgcn_update_dpp(one, iv, 0x118, 0xf, 0xf, false);
    return v * __builtin_bit_cast(float, r);
}
constexpr unsigned TAB_OFF = 131072u + 256u;
struct EpiP4 {
    static constexpr bool PERM = true, AFTER_DRAIN = false;
    __device__ __forceinline__ void init_acc(f32x4 (&acc)[2][2][4][2], const Unit&, int, int, int, int) const { zero_acc(acc); }
    bf16_t* Qt; bf16_t* Kt; bf16_t* V; float* DEC; const float* part; const float* lbnd;
    __device__ __forceinline__ void prologue(const StaticOrder& S, LAS unsigned char* lds, int tid) const {
        LAS float* T = (LAS float*)(lds + TAB_OFF); Unit u;
        for (int i = 0; i < 12 && S.next(i, u); ++i)
            if (tid < 256) T[i * 256 + tid] = row_rstd_b(part, (unsigned)(u.pm * BM + tid) * 64u);
        __syncthreads();
    }
    __device__ __forceinline__ void operator()(f32x4 (&acc)[2][2][4][2], const Unit& u, int wr, int wc, int fr, int fq, LAS unsigned char* lds, int ui) const {
        const unsigned row0 = (unsigned)(u.pm * BM + wr * 64 + fr);
        const LAS float* T = (const LAS float*)(lds + TAB_OFF) + ui * 256 + wr * 64 + fr;
        if (u.pn >= 16) {
            const unsigned vofs = (row0 * DI + (unsigned)((u.pn - 16) * BM + wc * 32 + 8 * fq)) * 2u;
#pragma unroll
            for (int ai = 0; ai < 2; ++ai)
#pragma unroll
                for (int m = 0; m < 4; ++m) { const float rs = T[ai * HALF + m * 16];
#pragma unroll
                    for (int bj = 0; bj < 2; ++bj) { const f32x4 v0 = acc[ai][bj][m][0] * rs, v1 = acc[ai][bj][m][1] * rs;
                        u32x4 w; w.x = pkbf(v0[0], v0[1]); w.y = pkbf(v0[2], v0[3]); w.z = pkbf(v1[0], v1[1]); w.w = pkbf(v1[2], v1[3]);
                        *(u32x4*)((char*)V + (vofs + (unsigned)((ai * HALF + m * 16) * DI + bj * HALF) * 2u)) = w; } }
            return;
        }
        const unsigned c0 = (unsigned)(u.pn * HD + wc * 32 + 8 * fq);
        const unsigned qofs = (row0 * DI + c0) * 2u;
#pragma unroll
        for (int ai = 0; ai < 2; ++ai) {
            float rs[4];
#pragma unroll
            for (int m = 0; m < 4; ++m) rs[m] = T[ai * HALF + m * 16];
            unsigned cc = c0; asm volatile("" : "+v"(cc));
#pragma unroll
            for (int n = 0; n < 2; ++n) {
                const f32x4 l0 = *(const f32x4*)((const char*)lbnd + (cc + 4 * n) * 4u), l1 = *(const f32x4*)((const char*)lbnd + (cc + 4 * n + DI) * 4u);
                f32x4 decv;
#pragma unroll
                for (int j = 0; j < 4; ++j) { const float ex = __expf(l0[j] - l1[j]); const float lb = __builtin_amdgcn_rcpf(1.0f + ex), omlb = ex * lb; float bprod = 1.0f;
#pragma unroll
                    for (int m = 0; m < 4; ++m) {
                        const float qv = acc[ai][0][m][n][j] * rs[m], z = acc[ai][1][m][n][j] * rs[m];
                        const float sg = __builtin_amdgcn_rcpf(1.0f + __builtin_amdgcn_exp2f(-1.44269504089f * z));
                        const float f = lb + omlb * sg, k = omlb * (1.0f - sg);
                        float s = f; s = dpp_shr_mul(s, 1); s = dpp_shr_mul(s, 2); s = dpp_shr_mul(s, 4); s = dpp_shr_mul(s, 8);
                        const float E = bprod * s;
                        if (m < 3) bprod *= lane_get(s, fq * 16 + 15);
                        const float Ei = __builtin_amdgcn_rcpf(fmaxf(E, 7.9e-31f));
                        acc[ai][0][m][n][j] = qv * E; acc[ai][1][m][n][j] = k * Ei;
                        if (m == 3) decv[j] = E;
                    } }
                if (fr == 15) *(f32x4*)((char*)DEC + ((unsigned)(u.pm * 4 + ai * 2 + wr) * DI + cc + 4 * n) * 4u) = decv;
            }
#pragma unroll
            for (int m = 0; m < 4; ++m) { const unsigned ob = qofs + (unsigned)((ai * HALF + m * 16) * DI) * 2u;
                u32x4 w; w.x = pkbf(acc[ai][0][m][0][0], acc[ai][0][m][0][1]); w.y = pkbf(acc[ai][0][m][0][2], acc[ai][0][m][0][3]); w.z = pkbf(acc[ai][0][m][1][0], acc[ai][0][m][1][1]); w.w = pkbf(acc[ai][0][m][1][2], acc[ai][0][m][1][3]);
                *(u32x4*)((char*)Qt + ob) = w;
                u32x4 x; x.x = pkbf(acc[ai][1][m][0][0], acc[ai][1][m][0][1]); x.y = pkbf(acc[ai][1][m][0][2], acc[ai][1][m][0][3]); x.z = pkbf(acc[ai][1][m][1][0], acc[ai][1][m][1][1]); x.w = pkbf(acc[ai][1][m][1][2], acc[ai][1][m][1][3]);
                *(u32x4*)((char*)Kt + ob) = x; }
            asm volatile("" ::: "memory");
        }
    }
};
struct EpiP5b {
    static constexpr bool PERM = true, AFTER_DRAIN = false;
    __device__ __forceinline__ void init_acc(f32x4 (&acc)[2][2][4][2], const Unit&, int, int, int, int) const { zero_acc(acc); }
    bf16_t* O; const float* part; const float* ss;
    __device__ __forceinline__ void prologue(const StaticOrder& S, LAS unsigned char* lds, int tid) const {
        LAS float* T = (LAS float*)(lds + TAB_OFF); Unit u;
        for (int i = 0; i < 4 && S.next(i, u); ++i) {
            if (tid < 256) T[i * 768 + tid] = row_rstd_b(part, (unsigned)(u.pm * BM + tid) * 64u);
            { const int r = tid >> 1, hh = tid & 1; const f32x4* sp = (const f32x4*)(ss + (size_t)(u.pm * BM + r) * 128 + (u.pn * 2 + hh) * 8); const f32x4 s0 = sp[0], s1 = sp[1];
              T[i * 768 + 256 + tid] = __builtin_amdgcn_rsqf((((s0[0] + s0[1]) + (s0[2] + s0[3])) + ((s1[0] + s1[1]) + (s1[2] + s1[3]))) * (1.0f / HD) + EPS); }
        }
        __syncthreads();
    }
    __device__ __forceinline__ void operator()(f32x4 (&acc)[2][2][4][2], const Unit& u, int wr, int wc, int fr, int fq, LAS unsigned char* lds, int ui) const {
        const unsigned row0 = (unsigned)(u.pm * BM + wr * 64 + fr), col0 = (unsigned)(u.pn * BM + wc * 32 + 8 * fq);
        const LAS float* T = (const LAS float*)(lds + TAB_OFF) + ui * 768 + wr * 64 + fr;
        const unsigned oofs = (row0 * DI + col0) * 2u;
#pragma unroll
        for (int ai = 0; ai < 2; ++ai) {
            u32x4 ov[4][2];
#pragma unroll
            for (int m = 0; m < 4; ++m)
#pragma unroll
                for (int bj = 0; bj < 2; ++bj) ov[m][bj] = *(const u32x4*)((const char*)O + (oofs + (unsigned)((ai * HALF + m * 16) * DI + bj * HALF) * 2u));
#pragma unroll
            for (int m = 0; m < 4; ++m) { const int rl = ai * HALF + m * 16; const float rs = T[rl];
#pragma unroll
                for (int bj = 0; bj < 2; ++bj) { const f32x4 v0 = acc[ai][bj][m][0] * rs, v1 = acc[ai][bj][m][1] * rs;
                    const float rh = T[256 + 2 * rl + bj + (wr * 64 + fr)];
                    const u32x4 s = ov[m][bj];
                    u32x4 w; w.x = pkbf(bf_lo(s.x) * rh * silu_f(v0[0]), bf_hi(s.x) * rh * silu_f(v0[1])); w.y = pkbf(bf_lo(s.y) * rh * silu_f(v0[2]), bf_hi(s.y) * rh * silu_f(v0[3]));
                    w.z = pkbf(bf_lo(s.z) * rh * silu_f(v1[0]), bf_hi(s.z) * rh * silu_f(v1[1])); w.w = pkbf(bf_lo(s.w) * rh * silu_f(v1[2]), bf_hi(s.w) * rh * silu_f(v1[3]));
                    *(u32x4*)((char*)O + (oofs + (unsigned)((ai * HALF + m * 16) * DI + bj * HALF) * 2u)) = w; } }
            asm volatile("" ::: "memory"); }
    }
};
struct EpiFinal {
    static constexpr bool PERM = true, AFTER_DRAIN = false;
    __device__ __forceinline__ void init_acc(f32x4 (&acc)[2][2][4][2], const Unit&, int, int, int, int) const { zero_acc(acc); }
    const bf16_t* HB; float* H; const float* fg; float* X; unsigned* cnt;
    __device__ __forceinline__ void prologue(const StaticOrder&, LAS unsigned char*, int) const {}
    __device__ __forceinline__ void operator()(f32x4 (&acc)[2][2][4][2], const Unit& u, int wr, int wc, int fr, int fq, LAS unsigned char* lds, int ui) const {
        LAS float* Pt = (LAS float*)(lds + TAB_OFF);
        LAS float* St = Pt + 1024;
        const int tid = (wr * 4 + wc) * 64 + fq * 16 + fr;
        const unsigned row0 = (unsigned)(u.pm * BM + wr * 64 + fr), col0 = (unsigned)(u.pn * BM + wc * 32 + 8 * fq);
        const unsigned ofs = (row0 * DM + col0) * 4u;
#pragma unroll
        for (int ai = 0; ai < 2; ++ai) {
            u32x4 hv[4][2];
#pragma unroll
            for (int m = 0; m < 4; ++m)
#pragma unroll
                for (int bj = 0; bj < 2; ++bj) hv[m][bj] = *(const u32x4*)((const char*)HB + ((ofs + (unsigned)((ai * HALF + m * 16) * DM + bj * HALF) * 4u) >> 1));
#pragma unroll
            for (int m = 0; m < 4; ++m) { float ss = 0.f;
#pragma unroll
                for (int bj = 0; bj < 2; ++bj) { const u32x4 hb = hv[m][bj];
                    const f32x4 h0 = acc[ai][bj][m][0] + (f32x4){bf_lo(hb.x), bf_hi(hb.x), bf_lo(hb.y), bf_hi(hb.y)}, h1 = acc[ai][bj][m][1] + (f32x4){bf_lo(hb.z), bf_hi(hb.z), bf_lo(hb.w), bf_hi(hb.w)};
                    acc[ai][bj][m][0] = h0; acc[ai][bj][m][1] = h1;
                    ss += ((h0[0] * h0[0] + h0[1] * h0[1]) + (h0[2] * h0[2] + h0[3] * h0[3])) + ((h1[0] * h1[0] + h1[1] * h1[1]) + (h1[2] * h1[2] + h1[3] * h1[3])); }
                ss += xor_get(ss, fq * 16 + fr, 16); ss += xor_get(ss, fq * 16 + fr, 32);
                if (fq == 0) Pt[(ai * HALF + wr * 64 + m * 16 + fr) * 4 + wc] = ss; }
            asm volatile("" ::: "memory"); }
        __syncthreads();
        float* xs = X + (size_t)u.pm * 1024;
        if (tid < 256) { const f32x4 p = *(const LAS f32x4*)(Pt + tid * 4);
            __hip_atomic_store(xs + u.pn * 256 + tid, (p[0] + p[1]) + (p[2] + p[3]), __ATOMIC_RELAXED, __HIP_MEMORY_SCOPE_AGENT); }
        asm volatile("s_waitcnt vmcnt(0)" ::: "memory");
        __syncthreads();
        if (tid == 0) {
            unsigned* c = cnt + 16 * u.pm;
            __hip_atomic_fetch_add(c, 1u, __ATOMIC_RELAXED, __HIP_MEMORY_SCOPE_AGENT);
            unsigned spins = 0;
            while (__hip_atomic_load(c, __ATOMIC_RELAXED, __HIP_MEMORY_SCOPE_AGENT) < 4u) { __builtin_amdgcn_s_sleep(2); if (++spins > (1u << 22)) break; }
            __builtin_amdgcn_fence(__ATOMIC_ACQUIRE, "agent");
            asm volatile("s_waitcnt vmcnt(0)" ::: "memory");
        }
        __syncthreads();
        if (tid < 256) { float s = 0.f;
#pragma unroll
            for (int t = 0; t < 4; ++t) s += __hip_atomic_load(xs + t * 256 + tid, __ATOMIC_RELAXED, __HIP_MEMORY_SCOPE_AGENT);
            St[tid] = __builtin_amdgcn_rsqf(s * (1.0f / DM) + EPS); }
        __syncthreads();
        f32x4 gv[2][2];
#pragma unroll
        for (int bj = 0; bj < 2; ++bj)
#pragma unroll
            for (int n = 0; n < 2; ++n) gv[bj][n] = *(const f32x4*)(fg + col0 + bj * HALF + n * 4);
#pragma unroll
        for (int ai = 0; ai < 2; ++ai)
#pragma unroll
            for (int m = 0; m < 4; ++m) { const float rs = St[ai * HALF + wr * 64 + m * 16 + fr];
#pragma unroll
                for (int bj = 0; bj < 2; ++bj) { const unsigned oo = ofs + (unsigned)((ai * HALF + m * 16) * DM + bj * HALF) * 4u;
                    *(f32x4*)((char*)H + oo) = acc[ai][bj][m][0] * rs * gv[bj][0]; *(f32x4*)((char*)H + oo + 16u) = acc[ai][bj][m][1] * rs * gv[bj][1]; } }
        __syncthreads();
    }
};
}

namespace scan {
#define MFMA16(a, b, c) __builtin_amdgcn_mfma_f32_16x16x32_bf16((a), (b), (c), 0, 0, 0)
__device__ __forceinline__ unsigned offb(unsigned row, unsigned ch) { return 256u * row + 16u * (ch ^ (((row & 3u) << 2) | ((row >> 2) & 3u))); }
__device__ __forceinline__ unsigned voffv(unsigned r, unsigned cp) { return 128u * r + 32u * (cp ^ (((r >> 1) & 3u) ^ (((r >> 3) & 1u) << 1))); }
__device__ __forceinline__ void tr8(unsigned a0, unsigned a1, unsigned c0, unsigned c1, bf16x8& f00, bf16x8& f01, bf16x8& f10, bf16x8& f11) {
    u32x2 r0, r1, r2, r3, r4, r5, r6, r7;
    asm volatile("ds_read_b64_tr_b16 %0, %8\n\tds_read_b64_tr_b16 %1, %9\n\tds_read_b64_tr_b16 %2, %8 offset:8192\n\tds_read_b64_tr_b16 %3, %9 offset:8192\n\t"
                 "ds_read_b64_tr_b16 %4, %10\n\tds_read_b64_tr_b16 %5, %11\n\tds_read_b64_tr_b16 %6, %10 offset:8192\n\tds_read_b64_tr_b16 %7, %11 offset:8192\n\ts_waitcnt lgkmcnt(0)"
                 : "=&v"(r0), "=&v"(r1), "=&v"(r2), "=&v"(r3), "=&v"(r4), "=&v"(r5), "=&v"(r6), "=&v"(r7) : "v"(a0), "v"(a1), "v"(c0), "v"(c1) : "memory");
    const u32x4 x00 = {r0.x, r0.y, r1.x, r1.y}, x01 = {r2.x, r2.y, r3.x, r3.y}, x10 = {r4.x, r4.y, r5.x, r5.y}, x11 = {r6.x, r6.y, r7.x, r7.y};
    f00 = __builtin_bit_cast(bf16x8, x00); f01 = __builtin_bit_cast(bf16x8, x01); f10 = __builtin_bit_cast(bf16x8, x10); f11 = __builtin_bit_cast(bf16x8, x11);
}
__device__ __forceinline__ bf16x8 pack8(const f32x4 a, const f32x4 b) { const u32x4 r = {pkbf(a[0], a[1]), pkbf(a[2], a[3]), pkbf(b[0], b[1]), pkbf(b[2], b[3])}; return __builtin_bit_cast(bf16x8, r); }
__device__ __forceinline__ u32x2 tr_issue(unsigned a) { u32x2 r; asm volatile("ds_read_b64_tr_b16 %0, %1" : "=v"(r) : "v"(a) : "memory"); return r; }
__device__ __forceinline__ bf16x8 frag2(const u32x2 lo, const u32x2 hi) { const u32x4 r = {lo.x, lo.y, hi.x, hi.y}; return __builtin_bit_cast(bf16x8, r); }
template <int NJ>
__device__ __forceinline__ void at_part(LAS unsigned char* lds, unsigned QI, unsigned KI, int it, unsigned l15, unsigned g, bf16x8 (&at)[NJ / 2]) {
    const unsigned trow = 16u * (unsigned)it + l15;
    bf16x8 qb[4];
#pragma unroll
    for (int kd = 0; kd < 4; ++kd) qb[kd] = *(const LAS bf16x8*)(lds + QI + offb(trow, 4u * kd + g));
    f32x4 c[NJ];
#pragma unroll
    for (int j = 0; j < NJ; ++j) { c[j] = (f32x4){0.f, 0.f, 0.f, 0.f};
        if (j <= it) {
#pragma unroll
            for (int kd = 0; kd < 4; ++kd) { const bf16x8 a = *(const LAS bf16x8*)(lds + KI + offb(16u * j + l15, 4u * kd + g)); c[j] = MFMA16(a, qb[kd], c[j]); }
            if (j == it) {
#pragma unroll
                for (int r = 0; r < 4; ++r) c[j][r] = (4u * g + r <= l15) ? c[j][r] : 0.f; } } }
#pragma unroll
    for (int ks = 0; ks < NJ / 2; ++ks) at[ks] = pack8(c[2 * ks], c[2 * ks + 1]);
}
template <int NK>
__device__ __forceinline__ f32x4 o_part(LAS unsigned char* lds, unsigned QI, int it, const bf16x8 (&at)[NK], const bf16x8 (&vf)[2], const bf16x8 (&sfrag)[4], unsigned l15, unsigned g) {
    const unsigned trow = 16u * (unsigned)it + l15;
    f32x4 o = (f32x4){0.f, 0.f, 0.f, 0.f};
#pragma unroll
    for (int ks = 0; ks < NK; ++ks) if (2 * ks <= it) o = MFMA16(vf[ks], at[ks], o);
#pragma unroll
    for (int kd = 0; kd < 4; ++kd) {
        const u32x2 q0 = *(const LAS u32x2*)(lds + QI + offb(trow, 4u * kd + (g >> 1)) + 8u * (g & 1)), q1 = *(const LAS u32x2*)(lds + QI + offb(trow, 4u * kd + 2u + (g >> 1)) + 8u * (g & 1));
        o = MFMA16(sfrag[kd], frag2(q0, q1), o); }
    return o;
}
__device__ __forceinline__ void phase(LAS unsigned char* lds, const bf16_t* Qt, const bf16_t* Kt, bf16_t* VO, const float* DEC, float* ss8, int bid, int G, int wave) {
    int lane_ = (int)__builtin_amdgcn_mbcnt_hi(~0u, __builtin_amdgcn_mbcnt_lo(~0u, 0u)); asm volatile("" : "+v"(lane_));
    const unsigned lane = (unsigned)lane_, tid = (unsigned)wave * 64u + lane, l15 = lane & 15u, g = lane >> 4, ql = l15 >> 2, p = lane & 3u;
    const unsigned vs = (unsigned)wave & 3u; const int th = wave >> 2, tA = th ? 1 : 0, tB = th ? 2 : 3;
    const unsigned ldsb = (unsigned)(uintptr_t)lds;
    const unsigned srow = tid >> 4, sch = tid & 15u, vrow = tid >> 3, vch = tid & 7u;
    for (int item = bid; item < BATCH * NHEAD * 2; item += G) {
        const int half = (item >> 3) & 1, pair = (item & 7) | ((item >> 4) << 3), b = pair >> 4, h = pair & 15;
        const size_t tokb = (size_t)b * SEQ;
        const bf16_t* qg = Qt + (tokb + srow) * DI + h * HD + sch * 8;
        const bf16_t* kg = Kt + (tokb + srow) * DI + h * HD + sch * 8;
        bf16_t* vg = VO + tokb * DI + h * HD + half * 64;
        f32x4 S[8]; bf16x8 sfrag[4];
#pragma unroll
        for (int i = 0; i < 8; ++i) S[i] = (f32x4){0.f, 0.f, 0.f, 0.f};
#pragma unroll
        for (int i = 0; i < 4; ++i) sfrag[i] = (bf16x8){0, 0, 0, 0, 0, 0, 0, 0};
        u32x4 rq0, rq1, rk0, rk1, rv; f32x4 rdec = (f32x4){0.f, 0.f, 0.f, 0.f};
        const float* dg = DEC + (size_t)(b * (SEQ / 64)) * DI + h * HD + (tid & 31u) * 4u;
#define SC_LOAD(n_) do { const size_t t0_ = (size_t)(n_) * 64; \
            rq0 = *(const u32x4*)(qg + t0_ * DI); rq1 = *(const u32x4*)(qg + (t0_ + 32) * DI); rk0 = *(const u32x4*)(kg + t0_ * DI); rk1 = *(const u32x4*)(kg + (t0_ + 32) * DI); \
            rv = *(const u32x4*)(vg + (t0_ + vrow) * DI + vch * 8); if (tid < 32u) rdec = *(const f32x4*)(dg + (size_t)(n_) * DI); } while (0)
#define SC_STORE(base_) do { *(LAS u32x4*)(lds + (base_) + offb(srow, sch)) = rq0; *(LAS u32x4*)(lds + (base_) + offb(srow + 32u, sch)) = rq1; \
            *(LAS u32x4*)(lds + (base_) + 16384u + offb(srow, sch)) = rk0; *(LAS u32x4*)(lds + (base_) + 16384u + offb(srow + 32u, sch)) = rk1; \
            *(LAS u32x4*)(lds + (base_) + 32768u + voffv(vrow, vch >> 1) + 16u * (vch & 1u)) = rv; \
            if (tid < 32u) *(LAS f32x4*)(lds + 81920u + ((base_) ? 512u : 0u) + tid * 16u) = rdec; } while (0)
        SC_LOAD(0); SC_STORE(0u); __syncthreads();
        for (int n = 0; n < SEQ / 64; ++n) {
            const unsigned QI = (unsigned)(n & 1) * 40960u, KI = QI + 16384u, VI = QI + 32768u;
            if (n + 1 < SEQ / 64) SC_LOAD(n + 1);
            u32x2 tv0, tv1, tv2, tv3, tv4, tv5, tv6, tv7;
            {
                const unsigned va = ldsb + VI + 8u * p;
                tv0 = tr_issue(va + voffv(4u * g + ql, vs)); tv1 = tr_issue(va + voffv(16u + 4u * g + ql, vs)); tv2 = tr_issue(va + voffv(32u + 4u * g + ql, vs)); tv3 = tr_issue(va + voffv(48u + 4u * g + ql, vs));
                tv4 = tr_issue(va + voffv(8u * g + ql, vs)); tv5 = tr_issue(va + voffv(8u * g + 4u + ql, vs)); tv6 = tr_issue(va + voffv(32u + 8u * g + ql, vs)); tv7 = tr_issue(va + voffv(36u + 8u * g + ql, vs));
            }
            bf16x8 atB[2], atA[1];
            at_part<4>(lds, QI, KI, tB, l15, g, atB);
            at_part<2>(lds, QI, KI, tA, l15, g, atA);
            asm volatile("s_waitcnt lgkmcnt(0)" : "+v"(tv0), "+v"(tv1), "+v"(tv2), "+v"(tv3), "+v"(tv4), "+v"(tv5), "+v"(tv6), "+v"(tv7) :: "memory");
            __builtin_amdgcn_sched_barrier(0);
            const bf16x8 vf[2] = {frag2(tv0, tv1), frag2(tv2, tv3)};
            const f32x4 oB = o_part<2>(lds, QI, tB, atB, vf, sfrag, l15, g);
            const f32x4 oA = o_part<1>(lds, QI, tA, atA, vf, sfrag, l15, g);
            {
                const bf16x8 vn0 = frag2(tv4, tv5), vn1 = frag2(tv6, tv7);
                const LAS float* dcp = (const LAS float*)(lds + 81920u + (unsigned)(n & 1) * 512u) + 4u * g;
                const unsigned ka = ldsb + KI + offb(8u * g + ql, (p >> 1)) + 8u * (p & 1u), kb = ldsb + KI + offb(8u * g + 4u + ql, (p >> 1)) + 8u * (p & 1u);
#pragma unroll
                for (int i = 0; i < 8; i += 2) {
                    bf16x8 k00, k01, k10, k11;
                    tr8(ka ^ ((unsigned)i << 5), kb ^ ((unsigned)i << 5), ka ^ ((unsigned)(i + 1) << 5), kb ^ ((unsigned)(i + 1) << 5), k00, k01, k10, k11);
                    S[i] = MFMA16(k00, vn0, S[i]); S[i + 1] = MFMA16(k10, vn0, S[i + 1]); S[i] = MFMA16(k01, vn1, S[i]); S[i + 1] = MFMA16(k11, vn1, S[i + 1]); }
#pragma unroll
                for (int i = 0; i < 8; ++i) { const f32x4 dc = *(const LAS f32x4*)(dcp + 16 * i); S[i] = S[i] * dc; }
#pragma unroll
                for (int kd = 0; kd < 4; ++kd) sfrag[kd] = pack8(S[2 * kd], S[2 * kd + 1]);
            }
            if (n + 1 < SEQ / 64) SC_STORE((unsigned)((n + 1) & 1) * 40960u);
            {
                const size_t tlB = (size_t)n * 64 + 16u * (unsigned)tB + l15, tlA = (size_t)n * 64 + 16u * (unsigned)tA + l15;
                const u32x2 wB = {pkbf(oB[0], oB[1]), pkbf(oB[2], oB[3])}, wA = {pkbf(oA[0], oA[1]), pkbf(oA[2], oA[3])};
                *(u32x2*)(vg + tlB * DI + 16u * vs + 4u * g) = wB; *(u32x2*)(vg + tlA * DI + 16u * vs + 4u * g) = wA;
                float sB = (oB[0] * oB[0] + oB[1] * oB[1]) + (oB[2] * oB[2] + oB[3] * oB[3]), sA = (oA[0] * oA[0] + oA[1] * oA[1]) + (oA[2] * oA[2] + oA[3] * oA[3]);
                sB += xor_get(sB, (int)lane, 16); sA += xor_get(sA, (int)lane, 16); sB += xor_get(sB, (int)lane, 32); sA += xor_get(sA, (int)lane, 32);
                if (g == 0) { ss8[(tokb + tlB) * 128 + h * 8 + half * 4 + vs] = sB; ss8[(tokb + tlA) * 128 + h * 8 + half * 4 + vs] = sA; }
            }
            __syncthreads();
        }
#undef SC_LOAD
#undef SC_STORE
    }
}
#undef MFMA16
}

#define XB_TMO      128
#define XB_XCNT(j)  (256  + 64 * (j))
#define XB_XSUB(j)  (1280 + 64 * (j))
#define XB_XGEN(j)  (2304 + 64 * (j))
#define XB_TOP      3328
#define XB_TOPGEN   3392
#define XCD_BAR_WORDS 3456
#define XB_SPIN_CAP (1u << 18)
__device__ __forceinline__ unsigned xb_ld(unsigned* p)              { return __hip_atomic_load(p, __ATOMIC_RELAXED, __HIP_MEMORY_SCOPE_AGENT); }
__device__ __forceinline__ unsigned xb_add(unsigned* p, unsigned v) { return __hip_atomic_fetch_add(p, v, __ATOMIC_RELAXED, __HIP_MEMORY_SCOPE_AGENT); }
__device__ __forceinline__ unsigned xb_xcc_id() { return (unsigned)__builtin_amdgcn_s_getreg((3 << 11) | 20) & 0xFu; }
#define XB_SPIN(cond, bar) do { unsigned _sp = 0; while (cond) { __builtin_amdgcn_s_sleep(1); \
    if ((++_sp & 255u) == 0u) { if (xb_ld(&(bar)[XB_TMO])) break; if (_sp > XB_SPIN_CAP) { atomicAdd(&(bar)[XB_TMO], 1u); break; } } } } while (0)
struct XcdBarrier { unsigned* bar; unsigned x; volatile LAS unsigned* st; };
__device__ __forceinline__ XcdBarrier xcd_barrier_post(unsigned* bar, volatile LAS unsigned* st) {
    XcdBarrier b; b.bar = bar; b.x = xb_xcc_id(); b.st = st;
    if (threadIdx.x == 0) (void)xb_add(&bar[XB_XCNT(b.x)], 1u);
    return b;
}
__device__ __forceinline__ void xcd_barrier_complete(unsigned* bar, unsigned x, unsigned& nloc, unsigned& nx) {
    const unsigned G = gridDim.x * gridDim.y * gridDim.z;
    unsigned sum, cnt, mine, sp = 0u;
    for (;;) {
        sum = 0u; cnt = 0u; mine = 0u;
#pragma unroll
        for (unsigned j = 0; j < 16; ++j) { const unsigned c = xb_ld(&bar[XB_XCNT(j)]); sum += c; cnt += (c > 0u) ? 1u : 0u; mine = (j == x) ? c : mine; }
        if (sum == G) break;
        __builtin_amdgcn_s_sleep(1);
        if ((++sp & 255u) == 0u) { if (xb_ld(&bar[XB_TMO])) break; if (sp > XB_SPIN_CAP) { atomicAdd(&bar[XB_TMO], 1u); break; } }
    }
    nloc = mine > 0u ? mine : 1u; nx = cnt > 0u ? cnt : 1u;
}
__device__ __forceinline__ void xcd_barrier(const XcdBarrier& b) {
    asm volatile("s_waitcnt vmcnt(0)" ::: "memory");
    __syncthreads();
    if (threadIdx.x == 0) {
        unsigned* bar = b.bar;
        __builtin_amdgcn_s_waitcnt(0);
        unsigned nloc = b.st[0], nx = b.st[1];
        if (nloc == 0u) { xcd_barrier_complete(bar, b.x, nloc, nx); b.st[0] = nloc; b.st[1] = nx; }
        const unsigned old = xb_add(&bar[XB_XSUB(b.x)], 1u);
        const unsigned gen = old / nloc;
        if (old + 1u == (gen + 1u) * nloc) {
            __builtin_amdgcn_fence(__ATOMIC_RELEASE, "agent");
            asm volatile("s_waitcnt vmcnt(0)" ::: "memory");
            const unsigned og = xb_add(&bar[XB_TOP], 1u);
            const unsigned tg = og / nx;
            if (og + 1u == (tg + 1u) * nx) xb_add(&bar[XB_TOPGEN], 1u);
            else XB_SPIN(xb_ld(&bar[XB_TOPGEN]) == tg, bar);
            __builtin_amdgcn_fence(__ATOMIC_ACQUIRE, "agent");
            xb_add(&bar[XB_XGEN(b.x)], 1u);
            asm volatile("s_waitcnt vmcnt(0)" ::: "memory");
        } else {
            XB_SPIN(xb_ld(&bar[XB_XGEN(b.x)]) == gen, bar);
            __builtin_amdgcn_fence(__ATOMIC_ACQUIRE, "agent");
            asm volatile("s_waitcnt vmcnt(0)" ::: "memory");
        }
    }
    __syncthreads();
}

struct Args {
    const float* x; const float* norm_g; const float* pool_w_in; const float* pool_w_grp; const float* pool_scale; const float* pool_w_out;
    const float* hgrn_w_in; const float* hgrn_lb; const float* hgrn_norm_g; const float* hgrn_w_out; const float* final_g;
    float* out; unsigned char* ws;
};

struct TItem { const float* W; bf16_t* WT; const float* ks; const float* ns; int K, N, row_off, item; };
__device__ __forceinline__ void titem_issue(const TItem& t, int lane, float (&wv)[32]) {
    const int nblk = t.N / 32, kb = t.item / nblk, nb = t.item % nblk, k0 = 64 * kb, n0 = 32 * nb;
    const float* wp = t.W + (size_t)(k0 + (lane >> 5)) * t.N + n0 + (lane & 31);
#pragma unroll
    for (int i = 0; i < 32; ++i) wv[i] = wp[(size_t)(2 * i) * t.N];
}
__device__ __forceinline__ void titem_finish(const TItem& t, int lane, const float (&wv)[32], LAS float* scr) {
    const int nblk = t.N / 32, kb = t.item / nblk, nb = t.item % nblk, k0 = 64 * kb, n0 = 32 * nb;
    const float nsv = t.ns ? t.ns[n0 + (lane & 31)] : 1.0f;
    const float ksv = t.ks ? t.ks[k0 + lane] : 1.0f;
#pragma unroll
    for (int i = 0; i < 32; ++i) { const int kk = 2 * i + (lane >> 5); scr[kk * 33 + (lane & 31)] = wv[i] * nsv * lane_get(ksv, kk); }
    asm volatile("s_waitcnt lgkmcnt(0)" ::: "memory");
    const int c = lane & 7;
#pragma unroll
    for (int j = 0; j < 4; ++j) { const int n = (lane >> 3) + 8 * j; const LAS float* s = scr + (8 * c) * 33 + n;
        u32x4 o; o.x = pkbf(s[0 * 33], s[1 * 33]); o.y = pkbf(s[2 * 33], s[3 * 33]); o.z = pkbf(s[4 * 33], s[5 * 33]); o.w = pkbf(s[6 * 33], s[7 * 33]);
        *(u32x4*)(t.WT + (size_t)(t.row_off + n0 + n) * t.K + k0 + 8 * c) = o; }
    asm volatile("s_waitcnt lgkmcnt(0)" ::: "memory");
}

__global__ void __launch_bounds__(512, 2) fwd_kernel(Args a) {
    extern __shared__ __attribute__((aligned(16))) unsigned char lds_raw[];
    LAS unsigned char* lds = (LAS unsigned char*)lds_raw;
    volatile LAS unsigned* xst = (volatile LAS unsigned*)(lds + 131072 + 64);
    if (threadIdx.x < 2) xst[threadIdx.x] = 0u;
    __syncthreads();
    const XcdBarrier xbar = xcd_barrier_post((unsigned*)a.ws, xst);
#define GRID_BAR() xcd_barrier(xbar)
    const int G = gridDim.x, bid = blockIdx.x;
    const int NGW = G * 8;
    const int wave = __builtin_amdgcn_readfirstlane((int)threadIdx.x >> 6);
#define PHASE_IDS int lane_ = (int)__builtin_amdgcn_mbcnt_hi(~0u, __builtin_amdgcn_mbcnt_lo(~0u, 0u)); asm volatile("" : "+v"(lane_)); const int lane = lane_, tid = wave * 64 + lane, gw = bid * 8 + wave; (void)gw; (void)tid;
    unsigned char* ws = a.ws;
    bf16_t* Wt_in0 = (bf16_t*)(ws + WS_WIN0); bf16_t* Wt_grp = (bf16_t*)(ws + WS_WGRP); bf16_t* Wt_out0 = (bf16_t*)(ws + WS_WOUT0);
    bf16_t* Wt_in1 = (bf16_t*)(ws + WS_WIN1); bf16_t* Wt_out1 = (bf16_t*)(ws + WS_WOUT1);
    float* part1 = (float*)(ws + WS_PART1); float* ssb = (float*)(ws + WS_SS); float* decb = (float*)(ws + WS_DEC);
    bf16_t* XB = (bf16_t*)(ws + WS_XB); bf16_t* BA = (bf16_t*)(ws + WS_A); bf16_t* BB = (bf16_t*)(ws + WS_B); bf16_t* BC = (bf16_t*)(ws + WS_C);

    {
        PHASE_IDS
        LAS float* scr = (LAS float*)(lds + wave * 16384);
        constexpr int I_IN0 = (DM / 64) * (4096 / 32), I_GRP1 = (512 / 64) * (512 / 32), I_OUT = (DI / 64) * (DM / 32), I_IN1 = (DM / 64) * (8192 / 32);
        constexpr int NITEMS = I_IN0 + 4 * I_GRP1 + I_OUT + I_IN1 + I_OUT;
        auto decode = [&](int it) -> TItem {
            int r = it;
            if (r < I_IN0) return TItem{a.pool_w_in, Wt_in0, a.norm_g, nullptr, DM, 4096, 0, r}; r -= I_IN0;
            if (r < 4 * I_GRP1) { const int g = r / I_GRP1; return TItem{a.pool_w_grp + (size_t)g * 512 * 512, Wt_grp, nullptr, a.pool_scale + g * 512, 512, 512, g * 512, r % I_GRP1}; } r -= 4 * I_GRP1;
            if (r < I_OUT) return TItem{a.pool_w_out, Wt_out0, nullptr, nullptr, DI, DM, 0, r}; r -= I_OUT;
            if (r < I_IN1) {
                const int n0 = 32 * (r % (8192 / 32)); int d0 = n0;
                if (n0 < 2048) d0 = 256 * (n0 >> 7) + (n0 & 127); else if (n0 < 4096) d0 = 256 * ((n0 - 2048) >> 7) + 128 + (n0 & 127);
                return TItem{a.hgrn_w_in, Wt_in1, a.norm_g + DM, nullptr, DM, 8192, d0 - n0, r}; } r -= I_IN1;
            return TItem{a.hgrn_w_out, Wt_out1, a.hgrn_norm_g, nullptr, DI, DM, 0, r};
        };
        {
            float wa[32], wb[32]; TItem ia{}, ib{};
            int it = gw; bool ha = it < NITEMS;
            if (ha) { ia = decode(it); titem_issue(ia, lane, wa); }
            while (ha) {
                const int itb = it + NGW; const bool hb = itb < NITEMS;
                if (hb) { ib = decode(itb); titem_issue(ib, lane, wb); }
                titem_finish(ia, lane, wa, scr);
                it = itb + NGW; ha = it < NITEMS;
                if (ha) { ia = decode(it); titem_issue(ia, lane, wa); }
                if (!hb) break;
                titem_finish(ib, lane, wb, scr);
            }
        }
        for (int m0 = gw * 8; m0 < M; m0 += NGW * 8) {
            f32x4 v[8][4]; float s[8];
#pragma unroll
            for (int r = 0; r < 8; ++r) { const f32x4* xr = (const f32x4*)(a.x + (size_t)(m0 + r) * DM) + lane;
#pragma unroll
                for (int j = 0; j < 4; ++j) v[r][j] = xr[64 * j]; }
#pragma unroll
            for (int r = 0; r < 8; ++r) { s[r] = 0.f;
#pragma unroll
                for (int j = 0; j < 4; ++j) s[r] += (v[r][j][0] * v[r][j][0] + v[r][j][1] * v[r][j][1]) + (v[r][j][2] * v[r][j][2] + v[r][j][3] * v[r][j][3]); }
#pragma unroll
            for (int o = 1; o < 64; o <<= 1) {
#pragma unroll
                for (int r = 0; r < 8; ++r) s[r] += xor_get(s[r], lane, o); }
#pragma unroll
            for (int r = 0; r < 8; ++r) { const float rstd = 1.0f / sqrtf(s[r] * (1.0f / DM) + EPS);
                unsigned long long* o8 = (unsigned long long*)(XB + (size_t)(m0 + r) * DM) + lane;
#pragma unroll
                for (int j = 0; j < 4; ++j) o8[64 * j] = (unsigned long long)pkbf(v[r][j][0] * rstd, v[r][j][1] * rstd) | ((unsigned long long)pkbf(v[r][j][2] * rstd, v[r][j][3] * rstd) << 32); }
        }
    }
    GRID_BAR();

    {
        pg8::Gemm g{XB, Wt_in0, DM, DM, DM, 0}; pg8::StaticOrder S; S.init(M, 4096, G, bid);
        pg8::EpiP1 E{BA, BB};
        pg8::gemm_phase<pg8::EpiP1>(lds, g, S, E, wave);
    }
    GRID_BAR();

    {
        PHASE_IDS
        constexpr int RUN = 64;
        const int nruns = (M / RUN) * (DI / 8);
        for (int idx = bid * 512 + tid; idx < nruns; idx += G * 512) {
            const int cgp = idx & 255, run = idx >> 8, grp = cgp >> 6, w = 2 << grp;
            const int m0 = run * RUN, t0 = m0 & (SEQ - 1);
            const bf16_t* vp = BA + (size_t)m0 * DI + cgp * 8; bf16_t* pp = BC + (size_t)m0 * DI + cgp * 8;
            float sum[8];
#pragma unroll
            for (int j = 0; j < 8; ++j) sum[j] = 0.f;
            if (t0 > 0) for (int k = 1; k < w; ++k) { const u32x4 vv = *(const u32x4*)(vp - (size_t)k * DI);
                sum[0] += bf_lo(vv.x); sum[1] += bf_hi(vv.x); sum[2] += bf_lo(vv.y); sum[3] += bf_hi(vv.y); sum[4] += bf_lo(vv.z); sum[5] += bf_hi(vv.z); sum[6] += bf_lo(vv.w); sum[7] += bf_hi(vv.w); }
            for (int i0 = 0; i0 < RUN; i0 += 8) {
                u32x4 vin[8], vout[8];
#pragma unroll
                for (int j = 0; j < 8; ++j) vin[j] = *(const u32x4*)(vp + (size_t)(i0 + j) * DI);
#pragma unroll
                for (int j = 0; j < 8; ++j) { const int i = i0 + j; vout[j] = (t0 + i + 1 >= w) ? *(const u32x4*)(vp + (size_t)(i + 1 - w) * DI) : (u32x4){0u, 0u, 0u, 0u}; }
#pragma unroll
                for (int j = 0; j < 8; ++j) {
                    const int i = i0 + j, t = t0 + i;
                    const u32x4 vv = vin[j];
                    float x[8] = {bf_lo(vv.x), bf_hi(vv.x), bf_lo(vv.y), bf_hi(vv.y), bf_lo(vv.z), bf_hi(vv.z), bf_lo(vv.w), bf_hi(vv.w)};
#pragma unroll
                    for (int c = 0; c < 8; ++c) sum[c] += x[c];
                    const int cnt = (t + 1) < w ? (t + 1) : w; const float inv = 1.0f / (float)cnt;
                    u32x4 o; o.x = pkbf(sum[0] * inv - x[0], sum[1] * inv - x[1]); o.y = pkbf(sum[2] * inv - x[2], sum[3] * inv - x[3]);
                    o.z = pkbf(sum[4] * inv - x[4], sum[5] * inv - x[5]); o.w = pkbf(sum[6] * inv - x[6], sum[7] * inv - x[7]);
                    *(u32x4*)(pp + (size_t)i * DI) = o;
                    const u32x4 uu = vout[j];
                    sum[0] -= bf_lo(uu.x); sum[1] -= bf_hi(uu.x); sum[2] -= bf_lo(uu.y); sum[3] -= bf_hi(uu.y); sum[4] -= bf_lo(uu.z); sum[5] -= bf_hi(uu.z); sum[6] -= bf_lo(uu.w); sum[7] -= bf_hi(uu.w);
                }
            }
        }
    }
    GRID_BAR();

    {
        pg8::Gemm g{BC, Wt_grp, DI, 512, 512, 2}; pg8::StaticOrder S; S.init(M, DI, G, bid);
        pg8::EpiP2 E{BB};
        pg8::gemm_phase<pg8::EpiP2>(lds, g, S, E, wave);
    }
    GRID_BAR();

    {
        pg8::Gemm g{BB, Wt_out0, DI, DI, DI, 0}; pg8::StaticOrder S; S.init(M, DM, G, bid);
        pg8::EpiRes<true, false> E{a.x, nullptr, XB, part1};
        pg8::gemm_phase<pg8::EpiRes<true, false>>(lds, g, S, E, wave);
    }
    GRID_BAR();

    {
        pg8::Gemm g{XB, Wt_in1, DM, DM, DM, 0}; pg8::StaticOrder S; S.init(M, 6144, G, bid);
        pg8::EpiP4 E{BA, BB, BC, decb, part1, a.hgrn_lb};
        pg8::gemm_phase<pg8::EpiP4>(lds, g, S, E, wave);
    }
    GRID_BAR();

    scan::phase(lds, BA, BB, BC, decb, ssb, bid, G, wave);
    GRID_BAR();

    {
        pg8::Gemm g{XB, Wt_in1 + (size_t)6144 * DM, DM, DM, DM, 0}; pg8::StaticOrder S; S.init(M, DI, G, bid);
        pg8::EpiP5b E{BC, part1, ssb};
        pg8::gemm_phase<pg8::EpiP5b>(lds, g, S, E, wave);
    }
    GRID_BAR();

    {
        pg8::Gemm g{BC, Wt_out1, DI, DI, DI, 0}; pg8::StaticOrder S; S.init(M, DM, G, bid);
        pg8::EpiFinal E{XB, a.out, a.final_g, (float*)(ws + WS_X), (unsigned*)(ws + WS_CNT)};
        pg8::gemm_phase<pg8::EpiFinal>(lds, g, S, E, wave);
    }
}

extern "C" void kernel_launch(void* const* d_in, const int* in_sizes, int n_in, void* d_out, int out_size, void* d_ws, size_t ws_size, hipStream_t stream) {
    static int grid = 0;
    if (grid == 0) {
        if (n_in != 11 || in_sizes[0] != M * DM || out_size != M * DM || ws_size < WS_END) { fprintf(stderr, "kernel_launch: unexpected shapes (n_in %d in0 %d out %d ws %zu)\n", n_in, n_in > 0 ? in_sizes[0] : -1, out_size, ws_size); grid = -1; return; }
        int dev = 0, cus = 0, per = 0;
        if (hipGetDevice(&dev) != hipSuccess || hipDeviceGetAttribute(&cus, hipDeviceAttributeMultiprocessorCount, dev) != hipSuccess) { grid = -1; return; }
        if (hipFuncSetAttribute((const void*)fwd_kernel, hipFuncAttributeMaxDynamicSharedMemorySize, LDS_BYTES) != hipSuccess) { fprintf(stderr, "kernel_launch: hipFuncSetAttribute failed\n"); grid = -1; return; }
        if (hipOccupancyMaxActiveBlocksPerMultiprocessor(&per, (const void*)fwd_kernel, 512, LDS_BYTES) != hipSuccess || per < 1) { fprintf(stderr, "kernel_launch: occupancy query says %d\n", per); (void)hipGetLastError(); grid = -1; return; }
        grid = cus;
        fprintf(stderr, "kernel_launch: cus %d per_cu %d grid %d\n", cus, per, grid);
    }
    if (grid < 0) return;
    if (hipMemsetAsync(d_ws, 0, 32768, stream) != hipSuccess) { fprintf(stderr, "kernel_launch: hipMemsetAsync failed\n"); return; }
    Args a{};
    a.x = (const float*)d_in[0]; a.norm_g = (const float*)d_in[1]; a.pool_w_in = (const float*)d_in[2]; a.pool_w_grp = (const float*)d_in[3];
    a.pool_scale = (const float*)d_in[4]; a.pool_w_out = (const float*)d_in[5]; a.hgrn_w_in = (const float*)d_in[6]; a.hgrn_lb = (const float*)d_in[7];
    a.hgrn_norm_g = (const float*)d_in[8]; a.hgrn_w_out = (const float*)d_in[9]; a.final_g = (const float*)d_in[10];
    a.out = (float*)d_out; a.ws = (unsigned char*)d_ws;
    void* args[] = {&a};
    hipError_t e = hipLaunchCooperativeKernel((void*)fwd_kernel, dim3(grid), dim3(512), args, LDS_BYTES, stream);
    if (e != hipSuccess) fprintf(stderr, "kernel_launch: cooperative launch failed: %s (grid %d)\n", hipGetErrorString(e), grid);
}
```

```cpp
#include <hip/hip_runtime.h>
#include <cstdio>
#include <cstdint>

#define LAS __attribute__((address_space(3)))
typedef unsigned short bf16_t;
typedef short bf16x8 __attribute__((ext_vector_type(8)));
typedef float f32x4 __attribute__((ext_vector_type(4)));
typedef float f32x2 __attribute__((ext_vector_type(2)));
typedef unsigned u32x4 __attribute__((ext_vector_type(4)));
typedef unsigned u32x2 __attribute__((ext_vector_type(2)));

constexpr int DM = 1024, BATCH = 8, SEQ = 4096, DI = 2048, M = BATCH * SEQ;
constexpr int NHEAD = 16, HD = 128;
constexpr float EPS = 1e-6f;
constexpr size_t MiB = 1u << 20;
constexpr size_t WS_WIN0 = 2 * MiB;
constexpr size_t WS_WGRP = 10 * MiB;
constexpr size_t WS_WOUT0 = 12 * MiB;
constexpr size_t WS_WIN1 = 16 * MiB;
constexpr size_t WS_WOUT1 = 32 * MiB;
constexpr size_t WS_PART1 = 36 * MiB;
constexpr size_t WS_CNT = 16384;
constexpr size_t WS_X = 40 * MiB;
constexpr size_t WS_DEC = 44 * MiB;
constexpr size_t WS_SS = 112 * MiB;
constexpr size_t WS_XB = 48 * MiB;
constexpr size_t WS_A = 128 * MiB;
constexpr size_t WS_B = 256 * MiB;
constexpr size_t WS_C = 384 * MiB;
constexpr size_t WS_END = 512 * MiB;
constexpr int LDS_BYTES = 147456;

typedef __bf16 bf2_t __attribute__((ext_vector_type(2)));
__device__ __forceinline__ unsigned pkbf(float lo, float hi) { f32x2 v = {lo, hi}; return __builtin_bit_cast(unsigned, __builtin_convertvector(v, bf2_t)); }
__device__ __forceinline__ float bf_lo(unsigned w) { return __builtin_bit_cast(float, w << 16); }
__device__ __forceinline__ float bf_hi(unsigned w) { return __builtin_bit_cast(float, w & 0xffff0000u); }
__device__ __forceinline__ float silu_f(float x) { return x * __builtin_amdgcn_rcpf(1.0f + __builtin_amdgcn_exp2f(-1.44269504089f * x)); }
__device__ __forceinline__ int fresh_lane_id() { int l; asm volatile("v_mbcnt_lo_u32_b32 %0, -1, 0\n\tv_mbcnt_hi_u32_b32 %0, -1, %0" : "=v"(l)); return l; }
__device__ __forceinline__ float lane_get(float v, int src_lane) { return __builtin_bit_cast(float, __builtin_amdgcn_ds_bpermute(src_lane << 2, __builtin_bit_cast(int, v))); }
__device__ __forceinline__ float xor_get(float v, int lane, int m) { return lane_get(v, lane ^ m); }
__device__ __forceinline__ float wave_sum(float v, int lane) {
#pragma unroll
    for (int o = 1; o < 64; o <<= 1) v += xor_get(v, lane, o);
    return v;
}

namespace pg8 {
constexpr int BM = 256, BK = 64, HALF = 128, HTB = HALF * BK * 2, NXCD = 8, WGM = 4;
__host__ __device__ __forceinline__ int lds_byte(int r, int c) { const int st = (r >> 4) * 2 + (c >> 5), rr = r & 15, cc = c & 31, ob = rr * 64 + cc * 2; return st * 1024 + (ob ^ (((ob >> 9) & 1) << 5)); }
__host__ __device__ __forceinline__ void stage_rc(int b, int& R, int& C) { const int st = b / 1024, sb = b % 1024, swz = sb ^ (((sb >> 9) & 1) << 5); R = (st >> 1) * 16 + swz / 64; C = (st & 1) * 32 + (swz % 64) / 2; }
__host__ __device__ __forceinline__ int perm32(int rho) { const int n = rho >> 4, i = rho & 15; return 8 * (i >> 2) + 4 * n + (i & 3); }

struct Unit { int pm, pn; };
struct Gemm { const bf16_t* A; const bf16_t* Bt; int lda, ldb, K, grp_tiles; };

struct StaticOrder {
    int nM, nN, nwg, G, c;
    __host__ __device__ void init(int M_, int N_, int G_, int c_) { nM = M_ / BM; nN = N_ / BM; nwg = nM * nN; G = G_; c = c_; }
    __host__ __device__ bool next(int i, Unit& u) const {
        const long L = (long)i * G + c; if (L >= nwg) return false;
        int wgid = (int)L; { const int q = nwg / NXCD, r = nwg % NXCD, xcd = wgid % NXCD, off = wgid / NXCD; wgid = (xcd < r ? xcd * (q + 1) : r * (q + 1) + (xcd - r) * q) + off; }
        const int nig = WGM * nN, gid = wgid / nig, fm = gid * WGM, gsz = (nM - fm) < WGM ? (nM - fm) : WGM;
        u.pm = fm + ((wgid % nig) % gsz); u.pn = (wgid % nig) / gsz; return true;
    }
};


__device__ __forceinline__ void zero_acc(f32x4 (&acc)[2][2][4][2]) {
#pragma unroll
    for (int a = 0; a < 2; ++a)
#pragma unroll
        for (int b = 0; b < 2; ++b)
#pragma unroll
            for (int m = 0; m < 4; ++m)
#pragma unroll
                for (int n = 0; n < 2; ++n) acc[a][b][m][n] = (f32x4){0.f, 0.f, 0.f, 0.f};
}
template <class Epi, bool ALIGN_EPI = true, bool SP2 = true>
__device__ __forceinline__ void gemm_phase(LAS unsigned char* lds, const Gemm g, const StaticOrder& S, const Epi& E, const int wid) {
    int lane_ = fresh_lane_id();
    int lane = lane_, tid = wid * 64 + lane, fr = lane & 15, fq = lane >> 4; const int wr = wid >> 2, wc = wid & 3;
    const int K = g.K, nt = K / BK;
    unsigned voffA[2], voffB[2]; int aoff, boff;
#define PG8_LANE_STATE() do { _Pragma("unroll") for (int i = 0; i < 2; ++i) { int R, C; stage_rc(tid * 16 + i * 8192, R, C); const int Rb = Epi::PERM ? ((R & ~31) + perm32(R & 31)) : R; \
        voffA[i] = (unsigned)(R * g.lda + C) * 2u; voffB[i] = (unsigned)(Rb * g.ldb + C) * 2u; } \
        aoff = lds_byte(wr * 64 + fr, fq * 8); boff = lds_byte(wc * 32 + fr, fq * 8); } while (0)
    PG8_LANE_STATE();
    const size_t kstep = (size_t)(BK * 2);
    const size_t hstepA = (size_t)HALF * g.lda * 2, hstepB = (size_t)HALF * g.ldb * 2;
    const size_t tstepA = 2 * hstepA, tstepB = 2 * hstepB;
    const unsigned ldsw = (unsigned)wid * 1024u;
#define PG8_SA(b, h) (((b) * 2 + (h)) * HTB)
#define PG8_SB(b, h) ((4 + (b) * 2 + (h)) * HTB)
#define PG8_STAGE(bufoff, gbase, voff) do { _Pragma("unroll") for (int _i = 0; _i < 2; ++_i) \
        __builtin_amdgcn_global_load_lds((const unsigned*)((const char*)(gbase) + (voff)[_i]), (LAS unsigned*)(lds + (bufoff) + ldsw + _i * 8192), 16, 0, 0); } while (0)
#define PG8_LDA(dst, b, h) do { _Pragma("unroll") for (int m = 0; m < 4; ++m) _Pragma("unroll") for (int k = 0; k < 2; ++k) dst[m][k] = *(const LAS bf16x8*)(lds + PG8_SA(b, h) + aoff + m * 2048 + k * 1024); } while (0)
#define PG8_LDB(dst, b, h) do { _Pragma("unroll") for (int n = 0; n < 2; ++n) _Pragma("unroll") for (int k = 0; k < 2; ++k) dst[n][k] = *(const LAS bf16x8*)(lds + PG8_SB(b, h) + boff + n * 2048 + k * 1024); } while (0)
#define PG8_MMA(ai, bj, At, Bt) do { __builtin_amdgcn_s_setprio(1); _Pragma("unroll") for (int m = 0; m < 4; ++m) _Pragma("unroll") for (int n = 0; n < 2; ++n) _Pragma("unroll") for (int k = 0; k < 2; ++k) \
        acc[ai][bj][m][n] = __builtin_amdgcn_mfma_f32_16x16x32_bf16(Bt[n][k], At[m][k], acc[ai][bj][m][n], 0, 0, 0); __builtin_amdgcn_s_setprio(0); } while (0)
#define PG8_WAIT_V(n) asm volatile("s_waitcnt vmcnt(" #n ")" ::: "memory")
#define PG8_WAIT_L(n) asm volatile("s_waitcnt lgkmcnt(" #n ")" ::: "memory")
#define PG8_BAR __builtin_amdgcn_s_barrier()
#define PG8_SCHED __builtin_amdgcn_sched_barrier(0)
#define PG8_ABASE(u) ((const char*)g.A + (size_t)(u).pm * tstepA + (g.grp_tiles ? (size_t)((u).pn / g.grp_tiles) * (size_t)K * 2 : (size_t)0))
#define PG8_BBASE(u) ((const char*)g.Bt + (size_t)(u).pn * tstepB)
    Unit cur, nxt; int ui = 0;
    E.prologue(S, lds, tid);
    if (!S.next(0, cur)) return;
    f32x4 acc[2][2][4][2];
    E.init_acc(acc, cur, wr, wc, fr, fq);
    bf16x8 At[4][2], B0[2][2], B1[2][2];
    const char* cA = PG8_ABASE(cur); const char* cB = PG8_BBASE(cur);
    if constexpr (SP2) {
        PG8_STAGE(PG8_SB(0, 0), cB, voffB); PG8_STAGE(PG8_SB(0, 1), cB + hstepB, voffB); PG8_STAGE(PG8_SA(0, 0), cA, voffA); PG8_STAGE(PG8_SA(0, 1), cA + hstepA, voffA);
        if (wr == 1) PG8_BAR;
        PG8_WAIT_V(2); PG8_BAR;
        PG8_STAGE(PG8_SB(1, 0), cB + kstep, voffB); PG8_STAGE(PG8_SA(1, 0), cA + kstep, voffA); PG8_STAGE(PG8_SB(1, 1), cB + hstepB + kstep, voffB);
        PG8_WAIT_V(6); PG8_BAR;
    } else {
        PG8_STAGE(PG8_SB(0, 0), cB, voffB); PG8_STAGE(PG8_SA(0, 0), cA, voffA); PG8_STAGE(PG8_SB(0, 1), cB + hstepB, voffB); PG8_STAGE(PG8_SA(0, 1), cA + hstepA, voffA);
        if (wr == 1) PG8_BAR;
        PG8_WAIT_V(4); PG8_BAR;
        PG8_STAGE(PG8_SB(1, 0), cB + kstep, voffB); PG8_STAGE(PG8_SA(1, 0), cA + kstep, voffA); PG8_STAGE(PG8_SB(1, 1), cB + hstepB + kstep, voffB);
        PG8_WAIT_V(6); PG8_BAR;
    }
    for (;;) {
        const bool has_next = S.next(ui + 1, nxt);
        const char* nA = has_next ? PG8_ABASE(nxt) : cA; const char* nB = has_next ? PG8_BBASE(nxt) : cB;
        for (int t = 0; t < nt; t += 2) {
            const bool last = (t == nt - 2);
            const char* a1 = cA + (size_t)(t + 1) * kstep;
            const char* a2 = last ? nA : cA + (size_t)(t + 2) * kstep; const char* b2 = last ? nB : cB + (size_t)(t + 2) * kstep;
            const char* a3 = a2 + kstep; const char* b3 = b2 + kstep;
            if constexpr (SP2) {
            PG8_LDB(B0, 0, 0); PG8_LDB(B1, 0, 1); PG8_SCHED; PG8_LDA(At, 0, 0); PG8_STAGE(PG8_SA(1, 1), a1 + hstepA, voffA);
            PG8_WAIT_V(8); PG8_WAIT_L(0); PG8_BAR; PG8_MMA(0, 0, At, B0); PG8_MMA(0, 1, At, B1); PG8_BAR; PG8_SCHED;
            PG8_LDA(At, 0, 1); PG8_STAGE(PG8_SB(0, 0), b2, voffB); PG8_STAGE(PG8_SB(0, 1), b2 + hstepB, voffB); PG8_STAGE(PG8_SA(0, 0), a2, voffA);
            PG8_WAIT_V(8); PG8_WAIT_L(0); PG8_BAR; PG8_MMA(1, 0, At, B0); PG8_MMA(1, 1, At, B1); PG8_BAR; PG8_SCHED;
            PG8_LDB(B0, 1, 0); PG8_LDB(B1, 1, 1); PG8_SCHED; PG8_LDA(At, 1, 0); PG8_STAGE(PG8_SA(0, 1), a2 + hstepA, voffA);
            PG8_WAIT_V(8); PG8_WAIT_L(0); PG8_BAR; PG8_MMA(0, 0, At, B0); PG8_MMA(0, 1, At, B1); PG8_BAR; PG8_SCHED;
            PG8_LDA(At, 1, 1); PG8_STAGE(PG8_SB(1, 0), b3, voffB); PG8_STAGE(PG8_SB(1, 1), b3 + hstepB, voffB); PG8_STAGE(PG8_SA(1, 0), a3, voffA);
            PG8_WAIT_V(8); PG8_WAIT_L(0); PG8_BAR; PG8_MMA(1, 0, At, B0); PG8_MMA(1, 1, At, B1); PG8_BAR; PG8_SCHED;
            } else {
            PG8_LDB(B0, 0, 0); PG8_SCHED; PG8_LDA(At, 0, 0); PG8_STAGE(PG8_SA(1, 1), a1 + hstepA, voffA);
            PG8_WAIT_L(8); PG8_BAR; PG8_WAIT_L(0); PG8_MMA(0, 0, At, B0); PG8_BAR; PG8_SCHED;
            PG8_LDB(B1, 0, 1); PG8_STAGE(PG8_SB(0, 0), b2, voffB);
            PG8_BAR; PG8_WAIT_L(0); PG8_MMA(0, 1, At, B1); PG8_BAR;
            PG8_LDA(At, 0, 1); PG8_STAGE(PG8_SA(0, 0), a2, voffA);
            PG8_BAR; PG8_WAIT_L(0); PG8_MMA(1, 0, At, B0); PG8_BAR; PG8_SCHED;
            PG8_STAGE(PG8_SB(0, 1), b2 + hstepB, voffB);
            PG8_WAIT_V(6); PG8_BAR; PG8_MMA(1, 1, At, B1); PG8_BAR;
            PG8_LDB(B0, 1, 0); PG8_SCHED; PG8_LDA(At, 1, 0); PG8_STAGE(PG8_SA(0, 1), a2 + hstepA, voffA);
            PG8_WAIT_L(8); PG8_BAR; PG8_WAIT_L(0); PG8_MMA(0, 0, At, B0); PG8_BAR; PG8_SCHED;
            PG8_LDB(B1, 1, 1); PG8_STAGE(PG8_SB(1, 0), b3, voffB);
            PG8_BAR; PG8_WAIT_L(0); PG8_MMA(0, 1, At, B1); PG8_BAR;
            PG8_LDA(At, 1, 1); PG8_STAGE(PG8_SA(1, 0), a3, voffA);
            PG8_BAR; PG8_WAIT_L(0); PG8_MMA(1, 0, At, B0); PG8_BAR; PG8_SCHED;
            PG8_STAGE(PG8_SB(1, 1), b3 + hstepB, voffB);
            PG8_WAIT_V(6); PG8_BAR; PG8_MMA(1, 1, At, B1); PG8_BAR;
            }
        }
        if constexpr (ALIGN_EPI) { if (wr == 0) PG8_BAR; }
        if constexpr (!Epi::AFTER_DRAIN) E(acc, cur, wr, wc, fr, fq, lds, ui);
        if (!has_next) break;
        cur = nxt; cA = nA; cB = nB; ++ui;
        asm volatile("" : "+v"(lane)); tid = wid * 64 + lane; fr = lane & 15; fq = lane >> 4; PG8_LANE_STATE();
        E.init_acc(acc, cur, wr, wc, fr, fq);
        if constexpr (ALIGN_EPI) { if (wr == 1) PG8_BAR; }
    }
    PG8_WAIT_V(0);
    if constexpr (!ALIGN_EPI) { if (wr == 0) PG8_BAR; }
    PG8_BAR;
    if constexpr (Epi::AFTER_DRAIN) E.fused(acc, cur, wr, wc, fr, fq, lds, tid);
#undef PG8_SA
#undef PG8_SB
#undef PG8_STAGE
#undef PG8_LDA
#undef PG8_LDB
#undef PG8_MMA
#undef PG8_WAIT_V
#undef PG8_WAIT_L
#undef PG8_BAR
#undef PG8_SCHED
#undef PG8_ABASE
#undef PG8_LANE_STATE
#undef PG8_BBASE
}

struct EpiP1 {
    static constexpr bool PERM = true, AFTER_DRAIN = false;
    __device__ __forceinline__ void init_acc(f32x4 (&acc)[2][2][4][2], const Unit&, int, int, int, int) const { zero_acc(acc); }
    __device__ __forceinline__ void prologue(const StaticOrder&, LAS unsigned char*, int) const {}
    bf16_t* V; bf16_t* SG;
    __device__ __forceinline__ void operator()(f32x4 (&acc)[2][2][4][2], const Unit& u, int wr, int wc, int fr, int fq, LAS unsigned char* lds, int ui) const {
        const int row0 = u.pm * BM + wr * 64 + fr; const bool gate = u.pn >= 8;
        bf16_t* base = gate ? SG : V; const int col0 = (u.pn & 7) * BM + wc * 32 + 8 * fq;
#pragma unroll
        for (int ai = 0; ai < 2; ++ai)
#pragma unroll
            for (int m = 0; m < 4; ++m) { bf16_t* rowp = base + (size_t)(row0 + ai * HALF + m * 16) * DI + col0;
#pragma unroll
                for (int bj = 0; bj < 2; ++bj) { f32x4 v0 = acc[ai][bj][m][0], v1 = acc[ai][bj][m][1];
                    if (gate) {
#pragma unroll
                        for (int j = 0; j < 4; ++j) { v0[j] = silu_f(v0[j]); v1[j] = silu_f(v1[j]); } }
                    u32x4 w; w.x = pkbf(v0[0], v0[1]); w.y = pkbf(v0[2], v0[3]); w.z = pkbf(v1[0], v1[1]); w.w = pkbf(v1[2], v1[3]);
                    *(u32x4*)(rowp + bj * HALF) = w; } }
    }
};
struct EpiP2 {
    static constexpr bool PERM = true, AFTER_DRAIN = false;
    __device__ __forceinline__ void init_acc(f32x4 (&acc)[2][2][4][2], const Unit&, int, int, int, int) const { zero_acc(acc); }
    __device__ __forceinline__ void prologue(const StaticOrder&, LAS unsigned char*, int) const {}
    bf16_t* Z;
    __device__ __forceinline__ void operator()(f32x4 (&acc)[2][2][4][2], const Unit& u, int wr, int wc, int fr, int fq, LAS unsigned char* lds, int ui) const {
        const unsigned row0 = (unsigned)(u.pm * BM + wr * 64 + fr), col0 = (unsigned)(u.pn * BM + wc * 32 + 8 * fq);
        const unsigned zofs = (row0 * DI + col0) * 2u;
#pragma unroll
        for (int ai = 0; ai < 2; ++ai) {
            u32x4 sv[4][2];
#pragma unroll
            for (int m = 0; m < 4; ++m)
#pragma unroll
                for (int bj = 0; bj < 2; ++bj) sv[m][bj] = *(const u32x4*)((const char*)Z + (zofs + (unsigned)((ai * HALF + m * 16) * DI + bj * HALF) * 2u));
#pragma unroll
            for (int m = 0; m < 4; ++m)
#pragma unroll
                for (int bj = 0; bj < 2; ++bj) { const f32x4 v0 = acc[ai][bj][m][0], v1 = acc[ai][bj][m][1]; const u32x4 s = sv[m][bj];
                    u32x4 w; w.x = pkbf(v0[0] * bf_lo(s.x), v0[1] * bf_hi(s.x)); w.y = pkbf(v0[2] * bf_lo(s.y), v0[3] * bf_hi(s.y));
                    w.z = pkbf(v1[0] * bf_lo(s.z), v1[1] * bf_hi(s.z)); w.w = pkbf(v1[2] * bf_lo(s.w), v1[3] * bf_hi(s.w));
                    *(u32x4*)((char*)Z + (zofs + (unsigned)((ai * HALF + m * 16) * DI + bj * HALF) * 2u)) = w; }
            asm volatile("" ::: "memory"); }
    }
};
template <bool WRITE_HB, bool WRITE_H = true> struct EpiRes {
    static constexpr bool PERM = true, AFTER_DRAIN = false;
    __device__ __forceinline__ void prologue(const StaticOrder&, LAS unsigned char*, int) const {}
    const float* R; float* H; bf16_t* HB; float* part;
    __device__ __forceinline__ void init_acc(f32x4 (&acc)[2][2][4][2], const Unit& u, int wr, int wc, int fr, int fq) const {
        const unsigned row0 = (unsigned)(u.pm * BM + wr * 64 + fr), col0 = (unsigned)(u.pn * BM + wc * 32 + 8 * fq);
        const unsigned ofs = (row0 * DM + col0) * 4u;
#pragma unroll
        for (int ai = 0; ai < 2; ++ai)
#pragma unroll
            for (int bj = 0; bj < 2; ++bj)
#pragma unroll
                for (int m = 0; m < 4; ++m)
#pragma unroll
                    for (int n = 0; n < 2; ++n) acc[ai][bj][m][n] = *(const f32x4*)((const char*)R + (ofs + (unsigned)((ai * HALF + m * 16) * DM + bj * HALF + n * 4) * 4u));
    }
    __device__ __forceinline__ void operator()(f32x4 (&acc)[2][2][4][2], const Unit& u, int wr, int wc, int fr, int fq, LAS unsigned char* lds, int ui) const {
        const unsigned row0 = (unsigned)(u.pm * BM + wr * 64 + fr), col0 = (unsigned)(u.pn * BM + wc * 32 + 8 * fq);
        const unsigned ofs = (row0 * DM + col0) * 4u, pofs = (row0 * 16u + (unsigned)(u.pn * 4 + wc)) * 4u;
#pragma unroll
        for (int ai = 0; ai < 2; ++ai)
#pragma unroll
            for (int m = 0; m < 4; ++m) { const unsigned o = ofs + (unsigned)((ai * HALF + m * 16) * DM) * 4u; float ss = 0.f;
#pragma unroll
                for (int bj = 0; bj < 2; ++bj) { const unsigned oo = o + (unsigned)(bj * HALF) * 4u; const f32x4 h0 = acc[ai][bj][m][0], h1 = acc[ai][bj][m][1];
                    if (WRITE_H) { *(f32x4*)((char*)H + oo) = h0; *(f32x4*)((char*)H + oo + 16u) = h1; }
                    ss += ((h0[0] * h0[0] + h0[1] * h0[1]) + (h0[2] * h0[2] + h0[3] * h0[3])) + ((h1[0] * h1[0] + h1[1] * h1[1]) + (h1[2] * h1[2] + h1[3] * h1[3]));
                    if (WRITE_HB) { u32x4 w; w.x = pkbf(h0[0], h0[1]); w.y = pkbf(h0[2], h0[3]); w.z = pkbf(h1[0], h1[1]); w.w = pkbf(h1[2], h1[3]); *(u32x4*)((char*)HB + (oo >> 1)) = w; } }
                ss += xor_get(ss, fq * 16 + fr, 16); ss += xor_get(ss, fq * 16 + fr, 32);
                if (fq == 0) *(float*)((char*)part + (pofs + (unsigned)(ai * HALF + m * 16) * 64u)) = ss; }
    }
};
__device__ __forceinline__ float row_rstd_b(const float* part, unsigned bofs) {
    const f32x4* p = (const f32x4*)((const char*)part + bofs); const f32x4 a = p[0], b = p[1], c = p[2], d = p[3];
    return __builtin_amdgcn_rsqf((((a[0] + a[1]) + (a[2] + a[3])) + ((b[0] + b[1]) + (b[2] + b[3])) + ((c[0] + c[1]) + (c[2] + c[3])) + ((d[0] + d[1]) + (d[2] + d[3]))) * (1.0f / DM) + EPS);
}
__device__ __forceinline__ float dpp_shr_mul(float v, const int n) {
    const int iv = __builtin_bit_cast(int, v), one = 0x3f800000; int r;
    if (n == 1) r = __builtin_amdgcn_update_dpp(one, iv, 0x111, 0xf, 0xf, false); else if (n == 2) r = __builtin_amdgcn_update_dpp(one, iv, 0x112, 0xf, 0xf, false);
    else if (n == 4) r = __builtin_amdgcn_update_dpp(one, iv, 0x114, 0xf, 0xf, false); else r = __builtin_amdgcn_update_dpp(one, iv, 0x118, 0xf, 0xf, false);
    return v * __builtin_bit_cast(float, r);
}
constexpr unsigned TAB_OFF = 131072u + 256u;
struct EpiP4 {
    static constexpr bool PERM = true, AFTER_DRAIN = false;
    __device__ __forceinline__ void init_acc(f32x4 (&acc)[2][2][4][2], const Unit&, int, int, int, int) const { zero_acc(acc); }
    bf16_t* Qt; bf16_t* Kt; bf16_t* V; float* DEC; const float* part; const float* lbnd;
    __device__ __forceinline__ void prologue(const StaticOrder& S, LAS unsigned char* lds, int tid) const {
        LAS float* T = (LAS float*)(lds + TAB_OFF); Unit u;
        for (int i = 0; i < 12 && S.next(i, u); ++i)
            if (tid < 256) T[i * 256 + tid] = row_rstd_b(part, (unsigned)(u.pm * BM + tid) * 64u);
        __syncthreads();
    }
    __device__ __forceinline__ void operator()(f32x4 (&acc)[2][2][4][2], const Unit& u, int wr, int wc, int fr, int fq, LAS unsigned char* lds, int ui) const {
        const unsigned row0 = (unsigned)(u.pm * BM + wr * 64 + fr);
        const LAS float* T = (const LAS float*)(lds + TAB_OFF) + ui * 256 + wr * 64 + fr;
        if (u.pn >= 16) {
            const unsigned vofs = (row0 * DI + (unsigned)((u.pn - 16) * BM + wc * 32 + 8 * fq)) * 2u;
#pragma unroll
            for (int ai = 0; ai < 2; ++ai)
#pragma unroll
                for (int m = 0; m < 4; ++m) { const float rs = T[ai * HALF + m * 16];
#pragma unroll
                    for (int bj = 0; bj < 2; ++bj) { const f32x4 v0 = acc[ai][bj][m][0] * rs, v1 = acc[ai][bj][m][1] * rs;
                        u32x4 w; w.x = pkbf(v0[0], v0[1]); w.y = pkbf(v0[2], v0[3]); w.z = pkbf(v1[0], v1[1]); w.w = pkbf(v1[2], v1[3]);
                        *(u32x4*)((char*)V + (vofs + (unsigned)((ai * HALF + m * 16) * DI + bj * HALF) * 2u)) = w; } }
            return;
        }
        const unsigned c0 = (unsigned)(u.pn * HD + wc * 32 + 8 * fq);
        const unsigned qofs = (row0 * DI + c0) * 2u;
#pragma unroll
        for (int ai = 0; ai < 2; ++ai) {
            float rs[4];
#pragma unroll
            for (int m = 0; m < 4; ++m) rs[m] = T[ai * HALF + m * 16];
            unsigned cc = c0; asm volatile("" : "+v"(cc));
#pragma unroll
            for (int n = 0; n < 2; ++n) {
                const f32x4 l0 = *(const f32x4*)((const char*)lbnd + (cc + 4 * n) * 4u), l1 = *(const f32x4*)((const char*)lbnd + (cc + 4 * n + DI) * 4u);
                f32x4 decv;
#pragma unroll
                for (int j = 0; j < 4; ++j) { const float ex = __expf(l0[j] - l1[j]); const float lb = __builtin_amdgcn_rcpf(1.0f + ex), omlb = ex * lb; float bprod = 1.0f;
#pragma unroll
                    for (int m = 0; m < 4; ++m) {
                        const float qv = acc[ai][0][m][n][j] * rs[m], z = acc[ai][1][m][n][j] * rs[m];
                        const float sg = __builtin_amdgcn_rcpf(1.0f + __builtin_amdgcn_exp2f(-1.44269504089f * z));
                        const float f = lb + omlb * sg, k = omlb * (1.0f - sg);
                        float s = f; s = dpp_shr_mul(s, 1); s = dpp_shr_mul(s, 2); s = dpp_shr_mul(s, 4); s = dpp_shr_mul(s, 8);
                        const float E = bprod * s;
                        if (m < 3) bprod *= lane_get(s, fq * 16 + 15);
                        const float Ei = __builtin_amdgcn_rcpf(fmaxf(E, 7.9e-31f));
                        acc[ai][0][m][n][j] = qv * E; acc[ai][1][m][n][j] = k * Ei;
                        if (m == 3) decv[j] = E;
                    } }
                if (fr == 15) *(f32x4*)((char*)DEC + ((unsigned)(u.pm * 4 + ai * 2 + wr) * DI + cc + 4 * n) * 4u) = decv;
            }
#pragma unroll
            for (int m = 0; m < 4; ++m) { const unsigned ob = qofs + (unsigned)((ai * HALF + m * 16) * DI) * 2u;
                u32x4 w; w.x = pkbf(acc[ai][0][m][0][0], acc[ai][0][m][0][1]); w.y = pkbf(acc[ai][0][m][0][2], acc[ai][0][m][0][3]); w.z = pkbf(acc[ai][0][m][1][0], acc[ai][0][m][1][1]); w.w = pkbf(acc[ai][0][m][1][2], acc[ai][0][m][1][3]);
                *(u32x4*)((char*)Qt + ob) = w;
                u32x4 x; x.x = pkbf(acc[ai][1][m][0][0], acc[ai][1][m][0][1]); x.y = pkbf(acc[ai][1][m][0][2], acc[ai][1][m][0][3]); x.z = pkbf(acc[ai][1][m][1][0], acc[ai][1][m][1][1]); x.w = pkbf(acc[ai][1][m][1][2], acc[ai][1][m][1][3]);
                *(u32x4*)((char*)Kt + ob) = x; }
            asm volatile("" ::: "memory");
        }
    }
};
struct EpiP5b {
    static constexpr bool PERM = true, AFTER_DRAIN = false;
    __device__ __forceinline__ void init_acc(f32x4 (&acc)[2][2][4][2], const Unit&, int, int, int, int) const { zero_acc(acc); }
    bf16_t* O; const float* part; const float* ss;
    __device__ __forceinline__ void prologue(const StaticOrder& S, LAS unsigned char* lds, int tid) const {
        LAS float* T = (LAS float*)(lds + TAB_OFF); Unit u;
        for (int i = 0; i < 4 && S.next(i, u); ++i) {
            if (tid < 256) T[i * 768 + tid] = row_rstd_b(part, (unsigned)(u.pm * BM + tid) * 64u);
            { const int r = tid >> 1, hh = tid & 1; const f32x4* sp = (const f32x4*)(ss + (size_t)(u.pm * BM + r) * 128 + (u.pn * 2 + hh) * 8); const f32x4 s0 = sp[0], s1 = sp[1];
              T[i * 768 + 256 + tid] = __builtin_amdgcn_rsqf((((s0[0] + s0[1]) + (s0[2] + s0[3])) + ((s1[0] + s1[1]) + (s1[2] + s1[3]))) * (1.0f / HD) + EPS); }
        }
        __syncthreads();
    }
    __device__ __forceinline__ void operator()(f32x4 (&acc)[2][2][4][2], const Unit& u, int wr, int wc, int fr, int fq, LAS unsigned char* lds, int ui) const {
        const unsigned row0 = (unsigned)(u.pm * BM + wr * 64 + fr), col0 = (unsigned)(u.pn * BM + wc * 32 + 8 * fq);
        const LAS float* T = (const LAS float*)(lds + TAB_OFF) + ui * 768 + wr * 64 + fr;
        const unsigned oofs = (row0 * DI + col0) * 2u;
#pragma unroll
        for (int ai = 0; ai < 2; ++ai) {
            u32x4 ov[4][2];
#pragma unroll
            for (int m = 0; m < 4; ++m)
#pragma unroll
                for (int bj = 0; bj < 2; ++bj) ov[m][bj] = *(const u32x4*)((const char*)O + (oofs + (unsigned)((ai * HALF + m * 16) * DI + bj * HALF) * 2u));
#pragma unroll
            for (int m = 0; m < 4; ++m) { const int rl = ai * HALF + m * 16; const float rs = T[rl];
#pragma unroll
                for (int bj = 0; bj < 2; ++bj) { const f32x4 v0 = acc[ai][bj][m][0] * rs, v1 = acc[ai][bj][m][1] * rs;
                    const float rh = T[256 + 2 * rl + bj + (wr * 64 + fr)];
                    const u32x4 s = ov[m][bj];
                    u32x4 w; w.x = pkbf(bf_lo(s.x) * rh * silu_f(v0[0]), bf_hi(s.x) * rh * silu_f(v0[1])); w.y = pkbf(bf_lo(s.y) * rh * silu_f(v0[2]), bf_hi(s.y) * rh * silu_f(v0[3]));
                    w.z = pkbf(bf_lo(s.z) * rh * silu_f(v1[0]), bf_hi(s.z) * rh * silu_f(v1[1])); w.w = pkbf(bf_lo(s.w) * rh * silu_f(v1[2]), bf_hi(s.w) * rh * silu_f(v1[3]));
                    *(u32x4*)((char*)O + (oofs + (unsigned)((ai * HALF + m * 16) * DI + bj * HALF) * 2u)) = w; } }
            asm volatile("" ::: "memory"); }
    }
};
struct EpiFinal {
    static constexpr bool PERM = true, AFTER_DRAIN = false;
    __device__ __forceinline__ void init_acc(f32x4 (&acc)[2][2][4][2], const Unit&, int, int, int, int) const { zero_acc(acc); }
    const bf16_t* HB; float* H; const float* fg; float* X; unsigned* cnt;
    __device__ __forceinline__ void prologue(const StaticOrder&, LAS unsigned char*, int) const {}
    __device__ __forceinline__ void operator()(f32x4 (&acc)[2][2][4][2], const Unit& u, int wr, int wc, int fr, int fq, LAS unsigned char* lds, int ui) const {
        LAS float* Pt = (LAS float*)(lds + TAB_OFF);
        LAS float* St = Pt + 1024;
        const int tid = (wr * 4 + wc) * 64 + fq * 16 + fr;
        const unsigned row0 = (unsigned)(u.pm * BM + wr * 64 + fr), col0 = (unsigned)(u.pn * BM + wc * 32 + 8 * fq);
        const unsigned ofs = (row0 * DM + col0) * 4u;
#pragma unroll
        for (int ai = 0; ai < 2; ++ai) {
            u32x4 hv[4][2];
#pragma unroll
            for (int m = 0; m < 4; ++m)
#pragma unroll
                for (int bj = 0; bj < 2; ++bj) hv[m][bj] = *(const u32x4*)((const char*)HB + ((ofs + (unsigned)((ai * HALF + m * 16) * DM + bj * HALF) * 4u) >> 1));
#pragma unroll
            for (int m = 0; m < 4; ++m) { float ss = 0.f;
#pragma unroll
                for (int bj = 0; bj < 2; ++bj) { const u32x4 hb = hv[m][bj];
                    const f32x4 h0 = acc[ai][bj][m][0] + (f32x4){bf_lo(hb.x), bf_hi(hb.x), bf_lo(hb.y), bf_hi(hb.y)}, h1 = acc[ai][bj][m][1] + (f32x4){bf_lo(hb.z), bf_hi(hb.z), bf_lo(hb.w), bf_hi(hb.w)};
                    acc[ai][bj][m][0] = h0; acc[ai][bj][m][1] = h1;
                    ss += ((h0[0] * h0[0] + h0[1] * h0[1]) + (h0[2] * h0[2] + h0[3] * h0[3])) + ((h1[0] * h1[0] + h1[1] * h1[1]) + (h1[2] * h1[2] + h1[3] * h1[3])); }
                ss += xor_get(ss, fq * 16 + fr, 16); ss += xor_get(ss, fq * 16 + fr, 32);
                if (fq == 0) Pt[(ai * HALF + wr * 64 + m * 16 + fr) * 4 + wc] = ss; }
            asm volatile("" ::: "memory"); }
        __syncthreads();
        float* xs = X + (size_t)u.pm * 1024;
        if (tid < 256) { const f32x4 p = *(const LAS f32x4*)(Pt + tid * 4);
            __hip_atomic_store(xs + u.pn * 256 + tid, (p[0] + p[1]) + (p[2] + p[3]), __ATOMIC_RELAXED, __HIP_MEMORY_SCOPE_AGENT); }
        asm volatile("s_waitcnt vmcnt(0)" ::: "memory");
        __syncthreads();
        if (tid == 0) {
            unsigned* c = cnt + 16 * u.pm;
            __hip_atomic_fetch_add(c, 1u, __ATOMIC_RELAXED, __HIP_MEMORY_SCOPE_AGENT);
            unsigned spins = 0;
            while (__hip_atomic_load(c, __ATOMIC_RELAXED, __HIP_MEMORY_SCOPE_AGENT) < 4u) { __builtin_amdgcn_s_sleep(2); if (++spins > (1u << 22)) break; }
            __builtin_amdgcn_fence(__ATOMIC_ACQUIRE, "agent");
            asm volatile("s_waitcnt vmcnt(0)" ::: "memory");
        }
        __syncthreads();
        if (tid < 256) { float s = 0.f;
#pragma unroll
            for (int t = 0; t < 4; ++t) s += __hip_atomic_load(xs + t * 256 + tid, __ATOMIC_RELAXED, __HIP_MEMORY_SCOPE_AGENT);
            St[tid] = __builtin_amdgcn_rsqf(s * (1.0f / DM) + EPS); }
        __syncthreads();
        f32x4 gv[2][2];
#pragma unroll
        for (int bj = 0; bj < 2; ++bj)
#pragma unroll
            for (int n = 0; n < 2; ++n) gv[bj][n] = *(const f32x4*)(fg + col0 + bj * HALF + n * 4);
#pragma unroll
        for (int ai = 0; ai < 2; ++ai)
#pragma unroll
            for (int m = 0; m < 4; ++m) { const float rs = St[ai * HALF + wr * 64 + m * 16 + fr];
#pragma unroll
                for (int bj = 0; bj < 2; ++bj) { const unsigned oo = ofs + (unsigned)((ai * HALF + m * 16) * DM + bj * HALF) * 4u;
                    *(f32x4*)((char*)H + oo) = acc[ai][bj][m][0] * rs * gv[bj][0]; *(f32x4*)((char*)H + oo + 16u) = acc[ai][bj][m][1] * rs * gv[bj][1]; } }
        __syncthreads();
    }
};
}

namespace scan {
#define MFMA16(a, b, c) __builtin_amdgcn_mfma_f32_16x16x32_bf16((a), (b), (c), 0, 0, 0)
__device__ __forceinline__ unsigned offb(unsigned row, unsigned ch) { return 256u * row + 16u * (ch ^ (((row & 3u) << 2) | ((row >> 2) & 3u))); }
__device__ __forceinline__ unsigned voffv(unsigned r, unsigned cp) { return 128u * r + 32u * (cp ^ (((r >> 1) & 3u) ^ (((r >> 3) & 1u) << 1))); }
__device__ __forceinline__ void tr8(unsigned a0, unsigned a1, unsigned c0, unsigned c1, bf16x8& f00, bf16x8& f01, bf16x8& f10, bf16x8& f11) {
    u32x2 r0, r1, r2, r3, r4, r5, r6, r7;
    asm volatile("ds_read_b64_tr_b16 %0, %8\n\tds_read_b64_tr_b16 %1, %9\n\tds_read_b64_tr_b16 %2, %8 offset:8192\n\tds_read_b64_tr_b16 %3, %9 offset:8192\n\t"
                 "ds_read_b64_tr_b16 %4, %10\n\tds_read_b64_tr_b16 %5, %11\n\tds_read_b64_tr_b16 %6, %10 offset:8192\n\tds_read_b64_tr_b16 %7, %11 offset:8192\n\ts_waitcnt lgkmcnt(0)"
                 : "=&v"(r0), "=&v"(r1), "=&v"(r2), "=&v"(r3), "=&v"(r4), "=&v"(r5), "=&v"(r6), "=&v"(r7) : "v"(a0), "v"(a1), "v"(c0), "v"(c1) : "memory");
    const u32x4 x00 = {r0.x, r0.y, r1.x, r1.y}, x01 = {r2.x, r2.y, r3.x, r3.y}, x10 = {r4.x, r4.y, r5.x, r5.y}, x11 = {r6.x, r6.y, r7.x, r7.y};
    f00 = __builtin_bit_cast(bf16x8, x00); f01 = __builtin_bit_cast(bf16x8, x01); f10 = __builtin_bit_cast(bf16x8, x10); f11 = __builtin_bit_cast(bf16x8, x11);
}
__device__ __forceinline__ bf16x8 pack8(const f32x4 a, const f32x4 b) { const u32x4 r = {pkbf(a[0], a[1]), pkbf(a[2], a[3]), pkbf(b[0], b[1]), pkbf(b[2], b[3])}; return __builtin_bit_cast(bf16x8, r); }
__device__ __forceinline__ u32x2 tr_issue(unsigned a) { u32x2 r; asm volatile("ds_read_b64_tr_b16 %0, %1" : "=v"(r) : "v"(a) : "memory"); return r; }
__device__ __forceinline__ bf16x8 frag2(const u32x2 lo, const u32x2 hi) { const u32x4 r = {lo.x, lo.y, hi.x, hi.y}; return __builtin_bit_cast(bf16x8, r); }
__device__ __forceinline__ u32x2 at_tile(LAS unsigned char* lds, unsigned QI, unsigned KI, int it, int j, unsigned l15, unsigned g) {
    f32x4 c = (f32x4){0.f, 0.f, 0.f, 0.f};
#pragma unroll
    for (int kd = 0; kd < 4; ++kd) { const bf16x8 qb = *(const LAS bf16x8*)(lds + QI + offb(16u * (unsigned)it + l15, 4u * kd + g)), a = *(const LAS bf16x8*)(lds + KI + offb(16u * (unsigned)j + l15, 4u * kd + g)); c = MFMA16(a, qb, c); }
    if (j == it) {
#pragma unroll
        for (int r = 0; r < 4; ++r) c[r] = (4u * g + r <= l15) ? c[r] : 0.f; }
    const u32x2 w = {pkbf(c[0], c[1]), pkbf(c[2], c[3])}; return w;
}
template <int NK>
__device__ __forceinline__ f32x4 o_part(LAS unsigned char* lds, unsigned QI, int it, const bf16x8 (&at)[NK], const bf16x8 (&vf)[2], const bf16x8 (&sfrag)[4], unsigned l15, unsigned g) {
    const unsigned trow = 16u * (unsigned)it + l15;
    f32x4 o = (f32x4){0.f, 0.f, 0.f, 0.f};
#pragma unroll
    for (int ks = 0; ks < NK; ++ks) if (2 * ks <= it) o = MFMA16(vf[ks], at[ks], o);
#pragma unroll
    for (int kd = 0; kd < 4; ++kd) {
        const u32x2 q0 = *(const LAS u32x2*)(lds + QI + offb(trow, 4u * kd + (g >> 1)) + 8u * (g & 1)), q1 = *(const LAS u32x2*)(lds + QI + offb(trow, 4u * kd + 2u + (g >> 1)) + 8u * (g & 1));
        o = MFMA16(sfrag[kd], frag2(q0, q1), o); }
    return o;
}
__device__ __forceinline__ void phase(LAS unsigned char* lds, const bf16_t* Qt, const bf16_t* Kt, bf16_t* VO, const float* DEC, float* ss8, int bid, int G, int wave) {
    int lane_ = fresh_lane_id();
    const unsigned lane = (unsigned)lane_, l15 = lane & 15u, g = lane >> 4, ql = l15 >> 2, p = lane & 3u;
    const unsigned vs = (unsigned)wave & 3u; const int th = wave >> 2, tA = th ? 1 : 0, tB = th ? 2 : 3;
    const unsigned ldsb = (unsigned)(uintptr_t)lds;
    constexpr unsigned BUFB = 40960u, DECB = 3u * BUFB, ATB = 131072u + 256u;
    unsigned qoff[2], voff_, doff;
#pragma unroll
    for (int i = 0; i < 2; ++i) { const unsigned j = 2u * (unsigned)wave + i, r = 4u * j + (lane >> 4), pc = lane & 15u, ch = pc ^ (((r & 3u) << 2) | ((r >> 2) & 3u)); qoff[i] = (r * DI + ch * 8u) * 2u; }
    { const unsigned r = 8u * (unsigned)wave + (lane >> 3), s16 = lane & 7u, ul = (s16 >> 1) ^ (((r >> 1) & 3u) ^ (((r >> 3) & 1u) << 1)); voff_ = (r * DI + (ul * 2u + (s16 & 1u)) * 8u) * 2u; }
    doff = (64u * ((unsigned)wave & 1u) + lane) * 4u;
    const int my_it = wave == 0 ? 0 : wave <= 2 ? 1 : wave <= 5 ? 2 : 3, my_j = wave == 0 ? 0 : wave <= 2 ? wave - 1 : wave <= 5 ? wave - 3 : wave - 6;
    for (int item = bid; item < BATCH * NHEAD * 2; item += G) {
        const int half = (item >> 3) & 1, pair = (item & 7) | ((item >> 4) << 3), b = pair >> 4, h = pair & 15;
        const size_t tokb = (size_t)b * SEQ;
        const char* qg = (const char*)(Qt + tokb * DI + h * HD);
        const char* kg = (const char*)(Kt + tokb * DI + h * HD);
        bf16_t* vg = VO + tokb * DI + h * HD + half * 64;
        const char* dg = (const char*)(DEC + (size_t)(b * (SEQ / 64)) * DI + h * HD);
        f32x4 S[8]; bf16x8 sfrag[4];
#pragma unroll
        for (int i = 0; i < 8; ++i) S[i] = (f32x4){0.f, 0.f, 0.f, 0.f};
#pragma unroll
        for (int i = 0; i < 4; ++i) sfrag[i] = (bf16x8){0, 0, 0, 0, 0, 0, 0, 0};
#define SC_DMA(n_, base_) do { const size_t c_ = (size_t)(n_) * 64 * DI * 2; \
            __builtin_amdgcn_global_load_lds((const unsigned*)(qg + c_ + qoff[0]), (LAS unsigned*)(lds + (base_) + (unsigned)wave * 2048u), 16, 0, 0); \
            __builtin_amdgcn_global_load_lds((const unsigned*)(qg + c_ + qoff[1]), (LAS unsigned*)(lds + (base_) + (unsigned)wave * 2048u + 1024u), 16, 0, 0); \
            __builtin_amdgcn_global_load_lds((const unsigned*)(kg + c_ + qoff[0]), (LAS unsigned*)(lds + (base_) + 16384u + (unsigned)wave * 2048u), 16, 0, 0); \
            __builtin_amdgcn_global_load_lds((const unsigned*)(kg + c_ + qoff[1]), (LAS unsigned*)(lds + (base_) + 16384u + (unsigned)wave * 2048u + 1024u), 16, 0, 0); \
            __builtin_amdgcn_global_load_lds((const unsigned*)((const char*)vg + c_ + voff_), (LAS unsigned*)(lds + (base_) + 32768u + (unsigned)wave * 1024u), 16, 0, 0); \
            __builtin_amdgcn_global_load_lds((const unsigned*)(dg + (size_t)(n_) * DI * 4 + doff), (LAS unsigned*)(lds + DECB + ((base_) / BUFB) * 512u + ((unsigned)wave & 1u) * 256u), 4, 0, 0); } while (0)
#define SC_AT(c_, base_) do { LAS u32x2* atw = (LAS u32x2*)(lds + ATB + (unsigned)((c_) & 1) * 5120u) + lane; \
            atw[64 * wave] = at_tile(lds, (base_), (base_) + 16384u, my_it, my_j, l15, g); \
            if (wave < 2) atw[64 * (8 + wave)] = at_tile(lds, (base_), (base_) + 16384u, 3, 2 + wave, l15, g); } while (0)
        SC_DMA(0, 0u); SC_DMA(1, BUFB);
        asm volatile("s_waitcnt vmcnt(0)" ::: "memory");
        __builtin_amdgcn_s_barrier();
        SC_AT(0, 0u);
        asm volatile("s_waitcnt lgkmcnt(0)" ::: "memory");
        __builtin_amdgcn_s_barrier();
        for (int n = 0; n < SEQ / 64; ++n) {
            const unsigned bi = (unsigned)n % 3u, QI = bi * BUFB, KI = QI + 16384u, VI = QI + 32768u;
            if (n + 2 < SEQ / 64) SC_DMA(n + 2, ((unsigned)(n + 2) % 3u) * BUFB);
            u32x2 tv0, tv1, tv2, tv3, tv4, tv5, tv6, tv7;
            {
                const unsigned va = ldsb + VI + 8u * p;
                tv0 = tr_issue(va + voffv(4u * g + ql, vs)); tv1 = tr_issue(va + voffv(16u + 4u * g + ql, vs)); tv2 = tr_issue(va + voffv(32u + 4u * g + ql, vs)); tv3 = tr_issue(va + voffv(48u + 4u * g + ql, vs));
                tv4 = tr_issue(va + voffv(8u * g + ql, vs)); tv5 = tr_issue(va + voffv(8u * g + 4u + ql, vs)); tv6 = tr_issue(va + voffv(32u + 8u * g + ql, vs)); tv7 = tr_issue(va + voffv(36u + 8u * g + ql, vs));
            }
            if (n + 1 < SEQ / 64) SC_AT(n + 1, (((unsigned)(n + 1)) % 3u) * BUFB);
            bf16x8 atB[2], atA[1];
            { const LAS u32x2* atr = (const LAS u32x2*)(lds + ATB + (unsigned)(n & 1) * 5120u) + lane; const u32x2 z2 = {0u, 0u};
              if (th == 0) { atB[0] = frag2(atr[64 * 6], atr[64 * 7]); atB[1] = frag2(atr[64 * 8], atr[64 * 9]); atA[0] = frag2(atr[0], z2); }
              else         { atB[0] = frag2(atr[64 * 3], atr[64 * 4]); atB[1] = frag2(atr[64 * 5], z2);          atA[0] = frag2(atr[64 * 1], atr[64 * 2]); } }
            asm volatile("s_waitcnt lgkmcnt(0)" : "+v"(tv0), "+v"(tv1), "+v"(tv2), "+v"(tv3), "+v"(tv4), "+v"(tv5), "+v"(tv6), "+v"(tv7) :: "memory");
            __builtin_amdgcn_sched_barrier(0);
            const bf16x8 vf[2] = {frag2(tv0, tv1), frag2(tv2, tv3)};
            const f32x4 oB = o_part<2>(lds, QI, tB, atB, vf, sfrag, l15, g);
            const f32x4 oA = o_part<1>(lds, QI, tA, atA, vf, sfrag, l15, g);
            {
                const bf16x8 vn0 = frag2(tv4, tv5), vn1 = frag2(tv6, tv7);
                const LAS float* dcp = (const LAS float*)(lds + DECB + bi * 512u) + 4u * g;
                const unsigned ka = ldsb + KI + offb(8u * g + ql, (p >> 1)) + 8u * (p & 1u), kb = ldsb + KI + offb(8u * g + 4u + ql, (p >> 1)) + 8u * (p & 1u);
#pragma unroll
                for (int i = 0; i < 8; i += 2) {
                    bf16x8 k00, k01, k10, k11;
                    tr8(ka ^ ((unsigned)i << 5), kb ^ ((unsigned)i << 5), ka ^ ((unsigned)(i + 1) << 5), kb ^ ((unsigned)(i + 1) << 5), k00, k01, k10, k11);
                    S[i] = MFMA16(k00, vn0, S[i]); S[i + 1] = MFMA16(k10, vn0, S[i + 1]); S[i] = MFMA16(k01, vn1, S[i]); S[i + 1] = MFMA16(k11, vn1, S[i + 1]); }
#pragma unroll
                for (int i = 0; i < 8; ++i) { const f32x4 dc = *(const LAS f32x4*)(dcp + 16 * i); S[i] = S[i] * dc; }
#pragma unroll
                for (int kd = 0; kd < 4; ++kd) sfrag[kd] = pack8(S[2 * kd], S[2 * kd + 1]);
            }
            asm volatile("s_waitcnt vmcnt(0)" ::: "memory");
            {
                const size_t tlB = (size_t)n * 64 + 16u * (unsigned)tB + l15, tlA = (size_t)n * 64 + 16u * (unsigned)tA + l15;
                const u32x2 wB = {pkbf(oB[0], oB[1]), pkbf(oB[2], oB[3])}, wA = {pkbf(oA[0], oA[1]), pkbf(oA[2], oA[3])};
                *(u32x2*)(vg + tlB * DI + 16u * vs + 4u * g) = wB; *(u32x2*)(vg + tlA * DI + 16u * vs + 4u * g) = wA;
                float sB = (oB[0] * oB[0] + oB[1] * oB[1]) + (oB[2] * oB[2] + oB[3] * oB[3]), sA = (oA[0] * oA[0] + oA[1] * oA[1]) + (oA[2] * oA[2] + oA[3] * oA[3]);
                sB += xor_get(sB, (int)lane, 16); sA += xor_get(sA, (int)lane, 16); sB += xor_get(sB, (int)lane, 32); sA += xor_get(sA, (int)lane, 32);
                if (g == 0) { ss8[(tokb + tlB) * 128 + h * 8 + half * 4 + vs] = sB; ss8[(tokb + tlA) * 128 + h * 8 + half * 4 + vs] = sA; }
            }
            asm volatile("s_waitcnt lgkmcnt(0)" ::: "memory");
            __builtin_amdgcn_s_barrier();
        }
#undef SC_DMA
#undef SC_AT
    }
}
#undef MFMA16
}

#define XB_TMO      128
#define XB_XCNT(j)  (256  + 64 * (j))
#define XB_XSUB(j)  (1280 + 64 * (j))
#define XB_XGEN(j)  (2304 + 64 * (j))
#define XB_TOP      3328
#define XB_TOPGEN   3392
#define XCD_BAR_WORDS 3456
#define XB_SPIN_CAP (1u << 18)
__device__ __forceinline__ unsigned xb_ld(unsigned* p)              { return __hip_atomic_load(p, __ATOMIC_RELAXED, __HIP_MEMORY_SCOPE_AGENT); }
__device__ __forceinline__ unsigned xb_add(unsigned* p, unsigned v) { return __hip_atomic_fetch_add(p, v, __ATOMIC_RELAXED, __HIP_MEMORY_SCOPE_AGENT); }
__device__ __forceinline__ unsigned xb_xcc_id() { return (unsigned)__builtin_amdgcn_s_getreg((3 << 11) | 20) & 0xFu; }
#define XB_SPIN(cond, bar) do { unsigned _sp = 0; while (cond) { __builtin_amdgcn_s_sleep(1); \
    if ((++_sp & 255u) == 0u) { if (xb_ld(&(bar)[XB_TMO])) break; if (_sp > XB_SPIN_CAP) { atomicAdd(&(bar)[XB_TMO], 1u); break; } } } } while (0)
struct XcdBarrier { unsigned* bar; unsigned x; volatile LAS unsigned* st; };
__device__ __forceinline__ XcdBarrier xcd_barrier_post(unsigned* bar, volatile LAS unsigned* st) {
    XcdBarrier b; b.bar = bar; b.x = xb_xcc_id(); b.st = st;
    if (threadIdx.x == 0) (void)xb_add(&bar[XB_XCNT(b.x)], 1u);
    return b;
}
__device__ __forceinline__ void xcd_barrier_complete(unsigned* bar, unsigned x, unsigned& nloc, unsigned& nx) {
    const unsigned G = gridDim.x * gridDim.y * gridDim.z;
    unsigned sum, cnt, mine, sp = 0u;
    for (;;) {
        sum = 0u; cnt = 0u; mine = 0u;
#pragma unroll
        for (unsigned j = 0; j < 16; ++j) { const unsigned c = xb_ld(&bar[XB_XCNT(j)]); sum += c; cnt += (c > 0u) ? 1u : 0u; mine = (j == x) ? c : mine; }
        if (sum == G) break;
        __builtin_amdgcn_s_sleep(1);
        if ((++sp & 255u) == 0u) { if (xb_ld(&bar[XB_TMO])) break; if (sp > XB_SPIN_CAP) { atomicAdd(&bar[XB_TMO], 1u); break; } }
    }
    nloc = mine > 0u ? mine : 1u; nx = cnt > 0u ? cnt : 1u;
}
__device__ __forceinline__ void xcd_barrier(const XcdBarrier& b) {
    asm volatile("s_waitcnt vmcnt(0)" ::: "memory");
    __syncthreads();
    if (threadIdx.x == 0) {
        unsigned* bar = b.bar;
        __builtin_amdgcn_s_waitcnt(0);
        unsigned nloc = b.st[0], nx = b.st[1];
        if (nloc == 0u) { xcd_barrier_complete(bar, b.x, nloc, nx); b.st[0] = nloc; b.st[1] = nx; }
        const unsigned old = xb_add(&bar[XB_XSUB(b.x)], 1u);
        const unsigned gen = old / nloc;
        if (old + 1u == (gen + 1u) * nloc) {
            __builtin_amdgcn_fence(__ATOMIC_RELEASE, "agent");
            asm volatile("s_waitcnt vmcnt(0)" ::: "memory");
            const unsigned og = xb_add(&bar[XB_TOP], 1u);
            const unsigned tg = og / nx;
            if (og + 1u == (tg + 1u) * nx) xb_add(&bar[XB_TOPGEN], 1u);
            else XB_SPIN(xb_ld(&bar[XB_TOPGEN]) == tg, bar);
            __builtin_amdgcn_fence(__ATOMIC_ACQUIRE, "agent");
            xb_add(&bar[XB_XGEN(b.x)], 1u);
            asm volatile("s_waitcnt vmcnt(0)" ::: "memory");
        } else {
            XB_SPIN(xb_ld(&bar[XB_XGEN(b.x)]) == gen, bar);
            __builtin_amdgcn_fence(__ATOMIC_ACQUIRE, "agent");
            asm volatile("s_waitcnt vmcnt(0)" ::: "memory");
        }
    }
    __syncthreads();
}

struct Args {
    const float* x; const float* norm_g; const float* pool_w_in; const float* pool_w_grp; const float* pool_scale; const float* pool_w_out;
    const float* hgrn_w_in; const float* hgrn_lb; const float* hgrn_norm_g; const float* hgrn_w_out; const float* final_g;
    float* out; unsigned char* ws;
};

struct TItem { const float* W; bf16_t* WT; const float* ks; const float* ns; int K, N, row_off, item; };
__device__ __forceinline__ void titem_issue(const TItem& t, int lane, float (&wv)[32]) {
    const int nblk = t.N / 32, kb = t.item / nblk, nb = t.item % nblk, k0 = 64 * kb, n0 = 32 * nb;
    const float* wp = t.W + (size_t)(k0 + (lane >> 5)) * t.N + n0 + (lane & 31);
#pragma unroll
    for (int i = 0; i < 32; ++i) wv[i] = wp[(size_t)(2 * i) * t.N];
}
__device__ __forceinline__ void titem_finish(const TItem& t, int lane, const float (&wv)[32], LAS float* scr) {
    const int nblk = t.N / 32, kb = t.item / nblk, nb = t.item % nblk, k0 = 64 * kb, n0 = 32 * nb;
    const float nsv = t.ns ? t.ns[n0 + (lane & 31)] : 1.0f;
    const float ksv = t.ks ? t.ks[k0 + lane] : 1.0f;
#pragma unroll
    for (int i = 0; i < 32; ++i) { const int kk = 2 * i + (lane >> 5); scr[kk * 33 + (lane & 31)] = wv[i] * nsv * lane_get(ksv, kk); }
    asm volatile("s_waitcnt lgkmcnt(0)" ::: "memory");
    const int c = lane & 7;
#pragma unroll
    for (int j = 0; j < 4; ++j) { const int n = (lane >> 3) + 8 * j; const LAS float* s = scr + (8 * c) * 33 + n;
        u32x4 o; o.x = pkbf(s[0 * 33], s[1 * 33]); o.y = pkbf(s[2 * 33], s[3 * 33]); o.z = pkbf(s[4 * 33], s[5 * 33]); o.w = pkbf(s[6 * 33], s[7 * 33]);
        *(u32x4*)(t.WT + (size_t)(t.row_off + n0 + n) * t.K + k0 + 8 * c) = o; }
    asm volatile("s_waitcnt lgkmcnt(0)" ::: "memory");
}

__global__ void __launch_bounds__(512, 2) fwd_kernel(Args a) {
    extern __shared__ __attribute__((aligned(16))) unsigned char lds_raw[];
    LAS unsigned char* lds = (LAS unsigned char*)lds_raw;
    volatile LAS unsigned* xst = (volatile LAS unsigned*)(lds + 131072 + 64);
    if (threadIdx.x < 2) xst[threadIdx.x] = 0u;
    __syncthreads();
    const XcdBarrier xbar = xcd_barrier_post((unsigned*)a.ws, xst);
#define GRID_BAR() xcd_barrier(xbar)
    const int G = gridDim.x, bid = blockIdx.x;
    const int NGW = G * 8;
    const int wave = __builtin_amdgcn_readfirstlane((int)threadIdx.x >> 6);
#define PHASE_IDS int lane_ = fresh_lane_id(); const int lane = lane_, tid = wave * 64 + lane, gw = bid * 8 + wave; (void)gw; (void)tid;
    unsigned char* ws = a.ws;
    bf16_t* Wt_in0 = (bf16_t*)(ws + WS_WIN0); bf16_t* Wt_grp = (bf16_t*)(ws + WS_WGRP); bf16_t* Wt_out0 = (bf16_t*)(ws + WS_WOUT0);
    bf16_t* Wt_in1 = (bf16_t*)(ws + WS_WIN1); bf16_t* Wt_out1 = (bf16_t*)(ws + WS_WOUT1);
    float* part1 = (float*)(ws + WS_PART1); float* ssb = (float*)(ws + WS_SS); float* decb = (float*)(ws + WS_DEC);
    bf16_t* XB = (bf16_t*)(ws + WS_XB); bf16_t* BA = (bf16_t*)(ws + WS_A); bf16_t* BB = (bf16_t*)(ws + WS_B); bf16_t* BC = (bf16_t*)(ws + WS_C);

    {
        PHASE_IDS
        LAS float* scr = (LAS float*)(lds + wave * 16384);
        constexpr int I_IN0 = (DM / 64) * (4096 / 32), I_GRP1 = (512 / 64) * (512 / 32), I_OUT = (DI / 64) * (DM / 32), I_IN1 = (DM / 64) * (8192 / 32);
        constexpr int NITEMS = I_IN0 + 4 * I_GRP1 + I_OUT + I_IN1 + I_OUT;
        auto decode = [&](int it) -> TItem {
            int r = it;
            if (r < I_IN0) return TItem{a.pool_w_in, Wt_in0, a.norm_g, nullptr, DM, 4096, 0, r}; r -= I_IN0;
            if (r < 4 * I_GRP1) { const int g = r / I_GRP1; return TItem{a.pool_w_grp + (size_t)g * 512 * 512, Wt_grp, nullptr, a.pool_scale + g * 512, 512, 512, g * 512, r % I_GRP1}; } r -= 4 * I_GRP1;
            if (r < I_OUT) return TItem{a.pool_w_out, Wt_out0, nullptr, nullptr, DI, DM, 0, r}; r -= I_OUT;
            if (r < I_IN1) {
                const int n0 = 32 * (r % (8192 / 32)); int d0 = n0;
                if (n0 < 2048) d0 = 256 * (n0 >> 7) + (n0 & 127); else if (n0 < 4096) d0 = 256 * ((n0 - 2048) >> 7) + 128 + (n0 & 127);
                return TItem{a.hgrn_w_in, Wt_in1, a.norm_g + DM, nullptr, DM, 8192, d0 - n0, r}; } r -= I_IN1;
            return TItem{a.hgrn_w_out, Wt_out1, a.hgrn_norm_g, nullptr, DI, DM, 0, r};
        };
        {
            float wa[32], wb[32]; TItem ia{}, ib{};
            int it = gw; bool ha = it < NITEMS;
            if (ha) { ia = decode(it); titem_issue(ia, lane, wa); }
            while (ha) {
                const int itb = it + NGW; const bool hb = itb < NITEMS;
                if (hb) { ib = decode(itb); titem_issue(ib, lane, wb); }
                titem_finish(ia, lane, wa, scr);
                it = itb + NGW; ha = it < NITEMS;
                if (ha) { ia = decode(it); titem_issue(ia, lane, wa); }
                if (!hb) break;
                titem_finish(ib, lane, wb, scr);
            }
        }
        for (int m0 = gw * 8; m0 < M; m0 += NGW * 8) {
            f32x4 v[8][4]; float s[8];
#pragma unroll
            for (int r = 0; r < 8; ++r) { const f32x4* xr = (const f32x4*)(a.x + (size_t)(m0 + r) * DM) + lane;
#pragma unroll
                for (int j = 0; j < 4; ++j) v[r][j] = xr[64 * j]; }
#pragma unroll
            for (int r = 0; r < 8; ++r) { s[r] = 0.f;
#pragma unroll
                for (int j = 0; j < 4; ++j) s[r] += (v[r][j][0] * v[r][j][0] + v[r][j][1] * v[r][j][1]) + (v[r][j][2] * v[r][j][2] + v[r][j][3] * v[r][j][3]); }
#pragma unroll
            for (int o = 1; o < 64; o <<= 1) {
#pragma unroll
                for (int r = 0; r < 8; ++r) s[r] += xor_get(s[r], lane, o); }
#pragma unroll
            for (int r = 0; r < 8; ++r) { const float rstd = 1.0f / sqrtf(s[r] * (1.0f / DM) + EPS);
                unsigned long long* o8 = (unsigned long long*)(XB + (size_t)(m0 + r) * DM) + lane;
#pragma unroll
                for (int j = 0; j < 4; ++j) o8[64 * j] = (unsigned long long)pkbf(v[r][j][0] * rstd, v[r][j][1] * rstd) | ((unsigned long long)pkbf(v[r][j][2] * rstd, v[r][j][3] * rstd) << 32); }
        }
    }
    GRID_BAR();

    {
        pg8::Gemm g{XB, Wt_in0, DM, DM, DM, 0}; pg8::StaticOrder S; S.init(M, 4096, G, bid);
        pg8::EpiP1 E{BA, BB};
        pg8::gemm_phase<pg8::EpiP1>(lds, g, S, E, wave);
    }
    GRID_BAR();

    {
        PHASE_IDS
        constexpr int RUN = 64;
        const int nruns = (M / RUN) * (DI / 8);
        for (int idx = bid * 512 + tid; idx < nruns; idx += G * 512) {
            const int cgp = idx & 255, run = idx >> 8, grp = cgp >> 6, w = 2 << grp;
            const int m0 = run * RUN, t0 = m0 & (SEQ - 1);
            const bf16_t* vp = BA + (size_t)m0 * DI + cgp * 8; bf16_t* pp = BC + (size_t)m0 * DI + cgp * 8;
            float sum[8];
#pragma unroll
            for (int j = 0; j < 8; ++j) sum[j] = 0.f;
            if (t0 > 0) for (int k = 1; k < w; ++k) { const u32x4 vv = *(const u32x4*)(vp - (size_t)k * DI);
                sum[0] += bf_lo(vv.x); sum[1] += bf_hi(vv.x); sum[2] += bf_lo(vv.y); sum[3] += bf_hi(vv.y); sum[4] += bf_lo(vv.z); sum[5] += bf_hi(vv.z); sum[6] += bf_lo(vv.w); sum[7] += bf_hi(vv.w); }
            for (int i0 = 0; i0 < RUN; i0 += 8) {
                u32x4 vin[8], vout[8];
#pragma unroll
                for (int j = 0; j < 8; ++j) vin[j] = *(const u32x4*)(vp + (size_t)(i0 + j) * DI);
#pragma unroll
                for (int j = 0; j < 8; ++j) { const int i = i0 + j; vout[j] = (t0 + i + 1 >= w) ? *(const u32x4*)(vp + (size_t)(i + 1 - w) * DI) : (u32x4){0u, 0u, 0u, 0u}; }
#pragma unroll
                for (int j = 0; j < 8; ++j) {
                    const int i = i0 + j, t = t0 + i;
                    const u32x4 vv = vin[j];
                    float x[8] = {bf_lo(vv.x), bf_hi(vv.x), bf_lo(vv.y), bf_hi(vv.y), bf_lo(vv.z), bf_hi(vv.z), bf_lo(vv.w), bf_hi(vv.w)};
#pragma unroll
                    for (int c = 0; c < 8; ++c) sum[c] += x[c];
                    const int cnt = (t + 1) < w ? (t + 1) : w; const float inv = 1.0f / (float)cnt;
                    u32x4 o; o.x = pkbf(sum[0] * inv - x[0], sum[1] * inv - x[1]); o.y = pkbf(sum[2] * inv - x[2], sum[3] * inv - x[3]);
                    o.z = pkbf(sum[4] * inv - x[4], sum[5] * inv - x[5]); o.w = pkbf(sum[6] * inv - x[6], sum[7] * inv - x[7]);
                    *(u32x4*)(pp + (size_t)i * DI) = o;
                    const u32x4 uu = vout[j];
                    sum[0] -= bf_lo(uu.x); sum[1] -= bf_hi(uu.x); sum[2] -= bf_lo(uu.y); sum[3] -= bf_hi(uu.y); sum[4] -= bf_lo(uu.z); sum[5] -= bf_hi(uu.z); sum[6] -= bf_lo(uu.w); sum[7] -= bf_hi(uu.w);
                }
            }
        }
    }
    GRID_BAR();

    {
        pg8::Gemm g{BC, Wt_grp, DI, 512, 512, 2}; pg8::StaticOrder S; S.init(M, DI, G, bid);
        pg8::EpiP2 E{BB};
        pg8::gemm_phase<pg8::EpiP2>(lds, g, S, E, wave);
    }
    GRID_BAR();

    {
        pg8::Gemm g{BB, Wt_out0, DI, DI, DI, 0}; pg8::StaticOrder S; S.init(M, DM, G, bid);
        pg8::EpiRes<true, false> E{a.x, nullptr, XB, part1};
        pg8::gemm_phase<pg8::EpiRes<true, false>>(lds, g, S, E, wave);
    }
    GRID_BAR();

    {
        pg8::Gemm g{XB, Wt_in1, DM, DM, DM, 0}; pg8::StaticOrder S; S.init(M, 6144, G, bid);
        pg8::EpiP4 E{BA, BB, BC, decb, part1, a.hgrn_lb};
        pg8::gemm_phase<pg8::EpiP4>(lds, g, S, E, wave);
    }
    GRID_BAR();

    scan::phase(lds, BA, BB, BC, decb, ssb, bid, G, wave);
    GRID_BAR();

    {
        pg8::Gemm g{XB, Wt_in1 + (size_t)6144 * DM, DM, DM, DM, 0}; pg8::StaticOrder S; S.init(M, DI, G, bid);
        pg8::EpiP5b E{BC, part1, ssb};
        pg8::gemm_phase<pg8::EpiP5b>(lds, g, S, E, wave);
    }
    GRID_BAR();

    {
        pg8::Gemm g{BC, Wt_out1, DI, DI, DI, 0}; pg8::StaticOrder S; S.init(M, DM, G, bid);
        pg8::EpiFinal E{XB, a.out, a.final_g, (float*)(ws + WS_X), (unsigned*)(ws + WS_CNT)};
        pg8::gemm_phase<pg8::EpiFinal>(lds, g, S, E, wave);
    }
}

extern "C" void kernel_launch(void* const* d_in, const int* in_sizes, int n_in, void* d_out, int out_size, void* d_ws, size_t ws_size, hipStream_t stream) {
    static int grid = 0;
    if (grid == 0) {
        if (n_in != 11 || in_sizes[0] != M * DM || out_size != M * DM || ws_size < WS_END) { fprintf(stderr, "kernel_launch: unexpected shapes (n_in %d in0 %d out %d ws %zu)\n", n_in, n_in > 0 ? in_sizes[0] : -1, out_size, ws_size); grid = -1; return; }
        int dev = 0, cus = 0, per = 0;
        if (hipGetDevice(&dev) != hipSuccess || hipDeviceGetAttribute(&cus, hipDeviceAttributeMultiprocessorCount, dev) != hipSuccess) { grid = -1; return; }
        if (hipFuncSetAttribute((const void*)fwd_kernel, hipFuncAttributeMaxDynamicSharedMemorySize, LDS_BYTES) != hipSuccess) { fprintf(stderr, "kernel_launch: hipFuncSetAttribute failed\n"); grid = -1; return; }
        if (hipOccupancyMaxActiveBlocksPerMultiprocessor(&per, (const void*)fwd_kernel, 512, LDS_BYTES) != hipSuccess || per < 1) { fprintf(stderr, "kernel_launch: occupancy query says %d\n", per); (void)hipGetLastError(); grid = -1; return; }
        grid = cus;
        fprintf(stderr, "kernel_launch: cus %d per_cu %d grid %d\n", cus, per, grid);
    }
    if (grid < 0) return;
    if (hipMemsetAsync(d_ws, 0, 32768, stream) != hipSuccess) { fprintf(stderr, "kernel_launch: hipMemsetAsync failed\n"); return; }
    Args a{};
    a.x = (const float*)d_in[0]; a.norm_g = (const float*)d_in[1]; a.pool_w_in = (const float*)d_in[2]; a.pool_w_grp = (const float*)d_in[3];
    a.pool_scale = (const float*)d_in[4]; a.pool_w_out = (const float*)d_in[5]; a.hgrn_w_in = (const float*)d_in[6]; a.hgrn_lb = (const float*)d_in[7];
    a.hgrn_norm_g = (const float*)d_in[8]; a.hgrn_w_out = (const float*)d_in[9]; a.final_g = (const float*)d_in[10];
    a.out = (float*)d_out; a.ws = (unsigned char*)d_ws;
    void* args[] = {&a};
    hipError_t e = hipLaunchCooperativeKernel((void*)fwd_kernel, dim3(grid), dim3(512), args, LDS_BYTES, stream);
    if (e != hipSuccess) fprintf(stderr, "kernel_launch: cooperative launch failed: %s (grid %d)\n", hipGetErrorString(e), grid);
}
```

```cpp
#include <hip/hip_runtime.h>
#include <cstdio>
#include <cstdint>

#define LAS __attribute__((address_space(3)))
typedef unsigned short bf16_t;
typedef short bf16x8 __attribute__((ext_vector_type(8)));
typedef float f32x4 __attribute__((ext_vector_type(4)));
typedef float f32x2 __attribute__((ext_vector_type(2)));
typedef unsigned u32x4 __attribute__((ext_vector_type(4)));
typedef unsigned u32x2 __attribute__((ext_vector_type(2)));

constexpr int DM = 1024, BATCH = 8, SEQ = 4096, DI = 2048, M = BATCH * SEQ;
constexpr int NHEAD = 16, HD = 128;
constexpr float EPS = 1e-6f;
constexpr size_t MiB = 1u << 20;
constexpr size_t WS_WIN0 = 2 * MiB;
constexpr size_t WS_WGRP = 10 * MiB;
constexpr size_t WS_WOUT0 = 12 * MiB;
constexpr size_t WS_WIN1 = 16 * MiB;
constexpr size_t WS_WOUT1 = 32 * MiB;
constexpr size_t WS_PART1 = 36 * MiB;
constexpr size_t WS_CNT = 16384;
constexpr size_t WS_X = 40 * MiB;
constexpr size_t WS_DEC = 44 * MiB;
constexpr size_t WS_SS = 112 * MiB;
constexpr size_t WS_XB = 48 * MiB;
constexpr size_t WS_A = 128 * MiB;
constexpr size_t WS_B = 256 * MiB;
constexpr size_t WS_C = 384 * MiB;
constexpr size_t WS_END = 512 * MiB;
constexpr int LDS_BYTES = 147456;

typedef __bf16 bf2_t __attribute__((ext_vector_type(2)));
__device__ __forceinline__ unsigned pkbf(float lo, float hi) { f32x2 v = {lo, hi}; return __builtin_bit_cast(unsigned, __builtin_convertvector(v, bf2_t)); }
__device__ __forceinline__ float bf_lo(unsigned w) { return __builtin_bit_cast(float, w << 16); }
__device__ __forceinline__ float bf_hi(unsigned w) { return __builtin_bit_cast(float, w & 0xffff0000u); }
__device__ __forceinline__ float silu_f(float x) { return x * __builtin_amdgcn_rcpf(1.0f + __builtin_amdgcn_exp2f(-1.44269504089f * x)); }
__device__ __forceinline__ int fresh_lane_id() { int l; asm volatile("v_mbcnt_lo_u32_b32 %0, -1, 0\n\tv_mbcnt_hi_u32_b32 %0, -1, %0" : "=v"(l)); return l; }
__device__ __forceinline__ float lane_get(float v, int src_lane) { return __builtin_bit_cast(float, __builtin_amdgcn_ds_bpermute(src_lane << 2, __builtin_bit_cast(int, v))); }
__device__ __forceinline__ float xor_get(float v, int lane, int m) { return lane_get(v, lane ^ m); }
__device__ __forceinline__ float wave_sum(float v, int lane) {
#pragma unroll
    for (int o = 1; o < 64; o <<= 1) v += xor_get(v, lane, o);
    return v;
}

namespace pg8 {
constexpr int BM = 256, BK = 64, HALF = 128, HTB = HALF * BK * 2, NXCD = 8, WGM = 4;
__host__ __device__ __forceinline__ int lds_byte(int r, int c) { const int st = (r >> 4) * 2 + (c >> 5), rr = r & 15, cc = c & 31, ob = rr * 64 + cc * 2; return st * 1024 + (ob ^ (((ob >> 9) & 1) << 5)); }
__host__ __device__ __forceinline__ void stage_rc(int b, int& R, int& C) { const int st = b / 1024, sb = b % 1024, swz = sb ^ (((sb >> 9) & 1) << 5); R = (st >> 1) * 16 + swz / 64; C = (st & 1) * 32 + (swz % 64) / 2; }
__host__ __device__ __forceinline__ int perm32(int rho) { const int n = rho >> 4, i = rho & 15; return 8 * (i >> 2) + 4 * n + (i & 3); }

struct Unit { int pm, pn; };
struct Gemm { const bf16_t* A; const bf16_t* Bt; int lda, ldb, K, grp_tiles; };

struct StaticOrder {
    int nM, nN, nwg, G, c;
    __host__ __device__ void init(int M_, int N_, int G_, int c_) { nM = M_ / BM; nN = N_ / BM; nwg = nM * nN; G = G_; c = c_; }
    __host__ __device__ bool next(int i, Unit& u) const {
        const long L = (long)i * G + c; if (L >= nwg) return false;
        int wgid = (int)L; { const int q = nwg / NXCD, r = nwg % NXCD, xcd = wgid % NXCD, off = wgid / NXCD; wgid = (xcd < r ? xcd * (q + 1) : r * (q + 1) + (xcd - r) * q) + off; }
        const int nig = WGM * nN, gid = wgid / nig, fm = gid * WGM, gsz = (nM - fm) < WGM ? (nM - fm) : WGM;
        u.pm = fm + ((wgid % nig) % gsz); u.pn = (wgid % nig) / gsz; return true;
    }
};


__device__ __forceinline__ void zero_acc(f32x4 (&acc)[2][2][4][2]) {
#pragma unroll
    for (int a = 0; a < 2; ++a)
#pragma unroll
        for (int b = 0; b < 2; ++b)
#pragma unroll
            for (int m = 0; m < 4; ++m)
#pragma unroll
                for (int n = 0; n < 2; ++n) acc[a][b][m][n] = (f32x4){0.f, 0.f, 0.f, 0.f};
}
template <class Epi, bool ALIGN_EPI = true, bool SP2 = true>
__device__ __forceinline__ void gemm_phase(LAS unsigned char* lds, const Gemm g, const StaticOrder& S, const Epi& E, const int wid) {
    int lane_ = fresh_lane_id();
    int lane = lane_, tid = wid * 64 + lane, fr = lane & 15, fq = lane >> 4; const int wr = wid >> 2, wc = wid & 3;
    const int K = g.K, nt = K / BK;
    unsigned voffA[2], voffB[2]; int aoff, boff;
#define PG8_LANE_STATE() do { _Pragma("unroll") for (int i = 0; i < 2; ++i) { int R, C; stage_rc(tid * 16 + i * 8192, R, C); const int Rb = Epi::PERM ? ((R & ~31) + perm32(R & 31)) : R; \
        voffA[i] = (unsigned)(R * g.lda + C) * 2u; voffB[i] = (unsigned)(Rb * g.ldb + C) * 2u; } \
        aoff = lds_byte(wr * 64 + fr, fq * 8); boff = lds_byte(wc * 32 + fr, fq * 8); } while (0)
    PG8_LANE_STATE();
    const size_t kstep = (size_t)(BK * 2);
    const size_t hstepA = (size_t)HALF * g.lda * 2, hstepB = (size_t)HALF * g.ldb * 2;
    const size_t tstepA = 2 * hstepA, tstepB = 2 * hstepB;
    const unsigned ldsw = (unsigned)wid * 1024u;
#define PG8_SA(b, h) (((b) * 2 + (h)) * HTB)
#define PG8_SB(b, h) ((4 + (b) * 2 + (h)) * HTB)
#define PG8_STAGE(bufoff, gbase, voff) do { _Pragma("unroll") for (int _i = 0; _i < 2; ++_i) \
        __builtin_amdgcn_global_load_lds((const unsigned*)((const char*)(gbase) + (voff)[_i]), (LAS unsigned*)(lds + (bufoff) + ldsw + _i * 8192), 16, 0, 0); } while (0)
#define PG8_LDA(dst, b, h) do { _Pragma("unroll") for (int m = 0; m < 4; ++m) _Pragma("unroll") for (int k = 0; k < 2; ++k) dst[m][k] = *(const LAS bf16x8*)(lds + PG8_SA(b, h) + aoff + m * 2048 + k * 1024); } while (0)
#define PG8_LDB(dst, b, h) do { _Pragma("unroll") for (int n = 0; n < 2; ++n) _Pragma("unroll") for (int k = 0; k < 2; ++k) dst[n][k] = *(const LAS bf16x8*)(lds + PG8_SB(b, h) + boff + n * 2048 + k * 1024); } while (0)
#define PG8_MMA(ai, bj, At, Bt) do { __builtin_amdgcn_s_setprio(1); _Pragma("unroll") for (int m = 0; m < 4; ++m) _Pragma("unroll") for (int n = 0; n < 2; ++n) _Pragma("unroll") for (int k = 0; k < 2; ++k) \
        acc[ai][bj][m][n] = __builtin_amdgcn_mfma_f32_16x16x32_bf16(Bt[n][k], At[m][k], acc[ai][bj][m][n], 0, 0, 0); __builtin_amdgcn_s_setprio(0); } while (0)
#define PG8_WAIT_V(n) asm volatile("s_waitcnt vmcnt(" #n ")" ::: "memory")
#define PG8_WAIT_L(n) asm volatile("s_waitcnt lgkmcnt(" #n ")" ::: "memory")
#define PG8_BAR __builtin_amdgcn_s_barrier()
#define PG8_SCHED __builtin_amdgcn_sched_barrier(0)
#define PG8_ABASE(u) ((const char*)g.A + (size_t)(u).pm * tstepA + (g.grp_tiles ? (size_t)((u).pn / g.grp_tiles) * (size_t)K * 2 : (size_t)0))
#define PG8_BBASE(u) ((const char*)g.Bt + (size_t)(u).pn * tstepB)
    Unit cur, nxt; int ui = 0;
    E.prologue(S, lds, tid);
    if (!S.next(0, cur)) return;
    f32x4 acc[2][2][4][2];
    E.init_acc(acc, cur, wr, wc, fr, fq);
    bf16x8 At[4][2], B0[2][2], B1[2][2];
    const char* cA = PG8_ABASE(cur); const char* cB = PG8_BBASE(cur);
    if constexpr (SP2) {
        PG8_STAGE(PG8_SB(0, 0), cB, voffB); PG8_STAGE(PG8_SB(0, 1), cB + hstepB, voffB); PG8_STAGE(PG8_SA(0, 0), cA, voffA); PG8_STAGE(PG8_SA(0, 1), cA + hstepA, voffA);
        if (wr == 1) PG8_BAR;
        PG8_WAIT_V(2); PG8_BAR;
        PG8_STAGE(PG8_SB(1, 0), cB + kstep, voffB); PG8_STAGE(PG8_SA(1, 0), cA + kstep, voffA); PG8_STAGE(PG8_SB(1, 1), cB + hstepB + kstep, voffB);
        PG8_WAIT_V(6); PG8_BAR;
    } else {
        PG8_STAGE(PG8_SB(0, 0), cB, voffB); PG8_STAGE(PG8_SA(0, 0), cA, voffA); PG8_STAGE(PG8_SB(0, 1), cB + hstepB, voffB); PG8_STAGE(PG8_SA(0, 1), cA + hstepA, voffA);
        if (wr == 1) PG8_BAR;
        PG8_WAIT_V(4); PG8_BAR;
        PG8_STAGE(PG8_SB(1, 0), cB + kstep, voffB); PG8_STAGE(PG8_SA(1, 0), cA + kstep, voffA); PG8_STAGE(PG8_SB(1, 1), cB + hstepB + kstep, voffB);
        PG8_WAIT_V(6); PG8_BAR;
    }
    for (;;) {
        const bool has_next = S.next(ui + 1, nxt);
        const char* nA = has_next ? PG8_ABASE(nxt) : cA; const char* nB = has_next ? PG8_BBASE(nxt) : cB;
        for (int t = 0; t < nt; t += 2) {
            const bool last = (t == nt - 2);
            const char* a1 = cA + (size_t)(t + 1) * kstep;
            const char* a2 = last ? nA : cA + (size_t)(t + 2) * kstep; const char* b2 = last ? nB : cB + (size_t)(t + 2) * kstep;
            const char* a3 = a2 + kstep; const char* b3 = b2 + kstep;
            if constexpr (SP2) {
            PG8_LDB(B0, 0, 0); PG8_LDB(B1, 0, 1); PG8_SCHED; PG8_LDA(At, 0, 0); PG8_STAGE(PG8_SA(1, 1), a1 + hstepA, voffA);
            PG8_WAIT_V(8); PG8_WAIT_L(0); PG8_BAR; PG8_MMA(0, 0, At, B0); PG8_MMA(0, 1, At, B1); PG8_BAR; PG8_SCHED;
            PG8_LDA(At, 0, 1); PG8_STAGE(PG8_SB(0, 0), b2, voffB); PG8_STAGE(PG8_SB(0, 1), b2 + hstepB, voffB); PG8_STAGE(PG8_SA(0, 0), a2, voffA);
            PG8_WAIT_V(8); PG8_WAIT_L(0); PG8_BAR; PG8_MMA(1, 0, At, B0); PG8_MMA(1, 1, At, B1); PG8_BAR; PG8_SCHED;
            PG8_LDB(B0, 1, 0); PG8_LDB(B1, 1, 1); PG8_SCHED; PG8_LDA(At, 1, 0); PG8_STAGE(PG8_SA(0, 1), a2 + hstepA, voffA);
            PG8_WAIT_V(8); PG8_WAIT_L(0); PG8_BAR; PG8_MMA(0, 0, At, B0); PG8_MMA(0, 1, At, B1); PG8_BAR; PG8_SCHED;
            PG8_LDA(At, 1, 1); PG8_STAGE(PG8_SB(1, 0), b3, voffB); PG8_STAGE(PG8_SB(1, 1), b3 + hstepB, voffB); PG8_STAGE(PG8_SA(1, 0), a3, voffA);
            PG8_WAIT_V(8); PG8_WAIT_L(0); PG8_BAR; PG8_MMA(1, 0, At, B0); PG8_MMA(1, 1, At, B1); PG8_BAR; PG8_SCHED;
            } else {
            PG8_LDB(B0, 0, 0); PG8_SCHED; PG8_LDA(At, 0, 0); PG8_STAGE(PG8_SA(1, 1), a1 + hstepA, voffA);
            PG8_WAIT_L(8); PG8_BAR; PG8_WAIT_L(0); PG8_MMA(0, 0, At, B0); PG8_BAR; PG8_SCHED;
            PG8_LDB(B1, 0, 1); PG8_STAGE(PG8_SB(0, 0), b2, voffB);
            PG8_BAR; PG8_WAIT_L(0); PG8_MMA(0, 1, At, B1); PG8_BAR;
            PG8_LDA(At, 0, 1); PG8_STAGE(PG8_SA(0, 0), a2, voffA);
            PG8_BAR; PG8_WAIT_L(0); PG8_MMA(1, 0, At, B0); PG8_BAR; PG8_SCHED;
            PG8_STAGE(PG8_SB(0, 1), b2 + hstepB, voffB);
            PG8_WAIT_V(6); PG8_BAR; PG8_MMA(1, 1, At, B1); PG8_BAR;
            PG8_LDB(B0, 1, 0); PG8_SCHED; PG8_LDA(At, 1, 0); PG8_STAGE(PG8_SA(0, 1), a2 + hstepA, voffA);
            PG8_WAIT_L(8); PG8_BAR; PG8_WAIT_L(0); PG8_MMA(0, 0, At, B0); PG8_BAR; PG8_SCHED;
            PG8_LDB(B1, 1, 1); PG8_STAGE(PG8_SB(1, 0), b3, voffB);
            PG8_BAR; PG8_WAIT_L(0); PG8_MMA(0, 1, At, B1); PG8_BAR;
            PG8_LDA(At, 1, 1); PG8_STAGE(PG8_SA(1, 0), a3, voffA);
            PG8_BAR; PG8_WAIT_L(0); PG8_MMA(1, 0, At, B0); PG8_BAR; PG8_SCHED;
            PG8_STAGE(PG8_SB(1, 1), b3 + hstepB, voffB);
            PG8_WAIT_V(6); PG8_BAR; PG8_MMA(1, 1, At, B1); PG8_BAR;
            }
        }
        if constexpr (ALIGN_EPI) { if (wr == 0) PG8_BAR; }
        if constexpr (!Epi::AFTER_DRAIN) E(acc, cur, wr, wc, fr, fq, lds, ui);
        if (!has_next) break;
        cur = nxt; cA = nA; cB = nB; ++ui;
        asm volatile("" : "+v"(lane)); tid = wid * 64 + lane; fr = lane & 15; fq = lane >> 4; PG8_LANE_STATE();
        E.init_acc(acc, cur, wr, wc, fr, fq);
        if constexpr (ALIGN_EPI) { if (wr == 1) PG8_BAR; }
    }
    PG8_WAIT_V(0);
    if constexpr (!ALIGN_EPI) { if (wr == 0) PG8_BAR; }
    PG8_BAR;
    if constexpr (Epi::AFTER_DRAIN) E.fused(acc, cur, wr, wc, fr, fq, lds, tid);
#undef PG8_SA
#undef PG8_SB
#undef PG8_STAGE
#undef PG8_LDA
#undef PG8_LDB
#undef PG8_MMA
#undef PG8_WAIT_V
#undef PG8_WAIT_L
#undef PG8_BAR
#undef PG8_SCHED
#undef PG8_ABASE
#undef PG8_LANE_STATE
#undef PG8_BBASE
}

struct EpiP1 {
    static constexpr bool PERM = true, AFTER_DRAIN = false;
    __device__ __forceinline__ void init_acc(f32x4 (&acc)[2][2][4][2], const Unit&, int, int, int, int) const { zero_acc(acc); }
    __device__ __forceinline__ void prologue(const StaticOrder&, LAS unsigned char*, int) const {}
    bf16_t* V; bf16_t* SG;
    __device__ __forceinline__ void operator()(f32x4 (&acc)[2][2][4][2], const Unit& u, int wr, int wc, int fr, int fq, LAS unsigned char* lds, int ui) const {
        const int row0 = u.pm * BM + wr * 64 + fr; const bool gate = u.pn >= 8;
        bf16_t* base = gate ? SG : V; const int col0 = (u.pn & 7) * BM + wc * 32 + 8 * fq;
#pragma unroll
        for (int ai = 0; ai < 2; ++ai)
#pragma unroll
            for (int m = 0; m < 4; ++m) { bf16_t* rowp = base + (size_t)(row0 + ai * HALF + m * 16) * DI + col0;
#pragma unroll
                for (int bj = 0; bj < 2; ++bj) { f32x4 v0 = acc[ai][bj][m][0], v1 = acc[ai][bj][m][1];
                    if (gate) {
#pragma unroll
                        for (int j = 0; j < 4; ++j) { v0[j] = silu_f(v0[j]); v1[j] = silu_f(v1[j]); } }
                    u32x4 w; w.x = pkbf(v0[0], v0[1]); w.y = pkbf(v0[2], v0[3]); w.z = pkbf(v1[0], v1[1]); w.w = pkbf(v1[2], v1[3]);
                    __builtin_nontemporal_store(w, (u32x4*)(rowp + bj * HALF)); } }
    }
};
struct EpiP2 {
    static constexpr bool PERM = true, AFTER_DRAIN = false;
    __device__ __forceinline__ void init_acc(f32x4 (&acc)[2][2][4][2], const Unit&, int, int, int, int) const { zero_acc(acc); }
    __device__ __forceinline__ void prologue(const StaticOrder&, LAS unsigned char*, int) const {}
    bf16_t* Z;
    __device__ __forceinline__ void operator()(f32x4 (&acc)[2][2][4][2], const Unit& u, int wr, int wc, int fr, int fq, LAS unsigned char* lds, int ui) const {
        const unsigned row0 = (unsigned)(u.pm * BM + wr * 64 + fr), col0 = (unsigned)(u.pn * BM + wc * 32 + 8 * fq);
        const unsigned zofs = (row0 * DI + col0) * 2u;
#pragma unroll
        for (int ai = 0; ai < 2; ++ai) {
            u32x4 sv[4][2];
#pragma unroll
            for (int m = 0; m < 4; ++m)
#pragma unroll
                for (int bj = 0; bj < 2; ++bj) sv[m][bj] = *(const u32x4*)((const char*)Z + (zofs + (unsigned)((ai * HALF + m * 16) * DI + bj * HALF) * 2u));
#pragma unroll
            for (int m = 0; m < 4; ++m)
#pragma unroll
                for (int bj = 0; bj < 2; ++bj) { const f32x4 v0 = acc[ai][bj][m][0], v1 = acc[ai][bj][m][1]; const u32x4 s = sv[m][bj];
                    u32x4 w; w.x = pkbf(v0[0] * bf_lo(s.x), v0[1] * bf_hi(s.x)); w.y = pkbf(v0[2] * bf_lo(s.y), v0[3] * bf_hi(s.y));
                    w.z = pkbf(v1[0] * bf_lo(s.z), v1[1] * bf_hi(s.z)); w.w = pkbf(v1[2] * bf_lo(s.w), v1[3] * bf_hi(s.w));
                    *(u32x4*)((char*)Z + (zofs + (unsigned)((ai * HALF + m * 16) * DI + bj * HALF) * 2u)) = w; }
            asm volatile("" ::: "memory"); }
    }
};
template <bool WRITE_HB, bool WRITE_H = true> struct EpiRes {
    static constexpr bool PERM = true, AFTER_DRAIN = false;
    __device__ __forceinline__ void prologue(const StaticOrder&, LAS unsigned char*, int) const {}
    const float* R; float* H; bf16_t* HB; float* part;
    __device__ __forceinline__ void init_acc(f32x4 (&acc)[2][2][4][2], const Unit& u, int wr, int wc, int fr, int fq) const {
        const unsigned row0 = (unsigned)(u.pm * BM + wr * 64 + fr), col0 = (unsigned)(u.pn * BM + wc * 32 + 8 * fq);
        const unsigned ofs = (row0 * DM + col0) * 4u;
#pragma unroll
        for (int ai = 0; ai < 2; ++ai)
#pragma unroll
            for (int bj = 0; bj < 2; ++bj)
#pragma unroll
                for (int m = 0; m < 4; ++m)
#pragma unroll
                    for (int n = 0; n < 2; ++n) acc[ai][bj][m][n] = __builtin_nontemporal_load((const f32x4*)((const char*)R + (ofs + (unsigned)((ai * HALF + m * 16) * DM + bj * HALF + n * 4) * 4u)));
    }
    __device__ __forceinline__ void operator()(f32x4 (&acc)[2][2][4][2], const Unit& u, int wr, int wc, int fr, int fq, LAS unsigned char* lds, int ui) const {
        const unsigned row0 = (unsigned)(u.pm * BM + wr * 64 + fr), col0 = (unsigned)(u.pn * BM + wc * 32 + 8 * fq);
        const unsigned ofs = (row0 * DM + col0) * 4u, pofs = (row0 * 16u + (unsigned)(u.pn * 4 + wc)) * 4u;
#pragma unroll
        for (int ai = 0; ai < 2; ++ai)
#pragma unroll
            for (int m = 0; m < 4; ++m) { const unsigned o = ofs + (unsigned)((ai * HALF + m * 16) * DM) * 4u; float ss = 0.f;
#pragma unroll
                for (int bj = 0; bj < 2; ++bj) { const unsigned oo = o + (unsigned)(bj * HALF) * 4u; const f32x4 h0 = acc[ai][bj][m][0], h1 = acc[ai][bj][m][1];
                    if (WRITE_H) { *(f32x4*)((char*)H + oo) = h0; *(f32x4*)((char*)H + oo + 16u) = h1; }
                    ss += ((h0[0] * h0[0] + h0[1] * h0[1]) + (h0[2] * h0[2] + h0[3] * h0[3])) + ((h1[0] * h1[0] + h1[1] * h1[1]) + (h1[2] * h1[2] + h1[3] * h1[3]));
                    if (WRITE_HB) { u32x4 w; w.x = pkbf(h0[0], h0[1]); w.y = pkbf(h0[2], h0[3]); w.z = pkbf(h1[0], h1[1]); w.w = pkbf(h1[2], h1[3]); *(u32x4*)((char*)HB + (oo >> 1)) = w; } }
                ss += xor_get(ss, fq * 16 + fr, 16); ss += xor_get(ss, fq * 16 + fr, 32);
                if (fq == 0) *(float*)((char*)part + (pofs + (unsigned)(ai * HALF + m * 16) * 64u)) = ss; }
    }
};
__device__ __forceinline__ float row_rstd_b(const float* part, unsigned bofs) {
    const f32x4* p = (const f32x4*)((const char*)part + bofs); const f32x4 a = p[0], b = p[1], c = p[2], d = p[3];
    return __builtin_amdgcn_rsqf((((a[0] + a[1]) + (a[2] + a[3])) + ((b[0] + b[1]) + (b[2] + b[3])) + ((c[0] + c[1]) + (c[2] + c[3])) + ((d[0] + d[1]) + (d[2] + d[3]))) * (1.0f / DM) + EPS);
}
__device__ __forceinline__ float dpp_shr_mul(float v, const int n) {
    const int iv = __builtin_bit_cast(int, v), one = 0x3f800000; int r;
    if (n == 1) r = __builtin_amdgcn_update_dpp(one, iv, 0x111, 0xf, 0xf, false); else if (n == 2) r = __builtin_amdgcn_update_dpp(one, iv, 0x112, 0xf, 0xf, false);
    else if (n == 4) r = __builtin_amdgcn_update_dpp(one, iv, 0x114, 0xf, 0xf, false); else r = __builtin_amdgcn_update_dpp(one, iv, 0x118, 0xf, 0xf, false);
    return v * __builtin_bit_cast(float, r);
}
constexpr unsigned TAB_OFF = 131072u + 256u;
struct EpiP4 {
    static constexpr bool PERM = true, AFTER_DRAIN = false;
    __device__ __forceinline__ void init_acc(f32x4 (&acc)[2][2][4][2], const Unit&, int, int, int, int) const { zero_acc(acc); }
    bf16_t* Qt; bf16_t* Kt; bf16_t* V; float* DEC; const float* part; const float* lbnd;
    __device__ __forceinline__ void prologue(const StaticOrder& S, LAS unsigned char* lds, int tid) const {
        LAS float* T = (LAS float*)(lds + TAB_OFF); Unit u;
        for (int i = 0; i < 12 && S.next(i, u); ++i)
            if (tid < 256) T[i * 256 + tid] = row_rstd_b(part, (unsigned)(u.pm * BM + tid) * 64u);
        __syncthreads();
    }
    __device__ __forceinline__ void operator()(f32x4 (&acc)[2][2][4][2], const Unit& u, int wr, int wc, int fr, int fq, LAS unsigned char* lds, int ui) const {
        const unsigned row0 = (unsigned)(u.pm * BM + wr * 64 + fr);
        const LAS float* T = (const LAS float*)(lds + TAB_OFF) + ui * 256 + wr * 64 + fr;
        if (u.pn >= 16) {
            const unsigned vofs = (row0 * DI + (unsigned)((u.pn - 16) * BM + wc * 32 + 8 * fq)) * 2u;
#pragma unroll
            for (int ai = 0; ai < 2; ++ai)
#pragma unroll
                for (int m = 0; m < 4; ++m) { const float rs = T[ai * HALF + m * 16];
#pragma unroll
                    for (int bj = 0; bj < 2; ++bj) { const f32x4 v0 = acc[ai][bj][m][0] * rs, v1 = acc[ai][bj][m][1] * rs;
                        u32x4 w; w.x = pkbf(v0[0], v0[1]); w.y = pkbf(v0[2], v0[3]); w.z = pkbf(v1[0], v1[1]); w.w = pkbf(v1[2], v1[3]);
                        __builtin_nontemporal_store(w, (u32x4*)((char*)V + (vofs + (unsigned)((ai * HALF + m * 16) * DI + bj * HALF) * 2u))); } }
            return;
        }
        const unsigned c0 = (unsigned)(u.pn * HD + wc * 32 + 8 * fq);
        const unsigned qofs = (row0 * DI + c0) * 2u;
#pragma unroll
        for (int ai = 0; ai < 2; ++ai) {
            float rs[4];
#pragma unroll
            for (int m = 0; m < 4; ++m) rs[m] = T[ai * HALF + m * 16];
            unsigned cc = c0; asm volatile("" : "+v"(cc));
#pragma unroll
            for (int n = 0; n < 2; ++n) {
                const f32x4 l0 = *(const f32x4*)((const char*)lbnd + (cc + 4 * n) * 4u), l1 = *(const f32x4*)((const char*)lbnd + (cc + 4 * n + DI) * 4u);
                f32x4 decv;
#pragma unroll
                for (int j = 0; j < 4; ++j) { const float ex = __expf(l0[j] - l1[j]); const float lb = __builtin_amdgcn_rcpf(1.0f + ex), omlb = ex * lb; float bprod = 1.0f;
#pragma unroll
                    for (int m = 0; m < 4; ++m) {
                        const float qv = acc[ai][0][m][n][j] * rs[m], z = acc[ai][1][m][n][j] * rs[m];
                        const float sg = __builtin_amdgcn_rcpf(1.0f + __builtin_amdgcn_exp2f(-1.44269504089f * z));
                        const float f = lb + omlb * sg, k = omlb * (1.0f - sg);
                        float s = f; s = dpp_shr_mul(s, 1); s = dpp_shr_mul(s, 2); s = dpp_shr_mul(s, 4); s = dpp_shr_mul(s, 8);
                        const float E = bprod * s;
                        if (m < 3) bprod *= lane_get(s, fq * 16 + 15);
                        const float Ei = __builtin_amdgcn_rcpf(fmaxf(E, 7.9e-31f));
                        acc[ai][0][m][n][j] = qv * E; acc[ai][1][m][n][j] = k * Ei;
                        if (m == 3) decv[j] = E;
                    } }
                if (fr == 15) *(f32x4*)((char*)DEC + ((unsigned)(u.pm * 4 + ai * 2 + wr) * DI + cc + 4 * n) * 4u) = decv;
            }
#pragma unroll
            for (int m = 0; m < 4; ++m) { const unsigned ob = qofs + (unsigned)((ai * HALF + m * 16) * DI) * 2u;
                u32x4 w; w.x = pkbf(acc[ai][0][m][0][0], acc[ai][0][m][0][1]); w.y = pkbf(acc[ai][0][m][0][2], acc[ai][0][m][0][3]); w.z = pkbf(acc[ai][0][m][1][0], acc[ai][0][m][1][1]); w.w = pkbf(acc[ai][0][m][1][2], acc[ai][0][m][1][3]);
                __builtin_nontemporal_store(w, (u32x4*)((char*)Qt + ob));
                u32x4 x; x.x = pkbf(acc[ai][1][m][0][0], acc[ai][1][m][0][1]); x.y = pkbf(acc[ai][1][m][0][2], acc[ai][1][m][0][3]); x.z = pkbf(acc[ai][1][m][1][0], acc[ai][1][m][1][1]); x.w = pkbf(acc[ai][1][m][1][2], acc[ai][1][m][1][3]);
                __builtin_nontemporal_store(x, (u32x4*)((char*)Kt + ob)); }
            asm volatile("" ::: "memory");
        }
    }
};
struct EpiP5b {
    static constexpr bool PERM = true, AFTER_DRAIN = false;
    __device__ __forceinline__ void init_acc(f32x4 (&acc)[2][2][4][2], const Unit&, int, int, int, int) const { zero_acc(acc); }
    bf16_t* O; const float* part; const float* ss;
    __device__ __forceinline__ void prologue(const StaticOrder& S, LAS unsigned char* lds, int tid) const {
        LAS float* T = (LAS float*)(lds + TAB_OFF); Unit u;
        for (int i = 0; i < 4 && S.next(i, u); ++i) {
            if (tid < 256) T[i * 768 + tid] = row_rstd_b(part, (unsigned)(u.pm * BM + tid) * 64u);
            { const int r = tid >> 1, hh = tid & 1; const f32x4* sp = (const f32x4*)(ss + (size_t)(u.pm * BM + r) * 128 + (u.pn * 2 + hh) * 8); const f32x4 s0 = sp[0], s1 = sp[1];
              T[i * 768 + 256 + tid] = __builtin_amdgcn_rsqf((((s0[0] + s0[1]) + (s0[2] + s0[3])) + ((s1[0] + s1[1]) + (s1[2] + s1[3]))) * (1.0f / HD) + EPS); }
        }
        __syncthreads();
    }
    __device__ __forceinline__ void operator()(f32x4 (&acc)[2][2][4][2], const Unit& u, int wr, int wc, int fr, int fq, LAS unsigned char* lds, int ui) const {
        const unsigned row0 = (unsigned)(u.pm * BM + wr * 64 + fr), col0 = (unsigned)(u.pn * BM + wc * 32 + 8 * fq);
        const LAS float* T = (const LAS float*)(lds + TAB_OFF) + ui * 768 + wr * 64 + fr;
        const unsigned oofs = (row0 * DI + col0) * 2u;
#pragma unroll
        for (int ai = 0; ai < 2; ++ai) {
            u32x4 ov[4][2];
#pragma unroll
            for (int m = 0; m < 4; ++m)
#pragma unroll
                for (int bj = 0; bj < 2; ++bj) ov[m][bj] = *(const u32x4*)((const char*)O + (oofs + (unsigned)((ai * HALF + m * 16) * DI + bj * HALF) * 2u));
#pragma unroll
            for (int m = 0; m < 4; ++m) { const int rl = ai * HALF + m * 16; const float rs = T[rl];
#pragma unroll
                for (int bj = 0; bj < 2; ++bj) { const f32x4 v0 = acc[ai][bj][m][0] * rs, v1 = acc[ai][bj][m][1] * rs;
                    const float rh = T[256 + 2 * rl + bj + (wr * 64 + fr)];
                    const u32x4 s = ov[m][bj];
                    u32x4 w; w.x = pkbf(bf_lo(s.x) * rh * silu_f(v0[0]), bf_hi(s.x) * rh * silu_f(v0[1])); w.y = pkbf(bf_lo(s.y) * rh * silu_f(v0[2]), bf_hi(s.y) * rh * silu_f(v0[3]));
                    w.z = pkbf(bf_lo(s.z) * rh * silu_f(v1[0]), bf_hi(s.z) * rh * silu_f(v1[1])); w.w = pkbf(bf_lo(s.w) * rh * silu_f(v1[2]), bf_hi(s.w) * rh * silu_f(v1[3]));
                    *(u32x4*)((char*)O + (oofs + (unsigned)((ai * HALF + m * 16) * DI + bj * HALF) * 2u)) = w; } }
            asm volatile("" ::: "memory"); }
    }
};
struct EpiFinal {
    static constexpr bool PERM = true, AFTER_DRAIN = false;
    __device__ __forceinline__ void init_acc(f32x4 (&acc)[2][2][4][2], const Unit&, int, int, int, int) const { zero_acc(acc); }
    const bf16_t* HB; float* H; const float* fg; float* X; unsigned* cnt;
    __device__ __forceinline__ void prologue(const StaticOrder&, LAS unsigned char*, int) const {}
    __device__ __forceinline__ void operator()(f32x4 (&acc)[2][2][4][2], const Unit& u, int wr, int wc, int fr, int fq, LAS unsigned char* lds, int ui) const {
        LAS float* Pt = (LAS float*)(lds + TAB_OFF);
        LAS float* St = Pt + 1024;
        const int tid = (wr * 4 + wc) * 64 + fq * 16 + fr;
        const unsigned row0 = (unsigned)(u.pm * BM + wr * 64 + fr), col0 = (unsigned)(u.pn * BM + wc * 32 + 8 * fq);
        const unsigned ofs = (row0 * DM + col0) * 4u;
#pragma unroll
        for (int ai = 0; ai < 2; ++ai) {
            u32x4 hv[4][2];
#pragma unroll
            for (int m = 0; m < 4; ++m)
#pragma unroll
                for (int bj = 0; bj < 2; ++bj) hv[m][bj] = *(const u32x4*)((const char*)HB + ((ofs + (unsigned)((ai * HALF + m * 16) * DM + bj * HALF) * 4u) >> 1));
#pragma unroll
            for (int m = 0; m < 4; ++m) { float ss = 0.f;
#pragma unroll
                for (int bj = 0; bj < 2; ++bj) { const u32x4 hb = hv[m][bj];
                    const f32x4 h0 = acc[ai][bj][m][0] + (f32x4){bf_lo(hb.x), bf_hi(hb.x), bf_lo(hb.y), bf_hi(hb.y)}, h1 = acc[ai][bj][m][1] + (f32x4){bf_lo(hb.z), bf_hi(hb.z), bf_lo(hb.w), bf_hi(hb.w)};
                    acc[ai][bj][m][0] = h0; acc[ai][bj][m][1] = h1;
                    ss += ((h0[0] * h0[0] + h0[1] * h0[1]) + (h0[2] * h0[2] + h0[3] * h0[3])) + ((h1[0] * h1[0] + h1[1] * h1[1]) + (h1[2] * h1[2] + h1[3] * h1[3])); }
                ss += xor_get(ss, fq * 16 + fr, 16); ss += xor_get(ss, fq * 16 + fr, 32);
                if (fq == 0) Pt[(ai * HALF + wr * 64 + m * 16 + fr) * 4 + wc] = ss; }
            asm volatile("" ::: "memory"); }
        __syncthreads();
        float* xs = X + (size_t)u.pm * 1024;
        if (tid < 256) { const f32x4 p = *(const LAS f32x4*)(Pt + tid * 4);
            __hip_atomic_store(xs + u.pn * 256 + tid, (p[0] + p[1]) + (p[2] + p[3]), __ATOMIC_RELAXED, __HIP_MEMORY_SCOPE_AGENT); }
        asm volatile("s_waitcnt vmcnt(0)" ::: "memory");
        __syncthreads();
        if (tid == 0) {
            unsigned* c = cnt + 16 * u.pm;
            __hip_atomic_fetch_add(c, 1u, __ATOMIC_RELAXED, __HIP_MEMORY_SCOPE_AGENT);
            unsigned spins = 0;
            while (__hip_atomic_load(c, __ATOMIC_RELAXED, __HIP_MEMORY_SCOPE_AGENT) < 4u) { __builtin_amdgcn_s_sleep(2); if (++spins > (1u << 22)) break; }
            __builtin_amdgcn_fence(__ATOMIC_ACQUIRE, "agent");
            asm volatile("s_waitcnt vmcnt(0)" ::: "memory");
        }
        __syncthreads();
        if (tid < 256) { float s = 0.f;
#pragma unroll
            for (int t = 0; t < 4; ++t) s += __hip_atomic_load(xs + t * 256 + tid, __ATOMIC_RELAXED, __HIP_MEMORY_SCOPE_AGENT);
            St[tid] = __builtin_amdgcn_rsqf(s * (1.0f / DM) + EPS); }
        __syncthreads();
        f32x4 gv[2][2];
#pragma unroll
        for (int bj = 0; bj < 2; ++bj)
#pragma unroll
            for (int n = 0; n < 2; ++n) gv[bj][n] = *(const f32x4*)(fg + col0 + bj * HALF + n * 4);
#pragma unroll
        for (int ai = 0; ai < 2; ++ai)
#pragma unroll
            for (int m = 0; m < 4; ++m) { const float rs = St[ai * HALF + wr * 64 + m * 16 + fr];
#pragma unroll
                for (int bj = 0; bj < 2; ++bj) { const unsigned oo = ofs + (unsigned)((ai * HALF + m * 16) * DM + bj * HALF) * 4u;
                    *(f32x4*)((char*)H + oo) = acc[ai][bj][m][0] * rs * gv[bj][0]; *(f32x4*)((char*)H + oo + 16u) = acc[ai][bj][m][1] * rs * gv[bj][1]; } }
        __syncthreads();
    }
};
}

namespace scan {
#define MFMA16(a, b, c) __builtin_amdgcn_mfma_f32_16x16x32_bf16((a), (b), (c), 0, 0, 0)
__device__ __forceinline__ unsigned offb(unsigned row, unsigned ch) { return 256u * row + 16u * (ch ^ (((row & 3u) << 2) | ((row >> 2) & 3u))); }
__device__ __forceinline__ unsigned voffv(unsigned r, unsigned cp) { return 128u * r + 32u * (cp ^ (((r >> 1) & 3u) ^ (((r >> 3) & 1u) << 1))); }
__device__ __forceinline__ void tr8(unsigned a0, unsigned a1, unsigned c0, unsigned c1, bf16x8& f00, bf16x8& f01, bf16x8& f10, bf16x8& f11) {
    u32x2 r0, r1, r2, r3, r4, r5, r6, r7;
    asm volatile("ds_read_b64_tr_b16 %0, %8\n\tds_read_b64_tr_b16 %1, %9\n\tds_read_b64_tr_b16 %2, %8 offset:8192\n\tds_read_b64_tr_b16 %3, %9 offset:8192\n\t"
                 "ds_read_b64_tr_b16 %4, %10\n\tds_read_b64_tr_b16 %5, %11\n\tds_read_b64_tr_b16 %6, %10 offset:8192\n\tds_read_b64_tr_b16 %7, %11 offset:8192\n\ts_waitcnt lgkmcnt(0)"
                 : "=&v"(r0), "=&v"(r1), "=&v"(r2), "=&v"(r3), "=&v"(r4), "=&v"(r5), "=&v"(r6), "=&v"(r7) : "v"(a0), "v"(a1), "v"(c0), "v"(c1) : "memory");
    const u32x4 x00 = {r0.x, r0.y, r1.x, r1.y}, x01 = {r2.x, r2.y, r3.x, r3.y}, x10 = {r4.x, r4.y, r5.x, r5.y}, x11 = {r6.x, r6.y, r7.x, r7.y};
    f00 = __builtin_bit_cast(bf16x8, x00); f01 = __builtin_bit_cast(bf16x8, x01); f10 = __builtin_bit_cast(bf16x8, x10); f11 = __builtin_bit_cast(bf16x8, x11);
}
__device__ __forceinline__ bf16x8 pack8(const f32x4 a, const f32x4 b) { const u32x4 r = {pkbf(a[0], a[1]), pkbf(a[2], a[3]), pkbf(b[0], b[1]), pkbf(b[2], b[3])}; return __builtin_bit_cast(bf16x8, r); }
__device__ __forceinline__ u32x2 tr_issue(unsigned a) { u32x2 r; asm volatile("ds_read_b64_tr_b16 %0, %1" : "=v"(r) : "v"(a) : "memory"); return r; }
__device__ __forceinline__ bf16x8 frag2(const u32x2 lo, const u32x2 hi) { const u32x4 r = {lo.x, lo.y, hi.x, hi.y}; return __builtin_bit_cast(bf16x8, r); }
__device__ __forceinline__ u32x2 at_tile(LAS unsigned char* lds, unsigned QI, unsigned KI, int it, int j, unsigned l15, unsigned g) {
    f32x4 c = (f32x4){0.f, 0.f, 0.f, 0.f};
#pragma unroll
    for (int kd = 0; kd < 4; ++kd) { const bf16x8 qb = *(const LAS bf16x8*)(lds + QI + offb(16u * (unsigned)it + l15, 4u * kd + g)), a = *(const LAS bf16x8*)(lds + KI + offb(16u * (unsigned)j + l15, 4u * kd + g)); c = MFMA16(a, qb, c); }
    if (j == it) {
#pragma unroll
        for (int r = 0; r < 4; ++r) c[r] = (4u * g + r <= l15) ? c[r] : 0.f; }
    const u32x2 w = {pkbf(c[0], c[1]), pkbf(c[2], c[3])}; return w;
}
template <int NK>
__device__ __forceinline__ f32x4 o_part(LAS unsigned char* lds, unsigned QI, int it, const bf16x8 (&at)[NK], const bf16x8 (&vf)[2], const bf16x8 (&sfrag)[4], unsigned l15, unsigned g) {
    const unsigned trow = 16u * (unsigned)it + l15;
    f32x4 o = (f32x4){0.f, 0.f, 0.f, 0.f};
#pragma unroll
    for (int ks = 0; ks < NK; ++ks) if (2 * ks <= it) o = MFMA16(vf[ks], at[ks], o);
#pragma unroll
    for (int kd = 0; kd < 4; ++kd) {
        const u32x2 q0 = *(const LAS u32x2*)(lds + QI + offb(trow, 4u * kd + (g >> 1)) + 8u * (g & 1)), q1 = *(const LAS u32x2*)(lds + QI + offb(trow, 4u * kd + 2u + (g >> 1)) + 8u * (g & 1));
        o = MFMA16(sfrag[kd], frag2(q0, q1), o); }
    return o;
}
__device__ __forceinline__ void phase(LAS unsigned char* lds, const bf16_t* Qt, const bf16_t* Kt, bf16_t* VO, const float* DEC, float* ss8, int bid, int G, int wave) {
    int lane_ = fresh_lane_id();
    const unsigned lane = (unsigned)lane_, l15 = lane & 15u, g = lane >> 4, ql = l15 >> 2, p = lane & 3u;
    const unsigned vs = (unsigned)wave & 3u; const int th = wave >> 2, tA = th ? 1 : 0, tB = th ? 2 : 3;
    const unsigned ldsb = (unsigned)(uintptr_t)lds;
    constexpr unsigned BUFB = 40960u, DECB = 3u * BUFB, ATB = 131072u + 256u;
    unsigned qoff[2], voff_, doff;
#pragma unroll
    for (int i = 0; i < 2; ++i) { const unsigned j = 2u * (unsigned)wave + i, r = 4u * j + (lane >> 4), pc = lane & 15u, ch = pc ^ (((r & 3u) << 2) | ((r >> 2) & 3u)); qoff[i] = (r * DI + ch * 8u) * 2u; }
    { const unsigned r = 8u * (unsigned)wave + (lane >> 3), s16 = lane & 7u, ul = (s16 >> 1) ^ (((r >> 1) & 3u) ^ (((r >> 3) & 1u) << 1)); voff_ = (r * DI + (ul * 2u + (s16 & 1u)) * 8u) * 2u; }
    doff = (64u * ((unsigned)wave & 1u) + lane) * 4u;
    const int my_it = wave == 0 ? 0 : wave <= 2 ? 1 : wave <= 5 ? 2 : 3, my_j = wave == 0 ? 0 : wave <= 2 ? wave - 1 : wave <= 5 ? wave - 3 : wave - 6;
    for (int item = bid; item < BATCH * NHEAD * 2; item += G) {
        const int half = (item >> 3) & 1, pair = (item & 7) | ((item >> 4) << 3), b = pair >> 4, h = pair & 15;
        const size_t tokb = (size_t)b * SEQ;
        const char* qg = (const char*)(Qt + tokb * DI + h * HD);
        const char* kg = (const char*)(Kt + tokb * DI + h * HD);
        bf16_t* vg = VO + tokb * DI + h * HD + half * 64;
        const char* dg = (const char*)(DEC + (size_t)(b * (SEQ / 64)) * DI + h * HD);
        f32x4 S[8]; bf16x8 sfrag[4];
#pragma unroll
        for (int i = 0; i < 8; ++i) S[i] = (f32x4){0.f, 0.f, 0.f, 0.f};
#pragma unroll
        for (int i = 0; i < 4; ++i) sfrag[i] = (bf16x8){0, 0, 0, 0, 0, 0, 0, 0};
#define SC_DMA(n_, base_) do { const size_t c_ = (size_t)(n_) * 64 * DI * 2; \
            __builtin_amdgcn_global_load_lds((const unsigned*)(qg + c_ + qoff[0]), (LAS unsigned*)(lds + (base_) + (unsigned)wave * 2048u), 16, 0, 0); \
            __builtin_amdgcn_global_load_lds((const unsigned*)(qg + c_ + qoff[1]), (LAS unsigned*)(lds + (base_) + (unsigned)wave * 2048u + 1024u), 16, 0, 0); \
            __builtin_amdgcn_global_load_lds((const unsigned*)(kg + c_ + qoff[0]), (LAS unsigned*)(lds + (base_) + 16384u + (unsigned)wave * 2048u), 16, 0, 0); \
            __builtin_amdgcn_global_load_lds((const unsigned*)(kg + c_ + qoff[1]), (LAS unsigned*)(lds + (base_) + 16384u + (unsigned)wave * 2048u + 1024u), 16, 0, 0); \
            __builtin_amdgcn_global_load_lds((const unsigned*)((const char*)vg + c_ + voff_), (LAS unsigned*)(lds + (base_) + 32768u + (unsigned)wave * 1024u), 16, 0, 0); \
            __builtin_amdgcn_global_load_lds((const unsigned*)(dg + (size_t)(n_) * DI * 4 + doff), (LAS unsigned*)(lds + DECB + ((base_) / BUFB) * 512u + ((unsigned)wave & 1u) * 256u), 4, 0, 0); } while (0)
#define SC_AT(c_, base_) do { LAS u32x2* atw = (LAS u32x2*)(lds + ATB + (unsigned)((c_) & 1) * 5120u) + lane; \
            atw[64 * wave] = at_tile(lds, (base_), (base_) + 16384u, my_it, my_j, l15, g); \
            if (wave < 2) atw[64 * (8 + wave)] = at_tile(lds, (base_), (base_) + 16384u, 3, 2 + wave, l15, g); } while (0)
        SC_DMA(0, 0u); SC_DMA(1, BUFB);
        asm volatile("s_waitcnt vmcnt(0)" ::: "memory");
        __builtin_amdgcn_s_barrier();
        SC_AT(0, 0u);
        asm volatile("s_waitcnt lgkmcnt(0)" ::: "memory");
        __builtin_amdgcn_s_barrier();
        for (int n = 0; n < SEQ / 64; ++n) {
            const unsigned bi = (unsigned)n % 3u, QI = bi * BUFB, KI = QI + 16384u, VI = QI + 32768u;
            if (n + 2 < SEQ / 64) SC_DMA(n + 2, ((unsigned)(n + 2) % 3u) * BUFB);
            u32x2 tv0, tv1, tv2, tv3, tv4, tv5, tv6, tv7;
            {
                const unsigned va = ldsb + VI + 8u * p;
                tv0 = tr_issue(va + voffv(4u * g + ql, vs)); tv1 = tr_issue(va + voffv(16u + 4u * g + ql, vs)); tv2 = tr_issue(va + voffv(32u + 4u * g + ql, vs)); tv3 = tr_issue(va + voffv(48u + 4u * g + ql, vs));
                tv4 = tr_issue(va + voffv(8u * g + ql, vs)); tv5 = tr_issue(va + voffv(8u * g + 4u + ql, vs)); tv6 = tr_issue(va + voffv(32u + 8u * g + ql, vs)); tv7 = tr_issue(va + voffv(36u + 8u * g + ql, vs));
            }
            if (n + 1 < SEQ / 64) SC_AT(n + 1, (((unsigned)(n + 1)) % 3u) * BUFB);
            bf16x8 atB[2], atA[1];
            { const LAS u32x2* atr = (const LAS u32x2*)(lds + ATB + (unsigned)(n & 1) * 5120u) + lane; const u32x2 z2 = {0u, 0u};
              if (th == 0) { atB[0] = frag2(atr[64 * 6], atr[64 * 7]); atB[1] = frag2(atr[64 * 8], atr[64 * 9]); atA[0] = frag2(atr[0], z2); }
              else         { atB[0] = frag2(atr[64 * 3], atr[64 * 4]); atB[1] = frag2(atr[64 * 5], z2);          atA[0] = frag2(atr[64 * 1], atr[64 * 2]); } }
            asm volatile("s_waitcnt lgkmcnt(0)" : "+v"(tv0), "+v"(tv1), "+v"(tv2), "+v"(tv3), "+v"(tv4), "+v"(tv5), "+v"(tv6), "+v"(tv7) :: "memory");
            __builtin_amdgcn_sched_barrier(0);
            const bf16x8 vf[2] = {frag2(tv0, tv1), frag2(tv2, tv3)};
            const f32x4 oB = o_part<2>(lds, QI, tB, atB, vf, sfrag, l15, g);
            const f32x4 oA = o_part<1>(lds, QI, tA, atA, vf, sfrag, l15, g);
            {
                const bf16x8 vn0 = frag2(tv4, tv5), vn1 = frag2(tv6, tv7);
                const LAS float* dcp = (const LAS float*)(lds + DECB + bi * 512u) + 4u * g;
                const unsigned ka = ldsb + KI + offb(8u * g + ql, (p >> 1)) + 8u * (p & 1u), kb = ldsb + KI + offb(8u * g + 4u + ql, (p >> 1)) + 8u * (p & 1u);
#pragma unroll
                for (int i = 0; i < 8; i += 2) {
                    bf16x8 k00, k01, k10, k11;
                    tr8(ka ^ ((unsigned)i << 5), kb ^ ((unsigned)i << 5), ka ^ ((unsigned)(i + 1) << 5), kb ^ ((unsigned)(i + 1) << 5), k00, k01, k10, k11);
                    S[i] = MFMA16(k00, vn0, S[i]); S[i + 1] = MFMA16(k10, vn0, S[i + 1]); S[i] = MFMA16(k01, vn1, S[i]); S[i + 1] = MFMA16(k11, vn1, S[i + 1]); }
#pragma unroll
                for (int i = 0; i < 8; ++i) { const f32x4 dc = *(const LAS f32x4*)(dcp + 16 * i); S[i] = S[i] * dc; }
#pragma unroll
                for (int kd = 0; kd < 4; ++kd) sfrag[kd] = pack8(S[2 * kd], S[2 * kd + 1]);
            }
            asm volatile("s_waitcnt vmcnt(0)" ::: "memory");
            {
                const size_t tlB = (size_t)n * 64 + 16u * (unsigned)tB + l15, tlA = (size_t)n * 64 + 16u * (unsigned)tA + l15;
                const u32x2 wB = {pkbf(oB[0], oB[1]), pkbf(oB[2], oB[3])}, wA = {pkbf(oA[0], oA[1]), pkbf(oA[2], oA[3])};
                *(u32x2*)(vg + tlB * DI + 16u * vs + 4u * g) = wB; *(u32x2*)(vg + tlA * DI + 16u * vs + 4u * g) = wA;
                float sB = (oB[0] * oB[0] + oB[1] * oB[1]) + (oB[2] * oB[2] + oB[3] * oB[3]), sA = (oA[0] * oA[0] + oA[1] * oA[1]) + (oA[2] * oA[2] + oA[3] * oA[3]);
                sB += xor_get(sB, (int)lane, 16); sA += xor_get(sA, (int)lane, 16); sB += xor_get(sB, (int)lane, 32); sA += xor_get(sA, (int)lane, 32);
                if (g == 0) { ss8[(tokb + tlB) * 128 + h * 8 + half * 4 + vs] = sB; ss8[(tokb + tlA) * 128 + h * 8 + half * 4 + vs] = sA; }
            }
            asm volatile("s_waitcnt lgkmcnt(0)" ::: "memory");
            __builtin_amdgcn_s_barrier();
        }
#undef SC_DMA
#undef SC_AT
    }
}
#undef MFMA16
}

#define XB_TMO      128
#define XB_XCNT(j)  (256  + 64 * (j))
#define XB_XSUB(j)  (1280 + 64 * (j))
#define XB_XGEN(j)  (2304 + 64 * (j))
#define XB_TOP      3328
#define XB_TOPGEN   3392
#define XCD_BAR_WORDS 3456
#define XB_SPIN_CAP (1u << 18)
__device__ __forceinline__ unsigned xb_ld(unsigned* p)              { return __hip_atomic_load(p, __ATOMIC_RELAXED, __HIP_MEMORY_SCOPE_AGENT); }
__device__ __forceinline__ unsigned xb_add(unsigned* p, unsigned v) { return __hip_atomic_fetch_add(p, v, __ATOMIC_RELAXED, __HIP_MEMORY_SCOPE_AGENT); }
__device__ __forceinline__ unsigned xb_xcc_id() { return (unsigned)__builtin_amdgcn_s_getreg((3 << 11) | 20) & 0xFu; }
#define XB_SPIN(cond, bar) do { unsigned _sp = 0; while (cond) { __builtin_amdgcn_s_sleep(1); \
    if ((++_sp & 255u) == 0u) { if (xb_ld(&(bar)[XB_TMO])) break; if (_sp > XB_SPIN_CAP) { atomicAdd(&(bar)[XB_TMO], 1u); break; } } } } while (0)
struct XcdBarrier { unsigned* bar; unsigned x; volatile LAS unsigned* st; };
__device__ __forceinline__ XcdBarrier xcd_barrier_post(unsigned* bar, volatile LAS unsigned* st) {
    XcdBarrier b; b.bar = bar; b.x = xb_xcc_id(); b.st = st;
    if (threadIdx.x == 0) (void)xb_add(&bar[XB_XCNT(b.x)], 1u);
    return b;
}
__device__ __forceinline__ void xcd_barrier_complete(unsigned* bar, unsigned x, unsigned& nloc, unsigned& nx) {
    const unsigned G = gridDim.x * gridDim.y * gridDim.z;
    unsigned sum, cnt, mine, sp = 0u;
    for (;;) {
        sum = 0u; cnt = 0u; mine = 0u;
#pragma unroll
        for (unsigned j = 0; j < 16; ++j) { const unsigned c = xb_ld(&bar[XB_XCNT(j)]); sum += c; cnt += (c > 0u) ? 1u : 0u; mine = (j == x) ? c : mine; }
        if (sum == G) break;
        __builtin_amdgcn_s_sleep(1);
        if ((++sp & 255u) == 0u) { if (xb_ld(&bar[XB_TMO])) break; if (sp > XB_SPIN_CAP) { atomicAdd(&bar[XB_TMO], 1u); break; } }
    }
    nloc = mine > 0u ? mine : 1u; nx = cnt > 0u ? cnt : 1u;
}
__device__ __forceinline__ void xcd_barrier(const XcdBarrier& b) {
    asm volatile("s_waitcnt vmcnt(0)" ::: "memory");
    __syncthreads();
    if (threadIdx.x == 0) {
        unsigned* bar = b.bar;
        __builtin_amdgcn_s_waitcnt(0);
        unsigned nloc = b.st[0], nx = b.st[1];
        if (nloc == 0u) { xcd_barrier_complete(bar, b.x, nloc, nx); b.st[0] = nloc; b.st[1] = nx; }
        const unsigned old = xb_add(&bar[XB_XSUB(b.x)], 1u);
        const unsigned gen = old / nloc;
        if (old + 1u == (gen + 1u) * nloc) {
            __builtin_amdgcn_fence(__ATOMIC_RELEASE, "agent");
            asm volatile("s_waitcnt vmcnt(0)" ::: "memory");
            const unsigned og = xb_add(&bar[XB_TOP], 1u);
            const unsigned tg = og / nx;
            if (og + 1u == (tg + 1u) * nx) xb_add(&bar[XB_TOPGEN], 1u);
            else XB_SPIN(xb_ld(&bar[XB_TOPGEN]) == tg, bar);
            __builtin_amdgcn_fence(__ATOMIC_ACQUIRE, "agent");
            xb_add(&bar[XB_XGEN(b.x)], 1u);
            asm volatile("s_waitcnt vmcnt(0)" ::: "memory");
        } else {
            XB_SPIN(xb_ld(&bar[XB_XGEN(b.x)]) == gen, bar);
            __builtin_amdgcn_fence(__ATOMIC_ACQUIRE, "agent");
            asm volatile("s_waitcnt vmcnt(0)" ::: "memory");
        }
    }
    __syncthreads();
}

struct Args {
    const float* x; const float* norm_g; const float* pool_w_in; const float* pool_w_grp; const float* pool_scale; const float* pool_w_out;
    const float* hgrn_w_in; const float* hgrn_lb; const float* hgrn_norm_g; const float* hgrn_w_out; const float* final_g;
    float* out; unsigned char* ws;
};

struct TItem { const float* W; bf16_t* WT; const float* ks; const float* ns; int K, N, row_off, item; };
__device__ __forceinline__ void titem_issue(const TItem& t, int lane, float (&wv)[32]) {
    const int nblk = t.N / 32, kb = t.item / nblk, nb = t.item % nblk, k0 = 64 * kb, n0 = 32 * nb;
    const float* wp = t.W + (size_t)(k0 + (lane >> 5)) * t.N + n0 + (lane & 31);
#pragma unroll
    for (int i = 0; i < 32; ++i) wv[i] = wp[(size_t)(2 * i) * t.N];
}
__device__ __forceinline__ void titem_finish(const TItem& t, int lane, const float (&wv)[32], LAS float* scr) {
    const int nblk = t.N / 32, kb = t.item / nblk, nb = t.item % nblk, k0 = 64 * kb, n0 = 32 * nb;
    const float nsv = t.ns ? t.ns[n0 + (lane & 31)] : 1.0f;
    const float ksv = t.ks ? t.ks[k0 + lane] : 1.0f;
#pragma unroll
    for (int i = 0; i < 32; ++i) { const int kk = 2 * i + (lane >> 5); scr[kk * 33 + (lane & 31)] = wv[i] * nsv * lane_get(ksv, kk); }
    asm volatile("s_waitcnt lgkmcnt(0)" ::: "memory");
    const int c = lane & 7;
#pragma unroll
    for (int j = 0; j < 4; ++j) { const int n = (lane >> 3) + 8 * j; const LAS float* s = scr + (8 * c) * 33 + n;
        u32x4 o; o.x = pkbf(s[0 * 33], s[1 * 33]); o.y = pkbf(s[2 * 33], s[3 * 33]); o.z = pkbf(s[4 * 33], s[5 * 33]); o.w = pkbf(s[6 * 33], s[7 * 33]);
        *(u32x4*)(t.WT + (size_t)(t.row_off + n0 + n) * t.K + k0 + 8 * c) = o; }
    asm volatile("s_waitcnt lgkmcnt(0)" ::: "memory");
}

__global__ void __launch_bounds__(512, 2) fwd_kernel(Args a) {
    extern __shared__ __attribute__((aligned(16))) unsigned char lds_raw[];
    LAS unsigned char* lds = (LAS unsigned char*)lds_raw;
    volatile LAS unsigned* xst = (volatile LAS unsigned*)(lds + 131072 + 64);
    if (threadIdx.x < 2) xst[threadIdx.x] = 0u;
    __syncthreads();
    const XcdBarrier xbar = xcd_barrier_post((unsigned*)a.ws, xst);
#define GRID_BAR() xcd_barrier(xbar)
    const int G = gridDim.x, bid = blockIdx.x;
    const int NGW = G * 8;
    const int wave = __builtin_amdgcn_readfirstlane((int)threadIdx.x >> 6);
#define PHASE_IDS int lane_ = fresh_lane_id(); const int lane = lane_, tid = wave * 64 + lane, gw = bid * 8 + wave; (void)gw; (void)tid;
    unsigned char* ws = a.ws;
    bf16_t* Wt_in0 = (bf16_t*)(ws + WS_WIN0); bf16_t* Wt_grp = (bf16_t*)(ws + WS_WGRP); bf16_t* Wt_out0 = (bf16_t*)(ws + WS_WOUT0);
    bf16_t* Wt_in1 = (bf16_t*)(ws + WS_WIN1); bf16_t* Wt_out1 = (bf16_t*)(ws + WS_WOUT1);
    float* part1 = (float*)(ws + WS_PART1); float* ssb = (float*)(ws + WS_SS); float* decb = (float*)(ws + WS_DEC);
    bf16_t* XB = (bf16_t*)(ws + WS_XB); bf16_t* BA = (bf16_t*)(ws + WS_A); bf16_t* BB = (bf16_t*)(ws + WS_B); bf16_t* BC = (bf16_t*)(ws + WS_C);

    {
        PHASE_IDS
        LAS float* scr = (LAS float*)(lds + wave * 16384);
        constexpr int I_IN0 = (DM / 64) * (4096 / 32), I_GRP1 = (512 / 64) * (512 / 32), I_OUT = (DI / 64) * (DM / 32), I_IN1 = (DM / 64) * (8192 / 32);
        constexpr int NITEMS = I_IN0 + 4 * I_GRP1 + I_OUT + I_IN1 + I_OUT;
        auto decode = [&](int it) -> TItem {
            int r = it;
            if (r < I_IN0) return TItem{a.pool_w_in, Wt_in0, a.norm_g, nullptr, DM, 4096, 0, r}; r -= I_IN0;
            if (r < 4 * I_GRP1) { const int g = r / I_GRP1; return TItem{a.pool_w_grp + (size_t)g * 512 * 512, Wt_grp, nullptr, a.pool_scale + g * 512, 512, 512, g * 512, r % I_GRP1}; } r -= 4 * I_GRP1;
            if (r < I_OUT) return TItem{a.pool_w_out, Wt_out0, nullptr, nullptr, DI, DM, 0, r}; r -= I_OUT;
            if (r < I_IN1) {
                const int n0 = 32 * (r % (8192 / 32)); int d0 = n0;
                if (n0 < 2048) d0 = 256 * (n0 >> 7) + (n0 & 127); else if (n0 < 4096) d0 = 256 * ((n0 - 2048) >> 7) + 128 + (n0 & 127);
                return TItem{a.hgrn_w_in, Wt_in1, a.norm_g + DM, nullptr, DM, 8192, d0 - n0, r}; } r -= I_IN1;
            return TItem{a.hgrn_w_out, Wt_out1, a.hgrn_norm_g, nullptr, DI, DM, 0, r};
        };
        {
            float wa[32], wb[32]; TItem ia{}, ib{};
            int it = gw; bool ha = it < NITEMS;
            if (ha) { ia = decode(it); titem_issue(ia, lane, wa); }
            while (ha) {
                const int itb = it + NGW; const bool hb = itb < NITEMS;
                if (hb) { ib = decode(itb); titem_issue(ib, lane, wb); }
                titem_finish(ia, lane, wa, scr);
                it = itb + NGW; ha = it < NITEMS;
                if (ha) { ia = decode(it); titem_issue(ia, lane, wa); }
                if (!hb) break;
                titem_finish(ib, lane, wb, scr);
            }
        }
        for (int m0 = gw * 8; m0 < M; m0 += NGW * 8) {
            f32x4 v[8][4]; float s[8];
#pragma unroll
            for (int r = 0; r < 8; ++r) { const f32x4* xr = (const f32x4*)(a.x + (size_t)(m0 + r) * DM) + lane;
#pragma unroll
                for (int j = 0; j < 4; ++j) v[r][j] = xr[64 * j]; }
#pragma unroll
            for (int r = 0; r < 8; ++r) { s[r] = 0.f;
#pragma unroll
                for (int j = 0; j < 4; ++j) s[r] += (v[r][j][0] * v[r][j][0] + v[r][j][1] * v[r][j][1]) + (v[r][j][2] * v[r][j][2] + v[r][j][3] * v[r][j][3]); }
#pragma unroll
            for (int o = 1; o < 64; o <<= 1) {
#pragma unroll
                for (int r = 0; r < 8; ++r) s[r] += xor_get(s[r], lane, o); }
#pragma unroll
            for (int r = 0; r < 8; ++r) { const float rstd = 1.0f / sqrtf(s[r] * (1.0f / DM) + EPS);
                unsigned long long* o8 = (unsigned long long*)(XB + (size_t)(m0 + r) * DM) + lane;
#pragma unroll
                for (int j = 0; j < 4; ++j) o8[64 * j] = (unsigned long long)pkbf(v[r][j][0] * rstd, v[r][j][1] * rstd) | ((unsigned long long)pkbf(v[r][j][2] * rstd, v[r][j][3] * rstd) << 32); }
        }
    }
    GRID_BAR();

    {
        pg8::Gemm g{XB, Wt_in0, DM, DM, DM, 0}; pg8::StaticOrder S; S.init(M, 4096, G, bid);
        pg8::EpiP1 E{BA, BB};
        pg8::gemm_phase<pg8::EpiP1>(lds, g, S, E, wave);
    }
    GRID_BAR();

    {
        PHASE_IDS
        constexpr int RUN = 64;
        const int nruns = (M / RUN) * (DI / 8);
        for (int idx = bid * 512 + tid; idx < nruns; idx += G * 512) {
            const int cgp = idx & 255, run = idx >> 8, grp = cgp >> 6, w = 2 << grp;
            const int m0 = run * RUN, t0 = m0 & (SEQ - 1);
            const bf16_t* vp = BA + (size_t)m0 * DI + cgp * 8; bf16_t* pp = BC + (size_t)m0 * DI + cgp * 8;
            float sum[8];
#pragma unroll
            for (int j = 0; j < 8; ++j) sum[j] = 0.f;
            if (t0 > 0) for (int k = 1; k < w; ++k) { const u32x4 vv = *(const u32x4*)(vp - (size_t)k * DI);
                sum[0] += bf_lo(vv.x); sum[1] += bf_hi(vv.x); sum[2] += bf_lo(vv.y); sum[3] += bf_hi(vv.y); sum[4] += bf_lo(vv.z); sum[5] += bf_hi(vv.z); sum[6] += bf_lo(vv.w); sum[7] += bf_hi(vv.w); }
            for (int i0 = 0; i0 < RUN; i0 += 8) {
                u32x4 vin[8], vout[8];
#pragma unroll
                for (int j = 0; j < 8; ++j) vin[j] = *(const u32x4*)(vp + (size_t)(i0 + j) * DI);
#pragma unroll
                for (int j = 0; j < 8; ++j) { const int i = i0 + j; vout[j] = (t0 + i + 1 >= w) ? *(const u32x4*)(vp + (size_t)(i + 1 - w) * DI) : (u32x4){0u, 0u, 0u, 0u}; }
#pragma unroll
                for (int j = 0; j < 8; ++j) {
                    const int i = i0 + j, t = t0 + i;
                    const u32x4 vv = vin[j];
                    float x[8] = {bf_lo(vv.x), bf_hi(vv.x), bf_lo(vv.y), bf_hi(vv.y), bf_lo(vv.z), bf_hi(vv.z), bf_lo(vv.w), bf_hi(vv.w)};
#pragma unroll
                    for (int c = 0; c < 8; ++c) sum[c] += x[c];
                    const int cnt = (t + 1) < w ? (t + 1) : w; const float inv = 1.0f / (float)cnt;
                    u32x4 o; o.x = pkbf(sum[0] * inv - x[0], sum[1] * inv - x[1]); o.y = pkbf(sum[2] * inv - x[2], sum[3] * inv - x[3]);
                    o.z = pkbf(sum[4] * inv - x[4], sum[5] * inv - x[5]); o.w = pkbf(sum[6] * inv - x[6], sum[7] * inv - x[7]);
                    *(u32x4*)(pp + (size_t)i * DI) = o;
                    const u32x4 uu = vout[j];
                    sum[0] -= bf_lo(uu.x); sum[1] -= bf_hi(uu.x); sum[2] -= bf_lo(uu.y); sum[3] -= bf_hi(uu.y); sum[4] -= bf_lo(uu.z); sum[5] -= bf_hi(uu.z); sum[6] -= bf_lo(uu.w); sum[7] -= bf_hi(uu.w);
                }
            }
        }
    }
    GRID_BAR();

    {
        pg8::Gemm g{BC, Wt_grp, DI, 512, 512, 2}; pg8::StaticOrder S; S.init(M, DI, G, bid);
        pg8::EpiP2 E{BB};
        pg8::gemm_phase<pg8::EpiP2>(lds, g, S, E, wave);
    }
    GRID_BAR();

    {
        pg8::Gemm g{BB, Wt_out0, DI, DI, DI, 0}; pg8::StaticOrder S; S.init(M, DM, G, bid);
        pg8::EpiRes<true, false> E{a.x, nullptr, XB, part1};
        pg8::gemm_phase<pg8::EpiRes<true, false>>(lds, g, S, E, wave);
    }
    GRID_BAR();

    {
        pg8::Gemm g{XB, Wt_in1, DM, DM, DM, 0}; pg8::StaticOrder S; S.init(M, 6144, G, bid);
        pg8::EpiP4 E{BA, BB, BC, decb, part1, a.hgrn_lb};
        pg8::gemm_phase<pg8::EpiP4>(lds, g, S, E, wave);
    }
    GRID_BAR();

    scan::phase(lds, BA, BB, BC, decb, ssb, bid, G, wave);
    GRID_BAR();

    {
        pg8::Gemm g{XB, Wt_in1 + (size_t)6144 * DM, DM, DM, DM, 0}; pg8::StaticOrder S; S.init(M, DI, G, bid);
        pg8::EpiP5b E{BC, part1, ssb};
        pg8::gemm_phase<pg8::EpiP5b>(lds, g, S, E, wave);
    }
    GRID_BAR();

    {
        pg8::Gemm g{BC, Wt_out1, DI, DI, DI, 0}; pg8::StaticOrder S; S.init(M, DM, G, bid);
        pg8::EpiFinal E{XB, a.out, a.final_g, (float*)(ws + WS_X), (unsigned*)(ws + WS_CNT)};
        pg8::gemm_phase<pg8::EpiFinal>(lds, g, S, E, wave);
    }
}

extern "C" void kernel_launch(void* const* d_in, const int* in_sizes, int n_in, void* d_out, int out_size, void* d_ws, size_t ws_size, hipStream_t stream) {
    static int grid = 0;
    if (grid == 0) {
        if (n_in != 11 || in_sizes[0] != M * DM || out_size != M * DM || ws_size < WS_END) { fprintf(stderr, "kernel_launch: unexpected shapes (n_in %d in0 %d out %d ws %zu)\n", n_in, n_in > 0 ? in_sizes[0] : -1, out_size, ws_size); grid = -1; return; }
        int dev = 0, cus = 0, per = 0;
        if (hipGetDevice(&dev) != hipSuccess || hipDeviceGetAttribute(&cus, hipDeviceAttributeMultiprocessorCount, dev) != hipSuccess) { grid = -1; return; }
        if (hipFuncSetAttribute((const void*)fwd_kernel, hipFuncAttributeMaxDynamicSharedMemorySize, LDS_BYTES) != hipSuccess) { fprintf(stderr, "kernel_launch: hipFuncSetAttribute failed\n"); grid = -1; return; }
        if (hipOccupancyMaxActiveBlocksPerMultiprocessor(&per, (const void*)fwd_kernel, 512, LDS_BYTES) != hipSuccess || per < 1) { fprintf(stderr, "kernel_launch: occupancy query says %d\n", per); (void)hipGetLastError(); grid = -1; return; }
        grid = cus;
        fprintf(stderr, "kernel_launch: cus %d per_cu %d grid %d\n", cus, per, grid);
    }
    if (grid < 0) return;
    if (hipMemsetAsync(d_ws, 0, 32768, stream) != hipSuccess) { fprintf(stderr, "kernel_launch: hipMemsetAsync failed\n"); return; }
    Args a{};
    a.x = (const float*)d_in[0]; a.norm_g = (const float*)d_in[1]; a.pool_w_in = (const float*)d_in[2]; a.pool_w_grp = (const float*)d_in[3];
    a.pool_scale = (const float*)d_in[4]; a.pool_w_out = (const float*)d_in[5]; a.hgrn_w_in = (const float*)d_in[6]; a.hgrn_lb = (const float*)d_in[7];
    a.hgrn_norm_g = (const float*)d_in[8]; a.hgrn_w_out = (const float*)d_in[9]; a.final_g = (const float*)d_in[10];
    a.out = (float*)d_out; a.ws = (unsigned char*)d_ws;
    void* args[] = {&a};
    hipError_t e = hipLaunchCooperativeKernel((void*)fwd_kernel, dim3(grid), dim3(512), args, LDS_BYTES, stream);
    if (e != hipSuccess) fprintf(stderr, "kernel_launch: cooperative launch failed: %s (grid %d)\n", hipGetErrorString(e), grid);
}
```

```cpp
#include <hip/hip_runtime.h>
#include <cstdio>
#include <cstdint>

#define LAS __attribute__((address_space(3)))
typedef unsigned short bf16_t;
typedef short bf16x8 __attribute__((ext_vector_type(8)));
typedef float f32x4 __attribute__((ext_vector_type(4)));
typedef float f32x2 __attribute__((ext_vector_type(2)));
typedef unsigned u32x4 __attribute__((ext_vector_type(4)));
typedef unsigned u32x2 __attribute__((ext_vector_type(2)));

constexpr int DM = 1024, BATCH = 8, SEQ = 4096, DI = 2048, M = BATCH * SEQ;
constexpr int NHEAD = 16, HD = 128;
constexpr float EPS = 1e-6f;
constexpr size_t MiB = 1u << 20;
constexpr size_t WS_WIN0 = 2 * MiB;
constexpr size_t WS_WGRP = 10 * MiB;
constexpr size_t WS_WOUT0 = 12 * MiB;
constexpr size_t WS_WIN1 = 16 * MiB;
constexpr size_t WS_WOUT1 = 32 * MiB;
constexpr size_t WS_PART1 = 36 * MiB;
constexpr size_t WS_CNT = 16384;
constexpr size_t WS_X = 40 * MiB;
constexpr size_t WS_DEC = 44 * MiB;
constexpr size_t WS_SS = 112 * MiB;
constexpr size_t WS_XB = 48 * MiB;
constexpr size_t WS_A = 128 * MiB;
constexpr size_t WS_B = 256 * MiB;
constexpr size_t WS_C = 384 * MiB;
constexpr size_t WS_END = 512 * MiB;
constexpr int LDS_BYTES = 147456;

typedef __bf16 bf2_t __attribute__((ext_vector_type(2)));
__device__ __forceinline__ unsigned pkbf(float lo, float hi) { f32x2 v = {lo, hi}; return __builtin_bit_cast(unsigned, __builtin_convertvector(v, bf2_t)); }
__device__ __forceinline__ float bf_lo(unsigned w) { return __builtin_bit_cast(float, w << 16); }
__device__ __forceinline__ float bf_hi(unsigned w) { return __builtin_bit_cast(float, w & 0xffff0000u); }
__device__ __forceinline__ float silu_f(float x) { return x * __builtin_amdgcn_rcpf(1.0f + __builtin_amdgcn_exp2f(-1.44269504089f * x)); }
__device__ __forceinline__ int fresh_lane_id() { int l; asm volatile("v_mbcnt_lo_u32_b32 %0, -1, 0\n\tv_mbcnt_hi_u32_b32 %0, -1, %0" : "=v"(l)); return l; }
__device__ __forceinline__ float lane_get(float v, int src_lane) { return __builtin_bit_cast(float, __builtin_amdgcn_ds_bpermute(src_lane << 2, __builtin_bit_cast(int, v))); }
__device__ __forceinline__ float xor_get(float v, int lane, int m) { return lane_get(v, lane ^ m); }
__device__ __forceinline__ float wave_sum(float v, int lane) {
#pragma unroll
    for (int o = 1; o < 64; o <<= 1) v += xor_get(v, lane, o);
    return v;
}

namespace pg8 {
constexpr int BM = 256, BK = 64, HALF = 128, HTB = HALF * BK * 2, NXCD = 8, WGM = 4;
__host__ __device__ __forceinline__ int lds_byte(int r, int c) { const int st = (r >> 4) * 2 + (c >> 5), rr = r & 15, cc = c & 31, ob = rr * 64 + cc * 2; return st * 1024 + (ob ^ (((ob >> 9) & 1) << 5)); }
__host__ __device__ __forceinline__ void stage_rc(int b, int& R, int& C) { const int st = b / 1024, sb = b % 1024, swz = sb ^ (((sb >> 9) & 1) << 5); R = (st >> 1) * 16 + swz / 64; C = (st & 1) * 32 + (swz % 64) / 2; }
__host__ __device__ __forceinline__ int perm32(int rho) { const int n = rho >> 4, i = rho & 15; return 8 * (i >> 2) + 4 * n + (i & 3); }

struct Unit { int pm, pn; };
struct Gemm { const bf16_t* A; const bf16_t* Bt; int lda, ldb, K, grp_tiles; };

struct StaticOrder {
    int nM, nN, nwg, G, c;
    __host__ __device__ void init(int M_, int N_, int G_, int c_) { nM = M_ / BM; nN = N_ / BM; nwg = nM * nN; G = G_; c = c_; }
    __host__ __device__ bool next(int i, Unit& u) const {
        const long L = (long)i * G + c; if (L >= nwg) return false;
        int wgid = (int)L; { const int q = nwg / NXCD, r = nwg % NXCD, xcd = wgid % NXCD, off = wgid / NXCD; wgid = (xcd < r ? xcd * (q + 1) : r * (q + 1) + (xcd - r) * q) + off; }
        const int nig = WGM * nN, gid = wgid / nig, fm = gid * WGM, gsz = (nM - fm) < WGM ? (nM - fm) : WGM;
        u.pm = fm + ((wgid % nig) % gsz); u.pn = (wgid % nig) / gsz; return true;
    }
};


__device__ __forceinline__ void zero_acc(f32x4 (&acc)[2][2][4][2]) {
#pragma unroll
    for (int a = 0; a < 2; ++a)
#pragma unroll
        for (int b = 0; b < 2; ++b)
#pragma unroll
            for (int m = 0; m < 4; ++m)
#pragma unroll
                for (int n = 0; n < 2; ++n) acc[a][b][m][n] = (f32x4){0.f, 0.f, 0.f, 0.f};
}
template <class Epi, bool ALIGN_EPI = true, bool SP2 = true>
__device__ __forceinline__ void gemm_phase(LAS unsigned char* lds, const Gemm g, const StaticOrder& S, const Epi& E, const int wid) {
    int lane_ = fresh_lane_id();
    int lane = lane_, tid = wid * 64 + lane, fr = lane & 15, fq = lane >> 4; const int wr = wid >> 2, wc = wid & 3;
    const int K = g.K, nt = K / BK;
    unsigned voffA[2], voffB[2]; int aoff, boff;
#define PG8_LANE_STATE() do { _Pragma("unroll") for (int i = 0; i < 2; ++i) { int R, C; stage_rc(tid * 16 + i * 8192, R, C); const int Rb = Epi::PERM ? ((R & ~31) + perm32(R & 31)) : R; \
        voffA[i] = (unsigned)(R * g.lda + C) * 2u; voffB[i] = (unsigned)(Rb * g.ldb + C) * 2u; } \
        aoff = lds_byte(wr * 64 + fr, fq * 8); boff = lds_byte(wc * 32 + fr, fq * 8); } while (0)
    PG8_LANE_STATE();
    const size_t kstep = (size_t)(BK * 2);
    const size_t hstepA = (size_t)HALF * g.lda * 2, hstepB = (size_t)HALF * g.ldb * 2;
    const size_t tstepA = 2 * hstepA, tstepB = 2 * hstepB;
    const unsigned ldsw = (unsigned)wid * 1024u;
#define PG8_SA(b, h) (((b) * 2 + (h)) * HTB)
#define PG8_SB(b, h) ((4 + (b) * 2 + (h)) * HTB)
#define PG8_STAGE(bufoff, gbase, voff) do { _Pragma("unroll") for (int _i = 0; _i < 2; ++_i) \
        __builtin_amdgcn_global_load_lds((const unsigned*)((const char*)(gbase) + (voff)[_i]), (LAS unsigned*)(lds + (bufoff) + ldsw + _i * 8192), 16, 0, 0); } while (0)
#define PG8_LDA(dst, b, h) do { _Pragma("unroll") for (int m = 0; m < 4; ++m) _Pragma("unroll") for (int k = 0; k < 2; ++k) dst[m][k] = *(const LAS bf16x8*)(lds + PG8_SA(b, h) + aoff + m * 2048 + k * 1024); } while (0)
#define PG8_LDB(dst, b, h) do { _Pragma("unroll") for (int n = 0; n < 2; ++n) _Pragma("unroll") for (int k = 0; k < 2; ++k) dst[n][k] = *(const LAS bf16x8*)(lds + PG8_SB(b, h) + boff + n * 2048 + k * 1024); } while (0)
#define PG8_MMA(ai, bj, At, Bt) do { __builtin_amdgcn_s_setprio(1); _Pragma("unroll") for (int m = 0; m < 4; ++m) _Pragma("unroll") for (int n = 0; n < 2; ++n) _Pragma("unroll") for (int k = 0; k < 2; ++k) \
        acc[ai][bj][m][n] = __builtin_amdgcn_mfma_f32_16x16x32_bf16(Bt[n][k], At[m][k], acc[ai][bj][m][n], 0, 0, 0); __builtin_amdgcn_s_setprio(0); } while (0)
#define PG8_WAIT_V(n) asm volatile("s_waitcnt vmcnt(" #n ")" ::: "memory")
#define PG8_WAIT_L(n) asm volatile("s_waitcnt lgkmcnt(" #n ")" ::: "memory")
#define PG8_BAR __builtin_amdgcn_s_barrier()
#define PG8_SCHED __builtin_amdgcn_sched_barrier(0)
#define PG8_ABASE(u) ((const char*)g.A + (size_t)(u).pm * tstepA + (g.grp_tiles ? (size_t)((u).pn / g.grp_tiles) * (size_t)K * 2 : (size_t)0))
#define PG8_BBASE(u) ((const char*)g.Bt + (size_t)(u).pn * tstepB)
    Unit cur, nxt; int ui = 0;
    E.prologue(S, lds, tid);
    if (!S.next(0, cur)) return;
    f32x4 acc[2][2][4][2];
    E.init_acc(acc, cur, wr, wc, fr, fq);
    bf16x8 At[4][2], B0[2][2], B1[2][2];
    const char* cA = PG8_ABASE(cur); const char* cB = PG8_BBASE(cur);
    if constexpr (SP2) {
        PG8_STAGE(PG8_SB(0, 0), cB, voffB); PG8_STAGE(PG8_SB(0, 1), cB + hstepB, voffB); PG8_STAGE(PG8_SA(0, 0), cA, voffA); PG8_STAGE(PG8_SA(0, 1), cA + hstepA, voffA);
        if (wr == 1) PG8_BAR;
        PG8_WAIT_V(2); PG8_BAR;
        PG8_STAGE(PG8_SB(1, 0), cB + kstep, voffB); PG8_STAGE(PG8_SA(1, 0), cA + kstep, voffA); PG8_STAGE(PG8_SB(1, 1), cB + hstepB + kstep, voffB);
        PG8_WAIT_V(6); PG8_BAR;
    } else {
        PG8_STAGE(PG8_SB(0, 0), cB, voffB); PG8_STAGE(PG8_SA(0, 0), cA, voffA); PG8_STAGE(PG8_SB(0, 1), cB + hstepB, voffB); PG8_STAGE(PG8_SA(0, 1), cA + hstepA, voffA);
        if (wr == 1) PG8_BAR;
        PG8_WAIT_V(4); PG8_BAR;
        PG8_STAGE(PG8_SB(1, 0), cB + kstep, voffB); PG8_STAGE(PG8_SA(1, 0), cA + kstep, voffA); PG8_STAGE(PG8_SB(1, 1), cB + hstepB + kstep, voffB);
        PG8_WAIT_V(6); PG8_BAR;
    }
    for (;;) {
        const bool has_next = S.next(ui + 1, nxt);
        const char* nA = has_next ? PG8_ABASE(nxt) : cA; const char* nB = has_next ? PG8_BBASE(nxt) : cB;
        for (int t = 0; t < nt; t += 2) {
            const bool last = (t == nt - 2);
            const char* a1 = cA + (size_t)(t + 1) * kstep;
            const char* a2 = last ? nA : cA + (size_t)(t + 2) * kstep; const char* b2 = last ? nB : cB + (size_t)(t + 2) * kstep;
            const char* a3 = a2 + kstep; const char* b3 = b2 + kstep;
            if constexpr (SP2) {
            PG8_LDB(B0, 0, 0); PG8_LDB(B1, 0, 1); PG8_SCHED; PG8_LDA(At, 0, 0); PG8_STAGE(PG8_SA(1, 1), a1 + hstepA, voffA);
            PG8_WAIT_V(8); PG8_WAIT_L(0); PG8_BAR; PG8_MMA(0, 0, At, B0); PG8_MMA(0, 1, At, B1); PG8_BAR; PG8_SCHED;
            PG8_LDA(At, 0, 1); PG8_STAGE(PG8_SB(0, 0), b2, voffB); PG8_STAGE(PG8_SB(0, 1), b2 + hstepB, voffB); PG8_STAGE(PG8_SA(0, 0), a2, voffA);
            PG8_WAIT_V(8); PG8_WAIT_L(0); PG8_BAR; PG8_MMA(1, 0, At, B0); PG8_MMA(1, 1, At, B1); PG8_BAR; PG8_SCHED;
            PG8_LDB(B0, 1, 0); PG8_LDB(B1, 1, 1); PG8_SCHED; PG8_LDA(At, 1, 0); PG8_STAGE(PG8_SA(0, 1), a2 + hstepA, voffA);
            PG8_WAIT_V(8); PG8_WAIT_L(0); PG8_BAR; PG8_MMA(0, 0, At, B0); PG8_MMA(0, 1, At, B1); PG8_BAR; PG8_SCHED;
            PG8_LDA(At, 1, 1); PG8_STAGE(PG8_SB(1, 0), b3, voffB); PG8_STAGE(PG8_SB(1, 1), b3 + hstepB, voffB); PG8_STAGE(PG8_SA(1, 0), a3, voffA);
            PG8_WAIT_V(8); PG8_WAIT_L(0); PG8_BAR; PG8_MMA(1, 0, At, B0); PG8_MMA(1, 1, At, B1); PG8_BAR; PG8_SCHED;
            } else {
            PG8_LDB(B0, 0, 0); PG8_SCHED; PG8_LDA(At, 0, 0); PG8_STAGE(PG8_SA(1, 1), a1 + hstepA, voffA);
            PG8_WAIT_L(8); PG8_BAR; PG8_WAIT_L(0); PG8_MMA(0, 0, At, B0); PG8_BAR; PG8_SCHED;
            PG8_LDB(B1, 0, 1); PG8_STAGE(PG8_SB(0, 0), b2, voffB);
            PG8_BAR; PG8_WAIT_L(0); PG8_MMA(0, 1, At, B1); PG8_BAR;
            PG8_LDA(At, 0, 1); PG8_STAGE(PG8_SA(0, 0), a2, voffA);
            PG8_BAR; PG8_WAIT_L(0); PG8_MMA(1, 0, At, B0); PG8_BAR; PG8_SCHED;
            PG8_STAGE(PG8_SB(0, 1), b2 + hstepB, voffB);
            PG8_WAIT_V(6); PG8_BAR; PG8_MMA(1, 1, At, B1); PG8_BAR;
            PG8_LDB(B0, 1, 0); PG8_SCHED; PG8_LDA(At, 1, 0); PG8_STAGE(PG8_SA(0, 1), a2 + hstepA, voffA);
            PG8_WAIT_L(8); PG8_BAR; PG8_WAIT_L(0); PG8_MMA(0, 0, At, B0); PG8_BAR; PG8_SCHED;
            PG8_LDB(B1, 1, 1); PG8_STAGE(PG8_SB(1, 0), b3, voffB);
            PG8_BAR; PG8_WAIT_L(0); PG8_MMA(0, 1, At, B1); PG8_BAR;
            PG8_LDA(At, 1, 1); PG8_STAGE(PG8_SA(1, 0), a3, voffA);
            PG8_BAR; PG8_WAIT_L(0); PG8_MMA(1, 0, At, B0); PG8_BAR; PG8_SCHED;
            PG8_STAGE(PG8_SB(1, 1), b3 + hstepB, voffB);
            PG8_WAIT_V(6); PG8_BAR; PG8_MMA(1, 1, At, B1); PG8_BAR;
            }
        }
        if constexpr (ALIGN_EPI) { if (wr == 0) PG8_BAR; }
        if constexpr (!Epi::AFTER_DRAIN) E(acc, cur, wr, wc, fr, fq, lds, ui);
        if (!has_next) break;
        cur = nxt; cA = nA; cB = nB; ++ui;
        asm volatile("" : "+v"(lane)); tid = wid * 64 + lane; fr = lane & 15; fq = lane >> 4; PG8_LANE_STATE();
        E.init_acc(acc, cur, wr, wc, fr, fq);
        if constexpr (ALIGN_EPI) { if (wr == 1) PG8_BAR; }
    }
    PG8_WAIT_V(0);
    if constexpr (!ALIGN_EPI) { if (wr == 0) PG8_BAR; }
    PG8_BAR;
    if constexpr (Epi::AFTER_DRAIN) E.fused(acc, cur, wr, wc, fr, fq, lds, tid);
#undef PG8_SA
#undef PG8_SB
#undef PG8_STAGE
#undef PG8_LDA
#undef PG8_LDB
#undef PG8_MMA
#undef PG8_WAIT_V
#undef PG8_WAIT_L
#undef PG8_BAR
#undef PG8_SCHED
#undef PG8_ABASE
#undef PG8_LANE_STATE
#undef PG8_BBASE
}

struct EpiP1 {
    static constexpr bool PERM = true, AFTER_DRAIN = false;
    __device__ __forceinline__ void init_acc(f32x4 (&acc)[2][2][4][2], const Unit&, int, int, int, int) const { zero_acc(acc); }
    __device__ __forceinline__ void prologue(const StaticOrder&, LAS unsigned char*, int) const {}
    bf16_t* V; bf16_t* SG;
    __device__ __forceinline__ void operator()(f32x4 (&acc)[2][2][4][2], const Unit& u, int wr, int wc, int fr, int fq, LAS unsigned char* lds, int ui) const {
        const int row0 = u.pm * BM + wr * 64 + fr; const bool gate = u.pn >= 8;
        bf16_t* base = gate ? SG : V; const int col0 = (u.pn & 7) * BM + wc * 32 + 8 * fq;
#pragma unroll
        for (int ai = 0; ai < 2; ++ai)
#pragma unroll
            for (int m = 0; m < 4; ++m) { bf16_t* rowp = base + (size_t)(row0 + ai * HALF + m * 16) * DI + col0;
#pragma unroll
                for (int bj = 0; bj < 2; ++bj) { f32x4 v0 = acc[ai][bj][m][0], v1 = acc[ai][bj][m][1];
                    if (gate) {
#pragma unroll
                        for (int j = 0; j < 4; ++j) { v0[j] = silu_f(v0[j]); v1[j] = silu_f(v1[j]); } }
                    u32x4 w; w.x = pkbf(v0[0], v0[1]); w.y = pkbf(v0[2], v0[3]); w.z = pkbf(v1[0], v1[1]); w.w = pkbf(v1[2], v1[3]);
                    __builtin_nontemporal_store(w, (u32x4*)(rowp + bj * HALF)); } }
    }
};
struct EpiP2 {
    static constexpr bool PERM = true, AFTER_DRAIN = false;
    __device__ __forceinline__ void init_acc(f32x4 (&acc)[2][2][4][2], const Unit&, int, int, int, int) const { zero_acc(acc); }
    __device__ __forceinline__ void prologue(const StaticOrder&, LAS unsigned char*, int) const {}
    bf16_t* Z;
    __device__ __forceinline__ void operator()(f32x4 (&acc)[2][2][4][2], const Unit& u, int wr, int wc, int fr, int fq, LAS unsigned char* lds, int ui) const {
        const unsigned row0 = (unsigned)(u.pm * BM + wr * 64 + fr), col0 = (unsigned)(u.pn * BM + wc * 32 + 8 * fq);
        const unsigned zofs = (row0 * DI + col0) * 2u;
#pragma unroll
        for (int ai = 0; ai < 2; ++ai) {
            u32x4 sv[4][2];
#pragma unroll
            for (int m = 0; m < 4; ++m)
#pragma unroll
                for (int bj = 0; bj < 2; ++bj) sv[m][bj] = *(const u32x4*)((const char*)Z + (zofs + (unsigned)((ai * HALF + m * 16) * DI + bj * HALF) * 2u));
#pragma unroll
            for (int m = 0; m < 4; ++m)
#pragma unroll
                for (int bj = 0; bj < 2; ++bj) { const f32x4 v0 = acc[ai][bj][m][0], v1 = acc[ai][bj][m][1]; const u32x4 s = sv[m][bj];
                    u32x4 w; w.x = pkbf(v0[0] * bf_lo(s.x), v0[1] * bf_hi(s.x)); w.y = pkbf(v0[2] * bf_lo(s.y), v0[3] * bf_hi(s.y));
                    w.z = pkbf(v1[0] * bf_lo(s.z), v1[1] * bf_hi(s.z)); w.w = pkbf(v1[2] * bf_lo(s.w), v1[3] * bf_hi(s.w));
                    *(u32x4*)((char*)Z + (zofs + (unsigned)((ai * HALF + m * 16) * DI + bj * HALF) * 2u)) = w; }
            asm volatile("" ::: "memory"); }
    }
};
template <bool WRITE_HB, bool WRITE_H = true> struct EpiRes {
    static constexpr bool PERM = true, AFTER_DRAIN = false;
    __device__ __forceinline__ void prologue(const StaticOrder&, LAS unsigned char*, int) const {}
    const float* R; float* H; bf16_t* HB; float* part;
    __device__ __forceinline__ void init_acc(f32x4 (&acc)[2][2][4][2], const Unit& u, int wr, int wc, int fr, int fq) const {
        const unsigned row0 = (unsigned)(u.pm * BM + wr * 64 + fr), col0 = (unsigned)(u.pn * BM + wc * 32 + 8 * fq);
        const unsigned ofs = (row0 * DM + col0) * 4u;
#pragma unroll
        for (int ai = 0; ai < 2; ++ai)
#pragma unroll
            for (int bj = 0; bj < 2; ++bj)
#pragma unroll
                for (int m = 0; m < 4; ++m)
#pragma unroll
                    for (int n = 0; n < 2; ++n) acc[ai][bj][m][n] = __builtin_nontemporal_load((const f32x4*)((const char*)R + (ofs + (unsigned)((ai * HALF + m * 16) * DM + bj * HALF + n * 4) * 4u)));
    }
    __device__ __forceinline__ void operator()(f32x4 (&acc)[2][2][4][2], const Unit& u, int wr, int wc, int fr, int fq, LAS unsigned char* lds, int ui) const {
        const unsigned row0 = (unsigned)(u.pm * BM + wr * 64 + fr), col0 = (unsigned)(u.pn * BM + wc * 32 + 8 * fq);
        const unsigned ofs = (row0 * DM + col0) * 4u, pofs = (row0 * 16u + (unsigned)(u.pn * 4 + wc)) * 4u;
#pragma unroll
        for (int ai = 0; ai < 2; ++ai)
#pragma unroll
            for (int m = 0; m < 4; ++m) { const unsigned o = ofs + (unsigned)((ai * HALF + m * 16) * DM) * 4u; float ss = 0.f;
#pragma unroll
                for (int bj = 0; bj < 2; ++bj) { const unsigned oo = o + (unsigned)(bj * HALF) * 4u; const f32x4 h0 = acc[ai][bj][m][0], h1 = acc[ai][bj][m][1];
                    if (WRITE_H) { *(f32x4*)((char*)H + oo) = h0; *(f32x4*)((char*)H + oo + 16u) = h1; }
                    ss += ((h0[0] * h0[0] + h0[1] * h0[1]) + (h0[2] * h0[2] + h0[3] * h0[3])) + ((h1[0] * h1[0] + h1[1] * h1[1]) + (h1[2] * h1[2] + h1[3] * h1[3]));
                    if (WRITE_HB) { u32x4 w; w.x = pkbf(h0[0], h0[1]); w.y = pkbf(h0[2], h0[3]); w.z = pkbf(h1[0], h1[1]); w.w = pkbf(h1[2], h1[3]); *(u32x4*)((char*)HB + (oo >> 1)) = w; } }
                ss += xor_get(ss, fq * 16 + fr, 16); ss += xor_get(ss, fq * 16 + fr, 32);
                if (fq == 0) *(float*)((char*)part + (pofs + (unsigned)(ai * HALF + m * 16) * 64u)) = ss; }
    }
};
__device__ __forceinline__ float row_rstd_b(const float* part, unsigned bofs) {
    const f32x4* p = (const f32x4*)((const char*)part + bofs); const f32x4 a = p[0], b = p[1], c = p[2], d = p[3];
    return __builtin_amdgcn_rsqf((((a[0] + a[1]) + (a[2] + a[3])) + ((b[0] + b[1]) + (b[2] + b[3])) + ((c[0] + c[1]) + (c[2] + c[3])) + ((d[0] + d[1]) + (d[2] + d[3]))) * (1.0f / DM) + EPS);
}
__device__ __forceinline__ float dpp_shr_mul(float v, const int n) {
    const int iv = __builtin_bit_cast(int, v), one = 0x3f800000; int r;
    if (n == 1) r = __builtin_amdgcn_update_dpp(one, iv, 0x111, 0xf, 0xf, false); else if (n == 2) r = __builtin_amdgcn_update_dpp(one, iv, 0x112, 0xf, 0xf, false);
    else if (n == 4) r = __builtin_amdgcn_update_dpp(one, iv, 0x114, 0xf, 0xf, false); else r = __builtin_amdgcn_update_dpp(one, iv, 0x118, 0xf, 0xf, false);
    return v * __builtin_bit_cast(float, r);
}
constexpr unsigned TAB_OFF = 131072u + 256u;
struct EpiP4 {
    static constexpr bool PERM = true, AFTER_DRAIN = false;
    __device__ __forceinline__ void init_acc(f32x4 (&acc)[2][2][4][2], const Unit&, int, int, int, int) const { zero_acc(acc); }
    bf16_t* Qt; bf16_t* Kt; bf16_t* V; float* DEC; const float* part; const float* lbnd;
    __device__ __forceinline__ void prologue(const StaticOrder& S, LAS unsigned char* lds, int tid) const {
        LAS float* T = (LAS float*)(lds + TAB_OFF); Unit u;
        for (int i = 0; i < 12 && S.next(i, u); ++i)
            if (tid < 256) T[i * 256 + tid] = row_rstd_b(part, (unsigned)(u.pm * BM + tid) * 64u);
        __syncthreads();
    }
    __device__ __forceinline__ void operator()(f32x4 (&acc)[2][2][4][2], const Unit& u, int wr, int wc, int fr, int fq, LAS unsigned char* lds, int ui) const {
        const unsigned row0 = (unsigned)(u.pm * BM + wr * 64 + fr);
        const LAS float* T = (const LAS float*)(lds + TAB_OFF) + ui * 256 + wr * 64 + fr;
        if (u.pn >= 16) {
            const unsigned vofs = (row0 * DI + (unsigned)((u.pn - 16) * BM + wc * 32 + 8 * fq)) * 2u;
#pragma unroll
            for (int ai = 0; ai < 2; ++ai)
#pragma unroll
                for (int m = 0; m < 4; ++m) { const float rs = T[ai * HALF + m * 16];
#pragma unroll
                    for (int bj = 0; bj < 2; ++bj) { const f32x4 v0 = acc[ai][bj][m][0] * rs, v1 = acc[ai][bj][m][1] * rs;
                        u32x4 w; w.x = pkbf(v0[0], v0[1]); w.y = pkbf(v0[2], v0[3]); w.z = pkbf(v1[0], v1[1]); w.w = pkbf(v1[2], v1[3]);
                        __builtin_nontemporal_store(w, (u32x4*)((char*)V + (vofs + (unsigned)((ai * HALF + m * 16) * DI + bj * HALF) * 2u))); } }
            return;
        }
        const unsigned c0 = (unsigned)(u.pn * HD + wc * 32 + 8 * fq);
        const unsigned qofs = (row0 * DI + c0) * 2u;
#pragma unroll
        for (int ai = 0; ai < 2; ++ai) {
            float rs[4];
#pragma unroll
            for (int m = 0; m < 4; ++m) rs[m] = T[ai * HALF + m * 16];
            unsigned cc = c0; asm volatile("" : "+v"(cc));
#pragma unroll
            for (int n = 0; n < 2; ++n) {
                const f32x4 l0 = *(const f32x4*)((const char*)lbnd + (cc + 4 * n) * 4u), l1 = *(const f32x4*)((const char*)lbnd + (cc + 4 * n + DI) * 4u);
                f32x4 decv;
#pragma unroll
                for (int j = 0; j < 4; ++j) { const float ex = __expf(l0[j] - l1[j]); const float lb = __builtin_amdgcn_rcpf(1.0f + ex), omlb = ex * lb; float bprod = 1.0f;
#pragma unroll
                    for (int m = 0; m < 4; ++m) {
                        const float qv = acc[ai][0][m][n][j] * rs[m], z = acc[ai][1][m][n][j] * rs[m];
                        const float sg = __builtin_amdgcn_rcpf(1.0f + __builtin_amdgcn_exp2f(-1.44269504089f * z));
                        const float f = lb + omlb * sg, k = omlb * (1.0f - sg);
                        float s = f; s = dpp_shr_mul(s, 1); s = dpp_shr_mul(s, 2); s = dpp_shr_mul(s, 4); s = dpp_shr_mul(s, 8);
                        const float E = bprod * s;
                        if (m < 3) bprod *= lane_get(s, fq * 16 + 15);
                        const float Ei = __builtin_amdgcn_rcpf(fmaxf(E, 7.9e-31f));
                        acc[ai][0][m][n][j] = qv * E; acc[ai][1][m][n][j] = k * Ei;
                        if (m == 3) decv[j] = E;
                    } }
                if (fr == 15) *(f32x4*)((char*)DEC + ((unsigned)(u.pm * 4 + ai * 2 + wr) * DI + cc + 4 * n) * 4u) = decv;
            }
#pragma unroll
            for (int m = 0; m < 4; ++m) { const unsigned ob = qofs + (unsigned)((ai * HALF + m * 16) * DI) * 2u;
                u32x4 w; w.x = pkbf(acc[ai][0][m][0][0], acc[ai][0][m][0][1]); w.y = pkbf(acc[ai][0][m][0][2], acc[ai][0][m][0][3]); w.z = pkbf(acc[ai][0][m][1][0], acc[ai][0][m][1][1]); w.w = pkbf(acc[ai][0][m][1][2], acc[ai][0][m][1][3]);
                __builtin_nontemporal_store(w, (u32x4*)((char*)Qt + ob));
                u32x4 x; x.x = pkbf(acc[ai][1][m][0][0], acc[ai][1][m][0][1]); x.y = pkbf(acc[ai][1][m][0][2], acc[ai][1][m][0][3]); x.z = pkbf(acc[ai][1][m][1][0], acc[ai][1][m][1][1]); x.w = pkbf(acc[ai][1][m][1][2], acc[ai][1][m][1][3]);
                __builtin_nontemporal_store(x, (u32x4*)((char*)Kt + ob)); }
            asm volatile("" ::: "memory");
        }
    }
};
struct EpiP5b {
    static constexpr bool PERM = true, AFTER_DRAIN = false;
    __device__ __forceinline__ void init_acc(f32x4 (&acc)[2][2][4][2], const Unit&, int, int, int, int) const { zero_acc(acc); }
    bf16_t* O; const float* part; const float* ss;
    __device__ __forceinline__ void prologue(const StaticOrder& S, LAS unsigned char* lds, int tid) const {
        LAS float* T = (LAS float*)(lds + TAB_OFF); Unit u;
        for (int i = 0; i < 4 && S.next(i, u); ++i) {
            if (tid < 256) T[i * 768 + tid] = row_rstd_b(part, (unsigned)(u.pm * BM + tid) * 64u);
            { const int r = tid >> 1, hh = tid & 1; const f32x4* sp = (const f32x4*)(ss + (size_t)(u.pm * BM + r) * 128 + (u.pn * 2 + hh) * 8); const f32x4 s0 = sp[0], s1 = sp[1];
              T[i * 768 + 256 + tid] = __builtin_amdgcn_rsqf((((s0[0] + s0[1]) + (s0[2] + s0[3])) + ((s1[0] + s1[1]) + (s1[2] + s1[3]))) * (1.0f / HD) + EPS); }
        }
        __syncthreads();
    }
    __device__ __forceinline__ void operator()(f32x4 (&acc)[2][2][4][2], const Unit& u, int wr, int wc, int fr, int fq, LAS unsigned char* lds, int ui) const {
        const unsigned row0 = (unsigned)(u.pm * BM + wr * 64 + fr), col0 = (unsigned)(u.pn * BM + wc * 32 + 8 * fq);
        const LAS float* T = (const LAS float*)(lds + TAB_OFF) + ui * 768 + wr * 64 + fr;
        const unsigned oofs = (row0 * DI + col0) * 2u;
#pragma unroll
        for (int ai = 0; ai < 2; ++ai) {
            u32x4 ov[4][2];
#pragma unroll
            for (int m = 0; m < 4; ++m)
#pragma unroll
                for (int bj = 0; bj < 2; ++bj) ov[m][bj] = *(const u32x4*)((const char*)O + (oofs + (unsigned)((ai * HALF + m * 16) * DI + bj * HALF) * 2u));
#pragma unroll
            for (int m = 0; m < 4; ++m) { const int rl = ai * HALF + m * 16; const float rs = T[rl];
#pragma unroll
                for (int bj = 0; bj < 2; ++bj) { const f32x4 v0 = acc[ai][bj][m][0] * rs, v1 = acc[ai][bj][m][1] * rs;
                    const float rh = T[256 + 2 * rl + bj + (wr * 64 + fr)];
                    const u32x4 s = ov[m][bj];
                    u32x4 w; w.x = pkbf(bf_lo(s.x) * rh * silu_f(v0[0]), bf_hi(s.x) * rh * silu_f(v0[1])); w.y = pkbf(bf_lo(s.y) * rh * silu_f(v0[2]), bf_hi(s.y) * rh * silu_f(v0[3]));
                    w.z = pkbf(bf_lo(s.z) * rh * silu_f(v1[0]), bf_hi(s.z) * rh * silu_f(v1[1])); w.w = pkbf(bf_lo(s.w) * rh * silu_f(v1[2]), bf_hi(s.w) * rh * silu_f(v1[3]));
                    *(u32x4*)((char*)O + (oofs + (unsigned)((ai * HALF + m * 16) * DI + bj * HALF) * 2u)) = w; } }
            asm volatile("" ::: "memory"); }
    }
};
struct EpiFinal {
    static constexpr bool PERM = true, AFTER_DRAIN = false;
    __device__ __forceinline__ void init_acc(f32x4 (&acc)[2][2][4][2], const Unit&, int, int, int, int) const { zero_acc(acc); }
    const bf16_t* HB; float* H; const float* fg; float* X; unsigned* cnt;
    __device__ __forceinline__ void prologue(const StaticOrder&, LAS unsigned char*, int) const {}
    __device__ __forceinline__ void operator()(f32x4 (&acc)[2][2][4][2], const Unit& u, int wr, int wc, int fr, int fq, LAS unsigned char* lds, int ui) const {
        LAS float* Pt = (LAS float*)(lds + TAB_OFF);
        LAS float* St = Pt + 1024;
        const int tid = (wr * 4 + wc) * 64 + fq * 16 + fr;
        const unsigned row0 = (unsigned)(u.pm * BM + wr * 64 + fr), col0 = (unsigned)(u.pn * BM + wc * 32 + 8 * fq);
        const unsigned ofs = (row0 * DM + col0) * 4u;
#pragma unroll
        for (int ai = 0; ai < 2; ++ai) {
            u32x4 hv[4][2];
#pragma unroll
            for (int m = 0; m < 4; ++m)
#pragma unroll
                for (int bj = 0; bj < 2; ++bj) hv[m][bj] = *(const u32x4*)((const char*)HB + ((ofs + (unsigned)((ai * HALF + m * 16) * DM + bj * HALF) * 4u) >> 1));
#pragma unroll
            for (int m = 0; m < 4; ++m) { float ss = 0.f;
#pragma unroll
                for (int bj = 0; bj < 2; ++bj) { const u32x4 hb = hv[m][bj];
                    const f32x4 h0 = acc[ai][bj][m][0] + (f32x4){bf_lo(hb.x), bf_hi(hb.x), bf_lo(hb.y), bf_hi(hb.y)}, h1 = acc[ai][bj][m][1] + (f32x4){bf_lo(hb.z), bf_hi(hb.z), bf_lo(hb.w), bf_hi(hb.w)};
                    acc[ai][bj][m][0] = h0; acc[ai][bj][m][1] = h1;
                    ss += ((h0[0] * h0[0] + h0[1] * h0[1]) + (h0[2] * h0[2] + h0[3] * h0[3])) + ((h1[0] * h1[0] + h1[1] * h1[1]) + (h1[2] * h1[2] + h1[3] * h1[3])); }
                ss += xor_get(ss, fq * 16 + fr, 16); ss += xor_get(ss, fq * 16 + fr, 32);
                if (fq == 0) Pt[(ai * HALF + wr * 64 + m * 16 + fr) * 4 + wc] = ss; }
            asm volatile("" ::: "memory"); }
        __syncthreads();
        float* xs = X + (size_t)u.pm * 1024;
        if (tid < 256) { const f32x4 p = *(const LAS f32x4*)(Pt + tid * 4);
            __hip_atomic_store(xs + u.pn * 256 + tid, (p[0] + p[1]) + (p[2] + p[3]), __ATOMIC_RELAXED, __HIP_MEMORY_SCOPE_AGENT); }
        asm volatile("s_waitcnt vmcnt(0)" ::: "memory");
        __syncthreads();
        if (tid == 0) {
            unsigned* c = cnt + 16 * u.pm;
            __hip_atomic_fetch_add(c, 1u, __ATOMIC_RELAXED, __HIP_MEMORY_SCOPE_AGENT);
            unsigned spins = 0;
            while (__hip_atomic_load(c, __ATOMIC_RELAXED, __HIP_MEMORY_SCOPE_AGENT) < 4u) { __builtin_amdgcn_s_sleep(2); if (++spins > (1u << 22)) break; }
            __builtin_amdgcn_fence(__ATOMIC_ACQUIRE, "agent");
            asm volatile("s_waitcnt vmcnt(0)" ::: "memory");
        }
        __syncthreads();
        if (tid < 256) { float s = 0.f;
#pragma unroll
            for (int t = 0; t < 4; ++t) s += __hip_atomic_load(xs + t * 256 + tid, __ATOMIC_RELAXED, __HIP_MEMORY_SCOPE_AGENT);
            St[tid] = __builtin_amdgcn_rsqf(s * (1.0f / DM) + EPS); }
        __syncthreads();
        f32x4 gv[2][2];
#pragma unroll
        for (int bj = 0; bj < 2; ++bj)
#pragma unroll
            for (int n = 0; n < 2; ++n) gv[bj][n] = *(const f32x4*)(fg + col0 + bj * HALF + n * 4);
#pragma unroll
        for (int ai = 0; ai < 2; ++ai)
#pragma unroll
            for (int m = 0; m < 4; ++m) { const float rs = St[ai * HALF + wr * 64 + m * 16 + fr];
#pragma unroll
                for (int bj = 0; bj < 2; ++bj) { const unsigned oo = ofs + (unsigned)((ai * HALF + m * 16) * DM + bj * HALF) * 4u;
                    *(f32x4*)((char*)H + oo) = acc[ai][bj][m][0] * rs * gv[bj][0]; *(f32x4*)((char*)H + oo + 16u) = acc[ai][bj][m][1] * rs * gv[bj][1]; } }
        __syncthreads();
    }
};
}

namespace scan {
#define MFMA16(a, b, c) __builtin_amdgcn_mfma_f32_16x16x32_bf16((a), (b), (c), 0, 0, 0)
__device__ __forceinline__ unsigned offb(unsigned row, unsigned ch) { return 256u * row + 16u * (ch ^ (((row & 3u) << 2) | ((row >> 2) & 3u))); }
__device__ __forceinline__ unsigned voffv(unsigned r, unsigned cp) { return 128u * r + 32u * (cp ^ (((r >> 1) & 3u) ^ (((r >> 3) & 1u) << 1))); }
__device__ __forceinline__ void tr8(unsigned a0, unsigned a1, unsigned c0, unsigned c1, bf16x8& f00, bf16x8& f01, bf16x8& f10, bf16x8& f11) {
    u32x2 r0, r1, r2, r3, r4, r5, r6, r7;
    asm volatile("ds_read_b64_tr_b16 %0, %8\n\tds_read_b64_tr_b16 %1, %9\n\tds_read_b64_tr_b16 %2, %8 offset:8192\n\tds_read_b64_tr_b16 %3, %9 offset:8192\n\t"
                 "ds_read_b64_tr_b16 %4, %10\n\tds_read_b64_tr_b16 %5, %11\n\tds_read_b64_tr_b16 %6, %10 offset:8192\n\tds_read_b64_tr_b16 %7, %11 offset:8192\n\ts_waitcnt lgkmcnt(0)"
                 : "=&v"(r0), "=&v"(r1), "=&v"(r2), "=&v"(r3), "=&v"(r4), "=&v"(r5), "=&v"(r6), "=&v"(r7) : "v"(a0), "v"(a1), "v"(c0), "v"(c1) : "memory");
    const u32x4 x00 = {r0.x, r0.y, r1.x, r1.y}, x01 = {r2.x, r2.y, r3.x, r3.y}, x10 = {r4.x, r4.y, r5.x, r5.y}, x11 = {r6.x, r6.y, r7.x, r7.y};
    f00 = __builtin_bit_cast(bf16x8, x00); f01 = __builtin_bit_cast(bf16x8, x01); f10 = __builtin_bit_cast(bf16x8, x10); f11 = __builtin_bit_cast(bf16x8, x11);
}
__device__ __forceinline__ bf16x8 pack8(const f32x4 a, const f32x4 b) { const u32x4 r = {pkbf(a[0], a[1]), pkbf(a[2], a[3]), pkbf(b[0], b[1]), pkbf(b[2], b[3])}; return __builtin_bit_cast(bf16x8, r); }
__device__ __forceinline__ u32x2 tr_issue(unsigned a) { u32x2 r; asm volatile("ds_read_b64_tr_b16 %0, %1" : "=v"(r) : "v"(a) : "memory"); return r; }
__device__ __forceinline__ bf16x8 frag2(const u32x2 lo, const u32x2 hi) { const u32x4 r = {lo.x, lo.y, hi.x, hi.y}; return __builtin_bit_cast(bf16x8, r); }
__device__ __forceinline__ u32x2 at_tile(LAS unsigned char* lds, unsigned QI, unsigned KI, int it, int j, unsigned l15, unsigned g) {
    f32x4 c = (f32x4){0.f, 0.f, 0.f, 0.f};
#pragma unroll
    for (int kd = 0; kd < 4; ++kd) { const bf16x8 qb = *(const LAS bf16x8*)(lds + QI + offb(16u * (unsigned)it + l15, 4u * kd + g)), a = *(const LAS bf16x8*)(lds + KI + offb(16u * (unsigned)j + l15, 4u * kd + g)); c = MFMA16(a, qb, c); }
    if (j == it) {
#pragma unroll
        for (int r = 0; r < 4; ++r) c[r] = (4u * g + r <= l15) ? c[r] : 0.f; }
    const u32x2 w = {pkbf(c[0], c[1]), pkbf(c[2], c[3])}; return w;
}
template <int NK>
__device__ __forceinline__ f32x4 o_part(LAS unsigned char* lds, unsigned QI, int it, const bf16x8 (&at)[NK], const bf16x8 (&vf)[2], const bf16x8 (&sfrag)[4], unsigned l15, unsigned g) {
    const unsigned trow = 16u * (unsigned)it + l15;
    f32x4 o = (f32x4){0.f, 0.f, 0.f, 0.f};
#pragma unroll
    for (int ks = 0; ks < NK; ++ks) if (2 * ks <= it) o = MFMA16(vf[ks], at[ks], o);
#pragma unroll
    for (int kd = 0; kd < 4; ++kd) {
        const u32x2 q0 = *(const LAS u32x2*)(lds + QI + offb(trow, 4u * kd + (g >> 1)) + 8u * (g & 1)), q1 = *(const LAS u32x2*)(lds + QI + offb(trow, 4u * kd + 2u + (g >> 1)) + 8u * (g & 1));
        o = MFMA16(sfrag[kd], frag2(q0, q1), o); }
    return o;
}
__device__ __forceinline__ void phase(LAS unsigned char* lds, const bf16_t* Qt, const bf16_t* Kt, bf16_t* VO, const float* DEC, float* ss8, int bid, int G, int wave) {
    int lane_ = fresh_lane_id();
    const unsigned lane = (unsigned)lane_, l15 = lane & 15u, g = lane >> 4, ql = l15 >> 2, p = lane & 3u;
    const unsigned vs = (unsigned)wave & 3u; const int th = wave >> 2, tA = th ? 1 : 0, tB = th ? 2 : 3;
    const unsigned ldsb = (unsigned)(uintptr_t)lds;
    constexpr unsigned BUFB = 40960u, DECB = 3u * BUFB, ATB = 131072u + 256u;
    unsigned qoff[2], voff_, doff;
#pragma unroll
    for (int i = 0; i < 2; ++i) { const unsigned j = 2u * (unsigned)wave + i, r = 4u * j + (lane >> 4), pc = lane & 15u, ch = pc ^ (((r & 3u) << 2) | ((r >> 2) & 3u)); qoff[i] = (r * DI + ch * 8u) * 2u; }
    { const unsigned r = 8u * (unsigned)wave + (lane >> 3), s16 = lane & 7u, ul = (s16 >> 1) ^ (((r >> 1) & 3u) ^ (((r >> 3) & 1u) << 1)); voff_ = (r * DI + (ul * 2u + (s16 & 1u)) * 8u) * 2u; }
    doff = (64u * ((unsigned)wave & 1u) + lane) * 4u;
    const int my_it = wave == 0 ? 0 : wave <= 2 ? 1 : wave <= 5 ? 2 : 3, my_j = wave == 0 ? 0 : wave <= 2 ? wave - 1 : wave <= 5 ? wave - 3 : wave - 6;
    for (int item = bid; item < BATCH * NHEAD * 2; item += G) {
        const int half = (item >> 3) & 1, pair = (item & 7) | ((item >> 4) << 3), b = pair >> 4, h = pair & 15;
        const size_t tokb = (size_t)b * SEQ;
        const char* qg = (const char*)(Qt + tokb * DI + h * HD);
        const char* kg = (const char*)(Kt + tokb * DI + h * HD);
        bf16_t* vg = VO + tokb * DI + h * HD + half * 64;
        const char* dg = (const char*)(DEC + (size_t)(b * (SEQ / 64)) * DI + h * HD);
        f32x4 S[8]; bf16x8 sfrag[4];
#pragma unroll
        for (int i = 0; i < 8; ++i) S[i] = (f32x4){0.f, 0.f, 0.f, 0.f};
#pragma unroll
        for (int i = 0; i < 4; ++i) sfrag[i] = (bf16x8){0, 0, 0, 0, 0, 0, 0, 0};
#define SC_DMA(n_, base_) do { const size_t c_ = (size_t)(n_) * 64 * DI * 2; \
            __builtin_amdgcn_global_load_lds((const unsigned*)(qg + c_ + qoff[0]), (LAS unsigned*)(lds + (base_) + (unsigned)wave * 2048u), 16, 0, 0); \
            __builtin_amdgcn_global_load_lds((const unsigned*)(qg + c_ + qoff[1]), (LAS unsigned*)(lds + (base_) + (unsigned)wave * 2048u + 1024u), 16, 0, 0); \
            __builtin_amdgcn_global_load_lds((const unsigned*)(kg + c_ + qoff[0]), (LAS unsigned*)(lds + (base_) + 16384u + (unsigned)wave * 2048u), 16, 0, 0); \
            __builtin_amdgcn_global_load_lds((const unsigned*)(kg + c_ + qoff[1]), (LAS unsigned*)(lds + (base_) + 16384u + (unsigned)wave * 2048u + 1024u), 16, 0, 0); \
            __builtin_amdgcn_global_load_lds((const unsigned*)((const char*)vg + c_ + voff_), (LAS unsigned*)(lds + (base_) + 32768u + (unsigned)wave * 1024u), 16, 0, 0); \
            __builtin_amdgcn_global_load_lds((const unsigned*)(dg + (size_t)(n_) * DI * 4 + doff), (LAS unsigned*)(lds + DECB + ((base_) / BUFB) * 512u + ((unsigned)wave & 1u) * 256u), 4, 0, 0); } while (0)
#define SC_AT(c_, base_) do { LAS u32x2* atw = (LAS u32x2*)(lds + ATB + (unsigned)((c_) & 1) * 5120u) + lane; \
            atw[64 * wave] = at_tile(lds, (base_), (base_) + 16384u, my_it, my_j, l15, g); \
            if (wave < 2) atw[64 * (8 + wave)] = at_tile(lds, (base_), (base_) + 16384u, 3, 2 + wave, l15, g); } while (0)
        SC_DMA(0, 0u); SC_DMA(1, BUFB);
        asm volatile("s_waitcnt vmcnt(0)" ::: "memory");
        __builtin_amdgcn_s_barrier();
        SC_AT(0, 0u);
        asm volatile("s_waitcnt lgkmcnt(0)" ::: "memory");
        __builtin_amdgcn_s_barrier();
        for (int n = 0; n < SEQ / 64; ++n) {
            const unsigned bi = (unsigned)n % 3u, QI = bi * BUFB, KI = QI + 16384u, VI = QI + 32768u;
            if (n + 2 < SEQ / 64) SC_DMA(n + 2, ((unsigned)(n + 2) % 3u) * BUFB);
            u32x2 tv0, tv1, tv2, tv3, tv4, tv5, tv6, tv7;
            {
                const unsigned va = ldsb + VI + 8u * p;
                tv0 = tr_issue(va + voffv(4u * g + ql, vs)); tv1 = tr_issue(va + voffv(16u + 4u * g + ql, vs)); tv2 = tr_issue(va + voffv(32u + 4u * g + ql, vs)); tv3 = tr_issue(va + voffv(48u + 4u * g + ql, vs));
                tv4 = tr_issue(va + voffv(8u * g + ql, vs)); tv5 = tr_issue(va + voffv(8u * g + 4u + ql, vs)); tv6 = tr_issue(va + voffv(32u + 8u * g + ql, vs)); tv7 = tr_issue(va + voffv(36u + 8u * g + ql, vs));
            }
            if (n + 1 < SEQ / 64) SC_AT(n + 1, (((unsigned)(n + 1)) % 3u) * BUFB);
            bf16x8 atB[2], atA[1];
            { const LAS u32x2* atr = (const LAS u32x2*)(lds + ATB + (unsigned)(n & 1) * 5120u) + lane; const u32x2 z2 = {0u, 0u};
              if (th == 0) { atB[0] = frag2(atr[64 * 6], atr[64 * 7]); atB[1] = frag2(atr[64 * 8], atr[64 * 9]); atA[0] = frag2(atr[0], z2); }
              else         { atB[0] = frag2(atr[64 * 3], atr[64 * 4]); atB[1] = frag2(atr[64 * 5], z2);          atA[0] = frag2(atr[64 * 1], atr[64 * 2]); } }
            asm volatile("s_waitcnt lgkmcnt(0)" : "+v"(tv0), "+v"(tv1), "+v"(tv2), "+v"(tv3), "+v"(tv4), "+v"(tv5), "+v"(tv6), "+v"(tv7) :: "memory");
            __builtin_amdgcn_sched_barrier(0);
            const bf16x8 vf[2] = {frag2(tv0, tv1), frag2(tv2, tv3)};
            const f32x4 oB = o_part<2>(lds, QI, tB, atB, vf, sfrag, l15, g);
            const f32x4 oA = o_part<1>(lds, QI, tA, atA, vf, sfrag, l15, g);
            {
                const bf16x8 vn0 = frag2(tv4, tv5), vn1 = frag2(tv6, tv7);
                const LAS float* dcp = (const LAS float*)(lds + DECB + bi * 512u) + 4u * g;
                const unsigned ka = ldsb + KI + offb(8u * g + ql, (p >> 1)) + 8u * (p & 1u), kb = ldsb + KI + offb(8u * g + 4u + ql, (p >> 1)) + 8u * (p & 1u);
#pragma unroll
                for (int i = 0; i < 8; i += 2) {
                    bf16x8 k00, k01, k10, k11;
                    tr8(ka ^ ((unsigned)i << 5), kb ^ ((unsigned)i << 5), ka ^ ((unsigned)(i + 1) << 5), kb ^ ((unsigned)(i + 1) << 5), k00, k01, k10, k11);
                    S[i] = MFMA16(k00, vn0, S[i]); S[i + 1] = MFMA16(k10, vn0, S[i + 1]); S[i] = MFMA16(k01, vn1, S[i]); S[i + 1] = MFMA16(k11, vn1, S[i + 1]); }
#pragma unroll
                for (int i = 0; i < 8; ++i) { const f32x4 dc = *(const LAS f32x4*)(dcp + 16 * i); S[i] = S[i] * dc; }
#pragma unroll
                for (int kd = 0; kd < 4; ++kd) sfrag[kd] = pack8(S[2 * kd], S[2 * kd + 1]);
            }
            asm volatile("s_waitcnt vmcnt(0)" ::: "memory");
            {
                const size_t tlB = (size_t)n * 64 + 16u * (unsigned)tB + l15, tlA = (size_t)n * 64 + 16u * (unsigned)tA + l15;
                const u32x2 wB = {pkbf(oB[0], oB[1]), pkbf(oB[2], oB[3])}, wA = {pkbf(oA[0], oA[1]), pkbf(oA[2], oA[3])};
                *(u32x2*)(vg + tlB * DI + 16u * vs + 4u * g) = wB; *(u32x2*)(vg + tlA * DI + 16u * vs + 4u * g) = wA;
                float sB = (oB[0] * oB[0] + oB[1] * oB[1]) + (oB[2] * oB[2] + oB[3] * oB[3]), sA = (oA[0] * oA[0] + oA[1] * oA[1]) + (oA[2] * oA[2] + oA[3] * oA[3]);
                sB += xor_get(sB, (int)lane, 16); sA += xor_get(sA, (int)lane, 16); sB += xor_get(sB, (int)lane, 32); sA += xor_get(sA, (int)lane, 32);
                if (g == 0) { ss8[(tokb + tlB) * 128 + h * 8 + half * 4 + vs] = sB; ss8[(tokb + tlA) * 128 + h * 8 + half * 4 + vs] = sA; }
            }
            asm volatile("s_waitcnt lgkmcnt(0)" ::: "memory");
            __builtin_amdgcn_s_barrier();
        }
#undef SC_DMA
#undef SC_AT
    }
}
#undef MFMA16
}

#define XB_TMO      128
#define XB_XCNT(j)  (256  + 64 * (j))
#define XB_XSUB(j)  (1280 + 64 * (j))
#define XB_XGEN(j)  (2304 + 64 * (j))
#define XB_TOP      3328
#define XB_TOPGEN   3392
#define XCD_BAR_WORDS 3456
#define XB_SPIN_CAP (1u << 18)
__device__ __forceinline__ unsigned xb_ld(unsigned* p)              { return __hip_atomic_load(p, __ATOMIC_RELAXED, __HIP_MEMORY_SCOPE_AGENT); }
__device__ __forceinline__ unsigned xb_add(unsigned* p, unsigned v) { return __hip_atomic_fetch_add(p, v, __ATOMIC_RELAXED, __HIP_MEMORY_SCOPE_AGENT); }
__device__ __forceinline__ unsigned xb_xcc_id() { return (unsigned)__builtin_amdgcn_s_getreg((3 << 11) | 20) & 0xFu; }
#define XB_SPIN(cond, bar) do { unsigned _sp = 0; while (cond) { __builtin_amdgcn_s_sleep(1); \
    if ((++_sp & 255u) == 0u) { if (xb_ld(&(bar)[XB_TMO])) break; if (_sp > XB_SPIN_CAP) { atomicAdd(&(bar)[XB_TMO], 1u); break; } } } } while (0)
struct XcdBarrier { unsigned* bar; unsigned x; volatile LAS unsigned* st; };
__device__ __forceinline__ XcdBarrier xcd_barrier_post(unsigned* bar, volatile LAS unsigned* st) {
    XcdBarrier b; b.bar = bar; b.x = xb_xcc_id(); b.st = st;
    if (threadIdx.x == 0) (void)xb_add(&bar[XB_XCNT(b.x)], 1u);
    return b;
}
__device__ __forceinline__ void xcd_barrier_complete(unsigned* bar, unsigned x, unsigned& nloc, unsigned& nx) {
    const unsigned G = gridDim.x * gridDim.y * gridDim.z;
    unsigned sum, cnt, mine, sp = 0u;
    for (;;) {
        sum = 0u; cnt = 0u; mine = 0u;
#pragma unroll
        for (unsigned j = 0; j < 16; ++j) { const unsigned c = xb_ld(&bar[XB_XCNT(j)]); sum += c; cnt += (c > 0u) ? 1u : 0u; mine = (j == x) ? c : mine; }
        if (sum == G) break;
        __builtin_amdgcn_s_sleep(1);
        if ((++sp & 255u) == 0u) { if (xb_ld(&bar[XB_TMO])) break; if (sp > XB_SPIN_CAP) { atomicAdd(&bar[XB_TMO], 1u); break; } }
    }
    nloc = mine > 0u ? mine : 1u; nx = cnt > 0u ? cnt : 1u;
}
__device__ __forceinline__ void xcd_barrier(const XcdBarrier& b) {
    asm volatile("s_waitcnt vmcnt(0)" ::: "memory");
    __syncthreads();
    if (threadIdx.x == 0) {
        unsigned* bar = b.bar;
        __builtin_amdgcn_s_waitcnt(0);
        unsigned nloc = b.st[0], nx = b.st[1];
        if (nloc == 0u) { xcd_barrier_complete(bar, b.x, nloc, nx); b.st[0] = nloc; b.st[1] = nx; }
        const unsigned old = xb_add(&bar[XB_XSUB(b.x)], 1u);
        const unsigned gen = old / nloc;
        if (old + 1u == (gen + 1u) * nloc) {
            __builtin_amdgcn_fence(__ATOMIC_RELEASE, "agent");
            asm volatile("s_waitcnt vmcnt(0)" ::: "memory");
            const unsigned og = xb_add(&bar[XB_TOP], 1u);
            const unsigned tg = og / nx;
            if (og + 1u == (tg + 1u) * nx) xb_add(&bar[XB_TOPGEN], 1u);
            else XB_SPIN(xb_ld(&bar[XB_TOPGEN]) == tg, bar);
            __builtin_amdgcn_fence(__ATOMIC_ACQUIRE, "agent");
            xb_add(&bar[XB_XGEN(b.x)], 1u);
            asm volatile("s_waitcnt vmcnt(0)" ::: "memory");
        } else {
            XB_SPIN(xb_ld(&bar[XB_XGEN(b.x)]) == gen, bar);
            __builtin_amdgcn_fence(__ATOMIC_ACQUIRE, "agent");
            asm volatile("s_waitcnt vmcnt(0)" ::: "memory");
        }
    }
    __syncthreads();
}

struct Args {
    const float* x; const float* norm_g; const float* pool_w_in; const float* pool_w_grp; const float* pool_scale; const float* pool_w_out;
    const float* hgrn_w_in; const float* hgrn_lb; const float* hgrn_norm_g; const float* hgrn_w_out; const float* final_g;
    float* out; unsigned char* ws;
};

struct TItem { const float* W; bf16_t* WT; const float* ks; const float* ns; int K, N, row_off, item; };
__device__ __forceinline__ void titem_issue(const TItem& t, int lane, float (&wv)[32]) {
    const int nblk = t.N / 32, kb = t.item / nblk, nb = t.item % nblk, k0 = 64 * kb, n0 = 32 * nb;
    const float* wp = t.W + (size_t)(k0 + (lane >> 5)) * t.N + n0 + (lane & 31);
#pragma unroll
    for (int i = 0; i < 32; ++i) wv[i] = __builtin_nontemporal_load(wp + (size_t)(2 * i) * t.N);
}
__device__ __forceinline__ void titem_finish(const TItem& t, int lane, const float (&wv)[32], LAS float* scr) {
    const int nblk = t.N / 32, kb = t.item / nblk, nb = t.item % nblk, k0 = 64 * kb, n0 = 32 * nb;
    const float nsv = t.ns ? t.ns[n0 + (lane & 31)] : 1.0f;
    const float ksv = t.ks ? t.ks[k0 + lane] : 1.0f;
#pragma unroll
    for (int i = 0; i < 32; ++i) { const int kk = 2 * i + (lane >> 5); scr[kk * 33 + (lane & 31)] = wv[i] * nsv * lane_get(ksv, kk); }
    asm volatile("s_waitcnt lgkmcnt(0)" ::: "memory");
    const int c = lane & 7;
#pragma unroll
    for (int j = 0; j < 4; ++j) { const int n = (lane >> 3) + 8 * j; const LAS float* s = scr + (8 * c) * 33 + n;
        u32x4 o; o.x = pkbf(s[0 * 33], s[1 * 33]); o.y = pkbf(s[2 * 33], s[3 * 33]); o.z = pkbf(s[4 * 33], s[5 * 33]); o.w = pkbf(s[6 * 33], s[7 * 33]);
        *(u32x4*)(t.WT + (size_t)(t.row_off + n0 + n) * t.K + k0 + 8 * c) = o; }
    asm volatile("s_waitcnt lgkmcnt(0)" ::: "memory");
}

__global__ void __launch_bounds__(512, 2) fwd_kernel(Args a) {
    extern __shared__ __attribute__((aligned(16))) unsigned char lds_raw[];
    LAS unsigned char* lds = (LAS unsigned char*)lds_raw;
    volatile LAS unsigned* xst = (volatile LAS unsigned*)(lds + 131072 + 64);
    if (threadIdx.x < 2) xst[threadIdx.x] = 0u;
    __syncthreads();
    const XcdBarrier xbar = xcd_barrier_post((unsigned*)a.ws, xst);
#define GRID_BAR() xcd_barrier(xbar)
    const int G = gridDim.x, bid = blockIdx.x;
    const int NGW = G * 8;
    const int wave = __builtin_amdgcn_readfirstlane((int)threadIdx.x >> 6);
#define PHASE_IDS int lane_ = fresh_lane_id(); const int lane = lane_, tid = wave * 64 + lane, gw = bid * 8 + wave; (void)gw; (void)tid;
    unsigned char* ws = a.ws;
    bf16_t* Wt_in0 = (bf16_t*)(ws + WS_WIN0); bf16_t* Wt_grp = (bf16_t*)(ws + WS_WGRP); bf16_t* Wt_out0 = (bf16_t*)(ws + WS_WOUT0);
    bf16_t* Wt_in1 = (bf16_t*)(ws + WS_WIN1); bf16_t* Wt_out1 = (bf16_t*)(ws + WS_WOUT1);
    float* part1 = (float*)(ws + WS_PART1); float* ssb = (float*)(ws + WS_SS); float* decb = (float*)(ws + WS_DEC);
    bf16_t* XB = (bf16_t*)(ws + WS_XB); bf16_t* BA = (bf16_t*)(ws + WS_A); bf16_t* BB = (bf16_t*)(ws + WS_B); bf16_t* BC = (bf16_t*)(ws + WS_C);

    {
        PHASE_IDS
        LAS float* scr = (LAS float*)(lds + wave * 16384);
        constexpr int I_IN0 = (DM / 64) * (4096 / 32), I_GRP1 = (512 / 64) * (512 / 32), I_OUT = (DI / 64) * (DM / 32), I_IN1 = (DM / 64) * (8192 / 32);
        constexpr int NITEMS = I_IN0 + 4 * I_GRP1 + I_OUT + I_IN1 + I_OUT;
        auto decode = [&](int it) -> TItem {
            int r = it;
            if (r < I_IN0) return TItem{a.pool_w_in, Wt_in0, a.norm_g, nullptr, DM, 4096, 0, r}; r -= I_IN0;
            if (r < 4 * I_GRP1) { const int g = r / I_GRP1; return TItem{a.pool_w_grp + (size_t)g * 512 * 512, Wt_grp, nullptr, a.pool_scale + g * 512, 512, 512, g * 512, r % I_GRP1}; } r -= 4 * I_GRP1;
            if (r < I_OUT) return TItem{a.pool_w_out, Wt_out0, nullptr, nullptr, DI, DM, 0, r}; r -= I_OUT;
            if (r < I_IN1) {
                const int n0 = 32 * (r % (8192 / 32)); int d0 = n0;
                if (n0 < 2048) d0 = 256 * (n0 >> 7) + (n0 & 127); else if (n0 < 4096) d0 = 256 * ((n0 - 2048) >> 7) + 128 + (n0 & 127);
                return TItem{a.hgrn_w_in, Wt_in1, a.norm_g + DM, nullptr, DM, 8192, d0 - n0, r}; } r -= I_IN1;
            return TItem{a.hgrn_w_out, Wt_out1, a.hgrn_norm_g, nullptr, DI, DM, 0, r};
        };
        {
            float wa[32], wb[32]; TItem ia{}, ib{};
            int it = gw; bool ha = it < NITEMS;
            if (ha) { ia = decode(it); titem_issue(ia, lane, wa); }
            while (ha) {
                const int itb = it + NGW; const bool hb = itb < NITEMS;
                if (hb) { ib = decode(itb); titem_issue(ib, lane, wb); }
                titem_finish(ia, lane, wa, scr);
                it = itb + NGW; ha = it < NITEMS;
                if (ha) { ia = decode(it); titem_issue(ia, lane, wa); }
                if (!hb) break;
                titem_finish(ib, lane, wb, scr);
            }
        }
        for (int m0 = gw * 8; m0 < M; m0 += NGW * 8) {
            f32x4 v[8][4]; float s[8];
#pragma unroll
            for (int r = 0; r < 8; ++r) { const f32x4* xr = (const f32x4*)(a.x + (size_t)(m0 + r) * DM) + lane;
#pragma unroll
                for (int j = 0; j < 4; ++j) v[r][j] = __builtin_nontemporal_load(xr + 64 * j); }
#pragma unroll
            for (int r = 0; r < 8; ++r) { s[r] = 0.f;
#pragma unroll
                for (int j = 0; j < 4; ++j) s[r] += (v[r][j][0] * v[r][j][0] + v[r][j][1] * v[r][j][1]) + (v[r][j][2] * v[r][j][2] + v[r][j][3] * v[r][j][3]); }
#pragma unroll
            for (int o = 1; o < 64; o <<= 1) {
#pragma unroll
                for (int r = 0; r < 8; ++r) s[r] += xor_get(s[r], lane, o); }
#pragma unroll
            for (int r = 0; r < 8; ++r) { const float rstd = 1.0f / sqrtf(s[r] * (1.0f / DM) + EPS);
                unsigned long long* o8 = (unsigned long long*)(XB + (size_t)(m0 + r) * DM) + lane;
#pragma unroll
                for (int j = 0; j < 4; ++j) o8[64 * j] = (unsigned long long)pkbf(v[r][j][0] * rstd, v[r][j][1] * rstd) | ((unsigned long long)pkbf(v[r][j][2] * rstd, v[r][j][3] * rstd) << 32); }
        }
    }
    GRID_BAR();

    {
        pg8::Gemm g{XB, Wt_in0, DM, DM, DM, 0}; pg8::StaticOrder S; S.init(M, 4096, G, bid);
        pg8::EpiP1 E{BA, BB};
        pg8::gemm_phase<pg8::EpiP1>(lds, g, S, E, wave);
    }
    GRID_BAR();

    {
        PHASE_IDS
        constexpr int RUN = 64;
        const int nruns = (M / RUN) * (DI / 8);
        for (int idx = bid * 512 + tid; idx < nruns; idx += G * 512) {
            const int cgp = idx & 255, run = idx >> 8, grp = cgp >> 6, w = 2 << grp;
            const int m0 = run * RUN, t0 = m0 & (SEQ - 1);
            const bf16_t* vp = BA + (size_t)m0 * DI + cgp * 8; bf16_t* pp = BC + (size_t)m0 * DI + cgp * 8;
            float sum[8];
#pragma unroll
            for (int j = 0; j < 8; ++j) sum[j] = 0.f;
            if (t0 > 0) for (int k = 1; k < w; ++k) { const u32x4 vv = *(const u32x4*)(vp - (size_t)k * DI);
                sum[0] += bf_lo(vv.x); sum[1] += bf_hi(vv.x); sum[2] += bf_lo(vv.y); sum[3] += bf_hi(vv.y); sum[4] += bf_lo(vv.z); sum[5] += bf_hi(vv.z); sum[6] += bf_lo(vv.w); sum[7] += bf_hi(vv.w); }
            for (int i0 = 0; i0 < RUN; i0 += 8) {
                u32x4 vin[8], vout[8];
#pragma unroll
                for (int j = 0; j < 8; ++j) vin[j] = *(const u32x4*)(vp + (size_t)(i0 + j) * DI);
#pragma unroll
                for (int j = 0; j < 8; ++j) { const int i = i0 + j; vout[j] = (t0 + i + 1 >= w) ? *(const u32x4*)(vp + (size_t)(i + 1 - w) * DI) : (u32x4){0u, 0u, 0u, 0u}; }
#pragma unroll
                for (int j = 0; j < 8; ++j) {
                    const int i = i0 + j, t = t0 + i;
                    const u32x4 vv = vin[j];
                    float x[8] = {bf_lo(vv.x), bf_hi(vv.x), bf_lo(vv.y), bf_hi(vv.y), bf_lo(vv.z), bf_hi(vv.z), bf_lo(vv.w), bf_hi(vv.w)};
#pragma unroll
                    for (int c = 0; c < 8; ++c) sum[c] += x[c];
                    const int cnt = (t + 1) < w ? (t + 1) : w; const float inv = 1.0f / (float)cnt;
                    u32x4 o; o.x = pkbf(sum[0] * inv - x[0], sum[1] * inv - x[1]); o.y = pkbf(sum[2] * inv - x[2], sum[3] * inv - x[3]);
                    o.z = pkbf(sum[4] * inv - x[4], sum[5] * inv - x[5]); o.w = pkbf(sum[6] * inv - x[6], sum[7] * inv - x[7]);
                    *(u32x4*)(pp + (size_t)i * DI) = o;
                    const u32x4 uu = vout[j];
                    sum[0] -= bf_lo(uu.x); sum[1] -= bf_hi(uu.x); sum[2] -= bf_lo(uu.y); sum[3] -= bf_hi(uu.y); sum[4] -= bf_lo(uu.z); sum[5] -= bf_hi(uu.z); sum[6] -= bf_lo(uu.w); sum[7] -= bf_hi(uu.w);
                }
            }
        }
    }
    GRID_BAR();

    {
        pg8::Gemm g{BC, Wt_grp, DI, 512, 512, 2}; pg8::StaticOrder S; S.init(M, DI, G, bid);
        pg8::EpiP2 E{BB};
        pg8::gemm_phase<pg8::EpiP2>(lds, g, S, E, wave);
    }
    GRID_BAR();

    {
        pg8::Gemm g{BB, Wt_out0, DI, DI, DI, 0}; pg8::StaticOrder S; S.init(M, DM, G, bid);
        pg8::EpiRes<true, false> E{a.x, nullptr, XB, part1};
        pg8::gemm_phase<pg8::EpiRes<true, false>>(lds, g, S, E, wave);
    }
    GRID_BAR();

    {
        pg8::Gemm g{XB, Wt_in1, DM, DM, DM, 0}; pg8::StaticOrder S; S.init(M, 6144, G, bid);
        pg8::EpiP4 E{BA, BB, BC, decb, part1, a.hgrn_lb};
        pg8::gemm_phase<pg8::EpiP4>(lds, g, S, E, wave);
    }
    GRID_BAR();

    scan::phase(lds, BA, BB, BC, decb, ssb, bid, G, wave);
    GRID_BAR();

    {
        pg8::Gemm g{XB, Wt_in1 + (size_t)6144 * DM, DM, DM, DM, 0}; pg8::StaticOrder S; S.init(M, DI, G, bid);
        pg8::EpiP5b E{BC, part1, ssb};
        pg8::gemm_phase<pg8::EpiP5b>(lds, g, S, E, wave);
    }
    GRID_BAR();

    {
        pg8::Gemm g{BC, Wt_out1, DI, DI, DI, 0}; pg8::StaticOrder S; S.init(M, DM, G, bid);
        pg8::EpiFinal E{XB, a.out, a.final_g, (float*)(ws + WS_X), (unsigned*)(ws + WS_CNT)};
        pg8::gemm_phase<pg8::EpiFinal>(lds, g, S, E, wave);
    }
}

extern "C" void kernel_launch(void* const* d_in, const int* in_sizes, int n_in, void* d_out, int out_size, void* d_ws, size_t ws_size, hipStream_t stream) {
    static int grid = 0;
    if (grid == 0) {
        if (n_in != 11 || in_sizes[0] != M * DM || out_size != M * DM || ws_size < WS_END) { fprintf(stderr, "kernel_launch: unexpected shapes (n_in %d in0 %d out %d ws %zu)\n", n_in, n_in > 0 ? in_sizes[0] : -1, out_size, ws_size); grid = -1; return; }
        int dev = 0, cus = 0, per = 0;
        if (hipGetDevice(&dev) != hipSuccess || hipDeviceGetAttribute(&cus, hipDeviceAttributeMultiprocessorCount, dev) != hipSuccess) { grid = -1; return; }
        if (hipFuncSetAttribute((const void*)fwd_kernel, hipFuncAttributeMaxDynamicSharedMemorySize, LDS_BYTES) != hipSuccess) { fprintf(stderr, "kernel_launch: hipFuncSetAttribute failed\n"); grid = -1; return; }
        if (hipOccupancyMaxActiveBlocksPerMultiprocessor(&per, (const void*)fwd_kernel, 512, LDS_BYTES) != hipSuccess || per < 1) { fprintf(stderr, "kernel_launch: occupancy query says %d\n", per); (void)hipGetLastError(); grid = -1; return; }
        grid = cus;
        fprintf(stderr, "kernel_launch: cus %d per_cu %d grid %d\n", cus, per, grid);
    }
    if (grid < 0) return;
    if (hipMemsetAsync(d_ws, 0, 32768, stream) != hipSuccess) { fprintf(stderr, "kernel_launch: hipMemsetAsync failed\n"); return; }
    Args a{};
    a.x = (const float*)d_in[0]; a.norm_g = (const float*)d_in[1]; a.pool_w_in = (const float*)d_in[2]; a.pool_w_grp = (const float*)d_in[3];
    a.pool_scale = (const float*)d_in[4]; a.pool_w_out = (const float*)d_in[5]; a.hgrn_w_in = (const float*)d_in[6]; a.hgrn_lb = (const float*)d_in[7];
    a.hgrn_norm_g = (const float*)d_in[8]; a.hgrn_w_out = (const float*)d_in[9]; a.final_g = (const float*)d_in[10];
    a.out = (float*)d_out; a.ws = (unsigned char*)d_ws;
    void* args[] = {&a};
    hipError_t e = hipLaunchCooperativeKernel((void*)fwd_kernel, dim3(grid), dim3(512), args, LDS_BYTES, stream);
    if (e != hipSuccess) fprintf(stderr, "kernel_launch: cooperative launch failed: %s (grid %d)\n", hipGetErrorString(e), grid);
}
```

```cpp
#include <hip/hip_runtime.h>
#include <cstdio>
#include <cstdint>

#define LAS __attribute__((address_space(3)))
typedef unsigned short bf16_t;
typedef short bf16x8 __attribute__((ext_vector_type(8)));
typedef float f32x4 __attribute__((ext_vector_type(4)));
typedef float f32x2 __attribute__((ext_vector_type(2)));
typedef unsigned u32x4 __attribute__((ext_vector_type(4)));
typedef unsigned u32x2 __attribute__((ext_vector_type(2)));

constexpr int DM = 1024, BATCH = 8, SEQ = 4096, DI = 2048, M = BATCH * SEQ;
constexpr int NHEAD = 16, HD = 128;
constexpr float EPS = 1e-6f;
constexpr size_t MiB = 1u << 20;
constexpr size_t WS_WIN0 = 2 * MiB;
constexpr size_t WS_WGRP = 10 * MiB;
constexpr size_t WS_WOUT0 = 12 * MiB;
constexpr size_t WS_WIN1 = 16 * MiB;
constexpr size_t WS_WOUT1 = 32 * MiB;
constexpr size_t WS_PART1 = 36 * MiB;
constexpr size_t WS_CNT = 16384;
constexpr size_t WS_X = 40 * MiB;
constexpr size_t WS_DEC = 44 * MiB;
constexpr size_t WS_SS = 112 * MiB;
constexpr size_t WS_XB = 48 * MiB;
constexpr size_t WS_A = 128 * MiB;
constexpr size_t WS_B = 256 * MiB;
constexpr size_t WS_C = 384 * MiB;
constexpr size_t WS_END = 512 * MiB;
constexpr int LDS_BYTES = 147456;

typedef __bf16 bf2_t __attribute__((ext_vector_type(2)));
__device__ __forceinline__ unsigned pkbf(float lo, float hi) { f32x2 v = {lo, hi}; return __builtin_bit_cast(unsigned, __builtin_convertvector(v, bf2_t)); }
__device__ __forceinline__ float bf_lo(unsigned w) { return __builtin_bit_cast(float, w << 16); }
__device__ __forceinline__ float bf_hi(unsigned w) { return __builtin_bit_cast(float, w & 0xffff0000u); }
__device__ __forceinline__ float silu_f(float x) { return x * __builtin_amdgcn_rcpf(1.0f + __builtin_amdgcn_exp2f(-1.44269504089f * x)); }
__device__ __forceinline__ int fresh_lane_id() { int l; asm volatile("v_mbcnt_lo_u32_b32 %0, -1, 0\n\tv_mbcnt_hi_u32_b32 %0, -1, %0" : "=v"(l)); return l; }
__device__ __forceinline__ float lane_get(float v, int src_lane) { return __builtin_bit_cast(float, __builtin_amdgcn_ds_bpermute(src_lane << 2, __builtin_bit_cast(int, v))); }
__device__ __forceinline__ float xor_get(float v, int lane, int m) { return lane_get(v, lane ^ m); }
__device__ __forceinline__ float wave_sum(float v, int lane) {
#pragma unroll
    for (int o = 1; o < 64; o <<= 1) v += xor_get(v, lane, o);
    return v;
}

namespace pg8 {
constexpr int BM = 256, BK = 64, HALF = 128, HTB = HALF * BK * 2, NXCD = 8, WGM = 4;
__host__ __device__ __forceinline__ int lds_byte(int r, int c) { const int st = (r >> 4) * 2 + (c >> 5), rr = r & 15, cc = c & 31, ob = rr * 64 + cc * 2; return st * 1024 + (ob ^ (((ob >> 9) & 1) << 5)); }
__host__ __device__ __forceinline__ void stage_rc(int b, int& R, int& C) { const int st = b / 1024, sb = b % 1024, swz = sb ^ (((sb >> 9) & 1) << 5); R = (st >> 1) * 16 + swz / 64; C = (st & 1) * 32 + (swz % 64) / 2; }
__host__ __device__ __forceinline__ int perm32(int rho) { const int n = rho >> 4, i = rho & 15; return 8 * (i >> 2) + 4 * n + (i & 3); }

struct Unit { int pm, pn; };
struct Gemm { const bf16_t* A; const bf16_t* Bt; int lda, ldb, K, grp_tiles; };

struct StaticOrder {
    int nM, nN, nwg, G, c;
    __host__ __device__ void init(int M_, int N_, int G_, int c_) { nM = M_ / BM; nN = N_ / BM; nwg = nM * nN; G = G_; c = c_; }
    __host__ __device__ bool next(int i, Unit& u) const {
        const long L = (long)i * G + c; if (L >= nwg) return false;
        int wgid = (int)L; { const int q = nwg / NXCD, r = nwg % NXCD, xcd = wgid % NXCD, off = wgid / NXCD; wgid = (xcd < r ? xcd * (q + 1) : r * (q + 1) + (xcd - r) * q) + off; }
        const int nig = WGM * nN, gid = wgid / nig, fm = gid * WGM, gsz = (nM - fm) < WGM ? (nM - fm) : WGM;
        u.pm = fm + ((wgid % nig) % gsz); u.pn = (wgid % nig) / gsz; return true;
    }
};


__device__ __forceinline__ void zero_acc(f32x4 (&acc)[2][2][4][2]) {
#pragma unroll
    for (int a = 0; a < 2; ++a)
#pragma unroll
        for (int b = 0; b < 2; ++b)
#pragma unroll
            for (int m = 0; m < 4; ++m)
#pragma unroll
                for (int n = 0; n < 2; ++n) acc[a][b][m][n] = (f32x4){0.f, 0.f, 0.f, 0.f};
}
template <class Epi, bool ALIGN_EPI = true, bool SP2 = true>
__device__ __forceinline__ void gemm_phase(LAS unsigned char* lds, const Gemm g, const StaticOrder& S, const Epi& E, const int wid) {
    int lane_ = fresh_lane_id();
    int lane = lane_, tid = wid * 64 + lane, fr = lane & 15, fq = lane >> 4; const int wr = wid >> 2, wc = wid & 3;
    const int K = g.K, nt = K / BK;
    unsigned voffA[2], voffB[2]; int aoff, boff;
#define PG8_LANE_STATE() do { _Pragma("unroll") for (int i = 0; i < 2; ++i) { int R, C; stage_rc(tid * 16 + i * 8192, R, C); const int Rb = Epi::PERM ? ((R & ~31) + perm32(R & 31)) : R; \
        voffA[i] = (unsigned)(R * g.lda + C) * 2u; voffB[i] = (unsigned)(Rb * g.ldb + C) * 2u; } \
        aoff = lds_byte(wr * 64 + fr, fq * 8); boff = lds_byte(wc * 32 + fr, fq * 8); } while (0)
    PG8_LANE_STATE();
    const size_t kstep = (size_t)(BK * 2);
    const size_t hstepA = (size_t)HALF * g.lda * 2, hstepB = (size_t)HALF * g.ldb * 2;
    const size_t tstepA = 2 * hstepA, tstepB = 2 * hstepB;
    const unsigned ldsw = (unsigned)wid * 1024u;
#define PG8_SA(b, h) (((b) * 2 + (h)) * HTB)
#define PG8_SB(b, h) ((4 + (b) * 2 + (h)) * HTB)
#define PG8_STAGE(bufoff, gbase, voff) do { _Pragma("unroll") for (int _i = 0; _i < 2; ++_i) \
        __builtin_amdgcn_global_load_lds((const unsigned*)((const char*)(gbase) + (voff)[_i]), (LAS unsigned*)(lds + (bufoff) + ldsw + _i * 8192), 16, 0, 0); } while (0)
#define PG8_LDA(dst, b, h) do { _Pragma("unroll") for (int m = 0; m < 4; ++m) _Pragma("unroll") for (int k = 0; k < 2; ++k) dst[m][k] = *(const LAS bf16x8*)(lds + PG8_SA(b, h) + aoff + m * 2048 + k * 1024); } while (0)
#define PG8_LDB(dst, b, h) do { _Pragma("unroll") for (int n = 0; n < 2; ++n) _Pragma("unroll") for (int k = 0; k < 2; ++k) dst[n][k] = *(const LAS bf16x8*)(lds + PG8_SB(b, h) + boff + n * 2048 + k * 1024); } while (0)
#define PG8_MMA(ai, bj, At, Bt) do { __builtin_amdgcn_s_setprio(1); _Pragma("unroll") for (int m = 0; m < 4; ++m) _Pragma("unroll") for (int n = 0; n < 2; ++n) _Pragma("unroll") for (int k = 0; k < 2; ++k) \
        acc[ai][bj][m][n] = __builtin_amdgcn_mfma_f32_16x16x32_bf16(Bt[n][k], At[m][k], acc[ai][bj][m][n], 0, 0, 0); __builtin_amdgcn_s_setprio(0); } while (0)
#define PG8_WAIT_V(n) asm volatile("s_waitcnt vmcnt(" #n ")" ::: "memory")
#define PG8_WAIT_L(n) asm volatile("s_waitcnt lgkmcnt(" #n ")" ::: "memory")
#define PG8_BAR __builtin_amdgcn_s_barrier()
#define PG8_SCHED __builtin_amdgcn_sched_barrier(0)
#define PG8_ABASE(u) ((const char*)g.A + (size_t)(u).pm * tstepA + (g.grp_tiles ? (size_t)((u).pn / g.grp_tiles) * (size_t)K * 2 : (size_t)0))
#define PG8_BBASE(u) ((const char*)g.Bt + (size_t)(u).pn * tstepB)
    Unit cur, nxt; int ui = 0;
    E.prologue(S, lds, tid);
    if (!S.next(0, cur)) return;
    f32x4 acc[2][2][4][2];
    E.init_acc(acc, cur, wr, wc, fr, fq);
    bf16x8 At[4][2], B0[2][2], B1[2][2];
    const char* cA = PG8_ABASE(cur); const char* cB = PG8_BBASE(cur);
    if constexpr (SP2) {
        PG8_STAGE(PG8_SB(0, 0), cB, voffB); PG8_STAGE(PG8_SB(0, 1), cB + hstepB, voffB); PG8_STAGE(PG8_SA(0, 0), cA, voffA); PG8_STAGE(PG8_SA(0, 1), cA + hstepA, voffA);
        if (wr == 1) PG8_BAR;
        PG8_WAIT_V(2); PG8_BAR;
        PG8_STAGE(PG8_SB(1, 0), cB + kstep, voffB); PG8_STAGE(PG8_SA(1, 0), cA + kstep, voffA); PG8_STAGE(PG8_SB(1, 1), cB + hstepB + kstep, voffB);
        PG8_WAIT_V(6); PG8_BAR;
    } else {
        PG8_STAGE(PG8_SB(0, 0), cB, voffB); PG8_STAGE(PG8_SA(0, 0), cA, voffA); PG8_STAGE(PG8_SB(0, 1), cB + hstepB, voffB); PG8_STAGE(PG8_SA(0, 1), cA + hstepA, voffA);
        if (wr == 1) PG8_BAR;
        PG8_WAIT_V(4); PG8_BAR;
        PG8_STAGE(PG8_SB(1, 0), cB + kstep, voffB); PG8_STAGE(PG8_SA(1, 0), cA + kstep, voffA); PG8_STAGE(PG8_SB(1, 1), cB + hstepB + kstep, voffB);
        PG8_WAIT_V(6); PG8_BAR;
    }
    for (;;) {
        const bool has_next = S.next(ui + 1, nxt);
        const char* nA = has_next ? PG8_ABASE(nxt) : cA; const char* nB = has_next ? PG8_BBASE(nxt) : cB;
        for (int t = 0; t < nt; t += 2) {
            const bool last = (t == nt - 2);
            const char* a1 = cA + (size_t)(t + 1) * kstep;
            const char* a2 = last ? nA : cA + (size_t)(t + 2) * kstep; const char* b2 = last ? nB : cB + (size_t)(t + 2) * kstep;
            const char* a3 = a2 + kstep; const char* b3 = b2 + kstep;
            if constexpr (SP2) {
            PG8_LDB(B0, 0, 0); PG8_LDB(B1, 0, 1); PG8_SCHED; PG8_LDA(At, 0, 0); PG8_STAGE(PG8_SA(1, 1), a1 + hstepA, voffA);
            PG8_WAIT_V(8); PG8_WAIT_L(0); PG8_BAR; PG8_MMA(0, 0, At, B0); PG8_MMA(0, 1, At, B1); PG8_BAR; PG8_SCHED;
            PG8_LDA(At, 0, 1); PG8_STAGE(PG8_SB(0, 0), b2, voffB); PG8_STAGE(PG8_SB(0, 1), b2 + hstepB, voffB); PG8_STAGE(PG8_SA(0, 0), a2, voffA);
            PG8_WAIT_V(8); PG8_WAIT_L(0); PG8_BAR; PG8_MMA(1, 0, At, B0); PG8_MMA(1, 1, At, B1); PG8_BAR; PG8_SCHED;
            PG8_LDB(B0, 1, 0); PG8_LDB(B1, 1, 1); PG8_SCHED; PG8_LDA(At, 1, 0); PG8_STAGE(PG8_SA(0, 1), a2 + hstepA, voffA);
            PG8_WAIT_V(8); PG8_WAIT_L(0); PG8_BAR; PG8_MMA(0, 0, At, B0); PG8_MMA(0, 1, At, B1); PG8_BAR; PG8_SCHED;
            PG8_LDA(At, 1, 1); PG8_STAGE(PG8_SB(1, 0), b3, voffB); PG8_STAGE(PG8_SB(1, 1), b3 + hstepB, voffB); PG8_STAGE(PG8_SA(1, 0), a3, voffA);
            PG8_WAIT_V(8); PG8_WAIT_L(0); PG8_BAR; PG8_MMA(1, 0, At, B0); PG8_MMA(1, 1, At, B1); PG8_BAR; PG8_SCHED;
            } else {
            PG8_LDB(B0, 0, 0); PG8_SCHED; PG8_LDA(At, 0, 0); PG8_STAGE(PG8_SA(1, 1), a1 + hstepA, voffA);
            PG8_WAIT_L(8); PG8_BAR; PG8_WAIT_L(0); PG8_MMA(0, 0, At, B0); PG8_BAR; PG8_SCHED;
            PG8_LDB(B1, 0, 1); PG8_STAGE(PG8_SB(0, 0), b2, voffB);
            PG8_BAR; PG8_WAIT_L(0); PG8_MMA(0, 1, At, B1); PG8_BAR;
            PG8_LDA(At, 0, 1); PG8_STAGE(PG8_SA(0, 0), a2, voffA);
            PG8_BAR; PG8_WAIT_L(0); PG8_MMA(1, 0, At, B0); PG8_BAR; PG8_SCHED;
            PG8_STAGE(PG8_SB(0, 1), b2 + hstepB, voffB);
            PG8_WAIT_V(6); PG8_BAR; PG8_MMA(1, 1, At, B1); PG8_BAR;
            PG8_LDB(B0, 1, 0); PG8_SCHED; PG8_LDA(At, 1, 0); PG8_STAGE(PG8_SA(0, 1), a2 + hstepA, voffA);
            PG8_WAIT_L(8); PG8_BAR; PG8_WAIT_L(0); PG8_MMA(0, 0, At, B0); PG8_BAR; PG8_SCHED;
            PG8_LDB(B1, 1, 1); PG8_STAGE(PG8_SB(1, 0), b3, voffB);
            PG8_BAR; PG8_WAIT_L(0); PG8_MMA(0, 1, At, B1); PG8_BAR;
            PG8_LDA(At, 1, 1); PG8_STAGE(PG8_SA(1, 0), a3, voffA);
            PG8_BAR; PG8_WAIT_L(0); PG8_MMA(1, 0, At, B0); PG8_BAR; PG8_SCHED;
            PG8_STAGE(PG8_SB(1, 1), b3 + hstepB, voffB);
            PG8_WAIT_V(6); PG8_BAR; PG8_MMA(1, 1, At, B1); PG8_BAR;
            }
        }
        if constexpr (ALIGN_EPI) { if (wr == 0) PG8_BAR; }
        if constexpr (!Epi::AFTER_DRAIN) E(acc, cur, wr, wc, fr, fq, lds, ui);
        if (!has_next) break;
        cur = nxt; cA = nA; cB = nB; ++ui;
        asm volatile("" : "+v"(lane)); tid = wid * 64 + lane; fr = lane & 15; fq = lane >> 4; PG8_LANE_STATE();
        E.init_acc(acc, cur, wr, wc, fr, fq);
        if constexpr (ALIGN_EPI) { if (wr == 1) PG8_BAR; }
    }
    PG8_WAIT_V(0);
    if constexpr (!ALIGN_EPI) { if (wr == 0) PG8_BAR; }
    PG8_BAR;
    if constexpr (Epi::AFTER_DRAIN) E.fused(acc, cur, wr, wc, fr, fq, lds, tid);
#undef PG8_SA
#undef PG8_SB
#undef PG8_STAGE
#undef PG8_LDA
#undef PG8_LDB
#undef PG8_MMA
#undef PG8_WAIT_V
#undef PG8_WAIT_L
#undef PG8_BAR
#undef PG8_SCHED
#undef PG8_ABASE
#undef PG8_LANE_STATE
#undef PG8_BBASE
}

struct EpiP1 {
    static constexpr bool PERM = true, AFTER_DRAIN = false;
    __device__ __forceinline__ void init_acc(f32x4 (&acc)[2][2][4][2], const Unit&, int, int, int, int) const { zero_acc(acc); }
    __device__ __forceinline__ void prologue(const StaticOrder&, LAS unsigned char*, int) const {}
    bf16_t* V; bf16_t* SG;
    __device__ __forceinline__ void operator()(f32x4 (&acc)[2][2][4][2], const Unit& u, int wr, int wc, int fr, int fq, LAS unsigned char* lds, int ui) const {
        const int row0 = u.pm * BM + wr * 64 + fr; const bool gate = u.pn >= 8;
        bf16_t* base = gate ? SG : V; const int col0 = (u.pn & 7) * BM + wc * 32 + 8 * fq;
#pragma unroll
        for (int ai = 0; ai < 2; ++ai)
#pragma unroll
            for (int m = 0; m < 4; ++m) { bf16_t* rowp = base + (size_t)(row0 + ai * HALF + m * 16) * DI + col0;
#pragma unroll
                for (int bj = 0; bj < 2; ++bj) { f32x4 v0 = acc[ai][bj][m][0], v1 = acc[ai][bj][m][1];
                    if (gate) {
#pragma unroll
                        for (int j = 0; j < 4; ++j) { v0[j] = silu_f(v0[j]); v1[j] = silu_f(v1[j]); } }
                    u32x4 w; w.x = pkbf(v0[0], v0[1]); w.y = pkbf(v0[2], v0[3]); w.z = pkbf(v1[0], v1[1]); w.w = pkbf(v1[2], v1[3]);
                    __builtin_nontemporal_store(w, (u32x4*)(rowp + bj * HALF)); } }
    }
};
struct EpiP2 {
    static constexpr bool PERM = true, AFTER_DRAIN = false;
    __device__ __forceinline__ void init_acc(f32x4 (&acc)[2][2][4][2], const Unit&, int, int, int, int) const { zero_acc(acc); }
    __device__ __forceinline__ void prologue(const StaticOrder&, LAS unsigned char*, int) const {}
    bf16_t* Z;
    __device__ __forceinline__ void operator()(f32x4 (&acc)[2][2][4][2], const Unit& u, int wr, int wc, int fr, int fq, LAS unsigned char* lds, int ui) const {
        const unsigned row0 = (unsigned)(u.pm * BM + wr * 64 + fr), col0 = (unsigned)(u.pn * BM + wc * 32 + 8 * fq);
        const unsigned zofs = (row0 * DI + col0) * 2u;
#pragma unroll
        for (int ai = 0; ai < 2; ++ai) {
            u32x4 sv[4][2];
#pragma unroll
            for (int m = 0; m < 4; ++m)
#pragma unroll
                for (int bj = 0; bj < 2; ++bj) sv[m][bj] = *(const u32x4*)((const char*)Z + (zofs + (unsigned)((ai * HALF + m * 16) * DI + bj * HALF) * 2u));
#pragma unroll
            for (int m = 0; m < 4; ++m)
#pragma unroll
                for (int bj = 0; bj < 2; ++bj) { const f32x4 v0 = acc[ai][bj][m][0], v1 = acc[ai][bj][m][1]; const u32x4 s = sv[m][bj];
                    u32x4 w; w.x = pkbf(v0[0] * bf_lo(s.x), v0[1] * bf_hi(s.x)); w.y = pkbf(v0[2] * bf_lo(s.y), v0[3] * bf_hi(s.y));
                    w.z = pkbf(v1[0] * bf_lo(s.z), v1[1] * bf_hi(s.z)); w.w = pkbf(v1[2] * bf_lo(s.w), v1[3] * bf_hi(s.w));
                    *(u32x4*)((char*)Z + (zofs + (unsigned)((ai * HALF + m * 16) * DI + bj * HALF) * 2u)) = w; }
            asm volatile("" ::: "memory"); }
    }
};
template <bool WRITE_HB, bool WRITE_H = true> struct EpiRes {
    static constexpr bool PERM = true, AFTER_DRAIN = false;
    __device__ __forceinline__ void prologue(const StaticOrder&, LAS unsigned char*, int) const {}
    const float* R; float* H; bf16_t* HB; float* part;
    __device__ __forceinline__ void init_acc(f32x4 (&acc)[2][2][4][2], const Unit& u, int wr, int wc, int fr, int fq) const {
        const unsigned row0 = (unsigned)(u.pm * BM + wr * 64 + fr), col0 = (unsigned)(u.pn * BM + wc * 32 + 8 * fq);
        const unsigned ofs = (row0 * DM + col0) * 4u;
#pragma unroll
        for (int ai = 0; ai < 2; ++ai)
#pragma unroll
            for (int bj = 0; bj < 2; ++bj)
#pragma unroll
                for (int m = 0; m < 4; ++m)
#pragma unroll
                    for (int n = 0; n < 2; ++n) acc[ai][bj][m][n] = __builtin_nontemporal_load((const f32x4*)((const char*)R + (ofs + (unsigned)((ai * HALF + m * 16) * DM + bj * HALF + n * 4) * 4u)));
    }
    __device__ __forceinline__ void operator()(f32x4 (&acc)[2][2][4][2], const Unit& u, int wr, int wc, int fr, int fq, LAS unsigned char* lds, int ui) const {
        const unsigned row0 = (unsigned)(u.pm * BM + wr * 64 + fr), col0 = (unsigned)(u.pn * BM + wc * 32 + 8 * fq);
        const unsigned ofs = (row0 * DM + col0) * 4u, pofs = (row0 * 16u + (unsigned)(u.pn * 4 + wc)) * 4u;
#pragma unroll
        for (int ai = 0; ai < 2; ++ai)
#pragma unroll
            for (int m = 0; m < 4; ++m) { const unsigned o = ofs + (unsigned)((ai * HALF + m * 16) * DM) * 4u; float ss = 0.f;
#pragma unroll
                for (int bj = 0; bj < 2; ++bj) { const unsigned oo = o + (unsigned)(bj * HALF) * 4u; const f32x4 h0 = acc[ai][bj][m][0], h1 = acc[ai][bj][m][1];
                    if (WRITE_H) { *(f32x4*)((char*)H + oo) = h0; *(f32x4*)((char*)H + oo + 16u) = h1; }
                    ss += ((h0[0] * h0[0] + h0[1] * h0[1]) + (h0[2] * h0[2] + h0[3] * h0[3])) + ((h1[0] * h1[0] + h1[1] * h1[1]) + (h1[2] * h1[2] + h1[3] * h1[3]));
                    if (WRITE_HB) { u32x4 w; w.x = pkbf(h0[0], h0[1]); w.y = pkbf(h0[2], h0[3]); w.z = pkbf(h1[0], h1[1]); w.w = pkbf(h1[2], h1[3]); *(u32x4*)((char*)HB + (oo >> 1)) = w; } }
                ss += xor_get(ss, fq * 16 + fr, 16); ss += xor_get(ss, fq * 16 + fr, 32);
                if (fq == 0) *(float*)((char*)part + (pofs + (unsigned)(ai * HALF + m * 16) * 64u)) = ss; }
    }
};
__device__ __forceinline__ float row_rstd_b(const float* part, unsigned bofs) {
    const f32x4* p = (const f32x4*)((const char*)part + bofs); const f32x4 a = p[0], b = p[1], c = p[2], d = p[3];
    return __builtin_amdgcn_rsqf((((a[0] + a[1]) + (a[2] + a[3])) + ((b[0] + b[1]) + (b[2] + b[3])) + ((c[0] + c[1]) + (c[2] + c[3])) + ((d[0] + d[1]) + (d[2] + d[3]))) * (1.0f / DM) + EPS);
}
__device__ __forceinline__ float dpp_shr_mul(float v, const int n) {
    const int iv = __builtin_bit_cast(int, v), one = 0x3f800000; int r;
    if (n == 1) r = __builtin_amdgcn_update_dpp(one, iv, 0x111, 0xf, 0xf, false); else if (n == 2) r = __builtin_amdgcn_update_dpp(one, iv, 0x112, 0xf, 0xf, false);
    else if (n == 4) r = __builtin_amdgcn_update_dpp(one, iv, 0x114, 0xf, 0xf, false); else r = __builtin_amdgcn_update_dpp(one, iv, 0x118, 0xf, 0xf, false);
    return v * __builtin_bit_cast(float, r);
}
constexpr unsigned TAB_OFF = 131072u + 256u;
struct EpiP4 {
    static constexpr bool PERM = true, AFTER_DRAIN = false;
    __device__ __forceinline__ void init_acc(f32x4 (&acc)[2][2][4][2], const Unit&, int, int, int, int) const { zero_acc(acc); }
    bf16_t* Qt; bf16_t* Kt; bf16_t* V; float* DEC; const float* part; const float* lbnd;
    __device__ __forceinline__ void prologue(const StaticOrder& S, LAS unsigned char* lds, int tid) const {
        LAS float* T = (LAS float*)(lds + TAB_OFF); Unit u;
        for (int i = 0; i < 12 && S.next(i, u); ++i)
            if (tid < 256) T[i * 256 + tid] = row_rstd_b(part, (unsigned)(u.pm * BM + tid) * 64u);
        __syncthreads();
    }
    __device__ __forceinline__ void operator()(f32x4 (&acc)[2][2][4][2], const Unit& u, int wr, int wc, int fr, int fq, LAS unsigned char* lds, int ui) const {
        const unsigned row0 = (unsigned)(u.pm * BM + wr * 64 + fr);
        const LAS float* T = (const LAS float*)(lds + TAB_OFF) + ui * 256 + wr * 64 + fr;
        if (u.pn >= 16) {
            const unsigned vofs = (row0 * DI + (unsigned)((u.pn - 16) * BM + wc * 32 + 8 * fq)) * 2u;
#pragma unroll
            for (int ai = 0; ai < 2; ++ai)
#pragma unroll
                for (int m = 0; m < 4; ++m) { const float rs = T[ai * HALF + m * 16];
#pragma unroll
                    for (int bj = 0; bj < 2; ++bj) { const f32x4 v0 = acc[ai][bj][m][0] * rs, v1 = acc[ai][bj][m][1] * rs;
                        u32x4 w; w.x = pkbf(v0[0], v0[1]); w.y = pkbf(v0[2], v0[3]); w.z = pkbf(v1[0], v1[1]); w.w = pkbf(v1[2], v1[3]);
                        __builtin_nontemporal_store(w, (u32x4*)((char*)V + (vofs + (unsigned)((ai * HALF + m * 16) * DI + bj * HALF) * 2u))); } }
            return;
        }
        const unsigned c0 = (unsigned)(u.pn * HD + wc * 32 + 8 * fq);
        const unsigned qofs = (row0 * DI + c0) * 2u;
#pragma unroll
        for (int ai = 0; ai < 2; ++ai) {
            float rs[4];
#pragma unroll
            for (int m = 0; m < 4; ++m) rs[m] = T[ai * HALF + m * 16];
            unsigned cc = c0; asm volatile("" : "+v"(cc));
#pragma unroll
            for (int n = 0; n < 2; ++n) {
                const f32x4 l0 = *(const f32x4*)((const char*)lbnd + (cc + 4 * n) * 4u), l1 = *(const f32x4*)((const char*)lbnd + (cc + 4 * n + DI) * 4u);
                f32x4 decv;
#pragma unroll
                for (int j = 0; j < 4; ++j) { const float ex = __expf(l0[j] - l1[j]); const float lb = __builtin_amdgcn_rcpf(1.0f + ex), omlb = ex * lb; float bprod = 1.0f;
#pragma unroll
                    for (int m = 0; m < 4; ++m) {
                        const float qv = acc[ai][0][m][n][j] * rs[m], z = acc[ai][1][m][n][j] * rs[m];
                        const float sg = __builtin_amdgcn_rcpf(1.0f + __builtin_amdgcn_exp2f(-1.44269504089f * z));
                        const float f = lb + omlb * sg, k = omlb * (1.0f - sg);
                        float s = f; s = dpp_shr_mul(s, 1); s = dpp_shr_mul(s, 2); s = dpp_shr_mul(s, 4); s = dpp_shr_mul(s, 8);
                        const float E = bprod * s;
                        if (m < 3) bprod *= lane_get(s, fq * 16 + 15);
                        const float Ei = __builtin_amdgcn_rcpf(fmaxf(E, 7.9e-31f));
                        acc[ai][0][m][n][j] = qv * E; acc[ai][1][m][n][j] = k * Ei;
                        if (m == 3) decv[j] = E;
                    } }
                if (fr == 15) *(f32x4*)((char*)DEC + ((unsigned)(u.pm * 4 + ai * 2 + wr) * DI + cc + 4 * n) * 4u) = decv;
            }
#pragma unroll
            for (int m = 0; m < 4; ++m) { const unsigned ob = qofs + (unsigned)((ai * HALF + m * 16) * DI) * 2u;
                u32x4 w; w.x = pkbf(acc[ai][0][m][0][0], acc[ai][0][m][0][1]); w.y = pkbf(acc[ai][0][m][0][2], acc[ai][0][m][0][3]); w.z = pkbf(acc[ai][0][m][1][0], acc[ai][0][m][1][1]); w.w = pkbf(acc[ai][0][m][1][2], acc[ai][0][m][1][3]);
                __builtin_nontemporal_store(w, (u32x4*)((char*)Qt + ob));
                u32x4 x; x.x = pkbf(acc[ai][1][m][0][0], acc[ai][1][m][0][1]); x.y = pkbf(acc[ai][1][m][0][2], acc[ai][1][m][0][3]); x.z = pkbf(acc[ai][1][m][1][0], acc[ai][1][m][1][1]); x.w = pkbf(acc[ai][1][m][1][2], acc[ai][1][m][1][3]);
                __builtin_nontemporal_store(x, (u32x4*)((char*)Kt + ob)); }
            asm volatile("" ::: "memory");
        }
    }
};
struct EpiP5b {
    static constexpr bool PERM = true, AFTER_DRAIN = false;
    __device__ __forceinline__ void init_acc(f32x4 (&acc)[2][2][4][2], const Unit&, int, int, int, int) const { zero_acc(acc); }
    bf16_t* O; const float* part; const float* ss;
    __device__ __forceinline__ void prologue(const StaticOrder& S, LAS unsigned char* lds, int tid) const {
        LAS float* T = (LAS float*)(lds + TAB_OFF); Unit u;
        for (int i = 0; i < 4 && S.next(i, u); ++i) {
            if (tid < 256) T[i * 768 + tid] = row_rstd_b(part, (unsigned)(u.pm * BM + tid) * 64u);
            { const int r = tid >> 1, hh = tid & 1; const f32x4* sp = (const f32x4*)(ss + (size_t)(u.pm * BM + r) * 128 + (u.pn * 2 + hh) * 8); const f32x4 s0 = sp[0], s1 = sp[1];
              T[i * 768 + 256 + tid] = __builtin_amdgcn_rsqf((((s0[0] + s0[1]) + (s0[2] + s0[3])) + ((s1[0] + s1[1]) + (s1[2] + s1[3]))) * (1.0f / HD) + EPS); }
        }
        __syncthreads();
    }
    __device__ __forceinline__ void operator()(f32x4 (&acc)[2][2][4][2], const Unit& u, int wr, int wc, int fr, int fq, LAS unsigned char* lds, int ui) const {
        const unsigned row0 = (unsigned)(u.pm * BM + wr * 64 + fr), col0 = (unsigned)(u.pn * BM + wc * 32 + 8 * fq);
        const LAS float* T = (const LAS float*)(lds + TAB_OFF) + ui * 768 + wr * 64 + fr;
        const unsigned oofs = (row0 * DI + col0) * 2u;
#pragma unroll
        for (int ai = 0; ai < 2; ++ai) {
            u32x4 ov[4][2];
#pragma unroll
            for (int m = 0; m < 4; ++m)
#pragma unroll
                for (int bj = 0; bj < 2; ++bj) ov[m][bj] = *(const u32x4*)((const char*)O + (oofs + (unsigned)((ai * HALF + m * 16) * DI + bj * HALF) * 2u));
#pragma unroll
            for (int m = 0; m < 4; ++m) { const int rl = ai * HALF + m * 16; const float rs = T[rl];
#pragma unroll
                for (int bj = 0; bj < 2; ++bj) { const f32x4 v0 = acc[ai][bj][m][0] * rs, v1 = acc[ai][bj][m][1] * rs;
                    const float rh = T[256 + 2 * rl + bj + (wr * 64 + fr)];
                    const u32x4 s = ov[m][bj];
                    u32x4 w; w.x = pkbf(bf_lo(s.x) * rh * silu_f(v0[0]), bf_hi(s.x) * rh * silu_f(v0[1])); w.y = pkbf(bf_lo(s.y) * rh * silu_f(v0[2]), bf_hi(s.y) * rh * silu_f(v0[3]));
                    w.z = pkbf(bf_lo(s.z) * rh * silu_f(v1[0]), bf_hi(s.z) * rh * silu_f(v1[1])); w.w = pkbf(bf_lo(s.w) * rh * silu_f(v1[2]), bf_hi(s.w) * rh * silu_f(v1[3]));
                    *(u32x4*)((char*)O + (oofs + (unsigned)((ai * HALF + m * 16) * DI + bj * HALF) * 2u)) = w; } }
            asm volatile("" ::: "memory"); }
    }
};
struct EpiFinal {
    static constexpr bool PERM = true, AFTER_DRAIN = false;
    __device__ __forceinline__ void init_acc(f32x4 (&acc)[2][2][4][2], const Unit&, int, int, int, int) const { zero_acc(acc); }
    const bf16_t* HB; float* H; const float* fg; float* X; unsigned* cnt;
    __device__ __forceinline__ void prologue(const StaticOrder&, LAS unsigned char*, int) const {}
    __device__ __forceinline__ void operator()(f32x4 (&acc)[2][2][4][2], const Unit& u, int wr, int wc, int fr, int fq, LAS unsigned char* lds, int ui) const {
        LAS float* Pt = (LAS float*)(lds + TAB_OFF);
        LAS float* St = Pt + 1024;
        const int tid = (wr * 4 + wc) * 64 + fq * 16 + fr;
        const unsigned row0 = (unsigned)(u.pm * BM + wr * 64 + fr), col0 = (unsigned)(u.pn * BM + wc * 32 + 8 * fq);
        const unsigned ofs = (row0 * DM + col0) * 4u;
#pragma unroll
        for (int ai = 0; ai < 2; ++ai) {
            u32x4 hv[4][2];
#pragma unroll
            for (int m = 0; m < 4; ++m)
#pragma unroll
                for (int bj = 0; bj < 2; ++bj) hv[m][bj] = *(const u32x4*)((const char*)HB + ((ofs + (unsigned)((ai * HALF + m * 16) * DM + bj * HALF) * 4u) >> 1));
#pragma unroll
            for (int m = 0; m < 4; ++m) { float ss = 0.f;
#pragma unroll
                for (int bj = 0; bj < 2; ++bj) { const u32x4 hb = hv[m][bj];
                    const f32x4 h0 = acc[ai][bj][m][0] + (f32x4){bf_lo(hb.x), bf_hi(hb.x), bf_lo(hb.y), bf_hi(hb.y)}, h1 = acc[ai][bj][m][1] + (f32x4){bf_lo(hb.z), bf_hi(hb.z), bf_lo(hb.w), bf_hi(hb.w)};
                    acc[ai][bj][m][0] = h0; acc[ai][bj][m][1] = h1;
                    ss += ((h0[0] * h0[0] + h0[1] * h0[1]) + (h0[2] * h0[2] + h0[3] * h0[3])) + ((h1[0] * h1[0] + h1[1] * h1[1]) + (h1[2] * h1[2] + h1[3] * h1[3])); }
                ss += xor_get(ss, fq * 16 + fr, 16); ss += xor_get(ss, fq * 16 + fr, 32);
                if (fq == 0) Pt[(ai * HALF + wr * 64 + m * 16 + fr) * 4 + wc] = ss; }
            asm volatile("" ::: "memory"); }
        __syncthreads();
        float* xs = X + (size_t)u.pm * 1024;
        if (tid < 256) { const f32x4 p = *(const LAS f32x4*)(Pt + tid * 4);
            __hip_atomic_store(xs + u.pn * 256 + tid, (p[0] + p[1]) + (p[2] + p[3]), __ATOMIC_RELAXED, __HIP_MEMORY_SCOPE_AGENT); }
        asm volatile("s_waitcnt vmcnt(0)" ::: "memory");
        __syncthreads();
        if (tid == 0) {
            unsigned* c = cnt + 16 * u.pm;
            __hip_atomic_fetch_add(c, 1u, __ATOMIC_RELAXED, __HIP_MEMORY_SCOPE_AGENT);
            unsigned spins = 0;
            while (__hip_atomic_load(c, __ATOMIC_RELAXED, __HIP_MEMORY_SCOPE_AGENT) < 4u) { __builtin_amdgcn_s_sleep(2); if (++spins > (1u << 22)) break; }
            __builtin_amdgcn_fence(__ATOMIC_ACQUIRE, "agent");
            asm volatile("s_waitcnt vmcnt(0)" ::: "memory");
        }
        __syncthreads();
        if (tid < 256) { float s = 0.f;
#pragma unroll
            for (int t = 0; t < 4; ++t) s += __hip_atomic_load(xs + t * 256 + tid, __ATOMIC_RELAXED, __HIP_MEMORY_SCOPE_AGENT);
            St[tid] = __builtin_amdgcn_rsqf(s * (1.0f / DM) + EPS); }
        __syncthreads();
        f32x4 gv[2][2];
#pragma unroll
        for (int bj = 0; bj < 2; ++bj)
#pragma unroll
            for (int n = 0; n < 2; ++n) gv[bj][n] = *(const f32x4*)(fg + col0 + bj * HALF + n * 4);
#pragma unroll
        for (int ai = 0; ai < 2; ++ai)
#pragma unroll
            for (int m = 0; m < 4; ++m) { const float rs = St[ai * HALF + wr * 64 + m * 16 + fr];
#pragma unroll
                for (int bj = 0; bj < 2; ++bj) { const unsigned oo = ofs + (unsigned)((ai * HALF + m * 16) * DM + bj * HALF) * 4u;
                    *(f32x4*)((char*)H + oo) = acc[ai][bj][m][0] * rs * gv[bj][0]; *(f32x4*)((char*)H + oo + 16u) = acc[ai][bj][m][1] * rs * gv[bj][1]; } }
        __syncthreads();
    }
};
}

namespace scan {
#define MFMA16(a, b, c) __builtin_amdgcn_mfma_f32_16x16x32_bf16((a), (b), (c), 0, 0, 0)
__device__ __forceinline__ unsigned offb(unsigned row, unsigned ch) { return 256u * row + 16u * (ch ^ (((row & 3u) << 2) | ((row >> 2) & 3u))); }
__device__ __forceinline__ unsigned voffv(unsigned r, unsigned cp) { return 128u * r + 32u * (cp ^ (((r >> 1) & 3u) ^ (((r >> 3) & 1u) << 1))); }
__device__ __forceinline__ void tr8(unsigned a0, unsigned a1, unsigned c0, unsigned c1, bf16x8& f00, bf16x8& f01, bf16x8& f10, bf16x8& f11) {
    u32x2 r0, r1, r2, r3, r4, r5, r6, r7;
    asm volatile("ds_read_b64_tr_b16 %0, %8\n\tds_read_b64_tr_b16 %1, %9\n\tds_read_b64_tr_b16 %2, %8 offset:8192\n\tds_read_b64_tr_b16 %3, %9 offset:8192\n\t"
                 "ds_read_b64_tr_b16 %4, %10\n\tds_read_b64_tr_b16 %5, %11\n\tds_read_b64_tr_b16 %6, %10 offset:8192\n\tds_read_b64_tr_b16 %7, %11 offset:8192\n\ts_waitcnt lgkmcnt(0)"
                 : "=&v"(r0), "=&v"(r1), "=&v"(r2), "=&v"(r3), "=&v"(r4), "=&v"(r5), "=&v"(r6), "=&v"(r7) : "v"(a0), "v"(a1), "v"(c0), "v"(c1) : "memory");
    const u32x4 x00 = {r0.x, r0.y, r1.x, r1.y}, x01 = {r2.x, r2.y, r3.x, r3.y}, x10 = {r4.x, r4.y, r5.x, r5.y}, x11 = {r6.x, r6.y, r7.x, r7.y};
    f00 = __builtin_bit_cast(bf16x8, x00); f01 = __builtin_bit_cast(bf16x8, x01); f10 = __builtin_bit_cast(bf16x8, x10); f11 = __builtin_bit_cast(bf16x8, x11);
}
__device__ __forceinline__ bf16x8 pack8(const f32x4 a, const f32x4 b) { const u32x4 r = {pkbf(a[0], a[1]), pkbf(a[2], a[3]), pkbf(b[0], b[1]), pkbf(b[2], b[3])}; return __builtin_bit_cast(bf16x8, r); }
__device__ __forceinline__ u32x2 tr_issue(unsigned a) { u32x2 r; asm volatile("ds_read_b64_tr_b16 %0, %1" : "=v"(r) : "v"(a) : "memory"); return r; }
__device__ __forceinline__ bf16x8 frag2(const u32x2 lo, const u32x2 hi) { const u32x4 r = {lo.x, lo.y, hi.x, hi.y}; return __builtin_bit_cast(bf16x8, r); }
__device__ __forceinline__ u32x2 at_tile(LAS unsigned char* lds, unsigned QI, unsigned KI, int it, int j, unsigned l15, unsigned g) {
    f32x4 c = (f32x4){0.f, 0.f, 0.f, 0.f};
#pragma unroll
    for (int kd = 0; kd < 4; ++kd) { const bf16x8 qb = *(const LAS bf16x8*)(lds + QI + offb(16u * (unsigned)it + l15, 4u * kd + g)), a = *(const LAS bf16x8*)(lds + KI + offb(16u * (unsigned)j + l15, 4u * kd + g)); c = MFMA16(a, qb, c); }
    if (j == it) {
#pragma unroll
        for (int r = 0; r < 4; ++r) c[r] = (4u * g + r <= l15) ? c[r] : 0.f; }
    const u32x2 w = {pkbf(c[0], c[1]), pkbf(c[2], c[3])}; return w;
}
template <int NK>
__device__ __forceinline__ f32x4 o_part(LAS unsigned char* lds, unsigned QI, int it, const bf16x8 (&at)[NK], const bf16x8 (&vf)[2], const bf16x8 (&sfrag)[4], unsigned l15, unsigned g) {
    const unsigned trow = 16u * (unsigned)it + l15;
    f32x4 o = (f32x4){0.f, 0.f, 0.f, 0.f};
#pragma unroll
    for (int ks = 0; ks < NK; ++ks) if (2 * ks <= it) o = MFMA16(vf[ks], at[ks], o);
#pragma unroll
    for (int kd = 0; kd < 4; ++kd) {
        const u32x2 q0 = *(const LAS u32x2*)(lds + QI + offb(trow, 4u * kd + (g >> 1)) + 8u * (g & 1)), q1 = *(const LAS u32x2*)(lds + QI + offb(trow, 4u * kd + 2u + (g >> 1)) + 8u * (g & 1));
        o = MFMA16(sfrag[kd], frag2(q0, q1), o); }
    return o;
}
__device__ __forceinline__ void phase(LAS unsigned char* lds, const bf16_t* Qt, const bf16_t* Kt, bf16_t* VO, const float* DEC, float* ss8, int bid, int G, int wave) {
    int lane_ = fresh_lane_id();
    const unsigned lane = (unsigned)lane_, l15 = lane & 15u, g = lane >> 4, ql = l15 >> 2, p = lane & 3u;
    const unsigned vs = (unsigned)wave & 3u; const int th = wave >> 2, tA = th ? 1 : 0, tB = th ? 2 : 3;
    const unsigned ldsb = (unsigned)(uintptr_t)lds;
    constexpr unsigned BUFB = 40960u, DECB = 3u * BUFB, ATB = 131072u + 256u;
    unsigned qoff[2], voff_, doff;
#pragma unroll
    for (int i = 0; i < 2; ++i) { const unsigned j = 2u * (unsigned)wave + i, r = 4u * j + (lane >> 4), pc = lane & 15u, ch = pc ^ (((r & 3u) << 2) | ((r >> 2) & 3u)); qoff[i] = (r * DI + ch * 8u) * 2u; }
    { const unsigned r = 8u * (unsigned)wave + (lane >> 3), s16 = lane & 7u, ul = (s16 >> 1) ^ (((r >> 1) & 3u) ^ (((r >> 3) & 1u) << 1)); voff_ = (r * DI + (ul * 2u + (s16 & 1u)) * 8u) * 2u; }
    doff = (64u * ((unsigned)wave & 1u) + lane) * 4u;
    const int my_it = wave == 0 ? 0 : wave <= 2 ? 1 : wave <= 5 ? 2 : 3, my_j = wave == 0 ? 0 : wave <= 2 ? wave - 1 : wave <= 5 ? wave - 3 : wave - 6;
    for (int item = bid; item < BATCH * NHEAD * 2; item += G) {
        const int half = (item >> 3) & 1, pair = (item & 7) | ((item >> 4) << 3), b = pair >> 4, h = pair & 15;
        const size_t tokb = (size_t)b * SEQ;
        const char* qg = (const char*)(Qt + tokb * DI + h * HD);
        const char* kg = (const char*)(Kt + tokb * DI + h * HD);
        bf16_t* vg = VO + tokb * DI + h * HD + half * 64;
        const char* dg = (const char*)(DEC + (size_t)(b * (SEQ / 64)) * DI + h * HD);
        f32x4 S[8]; bf16x8 sfrag[4];
#pragma unroll
        for (int i = 0; i < 8; ++i) S[i] = (f32x4){0.f, 0.f, 0.f, 0.f};
#pragma unroll
        for (int i = 0; i < 4; ++i) sfrag[i] = (bf16x8){0, 0, 0, 0, 0, 0, 0, 0};
#define SC_DMA(n_, base_) do { const size_t c_ = (size_t)(n_) * 64 * DI * 2; \
            __builtin_amdgcn_global_load_lds((const unsigned*)(qg + c_ + qoff[0]), (LAS unsigned*)(lds + (base_) + (unsigned)wave * 2048u), 16, 0, 0); \
            __builtin_amdgcn_global_load_lds((const unsigned*)(qg + c_ + qoff[1]), (LAS unsigned*)(lds + (base_) + (unsigned)wave * 2048u + 1024u), 16, 0, 0); \
            __builtin_amdgcn_global_load_lds((const unsigned*)(kg + c_ + qoff[0]), (LAS unsigned*)(lds + (base_) + 16384u + (unsigned)wave * 2048u), 16, 0, 0); \
            __builtin_amdgcn_global_load_lds((const unsigned*)(kg + c_ + qoff[1]), (LAS unsigned*)(lds + (base_) + 16384u + (unsigned)wave * 2048u + 1024u), 16, 0, 0); \
            __builtin_amdgcn_global_load_lds((const unsigned*)((const char*)vg + c_ + voff_), (LAS unsigned*)(lds + (base_) + 32768u + (unsigned)wave * 1024u), 16, 0, 0); \
            __builtin_amdgcn_global_load_lds((const unsigned*)(dg + (size_t)(n_) * DI * 4 + doff), (LAS unsigned*)(lds + DECB + ((base_) / BUFB) * 512u + ((unsigned)wave & 1u) * 256u), 4, 0, 0); } while (0)
#define SC_AT(c_, base_) do { LAS u32x2* atw = (LAS u32x2*)(lds + ATB + (unsigned)((c_) & 1) * 5120u) + lane; \
            atw[64 * wave] = at_tile(lds, (base_), (base_) + 16384u, my_it, my_j, l15, g); \
            if (wave < 2) atw[64 * (8 + wave)] = at_tile(lds, (base_), (base_) + 16384u, 3, 2 + wave, l15, g); } while (0)
        SC_DMA(0, 0u); SC_DMA(1, BUFB);
        asm volatile("s_waitcnt vmcnt(0)" ::: "memory");
        __builtin_amdgcn_s_barrier();
        SC_AT(0, 0u);
        asm volatile("s_waitcnt lgkmcnt(0)" ::: "memory");
        __builtin_amdgcn_s_barrier();
        for (int n = 0; n < SEQ / 64; ++n) {
            const unsigned bi = (unsigned)n % 3u, QI = bi * BUFB, KI = QI + 16384u, VI = QI + 32768u;
            if (n + 2 < SEQ / 64) SC_DMA(n + 2, ((unsigned)(n + 2) % 3u) * BUFB);
            u32x2 tv0, tv1, tv2, tv3, tv4, tv5, tv6, tv7;
            {
                const unsigned va = ldsb + VI + 8u * p;
                tv0 = tr_issue(va + voffv(4u * g + ql, vs)); tv1 = tr_issue(va + voffv(16u + 4u * g + ql, vs)); tv2 = tr_issue(va + voffv(32u + 4u * g + ql, vs)); tv3 = tr_issue(va + voffv(48u + 4u * g + ql, vs));
                tv4 = tr_issue(va + voffv(8u * g + ql, vs)); tv5 = tr_issue(va + voffv(8u * g + 4u + ql, vs)); tv6 = tr_issue(va + voffv(32u + 8u * g + ql, vs)); tv7 = tr_issue(va + voffv(36u + 8u * g + ql, vs));
            }
            if (n + 1 < SEQ / 64) SC_AT(n + 1, (((unsigned)(n + 1)) % 3u) * BUFB);
            bf16x8 atB[2], atA[1];
            { const LAS u32x2* atr = (const LAS u32x2*)(lds + ATB + (unsigned)(n & 1) * 5120u) + lane; const u32x2 z2 = {0u, 0u};
              if (th == 0) { atB[0] = frag2(atr[64 * 6], atr[64 * 7]); atB[1] = frag2(atr[64 * 8], atr[64 * 9]); atA[0] = frag2(atr[0], z2); }
              else         { atB[0] = frag2(atr[64 * 3], atr[64 * 4]); atB[1] = frag2(atr[64 * 5], z2);          atA[0] = frag2(atr[64 * 1], atr[64 * 2]); } }
            asm volatile("s_waitcnt lgkmcnt(0)" : "+v"(tv0), "+v"(tv1), "+v"(tv2), "+v"(tv3), "+v"(tv4), "+v"(tv5), "+v"(tv6), "+v"(tv7) :: "memory");
            __builtin_amdgcn_sched_barrier(0);
            const bf16x8 vf[2] = {frag2(tv0, tv1), frag2(tv2, tv3)};
            const f32x4 oB = o_part<2>(lds, QI, tB, atB, vf, sfrag, l15, g);
            const f32x4 oA = o_part<1>(lds, QI, tA, atA, vf, sfrag, l15, g);
            {
                const bf16x8 vn0 = frag2(tv4, tv5), vn1 = frag2(tv6, tv7);
                const LAS float* dcp = (const LAS float*)(lds + DECB + bi * 512u) + 4u * g;
                const unsigned ka = ldsb + KI + offb(8u * g + ql, (p >> 1)) + 8u * (p & 1u), kb = ldsb + KI + offb(8u * g + 4u + ql, (p >> 1)) + 8u * (p & 1u);
#pragma unroll
                for (int i = 0; i < 8; i += 2) {
                    bf16x8 k00, k01, k10, k11;
                    tr8(ka ^ ((unsigned)i << 5), kb ^ ((unsigned)i << 5), ka ^ ((unsigned)(i + 1) << 5), kb ^ ((unsigned)(i + 1) << 5), k00, k01, k10, k11);
                    S[i] = MFMA16(k00, vn0, S[i]); S[i + 1] = MFMA16(k10, vn0, S[i + 1]); S[i] = MFMA16(k01, vn1, S[i]); S[i + 1] = MFMA16(k11, vn1, S[i + 1]); }
#pragma unroll
                for (int i = 0; i < 8; ++i) { const f32x4 dc = *(const LAS f32x4*)(dcp + 16 * i); S[i] = S[i] * dc; }
#pragma unroll
                for (int kd = 0; kd < 4; ++kd) sfrag[kd] = pack8(S[2 * kd], S[2 * kd + 1]);
            }
            asm volatile("s_waitcnt vmcnt(0)" ::: "memory");
            {
                const size_t tlB = (size_t)n * 64 + 16u * (unsigned)tB + l15, tlA = (size_t)n * 64 + 16u * (unsigned)tA + l15;
                const u32x2 wB = {pkbf(oB[0], oB[1]), pkbf(oB[2], oB[3])}, wA = {pkbf(oA[0], oA[1]), pkbf(oA[2], oA[3])};
                *(u32x2*)(vg + tlB * DI + 16u * vs + 4u * g) = wB; *(u32x2*)(vg + tlA * DI + 16u * vs + 4u * g) = wA;
                float sB = (oB[0] * oB[0] + oB[1] * oB[1]) + (oB[2] * oB[2] + oB[3] * oB[3]), sA = (oA[0] * oA[0] + oA[1] * oA[1]) + (oA[2] * oA[2] + oA[3] * oA[3]);
                sB += xor_get(sB, (int)lane, 16); sA += xor_get(sA, (int)lane, 16); sB += xor_get(sB, (int)lane, 32); sA += xor_get(sA, (int)lane, 32);
                if (g == 0) { ss8[(tokb + tlB) * 128 + h * 8 + half * 4 + vs] = sB; ss8[(tokb + tlA) * 128 + h * 8 + half * 4 + vs] = sA; }
            }
            asm volatile("s_waitcnt lgkmcnt(0)" ::: "memory");
            __builtin_amdgcn_s_barrier();
        }
#undef SC_DMA
#undef SC_AT
    }
}
#undef MFMA16
}

#define XB_TMO      128
#define XB_XCNT(j)  (256  + 64 * (j))
#define XB_XSUB(j)  (1280 + 64 * (j))
#define XB_XGEN(j)  (2304 + 64 * (j))
#define XB_TOP      3328
#define XB_TOPGEN   3392
#define XCD_BAR_WORDS 3456
#define XB_SPIN_CAP (1u << 18)
__device__ __forceinline__ unsigned xb_ld(unsigned* p)              { return __hip_atomic_load(p, __ATOMIC_RELAXED, __HIP_MEMORY_SCOPE_AGENT); }
__device__ __forceinline__ unsigned xb_add(unsigned* p, unsigned v) { return __hip_atomic_fetch_add(p, v, __ATOMIC_RELAXED, __HIP_MEMORY_SCOPE_AGENT); }
__device__ __forceinline__ unsigned xb_xcc_id() { return (unsigned)__builtin_amdgcn_s_getreg((3 << 11) | 20) & 0xFu; }
#define XB_SPIN(cond, bar) do { unsigned _sp = 0; while (cond) { __builtin_amdgcn_s_sleep(1); \
    if ((++_sp & 255u) == 0u) { if (xb_ld(&(bar)[XB_TMO])) break; if (_sp > XB_SPIN_CAP) { atomicAdd(&(bar)[XB_TMO], 1u); break; } } } } while (0)
struct XcdBarrier { unsigned* bar; unsigned x; volatile LAS unsigned* st; };
__device__ __forceinline__ XcdBarrier xcd_barrier_post(unsigned* bar, volatile LAS unsigned* st) {
    XcdBarrier b; b.bar = bar; b.x = xb_xcc_id(); b.st = st;
    if (threadIdx.x == 0) (void)xb_add(&bar[XB_XCNT(b.x)], 1u);
    return b;
}
__device__ __forceinline__ void xcd_barrier_complete(unsigned* bar, unsigned x, unsigned& nloc, unsigned& nx) {
    const unsigned G = gridDim.x * gridDim.y * gridDim.z;
    unsigned sum, cnt, mine, sp = 0u;
    for (;;) {
        sum = 0u; cnt = 0u; mine = 0u;
#pragma unroll
        for (unsigned j = 0; j < 16; ++j) { const unsigned c = xb_ld(&bar[XB_XCNT(j)]); sum += c; cnt += (c > 0u) ? 1u : 0u; mine = (j == x) ? c : mine; }
        if (sum == G) break;
        __builtin_amdgcn_s_sleep(1);
        if ((++sp & 255u) == 0u) { if (xb_ld(&bar[XB_TMO])) break; if (sp > XB_SPIN_CAP) { atomicAdd(&bar[XB_TMO], 1u); break; } }
    }
    nloc = mine > 0u ? mine : 1u; nx = cnt > 0u ? cnt : 1u;
}
__device__ __forceinline__ void xcd_barrier(const XcdBarrier& b) {
    asm volatile("s_waitcnt vmcnt(0)" ::: "memory");
    __syncthreads();
    if (threadIdx.x == 0) {
        unsigned* bar = b.bar;
        __builtin_amdgcn_s_waitcnt(0);
        unsigned nloc = b.st[0], nx = b.st[1];
        if (nloc == 0u) { xcd_barrier_complete(bar, b.x, nloc, nx); b.st[0] = nloc; b.st[1] = nx; }
        const unsigned old = xb_add(&bar[XB_XSUB(b.x)], 1u);
        const unsigned gen = old / nloc;
        if (old + 1u == (gen + 1u) * nloc) {
            __builtin_amdgcn_fence(__ATOMIC_RELEASE, "agent");
            asm volatile("s_waitcnt vmcnt(0)" ::: "memory");
            const unsigned og = xb_add(&bar[XB_TOP], 1u);
            const unsigned tg = og / nx;
            if (og + 1u == (tg + 1u) * nx) xb_add(&bar[XB_TOPGEN], 1u);
            else XB_SPIN(xb_ld(&bar[XB_TOPGEN]) == tg, bar);
            __builtin_amdgcn_fence(__ATOMIC_ACQUIRE, "agent");
            xb_add(&bar[XB_XGEN(b.x)], 1u);
            asm volatile("s_waitcnt vmcnt(0)" ::: "memory");
        } else {
            XB_SPIN(xb_ld(&bar[XB_XGEN(b.x)]) == gen, bar);
            __builtin_amdgcn_fence(__ATOMIC_ACQUIRE, "agent");
            asm volatile("s_waitcnt vmcnt(0)" ::: "memory");
        }
    }
    __syncthreads();
}

struct Args {
    const float* x; const float* norm_g; const float* pool_w_in; const float* pool_w_grp; const float* pool_scale; const float* pool_w_out;
    const float* hgrn_w_in; const float* hgrn_lb; const float* hgrn_norm_g; const float* hgrn_w_out; const float* final_g;
    float* out; unsigned char* ws;
};

struct TItem { const float* W; bf16_t* WT; const float* ks; const float* ns; int K, N, row_off, item; };
__device__ __forceinline__ void titem_issue(const TItem& t, int lane, float (&wv)[32]) {
    const int nblk = t.N / 32, kb = t.item / nblk, nb = t.item % nblk, k0 = 64 * kb, n0 = 32 * nb;
    const float* wp = t.W + (size_t)(k0 + (lane >> 5)) * t.N + n0 + (lane & 31);
#pragma unroll
    for (int i = 0; i < 32; ++i) wv[i] = __builtin_nontemporal_load(wp + (size_t)(2 * i) * t.N);
}
__device__ __forceinline__ void titem_finish(const TItem& t, int lane, const float (&wv)[32], LAS float* scr) {
    const int nblk = t.N / 32, kb = t.item / nblk, nb = t.item % nblk, k0 = 64 * kb, n0 = 32 * nb;
    const float nsv = t.ns ? t.ns[n0 + (lane & 31)] : 1.0f;
    const float ksv = t.ks ? t.ks[k0 + lane] : 1.0f;
#pragma unroll
    for (int i = 0; i < 32; ++i) { const int kk = 2 * i + (lane >> 5); scr[kk * 33 + (lane & 31)] = wv[i] * nsv * lane_get(ksv, kk); }
    asm volatile("s_waitcnt lgkmcnt(0)" ::: "memory");
    const int c = lane & 7;
#pragma unroll
    for (int j = 0; j < 4; ++j) { const int n = (lane >> 3) + 8 * j; const LAS float* s = scr + (8 * c) * 33 + n;
        u32x4 o; o.x = pkbf(s[0 * 33], s[1 * 33]); o.y = pkbf(s[2 * 33], s[3 * 33]); o.z = pkbf(s[4 * 33], s[5 * 33]); o.w = pkbf(s[6 * 33], s[7 * 33]);
        *(u32x4*)(t.WT + (size_t)(t.row_off + n0 + n) * t.K + k0 + 8 * c) = o; }
    asm volatile("s_waitcnt lgkmcnt(0)" ::: "memory");
}

__global__ void __launch_bounds__(512, 2) fwd_kernel(Args a) {
    extern __shared__ __attribute__((aligned(16))) unsigned char lds_raw[];
    LAS unsigned char* lds = (LAS unsigned char*)lds_raw;
    volatile LAS unsigned* xst = (volatile LAS unsigned*)(lds + 131072 + 64);
    if (threadIdx.x < 2) xst[threadIdx.x] = 0u;
    __syncthreads();
    const XcdBarrier xbar = xcd_barrier_post((unsigned*)a.ws, xst);
#define GRID_BAR() xcd_barrier(xbar)
    const int G = gridDim.x, bid = blockIdx.x;
    const int NGW = G * 8;
    const int wave = __builtin_amdgcn_readfirstlane((int)threadIdx.x >> 6);
#define PHASE_IDS int lane_ = fresh_lane_id(); const int lane = lane_, tid = wave * 64 + lane, gw = bid * 8 + wave; (void)gw; (void)tid;
    unsigned char* ws = a.ws;
    bf16_t* Wt_in0 = (bf16_t*)(ws + WS_WIN0); bf16_t* Wt_grp = (bf16_t*)(ws + WS_WGRP); bf16_t* Wt_out0 = (bf16_t*)(ws + WS_WOUT0);
    bf16_t* Wt_in1 = (bf16_t*)(ws + WS_WIN1); bf16_t* Wt_out1 = (bf16_t*)(ws + WS_WOUT1);
    float* part1 = (float*)(ws + WS_PART1); float* ssb = (float*)(ws + WS_SS); float* decb = (float*)(ws + WS_DEC);
    bf16_t* XB = (bf16_t*)(ws + WS_XB); bf16_t* BA = (bf16_t*)(ws + WS_A); bf16_t* BB = (bf16_t*)(ws + WS_B); bf16_t* BC = (bf16_t*)(ws + WS_C);

    {
        PHASE_IDS
        LAS float* scr = (LAS float*)(lds + wave * 16384);
        constexpr int I_IN0 = (DM / 64) * (4096 / 32), I_GRP1 = (512 / 64) * (512 / 32), I_OUT = (DI / 64) * (DM / 32), I_IN1 = (DM / 64) * (8192 / 32);
        constexpr int NITEMS = I_IN0 + 4 * I_GRP1 + I_OUT + I_IN1 + I_OUT;
        auto decode = [&](int it) -> TItem {
            int r = it;
            if (r < I_IN0) return TItem{a.pool_w_in, Wt_in0, a.norm_g, nullptr, DM, 4096, 0, r}; r -= I_IN0;
            if (r < 4 * I_GRP1) { const int g = r / I_GRP1; return TItem{a.pool_w_grp + (size_t)g * 512 * 512, Wt_grp, nullptr, a.pool_scale + g * 512, 512, 512, g * 512, r % I_GRP1}; } r -= 4 * I_GRP1;
            if (r < I_OUT) return TItem{a.pool_w_out, Wt_out0, nullptr, nullptr, DI, DM, 0, r}; r -= I_OUT;
            if (r < I_IN1) {
                const int n0 = 32 * (r % (8192 / 32)); int d0 = n0;
                if (n0 < 2048) d0 = 256 * (n0 >> 7) + (n0 & 127); else if (n0 < 4096) d0 = 256 * ((n0 - 2048) >> 7) + 128 + (n0 & 127);
                return TItem{a.hgrn_w_in, Wt_in1, a.norm_g + DM, nullptr, DM, 8192, d0 - n0, r}; } r -= I_IN1;
            return TItem{a.hgrn_w_out, Wt_out1, a.hgrn_norm_g, nullptr, DI, DM, 0, r};
        };
        {
            float wa[32], wb[32]; TItem ia{}, ib{};
            int it = gw; bool ha = it < NITEMS;
            if (ha) { ia = decode(it); titem_issue(ia, lane, wa); }
            while (ha) {
                const int itb = it + NGW; const bool hb = itb < NITEMS;
                if (hb) { ib = decode(itb); titem_issue(ib, lane, wb); }
                titem_finish(ia, lane, wa, scr);
                it = itb + NGW; ha = it < NITEMS;
                if (ha) { ia = decode(it); titem_issue(ia, lane, wa); }
                if (!hb) break;
                titem_finish(ib, lane, wb, scr);
            }
        }
        for (int m0 = gw * 8; m0 < M; m0 += NGW * 8) {
            f32x4 v[8][4]; float s[8];
#pragma unroll
            for (int r = 0; r < 8; ++r) { const f32x4* xr = (const f32x4*)(a.x + (size_t)(m0 + r) * DM) + lane;
#pragma unroll
                for (int j = 0; j < 4; ++j) v[r][j] = __builtin_nontemporal_load(xr + 64 * j); }
#pragma unroll
            for (int r = 0; r < 8; ++r) { s[r] = 0.f;
#pragma unroll
                for (int j = 0; j < 4; ++j) s[r] += (v[r][j][0] * v[r][j][0] + v[r][j][1] * v[r][j][1]) + (v[r][j][2] * v[r][j][2] + v[r][j][3] * v[r][j][3]); }
#pragma unroll
            for (int o = 1; o < 64; o <<= 1) {
#pragma unroll
                for (int r = 0; r < 8; ++r) s[r] += xor_get(s[r], lane, o); }
#pragma unroll
            for (int r = 0; r < 8; ++r) { const float rstd = 1.0f / sqrtf(s[r] * (1.0f / DM) + EPS);
                unsigned long long* o8 = (unsigned long long*)(XB + (size_t)(m0 + r) * DM) + lane;
#pragma unroll
                for (int j = 0; j < 4; ++j) o8[64 * j] = (unsigned long long)pkbf(v[r][j][0] * rstd, v[r][j][1] * rstd) | ((unsigned long long)pkbf(v[r][j][2] * rstd, v[r][j][3] * rstd) << 32); }
        }
    }
    GRID_BAR();

    {
        pg8::Gemm g{XB, Wt_in0, DM, DM, DM, 0}; pg8::StaticOrder S; S.init(M, 4096, G, bid);
        pg8::EpiP1 E{BA, BB};
        pg8::gemm_phase<pg8::EpiP1>(lds, g, S, E, wave);
    }
    GRID_BAR();

    {
        PHASE_IDS
        constexpr int RUN = 64;
        const int nruns = (M / RUN) * (DI / 8);
        for (int idx = bid * 512 + tid; idx < nruns; idx += G * 512) {
            const int cgp = idx & 255, run = idx >> 8, grp = cgp >> 6, w = 2 << grp;
            const int m0 = run * RUN, t0 = m0 & (SEQ - 1);
            const bf16_t* vp = BA + (size_t)m0 * DI + cgp * 8; bf16_t* pp = BC + (size_t)m0 * DI + cgp * 8;
            float sum[8];
#pragma unroll
            for (int j = 0; j < 8; ++j) sum[j] = 0.f;
            if (t0 > 0) for (int k = 1; k < w; ++k) { const u32x4 vv = *(const u32x4*)(vp - (size_t)k * DI);
                sum[0] += bf_lo(vv.x); sum[1] += bf_hi(vv.x); sum[2] += bf_lo(vv.y); sum[3] += bf_hi(vv.y); sum[4] += bf_lo(vv.z); sum[5] += bf_hi(vv.z); sum[6] += bf_lo(vv.w); sum[7] += bf_hi(vv.w); }
            for (int i0 = 0; i0 < RUN; i0 += 8) {
                u32x4 vin[8], vout[8];
#pragma unroll
                for (int j = 0; j < 8; ++j) vin[j] = *(const u32x4*)(vp + (size_t)(i0 + j) * DI);
#pragma unroll
                for (int j = 0; j < 8; ++j) { const int i = i0 + j; vout[j] = (t0 + i + 1 >= w) ? *(const u32x4*)(vp + (size_t)(i + 1 - w) * DI) : (u32x4){0u, 0u, 0u, 0u}; }
#pragma unroll
                for (int j = 0; j < 8; ++j) {
                    const int i = i0 + j, t = t0 + i;
                    const u32x4 vv = vin[j];
                    float x[8] = {bf_lo(vv.x), bf_hi(vv.x), bf_lo(vv.y), bf_hi(vv.y), bf_lo(vv.z), bf_hi(vv.z), bf_lo(vv.w), bf_hi(vv.w)};
#pragma unroll
                    for (int c = 0; c < 8; ++c) sum[c] += x[c];
                    const int cnt = (t + 1) < w ? (t + 1) : w; const float inv = 1.0f / (float)cnt;
                    u32x4 o; o.x = pkbf(sum[0] * inv - x[0], sum[1] * inv - x[1]); o.y = pkbf(sum[2] * inv - x[2], sum[3] * inv - x[3]);
                    o.z = pkbf(sum[4] * inv - x[4], sum[5] * inv - x[5]); o.w = pkbf(sum[6] * inv - x[6], sum[7] * inv - x[7]);
                    __builtin_nontemporal_store(o, (u32x4*)(pp + (size_t)i * DI));
                    const u32x4 uu = vout[j];
                    sum[0] -= bf_lo(uu.x); sum[1] -= bf_hi(uu.x); sum[2] -= bf_lo(uu.y); sum[3] -= bf_hi(uu.y); sum[4] -= bf_lo(uu.z); sum[5] -= bf_hi(uu.z); sum[6] -= bf_lo(uu.w); sum[7] -= bf_hi(uu.w);
                }
            }
        }
    }
    GRID_BAR();

    {
        pg8::Gemm g{BC, Wt_grp, DI, 512, 512, 2}; pg8::StaticOrder S; S.init(M, DI, G, bid);
        pg8::EpiP2 E{BB};
        pg8::gemm_phase<pg8::EpiP2>(lds, g, S, E, wave);
    }
    GRID_BAR();

    {
        pg8::Gemm g{BB, Wt_out0, DI, DI, DI, 0}; pg8::StaticOrder S; S.init(M, DM, G, bid);
        pg8::EpiRes<true, false> E{a.x, nullptr, XB, part1};
        pg8::gemm_phase<pg8::EpiRes<true, false>>(lds, g, S, E, wave);
    }
    GRID_BAR();

    {
        pg8::Gemm g{XB, Wt_in1, DM, DM, DM, 0}; pg8::StaticOrder S; S.init(M, 6144, G, bid);
        pg8::EpiP4 E{BA, BB, BC, decb, part1, a.hgrn_lb};
        pg8::gemm_phase<pg8::EpiP4>(lds, g, S, E, wave);
    }
    GRID_BAR();

    scan::phase(lds, BA, BB, BC, decb, ssb, bid, G, wave);
    GRID_BAR();

    {
        pg8::Gemm g{XB, Wt_in1 + (size_t)6144 * DM, DM, DM, DM, 0}; pg8::StaticOrder S; S.init(M, DI, G, bid);
        pg8::EpiP5b E{BC, part1, ssb};
        pg8::gemm_phase<pg8::EpiP5b>(lds, g, S, E, wave);
    }
    GRID_BAR();

    {
        pg8::Gemm g{BC, Wt_out1, DI, DI, DI, 0}; pg8::StaticOrder S; S.init(M, DM, G, bid);
        pg8::EpiFinal E{XB, a.out, a.final_g, (float*)(ws + WS_X), (unsigned*)(ws + WS_CNT)};
        pg8::gemm_phase<pg8::EpiFinal>(lds, g, S, E, wave);
    }
}

extern "C" void kernel_launch(void* const* d_in, const int* in_sizes, int n_in, void* d_out, int out_size, void* d_ws, size_t ws_size, hipStream_t stream) {
    static int grid = 0;
    if (grid == 0) {
        if (n_in != 11 || in_sizes[0] != M * DM || out_size != M * DM || ws_size < WS_END) { fprintf(stderr, "kernel_launch: unexpected shapes (n_in %d in0 %d out %d ws %zu)\n", n_in, n_in > 0 ? in_sizes[0] : -1, out_size, ws_size); grid = -1; return; }
        int dev = 0, cus = 0, per = 0;
        if (hipGetDevice(&dev) != hipSuccess || hipDeviceGetAttribute(&cus, hipDeviceAttributeMultiprocessorCount, dev) != hipSuccess) { grid = -1; return; }
        if (hipFuncSetAttribute((const void*)fwd_kernel, hipFuncAttributeMaxDynamicSharedMemorySize, LDS_BYTES) != hipSuccess) { fprintf(stderr, "kernel_launch: hipFuncSetAttribute failed\n"); grid = -1; return; }
        if (hipOccupancyMaxActiveBlocksPerMultiprocessor(&per, (const void*)fwd_kernel, 512, LDS_BYTES) != hipSuccess || per < 1) { fprintf(stderr, "kernel_launch: occupancy query says %d\n", per); (void)hipGetLastError(); grid = -1; return; }
        grid = cus;
        fprintf(stderr, "kernel_launch: cus %d per_cu %d grid %d\n", cus, per, grid);
    }
    if (grid < 0) return;
    if (hipMemsetAsync(d_ws, 0, 32768, stream) != hipSuccess) { fprintf(stderr, "kernel_launch: hipMemsetAsync failed\n"); return; }
    Args a{};
    a.x = (const float*)d_in[0]; a.norm_g = (const float*)d_in[1]; a.pool_w_in = (const float*)d_in[2]; a.pool_w_grp = (const float*)d_in[3];
    a.pool_scale = (const float*)d_in[4]; a.pool_w_out = (const float*)d_in[5]; a.hgrn_w_in = (const float*)d_in[6]; a.hgrn_lb = (const float*)d_in[7];
    a.hgrn_norm_g = (const float*)d_in[8]; a.hgrn_w_out = (const float*)d_in[9]; a.final_g = (const float*)d_in[10];
    a.out = (float*)d_out; a.ws = (unsigned char*)d_ws;
    void* args[] = {&a};
    hipError_t e = hipLaunchCooperativeKernel((void*)fwd_kernel, dim3(grid), dim3(512), args, LDS_BYTES, stream);
    if (e != hipSuccess) fprintf(stderr, "kernel_launch: cooperative launch failed: %s (grid %d)\n", hipGetErrorString(e), grid);
}
```

```cpp
#include <hip/hip_runtime.h>
#include <cstdio>
#include <cstdint>

#define LAS __attribute__((address_space(3)))
typedef unsigned short bf16_t;
typedef short bf16x8 __attribute__((ext_vector_type(8)));
typedef float f32x4 __attribute__((ext_vector_type(4)));
typedef float f32x2 __attribute__((ext_vector_type(2)));
typedef unsigned u32x4 __attribute__((ext_vector_type(4)));
typedef unsigned u32x2 __attribute__((ext_vector_type(2)));

constexpr int DM = 1024, BATCH = 8, SEQ = 4096, DI = 2048, M = BATCH * SEQ;
constexpr int NHEAD = 16, HD = 128;
constexpr float EPS = 1e-6f;
constexpr size_t MiB = 1u << 20;
constexpr size_t WS_WIN0 = 2 * MiB;
constexpr size_t WS_WGRP = 10 * MiB;
constexpr size_t WS_WOUT0 = 12 * MiB;
constexpr size_t WS_WIN1 = 16 * MiB;
constexpr size_t WS_WOUT1 = 32 * MiB;
constexpr size_t WS_PART1 = 36 * MiB;
constexpr size_t WS_CNT = 16384;
constexpr size_t WS_X = 40 * MiB;
constexpr size_t WS_DEC = 44 * MiB;
constexpr size_t WS_SS = 112 * MiB;
constexpr size_t WS_XB = 48 * MiB;
constexpr size_t WS_A = 128 * MiB;
constexpr size_t WS_B = 256 * MiB;
constexpr size_t WS_C = 384 * MiB;
constexpr size_t WS_END = 512 * MiB;
constexpr int LDS_BYTES = 163840;
constexpr unsigned XST_OFF = 163840u - 256u;

typedef __bf16 bf2_t __attribute__((ext_vector_type(2)));
__device__ __forceinline__ unsigned pkbf(float lo, float hi) { f32x2 v = {lo, hi}; return __builtin_bit_cast(unsigned, __builtin_convertvector(v, bf2_t)); }
__device__ __forceinline__ float bf_lo(unsigned w) { return __builtin_bit_cast(float, w << 16); }
__device__ __forceinline__ float bf_hi(unsigned w) { return __builtin_bit_cast(float, w & 0xffff0000u); }
__device__ __forceinline__ float silu_f(float x) { return x * __builtin_amdgcn_rcpf(1.0f + __builtin_amdgcn_exp2f(-1.44269504089f * x)); }
__device__ __forceinline__ int fresh_lane_id() { int l; asm volatile("v_mbcnt_lo_u32_b32 %0, -1, 0\n\tv_mbcnt_hi_u32_b32 %0, -1, %0" : "=v"(l)); return l; }
__device__ __forceinline__ float lane_get(float v, int src_lane) { return __builtin_bit_cast(float, __builtin_amdgcn_ds_bpermute(src_lane << 2, __builtin_bit_cast(int, v))); }
__device__ __forceinline__ float xor_get(float v, int lane, int m) { return lane_get(v, lane ^ m); }
__device__ __forceinline__ float wave_sum(float v, int lane) {
#pragma unroll
    for (int o = 1; o < 64; o <<= 1) v += xor_get(v, lane, o);
    return v;
}

namespace pg8 {
constexpr int BM = 256, BK = 64, HALF = 128, HTB = HALF * BK * 2, NXCD = 8, WGM = 4;
__host__ __device__ __forceinline__ int lds_byte(int r, int c) { const int st = (r >> 4) * 2 + (c >> 5), rr = r & 15, cc = c & 31, ob = rr * 64 + cc * 2; return st * 1024 + (ob ^ (((ob >> 9) & 1) << 5)); }
__host__ __device__ __forceinline__ void stage_rc(int b, int& R, int& C) { const int st = b / 1024, sb = b % 1024, swz = sb ^ (((sb >> 9) & 1) << 5); R = (st >> 1) * 16 + swz / 64; C = (st & 1) * 32 + (swz % 64) / 2; }
__host__ __device__ __forceinline__ int perm32(int rho) { const int n = rho >> 4, i = rho & 15; return 8 * (i >> 2) + 4 * n + (i & 3); }

struct Unit { int pm, pn; };
struct Gemm { const bf16_t* A; const bf16_t* Bt; int lda, ldb, K, grp_tiles; };

struct StaticOrder {
    int nM, nN, nwg, G, c;
    __host__ __device__ void init(int M_, int N_, int G_, int c_) { nM = M_ / BM; nN = N_ / BM; nwg = nM * nN; G = G_; c = c_; }
    __host__ __device__ bool next(int i, Unit& u) const {
        const long L = (long)i * G + c; if (L >= nwg) return false;
        int wgid = (int)L; { const int q = nwg / NXCD, r = nwg % NXCD, xcd = wgid % NXCD, off = wgid / NXCD; wgid = (xcd < r ? xcd * (q + 1) : r * (q + 1) + (xcd - r) * q) + off; }
        const int nig = WGM * nN, gid = wgid / nig, fm = gid * WGM, gsz = (nM - fm) < WGM ? (nM - fm) : WGM;
        u.pm = fm + ((wgid % nig) % gsz); u.pn = (wgid % nig) / gsz; return true;
    }
};


__device__ __forceinline__ void zero_acc(f32x4 (&acc)[2][2][4][2]) {
#pragma unroll
    for (int a = 0; a < 2; ++a)
#pragma unroll
        for (int b = 0; b < 2; ++b)
#pragma unroll
            for (int m = 0; m < 4; ++m)
#pragma unroll
                for (int n = 0; n < 2; ++n) acc[a][b][m][n] = (f32x4){0.f, 0.f, 0.f, 0.f};
}
template <class Epi, bool ALIGN_EPI = true, bool SP2 = true>
__device__ __forceinline__ void gemm_phase(LAS unsigned char* lds, const Gemm g, const StaticOrder& S, const Epi& E, const int wid) {
    int lane_ = fresh_lane_id();
    int lane = lane_, tid = wid * 64 + lane, fr = lane & 15, fq = lane >> 4; const int wr = wid >> 2, wc = wid & 3;
    const int K = g.K, nt = K / BK;
    unsigned voffA[2], voffB[2]; int aoff, boff;
#define PG8_LANE_STATE() do { _Pragma("unroll") for (int i = 0; i < 2; ++i) { int R, C; stage_rc(tid * 16 + i * 8192, R, C); const int Rb = Epi::PERM ? ((R & ~31) + perm32(R & 31)) : R; \
        voffA[i] = (unsigned)(R * g.lda + C) * 2u; voffB[i] = (unsigned)(Rb * g.ldb + C) * 2u; } \
        aoff = lds_byte(wr * 64 + fr, fq * 8); boff = lds_byte(wc * 32 + fr, fq * 8); } while (0)
    PG8_LANE_STATE();
    const size_t kstep = (size_t)(BK * 2);
    const size_t hstepA = (size_t)HALF * g.lda * 2, hstepB = (size_t)HALF * g.ldb * 2;
    const size_t tstepA = 2 * hstepA, tstepB = 2 * hstepB;
    const unsigned ldsw = (unsigned)wid * 1024u;
#define PG8_SA(b, h) (((b) * 2 + (h)) * HTB)
#define PG8_SB(b, h) ((4 + (b) * 2 + (h)) * HTB)
#define PG8_STAGE(bufoff, gbase, voff) do { _Pragma("unroll") for (int _i = 0; _i < 2; ++_i) \
        __builtin_amdgcn_global_load_lds((const unsigned*)((const char*)(gbase) + (voff)[_i]), (LAS unsigned*)(lds + (bufoff) + ldsw + _i * 8192), 16, 0, 0); } while (0)
#define PG8_LDA(dst, b, h) do { _Pragma("unroll") for (int m = 0; m < 4; ++m) _Pragma("unroll") for (int k = 0; k < 2; ++k) dst[m][k] = *(const LAS bf16x8*)(lds + PG8_SA(b, h) + aoff + m * 2048 + k * 1024); } while (0)
#define PG8_LDB(dst, b, h) do { _Pragma("unroll") for (int n = 0; n < 2; ++n) _Pragma("unroll") for (int k = 0; k < 2; ++k) dst[n][k] = *(const LAS bf16x8*)(lds + PG8_SB(b, h) + boff + n * 2048 + k * 1024); } while (0)
#define PG8_MMA(ai, bj, At, Bt) do { __builtin_amdgcn_s_setprio(1); _Pragma("unroll") for (int m = 0; m < 4; ++m) _Pragma("unroll") for (int n = 0; n < 2; ++n) _Pragma("unroll") for (int k = 0; k < 2; ++k) \
        acc[ai][bj][m][n] = __builtin_amdgcn_mfma_f32_16x16x32_bf16(Bt[n][k], At[m][k], acc[ai][bj][m][n], 0, 0, 0); __builtin_amdgcn_s_setprio(0); } while (0)
#define PG8_WAIT_V(n) asm volatile("s_waitcnt vmcnt(" #n ")" ::: "memory")
#define PG8_WAIT_L(n) asm volatile("s_waitcnt lgkmcnt(" #n ")" ::: "memory")
#define PG8_BAR __builtin_amdgcn_s_barrier()
#define PG8_SCHED __builtin_amdgcn_sched_barrier(0)
#define PG8_ABASE(u) ((const char*)g.A + (size_t)(u).pm * tstepA + (g.grp_tiles ? (size_t)((u).pn / g.grp_tiles) * (size_t)K * 2 : (size_t)0))
#define PG8_BBASE(u) ((const char*)g.Bt + (size_t)(u).pn * tstepB)
    Unit cur, nxt; int ui = 0;
    E.prologue(S, lds, tid);
    if (!S.next(0, cur)) return;
    f32x4 acc[2][2][4][2];
    E.init_acc(acc, cur, wr, wc, fr, fq);
    bf16x8 At[4][2], B0[2][2], B1[2][2];
    const char* cA = PG8_ABASE(cur); const char* cB = PG8_BBASE(cur);
    if constexpr (SP2) {
        PG8_STAGE(PG8_SB(0, 0), cB, voffB); PG8_STAGE(PG8_SB(0, 1), cB + hstepB, voffB); PG8_STAGE(PG8_SA(0, 0), cA, voffA); PG8_STAGE(PG8_SA(0, 1), cA + hstepA, voffA);
        if (wr == 1) PG8_BAR;
        PG8_WAIT_V(2); PG8_BAR;
        PG8_STAGE(PG8_SB(1, 0), cB + kstep, voffB); PG8_STAGE(PG8_SA(1, 0), cA + kstep, voffA); PG8_STAGE(PG8_SB(1, 1), cB + hstepB + kstep, voffB);
        PG8_WAIT_V(6); PG8_BAR;
    } else {
        PG8_STAGE(PG8_SB(0, 0), cB, voffB); PG8_STAGE(PG8_SA(0, 0), cA, voffA); PG8_STAGE(PG8_SB(0, 1), cB + hstepB, voffB); PG8_STAGE(PG8_SA(0, 1), cA + hstepA, voffA);
        if (wr == 1) PG8_BAR;
        PG8_WAIT_V(4); PG8_BAR;
        PG8_STAGE(PG8_SB(1, 0), cB + kstep, voffB); PG8_STAGE(PG8_SA(1, 0), cA + kstep, voffA); PG8_STAGE(PG8_SB(1, 1), cB + hstepB + kstep, voffB);
        PG8_WAIT_V(6); PG8_BAR;
    }
    for (;;) {
        const bool has_next = S.next(ui + 1, nxt);
        const char* nA = has_next ? PG8_ABASE(nxt) : cA; const char* nB = has_next ? PG8_BBASE(nxt) : cB;
        for (int t = 0; t < nt; t += 2) {
            const bool last = (t == nt - 2);
            const char* a1 = cA + (size_t)(t + 1) * kstep;
            const char* a2 = last ? nA : cA + (size_t)(t + 2) * kstep; const char* b2 = last ? nB : cB + (size_t)(t + 2) * kstep;
            const char* a3 = a2 + kstep; const char* b3 = b2 + kstep;
            if constexpr (SP2) {
            PG8_LDB(B0, 0, 0); PG8_LDB(B1, 0, 1); PG8_SCHED; PG8_LDA(At, 0, 0); PG8_STAGE(PG8_SA(1, 1), a1 + hstepA, voffA);
            PG8_WAIT_V(8); PG8_WAIT_L(0); PG8_BAR; PG8_MMA(0, 0, At, B0); PG8_MMA(0, 1, At, B1); PG8_BAR; PG8_SCHED;
            PG8_LDA(At, 0, 1); PG8_STAGE(PG8_SB(0, 0), b2, voffB); PG8_STAGE(PG8_SB(0, 1), b2 + hstepB, voffB); PG8_STAGE(PG8_SA(0, 0), a2, voffA);
            PG8_WAIT_V(8); PG8_WAIT_L(0); PG8_BAR; PG8_MMA(1, 0, At, B0); PG8_MMA(1, 1, At, B1); PG8_BAR; PG8_SCHED;
            PG8_LDB(B0, 1, 0); PG8_LDB(B1, 1, 1); PG8_SCHED; PG8_LDA(At, 1, 0); PG8_STAGE(PG8_SA(0, 1), a2 + hstepA, voffA);
            PG8_WAIT_V(8); PG8_WAIT_L(0); PG8_BAR; PG8_MMA(0, 0, At, B0); PG8_MMA(0, 1, At, B1); PG8_BAR; PG8_SCHED;
            PG8_LDA(At, 1, 1); PG8_STAGE(PG8_SB(1, 0), b3, voffB); PG8_STAGE(PG8_SB(1, 1), b3 + hstepB, voffB); PG8_STAGE(PG8_SA(1, 0), a3, voffA);
            PG8_WAIT_V(8); PG8_WAIT_L(0); PG8_BAR; PG8_MMA(1, 0, At, B0); PG8_MMA(1, 1, At, B1); PG8_BAR; PG8_SCHED;
            } else {
            PG8_LDB(B0, 0, 0); PG8_SCHED; PG8_LDA(At, 0, 0); PG8_STAGE(PG8_SA(1, 1), a1 + hstepA, voffA);
            PG8_WAIT_L(8); PG8_BAR; PG8_WAIT_L(0); PG8_MMA(0, 0, At, B0); PG8_BAR; PG8_SCHED;
            PG8_LDB(B1, 0, 1); PG8_STAGE(PG8_SB(0, 0), b2, voffB);
            PG8_BAR; PG8_WAIT_L(0); PG8_MMA(0, 1, At, B1); PG8_BAR;
            PG8_LDA(At, 0, 1); PG8_STAGE(PG8_SA(0, 0), a2, voffA);
            PG8_BAR; PG8_WAIT_L(0); PG8_MMA(1, 0, At, B0); PG8_BAR; PG8_SCHED;
            PG8_STAGE(PG8_SB(0, 1), b2 + hstepB, voffB);
            PG8_WAIT_V(6); PG8_BAR; PG8_MMA(1, 1, At, B1); PG8_BAR;
            PG8_LDB(B0, 1, 0); PG8_SCHED; PG8_LDA(At, 1, 0); PG8_STAGE(PG8_SA(0, 1), a2 + hstepA, voffA);
            PG8_WAIT_L(8); PG8_BAR; PG8_WAIT_L(0); PG8_MMA(0, 0, At, B0); PG8_BAR; PG8_SCHED;
            PG8_LDB(B1, 1, 1); PG8_STAGE(PG8_SB(1, 0), b3, voffB);
            PG8_BAR; PG8_WAIT_L(0); PG8_MMA(0, 1, At, B1); PG8_BAR;
            PG8_LDA(At, 1, 1); PG8_STAGE(PG8_SA(1, 0), a3, voffA);
            PG8_BAR; PG8_WAIT_L(0); PG8_MMA(1, 0, At, B0); PG8_BAR; PG8_SCHED;
            PG8_STAGE(PG8_SB(1, 1), b3 + hstepB, voffB);
            PG8_WAIT_V(6); PG8_BAR; PG8_MMA(1, 1, At, B1); PG8_BAR;
            }
        }
        if constexpr (ALIGN_EPI) { if (wr == 0) PG8_BAR; }
        if constexpr (!Epi::AFTER_DRAIN) E(acc, cur, wr, wc, fr, fq, lds, ui);
        if (!has_next) break;
        cur = nxt; cA = nA; cB = nB; ++ui;
        asm volatile("" : "+v"(lane)); tid = wid * 64 + lane; fr = lane & 15; fq = lane >> 4; PG8_LANE_STATE();
        E.init_acc(acc, cur, wr, wc, fr, fq);
        if constexpr (ALIGN_EPI) { if (wr == 1) PG8_BAR; }
    }
    PG8_WAIT_V(0);
    if constexpr (!ALIGN_EPI) { if (wr == 0) PG8_BAR; }
    PG8_BAR;
    if constexpr (Epi::AFTER_DRAIN) E.fused(acc, cur, wr, wc, fr, fq, lds, tid);
#undef PG8_SA
#undef PG8_SB
#undef PG8_STAGE
#undef PG8_LDA
#undef PG8_LDB
#undef PG8_MMA
#undef PG8_WAIT_V
#undef PG8_WAIT_L
#undef PG8_BAR
#undef PG8_SCHED
#undef PG8_ABASE
#undef PG8_LANE_STATE
#undef PG8_BBASE
}

struct EpiP1 {
    static constexpr bool PERM = true, AFTER_DRAIN = false;
    __device__ __forceinline__ void init_acc(f32x4 (&acc)[2][2][4][2], const Unit&, int, int, int, int) const { zero_acc(acc); }
    __device__ __forceinline__ void prologue(const StaticOrder&, LAS unsigned char*, int) const {}
    bf16_t* V; bf16_t* SG;
    __device__ __forceinline__ void operator()(f32x4 (&acc)[2][2][4][2], const Unit& u, int wr, int wc, int fr, int fq, LAS unsigned char* lds, int ui) const {
        const int row0 = u.pm * BM + wr * 64 + fr; const bool gate = u.pn >= 8;
        bf16_t* base = gate ? SG : V; const int col0 = (u.pn & 7) * BM + wc * 32 + 8 * fq;
#pragma unroll
        for (int ai = 0; ai < 2; ++ai)
#pragma unroll
            for (int m = 0; m < 4; ++m) { bf16_t* rowp = base + (size_t)(row0 + ai * HALF + m * 16) * DI + col0;
#pragma unroll
                for (int bj = 0; bj < 2; ++bj) { f32x4 v0 = acc[ai][bj][m][0], v1 = acc[ai][bj][m][1];
                    if (gate) {
#pragma unroll
                        for (int j = 0; j < 4; ++j) { v0[j] = silu_f(v0[j]); v1[j] = silu_f(v1[j]); } }
                    u32x4 w; w.x = pkbf(v0[0], v0[1]); w.y = pkbf(v0[2], v0[3]); w.z = pkbf(v1[0], v1[1]); w.w = pkbf(v1[2], v1[3]);
                    __builtin_nontemporal_store(w, (u32x4*)(rowp + bj * HALF)); } }
    }
};
struct EpiP2 {
    static constexpr bool PERM = true, AFTER_DRAIN = false;
    __device__ __forceinline__ void init_acc(f32x4 (&acc)[2][2][4][2], const Unit&, int, int, int, int) const { zero_acc(acc); }
    __device__ __forceinline__ void prologue(const StaticOrder&, LAS unsigned char*, int) const {}
    bf16_t* Z;
    __device__ __forceinline__ void operator()(f32x4 (&acc)[2][2][4][2], const Unit& u, int wr, int wc, int fr, int fq, LAS unsigned char* lds, int ui) const {
        const unsigned row0 = (unsigned)(u.pm * BM + wr * 64 + fr), col0 = (unsigned)(u.pn * BM + wc * 32 + 8 * fq);
        const unsigned zofs = (row0 * DI + col0) * 2u;
#pragma unroll
        for (int ai = 0; ai < 2; ++ai) {
            u32x4 sv[4][2];
#pragma unroll
            for (int m = 0; m < 4; ++m)
#pragma unroll
                for (int bj = 0; bj < 2; ++bj) sv[m][bj] = *(const u32x4*)((const char*)Z + (zofs + (unsigned)((ai * HALF + m * 16) * DI + bj * HALF) * 2u));
#pragma unroll
            for (int m = 0; m < 4; ++m)
#pragma unroll
                for (int bj = 0; bj < 2; ++bj) { const f32x4 v0 = acc[ai][bj][m][0], v1 = acc[ai][bj][m][1]; const u32x4 s = sv[m][bj];
                    u32x4 w; w.x = pkbf(v0[0] * bf_lo(s.x), v0[1] * bf_hi(s.x)); w.y = pkbf(v0[2] * bf_lo(s.y), v0[3] * bf_hi(s.y));
                    w.z = pkbf(v1[0] * bf_lo(s.z), v1[1] * bf_hi(s.z)); w.w = pkbf(v1[2] * bf_lo(s.w), v1[3] * bf_hi(s.w));
                    *(u32x4*)((char*)Z + (zofs + (unsigned)((ai * HALF + m * 16) * DI + bj * HALF) * 2u)) = w; }
            asm volatile("" ::: "memory"); }
    }
};
template <bool WRITE_HB, bool WRITE_H = true> struct EpiRes {
    static constexpr bool PERM = true, AFTER_DRAIN = false;
    __device__ __forceinline__ void prologue(const StaticOrder&, LAS unsigned char*, int) const {}
    const float* R; float* H; bf16_t* HB; float* part;
    __device__ __forceinline__ void init_acc(f32x4 (&acc)[2][2][4][2], const Unit& u, int wr, int wc, int fr, int fq) const {
        const unsigned row0 = (unsigned)(u.pm * BM + wr * 64 + fr), col0 = (unsigned)(u.pn * BM + wc * 32 + 8 * fq);
        const unsigned ofs = (row0 * DM + col0) * 4u;
#pragma unroll
        for (int ai = 0; ai < 2; ++ai)
#pragma unroll
            for (int bj = 0; bj < 2; ++bj)
#pragma unroll
                for (int m = 0; m < 4; ++m)
#pragma unroll
                    for (int n = 0; n < 2; ++n) acc[ai][bj][m][n] = __builtin_nontemporal_load((const f32x4*)((const char*)R + (ofs + (unsigned)((ai * HALF + m * 16) * DM + bj * HALF + n * 4) * 4u)));
    }
    __device__ __forceinline__ void operator()(f32x4 (&acc)[2][2][4][2], const Unit& u, int wr, int wc, int fr, int fq, LAS unsigned char* lds, int ui) const {
        const unsigned row0 = (unsigned)(u.pm * BM + wr * 64 + fr), col0 = (unsigned)(u.pn * BM + wc * 32 + 8 * fq);
        const unsigned ofs = (row0 * DM + col0) * 4u, pofs = (row0 * 16u + (unsigned)(u.pn * 4 + wc)) * 4u;
#pragma unroll
        for (int ai = 0; ai < 2; ++ai)
#pragma unroll
            for (int m = 0; m < 4; ++m) { const unsigned o = ofs + (unsigned)((ai * HALF + m * 16) * DM) * 4u; float ss = 0.f;
#pragma unroll
                for (int bj = 0; bj < 2; ++bj) { const unsigned oo = o + (unsigned)(bj * HALF) * 4u; const f32x4 h0 = acc[ai][bj][m][0], h1 = acc[ai][bj][m][1];
                    if (WRITE_H) { *(f32x4*)((char*)H + oo) = h0; *(f32x4*)((char*)H + oo + 16u) = h1; }
                    ss += ((h0[0] * h0[0] + h0[1] * h0[1]) + (h0[2] * h0[2] + h0[3] * h0[3])) + ((h1[0] * h1[0] + h1[1] * h1[1]) + (h1[2] * h1[2] + h1[3] * h1[3]));
                    if (WRITE_HB) { u32x4 w; w.x = pkbf(h0[0], h0[1]); w.y = pkbf(h0[2], h0[3]); w.z = pkbf(h1[0], h1[1]); w.w = pkbf(h1[2], h1[3]); *(u32x4*)((char*)HB + (oo >> 1)) = w; } }
                ss += xor_get(ss, fq * 16 + fr, 16); ss += xor_get(ss, fq * 16 + fr, 32);
                if (fq == 0) *(float*)((char*)part + (pofs + (unsigned)(ai * HALF + m * 16) * 64u)) = ss; }
    }
};
__device__ __forceinline__ float row_rstd_b(const float* part, unsigned bofs) {
    const f32x4* p = (const f32x4*)((const char*)part + bofs); const f32x4 a = p[0], b = p[1], c = p[2], d = p[3];
    return __builtin_amdgcn_rsqf((((a[0] + a[1]) + (a[2] + a[3])) + ((b[0] + b[1]) + (b[2] + b[3])) + ((c[0] + c[1]) + (c[2] + c[3])) + ((d[0] + d[1]) + (d[2] + d[3]))) * (1.0f / DM) + EPS);
}
__device__ __forceinline__ float dpp_shr_mul(float v, const int n) {
    const int iv = __builtin_bit_cast(int, v), one = 0x3f800000; int r;
    if (n == 1) r = __builtin_amdgcn_update_dpp(one, iv, 0x111, 0xf, 0xf, false); else if (n == 2) r = __builtin_amdgcn_update_dpp(one, iv, 0x112, 0xf, 0xf, false);
    else if (n == 4) r = __builtin_amdgcn_update_dpp(one, iv, 0x114, 0xf, 0xf, false); else r = __builtin_amdgcn_update_dpp(one, iv, 0x118, 0xf, 0xf, false);
    return v * __builtin_bit_cast(float, r);
}
constexpr unsigned TAB_OFF = 131072u;
struct EpiP4 {
    static constexpr bool PERM = true, AFTER_DRAIN = false;
    __device__ __forceinline__ void init_acc(f32x4 (&acc)[2][2][4][2], const Unit&, int, int, int, int) const { zero_acc(acc); }
    bf16_t* Qt; bf16_t* Kt; bf16_t* V; float* DEC; const float* part; const float* lbnd;
    __device__ __forceinline__ void prologue(const StaticOrder& S, LAS unsigned char* lds, int tid) const {
        LAS float* T = (LAS float*)(lds + TAB_OFF); Unit u;
        for (int i = 0; i < 12 && S.next(i, u); ++i)
            if (tid < 256) T[i * 256 + tid] = row_rstd_b(part, (unsigned)(u.pm * BM + tid) * 64u);
        __syncthreads();
    }
    __device__ __forceinline__ void operator()(f32x4 (&acc)[2][2][4][2], const Unit& u, int wr, int wc, int fr, int fq, LAS unsigned char* lds, int ui) const {
        const unsigned row0 = (unsigned)(u.pm * BM + wr * 64 + fr);
        const LAS float* T = (const LAS float*)(lds + TAB_OFF) + ui * 256 + wr * 64 + fr;
        if (u.pn >= 16) {
            const unsigned vofs = (row0 * DI + (unsigned)((u.pn - 16) * BM + wc * 32 + 8 * fq)) * 2u;
#pragma unroll
            for (int ai = 0; ai < 2; ++ai)
#pragma unroll
                for (int m = 0; m < 4; ++m) { const float rs = T[ai * HALF + m * 16];
#pragma unroll
                    for (int bj = 0; bj < 2; ++bj) { const f32x4 v0 = acc[ai][bj][m][0] * rs, v1 = acc[ai][bj][m][1] * rs;
                        u32x4 w; w.x = pkbf(v0[0], v0[1]); w.y = pkbf(v0[2], v0[3]); w.z = pkbf(v1[0], v1[1]); w.w = pkbf(v1[2], v1[3]);
                        __builtin_nontemporal_store(w, (u32x4*)((char*)V + (vofs + (unsigned)((ai * HALF + m * 16) * DI + bj * HALF) * 2u))); } }
            return;
        }
        const unsigned c0 = (unsigned)(u.pn * HD + wc * 32 + 8 * fq);
        const unsigned qofs = (row0 * DI + c0) * 2u;
#pragma unroll
        for (int ai = 0; ai < 2; ++ai) {
            float rs[4];
#pragma unroll
            for (int m = 0; m < 4; ++m) rs[m] = T[ai * HALF + m * 16];
            unsigned cc = c0; asm volatile("" : "+v"(cc));
#pragma unroll
            for (int n = 0; n < 2; ++n) {
                const f32x4 l0 = *(const f32x4*)((const char*)lbnd + (cc + 4 * n) * 4u), l1 = *(const f32x4*)((const char*)lbnd + (cc + 4 * n + DI) * 4u);
                f32x4 decv;
#pragma unroll
                for (int j = 0; j < 4; ++j) { const float ex = __expf(l0[j] - l1[j]); const float lb = __builtin_amdgcn_rcpf(1.0f + ex), omlb = ex * lb; float bprod = 1.0f;
#pragma unroll
                    for (int m = 0; m < 4; ++m) {
                        const float qv = acc[ai][0][m][n][j] * rs[m], z = acc[ai][1][m][n][j] * rs[m];
                        const float sg = __builtin_amdgcn_rcpf(1.0f + __builtin_amdgcn_exp2f(-1.44269504089f * z));
                        const float f = lb + omlb * sg, k = omlb * (1.0f - sg);
                        float s = f; s = dpp_shr_mul(s, 1); s = dpp_shr_mul(s, 2); s = dpp_shr_mul(s, 4); s = dpp_shr_mul(s, 8);
                        const float E = bprod * s;
                        if (m < 3) bprod *= lane_get(s, fq * 16 + 15);
                        const float Ei = __builtin_amdgcn_rcpf(fmaxf(E, 7.9e-31f));
                        acc[ai][0][m][n][j] = qv * E; acc[ai][1][m][n][j] = k * Ei;
                        if (m == 3) decv[j] = E;
                    } }
                if (fr == 15) *(f32x4*)((char*)DEC + ((unsigned)(u.pm * 4 + ai * 2 + wr) * DI + cc + 4 * n) * 4u) = decv;
            }
#pragma unroll
            for (int m = 0; m < 4; ++m) { const unsigned ob = qofs + (unsigned)((ai * HALF + m * 16) * DI) * 2u;
                u32x4 w; w.x = pkbf(acc[ai][0][m][0][0], acc[ai][0][m][0][1]); w.y = pkbf(acc[ai][0][m][0][2], acc[ai][0][m][0][3]); w.z = pkbf(acc[ai][0][m][1][0], acc[ai][0][m][1][1]); w.w = pkbf(acc[ai][0][m][1][2], acc[ai][0][m][1][3]);
                __builtin_nontemporal_store(w, (u32x4*)((char*)Qt + ob));
                u32x4 x; x.x = pkbf(acc[ai][1][m][0][0], acc[ai][1][m][0][1]); x.y = pkbf(acc[ai][1][m][0][2], acc[ai][1][m][0][3]); x.z = pkbf(acc[ai][1][m][1][0], acc[ai][1][m][1][1]); x.w = pkbf(acc[ai][1][m][1][2], acc[ai][1][m][1][3]);
                __builtin_nontemporal_store(x, (u32x4*)((char*)Kt + ob)); }
            asm volatile("" ::: "memory");
        }
    }
};
struct EpiP5b {
    static constexpr bool PERM = true, AFTER_DRAIN = false;
    __device__ __forceinline__ void init_acc(f32x4 (&acc)[2][2][4][2], const Unit&, int, int, int, int) const { zero_acc(acc); }
    bf16_t* O; const float* part; const float* ss;
    __device__ __forceinline__ void prologue(const StaticOrder& S, LAS unsigned char* lds, int tid) const {
        LAS float* T = (LAS float*)(lds + TAB_OFF); Unit u;
        for (int i = 0; i < 4 && S.next(i, u); ++i) {
            if (tid < 256) T[i * 768 + tid] = row_rstd_b(part, (unsigned)(u.pm * BM + tid) * 64u);
            { const int r = tid >> 1, hh = tid & 1; const f32x4* sp = (const f32x4*)(ss + (size_t)(u.pm * BM + r) * 128 + (u.pn * 2 + hh) * 8); const f32x4 s0 = sp[0], s1 = sp[1];
              T[i * 768 + 256 + tid] = __builtin_amdgcn_rsqf((((s0[0] + s0[1]) + (s0[2] + s0[3])) + ((s1[0] + s1[1]) + (s1[2] + s1[3]))) * (1.0f / HD) + EPS); }
        }
        __syncthreads();
    }
    __device__ __forceinline__ void operator()(f32x4 (&acc)[2][2][4][2], const Unit& u, int wr, int wc, int fr, int fq, LAS unsigned char* lds, int ui) const {
        const unsigned row0 = (unsigned)(u.pm * BM + wr * 64 + fr), col0 = (unsigned)(u.pn * BM + wc * 32 + 8 * fq);
        const LAS float* T = (const LAS float*)(lds + TAB_OFF) + ui * 768 + wr * 64 + fr;
        const unsigned oofs = (row0 * DI + col0) * 2u;
#pragma unroll
        for (int ai = 0; ai < 2; ++ai) {
            u32x4 ov[4][2];
#pragma unroll
            for (int m = 0; m < 4; ++m)
#pragma unroll
                for (int bj = 0; bj < 2; ++bj) ov[m][bj] = *(const u32x4*)((const char*)O + (oofs + (unsigned)((ai * HALF + m * 16) * DI + bj * HALF) * 2u));
#pragma unroll
            for (int m = 0; m < 4; ++m) { const int rl = ai * HALF + m * 16; const float rs = T[rl];
#pragma unroll
                for (int bj = 0; bj < 2; ++bj) { const f32x4 v0 = acc[ai][bj][m][0] * rs, v1 = acc[ai][bj][m][1] * rs;
                    const float rh = T[256 + 2 * rl + bj + (wr * 64 + fr)];
                    const u32x4 s = ov[m][bj];
                    u32x4 w; w.x = pkbf(bf_lo(s.x) * rh * silu_f(v0[0]), bf_hi(s.x) * rh * silu_f(v0[1])); w.y = pkbf(bf_lo(s.y) * rh * silu_f(v0[2]), bf_hi(s.y) * rh * silu_f(v0[3]));
                    w.z = pkbf(bf_lo(s.z) * rh * silu_f(v1[0]), bf_hi(s.z) * rh * silu_f(v1[1])); w.w = pkbf(bf_lo(s.w) * rh * silu_f(v1[2]), bf_hi(s.w) * rh * silu_f(v1[3]));
                    *(u32x4*)((char*)O + (oofs + (unsigned)((ai * HALF + m * 16) * DI + bj * HALF) * 2u)) = w; } }
            asm volatile("" ::: "memory"); }
    }
};
struct EpiFinal {
    static constexpr bool PERM = true, AFTER_DRAIN = false;
    __device__ __forceinline__ void init_acc(f32x4 (&acc)[2][2][4][2], const Unit&, int, int, int, int) const { zero_acc(acc); }
    const bf16_t* HB; float* H; const float* fg; float* X; unsigned* cnt;
    __device__ __forceinline__ void prologue(const StaticOrder&, LAS unsigned char*, int) const {}
    __device__ __forceinline__ void operator()(f32x4 (&acc)[2][2][4][2], const Unit& u, int wr, int wc, int fr, int fq, LAS unsigned char* lds, int ui) const {
        LAS float* Pt = (LAS float*)(lds + TAB_OFF);
        LAS float* St = Pt + 1024;
        const int tid = (wr * 4 + wc) * 64 + fq * 16 + fr;
        const unsigned row0 = (unsigned)(u.pm * BM + wr * 64 + fr), col0 = (unsigned)(u.pn * BM + wc * 32 + 8 * fq);
        const unsigned ofs = (row0 * DM + col0) * 4u;
#pragma unroll
        for (int ai = 0; ai < 2; ++ai) {
            u32x4 hv[4][2];
#pragma unroll
            for (int m = 0; m < 4; ++m)
#pragma unroll
                for (int bj = 0; bj < 2; ++bj) hv[m][bj] = *(const u32x4*)((const char*)HB + ((ofs + (unsigned)((ai * HALF + m * 16) * DM + bj * HALF) * 4u) >> 1));
#pragma unroll
            for (int m = 0; m < 4; ++m) { float ss = 0.f;
#pragma unroll
                for (int bj = 0; bj < 2; ++bj) { const u32x4 hb = hv[m][bj];
                    const f32x4 h0 = acc[ai][bj][m][0] + (f32x4){bf_lo(hb.x), bf_hi(hb.x), bf_lo(hb.y), bf_hi(hb.y)}, h1 = acc[ai][bj][m][1] + (f32x4){bf_lo(hb.z), bf_hi(hb.z), bf_lo(hb.w), bf_hi(hb.w)};
                    acc[ai][bj][m][0] = h0; acc[ai][bj][m][1] = h1;
                    ss += ((h0[0] * h0[0] + h0[1] * h0[1]) + (h0[2] * h0[2] + h0[3] * h0[3])) + ((h1[0] * h1[0] + h1[1] * h1[1]) + (h1[2] * h1[2] + h1[3] * h1[3])); }
                ss += xor_get(ss, fq * 16 + fr, 16); ss += xor_get(ss, fq * 16 + fr, 32);
                if (fq == 0) Pt[(ai * HALF + wr * 64 + m * 16 + fr) * 4 + wc] = ss; }
            asm volatile("" ::: "memory"); }
        __syncthreads();
        float* xs = X + (size_t)u.pm * 1024;
        if (tid < 256) { const f32x4 p = *(const LAS f32x4*)(Pt + tid * 4);
            __hip_atomic_store(xs + u.pn * 256 + tid, (p[0] + p[1]) + (p[2] + p[3]), __ATOMIC_RELAXED, __HIP_MEMORY_SCOPE_AGENT); }
        asm volatile("s_waitcnt vmcnt(0)" ::: "memory");
        __syncthreads();
        if (tid == 0) {
            unsigned* c = cnt + 16 * u.pm;
            __hip_atomic_fetch_add(c, 1u, __ATOMIC_RELAXED, __HIP_MEMORY_SCOPE_AGENT);
            unsigned spins = 0;
            while (__hip_atomic_load(c, __ATOMIC_RELAXED, __HIP_MEMORY_SCOPE_AGENT) < 4u) { __builtin_amdgcn_s_sleep(2); if (++spins > (1u << 22)) break; }
            __builtin_amdgcn_fence(__ATOMIC_ACQUIRE, "agent");
            asm volatile("s_waitcnt vmcnt(0)" ::: "memory");
        }
        __syncthreads();
        if (tid < 256) { float s = 0.f;
#pragma unroll
            for (int t = 0; t < 4; ++t) s += __hip_atomic_load(xs + t * 256 + tid, __ATOMIC_RELAXED, __HIP_MEMORY_SCOPE_AGENT);
            St[tid] = __builtin_amdgcn_rsqf(s * (1.0f / DM) + EPS); }
        __syncthreads();
        f32x4 gv[2][2];
#pragma unroll
        for (int bj = 0; bj < 2; ++bj)
#pragma unroll
            for (int n = 0; n < 2; ++n) gv[bj][n] = *(const f32x4*)(fg + col0 + bj * HALF + n * 4);
#pragma unroll
        for (int ai = 0; ai < 2; ++ai)
#pragma unroll
            for (int m = 0; m < 4; ++m) { const float rs = St[ai * HALF + wr * 64 + m * 16 + fr];
#pragma unroll
                for (int bj = 0; bj < 2; ++bj) { const unsigned oo = ofs + (unsigned)((ai * HALF + m * 16) * DM + bj * HALF) * 4u;
                    *(f32x4*)((char*)H + oo) = acc[ai][bj][m][0] * rs * gv[bj][0]; *(f32x4*)((char*)H + oo + 16u) = acc[ai][bj][m][1] * rs * gv[bj][1]; } }
        __syncthreads();
    }
};
}

namespace scan {
#define MFMA16(a, b, c) __builtin_amdgcn_mfma_f32_16x16x32_bf16((a), (b), (c), 0, 0, 0)
__device__ __forceinline__ unsigned offb(unsigned row, unsigned ch) { return 256u * row + 16u * (ch ^ (((row & 3u) << 2) | ((row >> 2) & 3u))); }
__device__ __forceinline__ unsigned voffv(unsigned r, unsigned cp) { return 128u * r + 32u * (cp ^ (((r >> 1) & 3u) ^ (((r >> 3) & 1u) << 1))); }
__device__ __forceinline__ void tr8(unsigned a0, unsigned a1, unsigned c0, unsigned c1, bf16x8& f00, bf16x8& f01, bf16x8& f10, bf16x8& f11) {
    u32x2 r0, r1, r2, r3, r4, r5, r6, r7;
    asm volatile("ds_read_b64_tr_b16 %0, %8\n\tds_read_b64_tr_b16 %1, %9\n\tds_read_b64_tr_b16 %2, %8 offset:8192\n\tds_read_b64_tr_b16 %3, %9 offset:8192\n\t"
                 "ds_read_b64_tr_b16 %4, %10\n\tds_read_b64_tr_b16 %5, %11\n\tds_read_b64_tr_b16 %6, %10 offset:8192\n\tds_read_b64_tr_b16 %7, %11 offset:8192\n\ts_waitcnt lgkmcnt(0)"
                 : "=&v"(r0), "=&v"(r1), "=&v"(r2), "=&v"(r3), "=&v"(r4), "=&v"(r5), "=&v"(r6), "=&v"(r7) : "v"(a0), "v"(a1), "v"(c0), "v"(c1) : "memory");
    const u32x4 x00 = {r0.x, r0.y, r1.x, r1.y}, x01 = {r2.x, r2.y, r3.x, r3.y}, x10 = {r4.x, r4.y, r5.x, r5.y}, x11 = {r6.x, r6.y, r7.x, r7.y};
    f00 = __builtin_bit_cast(bf16x8, x00); f01 = __builtin_bit_cast(bf16x8, x01); f10 = __builtin_bit_cast(bf16x8, x10); f11 = __builtin_bit_cast(bf16x8, x11);
}
__device__ __forceinline__ bf16x8 pack8(const f32x4 a, const f32x4 b) { const u32x4 r = {pkbf(a[0], a[1]), pkbf(a[2], a[3]), pkbf(b[0], b[1]), pkbf(b[2], b[3])}; return __builtin_bit_cast(bf16x8, r); }
__device__ __forceinline__ u32x2 tr_issue(unsigned a) { u32x2 r; asm volatile("ds_read_b64_tr_b16 %0, %1" : "=v"(r) : "v"(a) : "memory"); return r; }
__device__ __forceinline__ bf16x8 frag2(const u32x2 lo, const u32x2 hi) { const u32x4 r = {lo.x, lo.y, hi.x, hi.y}; return __builtin_bit_cast(bf16x8, r); }
__device__ __forceinline__ u32x2 at_tile(LAS unsigned char* lds, unsigned QI, unsigned KI, int it, int j, unsigned l15, unsigned g) {
    f32x4 c = (f32x4){0.f, 0.f, 0.f, 0.f};
#pragma unroll
    for (int kd = 0; kd < 4; ++kd) { const bf16x8 qb = *(const LAS bf16x8*)(lds + QI + offb(16u * (unsigned)it + l15, 4u * kd + g)), a = *(const LAS bf16x8*)(lds + KI + offb(16u * (unsigned)j + l15, 4u * kd + g)); c = MFMA16(a, qb, c); }
    if (j == it) {
#pragma unroll
        for (int r = 0; r < 4; ++r) c[r] = (4u * g + r <= l15) ? c[r] : 0.f; }
    const u32x2 w = {pkbf(c[0], c[1]), pkbf(c[2], c[3])}; return w;
}
template <int NK>
__device__ __forceinline__ f32x4 o_part(LAS unsigned char* lds, unsigned QI, int it, const bf16x8 (&at)[NK], const bf16x8 (&vf)[2], const bf16x8 so0, const bf16x8 so1, const bf16x8 sp0, const bf16x8 sp1, int th, unsigned l15, unsigned g) {
    const unsigned trow = 16u * (unsigned)it + l15;
    f32x4 o = (f32x4){0.f, 0.f, 0.f, 0.f};
#pragma unroll
    for (int ks = 0; ks < NK; ++ks) if (2 * ks <= it) o = MFMA16(vf[ks], at[ks], o);
#pragma unroll
    for (int j = 0; j < 4; ++j) {
        const unsigned kd = (j < 2) ? (2u * (unsigned)th + j) : (2u * (unsigned)(1 - th) + (j - 2));
        const u32x2 q0 = *(const LAS u32x2*)(lds + QI + offb(trow, 4u * kd + (g >> 1)) + 8u * (g & 1)), q1 = *(const LAS u32x2*)(lds + QI + offb(trow, 4u * kd + 2u + (g >> 1)) + 8u * (g & 1));
        o = MFMA16(j == 0 ? so0 : j == 1 ? so1 : j == 2 ? sp0 : sp1, frag2(q0, q1), o); }
    return o;
}
__device__ __forceinline__ void phase(LAS unsigned char* lds, const bf16_t* Qt, const bf16_t* Kt, bf16_t* VO, const float* DEC, float* ss8, int bid, int G, int wave) {
    const unsigned lane = (unsigned)fresh_lane_id(), l15 = lane & 15u, g = lane >> 4, ql = l15 >> 2, p = lane & 3u;
    const unsigned vs = (unsigned)wave & 3u; const int th = wave >> 2, tA = th ? 1 : 0, tB = th ? 2 : 3;
    const unsigned ldsb = (unsigned)(uintptr_t)lds;
    constexpr unsigned QKB = 32768u, VRING = 3u * QKB, DECB = VRING + 2u * 8192u, SFB = DECB + 1536u, ATB = SFB + 32768u;
    static_assert(ATB + 2u * 5120u <= XST_OFF, "scan LDS map");
    unsigned qoff[2], voff_, doff;
#pragma unroll
    for (int i = 0; i < 2; ++i) { const unsigned j = 2u * (unsigned)wave + i, r = 4u * j + (lane >> 4), pc = lane & 15u, ch = pc ^ (((r & 3u) << 2) | ((r >> 2) & 3u)); qoff[i] = (r * DI + ch * 8u) * 2u; }
    { const unsigned r = 8u * (unsigned)wave + (lane >> 3), s16 = lane & 7u, ul = (s16 >> 1) ^ (((r >> 1) & 3u) ^ (((r >> 3) & 1u) << 1)); voff_ = (r * DI + (ul * 2u + (s16 & 1u)) * 8u) * 2u; }
    doff = (64u * ((unsigned)wave & 1u) + lane) * 4u;
    const int my_it = wave == 0 ? 0 : wave <= 2 ? 1 : wave <= 5 ? 2 : 3, my_j = wave == 0 ? 0 : wave <= 2 ? wave - 1 : wave <= 5 ? wave - 3 : wave - 6;
    for (int item = bid; item < BATCH * NHEAD * 2; item += G) {
        const int half = (item >> 3) & 1, pair = (item & 7) | ((item >> 4) << 3), b = pair >> 4, h = pair & 15;
        const size_t tokb = (size_t)b * SEQ;
        const char* qg = (const char*)(Qt + tokb * DI + h * HD);
        const char* kg = (const char*)(Kt + tokb * DI + h * HD);
        bf16_t* vg = VO + tokb * DI + h * HD + half * 64;
        const char* dg = (const char*)(DEC + (size_t)(b * (SEQ / 64)) * DI + h * HD);
        f32x4 S[4];
        bf16x8 so0 = (bf16x8){0, 0, 0, 0, 0, 0, 0, 0}, so1 = so0, sp0 = so0, sp1 = so0;
#pragma unroll
        for (int i = 0; i < 4; ++i) S[i] = (f32x4){0.f, 0.f, 0.f, 0.f};
#define SC_DMA_QK(c_) do { const size_t o_ = (size_t)(c_) * 64 * DI * 2; const unsigned base_ = ((unsigned)(c_) % 3u) * QKB; \
            __builtin_amdgcn_global_load_lds((const unsigned*)(qg + o_ + qoff[0]), (LAS unsigned*)(lds + base_ + (unsigned)wave * 2048u), 16, 0, 0); \
            __builtin_amdgcn_global_load_lds((const unsigned*)(qg + o_ + qoff[1]), (LAS unsigned*)(lds + base_ + (unsigned)wave * 2048u + 1024u), 16, 0, 0); \
            __builtin_amdgcn_global_load_lds((const unsigned*)(kg + o_ + qoff[0]), (LAS unsigned*)(lds + base_ + 16384u + (unsigned)wave * 2048u), 16, 0, 0); \
            __builtin_amdgcn_global_load_lds((const unsigned*)(kg + o_ + qoff[1]), (LAS unsigned*)(lds + base_ + 16384u + (unsigned)wave * 2048u + 1024u), 16, 0, 0); \
            __builtin_amdgcn_global_load_lds((const unsigned*)(dg + (size_t)(c_) * DI * 4 + doff), (LAS unsigned*)(lds + DECB + ((unsigned)(c_) % 3u) * 512u + ((unsigned)wave & 1u) * 256u), 4, 0, 0); } while (0)
#define SC_DMA_V(c_) __builtin_amdgcn_global_load_lds((const unsigned*)((const char*)vg + (size_t)(c_) * 64 * DI * 2 + voff_), (LAS unsigned*)(lds + VRING + ((unsigned)(c_) & 1u) * 8192u + (unsigned)wave * 1024u), 16, 0, 0)
#define SC_AT(c_) do { LAS u32x2* atw = (LAS u32x2*)(lds + ATB + (unsigned)((c_) & 1) * 5120u) + lane; const unsigned b_ = ((unsigned)(c_) % 3u) * QKB; \
            atw[64 * wave] = at_tile(lds, b_, b_ + 16384u, my_it, my_j, l15, g); \
            if (wave < 2) atw[64 * (8 + wave)] = at_tile(lds, b_, b_ + 16384u, 3, 2 + wave, l15, g); } while (0)
        SC_DMA_QK(0); SC_DMA_QK(1); SC_DMA_V(0);
        asm volatile("s_waitcnt vmcnt(0)" ::: "memory");
        __builtin_amdgcn_s_barrier();
        SC_AT(0);
        asm volatile("s_waitcnt lgkmcnt(0)" ::: "memory");
        __builtin_amdgcn_s_barrier();
        for (int n = 0; n < SEQ / 64; ++n) {
            const unsigned QI = ((unsigned)n % 3u) * QKB, KI = QI + 16384u, VI = VRING + ((unsigned)n & 1u) * 8192u;
            if (n + 2 < SEQ / 64) SC_DMA_QK(n + 2);
            if (n + 1 < SEQ / 64) SC_DMA_V(n + 1);
            if (n > 0) { const LAS bf16x8* sfr = (const LAS bf16x8*)(lds + SFB + ((unsigned)n & 1u) * 16384u + (unsigned)(wave ^ 4) * 2048u) + lane;
                sp0 = sfr[0]; sp1 = sfr[64]; }
            u32x2 tv0, tv1, tv2, tv3, tv4, tv5, tv6, tv7;
            {
                const unsigned va = ldsb + VI + 8u * p;
                tv0 = tr_issue(va + voffv(4u * g + ql, vs)); tv1 = tr_issue(va + voffv(16u + 4u * g + ql, vs)); tv2 = tr_issue(va + voffv(32u + 4u * g + ql, vs)); tv3 = tr_issue(va + voffv(48u + 4u * g + ql, vs));
                tv4 = tr_issue(va + voffv(8u * g + ql, vs)); tv5 = tr_issue(va + voffv(8u * g + 4u + ql, vs)); tv6 = tr_issue(va + voffv(32u + 8u * g + ql, vs)); tv7 = tr_issue(va + voffv(36u + 8u * g + ql, vs));
            }
            if (n + 1 < SEQ / 64) SC_AT(n + 1);
            bf16x8 atB[2], atA[1];
            { const LAS u32x2* atr = (const LAS u32x2*)(lds + ATB + (unsigned)(n & 1) * 5120u) + lane; const u32x2 z2 = {0u, 0u};
              if (th == 0) { atB[0] = frag2(atr[64 * 6], atr[64 * 7]); atB[1] = frag2(atr[64 * 8], atr[64 * 9]); atA[0] = frag2(atr[0], z2); }
              else         { atB[0] = frag2(atr[64 * 3], atr[64 * 4]); atB[1] = frag2(atr[64 * 5], z2);          atA[0] = frag2(atr[64 * 1], atr[64 * 2]); } }
            asm volatile("s_waitcnt lgkmcnt(0)" : "+v"(tv0), "+v"(tv1), "+v"(tv2), "+v"(tv3), "+v"(tv4), "+v"(tv5), "+v"(tv6), "+v"(tv7) :: "memory");
            __builtin_amdgcn_sched_barrier(0);
            const bf16x8 vf[2] = {frag2(tv0, tv1), frag2(tv2, tv3)};
            const f32x4 oB = o_part<2>(lds, QI, tB, atB, vf, so0, so1, sp0, sp1, th, l15, g);
            const f32x4 oA = o_part<1>(lds, QI, tA, atA, vf, so0, so1, sp0, sp1, th, l15, g);
            {
                const bf16x8 vn0 = frag2(tv4, tv5), vn1 = frag2(tv6, tv7);
                const LAS float* dcp = (const LAS float*)(lds + DECB + ((unsigned)n % 3u) * 512u) + 4u * g + 64u * (unsigned)th;
                const unsigned ka = (ldsb + KI + offb(8u * g + ql, (p >> 1)) + 8u * (p & 1u)) ^ ((unsigned)th << 7), kb = (ldsb + KI + offb(8u * g + 4u + ql, (p >> 1)) + 8u * (p & 1u)) ^ ((unsigned)th << 7);
#pragma unroll
                for (int i = 0; i < 4; i += 2) {
                    bf16x8 k00, k01, k10, k11;
                    tr8(ka ^ ((unsigned)i << 5), kb ^ ((unsigned)i << 5), ka ^ ((unsigned)(i + 1) << 5), kb ^ ((unsigned)(i + 1) << 5), k00, k01, k10, k11);
                    S[i] = MFMA16(k00, vn0, S[i]); S[i + 1] = MFMA16(k10, vn0, S[i + 1]); S[i] = MFMA16(k01, vn1, S[i]); S[i + 1] = MFMA16(k11, vn1, S[i + 1]); }
#pragma unroll
                for (int i = 0; i < 4; ++i) { const f32x4 dc = *(const LAS f32x4*)(dcp + 16 * i); S[i] = S[i] * dc; }
                const bf16x8 f0 = pack8(S[0], S[1]), f1 = pack8(S[2], S[3]);
                so0 = f0; so1 = f1;
                LAS bf16x8* sfw = (LAS bf16x8*)(lds + SFB + ((unsigned)(n + 1) & 1u) * 16384u + (unsigned)wave * 2048u) + lane;
                sfw[0] = f0; sfw[64] = f1;
            }
            asm volatile("s_waitcnt vmcnt(0)" ::: "memory");
            {
                const size_t tlB = (size_t)n * 64 + 16u * (unsigned)tB + l15, tlA = (size_t)n * 64 + 16u * (unsigned)tA + l15;
                const u32x2 wB = {pkbf(oB[0], oB[1]), pkbf(oB[2], oB[3])}, wA = {pkbf(oA[0], oA[1]), pkbf(oA[2], oA[3])};
                *(u32x2*)(vg + tlB * DI + 16u * vs + 4u * g) = wB; *(u32x2*)(vg + tlA * DI + 16u * vs + 4u * g) = wA;
                float sB = (oB[0] * oB[0] + oB[1] * oB[1]) + (oB[2] * oB[2] + oB[3] * oB[3]), sA = (oA[0] * oA[0] + oA[1] * oA[1]) + (oA[2] * oA[2] + oA[3] * oA[3]);
                sB += xor_get(sB, (int)lane, 16); sA += xor_get(sA, (int)lane, 16); sB += xor_get(sB, (int)lane, 32); sA += xor_get(sA, (int)lane, 32);
                if (g == 0) { ss8[(tokb + tlB) * 128 + h * 8 + half * 4 + vs] = sB; ss8[(tokb + tlA) * 128 + h * 8 + half * 4 + vs] = sA; }
            }
            asm volatile("s_waitcnt lgkmcnt(0)" ::: "memory");
            __builtin_amdgcn_s_barrier();
        }
#undef SC_DMA_QK
#undef SC_DMA_V
#undef SC_AT
    }
}
#undef MFMA16
}

#define XB_TMO      128
#define XB_XCNT(j)  (256  + 64 * (j))
#define XB_XSUB(j)  (1280 + 64 * (j))
#define XB_XGEN(j)  (2304 + 64 * (j))
#define XB_TOP      3328
#define XB_TOPGEN   3392
#define XCD_BAR_WORDS 3456
#define XB_SPIN_CAP (1u << 18)
__device__ __forceinline__ unsigned xb_ld(unsigned* p)              { return __hip_atomic_load(p, __ATOMIC_RELAXED, __HIP_MEMORY_SCOPE_AGENT); }
__device__ __forceinline__ unsigned xb_add(unsigned* p, unsigned v) { return __hip_atomic_fetch_add(p, v, __ATOMIC_RELAXED, __HIP_MEMORY_SCOPE_AGENT); }
__device__ __forceinline__ unsigned xb_xcc_id() { return (unsigned)__builtin_amdgcn_s_getreg((3 << 11) | 20) & 0xFu; }
#define XB_SPIN(cond, bar) do { unsigned _sp = 0; while (cond) { __builtin_amdgcn_s_sleep(1); \
    if ((++_sp & 255u) == 0u) { if (xb_ld(&(bar)[XB_TMO])) break; if (_sp > XB_SPIN_CAP) { atomicAdd(&(bar)[XB_TMO], 1u); break; } } } } while (0)
struct XcdBarrier { unsigned* bar; unsigned x; volatile LAS unsigned* st; };
__device__ __forceinline__ XcdBarrier xcd_barrier_post(unsigned* bar, volatile LAS unsigned* st) {
    XcdBarrier b; b.bar = bar; b.x = xb_xcc_id(); b.st = st;
    if (threadIdx.x == 0) (void)xb_add(&bar[XB_XCNT(b.x)], 1u);
    return b;
}
__device__ __forceinline__ void xcd_barrier_complete(unsigned* bar, unsigned x, unsigned& nloc, unsigned& nx) {
    const unsigned G = gridDim.x * gridDim.y * gridDim.z;
    unsigned sum, cnt, mine, sp = 0u;
    for (;;) {
        sum = 0u; cnt = 0u; mine = 0u;
#pragma unroll
        for (unsigned j = 0; j < 16; ++j) { const unsigned c = xb_ld(&bar[XB_XCNT(j)]); sum += c; cnt += (c > 0u) ? 1u : 0u; mine = (j == x) ? c : mine; }
        if (sum == G) break;
        __builtin_amdgcn_s_sleep(1);
        if ((++sp & 255u) == 0u) { if (xb_ld(&bar[XB_TMO])) break; if (sp > XB_SPIN_CAP) { atomicAdd(&bar[XB_TMO], 1u); break; } }
    }
    nloc = mine > 0u ? mine : 1u; nx = cnt > 0u ? cnt : 1u;
}
__device__ __forceinline__ void xcd_barrier(const XcdBarrier& b) {
    asm volatile("s_waitcnt vmcnt(0)" ::: "memory");
    __syncthreads();
    if (threadIdx.x == 0) {
        unsigned* bar = b.bar;
        __builtin_amdgcn_s_waitcnt(0);
        unsigned nloc = b.st[0], nx = b.st[1];
        if (nloc == 0u) { xcd_barrier_complete(bar, b.x, nloc, nx); b.st[0] = nloc; b.st[1] = nx; }
        const unsigned old = xb_add(&bar[XB_XSUB(b.x)], 1u);
        const unsigned gen = old / nloc;
        if (old + 1u == (gen + 1u) * nloc) {
            __builtin_amdgcn_fence(__ATOMIC_RELEASE, "agent");
            asm volatile("s_waitcnt vmcnt(0)" ::: "memory");
            const unsigned og = xb_add(&bar[XB_TOP], 1u);
            const unsigned tg = og / nx;
            if (og + 1u == (tg + 1u) * nx) xb_add(&bar[XB_TOPGEN], 1u);
            else XB_SPIN(xb_ld(&bar[XB_TOPGEN]) == tg, bar);
            __builtin_amdgcn_fence(__ATOMIC_ACQUIRE, "agent");
            xb_add(&bar[XB_XGEN(b.x)], 1u);
            asm volatile("s_waitcnt vmcnt(0)" ::: "memory");
        } else {
            XB_SPIN(xb_ld(&bar[XB_XGEN(b.x)]) == gen, bar);
            __builtin_amdgcn_fence(__ATOMIC_ACQUIRE, "agent");
            asm volatile("s_waitcnt vmcnt(0)" ::: "memory");
        }
    }
    __syncthreads();
}

struct Args {
    const float* x; const float* norm_g; const float* pool_w_in; const float* pool_w_grp; const float* pool_scale; const float* pool_w_out;
    const float* hgrn_w_in; const float* hgrn_lb; const float* hgrn_norm_g; const float* hgrn_w_out; const float* final_g;
    float* out; unsigned char* ws;
};

struct TItem { const float* W; bf16_t* WT; const float* ks; const float* ns; int K, N, row_off, item; };
__device__ __forceinline__ void titem_issue(const TItem& t, int lane, float (&wv)[32]) {
    const int nblk = t.N / 32, kb = t.item / nblk, nb = t.item % nblk, k0 = 64 * kb, n0 = 32 * nb;
    const float* wp = t.W + (size_t)(k0 + (lane >> 5)) * t.N + n0 + (lane & 31);
#pragma unroll
    for (int i = 0; i < 32; ++i) wv[i] = __builtin_nontemporal_load(wp + (size_t)(2 * i) * t.N);
}
__device__ __forceinline__ void titem_finish(const TItem& t, int lane, const float (&wv)[32], LAS float* scr) {
    const int nblk = t.N / 32, kb = t.item / nblk, nb = t.item % nblk, k0 = 64 * kb, n0 = 32 * nb;
    const float nsv = t.ns ? t.ns[n0 + (lane & 31)] : 1.0f;
    const float ksv = t.ks ? t.ks[k0 + lane] : 1.0f;
#pragma unroll
    for (int i = 0; i < 32; ++i) { const int kk = 2 * i + (lane >> 5); scr[kk * 33 + (lane & 31)] = wv[i] * nsv * lane_get(ksv, kk); }
    asm volatile("s_waitcnt lgkmcnt(0)" ::: "memory");
    const int c = lane & 7;
#pragma unroll
    for (int j = 0; j < 4; ++j) { const int n = (lane >> 3) + 8 * j; const LAS float* s = scr + (8 * c) * 33 + n;
        u32x4 o; o.x = pkbf(s[0 * 33], s[1 * 33]); o.y = pkbf(s[2 * 33], s[3 * 33]); o.z = pkbf(s[4 * 33], s[5 * 33]); o.w = pkbf(s[6 * 33], s[7 * 33]);
        *(u32x4*)(t.WT + (size_t)(t.row_off + n0 + n) * t.K + k0 + 8 * c) = o; }
    asm volatile("s_waitcnt lgkmcnt(0)" ::: "memory");
}

__global__ void __launch_bounds__(512, 2) fwd_kernel(Args a) {
    extern __shared__ __attribute__((aligned(16))) unsigned char lds_raw[];
    LAS unsigned char* lds = (LAS unsigned char*)lds_raw;
    volatile LAS unsigned* xst = (volatile LAS unsigned*)(lds + XST_OFF);
    if (threadIdx.x < 2) xst[threadIdx.x] = 0u;
    __syncthreads();
    const XcdBarrier xbar = xcd_barrier_post((unsigned*)a.ws, xst);
#define GRID_BAR() xcd_barrier(xbar)
    const int G = gridDim.x, bid = blockIdx.x;
    const int NGW = G * 8;
    const int wave = __builtin_amdgcn_readfirstlane((int)threadIdx.x >> 6);
#define PHASE_IDS int lane_ = fresh_lane_id(); const int lane = lane_, tid = wave * 64 + lane, gw = bid * 8 + wave; (void)gw; (void)tid;
    unsigned char* ws = a.ws;
    bf16_t* Wt_in0 = (bf16_t*)(ws + WS_WIN0); bf16_t* Wt_grp = (bf16_t*)(ws + WS_WGRP); bf16_t* Wt_out0 = (bf16_t*)(ws + WS_WOUT0);
    bf16_t* Wt_in1 = (bf16_t*)(ws + WS_WIN1); bf16_t* Wt_out1 = (bf16_t*)(ws + WS_WOUT1);
    float* part1 = (float*)(ws + WS_PART1); float* ssb = (float*)(ws + WS_SS); float* decb = (float*)(ws + WS_DEC);
    bf16_t* XB = (bf16_t*)(ws + WS_XB); bf16_t* BA = (bf16_t*)(ws + WS_A); bf16_t* BB = (bf16_t*)(ws + WS_B); bf16_t* BC = (bf16_t*)(ws + WS_C);

    {
        PHASE_IDS
        LAS float* scr = (LAS float*)(lds + wave * 16384);
        constexpr int I_IN0 = (DM / 64) * (4096 / 32), I_GRP1 = (512 / 64) * (512 / 32), I_OUT = (DI / 64) * (DM / 32), I_IN1 = (DM / 64) * (8192 / 32);
        constexpr int NITEMS = I_IN0 + 4 * I_GRP1 + I_OUT + I_IN1 + I_OUT;
        auto decode = [&](int it) -> TItem {
            int r = it;
            if (r < I_IN0) return TItem{a.pool_w_in, Wt_in0, a.norm_g, nullptr, DM, 4096, 0, r}; r -= I_IN0;
            if (r < 4 * I_GRP1) { const int g = r / I_GRP1; return TItem{a.pool_w_grp + (size_t)g * 512 * 512, Wt_grp, nullptr, a.pool_scale + g * 512, 512, 512, g * 512, r % I_GRP1}; } r -= 4 * I_GRP1;
            if (r < I_OUT) return TItem{a.pool_w_out, Wt_out0, nullptr, nullptr, DI, DM, 0, r}; r -= I_OUT;
            if (r < I_IN1) {
                const int n0 = 32 * (r % (8192 / 32)); int d0 = n0;
                if (n0 < 2048) d0 = 256 * (n0 >> 7) + (n0 & 127); else if (n0 < 4096) d0 = 256 * ((n0 - 2048) >> 7) + 128 + (n0 & 127);
                return TItem{a.hgrn_w_in, Wt_in1, a.norm_g + DM, nullptr, DM, 8192, d0 - n0, r}; } r -= I_IN1;
            return TItem{a.hgrn_w_out, Wt_out1, a.hgrn_norm_g, nullptr, DI, DM, 0, r};
        };
        {
            float wa[32], wb[32]; TItem ia{}, ib{};
            int it = gw; bool ha = it < NITEMS;
            if (ha) { ia = decode(it); titem_issue(ia, lane, wa); }
            while (ha) {
                const int itb = it + NGW; const bool hb = itb < NITEMS;
                if (hb) { ib = decode(itb); titem_issue(ib, lane, wb); }
                titem_finish(ia, lane, wa, scr);
                it = itb + NGW; ha = it < NITEMS;
                if (ha) { ia = decode(it); titem_issue(ia, lane, wa); }
                if (!hb) break;
                titem_finish(ib, lane, wb, scr);
            }
        }
        for (int m0 = gw * 8; m0 < M; m0 += NGW * 8) {
            f32x4 v[8][4]; float s[8];
#pragma unroll
            for (int r = 0; r < 8; ++r) { const f32x4* xr = (const f32x4*)(a.x + (size_t)(m0 + r) * DM) + lane;
#pragma unroll
                for (int j = 0; j < 4; ++j) v[r][j] = __builtin_nontemporal_load(xr + 64 * j); }
#pragma unroll
            for (int r = 0; r < 8; ++r) { s[r] = 0.f;
#pragma unroll
                for (int j = 0; j < 4; ++j) s[r] += (v[r][j][0] * v[r][j][0] + v[r][j][1] * v[r][j][1]) + (v[r][j][2] * v[r][j][2] + v[r][j][3] * v[r][j][3]); }
#pragma unroll
            for (int o = 1; o < 64; o <<= 1) {
#pragma unroll
                for (int r = 0; r < 8; ++r) s[r] += xor_get(s[r], lane, o); }
#pragma unroll
            for (int r = 0; r < 8; ++r) { const float rstd = 1.0f / sqrtf(s[r] * (1.0f / DM) + EPS);
                unsigned long long* o8 = (unsigned long long*)(XB + (size_t)(m0 + r) * DM) + lane;
#pragma unroll
                for (int j = 0; j < 4; ++j) o8[64 * j] = (unsigned long long)pkbf(v[r][j][0] * rstd, v[r][j][1] * rstd) | ((unsigned long long)pkbf(v[r][j][2] * rstd, v[r][j][3] * rstd) << 32); }
        }
    }
    GRID_BAR();

    {
        pg8::Gemm g{XB, Wt_in0, DM, DM, DM, 0}; pg8::StaticOrder S; S.init(M, 4096, G, bid);
        pg8::EpiP1 E{BA, BB};
        pg8::gemm_phase<pg8::EpiP1>(lds, g, S, E, wave);
    }
    GRID_BAR();

    {
        PHASE_IDS
        constexpr int RUN = 64;
        const int nruns = (M / RUN) * (DI / 8);
        for (int idx = bid * 512 + tid; idx < nruns; idx += G * 512) {
            const int cgp = idx & 255, run = idx >> 8, grp = cgp >> 6, w = 2 << grp;
            const int m0 = run * RUN, t0 = m0 & (SEQ - 1);
            const bf16_t* vp = BA + (size_t)m0 * DI + cgp * 8; bf16_t* pp = BC + (size_t)m0 * DI + cgp * 8;
            float sum[8];
#pragma unroll
            for (int j = 0; j < 8; ++j) sum[j] = 0.f;
            if (t0 > 0) for (int k = 1; k < w; ++k) { const u32x4 vv = *(const u32x4*)(vp - (size_t)k * DI);
                sum[0] += bf_lo(vv.x); sum[1] += bf_hi(vv.x); sum[2] += bf_lo(vv.y); sum[3] += bf_hi(vv.y); sum[4] += bf_lo(vv.z); sum[5] += bf_hi(vv.z); sum[6] += bf_lo(vv.w); sum[7] += bf_hi(vv.w); }
            for (int i0 = 0; i0 < RUN; i0 += 8) {
                u32x4 vin[8], vout[8];
#pragma unroll
                for (int j = 0; j < 8; ++j) vin[j] = *(const u32x4*)(vp + (size_t)(i0 + j) * DI);
#pragma unroll
                for (int j = 0; j < 8; ++j) { const int i = i0 + j; vout[j] = (t0 + i + 1 >= w) ? *(const u32x4*)(vp + (size_t)(i + 1 - w) * DI) : (u32x4){0u, 0u, 0u, 0u}; }
#pragma unroll
                for (int j = 0; j < 8; ++j) {
                    const int i = i0 + j, t = t0 + i;
                    const u32x4 vv = vin[j];
                    float x[8] = {bf_lo(vv.x), bf_hi(vv.x), bf_lo(vv.y), bf_hi(vv.y), bf_lo(vv.z), bf_hi(vv.z), bf_lo(vv.w), bf_hi(vv.w)};
#pragma unroll
                    for (int c = 0; c < 8; ++c) sum[c] += x[c];
                    const int cnt = (t + 1) < w ? (t + 1) : w; const float inv = 1.0f / (float)cnt;
                    u32x4 o; o.x = pkbf(sum[0] * inv - x[0], sum[1] * inv - x[1]); o.y = pkbf(sum[2] * inv - x[2], sum[3] * inv - x[3]);
                    o.z = pkbf(sum[4] * inv - x[4], sum[5] * inv - x[5]); o.w = pkbf(sum[6] * inv - x[6], sum[7] * inv - x[7]);
                    __builtin_nontemporal_store(o, (u32x4*)(pp + (size_t)i * DI));
                    const u32x4 uu = vout[j];
                    sum[0] -= bf_lo(uu.x); sum[1] -= bf_hi(uu.x); sum[2] -= bf_lo(uu.y); sum[3] -= bf_hi(uu.y); sum[4] -= bf_lo(uu.z); sum[5] -= bf_hi(uu.z); sum[6] -= bf_lo(uu.w); sum[7] -= bf_hi(uu.w);
                }
            }
        }
    }
    GRID_BAR();

    {
        pg8::Gemm g{BC, Wt_grp, DI, 512, 512, 2}; pg8::StaticOrder S; S.init(M, DI, G, bid);
        pg8::EpiP2 E{BB};
        pg8::gemm_phase<pg8::EpiP2>(lds, g, S, E, wave);
    }
    GRID_BAR();

    {
        pg8::Gemm g{BB, Wt_out0, DI, DI, DI, 0}; pg8::StaticOrder S; S.init(M, DM, G, bid);
        pg8::EpiRes<true, false> E{a.x, nullptr, XB, part1};
        pg8::gemm_phase<pg8::EpiRes<true, false>>(lds, g, S, E, wave);
    }
    GRID_BAR();

    {
        pg8::Gemm g{XB, Wt_in1, DM, DM, DM, 0}; pg8::StaticOrder S; S.init(M, 6144, G, bid);
        pg8::EpiP4 E{BA, BB, BC, decb, part1, a.hgrn_lb};
        pg8::gemm_phase<pg8::EpiP4>(lds, g, S, E, wave);
    }
    GRID_BAR();

    scan::phase(lds, BA, BB, BC, decb, ssb, bid, G, wave);
    GRID_BAR();

    {
        pg8::Gemm g{XB, Wt_in1 + (size_t)6144 * DM, DM, DM, DM, 0}; pg8::StaticOrder S; S.init(M, DI, G, bid);
        pg8::EpiP5b E{BC, part1, ssb};
        pg8::gemm_phase<pg8::EpiP5b>(lds, g, S, E, wave);
    }
    GRID_BAR();

    {
        pg8::Gemm g{BC, Wt_out1, DI, DI, DI, 0}; pg8::StaticOrder S; S.init(M, DM, G, bid);
        pg8::EpiFinal E{XB, a.out, a.final_g, (float*)(ws + WS_X), (unsigned*)(ws + WS_CNT)};
        pg8::gemm_phase<pg8::EpiFinal>(lds, g, S, E, wave);
    }
}

extern "C" void kernel_launch(void* const* d_in, const int* in_sizes, int n_in, void* d_out, int out_size, void* d_ws, size_t ws_size, hipStream_t stream) {
    static int grid = 0;
    if (grid == 0) {
        if (n_in != 11 || in_sizes[0] != M * DM || out_size != M * DM || ws_size < WS_END) { fprintf(stderr, "kernel_launch: unexpected shapes (n_in %d in0 %d out %d ws %zu)\n", n_in, n_in > 0 ? in_sizes[0] : -1, out_size, ws_size); grid = -1; return; }
        int dev = 0, cus = 0, per = 0;
        if (hipGetDevice(&dev) != hipSuccess || hipDeviceGetAttribute(&cus, hipDeviceAttributeMultiprocessorCount, dev) != hipSuccess) { grid = -1; return; }
        if (hipFuncSetAttribute((const void*)fwd_kernel, hipFuncAttributeMaxDynamicSharedMemorySize, LDS_BYTES) != hipSuccess) { fprintf(stderr, "kernel_launch: hipFuncSetAttribute failed\n"); grid = -1; return; }
        if (hipOccupancyMaxActiveBlocksPerMultiprocessor(&per, (const void*)fwd_kernel, 512, LDS_BYTES) != hipSuccess || per < 1) { fprintf(stderr, "kernel_launch: occupancy query says %d\n", per); (void)hipGetLastError(); grid = -1; return; }
        grid = cus;
        fprintf(stderr, "kernel_launch: cus %d per_cu %d grid %d\n", cus, per, grid);
    }
    if (grid < 0) return;
    if (hipMemsetAsync(d_ws, 0, 32768, stream) != hipSuccess) { fprintf(stderr, "kernel_launch: hipMemsetAsync failed\n"); return; }
    Args a{};
    a.x = (const float*)d_in[0]; a.norm_g = (const float*)d_in[1]; a.pool_w_in = (const float*)d_in[2]; a.pool_w_grp = (const float*)d_in[3];
    a.pool_scale = (const float*)d_in[4]; a.pool_w_out = (const float*)d_in[5]; a.hgrn_w_in = (const float*)d_in[6]; a.hgrn_lb = (const float*)d_in[7];
    a.hgrn_norm_g = (const float*)d_in[8]; a.hgrn_w_out = (const float*)d_in[9]; a.final_g = (const float*)d_in[10];
    a.out = (float*)d_out; a.ws = (unsigned char*)d_ws;
    void* args[] = {&a};
    hipError_t e = hipLaunchCooperativeKernel((void*)fwd_kernel, dim3(grid), dim3(512), args, LDS_BYTES, stream);
    if (e != hipSuccess) fprintf(stderr, "kernel_launch: cooperative launch failed: %s (grid %d)\n", hipGetErrorString(e), grid);
}
```

```cpp
#include <hip/hip_runtime.h>
#include <cstdio>
#include <cstdint>

#define LAS __attribute__((address_space(3)))
typedef unsigned short bf16_t;
typedef short bf16x8 __attribute__((ext_vector_type(8)));
typedef float f32x4 __attribute__((ext_vector_type(4)));
typedef float f32x2 __attribute__((ext_vector_type(2)));
typedef unsigned u32x4 __attribute__((ext_vector_type(4)));
typedef unsigned u32x2 __attribute__((ext_vector_type(2)));

constexpr int DM = 1024, BATCH = 8, SEQ = 4096, DI = 2048, M = BATCH * SEQ;
constexpr int NHEAD = 16, HD = 128;
constexpr float EPS = 1e-6f;
constexpr size_t MiB = 1u << 20;
constexpr size_t WS_WIN0 = 2 * MiB;
constexpr size_t WS_WGRP = 10 * MiB;
constexpr size_t WS_WOUT0 = 12 * MiB;
constexpr size_t WS_WIN1 = 16 * MiB;
constexpr size_t WS_WOUT1 = 32 * MiB;
constexpr size_t WS_PART1 = 36 * MiB;
constexpr size_t WS_INVR = 38 * MiB;
constexpr size_t WS_CNT = 16384;
constexpr size_t WS_X = 40 * MiB;
constexpr size_t WS_DEC = 44 * MiB;
constexpr size_t WS_SS = 112 * MiB;
constexpr size_t WS_XB = 48 * MiB;
constexpr size_t WS_A = 128 * MiB;
constexpr size_t WS_B = 256 * MiB;
constexpr size_t WS_C = 384 * MiB;
constexpr size_t WS_END = 512 * MiB;
constexpr int LDS_BYTES = 163840;
constexpr unsigned XST_OFF = 163840u - 256u;

typedef __bf16 bf2_t __attribute__((ext_vector_type(2)));
__device__ __forceinline__ unsigned pkbf(float lo, float hi) { f32x2 v = {lo, hi}; return __builtin_bit_cast(unsigned, __builtin_convertvector(v, bf2_t)); }
__device__ __forceinline__ float bf_lo(unsigned w) { return __builtin_bit_cast(float, w << 16); }
__device__ __forceinline__ float bf_hi(unsigned w) { return __builtin_bit_cast(float, w & 0xffff0000u); }
__device__ __forceinline__ float silu_f(float x) { return x * __builtin_amdgcn_rcpf(1.0f + __builtin_amdgcn_exp2f(-1.44269504089f * x)); }
__device__ __forceinline__ float silu_pre(float t) { return t * __builtin_amdgcn_rcpf(1.0f + __builtin_amdgcn_exp2f(t)); }
constexpr float NEG_LOG2E = -1.44269504089f, NEG_LN2 = -0.69314718056f;
__device__ __forceinline__ int fresh_lane_id() { int l; asm volatile("v_mbcnt_lo_u32_b32 %0, -1, 0\n\tv_mbcnt_hi_u32_b32 %0, -1, %0" : "=v"(l)); return l; }
__device__ __forceinline__ float lane_get(float v, int src_lane) { return __builtin_bit_cast(float, __builtin_amdgcn_ds_bpermute(src_lane << 2, __builtin_bit_cast(int, v))); }
__device__ __forceinline__ float xor_get(float v, int lane, int m) { return lane_get(v, lane ^ m); }
__device__ __forceinline__ float wave_sum(float v, int lane) {
#pragma unroll
    for (int o = 1; o < 64; o <<= 1) v += xor_get(v, lane, o);
    return v;
}

namespace pg8 {
constexpr int BM = 256, BK = 64, HALF = 128, HTB = HALF * BK * 2, NXCD = 8, WGM = 4;
__host__ __device__ __forceinline__ int lds_byte(int r, int c) { const int st = (r >> 4) * 2 + (c >> 5), rr = r & 15, cc = c & 31, ob = rr * 64 + cc * 2; return st * 1024 + (ob ^ (((ob >> 9) & 1) << 5)); }
__host__ __device__ __forceinline__ void stage_rc(int b, int& R, int& C) { const int st = b / 1024, sb = b % 1024, swz = sb ^ (((sb >> 9) & 1) << 5); R = (st >> 1) * 16 + swz / 64; C = (st & 1) * 32 + (swz % 64) / 2; }
__host__ __device__ __forceinline__ int perm32(int rho) { const int n = rho >> 4, i = rho & 15; return 8 * (i >> 2) + 4 * n + (i & 3); }

struct Unit { int pm, pn; };
struct Gemm { const bf16_t* A; const bf16_t* Bt; int lda, ldb, K, grp_tiles, grp_b; };

struct StaticOrder {
    int nM, nN, nwg, G, c;
    __host__ __device__ void init(int M_, int N_, int G_, int c_) { nM = M_ / BM; nN = N_ / BM; nwg = nM * nN; G = G_; c = c_; }
    __host__ __device__ bool next(int i, Unit& u) const {
        const long L = (long)i * G + c; if (L >= nwg) return false;
        int wgid = (int)L; { const int q = nwg / NXCD, r = nwg % NXCD, xcd = wgid % NXCD, off = wgid / NXCD; wgid = (xcd < r ? xcd * (q + 1) : r * (q + 1) + (xcd - r) * q) + off; }
        const int nig = WGM * nN, gid = wgid / nig, fm = gid * WGM, gsz = (nM - fm) < WGM ? (nM - fm) : WGM;
        u.pm = fm + ((wgid % nig) % gsz); u.pn = (wgid % nig) / gsz; return true;
    }
};


__device__ __forceinline__ void zero_acc(f32x4 (&acc)[2][2][4][2]) {
#pragma unroll
    for (int a = 0; a < 2; ++a)
#pragma unroll
        for (int b = 0; b < 2; ++b)
#pragma unroll
            for (int m = 0; m < 4; ++m)
#pragma unroll
                for (int n = 0; n < 2; ++n) acc[a][b][m][n] = (f32x4){0.f, 0.f, 0.f, 0.f};
}
template <class Epi, bool ALIGN_EPI = true, bool SP2 = true>
__device__ __forceinline__ void gemm_phase(LAS unsigned char* lds, const Gemm g, const StaticOrder& S, const Epi& E, const int wid) {
    int lane_ = fresh_lane_id();
    int lane = lane_, tid = wid * 64 + lane, fr = lane & 15, fq = lane >> 4; const int wr = wid >> 2, wc = wid & 3;
    const int K = g.K, nt = K / BK;
    unsigned voffA[2], voffB[2]; int aoff, boff;
#define PG8_LANE_STATE() do { _Pragma("unroll") for (int i = 0; i < 2; ++i) { int R, C; stage_rc(tid * 16 + i * 8192, R, C); const int Rb = Epi::PERM ? ((R & ~31) + perm32(R & 31)) : R; \
        voffA[i] = (unsigned)(R * g.lda + C) * 2u; voffB[i] = (unsigned)(Rb * g.ldb + C) * 2u; } \
        aoff = lds_byte(wr * 64 + fr, fq * 8); boff = lds_byte(wc * 32 + fr, fq * 8); } while (0)
    PG8_LANE_STATE();
    const size_t kstep = (size_t)(BK * 2);
    const size_t hstepA = (size_t)HALF * g.lda * 2, hstepB = (size_t)HALF * g.ldb * 2;
    const size_t tstepA = 2 * hstepA, tstepB = 2 * hstepB;
    const unsigned ldsw = (unsigned)wid * 1024u;
#define PG8_SA(b, h) (((b) * 2 + (h)) * HTB)
#define PG8_SB(b, h) ((4 + (b) * 2 + (h)) * HTB)
#define PG8_STAGE(bufoff, gbase, voff) do { _Pragma("unroll") for (int _i = 0; _i < 2; ++_i) \
        __builtin_amdgcn_global_load_lds((const unsigned*)((const char*)(gbase) + (voff)[_i]), (LAS unsigned*)(lds + (bufoff) + ldsw + _i * 8192), 16, 0, 0); } while (0)
#define PG8_LDA(dst, b, h) do { _Pragma("unroll") for (int m = 0; m < 4; ++m) _Pragma("unroll") for (int k = 0; k < 2; ++k) dst[m][k] = *(const LAS bf16x8*)(lds + PG8_SA(b, h) + aoff + m * 2048 + k * 1024); } while (0)
#define PG8_LDB(dst, b, h) do { _Pragma("unroll") for (int n = 0; n < 2; ++n) _Pragma("unroll") for (int k = 0; k < 2; ++k) dst[n][k] = *(const LAS bf16x8*)(lds + PG8_SB(b, h) + boff + n * 2048 + k * 1024); } while (0)
#define PG8_MMA(ai, bj, At, Bt) do { __builtin_amdgcn_s_setprio(1); _Pragma("unroll") for (int m = 0; m < 4; ++m) _Pragma("unroll") for (int n = 0; n < 2; ++n) _Pragma("unroll") for (int k = 0; k < 2; ++k) \
        acc[ai][bj][m][n] = __builtin_amdgcn_mfma_f32_16x16x32_bf16(Bt[n][k], At[m][k], acc[ai][bj][m][n], 0, 0, 0); __builtin_amdgcn_s_setprio(0); } while (0)
#define PG8_WAIT_V(n) asm volatile("s_waitcnt vmcnt(" #n ")" ::: "memory")
#define PG8_WAIT_L(n) asm volatile("s_waitcnt lgkmcnt(" #n ")" ::: "memory")
#define PG8_BAR __builtin_amdgcn_s_barrier()
#define PG8_SCHED __builtin_amdgcn_sched_barrier(0)
#define PG8_ABASE(u) ((const char*)g.A + (size_t)(u).pm * tstepA + (g.grp_tiles ? (size_t)((u).pn / g.grp_tiles) * (size_t)K * 2 : (size_t)0))
#define PG8_BBASE(u) ((const char*)g.Bt + (size_t)(u).pn * tstepB + (g.grp_b ? (size_t)((u).pm / g.grp_b) * (size_t)K * 2 : (size_t)0))
    Unit cur, nxt; int ui = 0;
    E.prologue(S, lds, tid);
    if (!S.next(0, cur)) return;
    f32x4 acc[2][2][4][2];
    E.init_acc(acc, cur, wr, wc, fr, fq);
    bf16x8 At[4][2], B0[2][2], B1[2][2];
    const char* cA = PG8_ABASE(cur); const char* cB = PG8_BBASE(cur);
    if constexpr (SP2) {
        PG8_STAGE(PG8_SB(0, 0), cB, voffB); PG8_STAGE(PG8_SB(0, 1), cB + hstepB, voffB); PG8_STAGE(PG8_SA(0, 0), cA, voffA); PG8_STAGE(PG8_SA(0, 1), cA + hstepA, voffA);
        if (wr == 1) PG8_BAR;
        PG8_WAIT_V(2); PG8_BAR;
        PG8_STAGE(PG8_SB(1, 0), cB + kstep, voffB); PG8_STAGE(PG8_SA(1, 0), cA + kstep, voffA); PG8_STAGE(PG8_SB(1, 1), cB + hstepB + kstep, voffB);
        PG8_WAIT_V(6); PG8_BAR;
    } else {
        PG8_STAGE(PG8_SB(0, 0), cB, voffB); PG8_STAGE(PG8_SA(0, 0), cA, voffA); PG8_STAGE(PG8_SB(0, 1), cB + hstepB, voffB); PG8_STAGE(PG8_SA(0, 1), cA + hstepA, voffA);
        if (wr == 1) PG8_BAR;
        PG8_WAIT_V(4); PG8_BAR;
        PG8_STAGE(PG8_SB(1, 0), cB + kstep, voffB); PG8_STAGE(PG8_SA(1, 0), cA + kstep, voffA); PG8_STAGE(PG8_SB(1, 1), cB + hstepB + kstep, voffB);
        PG8_WAIT_V(6); PG8_BAR;
    }
    for (;;) {
        const bool has_next = S.next(ui + 1, nxt);
        const char* nA = has_next ? PG8_ABASE(nxt) : cA; const char* nB = has_next ? PG8_BBASE(nxt) : cB;
        for (int t = 0; t < nt; t += 2) {
            const bool last = (t == nt - 2);
            const char* a1 = cA + (size_t)(t + 1) * kstep;
            const char* a2 = last ? nA : cA + (size_t)(t + 2) * kstep; const char* b2 = last ? nB : cB + (size_t)(t + 2) * kstep;
            const char* a3 = a2 + kstep; const char* b3 = b2 + kstep;
            if constexpr (SP2) {
            PG8_LDB(B0, 0, 0); PG8_LDB(B1, 0, 1); PG8_SCHED; PG8_LDA(At, 0, 0); PG8_STAGE(PG8_SA(1, 1), a1 + hstepA, voffA);
            PG8_WAIT_V(8); PG8_WAIT_L(0); PG8_BAR; PG8_MMA(0, 0, At, B0); PG8_MMA(0, 1, At, B1); PG8_BAR; PG8_SCHED;
            PG8_LDA(At, 0, 1); PG8_STAGE(PG8_SB(0, 0), b2, voffB); PG8_STAGE(PG8_SB(0, 1), b2 + hstepB, voffB); PG8_STAGE(PG8_SA(0, 0), a2, voffA);
            PG8_WAIT_V(8); PG8_WAIT_L(0); PG8_BAR; PG8_MMA(1, 0, At, B0); PG8_MMA(1, 1, At, B1); PG8_BAR; PG8_SCHED;
            PG8_LDB(B0, 1, 0); PG8_LDB(B1, 1, 1); PG8_SCHED; PG8_LDA(At, 1, 0); PG8_STAGE(PG8_SA(0, 1), a2 + hstepA, voffA);
            PG8_WAIT_V(8); PG8_WAIT_L(0); PG8_BAR; PG8_MMA(0, 0, At, B0); PG8_MMA(0, 1, At, B1); PG8_BAR; PG8_SCHED;
            PG8_LDA(At, 1, 1); PG8_STAGE(PG8_SB(1, 0), b3, voffB); PG8_STAGE(PG8_SB(1, 1), b3 + hstepB, voffB); PG8_STAGE(PG8_SA(1, 0), a3, voffA);
            PG8_WAIT_V(8); PG8_WAIT_L(0); PG8_BAR; PG8_MMA(1, 0, At, B0); PG8_MMA(1, 1, At, B1); PG8_BAR; PG8_SCHED;
            } else {
            PG8_LDB(B0, 0, 0); PG8_SCHED; PG8_LDA(At, 0, 0); PG8_STAGE(PG8_SA(1, 1), a1 + hstepA, voffA);
            PG8_WAIT_L(8); PG8_BAR; PG8_WAIT_L(0); PG8_MMA(0, 0, At, B0); PG8_BAR; PG8_SCHED;
            PG8_LDB(B1, 0, 1); PG8_STAGE(PG8_SB(0, 0), b2, voffB);
            PG8_BAR; PG8_WAIT_L(0); PG8_MMA(0, 1, At, B1); PG8_BAR;
            PG8_LDA(At, 0, 1); PG8_STAGE(PG8_SA(0, 0), a2, voffA);
            PG8_BAR; PG8_WAIT_L(0); PG8_MMA(1, 0, At, B0); PG8_BAR; PG8_SCHED;
            PG8_STAGE(PG8_SB(0, 1), b2 + hstepB, voffB);
            PG8_WAIT_V(6); PG8_BAR; PG8_MMA(1, 1, At, B1); PG8_BAR;
            PG8_LDB(B0, 1, 0); PG8_SCHED; PG8_LDA(At, 1, 0); PG8_STAGE(PG8_SA(0, 1), a2 + hstepA, voffA);
            PG8_WAIT_L(8); PG8_BAR; PG8_WAIT_L(0); PG8_MMA(0, 0, At, B0); PG8_BAR; PG8_SCHED;
            PG8_LDB(B1, 1, 1); PG8_STAGE(PG8_SB(1, 0), b3, voffB);
            PG8_BAR; PG8_WAIT_L(0); PG8_MMA(0, 1, At, B1); PG8_BAR;
            PG8_LDA(At, 1, 1); PG8_STAGE(PG8_SA(1, 0), a3, voffA);
            PG8_BAR; PG8_WAIT_L(0); PG8_MMA(1, 0, At, B0); PG8_BAR; PG8_SCHED;
            PG8_STAGE(PG8_SB(1, 1), b3 + hstepB, voffB);
            PG8_WAIT_V(6); PG8_BAR; PG8_MMA(1, 1, At, B1); PG8_BAR;
            }
        }
        if constexpr (ALIGN_EPI) { if (wr == 0) PG8_BAR; }
        if constexpr (!Epi::AFTER_DRAIN) E(acc, cur, wr, wc, fr, fq, lds, ui);
        if (!has_next) break;
        cur = nxt; cA = nA; cB = nB; ++ui;
        asm volatile("" : "+v"(lane)); tid = wid * 64 + lane; fr = lane & 15; fq = lane >> 4; PG8_LANE_STATE();
        E.init_acc(acc, cur, wr, wc, fr, fq);
        if constexpr (ALIGN_EPI) { if (wr == 1) PG8_BAR; }
    }
    PG8_WAIT_V(0);
    if constexpr (!ALIGN_EPI) { if (wr == 0) PG8_BAR; }
    PG8_BAR;
    if constexpr (Epi::AFTER_DRAIN) E.fused(acc, cur, wr, wc, fr, fq, lds, tid);
#undef PG8_SA
#undef PG8_SB
#undef PG8_STAGE
#undef PG8_LDA
#undef PG8_LDB
#undef PG8_MMA
#undef PG8_WAIT_V
#undef PG8_WAIT_L
#undef PG8_BAR
#undef PG8_SCHED
#undef PG8_ABASE
#undef PG8_LANE_STATE
#undef PG8_BBASE
}

constexpr unsigned TAB_OFF = 131072u;
__device__ __forceinline__ void row_scan_mul4(float& a, float& b, float& c, float& d) {
#define PG8_SCAN_STEP(n) "v_mul_f32_dpp %0, %0, %0 row_shr:" #n " row_mask:0xf bank_mask:0xf\n" "v_mul_f32_dpp %1, %1, %1 row_shr:" #n " row_mask:0xf bank_mask:0xf\n" \
                         "v_mul_f32_dpp %2, %2, %2 row_shr:" #n " row_mask:0xf bank_mask:0xf\n" "v_mul_f32_dpp %3, %3, %3 row_shr:" #n " row_mask:0xf bank_mask:0xf\n"
    asm("s_nop 1\n" PG8_SCAN_STEP(1) PG8_SCAN_STEP(2) PG8_SCAN_STEP(4) PG8_SCAN_STEP(8) : "+v"(a), "+v"(b), "+v"(c), "+v"(d));
#undef PG8_SCAN_STEP
}
__device__ __forceinline__ void row_scan_add4(float& a, float& b, float& c, float& d) {
#define PG8_SCAN_STEP(n) "v_add_f32_dpp %0, %0, %0 row_shr:" #n " row_mask:0xf bank_mask:0xf\n" "v_add_f32_dpp %1, %1, %1 row_shr:" #n " row_mask:0xf bank_mask:0xf\n" \
                         "v_add_f32_dpp %2, %2, %2 row_shr:" #n " row_mask:0xf bank_mask:0xf\n" "v_add_f32_dpp %3, %3, %3 row_shr:" #n " row_mask:0xf bank_mask:0xf\n"
    asm("s_nop 1\n" PG8_SCAN_STEP(1) PG8_SCAN_STEP(2) PG8_SCAN_STEP(4) PG8_SCAN_STEP(8) : "+v"(a), "+v"(b), "+v"(c), "+v"(d));
#undef PG8_SCAN_STEP
}
__device__ __forceinline__ float row_bcast15(float v) { float r; asm("s_nop 1\n v_mov_b32_dpp %0, %1 row_newbcast:15 row_mask:0xf bank_mask:0xf" : "=v"(r) : "v"(v)); return r; }
template <int W> __device__ __forceinline__ float window_sum(float p, float pp, float c) {
    if constexpr (W == 16) return c - pp;
    else { float w = c;
        if constexpr (W == 8) asm("s_nop 1\n v_subrev_f32_dpp %0, %1, %2 row_shl:8 row_mask:0xf bank_mask:0xf\n v_subrev_f32_dpp %0, %3, %3 row_shr:8 row_mask:0xf bank_mask:0xf" : "+v"(w) : "v"(pp), "v"(c), "v"(p));
        else if constexpr (W == 4) asm("s_nop 1\n v_subrev_f32_dpp %0, %1, %2 row_shl:12 row_mask:0xf bank_mask:0xf\n v_subrev_f32_dpp %0, %3, %3 row_shr:4 row_mask:0xf bank_mask:0xf" : "+v"(w) : "v"(pp), "v"(c), "v"(p));
        else asm("s_nop 1\n v_subrev_f32_dpp %0, %1, %2 row_shl:14 row_mask:0xf bank_mask:0xf\n v_subrev_f32_dpp %0, %3, %3 row_shr:2 row_mask:0xf bank_mask:0xf" : "+v"(w) : "v"(pp), "v"(c), "v"(p));
        return w; }
}
#define PG8_POOL_STEP(SHL, SHR) \
    asm("s_nop 1\n" \
        "v_add_f32_dpp %0, %8, %4 row_shl:" #SHL " row_mask:0xf bank_mask:0xf bound_ctrl:1\n" "v_add_f32_dpp %1, %9, %5 row_shl:" #SHL " row_mask:0xf bank_mask:0xf bound_ctrl:1\n" \
        "v_add_f32_dpp %2, %10, %6 row_shl:" #SHL " row_mask:0xf bank_mask:0xf bound_ctrl:1\n" "v_add_f32_dpp %3, %11, %7 row_shl:" #SHL " row_mask:0xf bank_mask:0xf bound_ctrl:1\n" \
        "v_add_f32_dpp %0, %4, %0 row_shr:" #SHR " row_mask:0xf bank_mask:0xf\n" "v_add_f32_dpp %1, %5, %1 row_shr:" #SHR " row_mask:0xf bank_mask:0xf\n" \
        "v_add_f32_dpp %2, %6, %2 row_shr:" #SHR " row_mask:0xf bank_mask:0xf\n" "v_add_f32_dpp %3, %7, %3 row_shr:" #SHR " row_mask:0xf bank_mask:0xf" \
        : "=&v"(a[0]), "=&v"(a[1]), "=&v"(a[2]), "=&v"(a[3]) : "v"(b[0]), "v"(b[1]), "v"(b[2]), "v"(b[3]), "v"(bp[0]), "v"(bp[1]), "v"(bp[2]), "v"(bp[3]))
template <int K> __device__ __forceinline__ void pool_step4(float (&a)[4], const float (&b)[4], const float (&bp)[4]) {
    if constexpr (K == 1) PG8_POOL_STEP(15, 1); else if constexpr (K == 2) PG8_POOL_STEP(14, 2); else PG8_POOL_STEP(12, 4);
}
#undef PG8_POOL_STEP
#define PG8_HALO_STEP(SHR) \
    asm("s_nop 1\n" "v_add_f32_dpp %0, %4, %4 row_shr:" #SHR " row_mask:0xf bank_mask:0xf bound_ctrl:1\n" "v_add_f32_dpp %1, %5, %5 row_shr:" #SHR " row_mask:0xf bank_mask:0xf bound_ctrl:1\n" \
        "v_add_f32_dpp %2, %6, %6 row_shr:" #SHR " row_mask:0xf bank_mask:0xf bound_ctrl:1\n" "v_add_f32_dpp %3, %7, %7 row_shr:" #SHR " row_mask:0xf bank_mask:0xf bound_ctrl:1" \
        : "=&v"(a[0]), "=&v"(a[1]), "=&v"(a[2]), "=&v"(a[3]) : "v"(b[0]), "v"(b[1]), "v"(b[2]), "v"(b[3]))
template <int K> __device__ __forceinline__ void halo_step4(float (&a)[4], const float (&b)[4]) { if constexpr (K == 1) PG8_HALO_STEP(1); else PG8_HALO_STEP(2); }
#undef PG8_HALO_STEP
struct EpiFold {
    static constexpr bool PERM = true, AFTER_DRAIN = false;
    __device__ __forceinline__ void init_acc(f32x4 (&acc)[2][2][4][2], const Unit&, int, int, int, int) const { zero_acc(acc); }
    __device__ __forceinline__ void prologue(const StaticOrder&, LAS unsigned char*, int) const {}
    bf16_t* WT;
    __device__ __forceinline__ void operator()(f32x4 (&acc)[2][2][4][2], const Unit& u, int wr, int wc, int fr, int fq, LAS unsigned char* lds, int ui) const {
        const unsigned k0 = (unsigned)(u.pn * BM + wc * 32 + 8 * fq);
#pragma unroll
        for (int ai = 0; ai < 2; ++ai)
#pragma unroll
            for (int m = 0; m < 4; ++m) { const unsigned c = (unsigned)(u.pm * BM + ai * HALF + wr * 64 + m * 16 + fr), drow = (c >> 7) * 256u + (c & 127u);
#pragma unroll
                for (int bj = 0; bj < 2; ++bj) { const f32x4 v0 = acc[ai][bj][m][0], v1 = acc[ai][bj][m][1];
                    u32x4 w; w.x = pkbf(v0[0], v0[1]); w.y = pkbf(v0[2], v0[3]); w.z = pkbf(v1[0], v1[1]); w.w = pkbf(v1[2], v1[3]);
                    *(u32x4*)(WT + (size_t)drow * DM + k0 + bj * HALF) = w; } }
    }
};
constexpr unsigned HALO_TILE = 4 * 64 * 16;
struct EpiP1 {
    static constexpr bool PERM = true, AFTER_DRAIN = false;
    __device__ __forceinline__ void init_acc(f32x4 (&acc)[2][2][4][2], const Unit&, int, int, int, int) const { zero_acc(acc); }
    __device__ __forceinline__ void prologue(const StaticOrder&, LAS unsigned char*, int) const {}
    bf16_t* Z; unsigned char* HALO; unsigned char* SG0;
    template <int W> __device__ __forceinline__ void tile(f32x4 (&acc)[2][2][4][2], const Unit& u, int wr, int wc, int fr, int fq, LAS unsigned char* lds) const {
        const unsigned lane = (unsigned)(fq * 16 + fr);
        LAS unsigned char* HX = lds + TAB_OFF;
        const unsigned sideofs = (unsigned)(u.pm * 16 + u.pn) * HALO_TILE + ((unsigned)wc * 64u + lane) * 16u;
#pragma unroll
        for (int ai = 0; ai < 2; ++ai) {
            u32x4 h; h.x = pkbf(acc[ai][0][3][0][0], acc[ai][0][3][0][1]); h.y = pkbf(acc[ai][0][3][0][2], acc[ai][0][3][0][3]); h.z = pkbf(acc[ai][0][3][1][0], acc[ai][0][3][1][1]); h.w = pkbf(acc[ai][0][3][1][2], acc[ai][0][3][1][3]);
            const int sl = 2 * ai + wr;
            if (sl < 3) *(LAS u32x4*)(HX + ((unsigned)(sl * 4 + wc) * 64u + lane) * 16u) = h;
            else *(u32x4*)(HALO + sideofs) = h;
        }
        asm volatile("s_waitcnt lgkmcnt(0)" ::: "memory"); __builtin_amdgcn_s_barrier(); asm volatile("" ::: "memory");
        const bool seq0 = (u.pm & 15) == 0;
        const float invw = 1.0f / (float)W;
        const float inv00 = seq0 ? 1.0f / (float)((fr + 1) < W ? (fr + 1) : W) : invw;
        const unsigned zofs = ((unsigned)(u.pm * BM + wr * 64 + fr) * DI + (unsigned)(u.pn * HD + wc * 32 + 8 * fq)) * 2u;
#pragma unroll
        for (int ai = 0; ai < 2; ++ai) {
            const int sl = 2 * ai + wr;
            float pp[2][4], pt[2][4];
            if (sl > 0) {
                const u32x4 h = *(const LAS u32x4*)(HX + ((unsigned)((sl - 1) * 4 + wc) * 64u + lane) * 16u);
                pp[0][0] = bf_lo(h.x); pp[0][1] = bf_hi(h.x); pp[0][2] = bf_lo(h.y); pp[0][3] = bf_hi(h.y); pp[1][0] = bf_lo(h.z); pp[1][1] = bf_hi(h.z); pp[1][2] = bf_lo(h.w); pp[1][3] = bf_hi(h.w);
#pragma unroll
                for (int n = 0; n < 2; ++n) { row_scan_add4(pp[n][0], pp[n][1], pp[n][2], pp[n][3]);
#pragma unroll
                    for (int j = 0; j < 4; ++j) pt[n][j] = row_bcast15(pp[n][j]); }
            } else {
#pragma unroll
                for (int n = 0; n < 2; ++n)
#pragma unroll
                    for (int j = 0; j < 4; ++j) { pp[n][j] = 0.f; pt[n][j] = 0.f; }
            }
#pragma unroll
            for (int m = 0; m < 4; ++m) {
                const float inv = (sl == 0 && m == 0) ? inv00 : invw;
                float z[2][4], sgv[2][4];
#pragma unroll
                for (int n = 0; n < 2; ++n) {
                    float p[4];
#pragma unroll
                    for (int j = 0; j < 4; ++j) p[j] = acc[ai][0][m][n][j];
                    row_scan_add4(p[0], p[1], p[2], p[3]);
#pragma unroll
                    for (int j = 0; j < 4; ++j) {
                        const float ws = window_sum<W>(p[j], pp[n][j], p[j] + pt[n][j]);
                        sgv[n][j] = silu_pre(acc[ai][1][m][n][j]);
                        z[n][j] = __builtin_fmaf(ws, inv, -acc[ai][0][m][n][j]) * sgv[n][j];
                        pp[n][j] = p[j]; pt[n][j] = row_bcast15(p[j]); }
                }
                u32x4 w; w.x = pkbf(z[0][0], z[0][1]); w.y = pkbf(z[0][2], z[0][3]); w.z = pkbf(z[1][0], z[1][1]); w.w = pkbf(z[1][2], z[1][3]);
                *(u32x4*)((char*)Z + (zofs + (unsigned)((ai * HALF + m * 16) * DI) * 2u)) = w;
                if (sl == 0 && m == 0) { u32x4 g; g.x = pkbf(sgv[0][0], sgv[0][1]); g.y = pkbf(sgv[0][2], sgv[0][3]); g.z = pkbf(sgv[1][0], sgv[1][1]); g.w = pkbf(sgv[1][2], sgv[1][3]);
                    *(u32x4*)(SG0 + sideofs) = g; }
                asm volatile("" ::: "memory");
            }
        }
    }
    template <int W> __device__ __forceinline__ void tile_dbl(f32x4 (&acc)[2][2][4][2], const Unit& u, int wr, int wc, int fr, int fq, LAS unsigned char* lds) const {
        constexpr int NL = (W == 2) ? 1 : (W == 4) ? 2 : 3;
        const unsigned lane = (unsigned)(fq * 16 + fr);
        LAS unsigned char* HX = lds + TAB_OFF;
        const unsigned sideofs = (unsigned)(u.pm * 16 + u.pn) * HALO_TILE + ((unsigned)wc * 64u + lane) * 16u;
#pragma unroll
        for (int ai = 0; ai < 2; ++ai) {
            u32x4 h; h.x = pkbf(acc[ai][0][3][0][0], acc[ai][0][3][0][1]); h.y = pkbf(acc[ai][0][3][0][2], acc[ai][0][3][0][3]); h.z = pkbf(acc[ai][0][3][1][0], acc[ai][0][3][1][1]); h.w = pkbf(acc[ai][0][3][1][2], acc[ai][0][3][1][3]);
            const int sl = 2 * ai + wr;
            if (sl < 3) *(LAS u32x4*)(HX + ((unsigned)(sl * 4 + wc) * 64u + lane) * 16u) = h;
            else *(u32x4*)(HALO + sideofs) = h;
        }
        asm volatile("s_waitcnt lgkmcnt(0)" ::: "memory"); __builtin_amdgcn_s_barrier(); asm volatile("" ::: "memory");
        const bool seq0 = (u.pm & 15) == 0;
        const float invw = 1.0f / (float)W;
        const float inv00 = seq0 ? 1.0f / (float)((fr + 1) < W ? (fr + 1) : W) : invw;
        const unsigned zofs = ((unsigned)(u.pm * BM + wr * 64 + fr) * DI + (unsigned)(u.pn * HD + wc * 32 + 8 * fq)) * 2u;
#pragma unroll
        for (int ai = 0; ai < 2; ++ai) {
            const int sl = 2 * ai + wr;
            float prev[NL][2][4];
            if (sl > 0) {
                const u32x4 h = *(const LAS u32x4*)(HX + ((unsigned)((sl - 1) * 4 + wc) * 64u + lane) * 16u);
                prev[0][0][0] = bf_lo(h.x); prev[0][0][1] = bf_hi(h.x); prev[0][0][2] = bf_lo(h.y); prev[0][0][3] = bf_hi(h.y);
                prev[0][1][0] = bf_lo(h.z); prev[0][1][1] = bf_hi(h.z); prev[0][1][2] = bf_lo(h.w); prev[0][1][3] = bf_hi(h.w);
#pragma unroll
                for (int n = 0; n < 2; ++n) { if constexpr (NL >= 2) halo_step4<1>(prev[1][n], prev[0][n]); if constexpr (NL >= 3) halo_step4<2>(prev[2][n], prev[1][n]); }
            } else {
#pragma unroll
                for (int l = 0; l < NL; ++l)
#pragma unroll
                    for (int n = 0; n < 2; ++n)
#pragma unroll
                        for (int j = 0; j < 4; ++j) prev[l][n][j] = 0.f;
            }
#pragma unroll
            for (int m = 0; m < 4; ++m) {
                const float inv = (sl == 0 && m == 0) ? inv00 : invw;
                float z[2][4], sgv[2][4];
#pragma unroll
                for (int n = 0; n < 2; ++n) {
                    float l0[4], l1[4], l2[4], l3[4];
#pragma unroll
                    for (int j = 0; j < 4; ++j) l0[j] = acc[ai][0][m][n][j];
                    pool_step4<1>(l1, l0, prev[0][n]);
                    if constexpr (NL >= 2) pool_step4<2>(l2, l1, prev[1][n]);
                    if constexpr (NL >= 3) pool_step4<4>(l3, l2, prev[2][n]);
#pragma unroll
                    for (int j = 0; j < 4; ++j) {
                        const float ws = (NL == 1) ? l1[j] : (NL == 2) ? l2[j] : l3[j];
                        sgv[n][j] = silu_pre(acc[ai][1][m][n][j]);
                        z[n][j] = __builtin_fmaf(ws, inv, -l0[j]) * sgv[n][j];
                        prev[0][n][j] = l0[j]; if constexpr (NL >= 2) prev[1][n][j] = l1[j]; if constexpr (NL >= 3) prev[2][n][j] = l2[j]; }
                }
                u32x4 w; w.x = pkbf(z[0][0], z[0][1]); w.y = pkbf(z[0][2], z[0][3]); w.z = pkbf(z[1][0], z[1][1]); w.w = pkbf(z[1][2], z[1][3]);
                *(u32x4*)((char*)Z + (zofs + (unsigned)((ai * HALF + m * 16) * DI) * 2u)) = w;
                if (sl == 0 && m == 0) { u32x4 g; g.x = pkbf(sgv[0][0], sgv[0][1]); g.y = pkbf(sgv[0][2], sgv[0][3]); g.z = pkbf(sgv[1][0], sgv[1][1]); g.w = pkbf(sgv[1][2], sgv[1][3]);
                    *(u32x4*)(SG0 + sideofs) = g; }
                asm volatile("" ::: "memory");
            }
        }
    }
    __device__ __forceinline__ void operator()(f32x4 (&acc)[2][2][4][2], const Unit& u, int wr, int wc, int fr, int fq, LAS unsigned char* lds, int ui) const {
        const int g = u.pn >> 2;
        if (g == 0) tile_dbl<2>(acc, u, wr, wc, fr, fq, lds); else if (g == 1) tile_dbl<4>(acc, u, wr, wc, fr, fq, lds);
        else if (g == 2) tile_dbl<8>(acc, u, wr, wc, fr, fq, lds); else tile<16>(acc, u, wr, wc, fr, fq, lds);
    }
};
template <bool WRITE_HB, bool WRITE_H = true> struct EpiRes {
    static constexpr bool PERM = true, AFTER_DRAIN = false;
    __device__ __forceinline__ void prologue(const StaticOrder&, LAS unsigned char*, int) const {}
    const bf16_t* RB; const float* invr; float* H; bf16_t* HB; float* part;
    __device__ __forceinline__ void init_acc(f32x4 (&acc)[2][2][4][2], const Unit& u, int wr, int wc, int fr, int fq) const {
        const unsigned row0 = (unsigned)(u.pm * BM + wr * 64 + fr), col0 = (unsigned)(u.pn * BM + wc * 32 + 8 * fq);
        const unsigned ofs = (row0 * DM + col0) * 2u;
#pragma unroll
        for (int ai = 0; ai < 2; ++ai)
#pragma unroll
            for (int m = 0; m < 4; ++m) { const float ir = invr[row0 + (unsigned)(ai * HALF + m * 16)];
#pragma unroll
                for (int bj = 0; bj < 2; ++bj) { const u32x4 r = __builtin_nontemporal_load((const u32x4*)((const char*)RB + (ofs + (unsigned)((ai * HALF + m * 16) * DM + bj * HALF) * 2u)));
                    acc[ai][bj][m][0] = (f32x4){bf_lo(r.x) * ir, bf_hi(r.x) * ir, bf_lo(r.y) * ir, bf_hi(r.y) * ir};
                    acc[ai][bj][m][1] = (f32x4){bf_lo(r.z) * ir, bf_hi(r.z) * ir, bf_lo(r.w) * ir, bf_hi(r.w) * ir}; } }
    }
    __device__ __forceinline__ void operator()(f32x4 (&acc)[2][2][4][2], const Unit& u, int wr, int wc, int fr, int fq, LAS unsigned char* lds, int ui) const {
        const unsigned row0 = (unsigned)(u.pm * BM + wr * 64 + fr), col0 = (unsigned)(u.pn * BM + wc * 32 + 8 * fq);
        const unsigned ofs = (row0 * DM + col0) * 4u, pofs = (row0 * 16u + (unsigned)(u.pn * 4 + wc)) * 4u;
#pragma unroll
        for (int ai = 0; ai < 2; ++ai)
#pragma unroll
            for (int m = 0; m < 4; ++m) { const unsigned o = ofs + (unsigned)((ai * HALF + m * 16) * DM) * 4u; float ss = 0.f;
#pragma unroll
                for (int bj = 0; bj < 2; ++bj) { const unsigned oo = o + (unsigned)(bj * HALF) * 4u; const f32x4 h0 = acc[ai][bj][m][0], h1 = acc[ai][bj][m][1];
                    if (WRITE_H) { *(f32x4*)((char*)H + oo) = h0; *(f32x4*)((char*)H + oo + 16u) = h1; }
                    ss += ((h0[0] * h0[0] + h0[1] * h0[1]) + (h0[2] * h0[2] + h0[3] * h0[3])) + ((h1[0] * h1[0] + h1[1] * h1[1]) + (h1[2] * h1[2] + h1[3] * h1[3]));
                    if (WRITE_HB) { u32x4 w; w.x = pkbf(h0[0], h0[1]); w.y = pkbf(h0[2], h0[3]); w.z = pkbf(h1[0], h1[1]); w.w = pkbf(h1[2], h1[3]); *(u32x4*)((char*)HB + (oo >> 1)) = w; } }
                ss += xor_get(ss, fq * 16 + fr, 16); ss += xor_get(ss, fq * 16 + fr, 32);
                if (fq == 0) *(float*)((char*)part + (pofs + (unsigned)(ai * HALF + m * 16) * 64u)) = ss; }
    }
};
__device__ __forceinline__ float row_rstd_b(const float* part, unsigned bofs) {
    const f32x4* p = (const f32x4*)((const char*)part + bofs); const f32x4 a = p[0], b = p[1], c = p[2], d = p[3];
    return __builtin_amdgcn_rsqf((((a[0] + a[1]) + (a[2] + a[3])) + ((b[0] + b[1]) + (b[2] + b[3])) + ((c[0] + c[1]) + (c[2] + c[3])) + ((d[0] + d[1]) + (d[2] + d[3]))) * (1.0f / DM) + EPS);
}
struct EpiP4 {
    static constexpr bool PERM = true, AFTER_DRAIN = false;
    __device__ __forceinline__ void init_acc(f32x4 (&acc)[2][2][4][2], const Unit&, int, int, int, int) const { zero_acc(acc); }
    bf16_t* Qt; bf16_t* Kt; bf16_t* V; float* DEC; const float* part; const float* lbnd;
    __device__ __forceinline__ void prologue(const StaticOrder& S, LAS unsigned char* lds, int tid) const {
        LAS float* T = (LAS float*)(lds + TAB_OFF); Unit u;
        for (int i = 0; i < 12 && S.next(i, u); ++i) {
            if (tid < 256) T[i * 256 + tid] = row_rstd_b(part, (unsigned)(u.pm * BM + tid) * 64u);
            else if (u.pn < 16) {
                const int c = tid - 256, ch = u.pn * HD + (c & 127);
                const float ex = __expf(lbnd[ch] - lbnd[DI + ch]), lb = __builtin_amdgcn_rcpf(1.0f + ex);
                T[3072 + i * 256 + c] = (c < 128) ? lb : ex * lb; }
        }
        __syncthreads();
    }
    __device__ __forceinline__ void operator()(f32x4 (&acc)[2][2][4][2], const Unit& u, int wr, int wc, int fr, int fq, LAS unsigned char* lds, int ui) const {
        const unsigned row0 = (unsigned)(u.pm * BM + wr * 64 + fr);
        const LAS float* T = (const LAS float*)(lds + TAB_OFF) + ui * 256 + wr * 64 + fr;
        if (u.pn >= 16) {
            const unsigned vofs = (row0 * DI + (unsigned)((u.pn - 16) * BM + wc * 32 + 8 * fq)) * 2u;
#pragma unroll
            for (int ai = 0; ai < 2; ++ai)
#pragma unroll
                for (int m = 0; m < 4; ++m) { const float rs = T[ai * HALF + m * 16];
#pragma unroll
                    for (int bj = 0; bj < 2; ++bj) { const f32x4 v0 = acc[ai][bj][m][0] * rs, v1 = acc[ai][bj][m][1] * rs;
                        u32x4 w; w.x = pkbf(v0[0], v0[1]); w.y = pkbf(v0[2], v0[3]); w.z = pkbf(v1[0], v1[1]); w.w = pkbf(v1[2], v1[3]);
                        __builtin_nontemporal_store(w, (u32x4*)((char*)V + (vofs + (unsigned)((ai * HALF + m * 16) * DI + bj * HALF) * 2u))); } }
            return;
        }
        const unsigned c0 = (unsigned)(u.pn * HD + wc * 32 + 8 * fq);
        const unsigned qofs = (row0 * DI + c0) * 2u;
        const LAS float* LB = (const LAS float*)(lds + TAB_OFF) + 3072 + ui * 256 + wc * 32 + 8 * fq;
#pragma unroll
        for (int ai = 0; ai < 2; ++ai) {
            float rs[4], rz[4];
#pragma unroll
            for (int m = 0; m < 4; ++m) { rs[m] = T[ai * HALF + m * 16]; rz[m] = -1.44269504089f * rs[m]; }
            float bp[2][4]; f32x4 decv[2];
#pragma unroll
            for (int m = 0; m < 4; ++m) {
#pragma unroll
                for (int n = 0; n < 2; ++n) {
                    const f32x4 lbv = *(const LAS f32x4*)(LB + 4 * n), omv = *(const LAS f32x4*)(LB + 128 + 4 * n);
                    float s[4], k[4];
#pragma unroll
                    for (int j = 0; j < 4; ++j) {
                        const float sg = __builtin_amdgcn_rcpf(1.0f + __builtin_amdgcn_exp2f(acc[ai][1][m][n][j] * rz[m]));
                        s[j] = __builtin_fmaf(omv[j], sg, lbv[j]); k[j] = __builtin_fmaf(-omv[j], sg, omv[j]); }
                    row_scan_mul4(s[0], s[1], s[2], s[3]);
#pragma unroll
                    for (int j = 0; j < 4; ++j) {
                        const float E = (m == 0) ? s[j] : s[j] * bp[n][j];
                        if (m < 3) { const float tot = lane_get(s[j], fq * 16 + 15); bp[n][j] = (m == 0) ? tot : bp[n][j] * tot; }
                        const float Ei = __builtin_amdgcn_rcpf(fmaxf(E, 7.9e-31f));
                        acc[ai][0][m][n][j] = acc[ai][0][m][n][j] * (rs[m] * E); acc[ai][1][m][n][j] = k[j] * Ei;
                        if (m == 3) decv[n][j] = E; }
                }
                const unsigned ob = qofs + (unsigned)((ai * HALF + m * 16) * DI) * 2u;
                u32x4 w; w.x = pkbf(acc[ai][0][m][0][0], acc[ai][0][m][0][1]); w.y = pkbf(acc[ai][0][m][0][2], acc[ai][0][m][0][3]); w.z = pkbf(acc[ai][0][m][1][0], acc[ai][0][m][1][1]); w.w = pkbf(acc[ai][0][m][1][2], acc[ai][0][m][1][3]);
                __builtin_nontemporal_store(w, (u32x4*)((char*)Qt + ob));
                u32x4 x; x.x = pkbf(acc[ai][1][m][0][0], acc[ai][1][m][0][1]); x.y = pkbf(acc[ai][1][m][0][2], acc[ai][1][m][0][3]); x.z = pkbf(acc[ai][1][m][1][0], acc[ai][1][m][1][1]); x.w = pkbf(acc[ai][1][m][1][2], acc[ai][1][m][1][3]);
                __builtin_nontemporal_store(x, (u32x4*)((char*)Kt + ob));
                asm volatile("" ::: "memory");
            }
            if (fr == 15) { float* dp = (float*)((char*)DEC + ((unsigned)(u.pm * 4 + ai * 2 + wr) * DI + c0) * 4u); *(f32x4*)dp = decv[0]; *(f32x4*)(dp + 4) = decv[1]; }
            asm volatile("" ::: "memory");
        }
    }
};
struct EpiP5b {
    static constexpr bool PERM = true, AFTER_DRAIN = false;
    __device__ __forceinline__ void init_acc(f32x4 (&acc)[2][2][4][2], const Unit&, int, int, int, int) const { zero_acc(acc); }
    bf16_t* O; const float* part; const float* ss;
    __device__ __forceinline__ void prologue(const StaticOrder& S, LAS unsigned char* lds, int tid) const {
        LAS float* T = (LAS float*)(lds + TAB_OFF); Unit u;
        for (int i = 0; i < 4 && S.next(i, u); ++i) {
            if (tid < 256) T[i * 768 + tid] = row_rstd_b(part, (unsigned)(u.pm * BM + tid) * 64u);
            { const int r = tid >> 1, hh = tid & 1; const f32x4* sp = (const f32x4*)(ss + (size_t)(u.pm * BM + r) * 128 + (u.pn * 2 + hh) * 8); const f32x4 s0 = sp[0], s1 = sp[1];
              T[i * 768 + 256 + tid] = __builtin_amdgcn_rsqf((((s0[0] + s0[1]) + (s0[2] + s0[3])) + ((s1[0] + s1[1]) + (s1[2] + s1[3]))) * (1.0f / HD) + EPS); }
        }
        __syncthreads();
    }
    __device__ __forceinline__ void operator()(f32x4 (&acc)[2][2][4][2], const Unit& u, int wr, int wc, int fr, int fq, LAS unsigned char* lds, int ui) const {
        const unsigned row0 = (unsigned)(u.pm * BM + wr * 64 + fr), col0 = (unsigned)(u.pn * BM + wc * 32 + 8 * fq);
        const LAS float* T = (const LAS float*)(lds + TAB_OFF) + ui * 768 + wr * 64 + fr;
        const unsigned oofs = (row0 * DI + col0) * 2u;
#pragma unroll
        for (int ai = 0; ai < 2; ++ai) {
            u32x4 ov[4][2];
#pragma unroll
            for (int m = 0; m < 4; ++m)
#pragma unroll
                for (int bj = 0; bj < 2; ++bj) ov[m][bj] = *(const u32x4*)((const char*)O + (oofs + (unsigned)((ai * HALF + m * 16) * DI + bj * HALF) * 2u));
#pragma unroll
            for (int m = 0; m < 4; ++m) { const int rl = ai * HALF + m * 16; const float rs = T[rl];
#pragma unroll
                for (int bj = 0; bj < 2; ++bj) { const f32x4 v0 = acc[ai][bj][m][0] * rs, v1 = acc[ai][bj][m][1] * rs;
                    const float rh = T[256 + 2 * rl + bj + (wr * 64 + fr)];
                    const u32x4 s = ov[m][bj];
                    u32x4 w; w.x = pkbf(bf_lo(s.x) * rh * silu_pre(v0[0]), bf_hi(s.x) * rh * silu_pre(v0[1])); w.y = pkbf(bf_lo(s.y) * rh * silu_pre(v0[2]), bf_hi(s.y) * rh * silu_pre(v0[3]));
                    w.z = pkbf(bf_lo(s.z) * rh * silu_pre(v1[0]), bf_hi(s.z) * rh * silu_pre(v1[1])); w.w = pkbf(bf_lo(s.w) * rh * silu_pre(v1[2]), bf_hi(s.w) * rh * silu_pre(v1[3]));
                    *(u32x4*)((char*)O + (oofs + (unsigned)((ai * HALF + m * 16) * DI + bj * HALF) * 2u)) = w; } }
            asm volatile("" ::: "memory"); }
    }
};
struct EpiFinal {
    static constexpr bool PERM = true, AFTER_DRAIN = false;
    __device__ __forceinline__ void init_acc(f32x4 (&acc)[2][2][4][2], const Unit&, int, int, int, int) const { zero_acc(acc); }
    const bf16_t* HB; float* H; const float* fg; float* X; unsigned* cnt;
    __device__ __forceinline__ void prologue(const StaticOrder&, LAS unsigned char*, int) const {}
    __device__ __forceinline__ void operator()(f32x4 (&acc)[2][2][4][2], const Unit& u, int wr, int wc, int fr, int fq, LAS unsigned char* lds, int ui) const {
        LAS float* Pt = (LAS float*)(lds + TAB_OFF);
        LAS float* St = Pt + 1024;
        const int tid = (wr * 4 + wc) * 64 + fq * 16 + fr;
        const unsigned row0 = (unsigned)(u.pm * BM + wr * 64 + fr), col0 = (unsigned)(u.pn * BM + wc * 32 + 8 * fq);
        const unsigned ofs = (row0 * DM + col0) * 4u;
#pragma unroll
        for (int ai = 0; ai < 2; ++ai) {
            u32x4 hv[4][2];
#pragma unroll
            for (int m = 0; m < 4; ++m)
#pragma unroll
                for (int bj = 0; bj < 2; ++bj) hv[m][bj] = *(const u32x4*)((const char*)HB + ((ofs + (unsigned)((ai * HALF + m * 16) * DM + bj * HALF) * 4u) >> 1));
#pragma unroll
            for (int m = 0; m < 4; ++m) { float ss = 0.f;
#pragma unroll
                for (int bj = 0; bj < 2; ++bj) { const u32x4 hb = hv[m][bj];
                    const f32x4 h0 = acc[ai][bj][m][0] + (f32x4){bf_lo(hb.x), bf_hi(hb.x), bf_lo(hb.y), bf_hi(hb.y)}, h1 = acc[ai][bj][m][1] + (f32x4){bf_lo(hb.z), bf_hi(hb.z), bf_lo(hb.w), bf_hi(hb.w)};
                    acc[ai][bj][m][0] = h0; acc[ai][bj][m][1] = h1;
                    ss += ((h0[0] * h0[0] + h0[1] * h0[1]) + (h0[2] * h0[2] + h0[3] * h0[3])) + ((h1[0] * h1[0] + h1[1] * h1[1]) + (h1[2] * h1[2] + h1[3] * h1[3])); }
                ss += xor_get(ss, fq * 16 + fr, 16); ss += xor_get(ss, fq * 16 + fr, 32);
                if (fq == 0) Pt[(ai * HALF + wr * 64 + m * 16 + fr) * 4 + wc] = ss; }
            asm volatile("" ::: "memory"); }
        __syncthreads();
        float* xs = X + (size_t)u.pm * 1024;
        if (tid < 256) { const f32x4 p = *(const LAS f32x4*)(Pt + tid * 4);
            __hip_atomic_store(xs + u.pn * 256 + tid, (p[0] + p[1]) + (p[2] + p[3]), __ATOMIC_RELAXED, __HIP_MEMORY_SCOPE_AGENT); }
        asm volatile("s_waitcnt vmcnt(0)" ::: "memory");
        __syncthreads();
        if (tid == 0) {
            unsigned* c = cnt + 16 * u.pm;
            __hip_atomic_fetch_add(c, 1u, __ATOMIC_RELAXED, __HIP_MEMORY_SCOPE_AGENT);
            unsigned spins = 0;
            while (__hip_atomic_load(c, __ATOMIC_RELAXED, __HIP_MEMORY_SCOPE_AGENT) < 4u) { __builtin_amdgcn_s_sleep(2); if (++spins > (1u << 22)) break; }
            __builtin_amdgcn_fence(__ATOMIC_ACQUIRE, "agent");
            asm volatile("s_waitcnt vmcnt(0)" ::: "memory");
        }
        __syncthreads();
        if (tid < 256) { float s = 0.f;
#pragma unroll
            for (int t = 0; t < 4; ++t) s += __hip_atomic_load(xs + t * 256 + tid, __ATOMIC_RELAXED, __HIP_MEMORY_SCOPE_AGENT);
            St[tid] = __builtin_amdgcn_rsqf(s * (1.0f / DM) + EPS); }
        __syncthreads();
        f32x4 gv[2][2];
#pragma unroll
        for (int bj = 0; bj < 2; ++bj)
#pragma unroll
            for (int n = 0; n < 2; ++n) gv[bj][n] = *(const f32x4*)(fg + col0 + bj * HALF + n * 4);
#pragma unroll
        for (int ai = 0; ai < 2; ++ai)
#pragma unroll
            for (int m = 0; m < 4; ++m) { const float rs = St[ai * HALF + wr * 64 + m * 16 + fr];
#pragma unroll
                for (int bj = 0; bj < 2; ++bj) { const unsigned oo = ofs + (unsigned)((ai * HALF + m * 16) * DM + bj * HALF) * 4u;
                    *(f32x4*)((char*)H + oo) = acc[ai][bj][m][0] * rs * gv[bj][0]; *(f32x4*)((char*)H + oo + 16u) = acc[ai][bj][m][1] * rs * gv[bj][1]; } }
        __syncthreads();
    }
};
}

namespace scan {
#define MFMA16(a, b, c) __builtin_amdgcn_mfma_f32_16x16x32_bf16((a), (b), (c), 0, 0, 0)
__device__ __forceinline__ unsigned offb(unsigned row, unsigned ch) { return 256u * row + 16u * (ch ^ (((row & 3u) << 2) | ((row >> 2) & 3u))); }
__device__ __forceinline__ unsigned voffv(unsigned r, unsigned cp) { return 128u * r + 32u * (cp ^ (((r >> 1) & 3u) ^ (((r >> 3) & 1u) << 1))); }
__device__ __forceinline__ void tr8(unsigned a0, unsigned a1, unsigned c0, unsigned c1, bf16x8& f00, bf16x8& f01, bf16x8& f10, bf16x8& f11) {
    u32x2 r0, r1, r2, r3, r4, r5, r6, r7;
    asm volatile("ds_read_b64_tr_b16 %0, %8\n\tds_read_b64_tr_b16 %1, %9\n\tds_read_b64_tr_b16 %2, %8 offset:8192\n\tds_read_b64_tr_b16 %3, %9 offset:8192\n\t"
                 "ds_read_b64_tr_b16 %4, %10\n\tds_read_b64_tr_b16 %5, %11\n\tds_read_b64_tr_b16 %6, %10 offset:8192\n\tds_read_b64_tr_b16 %7, %11 offset:8192\n\ts_waitcnt lgkmcnt(0)"
                 : "=&v"(r0), "=&v"(r1), "=&v"(r2), "=&v"(r3), "=&v"(r4), "=&v"(r5), "=&v"(r6), "=&v"(r7) : "v"(a0), "v"(a1), "v"(c0), "v"(c1) : "memory");
    const u32x4 x00 = {r0.x, r0.y, r1.x, r1.y}, x01 = {r2.x, r2.y, r3.x, r3.y}, x10 = {r4.x, r4.y, r5.x, r5.y}, x11 = {r6.x, r6.y, r7.x, r7.y};
    f00 = __builtin_bit_cast(bf16x8, x00); f01 = __builtin_bit_cast(bf16x8, x01); f10 = __builtin_bit_cast(bf16x8, x10); f11 = __builtin_bit_cast(bf16x8, x11);
}
__device__ __forceinline__ bf16x8 pack8(const f32x4 a, const f32x4 b) { const u32x4 r = {pkbf(a[0], a[1]), pkbf(a[2], a[3]), pkbf(b[0], b[1]), pkbf(b[2], b[3])}; return __builtin_bit_cast(bf16x8, r); }
__device__ __forceinline__ u32x2 tr_issue(unsigned a) { u32x2 r; asm volatile("ds_read_b64_tr_b16 %0, %1" : "=v"(r) : "v"(a) : "memory"); return r; }
__device__ __forceinline__ bf16x8 frag2(const u32x2 lo, const u32x2 hi) { const u32x4 r = {lo.x, lo.y, hi.x, hi.y}; return __builtin_bit_cast(bf16x8, r); }
__device__ __forceinline__ u32x2 at_tile(LAS unsigned char* lds, unsigned QI, unsigned KI, int it, int j, unsigned l15, unsigned g) {
    f32x4 c = (f32x4){0.f, 0.f, 0.f, 0.f};
#pragma unroll
    for (int kd = 0; kd < 4; ++kd) { const bf16x8 qb = *(const LAS bf16x8*)(lds + QI + offb(16u * (unsigned)it + l15, 4u * kd + g)), a = *(const LAS bf16x8*)(lds + KI + offb(16u * (unsigned)j + l15, 4u * kd + g)); c = MFMA16(a, qb, c); }
    if (j == it) {
#pragma unroll
        for (int r = 0; r < 4; ++r) c[r] = (4u * g + r <= l15) ? c[r] : 0.f; }
    const u32x2 w = {pkbf(c[0], c[1]), pkbf(c[2], c[3])}; return w;
}
template <int NK>
__device__ __forceinline__ f32x4 o_part(LAS unsigned char* lds, unsigned QI, int it, const bf16x8 (&at)[NK], const bf16x8 (&vf)[2], const bf16x8 so0, const bf16x8 so1, const bf16x8 sp0, const bf16x8 sp1, int th, unsigned l15, unsigned g) {
    const unsigned trow = 16u * (unsigned)it + l15;
    f32x4 o = (f32x4){0.f, 0.f, 0.f, 0.f};
#pragma unroll
    for (int ks = 0; ks < NK; ++ks) if (2 * ks <= it) o = MFMA16(vf[ks], at[ks], o);
#pragma unroll
    for (int j = 0; j < 4; ++j) {
        const unsigned kd = (j < 2) ? (2u * (unsigned)th + j) : (2u * (unsigned)(1 - th) + (j - 2));
        const u32x2 q0 = *(const LAS u32x2*)(lds + QI + offb(trow, 4u * kd + (g >> 1)) + 8u * (g & 1)), q1 = *(const LAS u32x2*)(lds + QI + offb(trow, 4u * kd + 2u + (g >> 1)) + 8u * (g & 1));
        o = MFMA16(j == 0 ? so0 : j == 1 ? so1 : j == 2 ? sp0 : sp1, frag2(q0, q1), o); }
    return o;
}
__device__ __forceinline__ void phase(LAS unsigned char* lds, const bf16_t* Qt, const bf16_t* Kt, bf16_t* VO, const float* DEC, float* ss8, int bid, int G, int wave) {
    const unsigned lane = (unsigned)fresh_lane_id(), l15 = lane & 15u, g = lane >> 4, ql = l15 >> 2, p = lane & 3u;
    const unsigned vs = (unsigned)wave & 3u; const int th = wave >> 2, tA = th ? 1 : 0, tB = th ? 2 : 3;
    const unsigned ldsb = (unsigned)(uintptr_t)lds;
    constexpr unsigned QKB = 32768u, VRING = 3u * QKB, DECB = VRING + 2u * 8192u, SFB = DECB + 1536u, ATB = SFB + 32768u;
    static_assert(ATB + 2u * 5120u <= XST_OFF, "scan LDS map");
    unsigned qoff[2], voff_, doff;
#pragma unroll
    for (int i = 0; i < 2; ++i) { const unsigned j = 2u * (unsigned)wave + i, r = 4u * j + (lane >> 4), pc = lane & 15u, ch = pc ^ (((r & 3u) << 2) | ((r >> 2) & 3u)); qoff[i] = (r * DI + ch * 8u) * 2u; }
    { const unsigned r = 8u * (unsigned)wave + (lane >> 3), s16 = lane & 7u, ul = (s16 >> 1) ^ (((r >> 1) & 3u) ^ (((r >> 3) & 1u) << 1)); voff_ = (r * DI + (ul * 2u + (s16 & 1u)) * 8u) * 2u; }
    doff = (64u * ((unsigned)wave & 1u) + lane) * 4u;
    const int my_it = wave == 0 ? 0 : wave <= 2 ? 1 : wave <= 5 ? 2 : 3, my_j = wave == 0 ? 0 : wave <= 2 ? wave - 1 : wave <= 5 ? wave - 3 : wave - 6;
    for (int item = bid; item < BATCH * NHEAD * 2; item += G) {
        const int half = (item >> 3) & 1, pair = (item & 7) | ((item >> 4) << 3), b = pair >> 4, h = pair & 15;
        const size_t tokb = (size_t)b * SEQ;
        const char* qg = (const char*)(Qt + tokb * DI + h * HD);
        const char* kg = (const char*)(Kt + tokb * DI + h * HD);
        bf16_t* vg = VO + tokb * DI + h * HD + half * 64;
        const char* dg = (const char*)(DEC + (size_t)(b * (SEQ / 64)) * DI + h * HD);
        f32x4 S[4];
        bf16x8 so0 = (bf16x8){0, 0, 0, 0, 0, 0, 0, 0}, so1 = so0, sp0 = so0, sp1 = so0;
#pragma unroll
        for (int i = 0; i < 4; ++i) S[i] = (f32x4){0.f, 0.f, 0.f, 0.f};
#define SC_DMA_QK(c_) do { const size_t o_ = (size_t)(c_) * 64 * DI * 2; const unsigned base_ = ((unsigned)(c_) % 3u) * QKB; \
            __builtin_amdgcn_global_load_lds((const unsigned*)(qg + o_ + qoff[0]), (LAS unsigned*)(lds + base_ + (unsigned)wave * 2048u), 16, 0, 0); \
            __builtin_amdgcn_global_load_lds((const unsigned*)(qg + o_ + qoff[1]), (LAS unsigned*)(lds + base_ + (unsigned)wave * 2048u + 1024u), 16, 0, 0); \
            __builtin_amdgcn_global_load_lds((const unsigned*)(kg + o_ + qoff[0]), (LAS unsigned*)(lds + base_ + 16384u + (unsigned)wave * 2048u), 16, 0, 0); \
            __builtin_amdgcn_global_load_lds((const unsigned*)(kg + o_ + qoff[1]), (LAS unsigned*)(lds + base_ + 16384u + (unsigned)wave * 2048u + 1024u), 16, 0, 0); \
            __builtin_amdgcn_global_load_lds((const unsigned*)(dg + (size_t)(c_) * DI * 4 + doff), (LAS unsigned*)(lds + DECB + ((unsigned)(c_) % 3u) * 512u + ((unsigned)wave & 1u) * 256u), 4, 0, 0); } while (0)
#define SC_DMA_V(c_) __builtin_amdgcn_global_load_lds((const unsigned*)((const char*)vg + (size_t)(c_) * 64 * DI * 2 + voff_), (LAS unsigned*)(lds + VRING + ((unsigned)(c_) & 1u) * 8192u + (unsigned)wave * 1024u), 16, 0, 0)
#define SC_AT(c_) do { LAS u32x2* atw = (LAS u32x2*)(lds + ATB + (unsigned)((c_) & 1) * 5120u) + lane; const unsigned b_ = ((unsigned)(c_) % 3u) * QKB; \
            atw[64 * wave] = at_tile(lds, b_, b_ + 16384u, my_it, my_j, l15, g); \
            if (wave < 2) atw[64 * (8 + wave)] = at_tile(lds, b_, b_ + 16384u, 3, 2 + wave, l15, g); } while (0)
        SC_DMA_QK(0); SC_DMA_QK(1); SC_DMA_V(0);
        asm volatile("s_waitcnt vmcnt(0)" ::: "memory");
        __builtin_amdgcn_s_barrier();
        SC_AT(0);
        asm volatile("s_waitcnt lgkmcnt(0)" ::: "memory");
        __builtin_amdgcn_s_barrier();
        for (int n = 0; n < SEQ / 64; ++n) {
            const unsigned QI = ((unsigned)n % 3u) * QKB, KI = QI + 16384u, VI = VRING + ((unsigned)n & 1u) * 8192u;
            if (n + 2 < SEQ / 64) SC_DMA_QK(n + 2);
            if (n + 1 < SEQ / 64) SC_DMA_V(n + 1);
            if (n > 0) { const LAS bf16x8* sfr = (const LAS bf16x8*)(lds + SFB + ((unsigned)n & 1u) * 16384u + (unsigned)(wave ^ 4) * 2048u) + lane;
                sp0 = sfr[0]; sp1 = sfr[64]; }
            u32x2 tv0, tv1, tv2, tv3, tv4, tv5, tv6, tv7;
            {
                const unsigned va = ldsb + VI + 8u * p;
                tv0 = tr_issue(va + voffv(4u * g + ql, vs)); tv1 = tr_issue(va + voffv(16u + 4u * g + ql, vs)); tv2 = tr_issue(va + voffv(32u + 4u * g + ql, vs)); tv3 = tr_issue(va + voffv(48u + 4u * g + ql, vs));
                tv4 = tr_issue(va + voffv(8u * g + ql, vs)); tv5 = tr_issue(va + voffv(8u * g + 4u + ql, vs)); tv6 = tr_issue(va + voffv(32u + 8u * g + ql, vs)); tv7 = tr_issue(va + voffv(36u + 8u * g + ql, vs));
            }
            if (n + 1 < SEQ / 64) SC_AT(n + 1);
            bf16x8 atB[2], atA[1];
            { const LAS u32x2* atr = (const LAS u32x2*)(lds + ATB + (unsigned)(n & 1) * 5120u) + lane; const u32x2 z2 = {0u, 0u};
              if (th == 0) { atB[0] = frag2(atr[64 * 6], atr[64 * 7]); atB[1] = frag2(atr[64 * 8], atr[64 * 9]); atA[0] = frag2(atr[0], z2); }
              else         { atB[0] = frag2(atr[64 * 3], atr[64 * 4]); atB[1] = frag2(atr[64 * 5], z2);          atA[0] = frag2(atr[64 * 1], atr[64 * 2]); } }
            asm volatile("s_waitcnt lgkmcnt(0)" : "+v"(tv0), "+v"(tv1), "+v"(tv2), "+v"(tv3), "+v"(tv4), "+v"(tv5), "+v"(tv6), "+v"(tv7) :: "memory");
            __builtin_amdgcn_sched_barrier(0);
            const bf16x8 vf[2] = {frag2(tv0, tv1), frag2(tv2, tv3)};
            const f32x4 oB = o_part<2>(lds, QI, tB, atB, vf, so0, so1, sp0, sp1, th, l15, g);
            const f32x4 oA = o_part<1>(lds, QI, tA, atA, vf, so0, so1, sp0, sp1, th, l15, g);
            {
                const bf16x8 vn0 = frag2(tv4, tv5), vn1 = frag2(tv6, tv7);
                const LAS float* dcp = (const LAS float*)(lds + DECB + ((unsigned)n % 3u) * 512u) + 4u * g + 64u * (unsigned)th;
                const unsigned ka = (ldsb + KI + offb(8u * g + ql, (p >> 1)) + 8u * (p & 1u)) ^ ((unsigned)th << 7), kb = (ldsb + KI + offb(8u * g + 4u + ql, (p >> 1)) + 8u * (p & 1u)) ^ ((unsigned)th << 7);
#pragma unroll
                for (int i = 0; i < 4; i += 2) {
                    bf16x8 k00, k01, k10, k11;
                    tr8(ka ^ ((unsigned)i << 5), kb ^ ((unsigned)i << 5), ka ^ ((unsigned)(i + 1) << 5), kb ^ ((unsigned)(i + 1) << 5), k00, k01, k10, k11);
                    S[i] = MFMA16(k00, vn0, S[i]); S[i + 1] = MFMA16(k10, vn0, S[i + 1]); S[i] = MFMA16(k01, vn1, S[i]); S[i + 1] = MFMA16(k11, vn1, S[i + 1]); }
#pragma unroll
                for (int i = 0; i < 4; ++i) { const f32x4 dc = *(const LAS f32x4*)(dcp + 16 * i); S[i] = S[i] * dc; }
                const bf16x8 f0 = pack8(S[0], S[1]), f1 = pack8(S[2], S[3]);
                so0 = f0; so1 = f1;
                LAS bf16x8* sfw = (LAS bf16x8*)(lds + SFB + ((unsigned)(n + 1) & 1u) * 16384u + (unsigned)wave * 2048u) + lane;
                sfw[0] = f0; sfw[64] = f1;
            }
            asm volatile("s_waitcnt vmcnt(0)" ::: "memory");
            {
                const size_t tlB = (size_t)n * 64 + 16u * (unsigned)tB + l15, tlA = (size_t)n * 64 + 16u * (unsigned)tA + l15;
                const u32x2 wB = {pkbf(oB[0], oB[1]), pkbf(oB[2], oB[3])}, wA = {pkbf(oA[0], oA[1]), pkbf(oA[2], oA[3])};
                *(u32x2*)(vg + tlB * DI + 16u * vs + 4u * g) = wB; *(u32x2*)(vg + tlA * DI + 16u * vs + 4u * g) = wA;
                float sB = (oB[0] * oB[0] + oB[1] * oB[1]) + (oB[2] * oB[2] + oB[3] * oB[3]), sA = (oA[0] * oA[0] + oA[1] * oA[1]) + (oA[2] * oA[2] + oA[3] * oA[3]);
                sB += xor_get(sB, (int)lane, 16); sA += xor_get(sA, (int)lane, 16); sB += xor_get(sB, (int)lane, 32); sA += xor_get(sA, (int)lane, 32);
                if (g == 0) { ss8[(tokb + tlB) * 128 + h * 8 + half * 4 + vs] = sB; ss8[(tokb + tlA) * 128 + h * 8 + half * 4 + vs] = sA; }
            }
            asm volatile("s_waitcnt lgkmcnt(0)" ::: "memory");
            __builtin_amdgcn_s_barrier();
        }
#undef SC_DMA_QK
#undef SC_DMA_V
#undef SC_AT
    }
}
#undef MFMA16
}

#define XB_TMO      128
#define XB_XCNT(j)  (256  + 64 * (j))
#define XB_XSUB(j)  (1280 + 64 * (j))
#define XB_XGEN(j)  (2304 + 64 * (j))
#define XB_TOP      3328
#define XB_TOPGEN   3392
#define XCD_BAR_WORDS 3456
#define XB_SPIN_CAP (1u << 18)
__device__ __forceinline__ unsigned xb_ld(unsigned* p)              { return __hip_atomic_load(p, __ATOMIC_RELAXED, __HIP_MEMORY_SCOPE_AGENT); }
__device__ __forceinline__ unsigned xb_add(unsigned* p, unsigned v) { return __hip_atomic_fetch_add(p, v, __ATOMIC_RELAXED, __HIP_MEMORY_SCOPE_AGENT); }
__device__ __forceinline__ unsigned xb_xcc_id() { return (unsigned)__builtin_amdgcn_s_getreg((3 << 11) | 20) & 0xFu; }
#define XB_SPIN(cond, bar) do { unsigned _sp = 0; while (cond) { __builtin_amdgcn_s_sleep(1); \
    if ((++_sp & 255u) == 0u) { if (xb_ld(&(bar)[XB_TMO])) break; if (_sp > XB_SPIN_CAP) { atomicAdd(&(bar)[XB_TMO], 1u); break; } } } } while (0)
struct XcdBarrier { unsigned* bar; unsigned x; volatile LAS unsigned* st; };
__device__ __forceinline__ XcdBarrier xcd_barrier_post(unsigned* bar, volatile LAS unsigned* st) {
    XcdBarrier b; b.bar = bar; b.x = xb_xcc_id(); b.st = st;
    if (threadIdx.x == 0) (void)xb_add(&bar[XB_XCNT(b.x)], 1u);
    return b;
}
__device__ __forceinline__ void xcd_barrier_complete(unsigned* bar, unsigned x, unsigned& nloc, unsigned& nx) {
    const unsigned G = gridDim.x * gridDim.y * gridDim.z;
    unsigned sum, cnt, mine, sp = 0u;
    for (;;) {
        sum = 0u; cnt = 0u; mine = 0u;
#pragma unroll
        for (unsigned j = 0; j < 16; ++j) { const unsigned c = xb_ld(&bar[XB_XCNT(j)]); sum += c; cnt += (c > 0u) ? 1u : 0u; mine = (j == x) ? c : mine; }
        if (sum == G) break;
        __builtin_amdgcn_s_sleep(1);
        if ((++sp & 255u) == 0u) { if (xb_ld(&bar[XB_TMO])) break; if (sp > XB_SPIN_CAP) { atomicAdd(&bar[XB_TMO], 1u); break; } }
    }
    nloc = mine > 0u ? mine : 1u; nx = cnt > 0u ? cnt : 1u;
}
__device__ __forceinline__ void xcd_barrier(const XcdBarrier& b) {
    asm volatile("s_waitcnt vmcnt(0)" ::: "memory");
    __syncthreads();
    if (threadIdx.x == 0) {
        unsigned* bar = b.bar;
        __builtin_amdgcn_s_waitcnt(0);
        unsigned nloc = b.st[0], nx = b.st[1];
        if (nloc == 0u) { xcd_barrier_complete(bar, b.x, nloc, nx); b.st[0] = nloc; b.st[1] = nx; }
        const unsigned old = xb_add(&bar[XB_XSUB(b.x)], 1u);
        const unsigned gen = old / nloc;
        if (old + 1u == (gen + 1u) * nloc) {
            __builtin_amdgcn_fence(__ATOMIC_RELEASE, "agent");
            asm volatile("s_waitcnt vmcnt(0)" ::: "memory");
            const unsigned og = xb_add(&bar[XB_TOP], 1u);
            const unsigned tg = og / nx;
            if (og + 1u == (tg + 1u) * nx) xb_add(&bar[XB_TOPGEN], 1u);
            else XB_SPIN(xb_ld(&bar[XB_TOPGEN]) == tg, bar);
            __builtin_amdgcn_fence(__ATOMIC_ACQUIRE, "agent");
            xb_add(&bar[XB_XGEN(b.x)], 1u);
            asm volatile("s_waitcnt vmcnt(0)" ::: "memory");
        } else {
            XB_SPIN(xb_ld(&bar[XB_XGEN(b.x)]) == gen, bar);
            __builtin_amdgcn_fence(__ATOMIC_ACQUIRE, "agent");
            asm volatile("s_waitcnt vmcnt(0)" ::: "memory");
        }
    }
    __syncthreads();
}

struct Args {
    const float* x; const float* norm_g; const float* pool_w_in; const float* pool_w_grp; const float* pool_scale; const float* pool_w_out;
    const float* hgrn_w_in; const float* hgrn_lb; const float* hgrn_norm_g; const float* hgrn_w_out; const float* final_g;
    float* out; unsigned char* ws;
};

struct TItem { const float* W; bf16_t* WT; const float* ks; const float* ns; int K, N, row_off, item; float cs; };
__device__ __forceinline__ void titem_issue(const TItem& t, int lane, float (&wv)[32]) {
    const int nblk = t.N / 32, kb = t.item / nblk, nb = t.item % nblk, k0 = 64 * kb, n0 = 32 * nb;
    const float* wp = t.W + (size_t)(k0 + (lane >> 5)) * t.N + n0 + (lane & 31);
#pragma unroll
    for (int i = 0; i < 32; ++i) wv[i] = __builtin_nontemporal_load(wp + (size_t)(2 * i) * t.N);
}
__device__ __forceinline__ void titem_finish(const TItem& t, int lane, const float (&wv)[32], LAS float* scr) {
    const int nblk = t.N / 32, kb = t.item / nblk, nb = t.item % nblk, k0 = 64 * kb, n0 = 32 * nb;
    const float nsv = (t.ns ? t.ns[n0 + (lane & 31)] : 1.0f) * t.cs;
    const float ksv = t.ks ? t.ks[k0 + lane] : 1.0f;
#pragma unroll
    for (int i = 0; i < 32; ++i) { const int kk = 2 * i + (lane >> 5); scr[kk * 33 + (lane & 31)] = wv[i] * nsv * lane_get(ksv, kk); }
    asm volatile("s_waitcnt lgkmcnt(0)" ::: "memory");
    const int c = lane & 7;
#pragma unroll
    for (int j = 0; j < 4; ++j) { const int n = (lane >> 3) + 8 * j; const LAS float* s = scr + (8 * c) * 33 + n;
        u32x4 o; o.x = pkbf(s[0 * 33], s[1 * 33]); o.y = pkbf(s[2 * 33], s[3 * 33]); o.z = pkbf(s[4 * 33], s[5 * 33]); o.w = pkbf(s[6 * 33], s[7 * 33]);
        *(u32x4*)(t.WT + (size_t)(t.row_off + n0 + n) * t.K + k0 + 8 * c) = o; }
    asm volatile("s_waitcnt lgkmcnt(0)" ::: "memory");
}

__global__ void __launch_bounds__(512, 2) fwd_kernel(Args a) {
    extern __shared__ __attribute__((aligned(16))) unsigned char lds_raw[];
    LAS unsigned char* lds = (LAS unsigned char*)lds_raw;
    volatile LAS unsigned* xst = (volatile LAS unsigned*)(lds + XST_OFF);
    if (threadIdx.x < 2) xst[threadIdx.x] = 0u;
    __syncthreads();
    const XcdBarrier xbar = xcd_barrier_post((unsigned*)a.ws, xst);
#define GRID_BAR() xcd_barrier(xbar)
    const int G = gridDim.x, bid = blockIdx.x;
    const int NGW = G * 8;
    const int wave = __builtin_amdgcn_readfirstlane((int)threadIdx.x >> 6);
#define PHASE_IDS int lane_ = fresh_lane_id(); const int lane = lane_, tid = wave * 64 + lane, gw = bid * 8 + wave; (void)gw; (void)tid;
    unsigned char* ws = a.ws;
    bf16_t* Wt_in0 = (bf16_t*)(ws + WS_WIN0); bf16_t* Wt_grp = (bf16_t*)(ws + WS_WGRP); bf16_t* Wt_out0 = (bf16_t*)(ws + WS_WOUT0);
    bf16_t* Wt_in1 = (bf16_t*)(ws + WS_WIN1); bf16_t* Wt_out1 = (bf16_t*)(ws + WS_WOUT1);
    float* invr0 = (float*)(ws + WS_INVR); float* part1 = (float*)(ws + WS_PART1); float* ssb = (float*)(ws + WS_SS); float* decb = (float*)(ws + WS_DEC);
    bf16_t* XB = (bf16_t*)(ws + WS_XB); bf16_t* BA = (bf16_t*)(ws + WS_A); bf16_t* BB = (bf16_t*)(ws + WS_B); bf16_t* BC = (bf16_t*)(ws + WS_C);

    {
        pg8::StaticOrder S; S.init(DI, DM, G, bid); pg8::Unit uf;
        if (S.next(0, uf)) {
            PHASE_IDS
            LAS float* scr = (LAS float*)(lds + wave * 16384);
            const int gsel = uf.pm >> 1, nb0 = (uf.pm & 1) * 8;
            for (int q = wave; q < 64; q += 8) {
                const TItem t{a.pool_w_grp + (size_t)gsel * 512 * 512, Wt_grp, nullptr, a.pool_scale + gsel * 512, 512, 512, gsel * 512, (q >> 3) * 16 + nb0 + (q & 7), 1.0f};
                float wv[32]; titem_issue(t, lane, wv); titem_finish(t, lane, wv, scr); }
            for (int idx = tid; idx < 256 * 64; idx += 512) {
                const int k = uf.pn * 256 + (idx >> 6), c8 = gsel * 512 + (idx & 63) * 8; const float gk = a.norm_g[k];
                const f32x4 w0 = __builtin_nontemporal_load((const f32x4*)(a.pool_w_in + (size_t)k * 4096 + c8)), w1 = __builtin_nontemporal_load((const f32x4*)(a.pool_w_in + (size_t)k * 4096 + c8 + 4));
                u32x4 o; o.x = pkbf(w0[0] * gk, w0[1] * gk); o.y = pkbf(w0[2] * gk, w0[3] * gk); o.z = pkbf(w1[0] * gk, w1[1] * gk); o.w = pkbf(w1[2] * gk, w1[3] * gk);
                *(u32x4*)(BC + (size_t)k * DI + c8) = o; }
            asm volatile("s_waitcnt vmcnt(0)" ::: "memory");
            __syncthreads();
        }
        pg8::Gemm g{Wt_grp, BC, 512, DI, 512, 0, 2};
        pg8::EpiFold E{Wt_in0};
        pg8::gemm_phase<pg8::EpiFold>(lds, g, S, E, wave);
    }
    {
        PHASE_IDS
        LAS float* scr = (LAS float*)(lds + wave * 16384);
        constexpr int I_IN0 = (DM / 64) * (2048 / 32), I_OUT = (DI / 64) * (DM / 32), I_IN1 = (DM / 64) * (8192 / 32);
        constexpr int NITEMS = I_IN0 + I_OUT + I_IN1 + I_OUT;
        auto decode = [&](int it) -> TItem {
            int r = it;
            if (r < I_IN0) {
                const int kb = r >> 6, nb = r & 63, n0 = 2048 + 32 * nb, d0 = 256 * ((n0 - 2048) >> 7) + 128 + (n0 & 127);
                return TItem{a.pool_w_in, Wt_in0, a.norm_g, nullptr, DM, 4096, d0 - n0, kb * 128 + 64 + nb, NEG_LOG2E}; } r -= I_IN0;
            if (r < I_OUT) return TItem{a.pool_w_out, Wt_out0, nullptr, nullptr, DI, DM, 0, r, NEG_LN2}; r -= I_OUT;
            if (r < I_IN1) {
                const int n0 = 32 * (r % (8192 / 32)); int d0 = n0;
                if (n0 < 2048) d0 = 256 * (n0 >> 7) + (n0 & 127); else if (n0 < 4096) d0 = 256 * ((n0 - 2048) >> 7) + 128 + (n0 & 127);
                return TItem{a.hgrn_w_in, Wt_in1, a.norm_g + DM, nullptr, DM, 8192, d0 - n0, r, n0 >= 6144 ? NEG_LOG2E : 1.0f}; } r -= I_IN1;
            return TItem{a.hgrn_w_out, Wt_out1, a.hgrn_norm_g, nullptr, DI, DM, 0, r, NEG_LN2};
        };
        __syncthreads();
        {
            float wa[32], wb[32]; TItem ia{}, ib{};
            int it = gw; bool ha = it < NITEMS;
            if (ha) { ia = decode(it); titem_issue(ia, lane, wa); }
            while (ha) {
                const int itb = it + NGW; const bool hb = itb < NITEMS;
                if (hb) { ib = decode(itb); titem_issue(ib, lane, wb); }
                titem_finish(ia, lane, wa, scr);
                it = itb + NGW; ha = it < NITEMS;
                if (ha) { ia = decode(it); titem_issue(ia, lane, wa); }
                if (!hb) break;
                titem_finish(ib, lane, wb, scr);
            }
        }
        for (int m0 = gw * 8; m0 < M; m0 += NGW * 8) {
            f32x4 v[8][4]; float s[8];
#pragma unroll
            for (int r = 0; r < 8; ++r) { const f32x4* xr = (const f32x4*)(a.x + (size_t)(m0 + r) * DM) + lane;
#pragma unroll
                for (int j = 0; j < 4; ++j) v[r][j] = __builtin_nontemporal_load(xr + 64 * j); }
#pragma unroll
            for (int r = 0; r < 8; ++r) { s[r] = 0.f;
#pragma unroll
                for (int j = 0; j < 4; ++j) s[r] += (v[r][j][0] * v[r][j][0] + v[r][j][1] * v[r][j][1]) + (v[r][j][2] * v[r][j][2] + v[r][j][3] * v[r][j][3]); }
#pragma unroll
            for (int o = 1; o < 64; o <<= 1) {
#pragma unroll
                for (int r = 0; r < 8; ++r) s[r] += xor_get(s[r], lane, o); }
#pragma unroll
            for (int r = 0; r < 8; ++r) { const float rms = sqrtf(s[r] * (1.0f / DM) + EPS), rstd = 1.0f / rms;
                if (lane == 0) invr0[m0 + r] = rms;
                unsigned long long* o8 = (unsigned long long*)(XB + (size_t)(m0 + r) * DM) + lane;
#pragma unroll
                for (int j = 0; j < 4; ++j) o8[64 * j] = (unsigned long long)pkbf(v[r][j][0] * rstd, v[r][j][1] * rstd) | ((unsigned long long)pkbf(v[r][j][2] * rstd, v[r][j][3] * rstd) << 32); }
        }
    }
    GRID_BAR();

    {
        pg8::Gemm g{XB, Wt_in0, DM, DM, DM, 0, 0}; pg8::StaticOrder S; S.init(M, 4096, G, bid);
        pg8::EpiP1 E{BB, (unsigned char*)BA, (unsigned char*)BA + 16 * MiB};
        pg8::gemm_phase<pg8::EpiP1>(lds, g, S, E, wave);
    }
    GRID_BAR();

    {
        PHASE_IDS
        const unsigned char* HALO = (const unsigned char*)BA; const unsigned char* SG0 = (const unsigned char*)BA + 16 * MiB;
        for (int idx = bid * 512 + tid; idx < 120 * 256; idx += G * 512) {
            const int sub = idx & 255, pq = idx >> 8, pm = (pq / 15) * 16 + (pq % 15) + 1;
            const int pn = sub >> 4, wc = (sub >> 2) & 3, fq = sub & 3, w = 2 << (pn >> 2);
            const unsigned char* hp = HALO + (size_t)((pm - 1) * 16 + pn) * pg8::HALO_TILE + (unsigned)((wc * 64 + fq * 16) * 16);
            const unsigned char* sp = SG0 + (size_t)(pm * 16 + pn) * pg8::HALO_TILE + (unsigned)((wc * 64 + fq * 16) * 16);
            bf16_t* zp = BB + (size_t)(pm * 256) * DI + pn * 128 + wc * 32 + fq * 8;
            const float inv = 1.0f / (float)w;
            float suf[8];
#pragma unroll
            for (int c = 0; c < 8; ++c) suf[c] = 0.f;
            for (int i = 15; i >= 17 - w; --i) {
                const u32x4 hv = *(const u32x4*)(hp + i * 16);
                suf[0] += bf_lo(hv.x); suf[1] += bf_hi(hv.x); suf[2] += bf_lo(hv.y); suf[3] += bf_hi(hv.y); suf[4] += bf_lo(hv.z); suf[5] += bf_hi(hv.z); suf[6] += bf_lo(hv.w); suf[7] += bf_hi(hv.w);
                const int t = w - 1 - (16 - i);
                const u32x4 sg = *(const u32x4*)(sp + t * 16);
                u32x4* q = (u32x4*)(zp + (size_t)t * DI); const u32x4 o = *q;
                u32x4 r; r.x = pkbf(bf_lo(o.x) + suf[0] * inv * bf_lo(sg.x), bf_hi(o.x) + suf[1] * inv * bf_hi(sg.x)); r.y = pkbf(bf_lo(o.y) + suf[2] * inv * bf_lo(sg.y), bf_hi(o.y) + suf[3] * inv * bf_hi(sg.y));
                r.z = pkbf(bf_lo(o.z) + suf[4] * inv * bf_lo(sg.z), bf_hi(o.z) + suf[5] * inv * bf_hi(sg.z)); r.w = pkbf(bf_lo(o.w) + suf[6] * inv * bf_lo(sg.w), bf_hi(o.w) + suf[7] * inv * bf_hi(sg.w));
                *q = r;
            }
        }
    }
    GRID_BAR();

    {
        pg8::Gemm g{BB, Wt_out0, DI, DI, DI, 0, 0}; pg8::StaticOrder S; S.init(M, DM, G, bid);
        pg8::EpiRes<true, false> E{XB, invr0, nullptr, XB, part1};
        pg8::gemm_phase<pg8::EpiRes<true, false>>(lds, g, S, E, wave);
    }
    GRID_BAR();

    {
        pg8::Gemm g{XB, Wt_in1, DM, DM, DM, 0, 0}; pg8::StaticOrder S; S.init(M, 6144, G, bid);
        pg8::EpiP4 E{BA, BB, BC, decb, part1, a.hgrn_lb};
        pg8::gemm_phase<pg8::EpiP4>(lds, g, S, E, wave);
    }
    GRID_BAR();

    scan::phase(lds, BA, BB, BC, decb, ssb, bid, G, wave);
    GRID_BAR();

    {
        pg8::Gemm g{XB, Wt_in1 + (size_t)6144 * DM, DM, DM, DM, 0, 0}; pg8::StaticOrder S; S.init(M, DI, G, bid);
        pg8::EpiP5b E{BC, part1, ssb};
        pg8::gemm_phase<pg8::EpiP5b>(lds, g, S, E, wave);
    }
    GRID_BAR();

    {
        pg8::Gemm g{BC, Wt_out1, DI, DI, DI, 0, 0}; pg8::StaticOrder S; S.init(M, DM, G, bid);
        pg8::EpiFinal E{XB, a.out, a.final_g, (float*)(ws + WS_X), (unsigned*)(ws + WS_CNT)};
        pg8::gemm_phase<pg8::EpiFinal>(lds, g, S, E, wave);
    }
}

extern "C" void kernel_launch(void* const* d_in, const int* in_sizes, int n_in, void* d_out, int out_size, void* d_ws, size_t ws_size, hipStream_t stream) {
    static int grid = 0;
    if (grid == 0) {
        if (n_in != 11 || in_sizes[0] != M * DM || out_size != M * DM || ws_size < WS_END) { fprintf(stderr, "kernel_launch: unexpected shapes (n_in %d in0 %d out %d ws %zu)\n", n_in, n_in > 0 ? in_sizes[0] : -1, out_size, ws_size); grid = -1; return; }
        int dev = 0, cus = 0, per = 0;
        if (hipGetDevice(&dev) != hipSuccess || hipDeviceGetAttribute(&cus, hipDeviceAttributeMultiprocessorCount, dev) != hipSuccess) { grid = -1; return; }
        if (hipFuncSetAttribute((const void*)fwd_kernel, hipFuncAttributeMaxDynamicSharedMemorySize, LDS_BYTES) != hipSuccess) { fprintf(stderr, "kernel_launch: hipFuncSetAttribute failed\n"); grid = -1; return; }
        if (hipOccupancyMaxActiveBlocksPerMultiprocessor(&per, (const void*)fwd_kernel, 512, LDS_BYTES) != hipSuccess || per < 1) { fprintf(stderr, "kernel_launch: occupancy query says %d\n", per); (void)hipGetLastError(); grid = -1; return; }
        grid = cus;
        fprintf(stderr, "kernel_launch: cus %d per_cu %d grid %d\n", cus, per, grid);
    }
    if (grid < 0) return;
    if (hipMemsetAsync(d_ws, 0, 32768, stream) != hipSuccess) { fprintf(stderr, "kernel_launch: hipMemsetAsync failed\n"); return; }
    Args a{};
    a.x = (const float*)d_in[0]; a.norm_g = (const float*)d_in[1]; a.pool_w_in = (const float*)d_in[2]; a.pool_w_grp = (const float*)d_in[3];
    a.pool_scale = (const float*)d_in[4]; a.pool_w_out = (const float*)d_in[5]; a.hgrn_w_in = (const float*)d_in[6]; a.hgrn_lb = (const float*)d_in[7];
    a.hgrn_norm_g = (const float*)d_in[8]; a.hgrn_w_out = (const float*)d_in[9]; a.final_g = (const float*)d_in[10];
    a.out = (float*)d_out; a.ws = (unsigned char*)d_ws;
    void* args[] = {&a};
    hipError_t e = hipLaunchCooperativeKernel((void*)fwd_kernel, dim3(grid), dim3(512), args, LDS_BYTES, stream);
    if (e != hipSuccess) fprintf(stderr, "kernel_launch: cooperative launch failed: %s (grid %d)\n", hipGetErrorString(e), grid);
}
```

```cpp
#include <hip/hip_runtime.h>
#include <cstdio>
#include <cstdint>

#define LAS __attribute__((address_space(3)))
typedef unsigned short bf16_t;
typedef short bf16x8 __attribute__((ext_vector_type(8)));
typedef float f32x4 __attribute__((ext_vector_type(4)));
typedef float f32x2 __attribute__((ext_vector_type(2)));
typedef unsigned u32x4 __attribute__((ext_vector_type(4)));
typedef unsigned u32x2 __attribute__((ext_vector_type(2)));

constexpr int DM = 1024, BATCH = 8, SEQ = 4096, DI = 2048, M = BATCH * SEQ;
constexpr int NHEAD = 16, HD = 128;
constexpr float EPS = 1e-6f;
constexpr size_t MiB = 1u << 20;
constexpr size_t WS_WIN0 = 2 * MiB;
constexpr size_t WS_WGRP = 10 * MiB;
constexpr size_t WS_WOUT0 = 12 * MiB;
constexpr size_t WS_WIN1 = 16 * MiB;
constexpr size_t WS_WOUT1 = 32 * MiB;
constexpr size_t WS_PART1 = 36 * MiB;
constexpr size_t WS_INVR = 38 * MiB;
constexpr size_t WS_CNT = 16384;
constexpr size_t WS_X = 40 * MiB;
constexpr size_t WS_DEC = 44 * MiB;
constexpr size_t WS_SS = 112 * MiB;
constexpr size_t WS_XB = 48 * MiB;
constexpr size_t WS_A = 128 * MiB;
constexpr size_t WS_B = 256 * MiB;
constexpr size_t WS_C = 384 * MiB;
constexpr size_t WS_END = 512 * MiB;
constexpr int LDS_BYTES = 163840;
constexpr unsigned XST_OFF = 163840u - 256u;

typedef __bf16 bf2_t __attribute__((ext_vector_type(2)));
__device__ __forceinline__ unsigned pkbf(float lo, float hi) { f32x2 v = {lo, hi}; return __builtin_bit_cast(unsigned, __builtin_convertvector(v, bf2_t)); }
__device__ __forceinline__ float bf_lo(unsigned w) { return __builtin_bit_cast(float, w << 16); }
__device__ __forceinline__ float bf_hi(unsigned w) { return __builtin_bit_cast(float, w & 0xffff0000u); }
__device__ __forceinline__ float silu_f(float x) { return x * __builtin_amdgcn_rcpf(1.0f + __builtin_amdgcn_exp2f(-1.44269504089f * x)); }
__device__ __forceinline__ float silu_pre(float t) { return t * __builtin_amdgcn_rcpf(1.0f + __builtin_amdgcn_exp2f(t)); }
constexpr float NEG_LOG2E = -1.44269504089f, NEG_LN2 = -0.69314718056f;
__device__ __forceinline__ int fresh_lane_id() { int l; asm volatile("v_mbcnt_lo_u32_b32 %0, -1, 0\n\tv_mbcnt_hi_u32_b32 %0, -1, %0" : "=v"(l)); return l; }
__device__ __forceinline__ float lane_get(float v, int src_lane) { return __builtin_bit_cast(float, __builtin_amdgcn_ds_bpermute(src_lane << 2, __builtin_bit_cast(int, v))); }
__device__ __forceinline__ float xor_get(float v, int lane, int m) { return lane_get(v, lane ^ m); }
__device__ __forceinline__ float wave_sum(float v, int lane) {
#pragma unroll
    for (int o = 1; o < 64; o <<= 1) v += xor_get(v, lane, o);
    return v;
}

namespace pg8 {
constexpr int BM = 256, BK = 64, HALF = 128, HTB = HALF * BK * 2, NXCD = 8, WGM = 4;
__host__ __device__ __forceinline__ int lds_byte(int r, int c) { const int st = (r >> 4) * 2 + (c >> 5), rr = r & 15, cc = c & 31, ob = rr * 64 + cc * 2; return st * 1024 + (ob ^ (((ob >> 9) & 1) << 5)); }
__host__ __device__ __forceinline__ void stage_rc(int b, int& R, int& C) { const int st = b / 1024, sb = b % 1024, swz = sb ^ (((sb >> 9) & 1) << 5); R = (st >> 1) * 16 + swz / 64; C = (st & 1) * 32 + (swz % 64) / 2; }
__host__ __device__ __forceinline__ int perm32(int rho) { const int n = rho >> 4, i = rho & 15; return 8 * (i >> 2) + 4 * n + (i & 3); }

struct Unit { int pm, pn; };
struct Gemm { const bf16_t* A; const bf16_t* Bt; int lda, ldb, K, grp_tiles, grp_b; };

struct StaticOrder {
    int nM, nN, nwg, G, c;
    __host__ __device__ void init(int M_, int N_, int G_, int c_) { nM = M_ / BM; nN = N_ / BM; nwg = nM * nN; G = G_; c = c_; }
    __host__ __device__ bool next(int i, Unit& u) const {
        const long L = (long)i * G + c; if (L >= nwg) return false;
        int wgid = (int)L; { const int q = nwg / NXCD, r = nwg % NXCD, xcd = wgid % NXCD, off = wgid / NXCD; wgid = (xcd < r ? xcd * (q + 1) : r * (q + 1) + (xcd - r) * q) + off; }
        const int nig = WGM * nN, gid = wgid / nig, fm = gid * WGM, gsz = (nM - fm) < WGM ? (nM - fm) : WGM;
        u.pm = fm + ((wgid % nig) % gsz); u.pn = (wgid % nig) / gsz; return true;
    }
};


__device__ __forceinline__ void zero_acc(f32x4 (&acc)[2][2][4][2]) {
#pragma unroll
    for (int a = 0; a < 2; ++a)
#pragma unroll
        for (int b = 0; b < 2; ++b)
#pragma unroll
            for (int m = 0; m < 4; ++m)
#pragma unroll
                for (int n = 0; n < 2; ++n) acc[a][b][m][n] = (f32x4){0.f, 0.f, 0.f, 0.f};
}
template <class Epi, bool ALIGN_EPI = true, bool SP2 = true>
__device__ __forceinline__ void gemm_phase(LAS unsigned char* lds, const Gemm g, const StaticOrder& S, const Epi& E, const int wid) {
    int lane_ = fresh_lane_id();
    int lane = lane_, tid = wid * 64 + lane, fr = lane & 15, fq = lane >> 4; const int wr = wid >> 2, wc = wid & 3;
    const int K = g.K, nt = K / BK;
    unsigned voffA[2], voffB[2]; int aoff, boff;
#define PG8_LANE_STATE() do { _Pragma("unroll") for (int i = 0; i < 2; ++i) { int R, C; stage_rc(tid * 16 + i * 8192, R, C); const int Rb = Epi::PERM ? ((R & ~31) + perm32(R & 31)) : R; \
        voffA[i] = (unsigned)(R * g.lda + C) * 2u; voffB[i] = (unsigned)(Rb * g.ldb + C) * 2u; } \
        aoff = lds_byte(wr * 64 + fr, fq * 8); boff = lds_byte(wc * 32 + fr, fq * 8); } while (0)
    PG8_LANE_STATE();
    const size_t kstep = (size_t)(BK * 2);
    const size_t hstepA = (size_t)HALF * g.lda * 2, hstepB = (size_t)HALF * g.ldb * 2;
    const size_t tstepA = 2 * hstepA, tstepB = 2 * hstepB;
    const unsigned ldsw = (unsigned)wid * 1024u;
#define PG8_SA(b, h) (((b) * 2 + (h)) * HTB)
#define PG8_SB(b, h) ((4 + (b) * 2 + (h)) * HTB)
#define PG8_STAGE(bufoff, gbase, voff) do { _Pragma("unroll") for (int _i = 0; _i < 2; ++_i) \
        __builtin_amdgcn_global_load_lds((const unsigned*)((const char*)(gbase) + (voff)[_i]), (LAS unsigned*)(lds + (bufoff) + ldsw + _i * 8192), 16, 0, 0); } while (0)
#define PG8_LDA(dst, b, h) do { _Pragma("unroll") for (int m = 0; m < 4; ++m) _Pragma("unroll") for (int k = 0; k < 2; ++k) dst[m][k] = *(const LAS bf16x8*)(lds + PG8_SA(b, h) + aoff + m * 2048 + k * 1024); } while (0)
#define PG8_LDB(dst, b, h) do { _Pragma("unroll") for (int n = 0; n < 2; ++n) _Pragma("unroll") for (int k = 0; k < 2; ++k) dst[n][k] = *(const LAS bf16x8*)(lds + PG8_SB(b, h) + boff + n * 2048 + k * 1024); } while (0)
#define PG8_MMA(ai, bj, At, Bt) do { __builtin_amdgcn_s_setprio(1); _Pragma("unroll") for (int m = 0; m < 4; ++m) _Pragma("unroll") for (int n = 0; n < 2; ++n) _Pragma("unroll") for (int k = 0; k < 2; ++k) \
        acc[ai][bj][m][n] = __builtin_amdgcn_mfma_f32_16x16x32_bf16(Bt[n][k], At[m][k], acc[ai][bj][m][n], 0, 0, 0); __builtin_amdgcn_s_setprio(0); } while (0)
#define PG8_WAIT_V(n) asm volatile("s_waitcnt vmcnt(" #n ")" ::: "memory")
#define PG8_WAIT_L(n) asm volatile("s_waitcnt lgkmcnt(" #n ")" ::: "memory")
#define PG8_BAR __builtin_amdgcn_s_barrier()
#define PG8_SCHED __builtin_amdgcn_sched_barrier(0)
#define PG8_ABASE(u) ((const char*)g.A + (size_t)(u).pm * tstepA + (g.grp_tiles ? (size_t)((u).pn / g.grp_tiles) * (size_t)K * 2 : (size_t)0))
#define PG8_BBASE(u) ((const char*)g.Bt + (size_t)(u).pn * tstepB + (g.grp_b ? (size_t)((u).pm / g.grp_b) * (size_t)K * 2 : (size_t)0))
    Unit cur, nxt; int ui = 0;
    E.prologue(S, lds, tid);
    if (!S.next(0, cur)) return;
    f32x4 acc[2][2][4][2];
    E.init_acc(acc, cur, wr, wc, fr, fq);
    bf16x8 At[4][2], B0[2][2], B1[2][2];
    const char* cA = PG8_ABASE(cur); const char* cB = PG8_BBASE(cur);
    if constexpr (SP2) {
        PG8_STAGE(PG8_SB(0, 0), cB, voffB); PG8_STAGE(PG8_SB(0, 1), cB + hstepB, voffB); PG8_STAGE(PG8_SA(0, 0), cA, voffA); PG8_STAGE(PG8_SA(0, 1), cA + hstepA, voffA);
        if (wr == 1) PG8_BAR;
        PG8_WAIT_V(2); PG8_BAR;
        PG8_STAGE(PG8_SB(1, 0), cB + kstep, voffB); PG8_STAGE(PG8_SA(1, 0), cA + kstep, voffA); PG8_STAGE(PG8_SB(1, 1), cB + hstepB + kstep, voffB);
        PG8_WAIT_V(6); PG8_BAR;
    } else {
        PG8_STAGE(PG8_SB(0, 0), cB, voffB); PG8_STAGE(PG8_SA(0, 0), cA, voffA); PG8_STAGE(PG8_SB(0, 1), cB + hstepB, voffB); PG8_STAGE(PG8_SA(0, 1), cA + hstepA, voffA);
        if (wr == 1) PG8_BAR;
        PG8_WAIT_V(4); PG8_BAR;
        PG8_STAGE(PG8_SB(1, 0), cB + kstep, voffB); PG8_STAGE(PG8_SA(1, 0), cA + kstep, voffA); PG8_STAGE(PG8_SB(1, 1), cB + hstepB + kstep, voffB);
        PG8_WAIT_V(6); PG8_BAR;
    }
    for (;;) {
        const bool has_next = S.next(ui + 1, nxt);
        const char* nA = has_next ? PG8_ABASE(nxt) : cA; const char* nB = has_next ? PG8_BBASE(nxt) : cB;
        for (int t = 0; t < nt; t += 2) {
            const bool last = (t == nt - 2);
            const char* a1 = cA + (size_t)(t + 1) * kstep;
            const char* a2 = last ? nA : cA + (size_t)(t + 2) * kstep; const char* b2 = last ? nB : cB + (size_t)(t + 2) * kstep;
            const char* a3 = a2 + kstep; const char* b3 = b2 + kstep;
            if constexpr (SP2) {
            PG8_LDB(B0, 0, 0); PG8_LDB(B1, 0, 1); PG8_SCHED; PG8_LDA(At, 0, 0); PG8_STAGE(PG8_SA(1, 1), a1 + hstepA, voffA);
            PG8_WAIT_V(8); PG8_WAIT_L(0); PG8_BAR; PG8_MMA(0, 0, At, B0); PG8_MMA(0, 1, At, B1); PG8_BAR; PG8_SCHED;
            PG8_LDA(At, 0, 1); PG8_STAGE(PG8_SB(0, 0), b2, voffB); PG8_STAGE(PG8_SB(0, 1), b2 + hstepB, voffB); PG8_STAGE(PG8_SA(0, 0), a2, voffA);
            PG8_WAIT_V(8); PG8_WAIT_L(0); PG8_BAR; PG8_MMA(1, 0, At, B0); PG8_MMA(1, 1, At, B1); PG8_BAR; PG8_SCHED;
            PG8_LDB(B0, 1, 0); PG8_LDB(B1, 1, 1); PG8_SCHED; PG8_LDA(At, 1, 0); PG8_STAGE(PG8_SA(0, 1), a2 + hstepA, voffA);
            PG8_WAIT_V(8); PG8_WAIT_L(0); PG8_BAR; PG8_MMA(0, 0, At, B0); PG8_MMA(0, 1, At, B1); PG8_BAR; PG8_SCHED;
            PG8_LDA(At, 1, 1); PG8_STAGE(PG8_SB(1, 0), b3, voffB); PG8_STAGE(PG8_SB(1, 1), b3 + hstepB, voffB); PG8_STAGE(PG8_SA(1, 0), a3, voffA);
            PG8_WAIT_V(8); PG8_WAIT_L(0); PG8_BAR; PG8_MMA(1, 0, At, B0); PG8_MMA(1, 1, At, B1); PG8_BAR; PG8_SCHED;
            } else {
            PG8_LDB(B0, 0, 0); PG8_SCHED; PG8_LDA(At, 0, 0); PG8_STAGE(PG8_SA(1, 1), a1 + hstepA, voffA);
            PG8_WAIT_L(8); PG8_BAR; PG8_WAIT_L(0); PG8_MMA(0, 0, At, B0); PG8_BAR; PG8_SCHED;
            PG8_LDB(B1, 0, 1); PG8_STAGE(PG8_SB(0, 0), b2, voffB);
            PG8_BAR; PG8_WAIT_L(0); PG8_MMA(0, 1, At, B1); PG8_BAR;
            PG8_LDA(At, 0, 1); PG8_STAGE(PG8_SA(0, 0), a2, voffA);
            PG8_BAR; PG8_WAIT_L(0); PG8_MMA(1, 0, At, B0); PG8_BAR; PG8_SCHED;
            PG8_STAGE(PG8_SB(0, 1), b2 + hstepB, voffB);
            PG8_WAIT_V(6); PG8_BAR; PG8_MMA(1, 1, At, B1); PG8_BAR;
            PG8_LDB(B0, 1, 0); PG8_SCHED; PG8_LDA(At, 1, 0); PG8_STAGE(PG8_SA(0, 1), a2 + hstepA, voffA);
            PG8_WAIT_L(8); PG8_BAR; PG8_WAIT_L(0); PG8_MMA(0, 0, At, B0); PG8_BAR; PG8_SCHED;
            PG8_LDB(B1, 1, 1); PG8_STAGE(PG8_SB(1, 0), b3, voffB);
            PG8_BAR; PG8_WAIT_L(0); PG8_MMA(0, 1, At, B1); PG8_BAR;
            PG8_LDA(At, 1, 1); PG8_STAGE(PG8_SA(1, 0), a3, voffA);
            PG8_BAR; PG8_WAIT_L(0); PG8_MMA(1, 0, At, B0); PG8_BAR; PG8_SCHED;
            PG8_STAGE(PG8_SB(1, 1), b3 + hstepB, voffB);
            PG8_WAIT_V(6); PG8_BAR; PG8_MMA(1, 1, At, B1); PG8_BAR;
            }
        }
        if constexpr (ALIGN_EPI) { if (wr == 0) PG8_BAR; }
        if constexpr (!Epi::AFTER_DRAIN) E(acc, cur, wr, wc, fr, fq, lds, ui);
        if (!has_next) break;
        cur = nxt; cA = nA; cB = nB; ++ui;
        asm volatile("" : "+v"(lane)); tid = wid * 64 + lane; fr = lane & 15; fq = lane >> 4; PG8_LANE_STATE();
        E.init_acc(acc, cur, wr, wc, fr, fq);
        if constexpr (ALIGN_EPI) { if (wr == 1) PG8_BAR; }
    }
    PG8_WAIT_V(0);
    if constexpr (!ALIGN_EPI) { if (wr == 0) PG8_BAR; }
    PG8_BAR;
    if constexpr (Epi::AFTER_DRAIN) E.fused(acc, cur, wr, wc, fr, fq, lds, tid);
#undef PG8_SA
#undef PG8_SB
#undef PG8_STAGE
#undef PG8_LDA
#undef PG8_LDB
#undef PG8_MMA
#undef PG8_WAIT_V
#undef PG8_WAIT_L
#undef PG8_BAR
#undef PG8_SCHED
#undef PG8_ABASE
#undef PG8_LANE_STATE
#undef PG8_BBASE
}

constexpr unsigned TAB_OFF = 131072u;
__device__ __forceinline__ void row_scan_mul4(float& a, float& b, float& c, float& d) {
#define PG8_SCAN_STEP(n) "v_mul_f32_dpp %0, %0, %0 row_shr:" #n " row_mask:0xf bank_mask:0xf\n" "v_mul_f32_dpp %1, %1, %1 row_shr:" #n " row_mask:0xf bank_mask:0xf\n" \
                         "v_mul_f32_dpp %2, %2, %2 row_shr:" #n " row_mask:0xf bank_mask:0xf\n" "v_mul_f32_dpp %3, %3, %3 row_shr:" #n " row_mask:0xf bank_mask:0xf\n"
    asm("s_nop 1\n" PG8_SCAN_STEP(1) PG8_SCAN_STEP(2) PG8_SCAN_STEP(4) PG8_SCAN_STEP(8) : "+v"(a), "+v"(b), "+v"(c), "+v"(d));
#undef PG8_SCAN_STEP
}
__device__ __forceinline__ void row_scan_add4(float& a, float& b, float& c, float& d) {
#define PG8_SCAN_STEP(n) "v_add_f32_dpp %0, %0, %0 row_shr:" #n " row_mask:0xf bank_mask:0xf\n" "v_add_f32_dpp %1, %1, %1 row_shr:" #n " row_mask:0xf bank_mask:0xf\n" \
                         "v_add_f32_dpp %2, %2, %2 row_shr:" #n " row_mask:0xf bank_mask:0xf\n" "v_add_f32_dpp %3, %3, %3 row_shr:" #n " row_mask:0xf bank_mask:0xf\n"
    asm("s_nop 1\n" PG8_SCAN_STEP(1) PG8_SCAN_STEP(2) PG8_SCAN_STEP(4) PG8_SCAN_STEP(8) : "+v"(a), "+v"(b), "+v"(c), "+v"(d));
#undef PG8_SCAN_STEP
}
__device__ __forceinline__ float row_bcast15(float v) { float r; asm("s_nop 1\n v_mov_b32_dpp %0, %1 row_newbcast:15 row_mask:0xf bank_mask:0xf" : "=v"(r) : "v"(v)); return r; }
template <int W> __device__ __forceinline__ float window_sum(float p, float pp, float c) {
    if constexpr (W == 16) return c - pp;
    else { float w = c;
        if constexpr (W == 8) asm("s_nop 1\n v_subrev_f32_dpp %0, %1, %2 row_shl:8 row_mask:0xf bank_mask:0xf\n v_subrev_f32_dpp %0, %3, %3 row_shr:8 row_mask:0xf bank_mask:0xf" : "+v"(w) : "v"(pp), "v"(c), "v"(p));
        else if constexpr (W == 4) asm("s_nop 1\n v_subrev_f32_dpp %0, %1, %2 row_shl:12 row_mask:0xf bank_mask:0xf\n v_subrev_f32_dpp %0, %3, %3 row_shr:4 row_mask:0xf bank_mask:0xf" : "+v"(w) : "v"(pp), "v"(c), "v"(p));
        else asm("s_nop 1\n v_subrev_f32_dpp %0, %1, %2 row_shl:14 row_mask:0xf bank_mask:0xf\n v_subrev_f32_dpp %0, %3, %3 row_shr:2 row_mask:0xf bank_mask:0xf" : "+v"(w) : "v"(pp), "v"(c), "v"(p));
        return w; }
}
#define PG8_POOL_STEP(SHL, SHR) \
    asm("s_nop 1\n" \
        "v_add_f32_dpp %0, %8, %4 row_shl:" #SHL " row_mask:0xf bank_mask:0xf bound_ctrl:1\n" "v_add_f32_dpp %1, %9, %5 row_shl:" #SHL " row_mask:0xf bank_mask:0xf bound_ctrl:1\n" \
        "v_add_f32_dpp %2, %10, %6 row_shl:" #SHL " row_mask:0xf bank_mask:0xf bound_ctrl:1\n" "v_add_f32_dpp %3, %11, %7 row_shl:" #SHL " row_mask:0xf bank_mask:0xf bound_ctrl:1\n" \
        "v_add_f32_dpp %0, %4, %0 row_shr:" #SHR " row_mask:0xf bank_mask:0xf\n" "v_add_f32_dpp %1, %5, %1 row_shr:" #SHR " row_mask:0xf bank_mask:0xf\n" \
        "v_add_f32_dpp %2, %6, %2 row_shr:" #SHR " row_mask:0xf bank_mask:0xf\n" "v_add_f32_dpp %3, %7, %3 row_shr:" #SHR " row_mask:0xf bank_mask:0xf" \
        : "=&v"(a[0]), "=&v"(a[1]), "=&v"(a[2]), "=&v"(a[3]) : "v"(b[0]), "v"(b[1]), "v"(b[2]), "v"(b[3]), "v"(bp[0]), "v"(bp[1]), "v"(bp[2]), "v"(bp[3]))
template <int K> __device__ __forceinline__ void pool_step4(float (&a)[4], const float (&b)[4], const float (&bp)[4]) {
    if constexpr (K == 1) PG8_POOL_STEP(15, 1); else if constexpr (K == 2) PG8_POOL_STEP(14, 2); else PG8_POOL_STEP(12, 4);
}
#undef PG8_POOL_STEP
#define PG8_HALO_STEP(SHR) \
    asm("s_nop 1\n" "v_add_f32_dpp %0, %4, %4 row_shr:" #SHR " row_mask:0xf bank_mask:0xf bound_ctrl:1\n" "v_add_f32_dpp %1, %5, %5 row_shr:" #SHR " row_mask:0xf bank_mask:0xf bound_ctrl:1\n" \
        "v_add_f32_dpp %2, %6, %6 row_shr:" #SHR " row_mask:0xf bank_mask:0xf bound_ctrl:1\n" "v_add_f32_dpp %3, %7, %7 row_shr:" #SHR " row_mask:0xf bank_mask:0xf bound_ctrl:1" \
        : "=&v"(a[0]), "=&v"(a[1]), "=&v"(a[2]), "=&v"(a[3]) : "v"(b[0]), "v"(b[1]), "v"(b[2]), "v"(b[3]))
template <int K> __device__ __forceinline__ void halo_step4(float (&a)[4], const float (&b)[4]) { if constexpr (K == 1) PG8_HALO_STEP(1); else PG8_HALO_STEP(2); }
#undef PG8_HALO_STEP
struct EpiFold {
    static constexpr bool PERM = true, AFTER_DRAIN = false;
    __device__ __forceinline__ void init_acc(f32x4 (&acc)[2][2][4][2], const Unit&, int, int, int, int) const { zero_acc(acc); }
    __device__ __forceinline__ void prologue(const StaticOrder&, LAS unsigned char*, int) const {}
    bf16_t* WT;
    __device__ __forceinline__ void operator()(f32x4 (&acc)[2][2][4][2], const Unit& u, int wr, int wc, int fr, int fq, LAS unsigned char* lds, int ui) const {
        const unsigned k0 = (unsigned)(u.pn * BM + wc * 32 + 8 * fq);
#pragma unroll
        for (int ai = 0; ai < 2; ++ai)
#pragma unroll
            for (int m = 0; m < 4; ++m) { const unsigned c = (unsigned)(u.pm * BM + ai * HALF + wr * 64 + m * 16 + fr), drow = (c >> 7) * 256u + (c & 127u);
#pragma unroll
                for (int bj = 0; bj < 2; ++bj) { const f32x4 v0 = acc[ai][bj][m][0], v1 = acc[ai][bj][m][1];
                    u32x4 w; w.x = pkbf(v0[0], v0[1]); w.y = pkbf(v0[2], v0[3]); w.z = pkbf(v1[0], v1[1]); w.w = pkbf(v1[2], v1[3]);
                    *(u32x4*)(WT + (size_t)drow * DM + k0 + bj * HALF) = w; } }
    }
};
constexpr unsigned HALO_TILE = 4 * 64 * 16;
struct EpiP1 {
    static constexpr bool PERM = true, AFTER_DRAIN = false;
    __device__ __forceinline__ void init_acc(f32x4 (&acc)[2][2][4][2], const Unit&, int, int, int, int) const { zero_acc(acc); }
    __device__ __forceinline__ void prologue(const StaticOrder&, LAS unsigned char*, int) const {}
    bf16_t* Z; unsigned char* HALO; unsigned char* SG0;
    template <int W> __device__ __forceinline__ void tile(f32x4 (&acc)[2][2][4][2], const Unit& u, int wr, int wc, int fr, int fq, LAS unsigned char* lds) const {
        const unsigned lane = (unsigned)(fq * 16 + fr);
        LAS unsigned char* HX = lds + TAB_OFF;
        const unsigned sideofs = (unsigned)(u.pm * 16 + u.pn) * HALO_TILE + ((unsigned)wc * 64u + lane) * 16u;
#pragma unroll
        for (int ai = 0; ai < 2; ++ai) {
            u32x4 h; h.x = pkbf(acc[ai][0][3][0][0], acc[ai][0][3][0][1]); h.y = pkbf(acc[ai][0][3][0][2], acc[ai][0][3][0][3]); h.z = pkbf(acc[ai][0][3][1][0], acc[ai][0][3][1][1]); h.w = pkbf(acc[ai][0][3][1][2], acc[ai][0][3][1][3]);
            const int sl = 2 * ai + wr;
            if (sl < 3) *(LAS u32x4*)(HX + ((unsigned)(sl * 4 + wc) * 64u + lane) * 16u) = h;
            else *(u32x4*)(HALO + sideofs) = h;
        }
        asm volatile("s_waitcnt lgkmcnt(0)" ::: "memory"); __builtin_amdgcn_s_barrier(); asm volatile("" ::: "memory");
        const bool seq0 = (u.pm & 15) == 0;
        const float invw = 1.0f / (float)W;
        const float inv00 = seq0 ? 1.0f / (float)((fr + 1) < W ? (fr + 1) : W) : invw;
        const unsigned zofs = ((unsigned)(u.pm * BM + wr * 64 + fr) * DI + (unsigned)(u.pn * HD + wc * 32 + 8 * fq)) * 2u;
#pragma unroll
        for (int ai = 0; ai < 2; ++ai) {
            const int sl = 2 * ai + wr;
            float pp[2][4], pt[2][4];
            if (sl > 0) {
                const u32x4 h = *(const LAS u32x4*)(HX + ((unsigned)((sl - 1) * 4 + wc) * 64u + lane) * 16u);
                pp[0][0] = bf_lo(h.x); pp[0][1] = bf_hi(h.x); pp[0][2] = bf_lo(h.y); pp[0][3] = bf_hi(h.y); pp[1][0] = bf_lo(h.z); pp[1][1] = bf_hi(h.z); pp[1][2] = bf_lo(h.w); pp[1][3] = bf_hi(h.w);
#pragma unroll
                for (int n = 0; n < 2; ++n) { row_scan_add4(pp[n][0], pp[n][1], pp[n][2], pp[n][3]);
#pragma unroll
                    for (int j = 0; j < 4; ++j) pt[n][j] = row_bcast15(pp[n][j]); }
            } else {
#pragma unroll
                for (int n = 0; n < 2; ++n)
#pragma unroll
                    for (int j = 0; j < 4; ++j) { pp[n][j] = 0.f; pt[n][j] = 0.f; }
            }
#pragma unroll
            for (int m = 0; m < 4; ++m) {
                const float inv = (sl == 0 && m == 0) ? inv00 : invw;
                float z[2][4], sgv[2][4];
#pragma unroll
                for (int n = 0; n < 2; ++n) {
                    float p[4];
#pragma unroll
                    for (int j = 0; j < 4; ++j) p[j] = acc[ai][0][m][n][j];
                    row_scan_add4(p[0], p[1], p[2], p[3]);
#pragma unroll
                    for (int j = 0; j < 4; ++j) {
                        const float ws = window_sum<W>(p[j], pp[n][j], p[j] + pt[n][j]);
                        sgv[n][j] = silu_pre(acc[ai][1][m][n][j]);
                        z[n][j] = __builtin_fmaf(ws, inv, -acc[ai][0][m][n][j]) * sgv[n][j];
                        pp[n][j] = p[j]; pt[n][j] = row_bcast15(p[j]); }
                }
                u32x4 w; w.x = pkbf(z[0][0], z[0][1]); w.y = pkbf(z[0][2], z[0][3]); w.z = pkbf(z[1][0], z[1][1]); w.w = pkbf(z[1][2], z[1][3]);
                *(u32x4*)((char*)Z + (zofs + (unsigned)((ai * HALF + m * 16) * DI) * 2u)) = w;
                if (sl == 0 && m == 0) { u32x4 g; g.x = pkbf(sgv[0][0], sgv[0][1]); g.y = pkbf(sgv[0][2], sgv[0][3]); g.z = pkbf(sgv[1][0], sgv[1][1]); g.w = pkbf(sgv[1][2], sgv[1][3]);
                    *(u32x4*)(SG0 + sideofs) = g; }
                asm volatile("" ::: "memory");
            }
        }
    }
    template <int W> __device__ __forceinline__ void tile_dbl(f32x4 (&acc)[2][2][4][2], const Unit& u, int wr, int wc, int fr, int fq, LAS unsigned char* lds) const {
        constexpr int NL = (W == 2) ? 1 : (W == 4) ? 2 : 3;
        const unsigned lane = (unsigned)(fq * 16 + fr);
        LAS unsigned char* HX = lds + TAB_OFF;
        const unsigned sideofs = (unsigned)(u.pm * 16 + u.pn) * HALO_TILE + ((unsigned)wc * 64u + lane) * 16u;
#pragma unroll
        for (int ai = 0; ai < 2; ++ai) {
            u32x4 h; h.x = pkbf(acc[ai][0][3][0][0], acc[ai][0][3][0][1]); h.y = pkbf(acc[ai][0][3][0][2], acc[ai][0][3][0][3]); h.z = pkbf(acc[ai][0][3][1][0], acc[ai][0][3][1][1]); h.w = pkbf(acc[ai][0][3][1][2], acc[ai][0][3][1][3]);
            const int sl = 2 * ai + wr;
            if (sl < 3) *(LAS u32x4*)(HX + ((unsigned)(sl * 4 + wc) * 64u + lane) * 16u) = h;
            else *(u32x4*)(HALO + sideofs) = h;
        }
        asm volatile("s_waitcnt lgkmcnt(0)" ::: "memory"); __builtin_amdgcn_s_barrier(); asm volatile("" ::: "memory");
        const bool seq0 = (u.pm & 15) == 0;
        const float invw = 1.0f / (float)W;
        const float inv00 = seq0 ? 1.0f / (float)((fr + 1) < W ? (fr + 1) : W) : invw;
        const unsigned zofs = ((unsigned)(u.pm * BM + wr * 64 + fr) * DI + (unsigned)(u.pn * HD + wc * 32 + 8 * fq)) * 2u;
#pragma unroll
        for (int ai = 0; ai < 2; ++ai) {
            const int sl = 2 * ai + wr;
            float prev[NL][2][4];
            if (sl > 0) {
                const u32x4 h = *(const LAS u32x4*)(HX + ((unsigned)((sl - 1) * 4 + wc) * 64u + lane) * 16u);
                prev[0][0][0] = bf_lo(h.x); prev[0][0][1] = bf_hi(h.x); prev[0][0][2] = bf_lo(h.y); prev[0][0][3] = bf_hi(h.y);
                prev[0][1][0] = bf_lo(h.z); prev[0][1][1] = bf_hi(h.z); prev[0][1][2] = bf_lo(h.w); prev[0][1][3] = bf_hi(h.w);
#pragma unroll
                for (int n = 0; n < 2; ++n) { if constexpr (NL >= 2) halo_step4<1>(prev[1][n], prev[0][n]); if constexpr (NL >= 3) halo_step4<2>(prev[2][n], prev[1][n]); }
            } else {
#pragma unroll
                for (int l = 0; l < NL; ++l)
#pragma unroll
                    for (int n = 0; n < 2; ++n)
#pragma unroll
                        for (int j = 0; j < 4; ++j) prev[l][n][j] = 0.f;
            }
#pragma unroll
            for (int m = 0; m < 4; ++m) {
                const float inv = (sl == 0 && m == 0) ? inv00 : invw;
                float z[2][4], sgv[2][4];
#pragma unroll
                for (int n = 0; n < 2; ++n) {
                    float l0[4], l1[4], l2[4], l3[4];
#pragma unroll
                    for (int j = 0; j < 4; ++j) l0[j] = acc[ai][0][m][n][j];
                    pool_step4<1>(l1, l0, prev[0][n]);
                    if constexpr (NL >= 2) pool_step4<2>(l2, l1, prev[1][n]);
                    if constexpr (NL >= 3) pool_step4<4>(l3, l2, prev[2][n]);
#pragma unroll
                    for (int j = 0; j < 4; ++j) {
                        const float ws = (NL == 1) ? l1[j] : (NL == 2) ? l2[j] : l3[j];
                        sgv[n][j] = silu_pre(acc[ai][1][m][n][j]);
                        z[n][j] = __builtin_fmaf(ws, inv, -l0[j]) * sgv[n][j];
                        prev[0][n][j] = l0[j]; if constexpr (NL >= 2) prev[1][n][j] = l1[j]; if constexpr (NL >= 3) prev[2][n][j] = l2[j]; }
                }
                u32x4 w; w.x = pkbf(z[0][0], z[0][1]); w.y = pkbf(z[0][2], z[0][3]); w.z = pkbf(z[1][0], z[1][1]); w.w = pkbf(z[1][2], z[1][3]);
                *(u32x4*)((char*)Z + (zofs + (unsigned)((ai * HALF + m * 16) * DI) * 2u)) = w;
                if (sl == 0 && m == 0) { u32x4 g; g.x = pkbf(sgv[0][0], sgv[0][1]); g.y = pkbf(sgv[0][2], sgv[0][3]); g.z = pkbf(sgv[1][0], sgv[1][1]); g.w = pkbf(sgv[1][2], sgv[1][3]);
                    *(u32x4*)(SG0 + sideofs) = g; }
                asm volatile("" ::: "memory");
            }
        }
    }
    __device__ __forceinline__ void operator()(f32x4 (&acc)[2][2][4][2], const Unit& u, int wr, int wc, int fr, int fq, LAS unsigned char* lds, int ui) const {
        const int g = u.pn >> 2;
        if (g == 0) tile_dbl<2>(acc, u, wr, wc, fr, fq, lds); else if (g == 1) tile_dbl<4>(acc, u, wr, wc, fr, fq, lds);
        else if (g == 2) tile_dbl<8>(acc, u, wr, wc, fr, fq, lds); else tile<16>(acc, u, wr, wc, fr, fq, lds);
    }
};
template <bool WRITE_HB, bool WRITE_H = true> struct EpiRes {
    static constexpr bool PERM = true, AFTER_DRAIN = false;
    __device__ __forceinline__ void prologue(const StaticOrder&, LAS unsigned char*, int) const {}
    const bf16_t* RB; const float* invr; float* H; bf16_t* HB; float* part;
    __device__ __forceinline__ void init_acc(f32x4 (&acc)[2][2][4][2], const Unit& u, int wr, int wc, int fr, int fq) const {
        const unsigned row0 = (unsigned)(u.pm * BM + wr * 64 + fr), col0 = (unsigned)(u.pn * BM + wc * 32 + 8 * fq);
        const unsigned ofs = (row0 * DM + col0) * 2u;
#pragma unroll
        for (int ai = 0; ai < 2; ++ai)
#pragma unroll
            for (int m = 0; m < 4; ++m) { const float ir = invr[row0 + (unsigned)(ai * HALF + m * 16)];
#pragma unroll
                for (int bj = 0; bj < 2; ++bj) { const u32x4 r = __builtin_nontemporal_load((const u32x4*)((const char*)RB + (ofs + (unsigned)((ai * HALF + m * 16) * DM + bj * HALF) * 2u)));
                    acc[ai][bj][m][0] = (f32x4){bf_lo(r.x) * ir, bf_hi(r.x) * ir, bf_lo(r.y) * ir, bf_hi(r.y) * ir};
                    acc[ai][bj][m][1] = (f32x4){bf_lo(r.z) * ir, bf_hi(r.z) * ir, bf_lo(r.w) * ir, bf_hi(r.w) * ir}; } }
    }
    __device__ __forceinline__ void operator()(f32x4 (&acc)[2][2][4][2], const Unit& u, int wr, int wc, int fr, int fq, LAS unsigned char* lds, int ui) const {
        const unsigned row0 = (unsigned)(u.pm * BM + wr * 64 + fr), col0 = (unsigned)(u.pn * BM + wc * 32 + 8 * fq);
        const unsigned ofs = (row0 * DM + col0) * 4u, pofs = (row0 * 16u + (unsigned)(u.pn * 4 + wc)) * 4u;
#pragma unroll
        for (int ai = 0; ai < 2; ++ai)
#pragma unroll
            for (int m = 0; m < 4; ++m) { const unsigned o = ofs + (unsigned)((ai * HALF + m * 16) * DM) * 4u; float ss = 0.f;
#pragma unroll
                for (int bj = 0; bj < 2; ++bj) { const unsigned oo = o + (unsigned)(bj * HALF) * 4u; const f32x4 h0 = acc[ai][bj][m][0], h1 = acc[ai][bj][m][1];
                    if (WRITE_H) { *(f32x4*)((char*)H + oo) = h0; *(f32x4*)((char*)H + oo + 16u) = h1; }
                    ss += ((h0[0] * h0[0] + h0[1] * h0[1]) + (h0[2] * h0[2] + h0[3] * h0[3])) + ((h1[0] * h1[0] + h1[1] * h1[1]) + (h1[2] * h1[2] + h1[3] * h1[3]));
                    if (WRITE_HB) { u32x4 w; w.x = pkbf(h0[0], h0[1]); w.y = pkbf(h0[2], h0[3]); w.z = pkbf(h1[0], h1[1]); w.w = pkbf(h1[2], h1[3]); *(u32x4*)((char*)HB + (oo >> 1)) = w; } }
                ss += xor_get(ss, fq * 16 + fr, 16); ss += xor_get(ss, fq * 16 + fr, 32);
                if (fq == 0) *(float*)((char*)part + (pofs + (unsigned)(ai * HALF + m * 16) * 64u)) = ss; }
    }
};
__device__ __forceinline__ float row_rstd_b(const float* part, unsigned bofs) {
    const f32x4* p = (const f32x4*)((const char*)part + bofs); const f32x4 a = p[0], b = p[1], c = p[2], d = p[3];
    return __builtin_amdgcn_rsqf((((a[0] + a[1]) + (a[2] + a[3])) + ((b[0] + b[1]) + (b[2] + b[3])) + ((c[0] + c[1]) + (c[2] + c[3])) + ((d[0] + d[1]) + (d[2] + d[3]))) * (1.0f / DM) + EPS);
}
struct EpiP4 {
    static constexpr bool PERM = true, AFTER_DRAIN = false;
    __device__ __forceinline__ void init_acc(f32x4 (&acc)[2][2][4][2], const Unit&, int, int, int, int) const { zero_acc(acc); }
    bf16_t* Qt; bf16_t* Kt; bf16_t* V; float* DEC; const float* part; const float* lbnd;
    __device__ __forceinline__ void prologue(const StaticOrder& S, LAS unsigned char* lds, int tid) const {
        LAS float* T = (LAS float*)(lds + TAB_OFF); Unit u;
        for (int i = 0; i < 12 && S.next(i, u); ++i) {
            if (tid < 256) T[i * 256 + tid] = row_rstd_b(part, (unsigned)(u.pm * BM + tid) * 64u);
            else if (u.pn < 16) {
                const int c = tid - 256, ch = u.pn * HD + (c & 127);
                const float ex = __expf(lbnd[ch] - lbnd[DI + ch]), lb = __builtin_amdgcn_rcpf(1.0f + ex);
                T[3072 + i * 256 + c] = (c < 128) ? lb : ex * lb; }
        }
        __syncthreads();
    }
    __device__ __forceinline__ void operator()(f32x4 (&acc)[2][2][4][2], const Unit& u, int wr, int wc, int fr, int fq, LAS unsigned char* lds, int ui) const {
        const unsigned row0 = (unsigned)(u.pm * BM + wr * 64 + fr);
        const LAS float* T = (const LAS float*)(lds + TAB_OFF) + ui * 256 + wr * 64 + fr;
        if (u.pn >= 16) {
            const unsigned vofs = (row0 * DI + (unsigned)((u.pn - 16) * BM + wc * 32 + 8 * fq)) * 2u;
#pragma unroll
            for (int ai = 0; ai < 2; ++ai)
#pragma unroll
                for (int m = 0; m < 4; ++m) { const float rs = T[ai * HALF + m * 16];
#pragma unroll
                    for (int bj = 0; bj < 2; ++bj) { const f32x4 v0 = acc[ai][bj][m][0] * rs, v1 = acc[ai][bj][m][1] * rs;
                        u32x4 w; w.x = pkbf(v0[0], v0[1]); w.y = pkbf(v0[2], v0[3]); w.z = pkbf(v1[0], v1[1]); w.w = pkbf(v1[2], v1[3]);
                        __builtin_nontemporal_store(w, (u32x4*)((char*)V + (vofs + (unsigned)((ai * HALF + m * 16) * DI + bj * HALF) * 2u))); } }
            return;
        }
        const unsigned c0 = (unsigned)(u.pn * HD + wc * 32 + 8 * fq);
        const unsigned qofs = (row0 * DI + c0) * 2u;
        const LAS float* LB = (const LAS float*)(lds + TAB_OFF) + 3072 + ui * 256 + wc * 32 + 8 * fq;
#pragma unroll
        for (int ai = 0; ai < 2; ++ai) {
            float rs[4], rz[4];
#pragma unroll
            for (int m = 0; m < 4; ++m) { rs[m] = T[ai * HALF + m * 16]; rz[m] = -1.44269504089f * rs[m]; }
            float bp[2][4]; f32x4 decv[2];
#pragma unroll
            for (int m = 0; m < 4; ++m) {
#pragma unroll
                for (int n = 0; n < 2; ++n) {
                    const f32x4 lbv = *(const LAS f32x4*)(LB + 4 * n), omv = *(const LAS f32x4*)(LB + 128 + 4 * n);
                    float s[4], k[4];
#pragma unroll
                    for (int j = 0; j < 4; ++j) {
                        const float sg = __builtin_amdgcn_rcpf(1.0f + __builtin_amdgcn_exp2f(acc[ai][1][m][n][j] * rz[m]));
                        s[j] = __builtin_fmaf(omv[j], sg, lbv[j]); k[j] = __builtin_fmaf(-omv[j], sg, omv[j]); }
                    row_scan_mul4(s[0], s[1], s[2], s[3]);
#pragma unroll
                    for (int j = 0; j < 4; ++j) {
                        const float E = (m == 0) ? s[j] : s[j] * bp[n][j];
                        if (m < 3) { const float tot = lane_get(s[j], fq * 16 + 15); bp[n][j] = (m == 0) ? tot : bp[n][j] * tot; }
                        const float Ei = __builtin_amdgcn_rcpf(fmaxf(E, 7.9e-31f));
                        acc[ai][0][m][n][j] = acc[ai][0][m][n][j] * (rs[m] * E); acc[ai][1][m][n][j] = k[j] * Ei;
                        if (m == 3) decv[n][j] = E; }
                }
                const unsigned ob = qofs + (unsigned)((ai * HALF + m * 16) * DI) * 2u;
                u32x4 w; w.x = pkbf(acc[ai][0][m][0][0], acc[ai][0][m][0][1]); w.y = pkbf(acc[ai][0][m][0][2], acc[ai][0][m][0][3]); w.z = pkbf(acc[ai][0][m][1][0], acc[ai][0][m][1][1]); w.w = pkbf(acc[ai][0][m][1][2], acc[ai][0][m][1][3]);
                __builtin_nontemporal_store(w, (u32x4*)((char*)Qt + ob));
                u32x4 x; x.x = pkbf(acc[ai][1][m][0][0], acc[ai][1][m][0][1]); x.y = pkbf(acc[ai][1][m][0][2], acc[ai][1][m][0][3]); x.z = pkbf(acc[ai][1][m][1][0], acc[ai][1][m][1][1]); x.w = pkbf(acc[ai][1][m][1][2], acc[ai][1][m][1][3]);
                __builtin_nontemporal_store(x, (u32x4*)((char*)Kt + ob));
                asm volatile("" ::: "memory");
            }
            if (fr == 15) { float* dp = (float*)((char*)DEC + ((unsigned)(u.pm * 4 + ai * 2 + wr) * DI + c0) * 4u); *(f32x4*)dp = decv[0]; *(f32x4*)(dp + 4) = decv[1]; }
            asm volatile("" ::: "memory");
        }
    }
};
struct EpiP5b {
    static constexpr bool PERM = true, AFTER_DRAIN = false;
    __device__ __forceinline__ void init_acc(f32x4 (&acc)[2][2][4][2], const Unit&, int, int, int, int) const { zero_acc(acc); }
    bf16_t* O; const float* part; const float* ss;
    __device__ __forceinline__ void prologue(const StaticOrder& S, LAS unsigned char* lds, int tid) const {
        LAS float* T = (LAS float*)(lds + TAB_OFF); Unit u;
        for (int i = 0; i < 4 && S.next(i, u); ++i) {
            if (tid < 256) T[i * 768 + tid] = row_rstd_b(part, (unsigned)(u.pm * BM + tid) * 64u);
            { const int r = tid >> 1, hh = tid & 1; const f32x4* sp = (const f32x4*)(ss + (size_t)(u.pm * BM + r) * 128 + (u.pn * 2 + hh) * 8); const f32x4 s0 = sp[0], s1 = sp[1];
              T[i * 768 + 256 + tid] = __builtin_amdgcn_rsqf((((s0[0] + s0[1]) + (s0[2] + s0[3])) + ((s1[0] + s1[1]) + (s1[2] + s1[3]))) * (1.0f / HD) + EPS); }
        }
        __syncthreads();
    }
    __device__ __forceinline__ void operator()(f32x4 (&acc)[2][2][4][2], const Unit& u, int wr, int wc, int fr, int fq, LAS unsigned char* lds, int ui) const {
        const unsigned row0 = (unsigned)(u.pm * BM + wr * 64 + fr), col0 = (unsigned)(u.pn * BM + wc * 32 + 8 * fq);
        const LAS float* T = (const LAS float*)(lds + TAB_OFF) + ui * 768 + wr * 64 + fr;
        const unsigned oofs = (row0 * DI + col0) * 2u;
#pragma unroll
        for (int ai = 0; ai < 2; ++ai) {
            u32x4 ov[4][2];
#pragma unroll
            for (int m = 0; m < 4; ++m)
#pragma unroll
                for (int bj = 0; bj < 2; ++bj) ov[m][bj] = *(const u32x4*)((const char*)O + (oofs + (unsigned)((ai * HALF + m * 16) * DI + bj * HALF) * 2u));
#pragma unroll
            for (int m = 0; m < 4; ++m) { const int rl = ai * HALF + m * 16; const float rs = T[rl];
#pragma unroll
                for (int bj = 0; bj < 2; ++bj) { const f32x4 v0 = acc[ai][bj][m][0] * rs, v1 = acc[ai][bj][m][1] * rs;
                    const float rh = T[256 + 2 * rl + bj + (wr * 64 + fr)];
                    const u32x4 s = ov[m][bj];
                    u32x4 w; w.x = pkbf(bf_lo(s.x) * rh * silu_pre(v0[0]), bf_hi(s.x) * rh * silu_pre(v0[1])); w.y = pkbf(bf_lo(s.y) * rh * silu_pre(v0[2]), bf_hi(s.y) * rh * silu_pre(v0[3]));
                    w.z = pkbf(bf_lo(s.z) * rh * silu_pre(v1[0]), bf_hi(s.z) * rh * silu_pre(v1[1])); w.w = pkbf(bf_lo(s.w) * rh * silu_pre(v1[2]), bf_hi(s.w) * rh * silu_pre(v1[3]));
                    *(u32x4*)((char*)O + (oofs + (unsigned)((ai * HALF + m * 16) * DI + bj * HALF) * 2u)) = w; } }
            asm volatile("" ::: "memory"); }
    }
};
struct EpiFinal {
    static constexpr bool PERM = true, AFTER_DRAIN = false;
    __device__ __forceinline__ void init_acc(f32x4 (&acc)[2][2][4][2], const Unit&, int, int, int, int) const { zero_acc(acc); }
    const bf16_t* HB; float* H; const float* fg; float* X; unsigned* cnt;
    __device__ __forceinline__ void prologue(const StaticOrder&, LAS unsigned char*, int) const {}
    __device__ __forceinline__ void operator()(f32x4 (&acc)[2][2][4][2], const Unit& u, int wr, int wc, int fr, int fq, LAS unsigned char* lds, int ui) const {
        LAS float* Pt = (LAS float*)(lds + TAB_OFF);
        LAS float* St = Pt + 1024;
        const int tid = (wr * 4 + wc) * 64 + fq * 16 + fr;
        const unsigned row0 = (unsigned)(u.pm * BM + wr * 64 + fr), col0 = (unsigned)(u.pn * BM + wc * 32 + 8 * fq);
        const unsigned ofs = (row0 * DM + col0) * 4u;
#pragma unroll
        for (int ai = 0; ai < 2; ++ai) {
            u32x4 hv[4][2];
#pragma unroll
            for (int m = 0; m < 4; ++m)
#pragma unroll
                for (int bj = 0; bj < 2; ++bj) hv[m][bj] = *(const u32x4*)((const char*)HB + ((ofs + (unsigned)((ai * HALF + m * 16) * DM + bj * HALF) * 4u) >> 1));
#pragma unroll
            for (int m = 0; m < 4; ++m) { float ss = 0.f;
#pragma unroll
                for (int bj = 0; bj < 2; ++bj) { const u32x4 hb = hv[m][bj];
                    const f32x4 h0 = acc[ai][bj][m][0] + (f32x4){bf_lo(hb.x), bf_hi(hb.x), bf_lo(hb.y), bf_hi(hb.y)}, h1 = acc[ai][bj][m][1] + (f32x4){bf_lo(hb.z), bf_hi(hb.z), bf_lo(hb.w), bf_hi(hb.w)};
                    acc[ai][bj][m][0] = h0; acc[ai][bj][m][1] = h1;
                    ss += ((h0[0] * h0[0] + h0[1] * h0[1]) + (h0[2] * h0[2] + h0[3] * h0[3])) + ((h1[0] * h1[0] + h1[1] * h1[1]) + (h1[2] * h1[2] + h1[3] * h1[3])); }
                ss += xor_get(ss, fq * 16 + fr, 16); ss += xor_get(ss, fq * 16 + fr, 32);
                if (fq == 0) Pt[(ai * HALF + wr * 64 + m * 16 + fr) * 4 + wc] = ss; }
            asm volatile("" ::: "memory"); }
        __syncthreads();
        float* xs = X + (size_t)u.pm * 1024;
        if (tid < 256) { const f32x4 p = *(const LAS f32x4*)(Pt + tid * 4);
            __hip_atomic_store(xs + u.pn * 256 + tid, (p[0] + p[1]) + (p[2] + p[3]), __ATOMIC_RELAXED, __HIP_MEMORY_SCOPE_AGENT); }
        asm volatile("s_waitcnt vmcnt(0)" ::: "memory");
        __syncthreads();
        if (tid == 0) {
            unsigned* c = cnt + 16 * u.pm;
            __hip_atomic_fetch_add(c, 1u, __ATOMIC_RELAXED, __HIP_MEMORY_SCOPE_AGENT);
            unsigned spins = 0;
            while (__hip_atomic_load(c, __ATOMIC_RELAXED, __HIP_MEMORY_SCOPE_AGENT) < 4u) { __builtin_amdgcn_s_sleep(2); if (++spins > (1u << 22)) break; }
            __builtin_amdgcn_fence(__ATOMIC_ACQUIRE, "agent");
            asm volatile("s_waitcnt vmcnt(0)" ::: "memory");
        }
        __syncthreads();
        if (tid < 256) { float s = 0.f;
#pragma unroll
            for (int t = 0; t < 4; ++t) s += __hip_atomic_load(xs + t * 256 + tid, __ATOMIC_RELAXED, __HIP_MEMORY_SCOPE_AGENT);
            St[tid] = __builtin_amdgcn_rsqf(s * (1.0f / DM) + EPS); }
        __syncthreads();
        f32x4 gv[2][2];
#pragma unroll
        for (int bj = 0; bj < 2; ++bj)
#pragma unroll
            for (int n = 0; n < 2; ++n) gv[bj][n] = *(const f32x4*)(fg + col0 + bj * HALF + n * 4);
#pragma unroll
        for (int ai = 0; ai < 2; ++ai)
#pragma unroll
            for (int m = 0; m < 4; ++m) { const float rs = St[ai * HALF + wr * 64 + m * 16 + fr];
#pragma unroll
                for (int bj = 0; bj < 2; ++bj) { const unsigned oo = ofs + (unsigned)((ai * HALF + m * 16) * DM + bj * HALF) * 4u;
                    *(f32x4*)((char*)H + oo) = acc[ai][bj][m][0] * rs * gv[bj][0]; *(f32x4*)((char*)H + oo + 16u) = acc[ai][bj][m][1] * rs * gv[bj][1]; } }
        __syncthreads();
    }
};
}

namespace scan {
#define MFMA16(a, b, c) __builtin_amdgcn_mfma_f32_16x16x32_bf16((a), (b), (c), 0, 0, 0)
__device__ __forceinline__ unsigned offb(unsigned row, unsigned ch) { return 256u * row + 16u * (ch ^ (((row & 3u) << 2) | ((row >> 2) & 3u))); }
__device__ __forceinline__ unsigned voffv(unsigned r, unsigned cp) { return 128u * r + 32u * (cp ^ (((r >> 1) & 3u) ^ (((r >> 3) & 1u) << 1))); }
__device__ __forceinline__ void tr8(unsigned a0, unsigned a1, unsigned c0, unsigned c1, bf16x8& f00, bf16x8& f01, bf16x8& f10, bf16x8& f11) {
    u32x2 r0, r1, r2, r3, r4, r5, r6, r7;
    asm volatile("ds_read_b64_tr_b16 %0, %8\n\tds_read_b64_tr_b16 %1, %9\n\tds_read_b64_tr_b16 %2, %8 offset:8192\n\tds_read_b64_tr_b16 %3, %9 offset:8192\n\t"
                 "ds_read_b64_tr_b16 %4, %10\n\tds_read_b64_tr_b16 %5, %11\n\tds_read_b64_tr_b16 %6, %10 offset:8192\n\tds_read_b64_tr_b16 %7, %11 offset:8192\n\ts_waitcnt lgkmcnt(0)"
                 : "=&v"(r0), "=&v"(r1), "=&v"(r2), "=&v"(r3), "=&v"(r4), "=&v"(r5), "=&v"(r6), "=&v"(r7) : "v"(a0), "v"(a1), "v"(c0), "v"(c1) : "memory");
    const u32x4 x00 = {r0.x, r0.y, r1.x, r1.y}, x01 = {r2.x, r2.y, r3.x, r3.y}, x10 = {r4.x, r4.y, r5.x, r5.y}, x11 = {r6.x, r6.y, r7.x, r7.y};
    f00 = __builtin_bit_cast(bf16x8, x00); f01 = __builtin_bit_cast(bf16x8, x01); f10 = __builtin_bit_cast(bf16x8, x10); f11 = __builtin_bit_cast(bf16x8, x11);
}
__device__ __forceinline__ bf16x8 pack8(const f32x4 a, const f32x4 b) { const u32x4 r = {pkbf(a[0], a[1]), pkbf(a[2], a[3]), pkbf(b[0], b[1]), pkbf(b[2], b[3])}; return __builtin_bit_cast(bf16x8, r); }
__device__ __forceinline__ u32x2 tr_issue(unsigned a) { u32x2 r; asm volatile("ds_read_b64_tr_b16 %0, %1" : "=v"(r) : "v"(a) : "memory"); return r; }
__device__ __forceinline__ bf16x8 frag2(const u32x2 lo, const u32x2 hi) { const u32x4 r = {lo.x, lo.y, hi.x, hi.y}; return __builtin_bit_cast(bf16x8, r); }
__device__ __forceinline__ u32x2 at_tile(LAS unsigned char* lds, unsigned QI, unsigned KI, int it, int j, unsigned l15, unsigned g) {
    f32x4 c = (f32x4){0.f, 0.f, 0.f, 0.f};
#pragma unroll
    for (int kd = 0; kd < 4; ++kd) { const bf16x8 qb = *(const LAS bf16x8*)(lds + QI + offb(16u * (unsigned)it + l15, 4u * kd + g)), a = *(const LAS bf16x8*)(lds + KI + offb(16u * (unsigned)j + l15, 4u * kd + g)); c = MFMA16(a, qb, c); }
    if (j == it) {
#pragma unroll
        for (int r = 0; r < 4; ++r) c[r] = (4u * g + r <= l15) ? c[r] : 0.f; }
    const u32x2 w = {pkbf(c[0], c[1]), pkbf(c[2], c[3])}; return w;
}
template <int NK>
__device__ __forceinline__ f32x4 o_part(LAS unsigned char* lds, unsigned QI, int it, const bf16x8 (&at)[NK], const bf16x8 (&vf)[2], const bf16x8 so0, const bf16x8 so1, const bf16x8 sp0, const bf16x8 sp1, int th, unsigned l15, unsigned g) {
    const unsigned trow = 16u * (unsigned)it + l15;
    f32x4 o = (f32x4){0.f, 0.f, 0.f, 0.f};
#pragma unroll
    for (int ks = 0; ks < NK; ++ks) if (2 * ks <= it) o = MFMA16(vf[ks], at[ks], o);
#pragma unroll
    for (int j = 0; j < 4; ++j) {
        const unsigned kd = (j < 2) ? (2u * (unsigned)th + j) : (2u * (unsigned)(1 - th) + (j - 2));
        const u32x2 q0 = *(const LAS u32x2*)(lds + QI + offb(trow, 4u * kd + (g >> 1)) + 8u * (g & 1)), q1 = *(const LAS u32x2*)(lds + QI + offb(trow, 4u * kd + 2u + (g >> 1)) + 8u * (g & 1));
        o = MFMA16(j == 0 ? so0 : j == 1 ? so1 : j == 2 ? sp0 : sp1, frag2(q0, q1), o); }
    return o;
}
__device__ __forceinline__ void phase(LAS unsigned char* lds, const bf16_t* Qt, const bf16_t* Kt, bf16_t* VO, const float* DEC, float* ss8, int bid, int G, int wave) {
    const unsigned lane = (unsigned)fresh_lane_id(), l15 = lane & 15u, g = lane >> 4, ql = l15 >> 2, p = lane & 3u;
    const unsigned vs = (unsigned)wave & 3u; const int th = wave >> 2, tA = th ? 1 : 0, tB = th ? 2 : 3;
    const unsigned ldsb = (unsigned)(uintptr_t)lds;
    constexpr unsigned QKB = 32768u, VRING = 3u * QKB, DECB = VRING + 2u * 8192u, SFB = DECB + 1536u, ATB = SFB + 32768u;
    static_assert(ATB + 2u * 5120u <= XST_OFF, "scan LDS map");
    unsigned qoff[2], voff_, doff;
#pragma unroll
    for (int i = 0; i < 2; ++i) { const unsigned j = 2u * (unsigned)wave + i, r = 4u * j + (lane >> 4), pc = lane & 15u, ch = pc ^ (((r & 3u) << 2) | ((r >> 2) & 3u)); qoff[i] = (r * DI + ch * 8u) * 2u; }
    { const unsigned r = 8u * (unsigned)wave + (lane >> 3), s16 = lane & 7u, ul = (s16 >> 1) ^ (((r >> 1) & 3u) ^ (((r >> 3) & 1u) << 1)); voff_ = (r * DI + (ul * 2u + (s16 & 1u)) * 8u) * 2u; }
    doff = (64u * ((unsigned)wave & 1u) + lane) * 4u;
    const int my_it = wave == 0 ? 0 : wave <= 2 ? 1 : wave <= 5 ? 2 : 3, my_j = wave == 0 ? 0 : wave <= 2 ? wave - 1 : wave <= 5 ? wave - 3 : wave - 6;
    for (int item = bid; item < BATCH * NHEAD * 2; item += G) {
        const int half = (item >> 3) & 1, pair = (item & 7) | ((item >> 4) << 3), b = pair >> 4, h = pair & 15;
        const size_t tokb = (size_t)b * SEQ;
        const char* qg = (const char*)(Qt + tokb * DI + h * HD);
        const char* kg = (const char*)(Kt + tokb * DI + h * HD);
        bf16_t* vg = VO + tokb * DI + h * HD + half * 64;
        const char* dg = (const char*)(DEC + (size_t)(b * (SEQ / 64)) * DI + h * HD);
        f32x4 S[4];
        bf16x8 so0 = (bf16x8){0, 0, 0, 0, 0, 0, 0, 0}, so1 = so0, sp0 = so0, sp1 = so0;
#pragma unroll
        for (int i = 0; i < 4; ++i) S[i] = (f32x4){0.f, 0.f, 0.f, 0.f};
#define SC_DMA_QK(c_) do { const size_t o_ = (size_t)(c_) * 64 * DI * 2; const unsigned base_ = ((unsigned)(c_) % 3u) * QKB; \
            __builtin_amdgcn_global_load_lds((const unsigned*)(qg + o_ + qoff[0]), (LAS unsigned*)(lds + base_ + (unsigned)wave * 2048u), 16, 0, 0); \
            __builtin_amdgcn_global_load_lds((const unsigned*)(qg + o_ + qoff[1]), (LAS unsigned*)(lds + base_ + (unsigned)wave * 2048u + 1024u), 16, 0, 0); \
            __builtin_amdgcn_global_load_lds((const unsigned*)(kg + o_ + qoff[0]), (LAS unsigned*)(lds + base_ + 16384u + (unsigned)wave * 2048u), 16, 0, 0); \
            __builtin_amdgcn_global_load_lds((const unsigned*)(kg + o_ + qoff[1]), (LAS unsigned*)(lds + base_ + 16384u + (unsigned)wave * 2048u + 1024u), 16, 0, 0); \
            __builtin_amdgcn_global_load_lds((const unsigned*)(dg + (size_t)(c_) * DI * 4 + doff), (LAS unsigned*)(lds + DECB + ((unsigned)(c_) % 3u) * 512u + ((unsigned)wave & 1u) * 256u), 4, 0, 0); } while (0)
#define SC_DMA_V(c_) __builtin_amdgcn_global_load_lds((const unsigned*)((const char*)vg + (size_t)(c_) * 64 * DI * 2 + voff_), (LAS unsigned*)(lds + VRING + ((unsigned)(c_) & 1u) * 8192u + (unsigned)wave * 1024u), 16, 0, 0)
#define SC_AT(c_) do { LAS u32x2* atw = (LAS u32x2*)(lds + ATB + (unsigned)((c_) & 1) * 5120u) + lane; const unsigned b_ = ((unsigned)(c_) % 3u) * QKB; \
            atw[64 * wave] = at_tile(lds, b_, b_ + 16384u, my_it, my_j, l15, g); \
            if (wave < 2) atw[64 * (8 + wave)] = at_tile(lds, b_, b_ + 16384u, 3, 2 + wave, l15, g); } while (0)
        SC_DMA_QK(0); SC_DMA_QK(1); SC_DMA_V(0);
        asm volatile("s_waitcnt vmcnt(0)" ::: "memory");
        __builtin_amdgcn_s_barrier();
        SC_AT(0);
        asm volatile("s_waitcnt lgkmcnt(0)" ::: "memory");
        __builtin_amdgcn_s_barrier();
        for (int n = 0; n < SEQ / 64; ++n) {
            const unsigned QI = ((unsigned)n % 3u) * QKB, KI = QI + 16384u, VI = VRING + ((unsigned)n & 1u) * 8192u;
            if (n + 2 < SEQ / 64) SC_DMA_QK(n + 2);
            if (n + 1 < SEQ / 64) SC_DMA_V(n + 1);
            if (n > 0) { const LAS bf16x8* sfr = (const LAS bf16x8*)(lds + SFB + ((unsigned)n & 1u) * 16384u + (unsigned)(wave ^ 4) * 2048u) + lane;
                sp0 = sfr[0]; sp1 = sfr[64]; }
            u32x2 tv0, tv1, tv2, tv3, tv4, tv5, tv6, tv7;
            {
                const unsigned va = ldsb + VI + 8u * p;
                tv0 = tr_issue(va + voffv(4u * g + ql, vs)); tv1 = tr_issue(va + voffv(16u + 4u * g + ql, vs)); tv2 = tr_issue(va + voffv(32u + 4u * g + ql, vs)); tv3 = tr_issue(va + voffv(48u + 4u * g + ql, vs));
                tv4 = tr_issue(va + voffv(8u * g + ql, vs)); tv5 = tr_issue(va + voffv(8u * g + 4u + ql, vs)); tv6 = tr_issue(va + voffv(32u + 8u * g + ql, vs)); tv7 = tr_issue(va + voffv(36u + 8u * g + ql, vs));
            }
            if (n + 1 < SEQ / 64) SC_AT(n + 1);
            bf16x8 atB[2], atA[1];
            { const LAS u32x2* atr = (const LAS u32x2*)(lds + ATB + (unsigned)(n & 1) * 5120u) + lane; const u32x2 z2 = {0u, 0u};
              if (th == 0) { atB[0] = frag2(atr[64 * 6], atr[64 * 7]); atB[1] = frag2(atr[64 * 8], atr[64 * 9]); atA[0] = frag2(atr[0], z2); }
              else         { atB[0] = frag2(atr[64 * 3], atr[64 * 4]); atB[1] = frag2(atr[64 * 5], z2);          atA[0] = frag2(atr[64 * 1], atr[64 * 2]); } }
            asm volatile("s_waitcnt lgkmcnt(0)" : "+v"(tv0), "+v"(tv1), "+v"(tv2), "+v"(tv3), "+v"(tv4), "+v"(tv5), "+v"(tv6), "+v"(tv7) :: "memory");
            __builtin_amdgcn_sched_barrier(0);
            const bf16x8 vf[2] = {frag2(tv0, tv1), frag2(tv2, tv3)};
            const f32x4 oB = o_part<2>(lds, QI, tB, atB, vf, so0, so1, sp0, sp1, th, l15, g);
            const f32x4 oA = o_part<1>(lds, QI, tA, atA, vf, so0, so1, sp0, sp1, th, l15, g);
            {
                const bf16x8 vn0 = frag2(tv4, tv5), vn1 = frag2(tv6, tv7);
                const LAS float* dcp = (const LAS float*)(lds + DECB + ((unsigned)n % 3u) * 512u) + 4u * g + 64u * (unsigned)th;
                const unsigned ka = (ldsb + KI + offb(8u * g + ql, (p >> 1)) + 8u * (p & 1u)) ^ ((unsigned)th << 7), kb = (ldsb + KI + offb(8u * g + 4u + ql, (p >> 1)) + 8u * (p & 1u)) ^ ((unsigned)th << 7);
#pragma unroll
                for (int i = 0; i < 4; i += 2) {
                    bf16x8 k00, k01, k10, k11;
                    tr8(ka ^ ((unsigned)i << 5), kb ^ ((unsigned)i << 5), ka ^ ((unsigned)(i + 1) << 5), kb ^ ((unsigned)(i + 1) << 5), k00, k01, k10, k11);
                    S[i] = MFMA16(k00, vn0, S[i]); S[i + 1] = MFMA16(k10, vn0, S[i + 1]); S[i] = MFMA16(k01, vn1, S[i]); S[i + 1] = MFMA16(k11, vn1, S[i + 1]); }
#pragma unroll
                for (int i = 0; i < 4; ++i) { const f32x4 dc = *(const LAS f32x4*)(dcp + 16 * i); S[i] = S[i] * dc; }
                const bf16x8 f0 = pack8(S[0], S[1]), f1 = pack8(S[2], S[3]);
                so0 = f0; so1 = f1;
                LAS bf16x8* sfw = (LAS bf16x8*)(lds + SFB + ((unsigned)(n + 1) & 1u) * 16384u + (unsigned)wave * 2048u) + lane;
                sfw[0] = f0; sfw[64] = f1;
            }
            asm volatile("s_waitcnt vmcnt(0)" ::: "memory");
            {
                const size_t tlB = (size_t)n * 64 + 16u * (unsigned)tB + l15, tlA = (size_t)n * 64 + 16u * (unsigned)tA + l15;
                const u32x2 wB = {pkbf(oB[0], oB[1]), pkbf(oB[2], oB[3])}, wA = {pkbf(oA[0], oA[1]), pkbf(oA[2], oA[3])};
                *(u32x2*)(vg + tlB * DI + 16u * vs + 4u * g) = wB; *(u32x2*)(vg + tlA * DI + 16u * vs + 4u * g) = wA;
                float sB = (oB[0] * oB[0] + oB[1] * oB[1]) + (oB[2] * oB[2] + oB[3] * oB[3]), sA = (oA[0] * oA[0] + oA[1] * oA[1]) + (oA[2] * oA[2] + oA[3] * oA[3]);
                sB += xor_get(sB, (int)lane, 16); sA += xor_get(sA, (int)lane, 16); sB += xor_get(sB, (int)lane, 32); sA += xor_get(sA, (int)lane, 32);
                if (g == 0) { ss8[(tokb + tlB) * 128 + h * 8 + half * 4 + vs] = sB; ss8[(tokb + tlA) * 128 + h * 8 + half * 4 + vs] = sA; }
            }
            asm volatile("s_waitcnt lgkmcnt(0)" ::: "memory");
            __builtin_amdgcn_s_barrier();
        }
#undef SC_DMA_QK
#undef SC_DMA_V
#undef SC_AT
    }
}
#undef MFMA16
}

#define XB_TMO      128
#define XB_XCNT(j)  (256  + 64 * (j))
#define XB_XSUB(j)  (1280 + 64 * (j))
#define XB_XGEN(j)  (2304 + 64 * (j))
#define XB_TOP      3328
#define XB_TOPGEN   3392
#define XCD_BAR_WORDS 3456
#define XB_SPIN_CAP (1u << 18)
__device__ __forceinline__ unsigned xb_ld(unsigned* p)              { return __hip_atomic_load(p, __ATOMIC_RELAXED, __HIP_MEMORY_SCOPE_AGENT); }
__device__ __forceinline__ unsigned xb_add(unsigned* p, unsigned v) { return __hip_atomic_fetch_add(p, v, __ATOMIC_RELAXED, __HIP_MEMORY_SCOPE_AGENT); }
__device__ __forceinline__ unsigned xb_xcc_id() { return (unsigned)__builtin_amdgcn_s_getreg((3 << 11) | 20) & 0xFu; }
#define XB_SPIN(cond, bar) do { unsigned _sp = 0; while (cond) { __builtin_amdgcn_s_sleep(1); \
    if ((++_sp & 255u) == 0u) { if (xb_ld(&(bar)[XB_TMO])) break; if (_sp > XB_SPIN_CAP) { atomicAdd(&(bar)[XB_TMO], 1u); break; } } } } while (0)
struct XcdBarrier { unsigned* bar; unsigned x; volatile LAS unsigned* st; };
__device__ __forceinline__ XcdBarrier xcd_barrier_post(unsigned* bar, volatile LAS unsigned* st) {
    XcdBarrier b; b.bar = bar; b.x = xb_xcc_id(); b.st = st;
    if (threadIdx.x == 0) (void)xb_add(&bar[XB_XCNT(b.x)], 1u);
    return b;
}
__device__ __forceinline__ void xcd_barrier_complete(unsigned* bar, unsigned x, unsigned& nloc, unsigned& nx) {
    const unsigned G = gridDim.x * gridDim.y * gridDim.z;
    unsigned sum, cnt, mine, sp = 0u;
    for (;;) {
        sum = 0u; cnt = 0u; mine = 0u;
#pragma unroll
        for (unsigned j = 0; j < 16; ++j) { const unsigned c = xb_ld(&bar[XB_XCNT(j)]); sum += c; cnt += (c > 0u) ? 1u : 0u; mine = (j == x) ? c : mine; }
        if (sum == G) break;
        __builtin_amdgcn_s_sleep(1);
        if ((++sp & 255u) == 0u) { if (xb_ld(&bar[XB_TMO])) break; if (sp > XB_SPIN_CAP) { atomicAdd(&bar[XB_TMO], 1u); break; } }
    }
    nloc = mine > 0u ? mine : 1u; nx = cnt > 0u ? cnt : 1u;
}
__device__ __forceinline__ void xcd_barrier(const XcdBarrier& b) {
    asm volatile("s_waitcnt vmcnt(0)" ::: "memory");
    __syncthreads();
    if (threadIdx.x == 0) {
        unsigned* bar = b.bar;
        __builtin_amdgcn_s_waitcnt(0);
        unsigned nloc = b.st[0], nx = b.st[1];
        if (nloc == 0u) { xcd_barrier_complete(bar, b.x, nloc, nx); b.st[0] = nloc; b.st[1] = nx; }
        const unsigned old = xb_add(&bar[XB_XSUB(b.x)], 1u);
        const unsigned gen = old / nloc;
        if (old + 1u == (gen + 1u) * nloc) {
            __builtin_amdgcn_fence(__ATOMIC_RELEASE, "agent");
            asm volatile("s_waitcnt vmcnt(0)" ::: "memory");
            const unsigned og = xb_add(&bar[XB_TOP], 1u);
            const unsigned tg = og / nx;
            if (og + 1u == (tg + 1u) * nx) xb_add(&bar[XB_TOPGEN], 1u);
            else XB_SPIN(xb_ld(&bar[XB_TOPGEN]) == tg, bar);
            __builtin_amdgcn_fence(__ATOMIC_ACQUIRE, "agent");
            xb_add(&bar[XB_XGEN(b.x)], 1u);
            asm volatile("s_waitcnt vmcnt(0)" ::: "memory");
        } else {
            XB_SPIN(xb_ld(&bar[XB_XGEN(b.x)]) == gen, bar);
            __builtin_amdgcn_fence(__ATOMIC_ACQUIRE, "agent");
            asm volatile("s_waitcnt vmcnt(0)" ::: "memory");
        }
    }
    __syncthreads();
}

struct Args {
    const float* x; const float* norm_g; const float* pool_w_in; const float* pool_w_grp; const float* pool_scale; const float* pool_w_out;
    const float* hgrn_w_in; const float* hgrn_lb; const float* hgrn_norm_g; const float* hgrn_w_out; const float* final_g;
    float* out; unsigned char* ws;
};

struct TItem { const float* W; bf16_t* WT; const float* ks; const float* ns; int K, N, row_off, item; float cs; };
__device__ __forceinline__ void titem_issue(const TItem& t, int lane, float (&wv)[32]) {
    const int nblk = t.N / 32, kb = t.item / nblk, nb = t.item % nblk, k0 = 64 * kb, n0 = 32 * nb;
    const float* wp = t.W + (size_t)(k0 + (lane >> 5)) * t.N + n0 + (lane & 31);
#pragma unroll
    for (int i = 0; i < 32; ++i) wv[i] = __builtin_nontemporal_load(wp + (size_t)(2 * i) * t.N);
}
__device__ __forceinline__ void titem_finish(const TItem& t, int lane, const float (&wv)[32], LAS float* scr) {
    const int nblk = t.N / 32, kb = t.item / nblk, nb = t.item % nblk, k0 = 64 * kb, n0 = 32 * nb;
    const float nsv = (t.ns ? t.ns[n0 + (lane & 31)] : 1.0f) * t.cs;
    const float ksv = t.ks ? t.ks[k0 + lane] : 1.0f;
#pragma unroll
    for (int i = 0; i < 32; ++i) { const int kk = 2 * i + (lane >> 5); scr[kk * 33 + (lane & 31)] = wv[i] * nsv * lane_get(ksv, kk); }
    asm volatile("s_waitcnt lgkmcnt(0)" ::: "memory");
    const int c = lane & 7;
#pragma unroll
    for (int j = 0; j < 4; ++j) { const int n = (lane >> 3) + 8 * j; const LAS float* s = scr + (8 * c) * 33 + n;
        u32x4 o; o.x = pkbf(s[0 * 33], s[1 * 33]); o.y = pkbf(s[2 * 33], s[3 * 33]); o.z = pkbf(s[4 * 33], s[5 * 33]); o.w = pkbf(s[6 * 33], s[7 * 33]);
        *(u32x4*)(t.WT + (size_t)(t.row_off + n0 + n) * t.K + k0 + 8 * c) = o; }
    asm volatile("s_waitcnt lgkmcnt(0)" ::: "memory");
}

__global__ void __launch_bounds__(512, 2) fwd_kernel(Args a) {
    extern __shared__ __attribute__((aligned(16))) unsigned char lds_raw[];
    LAS unsigned char* lds = (LAS unsigned char*)lds_raw;
    volatile LAS unsigned* xst = (volatile LAS unsigned*)(lds + XST_OFF);
    if (threadIdx.x < 2) xst[threadIdx.x] = 0u;
    __syncthreads();
    const XcdBarrier xbar = xcd_barrier_post((unsigned*)a.ws, xst);
#define GRID_BAR() xcd_barrier(xbar)
    const int G = gridDim.x, bid = blockIdx.x;
    const int NGW = G * 8;
    const int wave = __builtin_amdgcn_readfirstlane((int)threadIdx.x >> 6);
#define PHASE_IDS int lane_ = fresh_lane_id(); const int lane = lane_, tid = wave * 64 + lane, gw = bid * 8 + wave; (void)gw; (void)tid;
    unsigned char* ws = a.ws;
    bf16_t* Wt_in0 = (bf16_t*)(ws + WS_WIN0); bf16_t* Wt_grp = (bf16_t*)(ws + WS_WGRP); bf16_t* Wt_out0 = (bf16_t*)(ws + WS_WOUT0);
    bf16_t* Wt_in1 = (bf16_t*)(ws + WS_WIN1); bf16_t* Wt_out1 = (bf16_t*)(ws + WS_WOUT1);
    float* invr0 = (float*)(ws + WS_INVR); float* part1 = (float*)(ws + WS_PART1); float* ssb = (float*)(ws + WS_SS); float* decb = (float*)(ws + WS_DEC);
    bf16_t* XB = (bf16_t*)(ws + WS_XB); bf16_t* BA = (bf16_t*)(ws + WS_A); bf16_t* BB = (bf16_t*)(ws + WS_B); bf16_t* BC = (bf16_t*)(ws + WS_C);

    {
        pg8::StaticOrder S; S.init(DI, DM, G, bid); pg8::Unit uf;
        if (S.next(0, uf)) {
            PHASE_IDS
            LAS float* scr = (LAS float*)(lds + wave * 16384);
            const int gsel = uf.pm >> 1, nb0 = (uf.pm & 1) * 8;
            {
                auto own = [&](int q) -> TItem { return TItem{a.pool_w_grp + (size_t)gsel * 512 * 512, Wt_grp, nullptr, a.pool_scale + gsel * 512, 512, 512, gsel * 512, (q >> 3) * 16 + nb0 + (q & 7), 1.0f}; };
                float wa[32], wb[32]; TItem ia = own(wave), ib{};
                titem_issue(ia, lane, wa);
#pragma unroll 1
                for (int q = wave; q < 64; q += 16) {
                    ib = own(q + 8); titem_issue(ib, lane, wb);
                    titem_finish(ia, lane, wa, scr);
                    if (q + 16 < 64) { ia = own(q + 16); titem_issue(ia, lane, wa); }
                    titem_finish(ib, lane, wb, scr);
                }
            }
            for (int idx = tid; idx < 256 * 64; idx += 512) {
                const int k = uf.pn * 256 + (idx >> 6), c8 = gsel * 512 + (idx & 63) * 8; const float gk = a.norm_g[k];
                const f32x4 w0 = __builtin_nontemporal_load((const f32x4*)(a.pool_w_in + (size_t)k * 4096 + c8)), w1 = __builtin_nontemporal_load((const f32x4*)(a.pool_w_in + (size_t)k * 4096 + c8 + 4));
                u32x4 o; o.x = pkbf(w0[0] * gk, w0[1] * gk); o.y = pkbf(w0[2] * gk, w0[3] * gk); o.z = pkbf(w1[0] * gk, w1[1] * gk); o.w = pkbf(w1[2] * gk, w1[3] * gk);
                *(u32x4*)(BC + (size_t)k * DI + c8) = o; }
            asm volatile("s_waitcnt vmcnt(0)" ::: "memory");
            __syncthreads();
        }
        pg8::Gemm g{Wt_grp, BC, 512, DI, 512, 0, 2};
        pg8::EpiFold E{Wt_in0};
        pg8::gemm_phase<pg8::EpiFold>(lds, g, S, E, wave);
    }
    {
        PHASE_IDS
        LAS float* scr = (LAS float*)(lds + wave * 16384);
        constexpr int I_IN0 = (DM / 64) * (2048 / 32), I_OUT = (DI / 64) * (DM / 32), I_IN1 = (DM / 64) * (8192 / 32);
        constexpr int NITEMS = I_IN0 + I_OUT + I_IN1 + I_OUT;
        auto decode = [&](int it) -> TItem {
            int r = it;
            if (r < I_IN0) {
                const int kb = r >> 6, nb = r & 63, n0 = 2048 + 32 * nb, d0 = 256 * ((n0 - 2048) >> 7) + 128 + (n0 & 127);
                return TItem{a.pool_w_in, Wt_in0, a.norm_g, nullptr, DM, 4096, d0 - n0, kb * 128 + 64 + nb, NEG_LOG2E}; } r -= I_IN0;
            if (r < I_OUT) return TItem{a.pool_w_out, Wt_out0, nullptr, nullptr, DI, DM, 0, r, NEG_LN2}; r -= I_OUT;
            if (r < I_IN1) {
                const int n0 = 32 * (r % (8192 / 32)); int d0 = n0;
                if (n0 < 2048) d0 = 256 * (n0 >> 7) + (n0 & 127); else if (n0 < 4096) d0 = 256 * ((n0 - 2048) >> 7) + 128 + (n0 & 127);
                return TItem{a.hgrn_w_in, Wt_in1, a.norm_g + DM, nullptr, DM, 8192, d0 - n0, r, n0 >= 6144 ? NEG_LOG2E : 1.0f}; } r -= I_IN1;
            return TItem{a.hgrn_w_out, Wt_out1, a.hgrn_norm_g, nullptr, DI, DM, 0, r, NEG_LN2};
        };
        __syncthreads();
        {
            float wa[32], wb[32]; TItem ia{}, ib{};
            const int NTW = NGW - 32 * 8;
            int it = bid >= 32 ? gw - 32 * 8 : NITEMS; bool ha = it < NITEMS;
            if (ha) { ia = decode(it); titem_issue(ia, lane, wa); }
            while (ha) {
                const int itb = it + NTW; const bool hb = itb < NITEMS;
                if (hb) { ib = decode(itb); titem_issue(ib, lane, wb); }
                titem_finish(ia, lane, wa, scr);
                it = itb + NTW; ha = it < NITEMS;
                if (ha) { ia = decode(it); titem_issue(ia, lane, wa); }
                if (!hb) break;
                titem_finish(ib, lane, wb, scr);
            }
        }
        for (int m0 = gw * 8; m0 < M; m0 += NGW * 8) {
            f32x4 v[8][4]; float s[8];
#pragma unroll
            for (int r = 0; r < 8; ++r) { const f32x4* xr = (const f32x4*)(a.x + (size_t)(m0 + r) * DM) + lane;
#pragma unroll
                for (int j = 0; j < 4; ++j) v[r][j] = __builtin_nontemporal_load(xr + 64 * j); }
#pragma unroll
            for (int r = 0; r < 8; ++r) { s[r] = 0.f;
#pragma unroll
                for (int j = 0; j < 4; ++j) s[r] += (v[r][j][0] * v[r][j][0] + v[r][j][1] * v[r][j][1]) + (v[r][j][2] * v[r][j][2] + v[r][j][3] * v[r][j][3]); }
#pragma unroll
            for (int o = 1; o < 64; o <<= 1) {
#pragma unroll
                for (int r = 0; r < 8; ++r) s[r] += xor_get(s[r], lane, o); }
#pragma unroll
            for (int r = 0; r < 8; ++r) { const float rms = sqrtf(s[r] * (1.0f / DM) + EPS), rstd = 1.0f / rms;
                if (lane == 0) invr0[m0 + r] = rms;
                unsigned long long* o8 = (unsigned long long*)(XB + (size_t)(m0 + r) * DM) + lane;
#pragma unroll
                for (int j = 0; j < 4; ++j) o8[64 * j] = (unsigned long long)pkbf(v[r][j][0] * rstd, v[r][j][1] * rstd) | ((unsigned long long)pkbf(v[r][j][2] * rstd, v[r][j][3] * rstd) << 32); }
        }
    }
    GRID_BAR();

    {
        pg8::Gemm g{XB, Wt_in0, DM, DM, DM, 0, 0}; pg8::StaticOrder S; S.init(M, 4096, G, bid);
        pg8::EpiP1 E{BB, (unsigned char*)BA, (unsigned char*)BA + 16 * MiB};
        pg8::gemm_phase<pg8::EpiP1>(lds, g, S, E, wave);
    }
    GRID_BAR();

    {
        PHASE_IDS
        const unsigned char* HALO = (const unsigned char*)BA; const unsigned char* SG0 = (const unsigned char*)BA + 16 * MiB;
        for (int idx = bid * 512 + tid; idx < 120 * 256; idx += G * 512) {
            const int sub = idx & 255, pq = idx >> 8, pm = (pq / 15) * 16 + (pq % 15) + 1;
            const int pn = sub >> 4, wc = (sub >> 2) & 3, fq = sub & 3, w = 2 << (pn >> 2);
            const unsigned char* hp = HALO + (size_t)((pm - 1) * 16 + pn) * pg8::HALO_TILE + (unsigned)((wc * 64 + fq * 16) * 16);
            const unsigned char* sp = SG0 + (size_t)(pm * 16 + pn) * pg8::HALO_TILE + (unsigned)((wc * 64 + fq * 16) * 16);
            bf16_t* zp = BB + (size_t)(pm * 256) * DI + pn * 128 + wc * 32 + fq * 8;
            const float inv = 1.0f / (float)w;
            float suf[8];
#pragma unroll
            for (int c = 0; c < 8; ++c) suf[c] = 0.f;
            for (int i = 15; i >= 17 - w; --i) {
                const u32x4 hv = *(const u32x4*)(hp + i * 16);
                suf[0] += bf_lo(hv.x); suf[1] += bf_hi(hv.x); suf[2] += bf_lo(hv.y); suf[3] += bf_hi(hv.y); suf[4] += bf_lo(hv.z); suf[5] += bf_hi(hv.z); suf[6] += bf_lo(hv.w); suf[7] += bf_hi(hv.w);
                const int t = w - 1 - (16 - i);
                const u32x4 sg = *(const u32x4*)(sp + t * 16);
                u32x4* q = (u32x4*)(zp + (size_t)t * DI); const u32x4 o = *q;
                u32x4 r; r.x = pkbf(bf_lo(o.x) + suf[0] * inv * bf_lo(sg.x), bf_hi(o.x) + suf[1] * inv * bf_hi(sg.x)); r.y = pkbf(bf_lo(o.y) + suf[2] * inv * bf_lo(sg.y), bf_hi(o.y) + suf[3] * inv * bf_hi(sg.y));
                r.z = pkbf(bf_lo(o.z) + suf[4] * inv * bf_lo(sg.z), bf_hi(o.z) + suf[5] * inv * bf_hi(sg.z)); r.w = pkbf(bf_lo(o.w) + suf[6] * inv * bf_lo(sg.w), bf_hi(o.w) + suf[7] * inv * bf_hi(sg.w));
                *q = r;
            }
        }
    }
    GRID_BAR();

    {
        pg8::Gemm g{BB, Wt_out0, DI, DI, DI, 0, 0}; pg8::StaticOrder S; S.init(M, DM, G, bid);
        pg8::EpiRes<true, false> E{XB, invr0, nullptr, XB, part1};
        pg8::gemm_phase<pg8::EpiRes<true, false>>(lds, g, S, E, wave);
    }
    GRID_BAR();

    {
        pg8::Gemm g{XB, Wt_in1, DM, DM, DM, 0, 0}; pg8::StaticOrder S; S.init(M, 6144, G, bid);
        pg8::EpiP4 E{BA, BB, BC, decb, part1, a.hgrn_lb};
        pg8::gemm_phase<pg8::EpiP4>(lds, g, S, E, wave);
    }
    GRID_BAR();

    scan::phase(lds, BA, BB, BC, decb, ssb, bid, G, wave);
    GRID_BAR();

    {
        pg8::Gemm g{XB, Wt_in1 + (size_t)6144 * DM, DM, DM, DM, 0, 0}; pg8::StaticOrder S; S.init(M, DI, G, bid);
        pg8::EpiP5b E{BC, part1, ssb};
        pg8::gemm_phase<pg8::EpiP5b>(lds, g, S, E, wave);
    }
    GRID_BAR();

    {
        pg8::Gemm g{BC, Wt_out1, DI, DI, DI, 0, 0}; pg8::StaticOrder S; S.init(M, DM, G, bid);
        pg8::EpiFinal E{XB, a.out, a.final_g, (float*)(ws + WS_X), (unsigned*)(ws + WS_CNT)};
        pg8::gemm_phase<pg8::EpiFinal>(lds, g, S, E, wave);
    }
}

extern "C" void kernel_launch(void* const* d_in, const int* in_sizes, int n_in, void* d_out, int out_size, void* d_ws, size_t ws_size, hipStream_t stream) {
    static int grid = 0;
    if (grid == 0) {
        if (n_in != 11 || in_sizes[0] != M * DM || out_size != M * DM || ws_size < WS_END) { fprintf(stderr, "kernel_launch: unexpected shapes (n_in %d in0 %d out %d ws %zu)\n", n_in, n_in > 0 ? in_sizes[0] : -1, out_size, ws_size); grid = -1; return; }
        int dev = 0, cus = 0, per = 0;
        if (hipGetDevice(&dev) != hipSuccess || hipDeviceGetAttribute(&cus, hipDeviceAttributeMultiprocessorCount, dev) != hipSuccess) { grid = -1; return; }
        if (hipFuncSetAttribute((const void*)fwd_kernel, hipFuncAttributeMaxDynamicSharedMemorySize, LDS_BYTES) != hipSuccess) { fprintf(stderr, "kernel_launch: hipFuncSetAttribute failed\n"); grid = -1; return; }
        if (hipOccupancyMaxActiveBlocksPerMultiprocessor(&per, (const void*)fwd_kernel, 512, LDS_BYTES) != hipSuccess || per < 1) { fprintf(stderr, "kernel_launch: occupancy query says %d\n", per); (void)hipGetLastError(); grid = -1; return; }
        grid = cus;
        fprintf(stderr, "kernel_launch: cus %d per_cu %d grid %d\n", cus, per, grid);
    }
    if (grid < 0) return;
    if (hipMemsetAsync(d_ws, 0, 32768, stream) != hipSuccess) { fprintf(stderr, "kernel_launch: hipMemsetAsync failed\n"); return; }
    Args a{};
    a.x = (const float*)d_in[0]; a.norm_g = (const float*)d_in[1]; a.pool_w_in = (const float*)d_in[2]; a.pool_w_grp = (const float*)d_in[3];
    a.pool_scale = (const float*)d_in[4]; a.pool_w_out = (const float*)d_in[5]; a.hgrn_w_in = (const float*)d_in[6]; a.hgrn_lb = (const float*)d_in[7];
    a.hgrn_norm_g = (const float*)d_in[8]; a.hgrn_w_out = (const float*)d_in[9]; a.final_g = (const float*)d_in[10];
    a.out = (float*)d_out; a.ws = (unsigned char*)d_ws;
    void* args[] = {&a};
    hipError_t e = hipLaunchCooperativeKernel((void*)fwd_kernel, dim3(grid), dim3(512), args, LDS_BYTES, stream);
    if (e != hipSuccess) fprintf(stderr, "kernel_launch: cooperative launch failed: %s (grid %d)\n", hipGetErrorString(e), grid);
}
```

```cpp
#include <hip/hip_runtime.h>
#include <cstdio>
#include <cstdint>

#define LAS __attribute__((address_space(3)))
typedef unsigned short bf16_t;
typedef short bf16x8 __attribute__((ext_vector_type(8)));
typedef float f32x4 __attribute__((ext_vector_type(4)));
typedef float f32x2 __attribute__((ext_vector_type(2)));
typedef unsigned u32x4 __attribute__((ext_vector_type(4)));
typedef unsigned u32x2 __attribute__((ext_vector_type(2)));

constexpr int DM = 1024, BATCH = 8, SEQ = 4096, DI = 2048, M = BATCH * SEQ;
constexpr int NHEAD = 16, HD = 128;
constexpr float EPS = 1e-6f;
constexpr size_t MiB = 1u << 20;
constexpr size_t WS_WIN0 = 2 * MiB;
constexpr size_t WS_WGRP = 10 * MiB;
constexpr size_t WS_WOUT0 = 12 * MiB;
constexpr size_t WS_WIN1 = 16 * MiB;
constexpr size_t WS_WOUT1 = 32 * MiB;
constexpr size_t WS_PART1 = 36 * MiB;
constexpr size_t WS_INVR = 38 * MiB;
constexpr size_t WS_CNT = 16384;
constexpr size_t WS_X = 40 * MiB;
constexpr size_t WS_DEC = 44 * MiB;
constexpr size_t WS_SS = 112 * MiB;
constexpr size_t WS_XB = 48 * MiB;
constexpr size_t WS_A = 128 * MiB;
constexpr size_t WS_B = 256 * MiB;
constexpr size_t WS_C = 384 * MiB;
constexpr size_t WS_END = 512 * MiB;
constexpr int LDS_BYTES = 163840;
constexpr unsigned XST_OFF = 163840u - 256u;

typedef __bf16 bf2_t __attribute__((ext_vector_type(2)));
__device__ __forceinline__ unsigned pkbf(float lo, float hi) { f32x2 v = {lo, hi}; return __builtin_bit_cast(unsigned, __builtin_convertvector(v, bf2_t)); }
__device__ __forceinline__ float bf_lo(unsigned w) { return __builtin_bit_cast(float, w << 16); }
__device__ __forceinline__ float bf_hi(unsigned w) { return __builtin_bit_cast(float, w & 0xffff0000u); }
__device__ __forceinline__ float silu_f(float x) { return x * __builtin_amdgcn_rcpf(1.0f + __builtin_amdgcn_exp2f(-1.44269504089f * x)); }
__device__ __forceinline__ float silu_pre(float t) { return t * __builtin_amdgcn_rcpf(1.0f + __builtin_amdgcn_exp2f(t)); }
constexpr float NEG_LOG2E = -1.44269504089f, NEG_LN2 = -0.69314718056f;
__device__ __forceinline__ int fresh_lane_id() { int l; asm volatile("v_mbcnt_lo_u32_b32 %0, -1, 0\n\tv_mbcnt_hi_u32_b32 %0, -1, %0" : "=v"(l)); return l; }
__device__ __forceinline__ float lane_get(float v, int src_lane) { return __builtin_bit_cast(float, __builtin_amdgcn_ds_bpermute(src_lane << 2, __builtin_bit_cast(int, v))); }
__device__ __forceinline__ float xor_get(float v, int lane, int m) { return lane_get(v, lane ^ m); }
__device__ __forceinline__ float wave_sum(float v, int lane) {
#pragma unroll
    for (int o = 1; o < 64; o <<= 1) v += xor_get(v, lane, o);
    return v;
}

namespace pg8 {
constexpr int BM = 256, BK = 64, HALF = 128, HTB = HALF * BK * 2, NXCD = 8, WGM = 4;
__host__ __device__ __forceinline__ int lds_byte(int r, int c) { const int st = (r >> 4) * 2 + (c >> 5), rr = r & 15, cc = c & 31, ob = rr * 64 + cc * 2; return st * 1024 + (ob ^ (((ob >> 9) & 1) << 5)); }
__host__ __device__ __forceinline__ void stage_rc(int b, int& R, int& C) { const int st = b / 1024, sb = b % 1024, swz = sb ^ (((sb >> 9) & 1) << 5); R = (st >> 1) * 16 + swz / 64; C = (st & 1) * 32 + (swz % 64) / 2; }
__host__ __device__ __forceinline__ int perm32(int rho) { const int n = rho >> 4, i = rho & 15; return 8 * (i >> 2) + 4 * n + (i & 3); }

struct Unit { int pm, pn; };
struct Gemm { const bf16_t* A; const bf16_t* Bt; int lda, ldb, K, grp_tiles, grp_b; };

struct StaticOrder {
    int nM, nN, nwg, G, c;
    __host__ __device__ void init(int M_, int N_, int G_, int c_) { nM = M_ / BM; nN = N_ / BM; nwg = nM * nN; G = G_; c = c_; }
    __host__ __device__ bool next(int i, Unit& u) const {
        const long L = (long)i * G + c; if (L >= nwg) return false;
        int wgid = (int)L; { const int q = nwg / NXCD, r = nwg % NXCD, xcd = wgid % NXCD, off = wgid / NXCD; wgid = (xcd < r ? xcd * (q + 1) : r * (q + 1) + (xcd - r) * q) + off; }
        const int nig = WGM * nN, gid = wgid / nig, fm = gid * WGM, gsz = (nM - fm) < WGM ? (nM - fm) : WGM;
        u.pm = fm + ((wgid % nig) % gsz); u.pn = (wgid % nig) / gsz; return true;
    }
};


__device__ __forceinline__ void zero_acc(f32x4 (&acc)[2][2][4][2]) {
#pragma unroll
    for (int a = 0; a < 2; ++a)
#pragma unroll
        for (int b = 0; b < 2; ++b)
#pragma unroll
            for (int m = 0; m < 4; ++m)
#pragma unroll
                for (int n = 0; n < 2; ++n) acc[a][b][m][n] = (f32x4){0.f, 0.f, 0.f, 0.f};
}
template <class Epi, bool ALIGN_EPI = true, bool SP2 = true>
__device__ __forceinline__ void gemm_phase(LAS unsigned char* lds, const Gemm g, const StaticOrder& S, const Epi& E, const int wid) {
    int lane_ = fresh_lane_id();
    int lane = lane_, tid = wid * 64 + lane, fr = lane & 15, fq = lane >> 4; const int wr = wid >> 2, wc = wid & 3;
    const int K = g.K, nt = K / BK;
    unsigned voffA[2], voffB[2]; int aoff, boff;
#define PG8_LANE_STATE() do { _Pragma("unroll") for (int i = 0; i < 2; ++i) { int R, C; stage_rc(tid * 16 + i * 8192, R, C); const int Rb = Epi::PERM ? ((R & ~31) + perm32(R & 31)) : R; \
        voffA[i] = (unsigned)(R * g.lda + C) * 2u; voffB[i] = (unsigned)(Rb * g.ldb + C) * 2u; } \
        aoff = lds_byte(wr * 64 + fr, fq * 8); boff = lds_byte(wc * 32 + fr, fq * 8); } while (0)
    PG8_LANE_STATE();
    const size_t kstep = (size_t)(BK * 2);
    const size_t hstepA = (size_t)HALF * g.lda * 2, hstepB = (size_t)HALF * g.ldb * 2;
    const size_t tstepA = 2 * hstepA, tstepB = 2 * hstepB;
    const unsigned ldsw = (unsigned)wid * 1024u;
#define PG8_SA(b, h) (((b) * 2 + (h)) * HTB)
#define PG8_SB(b, h) ((4 + (b) * 2 + (h)) * HTB)
#define PG8_STAGE(bufoff, gbase, voff) do { _Pragma("unroll") for (int _i = 0; _i < 2; ++_i) \
        __builtin_amdgcn_global_load_lds((const unsigned*)((const char*)(gbase) + (voff)[_i]), (LAS unsigned*)(lds + (bufoff) + ldsw + _i * 8192), 16, 0, 0); } while (0)
#define PG8_LDA(dst, b, h) do { _Pragma("unroll") for (int m = 0; m < 4; ++m) _Pragma("unroll") for (int k = 0; k < 2; ++k) dst[m][k] = *(const LAS bf16x8*)(lds + PG8_SA(b, h) + aoff + m * 2048 + k * 1024); } while (0)
#define PG8_LDB(dst, b, h) do { _Pragma("unroll") for (int n = 0; n < 2; ++n) _Pragma("unroll") for (int k = 0; k < 2; ++k) dst[n][k] = *(const LAS bf16x8*)(lds + PG8_SB(b, h) + boff + n * 2048 + k * 1024); } while (0)
#define PG8_MMA(ai, bj, At, Bt) do { __builtin_amdgcn_s_setprio(1); _Pragma("unroll") for (int m = 0; m < 4; ++m) _Pragma("unroll") for (int n = 0; n < 2; ++n) _Pragma("unroll") for (int k = 0; k < 2; ++k) \
        acc[ai][bj][m][n] = __builtin_amdgcn_mfma_f32_16x16x32_bf16(Bt[n][k], At[m][k], acc[ai][bj][m][n], 0, 0, 0); __builtin_amdgcn_s_setprio(0); } while (0)
#define PG8_WAIT_V(n) asm volatile("s_waitcnt vmcnt(" #n ")" ::: "memory")
#define PG8_WAIT_L(n) asm volatile("s_waitcnt lgkmcnt(" #n ")" ::: "memory")
#define PG8_BAR __builtin_amdgcn_s_barrier()
#define PG8_SCHED __builtin_amdgcn_sched_barrier(0)
#define PG8_ABASE(u) ((const char*)g.A + (size_t)(u).pm * tstepA + (g.grp_tiles ? (size_t)((u).pn / g.grp_tiles) * (size_t)K * 2 : (size_t)0))
#define PG8_BBASE(u) ((const char*)g.Bt + (size_t)(u).pn * tstepB + (g.grp_b ? (size_t)((u).pm / g.grp_b) * (size_t)K * 2 : (size_t)0))
    Unit cur, nxt; int ui = 0;
    E.prologue(S, lds, tid);
    if (!S.next(0, cur)) return;
    f32x4 acc[2][2][4][2];
    E.init_acc(acc, cur, wr, wc, fr, fq);
    bf16x8 At[4][2], B0[2][2], B1[2][2];
    const char* cA = PG8_ABASE(cur); const char* cB = PG8_BBASE(cur);
    if constexpr (SP2) {
        PG8_STAGE(PG8_SB(0, 0), cB, voffB); PG8_STAGE(PG8_SB(0, 1), cB + hstepB, voffB); PG8_STAGE(PG8_SA(0, 0), cA, voffA); PG8_STAGE(PG8_SA(0, 1), cA + hstepA, voffA);
        if (wr == 1) PG8_BAR;
        PG8_WAIT_V(2); PG8_BAR;
        PG8_STAGE(PG8_SB(1, 0), cB + kstep, voffB); PG8_STAGE(PG8_SA(1, 0), cA + kstep, voffA); PG8_STAGE(PG8_SB(1, 1), cB + hstepB + kstep, voffB);
        PG8_WAIT_V(6); PG8_BAR;
    } else {
        PG8_STAGE(PG8_SB(0, 0), cB, voffB); PG8_STAGE(PG8_SA(0, 0), cA, voffA); PG8_STAGE(PG8_SB(0, 1), cB + hstepB, voffB); PG8_STAGE(PG8_SA(0, 1), cA + hstepA, voffA);
        if (wr == 1) PG8_BAR;
        PG8_WAIT_V(4); PG8_BAR;
        PG8_STAGE(PG8_SB(1, 0), cB + kstep, voffB); PG8_STAGE(PG8_SA(1, 0), cA + kstep, voffA); PG8_STAGE(PG8_SB(1, 1), cB + hstepB + kstep, voffB);
        PG8_WAIT_V(6); PG8_BAR;
    }
    for (;;) {
        const bool has_next = S.next(ui + 1, nxt);
        const char* nA = has_next ? PG8_ABASE(nxt) : cA; const char* nB = has_next ? PG8_BBASE(nxt) : cB;
        for (int t = 0; t < nt; t += 2) {
            const bool last = (t == nt - 2);
            const char* a1 = cA + (size_t)(t + 1) * kstep;
            const char* a2 = last ? nA : cA + (size_t)(t + 2) * kstep; const char* b2 = last ? nB : cB + (size_t)(t + 2) * kstep;
            const char* a3 = a2 + kstep; const char* b3 = b2 + kstep;
            if constexpr (SP2) {
            PG8_LDB(B0, 0, 0); PG8_LDB(B1, 0, 1); PG8_SCHED; PG8_LDA(At, 0, 0); PG8_STAGE(PG8_SA(1, 1), a1 + hstepA, voffA);
            PG8_WAIT_V(8); PG8_WAIT_L(0); PG8_BAR; PG8_MMA(0, 0, At, B0); PG8_MMA(0, 1, At, B1); PG8_BAR; PG8_SCHED;
            PG8_LDA(At, 0, 1); PG8_STAGE(PG8_SB(0, 0), b2, voffB); PG8_STAGE(PG8_SB(0, 1), b2 + hstepB, voffB); PG8_STAGE(PG8_SA(0, 0), a2, voffA);
            PG8_WAIT_V(8); PG8_WAIT_L(0); PG8_BAR; PG8_MMA(1, 0, At, B0); PG8_MMA(1, 1, At, B1); PG8_BAR; PG8_SCHED;
            PG8_LDB(B0, 1, 0); PG8_LDB(B1, 1, 1); PG8_SCHED; PG8_LDA(At, 1, 0); PG8_STAGE(PG8_SA(0, 1), a2 + hstepA, voffA);
            PG8_WAIT_V(8); PG8_WAIT_L(0); PG8_BAR; PG8_MMA(0, 0, At, B0); PG8_MMA(0, 1, At, B1); PG8_BAR; PG8_SCHED;
            PG8_LDA(At, 1, 1); PG8_STAGE(PG8_SB(1, 0), b3, voffB); PG8_STAGE(PG8_SB(1, 1), b3 + hstepB, voffB); PG8_STAGE(PG8_SA(1, 0), a3, voffA);
            PG8_WAIT_V(8); PG8_WAIT_L(0); PG8_BAR; PG8_MMA(1, 0, At, B0); PG8_MMA(1, 1, At, B1); PG8_BAR; PG8_SCHED;
            } else {
            PG8_LDB(B0, 0, 0); PG8_SCHED; PG8_LDA(At, 0, 0); PG8_STAGE(PG8_SA(1, 1), a1 + hstepA, voffA);
            PG8_WAIT_L(8); PG8_BAR; PG8_WAIT_L(0); PG8_MMA(0, 0, At, B0); PG8_BAR; PG8_SCHED;
            PG8_LDB(B1, 0, 1); PG8_STAGE(PG8_SB(0, 0), b2, voffB);
            PG8_BAR; PG8_WAIT_L(0); PG8_MMA(0, 1, At, B1); PG8_BAR;
            PG8_LDA(At, 0, 1); PG8_STAGE(PG8_SA(0, 0), a2, voffA);
            PG8_BAR; PG8_WAIT_L(0); PG8_MMA(1, 0, At, B0); PG8_BAR; PG8_SCHED;
            PG8_STAGE(PG8_SB(0, 1), b2 + hstepB, voffB);
            PG8_WAIT_V(6); PG8_BAR; PG8_MMA(1, 1, At, B1); PG8_BAR;
            PG8_LDB(B0, 1, 0); PG8_SCHED; PG8_LDA(At, 1, 0); PG8_STAGE(PG8_SA(0, 1), a2 + hstepA, voffA);
            PG8_WAIT_L(8); PG8_BAR; PG8_WAIT_L(0); PG8_MMA(0, 0, At, B0); PG8_BAR; PG8_SCHED;
            PG8_LDB(B1, 1, 1); PG8_STAGE(PG8_SB(1, 0), b3, voffB);
            PG8_BAR; PG8_WAIT_L(0); PG8_MMA(0, 1, At, B1); PG8_BAR;
            PG8_LDA(At, 1, 1); PG8_STAGE(PG8_SA(1, 0), a3, voffA);
            PG8_BAR; PG8_WAIT_L(0); PG8_MMA(1, 0, At, B0); PG8_BAR; PG8_SCHED;
            PG8_STAGE(PG8_SB(1, 1), b3 + hstepB, voffB);
            PG8_WAIT_V(6); PG8_BAR; PG8_MMA(1, 1, At, B1); PG8_BAR;
            }
        }
        if constexpr (ALIGN_EPI) { if (wr == 0) PG8_BAR; }
        if constexpr (!Epi::AFTER_DRAIN) E(acc, cur, wr, wc, fr, fq, lds, ui);
        if (!has_next) break;
        cur = nxt; cA = nA; cB = nB; ++ui;
        asm volatile("" : "+v"(lane)); tid = wid * 64 + lane; fr = lane & 15; fq = lane >> 4; PG8_LANE_STATE();
        E.init_acc(acc, cur, wr, wc, fr, fq);
        if constexpr (ALIGN_EPI) { if (wr == 1) PG8_BAR; }
    }
    PG8_WAIT_V(0);
    if constexpr (!ALIGN_EPI) { if (wr == 0) PG8_BAR; }
    PG8_BAR;
    if constexpr (Epi::AFTER_DRAIN) E.fused(acc, cur, wr, wc, fr, fq, lds, tid);
#undef PG8_SA
#undef PG8_SB
#undef PG8_STAGE
#undef PG8_LDA
#undef PG8_LDB
#undef PG8_MMA
#undef PG8_WAIT_V
#undef PG8_WAIT_L
#undef PG8_BAR
#undef PG8_SCHED
#undef PG8_ABASE
#undef PG8_LANE_STATE
#undef PG8_BBASE
}

constexpr unsigned TAB_OFF = 131072u;
__device__ __forceinline__ void row_scan_mul4(float& a, float& b, float& c, float& d) {
#define PG8_SCAN_STEP(n) "v_mul_f32_dpp %0, %0, %0 row_shr:" #n " row_mask:0xf bank_mask:0xf\n" "v_mul_f32_dpp %1, %1, %1 row_shr:" #n " row_mask:0xf bank_mask:0xf\n" \
                         "v_mul_f32_dpp %2, %2, %2 row_shr:" #n " row_mask:0xf bank_mask:0xf\n" "v_mul_f32_dpp %3, %3, %3 row_shr:" #n " row_mask:0xf bank_mask:0xf\n"
    asm("s_nop 1\n" PG8_SCAN_STEP(1) PG8_SCAN_STEP(2) PG8_SCAN_STEP(4) PG8_SCAN_STEP(8) : "+v"(a), "+v"(b), "+v"(c), "+v"(d));
#undef PG8_SCAN_STEP
}
__device__ __forceinline__ void row_scan_add4(float& a, float& b, float& c, float& d) {
#define PG8_SCAN_STEP(n) "v_add_f32_dpp %0, %0, %0 row_shr:" #n " row_mask:0xf bank_mask:0xf\n" "v_add_f32_dpp %1, %1, %1 row_shr:" #n " row_mask:0xf bank_mask:0xf\n" \
                         "v_add_f32_dpp %2, %2, %2 row_shr:" #n " row_mask:0xf bank_mask:0xf\n" "v_add_f32_dpp %3, %3, %3 row_shr:" #n " row_mask:0xf bank_mask:0xf\n"
    asm("s_nop 1\n" PG8_SCAN_STEP(1) PG8_SCAN_STEP(2) PG8_SCAN_STEP(4) PG8_SCAN_STEP(8) : "+v"(a), "+v"(b), "+v"(c), "+v"(d));
#undef PG8_SCAN_STEP
}
__device__ __forceinline__ float row_bcast15(float v) { float r; asm("s_nop 1\n v_mov_b32_dpp %0, %1 row_newbcast:15 row_mask:0xf bank_mask:0xf" : "=v"(r) : "v"(v)); return r; }
template <int W> __device__ __forceinline__ float window_sum(float p, float pp, float c) {
    if constexpr (W == 16) return c - pp;
    else { float w = c;
        if constexpr (W == 8) asm("s_nop 1\n v_subrev_f32_dpp %0, %1, %2 row_shl:8 row_mask:0xf bank_mask:0xf\n v_subrev_f32_dpp %0, %3, %3 row_shr:8 row_mask:0xf bank_mask:0xf" : "+v"(w) : "v"(pp), "v"(c), "v"(p));
        else if constexpr (W == 4) asm("s_nop 1\n v_subrev_f32_dpp %0, %1, %2 row_shl:12 row_mask:0xf bank_mask:0xf\n v_subrev_f32_dpp %0, %3, %3 row_shr:4 row_mask:0xf bank_mask:0xf" : "+v"(w) : "v"(pp), "v"(c), "v"(p));
        else asm("s_nop 1\n v_subrev_f32_dpp %0, %1, %2 row_shl:14 row_mask:0xf bank_mask:0xf\n v_subrev_f32_dpp %0, %3, %3 row_shr:2 row_mask:0xf bank_mask:0xf" : "+v"(w) : "v"(pp), "v"(c), "v"(p));
        return w; }
}
#define PG8_POOL_STEP(SHL, SHR) \
    asm("s_nop 1\n" \
        "v_add_f32_dpp %0, %8, %4 row_shl:" #SHL " row_mask:0xf bank_mask:0xf bound_ctrl:1\n" "v_add_f32_dpp %1, %9, %5 row_shl:" #SHL " row_mask:0xf bank_mask:0xf bound_ctrl:1\n" \
        "v_add_f32_dpp %2, %10, %6 row_shl:" #SHL " row_mask:0xf bank_mask:0xf bound_ctrl:1\n" "v_add_f32_dpp %3, %11, %7 row_shl:" #SHL " row_mask:0xf bank_mask:0xf bound_ctrl:1\n" \
        "v_add_f32_dpp %0, %4, %0 row_shr:" #SHR " row_mask:0xf bank_mask:0xf\n" "v_add_f32_dpp %1, %5, %1 row_shr:" #SHR " row_mask:0xf bank_mask:0xf\n" \
        "v_add_f32_dpp %2, %6, %2 row_shr:" #SHR " row_mask:0xf bank_mask:0xf\n" "v_add_f32_dpp %3, %7, %3 row_shr:" #SHR " row_mask:0xf bank_mask:0xf" \
        : "=&v"(a[0]), "=&v"(a[1]), "=&v"(a[2]), "=&v"(a[3]) : "v"(b[0]), "v"(b[1]), "v"(b[2]), "v"(b[3]), "v"(bp[0]), "v"(bp[1]), "v"(bp[2]), "v"(bp[3]))
template <int K> __device__ __forceinline__ void pool_step4(float (&a)[4], const float (&b)[4], const float (&bp)[4]) {
    if constexpr (K == 1) PG8_POOL_STEP(15, 1); else if constexpr (K == 2) PG8_POOL_STEP(14, 2); else PG8_POOL_STEP(12, 4);
}
#undef PG8_POOL_STEP
#define PG8_HALO_STEP(SHR) \
    asm("s_nop 1\n" "v_add_f32_dpp %0, %4, %4 row_shr:" #SHR " row_mask:0xf bank_mask:0xf bound_ctrl:1\n" "v_add_f32_dpp %1, %5, %5 row_shr:" #SHR " row_mask:0xf bank_mask:0xf bound_ctrl:1\n" \
        "v_add_f32_dpp %2, %6, %6 row_shr:" #SHR " row_mask:0xf bank_mask:0xf bound_ctrl:1\n" "v_add_f32_dpp %3, %7, %7 row_shr:" #SHR " row_mask:0xf bank_mask:0xf bound_ctrl:1" \
        : "=&v"(a[0]), "=&v"(a[1]), "=&v"(a[2]), "=&v"(a[3]) : "v"(b[0]), "v"(b[1]), "v"(b[2]), "v"(b[3]))
template <int K> __device__ __forceinline__ void halo_step4(float (&a)[4], const float (&b)[4]) { if constexpr (K == 1) PG8_HALO_STEP(1); else PG8_HALO_STEP(2); }
#undef PG8_HALO_STEP
struct EpiFold {
    static constexpr bool PERM = true, AFTER_DRAIN = false;
    __device__ __forceinline__ void init_acc(f32x4 (&acc)[2][2][4][2], const Unit&, int, int, int, int) const { zero_acc(acc); }
    __device__ __forceinline__ void prologue(const StaticOrder&, LAS unsigned char*, int) const {}
    bf16_t* WT;
    __device__ __forceinline__ void operator()(f32x4 (&acc)[2][2][4][2], const Unit& u, int wr, int wc, int fr, int fq, LAS unsigned char* lds, int ui) const {
        const unsigned k0 = (unsigned)(u.pn * BM + wc * 32 + 8 * fq);
#pragma unroll
        for (int ai = 0; ai < 2; ++ai)
#pragma unroll
            for (int m = 0; m < 4; ++m) { const unsigned c = (unsigned)(u.pm * BM + ai * HALF + wr * 64 + m * 16 + fr), drow = (c >> 7) * 256u + (c & 127u);
#pragma unroll
                for (int bj = 0; bj < 2; ++bj) { const f32x4 v0 = acc[ai][bj][m][0], v1 = acc[ai][bj][m][1];
                    u32x4 w; w.x = pkbf(v0[0], v0[1]); w.y = pkbf(v0[2], v0[3]); w.z = pkbf(v1[0], v1[1]); w.w = pkbf(v1[2], v1[3]);
                    *(u32x4*)(WT + (size_t)drow * DM + k0 + bj * HALF) = w; } }
    }
};
constexpr unsigned HALO_TILE = 4 * 64 * 16;
struct EpiP1 {
    static constexpr bool PERM = true, AFTER_DRAIN = false;
    __device__ __forceinline__ void init_acc(f32x4 (&acc)[2][2][4][2], const Unit&, int, int, int, int) const { zero_acc(acc); }
    __device__ __forceinline__ void prologue(const StaticOrder&, LAS unsigned char*, int) const {}
    bf16_t* Z; unsigned char* HALO; unsigned char* SG0;
    template <int W> __device__ __forceinline__ void tile(f32x4 (&acc)[2][2][4][2], const Unit& u, int wr, int wc, int fr, int fq, LAS unsigned char* lds) const {
        const unsigned lane = (unsigned)(fq * 16 + fr);
        LAS unsigned char* HX = lds + TAB_OFF;
        const unsigned sideofs = (unsigned)(u.pm * 16 + u.pn) * HALO_TILE + ((unsigned)wc * 64u + lane) * 16u;
#pragma unroll
        for (int ai = 0; ai < 2; ++ai) {
            u32x4 h; h.x = pkbf(acc[ai][0][3][0][0], acc[ai][0][3][0][1]); h.y = pkbf(acc[ai][0][3][0][2], acc[ai][0][3][0][3]); h.z = pkbf(acc[ai][0][3][1][0], acc[ai][0][3][1][1]); h.w = pkbf(acc[ai][0][3][1][2], acc[ai][0][3][1][3]);
            const int sl = 2 * ai + wr;
            if (sl < 3) *(LAS u32x4*)(HX + ((unsigned)(sl * 4 + wc) * 64u + lane) * 16u) = h;
            else *(u32x4*)(HALO + sideofs) = h;
        }
        asm volatile("s_waitcnt lgkmcnt(0)" ::: "memory"); __builtin_amdgcn_s_barrier(); asm volatile("" ::: "memory");
        const bool seq0 = (u.pm & 15) == 0;
        const float invw = 1.0f / (float)W;
        const float inv00 = seq0 ? 1.0f / (float)((fr + 1) < W ? (fr + 1) : W) : invw;
        const unsigned zofs = ((unsigned)(u.pm * BM + wr * 64 + fr) * DI + (unsigned)(u.pn * HD + wc * 32 + 8 * fq)) * 2u;
#pragma unroll
        for (int ai = 0; ai < 2; ++ai) {
            const int sl = 2 * ai + wr;
            float pp[2][4], pt[2][4];
            if (sl > 0) {
                const u32x4 h = *(const LAS u32x4*)(HX + ((unsigned)((sl - 1) * 4 + wc) * 64u + lane) * 16u);
                pp[0][0] = bf_lo(h.x); pp[0][1] = bf_hi(h.x); pp[0][2] = bf_lo(h.y); pp[0][3] = bf_hi(h.y); pp[1][0] = bf_lo(h.z); pp[1][1] = bf_hi(h.z); pp[1][2] = bf_lo(h.w); pp[1][3] = bf_hi(h.w);
#pragma unroll
                for (int n = 0; n < 2; ++n) { row_scan_add4(pp[n][0], pp[n][1], pp[n][2], pp[n][3]);
#pragma unroll
                    for (int j = 0; j < 4; ++j) pt[n][j] = row_bcast15(pp[n][j]); }
            } else {
#pragma unroll
                for (int n = 0; n < 2; ++n)
#pragma unroll
                    for (int j = 0; j < 4; ++j) { pp[n][j] = 0.f; pt[n][j] = 0.f; }
            }
#pragma unroll
            for (int m = 0; m < 4; ++m) {
                const float inv = (sl == 0 && m == 0) ? inv00 : invw;
                float z[2][4], sgv[2][4];
#pragma unroll
                for (int n = 0; n < 2; ++n) {
                    float p[4];
#pragma unroll
                    for (int j = 0; j < 4; ++j) p[j] = acc[ai][0][m][n][j];
                    row_scan_add4(p[0], p[1], p[2], p[3]);
#pragma unroll
                    for (int j = 0; j < 4; ++j) {
                        const float ws = window_sum<W>(p[j], pp[n][j], p[j] + pt[n][j]);
                        sgv[n][j] = silu_pre(acc[ai][1][m][n][j]);
                        z[n][j] = __builtin_fmaf(ws, inv, -acc[ai][0][m][n][j]) * sgv[n][j];
                        pp[n][j] = p[j]; pt[n][j] = row_bcast15(p[j]); }
                }
                u32x4 w; w.x = pkbf(z[0][0], z[0][1]); w.y = pkbf(z[0][2], z[0][3]); w.z = pkbf(z[1][0], z[1][1]); w.w = pkbf(z[1][2], z[1][3]);
                *(u32x4*)((char*)Z + (zofs + (unsigned)((ai * HALF + m * 16) * DI) * 2u)) = w;
                if (sl == 0 && m == 0) { u32x4 g; g.x = pkbf(sgv[0][0], sgv[0][1]); g.y = pkbf(sgv[0][2], sgv[0][3]); g.z = pkbf(sgv[1][0], sgv[1][1]); g.w = pkbf(sgv[1][2], sgv[1][3]);
                    *(u32x4*)(SG0 + sideofs) = g; }
                asm volatile("" ::: "memory");
            }
        }
    }
    template <int W> __device__ __forceinline__ void tile_dbl(f32x4 (&acc)[2][2][4][2], const Unit& u, int wr, int wc, int fr, int fq, LAS unsigned char* lds) const {
        constexpr int NL = (W == 2) ? 1 : (W == 4) ? 2 : 3;
        const unsigned lane = (unsigned)(fq * 16 + fr);
        LAS unsigned char* HX = lds + TAB_OFF;
        const unsigned sideofs = (unsigned)(u.pm * 16 + u.pn) * HALO_TILE + ((unsigned)wc * 64u + lane) * 16u;
#pragma unroll
        for (int ai = 0; ai < 2; ++ai) {
            u32x4 h; h.x = pkbf(acc[ai][0][3][0][0], acc[ai][0][3][0][1]); h.y = pkbf(acc[ai][0][3][0][2], acc[ai][0][3][0][3]); h.z = pkbf(acc[ai][0][3][1][0], acc[ai][0][3][1][1]); h.w = pkbf(acc[ai][0][3][1][2], acc[ai][0][3][1][3]);
            const int sl = 2 * ai + wr;
            if (sl < 3) *(LAS u32x4*)(HX + ((unsigned)(sl * 4 + wc) * 64u + lane) * 16u) = h;
            else *(u32x4*)(HALO + sideofs) = h;
        }
        asm volatile("s_waitcnt lgkmcnt(0)" ::: "memory"); __builtin_amdgcn_s_barrier(); asm volatile("" ::: "memory");
        const bool seq0 = (u.pm & 15) == 0;
        const float invw = 1.0f / (float)W;
        const float inv00 = seq0 ? 1.0f / (float)((fr + 1) < W ? (fr + 1) : W) : invw;
        const unsigned zofs = ((unsigned)(u.pm * BM + wr * 64 + fr) * DI + (unsigned)(u.pn * HD + wc * 32 + 8 * fq)) * 2u;
#pragma unroll
        for (int ai = 0; ai < 2; ++ai) {
            const int sl = 2 * ai + wr;
            float prev[NL][2][4];
            if (sl > 0) {
                const u32x4 h = *(const LAS u32x4*)(HX + ((unsigned)((sl - 1) * 4 + wc) * 64u + lane) * 16u);
                prev[0][0][0] = bf_lo(h.x); prev[0][0][1] = bf_hi(h.x); prev[0][0][2] = bf_lo(h.y); prev[0][0][3] = bf_hi(h.y);
                prev[0][1][0] = bf_lo(h.z); prev[0][1][1] = bf_hi(h.z); prev[0][1][2] = bf_lo(h.w); prev[0][1][3] = bf_hi(h.w);
#pragma unroll
                for (int n = 0; n < 2; ++n) { if constexpr (NL >= 2) halo_step4<1>(prev[1][n], prev[0][n]); if constexpr (NL >= 3) halo_step4<2>(prev[2][n], prev[1][n]); }
            } else {
#pragma unroll
                for (int l = 0; l < NL; ++l)
#pragma unroll
                    for (int n = 0; n < 2; ++n)
#pragma unroll
                        for (int j = 0; j < 4; ++j) prev[l][n][j] = 0.f;
            }
#pragma unroll
            for (int m = 0; m < 4; ++m) {
                const float inv = (sl == 0 && m == 0) ? inv00 : invw;
                float z[2][4], sgv[2][4];
#pragma unroll
                for (int n = 0; n < 2; ++n) {
                    float l0[4], l1[4], l2[4], l3[4];
#pragma unroll
                    for (int j = 0; j < 4; ++j) l0[j] = acc[ai][0][m][n][j];
                    pool_step4<1>(l1, l0, prev[0][n]);
                    if constexpr (NL >= 2) pool_step4<2>(l2, l1, prev[1][n]);
                    if constexpr (NL >= 3) pool_step4<4>(l3, l2, prev[2][n]);
#pragma unroll
                    for (int j = 0; j < 4; ++j) {
                        const float ws = (NL == 1) ? l1[j] : (NL == 2) ? l2[j] : l3[j];
                        sgv[n][j] = silu_pre(acc[ai][1][m][n][j]);
                        z[n][j] = __builtin_fmaf(ws, inv, -l0[j]) * sgv[n][j];
                        prev[0][n][j] = l0[j]; if constexpr (NL >= 2) prev[1][n][j] = l1[j]; if constexpr (NL >= 3) prev[2][n][j] = l2[j]; }
                }
                u32x4 w; w.x = pkbf(z[0][0], z[0][1]); w.y = pkbf(z[0][2], z[0][3]); w.z = pkbf(z[1][0], z[1][1]); w.w = pkbf(z[1][2], z[1][3]);
                *(u32x4*)((char*)Z + (zofs + (unsigned)((ai * HALF + m * 16) * DI) * 2u)) = w;
                if (sl == 0 && m == 0) { u32x4 g; g.x = pkbf(sgv[0][0], sgv[0][1]); g.y = pkbf(sgv[0][2], sgv[0][3]); g.z = pkbf(sgv[1][0], sgv[1][1]); g.w = pkbf(sgv[1][2], sgv[1][3]);
                    *(u32x4*)(SG0 + sideofs) = g; }
                asm volatile("" ::: "memory");
            }
        }
    }
    __device__ __forceinline__ void operator()(f32x4 (&acc)[2][2][4][2], const Unit& u, int wr, int wc, int fr, int fq, LAS unsigned char* lds, int ui) const {
        const int g = u.pn >> 2;
        if (g == 0) tile_dbl<2>(acc, u, wr, wc, fr, fq, lds); else if (g == 1) tile_dbl<4>(acc, u, wr, wc, fr, fq, lds);
        else if (g == 2) tile_dbl<8>(acc, u, wr, wc, fr, fq, lds); else tile<16>(acc, u, wr, wc, fr, fq, lds);
    }
};
template <bool WRITE_HB, bool WRITE_H = true> struct EpiRes {
    static constexpr bool PERM = true, AFTER_DRAIN = false;
    __device__ __forceinline__ void prologue(const StaticOrder&, LAS unsigned char*, int) const {}
    const bf16_t* RB; const float* invr; float* H; bf16_t* HB; float* part;
    __device__ __forceinline__ void init_acc(f32x4 (&acc)[2][2][4][2], const Unit& u, int wr, int wc, int fr, int fq) const {
        const unsigned row0 = (unsigned)(u.pm * BM + wr * 64 + fr), col0 = (unsigned)(u.pn * BM + wc * 32 + 8 * fq);
        const unsigned ofs = (row0 * DM + col0) * 2u;
#pragma unroll
        for (int ai = 0; ai < 2; ++ai)
#pragma unroll
            for (int m = 0; m < 4; ++m) { const float ir = invr[row0 + (unsigned)(ai * HALF + m * 16)];
#pragma unroll
                for (int bj = 0; bj < 2; ++bj) { const u32x4 r = __builtin_nontemporal_load((const u32x4*)((const char*)RB + (ofs + (unsigned)((ai * HALF + m * 16) * DM + bj * HALF) * 2u)));
                    acc[ai][bj][m][0] = (f32x4){bf_lo(r.x) * ir, bf_hi(r.x) * ir, bf_lo(r.y) * ir, bf_hi(r.y) * ir};
                    acc[ai][bj][m][1] = (f32x4){bf_lo(r.z) * ir, bf_hi(r.z) * ir, bf_lo(r.w) * ir, bf_hi(r.w) * ir}; } }
    }
    __device__ __forceinline__ void operator()(f32x4 (&acc)[2][2][4][2], const Unit& u, int wr, int wc, int fr, int fq, LAS unsigned char* lds, int ui) const {
        const unsigned row0 = (unsigned)(u.pm * BM + wr * 64 + fr), col0 = (unsigned)(u.pn * BM + wc * 32 + 8 * fq);
        const unsigned ofs = (row0 * DM + col0) * 4u, pofs = (row0 * 16u + (unsigned)(u.pn * 4 + wc)) * 4u;
#pragma unroll
        for (int ai = 0; ai < 2; ++ai)
#pragma unroll
            for (int m = 0; m < 4; ++m) { const unsigned o = ofs + (unsigned)((ai * HALF + m * 16) * DM) * 4u; float ss = 0.f;
#pragma unroll
                for (int bj = 0; bj < 2; ++bj) { const unsigned oo = o + (unsigned)(bj * HALF) * 4u; const f32x4 h0 = acc[ai][bj][m][0], h1 = acc[ai][bj][m][1];
                    if (WRITE_H) { *(f32x4*)((char*)H + oo) = h0; *(f32x4*)((char*)H + oo + 16u) = h1; }
                    ss += ((h0[0] * h0[0] + h0[1] * h0[1]) + (h0[2] * h0[2] + h0[3] * h0[3])) + ((h1[0] * h1[0] + h1[1] * h1[1]) + (h1[2] * h1[2] + h1[3] * h1[3]));
                    if (WRITE_HB) { u32x4 w; w.x = pkbf(h0[0], h0[1]); w.y = pkbf(h0[2], h0[3]); w.z = pkbf(h1[0], h1[1]); w.w = pkbf(h1[2], h1[3]); *(u32x4*)((char*)HB + (oo >> 1)) = w; } }
                ss += xor_get(ss, fq * 16 + fr, 16); ss += xor_get(ss, fq * 16 + fr, 32);
                if (fq == 0) *(float*)((char*)part + (pofs + (unsigned)(ai * HALF + m * 16) * 64u)) = ss; }
    }
};
__device__ __forceinline__ float row_rstd_b(const float* part, unsigned bofs) {
    const f32x4* p = (const f32x4*)((const char*)part + bofs); const f32x4 a = p[0], b = p[1], c = p[2], d = p[3];
    return __builtin_amdgcn_rsqf((((a[0] + a[1]) + (a[2] + a[3])) + ((b[0] + b[1]) + (b[2] + b[3])) + ((c[0] + c[1]) + (c[2] + c[3])) + ((d[0] + d[1]) + (d[2] + d[3]))) * (1.0f / DM) + EPS);
}
struct EpiP4 {
    static constexpr bool PERM = true, AFTER_DRAIN = false;
    __device__ __forceinline__ void init_acc(f32x4 (&acc)[2][2][4][2], const Unit&, int, int, int, int) const { zero_acc(acc); }
    bf16_t* Qt; bf16_t* Kt; bf16_t* V; float* DEC; const float* part; const float* lbnd;
    __device__ __forceinline__ void prologue(const StaticOrder& S, LAS unsigned char* lds, int tid) const {
        LAS float* T = (LAS float*)(lds + TAB_OFF); Unit u;
        for (int i = 0; i < 12 && S.next(i, u); ++i) {
            if (tid < 256) T[i * 256 + tid] = row_rstd_b(part, (unsigned)(u.pm * BM + tid) * 64u);
            else if (u.pn < 16) {
                const int c = tid - 256, ch = u.pn * HD + (c & 127);
                const float ex = __expf(lbnd[ch] - lbnd[DI + ch]), lb = __builtin_amdgcn_rcpf(1.0f + ex);
                T[3072 + i * 256 + c] = (c < 128) ? lb : ex * lb; }
        }
        __syncthreads();
    }
    __device__ __forceinline__ void operator()(f32x4 (&acc)[2][2][4][2], const Unit& u, int wr, int wc, int fr, int fq, LAS unsigned char* lds, int ui) const {
        const unsigned row0 = (unsigned)(u.pm * BM + wr * 64 + fr);
        const LAS float* T = (const LAS float*)(lds + TAB_OFF) + ui * 256 + wr * 64 + fr;
        if (u.pn >= 16) {
            const unsigned vofs = (row0 * DI + (unsigned)((u.pn - 16) * BM + wc * 32 + 8 * fq)) * 2u;
#pragma unroll
            for (int ai = 0; ai < 2; ++ai)
#pragma unroll
                for (int m = 0; m < 4; ++m) { const float rs = T[ai * HALF + m * 16];
#pragma unroll
                    for (int bj = 0; bj < 2; ++bj) { const f32x4 v0 = acc[ai][bj][m][0] * rs, v1 = acc[ai][bj][m][1] * rs;
                        u32x4 w; w.x = pkbf(v0[0], v0[1]); w.y = pkbf(v0[2], v0[3]); w.z = pkbf(v1[0], v1[1]); w.w = pkbf(v1[2], v1[3]);
                        __builtin_nontemporal_store(w, (u32x4*)((char*)V + (vofs + (unsigned)((ai * HALF + m * 16) * DI + bj * HALF) * 2u))); } }
            return;
        }
        const unsigned c0 = (unsigned)(u.pn * HD + wc * 32 + 8 * fq);
        const unsigned qofs = (row0 * DI + c0) * 2u;
        const LAS float* LB = (const LAS float*)(lds + TAB_OFF) + 3072 + ui * 256 + wc * 32 + 8 * fq;
#pragma unroll
        for (int ai = 0; ai < 2; ++ai) {
            float rs[4], rz[4];
#pragma unroll
            for (int m = 0; m < 4; ++m) { rs[m] = T[ai * HALF + m * 16]; rz[m] = -1.44269504089f * rs[m]; }
            float bp[2][4]; f32x4 decv[2];
#pragma unroll
            for (int m = 0; m < 4; ++m) {
#pragma unroll
                for (int n = 0; n < 2; ++n) {
                    const f32x4 lbv = *(const LAS f32x4*)(LB + 4 * n), omv = *(const LAS f32x4*)(LB + 128 + 4 * n);
                    float s[4], k[4];
#pragma unroll
                    for (int j = 0; j < 4; ++j) {
                        const float sg = __builtin_amdgcn_rcpf(1.0f + __builtin_amdgcn_exp2f(acc[ai][1][m][n][j] * rz[m]));
                        s[j] = __builtin_fmaf(omv[j], sg, lbv[j]); k[j] = __builtin_fmaf(-omv[j], sg, omv[j]); }
                    row_scan_mul4(s[0], s[1], s[2], s[3]);
#pragma unroll
                    for (int j = 0; j < 4; ++j) {
                        const float E = (m == 0) ? s[j] : s[j] * bp[n][j];
                        if (m < 3) { const float tot = lane_get(s[j], fq * 16 + 15); bp[n][j] = (m == 0) ? tot : bp[n][j] * tot; }
                        const float Ei = __builtin_amdgcn_rcpf(fmaxf(E, 7.9e-31f));
                        acc[ai][0][m][n][j] = acc[ai][0][m][n][j] * (rs[m] * E); acc[ai][1][m][n][j] = k[j] * Ei;
                        if (m == 3) decv[n][j] = E; }
                }
                const unsigned ob = qofs + (unsigned)((ai * HALF + m * 16) * DI) * 2u;
                u32x4 w; w.x = pkbf(acc[ai][0][m][0][0], acc[ai][0][m][0][1]); w.y = pkbf(acc[ai][0][m][0][2], acc[ai][0][m][0][3]); w.z = pkbf(acc[ai][0][m][1][0], acc[ai][0][m][1][1]); w.w = pkbf(acc[ai][0][m][1][2], acc[ai][0][m][1][3]);
                __builtin_nontemporal_store(w, (u32x4*)((char*)Qt + ob));
                u32x4 x; x.x = pkbf(acc[ai][1][m][0][0], acc[ai][1][m][0][1]); x.y = pkbf(acc[ai][1][m][0][2], acc[ai][1][m][0][3]); x.z = pkbf(acc[ai][1][m][1][0], acc[ai][1][m][1][1]); x.w = pkbf(acc[ai][1][m][1][2], acc[ai][1][m][1][3]);
                __builtin_nontemporal_store(x, (u32x4*)((char*)Kt + ob));
                asm volatile("" ::: "memory");
            }
            if (fr == 15) { float* dp = (float*)((char*)DEC + ((unsigned)(u.pm * 4 + ai * 2 + wr) * DI + c0) * 4u); *(f32x4*)dp = decv[0]; *(f32x4*)(dp + 4) = decv[1]; }
            asm volatile("" ::: "memory");
        }
    }
};
struct EpiP5b {
    static constexpr bool PERM = true, AFTER_DRAIN = false;
    __device__ __forceinline__ void init_acc(f32x4 (&acc)[2][2][4][2], const Unit&, int, int, int, int) const { zero_acc(acc); }
    bf16_t* O; const float* part; const float* ss;
    __device__ __forceinline__ void prologue(const StaticOrder& S, LAS unsigned char* lds, int tid) const {
        LAS float* T = (LAS float*)(lds + TAB_OFF); Unit u;
        for (int i = 0; i < 4 && S.next(i, u); ++i) {
            if (tid < 256) T[i * 768 + tid] = row_rstd_b(part, (unsigned)(u.pm * BM + tid) * 64u);
            { const int r = tid >> 1, hh = tid & 1; const f32x4* sp = (const f32x4*)(ss + (size_t)(u.pm * BM + r) * 128 + (u.pn * 2 + hh) * 8); const f32x4 s0 = sp[0], s1 = sp[1];
              T[i * 768 + 256 + tid] = __builtin_amdgcn_rsqf((((s0[0] + s0[1]) + (s0[2] + s0[3])) + ((s1[0] + s1[1]) + (s1[2] + s1[3]))) * (1.0f / HD) + EPS); }
        }
        __syncthreads();
    }
    __device__ __forceinline__ void operator()(f32x4 (&acc)[2][2][4][2], const Unit& u, int wr, int wc, int fr, int fq, LAS unsigned char* lds, int ui) const {
        const unsigned row0 = (unsigned)(u.pm * BM + wr * 64 + fr), col0 = (unsigned)(u.pn * BM + wc * 32 + 8 * fq);
        const LAS float* T = (const LAS float*)(lds + TAB_OFF) + ui * 768 + wr * 64 + fr;
        const unsigned oofs = (row0 * DI + col0) * 2u;
#pragma unroll
        for (int ai = 0; ai < 2; ++ai) {
            u32x4 ov[4][2];
#pragma unroll
            for (int m = 0; m < 4; ++m)
#pragma unroll
                for (int bj = 0; bj < 2; ++bj) ov[m][bj] = *(const u32x4*)((const char*)O + (oofs + (unsigned)((ai * HALF + m * 16) * DI + bj * HALF) * 2u));
#pragma unroll
            for (int m = 0; m < 4; ++m) { const int rl = ai * HALF + m * 16; const float rs = T[rl];
#pragma unroll
                for (int bj = 0; bj < 2; ++bj) { const f32x4 v0 = acc[ai][bj][m][0] * rs, v1 = acc[ai][bj][m][1] * rs;
                    const float rh = T[256 + 2 * rl + bj + (wr * 64 + fr)];
                    const u32x4 s = ov[m][bj];
                    u32x4 w; w.x = pkbf(bf_lo(s.x) * rh * silu_pre(v0[0]), bf_hi(s.x) * rh * silu_pre(v0[1])); w.y = pkbf(bf_lo(s.y) * rh * silu_pre(v0[2]), bf_hi(s.y) * rh * silu_pre(v0[3]));
                    w.z = pkbf(bf_lo(s.z) * rh * silu_pre(v1[0]), bf_hi(s.z) * rh * silu_pre(v1[1])); w.w = pkbf(bf_lo(s.w) * rh * silu_pre(v1[2]), bf_hi(s.w) * rh * silu_pre(v1[3]));
                    *(u32x4*)((char*)O + (oofs + (unsigned)((ai * HALF + m * 16) * DI + bj * HALF) * 2u)) = w; } }
            asm volatile("" ::: "memory"); }
    }
};
struct EpiFinal {
    static constexpr bool PERM = true, AFTER_DRAIN = false;
    __device__ __forceinline__ void init_acc(f32x4 (&acc)[2][2][4][2], const Unit&, int, int, int, int) const { zero_acc(acc); }
    const bf16_t* HB; float* H; const float* fg; float* X; unsigned* cnt;
    __device__ __forceinline__ void prologue(const StaticOrder&, LAS unsigned char*, int) const {}
    __device__ __forceinline__ void operator()(f32x4 (&acc)[2][2][4][2], const Unit& u, int wr, int wc, int fr, int fq, LAS unsigned char* lds, int ui) const {
        LAS float* Pt = (LAS float*)(lds + TAB_OFF);
        LAS float* St = Pt + 1024;
        const int tid = (wr * 4 + wc) * 64 + fq * 16 + fr;
        const unsigned row0 = (unsigned)(u.pm * BM + wr * 64 + fr), col0 = (unsigned)(u.pn * BM + wc * 32 + 8 * fq);
        const unsigned ofs = (row0 * DM + col0) * 4u;
#pragma unroll
        for (int ai = 0; ai < 2; ++ai) {
            u32x4 hv[4][2];
#pragma unroll
            for (int m = 0; m < 4; ++m)
#pragma unroll
                for (int bj = 0; bj < 2; ++bj) hv[m][bj] = *(const u32x4*)((const char*)HB + ((ofs + (unsigned)((ai * HALF + m * 16) * DM + bj * HALF) * 4u) >> 1));
#pragma unroll
            for (int m = 0; m < 4; ++m) { float ss = 0.f;
#pragma unroll
                for (int bj = 0; bj < 2; ++bj) { const u32x4 hb = hv[m][bj];
                    const f32x4 h0 = acc[ai][bj][m][0] + (f32x4){bf_lo(hb.x), bf_hi(hb.x), bf_lo(hb.y), bf_hi(hb.y)}, h1 = acc[ai][bj][m][1] + (f32x4){bf_lo(hb.z), bf_hi(hb.z), bf_lo(hb.w), bf_hi(hb.w)};
                    acc[ai][bj][m][0] = h0; acc[ai][bj][m][1] = h1;
                    ss += ((h0[0] * h0[0] + h0[1] * h0[1]) + (h0[2] * h0[2] + h0[3] * h0[3])) + ((h1[0] * h1[0] + h1[1] * h1[1]) + (h1[2] * h1[2] + h1[3] * h1[3])); }
                ss += xor_get(ss, fq * 16 + fr, 16); ss += xor_get(ss, fq * 16 + fr, 32);
                if (fq == 0) Pt[(ai * HALF + wr * 64 + m * 16 + fr) * 4 + wc] = ss; }
            asm volatile("" ::: "memory"); }
        __syncthreads();
        float* xs = X + (size_t)u.pm * 1024;
        if (tid < 256) { const f32x4 p = *(const LAS f32x4*)(Pt + tid * 4);
            __hip_atomic_store(xs + u.pn * 256 + tid, (p[0] + p[1]) + (p[2] + p[3]), __ATOMIC_RELAXED, __HIP_MEMORY_SCOPE_AGENT); }
        asm volatile("s_waitcnt vmcnt(0)" ::: "memory");
        __syncthreads();
        if (tid == 0) {
            unsigned* c = cnt + 16 * u.pm;
            __hip_atomic_fetch_add(c, 1u, __ATOMIC_RELAXED, __HIP_MEMORY_SCOPE_AGENT);
            unsigned spins = 0;
            while (__hip_atomic_load(c, __ATOMIC_RELAXED, __HIP_MEMORY_SCOPE_AGENT) < 4u) { __builtin_amdgcn_s_sleep(2); if (++spins > (1u << 22)) break; }
            __builtin_amdgcn_fence(__ATOMIC_ACQUIRE, "agent");
            asm volatile("s_waitcnt vmcnt(0)" ::: "memory");
        }
        __syncthreads();
        if (tid < 256) { float s = 0.f;
#pragma unroll
            for (int t = 0; t < 4; ++t) s += __hip_atomic_load(xs + t * 256 + tid, __ATOMIC_RELAXED, __HIP_MEMORY_SCOPE_AGENT);
            St[tid] = __builtin_amdgcn_rsqf(s * (1.0f / DM) + EPS); }
        __syncthreads();
        f32x4 gv[2][2];
#pragma unroll
        for (int bj = 0; bj < 2; ++bj)
#pragma unroll
            for (int n = 0; n < 2; ++n) gv[bj][n] = *(const f32x4*)(fg + col0 + bj * HALF + n * 4);
#pragma unroll
        for (int ai = 0; ai < 2; ++ai)
#pragma unroll
            for (int m = 0; m < 4; ++m) { const float rs = St[ai * HALF + wr * 64 + m * 16 + fr];
#pragma unroll
                for (int bj = 0; bj < 2; ++bj) { const unsigned oo = ofs + (unsigned)((ai * HALF + m * 16) * DM + bj * HALF) * 4u;
                    *(f32x4*)((char*)H + oo) = acc[ai][bj][m][0] * rs * gv[bj][0]; *(f32x4*)((char*)H + oo + 16u) = acc[ai][bj][m][1] * rs * gv[bj][1]; } }
        __syncthreads();
    }
};
}

namespace scan {
#define MFMA16(a, b, c) __builtin_amdgcn_mfma_f32_16x16x32_bf16((a), (b), (c), 0, 0, 0)
__device__ __forceinline__ unsigned offb(unsigned row, unsigned ch) { return 256u * row + 16u * (ch ^ (((row & 3u) << 2) | ((row >> 2) & 3u))); }
__device__ __forceinline__ unsigned voffv(unsigned r, unsigned cp) { return 128u * r + 32u * (cp ^ (((r >> 1) & 3u) ^ (((r >> 3) & 1u) << 1))); }
__device__ __forceinline__ void tr8(unsigned a0, unsigned a1, unsigned c0, unsigned c1, bf16x8& f00, bf16x8& f01, bf16x8& f10, bf16x8& f11) {
    u32x2 r0, r1, r2, r3, r4, r5, r6, r7;
    asm volatile("ds_read_b64_tr_b16 %0, %8\n\tds_read_b64_tr_b16 %1, %9\n\tds_read_b64_tr_b16 %2, %8 offset:8192\n\tds_read_b64_tr_b16 %3, %9 offset:8192\n\t"
                 "ds_read_b64_tr_b16 %4, %10\n\tds_read_b64_tr_b16 %5, %11\n\tds_read_b64_tr_b16 %6, %10 offset:8192\n\tds_read_b64_tr_b16 %7, %11 offset:8192\n\ts_waitcnt lgkmcnt(0)"
                 : "=&v"(r0), "=&v"(r1), "=&v"(r2), "=&v"(r3), "=&v"(r4), "=&v"(r5), "=&v"(r6), "=&v"(r7) : "v"(a0), "v"(a1), "v"(c0), "v"(c1) : "memory");
    const u32x4 x00 = {r0.x, r0.y, r1.x, r1.y}, x01 = {r2.x, r2.y, r3.x, r3.y}, x10 = {r4.x, r4.y, r5.x, r5.y}, x11 = {r6.x, r6.y, r7.x, r7.y};
    f00 = __builtin_bit_cast(bf16x8, x00); f01 = __builtin_bit_cast(bf16x8, x01); f10 = __builtin_bit_cast(bf16x8, x10); f11 = __builtin_bit_cast(bf16x8, x11);
}
__device__ __forceinline__ bf16x8 pack8(const f32x4 a, const f32x4 b) { const u32x4 r = {pkbf(a[0], a[1]), pkbf(a[2], a[3]), pkbf(b[0], b[1]), pkbf(b[2], b[3])}; return __builtin_bit_cast(bf16x8, r); }
__device__ __forceinline__ u32x2 tr_issue(unsigned a) { u32x2 r; asm volatile("ds_read_b64_tr_b16 %0, %1" : "=v"(r) : "v"(a) : "memory"); return r; }
__device__ __forceinline__ bf16x8 frag2(const u32x2 lo, const u32x2 hi) { const u32x4 r = {lo.x, lo.y, hi.x, hi.y}; return __builtin_bit_cast(bf16x8, r); }
__device__ __forceinline__ u32x2 at_tile(LAS unsigned char* lds, unsigned QI, unsigned KI, int it, int j, unsigned l15, unsigned g) {
    f32x4 c = (f32x4){0.f, 0.f, 0.f, 0.f};
#pragma unroll
    for (int kd = 0; kd < 4; ++kd) { const bf16x8 qb = *(const LAS bf16x8*)(lds + QI + offb(16u * (unsigned)it + l15, 4u * kd + g)), a = *(const LAS bf16x8*)(lds + KI + offb(16u * (unsigned)j + l15, 4u * kd + g)); c = MFMA16(a, qb, c); }
    if (j == it) {
#pragma unroll
        for (int r = 0; r < 4; ++r) c[r] = (4u * g + r <= l15) ? c[r] : 0.f; }
    const u32x2 w = {pkbf(c[0], c[1]), pkbf(c[2], c[3])}; return w;
}
template <int NK>
__device__ __forceinline__ f32x4 o_part(LAS unsigned char* lds, unsigned QI, int it, const bf16x8 (&at)[NK], const bf16x8 (&vf)[2], const bf16x8 so0, const bf16x8 so1, const bf16x8 sp0, const bf16x8 sp1, int th, unsigned l15, unsigned g) {
    const unsigned trow = 16u * (unsigned)it + l15;
    f32x4 o = (f32x4){0.f, 0.f, 0.f, 0.f};
#pragma unroll
    for (int ks = 0; ks < NK; ++ks) if (2 * ks <= it) o = MFMA16(vf[ks], at[ks], o);
#pragma unroll
    for (int j = 0; j < 4; ++j) {
        const unsigned kd = (j < 2) ? (2u * (unsigned)th + j) : (2u * (unsigned)(1 - th) + (j - 2));
        const u32x2 q0 = *(const LAS u32x2*)(lds + QI + offb(trow, 4u * kd + (g >> 1)) + 8u * (g & 1)), q1 = *(const LAS u32x2*)(lds + QI + offb(trow, 4u * kd + 2u + (g >> 1)) + 8u * (g & 1));
        o = MFMA16(j == 0 ? so0 : j == 1 ? so1 : j == 2 ? sp0 : sp1, frag2(q0, q1), o); }
    return o;
}
__device__ __forceinline__ void phase(LAS unsigned char* lds, const bf16_t* Qt, const bf16_t* Kt, bf16_t* VO, const float* DEC, float* ss8, int bid, int G, int wave) {
    const unsigned lane = (unsigned)fresh_lane_id(), l15 = lane & 15u, g = lane >> 4, ql = l15 >> 2, p = lane & 3u;
    const unsigned vs = (unsigned)wave & 3u; const int th = wave >> 2, tA = th ? 1 : 0, tB = th ? 2 : 3;
    const unsigned ldsb = (unsigned)(uintptr_t)lds;
    constexpr unsigned QKB = 32768u, VRING = 3u * QKB, DECB = VRING + 2u * 8192u, SFB = DECB + 1536u, ATB = SFB + 32768u;
    static_assert(ATB + 2u * 5120u <= XST_OFF, "scan LDS map");
    unsigned qoff[2], voff_, doff;
#pragma unroll
    for (int i = 0; i < 2; ++i) { const unsigned j = 2u * (unsigned)wave + i, r = 4u * j + (lane >> 4), pc = lane & 15u, ch = pc ^ (((r & 3u) << 2) | ((r >> 2) & 3u)); qoff[i] = (r * DI + ch * 8u) * 2u; }
    { const unsigned r = 8u * (unsigned)wave + (lane >> 3), s16 = lane & 7u, ul = (s16 >> 1) ^ (((r >> 1) & 3u) ^ (((r >> 3) & 1u) << 1)); voff_ = (r * DI + (ul * 2u + (s16 & 1u)) * 8u) * 2u; }
    doff = (64u * ((unsigned)wave & 1u) + lane) * 4u;
    const int my_it = wave == 0 ? 0 : wave <= 2 ? 1 : wave <= 5 ? 2 : 3, my_j = wave == 0 ? 0 : wave <= 2 ? wave - 1 : wave <= 5 ? wave - 3 : wave - 6;
    for (int item = bid; item < BATCH * NHEAD * 2; item += G) {
        const int half = (item >> 3) & 1, pair = (item & 7) | ((item >> 4) << 3), b = pair >> 4, h = pair & 15;
        const size_t tokb = (size_t)b * SEQ;
        const char* qg = (const char*)(Qt + tokb * DI + h * HD);
        const char* kg = (const char*)(Kt + tokb * DI + h * HD);
        bf16_t* vg = VO + tokb * DI + h * HD + half * 64;
        const char* dg = (const char*)(DEC + (size_t)(b * (SEQ / 64)) * DI + h * HD);
        f32x4 S[4];
        bf16x8 so0 = (bf16x8){0, 0, 0, 0, 0, 0, 0, 0}, so1 = so0, sp0 = so0, sp1 = so0;
#pragma unroll
        for (int i = 0; i < 4; ++i) S[i] = (f32x4){0.f, 0.f, 0.f, 0.f};
#define SC_DMA_QK(c_) do { const size_t o_ = (size_t)(c_) * 64 * DI * 2; const unsigned base_ = ((unsigned)(c_) % 3u) * QKB; \
            __builtin_amdgcn_global_load_lds((const unsigned*)(qg + o_ + qoff[0]), (LAS unsigned*)(lds + base_ + (unsigned)wave * 2048u), 16, 0, 0); \
            __builtin_amdgcn_global_load_lds((const unsigned*)(qg + o_ + qoff[1]), (LAS unsigned*)(lds + base_ + (unsigned)wave * 2048u + 1024u), 16, 0, 0); \
            __builtin_amdgcn_global_load_lds((const unsigned*)(kg + o_ + qoff[0]), (LAS unsigned*)(lds + base_ + 16384u + (unsigned)wave * 2048u), 16, 0, 0); \
            __builtin_amdgcn_global_load_lds((const unsigned*)(kg + o_ + qoff[1]), (LAS unsigned*)(lds + base_ + 16384u + (unsigned)wave * 2048u + 1024u), 16, 0, 0); \
            __builtin_amdgcn_global_load_lds((const unsigned*)(dg + (size_t)(c_) * DI * 4 + doff), (LAS unsigned*)(lds + DECB + ((unsigned)(c_) % 3u) * 512u + ((unsigned)wave & 1u) * 256u), 4, 0, 0); } while (0)
#define SC_DMA_V(c_) __builtin_amdgcn_global_load_lds((const unsigned*)((const char*)vg + (size_t)(c_) * 64 * DI * 2 + voff_), (LAS unsigned*)(lds + VRING + ((unsigned)(c_) & 1u) * 8192u + (unsigned)wave * 1024u), 16, 0, 0)
#define SC_AT(c_) do { LAS u32x2* atw = (LAS u32x2*)(lds + ATB + (unsigned)((c_) & 1) * 5120u) + lane; const unsigned b_ = ((unsigned)(c_) % 3u) * QKB; \
            atw[64 * wave] = at_tile(lds, b_, b_ + 16384u, my_it, my_j, l15, g); \
            if (wave < 2) atw[64 * (8 + wave)] = at_tile(lds, b_, b_ + 16384u, 3, 2 + wave, l15, g); } while (0)
        SC_DMA_QK(0); SC_DMA_QK(1); SC_DMA_V(0); SC_DMA_V(1);
        asm volatile("s_waitcnt vmcnt(0)" ::: "memory");
        __builtin_amdgcn_s_barrier();
        SC_AT(0);
        asm volatile("s_waitcnt lgkmcnt(0)" ::: "memory");
        __builtin_amdgcn_s_barrier();
        for (int n = 0; n < SEQ / 64; ++n) {
            const unsigned QI = ((unsigned)n % 3u) * QKB, KI = QI + 16384u, VI = VRING + ((unsigned)n & 1u) * 8192u;
            if (n + 2 < SEQ / 64) SC_DMA_QK(n + 2);
            if (n > 0) { const LAS bf16x8* sfr = (const LAS bf16x8*)(lds + SFB + ((unsigned)n & 1u) * 16384u + (unsigned)(wave ^ 4) * 2048u) + lane;
                sp0 = sfr[0]; sp1 = sfr[64]; }
            u32x2 tv0, tv1, tv2, tv3, tv4, tv5, tv6, tv7;
            {
                const unsigned va = ldsb + VI + 8u * p;
                tv0 = tr_issue(va + voffv(4u * g + ql, vs)); tv1 = tr_issue(va + voffv(16u + 4u * g + ql, vs)); tv2 = tr_issue(va + voffv(32u + 4u * g + ql, vs)); tv3 = tr_issue(va + voffv(48u + 4u * g + ql, vs));
                tv4 = tr_issue(va + voffv(8u * g + ql, vs)); tv5 = tr_issue(va + voffv(8u * g + 4u + ql, vs)); tv6 = tr_issue(va + voffv(32u + 8u * g + ql, vs)); tv7 = tr_issue(va + voffv(36u + 8u * g + ql, vs));
            }
            bf16x8 atB[2], atA[1];
            { const LAS u32x2* atr = (const LAS u32x2*)(lds + ATB + (unsigned)(n & 1) * 5120u) + lane; const u32x2 z2 = {0u, 0u};
              if (th == 0) { atB[0] = frag2(atr[64 * 6], atr[64 * 7]); atB[1] = frag2(atr[64 * 8], atr[64 * 9]); atA[0] = frag2(atr[0], z2); }
              else         { atB[0] = frag2(atr[64 * 3], atr[64 * 4]); atB[1] = frag2(atr[64 * 5], z2);          atA[0] = frag2(atr[64 * 1], atr[64 * 2]); } }
            if (n < SEQ / 64 - 2) asm volatile("s_waitcnt vmcnt(10)" ::: "memory"); else asm volatile("s_waitcnt vmcnt(0)" ::: "memory");
            asm volatile("s_waitcnt lgkmcnt(0)" : "+v"(tv0), "+v"(tv1), "+v"(tv2), "+v"(tv3), "+v"(tv4), "+v"(tv5), "+v"(tv6), "+v"(tv7) :: "memory");
            __builtin_amdgcn_s_barrier();
            if (n + 2 < SEQ / 64) SC_DMA_V(n + 2);
            if (n + 1 < SEQ / 64) SC_AT(n + 1);
            __builtin_amdgcn_sched_barrier(0);
            const bf16x8 vf[2] = {frag2(tv0, tv1), frag2(tv2, tv3)};
            const f32x4 oB = o_part<2>(lds, QI, tB, atB, vf, so0, so1, sp0, sp1, th, l15, g);
            const f32x4 oA = o_part<1>(lds, QI, tA, atA, vf, so0, so1, sp0, sp1, th, l15, g);
            {
                const bf16x8 vn0 = frag2(tv4, tv5), vn1 = frag2(tv6, tv7);
                const LAS float* dcp = (const LAS float*)(lds + DECB + ((unsigned)n % 3u) * 512u) + 4u * g + 64u * (unsigned)th;
                const unsigned ka = (ldsb + KI + offb(8u * g + ql, (p >> 1)) + 8u * (p & 1u)) ^ ((unsigned)th << 7), kb = (ldsb + KI + offb(8u * g + 4u + ql, (p >> 1)) + 8u * (p & 1u)) ^ ((unsigned)th << 7);
#pragma unroll
                for (int i = 0; i < 4; i += 2) {
                    bf16x8 k00, k01, k10, k11;
                    tr8(ka ^ ((unsigned)i << 5), kb ^ ((unsigned)i << 5), ka ^ ((unsigned)(i + 1) << 5), kb ^ ((unsigned)(i + 1) << 5), k00, k01, k10, k11);
                    S[i] = MFMA16(k00, vn0, S[i]); S[i + 1] = MFMA16(k10, vn0, S[i + 1]); S[i] = MFMA16(k01, vn1, S[i]); S[i + 1] = MFMA16(k11, vn1, S[i + 1]); }
#pragma unroll
                for (int i = 0; i < 4; ++i) { const f32x4 dc = *(const LAS f32x4*)(dcp + 16 * i); S[i] = S[i] * dc; }
                const bf16x8 f0 = pack8(S[0], S[1]), f1 = pack8(S[2], S[3]);
                so0 = f0; so1 = f1;
                LAS bf16x8* sfw = (LAS bf16x8*)(lds + SFB + ((unsigned)(n + 1) & 1u) * 16384u + (unsigned)wave * 2048u) + lane;
                sfw[0] = f0; sfw[64] = f1;
            }
            if (n < SEQ / 64 - 2) asm volatile("s_waitcnt vmcnt(10)" ::: "memory"); else asm volatile("s_waitcnt vmcnt(0)" ::: "memory");
            {
                const size_t tlB = (size_t)n * 64 + 16u * (unsigned)tB + l15, tlA = (size_t)n * 64 + 16u * (unsigned)tA + l15;
                const u32x2 wB = {pkbf(oB[0], oB[1]), pkbf(oB[2], oB[3])}, wA = {pkbf(oA[0], oA[1]), pkbf(oA[2], oA[3])};
                *(u32x2*)(vg + tlB * DI + 16u * vs + 4u * g) = wB; *(u32x2*)(vg + tlA * DI + 16u * vs + 4u * g) = wA;
                float sB = (oB[0] * oB[0] + oB[1] * oB[1]) + (oB[2] * oB[2] + oB[3] * oB[3]), sA = (oA[0] * oA[0] + oA[1] * oA[1]) + (oA[2] * oA[2] + oA[3] * oA[3]);
                sB += xor_get(sB, (int)lane, 16); sA += xor_get(sA, (int)lane, 16); sB += xor_get(sB, (int)lane, 32); sA += xor_get(sA, (int)lane, 32);
                if (g == 0) { ss8[(tokb + tlB) * 128 + h * 8 + half * 4 + vs] = sB; ss8[(tokb + tlA) * 128 + h * 8 + half * 4 + vs] = sA; }
            }
            asm volatile("s_waitcnt lgkmcnt(0)" ::: "memory");
            __builtin_amdgcn_s_barrier();
        }
#undef SC_DMA_QK
#undef SC_DMA_V
#undef SC_AT
    }
}
#undef MFMA16
}

#define XB_TMO      128
#define XB_XCNT(j)  (256  + 64 * (j))
#define XB_XSUB(j)  (1280 + 64 * (j))
#define XB_XGEN(j)  (2304 + 64 * (j))
#define XB_TOP      3328
#define XB_TOPGEN   3392
#define XCD_BAR_WORDS 3456
#define XB_SPIN_CAP (1u << 18)
__device__ __forceinline__ unsigned xb_ld(unsigned* p)              { return __hip_atomic_load(p, __ATOMIC_RELAXED, __HIP_MEMORY_SCOPE_AGENT); }
__device__ __forceinline__ unsigned xb_add(unsigned* p, unsigned v) { return __hip_atomic_fetch_add(p, v, __ATOMIC_RELAXED, __HIP_MEMORY_SCOPE_AGENT); }
__device__ __forceinline__ unsigned xb_xcc_id() { return (unsigned)__builtin_amdgcn_s_getreg((3 << 11) | 20) & 0xFu; }
#define XB_SPIN(cond, bar) do { unsigned _sp = 0; while (cond) { __builtin_amdgcn_s_sleep(1); \
    if ((++_sp & 255u) == 0u) { if (xb_ld(&(bar)[XB_TMO])) break; if (_sp > XB_SPIN_CAP) { atomicAdd(&(bar)[XB_TMO], 1u); break; } } } } while (0)
struct XcdBarrier { unsigned* bar; unsigned x; volatile LAS unsigned* st; };
__device__ __forceinline__ XcdBarrier xcd_barrier_post(unsigned* bar, volatile LAS unsigned* st) {
    XcdBarrier b; b.bar = bar; b.x = xb_xcc_id(); b.st = st;
    if (threadIdx.x == 0) (void)xb_add(&bar[XB_XCNT(b.x)], 1u);
    return b;
}
__device__ __forceinline__ void xcd_barrier_complete(unsigned* bar, unsigned x, unsigned& nloc, unsigned& nx) {
    const unsigned G = gridDim.x * gridDim.y * gridDim.z;
    unsigned sum, cnt, mine, sp = 0u;
    for (;;) {
        sum = 0u; cnt = 0u; mine = 0u;
#pragma unroll
        for (unsigned j = 0; j < 16; ++j) { const unsigned c = xb_ld(&bar[XB_XCNT(j)]); sum += c; cnt += (c > 0u) ? 1u : 0u; mine = (j == x) ? c : mine; }
        if (sum == G) break;
        __builtin_amdgcn_s_sleep(1);
        if ((++sp & 255u) == 0u) { if (xb_ld(&bar[XB_TMO])) break; if (sp > XB_SPIN_CAP) { atomicAdd(&bar[XB_TMO], 1u); break; } }
    }
    nloc = mine > 0u ? mine : 1u; nx = cnt > 0u ? cnt : 1u;
}
__device__ __forceinline__ void xcd_barrier(const XcdBarrier& b) {
    asm volatile("s_waitcnt vmcnt(0)" ::: "memory");
    __syncthreads();
    if (threadIdx.x == 0) {
        unsigned* bar = b.bar;
        __builtin_amdgcn_s_waitcnt(0);
        unsigned nloc = b.st[0], nx = b.st[1];
        if (nloc == 0u) { xcd_barrier_complete(bar, b.x, nloc, nx); b.st[0] = nloc; b.st[1] = nx; }
        const unsigned old = xb_add(&bar[XB_XSUB(b.x)], 1u);
        const unsigned gen = old / nloc;
        if (old + 1u == (gen + 1u) * nloc) {
            __builtin_amdgcn_fence(__ATOMIC_RELEASE, "agent");
            asm volatile("s_waitcnt vmcnt(0)" ::: "memory");
            const unsigned og = xb_add(&bar[XB_TOP], 1u);
            const unsigned tg = og / nx;
            if (og + 1u == (tg + 1u) * nx) xb_add(&bar[XB_TOPGEN], 1u);
            else XB_SPIN(xb_ld(&bar[XB_TOPGEN]) == tg, bar);
            __builtin_amdgcn_fence(__ATOMIC_ACQUIRE, "agent");
            xb_add(&bar[XB_XGEN(b.x)], 1u);
            asm volatile("s_waitcnt vmcnt(0)" ::: "memory");
        } else {
            XB_SPIN(xb_ld(&bar[XB_XGEN(b.x)]) == gen, bar);
            __builtin_amdgcn_fence(__ATOMIC_ACQUIRE, "agent");
            asm volatile("s_waitcnt vmcnt(0)" ::: "memory");
        }
    }
    __syncthreads();
}

struct Args {
    const float* x; const float* norm_g; const float* pool_w_in; const float* pool_w_grp; const float* pool_scale; const float* pool_w_out;
    const float* hgrn_w_in; const float* hgrn_lb; const float* hgrn_norm_g; const float* hgrn_w_out; const float* final_g;
    float* out; unsigned char* ws;
};

struct TItem { const float* W; bf16_t* WT; const float* ks; const float* ns; int K, N, row_off, item; float cs; };
__device__ __forceinline__ void titem_issue(const TItem& t, int lane, float (&wv)[32]) {
    const int nblk = t.N / 32, kb = t.item / nblk, nb = t.item % nblk, k0 = 64 * kb, n0 = 32 * nb;
    const float* wp = t.W + (size_t)(k0 + (lane >> 5)) * t.N + n0 + (lane & 31);
#pragma unroll
    for (int i = 0; i < 32; ++i) wv[i] = __builtin_nontemporal_load(wp + (size_t)(2 * i) * t.N);
}
__device__ __forceinline__ void titem_finish(const TItem& t, int lane, const float (&wv)[32], LAS float* scr) {
    const int nblk = t.N / 32, kb = t.item / nblk, nb = t.item % nblk, k0 = 64 * kb, n0 = 32 * nb;
    const float nsv = (t.ns ? t.ns[n0 + (lane & 31)] : 1.0f) * t.cs;
    const float ksv = t.ks ? t.ks[k0 + lane] : 1.0f;
#pragma unroll
    for (int i = 0; i < 32; ++i) { const int kk = 2 * i + (lane >> 5); scr[kk * 33 + (lane & 31)] = wv[i] * nsv * lane_get(ksv, kk); }
    asm volatile("s_waitcnt lgkmcnt(0)" ::: "memory");
    const int c = lane & 7;
#pragma unroll
    for (int j = 0; j < 4; ++j) { const int n = (lane >> 3) + 8 * j; const LAS float* s = scr + (8 * c) * 33 + n;
        u32x4 o; o.x = pkbf(s[0 * 33], s[1 * 33]); o.y = pkbf(s[2 * 33], s[3 * 33]); o.z = pkbf(s[4 * 33], s[5 * 33]); o.w = pkbf(s[6 * 33], s[7 * 33]);
        *(u32x4*)(t.WT + (size_t)(t.row_off + n0 + n) * t.K + k0 + 8 * c) = o; }
    asm volatile("s_waitcnt lgkmcnt(0)" ::: "memory");
}

__global__ void __launch_bounds__(512, 2) fwd_kernel(Args a) {
    extern __shared__ __attribute__((aligned(16))) unsigned char lds_raw[];
    LAS unsigned char* lds = (LAS unsigned char*)lds_raw;
    volatile LAS unsigned* xst = (volatile LAS unsigned*)(lds + XST_OFF);
    if (threadIdx.x < 2) xst[threadIdx.x] = 0u;
    __syncthreads();
    const XcdBarrier xbar = xcd_barrier_post((unsigned*)a.ws, xst);
#define GRID_BAR() xcd_barrier(xbar)
    const int G = gridDim.x, bid = blockIdx.x;
    const int NGW = G * 8;
    const int wave = __builtin_amdgcn_readfirstlane((int)threadIdx.x >> 6);
#define PHASE_IDS int lane_ = fresh_lane_id(); const int lane = lane_, tid = wave * 64 + lane, gw = bid * 8 + wave; (void)gw; (void)tid;
    unsigned char* ws = a.ws;
    bf16_t* Wt_in0 = (bf16_t*)(ws + WS_WIN0); bf16_t* Wt_grp = (bf16_t*)(ws + WS_WGRP); bf16_t* Wt_out0 = (bf16_t*)(ws + WS_WOUT0);
    bf16_t* Wt_in1 = (bf16_t*)(ws + WS_WIN1); bf16_t* Wt_out1 = (bf16_t*)(ws + WS_WOUT1);
    float* invr0 = (float*)(ws + WS_INVR); float* part1 = (float*)(ws + WS_PART1); float* ssb = (float*)(ws + WS_SS); float* decb = (float*)(ws + WS_DEC);
    bf16_t* XB = (bf16_t*)(ws + WS_XB); bf16_t* BA = (bf16_t*)(ws + WS_A); bf16_t* BB = (bf16_t*)(ws + WS_B); bf16_t* BC = (bf16_t*)(ws + WS_C);

    {
        PHASE_IDS
        LAS float* scr = (LAS float*)(lds + wave * 16384);
        constexpr int I_IN0 = (DM / 64) * (2048 / 32), I_GRP1 = (512 / 64) * (512 / 32), I_OUT = (DI / 64) * (DM / 32), I_IN1 = (DM / 64) * (8192 / 32);
        constexpr int NITEMS = I_IN0 + 4 * I_GRP1 + I_OUT + I_IN1 + I_OUT;
        auto decode = [&](int it) -> TItem {
            int r = it;
            if (r < I_IN0) {
                const int kb = r >> 6, nb = r & 63, n0 = 2048 + 32 * nb, d0 = 256 * ((n0 - 2048) >> 7) + 128 + (n0 & 127);
                return TItem{a.pool_w_in, Wt_in0, a.norm_g, nullptr, DM, 4096, d0 - n0, kb * 128 + 64 + nb, NEG_LOG2E}; } r -= I_IN0;
            if (r < 4 * I_GRP1) { const int g = r / I_GRP1; return TItem{a.pool_w_grp + (size_t)g * 512 * 512, Wt_grp, nullptr, a.pool_scale + g * 512, 512, 512, g * 512, r % I_GRP1, 1.0f}; } r -= 4 * I_GRP1;
            if (r < I_OUT) return TItem{a.pool_w_out, Wt_out0, nullptr, nullptr, DI, DM, 0, r, NEG_LN2}; r -= I_OUT;
            if (r < I_IN1) {
                const int n0 = 32 * (r % (8192 / 32)); int d0 = n0;
                if (n0 < 2048) d0 = 256 * (n0 >> 7) + (n0 & 127); else if (n0 < 4096) d0 = 256 * ((n0 - 2048) >> 7) + 128 + (n0 & 127);
                return TItem{a.hgrn_w_in, Wt_in1, a.norm_g + DM, nullptr, DM, 8192, d0 - n0, r, n0 >= 6144 ? NEG_LOG2E : 1.0f}; } r -= I_IN1;
            return TItem{a.hgrn_w_out, Wt_out1, a.hgrn_norm_g, nullptr, DI, DM, 0, r, NEG_LN2};
        };
        {
            float wa[32], wb[32]; TItem ia{}, ib{};
            int it = gw; bool ha = it < NITEMS;
            if (ha) { ia = decode(it); titem_issue(ia, lane, wa); }
            while (ha) {
                const int itb = it + NGW; const bool hb = itb < NITEMS;
                if (hb) { ib = decode(itb); titem_issue(ib, lane, wb); }
                titem_finish(ia, lane, wa, scr);
                it = itb + NGW; ha = it < NITEMS;
                if (ha) { ia = decode(it); titem_issue(ia, lane, wa); }
                if (!hb) break;
                titem_finish(ib, lane, wb, scr);
            }
        }
        for (int idx = gw * 64 + lane; idx < DM * (DI / 8); idx += NGW * 64) {
            const int k = idx >> 8, c8 = (idx & 255) * 8; const float gk = a.norm_g[k];
            const f32x4 w0 = __builtin_nontemporal_load((const f32x4*)(a.pool_w_in + (size_t)k * 4096 + c8)), w1 = __builtin_nontemporal_load((const f32x4*)(a.pool_w_in + (size_t)k * 4096 + c8 + 4));
            u32x4 o; o.x = pkbf(w0[0] * gk, w0[1] * gk); o.y = pkbf(w0[2] * gk, w0[3] * gk); o.z = pkbf(w1[0] * gk, w1[1] * gk); o.w = pkbf(w1[2] * gk, w1[3] * gk);
            *(u32x4*)(BC + (size_t)k * DI + c8) = o; }
    }
    GRID_BAR();

    {
        pg8::Gemm g{Wt_grp, BC, 512, DI, 512, 0, 2}; pg8::StaticOrder S; S.init(DI, DM, G, bid);
        pg8::EpiFold E{Wt_in0};
        pg8::gemm_phase<pg8::EpiFold>(lds, g, S, E, wave);
    }
    {
        PHASE_IDS
        for (int m0 = gw * 8; m0 < M; m0 += NGW * 8) {
            f32x4 v[8][4]; float s[8];
#pragma unroll
            for (int r = 0; r < 8; ++r) { const f32x4* xr = (const f32x4*)(a.x + (size_t)(m0 + r) * DM) + lane;
#pragma unroll
                for (int j = 0; j < 4; ++j) v[r][j] = __builtin_nontemporal_load(xr + 64 * j); }
#pragma unroll
            for (int r = 0; r < 8; ++r) { s[r] = 0.f;
#pragma unroll
                for (int j = 0; j < 4; ++j) s[r] += (v[r][j][0] * v[r][j][0] + v[r][j][1] * v[r][j][1]) + (v[r][j][2] * v[r][j][2] + v[r][j][3] * v[r][j][3]); }
#pragma unroll
            for (int o = 1; o < 64; o <<= 1) {
#pragma unroll
                for (int r = 0; r < 8; ++r) s[r] += xor_get(s[r], lane, o); }
#pragma unroll
            for (int r = 0; r < 8; ++r) { const float rms = sqrtf(s[r] * (1.0f / DM) + EPS), rstd = 1.0f / rms;
                if (lane == 0) invr0[m0 + r] = rms;
                unsigned long long* o8 = (unsigned long long*)(XB + (size_t)(m0 + r) * DM) + lane;
#pragma unroll
                for (int j = 0; j < 4; ++j) o8[64 * j] = (unsigned long long)pkbf(v[r][j][0] * rstd, v[r][j][1] * rstd) | ((unsigned long long)pkbf(v[r][j][2] * rstd, v[r][j][3] * rstd) << 32); }
        }
    }
    GRID_BAR();

    {
        pg8::Gemm g{XB, Wt_in0, DM, DM, DM, 0, 0}; pg8::StaticOrder S; S.init(M, 4096, G, bid);
        pg8::EpiP1 E{BB, (unsigned char*)BA, (unsigned char*)BA + 16 * MiB};
        pg8::gemm_phase<pg8::EpiP1>(lds, g, S, E, wave);
    }
    GRID_BAR();

    {
        PHASE_IDS
        const unsigned char* HALO = (const unsigned char*)BA; const unsigned char* SG0 = (const unsigned char*)BA + 16 * MiB;
        for (int idx = bid * 512 + tid; idx < 120 * 256; idx += G * 512) {
            const int sub = idx & 255, pq = idx >> 8, pm = (pq / 15) * 16 + (pq % 15) + 1;
            const int pn = sub >> 4, wc = (sub >> 2) & 3, fq = sub & 3, w = 2 << (pn >> 2);
            const unsigned char* hp = HALO + (size_t)((pm - 1) * 16 + pn) * pg8::HALO_TILE + (unsigned)((wc * 64 + fq * 16) * 16);
            const unsigned char* sp = SG0 + (size_t)(pm * 16 + pn) * pg8::HALO_TILE + (unsigned)((wc * 64 + fq * 16) * 16);
            bf16_t* zp = BB + (size_t)(pm * 256) * DI + pn * 128 + wc * 32 + fq * 8;
            const float inv = 1.0f / (float)w;
            float suf[8];
#pragma unroll
            for (int c = 0; c < 8; ++c) suf[c] = 0.f;
            for (int i = 15; i >= 17 - w; --i) {
                const u32x4 hv = *(const u32x4*)(hp + i * 16);
                suf[0] += bf_lo(hv.x); suf[1] += bf_hi(hv.x); suf[2] += bf_lo(hv.y); suf[3] += bf_hi(hv.y); suf[4] += bf_lo(hv.z); suf[5] += bf_hi(hv.z); suf[6] += bf_lo(hv.w); suf[7] += bf_hi(hv.w);
                const int t = w - 1 - (16 - i);
                const u32x4 sg = *(const u32x4*)(sp + t * 16);
                u32x4* q = (u32x4*)(zp + (size_t)t * DI); const u32x4 o = *q;
                u32x4 r; r.x = pkbf(bf_lo(o.x) + suf[0] * inv * bf_lo(sg.x), bf_hi(o.x) + suf[1] * inv * bf_hi(sg.x)); r.y = pkbf(bf_lo(o.y) + suf[2] * inv * bf_lo(sg.y), bf_hi(o.y) + suf[3] * inv * bf_hi(sg.y));
                r.z = pkbf(bf_lo(o.z) + suf[4] * inv * bf_lo(sg.z), bf_hi(o.z) + suf[5] * inv * bf_hi(sg.z)); r.w = pkbf(bf_lo(o.w) + suf[6] * inv * bf_lo(sg.w), bf_hi(o.w) + suf[7] * inv * bf_hi(sg.w));
                *q = r;
            }
        }
    }
    GRID_BAR();

    {
        pg8::Gemm g{BB, Wt_out0, DI, DI, DI, 0, 0}; pg8::StaticOrder S; S.init(M, DM, G, bid);
        pg8::EpiRes<true, false> E{XB, invr0, nullptr, XB, part1};
        pg8::gemm_phase<pg8::EpiRes<true, false>>(lds, g, S, E, wave);
    }
    GRID_BAR();

    {
        pg8::Gemm g{XB, Wt_in1, DM, DM, DM, 0, 0}; pg8::StaticOrder S; S.init(M, 6144, G, bid);
        pg8::EpiP4 E{BA, BB, BC, decb, part1, a.hgrn_lb};
        pg8::gemm_phase<pg8::EpiP4>(lds, g, S, E, wave);
    }
    GRID_BAR();

    scan::phase(lds, BA, BB, BC, decb, ssb, bid, G, wave);
    GRID_BAR();

    {
        pg8::Gemm g{XB, Wt_in1 + (size_t)6144 * DM, DM, DM, DM, 0, 0}; pg8::StaticOrder S; S.init(M, DI, G, bid);
        pg8::EpiP5b E{BC, part1, ssb};
        pg8::gemm_phase<pg8::EpiP5b>(lds, g, S, E, wave);
    }
    GRID_BAR();

    {
        pg8::Gemm g{BC, Wt_out1, DI, DI, DI, 0, 0}; pg8::StaticOrder S; S.init(M, DM, G, bid);
        pg8::EpiFinal E{XB, a.out, a.final_g, (float*)(ws + WS_X), (unsigned*)(ws + WS_CNT)};
        pg8::gemm_phase<pg8::EpiFinal>(lds, g, S, E, wave);
    }
}

extern "C" void kernel_launch(void* const* d_in, const int* in_sizes, int n_in, void* d_out, int out_size, void* d_ws, size_t ws_size, hipStream_t stream) {
    static int grid = 0;
    if (grid == 0) {
        if (n_in != 11 || in_sizes[0] != M * DM || out_size != M * DM || ws_size < WS_END) { fprintf(stderr, "kernel_launch: unexpected shapes (n_in %d in0 %d out %d ws %zu)\n", n_in, n_in > 0 ? in_sizes[0] : -1, out_size, ws_size); grid = -1; return; }
        int dev = 0, cus = 0, per = 0;
        if (hipGetDevice(&dev) != hipSuccess || hipDeviceGetAttribute(&cus, hipDeviceAttributeMultiprocessorCount, dev) != hipSuccess) { grid = -1; return; }
        if (hipFuncSetAttribute((const void*)fwd_kernel, hipFuncAttributeMaxDynamicSharedMemorySize, LDS_BYTES) != hipSuccess) { fprintf(stderr, "kernel_launch: hipFuncSetAttribute failed\n"); grid = -1; return; }
        if (hipOccupancyMaxActiveBlocksPerMultiprocessor(&per, (const void*)fwd_kernel, 512, LDS_BYTES) != hipSuccess || per < 1) { fprintf(stderr, "kernel_launch: occupancy query says %d\n", per); (void)hipGetLastError(); grid = -1; return; }
        grid = cus;
        fprintf(stderr, "kernel_launch: cus %d per_cu %d grid %d\n", cus, per, grid);
    }
    if (grid < 0) return;
    if (hipMemsetAsync(d_ws, 0, 32768, stream) != hipSuccess) { fprintf(stderr, "kernel_launch: hipMemsetAsync failed\n"); return; }
    Args a{};
    a.x = (const float*)d_in[0]; a.norm_g = (const float*)d_in[1]; a.pool_w_in = (const float*)d_in[2]; a.pool_w_grp = (const float*)d_in[3];
    a.pool_scale = (const float*)d_in[4]; a.pool_w_out = (const float*)d_in[5]; a.hgrn_w_in = (const float*)d_in[6]; a.hgrn_lb = (const float*)d_in[7];
    a.hgrn_norm_g = (const float*)d_in[8]; a.hgrn_w_out = (const float*)d_in[9]; a.final_g = (const float*)d_in[10];
    a.out = (float*)d_out; a.ws = (unsigned char*)d_ws;
    void* args[] = {&a};
    hipError_t e = hipLaunchCooperativeKernel((void*)fwd_kernel, dim3(grid), dim3(512), args, LDS_BYTES, stream);
    if (e != hipSuccess) fprintf(stderr, "kernel_launch: cooperative launch failed: %s (grid %d)\n", hipGetErrorString(e), grid);
}
```

```cpp
#include <hip/hip_runtime.h>
#include <cstdio>
#include <cstdint>

#define LAS __attribute__((address_space(3)))
typedef unsigned short bf16_t;
typedef short bf16x8 __attribute__((ext_vector_type(8)));
typedef float f32x4 __attribute__((ext_vector_type(4)));
typedef float f32x2 __attribute__((ext_vector_type(2)));
typedef unsigned u32x4 __attribute__((ext_vector_type(4)));
typedef unsigned u32x2 __attribute__((ext_vector_type(2)));

constexpr int DM = 1024, BATCH = 8, SEQ = 4096, DI = 2048, M = BATCH * SEQ;
constexpr int NHEAD = 16, HD = 128;
constexpr float EPS = 1e-6f;
constexpr size_t MiB = 1u << 20;
constexpr size_t WS_WIN0 = 2 * MiB;
constexpr size_t WS_WGRP = 10 * MiB;
constexpr size_t WS_WOUT0 = 12 * MiB;
constexpr size_t WS_WIN1 = 16 * MiB;
constexpr size_t WS_WOUT1 = 32 * MiB;
constexpr size_t WS_PART1 = 36 * MiB;
constexpr size_t WS_INVR = 38 * MiB;
constexpr size_t WS_CNT = 16384;
constexpr size_t WS_X = 40 * MiB;
constexpr size_t WS_DEC = 44 * MiB;
constexpr size_t WS_SS = 112 * MiB;
constexpr size_t WS_XB = 48 * MiB;
constexpr size_t WS_A = 128 * MiB;
constexpr size_t WS_B = 256 * MiB;
constexpr size_t WS_C = 384 * MiB;
constexpr size_t WS_END = 512 * MiB;
constexpr int LDS_BYTES = 163840;
constexpr unsigned XST_OFF = 163840u - 256u;

typedef __bf16 bf2_t __attribute__((ext_vector_type(2)));
__device__ __forceinline__ unsigned pkbf(float lo, float hi) { f32x2 v = {lo, hi}; return __builtin_bit_cast(unsigned, __builtin_convertvector(v, bf2_t)); }
__device__ __forceinline__ float bf_lo(unsigned w) { return __builtin_bit_cast(float, w << 16); }
__device__ __forceinline__ float bf_hi(unsigned w) { return __builtin_bit_cast(float, w & 0xffff0000u); }
__device__ __forceinline__ float silu_f(float x) { return x * __builtin_amdgcn_rcpf(1.0f + __builtin_amdgcn_exp2f(-1.44269504089f * x)); }
__device__ __forceinline__ float silu_pre(float t) { return t * __builtin_amdgcn_rcpf(1.0f + __builtin_amdgcn_exp2f(t)); }
constexpr float NEG_LOG2E = -1.44269504089f, NEG_LN2 = -0.69314718056f;
__device__ __forceinline__ int fresh_lane_id() { int l; asm volatile("v_mbcnt_lo_u32_b32 %0, -1, 0\n\tv_mbcnt_hi_u32_b32 %0, -1, %0" : "=v"(l)); return l; }
__device__ __forceinline__ float lane_get(float v, int src_lane) { return __builtin_bit_cast(float, __builtin_amdgcn_ds_bpermute(src_lane << 2, __builtin_bit_cast(int, v))); }
__device__ __forceinline__ float xor_get(float v, int lane, int m) { return lane_get(v, lane ^ m); }
__device__ __forceinline__ float wave_sum(float v, int lane) {
#pragma unroll
    for (int o = 1; o < 64; o <<= 1) v += xor_get(v, lane, o);
    return v;
}

namespace pg8 {
constexpr int BM = 256, BK = 64, HALF = 128, HTB = HALF * BK * 2, NXCD = 8, WGM = 4;
__host__ __device__ __forceinline__ int lds_byte(int r, int c) { const int st = (r >> 4) * 2 + (c >> 5), rr = r & 15, cc = c & 31, ob = rr * 64 + cc * 2; return st * 1024 + (ob ^ (((ob >> 9) & 1) << 5)); }
__host__ __device__ __forceinline__ void stage_rc(int b, int& R, int& C) { const int st = b / 1024, sb = b % 1024, swz = sb ^ (((sb >> 9) & 1) << 5); R = (st >> 1) * 16 + swz / 64; C = (st & 1) * 32 + (swz % 64) / 2; }
__host__ __device__ __forceinline__ int perm32(int rho) { const int n = rho >> 4, i = rho & 15; return 8 * (i >> 2) + 4 * n + (i & 3); }

struct Unit { int pm, pn; };
struct Gemm { const bf16_t* A; const bf16_t* Bt; int lda, ldb, K, grp_tiles, grp_b; };

struct StaticOrder {
    int nM, nN, nwg, G, c;
    __host__ __device__ void init(int M_, int N_, int G_, int c_) { nM = M_ / BM; nN = N_ / BM; nwg = nM * nN; G = G_; c = c_; }
    __host__ __device__ bool next(int i, Unit& u) const {
        const long L = (long)i * G + c; if (L >= nwg) return false;
        int wgid = (int)L; { const int q = nwg / NXCD, r = nwg % NXCD, xcd = wgid % NXCD, off = wgid / NXCD; wgid = (xcd < r ? xcd * (q + 1) : r * (q + 1) + (xcd - r) * q) + off; }
        const int nig = WGM * nN, gid = wgid / nig, fm = gid * WGM, gsz = (nM - fm) < WGM ? (nM - fm) : WGM;
        u.pm = fm + ((wgid % nig) % gsz); u.pn = (wgid % nig) / gsz; return true;
    }
};


__device__ __forceinline__ void zero_acc(f32x4 (&acc)[2][2][4][2]) {
#pragma unroll
    for (int a = 0; a < 2; ++a)
#pragma unroll
        for (int b = 0; b < 2; ++b)
#pragma unroll
            for (int m = 0; m < 4; ++m)
#pragma unroll
                for (int n = 0; n < 2; ++n) acc[a][b][m][n] = (f32x4){0.f, 0.f, 0.f, 0.f};
}
template <class Epi, bool ALIGN_EPI = true, bool SP2 = true>
__device__ __forceinline__ void gemm_phase(LAS unsigned char* lds, const Gemm g, const StaticOrder& S, const Epi& E, const int wid) {
    int lane_ = fresh_lane_id();
    int lane = lane_, tid = wid * 64 + lane, fr = lane & 15, fq = lane >> 4; const int wr = wid >> 2, wc = wid & 3;
    const int K = g.K, nt = K / BK;
    unsigned voffA[2], voffB[2]; int aoff, boff;
#define PG8_LANE_STATE() do { _Pragma("unroll") for (int i = 0; i < 2; ++i) { int R, C; stage_rc(tid * 16 + i * 8192, R, C); const int Rb = Epi::PERM ? ((R & ~31) + perm32(R & 31)) : R; \
        voffA[i] = (unsigned)(R * g.lda + C) * 2u; voffB[i] = (unsigned)(Rb * g.ldb + C) * 2u; } \
        aoff = lds_byte(wr * 64 + fr, fq * 8); boff = lds_byte(wc * 32 + fr, fq * 8); } while (0)
    PG8_LANE_STATE();
    const size_t kstep = (size_t)(BK * 2);
    const size_t hstepA = (size_t)HALF * g.lda * 2, hstepB = (size_t)HALF * g.ldb * 2;
    const size_t tstepA = 2 * hstepA, tstepB = 2 * hstepB;
    const unsigned ldsw = (unsigned)wid * 1024u;
#define PG8_SA(b, h) (((b) * 2 + (h)) * HTB)
#define PG8_SB(b, h) ((4 + (b) * 2 + (h)) * HTB)
#define PG8_STAGE(bufoff, gbase, voff) do { _Pragma("unroll") for (int _i = 0; _i < 2; ++_i) \
        __builtin_amdgcn_global_load_lds((const unsigned*)((const char*)(gbase) + (voff)[_i]), (LAS unsigned*)(lds + (bufoff) + ldsw + _i * 8192), 16, 0, 0); } while (0)
#define PG8_LDA(dst, b, h) do { _Pragma("unroll") for (int m = 0; m < 4; ++m) _Pragma("unroll") for (int k = 0; k < 2; ++k) dst[m][k] = *(const LAS bf16x8*)(lds + PG8_SA(b, h) + aoff + m * 2048 + k * 1024); } while (0)
#define PG8_LDB(dst, b, h) do { _Pragma("unroll") for (int n = 0; n < 2; ++n) _Pragma("unroll") for (int k = 0; k < 2; ++k) dst[n][k] = *(const LAS bf16x8*)(lds + PG8_SB(b, h) + boff + n * 2048 + k * 1024); } while (0)
#define PG8_MMA(ai, bj, At, Bt) do { __builtin_amdgcn_s_setprio(1); _Pragma("unroll") for (int m = 0; m < 4; ++m) _Pragma("unroll") for (int n = 0; n < 2; ++n) _Pragma("unroll") for (int k = 0; k < 2; ++k) \
        acc[ai][bj][m][n] = __builtin_amdgcn_mfma_f32_16x16x32_bf16(Bt[n][k], At[m][k], acc[ai][bj][m][n], 0, 0, 0); __builtin_amdgcn_s_setprio(0); } while (0)
#define PG8_WAIT_V(n) asm volatile("s_waitcnt vmcnt(" #n ")" ::: "memory")
#define PG8_WAIT_L(n) asm volatile("s_waitcnt lgkmcnt(" #n ")" ::: "memory")
#define PG8_BAR __builtin_amdgcn_s_barrier()
#define PG8_SCHED __builtin_amdgcn_sched_barrier(0)
#define PG8_ABASE(u) ((const char*)g.A + (size_t)(u).pm * tstepA + (g.grp_tiles ? (size_t)((u).pn / g.grp_tiles) * (size_t)K * 2 : (size_t)0))
#define PG8_BBASE(u) ((const char*)g.Bt + (size_t)(u).pn * tstepB + (g.grp_b ? (size_t)((u).pm / g.grp_b) * (size_t)K * 2 : (size_t)0))
    Unit cur, nxt; int ui = 0;
    E.prologue(S, lds, tid);
    if (!S.next(0, cur)) return;
    f32x4 acc[2][2][4][2];
    E.init_acc(acc, cur, wr, wc, fr, fq);
    bf16x8 At[4][2], B0[2][2], B1[2][2];
    const char* cA = PG8_ABASE(cur); const char* cB = PG8_BBASE(cur);
    if constexpr (SP2) {
        PG8_STAGE(PG8_SB(0, 0), cB, voffB); PG8_STAGE(PG8_SB(0, 1), cB + hstepB, voffB); PG8_STAGE(PG8_SA(0, 0), cA, voffA); PG8_STAGE(PG8_SA(0, 1), cA + hstepA, voffA);
        if (wr == 1) PG8_BAR;
        PG8_WAIT_V(2); PG8_BAR;
        PG8_STAGE(PG8_SB(1, 0), cB + kstep, voffB); PG8_STAGE(PG8_SA(1, 0), cA + kstep, voffA); PG8_STAGE(PG8_SB(1, 1), cB + hstepB + kstep, voffB);
        PG8_WAIT_V(6); PG8_BAR;
    } else {
        PG8_STAGE(PG8_SB(0, 0), cB, voffB); PG8_STAGE(PG8_SA(0, 0), cA, voffA); PG8_STAGE(PG8_SB(0, 1), cB + hstepB, voffB); PG8_STAGE(PG8_SA(0, 1), cA + hstepA, voffA);
        if (wr == 1) PG8_BAR;
        PG8_WAIT_V(4); PG8_BAR;
        PG8_STAGE(PG8_SB(1, 0), cB + kstep, voffB); PG8_STAGE(PG8_SA(1, 0), cA + kstep, voffA); PG8_STAGE(PG8_SB(1, 1), cB + hstepB + kstep, voffB);
        PG8_WAIT_V(6); PG8_BAR;
    }
    for (;;) {
        const bool has_next = S.next(ui + 1, nxt);
        const char* nA = has_next ? PG8_ABASE(nxt) : cA; const char* nB = has_next ? PG8_BBASE(nxt) : cB;
        for (int t = 0; t < nt; t += 2) {
            const bool last = (t == nt - 2);
            const char* a1 = cA + (size_t)(t + 1) * kstep;
            const char* a2 = last ? nA : cA + (size_t)(t + 2) * kstep; const char* b2 = last ? nB : cB + (size_t)(t + 2) * kstep;
            const char* a3 = a2 + kstep; const char* b3 = b2 + kstep;
            if constexpr (SP2) {
            PG8_LDB(B0, 0, 0); PG8_LDB(B1, 0, 1); PG8_SCHED; PG8_LDA(At, 0, 0); PG8_STAGE(PG8_SA(1, 1), a1 + hstepA, voffA);
            PG8_WAIT_V(8); PG8_WAIT_L(0); PG8_BAR; PG8_MMA(0, 0, At, B0); PG8_MMA(0, 1, At, B1); PG8_BAR; PG8_SCHED;
            PG8_LDA(At, 0, 1); PG8_STAGE(PG8_SB(0, 0), b2, voffB); PG8_STAGE(PG8_SB(0, 1), b2 + hstepB, voffB); PG8_STAGE(PG8_SA(0, 0), a2, voffA);
            PG8_WAIT_V(8); PG8_WAIT_L(0); PG8_BAR; PG8_MMA(1, 0, At, B0); PG8_MMA(1, 1, At, B1); PG8_BAR; PG8_SCHED;
            PG8_LDB(B0, 1, 0); PG8_LDB(B1, 1, 1); PG8_SCHED; PG8_LDA(At, 1, 0); PG8_STAGE(PG8_SA(0, 1), a2 + hstepA, voffA);
            PG8_WAIT_V(8); PG8_WAIT_L(0); PG8_BAR; PG8_MMA(0, 0, At, B0); PG8_MMA(0, 1, At, B1); PG8_BAR; PG8_SCHED;
            PG8_LDA(At, 1, 1); PG8_STAGE(PG8_SB(1, 0), b3, voffB); PG8_STAGE(PG8_SB(1, 1), b3 + hstepB, voffB); PG8_STAGE(PG8_SA(1, 0), a3, voffA);
            PG8_WAIT_V(8); PG8_WAIT_L(0); PG8_BAR; PG8_MMA(1, 0, At, B0); PG8_MMA(1, 1, At, B1); PG8_BAR; PG8_SCHED;
            } else {
            PG8_LDB(B0, 0, 0); PG8_SCHED; PG8_LDA(At, 0, 0); PG8_STAGE(PG8_SA(1, 1), a1 + hstepA, voffA);
            PG8_WAIT_L(8); PG8_BAR; PG8_WAIT_L(0); PG8_MMA(0, 0, At, B0); PG8_BAR; PG8_SCHED;
            PG8_LDB(B1, 0, 1); PG8_STAGE(PG8_SB(0, 0), b2, voffB);
            PG8_BAR; PG8_WAIT_L(0); PG8_MMA(0, 1, At, B1); PG8_BAR;
            PG8_LDA(At, 0, 1); PG8_STAGE(PG8_SA(0, 0), a2, voffA);
            PG8_BAR; PG8_WAIT_L(0); PG8_MMA(1, 0, At, B0); PG8_BAR; PG8_SCHED;
            PG8_STAGE(PG8_SB(0, 1), b2 + hstepB, voffB);
            PG8_WAIT_V(6); PG8_BAR; PG8_MMA(1, 1, At, B1); PG8_BAR;
            PG8_LDB(B0, 1, 0); PG8_SCHED; PG8_LDA(At, 1, 0); PG8_STAGE(PG8_SA(0, 1), a2 + hstepA, voffA);
            PG8_WAIT_L(8); PG8_BAR; PG8_WAIT_L(0); PG8_MMA(0, 0, At, B0); PG8_BAR; PG8_SCHED;
            PG8_LDB(B1, 1, 1); PG8_STAGE(PG8_SB(1, 0), b3, voffB);
            PG8_BAR; PG8_WAIT_L(0); PG8_MMA(0, 1, At, B1); PG8_BAR;
            PG8_LDA(At, 1, 1); PG8_STAGE(PG8_SA(1, 0), a3, voffA);
            PG8_BAR; PG8_WAIT_L(0); PG8_MMA(1, 0, At, B0); PG8_BAR; PG8_SCHED;
            PG8_STAGE(PG8_SB(1, 1), b3 + hstepB, voffB);
            PG8_WAIT_V(6); PG8_BAR; PG8_MMA(1, 1, At, B1); PG8_BAR;
            }
        }
        if constexpr (ALIGN_EPI) { if (wr == 0) PG8_BAR; }
        if constexpr (!Epi::AFTER_DRAIN) E(acc, cur, wr, wc, fr, fq, lds, ui);
        if (!has_next) break;
        cur = nxt; cA = nA; cB = nB; ++ui;
        asm volatile("" : "+v"(lane)); tid = wid * 64 + lane; fr = lane & 15; fq = lane >> 4; PG8_LANE_STATE();
        E.init_acc(acc, cur, wr, wc, fr, fq);
        if constexpr (ALIGN_EPI) { if (wr == 1) PG8_BAR; }
    }
    PG8_WAIT_V(0);
    if constexpr (!ALIGN_EPI) { if (wr == 0) PG8_BAR; }
    PG8_BAR;
    if constexpr (Epi::AFTER_DRAIN) E.fused(acc, cur, wr, wc, fr, fq, lds, tid);
#undef PG8_SA
#undef PG8_SB
#undef PG8_STAGE
#undef PG8_LDA
#undef PG8_LDB
#undef PG8_MMA
#undef PG8_WAIT_V
#undef PG8_WAIT_L
#undef PG8_BAR
#undef PG8_SCHED
#undef PG8_ABASE
#undef PG8_LANE_STATE
#undef PG8_BBASE
}

constexpr unsigned TAB_OFF = 131072u;
__device__ __forceinline__ void row_scan_mul4(float& a, float& b, float& c, float& d) {
#define PG8_SCAN_STEP(n) "v_mul_f32_dpp %0, %0, %0 row_shr:" #n " row_mask:0xf bank_mask:0xf\n" "v_mul_f32_dpp %1, %1, %1 row_shr:" #n " row_mask:0xf bank_mask:0xf\n" \
                         "v_mul_f32_dpp %2, %2, %2 row_shr:" #n " row_mask:0xf bank_mask:0xf\n" "v_mul_f32_dpp %3, %3, %3 row_shr:" #n " row_mask:0xf bank_mask:0xf\n"
    asm("s_nop 1\n" PG8_SCAN_STEP(1) PG8_SCAN_STEP(2) PG8_SCAN_STEP(4) PG8_SCAN_STEP(8) : "+v"(a), "+v"(b), "+v"(c), "+v"(d));
#undef PG8_SCAN_STEP
}
__device__ __forceinline__ void row_scan_add4(float& a, float& b, float& c, float& d) {
#define PG8_SCAN_STEP(n) "v_add_f32_dpp %0, %0, %0 row_shr:" #n " row_mask:0xf bank_mask:0xf\n" "v_add_f32_dpp %1, %1, %1 row_shr:" #n " row_mask:0xf bank_mask:0xf\n" \
                         "v_add_f32_dpp %2, %2, %2 row_shr:" #n " row_mask:0xf bank_mask:0xf\n" "v_add_f32_dpp %3, %3, %3 row_shr:" #n " row_mask:0xf bank_mask:0xf\n"
    asm("s_nop 1\n" PG8_SCAN_STEP(1) PG8_SCAN_STEP(2) PG8_SCAN_STEP(4) PG8_SCAN_STEP(8) : "+v"(a), "+v"(b), "+v"(c), "+v"(d));
#undef PG8_SCAN_STEP
}
__device__ __forceinline__ float row_bcast15(float v) { float r; asm("s_nop 1\n v_mov_b32_dpp %0, %1 row_newbcast:15 row_mask:0xf bank_mask:0xf" : "=v"(r) : "v"(v)); return r; }
template <int W> __device__ __forceinline__ float window_sum(float p, float pp, float c) {
    if constexpr (W == 16) return c - pp;
    else { float w = c;
        if constexpr (W == 8) asm("s_nop 1\n v_subrev_f32_dpp %0, %1, %2 row_shl:8 row_mask:0xf bank_mask:0xf\n v_subrev_f32_dpp %0, %3, %3 row_shr:8 row_mask:0xf bank_mask:0xf" : "+v"(w) : "v"(pp), "v"(c), "v"(p));
        else if constexpr (W == 4) asm("s_nop 1\n v_subrev_f32_dpp %0, %1, %2 row_shl:12 row_mask:0xf bank_mask:0xf\n v_subrev_f32_dpp %0, %3, %3 row_shr:4 row_mask:0xf bank_mask:0xf" : "+v"(w) : "v"(pp), "v"(c), "v"(p));
        else asm("s_nop 1\n v_subrev_f32_dpp %0, %1, %2 row_shl:14 row_mask:0xf bank_mask:0xf\n v_subrev_f32_dpp %0, %3, %3 row_shr:2 row_mask:0xf bank_mask:0xf" : "+v"(w) : "v"(pp), "v"(c), "v"(p));
        return w; }
}
#define PG8_POOL_STEP(SHL, SHR) \
    asm("s_nop 1\n" \
        "v_add_f32_dpp %0, %8, %4 row_shl:" #SHL " row_mask:0xf bank_mask:0xf bound_ctrl:1\n" "v_add_f32_dpp %1, %9, %5 row_shl:" #SHL " row_mask:0xf bank_mask:0xf bound_ctrl:1\n" \
        "v_add_f32_dpp %2, %10, %6 row_shl:" #SHL " row_mask:0xf bank_mask:0xf bound_ctrl:1\n" "v_add_f32_dpp %3, %11, %7 row_shl:" #SHL " row_mask:0xf bank_mask:0xf bound_ctrl:1\n" \
        "v_add_f32_dpp %0, %4, %0 row_shr:" #SHR " row_mask:0xf bank_mask:0xf\n" "v_add_f32_dpp %1, %5, %1 row_shr:" #SHR " row_mask:0xf bank_mask:0xf\n" \
        "v_add_f32_dpp %2, %6, %2 row_shr:" #SHR " row_mask:0xf bank_mask:0xf\n" "v_add_f32_dpp %3, %7, %3 row_shr:" #SHR " row_mask:0xf bank_mask:0xf" \
        : "=&v"(a[0]), "=&v"(a[1]), "=&v"(a[2]), "=&v"(a[3]) : "v"(b[0]), "v"(b[1]), "v"(b[2]), "v"(b[3]), "v"(bp[0]), "v"(bp[1]), "v"(bp[2]), "v"(bp[3]))
template <int K> __device__ __forceinline__ void pool_step4(float (&a)[4], const float (&b)[4], const float (&bp)[4]) {
    if constexpr (K == 1) PG8_POOL_STEP(15, 1); else if constexpr (K == 2) PG8_POOL_STEP(14, 2); else PG8_POOL_STEP(12, 4);
}
#undef PG8_POOL_STEP
#define PG8_HALO_STEP(SHR) \
    asm("s_nop 1\n" "v_add_f32_dpp %0, %4, %4 row_shr:" #SHR " row_mask:0xf bank_mask:0xf bound_ctrl:1\n" "v_add_f32_dpp %1, %5, %5 row_shr:" #SHR " row_mask:0xf bank_mask:0xf bound_ctrl:1\n" \
        "v_add_f32_dpp %2, %6, %6 row_shr:" #SHR " row_mask:0xf bank_mask:0xf bound_ctrl:1\n" "v_add_f32_dpp %3, %7, %7 row_shr:" #SHR " row_mask:0xf bank_mask:0xf bound_ctrl:1" \
        : "=&v"(a[0]), "=&v"(a[1]), "=&v"(a[2]), "=&v"(a[3]) : "v"(b[0]), "v"(b[1]), "v"(b[2]), "v"(b[3]))
template <int K> __device__ __forceinline__ void halo_step4(float (&a)[4], const float (&b)[4]) { if constexpr (K == 1) PG8_HALO_STEP(1); else PG8_HALO_STEP(2); }
#undef PG8_HALO_STEP
struct EpiFold {
    static constexpr bool PERM = true, AFTER_DRAIN = false;
    __device__ __forceinline__ void init_acc(f32x4 (&acc)[2][2][4][2], const Unit&, int, int, int, int) const { zero_acc(acc); }
    __device__ __forceinline__ void prologue(const StaticOrder&, LAS unsigned char*, int) const {}
    bf16_t* WT;
    __device__ __forceinline__ void operator()(f32x4 (&acc)[2][2][4][2], const Unit& u, int wr, int wc, int fr, int fq, LAS unsigned char* lds, int ui) const {
        const unsigned k0 = (unsigned)(u.pn * BM + wc * 32 + 8 * fq);
#pragma unroll
        for (int ai = 0; ai < 2; ++ai)
#pragma unroll
            for (int m = 0; m < 4; ++m) { const unsigned c = (unsigned)(u.pm * BM + ai * HALF + wr * 64 + m * 16 + fr), drow = (c >> 7) * 256u + (c & 127u);
#pragma unroll
                for (int bj = 0; bj < 2; ++bj) { const f32x4 v0 = acc[ai][bj][m][0], v1 = acc[ai][bj][m][1];
                    u32x4 w; w.x = pkbf(v0[0], v0[1]); w.y = pkbf(v0[2], v0[3]); w.z = pkbf(v1[0], v1[1]); w.w = pkbf(v1[2], v1[3]);
                    *(u32x4*)(WT + (size_t)drow * DM + k0 + bj * HALF) = w; } }
    }
};
constexpr unsigned HALO_TILE = 4 * 64 * 16;
struct EpiP1 {
    static constexpr bool PERM = true, AFTER_DRAIN = false;
    __device__ __forceinline__ void init_acc(f32x4 (&acc)[2][2][4][2], const Unit&, int, int, int, int) const { zero_acc(acc); }
    __device__ __forceinline__ void prologue(const StaticOrder&, LAS unsigned char*, int) const {}
    bf16_t* Z; unsigned char* HALO; unsigned char* SG0;
    template <int W> __device__ __forceinline__ void tile(f32x4 (&acc)[2][2][4][2], const Unit& u, int wr, int wc, int fr, int fq, LAS unsigned char* lds) const {
        const unsigned lane = (unsigned)(fq * 16 + fr);
        LAS unsigned char* HX = lds + TAB_OFF;
        const unsigned sideofs = (unsigned)(u.pm * 16 + u.pn) * HALO_TILE + ((unsigned)wc * 64u + lane) * 16u;
#pragma unroll
        for (int ai = 0; ai < 2; ++ai) {
            u32x4 h; h.x = pkbf(acc[ai][0][3][0][0], acc[ai][0][3][0][1]); h.y = pkbf(acc[ai][0][3][0][2], acc[ai][0][3][0][3]); h.z = pkbf(acc[ai][0][3][1][0], acc[ai][0][3][1][1]); h.w = pkbf(acc[ai][0][3][1][2], acc[ai][0][3][1][3]);
            const int sl = 2 * ai + wr;
            if (sl < 3) *(LAS u32x4*)(HX + ((unsigned)(sl * 4 + wc) * 64u + lane) * 16u) = h;
            else *(u32x4*)(HALO + sideofs) = h;
        }
        asm volatile("s_waitcnt lgkmcnt(0)" ::: "memory"); __builtin_amdgcn_s_barrier(); asm volatile("" ::: "memory");
        const bool seq0 = (u.pm & 15) == 0;
        const float invw = 1.0f / (float)W;
        const float inv00 = seq0 ? 1.0f / (float)((fr + 1) < W ? (fr + 1) : W) : invw;
        const unsigned zofs = ((unsigned)(u.pm * BM + wr * 64 + fr) * DI + (unsigned)(u.pn * HD + wc * 32 + 8 * fq)) * 2u;
#pragma unroll
        for (int ai = 0; ai < 2; ++ai) {
            const int sl = 2 * ai + wr;
            float pp[2][4], pt[2][4];
            if (sl > 0) {
                const u32x4 h = *(const LAS u32x4*)(HX + ((unsigned)((sl - 1) * 4 + wc) * 64u + lane) * 16u);
                pp[0][0] = bf_lo(h.x); pp[0][1] = bf_hi(h.x); pp[0][2] = bf_lo(h.y); pp[0][3] = bf_hi(h.y); pp[1][0] = bf_lo(h.z); pp[1][1] = bf_hi(h.z); pp[1][2] = bf_lo(h.w); pp[1][3] = bf_hi(h.w);
#pragma unroll
                for (int n = 0; n < 2; ++n) { row_scan_add4(pp[n][0], pp[n][1], pp[n][2], pp[n][3]);
#pragma unroll
                    for (int j = 0; j < 4; ++j) pt[n][j] = row_bcast15(pp[n][j]); }
            } else {
#pragma unroll
                for (int n = 0; n < 2; ++n)
#pragma unroll
                    for (int j = 0; j < 4; ++j) { pp[n][j] = 0.f; pt[n][j] = 0.f; }
            }
#pragma unroll
            for (int m = 0; m < 4; ++m) {
                const float inv = (sl == 0 && m == 0) ? inv00 : invw;
                float z[2][4], sgv[2][4];
#pragma unroll
                for (int n = 0; n < 2; ++n) {
                    float p[4];
#pragma unroll
                    for (int j = 0; j < 4; ++j) p[j] = acc[ai][0][m][n][j];
                    row_scan_add4(p[0], p[1], p[2], p[3]);
#pragma unroll
                    for (int j = 0; j < 4; ++j) {
                        const float ws = window_sum<W>(p[j], pp[n][j], p[j] + pt[n][j]);
                        sgv[n][j] = silu_pre(acc[ai][1][m][n][j]);
                        z[n][j] = __builtin_fmaf(ws, inv, -acc[ai][0][m][n][j]) * sgv[n][j];
                        pp[n][j] = p[j]; pt[n][j] = row_bcast15(p[j]); }
                }
                u32x4 w; w.x = pkbf(z[0][0], z[0][1]); w.y = pkbf(z[0][2], z[0][3]); w.z = pkbf(z[1][0], z[1][1]); w.w = pkbf(z[1][2], z[1][3]);
                *(u32x4*)((char*)Z + (zofs + (unsigned)((ai * HALF + m * 16) * DI) * 2u)) = w;
                if (sl == 0 && m == 0) { u32x4 g; g.x = pkbf(sgv[0][0], sgv[0][1]); g.y = pkbf(sgv[0][2], sgv[0][3]); g.z = pkbf(sgv[1][0], sgv[1][1]); g.w = pkbf(sgv[1][2], sgv[1][3]);
                    *(u32x4*)(SG0 + sideofs) = g; }
                asm volatile("" ::: "memory");
            }
        }
    }
    template <int W> __device__ __forceinline__ void tile_dbl(f32x4 (&acc)[2][2][4][2], const Unit& u, int wr, int wc, int fr, int fq, LAS unsigned char* lds) const {
        constexpr int NL = (W == 2) ? 1 : (W == 4) ? 2 : 3;
        const unsigned lane = (unsigned)(fq * 16 + fr);
        LAS unsigned char* HX = lds + TAB_OFF;
        const unsigned sideofs = (unsigned)(u.pm * 16 + u.pn) * HALO_TILE + ((unsigned)wc * 64u + lane) * 16u;
#pragma unroll
        for (int ai = 0; ai < 2; ++ai) {
            u32x4 h; h.x = pkbf(acc[ai][0][3][0][0], acc[ai][0][3][0][1]); h.y = pkbf(acc[ai][0][3][0][2], acc[ai][0][3][0][3]); h.z = pkbf(acc[ai][0][3][1][0], acc[ai][0][3][1][1]); h.w = pkbf(acc[ai][0][3][1][2], acc[ai][0][3][1][3]);
            const int sl = 2 * ai + wr;
            if (sl < 3) *(LAS u32x4*)(HX + ((unsigned)(sl * 4 + wc) * 64u + lane) * 16u) = h;
            else *(u32x4*)(HALO + sideofs) = h;
        }
        asm volatile("s_waitcnt lgkmcnt(0)" ::: "memory"); __builtin_amdgcn_s_barrier(); asm volatile("" ::: "memory");
        const bool seq0 = (u.pm & 15) == 0;
        const float invw = 1.0f / (float)W;
        const float inv00 = seq0 ? 1.0f / (float)((fr + 1) < W ? (fr + 1) : W) : invw;
        const unsigned zofs = ((unsigned)(u.pm * BM + wr * 64 + fr) * DI + (unsigned)(u.pn * HD + wc * 32 + 8 * fq)) * 2u;
#pragma unroll
        for (int ai = 0; ai < 2; ++ai) {
            const int sl = 2 * ai + wr;
            float prev[NL][2][4];
            if (sl > 0) {
                const u32x4 h = *(const LAS u32x4*)(HX + ((unsigned)((sl - 1) * 4 + wc) * 64u + lane) * 16u);
                prev[0][0][0] = bf_lo(h.x); prev[0][0][1] = bf_hi(h.x); prev[0][0][2] = bf_lo(h.y); prev[0][0][3] = bf_hi(h.y);
                prev[0][1][0] = bf_lo(h.z); prev[0][1][1] = bf_hi(h.z); prev[0][1][2] = bf_lo(h.w); prev[0][1][3] = bf_hi(h.w);
#pragma unroll
                for (int n = 0; n < 2; ++n) { if constexpr (NL >= 2) halo_step4<1>(prev[1][n], prev[0][n]); if constexpr (NL >= 3) halo_step4<2>(prev[2][n], prev[1][n]); }
            } else {
#pragma unroll
                for (int l = 0; l < NL; ++l)
#pragma unroll
                    for (int n = 0; n < 2; ++n)
#pragma unroll
                        for (int j = 0; j < 4; ++j) prev[l][n][j] = 0.f;
            }
#pragma unroll
            for (int m = 0; m < 4; ++m) {
                const float inv = (sl == 0 && m == 0) ? inv00 : invw;
                float z[2][4], sgv[2][4];
#pragma unroll
                for (int n = 0; n < 2; ++n) {
                    float l0[4], l1[4], l2[4], l3[4];
#pragma unroll
                    for (int j = 0; j < 4; ++j) l0[j] = acc[ai][0][m][n][j];
                    pool_step4<1>(l1, l0, prev[0][n]);
                    if constexpr (NL >= 2) pool_step4<2>(l2, l1, prev[1][n]);
                    if constexpr (NL >= 3) pool_step4<4>(l3, l2, prev[2][n]);
#pragma unroll
                    for (int j = 0; j < 4; ++j) {
                        const float ws = (NL == 1) ? l1[j] : (NL == 2) ? l2[j] : l3[j];
                        sgv[n][j] = silu_pre(acc[ai][1][m][n][j]);
                        z[n][j] = __builtin_fmaf(ws, inv, -l0[j]) * sgv[n][j];
                        prev[0][n][j] = l0[j]; if constexpr (NL >= 2) prev[1][n][j] = l1[j]; if constexpr (NL >= 3) prev[2][n][j] = l2[j]; }
                }
                u32x4 w; w.x = pkbf(z[0][0], z[0][1]); w.y = pkbf(z[0][2], z[0][3]); w.z = pkbf(z[1][0], z[1][1]); w.w = pkbf(z[1][2], z[1][3]);
                *(u32x4*)((char*)Z + (zofs + (unsigned)((ai * HALF + m * 16) * DI) * 2u)) = w;
                if (sl == 0 && m == 0) { u32x4 g; g.x = pkbf(sgv[0][0], sgv[0][1]); g.y = pkbf(sgv[0][2], sgv[0][3]); g.z = pkbf(sgv[1][0], sgv[1][1]); g.w = pkbf(sgv[1][2], sgv[1][3]);
                    *(u32x4*)(SG0 + sideofs) = g; }
                asm volatile("" ::: "memory");
            }
        }
    }
    __device__ __forceinline__ void operator()(f32x4 (&acc)[2][2][4][2], const Unit& u, int wr, int wc, int fr, int fq, LAS unsigned char* lds, int ui) const {
        const int g = u.pn >> 2;
        if (g == 0) tile_dbl<2>(acc, u, wr, wc, fr, fq, lds); else if (g == 1) tile_dbl<4>(acc, u, wr, wc, fr, fq, lds);
        else if (g == 2) tile_dbl<8>(acc, u, wr, wc, fr, fq, lds); else tile<16>(acc, u, wr, wc, fr, fq, lds);
    }
};
template <bool WRITE_HB, bool WRITE_H = true> struct EpiRes {
    static constexpr bool PERM = true, AFTER_DRAIN = false;
    __device__ __forceinline__ void prologue(const StaticOrder&, LAS unsigned char*, int) const {}
    const bf16_t* RB; const float* invr; float* H; bf16_t* HB; float* part;
    __device__ __forceinline__ void init_acc(f32x4 (&acc)[2][2][4][2], const Unit& u, int wr, int wc, int fr, int fq) const {
        const unsigned row0 = (unsigned)(u.pm * BM + wr * 64 + fr), col0 = (unsigned)(u.pn * BM + wc * 32 + 8 * fq);
        const unsigned ofs = (row0 * DM + col0) * 2u;
#pragma unroll
        for (int ai = 0; ai < 2; ++ai)
#pragma unroll
            for (int m = 0; m < 4; ++m) { const float ir = invr[row0 + (unsigned)(ai * HALF + m * 16)];
#pragma unroll
                for (int bj = 0; bj < 2; ++bj) { const u32x4 r = __builtin_nontemporal_load((const u32x4*)((const char*)RB + (ofs + (unsigned)((ai * HALF + m * 16) * DM + bj * HALF) * 2u)));
                    acc[ai][bj][m][0] = (f32x4){bf_lo(r.x) * ir, bf_hi(r.x) * ir, bf_lo(r.y) * ir, bf_hi(r.y) * ir};
                    acc[ai][bj][m][1] = (f32x4){bf_lo(r.z) * ir, bf_hi(r.z) * ir, bf_lo(r.w) * ir, bf_hi(r.w) * ir}; } }
    }
    __device__ __forceinline__ void operator()(f32x4 (&acc)[2][2][4][2], const Unit& u, int wr, int wc, int fr, int fq, LAS unsigned char* lds, int ui) const {
        const unsigned row0 = (unsigned)(u.pm * BM + wr * 64 + fr), col0 = (unsigned)(u.pn * BM + wc * 32 + 8 * fq);
        const unsigned ofs = (row0 * DM + col0) * 4u, pofs = (row0 * 16u + (unsigned)(u.pn * 4 + wc)) * 4u;
#pragma unroll
        for (int ai = 0; ai < 2; ++ai)
#pragma unroll
            for (int m = 0; m < 4; ++m) { const unsigned o = ofs + (unsigned)((ai * HALF + m * 16) * DM) * 4u; float ss = 0.f;
#pragma unroll
                for (int bj = 0; bj < 2; ++bj) { const unsigned oo = o + (unsigned)(bj * HALF) * 4u; const f32x4 h0 = acc[ai][bj][m][0], h1 = acc[ai][bj][m][1];
                    if (WRITE_H) { *(f32x4*)((char*)H + oo) = h0; *(f32x4*)((char*)H + oo + 16u) = h1; }
                    ss += ((h0[0] * h0[0] + h0[1] * h0[1]) + (h0[2] * h0[2] + h0[3] * h0[3])) + ((h1[0] * h1[0] + h1[1] * h1[1]) + (h1[2] * h1[2] + h1[3] * h1[3]));
                    if (WRITE_HB) { u32x4 w; w.x = pkbf(h0[0], h0[1]); w.y = pkbf(h0[2], h0[3]); w.z = pkbf(h1[0], h1[1]); w.w = pkbf(h1[2], h1[3]); *(u32x4*)((char*)HB + (oo >> 1)) = w; } }
                ss += xor_get(ss, fq * 16 + fr, 16); ss += xor_get(ss, fq * 16 + fr, 32);
                if (fq == 0) *(float*)((char*)part + (pofs + (unsigned)(ai * HALF + m * 16) * 64u)) = ss; }
    }
};
__device__ __forceinline__ float row_rstd_b(const float* part, unsigned bofs) {
    const f32x4* p = (const f32x4*)((const char*)part + bofs); const f32x4 a = p[0], b = p[1], c = p[2], d = p[3];
    return __builtin_amdgcn_rsqf((((a[0] + a[1]) + (a[2] + a[3])) + ((b[0] + b[1]) + (b[2] + b[3])) + ((c[0] + c[1]) + (c[2] + c[3])) + ((d[0] + d[1]) + (d[2] + d[3]))) * (1.0f / DM) + EPS);
}
struct EpiP4 {
    static constexpr bool PERM = true, AFTER_DRAIN = false;
    __device__ __forceinline__ void init_acc(f32x4 (&acc)[2][2][4][2], const Unit&, int, int, int, int) const { zero_acc(acc); }
    bf16_t* Qt; bf16_t* Kt; bf16_t* V; float* DEC; const float* part; const float* lbnd;
    __device__ __forceinline__ void prologue(const StaticOrder& S, LAS unsigned char* lds, int tid) const {
        LAS float* T = (LAS float*)(lds + TAB_OFF); Unit u;
        for (int i = 0; i < 12 && S.next(i, u); ++i) {
            if (tid < 256) T[i * 256 + tid] = row_rstd_b(part, (unsigned)(u.pm * BM + tid) * 64u);
            else if (u.pn < 16) {
                const int c = tid - 256, ch = u.pn * HD + (c & 127);
                const float ex = __expf(lbnd[ch] - lbnd[DI + ch]), lb = __builtin_amdgcn_rcpf(1.0f + ex);
                T[3072 + i * 256 + c] = (c < 128) ? lb : ex * lb; }
        }
        __syncthreads();
    }
    __device__ __forceinline__ void operator()(f32x4 (&acc)[2][2][4][2], const Unit& u, int wr, int wc, int fr, int fq, LAS unsigned char* lds, int ui) const {
        const unsigned row0 = (unsigned)(u.pm * BM + wr * 64 + fr);
        const LAS float* T = (const LAS float*)(lds + TAB_OFF) + ui * 256 + wr * 64 + fr;
        if (u.pn >= 16) {
            const unsigned vofs = (row0 * DI + (unsigned)((u.pn - 16) * BM + wc * 32 + 8 * fq)) * 2u;
#pragma unroll
            for (int ai = 0; ai < 2; ++ai)
#pragma unroll
                for (int m = 0; m < 4; ++m) { const float rs = T[ai * HALF + m * 16];
#pragma unroll
                    for (int bj = 0; bj < 2; ++bj) { const f32x4 v0 = acc[ai][bj][m][0] * rs, v1 = acc[ai][bj][m][1] * rs;
                        u32x4 w; w.x = pkbf(v0[0], v0[1]); w.y = pkbf(v0[2], v0[3]); w.z = pkbf(v1[0], v1[1]); w.w = pkbf(v1[2], v1[3]);
                        __builtin_nontemporal_store(w, (u32x4*)((char*)V + (vofs + (unsigned)((ai * HALF + m * 16) * DI + bj * HALF) * 2u))); } }
            return;
        }
        const unsigned c0 = (unsigned)(u.pn * HD + wc * 32 + 8 * fq);
        const unsigned qofs = (row0 * DI + c0) * 2u;
        const LAS float* LB = (const LAS float*)(lds + TAB_OFF) + 3072 + ui * 256 + wc * 32 + 8 * fq;
#pragma unroll
        for (int ai = 0; ai < 2; ++ai) {
            float rs[4], rz[4];
#pragma unroll
            for (int m = 0; m < 4; ++m) { rs[m] = T[ai * HALF + m * 16]; rz[m] = -1.44269504089f * rs[m]; }
            float bp[2][4]; f32x4 decv[2];
#pragma unroll
            for (int m = 0; m < 4; ++m) {
#pragma unroll
                for (int n = 0; n < 2; ++n) {
                    const f32x4 lbv = *(const LAS f32x4*)(LB + 4 * n), omv = *(const LAS f32x4*)(LB + 128 + 4 * n);
                    float s[4], k[4];
#pragma unroll
                    for (int j = 0; j < 4; ++j) {
                        const float sg = __builtin_amdgcn_rcpf(1.0f + __builtin_amdgcn_exp2f(acc[ai][1][m][n][j] * rz[m]));
                        s[j] = __builtin_fmaf(omv[j], sg, lbv[j]); k[j] = __builtin_fmaf(-omv[j], sg, omv[j]); }
                    row_scan_mul4(s[0], s[1], s[2], s[3]);
#pragma unroll
                    for (int j = 0; j < 4; ++j) {
                        const float E = (m == 0) ? s[j] : s[j] * bp[n][j];
                        if (m < 3) { const float tot = lane_get(s[j], fq * 16 + 15); bp[n][j] = (m == 0) ? tot : bp[n][j] * tot; }
                        const float Ei = __builtin_amdgcn_rcpf(fmaxf(E, 7.9e-31f));
                        acc[ai][0][m][n][j] = acc[ai][0][m][n][j] * (rs[m] * E); acc[ai][1][m][n][j] = k[j] * Ei;
                        if (m == 3) decv[n][j] = E; }
                }
                const unsigned ob = qofs + (unsigned)((ai * HALF + m * 16) * DI) * 2u;
                u32x4 w; w.x = pkbf(acc[ai][0][m][0][0], acc[ai][0][m][0][1]); w.y = pkbf(acc[ai][0][m][0][2], acc[ai][0][m][0][3]); w.z = pkbf(acc[ai][0][m][1][0], acc[ai][0][m][1][1]); w.w = pkbf(acc[ai][0][m][1][2], acc[ai][0][m][1][3]);
                __builtin_nontemporal_store(w, (u32x4*)((char*)Qt + ob));
                u32x4 x; x.x = pkbf(acc[ai][1][m][0][0], acc[ai][1][m][0][1]); x.y = pkbf(acc[ai][1][m][0][2], acc[ai][1][m][0][3]); x.z = pkbf(acc[ai][1][m][1][0], acc[ai][1][m][1][1]); x.w = pkbf(acc[ai][1][m][1][2], acc[ai][1][m][1][3]);
                __builtin_nontemporal_store(x, (u32x4*)((char*)Kt + ob));
                asm volatile("" ::: "memory");
            }
            if (fr == 15) { float* dp = (float*)((char*)DEC + ((unsigned)(u.pm * 4 + ai * 2 + wr) * DI + c0) * 4u); *(f32x4*)dp = decv[0]; *(f32x4*)(dp + 4) = decv[1]; }
            asm volatile("" ::: "memory");
        }
    }
};
struct EpiP5b {
    static constexpr bool PERM = true, AFTER_DRAIN = false;
    __device__ __forceinline__ void init_acc(f32x4 (&acc)[2][2][4][2], const Unit&, int, int, int, int) const { zero_acc(acc); }
    bf16_t* O; const float* part; const float* ss;
    __device__ __forceinline__ void prologue(const StaticOrder& S, LAS unsigned char* lds, int tid) const {
        LAS float* T = (LAS float*)(lds + TAB_OFF); Unit u;
        for (int i = 0; i < 4 && S.next(i, u); ++i) {
            if (tid < 256) T[i * 768 + tid] = row_rstd_b(part, (unsigned)(u.pm * BM + tid) * 64u);
            { const int r = tid >> 1, hh = tid & 1; const f32x4* sp = (const f32x4*)(ss + (size_t)(u.pm * BM + r) * 128 + (u.pn * 2 + hh) * 8); const f32x4 s0 = sp[0], s1 = sp[1];
              T[i * 768 + 256 + tid] = __builtin_amdgcn_rsqf((((s0[0] + s0[1]) + (s0[2] + s0[3])) + ((s1[0] + s1[1]) + (s1[2] + s1[3]))) * (1.0f / HD) + EPS); }
        }
        __syncthreads();
    }
    __device__ __forceinline__ void operator()(f32x4 (&acc)[2][2][4][2], const Unit& u, int wr, int wc, int fr, int fq, LAS unsigned char* lds, int ui) const {
        const unsigned row0 = (unsigned)(u.pm * BM + wr * 64 + fr), col0 = (unsigned)(u.pn * BM + wc * 32 + 8 * fq);
        const LAS float* T = (const LAS float*)(lds + TAB_OFF) + ui * 768 + wr * 64 + fr;
        const unsigned oofs = (row0 * DI + col0) * 2u;
#pragma unroll
        for (int ai = 0; ai < 2; ++ai) {
            u32x4 ov[4][2];
#pragma unroll
            for (int m = 0; m < 4; ++m)
#pragma unroll
                for (int bj = 0; bj < 2; ++bj) ov[m][bj] = *(const u32x4*)((const char*)O + (oofs + (unsigned)((ai * HALF + m * 16) * DI + bj * HALF) * 2u));
#pragma unroll
            for (int m = 0; m < 4; ++m) { const int rl = ai * HALF + m * 16; const float rs = T[rl];
#pragma unroll
                for (int bj = 0; bj < 2; ++bj) { const f32x4 v0 = acc[ai][bj][m][0] * rs, v1 = acc[ai][bj][m][1] * rs;
                    const float rh = T[256 + 2 * rl + bj + (wr * 64 + fr)];
                    const u32x4 s = ov[m][bj];
                    u32x4 w; w.x = pkbf(bf_lo(s.x) * rh * silu_pre(v0[0]), bf_hi(s.x) * rh * silu_pre(v0[1])); w.y = pkbf(bf_lo(s.y) * rh * silu_pre(v0[2]), bf_hi(s.y) * rh * silu_pre(v0[3]));
                    w.z = pkbf(bf_lo(s.z) * rh * silu_pre(v1[0]), bf_hi(s.z) * rh * silu_pre(v1[1])); w.w = pkbf(bf_lo(s.w) * rh * silu_pre(v1[2]), bf_hi(s.w) * rh * silu_pre(v1[3]));
                    *(u32x4*)((char*)O + (oofs + (unsigned)((ai * HALF + m * 16) * DI + bj * HALF) * 2u)) = w; } }
            asm volatile("" ::: "memory"); }
    }
};
struct EpiFinal {
    static constexpr bool PERM = true, AFTER_DRAIN = false;
    __device__ __forceinline__ void init_acc(f32x4 (&acc)[2][2][4][2], const Unit&, int, int, int, int) const { zero_acc(acc); }
    const bf16_t* HB; float* H; const float* fg; float* X; unsigned* cnt;
    __device__ __forceinline__ void prologue(const StaticOrder&, LAS unsigned char*, int) const {}
    __device__ __forceinline__ void operator()(f32x4 (&acc)[2][2][4][2], const Unit& u, int wr, int wc, int fr, int fq, LAS unsigned char* lds, int ui) const {
        LAS float* Pt = (LAS float*)(lds + TAB_OFF);
        LAS float* St = Pt + 1024;
        const int tid = (wr * 4 + wc) * 64 + fq * 16 + fr;
        const unsigned row0 = (unsigned)(u.pm * BM + wr * 64 + fr), col0 = (unsigned)(u.pn * BM + wc * 32 + 8 * fq);
        const unsigned ofs = (row0 * DM + col0) * 4u;
#pragma unroll
        for (int ai = 0; ai < 2; ++ai) {
            u32x4 hv[4][2];
#pragma unroll
            for (int m = 0; m < 4; ++m)
#pragma unroll
                for (int bj = 0; bj < 2; ++bj) hv[m][bj] = *(const u32x4*)((const char*)HB + ((ofs + (unsigned)((ai * HALF + m * 16) * DM + bj * HALF) * 4u) >> 1));
#pragma unroll
            for (int m = 0; m < 4; ++m) { float ss = 0.f;
#pragma unroll
                for (int bj = 0; bj < 2; ++bj) { const u32x4 hb = hv[m][bj];
                    const f32x4 h0 = acc[ai][bj][m][0] + (f32x4){bf_lo(hb.x), bf_hi(hb.x), bf_lo(hb.y), bf_hi(hb.y)}, h1 = acc[ai][bj][m][1] + (f32x4){bf_lo(hb.z), bf_hi(hb.z), bf_lo(hb.w), bf_hi(hb.w)};
                    acc[ai][bj][m][0] = h0; acc[ai][bj][m][1] = h1;
                    ss += ((h0[0] * h0[0] + h0[1] * h0[1]) + (h0[2] * h0[2] + h0[3] * h0[3])) + ((h1[0] * h1[0] + h1[1] * h1[1]) + (h1[2] * h1[2] + h1[3] * h1[3])); }
                ss += xor_get(ss, fq * 16 + fr, 16); ss += xor_get(ss, fq * 16 + fr, 32);
                if (fq == 0) Pt[(ai * HALF + wr * 64 + m * 16 + fr) * 4 + wc] = ss; }
            asm volatile("" ::: "memory"); }
        __syncthreads();
        float* xs = X + (size_t)u.pm * 1024;
        if (tid < 256) { const f32x4 p = *(const LAS f32x4*)(Pt + tid * 4);
            __hip_atomic_store(xs + u.pn * 256 + tid, (p[0] + p[1]) + (p[2] + p[3]), __ATOMIC_RELAXED, __HIP_MEMORY_SCOPE_AGENT); }
        asm volatile("s_waitcnt vmcnt(0)" ::: "memory");
        __syncthreads();
        if (tid == 0) {
            unsigned* c = cnt + 16 * u.pm;
            __hip_atomic_fetch_add(c, 1u, __ATOMIC_RELAXED, __HIP_MEMORY_SCOPE_AGENT);
            unsigned spins = 0;
            while (__hip_atomic_load(c, __ATOMIC_RELAXED, __HIP_MEMORY_SCOPE_AGENT) < 4u) { __builtin_amdgcn_s_sleep(2); if (++spins > (1u << 22)) break; }
            __builtin_amdgcn_fence(__ATOMIC_ACQUIRE, "agent");
            asm volatile("s_waitcnt vmcnt(0)" ::: "memory");
        }
        __syncthreads();
        if (tid < 256) { float s = 0.f;
#pragma unroll
            for (int t = 0; t < 4; ++t) s += __hip_atomic_load(xs + t * 256 + tid, __ATOMIC_RELAXED, __HIP_MEMORY_SCOPE_AGENT);
            St[tid] = __builtin_amdgcn_rsqf(s * (1.0f / DM) + EPS); }
        __syncthreads();
        f32x4 gv[2][2];
#pragma unroll
        for (int bj = 0; bj < 2; ++bj)
#pragma unroll
            for (int n = 0; n < 2; ++n) gv[bj][n] = *(const f32x4*)(fg + col0 + bj * HALF + n * 4);
#pragma unroll
        for (int ai = 0; ai < 2; ++ai)
#pragma unroll
            for (int m = 0; m < 4; ++m) { const float rs = St[ai * HALF + wr * 64 + m * 16 + fr];
#pragma unroll
                for (int bj = 0; bj < 2; ++bj) { const unsigned oo = ofs + (unsigned)((ai * HALF + m * 16) * DM + bj * HALF) * 4u;
                    *(f32x4*)((char*)H + oo) = acc[ai][bj][m][0] * rs * gv[bj][0]; *(f32x4*)((char*)H + oo + 16u) = acc[ai][bj][m][1] * rs * gv[bj][1]; } }
        __syncthreads();
    }
};
}

namespace scan {
#define MFMA16(a, b, c) __builtin_amdgcn_mfma_f32_16x16x32_bf16((a), (b), (c), 0, 0, 0)
__device__ __forceinline__ unsigned offb(unsigned row, unsigned ch) { return 256u * row + 16u * (ch ^ (((row & 3u) << 2) | ((row >> 2) & 3u))); }
__device__ __forceinline__ unsigned voffv(unsigned r, unsigned cp) { return 128u * r + 32u * (cp ^ (((r >> 1) & 3u) ^ (((r >> 3) & 1u) << 1))); }
__device__ __forceinline__ void tr8(unsigned a0, unsigned a1, unsigned c0, unsigned c1, bf16x8& f00, bf16x8& f01, bf16x8& f10, bf16x8& f11) {
    u32x2 r0, r1, r2, r3, r4, r5, r6, r7;
    asm volatile("ds_read_b64_tr_b16 %0, %8\n\tds_read_b64_tr_b16 %1, %9\n\tds_read_b64_tr_b16 %2, %8 offset:8192\n\tds_read_b64_tr_b16 %3, %9 offset:8192\n\t"
                 "ds_read_b64_tr_b16 %4, %10\n\tds_read_b64_tr_b16 %5, %11\n\tds_read_b64_tr_b16 %6, %10 offset:8192\n\tds_read_b64_tr_b16 %7, %11 offset:8192\n\ts_waitcnt lgkmcnt(0)"
                 : "=&v"(r0), "=&v"(r1), "=&v"(r2), "=&v"(r3), "=&v"(r4), "=&v"(r5), "=&v"(r6), "=&v"(r7) : "v"(a0), "v"(a1), "v"(c0), "v"(c1) : "memory");
    const u32x4 x00 = {r0.x, r0.y, r1.x, r1.y}, x01 = {r2.x, r2.y, r3.x, r3.y}, x10 = {r4.x, r4.y, r5.x, r5.y}, x11 = {r6.x, r6.y, r7.x, r7.y};
    f00 = __builtin_bit_cast(bf16x8, x00); f01 = __builtin_bit_cast(bf16x8, x01); f10 = __builtin_bit_cast(bf16x8, x10); f11 = __builtin_bit_cast(bf16x8, x11);
}
__device__ __forceinline__ bf16x8 pack8(const f32x4 a, const f32x4 b) { const u32x4 r = {pkbf(a[0], a[1]), pkbf(a[2], a[3]), pkbf(b[0], b[1]), pkbf(b[2], b[3])}; return __builtin_bit_cast(bf16x8, r); }
__device__ __forceinline__ u32x2 tr_issue(unsigned a) { u32x2 r; asm volatile("ds_read_b64_tr_b16 %0, %1" : "=v"(r) : "v"(a) : "memory"); return r; }
__device__ __forceinline__ u32x2 tr_issue8k(unsigned a) { u32x2 r; asm volatile("ds_read_b64_tr_b16 %0, %1 offset:8192" : "=v"(r) : "v"(a) : "memory"); return r; }
__device__ __forceinline__ bf16x8 frag2(const u32x2 lo, const u32x2 hi) { const u32x4 r = {lo.x, lo.y, hi.x, hi.y}; return __builtin_bit_cast(bf16x8, r); }
__device__ __forceinline__ u32x2 at_tile(LAS unsigned char* lds, unsigned QI, unsigned KI, int it, int j, unsigned l15, unsigned g) {
    f32x4 c = (f32x4){0.f, 0.f, 0.f, 0.f};
#pragma unroll
    for (int kd = 0; kd < 4; ++kd) { const bf16x8 qb = *(const LAS bf16x8*)(lds + QI + offb(16u * (unsigned)it + l15, 4u * kd + g)), a = *(const LAS bf16x8*)(lds + KI + offb(16u * (unsigned)j + l15, 4u * kd + g)); c = MFMA16(a, qb, c); }
    if (j == it) {
#pragma unroll
        for (int r = 0; r < 4; ++r) c[r] = (4u * g + r <= l15) ? c[r] : 0.f; }
    const u32x2 w = {pkbf(c[0], c[1]), pkbf(c[2], c[3])}; return w;
}
template <int NK>
__device__ __forceinline__ f32x4 o_part(LAS unsigned char* lds, unsigned QI, int it, const bf16x8 (&at)[NK], const bf16x8 (&vf)[2], const bf16x8 so0, const bf16x8 so1, const bf16x8 sp0, const bf16x8 sp1, int th, unsigned l15, unsigned g) {
    const unsigned trow = 16u * (unsigned)it + l15;
    f32x4 o = (f32x4){0.f, 0.f, 0.f, 0.f};
#pragma unroll
    for (int ks = 0; ks < NK; ++ks) if (2 * ks <= it) o = MFMA16(vf[ks], at[ks], o);
#pragma unroll
    for (int j = 0; j < 4; ++j) {
        const unsigned kd = (j < 2) ? (2u * (unsigned)th + j) : (2u * (unsigned)(1 - th) + (j - 2));
        const u32x2 q0 = *(const LAS u32x2*)(lds + QI + offb(trow, 4u * kd + (g >> 1)) + 8u * (g & 1)), q1 = *(const LAS u32x2*)(lds + QI + offb(trow, 4u * kd + 2u + (g >> 1)) + 8u * (g & 1));
        o = MFMA16(j == 0 ? so0 : j == 1 ? so1 : j == 2 ? sp0 : sp1, frag2(q0, q1), o); }
    return o;
}
__device__ __forceinline__ void phase(LAS unsigned char* lds, const bf16_t* Qt, const bf16_t* Kt, bf16_t* VO, const float* DEC, float* ss8, int bid, int G, int wave) {
    const unsigned lane = (unsigned)fresh_lane_id(), l15 = lane & 15u, g = lane >> 4, ql = l15 >> 2, p = lane & 3u;
    const unsigned vs = (unsigned)wave & 3u; const int th = wave >> 2, tA = th ? 1 : 0, tB = th ? 2 : 3;
    const unsigned ldsb = (unsigned)(uintptr_t)lds;
    constexpr unsigned QKB = 32768u, VRING = 3u * QKB, DECB = VRING + 2u * 8192u, SFB = DECB + 1536u, ATB = SFB + 32768u;
    static_assert(ATB + 2u * 5120u <= XST_OFF, "scan LDS map");
    unsigned qoff[2], voff_, doff;
#pragma unroll
    for (int i = 0; i < 2; ++i) { const unsigned j = 2u * (unsigned)wave + i, r = 4u * j + (lane >> 4), pc = lane & 15u, ch = pc ^ (((r & 3u) << 2) | ((r >> 2) & 3u)); qoff[i] = (r * DI + ch * 8u) * 2u; }
    { const unsigned r = 8u * (unsigned)wave + (lane >> 3), s16 = lane & 7u, ul = (s16 >> 1) ^ (((r >> 1) & 3u) ^ (((r >> 3) & 1u) << 1)); voff_ = (r * DI + (ul * 2u + (s16 & 1u)) * 8u) * 2u; }
    doff = (64u * ((unsigned)wave & 1u) + lane) * 4u;
    const int my_it = wave == 0 ? 0 : wave <= 2 ? 1 : wave <= 5 ? 2 : 3, my_j = wave == 0 ? 0 : wave <= 2 ? wave - 1 : wave <= 5 ? wave - 3 : wave - 6;
    for (int item = bid; item < BATCH * NHEAD * 2; item += G) {
        const int half = (item >> 3) & 1, pair = (item & 7) | ((item >> 4) << 3), b = pair >> 4, h = pair & 15;
        const size_t tokb = (size_t)b * SEQ;
        const char* qg = (const char*)(Qt + tokb * DI + h * HD);
        const char* kg = (const char*)(Kt + tokb * DI + h * HD);
        bf16_t* vg = VO + tokb * DI + h * HD + half * 64;
        const char* dg = (const char*)(DEC + (size_t)(b * (SEQ / 64)) * DI + h * HD);
        f32x4 S[4];
        bf16x8 so0 = (bf16x8){0, 0, 0, 0, 0, 0, 0, 0}, so1 = so0, sp0 = so0, sp1 = so0;
#pragma unroll
        for (int i = 0; i < 4; ++i) S[i] = (f32x4){0.f, 0.f, 0.f, 0.f};
#define SC_DMA_QK(c_) do { const size_t o_ = (size_t)(c_) * 64 * DI * 2; const unsigned base_ = ((unsigned)(c_) % 3u) * QKB; \
            __builtin_amdgcn_global_load_lds((const unsigned*)(qg + o_ + qoff[0]), (LAS unsigned*)(lds + base_ + (unsigned)wave * 2048u), 16, 0, 0); \
            __builtin_amdgcn_global_load_lds((const unsigned*)(qg + o_ + qoff[1]), (LAS unsigned*)(lds + base_ + (unsigned)wave * 2048u + 1024u), 16, 0, 0); \
            __builtin_amdgcn_global_load_lds((const unsigned*)(kg + o_ + qoff[0]), (LAS unsigned*)(lds + base_ + 16384u + (unsigned)wave * 2048u), 16, 0, 0); \
            __builtin_amdgcn_global_load_lds((const unsigned*)(kg + o_ + qoff[1]), (LAS unsigned*)(lds + base_ + 16384u + (unsigned)wave * 2048u + 1024u), 16, 0, 0); \
            __builtin_amdgcn_global_load_lds((const unsigned*)(dg + (size_t)(c_) * DI * 4 + doff), (LAS unsigned*)(lds + DECB + ((unsigned)(c_) % 3u) * 512u + ((unsigned)wave & 1u) * 256u), 4, 0, 0); } while (0)
#define SC_DMA_V(c_) __builtin_amdgcn_global_load_lds((const unsigned*)((const char*)vg + (size_t)(c_) * 64 * DI * 2 + voff_), (LAS unsigned*)(lds + VRING + ((unsigned)(c_) & 1u) * 8192u + (unsigned)wave * 1024u), 16, 0, 0)
#define SC_AT(c_) do { LAS u32x2* atw = (LAS u32x2*)(lds + ATB + (unsigned)((c_) & 1) * 5120u) + lane; const unsigned b_ = ((unsigned)(c_) % 3u) * QKB; \
            atw[64 * wave] = at_tile(lds, b_, b_ + 16384u, my_it, my_j, l15, g); \
            if (wave < 2) atw[64 * (8 + wave)] = at_tile(lds, b_, b_ + 16384u, 3, 2 + wave, l15, g); } while (0)
        SC_DMA_QK(0); SC_DMA_QK(1); SC_DMA_V(0); SC_DMA_V(1);
        asm volatile("s_waitcnt vmcnt(0)" ::: "memory");
        __builtin_amdgcn_s_barrier();
        SC_AT(0);
        asm volatile("s_waitcnt lgkmcnt(0)" ::: "memory");
        __builtin_amdgcn_s_barrier();
        for (int n = 0; n < SEQ / 64; ++n) {
            const unsigned QI = ((unsigned)n % 3u) * QKB, KI = QI + 16384u, VI = VRING + ((unsigned)n & 1u) * 8192u;
            if (n + 2 < SEQ / 64) SC_DMA_QK(n + 2);
            if (n > 0) { const LAS bf16x8* sfr = (const LAS bf16x8*)(lds + SFB + ((unsigned)n & 1u) * 16384u + (unsigned)(wave ^ 4) * 2048u) + lane;
                sp0 = sfr[0]; sp1 = sfr[64]; }
            u32x2 tv0, tv1, tv2, tv3, tv4, tv5, tv6, tv7;
            {
                const unsigned va = ldsb + VI + 8u * p;
                tv0 = tr_issue(va + voffv(4u * g + ql, vs)); tv1 = tr_issue(va + voffv(16u + 4u * g + ql, vs)); tv2 = tr_issue(va + voffv(32u + 4u * g + ql, vs)); tv3 = tr_issue(va + voffv(48u + 4u * g + ql, vs));
                tv4 = tr_issue(va + voffv(8u * g + ql, vs)); tv5 = tr_issue(va + voffv(8u * g + 4u + ql, vs)); tv6 = tr_issue(va + voffv(32u + 8u * g + ql, vs)); tv7 = tr_issue(va + voffv(36u + 8u * g + ql, vs));
            }
            bf16x8 atB[2], atA[1];
            { const LAS u32x2* atr = (const LAS u32x2*)(lds + ATB + (unsigned)(n & 1) * 5120u) + lane; const u32x2 z2 = {0u, 0u};
              if (th == 0) { atB[0] = frag2(atr[64 * 6], atr[64 * 7]); atB[1] = frag2(atr[64 * 8], atr[64 * 9]); atA[0] = frag2(atr[0], z2); }
              else         { atB[0] = frag2(atr[64 * 3], atr[64 * 4]); atB[1] = frag2(atr[64 * 5], z2);          atA[0] = frag2(atr[64 * 1], atr[64 * 2]); } }
            const unsigned ka = (ldsb + KI + offb(8u * g + ql, (p >> 1)) + 8u * (p & 1u)) ^ ((unsigned)th << 7), kb = (ldsb + KI + offb(8u * g + 4u + ql, (p >> 1)) + 8u * (p & 1u)) ^ ((unsigned)th << 7);
            const u32x2 ka0 = tr_issue(ka), kb0 = tr_issue(kb), ka0h = tr_issue8k(ka), kb0h = tr_issue8k(kb);
            const u32x2 ka1 = tr_issue(ka ^ 32u), kb1 = tr_issue(kb ^ 32u), ka1h = tr_issue8k(ka ^ 32u), kb1h = tr_issue8k(kb ^ 32u);
            const u32x2 ka2 = tr_issue(ka ^ 64u), kb2 = tr_issue(kb ^ 64u), ka2h = tr_issue8k(ka ^ 64u), kb2h = tr_issue8k(kb ^ 64u);
            const u32x2 ka3 = tr_issue(ka ^ 96u), kb3 = tr_issue(kb ^ 96u), ka3h = tr_issue8k(ka ^ 96u), kb3h = tr_issue8k(kb ^ 96u);
            u32x2 kq[16] = {ka0, kb0, ka0h, kb0h, ka1, kb1, ka1h, kb1h, ka2, kb2, ka2h, kb2h, ka3, kb3, ka3h, kb3h};
            if (n < SEQ / 64 - 2) asm volatile("s_waitcnt vmcnt(10)" ::: "memory"); else asm volatile("s_waitcnt vmcnt(0)" ::: "memory");
            asm volatile("s_waitcnt lgkmcnt(0)" : "+v"(tv0), "+v"(tv1), "+v"(tv2), "+v"(tv3), "+v"(tv4), "+v"(tv5), "+v"(tv6), "+v"(tv7),
                         "+v"(kq[0]), "+v"(kq[1]), "+v"(kq[2]), "+v"(kq[3]), "+v"(kq[4]), "+v"(kq[5]), "+v"(kq[6]), "+v"(kq[7]),
                         "+v"(kq[8]), "+v"(kq[9]), "+v"(kq[10]), "+v"(kq[11]), "+v"(kq[12]), "+v"(kq[13]), "+v"(kq[14]), "+v"(kq[15]) :: "memory");
            __builtin_amdgcn_s_barrier();
            if (n + 2 < SEQ / 64) SC_DMA_V(n + 2);
            if (n + 1 < SEQ / 64) SC_AT(n + 1);
            __builtin_amdgcn_sched_barrier(0);
            const bf16x8 vf[2] = {frag2(tv0, tv1), frag2(tv2, tv3)};
            const f32x4 oB = o_part<2>(lds, QI, tB, atB, vf, so0, so1, sp0, sp1, th, l15, g);
            const f32x4 oA = o_part<1>(lds, QI, tA, atA, vf, so0, so1, sp0, sp1, th, l15, g);
            {
                const bf16x8 vn0 = frag2(tv4, tv5), vn1 = frag2(tv6, tv7);
                const LAS float* dcp = (const LAS float*)(lds + DECB + ((unsigned)n % 3u) * 512u) + 4u * g + 64u * (unsigned)th;
#pragma unroll
                for (int i = 0; i < 4; i += 2) {
                    const bf16x8 k00 = frag2(kq[4 * i], kq[4 * i + 1]), k01 = frag2(kq[4 * i + 2], kq[4 * i + 3]), k10 = frag2(kq[4 * i + 4], kq[4 * i + 5]), k11 = frag2(kq[4 * i + 6], kq[4 * i + 7]);
                    S[i] = MFMA16(k00, vn0, S[i]); S[i + 1] = MFMA16(k10, vn0, S[i + 1]); S[i] = MFMA16(k01, vn1, S[i]); S[i + 1] = MFMA16(k11, vn1, S[i + 1]); }
#pragma unroll
                for (int i = 0; i < 4; ++i) { const f32x4 dc = *(const LAS f32x4*)(dcp + 16 * i); S[i] = S[i] * dc; }
                const bf16x8 f0 = pack8(S[0], S[1]), f1 = pack8(S[2], S[3]);
                so0 = f0; so1 = f1;
                LAS bf16x8* sfw = (LAS bf16x8*)(lds + SFB + ((unsigned)(n + 1) & 1u) * 16384u + (unsigned)wave * 2048u) + lane;
                sfw[0] = f0; sfw[64] = f1;
            }
            if (n < SEQ / 64 - 2) asm volatile("s_waitcnt vmcnt(10)" ::: "memory"); else asm volatile("s_waitcnt vmcnt(0)" ::: "memory");
            {
                const size_t tlB = (size_t)n * 64 + 16u * (unsigned)tB + l15, tlA = (size_t)n * 64 + 16u * (unsigned)tA + l15;
                const u32x2 wB = {pkbf(oB[0], oB[1]), pkbf(oB[2], oB[3])}, wA = {pkbf(oA[0], oA[1]), pkbf(oA[2], oA[3])};
                *(u32x2*)(vg + tlB * DI + 16u * vs + 4u * g) = wB; *(u32x2*)(vg + tlA * DI + 16u * vs + 4u * g) = wA;
                float sB = (oB[0] * oB[0] + oB[1] * oB[1]) + (oB[2] * oB[2] + oB[3] * oB[3]), sA = (oA[0] * oA[0] + oA[1] * oA[1]) + (oA[2] * oA[2] + oA[3] * oA[3]);
                sB += xor_get(sB, (int)lane, 16); sA += xor_get(sA, (int)lane, 16); sB += xor_get(sB, (int)lane, 32); sA += xor_get(sA, (int)lane, 32);
                if (g == 0) { ss8[(tokb + tlB) * 128 + h * 8 + half * 4 + vs] = sB; ss8[(tokb + tlA) * 128 + h * 8 + half * 4 + vs] = sA; }
            }
            asm volatile("s_waitcnt lgkmcnt(0)" ::: "memory");
            __builtin_amdgcn_s_barrier();
        }
#undef SC_DMA_QK
#undef SC_DMA_V
#undef SC_AT
    }
}
#undef MFMA16
}

#define XB_TMO      128
#define XB_XCNT(j)  (256  + 64 * (j))
#define XB_XSUB(j)  (1280 + 64 * (j))
#define XB_XGEN(j)  (2304 + 64 * (j))
#define XB_TOP      3328
#define XB_TOPGEN   3392
#define XCD_BAR_WORDS 3456
#define XB_SPIN_CAP (1u << 18)
__device__ __forceinline__ unsigned xb_ld(unsigned* p)              { return __hip_atomic_load(p, __ATOMIC_RELAXED, __HIP_MEMORY_SCOPE_AGENT); }
__device__ __forceinline__ unsigned xb_add(unsigned* p, unsigned v) { return __hip_atomic_fetch_add(p, v, __ATOMIC_RELAXED, __HIP_MEMORY_SCOPE_AGENT); }
__device__ __forceinline__ unsigned xb_xcc_id() { return (unsigned)__builtin_amdgcn_s_getreg((3 << 11) | 20) & 0xFu; }
#define XB_SPIN(cond, bar) do { unsigned _sp = 0; while (cond) { __builtin_amdgcn_s_sleep(1); \
    if ((++_sp & 255u) == 0u) { if (xb_ld(&(bar)[XB_TMO])) break; if (_sp > XB_SPIN_CAP) { atomicAdd(&(bar)[XB_TMO], 1u); break; } } } } while (0)
struct XcdBarrier { unsigned* bar; unsigned x; volatile LAS unsigned* st; };
__device__ __forceinline__ XcdBarrier xcd_barrier_post(unsigned* bar, volatile LAS unsigned* st) {
    XcdBarrier b; b.bar = bar; b.x = xb_xcc_id(); b.st = st;
    if (threadIdx.x == 0) (void)xb_add(&bar[XB_XCNT(b.x)], 1u);
    return b;
}
__device__ __forceinline__ void xcd_barrier_complete(unsigned* bar, unsigned x, unsigned& nloc, unsigned& nx) {
    const unsigned G = gridDim.x * gridDim.y * gridDim.z;
    unsigned sum, cnt, mine, sp = 0u;
    for (;;) {
        sum = 0u; cnt = 0u; mine = 0u;
#pragma unroll
        for (unsigned j = 0; j < 16; ++j) { const unsigned c = xb_ld(&bar[XB_XCNT(j)]); sum += c; cnt += (c > 0u) ? 1u : 0u; mine = (j == x) ? c : mine; }
        if (sum == G) break;
        __builtin_amdgcn_s_sleep(1);
        if ((++sp & 255u) == 0u) { if (xb_ld(&bar[XB_TMO])) break; if (sp > XB_SPIN_CAP) { atomicAdd(&bar[XB_TMO], 1u); break; } }
    }
    nloc = mine > 0u ? mine : 1u; nx = cnt > 0u ? cnt : 1u;
}
__device__ __forceinline__ void xcd_barrier(const XcdBarrier& b) {
    asm volatile("s_waitcnt vmcnt(0)" ::: "memory");
    __syncthreads();
    if (threadIdx.x == 0) {
        unsigned* bar = b.bar;
        __builtin_amdgcn_s_waitcnt(0);
        unsigned nloc = b.st[0], nx = b.st[1];
        if (nloc == 0u) { xcd_barrier_complete(bar, b.x, nloc, nx); b.st[0] = nloc; b.st[1] = nx; }
        const unsigned old = xb_add(&bar[XB_XSUB(b.x)], 1u);
        const unsigned gen = old / nloc;
        if (old + 1u == (gen + 1u) * nloc) {
            __builtin_amdgcn_fence(__ATOMIC_RELEASE, "agent");
            asm volatile("s_waitcnt vmcnt(0)" ::: "memory");
            const unsigned og = xb_add(&bar[XB_TOP], 1u);
            const unsigned tg = og / nx;
            if (og + 1u == (tg + 1u) * nx) xb_add(&bar[XB_TOPGEN], 1u);
            else XB_SPIN(xb_ld(&bar[XB_TOPGEN]) == tg, bar);
            __builtin_amdgcn_fence(__ATOMIC_ACQUIRE, "agent");
            xb_add(&bar[XB_XGEN(b.x)], 1u);
            asm volatile("s_waitcnt vmcnt(0)" ::: "memory");
        } else {
            XB_SPIN(xb_ld(&bar[XB_XGEN(b.x)]) == gen, bar);
            __builtin_amdgcn_fence(__ATOMIC_ACQUIRE, "agent");
            asm volatile("s_waitcnt vmcnt(0)" ::: "memory");
        }
    }
    __syncthreads();
}

struct Args {
    const float* x; const float* norm_g; const float* pool_w_in; const float* pool_w_grp; const float* pool_scale; const float* pool_w_out;
    const float* hgrn_w_in; const float* hgrn_lb; const float* hgrn_norm_g; const float* hgrn_w_out; const float* final_g;
    float* out; unsigned char* ws;
};

struct TItem { const float* W; bf16_t* WT; const float* ks; const float* ns; int K, N, row_off, item; float cs; };
__device__ __forceinline__ void titem_issue(const TItem& t, int lane, float (&wv)[32]) {
    const int nblk = t.N / 32, kb = t.item / nblk, nb = t.item % nblk, k0 = 64 * kb, n0 = 32 * nb;
    const float* wp = t.W + (size_t)(k0 + (lane >> 5)) * t.N + n0 + (lane & 31);
#pragma unroll
    for (int i = 0; i < 32; ++i) wv[i] = __builtin_nontemporal_load(wp + (size_t)(2 * i) * t.N);
}
__device__ __forceinline__ void titem_finish(const TItem& t, int lane, const float (&wv)[32], LAS float* scr) {
    const int nblk = t.N / 32, kb = t.item / nblk, nb = t.item % nblk, k0 = 64 * kb, n0 = 32 * nb;
    const float nsv = (t.ns ? t.ns[n0 + (lane & 31)] : 1.0f) * t.cs;
    const float ksv = t.ks ? t.ks[k0 + lane] : 1.0f;
#pragma unroll
    for (int i = 0; i < 32; ++i) { const int kk = 2 * i + (lane >> 5); scr[kk * 33 + (lane & 31)] = wv[i] * nsv * lane_get(ksv, kk); }
    asm volatile("s_waitcnt lgkmcnt(0)" ::: "memory");
    const int c = lane & 7;
#pragma unroll
    for (int j = 0; j < 4; ++j) { const int n = (lane >> 3) + 8 * j; const LAS float* s = scr + (8 * c) * 33 + n;
        u32x4 o; o.x = pkbf(s[0 * 33], s[1 * 33]); o.y = pkbf(s[2 * 33], s[3 * 33]); o.z = pkbf(s[4 * 33], s[5 * 33]); o.w = pkbf(s[6 * 33], s[7 * 33]);
        *(u32x4*)(t.WT + (size_t)(t.row_off + n0 + n) * t.K + k0 + 8 * c) = o; }
    asm volatile("s_waitcnt lgkmcnt(0)" ::: "memory");
}

__global__ void __launch_bounds__(512, 2) fwd_kernel(Args a) {
    extern __shared__ __attribute__((aligned(16))) unsigned char lds_raw[];
    LAS unsigned char* lds = (LAS unsigned char*)lds_raw;
    volatile LAS unsigned* xst = (volatile LAS unsigned*)(lds + XST_OFF);
    if (threadIdx.x < 2) xst[threadIdx.x] = 0u;
    __syncthreads();
    const XcdBarrier xbar = xcd_barrier_post((unsigned*)a.ws, xst);
#define GRID_BAR() xcd_barrier(xbar)
    const int G = gridDim.x, bid = blockIdx.x;
    const int NGW = G * 8;
    const int wave = __builtin_amdgcn_readfirstlane((int)threadIdx.x >> 6);
#define PHASE_IDS int lane_ = fresh_lane_id(); const int lane = lane_, tid = wave * 64 + lane, gw = bid * 8 + wave; (void)gw; (void)tid;
    unsigned char* ws = a.ws;
    bf16_t* Wt_in0 = (bf16_t*)(ws + WS_WIN0); bf16_t* Wt_grp = (bf16_t*)(ws + WS_WGRP); bf16_t* Wt_out0 = (bf16_t*)(ws + WS_WOUT0);
    bf16_t* Wt_in1 = (bf16_t*)(ws + WS_WIN1); bf16_t* Wt_out1 = (bf16_t*)(ws + WS_WOUT1);
    float* invr0 = (float*)(ws + WS_INVR); float* part1 = (float*)(ws + WS_PART1); float* ssb = (float*)(ws + WS_SS); float* decb = (float*)(ws + WS_DEC);
    bf16_t* XB = (bf16_t*)(ws + WS_XB); bf16_t* BA = (bf16_t*)(ws + WS_A); bf16_t* BB = (bf16_t*)(ws + WS_B); bf16_t* BC = (bf16_t*)(ws + WS_C);

    {
        PHASE_IDS
        LAS float* scr = (LAS float*)(lds + wave * 16384);
        constexpr int I_IN0 = (DM / 64) * (2048 / 32), I_GRP1 = (512 / 64) * (512 / 32), I_OUT = (DI / 64) * (DM / 32), I_IN1 = (DM / 64) * (8192 / 32);
        constexpr int NITEMS = I_IN0 + 4 * I_GRP1 + I_OUT + I_IN1 + I_OUT;
        auto decode = [&](int it) -> TItem {
            int r = it;
            if (r < I_IN0) {
                const int kb = r >> 6, nb = r & 63, n0 = 2048 + 32 * nb, d0 = 256 * ((n0 - 2048) >> 7) + 128 + (n0 & 127);
                return TItem{a.pool_w_in, Wt_in0, a.norm_g, nullptr, DM, 4096, d0 - n0, kb * 128 + 64 + nb, NEG_LOG2E}; } r -= I_IN0;
            if (r < 4 * I_GRP1) { const int g = r / I_GRP1; return TItem{a.pool_w_grp + (size_t)g * 512 * 512, Wt_grp, nullptr, a.pool_scale + g * 512, 512, 512, g * 512, r % I_GRP1, 1.0f}; } r -= 4 * I_GRP1;
            if (r < I_OUT) return TItem{a.pool_w_out, Wt_out0, nullptr, nullptr, DI, DM, 0, r, NEG_LN2}; r -= I_OUT;
            if (r < I_IN1) {
                const int n0 = 32 * (r % (8192 / 32)); int d0 = n0;
                if (n0 < 2048) d0 = 256 * (n0 >> 7) + (n0 & 127); else if (n0 < 4096) d0 = 256 * ((n0 - 2048) >> 7) + 128 + (n0 & 127);
                return TItem{a.hgrn_w_in, Wt_in1, a.norm_g + DM, nullptr, DM, 8192, d0 - n0, r, n0 >= 6144 ? NEG_LOG2E : 1.0f}; } r -= I_IN1;
            return TItem{a.hgrn_w_out, Wt_out1, a.hgrn_norm_g, nullptr, DI, DM, 0, r, NEG_LN2};
        };
        {
            float wa[32], wb[32]; TItem ia{}, ib{};
            int it = gw; bool ha = it < NITEMS;
            if (ha) { ia = decode(it); titem_issue(ia, lane, wa); }
            while (ha) {
                const int itb = it + NGW; const bool hb = itb < NITEMS;
                if (hb) { ib = decode(itb); titem_issue(ib, lane, wb); }
                titem_finish(ia, lane, wa, scr);
                it = itb + NGW; ha = it < NITEMS;
                if (ha) { ia = decode(it); titem_issue(ia, lane, wa); }
                if (!hb) break;
                titem_finish(ib, lane, wb, scr);
            }
        }
        for (int idx = gw * 64 + lane; idx < DM * (DI / 8); idx += NGW * 64) {
            const int k = idx >> 8, c8 = (idx & 255) * 8; const float gk = a.norm_g[k];
            const f32x4 w0 = __builtin_nontemporal_load((const f32x4*)(a.pool_w_in + (size_t)k * 4096 + c8)), w1 = __builtin_nontemporal_load((const f32x4*)(a.pool_w_in + (size_t)k * 4096 + c8 + 4));
            u32x4 o; o.x = pkbf(w0[0] * gk, w0[1] * gk); o.y = pkbf(w0[2] * gk, w0[3] * gk); o.z = pkbf(w1[0] * gk, w1[1] * gk); o.w = pkbf(w1[2] * gk, w1[3] * gk);
            *(u32x4*)(BC + (size_t)k * DI + c8) = o; }
    }
    GRID_BAR();

    {
        pg8::Gemm g{Wt_grp, BC, 512, DI, 512, 0, 2}; pg8::StaticOrder S; S.init(DI, DM, G, bid);
        pg8::EpiFold E{Wt_in0};
        pg8::gemm_phase<pg8::EpiFold>(lds, g, S, E, wave);
    }
    {
        PHASE_IDS
        for (int m0 = gw * 8; m0 < M; m0 += NGW * 8) {
            f32x4 v[8][4]; float s[8];
#pragma unroll
            for (int r = 0; r < 8; ++r) { const f32x4* xr = (const f32x4*)(a.x + (size_t)(m0 + r) * DM) + lane;
#pragma unroll
                for (int j = 0; j < 4; ++j) v[r][j] = __builtin_nontemporal_load(xr + 64 * j); }
#pragma unroll
            for (int r = 0; r < 8; ++r) { s[r] = 0.f;
#pragma unroll
                for (int j = 0; j < 4; ++j) s[r] += (v[r][j][0] * v[r][j][0] + v[r][j][1] * v[r][j][1]) + (v[r][j][2] * v[r][j][2] + v[r][j][3] * v[r][j][3]); }
#pragma unroll
            for (int o = 1; o < 64; o <<= 1) {
#pragma unroll
                for (int r = 0; r < 8; ++r) s[r] += xor_get(s[r], lane, o); }
#pragma unroll
            for (int r = 0; r < 8; ++r) { const float rms = sqrtf(s[r] * (1.0f / DM) + EPS), rstd = 1.0f / rms;
                if (lane == 0) invr0[m0 + r] = rms;
                unsigned long long* o8 = (unsigned long long*)(XB + (size_t)(m0 + r) * DM) + lane;
#pragma unroll
                for (int j = 0; j < 4; ++j) o8[64 * j] = (unsigned long long)pkbf(v[r][j][0] * rstd, v[r][j][1] * rstd) | ((unsigned long long)pkbf(v[r][j][2] * rstd, v[r][j][3] * rstd) << 32); }
        }
    }
    GRID_BAR();

    {
        pg8::Gemm g{XB, Wt_in0, DM, DM, DM, 0, 0}; pg8::StaticOrder S; S.init(M, 4096, G, bid);
        pg8::EpiP1 E{BB, (unsigned char*)BA, (unsigned char*)BA + 16 * MiB};
        pg8::gemm_phase<pg8::EpiP1>(lds, g, S, E, wave);
    }
    GRID_BAR();

    {
        PHASE_IDS
        const unsigned char* HALO = (const unsigned char*)BA; const unsigned char* SG0 = (const unsigned char*)BA + 16 * MiB;
        for (int idx = bid * 512 + tid; idx < 120 * 256; idx += G * 512) {
            const int sub = idx & 255, pq = idx >> 8, pm = (pq / 15) * 16 + (pq % 15) + 1;
            const int pn = sub >> 4, wc = (sub >> 2) & 3, fq = sub & 3, w = 2 << (pn >> 2);
            const unsigned char* hp = HALO + (size_t)((pm - 1) * 16 + pn) * pg8::HALO_TILE + (unsigned)((wc * 64 + fq * 16) * 16);
            const unsigned char* sp = SG0 + (size_t)(pm * 16 + pn) * pg8::HALO_TILE + (unsigned)((wc * 64 + fq * 16) * 16);
            bf16_t* zp = BB + (size_t)(pm * 256) * DI + pn * 128 + wc * 32 + fq * 8;
            const float inv = 1.0f / (float)w;
            float suf[8];
#pragma unroll
            for (int c = 0; c < 8; ++c) suf[c] = 0.f;
            for (int i = 15; i >= 17 - w; --i) {
                const u32x4 hv = *(const u32x4*)(hp + i * 16);
                suf[0] += bf_lo(hv.x); suf[1] += bf_hi(hv.x); suf[2] += bf_lo(hv.y); suf[3] += bf_hi(hv.y); suf[4] += bf_lo(hv.z); suf[5] += bf_hi(hv.z); suf[6] += bf_lo(hv.w); suf[7] += bf_hi(hv.w);
                const int t = w - 1 - (16 - i);
                const u32x4 sg = *(const u32x4*)(sp + t * 16);
                u32x4* q = (u32x4*)(zp + (size_t)t * DI); const u32x4 o = *q;
                u32x4 r; r.x = pkbf(bf_lo(o.x) + suf[0] * inv * bf_lo(sg.x), bf_hi(o.x) + suf[1] * inv * bf_hi(sg.x)); r.y = pkbf(bf_lo(o.y) + suf[2] * inv * bf_lo(sg.y), bf_hi(o.y) + suf[3] * inv * bf_hi(sg.y));
                r.z = pkbf(bf_lo(o.z) + suf[4] * inv * bf_lo(sg.z), bf_hi(o.z) + suf[5] * inv * bf_hi(sg.z)); r.w = pkbf(bf_lo(o.w) + suf[6] * inv * bf_lo(sg.w), bf_hi(o.w) + suf[7] * inv * bf_hi(sg.w));
                *q = r;
            }
        }
    }
    GRID_BAR();

    {
        pg8::Gemm g{BB, Wt_out0, DI, DI, DI, 0, 0}; pg8::StaticOrder S; S.init(M, DM, G, bid);
        pg8::EpiRes<true, false> E{XB, invr0, nullptr, XB, part1};
        pg8::gemm_phase<pg8::EpiRes<true, false>>(lds, g, S, E, wave);
    }
    GRID_BAR();

    {
        pg8::Gemm g{XB, Wt_in1, DM, DM, DM, 0, 0}; pg8::StaticOrder S; S.init(M, 6144, G, bid);
        pg8::EpiP4 E{BA, BB, BC, decb, part1, a.hgrn_lb};
        pg8::gemm_phase<pg8::EpiP4>(lds, g, S, E, wave);
    }
    GRID_BAR();

    scan::phase(lds, BA, BB, BC, decb, ssb, bid, G, wave);
    GRID_BAR();

    {
        pg8::Gemm g{XB, Wt_in1 + (size_t)6144 * DM, DM, DM, DM, 0, 0}; pg8::StaticOrder S; S.init(M, DI, G, bid);
        pg8::EpiP5b E{BC, part1, ssb};
        pg8::gemm_phase<pg8::EpiP5b>(lds, g, S, E, wave);
    }
    GRID_BAR();

    {
        pg8::Gemm g{BC, Wt_out1, DI, DI, DI, 0, 0}; pg8::StaticOrder S; S.init(M, DM, G, bid);
        pg8::EpiFinal E{XB, a.out, a.final_g, (float*)(ws + WS_X), (unsigned*)(ws + WS_CNT)};
        pg8::gemm_phase<pg8::EpiFinal>(lds, g, S, E, wave);
    }
}

extern "C" void kernel_launch(void* const* d_in, const int* in_sizes, int n_in, void* d_out, int out_size, void* d_ws, size_t ws_size, hipStream_t stream) {
    static int grid = 0;
    if (grid == 0) {
        if (n_in != 11 || in_sizes[0] != M * DM || out_size != M * DM || ws_size < WS_END) { fprintf(stderr, "kernel_launch: unexpected shapes (n_in %d in0 %d out %d ws %zu)\n", n_in, n_in > 0 ? in_sizes[0] : -1, out_size, ws_size); grid = -1; return; }
        int dev = 0, cus = 0, per = 0;
        if (hipGetDevice(&dev) != hipSuccess || hipDeviceGetAttribute(&cus, hipDeviceAttributeMultiprocessorCount, dev) != hipSuccess) { grid = -1; return; }
        if (hipFuncSetAttribute((const void*)fwd_kernel, hipFuncAttributeMaxDynamicSharedMemorySize, LDS_BYTES) != hipSuccess) { fprintf(stderr, "kernel_launch: hipFuncSetAttribute failed\n"); grid = -1; return; }
        if (hipOccupancyMaxActiveBlocksPerMultiprocessor(&per, (const void*)fwd_kernel, 512, LDS_BYTES) != hipSuccess || per < 1) { fprintf(stderr, "kernel_launch: occupancy query says %d\n", per); (void)hipGetLastError(); grid = -1; return; }
        grid = cus;
        fprintf(stderr, "kernel_launch: cus %d per_cu %d grid %d\n", cus, per, grid);
    }
    if (grid < 0) return;
    if (hipMemsetAsync(d_ws, 0, 32768, stream) != hipSuccess) { fprintf(stderr, "kernel_launch: hipMemsetAsync failed\n"); return; }
    Args a{};
    a.x = (const float*)d_in[0]; a.norm_g = (const float*)d_in[1]; a.pool_w_in = (const float*)d_in[2]; a.pool_w_grp = (const float*)d_in[3];
    a.pool_scale = (const float*)d_in[4]; a.pool_w_out = (const float*)d_in[5]; a.hgrn_w_in = (const float*)d_in[6]; a.hgrn_lb = (const float*)d_in[7];
    a.hgrn_norm_g = (const float*)d_in[8]; a.hgrn_w_out = (const float*)d_in[9]; a.final_g = (const float*)d_in[10];
    a.out = (float*)d_out; a.ws = (unsigned char*)d_ws;
    void* args[] = {&a};
    hipError_t e = hipLaunchCooperativeKernel((void*)fwd_kernel, dim3(grid), dim3(512), args, LDS_BYTES, stream);
    if (e != hipSuccess) fprintf(stderr, "kernel_launch: cooperative launch failed: %s (grid %d)\n", hipGetErrorString(e), grid);
}
```

```cpp
#include <hip/hip_runtime.h>
#include <cstdio>
#include <cstdint>

#define LAS __attribute__((address_space(3)))
typedef unsigned short bf16_t;
typedef short bf16x8 __attribute__((ext_vector_type(8)));
typedef float f32x4 __attribute__((ext_vector_type(4)));
typedef float f32x2 __attribute__((ext_vector_type(2)));
typedef unsigned u32x4 __attribute__((ext_vector_type(4)));
typedef unsigned u32x2 __attribute__((ext_vector_type(2)));

constexpr int DM = 1024, BATCH = 8, SEQ = 4096, DI = 2048, M = BATCH * SEQ;
constexpr int NHEAD = 16, HD = 128;
constexpr float EPS = 1e-6f;
constexpr size_t MiB = 1u << 20;
constexpr size_t WS_WIN0 = 2 * MiB;
constexpr size_t WS_WGRP = 10 * MiB;
constexpr size_t WS_WOUT0 = 12 * MiB;
constexpr size_t WS_WIN1 = 16 * MiB;
constexpr size_t WS_WOUT1 = 32 * MiB;
constexpr size_t WS_PART1 = 36 * MiB;
constexpr size_t WS_INVR = 38 * MiB;
constexpr size_t WS_CNT = 16384;
constexpr size_t WS_X = 40 * MiB;
constexpr size_t WS_DEC = 44 * MiB;
constexpr size_t WS_SS = 112 * MiB;
constexpr size_t WS_XB = 48 * MiB;
constexpr size_t WS_A = 128 * MiB;
constexpr size_t WS_B = 256 * MiB;
constexpr size_t WS_C = 384 * MiB;
constexpr size_t WS_END = 512 * MiB;
constexpr int LDS_BYTES = 163840;
constexpr unsigned XST_OFF = 163840u - 256u;

typedef __bf16 bf2_t __attribute__((ext_vector_type(2)));
__device__ __forceinline__ unsigned pkbf(float lo, float hi) { f32x2 v = {lo, hi}; return __builtin_bit_cast(unsigned, __builtin_convertvector(v, bf2_t)); }
__device__ __forceinline__ float bf_lo(unsigned w) { return __builtin_bit_cast(float, w << 16); }
__device__ __forceinline__ float bf_hi(unsigned w) { return __builtin_bit_cast(float, w & 0xffff0000u); }
__device__ __forceinline__ float silu_f(float x) { return x * __builtin_amdgcn_rcpf(1.0f + __builtin_amdgcn_exp2f(-1.44269504089f * x)); }
__device__ __forceinline__ float silu_pre(float t) { return t * __builtin_amdgcn_rcpf(1.0f + __builtin_amdgcn_exp2f(t)); }
constexpr float NEG_LOG2E = -1.44269504089f, NEG_LN2 = -0.69314718056f;
__device__ __forceinline__ int fresh_lane_id() { int l; asm volatile("v_mbcnt_lo_u32_b32 %0, -1, 0\n\tv_mbcnt_hi_u32_b32 %0, -1, %0" : "=v"(l)); return l; }
__device__ __forceinline__ float lane_get(float v, int src_lane) { return __builtin_bit_cast(float, __builtin_amdgcn_ds_bpermute(src_lane << 2, __builtin_bit_cast(int, v))); }
__device__ __forceinline__ float xor_get(float v, int lane, int m) { return lane_get(v, lane ^ m); }
__device__ __forceinline__ float wave_sum(float v, int lane) {
#pragma unroll
    for (int o = 1; o < 64; o <<= 1) v += xor_get(v, lane, o);
    return v;
}

namespace pg8 {
constexpr int BM = 256, BK = 64, HALF = 128, HTB = HALF * BK * 2, NXCD = 8, WGM = 4;
__host__ __device__ __forceinline__ int lds_byte(int r, int c) { const int st = (r >> 4) * 2 + (c >> 5), rr = r & 15, cc = c & 31, ob = rr * 64 + cc * 2; return st * 1024 + (ob ^ (((ob >> 9) & 1) << 5)); }
__host__ __device__ __forceinline__ void stage_rc(int b, int& R, int& C) { const int st = b / 1024, sb = b % 1024, swz = sb ^ (((sb >> 9) & 1) << 5); R = (st >> 1) * 16 + swz / 64; C = (st & 1) * 32 + (swz % 64) / 2; }
__host__ __device__ __forceinline__ int perm32(int rho) { const int n = rho >> 4, i = rho & 15; return 8 * (i >> 2) + 4 * n + (i & 3); }

struct Unit { int pm, pn; };
struct Gemm { const bf16_t* A; const bf16_t* Bt; int lda, ldb, K, grp_tiles, grp_b; };

struct StaticOrder {
    int nM, nN, nwg, G, c;
    __host__ __device__ void init(int M_, int N_, int G_, int c_) { nM = M_ / BM; nN = N_ / BM; nwg = nM * nN; G = G_; c = c_; }
    __host__ __device__ bool next(int i, Unit& u) const {
        const long L = (long)i * G + c; if (L >= nwg) return false;
        int wgid = (int)L; { const int q = nwg / NXCD, r = nwg % NXCD, xcd = wgid % NXCD, off = wgid / NXCD; wgid = (xcd < r ? xcd * (q + 1) : r * (q + 1) + (xcd - r) * q) + off; }
        const int nig = WGM * nN, gid = wgid / nig, fm = gid * WGM, gsz = (nM - fm) < WGM ? (nM - fm) : WGM;
        u.pm = fm + ((wgid % nig) % gsz); u.pn = (wgid % nig) / gsz; return true;
    }
};


__device__ __forceinline__ void zero_acc(f32x4 (&acc)[2][2][4][2]) {
#pragma unroll
    for (int a = 0; a < 2; ++a)
#pragma unroll
        for (int b = 0; b < 2; ++b)
#pragma unroll
            for (int m = 0; m < 4; ++m)
#pragma unroll
                for (int n = 0; n < 2; ++n) acc[a][b][m][n] = (f32x4){0.f, 0.f, 0.f, 0.f};
}
template <class Epi, bool ALIGN_EPI = true, bool SP2 = true>
__device__ __forceinline__ void gemm_phase(LAS unsigned char* lds, const Gemm g, const StaticOrder& S, const Epi& E, const int wid) {
    int lane_ = fresh_lane_id();
    int lane = lane_, tid = wid * 64 + lane, fr = lane & 15, fq = lane >> 4; const int wr = wid >> 2, wc = wid & 3;
    const int K = g.K, nt = K / BK;
    unsigned voffA[2], voffB[2]; int aoff, boff;
#define PG8_LANE_STATE() do { _Pragma("unroll") for (int i = 0; i < 2; ++i) { int R, C; stage_rc(tid * 16 + i * 8192, R, C); const int Rb = Epi::PERM ? ((R & ~31) + perm32(R & 31)) : R; \
        voffA[i] = (unsigned)(R * g.lda + C) * 2u; voffB[i] = (unsigned)(Rb * g.ldb + C) * 2u; } \
        aoff = lds_byte(wr * 64 + fr, fq * 8); boff = lds_byte(wc * 32 + fr, fq * 8); } while (0)
    PG8_LANE_STATE();
    const size_t kstep = (size_t)(BK * 2);
    const size_t hstepA = (size_t)HALF * g.lda * 2, hstepB = (size_t)HALF * g.ldb * 2;
    const size_t tstepA = 2 * hstepA, tstepB = 2 * hstepB;
    const unsigned ldsw = (unsigned)wid * 1024u;
#define PG8_SA(b, h) (((b) * 2 + (h)) * HTB)
#define PG8_SB(b, h) ((4 + (b) * 2 + (h)) * HTB)
#define PG8_STAGE(bufoff, gbase, voff) do { _Pragma("unroll") for (int _i = 0; _i < 2; ++_i) \
        __builtin_amdgcn_global_load_lds((const unsigned*)((const char*)(gbase) + (voff)[_i]), (LAS unsigned*)(lds + (bufoff) + ldsw + _i * 8192), 16, 0, 0); } while (0)
#define PG8_LDA(dst, b, h) do { _Pragma("unroll") for (int m = 0; m < 4; ++m) _Pragma("unroll") for (int k = 0; k < 2; ++k) dst[m][k] = *(const LAS bf16x8*)(lds + PG8_SA(b, h) + aoff + m * 2048 + k * 1024); } while (0)
#define PG8_LDB(dst, b, h) do { _Pragma("unroll") for (int n = 0; n < 2; ++n) _Pragma("unroll") for (int k = 0; k < 2; ++k) dst[n][k] = *(const LAS bf16x8*)(lds + PG8_SB(b, h) + boff + n * 2048 + k * 1024); } while (0)
#define PG8_MMA(ai, bj, At, Bt) do { __builtin_amdgcn_s_setprio(1); _Pragma("unroll") for (int m = 0; m < 4; ++m) _Pragma("unroll") for (int n = 0; n < 2; ++n) _Pragma("unroll") for (int k = 0; k < 2; ++k) \
        acc[ai][bj][m][n] = __builtin_amdgcn_mfma_f32_16x16x32_bf16(Bt[n][k], At[m][k], acc[ai][bj][m][n], 0, 0, 0); __builtin_amdgcn_s_setprio(0); } while (0)
#define PG8_WAIT_V(n) asm volatile("s_waitcnt vmcnt(" #n ")" ::: "memory")
#define PG8_WAIT_L(n) asm volatile("s_waitcnt lgkmcnt(" #n ")" ::: "memory")
#define PG8_BAR __builtin_amdgcn_s_barrier()
#define PG8_SCHED __builtin_amdgcn_sched_barrier(0)
#define PG8_ABASE(u) ((const char*)g.A + (size_t)(u).pm * tstepA + (g.grp_tiles ? (size_t)((u).pn / g.grp_tiles) * (size_t)K * 2 : (size_t)0))
#define PG8_BBASE(u) ((const char*)g.Bt + (size_t)(u).pn * tstepB + (g.grp_b ? (size_t)((u).pm / g.grp_b) * (size_t)K * 2 : (size_t)0))
    Unit cur, nxt; int ui = 0;
    E.prologue(S, lds, tid);
    if (!S.next(0, cur)) return;
    f32x4 acc[2][2][4][2];
    E.init_acc(acc, cur, wr, wc, fr, fq);
    bf16x8 At[4][2], B0[2][2], B1[2][2];
    const char* cA = PG8_ABASE(cur); const char* cB = PG8_BBASE(cur);
    if constexpr (SP2) {
        PG8_STAGE(PG8_SB(0, 0), cB, voffB); PG8_STAGE(PG8_SB(0, 1), cB + hstepB, voffB); PG8_STAGE(PG8_SA(0, 0), cA, voffA); PG8_STAGE(PG8_SA(0, 1), cA + hstepA, voffA);
        if (wr == 1) PG8_BAR;
        PG8_WAIT_V(2); PG8_BAR;
        PG8_STAGE(PG8_SB(1, 0), cB + kstep, voffB); PG8_STAGE(PG8_SA(1, 0), cA + kstep, voffA); PG8_STAGE(PG8_SB(1, 1), cB + hstepB + kstep, voffB);
        PG8_WAIT_V(6); PG8_BAR;
    } else {
        PG8_STAGE(PG8_SB(0, 0), cB, voffB); PG8_STAGE(PG8_SA(0, 0), cA, voffA); PG8_STAGE(PG8_SB(0, 1), cB + hstepB, voffB); PG8_STAGE(PG8_SA(0, 1), cA + hstepA, voffA);
        if (wr == 1) PG8_BAR;
        PG8_WAIT_V(4); PG8_BAR;
        PG8_STAGE(PG8_SB(1, 0), cB + kstep, voffB); PG8_STAGE(PG8_SA(1, 0), cA + kstep, voffA); PG8_STAGE(PG8_SB(1, 1), cB + hstepB + kstep, voffB);
        PG8_WAIT_V(6); PG8_BAR;
    }
    for (;;) {
        const bool has_next = S.next(ui + 1, nxt);
        const char* nA = has_next ? PG8_ABASE(nxt) : cA; const char* nB = has_next ? PG8_BBASE(nxt) : cB;
        for (int t = 0; t < nt; t += 2) {
            const bool last = (t == nt - 2);
            const char* a1 = cA + (size_t)(t + 1) * kstep;
            const char* a2 = last ? nA : cA + (size_t)(t + 2) * kstep; const char* b2 = last ? nB : cB + (size_t)(t + 2) * kstep;
            const char* a3 = a2 + kstep; const char* b3 = b2 + kstep;
            if constexpr (SP2) {
            PG8_LDB(B0, 0, 0); PG8_LDB(B1, 0, 1); PG8_SCHED; PG8_LDA(At, 0, 0); PG8_STAGE(PG8_SA(1, 1), a1 + hstepA, voffA);
            PG8_WAIT_V(8); PG8_WAIT_L(0); PG8_BAR; PG8_MMA(0, 0, At, B0); PG8_MMA(0, 1, At, B1); PG8_BAR; PG8_SCHED;
            PG8_LDA(At, 0, 1); PG8_STAGE(PG8_SB(0, 0), b2, voffB); PG8_STAGE(PG8_SB(0, 1), b2 + hstepB, voffB); PG8_STAGE(PG8_SA(0, 0), a2, voffA);
            PG8_WAIT_V(8); PG8_WAIT_L(0); PG8_BAR; PG8_MMA(1, 0, At, B0); PG8_MMA(1, 1, At, B1); PG8_BAR; PG8_SCHED;
            PG8_LDB(B0, 1, 0); PG8_LDB(B1, 1, 1); PG8_SCHED; PG8_LDA(At, 1, 0); PG8_STAGE(PG8_SA(0, 1), a2 + hstepA, voffA);
            PG8_WAIT_V(8); PG8_WAIT_L(0); PG8_BAR; PG8_MMA(0, 0, At, B0); PG8_MMA(0, 1, At, B1); PG8_BAR; PG8_SCHED;
            PG8_LDA(At, 1, 1); PG8_STAGE(PG8_SB(1, 0), b3, voffB); PG8_STAGE(PG8_SB(1, 1), b3 + hstepB, voffB); PG8_STAGE(PG8_SA(1, 0), a3, voffA);
            PG8_WAIT_V(8); PG8_WAIT_L(0); PG8_BAR; PG8_MMA(1, 0, At, B0); PG8_MMA(1, 1, At, B1); PG8_BAR; PG8_SCHED;
            } else {
            PG8_LDB(B0, 0, 0); PG8_SCHED; PG8_LDA(At, 0, 0); PG8_STAGE(PG8_SA(1, 1), a1 + hstepA, voffA);
            PG8_WAIT_L(8); PG8_BAR; PG8_WAIT_L(0); PG8_MMA(0, 0, At, B0); PG8_BAR; PG8_SCHED;
            PG8_LDB(B1, 0, 1); PG8_STAGE(PG8_SB(0, 0), b2, voffB);
            PG8_BAR; PG8_WAIT_L(0); PG8_MMA(0, 1, At, B1); PG8_BAR;
            PG8_LDA(At, 0, 1); PG8_STAGE(PG8_SA(0, 0), a2, voffA);
            PG8_BAR; PG8_WAIT_L(0); PG8_MMA(1, 0, At, B0); PG8_BAR; PG8_SCHED;
            PG8_STAGE(PG8_SB(0, 1), b2 + hstepB, voffB);
            PG8_WAIT_V(6); PG8_BAR; PG8_MMA(1, 1, At, B1); PG8_BAR;
            PG8_LDB(B0, 1, 0); PG8_SCHED; PG8_LDA(At, 1, 0); PG8_STAGE(PG8_SA(0, 1), a2 + hstepA, voffA);
            PG8_WAIT_L(8); PG8_BAR; PG8_WAIT_L(0); PG8_MMA(0, 0, At, B0); PG8_BAR; PG8_SCHED;
            PG8_LDB(B1, 1, 1); PG8_STAGE(PG8_SB(1, 0), b3, voffB);
            PG8_BAR; PG8_WAIT_L(0); PG8_MMA(0, 1, At, B1); PG8_BAR;
            PG8_LDA(At, 1, 1); PG8_STAGE(PG8_SA(1, 0), a3, voffA);
            PG8_BAR; PG8_WAIT_L(0); PG8_MMA(1, 0, At, B0); PG8_BAR; PG8_SCHED;
            PG8_STAGE(PG8_SB(1, 1), b3 + hstepB, voffB);
            PG8_WAIT_V(6); PG8_BAR; PG8_MMA(1, 1, At, B1); PG8_BAR;
            }
        }
        if constexpr (ALIGN_EPI) { if (wr == 0) PG8_BAR; }
        if constexpr (!Epi::AFTER_DRAIN) E(acc, cur, wr, wc, fr, fq, lds, ui);
        if (!has_next) break;
        cur = nxt; cA = nA; cB = nB; ++ui;
        asm volatile("" : "+v"(lane)); tid = wid * 64 + lane; fr = lane & 15; fq = lane >> 4; PG8_LANE_STATE();
        E.init_acc(acc, cur, wr, wc, fr, fq);
        if constexpr (ALIGN_EPI) { if (wr == 1) PG8_BAR; }
    }
    PG8_WAIT_V(0);
    if constexpr (!ALIGN_EPI) { if (wr == 0) PG8_BAR; }
    PG8_BAR;
    if constexpr (Epi::AFTER_DRAIN) E.fused(acc, cur, wr, wc, fr, fq, lds, tid);
#undef PG8_SA
#undef PG8_SB
#undef PG8_STAGE
#undef PG8_LDA
#undef PG8_LDB
#undef PG8_MMA
#undef PG8_WAIT_V
#undef PG8_WAIT_L
#undef PG8_BAR
#undef PG8_SCHED
#undef PG8_ABASE
#undef PG8_LANE_STATE
#undef PG8_BBASE
}

constexpr unsigned TAB_OFF = 131072u;
__device__ __forceinline__ void row_scan_mul4(float& a, float& b, float& c, float& d) {
#define PG8_SCAN_STEP(n) "v_mul_f32_dpp %0, %0, %0 row_shr:" #n " row_mask:0xf bank_mask:0xf\n" "v_mul_f32_dpp %1, %1, %1 row_shr:" #n " row_mask:0xf bank_mask:0xf\n" \
                         "v_mul_f32_dpp %2, %2, %2 row_shr:" #n " row_mask:0xf bank_mask:0xf\n" "v_mul_f32_dpp %3, %3, %3 row_shr:" #n " row_mask:0xf bank_mask:0xf\n"
    asm("s_nop 1\n" PG8_SCAN_STEP(1) PG8_SCAN_STEP(2) PG8_SCAN_STEP(4) PG8_SCAN_STEP(8) : "+v"(a), "+v"(b), "+v"(c), "+v"(d));
#undef PG8_SCAN_STEP
}
__device__ __forceinline__ void row_scan_add4(float& a, float& b, float& c, float& d) {
#define PG8_SCAN_STEP(n) "v_add_f32_dpp %0, %0, %0 row_shr:" #n " row_mask:0xf bank_mask:0xf\n" "v_add_f32_dpp %1, %1, %1 row_shr:" #n " row_mask:0xf bank_mask:0xf\n" \
                         "v_add_f32_dpp %2, %2, %2 row_shr:" #n " row_mask:0xf bank_mask:0xf\n" "v_add_f32_dpp %3, %3, %3 row_shr:" #n " row_mask:0xf bank_mask:0xf\n"
    asm("s_nop 1\n" PG8_SCAN_STEP(1) PG8_SCAN_STEP(2) PG8_SCAN_STEP(4) PG8_SCAN_STEP(8) : "+v"(a), "+v"(b), "+v"(c), "+v"(d));
#undef PG8_SCAN_STEP
}
__device__ __forceinline__ float row_bcast15(float v) { float r; asm("s_nop 1\n v_mov_b32_dpp %0, %1 row_newbcast:15 row_mask:0xf bank_mask:0xf" : "=v"(r) : "v"(v)); return r; }
template <int W> __device__ __forceinline__ float window_sum(float p, float pp, float c) {
    if constexpr (W == 16) return c - pp;
    else { float w = c;
        if constexpr (W == 8) asm("s_nop 1\n v_subrev_f32_dpp %0, %1, %2 row_shl:8 row_mask:0xf bank_mask:0xf\n v_subrev_f32_dpp %0, %3, %3 row_shr:8 row_mask:0xf bank_mask:0xf" : "+v"(w) : "v"(pp), "v"(c), "v"(p));
        else if constexpr (W == 4) asm("s_nop 1\n v_subrev_f32_dpp %0, %1, %2 row_shl:12 row_mask:0xf bank_mask:0xf\n v_subrev_f32_dpp %0, %3, %3 row_shr:4 row_mask:0xf bank_mask:0xf" : "+v"(w) : "v"(pp), "v"(c), "v"(p));
        else asm("s_nop 1\n v_subrev_f32_dpp %0, %1, %2 row_shl:14 row_mask:0xf bank_mask:0xf\n v_subrev_f32_dpp %0, %3, %3 row_shr:2 row_mask:0xf bank_mask:0xf" : "+v"(w) : "v"(pp), "v"(c), "v"(p));
        return w; }
}
#define PG8_POOL_STEP(SHL, SHR) \
    asm("s_nop 1\n" \
        "v_add_f32_dpp %0, %8, %4 row_shl:" #SHL " row_mask:0xf bank_mask:0xf bound_ctrl:1\n" "v_add_f32_dpp %1, %9, %5 row_shl:" #SHL " row_mask:0xf bank_mask:0xf bound_ctrl:1\n" \
        "v_add_f32_dpp %2, %10, %6 row_shl:" #SHL " row_mask:0xf bank_mask:0xf bound_ctrl:1\n" "v_add_f32_dpp %3, %11, %7 row_shl:" #SHL " row_mask:0xf bank_mask:0xf bound_ctrl:1\n" \
        "v_add_f32_dpp %0, %4, %0 row_shr:" #SHR " row_mask:0xf bank_mask:0xf\n" "v_add_f32_dpp %1, %5, %1 row_shr:" #SHR " row_mask:0xf bank_mask:0xf\n" \
        "v_add_f32_dpp %2, %6, %2 row_shr:" #SHR " row_mask:0xf bank_mask:0xf\n" "v_add_f32_dpp %3, %7, %3 row_shr:" #SHR " row_mask:0xf bank_mask:0xf" \
        : "=&v"(a[0]), "=&v"(a[1]), "=&v"(a[2]), "=&v"(a[3]) : "v"(b[0]), "v"(b[1]), "v"(b[2]), "v"(b[3]), "v"(bp[0]), "v"(bp[1]), "v"(bp[2]), "v"(bp[3]))
template <int K> __device__ __forceinline__ void pool_step4(float (&a)[4], const float (&b)[4], const float (&bp)[4]) {
    if constexpr (K == 1) PG8_POOL_STEP(15, 1); else if constexpr (K == 2) PG8_POOL_STEP(14, 2); else PG8_POOL_STEP(12, 4);
}
#undef PG8_POOL_STEP
#define PG8_HALO_STEP(SHR) \
    asm("s_nop 1\n" "v_add_f32_dpp %0, %4, %4 row_shr:" #SHR " row_mask:0xf bank_mask:0xf bound_ctrl:1\n" "v_add_f32_dpp %1, %5, %5 row_shr:" #SHR " row_mask:0xf bank_mask:0xf bound_ctrl:1\n" \
        "v_add_f32_dpp %2, %6, %6 row_shr:" #SHR " row_mask:0xf bank_mask:0xf bound_ctrl:1\n" "v_add_f32_dpp %3, %7, %7 row_shr:" #SHR " row_mask:0xf bank_mask:0xf bound_ctrl:1" \
        : "=&v"(a[0]), "=&v"(a[1]), "=&v"(a[2]), "=&v"(a[3]) : "v"(b[0]), "v"(b[1]), "v"(b[2]), "v"(b[3]))
template <int K> __device__ __forceinline__ void halo_step4(float (&a)[4], const float (&b)[4]) { if constexpr (K == 1) PG8_HALO_STEP(1); else PG8_HALO_STEP(2); }
#undef PG8_HALO_STEP
struct EpiFold {
    static constexpr bool PERM = true, AFTER_DRAIN = false;
    __device__ __forceinline__ void init_acc(f32x4 (&acc)[2][2][4][2], const Unit&, int, int, int, int) const { zero_acc(acc); }
    __device__ __forceinline__ void prologue(const StaticOrder&, LAS unsigned char*, int) const {}
    bf16_t* WT;
    __device__ __forceinline__ void operator()(f32x4 (&acc)[2][2][4][2], const Unit& u, int wr, int wc, int fr, int fq, LAS unsigned char* lds, int ui) const {
        const unsigned k0 = (unsigned)(u.pn * BM + wc * 32 + 8 * fq);
#pragma unroll
        for (int ai = 0; ai < 2; ++ai)
#pragma unroll
            for (int m = 0; m < 4; ++m) { const unsigned c = (unsigned)(u.pm * BM + ai * HALF + wr * 64 + m * 16 + fr), drow = (c >> 7) * 256u + (c & 127u);
#pragma unroll
                for (int bj = 0; bj < 2; ++bj) { const f32x4 v0 = acc[ai][bj][m][0], v1 = acc[ai][bj][m][1];
                    u32x4 w; w.x = pkbf(v0[0], v0[1]); w.y = pkbf(v0[2], v0[3]); w.z = pkbf(v1[0], v1[1]); w.w = pkbf(v1[2], v1[3]);
                    *(u32x4*)(WT + (size_t)drow * DM + k0 + bj * HALF) = w; } }
    }
};
constexpr unsigned HALO_TILE = 4 * 64 * 16;
struct EpiP1 {
    static constexpr bool PERM = true, AFTER_DRAIN = false;
    __device__ __forceinline__ void init_acc(f32x4 (&acc)[2][2][4][2], const Unit&, int, int, int, int) const { zero_acc(acc); }
    __device__ __forceinline__ void prologue(const StaticOrder&, LAS unsigned char*, int) const {}
    bf16_t* Z; unsigned char* HALO; unsigned char* SG0;
    template <int W> __device__ __forceinline__ void tile(f32x4 (&acc)[2][2][4][2], const Unit& u, int wr, int wc, int fr, int fq, LAS unsigned char* lds) const {
        const unsigned lane = (unsigned)(fq * 16 + fr);
        LAS unsigned char* HX = lds + TAB_OFF;
        const unsigned sideofs = (unsigned)(u.pm * 16 + u.pn) * HALO_TILE + ((unsigned)wc * 64u + lane) * 16u;
#pragma unroll
        for (int ai = 0; ai < 2; ++ai) {
            u32x4 h; h.x = pkbf(acc[ai][0][3][0][0], acc[ai][0][3][0][1]); h.y = pkbf(acc[ai][0][3][0][2], acc[ai][0][3][0][3]); h.z = pkbf(acc[ai][0][3][1][0], acc[ai][0][3][1][1]); h.w = pkbf(acc[ai][0][3][1][2], acc[ai][0][3][1][3]);
            const int sl = 2 * ai + wr;
            if (sl < 3) *(LAS u32x4*)(HX + ((unsigned)(sl * 4 + wc) * 64u + lane) * 16u) = h;
            else *(u32x4*)(HALO + sideofs) = h;
        }
        asm volatile("s_waitcnt lgkmcnt(0)" ::: "memory"); __builtin_amdgcn_s_barrier(); asm volatile("" ::: "memory");
        const bool seq0 = (u.pm & 15) == 0;
        const float invw = 1.0f / (float)W;
        const float inv00 = seq0 ? 1.0f / (float)((fr + 1) < W ? (fr + 1) : W) : invw;
        const unsigned zofs = ((unsigned)(u.pm * BM + wr * 64 + fr) * DI + (unsigned)(u.pn * HD + wc * 32 + 8 * fq)) * 2u;
#pragma unroll
        for (int ai = 0; ai < 2; ++ai) {
            const int sl = 2 * ai + wr;
            float pp[2][4], pt[2][4];
            if (sl > 0) {
                const u32x4 h = *(const LAS u32x4*)(HX + ((unsigned)((sl - 1) * 4 + wc) * 64u + lane) * 16u);
                pp[0][0] = bf_lo(h.x); pp[0][1] = bf_hi(h.x); pp[0][2] = bf_lo(h.y); pp[0][3] = bf_hi(h.y); pp[1][0] = bf_lo(h.z); pp[1][1] = bf_hi(h.z); pp[1][2] = bf_lo(h.w); pp[1][3] = bf_hi(h.w);
#pragma unroll
                for (int n = 0; n < 2; ++n) { row_scan_add4(pp[n][0], pp[n][1], pp[n][2], pp[n][3]);
#pragma unroll
                    for (int j = 0; j < 4; ++j) pt[n][j] = row_bcast15(pp[n][j]); }
            } else {
#pragma unroll
                for (int n = 0; n < 2; ++n)
#pragma unroll
                    for (int j = 0; j < 4; ++j) { pp[n][j] = 0.f; pt[n][j] = 0.f; }
            }
#pragma unroll
            for (int m = 0; m < 4; ++m) {
                const float inv = (sl == 0 && m == 0) ? inv00 : invw;
                float z[2][4], sgv[2][4];
#pragma unroll
                for (int n = 0; n < 2; ++n) {
                    float p[4];
#pragma unroll
                    for (int j = 0; j < 4; ++j) p[j] = acc[ai][0][m][n][j];
                    row_scan_add4(p[0], p[1], p[2], p[3]);
#pragma unroll
                    for (int j = 0; j < 4; ++j) {
                        const float ws = window_sum<W>(p[j], pp[n][j], p[j] + pt[n][j]);
                        sgv[n][j] = silu_pre(acc[ai][1][m][n][j]);
                        z[n][j] = __builtin_fmaf(ws, inv, -acc[ai][0][m][n][j]) * sgv[n][j];
                        pp[n][j] = p[j]; pt[n][j] = row_bcast15(p[j]); }
                }
                u32x4 w; w.x = pkbf(z[0][0], z[0][1]); w.y = pkbf(z[0][2], z[0][3]); w.z = pkbf(z[1][0], z[1][1]); w.w = pkbf(z[1][2], z[1][3]);
                *(u32x4*)((char*)Z + (zofs + (unsigned)((ai * HALF + m * 16) * DI) * 2u)) = w;
                if (sl == 0 && m == 0) { u32x4 g; g.x = pkbf(sgv[0][0], sgv[0][1]); g.y = pkbf(sgv[0][2], sgv[0][3]); g.z = pkbf(sgv[1][0], sgv[1][1]); g.w = pkbf(sgv[1][2], sgv[1][3]);
                    *(u32x4*)(SG0 + sideofs) = g; }
                asm volatile("" ::: "memory");
            }
        }
    }
    template <int W> __device__ __forceinline__ void tile_dbl(f32x4 (&acc)[2][2][4][2], const Unit& u, int wr, int wc, int fr, int fq, LAS unsigned char* lds) const {
        constexpr int NL = (W == 2) ? 1 : (W == 4) ? 2 : 3;
        const unsigned lane = (unsigned)(fq * 16 + fr);
        LAS unsigned char* HX = lds + TAB_OFF;
        const unsigned sideofs = (unsigned)(u.pm * 16 + u.pn) * HALO_TILE + ((unsigned)wc * 64u + lane) * 16u;
#pragma unroll
        for (int ai = 0; ai < 2; ++ai) {
            u32x4 h; h.x = pkbf(acc[ai][0][3][0][0], acc[ai][0][3][0][1]); h.y = pkbf(acc[ai][0][3][0][2], acc[ai][0][3][0][3]); h.z = pkbf(acc[ai][0][3][1][0], acc[ai][0][3][1][1]); h.w = pkbf(acc[ai][0][3][1][2], acc[ai][0][3][1][3]);
            const int sl = 2 * ai + wr;
            if (sl < 3) *(LAS u32x4*)(HX + ((unsigned)(sl * 4 + wc) * 64u + lane) * 16u) = h;
            else *(u32x4*)(HALO + sideofs) = h;
        }
        asm volatile("s_waitcnt lgkmcnt(0)" ::: "memory"); __builtin_amdgcn_s_barrier(); asm volatile("" ::: "memory");
        const bool seq0 = (u.pm & 15) == 0;
        const float invw = 1.0f / (float)W;
        const float inv00 = seq0 ? 1.0f / (float)((fr + 1) < W ? (fr + 1) : W) : invw;
        const unsigned zofs = ((unsigned)(u.pm * BM + wr * 64 + fr) * DI + (unsigned)(u.pn * HD + wc * 32 + 8 * fq)) * 2u;
#pragma unroll
        for (int ai = 0; ai < 2; ++ai) {
            const int sl = 2 * ai + wr;
            float prev[NL][2][4];
            if (sl > 0) {
                const u32x4 h = *(const LAS u32x4*)(HX + ((unsigned)((sl - 1) * 4 + wc) * 64u + lane) * 16u);
                prev[0][0][0] = bf_lo(h.x); prev[0][0][1] = bf_hi(h.x); prev[0][0][2] = bf_lo(h.y); prev[0][0][3] = bf_hi(h.y);
                prev[0][1][0] = bf_lo(h.z); prev[0][1][1] = bf_hi(h.z); prev[0][1][2] = bf_lo(h.w); prev[0][1][3] = bf_hi(h.w);
#pragma unroll
                for (int n = 0; n < 2; ++n) { if constexpr (NL >= 2) halo_step4<1>(prev[1][n], prev[0][n]); if constexpr (NL >= 3) halo_step4<2>(prev[2][n], prev[1][n]); }
            } else {
#pragma unroll
                for (int l = 0; l < NL; ++l)
#pragma unroll
                    for (int n = 0; n < 2; ++n)
#pragma unroll
                        for (int j = 0; j < 4; ++j) prev[l][n][j] = 0.f;
            }
#pragma unroll
            for (int m = 0; m < 4; ++m) {
                const float inv = (sl == 0 && m == 0) ? inv00 : invw;
                float z[2][4], sgv[2][4];
#pragma unroll
                for (int n = 0; n < 2; ++n) {
                    float l0[4], l1[4], l2[4], l3[4];
#pragma unroll
                    for (int j = 0; j < 4; ++j) l0[j] = acc[ai][0][m][n][j];
                    pool_step4<1>(l1, l0, prev[0][n]);
                    if constexpr (NL >= 2) pool_step4<2>(l2, l1, prev[1][n]);
                    if constexpr (NL >= 3) pool_step4<4>(l3, l2, prev[2][n]);
#pragma unroll
                    for (int j = 0; j < 4; ++j) {
                        const float ws = (NL == 1) ? l1[j] : (NL == 2) ? l2[j] : l3[j];
                        sgv[n][j] = silu_pre(acc[ai][1][m][n][j]);
                        z[n][j] = __builtin_fmaf(ws, inv, -l0[j]) * sgv[n][j];
                        prev[0][n][j] = l0[j]; if constexpr (NL >= 2) prev[1][n][j] = l1[j]; if constexpr (NL >= 3) prev[2][n][j] = l2[j]; }
                }
                u32x4 w; w.x = pkbf(z[0][0], z[0][1]); w.y = pkbf(z[0][2], z[0][3]); w.z = pkbf(z[1][0], z[1][1]); w.w = pkbf(z[1][2], z[1][3]);
                *(u32x4*)((char*)Z + (zofs + (unsigned)((ai * HALF + m * 16) * DI) * 2u)) = w;
                if (sl == 0 && m == 0) { u32x4 g; g.x = pkbf(sgv[0][0], sgv[0][1]); g.y = pkbf(sgv[0][2], sgv[0][3]); g.z = pkbf(sgv[1][0], sgv[1][1]); g.w = pkbf(sgv[1][2], sgv[1][3]);
                    *(u32x4*)(SG0 + sideofs) = g; }
                asm volatile("" ::: "memory");
            }
        }
    }
    __device__ __forceinline__ void operator()(f32x4 (&acc)[2][2][4][2], const Unit& u, int wr, int wc, int fr, int fq, LAS unsigned char* lds, int ui) const {
        const int g = u.pn >> 2;
        if (g == 0) tile_dbl<2>(acc, u, wr, wc, fr, fq, lds); else if (g == 1) tile_dbl<4>(acc, u, wr, wc, fr, fq, lds);
        else if (g == 2) tile_dbl<8>(acc, u, wr, wc, fr, fq, lds); else tile<16>(acc, u, wr, wc, fr, fq, lds);
    }
};
template <bool WRITE_HB, bool WRITE_H = true> struct EpiRes {
    static constexpr bool PERM = true, AFTER_DRAIN = false;
    __device__ __forceinline__ void prologue(const StaticOrder&, LAS unsigned char*, int) const {}
    const bf16_t* RB; const float* invr; float* H; bf16_t* HB; float* part;
    __device__ __forceinline__ void init_acc(f32x4 (&acc)[2][2][4][2], const Unit& u, int wr, int wc, int fr, int fq) const {
        const unsigned row0 = (unsigned)(u.pm * BM + wr * 64 + fr), col0 = (unsigned)(u.pn * BM + wc * 32 + 8 * fq);
        const unsigned ofs = (row0 * DM + col0) * 2u;
#pragma unroll
        for (int ai = 0; ai < 2; ++ai)
#pragma unroll
            for (int m = 0; m < 4; ++m) { const float ir = invr[row0 + (unsigned)(ai * HALF + m * 16)];
#pragma unroll
                for (int bj = 0; bj < 2; ++bj) { const u32x4 r = __builtin_nontemporal_load((const u32x4*)((const char*)RB + (ofs + (unsigned)((ai * HALF + m * 16) * DM + bj * HALF) * 2u)));
                    acc[ai][bj][m][0] = (f32x4){bf_lo(r.x) * ir, bf_hi(r.x) * ir, bf_lo(r.y) * ir, bf_hi(r.y) * ir};
                    acc[ai][bj][m][1] = (f32x4){bf_lo(r.z) * ir, bf_hi(r.z) * ir, bf_lo(r.w) * ir, bf_hi(r.w) * ir}; } }
    }
    __device__ __forceinline__ void operator()(f32x4 (&acc)[2][2][4][2], const Unit& u, int wr, int wc, int fr, int fq, LAS unsigned char* lds, int ui) const {
        const unsigned row0 = (unsigned)(u.pm * BM + wr * 64 + fr), col0 = (unsigned)(u.pn * BM + wc * 32 + 8 * fq);
        const unsigned ofs = (row0 * DM + col0) * 4u, pofs = (row0 * 16u + (unsigned)(u.pn * 4 + wc)) * 4u;
#pragma unroll
        for (int ai = 0; ai < 2; ++ai)
#pragma unroll
            for (int m = 0; m < 4; ++m) { const unsigned o = ofs + (unsigned)((ai * HALF + m * 16) * DM) * 4u; float ss = 0.f;
#pragma unroll
                for (int bj = 0; bj < 2; ++bj) { const unsigned oo = o + (unsigned)(bj * HALF) * 4u; const f32x4 h0 = acc[ai][bj][m][0], h1 = acc[ai][bj][m][1];
                    if (WRITE_H) { *(f32x4*)((char*)H + oo) = h0; *(f32x4*)((char*)H + oo + 16u) = h1; }
                    ss += ((h0[0] * h0[0] + h0[1] * h0[1]) + (h0[2] * h0[2] + h0[3] * h0[3])) + ((h1[0] * h1[0] + h1[1] * h1[1]) + (h1[2] * h1[2] + h1[3] * h1[3]));
                    if (WRITE_HB) { u32x4 w; w.x = pkbf(h0[0], h0[1]); w.y = pkbf(h0[2], h0[3]); w.z = pkbf(h1[0], h1[1]); w.w = pkbf(h1[2], h1[3]); *(u32x4*)((char*)HB + (oo >> 1)) = w; } }
                ss += xor_get(ss, fq * 16 + fr, 16); ss += xor_get(ss, fq * 16 + fr, 32);
                if (fq == 0) *(float*)((char*)part + (pofs + (unsigned)(ai * HALF + m * 16) * 64u)) = ss; }
    }
};
__device__ __forceinline__ float row_rstd_b(const float* part, unsigned bofs) {
    const f32x4* p = (const f32x4*)((const char*)part + bofs); const f32x4 a = p[0], b = p[1], c = p[2], d = p[3];
    return __builtin_amdgcn_rsqf((((a[0] + a[1]) + (a[2] + a[3])) + ((b[0] + b[1]) + (b[2] + b[3])) + ((c[0] + c[1]) + (c[2] + c[3])) + ((d[0] + d[1]) + (d[2] + d[3]))) * (1.0f / DM) + EPS);
}
struct EpiP4 {
    static constexpr bool PERM = true, AFTER_DRAIN = false;
    __device__ __forceinline__ void init_acc(f32x4 (&acc)[2][2][4][2], const Unit&, int, int, int, int) const { zero_acc(acc); }
    bf16_t* Qt; bf16_t* Kt; bf16_t* V; float* DEC; const float* part; const float* lbnd;
    __device__ __forceinline__ void prologue(const StaticOrder& S, LAS unsigned char* lds, int tid) const {
        LAS float* T = (LAS float*)(lds + TAB_OFF); Unit u;
        for (int i = 0; i < 12 && S.next(i, u); ++i) {
            if (tid < 256) T[i * 256 + tid] = row_rstd_b(part, (unsigned)(u.pm * BM + tid) * 64u);
            else if (u.pn < 16) {
                const int c = tid - 256, ch = u.pn * HD + (c & 127);
                const float ex = __expf(lbnd[ch] - lbnd[DI + ch]), lb = __builtin_amdgcn_rcpf(1.0f + ex);
                T[3072 + i * 256 + c] = (c < 128) ? lb : ex * lb; }
        }
        __syncthreads();
    }
    __device__ __forceinline__ void operator()(f32x4 (&acc)[2][2][4][2], const Unit& u, int wr, int wc, int fr, int fq, LAS unsigned char* lds, int ui) const {
        const unsigned row0 = (unsigned)(u.pm * BM + wr * 64 + fr);
        const LAS float* T = (const LAS float*)(lds + TAB_OFF) + ui * 256 + wr * 64 + fr;
        if (u.pn >= 16) {
            const unsigned vofs = (row0 * DI + (unsigned)((u.pn - 16) * BM + wc * 32 + 8 * fq)) * 2u;
#pragma unroll
            for (int ai = 0; ai < 2; ++ai)
#pragma unroll
                for (int m = 0; m < 4; ++m) { const float rs = T[ai * HALF + m * 16];
#pragma unroll
                    for (int bj = 0; bj < 2; ++bj) { const f32x4 v0 = acc[ai][bj][m][0] * rs, v1 = acc[ai][bj][m][1] * rs;
                        u32x4 w; w.x = pkbf(v0[0], v0[1]); w.y = pkbf(v0[2], v0[3]); w.z = pkbf(v1[0], v1[1]); w.w = pkbf(v1[2], v1[3]);
                        __builtin_nontemporal_store(w, (u32x4*)((char*)V + (vofs + (unsigned)((ai * HALF + m * 16) * DI + bj * HALF) * 2u))); } }
            return;
        }
        const unsigned c0 = (unsigned)(u.pn * HD + wc * 32 + 8 * fq);
        const unsigned qofs = (row0 * DI + c0) * 2u;
        const LAS float* LB = (const LAS float*)(lds + TAB_OFF) + 3072 + ui * 256 + wc * 32 + 8 * fq;
#pragma unroll
        for (int ai = 0; ai < 2; ++ai) {
            float rs[4], rz[4];
#pragma unroll
            for (int m = 0; m < 4; ++m) { rs[m] = T[ai * HALF + m * 16]; rz[m] = -1.44269504089f * rs[m]; }
            float bp[2][4]; f32x4 decv[2];
#pragma unroll
            for (int m = 0; m < 4; ++m) {
#pragma unroll
                for (int n = 0; n < 2; ++n) {
                    const f32x4 lbv = *(const LAS f32x4*)(LB + 4 * n), omv = *(const LAS f32x4*)(LB + 128 + 4 * n);
                    float s[4], k[4];
#pragma unroll
                    for (int j = 0; j < 4; ++j) {
                        const float sg = __builtin_amdgcn_rcpf(1.0f + __builtin_amdgcn_exp2f(acc[ai][1][m][n][j] * rz[m]));
                        s[j] = __builtin_fmaf(omv[j], sg, lbv[j]); k[j] = __builtin_fmaf(-omv[j], sg, omv[j]); }
                    row_scan_mul4(s[0], s[1], s[2], s[3]);
#pragma unroll
                    for (int j = 0; j < 4; ++j) {
                        const float E = (m == 0) ? s[j] : s[j] * bp[n][j];
                        if (m < 3) { const float tot = lane_get(s[j], fq * 16 + 15); bp[n][j] = (m == 0) ? tot : bp[n][j] * tot; }
                        const float Ei = __builtin_amdgcn_rcpf(fmaxf(E, 7.9e-31f));
                        acc[ai][0][m][n][j] = acc[ai][0][m][n][j] * (rs[m] * E); acc[ai][1][m][n][j] = k[j] * Ei;
                        if (m == 3) decv[n][j] = E; }
                }
                const unsigned ob = qofs + (unsigned)((ai * HALF + m * 16) * DI) * 2u;
                u32x4 w; w.x = pkbf(acc[ai][0][m][0][0], acc[ai][0][m][0][1]); w.y = pkbf(acc[ai][0][m][0][2], acc[ai][0][m][0][3]); w.z = pkbf(acc[ai][0][m][1][0], acc[ai][0][m][1][1]); w.w = pkbf(acc[ai][0][m][1][2], acc[ai][0][m][1][3]);
                __builtin_nontemporal_store(w, (u32x4*)((char*)Qt + ob));
                u32x4 x; x.x = pkbf(acc[ai][1][m][0][0], acc[ai][1][m][0][1]); x.y = pkbf(acc[ai][1][m][0][2], acc[ai][1][m][0][3]); x.z = pkbf(acc[ai][1][m][1][0], acc[ai][1][m][1][1]); x.w = pkbf(acc[ai][1][m][1][2], acc[ai][1][m][1][3]);
                __builtin_nontemporal_store(x, (u32x4*)((char*)Kt + ob));
                asm volatile("" ::: "memory");
            }
            if (fr == 15) { float* dp = (float*)((char*)DEC + ((unsigned)(u.pm * 4 + ai * 2 + wr) * DI + c0) * 4u); *(f32x4*)dp = decv[0]; *(f32x4*)(dp + 4) = decv[1]; }
            asm volatile("" ::: "memory");
        }
    }
};
struct EpiP5b {
    static constexpr bool PERM = true, AFTER_DRAIN = false;
    __device__ __forceinline__ void init_acc(f32x4 (&acc)[2][2][4][2], const Unit&, int, int, int, int) const { zero_acc(acc); }
    bf16_t* O; const float* part; const float* ss;
    __device__ __forceinline__ void prologue(const StaticOrder& S, LAS unsigned char* lds, int tid) const {
        LAS float* T = (LAS float*)(lds + TAB_OFF); Unit u;
        for (int i = 0; i < 4 && S.next(i, u); ++i) {
            if (tid < 256) T[i * 768 + tid] = row_rstd_b(part, (unsigned)(u.pm * BM + tid) * 64u);
            { const int r = tid >> 1, hh = tid & 1; const f32x4* sp = (const f32x4*)(ss + (size_t)(u.pm * BM + r) * 128 + (u.pn * 2 + hh) * 8); const f32x4 s0 = sp[0], s1 = sp[1];
              T[i * 768 + 256 + tid] = __builtin_amdgcn_rsqf((((s0[0] + s0[1]) + (s0[2] + s0[3])) + ((s1[0] + s1[1]) + (s1[2] + s1[3]))) * (1.0f / HD) + EPS); }
        }
        __syncthreads();
    }
    __device__ __forceinline__ void operator()(f32x4 (&acc)[2][2][4][2], const Unit& u, int wr, int wc, int fr, int fq, LAS unsigned char* lds, int ui) const {
        const unsigned row0 = (unsigned)(u.pm * BM + wr * 64 + fr), col0 = (unsigned)(u.pn * BM + wc * 32 + 8 * fq);
        const LAS float* T = (const LAS float*)(lds + TAB_OFF) + ui * 768 + wr * 64 + fr;
        const unsigned oofs = (row0 * DI + col0) * 2u;
        u32x4 ov[4][2][2];
#define P5B_LOAD(gq) do { _Pragma("unroll") for (int mm = 0; mm < 2; ++mm) _Pragma("unroll") for (int bj = 0; bj < 2; ++bj) \
            ov[gq][mm][bj] = *(const u32x4*)((const char*)O + (oofs + (unsigned)((((gq) >> 1) * HALF + (((gq) & 1) * 2 + mm) * 16) * DI + bj * HALF) * 2u)); } while (0)
        P5B_LOAD(0); P5B_LOAD(1); P5B_LOAD(2);
        asm volatile("" ::: "memory");
#pragma unroll
        for (int gq = 0; gq < 4; ++gq) {
            const int ai = gq >> 1;
#pragma unroll
            for (int mm = 0; mm < 2; ++mm) { const int m = (gq & 1) * 2 + mm; const int rl = ai * HALF + m * 16; const float rs = T[rl];
#pragma unroll
                for (int bj = 0; bj < 2; ++bj) { const f32x4 v0 = acc[ai][bj][m][0] * rs, v1 = acc[ai][bj][m][1] * rs;
                    const float rh = T[256 + 2 * rl + bj + (wr * 64 + fr)];
                    const u32x4 s = ov[gq][mm][bj];
                    u32x4 w; w.x = pkbf(bf_lo(s.x) * rh * silu_pre(v0[0]), bf_hi(s.x) * rh * silu_pre(v0[1])); w.y = pkbf(bf_lo(s.y) * rh * silu_pre(v0[2]), bf_hi(s.y) * rh * silu_pre(v0[3]));
                    w.z = pkbf(bf_lo(s.z) * rh * silu_pre(v1[0]), bf_hi(s.z) * rh * silu_pre(v1[1])); w.w = pkbf(bf_lo(s.w) * rh * silu_pre(v1[2]), bf_hi(s.w) * rh * silu_pre(v1[3]));
                    *(u32x4*)((char*)O + (oofs + (unsigned)((ai * HALF + m * 16) * DI + bj * HALF) * 2u)) = w; } }
            asm volatile("" ::: "memory");
            if (gq == 0) { P5B_LOAD(3); asm volatile("" ::: "memory"); }
        }
#undef P5B_LOAD
    }
};
struct EpiFinal {
    static constexpr bool PERM = true, AFTER_DRAIN = false;
    __device__ __forceinline__ void init_acc(f32x4 (&acc)[2][2][4][2], const Unit&, int, int, int, int) const { zero_acc(acc); }
    const bf16_t* HB; float* H; const float* fg; float* X; unsigned* cnt;
    __device__ __forceinline__ void prologue(const StaticOrder&, LAS unsigned char*, int) const {}
    __device__ __forceinline__ void operator()(f32x4 (&acc)[2][2][4][2], const Unit& u, int wr, int wc, int fr, int fq, LAS unsigned char* lds, int ui) const {
        LAS float* Pt = (LAS float*)(lds + TAB_OFF);
        LAS float* St = Pt + 1024;
        const int tid = (wr * 4 + wc) * 64 + fq * 16 + fr;
        const unsigned row0 = (unsigned)(u.pm * BM + wr * 64 + fr), col0 = (unsigned)(u.pn * BM + wc * 32 + 8 * fq);
        const unsigned ofs = (row0 * DM + col0) * 4u;
#pragma unroll
        for (int ai = 0; ai < 2; ++ai) {
            u32x4 hv[4][2];
#pragma unroll
            for (int m = 0; m < 4; ++m)
#pragma unroll
                for (int bj = 0; bj < 2; ++bj) hv[m][bj] = *(const u32x4*)((const char*)HB + ((ofs + (unsigned)((ai * HALF + m * 16) * DM + bj * HALF) * 4u) >> 1));
#pragma unroll
            for (int m = 0; m < 4; ++m) { float ss = 0.f;
#pragma unroll
                for (int bj = 0; bj < 2; ++bj) { const u32x4 hb = hv[m][bj];
                    const f32x4 h0 = acc[ai][bj][m][0] + (f32x4){bf_lo(hb.x), bf_hi(hb.x), bf_lo(hb.y), bf_hi(hb.y)}, h1 = acc[ai][bj][m][1] + (f32x4){bf_lo(hb.z), bf_hi(hb.z), bf_lo(hb.w), bf_hi(hb.w)};
                    acc[ai][bj][m][0] = h0; acc[ai][bj][m][1] = h1;
                    ss += ((h0[0] * h0[0] + h0[1] * h0[1]) + (h0[2] * h0[2] + h0[3] * h0[3])) + ((h1[0] * h1[0] + h1[1] * h1[1]) + (h1[2] * h1[2] + h1[3] * h1[3])); }
                ss += xor_get(ss, fq * 16 + fr, 16); ss += xor_get(ss, fq * 16 + fr, 32);
                if (fq == 0) Pt[(ai * HALF + wr * 64 + m * 16 + fr) * 4 + wc] = ss; }
            asm volatile("" ::: "memory"); }
        __syncthreads();
        float* xs = X + (size_t)u.pm * 1024;
        if (tid < 256) { const f32x4 p = *(const LAS f32x4*)(Pt + tid * 4);
            __hip_atomic_store(xs + u.pn * 256 + tid, (p[0] + p[1]) + (p[2] + p[3]), __ATOMIC_RELAXED, __HIP_MEMORY_SCOPE_AGENT); }
        asm volatile("s_waitcnt vmcnt(0)" ::: "memory");
        __syncthreads();
        if (tid == 0) {
            unsigned* c = cnt + 16 * u.pm;
            __hip_atomic_fetch_add(c, 1u, __ATOMIC_RELAXED, __HIP_MEMORY_SCOPE_AGENT);
            unsigned spins = 0;
            while (__hip_atomic_load(c, __ATOMIC_RELAXED, __HIP_MEMORY_SCOPE_AGENT) < 4u) { __builtin_amdgcn_s_sleep(2); if (++spins > (1u << 22)) break; }
            __builtin_amdgcn_fence(__ATOMIC_ACQUIRE, "agent");
            asm volatile("s_waitcnt vmcnt(0)" ::: "memory");
        }
        __syncthreads();
        if (tid < 256) { float s = 0.f;
#pragma unroll
            for (int t = 0; t < 4; ++t) s += __hip_atomic_load(xs + t * 256 + tid, __ATOMIC_RELAXED, __HIP_MEMORY_SCOPE_AGENT);
            St[tid] = __builtin_amdgcn_rsqf(s * (1.0f / DM) + EPS); }
        __syncthreads();
        f32x4 gv[2][2];
#pragma unroll
        for (int bj = 0; bj < 2; ++bj)
#pragma unroll
            for (int n = 0; n < 2; ++n) gv[bj][n] = *(const f32x4*)(fg + col0 + bj * HALF + n * 4);
#pragma unroll
        for (int ai = 0; ai < 2; ++ai)
#pragma unroll
            for (int m = 0; m < 4; ++m) { const float rs = St[ai * HALF + wr * 64 + m * 16 + fr];
#pragma unroll
                for (int bj = 0; bj < 2; ++bj) { const unsigned oo = ofs + (unsigned)((ai * HALF + m * 16) * DM + bj * HALF) * 4u;
                    *(f32x4*)((char*)H + oo) = acc[ai][bj][m][0] * rs * gv[bj][0]; *(f32x4*)((char*)H + oo + 16u) = acc[ai][bj][m][1] * rs * gv[bj][1]; } }
        __syncthreads();
    }
};
}

namespace scan {
#define MFMA16(a, b, c) __builtin_amdgcn_mfma_f32_16x16x32_bf16((a), (b), (c), 0, 0, 0)
__device__ __forceinline__ unsigned offb(unsigned row, unsigned ch) { return 256u * row + 16u * (ch ^ (((row & 3u) << 2) | ((row >> 2) & 3u))); }
__device__ __forceinline__ unsigned voffv(unsigned r, unsigned cp) { return 128u * r + 32u * (cp ^ (((r >> 1) & 3u) ^ (((r >> 3) & 1u) << 1))); }
__device__ __forceinline__ void tr8(unsigned a0, unsigned a1, unsigned c0, unsigned c1, bf16x8& f00, bf16x8& f01, bf16x8& f10, bf16x8& f11) {
    u32x2 r0, r1, r2, r3, r4, r5, r6, r7;
    asm volatile("ds_read_b64_tr_b16 %0, %8\n\tds_read_b64_tr_b16 %1, %9\n\tds_read_b64_tr_b16 %2, %8 offset:8192\n\tds_read_b64_tr_b16 %3, %9 offset:8192\n\t"
                 "ds_read_b64_tr_b16 %4, %10\n\tds_read_b64_tr_b16 %5, %11\n\tds_read_b64_tr_b16 %6, %10 offset:8192\n\tds_read_b64_tr_b16 %7, %11 offset:8192\n\ts_waitcnt lgkmcnt(0)"
                 : "=&v"(r0), "=&v"(r1), "=&v"(r2), "=&v"(r3), "=&v"(r4), "=&v"(r5), "=&v"(r6), "=&v"(r7) : "v"(a0), "v"(a1), "v"(c0), "v"(c1) : "memory");
    const u32x4 x00 = {r0.x, r0.y, r1.x, r1.y}, x01 = {r2.x, r2.y, r3.x, r3.y}, x10 = {r4.x, r4.y, r5.x, r5.y}, x11 = {r6.x, r6.y, r7.x, r7.y};
    f00 = __builtin_bit_cast(bf16x8, x00); f01 = __builtin_bit_cast(bf16x8, x01); f10 = __builtin_bit_cast(bf16x8, x10); f11 = __builtin_bit_cast(bf16x8, x11);
}
__device__ __forceinline__ bf16x8 pack8(const f32x4 a, const f32x4 b) { const u32x4 r = {pkbf(a[0], a[1]), pkbf(a[2], a[3]), pkbf(b[0], b[1]), pkbf(b[2], b[3])}; return __builtin_bit_cast(bf16x8, r); }
__device__ __forceinline__ u32x2 tr_issue(unsigned a) { u32x2 r; asm volatile("ds_read_b64_tr_b16 %0, %1" : "=v"(r) : "v"(a) : "memory"); return r; }
__device__ __forceinline__ u32x2 tr_issue8k(unsigned a) { u32x2 r; asm volatile("ds_read_b64_tr_b16 %0, %1 offset:8192" : "=v"(r) : "v"(a) : "memory"); return r; }
__device__ __forceinline__ bf16x8 frag2(const u32x2 lo, const u32x2 hi) { const u32x4 r = {lo.x, lo.y, hi.x, hi.y}; return __builtin_bit_cast(bf16x8, r); }
__device__ __forceinline__ u32x2 at_tile(LAS unsigned char* lds, unsigned QI, unsigned KI, int it, int j, unsigned l15, unsigned g) {
    f32x4 c = (f32x4){0.f, 0.f, 0.f, 0.f};
#pragma unroll
    for (int kd = 0; kd < 4; ++kd) { const bf16x8 qb = *(const LAS bf16x8*)(lds + QI + offb(16u * (unsigned)it + l15, 4u * kd + g)), a = *(const LAS bf16x8*)(lds + KI + offb(16u * (unsigned)j + l15, 4u * kd + g)); c = MFMA16(a, qb, c); }
    if (j == it) {
#pragma unroll
        for (int r = 0; r < 4; ++r) c[r] = (4u * g + r <= l15) ? c[r] : 0.f; }
    const u32x2 w = {pkbf(c[0], c[1]), pkbf(c[2], c[3])}; return w;
}
template <int NK>
__device__ __forceinline__ f32x4 o_part(LAS unsigned char* lds, unsigned QI, int it, const bf16x8 (&at)[NK], const bf16x8 (&vf)[2], const bf16x8 so0, const bf16x8 so1, const bf16x8 sp0, const bf16x8 sp1, int th, unsigned l15, unsigned g) {
    const unsigned trow = 16u * (unsigned)it + l15;
    f32x4 o = (f32x4){0.f, 0.f, 0.f, 0.f};
#pragma unroll
    for (int ks = 0; ks < NK; ++ks) if (2 * ks <= it) o = MFMA16(vf[ks], at[ks], o);
#pragma unroll
    for (int j = 0; j < 4; ++j) {
        const unsigned kd = (j < 2) ? (2u * (unsigned)th + j) : (2u * (unsigned)(1 - th) + (j - 2));
        const u32x2 q0 = *(const LAS u32x2*)(lds + QI + offb(trow, 4u * kd + (g >> 1)) + 8u * (g & 1)), q1 = *(const LAS u32x2*)(lds + QI + offb(trow, 4u * kd + 2u + (g >> 1)) + 8u * (g & 1));
        o = MFMA16(j == 0 ? so0 : j == 1 ? so1 : j == 2 ? sp0 : sp1, frag2(q0, q1), o); }
    return o;
}
__device__ __forceinline__ void phase(LAS unsigned char* lds, const bf16_t* Qt, const bf16_t* Kt, bf16_t* VO, const float* DEC, float* ss8, int bid, int G, int wave) {
    const unsigned lane = (unsigned)fresh_lane_id(), l15 = lane & 15u, g = lane >> 4, ql = l15 >> 2, p = lane & 3u;
    const unsigned vs = (unsigned)wave & 3u; const int th = wave >> 2, tA = th ? 1 : 0, tB = th ? 2 : 3;
    const unsigned ldsb = (unsigned)(uintptr_t)lds;
    constexpr unsigned QKB = 32768u, VRING = 3u * QKB, DECB = VRING + 2u * 8192u, SFB = DECB + 1536u, ATB = SFB + 32768u;
    static_assert(ATB + 2u * 5120u <= XST_OFF, "scan LDS map");
    unsigned qoff[2], voff_, doff;
#pragma unroll
    for (int i = 0; i < 2; ++i) { const unsigned j = 2u * (unsigned)wave + i, r = 4u * j + (lane >> 4), pc = lane & 15u, ch = pc ^ (((r & 3u) << 2) | ((r >> 2) & 3u)); qoff[i] = (r * DI + ch * 8u) * 2u; }
    { const unsigned r = 8u * (unsigned)wave + (lane >> 3), s16 = lane & 7u, ul = (s16 >> 1) ^ (((r >> 1) & 3u) ^ (((r >> 3) & 1u) << 1)); voff_ = (r * DI + (ul * 2u + (s16 & 1u)) * 8u) * 2u; }
    doff = (64u * ((unsigned)wave & 1u) + lane) * 4u;
    const int my_it = wave == 0 ? 0 : wave <= 2 ? 1 : wave <= 5 ? 2 : 3, my_j = wave == 0 ? 0 : wave <= 2 ? wave - 1 : wave <= 5 ? wave - 3 : wave - 6;
    for (int item = bid; item < BATCH * NHEAD * 2; item += G) {
        const int half = (item >> 3) & 1, pair = (item & 7) | ((item >> 4) << 3), b = pair >> 4, h = pair & 15;
        const size_t tokb = (size_t)b * SEQ;
        const char* qg = (const char*)(Qt + tokb * DI + h * HD);
        const char* kg = (const char*)(Kt + tokb * DI + h * HD);
        bf16_t* vg = VO + tokb * DI + h * HD + half * 64;
        const char* dg = (const char*)(DEC + (size_t)(b * (SEQ / 64)) * DI + h * HD);
        f32x4 S[4];
        bf16x8 so0 = (bf16x8){0, 0, 0, 0, 0, 0, 0, 0}, so1 = so0, sp0 = so0, sp1 = so0;
#pragma unroll
        for (int i = 0; i < 4; ++i) S[i] = (f32x4){0.f, 0.f, 0.f, 0.f};
#define SC_DMA_QK(c_) do { const size_t o_ = (size_t)(c_) * 64 * DI * 2; const unsigned base_ = ((unsigned)(c_) % 3u) * QKB; \
            __builtin_amdgcn_global_load_lds((const unsigned*)(qg + o_ + qoff[0]), (LAS unsigned*)(lds + base_ + (unsigned)wave * 2048u), 16, 0, 0); \
            __builtin_amdgcn_global_load_lds((const unsigned*)(qg + o_ + qoff[1]), (LAS unsigned*)(lds + base_ + (unsigned)wave * 2048u + 1024u), 16, 0, 0); \
            __builtin_amdgcn_global_load_lds((const unsigned*)(kg + o_ + qoff[0]), (LAS unsigned*)(lds + base_ + 16384u + (unsigned)wave * 2048u), 16, 0, 0); \
            __builtin_amdgcn_global_load_lds((const unsigned*)(kg + o_ + qoff[1]), (LAS unsigned*)(lds + base_ + 16384u + (unsigned)wave * 2048u + 1024u), 16, 0, 0); \
            __builtin_amdgcn_global_load_lds((const unsigned*)(dg + (size_t)(c_) * DI * 4 + doff), (LAS unsigned*)(lds + DECB + ((unsigned)(c_) % 3u) * 512u + ((unsigned)wave & 1u) * 256u), 4, 0, 0); } while (0)
#define SC_DMA_V(c_) __builtin_amdgcn_global_load_lds((const unsigned*)((const char*)vg + (size_t)(c_) * 64 * DI * 2 + voff_), (LAS unsigned*)(lds + VRING + ((unsigned)(c_) & 1u) * 8192u + (unsigned)wave * 1024u), 16, 0, 0)
#define SC_AT(c_) do { LAS u32x2* atw = (LAS u32x2*)(lds + ATB + (unsigned)((c_) & 1) * 5120u) + lane; const unsigned b_ = ((unsigned)(c_) % 3u) * QKB; \
            atw[64 * wave] = at_tile(lds, b_, b_ + 16384u, my_it, my_j, l15, g); \
            if (wave < 2) atw[64 * (8 + wave)] = at_tile(lds, b_, b_ + 16384u, 3, 2 + wave, l15, g); } while (0)
        SC_DMA_QK(0); SC_DMA_QK(1); SC_DMA_V(0); SC_DMA_V(1);
        asm volatile("s_waitcnt vmcnt(0)" ::: "memory");
        __builtin_amdgcn_s_barrier();
        SC_AT(0);
        asm volatile("s_waitcnt lgkmcnt(0)" ::: "memory");
        __builtin_amdgcn_s_barrier();
        for (int n = 0; n < SEQ / 64; ++n) {
            const unsigned QI = ((unsigned)n % 3u) * QKB, KI = QI + 16384u, VI = VRING + ((unsigned)n & 1u) * 8192u;
            if (n + 2 < SEQ / 64) SC_DMA_QK(n + 2);
            if (n > 0) { const LAS bf16x8* sfr = (const LAS bf16x8*)(lds + SFB + ((unsigned)n & 1u) * 16384u + (unsigned)(wave ^ 4) * 2048u) + lane;
                sp0 = sfr[0]; sp1 = sfr[64]; }
            u32x2 tv0, tv1, tv2, tv3, tv4, tv5, tv6, tv7;
            {
                const unsigned va = ldsb + VI + 8u * p;
                tv0 = tr_issue(va + voffv(4u * g + ql, vs)); tv1 = tr_issue(va + voffv(16u + 4u * g + ql, vs)); tv2 = tr_issue(va + voffv(32u + 4u * g + ql, vs)); tv3 = tr_issue(va + voffv(48u + 4u * g + ql, vs));
                tv4 = tr_issue(va + voffv(8u * g + ql, vs)); tv5 = tr_issue(va + voffv(8u * g + 4u + ql, vs)); tv6 = tr_issue(va + voffv(32u + 8u * g + ql, vs)); tv7 = tr_issue(va + voffv(36u + 8u * g + ql, vs));
            }
            bf16x8 atB[2], atA[1];
            { const LAS u32x2* atr = (const LAS u32x2*)(lds + ATB + (unsigned)(n & 1) * 5120u) + lane; const u32x2 z2 = {0u, 0u};
              if (th == 0) { atB[0] = frag2(atr[64 * 6], atr[64 * 7]); atB[1] = frag2(atr[64 * 8], atr[64 * 9]); atA[0] = frag2(atr[0], z2); }
              else         { atB[0] = frag2(atr[64 * 3], atr[64 * 4]); atB[1] = frag2(atr[64 * 5], z2);          atA[0] = frag2(atr[64 * 1], atr[64 * 2]); } }
            const unsigned ka = (ldsb + KI + offb(8u * g + ql, (p >> 1)) + 8u * (p & 1u)) ^ ((unsigned)th << 7), kb = (ldsb + KI + offb(8u * g + 4u + ql, (p >> 1)) + 8u * (p & 1u)) ^ ((unsigned)th << 7);
            const u32x2 ka0 = tr_issue(ka), kb0 = tr_issue(kb), ka0h = tr_issue8k(ka), kb0h = tr_issue8k(kb);
            const u32x2 ka1 = tr_issue(ka ^ 32u), kb1 = tr_issue(kb ^ 32u), ka1h = tr_issue8k(ka ^ 32u), kb1h = tr_issue8k(kb ^ 32u);
            const u32x2 ka2 = tr_issue(ka ^ 64u), kb2 = tr_issue(kb ^ 64u), ka2h = tr_issue8k(ka ^ 64u), kb2h = tr_issue8k(kb ^ 64u);
            const u32x2 ka3 = tr_issue(ka ^ 96u), kb3 = tr_issue(kb ^ 96u), ka3h = tr_issue8k(ka ^ 96u), kb3h = tr_issue8k(kb ^ 96u);
            u32x2 kq[16] = {ka0, kb0, ka0h, kb0h, ka1, kb1, ka1h, kb1h, ka2, kb2, ka2h, kb2h, ka3, kb3, ka3h, kb3h};
            if (n < SEQ / 64 - 2) asm volatile("s_waitcnt vmcnt(10)" ::: "memory"); else asm volatile("s_waitcnt vmcnt(0)" ::: "memory");
            asm volatile("s_waitcnt lgkmcnt(0)" : "+v"(tv0), "+v"(tv1), "+v"(tv2), "+v"(tv3), "+v"(tv4), "+v"(tv5), "+v"(tv6), "+v"(tv7),
                         "+v"(kq[0]), "+v"(kq[1]), "+v"(kq[2]), "+v"(kq[3]), "+v"(kq[4]), "+v"(kq[5]), "+v"(kq[6]), "+v"(kq[7]),
                         "+v"(kq[8]), "+v"(kq[9]), "+v"(kq[10]), "+v"(kq[11]), "+v"(kq[12]), "+v"(kq[13]), "+v"(kq[14]), "+v"(kq[15]) :: "memory");
            __builtin_amdgcn_s_barrier();
            if (n + 2 < SEQ / 64) SC_DMA_V(n + 2);
            if (n + 1 < SEQ / 64) SC_AT(n + 1);
            __builtin_amdgcn_sched_barrier(0);
            const bf16x8 vf[2] = {frag2(tv0, tv1), frag2(tv2, tv3)};
            const f32x4 oB = o_part<2>(lds, QI, tB, atB, vf, so0, so1, sp0, sp1, th, l15, g);
            const f32x4 oA = o_part<1>(lds, QI, tA, atA, vf, so0, so1, sp0, sp1, th, l15, g);
            {
                const bf16x8 vn0 = frag2(tv4, tv5), vn1 = frag2(tv6, tv7);
                const LAS float* dcp = (const LAS float*)(lds + DECB + ((unsigned)n % 3u) * 512u) + 4u * g + 64u * (unsigned)th;
#pragma unroll
                for (int i = 0; i < 4; i += 2) {
                    const bf16x8 k00 = frag2(kq[4 * i], kq[4 * i + 1]), k01 = frag2(kq[4 * i + 2], kq[4 * i + 3]), k10 = frag2(kq[4 * i + 4], kq[4 * i + 5]), k11 = frag2(kq[4 * i + 6], kq[4 * i + 7]);
                    S[i] = MFMA16(k00, vn0, S[i]); S[i + 1] = MFMA16(k10, vn0, S[i + 1]); S[i] = MFMA16(k01, vn1, S[i]); S[i + 1] = MFMA16(k11, vn1, S[i + 1]); }
#pragma unroll
                for (int i = 0; i < 4; ++i) { const f32x4 dc = *(const LAS f32x4*)(dcp + 16 * i); S[i] = S[i] * dc; }
                const bf16x8 f0 = pack8(S[0], S[1]), f1 = pack8(S[2], S[3]);
                so0 = f0; so1 = f1;
                LAS bf16x8* sfw = (LAS bf16x8*)(lds + SFB + ((unsigned)(n + 1) & 1u) * 16384u + (unsigned)wave * 2048u) + lane;
                sfw[0] = f0; sfw[64] = f1;
            }
            if (n < SEQ / 64 - 2) asm volatile("s_waitcnt vmcnt(10)" ::: "memory"); else asm volatile("s_waitcnt vmcnt(0)" ::: "memory");
            {
                const size_t tlB = (size_t)n * 64 + 16u * (unsigned)tB + l15, tlA = (size_t)n * 64 + 16u * (unsigned)tA + l15;
                const u32x2 wB = {pkbf(oB[0], oB[1]), pkbf(oB[2], oB[3])}, wA = {pkbf(oA[0], oA[1]), pkbf(oA[2], oA[3])};
                *(u32x2*)(vg + tlB * DI + 16u * vs + 4u * g) = wB; *(u32x2*)(vg + tlA * DI + 16u * vs + 4u * g) = wA;
                float sB = (oB[0] * oB[0] + oB[1] * oB[1]) + (oB[2] * oB[2] + oB[3] * oB[3]), sA = (oA[0] * oA[0] + oA[1] * oA[1]) + (oA[2] * oA[2] + oA[3] * oA[3]);
                sB += xor_get(sB, (int)lane, 16); sA += xor_get(sA, (int)lane, 16); sB += xor_get(sB, (int)lane, 32); sA += xor_get(sA, (int)lane, 32);
                if (g == 0) { ss8[(tokb + tlB) * 128 + h * 8 + half * 4 + vs] = sB; ss8[(tokb + tlA) * 128 + h * 8 + half * 4 + vs] = sA; }
            }
            asm volatile("s_waitcnt lgkmcnt(0)" ::: "memory");
            __builtin_amdgcn_s_barrier();
        }
#undef SC_DMA_QK
#undef SC_DMA_V
#undef SC_AT
    }
}
#undef MFMA16
}

#define XB_TMO      128
#define XB_XCNT(j)  (256  + 64 * (j))
#define XB_XSUB(j)  (1280 + 64 * (j))
#define XB_XGEN(j)  (2304 + 64 * (j))
#define XB_TOP      3328
#define XB_TOPGEN   3392
#define XCD_BAR_WORDS 3456
#define XB_SPIN_CAP (1u << 18)
__device__ __forceinline__ unsigned xb_ld(unsigned* p)              { return __hip_atomic_load(p, __ATOMIC_RELAXED, __HIP_MEMORY_SCOPE_AGENT); }
__device__ __forceinline__ unsigned xb_add(unsigned* p, unsigned v) { return __hip_atomic_fetch_add(p, v, __ATOMIC_RELAXED, __HIP_MEMORY_SCOPE_AGENT); }
__device__ __forceinline__ unsigned xb_xcc_id() { return (unsigned)__builtin_amdgcn_s_getreg((3 << 11) | 20) & 0xFu; }
#define XB_SPIN(cond, bar) do { unsigned _sp = 0; while (cond) { __builtin_amdgcn_s_sleep(1); \
    if ((++_sp & 255u) == 0u) { if (xb_ld(&(bar)[XB_TMO])) break; if (_sp > XB_SPIN_CAP) { atomicAdd(&(bar)[XB_TMO], 1u); break; } } } } while (0)
struct XcdBarrier { unsigned* bar; unsigned x; volatile LAS unsigned* st; };
__device__ __forceinline__ XcdBarrier xcd_barrier_post(unsigned* bar, volatile LAS unsigned* st) {
    XcdBarrier b; b.bar = bar; b.x = xb_xcc_id(); b.st = st;
    if (threadIdx.x == 0) (void)xb_add(&bar[XB_XCNT(b.x)], 1u);
    return b;
}
__device__ __forceinline__ void xcd_barrier_complete(unsigned* bar, unsigned x, unsigned& nloc, unsigned& nx) {
    const unsigned G = gridDim.x * gridDim.y * gridDim.z;
    unsigned sum, cnt, mine, sp = 0u;
    for (;;) {
        sum = 0u; cnt = 0u; mine = 0u;
#pragma unroll
        for (unsigned j = 0; j < 16; ++j) { const unsigned c = xb_ld(&bar[XB_XCNT(j)]); sum += c; cnt += (c > 0u) ? 1u : 0u; mine = (j == x) ? c : mine; }
        if (sum == G) break;
        __builtin_amdgcn_s_sleep(1);
        if ((++sp & 255u) == 0u) { if (xb_ld(&bar[XB_TMO])) break; if (sp > XB_SPIN_CAP) { atomicAdd(&bar[XB_TMO], 1u); break; } }
    }
    nloc = mine > 0u ? mine : 1u; nx = cnt > 0u ? cnt : 1u;
}
__device__ __forceinline__ void xcd_barrier(const XcdBarrier& b) {
    asm volatile("s_waitcnt vmcnt(0)" ::: "memory");
    __syncthreads();
    if (threadIdx.x == 0) {
        unsigned* bar = b.bar;
        __builtin_amdgcn_s_waitcnt(0);
        unsigned nloc = b.st[0], nx = b.st[1];
        if (nloc == 0u) { xcd_barrier_complete(bar, b.x, nloc, nx); b.st[0] = nloc; b.st[1] = nx; }
        const unsigned old = xb_add(&bar[XB_XSUB(b.x)], 1u);
        const unsigned gen = old / nloc;
        if (old + 1u == (gen + 1u) * nloc) {
            __builtin_amdgcn_fence(__ATOMIC_RELEASE, "agent");
            asm volatile("s_waitcnt vmcnt(0)" ::: "memory");
            const unsigned og = xb_add(&bar[XB_TOP], 1u);
            const unsigned tg = og / nx;
            if (og + 1u == (tg + 1u) * nx) xb_add(&bar[XB_TOPGEN], 1u);
            else XB_SPIN(xb_ld(&bar[XB_TOPGEN]) == tg, bar);
            __builtin_amdgcn_fence(__ATOMIC_ACQUIRE, "agent");
            xb_add(&bar[XB_XGEN(b.x)], 1u);
            asm volatile("s_waitcnt vmcnt(0)" ::: "memory");
        } else {
            XB_SPIN(xb_ld(&bar[XB_XGEN(b.x)]) == gen, bar);
            __builtin_amdgcn_fence(__ATOMIC_ACQUIRE, "agent");
            asm volatile("s_waitcnt vmcnt(0)" ::: "memory");
        }
    }
    __syncthreads();
}

struct Args {
    const float* x; const float* norm_g; const float* pool_w_in; const float* pool_w_grp; const float* pool_scale; const float* pool_w_out;
    const float* hgrn_w_in; const float* hgrn_lb; const float* hgrn_norm_g; const float* hgrn_w_out; const float* final_g;
    float* out; unsigned char* ws;
};

struct TItem { const float* W; bf16_t* WT; const float* ks; const float* ns; int K, N, row_off, item; float cs; };
__device__ __forceinline__ void titem_issue(const TItem& t, int lane, float (&wv)[32]) {
    const int nblk = t.N / 32, kb = t.item / nblk, nb = t.item % nblk, k0 = 64 * kb, n0 = 32 * nb;
    const float* wp = t.W + (size_t)(k0 + (lane >> 5)) * t.N + n0 + (lane & 31);
#pragma unroll
    for (int i = 0; i < 32; ++i) wv[i] = __builtin_nontemporal_load(wp + (size_t)(2 * i) * t.N);
}
__device__ __forceinline__ void titem_finish(const TItem& t, int lane, const float (&wv)[32], LAS float* scr) {
    const int nblk = t.N / 32, kb = t.item / nblk, nb = t.item % nblk, k0 = 64 * kb, n0 = 32 * nb;
    const float nsv = (t.ns ? t.ns[n0 + (lane & 31)] : 1.0f) * t.cs;
    const float ksv = t.ks ? t.ks[k0 + lane] : 1.0f;
#pragma unroll
    for (int i = 0; i < 32; ++i) { const int kk = 2 * i + (lane >> 5); scr[kk * 33 + (lane & 31)] = wv[i] * nsv * lane_get(ksv, kk); }
    asm volatile("s_waitcnt lgkmcnt(0)" ::: "memory");
    const int c = lane & 7;
#pragma unroll
    for (int j = 0; j < 4; ++j) { const int n = (lane >> 3) + 8 * j; const LAS float* s = scr + (8 * c) * 33 + n;
        u32x4 o; o.x = pkbf(s[0 * 33], s[1 * 33]); o.y = pkbf(s[2 * 33], s[3 * 33]); o.z = pkbf(s[4 * 33], s[5 * 33]); o.w = pkbf(s[6 * 33], s[7 * 33]);
        *(u32x4*)(t.WT + (size_t)(t.row_off + n0 + n) * t.K + k0 + 8 * c) = o; }
    asm volatile("s_waitcnt lgkmcnt(0)" ::: "memory");
}

__global__ void __launch_bounds__(512, 2) fwd_kernel(Args a) {
    extern __shared__ __attribute__((aligned(16))) unsigned char lds_raw[];
    LAS unsigned char* lds = (LAS unsigned char*)lds_raw;
    volatile LAS unsigned* xst = (volatile LAS unsigned*)(lds + XST_OFF);
    if (threadIdx.x < 2) xst[threadIdx.x] = 0u;
    __syncthreads();
    const XcdBarrier xbar = xcd_barrier_post((unsigned*)a.ws, xst);
#define GRID_BAR() xcd_barrier(xbar)
    const int G = gridDim.x, bid = blockIdx.x;
    const int NGW = G * 8;
    const int wave = __builtin_amdgcn_readfirstlane((int)threadIdx.x >> 6);
#define PHASE_IDS int lane_ = fresh_lane_id(); const int lane = lane_, tid = wave * 64 + lane, gw = bid * 8 + wave; (void)gw; (void)tid;
    unsigned char* ws = a.ws;
    bf16_t* Wt_in0 = (bf16_t*)(ws + WS_WIN0); bf16_t* Wt_grp = (bf16_t*)(ws + WS_WGRP); bf16_t* Wt_out0 = (bf16_t*)(ws + WS_WOUT0);
    bf16_t* Wt_in1 = (bf16_t*)(ws + WS_WIN1); bf16_t* Wt_out1 = (bf16_t*)(ws + WS_WOUT1);
    float* invr0 = (float*)(ws + WS_INVR); float* part1 = (float*)(ws + WS_PART1); float* ssb = (float*)(ws + WS_SS); float* decb = (float*)(ws + WS_DEC);
    bf16_t* XB = (bf16_t*)(ws + WS_XB); bf16_t* BA = (bf16_t*)(ws + WS_A); bf16_t* BB = (bf16_t*)(ws + WS_B); bf16_t* BC = (bf16_t*)(ws + WS_C);

    {
        PHASE_IDS
        LAS float* scr = (LAS float*)(lds + wave * 16384);
        constexpr int I_IN0 = (DM / 64) * (2048 / 32), I_GRP1 = (512 / 64) * (512 / 32), I_OUT = (DI / 64) * (DM / 32), I_IN1 = (DM / 64) * (8192 / 32);
        constexpr int NITEMS = I_IN0 + 4 * I_GRP1 + I_OUT + I_IN1 + I_OUT;
        auto decode = [&](int it) -> TItem {
            int r = it;
            if (r < I_IN0) {
                const int kb = r >> 6, nb = r & 63, n0 = 2048 + 32 * nb, d0 = 256 * ((n0 - 2048) >> 7) + 128 + (n0 & 127);
                return TItem{a.pool_w_in, Wt_in0, a.norm_g, nullptr, DM, 4096, d0 - n0, kb * 128 + 64 + nb, NEG_LOG2E}; } r -= I_IN0;
            if (r < 4 * I_GRP1) { const int g = r / I_GRP1; return TItem{a.pool_w_grp + (size_t)g * 512 * 512, Wt_grp, nullptr, a.pool_scale + g * 512, 512, 512, g * 512, r % I_GRP1, 1.0f}; } r -= 4 * I_GRP1;
            if (r < I_OUT) return TItem{a.pool_w_out, Wt_out0, nullptr, nullptr, DI, DM, 0, r, NEG_LN2}; r -= I_OUT;
            if (r < I_IN1) {
                const int n0 = 32 * (r % (8192 / 32)); int d0 = n0;
                if (n0 < 2048) d0 = 256 * (n0 >> 7) + (n0 & 127); else if (n0 < 4096) d0 = 256 * ((n0 - 2048) >> 7) + 128 + (n0 & 127);
                return TItem{a.hgrn_w_in, Wt_in1, a.norm_g + DM, nullptr, DM, 8192, d0 - n0, r, n0 >= 6144 ? NEG_LOG2E : 1.0f}; } r -= I_IN1;
            return TItem{a.hgrn_w_out, Wt_out1, a.hgrn_norm_g, nullptr, DI, DM, 0, r, NEG_LN2};
        };
        {
            float wa[32], wb[32]; TItem ia{}, ib{};
            int it = gw; bool ha = it < NITEMS;
            if (ha) { ia = decode(it); titem_issue(ia, lane, wa); }
            while (ha) {
                const int itb = it + NGW; const bool hb = itb < NITEMS;
                if (hb) { ib = decode(itb); titem_issue(ib, lane, wb); }
                titem_finish(ia, lane, wa, scr);
                it = itb + NGW; ha = it < NITEMS;
                if (ha) { ia = decode(it); titem_issue(ia, lane, wa); }
                if (!hb) break;
                titem_finish(ib, lane, wb, scr);
            }
        }
        for (int idx = gw * 64 + lane; idx < DM * (DI / 8); idx += NGW * 64) {
            const int k = idx >> 8, c8 = (idx & 255) * 8; const float gk = a.norm_g[k];
            const f32x4 w0 = __builtin_nontemporal_load((const f32x4*)(a.pool_w_in + (size_t)k * 4096 + c8)), w1 = __builtin_nontemporal_load((const f32x4*)(a.pool_w_in + (size_t)k * 4096 + c8 + 4));
            u32x4 o; o.x = pkbf(w0[0] * gk, w0[1] * gk); o.y = pkbf(w0[2] * gk, w0[3] * gk); o.z = pkbf(w1[0] * gk, w1[1] * gk); o.w = pkbf(w1[2] * gk, w1[3] * gk);
            *(u32x4*)(BC + (size_t)k * DI + c8) = o; }
    }
    GRID_BAR();

    {
        pg8::Gemm g{Wt_grp, BC, 512, DI, 512, 0, 2}; pg8::StaticOrder S; S.init(DI, DM, G, bid);
        pg8::EpiFold E{Wt_in0};
        pg8::gemm_phase<pg8::EpiFold>(lds, g, S, E, wave);
    }
    {
        PHASE_IDS
        for (int m0 = gw * 8; m0 < M; m0 += NGW * 8) {
            f32x4 v[8][4]; float s[8];
#pragma unroll
            for (int r = 0; r < 8; ++r) { const f32x4* xr = (const f32x4*)(a.x + (size_t)(m0 + r) * DM) + lane;
#pragma unroll
                for (int j = 0; j < 4; ++j) v[r][j] = __builtin_nontemporal_load(xr + 64 * j); }
#pragma unroll
            for (int r = 0; r < 8; ++r) { s[r] = 0.f;
#pragma unroll
                for (int j = 0; j < 4; ++j) s[r] += (v[r][j][0] * v[r][j][0] + v[r][j][1] * v[r][j][1]) + (v[r][j][2] * v[r][j][2] + v[r][j][3] * v[r][j][3]); }
#pragma unroll
            for (int o = 1; o < 64; o <<= 1) {
#pragma unroll
                for (int r = 0; r < 8; ++r) s[r] += xor_get(s[r], lane, o); }
#pragma unroll
            for (int r = 0; r < 8; ++r) { const float rms = sqrtf(s[r] * (1.0f / DM) + EPS), rstd = 1.0f / rms;
                if (lane == 0) invr0[m0 + r] = rms;
                unsigned long long* o8 = (unsigned long long*)(XB + (size_t)(m0 + r) * DM) + lane;
#pragma unroll
                for (int j = 0; j < 4; ++j) o8[64 * j] = (unsigned long long)pkbf(v[r][j][0] * rstd, v[r][j][1] * rstd) | ((unsigned long long)pkbf(v[r][j][2] * rstd, v[r][j][3] * rstd) << 32); }
        }
    }
    GRID_BAR();

    {
        pg8::Gemm g{XB, Wt_in0, DM, DM, DM, 0, 0}; pg8::StaticOrder S; S.init(M, 4096, G, bid);
        pg8::EpiP1 E{BB, (unsigned char*)BA, (unsigned char*)BA + 16 * MiB};
        pg8::gemm_phase<pg8::EpiP1>(lds, g, S, E, wave);
    }
    GRID_BAR();

    {
        PHASE_IDS
        const unsigned char* HALO = (const unsigned char*)BA; const unsigned char* SG0 = (const unsigned char*)BA + 16 * MiB;
        for (int idx = bid * 512 + tid; idx < 120 * 256; idx += G * 512) {
            const int sub = idx & 255, pq = idx >> 8, pm = (pq / 15) * 16 + (pq % 15) + 1;
            const int pn = sub >> 4, wc = (sub >> 2) & 3, fq = sub & 3, w = 2 << (pn >> 2);
            const unsigned char* hp = HALO + (size_t)((pm - 1) * 16 + pn) * pg8::HALO_TILE + (unsigned)((wc * 64 + fq * 16) * 16);
            const unsigned char* sp = SG0 + (size_t)(pm * 16 + pn) * pg8::HALO_TILE + (unsigned)((wc * 64 + fq * 16) * 16);
            bf16_t* zp = BB + (size_t)(pm * 256) * DI + pn * 128 + wc * 32 + fq * 8;
            const float inv = 1.0f / (float)w;
            float suf[8];
#pragma unroll
            for (int c = 0; c < 8; ++c) suf[c] = 0.f;
            for (int i = 15; i >= 17 - w; --i) {
                const u32x4 hv = *(const u32x4*)(hp + i * 16);
                suf[0] += bf_lo(hv.x); suf[1] += bf_hi(hv.x); suf[2] += bf_lo(hv.y); suf[3] += bf_hi(hv.y); suf[4] += bf_lo(hv.z); suf[5] += bf_hi(hv.z); suf[6] += bf_lo(hv.w); suf[7] += bf_hi(hv.w);
                const int t = w - 1 - (16 - i);
                const u32x4 sg = *(const u32x4*)(sp + t * 16);
                u32x4* q = (u32x4*)(zp + (size_t)t * DI); const u32x4 o = *q;
                u32x4 r; r.x = pkbf(bf_lo(o.x) + suf[0] * inv * bf_lo(sg.x), bf_hi(o.x) + suf[1] * inv * bf_hi(sg.x)); r.y = pkbf(bf_lo(o.y) + suf[2] * inv * bf_lo(sg.y), bf_hi(o.y) + suf[3] * inv * bf_hi(sg.y));
                r.z = pkbf(bf_lo(o.z) + suf[4] * inv * bf_lo(sg.z), bf_hi(o.z) + suf[5] * inv * bf_hi(sg.z)); r.w = pkbf(bf_lo(o.w) + suf[6] * inv * bf_lo(sg.w), bf_hi(o.w) + suf[7] * inv * bf_hi(sg.w));
                *q = r;
            }
        }
    }
    GRID_BAR();

    {
        pg8::Gemm g{BB, Wt_out0, DI, DI, DI, 0, 0}; pg8::StaticOrder S; S.init(M, DM, G, bid);
        pg8::EpiRes<true, false> E{XB, invr0, nullptr, XB, part1};
        pg8::gemm_phase<pg8::EpiRes<true, false>>(lds, g, S, E, wave);
    }
    GRID_BAR();

    {
        pg8::Gemm g{XB, Wt_in1, DM, DM, DM, 0, 0}; pg8::StaticOrder S; S.init(M, 6144, G, bid);
        pg8::EpiP4 E{BA, BB, BC, decb, part1, a.hgrn_lb};
        pg8::gemm_phase<pg8::EpiP4>(lds, g, S, E, wave);
    }
    GRID_BAR();

    scan::phase(lds, BA, BB, BC, decb, ssb, bid, G, wave);
    GRID_BAR();

    {
        pg8::Gemm g{XB, Wt_in1 + (size_t)6144 * DM, DM, DM, DM, 0, 0}; pg8::StaticOrder S; S.init(M, DI, G, bid);
        pg8::EpiP5b E{BC, part1, ssb};
        pg8::gemm_phase<pg8::EpiP5b>(lds, g, S, E, wave);
    }
    GRID_BAR();

    {
        pg8::Gemm g{BC, Wt_out1, DI, DI, DI, 0, 0}; pg8::StaticOrder S; S.init(M, DM, G, bid);
        pg8::EpiFinal E{XB, a.out, a.final_g, (float*)(ws + WS_X), (unsigned*)(ws + WS_CNT)};
        pg8::gemm_phase<pg8::EpiFinal>(lds, g, S, E, wave);
    }
}

extern "C" void kernel_launch(void* const* d_in, const int* in_sizes, int n_in, void* d_out, int out_size, void* d_ws, size_t ws_size, hipStream_t stream) {
    static int grid = 0;
    if (grid == 0) {
        if (n_in != 11 || in_sizes[0] != M * DM || out_size != M * DM || ws_size < WS_END) { fprintf(stderr, "kernel_launch: unexpected shapes (n_in %d in0 %d out %d ws %zu)\n", n_in, n_in > 0 ? in_sizes[0] : -1, out_size, ws_size); grid = -1; return; }
        int dev = 0, cus = 0, per = 0;
        if (hipGetDevice(&dev) != hipSuccess || hipDeviceGetAttribute(&cus, hipDeviceAttributeMultiprocessorCount, dev) != hipSuccess) { grid = -1; return; }
        if (hipFuncSetAttribute((const void*)fwd_kernel, hipFuncAttributeMaxDynamicSharedMemorySize, LDS_BYTES) != hipSuccess) { fprintf(stderr, "kernel_launch: hipFuncSetAttribute failed\n"); grid = -1; return; }
        if (hipOccupancyMaxActiveBlocksPerMultiprocessor(&per, (const void*)fwd_kernel, 512, LDS_BYTES) != hipSuccess || per < 1) { fprintf(stderr, "kernel_launch: occupancy query says %d\n", per); (void)hipGetLastError(); grid = -1; return; }
        grid = cus;
        fprintf(stderr, "kernel_launch: cus %d per_cu %d grid %d\n", cus, per, grid);
    }
    if (grid < 0) return;
    if (hipMemsetAsync(d_ws, 0, 32768, stream) != hipSuccess) { fprintf(stderr, "kernel_launch: hipMemsetAsync failed\n"); return; }
    Args a{};
    a.x = (const float*)d_in[0]; a.norm_g = (const float*)d_in[1]; a.pool_w_in = (const float*)d_in[2]; a.pool_w_grp = (const float*)d_in[3];
    a.pool_scale = (const float*)d_in[4]; a.pool_w_out = (const float*)d_in[5]; a.hgrn_w_in = (const float*)d_in[6]; a.hgrn_lb = (const float*)d_in[7];
    a.hgrn_norm_g = (const float*)d_in[8]; a.hgrn_w_out = (const float*)d_in[9]; a.final_g = (const float*)d_in[10];
    a.out = (float*)d_out; a.ws = (unsigned char*)d_ws;
    void* args[] = {&a};
    hipError_t e = hipLaunchCooperativeKernel((void*)fwd_kernel, dim3(grid), dim3(512), args, LDS_BYTES, stream);
    if (e != hipSuccess) fprintf(stderr, "kernel_launch: cooperative launch failed: %s (grid %d)\n", hipGetErrorString(e), grid);
}
```
